# Optimizing an MI355X kernel written in HIP

```python
import math
import jax, jax.numpy as jnp
from jax import lax
import numpy as np

D_MODEL = 2048
BATCH = 8
SEQ = 2048
DEPTH = 1

HEAD_DIM = 128
N_HEADS_SB = 8
N_HEADS_MOBA = 8
W_SB = N_HEADS_SB * HEAD_DIM
W_MOBA = N_HEADS_MOBA * HEAD_DIM
W_MIX = W_SB + W_MOBA
SB_BLOCK = 128
MOBA_BLOCK = 256
MOBA_TOP_K = 3
MOBA_Q_CHUNK = 16
ROPE_DIM = HEAD_DIM // 4
ROPE_THETA = 500000.0
N_MEM = 256
N_HEADS_X = 4
W_X = N_HEADS_X * HEAD_DIM
D_FF = ((8 * D_MODEL + 3 * 256 - 1) // (3 * 256)) * 256
EPS = 1e-6
ATTN_SCALE = HEAD_DIM ** -0.5

kernel_name = "hybrid_stickbreak_moba_memxattn_swiglu"


def rmsnorm(x, g):
    xf = x.astype(jnp.float32)
    y = xf * lax.rsqrt(jnp.mean(xf * xf, axis=-1, keepdims=True) + EPS)
    return (y * g.astype(jnp.float32)).astype(x.dtype)


def partial_rotary(x, positions):
    half = ROPE_DIM // 2
    inv_freq = ROPE_THETA ** (-jnp.arange(0, ROPE_DIM, 2, dtype=jnp.float32) / ROPE_DIM)
    ang = positions.astype(jnp.float32)[:, None, :, None] * inv_freq
    cos, sin = jnp.cos(ang), jnp.sin(ang)
    xf = x.astype(jnp.float32)
    x1, x2, rest = xf[..., :half], xf[..., half:ROPE_DIM], xf[..., ROPE_DIM:]
    out = jnp.concatenate([x1 * cos - x2 * sin, x2 * cos + x1 * sin, rest], axis=-1)
    return out.astype(x.dtype)


def stick_breaking_attention(q, k, v):
    S = q.shape[2]
    outs = []
    for i in range(S // SB_BLOCK):
        t0, t1 = i * SB_BLOCK, (i + 1) * SB_BLOCK
        qb = q[:, :, t0:t1].astype(jnp.float32)
        kb = k[:, :, :t1].astype(jnp.float32)
        vb = v[:, :, :t1]
        z = jnp.einsum('bhtd,bhsd->bhts', qb, kb) * ATTN_SCALE
        t_pos = t0 + jnp.arange(SB_BLOCK)[:, None]
        s_pos = jnp.arange(t1)[None, :]
        past = s_pos < t_pos
        log_1m_beta = jnp.where(past, jax.nn.log_sigmoid(-z), 0.0)
        after = lax.cumsum(log_1m_beta, axis=3, reverse=True) - log_1m_beta
        w = jnp.where(past, jnp.exp(jax.nn.log_sigmoid(z) + after), 0.0)
        outs.append(jnp.einsum('bhts,bhsd->bhtd', w.astype(vb.dtype), vb))
    return jnp.concatenate(outs, axis=2)


def moba_attention(q, k, v):
    B, H, S, d = q.shape
    NB = -(-S // MOBA_BLOCK)
    pad = NB * MOBA_BLOCK - S
    kp = jnp.pad(k, ((0, 0), (0, 0), (0, pad), (0, 0)))
    vp = jnp.pad(v, ((0, 0), (0, 0), (0, pad), (0, 0)))
    kblk = kp.reshape(B, H, NB, MOBA_BLOCK, d)
    vblk = vp.reshape(B, H, NB, MOBA_BLOCK, d)
    kmean = jnp.mean(kblk.astype(jnp.float32), axis=3)
    n_sel = min(MOBA_TOP_K, NB)
    bi = jnp.arange(B)[:, None, None, None]
    hi = jnp.arange(H)[None, :, None, None]

    def chunk(ci):
        t0 = ci * MOBA_Q_CHUNK
        blk = t0 // MOBA_BLOCK
        qc = lax.dynamic_slice_in_dim(q, t0, MOBA_Q_CHUNK, axis=2).astype(jnp.float32)
        gate = jnp.einsum('bhqd,bhnd->bhqn', qc, kmean)
        fully_past = jnp.arange(NB) < blk
        gate = jnp.where(fully_past, gate, -jnp.inf)
        top_val, top_idx = lax.top_k(gate, n_sel)
        valid = jnp.isfinite(top_val)
        kg = kblk[bi, hi, top_idx]
        vg = vblk[bi, hi, top_idx]
        s_sel = jnp.einsum('bhqd,bhqncd->bhqnc', qc, kg.astype(jnp.float32)) * ATTN_SCALE
        s_sel = jnp.where(valid[..., None], s_sel, -jnp.inf)
        s_sel = s_sel.reshape(B, H, MOBA_Q_CHUNK, n_sel * MOBA_BLOCK)
        k_own = lax.dynamic_slice_in_dim(kp, blk * MOBA_BLOCK, MOBA_BLOCK, axis=2)
        v_own = lax.dynamic_slice_in_dim(vp, blk * MOBA_BLOCK, MOBA_BLOCK, axis=2)
        s_own = jnp.einsum('bhqd,bhcd->bhqc', qc, k_own.astype(jnp.float32)) * ATTN_SCALE
        key_pos = blk * MOBA_BLOCK + jnp.arange(MOBA_BLOCK)
        q_pos = t0 + jnp.arange(MOBA_Q_CHUNK)
        s_own = jnp.where(key_pos[None, :] <= q_pos[:, None], s_own, -jnp.inf)
        p = jax.nn.softmax(jnp.concatenate([s_sel, s_own], axis=-1), axis=-1)
        p_sel = p[..., :n_sel * MOBA_BLOCK].reshape(B, H, MOBA_Q_CHUNK, n_sel, MOBA_BLOCK)
        p_own = p[..., n_sel * MOBA_BLOCK:]
        return (jnp.einsum('bhqnc,bhqncd->bhqd', p_sel.astype(v.dtype), vg)
                + jnp.einsum('bhqc,bhcd->bhqd', p_own.astype(v.dtype), v_own))

    outs = lax.map(chunk, jnp.arange(S // MOBA_Q_CHUNK))
    return outs.transpose(1, 2, 0, 3, 4).reshape(B, H, S, d)


def split_heads(t, n_heads):
    B, S, _ = t.shape
    return t.reshape(B, S, n_heads, HEAD_DIM).transpose(0, 2, 1, 3)


def parallel_mixer(h, positions, w_in, g_out_sb, g_out_moba, w_out):
    B, S, _ = h.shape
    proj = h @ w_in
    q_sb, k_sb, v_sb, q_mb, k_mb, v_mb = jnp.split(
        proj, [W_SB, 2 * W_SB, 3 * W_SB, 3 * W_SB + W_MOBA, 3 * W_SB + 2 * W_MOBA], axis=-1)
    o_sb = stick_breaking_attention(split_heads(q_sb, N_HEADS_SB),
                                    split_heads(k_sb, N_HEADS_SB),
                                    split_heads(v_sb, N_HEADS_SB))
    q_mb = partial_rotary(split_heads(q_mb, N_HEADS_MOBA), positions)
    k_mb = partial_rotary(split_heads(k_mb, N_HEADS_MOBA), positions)
    o_mb = moba_attention(q_mb, k_mb, split_heads(v_mb, N_HEADS_MOBA))
    o_sb = rmsnorm(o_sb.transpose(0, 2, 1, 3), g_out_sb.reshape(N_HEADS_SB, HEAD_DIM))
    o_mb = rmsnorm(o_mb.transpose(0, 2, 1, 3), g_out_moba.reshape(N_HEADS_MOBA, HEAD_DIM))
    o = jnp.concatenate([o_sb.reshape(B, S, W_SB), o_mb.reshape(B, S, W_MOBA)], axis=-1)
    return o @ w_out


def memory_cross_attention(h, m, w_xq, w_xkv, w_xo):
    B, S, _ = h.shape
    q = split_heads(h @ w_xq, N_HEADS_X).astype(jnp.float32)
    kv = (m @ w_xkv).reshape(B, N_MEM, 2, N_HEADS_X, HEAD_DIM)
    k = kv[:, :, 0].transpose(0, 2, 1, 3)
    v = kv[:, :, 1].transpose(0, 2, 1, 3)
    s = jnp.einsum('bhsd,bhmd->bhsm', q, k.astype(jnp.float32)) * ATTN_SCALE
    p = jax.nn.softmax(s, axis=-1)
    o = jnp.einsum('bhsm,bhmd->bhsd', p.astype(v.dtype), v)
    return o.transpose(0, 2, 1, 3).reshape(B, S, W_X) @ w_xo


def swiglu(h, w_gate_up, w_down):
    gu = h @ w_gate_up
    g, u = jnp.split(gu, 2, axis=-1)
    return (jax.nn.silu(g) * u) @ w_down


def setup_inputs(seed: int = 0) -> dict:
    key = jax.random.key(seed)
    ks = jax.random.split(key, 16)

    def w(k, fan_in, fan_out):
        return jax.random.normal(k, (fan_in, fan_out), jnp.float32) * fan_in ** -0.5

    def gain(k, n):
        return 1.0 + 0.01 * jax.random.normal(k, (n,), jnp.float32)

    x = jax.random.normal(ks[0], (BATCH, SEQ, D_MODEL), jnp.float32)
    mem = jax.random.normal(ks[1], (BATCH, N_MEM, D_MODEL), jnp.float32)
    offset = jax.random.randint(ks[2], (BATCH, 1), 0, 4096, dtype=jnp.int32)
    positions = offset + jnp.arange(SEQ, dtype=jnp.int32)[None, :]
    return {
        "x": x,
        "mem": mem,
        "positions": positions,
        "g_mix": gain(ks[3], D_MODEL),
        "w_in": w(ks[4], D_MODEL, 3 * W_SB + 3 * W_MOBA),
        "g_out_sb": gain(ks[5], W_SB),
        "g_out_moba": gain(ks[6], W_MOBA),
        "w_out": w(ks[7], W_MIX, D_MODEL),
        "g_xattn": gain(ks[8], D_MODEL),
        "g_mem": gain(ks[9], D_MODEL),
        "w_xq": w(ks[10], D_MODEL, W_X),
        "w_xkv": w(ks[11], D_MODEL, 2 * W_X),
        "w_xo": w(ks[12], W_X, D_MODEL),
        "g_ffn": gain(ks[13], D_MODEL),
        "w_gate_up": w(ks[14], D_MODEL, 2 * D_FF),
        "w_down": w(ks[15], D_FF, D_MODEL),
        "g_final": gain(jax.random.fold_in(key, 99), D_MODEL),
    }


def reference(x, mem, positions, g_mix, w_in, g_out_sb, g_out_moba, w_out,
              g_xattn, g_mem, w_xq, w_xkv, w_xo, g_ffn, w_gate_up, w_down, g_final):
    m = rmsnorm(mem, g_mem)
    for _ in range(DEPTH):
        x = x + parallel_mixer(rmsnorm(x, g_mix), positions, w_in, g_out_sb, g_out_moba, w_out)
        x = x + memory_cross_attention(rmsnorm(x, g_xattn), m, w_xq, w_xkv, w_xo)
        x = x + swiglu(rmsnorm(x, g_ffn), w_gate_up, w_down)
    return rmsnorm(x, g_final)
```

```cpp
#include <hip/hip_runtime.h>
#include <hip/hip_cooperative_groups.h>
#include <cstdio>
#include <cstdint>
namespace cg = cooperative_groups;
namespace pg8 {
#define PG8_LAS __attribute__((address_space(3)))
typedef unsigned short bf16_t;
typedef short bf16x8 __attribute__((ext_vector_type(8)));
typedef float f32x4 __attribute__((ext_vector_type(4)));
typedef unsigned u32x4 __attribute__((ext_vector_type(4)));
constexpr int BM = 256, BK = 64, HALF = 128, HTB = HALF * BK * 2  , STAGE_BYTES = 8 * HTB, NXCD = 8, WGM = 8;

__host__ __device__ __forceinline__ int lds_byte(int r, int c) { const int st = (r >> 4) * 2 + (c >> 5), rr = r & 15, cc = c & 31, ob = rr * 64 + cc * 2; return st * 1024 + (ob ^ (((ob >> 9) & 1) << 5)); }
__host__ __device__ __forceinline__ void stage_rc(int b, int& R, int& C) { const int st = b / 1024, sb = b % 1024, swz = sb ^ (((sb >> 9) & 1) << 5); R = (st >> 1) * 16 + swz / 64; C = (st & 1) * 32 + (swz % 64) / 2; }
__host__ __device__ __forceinline__ int perm32(int rho) { const int n = rho >> 4, i = rho & 15; return 8 * (i >> 2) + 4 * n + (i & 3); }

struct Unit { int pm, pn; };
struct Gemm { const bf16_t* A; const bf16_t* Bt; int M, N, K; };

struct StaticOrder {
    int nM, nN, nwg, G, c;
    __host__ __device__ void init(int M, int N, int G_, int c_) { nM = M / BM; nN = N / BM; nwg = nM * nN; G = G_; c = c_; }
    __host__ __device__ bool next(int i, Unit& u) const {
        const long L = (long)i * G + c; if (L >= nwg) return false;
        int wgid = (int)L; { const int q = nwg / NXCD, r = nwg % NXCD, xcd = wgid % NXCD, off = wgid / NXCD; wgid = (xcd < r ? xcd * (q + 1) : r * (q + 1) + (xcd - r) * q) + off; }
        const int nig = WGM * nN, gid = wgid / nig, fm = gid * WGM, gsz = (nM - fm) < WGM ? (nM - fm) : WGM;
        u.pm = fm + ((wgid % nig) % gsz); u.pn = (wgid % nig) / gsz; return true;
    }
    __device__ __forceinline__ void a_ready(const Unit&) const {}
    __device__ __forceinline__ void done(const Unit&) const {}
};

__device__ __forceinline__ unsigned cvt_pk_bf16(float lo, float hi) { unsigned r; asm volatile("v_cvt_pk_bf16_f32 %0, %1, %2" : "=v"(r) : "v"(lo), "v"(hi)); return r; }
typedef float f32x2 __attribute__((ext_vector_type(2)));
template <class Epi, class Sched, bool ALIGN_EPI = false, bool SP2 = false>
__device__ __forceinline__ void gemm_phase(PG8_LAS unsigned char* lds, const Gemm g, const Sched& S, const Epi& E) {
    const int tid = threadIdx.x, wid = __builtin_amdgcn_readfirstlane(tid >> 6), lane = tid & 63, wr = wid >> 2, wc = wid & 3, fr = lane & 15, fq = lane >> 4;
    const int K = g.K, nt = K / BK;
    unsigned voffA[2], voffB[2];
#pragma unroll
    for (int i = 0; i < 2; ++i) { int R, C; stage_rc(tid * 16 + i * 8192, R, C); const int Rb = Epi::PERM ? ((R & ~31) + perm32(R & 31)) : R;
        voffA[i] = (unsigned)(R * K + C) * 2u; voffB[i] = (unsigned)(Rb * K + C) * 2u; }
    const size_t kstep = (size_t)(BK * 2);
    const size_t hstep = (size_t)HALF * K * 2;
    const size_t tstep = 2 * hstep;
    const unsigned ldsw = (unsigned)wid * 1024u;
    const int aoff = lds_byte(wr * 64 + fr, fq * 8), boff = lds_byte(wc * 32 + fr, fq * 8);
#define PG8_SA(b, h) (((b) * 2 + (h)) * HTB)
#define PG8_SB(b, h) ((4 + (b) * 2 + (h)) * HTB)
#define PG8_STAGE(bufoff, gbase, voff) do { _Pragma("unroll") for (int _i = 0; _i < 2; ++_i) \
        __builtin_amdgcn_global_load_lds((const unsigned*)((const char*)(gbase) + (voff)[_i]), (PG8_LAS unsigned*)(lds + (bufoff) + ldsw + _i * 8192), 16, 0, 0); } while (0)
#define PG8_LDA(dst, b, h) do { _Pragma("unroll") for (int m = 0; m < 4; ++m) _Pragma("unroll") for (int k = 0; k < 2; ++k) dst[m][k] = *(const PG8_LAS bf16x8*)(lds + PG8_SA(b, h) + aoff + m * 2048 + k * 1024); } while (0)
#define PG8_LDB(dst, b, h) do { _Pragma("unroll") for (int n = 0; n < 2; ++n) _Pragma("unroll") for (int k = 0; k < 2; ++k) dst[n][k] = *(const PG8_LAS bf16x8*)(lds + PG8_SB(b, h) + boff + n * 2048 + k * 1024); } while (0)
#define PG8_MMA(ai, bj, At, Bt) do { __builtin_amdgcn_s_setprio(1); _Pragma("unroll") for (int m = 0; m < 4; ++m) _Pragma("unroll") for (int n = 0; n < 2; ++n) _Pragma("unroll") for (int k = 0; k < 2; ++k) \
        acc[ai][bj][m][n] = __builtin_amdgcn_mfma_f32_16x16x32_bf16(Bt[n][k], At[m][k], acc[ai][bj][m][n], 0, 0, 0); __builtin_amdgcn_s_setprio(0); } while (0)
#define PG8_WAIT_V(n) asm volatile("s_waitcnt vmcnt(" #n ")" ::: "memory")
#define PG8_WAIT_L(n) asm volatile("s_waitcnt lgkmcnt(" #n ")" ::: "memory")
#define PG8_BAR __builtin_amdgcn_s_barrier()
#define PG8_SCHED __builtin_amdgcn_sched_barrier(0)
    Unit cur, nxt; int ui = 0;
    if (!S.next(0, cur)) return;
    f32x4 acc[2][2][4][2];
#pragma unroll
    for (int a = 0; a < 2; ++a)
#pragma unroll
        for (int b = 0; b < 2; ++b)
#pragma unroll
            for (int m = 0; m < 4; ++m)
#pragma unroll
                for (int n = 0; n < 2; ++n) acc[a][b][m][n] = (f32x4){0.f, 0.f, 0.f, 0.f};
    bf16x8 At[4][2], B0[2][2], B1[2][2];
    const char* cA = (const char*)g.A + (size_t)cur.pm * tstep; const char* cB = (const char*)g.Bt + (size_t)cur.pn * tstep;
    S.a_ready(cur);
    if constexpr (SP2) {
        PG8_STAGE(PG8_SB(0, 0), cB, voffB); PG8_STAGE(PG8_SB(0, 1), cB + hstep, voffB); PG8_STAGE(PG8_SA(0, 0), cA, voffA); PG8_STAGE(PG8_SA(0, 1), cA + hstep, voffA);
        if (wr == 1) PG8_BAR;
        PG8_WAIT_V(2); PG8_BAR;
        PG8_STAGE(PG8_SB(1, 0), cB + kstep, voffB); PG8_STAGE(PG8_SA(1, 0), cA + kstep, voffA); PG8_STAGE(PG8_SB(1, 1), cB + hstep + kstep, voffB);
        PG8_WAIT_V(6); PG8_BAR;
    } else {
        PG8_STAGE(PG8_SB(0, 0), cB, voffB); PG8_STAGE(PG8_SA(0, 0), cA, voffA); PG8_STAGE(PG8_SB(0, 1), cB + hstep, voffB); PG8_STAGE(PG8_SA(0, 1), cA + hstep, voffA);
        if (wr == 1) PG8_BAR;
        PG8_WAIT_V(4); PG8_BAR;
        PG8_STAGE(PG8_SB(1, 0), cB + kstep, voffB); PG8_STAGE(PG8_SA(1, 0), cA + kstep, voffA); PG8_STAGE(PG8_SB(1, 1), cB + hstep + kstep, voffB);
        PG8_WAIT_V(6); PG8_BAR;
    }
    for (;;) {
        const bool has_next = S.next(ui + 1, nxt);
        const char* nA = has_next ? (const char*)g.A + (size_t)nxt.pm * tstep : cA; const char* nB = has_next ? (const char*)g.Bt + (size_t)nxt.pn * tstep : cB;
        for (int t = 0; t < nt; t += 2) {
            const bool last = (t == nt - 2);
            const char* a1 = cA + (size_t)(t + 1) * kstep;
            const char* a2 = last ? nA : cA + (size_t)(t + 2) * kstep; const char* b2 = last ? nB : cB + (size_t)(t + 2) * kstep;
            const char* a3 = a2 + kstep; const char* b3 = b2 + kstep;
            if (last && has_next) S.a_ready(nxt);
            if constexpr (SP2) {
            PG8_LDB(B0, 0, 0); PG8_LDB(B1, 0, 1); PG8_SCHED; PG8_LDA(At, 0, 0); PG8_STAGE(PG8_SA(1, 1), a1 + hstep, voffA);
            PG8_WAIT_V(8); PG8_WAIT_L(0); PG8_BAR; PG8_MMA(0, 0, At, B0); PG8_MMA(0, 1, At, B1); PG8_BAR; PG8_SCHED;
            PG8_LDA(At, 0, 1); PG8_STAGE(PG8_SB(0, 0), b2, voffB); PG8_STAGE(PG8_SB(0, 1), b2 + hstep, voffB); PG8_STAGE(PG8_SA(0, 0), a2, voffA);
            PG8_WAIT_V(8); PG8_WAIT_L(0); PG8_BAR; PG8_MMA(1, 0, At, B0); PG8_MMA(1, 1, At, B1); PG8_BAR; PG8_SCHED;
            PG8_LDB(B0, 1, 0); PG8_LDB(B1, 1, 1); PG8_SCHED; PG8_LDA(At, 1, 0); PG8_STAGE(PG8_SA(0, 1), a2 + hstep, voffA);
            PG8_WAIT_V(8); PG8_WAIT_L(0); PG8_BAR; PG8_MMA(0, 0, At, B0); PG8_MMA(0, 1, At, B1); PG8_BAR; PG8_SCHED;
            PG8_LDA(At, 1, 1); PG8_STAGE(PG8_SB(1, 0), b3, voffB); PG8_STAGE(PG8_SB(1, 1), b3 + hstep, voffB); PG8_STAGE(PG8_SA(1, 0), a3, voffA);
            PG8_WAIT_V(8); PG8_WAIT_L(0); PG8_BAR; PG8_MMA(1, 0, At, B0); PG8_MMA(1, 1, At, B1); PG8_BAR; PG8_SCHED;
            } else {
            PG8_LDB(B0, 0, 0); PG8_SCHED; PG8_LDA(At, 0, 0); PG8_STAGE(PG8_SA(1, 1), a1 + hstep, voffA);
            PG8_WAIT_L(8); PG8_BAR; PG8_WAIT_L(0); PG8_MMA(0, 0, At, B0); PG8_BAR; PG8_SCHED;
            PG8_LDB(B1, 0, 1); PG8_STAGE(PG8_SB(0, 0), b2, voffB);
            PG8_BAR; PG8_WAIT_L(0); PG8_MMA(0, 1, At, B1); PG8_BAR;
            PG8_LDA(At, 0, 1); PG8_STAGE(PG8_SA(0, 0), a2, voffA);
            PG8_BAR; PG8_WAIT_L(0); PG8_MMA(1, 0, At, B0); PG8_BAR; PG8_SCHED;
            PG8_STAGE(PG8_SB(0, 1), b2 + hstep, voffB);
            PG8_WAIT_V(6); PG8_BAR; PG8_MMA(1, 1, At, B1); PG8_BAR;
            PG8_LDB(B0, 1, 0); PG8_SCHED; PG8_LDA(At, 1, 0); PG8_STAGE(PG8_SA(0, 1), a2 + hstep, voffA);
            PG8_WAIT_L(8); PG8_BAR; PG8_WAIT_L(0); PG8_MMA(0, 0, At, B0); PG8_BAR; PG8_SCHED;
            PG8_LDB(B1, 1, 1); PG8_STAGE(PG8_SB(1, 0), b3, voffB);
            PG8_BAR; PG8_WAIT_L(0); PG8_MMA(0, 1, At, B1); PG8_BAR;
            PG8_LDA(At, 1, 1); PG8_STAGE(PG8_SA(1, 0), a3, voffA);
            PG8_BAR; PG8_WAIT_L(0); PG8_MMA(1, 0, At, B0); PG8_BAR; PG8_SCHED;
            PG8_STAGE(PG8_SB(1, 1), b3 + hstep, voffB);
            PG8_WAIT_V(6); PG8_BAR; PG8_MMA(1, 1, At, B1); PG8_BAR;
            }
        }
        if constexpr (ALIGN_EPI) { if (wr == 0) PG8_BAR; }
        if constexpr (!Epi::AFTER_DRAIN) { E(acc, cur, wr, wc, fr, fq); S.done(cur); }
        if (!has_next) break;
#pragma unroll
        for (int a = 0; a < 2; ++a)
#pragma unroll
            for (int b = 0; b < 2; ++b)
#pragma unroll
                for (int m = 0; m < 4; ++m)
#pragma unroll
                    for (int n = 0; n < 2; ++n) acc[a][b][m][n] = (f32x4){0.f, 0.f, 0.f, 0.f};
        cur = nxt; cA = nA; cB = nB; ++ui;
        if constexpr (ALIGN_EPI) { if (wr == 1) PG8_BAR; }
    }
    PG8_WAIT_V(0);
    if constexpr (!ALIGN_EPI) { if (wr == 0) PG8_BAR; }
    PG8_BAR;
    if constexpr (Epi::AFTER_DRAIN) { E.fused(acc, cur, wr, wc, fr, fq, lds, wid, lane); S.done(cur); }
#undef PG8_SA
#undef PG8_SB
#undef PG8_STAGE
#undef PG8_LDA
#undef PG8_LDB
#undef PG8_MMA
#undef PG8_WAIT_V
#undef PG8_WAIT_L
#undef PG8_BAR
#undef PG8_SCHED
}
}
namespace pg8 {
typedef unsigned u32x2 __attribute__((ext_vector_type(2)));
constexpr int LDX = 2048;
constexpr float RMS_EPS = 1e-6f;
struct EpiQKV {
    static constexpr bool PERM = true, AFTER_DRAIN = false;
    bf16_t* O; const float* cs; float qscale;
    __device__ __forceinline__ void operator()(const f32x4 (&acc)[2][2][4][2], const Unit& u, int wr, int wc, int fr, int fq) const {
        const int row0 = u.pm * BM + wr * 64 + fr, col0 = u.pn * BM + wc * 32 + 8 * fq, pn = u.pn;
        const float sc = (pn < 4 || (pn >= 12 && pn < 16)) ? qscale : 1.f;
        const bool rot = (pn >= 12 && pn < 20) && (wc == 0);
#pragma unroll
        for (int ai = 0; ai < 2; ++ai)
#pragma unroll
            for (int m = 0; m < 4; ++m) { const int row = row0 + ai * HALF + m * 16; bf16_t* rowp = O + (size_t)row * 6144 + col0;
                f32x4 c0 = {1.f, 1.f, 1.f, 1.f}, c1 = c0, s0 = {0.f, 0.f, 0.f, 0.f}, s1 = s0;
                if (rot) { const float* cr = cs + (size_t)row * 32 + 8 * (fq & 1); c0 = *(const f32x4*)cr; c1 = *(const f32x4*)(cr + 4); s0 = *(const f32x4*)(cr + 16); s1 = *(const f32x4*)(cr + 20);
                    if (fq < 2) { s0 = -s0; s1 = -s1; } }
#pragma unroll
                for (int bj = 0; bj < 2; ++bj) { f32x4 v0 = acc[ai][bj][m][0], v1 = acc[ai][bj][m][1];
                    if (rot) { f32x4 p0, p1;
#pragma unroll
                        for (int j = 0; j < 4; ++j) { p0[j] = __shfl_xor(v0[j], 32); p1[j] = __shfl_xor(v1[j], 32); }
                        v0 = v0 * c0 + p0 * s0; v1 = v1 * c1 + p1 * s1; }
                    v0 = v0 * sc; v1 = v1 * sc; u32x4 w; w.x = cvt_pk_bf16(v0[0], v0[1]); w.y = cvt_pk_bf16(v0[2], v0[3]); w.z = cvt_pk_bf16(v1[0], v1[1]); w.w = cvt_pk_bf16(v1[2], v1[3]);
                    *(u32x4*)(rowp + bj * HALF) = w; } }
    }
};
struct EpiRes {
    static constexpr bool PERM = false, AFTER_DRAIN = false;
    const float* base; float* out; bf16_t* xb; float* ssq;
    __device__ __forceinline__ void operator()(const f32x4 (&acc)[2][2][4][2], const Unit& u, int wr, int wc, int fr, int fq) const {
        const int row0 = u.pm * BM + wr * 64 + fr, col0 = u.pn * BM + wc * 32 + 4 * fq;
#pragma unroll
        for (int ai = 0; ai < 2; ++ai)
#pragma unroll
            for (int m = 0; m < 4; ++m) { const int row = row0 + ai * HALF + m * 16; const size_t off = (size_t)row * LDX + col0; float s = 0.f;
#pragma unroll
                for (int bj = 0; bj < 2; ++bj)
#pragma unroll
                    for (int n = 0; n < 2; ++n) { const f32x4 v = *(const f32x4*)(base + off + bj * HALF + n * 16) + acc[ai][bj][m][n];
                        *(f32x4*)(out + off + bj * HALF + n * 16) = v; s += (v[0] * v[0] + v[1] * v[1]) + (v[2] * v[2] + v[3] * v[3]);
                        if (xb) { u32x2 w; w.x = cvt_pk_bf16(v[0], v[1]); w.y = cvt_pk_bf16(v[2], v[3]); *(u32x2*)(xb + off + bj * HALF + n * 16) = w; } }
                if (ssq) { s += __shfl_xor(s, 16); s += __shfl_xor(s, 32); if (fq == 0) atomicAdd(ssq + row, s); }
                asm volatile("" ::: "memory"); }
    }
};
struct EpiScale {
    static constexpr bool PERM = true, AFTER_DRAIN = false;
    bf16_t* O; int ldc; const float* ssq; float sc;
    __device__ __forceinline__ void operator()(const f32x4 (&acc)[2][2][4][2], const Unit& u, int wr, int wc, int fr, int fq) const {
        const int row0 = u.pm * BM + wr * 64 + fr, col0 = u.pn * BM + wc * 32 + 8 * fq;
#pragma unroll
        for (int ai = 0; ai < 2; ++ai)
#pragma unroll
            for (int m = 0; m < 4; ++m) { const int row = row0 + ai * HALF + m * 16; bf16_t* rowp = O + (size_t)row * ldc + col0;
                const float f = ssq ? sc * __builtin_amdgcn_rsqf(ssq[row] * (1.0f / 2048.0f) + RMS_EPS) : sc;
#pragma unroll
                for (int bj = 0; bj < 2; ++bj) { const f32x4 v0 = acc[ai][bj][m][0] * f, v1 = acc[ai][bj][m][1] * f;
                    u32x4 w; w.x = cvt_pk_bf16(v0[0], v0[1]); w.y = cvt_pk_bf16(v0[2], v0[3]); w.z = cvt_pk_bf16(v1[0], v1[1]); w.w = cvt_pk_bf16(v1[2], v1[3]);
                    *(u32x4*)(rowp + bj * HALF) = w; } }
    }
};
struct EpiSwiGLU {
    static constexpr bool PERM = true, AFTER_DRAIN = false;
    bf16_t* O; const float* ssq;
    __device__ __forceinline__ void operator()(const f32x4 (&acc)[2][2][4][2], const Unit& u, int wr, int wc, int fr, int fq) const {
        const int row0 = u.pm * BM + wr * 64 + fr, col0 = u.pn * HALF + wc * 32 + 8 * fq;
#pragma unroll
        for (int ai = 0; ai < 2; ++ai)
#pragma unroll
            for (int m = 0; m < 4; ++m) { const int row = row0 + ai * HALF + m * 16; bf16_t* rowp = O + (size_t)row * 5632 + col0;
                const float f = __builtin_amdgcn_rsqf(ssq[row] * (1.0f / 2048.0f) + RMS_EPS);
                float r[8];
#pragma unroll
                for (int n = 0; n < 2; ++n)
#pragma unroll
                    for (int j = 0; j < 4; ++j) { const float g = acc[ai][0][m][n][j] * f, uu = acc[ai][1][m][n][j] * f;
                        const float sg = g * __builtin_amdgcn_rcpf(1.0f + __builtin_amdgcn_exp2f(-1.4426950408889634f * g)); r[n * 4 + j] = sg * uu; }
                u32x4 w; w.x = cvt_pk_bf16(r[0], r[1]); w.y = cvt_pk_bf16(r[2], r[3]); w.z = cvt_pk_bf16(r[4], r[5]); w.w = cvt_pk_bf16(r[6], r[7]);
                *(u32x4*)rowp = w; }
    }
};
}
#define GAS __attribute__((address_space(1)))
#define LAS __attribute__((address_space(3)))
typedef unsigned short bf16;
typedef unsigned v4u __attribute__((ext_vector_type(4)));
typedef float f32x4 __attribute__((ext_vector_type(4)));
#define LDS_WAIT() asm volatile("s_waitcnt lgkmcnt(0)" ::: "memory")
constexpr int NWAVES = 8;
constexpr int BATCH = 8, SEQ = 2048, DM = 2048, M = BATCH * SEQ, HD = 128, NH = 8;
constexpr int NQKV = 6144, FF = 5632, WX = 512, NMEM = 256, MMEM = BATCH * NMEM;
constexpr int QSB = 0, KSB = 1024, VSB = 2048, QMB = 3072, KMB = 4096, VMB = 5120;
constexpr float EPS = 1e-6f;
constexpr float QSCALE = 0.12751743082459868f;
constexpr size_t MiB = 1u << 20;
constexpr size_t WS_CTL = 0, CTL_ZERO_BYTES = 1 * MiB;
constexpr size_t WS_SSQ1 = 64 * 1024, WS_SSQ2 = 128 * 1024;
constexpr size_t WS_WIN = 1 * MiB, WS_WOUT = 25 * MiB, WS_WXQ = 33 * MiB, WS_WXKV = 35 * MiB, WS_WXO = 39 * MiB, WS_WGU = 41 * MiB, WS_WDN = 85 * MiB;
constexpr size_t WS_RA = 107 * MiB;
constexpr size_t WS_RB = 171 * MiB;
constexpr size_t WS_RC = 235 * MiB;
constexpr size_t WS_QX = 427 * MiB, WS_OX = 443 * MiB, WS_KVX = 459 * MiB, WS_MN = 463 * MiB, WS_KMEAN = 471 * MiB, WS_CS = 472 * MiB, WS_END = 474 * MiB;
constexpr int RING_BYTES = 131072, LDS_BYTES = 147456;

__device__ __forceinline__ float bf2f(unsigned short b) { return __uint_as_float((unsigned)b << 16); }
__device__ __forceinline__ unsigned f2bf(float f) { unsigned u = __builtin_bit_cast(unsigned, f); return (u + 0x7fffu + ((u >> 16) & 1u)) >> 16; }
__device__ __forceinline__ unsigned pk2(float lo, float hi) { return f2bf(lo) | (f2bf(hi) << 16); }
__device__ __forceinline__ float wave_sum(float v) {
#pragma unroll
    for (int o = 1; o < 64; o <<= 1) v += __shfl_xor(v, o);
    return v;
}
__device__ __forceinline__ float wave_max(float v) {
#pragma unroll
    for (int o = 1; o < 64; o <<= 1) v = fmaxf(v, __shfl_xor(v, o));
    return v;
}

struct Frame {
    LAS unsigned char* lds;
    int tid, lane, wave, vcu, G;
    const float *x, *mem; const int* pos;
    const float *g_mix, *w_in, *g_out_sb, *g_out_mb, *w_out, *g_xattn, *g_mem, *w_xq, *w_xkv, *w_xo, *g_ffn, *w_gu, *w_dn, *g_final;
    float* out; unsigned char* ws;
};

__device__ __forceinline__ void transpose_item(const float* W, int K, int N, bf16* WT, const float* gain, int inter, LAS float* scr, int item, int lane) {
    const int nblk = N / 32, kb = item / nblk, nb = item % nblk, k0 = 64 * kb, n0 = 32 * nb;
    int orow0 = n0;
    if (inter) orow0 = (n0 < FF) ? (n0 / 128) * 256 + (n0 % 128) : ((n0 - FF) / 128) * 256 + 128 + ((n0 - FF) % 128);
#pragma unroll 8
    for (int i = 0; i < 32; ++i) { const int kk = 2 * i + (lane >> 5); float v = W[(size_t)(k0 + kk) * N + n0 + (lane & 31)]; if (gain) v *= gain[k0 + kk]; scr[kk * 33 + (lane & 31)] = v; }
    LDS_WAIT(); asm volatile("" ::: "memory");
    const int c = lane & 7;
#pragma unroll
    for (int j = 0; j < 4; ++j) { const int n = (lane >> 3) + 8 * j; const LAS float* s = scr + (8 * c) * 33 + n;
        v4u o; o.x = pk2(s[0 * 33], s[1 * 33]); o.y = pk2(s[2 * 33], s[3 * 33]); o.z = pk2(s[4 * 33], s[5 * 33]); o.w = pk2(s[6 * 33], s[7 * 33]);
        *(GAS v4u*)(WT + (size_t)(orow0 + n) * K + k0 + 8 * c) = o; }
    LDS_WAIT(); asm volatile("" ::: "memory");
}
__device__ __forceinline__ void rms_row_to_bf16(const float* xrow, const float* g, bf16* orow, int lane) {
    const GAS f32x4* xr = (const GAS f32x4*)xrow + lane; const GAS f32x4* gr = (const GAS f32x4*)g + lane;
    f32x4 v[8]; float s = 0.f;
#pragma unroll
    for (int j = 0; j < 8; ++j) { v[j] = xr[64 * j]; s += (v[j].x * v[j].x + v[j].y * v[j].y) + (v[j].z * v[j].z + v[j].w * v[j].w); }
    const float rstd = 1.0f / sqrtf(wave_sum(s) * (1.f / DM) + EPS);
    GAS unsigned long long* o8 = (GAS unsigned long long*)orow + lane;
#pragma unroll
    for (int j = 0; j < 8; ++j) { const f32x4 gg = gr[64 * j];
        o8[64 * j] = (unsigned long long)pk2(v[j].x * rstd * gg.x, v[j].y * rstd * gg.y) | ((unsigned long long)pk2(v[j].z * rstd * gg.z, v[j].w * rstd * gg.w) << 32); }
}
__constant__ float INV_FREQ[16] = {1.000000000e+00f, 4.403665960e-01f, 1.939227432e-01f, 8.539710194e-02f, 3.760603070e-02f, 1.656043902e-02f, 7.292664610e-03f, 3.211445874e-03f,
                                   1.414213562e-03f, 6.227723788e-04f, 2.742481884e-04f, 1.207697351e-04f, 5.318296098e-05f, 2.341999971e-05f, 1.031338616e-05f, 4.541670478e-06f};

__device__ __forceinline__ void p0_prologue(Frame& F) {
    LAS float* scr = (LAS float*)(F.lds + F.wave * 16384);
    const int gw = F.vcu * NWAVES + F.wave, NGW = F.G * NWAVES;
    bf16* ws16 = (bf16*)F.ws;
    constexpr int I0 = (DM / 64) * (NQKV / 32), I1 = (DM / 64) * (DM / 32), I2 = (DM / 64) * (WX / 32), I3 = (DM / 64) * (2 * WX / 32), I4 = (WX / 64) * (DM / 32),
                  I5 = (DM / 64) * (2 * FF / 32), I6 = (FF / 64) * (DM / 32);
    constexpr int NITEMS = I0 + I1 + I2 + I3 + I4 + I5 + I6;
    for (int it = gw; it < NITEMS; it += NGW) {
        int r = it;
        if (r < I0) { transpose_item(F.w_in, DM, NQKV, (bf16*)(F.ws + WS_WIN), nullptr, 0, scr, r, F.lane); continue; } r -= I0;
        if (r < I1) { transpose_item(F.w_out, DM, DM, (bf16*)(F.ws + WS_WOUT), nullptr, 0, scr, r, F.lane); continue; } r -= I1;
        if (r < I2) { transpose_item(F.w_xq, DM, WX, (bf16*)(F.ws + WS_WXQ), F.g_xattn, 0, scr, r, F.lane); continue; } r -= I2;
        if (r < I3) { transpose_item(F.w_xkv, DM, 2 * WX, (bf16*)(F.ws + WS_WXKV), nullptr, 0, scr, r, F.lane); continue; } r -= I3;
        if (r < I4) { transpose_item(F.w_xo, WX, DM, (bf16*)(F.ws + WS_WXO), nullptr, 0, scr, r, F.lane); continue; } r -= I4;
        if (r < I5) { transpose_item(F.w_gu, DM, 2 * FF, (bf16*)(F.ws + WS_WGU), F.g_ffn, 1, scr, r, F.lane); continue; } r -= I5;
        transpose_item(F.w_dn, FF, DM, (bf16*)(F.ws + WS_WDN), nullptr, 0, scr, r, F.lane);
    }
    (void)ws16;
    for (int m = gw; m < M; m += NGW) rms_row_to_bf16(F.x + (size_t)m * DM, F.g_mix, (bf16*)(F.ws + WS_RA) + (size_t)m * DM, F.lane);
    for (int m = gw; m < MMEM; m += NGW) rms_row_to_bf16(F.mem + (size_t)m * DM, F.g_mem, (bf16*)(F.ws + WS_MN) + (size_t)m * DM, F.lane);
    float* cs = (float*)(F.ws + WS_CS);
    for (int e = (F.vcu * NWAVES + F.wave) * 64 + F.lane; e < M * 16; e += NGW * 64) {
        const int m = e >> 4, i = e & 15; const float ang = (float)F.pos[m] * INV_FREQ[i];
        double rev = (double)ang * 0.15915494309189535; rev -= floor(rev);
        const float a = (float)(rev * 6.283185307179586);
        cs[(size_t)m * 32 + i] = cosf(a); cs[(size_t)m * 32 + 16 + i] = sinf(a);
    }
}

__device__ __forceinline__ float dot128(const LAS float* qs, const bf16* krow) {
    float s = 0.f;
#pragma unroll
    for (int c = 0; c < 16; ++c) { const v4u kv = *(const v4u*)(krow + 8 * c); const LAS f32x4* q4 = (const LAS f32x4*)(qs + 8 * c); const f32x4 qa = q4[0], qb = q4[1];
        s += qa.x * __uint_as_float(kv.x << 16) + qa.y * __uint_as_float(kv.x & 0xffff0000u) + qa.z * __uint_as_float(kv.y << 16) + qa.w * __uint_as_float(kv.y & 0xffff0000u)
           + qb.x * __uint_as_float(kv.z << 16) + qb.y * __uint_as_float(kv.z & 0xffff0000u) + qb.z * __uint_as_float(kv.w << 16) + qb.w * __uint_as_float(kv.w & 0xffff0000u); }
    return s;
}
__device__ __forceinline__ void load_q_lds(LAS float* qs, const bf16* qp, int lane) { qs[lane] = bf2f(qp[lane]); qs[64 + lane] = bf2f(qp[64 + lane]); LDS_WAIT(); asm volatile("" ::: "memory"); }
__device__ __forceinline__ void pv64(float w, const bf16* vbase, size_t ld, int cnt, int lane, float& o0, float& o1) {
    for (int i = 0; i < cnt; ++i) { const float wi = __shfl(w, i); const unsigned vv = *(const unsigned*)(vbase + (size_t)i * ld + 2 * lane); o0 += wi * __uint_as_float(vv << 16); o1 += wi * __uint_as_float(vv & 0xffff0000u); }
}
__device__ __forceinline__ float softplus2(float y) { return fmaxf(y, 0.f) + __builtin_amdgcn_logf(1.0f + __builtin_amdgcn_exp2f(-fabsf(y))); }
__device__ __forceinline__ void store_head_norm(float o0, float o1, const float* g, bf16* op, int lane) {
    const float ssq = wave_sum(o0 * o0 + o1 * o1); const float r = 1.0f / sqrtf(ssq * (1.f / HD) + EPS);
    *(unsigned*)(op + 2 * lane) = pk2(o0 * r * g[2 * lane], o1 * r * g[2 * lane + 1]);
}
__device__ __forceinline__ void naive_sb_row(Frame& F, LAS float* qs, int bh, int t) {
    const int b = bh >> 3, h = bh & 7, lane = F.lane; const bf16* qkv = (const bf16*)(F.ws + WS_RC); const size_t rb = (size_t)b * SEQ;
    load_q_lds(qs, qkv + (rb + t) * NQKV + QSB + h * HD, lane);
    const bf16* kp = qkv + rb * NQKV + KSB + h * HD; const bf16* vp = qkv + rb * NQKV + VSB + h * HD;
    float o0 = 0.f, o1 = 0.f, carry = 0.f;
    for (int c = (t - 1) >> 6; c >= 0; --c) {
        const int key = c * 64 + lane; const bool valid = key < t;
        float y = 0.f; if (valid) y = dot128(qs, kp + (size_t)key * NQKV);
        const float sp = valid ? softplus2(y) : 0.f;
        float suf = sp;
#pragma unroll
        for (int off = 1; off < 64; off <<= 1) { const float tt = __shfl_down(suf, off); if (lane + off < 64) suf += tt; }
        const float w = valid ? __builtin_amdgcn_exp2f(y - (suf + carry)) : 0.f;
        carry += __shfl(suf, 0);
        const int cnt = (t - c * 64) < 64 ? (t - c * 64) : 64;
        pv64(w, vp + (size_t)(c * 64) * NQKV, NQKV, cnt, lane, o0, o1);
    }
    store_head_norm(o0, o1, F.g_out_sb + h * HD, (bf16*)(F.ws + WS_RA) + (rb + t) * DM + h * HD, lane);
    LDS_WAIT();
}
__device__ __forceinline__ void softmax_chunk(float s, bool valid, const bf16* vbase, size_t ld, int cnt, int lane, float& m, float& l, float& o0, float& o1) {
    const float cm = wave_max(valid ? s : -1e30f); const float mn = fmaxf(m, cm); const float alpha = __builtin_amdgcn_exp2f(m - mn);
    const float p = valid ? __builtin_amdgcn_exp2f(s - mn) : 0.f;
    l = l * alpha + wave_sum(p); o0 *= alpha; o1 *= alpha; m = mn;
    pv64(p, vbase, ld, cnt, lane, o0, o1);
}
__device__ __forceinline__ void naive_moba_row(Frame& F, LAS float* qs, int bh, int t) {
    const int b = bh >> 3, h = bh & 7, lane = F.lane; const bf16* qkv = (const bf16*)(F.ws + WS_RC); const size_t rb = (size_t)b * SEQ;
    load_q_lds(qs, qkv + (rb + t) * NQKV + QMB + h * HD, lane);
    const bf16* kp = qkv + rb * NQKV + KMB + h * HD; const bf16* vp = qkv + rb * NQKV + VMB + h * HD;
    const int blk = t >> 8;
    const float* km = (const float*)(F.ws + WS_KMEAN) + (size_t)bh * 8 * HD;
    float g = -INFINITY;
    { const int n = lane & 7; if (n < blk) { float a = 0.f; for (int d = 0; d < HD; ++d) a += qs[d] * km[n * HD + d]; g = a; } }
    int cnt = 0;
#pragma unroll
    for (int mI = 0; mI < 8; ++mI) { const float gm = __shfl(g, mI); cnt += (gm > g || (gm == g && mI < (lane & 7))) ? 1 : 0; }
    const bool sel = (lane < 8) && (lane < blk) && (cnt < 3);
    const unsigned selmask = (unsigned)(__ballot(sel) & 0xffull);
    float m = -1e30f, l = 0.f, o0 = 0.f, o1 = 0.f;
    for (int n = 0; n <= blk; ++n) {
        if (n < blk && !((selmask >> n) & 1u)) continue;
        for (int c = 0; c < 4; ++c) {
            const int key0 = n * 256 + c * 64; if (key0 > t) break;
            const int key = key0 + lane; const bool valid = key <= t;
            float s = 0.f; if (valid) s = dot128(qs, kp + (size_t)key * NQKV);
            const int cn = (t - key0 + 1) < 64 ? (t - key0 + 1) : 64;
            softmax_chunk(s, valid, vp + (size_t)key0 * NQKV, NQKV, cn, lane, m, l, o0, o1);
        }
    }
    const float il = 1.0f / l;
    store_head_norm(o0 * il, o1 * il, F.g_out_mb + h * HD, (bf16*)(F.ws + WS_RA) + (rb + t) * DM + NH * HD + h * HD, lane);
    LDS_WAIT();
}
__device__ __forceinline__ void naive_xattn_row(Frame& F, LAS float* qs, int b, int h, int t) {
    const int lane = F.lane; const bf16* qx = (const bf16*)(F.ws + WS_QX); const bf16* kv = (const bf16*)(F.ws + WS_KVX);
    load_q_lds(qs, qx + ((size_t)b * SEQ + t) * WX + h * HD, lane);
    const bf16* kp = kv + (size_t)b * NMEM * (2 * WX) + h * HD; const bf16* vp = kp + WX;
    float m = -1e30f, l = 0.f, o0 = 0.f, o1 = 0.f;
    for (int c = 0; c < 4; ++c) { const int key = c * 64 + lane; const float s = dot128(qs, kp + (size_t)key * (2 * WX));
        softmax_chunk(s, true, vp + (size_t)(c * 64) * (2 * WX), 2 * WX, 64, lane, m, l, o0, o1); }
    const float il = 1.0f / l;
    *(unsigned*)((bf16*)(F.ws + WS_OX) + ((size_t)b * SEQ + t) * WX + h * HD + 2 * lane) = pk2(o0 * il, o1 * il);
    LDS_WAIT();
}
__device__ __forceinline__ void kmean_phase(Frame& F) {
    LAS float* red = (LAS float*)F.lds;
    const bf16* qkv = (const bf16*)(F.ws + WS_RC); float* km = (float*)(F.ws + WS_KMEAN);
    const int cc = F.tid & 15, rg = F.tid >> 4;
    for (int item = F.vcu; item < 64 * 8; item += F.G) {
        const int bh = item >> 3, n = item & 7, b = bh >> 3, h = bh & 7;
        const bf16* kp = qkv + ((size_t)b * SEQ + n * 256 + rg * 8) * NQKV + KMB + h * HD + cc * 8;
        float a[8] = {0, 0, 0, 0, 0, 0, 0, 0};
#pragma unroll
        for (int r = 0; r < 8; ++r) { const v4u kv = *(const v4u*)(kp + (size_t)r * NQKV);
            a[0] += __uint_as_float(kv.x << 16); a[1] += __uint_as_float(kv.x & 0xffff0000u); a[2] += __uint_as_float(kv.y << 16); a[3] += __uint_as_float(kv.y & 0xffff0000u);
            a[4] += __uint_as_float(kv.z << 16); a[5] += __uint_as_float(kv.z & 0xffff0000u); a[6] += __uint_as_float(kv.w << 16); a[7] += __uint_as_float(kv.w & 0xffff0000u); }
#pragma unroll
        for (int j = 0; j < 8; ++j) red[rg * 128 + cc * 8 + j] = a[j];
        __syncthreads();
        if (F.tid < 128) { float s = 0.f; for (int r = 0; r < 32; ++r) s += red[r * 128 + F.tid]; km[(size_t)item * HD + F.tid] = s * (1.0f / 256.0f); }
        __syncthreads();
    }
}
__device__ __forceinline__ void final_norm_phase(Frame& F) {
    const int gw = F.vcu * NWAVES + F.wave, NGW = F.G * NWAVES;
    for (int m = gw; m < M; m += NGW) {
        GAS f32x4* xr = (GAS f32x4*)(F.out + (size_t)m * DM) + F.lane; const GAS f32x4* gr = (const GAS f32x4*)F.g_final + F.lane;
        f32x4 v[8]; float s = 0.f;
#pragma unroll
        for (int j = 0; j < 8; ++j) { v[j] = xr[64 * j]; s += (v[j].x * v[j].x + v[j].y * v[j].y) + (v[j].z * v[j].z + v[j].w * v[j].w); }
        const float rstd = 1.0f / sqrtf(wave_sum(s) * (1.f / DM) + EPS);
#pragma unroll
        for (int j = 0; j < 8; ++j) xr[64 * j] = v[j] * rstd * gr[64 * j];
    }
}

constexpr int NPH = 11;
#ifndef MK_ONE_LAUNCH
#define MK_ONE_LAUNCH 0
#endif
struct Args { const void* in[17]; float* out; unsigned char* ws; int ph_lo, ph_hi; };
__global__ void __launch_bounds__(NWAVES * 64, 2) mk_fwd(Args args) {
    extern __shared__ __attribute__((aligned(16))) unsigned char lds[];
    Frame F;
    F.lds = (LAS unsigned char*)lds;
    F.tid = threadIdx.x; F.lane = F.tid & 63; F.wave = __builtin_amdgcn_readfirstlane(F.tid >> 6);
    F.G = gridDim.x; { const int bx = blockIdx.x; F.vcu = (F.G % 8 == 0) ? (bx % 8) * (F.G / 8) + bx / 8 : bx; }
    F.x = (const float*)args.in[0]; F.mem = (const float*)args.in[1]; F.pos = (const int*)args.in[2];
    F.g_mix = (const float*)args.in[3]; F.w_in = (const float*)args.in[4]; F.g_out_sb = (const float*)args.in[5]; F.g_out_mb = (const float*)args.in[6]; F.w_out = (const float*)args.in[7];
    F.g_xattn = (const float*)args.in[8]; F.g_mem = (const float*)args.in[9]; F.w_xq = (const float*)args.in[10]; F.w_xkv = (const float*)args.in[11]; F.w_xo = (const float*)args.in[12];
    F.g_ffn = (const float*)args.in[13]; F.w_gu = (const float*)args.in[14]; F.w_dn = (const float*)args.in[15]; F.g_final = (const float*)args.in[16];
    F.out = args.out; F.ws = args.ws;
    unsigned char* ws = args.ws;
    const int lo = args.ph_lo, hi = args.ph_hi;
#define IN(k) (lo <= (k) && (k) < hi)
#define BOTH(k) (IN(k) && IN((k) + 1))
#define GRID_BAR() do { __threadfence(); cg::this_grid().sync(); } while (0)
    float* ssq1 = (float*)(ws + WS_SSQ1); float* ssq2 = (float*)(ws + WS_SSQ2);
    pg8::bf16_t* RA = (pg8::bf16_t*)(ws + WS_RA); pg8::bf16_t* RB = (pg8::bf16_t*)(ws + WS_RB); pg8::bf16_t* RC = (pg8::bf16_t*)(ws + WS_RC);

    if (IN(0)) { p0_prologue(F); if (BOTH(0)) GRID_BAR(); }
    if (IN(1)) {
        pg8::Gemm g{RA, (const pg8::bf16_t*)(ws + WS_WIN), M, NQKV, DM}; pg8::StaticOrder S; S.init(M, NQKV, F.G, (int)blockIdx.x);
        pg8::EpiQKV E{RC, (const float*)(ws + WS_CS), QSCALE};
        pg8::gemm_phase<pg8::EpiQKV, pg8::StaticOrder, true, true>(F.lds, g, S, E);
        if (BOTH(1)) GRID_BAR();
    }
    if (IN(2)) { kmean_phase(F); if (BOTH(2)) GRID_BAR(); }
    if (IN(3)) {
        LAS float* qs = (LAS float*)(F.lds + F.wave * 1024);
        const int gw = F.vcu * NWAVES + F.wave, NGW = F.G * NWAVES;
        for (int i = gw; i < 64 * SEQ; i += NGW) { const int bh = i >> 11, t = (int)(((unsigned)i + (unsigned)(i >> 11) * 997u) & 2047u); naive_sb_row(F, qs, bh, t); }
        for (int i = gw; i < 64 * SEQ; i += NGW) { const int bh = i >> 11, t = (int)(((unsigned)i + (unsigned)(i >> 11) * 997u) & 2047u); naive_moba_row(F, qs, bh, t); }
        if (BOTH(3)) GRID_BAR();
    }
    if (IN(4)) {
        pg8::Gemm g{RA, (const pg8::bf16_t*)(ws + WS_WOUT), M, DM, DM}; pg8::StaticOrder S; S.init(M, DM, F.G, (int)blockIdx.x);
        pg8::EpiRes E{F.x, F.out, RB, ssq1};
        pg8::gemm_phase<pg8::EpiRes, pg8::StaticOrder, true, true>(F.lds, g, S, E);
        if (BOTH(4)) GRID_BAR();
    }
    if (IN(5)) {
        { pg8::Gemm g{RB, (const pg8::bf16_t*)(ws + WS_WXQ), M, WX, DM}; pg8::StaticOrder S; S.init(M, WX, F.G, (int)blockIdx.x);
          pg8::EpiScale E{(pg8::bf16_t*)(ws + WS_QX), WX, ssq1, QSCALE};
          pg8::gemm_phase<pg8::EpiScale, pg8::StaticOrder, true, true>(F.lds, g, S, E); }
        { pg8::Gemm g{(const pg8::bf16_t*)(ws + WS_MN), (const pg8::bf16_t*)(ws + WS_WXKV), MMEM, 2 * WX, DM}; pg8::StaticOrder S; S.init(MMEM, 2 * WX, F.G, (int)((blockIdx.x + F.G - 128) % F.G));
          pg8::EpiScale E{(pg8::bf16_t*)(ws + WS_KVX), 2 * WX, nullptr, 1.0f};
          pg8::gemm_phase<pg8::EpiScale, pg8::StaticOrder, true, true>(F.lds, g, S, E); }
        if (BOTH(5)) GRID_BAR();
    }
    if (IN(6)) {
        LAS float* qs = (LAS float*)(F.lds + F.wave * 1024);
        const int gw = F.vcu * NWAVES + F.wave, NGW = F.G * NWAVES;
        for (int i = gw; i < BATCH * 4 * SEQ; i += NGW) { const int t = i & 2047, h = (i >> 11) & 3, b = i >> 13; naive_xattn_row(F, qs, b, h, t); }
        if (BOTH(6)) GRID_BAR();
    }
    if (IN(7)) {
        pg8::Gemm g{(const pg8::bf16_t*)(ws + WS_OX), (const pg8::bf16_t*)(ws + WS_WXO), M, DM, WX}; pg8::StaticOrder S; S.init(M, DM, F.G, (int)blockIdx.x);
        pg8::EpiRes E{F.out, F.out, RA, ssq2};
        pg8::gemm_phase<pg8::EpiRes, pg8::StaticOrder, true, true>(F.lds, g, S, E);
        if (BOTH(7)) GRID_BAR();
    }
    if (IN(8)) {
        pg8::Gemm g{RA, (const pg8::bf16_t*)(ws + WS_WGU), M, 2 * FF, DM}; pg8::StaticOrder S; S.init(M, 2 * FF, F.G, (int)blockIdx.x);
        pg8::EpiSwiGLU E{RC, ssq2};
        pg8::gemm_phase<pg8::EpiSwiGLU, pg8::StaticOrder, true, true>(F.lds, g, S, E);
        if (BOTH(8)) GRID_BAR();
    }
    if (IN(9)) {
        pg8::Gemm g{RC, (const pg8::bf16_t*)(ws + WS_WDN), M, DM, FF}; pg8::StaticOrder S; S.init(M, DM, F.G, (int)blockIdx.x);
        pg8::EpiRes E{F.out, F.out, nullptr, nullptr};
        pg8::gemm_phase<pg8::EpiRes, pg8::StaticOrder, true, true>(F.lds, g, S, E);
        if (BOTH(9)) GRID_BAR();
    }
    if (IN(10)) final_norm_phase(F);
#undef IN
#undef BOTH
}

extern "C" void kernel_launch(void* const* d_in, const int* in_sizes, int n_in, void* d_out, int out_size, void* d_ws, size_t ws_size, hipStream_t stream) {
    static int grid = 0;
    if (grid == 0) {
        if (n_in != 17 || in_sizes[0] != M * DM || out_size != M * DM || ws_size < WS_END) { fprintf(stderr, "kernel_launch: unexpected shapes (n_in %d in0 %d out %d ws %zu)\n", n_in, n_in > 0 ? in_sizes[0] : -1, out_size, ws_size); grid = -1; return; }
        int dev = 0, cus = 0, per_cu = 0;
        if (hipGetDevice(&dev) != hipSuccess || hipDeviceGetAttribute(&cus, hipDeviceAttributeMultiprocessorCount, dev) != hipSuccess) { grid = -1; return; }
        if (hipFuncSetAttribute((const void*)mk_fwd, hipFuncAttributeMaxDynamicSharedMemorySize, LDS_BYTES) != hipSuccess) { fprintf(stderr, "kernel_launch: hipFuncSetAttribute failed\n"); grid = -1; return; }
        if (hipOccupancyMaxActiveBlocksPerMultiprocessor(&per_cu, (const void*)mk_fwd, NWAVES * 64, LDS_BYTES) != hipSuccess || per_cu < 1) { fprintf(stderr, "kernel_launch: occupancy query failed (%d)\n", per_cu); per_cu = 1; }
        (void)hipGetLastError();
        grid = cus * (per_cu < 1 ? 1 : 1);
    }
    if (grid < 0) return;
    (void)hipMemsetAsync((char*)d_ws + WS_CTL, 0, CTL_ZERO_BYTES, stream);
    Args a{};
    for (int i = 0; i < 17; ++i) a.in[i] = d_in[i];
    a.out = (float*)d_out; a.ws = (unsigned char*)d_ws;
#if MK_ONE_LAUNCH
    a.ph_lo = 0; a.ph_hi = NPH;
    void* kargs[] = {&a};
    hipError_t e = hipLaunchCooperativeKernel((const void*)mk_fwd, dim3(grid), dim3(NWAVES * 64), kargs, LDS_BYTES, stream);
    if (e != hipSuccess) fprintf(stderr, "kernel_launch: cooperative launch failed: %s (grid %d)\n", hipGetErrorString(e), grid);
#else
    for (int p = 0; p < NPH; ++p) { a.ph_lo = p; a.ph_hi = p + 1; hipLaunchKernelGGL(mk_fwd, dim3(grid), dim3(NWAVES * 64), LDS_BYTES, stream, a); }
    const hipError_t le = hipPeekAtLastError();
    if (le != hipSuccess) fprintf(stderr, "kernel_launch: launch failed: %s\n", hipGetErrorName(le));
#endif
}
```

```cpp
#include <hip/hip_runtime.h>
#include <hip/hip_cooperative_groups.h>
#include <cstdio>
#include <cstdint>
namespace cg = cooperative_groups;
namespace pg8 {
#define PG8_LAS __attribute__((address_space(3)))
typedef unsigned short bf16_t;
typedef short bf16x8 __attribute__((ext_vector_type(8)));
typedef float f32x4 __attribute__((ext_vector_type(4)));
typedef unsigned u32x4 __attribute__((ext_vector_type(4)));
constexpr int BM = 256, BK = 64, HALF = 128, HTB = HALF * BK * 2  , STAGE_BYTES = 8 * HTB, NXCD = 8, WGM = 8;

__host__ __device__ __forceinline__ int lds_byte(int r, int c) { const int st = (r >> 4) * 2 + (c >> 5), rr = r & 15, cc = c & 31, ob = rr * 64 + cc * 2; return st * 1024 + (ob ^ (((ob >> 9) & 1) << 5)); }
__host__ __device__ __forceinline__ void stage_rc(int b, int& R, int& C) { const int st = b / 1024, sb = b % 1024, swz = sb ^ (((sb >> 9) & 1) << 5); R = (st >> 1) * 16 + swz / 64; C = (st & 1) * 32 + (swz % 64) / 2; }
__host__ __device__ __forceinline__ int perm32(int rho) { const int n = rho >> 4, i = rho & 15; return 8 * (i >> 2) + 4 * n + (i & 3); }

struct Unit { int pm, pn; };
struct Gemm { const bf16_t* A; const bf16_t* Bt; int M, N, K; };

struct StaticOrder {
    int nM, nN, nwg, G, c;
    __host__ __device__ void init(int M, int N, int G_, int c_) { nM = M / BM; nN = N / BM; nwg = nM * nN; G = G_; c = c_; }
    __host__ __device__ bool next(int i, Unit& u) const {
        const long L = (long)i * G + c; if (L >= nwg) return false;
        int wgid = (int)L; { const int q = nwg / NXCD, r = nwg % NXCD, xcd = wgid % NXCD, off = wgid / NXCD; wgid = (xcd < r ? xcd * (q + 1) : r * (q + 1) + (xcd - r) * q) + off; }
        const int nig = WGM * nN, gid = wgid / nig, fm = gid * WGM, gsz = (nM - fm) < WGM ? (nM - fm) : WGM;
        u.pm = fm + ((wgid % nig) % gsz); u.pn = (wgid % nig) / gsz; return true;
    }
    __device__ __forceinline__ void a_ready(const Unit&) const {}
    __device__ __forceinline__ void done(const Unit&) const {}
};

__device__ __forceinline__ unsigned cvt_pk_bf16(float lo, float hi) { unsigned r; asm volatile("v_cvt_pk_bf16_f32 %0, %1, %2" : "=v"(r) : "v"(lo), "v"(hi)); return r; }
typedef float f32x2 __attribute__((ext_vector_type(2)));
template <class Epi, class Sched, bool ALIGN_EPI = false, bool SP2 = false>
__device__ __forceinline__ void gemm_phase(PG8_LAS unsigned char* lds, const Gemm g, const Sched& S, const Epi& E) {
    const int tid = threadIdx.x, wid = __builtin_amdgcn_readfirstlane(tid >> 6), lane = tid & 63, wr = wid >> 2, wc = wid & 3, fr = lane & 15, fq = lane >> 4;
    const int K = g.K, nt = K / BK;
    unsigned voffA[2], voffB[2];
#pragma unroll
    for (int i = 0; i < 2; ++i) { int R, C; stage_rc(tid * 16 + i * 8192, R, C); const int Rb = Epi::PERM ? ((R & ~31) + perm32(R & 31)) : R;
        voffA[i] = (unsigned)(R * K + C) * 2u; voffB[i] = (unsigned)(Rb * K + C) * 2u; }
    const size_t kstep = (size_t)(BK * 2);
    const size_t hstep = (size_t)HALF * K * 2;
    const size_t tstep = 2 * hstep;
    const unsigned ldsw = (unsigned)wid * 1024u;
    const int aoff = lds_byte(wr * 64 + fr, fq * 8), boff = lds_byte(wc * 32 + fr, fq * 8);
#define PG8_SA(b, h) (((b) * 2 + (h)) * HTB)
#define PG8_SB(b, h) ((4 + (b) * 2 + (h)) * HTB)
#define PG8_STAGE(bufoff, gbase, voff) do { _Pragma("unroll") for (int _i = 0; _i < 2; ++_i) \
        __builtin_amdgcn_global_load_lds((const unsigned*)((const char*)(gbase) + (voff)[_i]), (PG8_LAS unsigned*)(lds + (bufoff) + ldsw + _i * 8192), 16, 0, 0); } while (0)
#define PG8_LDA(dst, b, h) do { _Pragma("unroll") for (int m = 0; m < 4; ++m) _Pragma("unroll") for (int k = 0; k < 2; ++k) dst[m][k] = *(const PG8_LAS bf16x8*)(lds + PG8_SA(b, h) + aoff + m * 2048 + k * 1024); } while (0)
#define PG8_LDB(dst, b, h) do { _Pragma("unroll") for (int n = 0; n < 2; ++n) _Pragma("unroll") for (int k = 0; k < 2; ++k) dst[n][k] = *(const PG8_LAS bf16x8*)(lds + PG8_SB(b, h) + boff + n * 2048 + k * 1024); } while (0)
#define PG8_MMA(ai, bj, At, Bt) do { __builtin_amdgcn_s_setprio(1); _Pragma("unroll") for (int m = 0; m < 4; ++m) _Pragma("unroll") for (int n = 0; n < 2; ++n) _Pragma("unroll") for (int k = 0; k < 2; ++k) \
        acc[ai][bj][m][n] = __builtin_amdgcn_mfma_f32_16x16x32_bf16(Bt[n][k], At[m][k], acc[ai][bj][m][n], 0, 0, 0); __builtin_amdgcn_s_setprio(0); } while (0)
#define PG8_WAIT_V(n) asm volatile("s_waitcnt vmcnt(" #n ")" ::: "memory")
#define PG8_WAIT_L(n) asm volatile("s_waitcnt lgkmcnt(" #n ")" ::: "memory")
#define PG8_BAR __builtin_amdgcn_s_barrier()
#define PG8_SCHED __builtin_amdgcn_sched_barrier(0)
    Unit cur, nxt; int ui = 0;
    if (!S.next(0, cur)) return;
    f32x4 acc[2][2][4][2];
#pragma unroll
    for (int a = 0; a < 2; ++a)
#pragma unroll
        for (int b = 0; b < 2; ++b)
#pragma unroll
            for (int m = 0; m < 4; ++m)
#pragma unroll
                for (int n = 0; n < 2; ++n) acc[a][b][m][n] = (f32x4){0.f, 0.f, 0.f, 0.f};
    bf16x8 At[4][2], B0[2][2], B1[2][2];
    const char* cA = (const char*)g.A + (size_t)cur.pm * tstep; const char* cB = (const char*)g.Bt + (size_t)cur.pn * tstep;
    S.a_ready(cur);
    if constexpr (SP2) {
        PG8_STAGE(PG8_SB(0, 0), cB, voffB); PG8_STAGE(PG8_SB(0, 1), cB + hstep, voffB); PG8_STAGE(PG8_SA(0, 0), cA, voffA); PG8_STAGE(PG8_SA(0, 1), cA + hstep, voffA);
        if (wr == 1) PG8_BAR;
        PG8_WAIT_V(2); PG8_BAR;
        PG8_STAGE(PG8_SB(1, 0), cB + kstep, voffB); PG8_STAGE(PG8_SA(1, 0), cA + kstep, voffA); PG8_STAGE(PG8_SB(1, 1), cB + hstep + kstep, voffB);
        PG8_WAIT_V(6); PG8_BAR;
    } else {
        PG8_STAGE(PG8_SB(0, 0), cB, voffB); PG8_STAGE(PG8_SA(0, 0), cA, voffA); PG8_STAGE(PG8_SB(0, 1), cB + hstep, voffB); PG8_STAGE(PG8_SA(0, 1), cA + hstep, voffA);
        if (wr == 1) PG8_BAR;
        PG8_WAIT_V(4); PG8_BAR;
        PG8_STAGE(PG8_SB(1, 0), cB + kstep, voffB); PG8_STAGE(PG8_SA(1, 0), cA + kstep, voffA); PG8_STAGE(PG8_SB(1, 1), cB + hstep + kstep, voffB);
        PG8_WAIT_V(6); PG8_BAR;
    }
    for (;;) {
        const bool has_next = S.next(ui + 1, nxt);
        const char* nA = has_next ? (const char*)g.A + (size_t)nxt.pm * tstep : cA; const char* nB = has_next ? (const char*)g.Bt + (size_t)nxt.pn * tstep : cB;
        for (int t = 0; t < nt; t += 2) {
            const bool last = (t == nt - 2);
            const char* a1 = cA + (size_t)(t + 1) * kstep;
            const char* a2 = last ? nA : cA + (size_t)(t + 2) * kstep; const char* b2 = last ? nB : cB + (size_t)(t + 2) * kstep;
            const char* a3 = a2 + kstep; const char* b3 = b2 + kstep;
            if (last && has_next) S.a_ready(nxt);
            if constexpr (SP2) {
            PG8_LDB(B0, 0, 0); PG8_LDB(B1, 0, 1); PG8_SCHED; PG8_LDA(At, 0, 0); PG8_STAGE(PG8_SA(1, 1), a1 + hstep, voffA);
            PG8_WAIT_V(8); PG8_WAIT_L(0); PG8_BAR; PG8_MMA(0, 0, At, B0); PG8_MMA(0, 1, At, B1); PG8_BAR; PG8_SCHED;
            PG8_LDA(At, 0, 1); PG8_STAGE(PG8_SB(0, 0), b2, voffB); PG8_STAGE(PG8_SB(0, 1), b2 + hstep, voffB); PG8_STAGE(PG8_SA(0, 0), a2, voffA);
            PG8_WAIT_V(8); PG8_WAIT_L(0); PG8_BAR; PG8_MMA(1, 0, At, B0); PG8_MMA(1, 1, At, B1); PG8_BAR; PG8_SCHED;
            PG8_LDB(B0, 1, 0); PG8_LDB(B1, 1, 1); PG8_SCHED; PG8_LDA(At, 1, 0); PG8_STAGE(PG8_SA(0, 1), a2 + hstep, voffA);
            PG8_WAIT_V(8); PG8_WAIT_L(0); PG8_BAR; PG8_MMA(0, 0, At, B0); PG8_MMA(0, 1, At, B1); PG8_BAR; PG8_SCHED;
            PG8_LDA(At, 1, 1); PG8_STAGE(PG8_SB(1, 0), b3, voffB); PG8_STAGE(PG8_SB(1, 1), b3 + hstep, voffB); PG8_STAGE(PG8_SA(1, 0), a3, voffA);
            PG8_WAIT_V(8); PG8_WAIT_L(0); PG8_BAR; PG8_MMA(1, 0, At, B0); PG8_MMA(1, 1, At, B1); PG8_BAR; PG8_SCHED;
            } else {
            PG8_LDB(B0, 0, 0); PG8_SCHED; PG8_LDA(At, 0, 0); PG8_STAGE(PG8_SA(1, 1), a1 + hstep, voffA);
            PG8_WAIT_L(8); PG8_BAR; PG8_WAIT_L(0); PG8_MMA(0, 0, At, B0); PG8_BAR; PG8_SCHED;
            PG8_LDB(B1, 0, 1); PG8_STAGE(PG8_SB(0, 0), b2, voffB);
            PG8_BAR; PG8_WAIT_L(0); PG8_MMA(0, 1, At, B1); PG8_BAR;
            PG8_LDA(At, 0, 1); PG8_STAGE(PG8_SA(0, 0), a2, voffA);
            PG8_BAR; PG8_WAIT_L(0); PG8_MMA(1, 0, At, B0); PG8_BAR; PG8_SCHED;
            PG8_STAGE(PG8_SB(0, 1), b2 + hstep, voffB);
            PG8_WAIT_V(6); PG8_BAR; PG8_MMA(1, 1, At, B1); PG8_BAR;
            PG8_LDB(B0, 1, 0); PG8_SCHED; PG8_LDA(At, 1, 0); PG8_STAGE(PG8_SA(0, 1), a2 + hstep, voffA);
            PG8_WAIT_L(8); PG8_BAR; PG8_WAIT_L(0); PG8_MMA(0, 0, At, B0); PG8_BAR; PG8_SCHED;
            PG8_LDB(B1, 1, 1); PG8_STAGE(PG8_SB(1, 0), b3, voffB);
            PG8_BAR; PG8_WAIT_L(0); PG8_MMA(0, 1, At, B1); PG8_BAR;
            PG8_LDA(At, 1, 1); PG8_STAGE(PG8_SA(1, 0), a3, voffA);
            PG8_BAR; PG8_WAIT_L(0); PG8_MMA(1, 0, At, B0); PG8_BAR; PG8_SCHED;
            PG8_STAGE(PG8_SB(1, 1), b3 + hstep, voffB);
            PG8_WAIT_V(6); PG8_BAR; PG8_MMA(1, 1, At, B1); PG8_BAR;
            }
        }
        if constexpr (ALIGN_EPI) { if (wr == 0) PG8_BAR; }
        if constexpr (!Epi::AFTER_DRAIN) { E(acc, cur, wr, wc, fr, fq); S.done(cur); }
        if (!has_next) break;
#pragma unroll
        for (int a = 0; a < 2; ++a)
#pragma unroll
            for (int b = 0; b < 2; ++b)
#pragma unroll
                for (int m = 0; m < 4; ++m)
#pragma unroll
                    for (int n = 0; n < 2; ++n) acc[a][b][m][n] = (f32x4){0.f, 0.f, 0.f, 0.f};
        cur = nxt; cA = nA; cB = nB; ++ui;
        if constexpr (ALIGN_EPI) { if (wr == 1) PG8_BAR; }
    }
    PG8_WAIT_V(0);
    if constexpr (!ALIGN_EPI) { if (wr == 0) PG8_BAR; }
    PG8_BAR;
    if constexpr (Epi::AFTER_DRAIN) { E.fused(acc, cur, wr, wc, fr, fq, lds, wid, lane); S.done(cur); }
#undef PG8_SA
#undef PG8_SB
#undef PG8_STAGE
#undef PG8_LDA
#undef PG8_LDB
#undef PG8_MMA
#undef PG8_WAIT_V
#undef PG8_WAIT_L
#undef PG8_BAR
#undef PG8_SCHED
}
}
namespace pg8 {
typedef unsigned u32x2 __attribute__((ext_vector_type(2)));
constexpr int LDX = 2048;
constexpr float RMS_EPS = 1e-6f;
struct EpiQKV {
    static constexpr bool PERM = true, AFTER_DRAIN = false;
    bf16_t* O; const float* cs; float qscale;
    __device__ __forceinline__ void operator()(const f32x4 (&acc)[2][2][4][2], const Unit& u, int wr, int wc, int fr, int fq) const {
        const int row0 = u.pm * BM + wr * 64 + fr, col0 = u.pn * BM + wc * 32 + 8 * fq, pn = u.pn;
        const float sc = (pn < 4 || (pn >= 12 && pn < 16)) ? qscale : 1.f;
        const bool rot = (pn >= 12 && pn < 20) && (wc == 0);
#pragma unroll
        for (int ai = 0; ai < 2; ++ai)
#pragma unroll
            for (int m = 0; m < 4; ++m) { const int row = row0 + ai * HALF + m * 16; bf16_t* rowp = O + (size_t)row * 6144 + col0;
                f32x4 c0 = {1.f, 1.f, 1.f, 1.f}, c1 = c0, s0 = {0.f, 0.f, 0.f, 0.f}, s1 = s0;
                if (rot) { const float* cr = cs + (size_t)row * 32 + 8 * (fq & 1); c0 = *(const f32x4*)cr; c1 = *(const f32x4*)(cr + 4); s0 = *(const f32x4*)(cr + 16); s1 = *(const f32x4*)(cr + 20);
                    if (fq < 2) { s0 = -s0; s1 = -s1; } }
#pragma unroll
                for (int bj = 0; bj < 2; ++bj) { f32x4 v0 = acc[ai][bj][m][0], v1 = acc[ai][bj][m][1];
                    if (rot) { f32x4 p0, p1;
#pragma unroll
                        for (int j = 0; j < 4; ++j) { p0[j] = __shfl_xor(v0[j], 32); p1[j] = __shfl_xor(v1[j], 32); }
                        v0 = v0 * c0 + p0 * s0; v1 = v1 * c1 + p1 * s1; }
                    v0 = v0 * sc; v1 = v1 * sc; u32x4 w; w.x = cvt_pk_bf16(v0[0], v0[1]); w.y = cvt_pk_bf16(v0[2], v0[3]); w.z = cvt_pk_bf16(v1[0], v1[1]); w.w = cvt_pk_bf16(v1[2], v1[3]);
                    *(u32x4*)(rowp + bj * HALF) = w; } }
    }
};
struct EpiRes {
    static constexpr bool PERM = false, AFTER_DRAIN = false;
    const float* base; float* out; bf16_t* xb; float* ssq;
    __device__ __forceinline__ void operator()(const f32x4 (&acc)[2][2][4][2], const Unit& u, int wr, int wc, int fr, int fq) const {
        const int row0 = u.pm * BM + wr * 64 + fr, col0 = u.pn * BM + wc * 32 + 4 * fq;
#pragma unroll
        for (int ai = 0; ai < 2; ++ai)
#pragma unroll
            for (int m = 0; m < 4; ++m) { const int row = row0 + ai * HALF + m * 16; const size_t off = (size_t)row * LDX + col0; float s = 0.f;
#pragma unroll
                for (int bj = 0; bj < 2; ++bj)
#pragma unroll
                    for (int n = 0; n < 2; ++n) { const f32x4 v = *(const f32x4*)(base + off + bj * HALF + n * 16) + acc[ai][bj][m][n];
                        *(f32x4*)(out + off + bj * HALF + n * 16) = v; s += (v[0] * v[0] + v[1] * v[1]) + (v[2] * v[2] + v[3] * v[3]);
                        if (xb) { u32x2 w; w.x = cvt_pk_bf16(v[0], v[1]); w.y = cvt_pk_bf16(v[2], v[3]); *(u32x2*)(xb + off + bj * HALF + n * 16) = w; } }
                if (ssq) { s += __shfl_xor(s, 16); s += __shfl_xor(s, 32); if (fq == 0) atomicAdd(ssq + row, s); }
                asm volatile("" ::: "memory"); }
    }
};
struct EpiScale {
    static constexpr bool PERM = true, AFTER_DRAIN = false;
    bf16_t* O; int ldc; const float* ssq; float sc;
    __device__ __forceinline__ void operator()(const f32x4 (&acc)[2][2][4][2], const Unit& u, int wr, int wc, int fr, int fq) const {
        const int row0 = u.pm * BM + wr * 64 + fr, col0 = u.pn * BM + wc * 32 + 8 * fq;
#pragma unroll
        for (int ai = 0; ai < 2; ++ai)
#pragma unroll
            for (int m = 0; m < 4; ++m) { const int row = row0 + ai * HALF + m * 16; bf16_t* rowp = O + (size_t)row * ldc + col0;
                const float f = ssq ? sc * __builtin_amdgcn_rsqf(ssq[row] * (1.0f / 2048.0f) + RMS_EPS) : sc;
#pragma unroll
                for (int bj = 0; bj < 2; ++bj) { const f32x4 v0 = acc[ai][bj][m][0] * f, v1 = acc[ai][bj][m][1] * f;
                    u32x4 w; w.x = cvt_pk_bf16(v0[0], v0[1]); w.y = cvt_pk_bf16(v0[2], v0[3]); w.z = cvt_pk_bf16(v1[0], v1[1]); w.w = cvt_pk_bf16(v1[2], v1[3]);
                    *(u32x4*)(rowp + bj * HALF) = w; } }
    }
};
struct EpiSwiGLU {
    static constexpr bool PERM = true, AFTER_DRAIN = false;
    bf16_t* O; const float* ssq;
    __device__ __forceinline__ void operator()(const f32x4 (&acc)[2][2][4][2], const Unit& u, int wr, int wc, int fr, int fq) const {
        const int row0 = u.pm * BM + wr * 64 + fr, col0 = u.pn * HALF + wc * 32 + 8 * fq;
#pragma unroll
        for (int ai = 0; ai < 2; ++ai)
#pragma unroll
            for (int m = 0; m < 4; ++m) { const int row = row0 + ai * HALF + m * 16; bf16_t* rowp = O + (size_t)row * 5632 + col0;
                const float f = __builtin_amdgcn_rsqf(ssq[row] * (1.0f / 2048.0f) + RMS_EPS);
                float r[8];
#pragma unroll
                for (int n = 0; n < 2; ++n)
#pragma unroll
                    for (int j = 0; j < 4; ++j) { const float g = acc[ai][0][m][n][j] * f, uu = acc[ai][1][m][n][j] * f;
                        const float sg = g * __builtin_amdgcn_rcpf(1.0f + __builtin_amdgcn_exp2f(-1.4426950408889634f * g)); r[n * 4 + j] = sg * uu; }
                u32x4 w; w.x = cvt_pk_bf16(r[0], r[1]); w.y = cvt_pk_bf16(r[2], r[3]); w.z = cvt_pk_bf16(r[4], r[5]); w.w = cvt_pk_bf16(r[6], r[7]);
                *(u32x4*)rowp = w; }
    }
};
}
#define GAS __attribute__((address_space(1)))
#define LAS __attribute__((address_space(3)))
typedef unsigned short bf16;
typedef unsigned v4u __attribute__((ext_vector_type(4)));
typedef float f32x4 __attribute__((ext_vector_type(4)));
#define LDS_WAIT() asm volatile("s_waitcnt lgkmcnt(0)" ::: "memory")
constexpr int NWAVES = 8;
constexpr int BATCH = 8, SEQ = 2048, DM = 2048, M = BATCH * SEQ, HD = 128, NH = 8;
constexpr int NQKV = 6144, FF = 5632, WX = 512, NMEM = 256, MMEM = BATCH * NMEM;
constexpr int QSB = 0, KSB = 1024, VSB = 2048, QMB = 3072, KMB = 4096, VMB = 5120;
constexpr float EPS = 1e-6f;
constexpr float QSCALE = 0.12751743082459868f;
constexpr size_t MiB = 1u << 20;
constexpr size_t WS_CTL = 0, CTL_ZERO_BYTES = 1 * MiB;
constexpr size_t WS_SSQ1 = 64 * 1024, WS_SSQ2 = 128 * 1024;
constexpr size_t WS_WIN = 1 * MiB, WS_WOUT = 25 * MiB, WS_WXQ = 33 * MiB, WS_WXKV = 35 * MiB, WS_WXO = 39 * MiB, WS_WGU = 41 * MiB, WS_WDN = 85 * MiB;
constexpr size_t WS_RA = 107 * MiB;
constexpr size_t WS_RB = 171 * MiB;
constexpr size_t WS_RC = 235 * MiB;
constexpr size_t WS_QX = 427 * MiB, WS_OX = 443 * MiB, WS_KVX = 459 * MiB, WS_MN = 463 * MiB, WS_KMEAN = 471 * MiB, WS_CS = 472 * MiB, WS_END = 474 * MiB;
constexpr int RING_BYTES = 131072, LDS_BYTES = 147456;

__device__ __forceinline__ float bf2f(unsigned short b) { return __uint_as_float((unsigned)b << 16); }
__device__ __forceinline__ unsigned f2bf(float f) { unsigned u = __builtin_bit_cast(unsigned, f); return (u + 0x7fffu + ((u >> 16) & 1u)) >> 16; }
__device__ __forceinline__ unsigned pk2(float lo, float hi) { return f2bf(lo) | (f2bf(hi) << 16); }
__device__ __forceinline__ float wave_sum(float v) {
#pragma unroll
    for (int o = 1; o < 64; o <<= 1) v += __shfl_xor(v, o);
    return v;
}
__device__ __forceinline__ float wave_max(float v) {
#pragma unroll
    for (int o = 1; o < 64; o <<= 1) v = fmaxf(v, __shfl_xor(v, o));
    return v;
}

struct Frame {
    LAS unsigned char* lds;
    int tid, lane, wave, vcu, G;
    const float *x, *mem; const int* pos;
    const float *g_mix, *w_in, *g_out_sb, *g_out_mb, *w_out, *g_xattn, *g_mem, *w_xq, *w_xkv, *w_xo, *g_ffn, *w_gu, *w_dn, *g_final;
    float* out; unsigned char* ws;
};

__device__ __forceinline__ void transpose_item(const float* W, int K, int N, bf16* WT, const float* gain, int inter, LAS float* scr, int item, int lane) {
    const int nblk = N / 32, kb = item / nblk, nb = item % nblk, k0 = 64 * kb, n0 = 32 * nb;
    int orow0 = n0;
    if (inter) orow0 = (n0 < FF) ? (n0 / 128) * 256 + (n0 % 128) : ((n0 - FF) / 128) * 256 + 128 + ((n0 - FF) % 128);
#pragma unroll 8
    for (int i = 0; i < 32; ++i) { const int kk = 2 * i + (lane >> 5); float v = W[(size_t)(k0 + kk) * N + n0 + (lane & 31)]; if (gain) v *= gain[k0 + kk]; scr[kk * 33 + (lane & 31)] = v; }
    LDS_WAIT(); asm volatile("" ::: "memory");
    const int c = lane & 7;
#pragma unroll
    for (int j = 0; j < 4; ++j) { const int n = (lane >> 3) + 8 * j; const LAS float* s = scr + (8 * c) * 33 + n;
        v4u o; o.x = pk2(s[0 * 33], s[1 * 33]); o.y = pk2(s[2 * 33], s[3 * 33]); o.z = pk2(s[4 * 33], s[5 * 33]); o.w = pk2(s[6 * 33], s[7 * 33]);
        *(GAS v4u*)(WT + (size_t)(orow0 + n) * K + k0 + 8 * c) = o; }
    LDS_WAIT(); asm volatile("" ::: "memory");
}
__device__ __forceinline__ void rms_row_to_bf16(const float* xrow, const float* g, bf16* orow, int lane) {
    const GAS f32x4* xr = (const GAS f32x4*)xrow + lane; const GAS f32x4* gr = (const GAS f32x4*)g + lane;
    f32x4 v[8]; float s = 0.f;
#pragma unroll
    for (int j = 0; j < 8; ++j) { v[j] = xr[64 * j]; s += (v[j].x * v[j].x + v[j].y * v[j].y) + (v[j].z * v[j].z + v[j].w * v[j].w); }
    const float rstd = 1.0f / sqrtf(wave_sum(s) * (1.f / DM) + EPS);
    GAS unsigned long long* o8 = (GAS unsigned long long*)orow + lane;
#pragma unroll
    for (int j = 0; j < 8; ++j) { const f32x4 gg = gr[64 * j];
        o8[64 * j] = (unsigned long long)pk2(v[j].x * rstd * gg.x, v[j].y * rstd * gg.y) | ((unsigned long long)pk2(v[j].z * rstd * gg.z, v[j].w * rstd * gg.w) << 32); }
}
__constant__ float INV_FREQ[16] = {1.000000000e+00f, 4.403665960e-01f, 1.939227432e-01f, 8.539710194e-02f, 3.760603070e-02f, 1.656043902e-02f, 7.292664610e-03f, 3.211445874e-03f,
                                   1.414213562e-03f, 6.227723788e-04f, 2.742481884e-04f, 1.207697351e-04f, 5.318296098e-05f, 2.341999971e-05f, 1.031338616e-05f, 4.541670478e-06f};

__device__ __forceinline__ void p0_prologue(Frame& F) {
    LAS float* scr = (LAS float*)(F.lds + F.wave * 16384);
    const int gw = F.vcu * NWAVES + F.wave, NGW = F.G * NWAVES;
    bf16* ws16 = (bf16*)F.ws;
    constexpr int I0 = (DM / 64) * (NQKV / 32), I1 = (DM / 64) * (DM / 32), I2 = (DM / 64) * (WX / 32), I3 = (DM / 64) * (2 * WX / 32), I4 = (WX / 64) * (DM / 32),
                  I5 = (DM / 64) * (2 * FF / 32), I6 = (FF / 64) * (DM / 32);
    constexpr int NITEMS = I0 + I1 + I2 + I3 + I4 + I5 + I6;
    for (int it = gw; it < NITEMS; it += NGW) {
        int r = it;
        if (r < I0) { transpose_item(F.w_in, DM, NQKV, (bf16*)(F.ws + WS_WIN), nullptr, 0, scr, r, F.lane); continue; } r -= I0;
        if (r < I1) { transpose_item(F.w_out, DM, DM, (bf16*)(F.ws + WS_WOUT), nullptr, 0, scr, r, F.lane); continue; } r -= I1;
        if (r < I2) { transpose_item(F.w_xq, DM, WX, (bf16*)(F.ws + WS_WXQ), F.g_xattn, 0, scr, r, F.lane); continue; } r -= I2;
        if (r < I3) { transpose_item(F.w_xkv, DM, 2 * WX, (bf16*)(F.ws + WS_WXKV), nullptr, 0, scr, r, F.lane); continue; } r -= I3;
        if (r < I4) { transpose_item(F.w_xo, WX, DM, (bf16*)(F.ws + WS_WXO), nullptr, 0, scr, r, F.lane); continue; } r -= I4;
        if (r < I5) { transpose_item(F.w_gu, DM, 2 * FF, (bf16*)(F.ws + WS_WGU), F.g_ffn, 1, scr, r, F.lane); continue; } r -= I5;
        transpose_item(F.w_dn, FF, DM, (bf16*)(F.ws + WS_WDN), nullptr, 0, scr, r, F.lane);
    }
    (void)ws16;
    for (int m = gw; m < M; m += NGW) rms_row_to_bf16(F.x + (size_t)m * DM, F.g_mix, (bf16*)(F.ws + WS_RA) + (size_t)m * DM, F.lane);
    for (int m = gw; m < MMEM; m += NGW) rms_row_to_bf16(F.mem + (size_t)m * DM, F.g_mem, (bf16*)(F.ws + WS_MN) + (size_t)m * DM, F.lane);
    float* cs = (float*)(F.ws + WS_CS);
    for (int e = (F.vcu * NWAVES + F.wave) * 64 + F.lane; e < M * 16; e += NGW * 64) {
        const int m = e >> 4, i = e & 15; const float ang = (float)F.pos[m] * INV_FREQ[i];
        double rev = (double)ang * 0.15915494309189535; rev -= floor(rev);
        const float a = (float)(rev * 6.283185307179586);
        cs[(size_t)m * 32 + i] = cosf(a); cs[(size_t)m * 32 + 16 + i] = sinf(a);
    }
}

__device__ __forceinline__ float dot128(const LAS float* qs, const bf16* krow) {
    float s = 0.f;
#pragma unroll
    for (int c = 0; c < 16; ++c) { const v4u kv = *(const v4u*)(krow + 8 * c); const LAS f32x4* q4 = (const LAS f32x4*)(qs + 8 * c); const f32x4 qa = q4[0], qb = q4[1];
        s += qa.x * __uint_as_float(kv.x << 16) + qa.y * __uint_as_float(kv.x & 0xffff0000u) + qa.z * __uint_as_float(kv.y << 16) + qa.w * __uint_as_float(kv.y & 0xffff0000u)
           + qb.x * __uint_as_float(kv.z << 16) + qb.y * __uint_as_float(kv.z & 0xffff0000u) + qb.z * __uint_as_float(kv.w << 16) + qb.w * __uint_as_float(kv.w & 0xffff0000u); }
    return s;
}
__device__ __forceinline__ void load_q_lds(LAS float* qs, const bf16* qp, int lane) { qs[lane] = bf2f(qp[lane]); qs[64 + lane] = bf2f(qp[64 + lane]); LDS_WAIT(); asm volatile("" ::: "memory"); }
__device__ __forceinline__ void pv64(float w, const bf16* vbase, size_t ld, int cnt, int lane, float& o0, float& o1) {
    for (int i = 0; i < cnt; ++i) { const float wi = __shfl(w, i); const unsigned vv = *(const unsigned*)(vbase + (size_t)i * ld + 2 * lane); o0 += wi * __uint_as_float(vv << 16); o1 += wi * __uint_as_float(vv & 0xffff0000u); }
}
__device__ __forceinline__ float softplus2(float y) { return fmaxf(y, 0.f) + __builtin_amdgcn_logf(1.0f + __builtin_amdgcn_exp2f(-fabsf(y))); }
__device__ __forceinline__ void store_head_norm(float o0, float o1, const float* g, bf16* op, int lane) {
    const float ssq = wave_sum(o0 * o0 + o1 * o1); const float r = 1.0f / sqrtf(ssq * (1.f / HD) + EPS);
    *(unsigned*)(op + 2 * lane) = pk2(o0 * r * g[2 * lane], o1 * r * g[2 * lane + 1]);
}
__device__ __forceinline__ void naive_sb_row(Frame& F, LAS float* qs, int bh, int t) {
    const int b = bh >> 3, h = bh & 7, lane = F.lane; const bf16* qkv = (const bf16*)(F.ws + WS_RC); const size_t rb = (size_t)b * SEQ;
    load_q_lds(qs, qkv + (rb + t) * NQKV + QSB + h * HD, lane);
    const bf16* kp = qkv + rb * NQKV + KSB + h * HD; const bf16* vp = qkv + rb * NQKV + VSB + h * HD;
    float o0 = 0.f, o1 = 0.f, carry = 0.f;
    for (int c = (t - 1) >> 6; c >= 0; --c) {
        const int key = c * 64 + lane; const bool valid = key < t;
        float y = 0.f; if (valid) y = dot128(qs, kp + (size_t)key * NQKV);
        const float sp = valid ? softplus2(y) : 0.f;
        float suf = sp;
#pragma unroll
        for (int off = 1; off < 64; off <<= 1) { const float tt = __shfl_down(suf, off); if (lane + off < 64) suf += tt; }
        const float w = valid ? __builtin_amdgcn_exp2f(y - (suf + carry)) : 0.f;
        carry += __shfl(suf, 0);
        const int cnt = (t - c * 64) < 64 ? (t - c * 64) : 64;
        pv64(w, vp + (size_t)(c * 64) * NQKV, NQKV, cnt, lane, o0, o1);
    }
    store_head_norm(o0, o1, F.g_out_sb + h * HD, (bf16*)(F.ws + WS_RA) + (rb + t) * DM + h * HD, lane);
    LDS_WAIT();
}
__device__ __forceinline__ void softmax_chunk(float s, bool valid, const bf16* vbase, size_t ld, int cnt, int lane, float& m, float& l, float& o0, float& o1) {
    const float cm = wave_max(valid ? s : -1e30f); const float mn = fmaxf(m, cm); const float alpha = __builtin_amdgcn_exp2f(m - mn);
    const float p = valid ? __builtin_amdgcn_exp2f(s - mn) : 0.f;
    l = l * alpha + wave_sum(p); o0 *= alpha; o1 *= alpha; m = mn;
    pv64(p, vbase, ld, cnt, lane, o0, o1);
}
__device__ __forceinline__ void naive_moba_row(Frame& F, LAS float* qs, int bh, int t) {
    const int b = bh >> 3, h = bh & 7, lane = F.lane; const bf16* qkv = (const bf16*)(F.ws + WS_RC); const size_t rb = (size_t)b * SEQ;
    load_q_lds(qs, qkv + (rb + t) * NQKV + QMB + h * HD, lane);
    const bf16* kp = qkv + rb * NQKV + KMB + h * HD; const bf16* vp = qkv + rb * NQKV + VMB + h * HD;
    const int blk = t >> 8;
    const float* km = (const float*)(F.ws + WS_KMEAN) + (size_t)bh * 8 * HD;
    float g = -INFINITY;
    { const int n = lane & 7; if (n < blk) { float a = 0.f; for (int d = 0; d < HD; ++d) a += qs[d] * km[n * HD + d]; g = a; } }
    int cnt = 0;
#pragma unroll
    for (int mI = 0; mI < 8; ++mI) { const float gm = __shfl(g, mI); cnt += (gm > g || (gm == g && mI < (lane & 7))) ? 1 : 0; }
    const bool sel = (lane < 8) && (lane < blk) && (cnt < 3);
    const unsigned selmask = (unsigned)(__ballot(sel) & 0xffull);
    float m = -1e30f, l = 0.f, o0 = 0.f, o1 = 0.f;
    for (int n = 0; n <= blk; ++n) {
        if (n < blk && !((selmask >> n) & 1u)) continue;
        for (int c = 0; c < 4; ++c) {
            const int key0 = n * 256 + c * 64; if (key0 > t) break;
            const int key = key0 + lane; const bool valid = key <= t;
            float s = 0.f; if (valid) s = dot128(qs, kp + (size_t)key * NQKV);
            const int cn = (t - key0 + 1) < 64 ? (t - key0 + 1) : 64;
            softmax_chunk(s, valid, vp + (size_t)key0 * NQKV, NQKV, cn, lane, m, l, o0, o1);
        }
    }
    const float il = 1.0f / l;
    store_head_norm(o0 * il, o1 * il, F.g_out_mb + h * HD, (bf16*)(F.ws + WS_RA) + (rb + t) * DM + NH * HD + h * HD, lane);
    LDS_WAIT();
}
__device__ __forceinline__ void naive_xattn_row(Frame& F, LAS float* qs, int b, int h, int t) {
    const int lane = F.lane; const bf16* qx = (const bf16*)(F.ws + WS_QX); const bf16* kv = (const bf16*)(F.ws + WS_KVX);
    load_q_lds(qs, qx + ((size_t)b * SEQ + t) * WX + h * HD, lane);
    const bf16* kp = kv + (size_t)b * NMEM * (2 * WX) + h * HD; const bf16* vp = kp + WX;
    float m = -1e30f, l = 0.f, o0 = 0.f, o1 = 0.f;
    for (int c = 0; c < 4; ++c) { const int key = c * 64 + lane; const float s = dot128(qs, kp + (size_t)key * (2 * WX));
        softmax_chunk(s, true, vp + (size_t)(c * 64) * (2 * WX), 2 * WX, 64, lane, m, l, o0, o1); }
    const float il = 1.0f / l;
    *(unsigned*)((bf16*)(F.ws + WS_OX) + ((size_t)b * SEQ + t) * WX + h * HD + 2 * lane) = pk2(o0 * il, o1 * il);
    LDS_WAIT();
}
__device__ __forceinline__ void kmean_phase(Frame& F) {
    LAS float* red = (LAS float*)F.lds;
    const bf16* qkv = (const bf16*)(F.ws + WS_RC); float* km = (float*)(F.ws + WS_KMEAN);
    const int cc = F.tid & 15, rg = F.tid >> 4;
    for (int item = F.vcu; item < 64 * 8; item += F.G) {
        const int bh = item >> 3, n = item & 7, b = bh >> 3, h = bh & 7;
        const bf16* kp = qkv + ((size_t)b * SEQ + n * 256 + rg * 8) * NQKV + KMB + h * HD + cc * 8;
        float a[8] = {0, 0, 0, 0, 0, 0, 0, 0};
#pragma unroll
        for (int r = 0; r < 8; ++r) { const v4u kv = *(const v4u*)(kp + (size_t)r * NQKV);
            a[0] += __uint_as_float(kv.x << 16); a[1] += __uint_as_float(kv.x & 0xffff0000u); a[2] += __uint_as_float(kv.y << 16); a[3] += __uint_as_float(kv.y & 0xffff0000u);
            a[4] += __uint_as_float(kv.z << 16); a[5] += __uint_as_float(kv.z & 0xffff0000u); a[6] += __uint_as_float(kv.w << 16); a[7] += __uint_as_float(kv.w & 0xffff0000u); }
#pragma unroll
        for (int j = 0; j < 8; ++j) red[rg * 128 + cc * 8 + j] = a[j];
        __syncthreads();
        if (F.tid < 128) { float s = 0.f; for (int r = 0; r < 32; ++r) s += red[r * 128 + F.tid]; km[(size_t)item * HD + F.tid] = s * (1.0f / 256.0f); }
        __syncthreads();
    }
}
__device__ __forceinline__ void final_norm_phase(Frame& F) {
    const int gw = F.vcu * NWAVES + F.wave, NGW = F.G * NWAVES;
    for (int m = gw; m < M; m += NGW) {
        GAS f32x4* xr = (GAS f32x4*)(F.out + (size_t)m * DM) + F.lane; const GAS f32x4* gr = (const GAS f32x4*)F.g_final + F.lane;
        f32x4 v[8]; float s = 0.f;
#pragma unroll
        for (int j = 0; j < 8; ++j) { v[j] = xr[64 * j]; s += (v[j].x * v[j].x + v[j].y * v[j].y) + (v[j].z * v[j].z + v[j].w * v[j].w); }
        const float rstd = 1.0f / sqrtf(wave_sum(s) * (1.f / DM) + EPS);
#pragma unroll
        for (int j = 0; j < 8; ++j) xr[64 * j] = v[j] * rstd * gr[64 * j];
    }
}

constexpr int NPH = 11;
#ifndef MK_ONE_LAUNCH
#define MK_ONE_LAUNCH 1
#endif
struct Args { const void* in[17]; float* out; unsigned char* ws; int ph_lo, ph_hi; };
__global__ void __launch_bounds__(NWAVES * 64, 2) mk_fwd(Args args) {
    extern __shared__ __attribute__((aligned(16))) unsigned char lds[];
    Frame F;
    F.lds = (LAS unsigned char*)lds;
    F.tid = threadIdx.x; F.lane = F.tid & 63; F.wave = __builtin_amdgcn_readfirstlane(F.tid >> 6);
    F.G = gridDim.x; { const int bx = blockIdx.x; F.vcu = (F.G % 8 == 0) ? (bx % 8) * (F.G / 8) + bx / 8 : bx; }
    F.x = (const float*)args.in[0]; F.mem = (const float*)args.in[1]; F.pos = (const int*)args.in[2];
    F.g_mix = (const float*)args.in[3]; F.w_in = (const float*)args.in[4]; F.g_out_sb = (const float*)args.in[5]; F.g_out_mb = (const float*)args.in[6]; F.w_out = (const float*)args.in[7];
    F.g_xattn = (const float*)args.in[8]; F.g_mem = (const float*)args.in[9]; F.w_xq = (const float*)args.in[10]; F.w_xkv = (const float*)args.in[11]; F.w_xo = (const float*)args.in[12];
    F.g_ffn = (const float*)args.in[13]; F.w_gu = (const float*)args.in[14]; F.w_dn = (const float*)args.in[15]; F.g_final = (const float*)args.in[16];
    F.out = args.out; F.ws = args.ws;
    unsigned char* ws = args.ws;
    const int lo = args.ph_lo, hi = args.ph_hi;
#define IN(k) (lo <= (k) && (k) < hi)
#define BOTH(k) (IN(k) && IN((k) + 1))
#define GRID_BAR() do { __threadfence(); cg::this_grid().sync(); } while (0)
    float* ssq1 = (float*)(ws + WS_SSQ1); float* ssq2 = (float*)(ws + WS_SSQ2);
    pg8::bf16_t* RA = (pg8::bf16_t*)(ws + WS_RA); pg8::bf16_t* RB = (pg8::bf16_t*)(ws + WS_RB); pg8::bf16_t* RC = (pg8::bf16_t*)(ws + WS_RC);

    if (IN(0)) { p0_prologue(F); if (BOTH(0)) GRID_BAR(); }
    if (IN(1)) {
        pg8::Gemm g{RA, (const pg8::bf16_t*)(ws + WS_WIN), M, NQKV, DM}; pg8::StaticOrder S; S.init(M, NQKV, F.G, (int)blockIdx.x);
        pg8::EpiQKV E{RC, (const float*)(ws + WS_CS), QSCALE};
        pg8::gemm_phase<pg8::EpiQKV, pg8::StaticOrder, true, true>(F.lds, g, S, E);
        if (BOTH(1)) GRID_BAR();
    }
    if (IN(2)) { kmean_phase(F); if (BOTH(2)) GRID_BAR(); }
    if (IN(3)) {
        LAS float* qs = (LAS float*)(F.lds + F.wave * 1024);
        const int gw = F.vcu * NWAVES + F.wave, NGW = F.G * NWAVES;
        for (int i = gw; i < 64 * SEQ; i += NGW) { const int bh = i >> 11, t = (int)(((unsigned)i + (unsigned)(i >> 11) * 997u) & 2047u); naive_sb_row(F, qs, bh, t); }
        for (int i = gw; i < 64 * SEQ; i += NGW) { const int bh = i >> 11, t = (int)(((unsigned)i + (unsigned)(i >> 11) * 997u) & 2047u); naive_moba_row(F, qs, bh, t); }
        if (BOTH(3)) GRID_BAR();
    }
    if (IN(4)) {
        pg8::Gemm g{RA, (const pg8::bf16_t*)(ws + WS_WOUT), M, DM, DM}; pg8::StaticOrder S; S.init(M, DM, F.G, (int)blockIdx.x);
        pg8::EpiRes E{F.x, F.out, RB, ssq1};
        pg8::gemm_phase<pg8::EpiRes, pg8::StaticOrder, true, true>(F.lds, g, S, E);
        if (BOTH(4)) GRID_BAR();
    }
    if (IN(5)) {
        { pg8::Gemm g{RB, (const pg8::bf16_t*)(ws + WS_WXQ), M, WX, DM}; pg8::StaticOrder S; S.init(M, WX, F.G, (int)blockIdx.x);
          pg8::EpiScale E{(pg8::bf16_t*)(ws + WS_QX), WX, ssq1, QSCALE};
          pg8::gemm_phase<pg8::EpiScale, pg8::StaticOrder, true, true>(F.lds, g, S, E); }
        { pg8::Gemm g{(const pg8::bf16_t*)(ws + WS_MN), (const pg8::bf16_t*)(ws + WS_WXKV), MMEM, 2 * WX, DM}; pg8::StaticOrder S; S.init(MMEM, 2 * WX, F.G, (int)((blockIdx.x + F.G - 128) % F.G));
          pg8::EpiScale E{(pg8::bf16_t*)(ws + WS_KVX), 2 * WX, nullptr, 1.0f};
          pg8::gemm_phase<pg8::EpiScale, pg8::StaticOrder, true, true>(F.lds, g, S, E); }
        if (BOTH(5)) GRID_BAR();
    }
    if (IN(6)) {
        LAS float* qs = (LAS float*)(F.lds + F.wave * 1024);
        const int gw = F.vcu * NWAVES + F.wave, NGW = F.G * NWAVES;
        for (int i = gw; i < BATCH * 4 * SEQ; i += NGW) { const int t = i & 2047, h = (i >> 11) & 3, b = i >> 13; naive_xattn_row(F, qs, b, h, t); }
        if (BOTH(6)) GRID_BAR();
    }
    if (IN(7)) {
        pg8::Gemm g{(const pg8::bf16_t*)(ws + WS_OX), (const pg8::bf16_t*)(ws + WS_WXO), M, DM, WX}; pg8::StaticOrder S; S.init(M, DM, F.G, (int)blockIdx.x);
        pg8::EpiRes E{F.out, F.out, RA, ssq2};
        pg8::gemm_phase<pg8::EpiRes, pg8::StaticOrder, true, true>(F.lds, g, S, E);
        if (BOTH(7)) GRID_BAR();
    }
    if (IN(8)) {
        pg8::Gemm g{RA, (const pg8::bf16_t*)(ws + WS_WGU), M, 2 * FF, DM}; pg8::StaticOrder S; S.init(M, 2 * FF, F.G, (int)blockIdx.x);
        pg8::EpiSwiGLU E{RC, ssq2};
        pg8::gemm_phase<pg8::EpiSwiGLU, pg8::StaticOrder, true, true>(F.lds, g, S, E);
        if (BOTH(8)) GRID_BAR();
    }
    if (IN(9)) {
        pg8::Gemm g{RC, (const pg8::bf16_t*)(ws + WS_WDN), M, DM, FF}; pg8::StaticOrder S; S.init(M, DM, F.G, (int)blockIdx.x);
        pg8::EpiRes E{F.out, F.out, nullptr, nullptr};
        pg8::gemm_phase<pg8::EpiRes, pg8::StaticOrder, true, true>(F.lds, g, S, E);
        if (BOTH(9)) GRID_BAR();
    }
    if (IN(10)) final_norm_phase(F);
#undef IN
#undef BOTH
}

extern "C" void kernel_launch(void* const* d_in, const int* in_sizes, int n_in, void* d_out, int out_size, void* d_ws, size_t ws_size, hipStream_t stream) {
    static int grid = 0;
    if (grid == 0) {
        if (n_in != 17 || in_sizes[0] != M * DM || out_size != M * DM || ws_size < WS_END) { fprintf(stderr, "kernel_launch: unexpected shapes (n_in %d in0 %d out %d ws %zu)\n", n_in, n_in > 0 ? in_sizes[0] : -1, out_size, ws_size); grid = -1; return; }
        int dev = 0, cus = 0, per_cu = 0;
        if (hipGetDevice(&dev) != hipSuccess || hipDeviceGetAttribute(&cus, hipDeviceAttributeMultiprocessorCount, dev) != hipSuccess) { grid = -1; return; }
        if (hipFuncSetAttribute((const void*)mk_fwd, hipFuncAttributeMaxDynamicSharedMemorySize, LDS_BYTES) != hipSuccess) { fprintf(stderr, "kernel_launch: hipFuncSetAttribute failed\n"); grid = -1; return; }
        if (hipOccupancyMaxActiveBlocksPerMultiprocessor(&per_cu, (const void*)mk_fwd, NWAVES * 64, LDS_BYTES) != hipSuccess || per_cu < 1) { fprintf(stderr, "kernel_launch: occupancy query failed (%d)\n", per_cu); per_cu = 1; }
        (void)hipGetLastError();
        grid = cus * (per_cu < 1 ? 1 : 1);
    }
    if (grid < 0) return;
    (void)hipMemsetAsync((char*)d_ws + WS_CTL, 0, CTL_ZERO_BYTES, stream);
    Args a{};
    for (int i = 0; i < 17; ++i) a.in[i] = d_in[i];
    a.out = (float*)d_out; a.ws = (unsigned char*)d_ws;
#if MK_ONE_LAUNCH
    a.ph_lo = 0; a.ph_hi = NPH;
    void* kargs[] = {&a};
    hipError_t e = hipLaunchCooperativeKernel((const void*)mk_fwd, dim3(grid), dim3(NWAVES * 64), kargs, LDS_BYTES, stream);
    if (e != hipSuccess) fprintf(stderr, "kernel_launch: cooperative launch failed: %s (grid %d)\n", hipGetErrorString(e), grid);
#else
    for (int p = 0; p < NPH; ++p) { a.ph_lo = p; a.ph_hi = p + 1; hipLaunchKernelGGL(mk_fwd, dim3(grid), dim3(NWAVES * 64), LDS_BYTES, stream, a); }
    const hipError_t le = hipPeekAtLastError();
    if (le != hipSuccess) fprintf(stderr, "kernel_launch: launch failed: %s\n", hipGetErrorName(le));
#endif
}
```

```cpp
#include <hip/hip_runtime.h>
#include <hip/hip_cooperative_groups.h>
#include <cstdio>
#include <cstdint>
namespace cg = cooperative_groups;
namespace pg8 {
#define PG8_LAS __attribute__((address_space(3)))
typedef unsigned short bf16_t;
typedef short bf16x8 __attribute__((ext_vector_type(8)));
typedef float f32x4 __attribute__((ext_vector_type(4)));
typedef unsigned u32x4 __attribute__((ext_vector_type(4)));
constexpr int BM = 256, BK = 64, HALF = 128, HTB = HALF * BK * 2  , STAGE_BYTES = 8 * HTB, NXCD = 8, WGM = 8;

__host__ __device__ __forceinline__ int lds_byte(int r, int c) { const int st = (r >> 4) * 2 + (c >> 5), rr = r & 15, cc = c & 31, ob = rr * 64 + cc * 2; return st * 1024 + (ob ^ (((ob >> 9) & 1) << 5)); }
__host__ __device__ __forceinline__ void stage_rc(int b, int& R, int& C) { const int st = b / 1024, sb = b % 1024, swz = sb ^ (((sb >> 9) & 1) << 5); R = (st >> 1) * 16 + swz / 64; C = (st & 1) * 32 + (swz % 64) / 2; }
__host__ __device__ __forceinline__ int perm32(int rho) { const int n = rho >> 4, i = rho & 15; return 8 * (i >> 2) + 4 * n + (i & 3); }

struct Unit { int pm, pn; };
struct Gemm { const bf16_t* A; const bf16_t* Bt; int M, N, K; };

struct StaticOrder {
    int nM, nN, nwg, G, c;
    __host__ __device__ void init(int M, int N, int G_, int c_) { nM = M / BM; nN = N / BM; nwg = nM * nN; G = G_; c = c_; }
    __host__ __device__ bool next(int i, Unit& u) const {
        const long L = (long)i * G + c; if (L >= nwg) return false;
        int wgid = (int)L; { const int q = nwg / NXCD, r = nwg % NXCD, xcd = wgid % NXCD, off = wgid / NXCD; wgid = (xcd < r ? xcd * (q + 1) : r * (q + 1) + (xcd - r) * q) + off; }
        const int nig = WGM * nN, gid = wgid / nig, fm = gid * WGM, gsz = (nM - fm) < WGM ? (nM - fm) : WGM;
        u.pm = fm + ((wgid % nig) % gsz); u.pn = (wgid % nig) / gsz; return true;
    }
    __device__ __forceinline__ void a_ready(const Unit&) const {}
    __device__ __forceinline__ void done(const Unit&) const {}
};

__device__ __forceinline__ unsigned cvt_pk_bf16(float lo, float hi) { unsigned r; asm volatile("v_cvt_pk_bf16_f32 %0, %1, %2" : "=v"(r) : "v"(lo), "v"(hi)); return r; }
typedef float f32x2 __attribute__((ext_vector_type(2)));
template <class Epi, class Sched, bool ALIGN_EPI = false, bool SP2 = false>
__device__ __forceinline__ void gemm_phase(PG8_LAS unsigned char* lds, const Gemm g, const Sched& S, const Epi& E) {
    int tid_ = threadIdx.x; asm volatile("" : "+v"(tid_));
    const int tid = tid_, wid = __builtin_amdgcn_readfirstlane(tid >> 6), lane = tid & 63, wr = wid >> 2, wc = wid & 3, fr = lane & 15, fq = lane >> 4;
    const int K = g.K, nt = K / BK;
    unsigned voffA[2], voffB[2];
#pragma unroll
    for (int i = 0; i < 2; ++i) { int R, C; stage_rc(tid * 16 + i * 8192, R, C); const int Rb = Epi::PERM ? ((R & ~31) + perm32(R & 31)) : R;
        voffA[i] = (unsigned)(R * K + C) * 2u; voffB[i] = (unsigned)(Rb * K + C) * 2u; }
    const size_t kstep = (size_t)(BK * 2);
    const size_t hstep = (size_t)HALF * K * 2;
    const size_t tstep = 2 * hstep;
    const unsigned ldsw = (unsigned)wid * 1024u;
    const int aoff = lds_byte(wr * 64 + fr, fq * 8), boff = lds_byte(wc * 32 + fr, fq * 8);
#define PG8_SA(b, h) (((b) * 2 + (h)) * HTB)
#define PG8_SB(b, h) ((4 + (b) * 2 + (h)) * HTB)
#define PG8_STAGE(bufoff, gbase, voff) do { _Pragma("unroll") for (int _i = 0; _i < 2; ++_i) \
        __builtin_amdgcn_global_load_lds((const unsigned*)((const char*)(gbase) + (voff)[_i]), (PG8_LAS unsigned*)(lds + (bufoff) + ldsw + _i * 8192), 16, 0, 0); } while (0)
#define PG8_LDA(dst, b, h) do { _Pragma("unroll") for (int m = 0; m < 4; ++m) _Pragma("unroll") for (int k = 0; k < 2; ++k) dst[m][k] = *(const PG8_LAS bf16x8*)(lds + PG8_SA(b, h) + aoff + m * 2048 + k * 1024); } while (0)
#define PG8_LDB(dst, b, h) do { _Pragma("unroll") for (int n = 0; n < 2; ++n) _Pragma("unroll") for (int k = 0; k < 2; ++k) dst[n][k] = *(const PG8_LAS bf16x8*)(lds + PG8_SB(b, h) + boff + n * 2048 + k * 1024); } while (0)
#define PG8_MMA(ai, bj, At, Bt) do { __builtin_amdgcn_s_setprio(1); _Pragma("unroll") for (int m = 0; m < 4; ++m) _Pragma("unroll") for (int n = 0; n < 2; ++n) _Pragma("unroll") for (int k = 0; k < 2; ++k) \
        acc[ai][bj][m][n] = __builtin_amdgcn_mfma_f32_16x16x32_bf16(Bt[n][k], At[m][k], acc[ai][bj][m][n], 0, 0, 0); __builtin_amdgcn_s_setprio(0); } while (0)
#define PG8_WAIT_V(n) asm volatile("s_waitcnt vmcnt(" #n ")" ::: "memory")
#define PG8_WAIT_L(n) asm volatile("s_waitcnt lgkmcnt(" #n ")" ::: "memory")
#define PG8_BAR __builtin_amdgcn_s_barrier()
#define PG8_SCHED __builtin_amdgcn_sched_barrier(0)
    Unit cur, nxt; int ui = 0;
    if (!S.next(0, cur)) return;
    f32x4 acc[2][2][4][2];
#pragma unroll
    for (int a = 0; a < 2; ++a)
#pragma unroll
        for (int b = 0; b < 2; ++b)
#pragma unroll
            for (int m = 0; m < 4; ++m)
#pragma unroll
                for (int n = 0; n < 2; ++n) acc[a][b][m][n] = (f32x4){0.f, 0.f, 0.f, 0.f};
    bf16x8 At[4][2], B0[2][2], B1[2][2];
    const char* cA = (const char*)g.A + (size_t)cur.pm * tstep; const char* cB = (const char*)g.Bt + (size_t)cur.pn * tstep;
    S.a_ready(cur);
    if constexpr (SP2) {
        PG8_STAGE(PG8_SB(0, 0), cB, voffB); PG8_STAGE(PG8_SB(0, 1), cB + hstep, voffB); PG8_STAGE(PG8_SA(0, 0), cA, voffA); PG8_STAGE(PG8_SA(0, 1), cA + hstep, voffA);
        if (wr == 1) PG8_BAR;
        PG8_WAIT_V(2); PG8_BAR;
        PG8_STAGE(PG8_SB(1, 0), cB + kstep, voffB); PG8_STAGE(PG8_SA(1, 0), cA + kstep, voffA); PG8_STAGE(PG8_SB(1, 1), cB + hstep + kstep, voffB);
        PG8_WAIT_V(6); PG8_BAR;
    } else {
        PG8_STAGE(PG8_SB(0, 0), cB, voffB); PG8_STAGE(PG8_SA(0, 0), cA, voffA); PG8_STAGE(PG8_SB(0, 1), cB + hstep, voffB); PG8_STAGE(PG8_SA(0, 1), cA + hstep, voffA);
        if (wr == 1) PG8_BAR;
        PG8_WAIT_V(4); PG8_BAR;
        PG8_STAGE(PG8_SB(1, 0), cB + kstep, voffB); PG8_STAGE(PG8_SA(1, 0), cA + kstep, voffA); PG8_STAGE(PG8_SB(1, 1), cB + hstep + kstep, voffB);
        PG8_WAIT_V(6); PG8_BAR;
    }
    for (;;) {
        const bool has_next = S.next(ui + 1, nxt);
        const char* nA = has_next ? (const char*)g.A + (size_t)nxt.pm * tstep : cA; const char* nB = has_next ? (const char*)g.Bt + (size_t)nxt.pn * tstep : cB;
        for (int t = 0; t < nt; t += 2) {
            const bool last = (t == nt - 2);
            const char* a1 = cA + (size_t)(t + 1) * kstep;
            const char* a2 = last ? nA : cA + (size_t)(t + 2) * kstep; const char* b2 = last ? nB : cB + (size_t)(t + 2) * kstep;
            const char* a3 = a2 + kstep; const char* b3 = b2 + kstep;
            if (last && has_next) S.a_ready(nxt);
            if constexpr (SP2) {
            PG8_LDB(B0, 0, 0); PG8_LDB(B1, 0, 1); PG8_SCHED; PG8_LDA(At, 0, 0); PG8_STAGE(PG8_SA(1, 1), a1 + hstep, voffA);
            PG8_WAIT_V(8); PG8_WAIT_L(0); PG8_BAR; PG8_MMA(0, 0, At, B0); PG8_MMA(0, 1, At, B1); PG8_BAR; PG8_SCHED;
            PG8_LDA(At, 0, 1); PG8_STAGE(PG8_SB(0, 0), b2, voffB); PG8_STAGE(PG8_SB(0, 1), b2 + hstep, voffB); PG8_STAGE(PG8_SA(0, 0), a2, voffA);
            PG8_WAIT_V(8); PG8_WAIT_L(0); PG8_BAR; PG8_MMA(1, 0, At, B0); PG8_MMA(1, 1, At, B1); PG8_BAR; PG8_SCHED;
            PG8_LDB(B0, 1, 0); PG8_LDB(B1, 1, 1); PG8_SCHED; PG8_LDA(At, 1, 0); PG8_STAGE(PG8_SA(0, 1), a2 + hstep, voffA);
            PG8_WAIT_V(8); PG8_WAIT_L(0); PG8_BAR; PG8_MMA(0, 0, At, B0); PG8_MMA(0, 1, At, B1); PG8_BAR; PG8_SCHED;
            PG8_LDA(At, 1, 1); PG8_STAGE(PG8_SB(1, 0), b3, voffB); PG8_STAGE(PG8_SB(1, 1), b3 + hstep, voffB); PG8_STAGE(PG8_SA(1, 0), a3, voffA);
            PG8_WAIT_V(8); PG8_WAIT_L(0); PG8_BAR; PG8_MMA(1, 0, At, B0); PG8_MMA(1, 1, At, B1); PG8_BAR; PG8_SCHED;
            } else {
            PG8_LDB(B0, 0, 0); PG8_SCHED; PG8_LDA(At, 0, 0); PG8_STAGE(PG8_SA(1, 1), a1 + hstep, voffA);
            PG8_WAIT_L(8); PG8_BAR; PG8_WAIT_L(0); PG8_MMA(0, 0, At, B0); PG8_BAR; PG8_SCHED;
            PG8_LDB(B1, 0, 1); PG8_STAGE(PG8_SB(0, 0), b2, voffB);
            PG8_BAR; PG8_WAIT_L(0); PG8_MMA(0, 1, At, B1); PG8_BAR;
            PG8_LDA(At, 0, 1); PG8_STAGE(PG8_SA(0, 0), a2, voffA);
            PG8_BAR; PG8_WAIT_L(0); PG8_MMA(1, 0, At, B0); PG8_BAR; PG8_SCHED;
            PG8_STAGE(PG8_SB(0, 1), b2 + hstep, voffB);
            PG8_WAIT_V(6); PG8_BAR; PG8_MMA(1, 1, At, B1); PG8_BAR;
            PG8_LDB(B0, 1, 0); PG8_SCHED; PG8_LDA(At, 1, 0); PG8_STAGE(PG8_SA(0, 1), a2 + hstep, voffA);
            PG8_WAIT_L(8); PG8_BAR; PG8_WAIT_L(0); PG8_MMA(0, 0, At, B0); PG8_BAR; PG8_SCHED;
            PG8_LDB(B1, 1, 1); PG8_STAGE(PG8_SB(1, 0), b3, voffB);
            PG8_BAR; PG8_WAIT_L(0); PG8_MMA(0, 1, At, B1); PG8_BAR;
            PG8_LDA(At, 1, 1); PG8_STAGE(PG8_SA(1, 0), a3, voffA);
            PG8_BAR; PG8_WAIT_L(0); PG8_MMA(1, 0, At, B0); PG8_BAR; PG8_SCHED;
            PG8_STAGE(PG8_SB(1, 1), b3 + hstep, voffB);
            PG8_WAIT_V(6); PG8_BAR; PG8_MMA(1, 1, At, B1); PG8_BAR;
            }
        }
        if constexpr (ALIGN_EPI) { if (wr == 0) PG8_BAR; }
        if constexpr (!Epi::AFTER_DRAIN) { E(acc, cur, wr, wc, fr, fq); S.done(cur); }
        if (!has_next) break;
#pragma unroll
        for (int a = 0; a < 2; ++a)
#pragma unroll
            for (int b = 0; b < 2; ++b)
#pragma unroll
                for (int m = 0; m < 4; ++m)
#pragma unroll
                    for (int n = 0; n < 2; ++n) acc[a][b][m][n] = (f32x4){0.f, 0.f, 0.f, 0.f};
        cur = nxt; cA = nA; cB = nB; ++ui;
        if constexpr (ALIGN_EPI) { if (wr == 1) PG8_BAR; }
    }
    PG8_WAIT_V(0);
    if constexpr (!ALIGN_EPI) { if (wr == 0) PG8_BAR; }
    PG8_BAR;
    if constexpr (Epi::AFTER_DRAIN) { E.fused(acc, cur, wr, wc, fr, fq, lds, wid, lane); S.done(cur); }
#undef PG8_SA
#undef PG8_SB
#undef PG8_STAGE
#undef PG8_LDA
#undef PG8_LDB
#undef PG8_MMA
#undef PG8_WAIT_V
#undef PG8_WAIT_L
#undef PG8_BAR
#undef PG8_SCHED
}
}
namespace pg8 {
typedef unsigned u32x2 __attribute__((ext_vector_type(2)));
constexpr int LDX = 2048;
constexpr float RMS_EPS = 1e-6f;
struct EpiQKV {
    static constexpr bool PERM = true, AFTER_DRAIN = false;
    bf16_t* O; const float* cs; float qscale;
    __device__ __forceinline__ void operator()(const f32x4 (&acc)[2][2][4][2], const Unit& u, int wr, int wc, int fr, int fq) const {
        const int row0 = u.pm * BM + wr * 64 + fr, col0 = u.pn * BM + wc * 32 + 8 * fq, pn = u.pn;
        const float sc = (pn < 4 || (pn >= 12 && pn < 16)) ? qscale : 1.f;
        const bool rot = (pn >= 12 && pn < 20) && (wc == 0);
#pragma unroll
        for (int ai = 0; ai < 2; ++ai)
#pragma unroll
            for (int m = 0; m < 4; ++m) { const int row = row0 + ai * HALF + m * 16; bf16_t* rowp = O + (size_t)row * 6144 + col0;
                f32x4 c0 = {1.f, 1.f, 1.f, 1.f}, c1 = c0, s0 = {0.f, 0.f, 0.f, 0.f}, s1 = s0;
                if (rot) { const float* cr = cs + (size_t)row * 32 + 8 * (fq & 1); c0 = *(const f32x4*)cr; c1 = *(const f32x4*)(cr + 4); s0 = *(const f32x4*)(cr + 16); s1 = *(const f32x4*)(cr + 20);
                    if (fq < 2) { s0 = -s0; s1 = -s1; } }
#pragma unroll
                for (int bj = 0; bj < 2; ++bj) { f32x4 v0 = acc[ai][bj][m][0], v1 = acc[ai][bj][m][1];
                    if (rot) { f32x4 p0, p1;
#pragma unroll
                        for (int j = 0; j < 4; ++j) { p0[j] = __shfl_xor(v0[j], 32); p1[j] = __shfl_xor(v1[j], 32); }
                        v0 = v0 * c0 + p0 * s0; v1 = v1 * c1 + p1 * s1; }
                    v0 = v0 * sc; v1 = v1 * sc; u32x4 w; w.x = cvt_pk_bf16(v0[0], v0[1]); w.y = cvt_pk_bf16(v0[2], v0[3]); w.z = cvt_pk_bf16(v1[0], v1[1]); w.w = cvt_pk_bf16(v1[2], v1[3]);
                    *(u32x4*)(rowp + bj * HALF) = w; } }
    }
};
struct EpiRes {
    static constexpr bool PERM = false, AFTER_DRAIN = false;
    const float* base; float* out; bf16_t* xb; float* ssq;
    __device__ __forceinline__ void operator()(const f32x4 (&acc)[2][2][4][2], const Unit& u, int wr, int wc, int fr, int fq) const {
        const int row0 = u.pm * BM + wr * 64 + fr, col0 = u.pn * BM + wc * 32 + 4 * fq;
#pragma unroll
        for (int ai = 0; ai < 2; ++ai)
#pragma unroll
            for (int m = 0; m < 4; ++m) { const int row = row0 + ai * HALF + m * 16; const size_t off = (size_t)row * LDX + col0; float s = 0.f;
#pragma unroll
                for (int bj = 0; bj < 2; ++bj)
#pragma unroll
                    for (int n = 0; n < 2; ++n) { const f32x4 v = *(const f32x4*)(base + off + bj * HALF + n * 16) + acc[ai][bj][m][n];
                        *(f32x4*)(out + off + bj * HALF + n * 16) = v; s += (v[0] * v[0] + v[1] * v[1]) + (v[2] * v[2] + v[3] * v[3]);
                        if (xb) { u32x2 w; w.x = cvt_pk_bf16(v[0], v[1]); w.y = cvt_pk_bf16(v[2], v[3]); *(u32x2*)(xb + off + bj * HALF + n * 16) = w; } }
                if (ssq) { s += __shfl_xor(s, 16); s += __shfl_xor(s, 32); if (fq == 0) atomicAdd(ssq + row, s); }
                asm volatile("" ::: "memory"); }
    }
};
struct EpiScale {
    static constexpr bool PERM = true, AFTER_DRAIN = false;
    bf16_t* O; int ldc; const float* ssq; float sc;
    __device__ __forceinline__ void operator()(const f32x4 (&acc)[2][2][4][2], const Unit& u, int wr, int wc, int fr, int fq) const {
        const int row0 = u.pm * BM + wr * 64 + fr, col0 = u.pn * BM + wc * 32 + 8 * fq;
#pragma unroll
        for (int ai = 0; ai < 2; ++ai)
#pragma unroll
            for (int m = 0; m < 4; ++m) { const int row = row0 + ai * HALF + m * 16; bf16_t* rowp = O + (size_t)row * ldc + col0;
                const float f = ssq ? sc * __builtin_amdgcn_rsqf(ssq[row] * (1.0f / 2048.0f) + RMS_EPS) : sc;
#pragma unroll
                for (int bj = 0; bj < 2; ++bj) { const f32x4 v0 = acc[ai][bj][m][0] * f, v1 = acc[ai][bj][m][1] * f;
                    u32x4 w; w.x = cvt_pk_bf16(v0[0], v0[1]); w.y = cvt_pk_bf16(v0[2], v0[3]); w.z = cvt_pk_bf16(v1[0], v1[1]); w.w = cvt_pk_bf16(v1[2], v1[3]);
                    *(u32x4*)(rowp + bj * HALF) = w; } }
    }
};
struct EpiSwiGLU {
    static constexpr bool PERM = true, AFTER_DRAIN = false;
    bf16_t* O; const float* ssq;
    __device__ __forceinline__ void operator()(const f32x4 (&acc)[2][2][4][2], const Unit& u, int wr, int wc, int fr, int fq) const {
        const int row0 = u.pm * BM + wr * 64 + fr, col0 = u.pn * HALF + wc * 32 + 8 * fq;
#pragma unroll
        for (int ai = 0; ai < 2; ++ai)
#pragma unroll
            for (int m = 0; m < 4; ++m) { const int row = row0 + ai * HALF + m * 16; bf16_t* rowp = O + (size_t)row * 5632 + col0;
                const float f = __builtin_amdgcn_rsqf(ssq[row] * (1.0f / 2048.0f) + RMS_EPS);
                float r[8];
#pragma unroll
                for (int n = 0; n < 2; ++n)
#pragma unroll
                    for (int j = 0; j < 4; ++j) { const float g = acc[ai][0][m][n][j] * f, uu = acc[ai][1][m][n][j] * f;
                        const float sg = g * __builtin_amdgcn_rcpf(1.0f + __builtin_amdgcn_exp2f(-1.4426950408889634f * g)); r[n * 4 + j] = sg * uu; }
                u32x4 w; w.x = cvt_pk_bf16(r[0], r[1]); w.y = cvt_pk_bf16(r[2], r[3]); w.z = cvt_pk_bf16(r[4], r[5]); w.w = cvt_pk_bf16(r[6], r[7]);
                *(u32x4*)rowp = w; }
    }
};
}
namespace att {
using bf16x8 = __attribute__((ext_vector_type(8))) short;
using s16x4  = __attribute__((ext_vector_type(4))) short;
using f32x16 = __attribute__((ext_vector_type(16))) float;
using f32x4  = __attribute__((ext_vector_type(4))) float;
using u32x4  = __attribute__((ext_vector_type(4))) unsigned;
typedef unsigned short bf16;
constexpr int D = 128, KVBLK = 64;
constexpr int SHM_V = KVBLK * D * 2, SHM_K = KVBLK * D * 2;
constexpr int OFF_WS = 2 * SHM_V + 2 * SHM_K, OFF_KM = OFF_WS + 2048, ATT_LDS = OFF_KM + 4096;
constexpr float THR = 8.f;
#define KSWZ(row, colB) ((row) * 256 + ((colB) ^ (((row) & 7) << 4)))
#define SBAR() __builtin_amdgcn_sched_barrier(0)
__device__ __forceinline__ int crow(int r, int hi) { return (r & 3) + 8 * (r >> 2) + 4 * hi; }
__device__ __forceinline__ unsigned cvtpk(float lo, float hi) { unsigned r; asm volatile("v_cvt_pk_bf16_f32 %0, %1, %2" : "=v"(r) : "v"(lo), "v"(hi)); return r; }
__device__ __forceinline__ float xchg32(float x, int hi) { auto rr = __builtin_amdgcn_permlane32_swap(__float_as_uint(x), __float_as_uint(x), false, false); return __uint_as_float(hi ? rr[0] : rr[1]); }
__device__ __forceinline__ void qkt(f32x16& p0, f32x16& p1, const char* Ks, const bf16x8* qr, int r32, int hi) {
  p0 = f32x16{}; p1 = f32x16{};
#pragma unroll
  for (int d0 = 0; d0 < 8; ++d0) { int cb = (d0 * 16 + hi * 8) * 2;
    bf16x8 b0 = *reinterpret_cast<const bf16x8*>(Ks + KSWZ(r32, cb));
    bf16x8 b1 = *reinterpret_cast<const bf16x8*>(Ks + KSWZ(32 + r32, cb));
    p0 = __builtin_amdgcn_mfma_f32_32x32x16_bf16(b0, qr[d0], p0, 0, 0, 0);
    p1 = __builtin_amdgcn_mfma_f32_32x32x16_bf16(b1, qr[d0], p1, 0, 0, 0); }
}
__device__ __forceinline__ int v_st(int k, int c) { const int kk = (k & ~0xC) | ((k & 4) << 1) | ((k & 8) >> 1); return ((kk >> 3) * 4 + (c >> 5)) * 512 + ((kk & 7) * 32 + (c & 31)) * 2; }
__device__ __forceinline__ int v_rd_base(int lane) { return ((lane & 3) << 3) | (((lane >> 2) & 3) << 6) | (((lane >> 4) & 1) << 5) | (((lane >> 5) & 1) << 8); }
constexpr int v_rd_off(int d0, int ks, int half) { return d0 * 512 + ks * 4096 + half * 2048; }
template <int OFF> __device__ __forceinline__ s16x4 tr_read(int vb) { s16x4 r; asm volatile("ds_read_b64_tr_b16 %0, %1 offset:%2" : "=&v"(r) : "v"(vb), "i"(OFF) : "memory"); return r; }
template <int D0> __device__ __forceinline__ void pv_one(f32x16& od, int vb, bf16x8 pa0, bf16x8 pa1, bf16x8 pa2, bf16x8 pa3) {
  const s16x4 l0 = tr_read<v_rd_off(D0, 0, 0)>(vb), h0 = tr_read<v_rd_off(D0, 0, 1)>(vb), l1 = tr_read<v_rd_off(D0, 1, 0)>(vb), h1 = tr_read<v_rd_off(D0, 1, 1)>(vb);
  const s16x4 l2 = tr_read<v_rd_off(D0, 2, 0)>(vb), h2 = tr_read<v_rd_off(D0, 2, 1)>(vb), l3 = tr_read<v_rd_off(D0, 3, 0)>(vb), h3 = tr_read<v_rd_off(D0, 3, 1)>(vb);
  asm volatile("s_waitcnt lgkmcnt(0)" ::: "memory"); SBAR();
#define PK(L, H) (bf16x8){L[0], L[1], L[2], L[3], H[0], H[1], H[2], H[3]}
  od = __builtin_amdgcn_mfma_f32_32x32x16_bf16(pa0, PK(l0, h0), od, 0, 0, 0);
  od = __builtin_amdgcn_mfma_f32_32x32x16_bf16(pa1, PK(l1, h1), od, 0, 0, 0);
  od = __builtin_amdgcn_mfma_f32_32x32x16_bf16(pa2, PK(l2, h2), od, 0, 0, 0);
  od = __builtin_amdgcn_mfma_f32_32x32x16_bf16(pa3, PK(l3, h3), od, 0, 0, 0);
#undef PK
}
__device__ __forceinline__ void pv_d0(f32x16* o, int vb, bf16x8 pa0, bf16x8 pa1, bf16x8 pa2, bf16x8 pa3) {
  pv_one<0>(o[0], vb, pa0, pa1, pa2, pa3); pv_one<1>(o[1], vb, pa0, pa1, pa2, pa3); pv_one<2>(o[2], vb, pa0, pa1, pa2, pa3); pv_one<3>(o[3], vb, pa0, pa1, pa2, pa3);
}
__device__ __forceinline__ void pack_p(const f32x16& p0, const f32x16& p1, bf16x8& pa0, bf16x8& pa1, bf16x8& pa2, bf16x8& pa3) {
#define PK4(P, BASE, OUT) do { unsigned a0 = cvtpk(P[BASE + 0], P[BASE + 1]), a1 = cvtpk(P[BASE + 2], P[BASE + 3]);   \
    unsigned b0 = cvtpk(P[BASE + 4], P[BASE + 5]), b1 = cvtpk(P[BASE + 6], P[BASE + 7]);                              \
    auto r0 = __builtin_amdgcn_permlane32_swap(a0, b0, false, false); auto r1 = __builtin_amdgcn_permlane32_swap(a1, b1, false, false); \
    u32x4 w = {r0[0], r1[0], r0[1], r1[1]}; OUT = *reinterpret_cast<bf16x8*>(&w); } while (0)
  PK4(p0, 0, pa0); PK4(p0, 8, pa1); PK4(p1, 0, pa2); PK4(p1, 8, pa3);
#undef PK4
}
__device__ __forceinline__ void softmax_tile(f32x16& p0, f32x16& p1, float& m_reg, float& l_reg, float& alpha) {
  float pmax = p0[0];
#pragma unroll
  for (int r = 1; r < 16; ++r) pmax = fmaxf(pmax, p0[r]);
#pragma unroll
  for (int r = 0; r < 16; ++r) pmax = fmaxf(pmax, p1[r]);
  pmax = fmaxf(pmax, xchg32(pmax, (int)(threadIdx.x >> 5) & 1));
  if (__all(pmax - m_reg <= THR)) { alpha = 1.f; }
  else { const float mn = fmaxf(m_reg, pmax); alpha = __builtin_amdgcn_exp2f(m_reg - mn); m_reg = mn; }
  float ps = 0.f;
#pragma unroll
  for (int r = 0; r < 16; ++r) { p0[r] = __builtin_amdgcn_exp2f(p0[r] - m_reg); ps += p0[r]; }
#pragma unroll
  for (int r = 0; r < 16; ++r) { p1[r] = __builtin_amdgcn_exp2f(p1[r] - m_reg); ps += p1[r]; }
  ps += xchg32(ps, (int)(threadIdx.x >> 5) & 1);
  l_reg = l_reg * alpha + ps;
}
__device__ __forceinline__ float softplus2(float y) { return fmaxf(y, 0.f) + __builtin_amdgcn_logf(1.0f + __builtin_amdgcn_exp2f(-fabsf(y))); }
__device__ __forceinline__ void sb_tile(f32x16& p0, f32x16& p1, float& carry, bool band, int kb, int qrel, int hi) {
  float gs[8];
#pragma unroll
  for (int i = 0; i < 4; ++i) { float run = 0.f;
#pragma unroll
    for (int e = 3; e >= 0; --e) { const int r = 4 * i + e; const bool valid = !band || (kb + crow(r, hi) < qrel); const float y = p0[r];
      const float sp = valid ? softplus2(y) : 0.f; run += sp; p0[r] = valid ? (y - run) : -INFINITY; }
    gs[i] = run; }
#pragma unroll
  for (int i = 0; i < 4; ++i) { float run = 0.f;
#pragma unroll
    for (int e = 3; e >= 0; --e) { const int r = 4 * i + e; const bool valid = !band || (kb + 32 + crow(r, hi) < qrel); const float y = p1[r];
      const float sp = valid ? softplus2(y) : 0.f; run += sp; p1[r] = valid ? (y - run) : -INFINITY; }
    gs[4 + i] = run; }
  float acc = 0.f;
#pragma unroll
  for (int i = 7; i >= 0; --i) { const float so_i = acc; acc += gs[i]; const float x = hi ? acc : so_i; gs[i] = carry + so_i + xchg32(x, hi); }
  const float tot = acc, ptot = xchg32(acc, hi);
#pragma unroll
  for (int i = 0; i < 4; ++i)
#pragma unroll
    for (int e = 0; e < 4; ++e) { p0[4 * i + e] = __builtin_amdgcn_exp2f(p0[4 * i + e] - gs[i]); p1[4 * i + e] = __builtin_amdgcn_exp2f(p1[4 * i + e] - gs[4 + i]); }
  carry += tot + ptot;
}

template <int MODE>
__device__ __forceinline__ void attn_unit(const bf16* __restrict__ Qb, int ldq, const bf16* __restrict__ Kh, const bf16* __restrict__ Vh, int ldk, bf16* __restrict__ Ob, int ldo,
                                          const float* __restrict__ gain, const float* __restrict__ kmean, int qb, int nkeys, char* lds) {
  int tid_ = threadIdx.x; asm volatile("" : "+v"(tid_));
  const int tid = tid_, wid = __builtin_amdgcn_readfirstlane(tid >> 6), lane = tid & 63, r32 = lane & 31, hi = lane >> 5;
  char* V_lds = lds; char* K_lds = lds + 2 * SHM_V;
  float* ws = (float*)(lds + OFF_WS) + wid * 64; float* li_l = ws; float* al_l = ws + 32;
  float* km_l = (float*)(lds + OFF_KM);
  const int NT = (MODE == 0) ? nkeys / KVBLK : 4 * (qb + 1);
  const int qrel = wid * 32 + r32;
  float m_reg = -1e30f, l_reg = 0.f, carry = 0.f; f32x16 o[4] = {}; bf16x8 qr[8];
  const bf16* Qw = Qb + (long)(wid * 32 + r32) * ldq + hi * 8;
#pragma unroll
  for (int d0 = 0; d0 < 8; ++d0) qr[d0] = *reinterpret_cast<const bf16x8*>(Qw + d0 * 16);
  const int vb0 = (int)(uintptr_t)V_lds + v_rd_base(lane);
  long ksrc[2], vsrc[2];
#pragma unroll
  for (int i = 0; i < 2; ++i) { const int piece = wid + 8 * i;
    { const int row = piece * 4 + (lane >> 4), c = (lane & 15) ^ (row & 7); ksrc[i] = (long)row * ldk + c * 8; }
    { const int sub = piece * 2 + (lane >> 5), kk = (sub >> 2) * 8 + ((lane & 31) >> 2), k = (kk & ~0xC) | ((kk & 4) << 1) | ((kk & 8) >> 1), c = (sub & 3) * 32 + (lane & 3) * 8; vsrc[i] = (long)k * ldk + c; } }
  typedef __attribute__((address_space(3))) unsigned lds_u32;
  lds_u32* kdst = (lds_u32*)(__attribute__((address_space(3))) char*)(K_lds) + wid * 256; lds_u32* vdst = (lds_u32*)(__attribute__((address_space(3))) char*)(V_lds) + wid * 256;
#define TILE(it) ((MODE == 2) ? (NT - 1 - (it)) : (it))
#define SDMA(k0, b) do { _Pragma("unroll") for (int i_ = 0; i_ < 2; ++i_) { \
    __builtin_amdgcn_global_load_lds((const unsigned*)(Kh + (long)(k0) * ldk + ksrc[i_]), kdst + (b) * (SHM_K / 4) + i_ * 2048, 16, 0, 0); \
    __builtin_amdgcn_global_load_lds((const unsigned*)(Vh + (long)(k0) * ldk + vsrc[i_]), vdst + (b) * (SHM_V / 4) + i_ * 2048, 16, 0, 0); } } while (0)
#define SDRAIN() asm volatile("s_waitcnt vmcnt(0)" ::: "memory")
  SDMA(TILE(0) * KVBLK, 0);
  unsigned selmask = 0u;
  if (MODE == 1) { if (tid < 256) *(f32x4*)(km_l + tid * 4) = *(const f32x4*)(kmean + tid * 4); }
  SDRAIN();
  __syncthreads();
  if (MODE == 1) {
    float g[8];
#pragma unroll
    for (int n = 0; n < 8; ++n) g[n] = 0.f;
#pragma unroll
    for (int d0 = 0; d0 < 8; ++d0) { float q[8];
#pragma unroll
      for (int j = 0; j < 8; ++j) q[j] = __uint_as_float(((unsigned)(unsigned short)qr[d0][j]) << 16);
#pragma unroll
      for (int n = 0; n < 7; ++n) { const f32x4 ka = *(const f32x4*)(km_l + n * 128 + d0 * 16 + hi * 8), kb2 = *(const f32x4*)(km_l + n * 128 + d0 * 16 + hi * 8 + 4);
        g[n] += (q[0] * ka[0] + q[1] * ka[1]) + (q[2] * ka[2] + q[3] * ka[3]) + (q[4] * kb2[0] + q[5] * kb2[1]) + (q[6] * kb2[2] + q[7] * kb2[3]); } }
#pragma unroll
    for (int n = 0; n < 7; ++n) { g[n] += xchg32(g[n], hi); if (n >= qb) g[n] = -INFINITY; }
    g[7] = -INFINITY;
#pragma unroll
    for (int n = 0; n < 7; ++n) { int cnt = 0;
#pragma unroll
      for (int mI = 0; mI < 7; ++mI) { if (mI != n) cnt += (g[mI] > g[n] || (g[mI] == g[n] && mI < n)) ? 1 : 0; }
      if (n < qb && cnt < 3) selmask |= (1u << n); }
  }
  for (int it = 0; it < NT; ++it) {
    const int j = TILE(it), buf = it & 1;
    if (it + 1 < NT) SDMA(TILE(it + 1) * KVBLK, buf ^ 1);
    const int jb = j - (NT - 4);
    bool skip = false;
    if (MODE == 1) skip = (jb >= 0) && (64 * jb > wid * 32 + 31);
    if (MODE == 2) skip = (jb >= 0) && (64 * jb >= wid * 32 + 31);
    if (!skip) {
      f32x16 p0, p1; bf16x8 pa0, pa1, pa2, pa3;
      qkt(p0, p1, K_lds + buf * SHM_K, qr, r32, hi);
      if (MODE == 2) {
        sb_tile(p0, p1, carry, jb >= 0, 64 * jb, qrel, hi);
      } else {
        if (MODE == 1) {
          if (jb < 0) { const bool s = (selmask >> (j >> 2)) & 1u;
#pragma unroll
            for (int r = 0; r < 16; ++r) { p0[r] = s ? p0[r] : -INFINITY; p1[r] = s ? p1[r] : -INFINITY; } }
          else {
#pragma unroll
            for (int r = 0; r < 16; ++r) { const int kr = 64 * jb + crow(r, hi); if (kr > qrel) p0[r] = -INFINITY; if (kr + 32 > qrel) p1[r] = -INFINITY; } }
        }
        float alpha; softmax_tile(p0, p1, m_reg, l_reg, alpha);
        if (__any(alpha < 1.f)) { if (hi == 0) al_l[r32] = alpha; asm volatile("s_waitcnt lgkmcnt(0)" ::: "memory");
#pragma unroll
          for (int d = 0; d < 4; ++d)
#pragma unroll
            for (int r = 0; r < 16; ++r) o[d][r] *= al_l[crow(r, hi)]; }
      }
      pack_p(p0, p1, pa0, pa1, pa2, pa3);
      pv_d0(o, vb0 + buf * SHM_V, pa0, pa1, pa2, pa3);
    }
    SDRAIN();
    __syncthreads();
  }
  float rli[16];
  if (MODE != 2) { if (hi == 0) li_l[r32] = l_reg; asm volatile("s_waitcnt lgkmcnt(0)" ::: "memory");
#pragma unroll
    for (int r = 0; r < 16; ++r) rli[r] = __builtin_amdgcn_rcpf(li_l[crow(r, hi)]); }
  else {
#pragma unroll
    for (int r = 0; r < 16; ++r) rli[r] = 1.f; }
  if (gain) {
    float gv[4];
#pragma unroll
    for (int d0 = 0; d0 < 4; ++d0) gv[d0] = gain[d0 * 32 + r32];
#pragma unroll
    for (int r = 0; r < 16; ++r) { float s = 0.f;
#pragma unroll
      for (int d0 = 0; d0 < 4; ++d0) { o[d0][r] *= rli[r]; s += o[d0][r] * o[d0][r]; }
      s += __shfl_xor(s, 1); s += __shfl_xor(s, 2); s += __shfl_xor(s, 4); s += __shfl_xor(s, 8); s += __shfl_xor(s, 16);
      rli[r] = __builtin_amdgcn_rsqf(s * (1.0f / 128.0f) + 1e-6f); }
#pragma unroll
    for (int r = 0; r < 16; ++r)
#pragma unroll
      for (int d0 = 0; d0 < 4; ++d0) o[d0][r] *= gv[d0];
  }
  { bf16* stg = (bf16*)lds + wid * 4096;
#pragma unroll
    for (int r = 0; r < 16; ++r) { const int orow = crow(r, hi);
#pragma unroll
      for (int d0 = 0; d0 < 4; ++d0) { const float v = o[d0][r] * rli[r]; unsigned u = __float_as_uint(v); u = (u + 0x7fffu + ((u >> 16) & 1u)) >> 16; stg[orow * 128 + d0 * 32 + r32] = (bf16)u; } }
    asm volatile("s_waitcnt lgkmcnt(0)" ::: "memory");
#pragma unroll
    for (int i = 0; i < 8; ++i) { const int row = i * 4 + (lane >> 4), ch = lane & 15; const u32x4 v = *(const u32x4*)(stg + row * 128 + ch * 8); *(u32x4*)(Ob + (long)(wid * 32 + row) * ldo + ch * 8) = v; } }
  __syncthreads();
#undef TILE
#undef SDMA
#undef SDRAIN
}
#undef KSWZ
#undef SBAR
}
#define GAS __attribute__((address_space(1)))
#define LAS __attribute__((address_space(3)))
typedef unsigned short bf16;
typedef unsigned v4u __attribute__((ext_vector_type(4)));
typedef float f32x4 __attribute__((ext_vector_type(4)));
#define LDS_WAIT() asm volatile("s_waitcnt lgkmcnt(0)" ::: "memory")
constexpr int NWAVES = 8;
constexpr int BATCH = 8, SEQ = 2048, DM = 2048, M = BATCH * SEQ, HD = 128, NH = 8;
constexpr int NQKV = 6144, FF = 5632, WX = 512, NMEM = 256, MMEM = BATCH * NMEM;
constexpr int QSB = 0, KSB = 1024, VSB = 2048, QMB = 3072, KMB = 4096, VMB = 5120;
constexpr float EPS = 1e-6f;
constexpr float QSCALE = 0.12751743082459868f;
constexpr size_t MiB = 1u << 20;
constexpr size_t WS_CTL = 0, CTL_ZERO_BYTES = 1 * MiB;
constexpr size_t WS_SSQ1 = 64 * 1024, WS_SSQ2 = 128 * 1024;
constexpr size_t WS_WIN = 1 * MiB, WS_WOUT = 25 * MiB, WS_WXQ = 33 * MiB, WS_WXKV = 35 * MiB, WS_WXO = 39 * MiB, WS_WGU = 41 * MiB, WS_WDN = 85 * MiB;
constexpr size_t WS_RA = 107 * MiB;
constexpr size_t WS_RB = 171 * MiB;
constexpr size_t WS_RC = 235 * MiB;
constexpr size_t WS_QX = 427 * MiB, WS_OX = 443 * MiB, WS_KVX = 459 * MiB, WS_MN = 463 * MiB, WS_KMEAN = 471 * MiB, WS_CS = 472 * MiB, WS_END = 474 * MiB;
constexpr int RING_BYTES = 131072, LDS_BYTES = 147456;

__device__ __forceinline__ float bf2f(unsigned short b) { return __uint_as_float((unsigned)b << 16); }
__device__ __forceinline__ unsigned f2bf(float f) { unsigned u = __builtin_bit_cast(unsigned, f); return (u + 0x7fffu + ((u >> 16) & 1u)) >> 16; }
__device__ __forceinline__ unsigned pk2(float lo, float hi) { return f2bf(lo) | (f2bf(hi) << 16); }
__device__ __forceinline__ float wave_sum(float v) {
#pragma unroll
    for (int o = 1; o < 64; o <<= 1) v += __shfl_xor(v, o);
    return v;
}
__device__ __forceinline__ float wave_max(float v) {
#pragma unroll
    for (int o = 1; o < 64; o <<= 1) v = fmaxf(v, __shfl_xor(v, o));
    return v;
}

struct Frame {
    LAS unsigned char* lds;
    int tid, lane, wave, vcu, G;
    const float *x, *mem; const int* pos;
    const float *g_mix, *w_in, *g_out_sb, *g_out_mb, *w_out, *g_xattn, *g_mem, *w_xq, *w_xkv, *w_xo, *g_ffn, *w_gu, *w_dn, *g_final;
    float* out; unsigned char* ws;
};

__device__ __forceinline__ void transpose_item(const float* W, int K, int N, bf16* WT, const float* gain, int inter, LAS float* scr, int item, int lane) {
    const int nblk = N / 32, kb = item / nblk, nb = item % nblk, k0 = 64 * kb, n0 = 32 * nb;
    int orow0 = n0;
    if (inter) orow0 = (n0 < FF) ? (n0 / 128) * 256 + (n0 % 128) : ((n0 - FF) / 128) * 256 + 128 + ((n0 - FF) % 128);
#pragma unroll 8
    for (int i = 0; i < 32; ++i) { const int kk = 2 * i + (lane >> 5); float v = W[(size_t)(k0 + kk) * N + n0 + (lane & 31)]; if (gain) v *= gain[k0 + kk]; scr[kk * 33 + (lane & 31)] = v; }
    LDS_WAIT(); asm volatile("" ::: "memory");
    const int c = lane & 7;
#pragma unroll
    for (int j = 0; j < 4; ++j) { const int n = (lane >> 3) + 8 * j; const LAS float* s = scr + (8 * c) * 33 + n;
        v4u o; o.x = pk2(s[0 * 33], s[1 * 33]); o.y = pk2(s[2 * 33], s[3 * 33]); o.z = pk2(s[4 * 33], s[5 * 33]); o.w = pk2(s[6 * 33], s[7 * 33]);
        *(GAS v4u*)(WT + (size_t)(orow0 + n) * K + k0 + 8 * c) = o; }
    LDS_WAIT(); asm volatile("" ::: "memory");
}
__device__ __forceinline__ void rms_row_to_bf16(const float* xrow, const float* g, bf16* orow, int lane) {
    const GAS f32x4* xr = (const GAS f32x4*)xrow + lane; const GAS f32x4* gr = (const GAS f32x4*)g + lane;
    f32x4 v[8]; float s = 0.f;
#pragma unroll
    for (int j = 0; j < 8; ++j) { v[j] = xr[64 * j]; s += (v[j].x * v[j].x + v[j].y * v[j].y) + (v[j].z * v[j].z + v[j].w * v[j].w); }
    const float rstd = 1.0f / sqrtf(wave_sum(s) * (1.f / DM) + EPS);
    GAS unsigned long long* o8 = (GAS unsigned long long*)orow + lane;
#pragma unroll
    for (int j = 0; j < 8; ++j) { const f32x4 gg = gr[64 * j];
        o8[64 * j] = (unsigned long long)pk2(v[j].x * rstd * gg.x, v[j].y * rstd * gg.y) | ((unsigned long long)pk2(v[j].z * rstd * gg.z, v[j].w * rstd * gg.w) << 32); }
}
__constant__ float INV_FREQ[16] = {1.000000000e+00f, 4.403665960e-01f, 1.939227432e-01f, 8.539710194e-02f, 3.760603070e-02f, 1.656043902e-02f, 7.292664610e-03f, 3.211445874e-03f,
                                   1.414213562e-03f, 6.227723788e-04f, 2.742481884e-04f, 1.207697351e-04f, 5.318296098e-05f, 2.341999971e-05f, 1.031338616e-05f, 4.541670478e-06f};

__device__ __forceinline__ void p0_prologue(Frame& F) {
    LAS float* scr = (LAS float*)(F.lds + F.wave * 16384);
    const int gw = F.vcu * NWAVES + F.wave, NGW = F.G * NWAVES;
    bf16* ws16 = (bf16*)F.ws;
    constexpr int I0 = (DM / 64) * (NQKV / 32), I1 = (DM / 64) * (DM / 32), I2 = (DM / 64) * (WX / 32), I3 = (DM / 64) * (2 * WX / 32), I4 = (WX / 64) * (DM / 32),
                  I5 = (DM / 64) * (2 * FF / 32), I6 = (FF / 64) * (DM / 32);
    constexpr int NITEMS = I0 + I1 + I2 + I3 + I4 + I5 + I6;
    for (int it = gw; it < NITEMS; it += NGW) {
        int r = it;
        if (r < I0) { transpose_item(F.w_in, DM, NQKV, (bf16*)(F.ws + WS_WIN), nullptr, 0, scr, r, F.lane); continue; } r -= I0;
        if (r < I1) { transpose_item(F.w_out, DM, DM, (bf16*)(F.ws + WS_WOUT), nullptr, 0, scr, r, F.lane); continue; } r -= I1;
        if (r < I2) { transpose_item(F.w_xq, DM, WX, (bf16*)(F.ws + WS_WXQ), F.g_xattn, 0, scr, r, F.lane); continue; } r -= I2;
        if (r < I3) { transpose_item(F.w_xkv, DM, 2 * WX, (bf16*)(F.ws + WS_WXKV), nullptr, 0, scr, r, F.lane); continue; } r -= I3;
        if (r < I4) { transpose_item(F.w_xo, WX, DM, (bf16*)(F.ws + WS_WXO), nullptr, 0, scr, r, F.lane); continue; } r -= I4;
        if (r < I5) { transpose_item(F.w_gu, DM, 2 * FF, (bf16*)(F.ws + WS_WGU), F.g_ffn, 1, scr, r, F.lane); continue; } r -= I5;
        transpose_item(F.w_dn, FF, DM, (bf16*)(F.ws + WS_WDN), nullptr, 0, scr, r, F.lane);
    }
    (void)ws16;
    for (int m = gw; m < M; m += NGW) rms_row_to_bf16(F.x + (size_t)m * DM, F.g_mix, (bf16*)(F.ws + WS_RA) + (size_t)m * DM, F.lane);
    for (int m = gw; m < MMEM; m += NGW) rms_row_to_bf16(F.mem + (size_t)m * DM, F.g_mem, (bf16*)(F.ws + WS_MN) + (size_t)m * DM, F.lane);
    float* cs = (float*)(F.ws + WS_CS);
    for (int e = (F.vcu * NWAVES + F.wave) * 64 + F.lane; e < M * 16; e += NGW * 64) {
        const int m = e >> 4, i = e & 15; const float ang = (float)F.pos[m] * INV_FREQ[i];
        double rev = (double)ang * 0.15915494309189535; rev -= floor(rev);
        const float a = (float)(rev * 6.283185307179586);
        cs[(size_t)m * 32 + i] = cosf(a); cs[(size_t)m * 32 + 16 + i] = sinf(a);
    }
}

__device__ __forceinline__ float dot128(const LAS float* qs, const bf16* krow) {
    float s = 0.f;
#pragma unroll
    for (int c = 0; c < 16; ++c) { const v4u kv = *(const v4u*)(krow + 8 * c); const LAS f32x4* q4 = (const LAS f32x4*)(qs + 8 * c); const f32x4 qa = q4[0], qb = q4[1];
        s += qa.x * __uint_as_float(kv.x << 16) + qa.y * __uint_as_float(kv.x & 0xffff0000u) + qa.z * __uint_as_float(kv.y << 16) + qa.w * __uint_as_float(kv.y & 0xffff0000u)
           + qb.x * __uint_as_float(kv.z << 16) + qb.y * __uint_as_float(kv.z & 0xffff0000u) + qb.z * __uint_as_float(kv.w << 16) + qb.w * __uint_as_float(kv.w & 0xffff0000u); }
    return s;
}
__device__ __forceinline__ void load_q_lds(LAS float* qs, const bf16* qp, int lane) { qs[lane] = bf2f(qp[lane]); qs[64 + lane] = bf2f(qp[64 + lane]); LDS_WAIT(); asm volatile("" ::: "memory"); }
__device__ __forceinline__ void pv64(float w, const bf16* vbase, size_t ld, int cnt, int lane, float& o0, float& o1) {
    for (int i = 0; i < cnt; ++i) { const float wi = __shfl(w, i); const unsigned vv = *(const unsigned*)(vbase + (size_t)i * ld + 2 * lane); o0 += wi * __uint_as_float(vv << 16); o1 += wi * __uint_as_float(vv & 0xffff0000u); }
}
__device__ __forceinline__ float softplus2(float y) { return fmaxf(y, 0.f) + __builtin_amdgcn_logf(1.0f + __builtin_amdgcn_exp2f(-fabsf(y))); }
__device__ __forceinline__ void store_head_norm(float o0, float o1, const float* g, bf16* op, int lane) {
    const float ssq = wave_sum(o0 * o0 + o1 * o1); const float r = 1.0f / sqrtf(ssq * (1.f / HD) + EPS);
    *(unsigned*)(op + 2 * lane) = pk2(o0 * r * g[2 * lane], o1 * r * g[2 * lane + 1]);
}
__device__ __forceinline__ void naive_sb_row(Frame& F, LAS float* qs, int bh, int t) {
    const int b = bh >> 3, h = bh & 7, lane = F.lane; const bf16* qkv = (const bf16*)(F.ws + WS_RC); const size_t rb = (size_t)b * SEQ;
    load_q_lds(qs, qkv + (rb + t) * NQKV + QSB + h * HD, lane);
    const bf16* kp = qkv + rb * NQKV + KSB + h * HD; const bf16* vp = qkv + rb * NQKV + VSB + h * HD;
    float o0 = 0.f, o1 = 0.f, carry = 0.f;
    for (int c = (t - 1) >> 6; c >= 0; --c) {
        const int key = c * 64 + lane; const bool valid = key < t;
        float y = 0.f; if (valid) y = dot128(qs, kp + (size_t)key * NQKV);
        const float sp = valid ? softplus2(y) : 0.f;
        float suf = sp;
#pragma unroll
        for (int off = 1; off < 64; off <<= 1) { const float tt = __shfl_down(suf, off); if (lane + off < 64) suf += tt; }
        const float w = valid ? __builtin_amdgcn_exp2f(y - (suf + carry)) : 0.f;
        carry += __shfl(suf, 0);
        const int cnt = (t - c * 64) < 64 ? (t - c * 64) : 64;
        pv64(w, vp + (size_t)(c * 64) * NQKV, NQKV, cnt, lane, o0, o1);
    }
    store_head_norm(o0, o1, F.g_out_sb + h * HD, (bf16*)(F.ws + WS_RA) + (rb + t) * DM + h * HD, lane);
    LDS_WAIT();
}
__device__ __forceinline__ void softmax_chunk(float s, bool valid, const bf16* vbase, size_t ld, int cnt, int lane, float& m, float& l, float& o0, float& o1) {
    const float cm = wave_max(valid ? s : -1e30f); const float mn = fmaxf(m, cm); const float alpha = __builtin_amdgcn_exp2f(m - mn);
    const float p = valid ? __builtin_amdgcn_exp2f(s - mn) : 0.f;
    l = l * alpha + wave_sum(p); o0 *= alpha; o1 *= alpha; m = mn;
    pv64(p, vbase, ld, cnt, lane, o0, o1);
}
__device__ __forceinline__ void naive_moba_row(Frame& F, LAS float* qs, int bh, int t) {
    const int b = bh >> 3, h = bh & 7, lane = F.lane; const bf16* qkv = (const bf16*)(F.ws + WS_RC); const size_t rb = (size_t)b * SEQ;
    load_q_lds(qs, qkv + (rb + t) * NQKV + QMB + h * HD, lane);
    const bf16* kp = qkv + rb * NQKV + KMB + h * HD; const bf16* vp = qkv + rb * NQKV + VMB + h * HD;
    const int blk = t >> 8;
    const float* km = (const float*)(F.ws + WS_KMEAN) + (size_t)bh * 8 * HD;
    float g = -INFINITY;
    { const int n = lane & 7; if (n < blk) { float a = 0.f; for (int d = 0; d < HD; ++d) a += qs[d] * km[n * HD + d]; g = a; } }
    int cnt = 0;
#pragma unroll
    for (int mI = 0; mI < 8; ++mI) { const float gm = __shfl(g, mI); cnt += (gm > g || (gm == g && mI < (lane & 7))) ? 1 : 0; }
    const bool sel = (lane < 8) && (lane < blk) && (cnt < 3);
    const unsigned selmask = (unsigned)(__ballot(sel) & 0xffull);
    float m = -1e30f, l = 0.f, o0 = 0.f, o1 = 0.f;
    for (int n = 0; n <= blk; ++n) {
        if (n < blk && !((selmask >> n) & 1u)) continue;
        for (int c = 0; c < 4; ++c) {
            const int key0 = n * 256 + c * 64; if (key0 > t) break;
            const int key = key0 + lane; const bool valid = key <= t;
            float s = 0.f; if (valid) s = dot128(qs, kp + (size_t)key * NQKV);
            const int cn = (t - key0 + 1) < 64 ? (t - key0 + 1) : 64;
            softmax_chunk(s, valid, vp + (size_t)key0 * NQKV, NQKV, cn, lane, m, l, o0, o1);
        }
    }
    const float il = 1.0f / l;
    store_head_norm(o0 * il, o1 * il, F.g_out_mb + h * HD, (bf16*)(F.ws + WS_RA) + (rb + t) * DM + NH * HD + h * HD, lane);
    LDS_WAIT();
}
__device__ __forceinline__ void naive_xattn_row(Frame& F, LAS float* qs, int b, int h, int t) {
    const int lane = F.lane; const bf16* qx = (const bf16*)(F.ws + WS_QX); const bf16* kv = (const bf16*)(F.ws + WS_KVX);
    load_q_lds(qs, qx + ((size_t)b * SEQ + t) * WX + h * HD, lane);
    const bf16* kp = kv + (size_t)b * NMEM * (2 * WX) + h * HD; const bf16* vp = kp + WX;
    float m = -1e30f, l = 0.f, o0 = 0.f, o1 = 0.f;
    for (int c = 0; c < 4; ++c) { const int key = c * 64 + lane; const float s = dot128(qs, kp + (size_t)key * (2 * WX));
        softmax_chunk(s, true, vp + (size_t)(c * 64) * (2 * WX), 2 * WX, 64, lane, m, l, o0, o1); }
    const float il = 1.0f / l;
    *(unsigned*)((bf16*)(F.ws + WS_OX) + ((size_t)b * SEQ + t) * WX + h * HD + 2 * lane) = pk2(o0 * il, o1 * il);
    LDS_WAIT();
}
__device__ __forceinline__ void kmean_phase(Frame& F) {
    LAS float* red = (LAS float*)F.lds;
    const bf16* qkv = (const bf16*)(F.ws + WS_RC); float* km = (float*)(F.ws + WS_KMEAN);
    const int cc = F.tid & 15, rg = F.tid >> 4;
    for (int item = F.vcu; item < 64 * 8; item += F.G) {
        const int bh = item >> 3, n = item & 7, b = bh >> 3, h = bh & 7;
        const bf16* kp = qkv + ((size_t)b * SEQ + n * 256 + rg * 8) * NQKV + KMB + h * HD + cc * 8;
        float a[8] = {0, 0, 0, 0, 0, 0, 0, 0};
#pragma unroll
        for (int r = 0; r < 8; ++r) { const v4u kv = *(const v4u*)(kp + (size_t)r * NQKV);
            a[0] += __uint_as_float(kv.x << 16); a[1] += __uint_as_float(kv.x & 0xffff0000u); a[2] += __uint_as_float(kv.y << 16); a[3] += __uint_as_float(kv.y & 0xffff0000u);
            a[4] += __uint_as_float(kv.z << 16); a[5] += __uint_as_float(kv.z & 0xffff0000u); a[6] += __uint_as_float(kv.w << 16); a[7] += __uint_as_float(kv.w & 0xffff0000u); }
#pragma unroll
        for (int j = 0; j < 8; ++j) red[rg * 128 + cc * 8 + j] = a[j];
        __syncthreads();
        if (F.tid < 128) { float s = 0.f; for (int r = 0; r < 32; ++r) s += red[r * 128 + F.tid]; km[(size_t)item * HD + F.tid] = s * (1.0f / 256.0f); }
        __syncthreads();
    }
}
__device__ __forceinline__ void final_norm_phase(Frame& F) {
    const int gw = F.vcu * NWAVES + F.wave, NGW = F.G * NWAVES;
    for (int m = gw; m < M; m += NGW) {
        GAS f32x4* xr = (GAS f32x4*)(F.out + (size_t)m * DM) + F.lane; const GAS f32x4* gr = (const GAS f32x4*)F.g_final + F.lane;
        f32x4 v[8]; float s = 0.f;
#pragma unroll
        for (int j = 0; j < 8; ++j) { v[j] = xr[64 * j]; s += (v[j].x * v[j].x + v[j].y * v[j].y) + (v[j].z * v[j].z + v[j].w * v[j].w); }
        const float rstd = 1.0f / sqrtf(wave_sum(s) * (1.f / DM) + EPS);
#pragma unroll
        for (int j = 0; j < 8; ++j) xr[64 * j] = v[j] * rstd * gr[64 * j];
    }
}

constexpr int NPH = 11;
#ifndef USE_MFMA_SB
#define USE_MFMA_SB 1
#endif
#ifndef USE_MFMA_MOBA
#define USE_MFMA_MOBA 1
#endif
#ifndef USE_MFMA_X
#define USE_MFMA_X 1
#endif
#ifndef MK_ONE_LAUNCH
#define MK_ONE_LAUNCH 1
#endif
struct Args { const void* in[17]; float* out; unsigned char* ws; int ph_lo, ph_hi; };
__global__ void __launch_bounds__(NWAVES * 64, 2) mk_fwd(Args args) {
    extern __shared__ __attribute__((aligned(16))) unsigned char lds[];
    Frame F;
    F.lds = (LAS unsigned char*)lds;
    F.tid = threadIdx.x; F.lane = F.tid & 63; F.wave = __builtin_amdgcn_readfirstlane(F.tid >> 6);
    F.G = gridDim.x; { const int bx = blockIdx.x; F.vcu = (F.G % 8 == 0) ? (bx % 8) * (F.G / 8) + bx / 8 : bx; }
    F.x = (const float*)args.in[0]; F.mem = (const float*)args.in[1]; F.pos = (const int*)args.in[2];
    F.g_mix = (const float*)args.in[3]; F.w_in = (const float*)args.in[4]; F.g_out_sb = (const float*)args.in[5]; F.g_out_mb = (const float*)args.in[6]; F.w_out = (const float*)args.in[7];
    F.g_xattn = (const float*)args.in[8]; F.g_mem = (const float*)args.in[9]; F.w_xq = (const float*)args.in[10]; F.w_xkv = (const float*)args.in[11]; F.w_xo = (const float*)args.in[12];
    F.g_ffn = (const float*)args.in[13]; F.w_gu = (const float*)args.in[14]; F.w_dn = (const float*)args.in[15]; F.g_final = (const float*)args.in[16];
    F.out = args.out; F.ws = args.ws;
    unsigned char* ws = args.ws;
    const int lo = args.ph_lo, hi = args.ph_hi;
#define IN(k) (lo <= (k) && (k) < hi)
#define BOTH(k) (IN(k) && IN((k) + 1))
#define GRID_BAR() do { __threadfence(); cg::this_grid().sync(); } while (0)
    float* ssq1 = (float*)(ws + WS_SSQ1); float* ssq2 = (float*)(ws + WS_SSQ2);
    pg8::bf16_t* RA = (pg8::bf16_t*)(ws + WS_RA); pg8::bf16_t* RB = (pg8::bf16_t*)(ws + WS_RB); pg8::bf16_t* RC = (pg8::bf16_t*)(ws + WS_RC);

    if (IN(0)) { p0_prologue(F); if (BOTH(0)) GRID_BAR(); }
    if (IN(1)) {
        pg8::Gemm g{RA, (const pg8::bf16_t*)(ws + WS_WIN), M, NQKV, DM}; pg8::StaticOrder S; S.init(M, NQKV, F.G, (int)blockIdx.x);
        pg8::EpiQKV E{RC, (const float*)(ws + WS_CS), QSCALE};
        pg8::gemm_phase<pg8::EpiQKV, pg8::StaticOrder, true, true>(F.lds, g, S, E);
        if (BOTH(1)) GRID_BAR();
    }
    if (IN(2)) { kmean_phase(F); if (BOTH(2)) GRID_BAR(); }
    if (IN(3)) {
        const att::bf16* qkv = (const att::bf16*)RC; att::bf16* ob = (att::bf16*)RA; const float* kmean = (const float*)(ws + WS_KMEAN);
#if !(USE_MFMA_SB && USE_MFMA_MOBA)
        LAS float* qs = (LAS float*)(F.lds + F.wave * 1024);
        const int gw = F.vcu * NWAVES + F.wave, NGW = F.G * NWAVES;
#endif
#if !USE_MFMA_SB
        for (int i = gw; i < 64 * SEQ; i += NGW) { const int bh = i >> 11, t = (int)(((unsigned)i + (unsigned)(i >> 11) * 997u) & 2047u); naive_sb_row(F, qs, bh, t); }
#endif
#if !USE_MFMA_MOBA
        for (int i = gw; i < 64 * SEQ; i += NGW) { const int bh = i >> 11, t = (int)(((unsigned)i + (unsigned)(i >> 11) * 997u) & 2047u); naive_moba_row(F, qs, bh, t); }
        __syncthreads();
#endif
#if USE_MFMA_SB
        for (int vv = F.vcu; vv < 256; vv += F.G) { const int bh = vv >> 2, s = vv & 3, b = bh >> 3, h = bh & 7; const size_t rb = (size_t)b * SEQ;
            for (int i = 0; i < 2; ++i) { const int qb = i ? s : 7 - s; const size_t r0 = rb + (size_t)qb * 256;
                att::attn_unit<2>(qkv + r0 * NQKV + QSB + h * HD, NQKV, qkv + rb * NQKV + KSB + h * HD, qkv + rb * NQKV + VSB + h * HD, NQKV, ob + r0 * DM + h * HD, DM, F.g_out_sb + h * HD, nullptr, qb, 0, (char*)lds); } }
#endif
#if USE_MFMA_MOBA
        for (int vv = F.vcu; vv < 256; vv += F.G) { const int bh = vv >> 2, s = vv & 3, b = bh >> 3, h = bh & 7; const size_t rb = (size_t)b * SEQ;
            for (int i = 0; i < 2; ++i) { const int qb = i ? s : 7 - s; const size_t r0 = rb + (size_t)qb * 256;
                att::attn_unit<1>(qkv + r0 * NQKV + QMB + h * HD, NQKV, qkv + rb * NQKV + KMB + h * HD, qkv + rb * NQKV + VMB + h * HD, NQKV, ob + r0 * DM + NH * HD + h * HD, DM, F.g_out_mb + h * HD, kmean + (size_t)bh * 1024, qb, 0, (char*)lds); } }
#endif
        if (BOTH(3)) GRID_BAR();
    }
    if (IN(4)) {
        pg8::Gemm g{RA, (const pg8::bf16_t*)(ws + WS_WOUT), M, DM, DM}; pg8::StaticOrder S; S.init(M, DM, F.G, (int)blockIdx.x);
        pg8::EpiRes E{F.x, F.out, RB, ssq1};
        pg8::gemm_phase<pg8::EpiRes, pg8::StaticOrder, true, true>(F.lds, g, S, E);
        if (BOTH(4)) GRID_BAR();
    }
    if (IN(5)) {
        { pg8::Gemm g{RB, (const pg8::bf16_t*)(ws + WS_WXQ), M, WX, DM}; pg8::StaticOrder S; S.init(M, WX, F.G, (int)blockIdx.x);
          pg8::EpiScale E{(pg8::bf16_t*)(ws + WS_QX), WX, ssq1, QSCALE};
          pg8::gemm_phase<pg8::EpiScale, pg8::StaticOrder, true, true>(F.lds, g, S, E); }
        { pg8::Gemm g{(const pg8::bf16_t*)(ws + WS_MN), (const pg8::bf16_t*)(ws + WS_WXKV), MMEM, 2 * WX, DM}; pg8::StaticOrder S; S.init(MMEM, 2 * WX, F.G, (int)((blockIdx.x + F.G - 128) % F.G));
          pg8::EpiScale E{(pg8::bf16_t*)(ws + WS_KVX), 2 * WX, nullptr, 1.0f};
          pg8::gemm_phase<pg8::EpiScale, pg8::StaticOrder, true, true>(F.lds, g, S, E); }
        if (BOTH(5)) GRID_BAR();
    }
    if (IN(6)) {
#if USE_MFMA_X
        const att::bf16* qx = (const att::bf16*)(ws + WS_QX); const att::bf16* kvx = (const att::bf16*)(ws + WS_KVX); att::bf16* ox = (att::bf16*)(ws + WS_OX);
        for (int vv = F.vcu; vv < 256; vv += F.G) { const int b = vv >> 5, h = (vv >> 3) & 3, qb = vv & 7; const size_t r0 = (size_t)b * SEQ + (size_t)qb * 256;
            att::attn_unit<0>(qx + r0 * WX + h * HD, WX, kvx + (size_t)b * NMEM * (2 * WX) + h * HD, kvx + (size_t)b * NMEM * (2 * WX) + WX + h * HD, 2 * WX, ox + r0 * WX + h * HD, WX, nullptr, nullptr, qb, NMEM, (char*)lds); }
#else
        LAS float* qs = (LAS float*)(F.lds + F.wave * 1024);
        const int gw = F.vcu * NWAVES + F.wave, NGW = F.G * NWAVES;
        for (int i = gw; i < BATCH * 4 * SEQ; i += NGW) { const int t = i & 2047, h = (i >> 11) & 3, b = i >> 13; naive_xattn_row(F, qs, b, h, t); }
#endif
        if (BOTH(6)) GRID_BAR();
    }
    if (IN(7)) {
        pg8::Gemm g{(const pg8::bf16_t*)(ws + WS_OX), (const pg8::bf16_t*)(ws + WS_WXO), M, DM, WX}; pg8::StaticOrder S; S.init(M, DM, F.G, (int)blockIdx.x);
        pg8::EpiRes E{F.out, F.out, RA, ssq2};
        pg8::gemm_phase<pg8::EpiRes, pg8::StaticOrder, true, true>(F.lds, g, S, E);
        if (BOTH(7)) GRID_BAR();
    }
    if (IN(8)) {
        pg8::Gemm g{RA, (const pg8::bf16_t*)(ws + WS_WGU), M, 2 * FF, DM}; pg8::StaticOrder S; S.init(M, 2 * FF, F.G, (int)blockIdx.x);
        pg8::EpiSwiGLU E{RC, ssq2};
        pg8::gemm_phase<pg8::EpiSwiGLU, pg8::StaticOrder, true, true>(F.lds, g, S, E);
        if (BOTH(8)) GRID_BAR();
    }
    if (IN(9)) {
        pg8::Gemm g{RC, (const pg8::bf16_t*)(ws + WS_WDN), M, DM, FF}; pg8::StaticOrder S; S.init(M, DM, F.G, (int)blockIdx.x);
        pg8::EpiRes E{F.out, F.out, nullptr, nullptr};
        pg8::gemm_phase<pg8::EpiRes, pg8::StaticOrder, true, true>(F.lds, g, S, E);
        if (BOTH(9)) GRID_BAR();
    }
    if (IN(10)) final_norm_phase(F);
#undef IN
#undef BOTH
}

extern "C" void kernel_launch(void* const* d_in, const int* in_sizes, int n_in, void* d_out, int out_size, void* d_ws, size_t ws_size, hipStream_t stream) {
    static int grid = 0;
    if (grid == 0) {
        if (n_in != 17 || in_sizes[0] != M * DM || out_size != M * DM || ws_size < WS_END) { fprintf(stderr, "kernel_launch: unexpected shapes (n_in %d in0 %d out %d ws %zu)\n", n_in, n_in > 0 ? in_sizes[0] : -1, out_size, ws_size); grid = -1; return; }
        int dev = 0, cus = 0, per_cu = 0;
        if (hipGetDevice(&dev) != hipSuccess || hipDeviceGetAttribute(&cus, hipDeviceAttributeMultiprocessorCount, dev) != hipSuccess) { grid = -1; return; }
        if (hipFuncSetAttribute((const void*)mk_fwd, hipFuncAttributeMaxDynamicSharedMemorySize, LDS_BYTES) != hipSuccess) { fprintf(stderr, "kernel_launch: hipFuncSetAttribute failed\n"); grid = -1; return; }
        if (hipOccupancyMaxActiveBlocksPerMultiprocessor(&per_cu, (const void*)mk_fwd, NWAVES * 64, LDS_BYTES) != hipSuccess || per_cu < 1) { fprintf(stderr, "kernel_launch: occupancy query failed (%d)\n", per_cu); per_cu = 1; }
        (void)hipGetLastError();
        grid = cus * (per_cu < 1 ? 1 : 1);
    }
    if (grid < 0) return;
    (void)hipMemsetAsync((char*)d_ws + WS_CTL, 0, CTL_ZERO_BYTES, stream);
    Args a{};
    for (int i = 0; i < 17; ++i) a.in[i] = d_in[i];
    a.out = (float*)d_out; a.ws = (unsigned char*)d_ws;
#if MK_ONE_LAUNCH
    a.ph_lo = 0; a.ph_hi = NPH;
    void* kargs[] = {&a};
    hipError_t e = hipLaunchCooperativeKernel((const void*)mk_fwd, dim3(grid), dim3(NWAVES * 64), kargs, LDS_BYTES, stream);
    if (e != hipSuccess) fprintf(stderr, "kernel_launch: cooperative launch failed: %s (grid %d)\n", hipGetErrorString(e), grid);
#else
    for (int p = 0; p < NPH; ++p) { a.ph_lo = p; a.ph_hi = p + 1; hipLaunchKernelGGL(mk_fwd, dim3(grid), dim3(NWAVES * 64), LDS_BYTES, stream, a); }
    const hipError_t le = hipPeekAtLastError();
    if (le != hipSuccess) fprintf(stderr, "kernel_launch: launch failed: %s\n", hipGetErrorName(le));
#endif
}
```

```cpp
#include <hip/hip_runtime.h>
#include <hip/hip_cooperative_groups.h>
#include <cstdio>
#include <cstdint>
namespace cg = cooperative_groups;
namespace pg8 {
#define PG8_LAS __attribute__((address_space(3)))
typedef unsigned short bf16_t;
typedef short bf16x8 __attribute__((ext_vector_type(8)));
typedef float f32x4 __attribute__((ext_vector_type(4)));
typedef unsigned u32x4 __attribute__((ext_vector_type(4)));
constexpr int BM = 256, BK = 64, HALF = 128, HTB = HALF * BK * 2  , STAGE_BYTES = 8 * HTB, NXCD = 8, WGM = 8;

__host__ __device__ __forceinline__ int lds_byte(int r, int c) { const int st = (r >> 4) * 2 + (c >> 5), rr = r & 15, cc = c & 31, ob = rr * 64 + cc * 2; return st * 1024 + (ob ^ (((ob >> 9) & 1) << 5)); }
__host__ __device__ __forceinline__ void stage_rc(int b, int& R, int& C) { const int st = b / 1024, sb = b % 1024, swz = sb ^ (((sb >> 9) & 1) << 5); R = (st >> 1) * 16 + swz / 64; C = (st & 1) * 32 + (swz % 64) / 2; }
__host__ __device__ __forceinline__ int perm32(int rho) { const int n = rho >> 4, i = rho & 15; return 8 * (i >> 2) + 4 * n + (i & 3); }

struct Unit { int pm, pn; };
struct Gemm { const bf16_t* A; const bf16_t* Bt; int M, N, K; };

struct StaticOrder {
    int nM, nN, nwg, G, c;
    __host__ __device__ void init(int M, int N, int G_, int c_) { nM = M / BM; nN = N / BM; nwg = nM * nN; G = G_; c = c_; }
    __host__ __device__ bool next(int i, Unit& u) const {
        const long L = (long)i * G + c; if (L >= nwg) return false;
        int wgid = (int)L; { const int q = nwg / NXCD, r = nwg % NXCD, xcd = wgid % NXCD, off = wgid / NXCD; wgid = (xcd < r ? xcd * (q + 1) : r * (q + 1) + (xcd - r) * q) + off; }
        const int nig = WGM * nN, gid = wgid / nig, fm = gid * WGM, gsz = (nM - fm) < WGM ? (nM - fm) : WGM;
        u.pm = fm + ((wgid % nig) % gsz); u.pn = (wgid % nig) / gsz; return true;
    }
    __device__ __forceinline__ void a_ready(const Unit&) const {}
    __device__ __forceinline__ void done(const Unit&) const {}
};

__device__ __forceinline__ unsigned cvt_pk_bf16(float lo, float hi) { unsigned r; asm volatile("v_cvt_pk_bf16_f32 %0, %1, %2" : "=v"(r) : "v"(lo), "v"(hi)); return r; }
typedef float f32x2 __attribute__((ext_vector_type(2)));
template <class Epi, class Sched, bool ALIGN_EPI = false, bool SP2 = false>
__device__ __forceinline__ void gemm_phase(PG8_LAS unsigned char* lds, const Gemm g, const Sched& S, const Epi& E) {
    int tid_ = threadIdx.x; asm volatile("" : "+v"(tid_));
    const int tid = tid_, wid = __builtin_amdgcn_readfirstlane(tid >> 6), lane = tid & 63, wr = wid >> 2, wc = wid & 3, fr = lane & 15, fq = lane >> 4;
    const int K = g.K, nt = K / BK;
    unsigned voffA[2], voffB[2];
#pragma unroll
    for (int i = 0; i < 2; ++i) { int R, C; stage_rc(tid * 16 + i * 8192, R, C); const int Rb = Epi::PERM ? ((R & ~31) + perm32(R & 31)) : R;
        voffA[i] = (unsigned)(R * K + C) * 2u; voffB[i] = (unsigned)(Rb * K + C) * 2u; }
    const size_t kstep = (size_t)(BK * 2);
    const size_t hstep = (size_t)HALF * K * 2;
    const size_t tstep = 2 * hstep;
    const unsigned ldsw = (unsigned)wid * 1024u;
    const int aoff = lds_byte(wr * 64 + fr, fq * 8), boff = lds_byte(wc * 32 + fr, fq * 8);
#define PG8_SA(b, h) (((b) * 2 + (h)) * HTB)
#define PG8_SB(b, h) ((4 + (b) * 2 + (h)) * HTB)
#define PG8_STAGE(bufoff, gbase, voff) do { _Pragma("unroll") for (int _i = 0; _i < 2; ++_i) \
        __builtin_amdgcn_global_load_lds((const unsigned*)((const char*)(gbase) + (voff)[_i]), (PG8_LAS unsigned*)(lds + (bufoff) + ldsw + _i * 8192), 16, 0, 0); } while (0)
#define PG8_LDA(dst, b, h) do { _Pragma("unroll") for (int m = 0; m < 4; ++m) _Pragma("unroll") for (int k = 0; k < 2; ++k) dst[m][k] = *(const PG8_LAS bf16x8*)(lds + PG8_SA(b, h) + aoff + m * 2048 + k * 1024); } while (0)
#define PG8_LDB(dst, b, h) do { _Pragma("unroll") for (int n = 0; n < 2; ++n) _Pragma("unroll") for (int k = 0; k < 2; ++k) dst[n][k] = *(const PG8_LAS bf16x8*)(lds + PG8_SB(b, h) + boff + n * 2048 + k * 1024); } while (0)
#define PG8_MMA(ai, bj, At, Bt) do { __builtin_amdgcn_s_setprio(1); _Pragma("unroll") for (int m = 0; m < 4; ++m) _Pragma("unroll") for (int n = 0; n < 2; ++n) _Pragma("unroll") for (int k = 0; k < 2; ++k) \
        acc[ai][bj][m][n] = __builtin_amdgcn_mfma_f32_16x16x32_bf16(Bt[n][k], At[m][k], acc[ai][bj][m][n], 0, 0, 0); __builtin_amdgcn_s_setprio(0); } while (0)
#define PG8_WAIT_V(n) asm volatile("s_waitcnt vmcnt(" #n ")" ::: "memory")
#define PG8_WAIT_L(n) asm volatile("s_waitcnt lgkmcnt(" #n ")" ::: "memory")
#define PG8_BAR __builtin_amdgcn_s_barrier()
#define PG8_SCHED __builtin_amdgcn_sched_barrier(0)
    Unit cur, nxt; int ui = 0;
    if (!S.next(0, cur)) return;
    f32x4 acc[2][2][4][2];
#pragma unroll
    for (int a = 0; a < 2; ++a)
#pragma unroll
        for (int b = 0; b < 2; ++b)
#pragma unroll
            for (int m = 0; m < 4; ++m)
#pragma unroll
                for (int n = 0; n < 2; ++n) acc[a][b][m][n] = (f32x4){0.f, 0.f, 0.f, 0.f};
    bf16x8 At[4][2], B0[2][2], B1[2][2];
    const char* cA = (const char*)g.A + (size_t)cur.pm * tstep; const char* cB = (const char*)g.Bt + (size_t)cur.pn * tstep;
    S.a_ready(cur);
    if constexpr (SP2) {
        PG8_STAGE(PG8_SB(0, 0), cB, voffB); PG8_STAGE(PG8_SB(0, 1), cB + hstep, voffB); PG8_STAGE(PG8_SA(0, 0), cA, voffA); PG8_STAGE(PG8_SA(0, 1), cA + hstep, voffA);
        if (wr == 1) PG8_BAR;
        PG8_WAIT_V(2); PG8_BAR;
        PG8_STAGE(PG8_SB(1, 0), cB + kstep, voffB); PG8_STAGE(PG8_SA(1, 0), cA + kstep, voffA); PG8_STAGE(PG8_SB(1, 1), cB + hstep + kstep, voffB);
        PG8_WAIT_V(6); PG8_BAR;
    } else {
        PG8_STAGE(PG8_SB(0, 0), cB, voffB); PG8_STAGE(PG8_SA(0, 0), cA, voffA); PG8_STAGE(PG8_SB(0, 1), cB + hstep, voffB); PG8_STAGE(PG8_SA(0, 1), cA + hstep, voffA);
        if (wr == 1) PG8_BAR;
        PG8_WAIT_V(4); PG8_BAR;
        PG8_STAGE(PG8_SB(1, 0), cB + kstep, voffB); PG8_STAGE(PG8_SA(1, 0), cA + kstep, voffA); PG8_STAGE(PG8_SB(1, 1), cB + hstep + kstep, voffB);
        PG8_WAIT_V(6); PG8_BAR;
    }
    for (;;) {
        const bool has_next = S.next(ui + 1, nxt);
        const char* nA = has_next ? (const char*)g.A + (size_t)nxt.pm * tstep : cA; const char* nB = has_next ? (const char*)g.Bt + (size_t)nxt.pn * tstep : cB;
        for (int t = 0; t < nt; t += 2) {
            const bool last = (t == nt - 2);
            const char* a1 = cA + (size_t)(t + 1) * kstep;
            const char* a2 = last ? nA : cA + (size_t)(t + 2) * kstep; const char* b2 = last ? nB : cB + (size_t)(t + 2) * kstep;
            const char* a3 = a2 + kstep; const char* b3 = b2 + kstep;
            if (last && has_next) S.a_ready(nxt);
            if constexpr (SP2) {
            PG8_LDB(B0, 0, 0); PG8_LDB(B1, 0, 1); PG8_SCHED; PG8_LDA(At, 0, 0); PG8_STAGE(PG8_SA(1, 1), a1 + hstep, voffA);
            PG8_WAIT_V(8); PG8_WAIT_L(0); PG8_BAR; PG8_MMA(0, 0, At, B0); PG8_MMA(0, 1, At, B1); PG8_BAR; PG8_SCHED;
            PG8_LDA(At, 0, 1); PG8_STAGE(PG8_SB(0, 0), b2, voffB); PG8_STAGE(PG8_SB(0, 1), b2 + hstep, voffB); PG8_STAGE(PG8_SA(0, 0), a2, voffA);
            PG8_WAIT_V(8); PG8_WAIT_L(0); PG8_BAR; PG8_MMA(1, 0, At, B0); PG8_MMA(1, 1, At, B1); PG8_BAR; PG8_SCHED;
            PG8_LDB(B0, 1, 0); PG8_LDB(B1, 1, 1); PG8_SCHED; PG8_LDA(At, 1, 0); PG8_STAGE(PG8_SA(0, 1), a2 + hstep, voffA);
            PG8_WAIT_V(8); PG8_WAIT_L(0); PG8_BAR; PG8_MMA(0, 0, At, B0); PG8_MMA(0, 1, At, B1); PG8_BAR; PG8_SCHED;
            PG8_LDA(At, 1, 1); PG8_STAGE(PG8_SB(1, 0), b3, voffB); PG8_STAGE(PG8_SB(1, 1), b3 + hstep, voffB); PG8_STAGE(PG8_SA(1, 0), a3, voffA);
            PG8_WAIT_V(8); PG8_WAIT_L(0); PG8_BAR; PG8_MMA(1, 0, At, B0); PG8_MMA(1, 1, At, B1); PG8_BAR; PG8_SCHED;
            } else {
            PG8_LDB(B0, 0, 0); PG8_SCHED; PG8_LDA(At, 0, 0); PG8_STAGE(PG8_SA(1, 1), a1 + hstep, voffA);
            PG8_WAIT_L(8); PG8_BAR; PG8_WAIT_L(0); PG8_MMA(0, 0, At, B0); PG8_BAR; PG8_SCHED;
            PG8_LDB(B1, 0, 1); PG8_STAGE(PG8_SB(0, 0), b2, voffB);
            PG8_BAR; PG8_WAIT_L(0); PG8_MMA(0, 1, At, B1); PG8_BAR;
            PG8_LDA(At, 0, 1); PG8_STAGE(PG8_SA(0, 0), a2, voffA);
            PG8_BAR; PG8_WAIT_L(0); PG8_MMA(1, 0, At, B0); PG8_BAR; PG8_SCHED;
            PG8_STAGE(PG8_SB(0, 1), b2 + hstep, voffB);
            PG8_WAIT_V(6); PG8_BAR; PG8_MMA(1, 1, At, B1); PG8_BAR;
            PG8_LDB(B0, 1, 0); PG8_SCHED; PG8_LDA(At, 1, 0); PG8_STAGE(PG8_SA(0, 1), a2 + hstep, voffA);
            PG8_WAIT_L(8); PG8_BAR; PG8_WAIT_L(0); PG8_MMA(0, 0, At, B0); PG8_BAR; PG8_SCHED;
            PG8_LDB(B1, 1, 1); PG8_STAGE(PG8_SB(1, 0), b3, voffB);
            PG8_BAR; PG8_WAIT_L(0); PG8_MMA(0, 1, At, B1); PG8_BAR;
            PG8_LDA(At, 1, 1); PG8_STAGE(PG8_SA(1, 0), a3, voffA);
            PG8_BAR; PG8_WAIT_L(0); PG8_MMA(1, 0, At, B0); PG8_BAR; PG8_SCHED;
            PG8_STAGE(PG8_SB(1, 1), b3 + hstep, voffB);
            PG8_WAIT_V(6); PG8_BAR; PG8_MMA(1, 1, At, B1); PG8_BAR;
            }
        }
        if constexpr (ALIGN_EPI) { if (wr == 0) PG8_BAR; }
        if constexpr (!Epi::AFTER_DRAIN) { E(acc, cur, wr, wc, fr, fq); S.done(cur); }
        if (!has_next) break;
#pragma unroll
        for (int a = 0; a < 2; ++a)
#pragma unroll
            for (int b = 0; b < 2; ++b)
#pragma unroll
                for (int m = 0; m < 4; ++m)
#pragma unroll
                    for (int n = 0; n < 2; ++n) acc[a][b][m][n] = (f32x4){0.f, 0.f, 0.f, 0.f};
        cur = nxt; cA = nA; cB = nB; ++ui;
        if constexpr (ALIGN_EPI) { if (wr == 1) PG8_BAR; }
    }
    PG8_WAIT_V(0);
    if constexpr (!ALIGN_EPI) { if (wr == 0) PG8_BAR; }
    PG8_BAR;
    if constexpr (Epi::AFTER_DRAIN) { E.fused(acc, cur, wr, wc, fr, fq, lds, wid, lane); S.done(cur); }
#undef PG8_SA
#undef PG8_SB
#undef PG8_STAGE
#undef PG8_LDA
#undef PG8_LDB
#undef PG8_MMA
#undef PG8_WAIT_V
#undef PG8_WAIT_L
#undef PG8_BAR
#undef PG8_SCHED
}
}
namespace pg8 {
typedef unsigned u32x2 __attribute__((ext_vector_type(2)));
constexpr int LDX = 2048;
constexpr float RMS_EPS = 1e-6f;
struct EpiQKV {
    static constexpr bool PERM = true, AFTER_DRAIN = false;
    bf16_t* O; const float* cs; float qscale;
    __device__ __forceinline__ void operator()(const f32x4 (&acc)[2][2][4][2], const Unit& u, int wr, int wc, int fr, int fq) const {
        const int row0 = u.pm * BM + wr * 64 + fr, col0 = u.pn * BM + wc * 32 + 8 * fq, pn = u.pn;
        const float sc = (pn < 4 || (pn >= 12 && pn < 16)) ? qscale : 1.f;
        const bool rot = (pn >= 12 && pn < 20) && (wc == 0);
#pragma unroll
        for (int ai = 0; ai < 2; ++ai)
#pragma unroll
            for (int m = 0; m < 4; ++m) { const int row = row0 + ai * HALF + m * 16; bf16_t* rowp = O + (size_t)row * 6144 + col0;
                f32x4 c0 = {1.f, 1.f, 1.f, 1.f}, c1 = c0, s0 = {0.f, 0.f, 0.f, 0.f}, s1 = s0;
                if (rot) { const float* cr = cs + (size_t)row * 32 + 8 * (fq & 1); c0 = *(const f32x4*)cr; c1 = *(const f32x4*)(cr + 4); s0 = *(const f32x4*)(cr + 16); s1 = *(const f32x4*)(cr + 20);
                    if (fq < 2) { s0 = -s0; s1 = -s1; } }
#pragma unroll
                for (int bj = 0; bj < 2; ++bj) { f32x4 v0 = acc[ai][bj][m][0], v1 = acc[ai][bj][m][1];
                    if (rot) { f32x4 p0, p1;
#pragma unroll
                        for (int j = 0; j < 4; ++j) { p0[j] = __shfl_xor(v0[j], 32); p1[j] = __shfl_xor(v1[j], 32); }
                        v0 = v0 * c0 + p0 * s0; v1 = v1 * c1 + p1 * s1; }
                    v0 = v0 * sc; v1 = v1 * sc; u32x4 w; w.x = cvt_pk_bf16(v0[0], v0[1]); w.y = cvt_pk_bf16(v0[2], v0[3]); w.z = cvt_pk_bf16(v1[0], v1[1]); w.w = cvt_pk_bf16(v1[2], v1[3]);
                    *(u32x4*)(rowp + bj * HALF) = w; } }
    }
};
struct EpiRes {
    static constexpr bool PERM = false, AFTER_DRAIN = false;
    const float* base; float* out; bf16_t* xb; float* ssq;
    __device__ __forceinline__ void operator()(const f32x4 (&acc)[2][2][4][2], const Unit& u, int wr, int wc, int fr, int fq) const {
        const int row0 = u.pm * BM + wr * 64 + fr, col0 = u.pn * BM + wc * 32 + 4 * fq;
#pragma unroll
        for (int ai = 0; ai < 2; ++ai)
#pragma unroll
            for (int m = 0; m < 4; ++m) { const int row = row0 + ai * HALF + m * 16; const size_t off = (size_t)row * LDX + col0; float s = 0.f;
#pragma unroll
                for (int bj = 0; bj < 2; ++bj)
#pragma unroll
                    for (int n = 0; n < 2; ++n) { const f32x4 v = *(const f32x4*)(base + off + bj * HALF + n * 16) + acc[ai][bj][m][n];
                        *(f32x4*)(out + off + bj * HALF + n * 16) = v; s += (v[0] * v[0] + v[1] * v[1]) + (v[2] * v[2] + v[3] * v[3]);
                        if (xb) { u32x2 w; w.x = cvt_pk_bf16(v[0], v[1]); w.y = cvt_pk_bf16(v[2], v[3]); *(u32x2*)(xb + off + bj * HALF + n * 16) = w; } }
                if (ssq) { s += __shfl_xor(s, 16); s += __shfl_xor(s, 32); if (fq == 0) atomicAdd(ssq + row, s); }
                asm volatile("" ::: "memory"); }
    }
};
struct EpiScale {
    static constexpr bool PERM = true, AFTER_DRAIN = false;
    bf16_t* O; int ldc; const float* ssq; float sc;
    __device__ __forceinline__ void operator()(const f32x4 (&acc)[2][2][4][2], const Unit& u, int wr, int wc, int fr, int fq) const {
        const int row0 = u.pm * BM + wr * 64 + fr, col0 = u.pn * BM + wc * 32 + 8 * fq;
#pragma unroll
        for (int ai = 0; ai < 2; ++ai)
#pragma unroll
            for (int m = 0; m < 4; ++m) { const int row = row0 + ai * HALF + m * 16; bf16_t* rowp = O + (size_t)row * ldc + col0;
                const float f = ssq ? sc * __builtin_amdgcn_rsqf(ssq[row] * (1.0f / 2048.0f) + RMS_EPS) : sc;
#pragma unroll
                for (int bj = 0; bj < 2; ++bj) { const f32x4 v0 = acc[ai][bj][m][0] * f, v1 = acc[ai][bj][m][1] * f;
                    u32x4 w; w.x = cvt_pk_bf16(v0[0], v0[1]); w.y = cvt_pk_bf16(v0[2], v0[3]); w.z = cvt_pk_bf16(v1[0], v1[1]); w.w = cvt_pk_bf16(v1[2], v1[3]);
                    *(u32x4*)(rowp + bj * HALF) = w; } }
    }
};
struct EpiSwiGLU {
    static constexpr bool PERM = true, AFTER_DRAIN = false;
    bf16_t* O; const float* ssq;
    __device__ __forceinline__ void operator()(const f32x4 (&acc)[2][2][4][2], const Unit& u, int wr, int wc, int fr, int fq) const {
        const int row0 = u.pm * BM + wr * 64 + fr, col0 = u.pn * HALF + wc * 32 + 8 * fq;
#pragma unroll
        for (int ai = 0; ai < 2; ++ai)
#pragma unroll
            for (int m = 0; m < 4; ++m) { const int row = row0 + ai * HALF + m * 16; bf16_t* rowp = O + (size_t)row * 5632 + col0;
                const float f = __builtin_amdgcn_rsqf(ssq[row] * (1.0f / 2048.0f) + RMS_EPS);
                float r[8];
#pragma unroll
                for (int n = 0; n < 2; ++n)
#pragma unroll
                    for (int j = 0; j < 4; ++j) { const float g = acc[ai][0][m][n][j] * f, uu = acc[ai][1][m][n][j] * f;
                        const float sg = g * __builtin_amdgcn_rcpf(1.0f + __builtin_amdgcn_exp2f(-1.4426950408889634f * g)); r[n * 4 + j] = sg * uu; }
                u32x4 w; w.x = cvt_pk_bf16(r[0], r[1]); w.y = cvt_pk_bf16(r[2], r[3]); w.z = cvt_pk_bf16(r[4], r[5]); w.w = cvt_pk_bf16(r[6], r[7]);
                *(u32x4*)rowp = w; }
    }
};
}
namespace att {
using bf16x8 = __attribute__((ext_vector_type(8))) short;
using s16x4  = __attribute__((ext_vector_type(4))) short;
using f32x16 = __attribute__((ext_vector_type(16))) float;
using f32x4  = __attribute__((ext_vector_type(4))) float;
using u32x4  = __attribute__((ext_vector_type(4))) unsigned;
typedef unsigned short bf16;
constexpr int D = 128, KVBLK = 64;
constexpr int SHM_V = KVBLK * D * 2, SHM_K = KVBLK * D * 2;
constexpr int OFF_WS = 2 * SHM_V + 2 * SHM_K, OFF_KM = OFF_WS + 2048, ATT_LDS = OFF_KM + 4096;
constexpr float THR = 8.f;
#define KSWZ(row, colB) ((row) * 256 + ((colB) ^ (((row) & 7) << 4)))
#define SBAR() __builtin_amdgcn_sched_barrier(0)
__device__ __forceinline__ int crow(int r, int hi) { return (r & 3) + 8 * (r >> 2) + 4 * hi; }
__device__ __forceinline__ unsigned cvtpk(float lo, float hi) { unsigned r; asm volatile("v_cvt_pk_bf16_f32 %0, %1, %2" : "=v"(r) : "v"(lo), "v"(hi)); return r; }
__device__ __forceinline__ float xchg32(float x, int hi) { auto rr = __builtin_amdgcn_permlane32_swap(__float_as_uint(x), __float_as_uint(x), false, false); return __uint_as_float(hi ? rr[0] : rr[1]); }
__device__ __forceinline__ void qkt(f32x16& p0, f32x16& p1, const char* Ks, const bf16x8* qr, int r32, int hi) {
  p0 = f32x16{}; p1 = f32x16{};
#pragma unroll
  for (int d0 = 0; d0 < 8; ++d0) { int cb = (d0 * 16 + hi * 8) * 2;
    bf16x8 b0 = *reinterpret_cast<const bf16x8*>(Ks + KSWZ(r32, cb));
    bf16x8 b1 = *reinterpret_cast<const bf16x8*>(Ks + KSWZ(32 + r32, cb));
    p0 = __builtin_amdgcn_mfma_f32_32x32x16_bf16(b0, qr[d0], p0, 0, 0, 0);
    p1 = __builtin_amdgcn_mfma_f32_32x32x16_bf16(b1, qr[d0], p1, 0, 0, 0); }
}
__device__ __forceinline__ int v_st(int k, int c) { const int kk = (k & ~0xC) | ((k & 4) << 1) | ((k & 8) >> 1); return ((kk >> 3) * 4 + (c >> 5)) * 512 + ((kk & 7) * 32 + (c & 31)) * 2; }
__device__ __forceinline__ int v_rd_base(int lane) { return ((lane & 3) << 3) | (((lane >> 2) & 3) << 6) | (((lane >> 4) & 1) << 5) | (((lane >> 5) & 1) << 8); }
constexpr int v_rd_off(int d0, int ks, int half) { return d0 * 512 + ks * 4096 + half * 2048; }
template <int OFF> __device__ __forceinline__ s16x4 tr_read(int vb) { s16x4 r; asm volatile("ds_read_b64_tr_b16 %0, %1 offset:%2" : "=&v"(r) : "v"(vb), "i"(OFF) : "memory"); return r; }
template <int D0> __device__ __forceinline__ void pv_one(f32x16& od, int vb, bf16x8 pa0, bf16x8 pa1, bf16x8 pa2, bf16x8 pa3) {
  const s16x4 l0 = tr_read<v_rd_off(D0, 0, 0)>(vb), h0 = tr_read<v_rd_off(D0, 0, 1)>(vb), l1 = tr_read<v_rd_off(D0, 1, 0)>(vb), h1 = tr_read<v_rd_off(D0, 1, 1)>(vb);
  const s16x4 l2 = tr_read<v_rd_off(D0, 2, 0)>(vb), h2 = tr_read<v_rd_off(D0, 2, 1)>(vb), l3 = tr_read<v_rd_off(D0, 3, 0)>(vb), h3 = tr_read<v_rd_off(D0, 3, 1)>(vb);
  asm volatile("s_waitcnt lgkmcnt(0)" ::: "memory"); SBAR();
#define PK(L, H) (bf16x8){L[0], L[1], L[2], L[3], H[0], H[1], H[2], H[3]}
  od = __builtin_amdgcn_mfma_f32_32x32x16_bf16(pa0, PK(l0, h0), od, 0, 0, 0);
  od = __builtin_amdgcn_mfma_f32_32x32x16_bf16(pa1, PK(l1, h1), od, 0, 0, 0);
  od = __builtin_amdgcn_mfma_f32_32x32x16_bf16(pa2, PK(l2, h2), od, 0, 0, 0);
  od = __builtin_amdgcn_mfma_f32_32x32x16_bf16(pa3, PK(l3, h3), od, 0, 0, 0);
#undef PK
}
__device__ __forceinline__ void pv_d0(f32x16* o, int vb, bf16x8 pa0, bf16x8 pa1, bf16x8 pa2, bf16x8 pa3) {
  pv_one<0>(o[0], vb, pa0, pa1, pa2, pa3); pv_one<1>(o[1], vb, pa0, pa1, pa2, pa3); pv_one<2>(o[2], vb, pa0, pa1, pa2, pa3); pv_one<3>(o[3], vb, pa0, pa1, pa2, pa3);
}
__device__ __forceinline__ void pack_p(const f32x16& p0, const f32x16& p1, bf16x8& pa0, bf16x8& pa1, bf16x8& pa2, bf16x8& pa3) {
#define PK4(P, BASE, OUT) do { unsigned a0 = cvtpk(P[BASE + 0], P[BASE + 1]), a1 = cvtpk(P[BASE + 2], P[BASE + 3]);   \
    unsigned b0 = cvtpk(P[BASE + 4], P[BASE + 5]), b1 = cvtpk(P[BASE + 6], P[BASE + 7]);                              \
    auto r0 = __builtin_amdgcn_permlane32_swap(a0, b0, false, false); auto r1 = __builtin_amdgcn_permlane32_swap(a1, b1, false, false); \
    u32x4 w = {r0[0], r1[0], r0[1], r1[1]}; OUT = *reinterpret_cast<bf16x8*>(&w); } while (0)
  PK4(p0, 0, pa0); PK4(p0, 8, pa1); PK4(p1, 0, pa2); PK4(p1, 8, pa3);
#undef PK4
}
__device__ __forceinline__ void softmax_tile(f32x16& p0, f32x16& p1, float& m_reg, float& l_reg, float& alpha) {
  float pmax = p0[0];
#pragma unroll
  for (int r = 1; r < 16; ++r) pmax = fmaxf(pmax, p0[r]);
#pragma unroll
  for (int r = 0; r < 16; ++r) pmax = fmaxf(pmax, p1[r]);
  pmax = fmaxf(pmax, xchg32(pmax, (int)(threadIdx.x >> 5) & 1));
  if (__all(pmax - m_reg <= THR)) { alpha = 1.f; }
  else { const float mn = fmaxf(m_reg, pmax); alpha = __builtin_amdgcn_exp2f(m_reg - mn); m_reg = mn; }
  float ps = 0.f;
#pragma unroll
  for (int r = 0; r < 16; ++r) { p0[r] = __builtin_amdgcn_exp2f(p0[r] - m_reg); ps += p0[r]; }
#pragma unroll
  for (int r = 0; r < 16; ++r) { p1[r] = __builtin_amdgcn_exp2f(p1[r] - m_reg); ps += p1[r]; }
  ps += xchg32(ps, (int)(threadIdx.x >> 5) & 1);
  l_reg = l_reg * alpha + ps;
}
__device__ __forceinline__ float softplus2(float y) { return fmaxf(y, 0.f) + __builtin_amdgcn_logf(1.0f + __builtin_amdgcn_exp2f(-fabsf(y))); }
__device__ __forceinline__ void sb_tile(f32x16& p0, f32x16& p1, float& carry, bool band, int kb, int qrel, int hi) {
  float gs[8];
#pragma unroll
  for (int i = 0; i < 4; ++i) { float run = 0.f;
#pragma unroll
    for (int e = 3; e >= 0; --e) { const int r = 4 * i + e; const bool valid = !band || (kb + crow(r, hi) < qrel); const float y = p0[r];
      const float sp = valid ? softplus2(y) : 0.f; run += sp; p0[r] = valid ? (y - run) : -INFINITY; }
    gs[i] = run; }
#pragma unroll
  for (int i = 0; i < 4; ++i) { float run = 0.f;
#pragma unroll
    for (int e = 3; e >= 0; --e) { const int r = 4 * i + e; const bool valid = !band || (kb + 32 + crow(r, hi) < qrel); const float y = p1[r];
      const float sp = valid ? softplus2(y) : 0.f; run += sp; p1[r] = valid ? (y - run) : -INFINITY; }
    gs[4 + i] = run; }
  float acc = 0.f;
#pragma unroll
  for (int i = 7; i >= 0; --i) { const float so_i = acc; acc += gs[i]; const float x = hi ? acc : so_i; gs[i] = carry + so_i + xchg32(x, hi); }
  const float tot = acc, ptot = xchg32(acc, hi);
#pragma unroll
  for (int i = 0; i < 4; ++i)
#pragma unroll
    for (int e = 0; e < 4; ++e) { p0[4 * i + e] = __builtin_amdgcn_exp2f(p0[4 * i + e] - gs[i]); p1[4 * i + e] = __builtin_amdgcn_exp2f(p1[4 * i + e] - gs[4 + i]); }
  carry += tot + ptot;
}

template <int MODE>
__device__ __forceinline__ void attn_unit(const bf16* __restrict__ Qb, int ldq, const bf16* __restrict__ Kh, const bf16* __restrict__ Vh, int ldk, bf16* __restrict__ Ob, int ldo,
                                          const float* __restrict__ gain, const float* __restrict__ kmean, int qb, int nkeys, char* lds) {
  int tid_ = threadIdx.x; asm volatile("" : "+v"(tid_));
  const int tid = tid_, wid = __builtin_amdgcn_readfirstlane(tid >> 6), lane = tid & 63, r32 = lane & 31, hi = lane >> 5;
  char* V_lds = lds; char* K_lds = lds + 2 * SHM_V;
  float* ws = (float*)(lds + OFF_WS) + wid * 64; float* li_l = ws; float* al_l = ws + 32;
  float* km_l = (float*)(lds + OFF_KM);
  const int NT = (MODE == 0) ? nkeys / KVBLK : 4 * (qb + 1);
  const int qrel = wid * 32 + r32;
  float m_reg = -1e30f, l_reg = 0.f, carry = 0.f; f32x16 o[4] = {}; bf16x8 qr[8];
  const bf16* Qw = Qb + (long)(wid * 32 + r32) * ldq + hi * 8;
#pragma unroll
  for (int d0 = 0; d0 < 8; ++d0) qr[d0] = *reinterpret_cast<const bf16x8*>(Qw + d0 * 16);
  const int vb0 = (int)(uintptr_t)V_lds + v_rd_base(lane);
  long ksrc[2], vsrc[2];
#pragma unroll
  for (int i = 0; i < 2; ++i) { const int piece = wid + 8 * i;
    { const int row = piece * 4 + (lane >> 4), c = (lane & 15) ^ (row & 7); ksrc[i] = (long)row * ldk + c * 8; }
    { const int sub = piece * 2 + (lane >> 5), kk = (sub >> 2) * 8 + ((lane & 31) >> 2), k = (kk & ~0xC) | ((kk & 4) << 1) | ((kk & 8) >> 1), c = (sub & 3) * 32 + (lane & 3) * 8; vsrc[i] = (long)k * ldk + c; } }
  typedef __attribute__((address_space(3))) unsigned lds_u32;
  lds_u32* kdst = (lds_u32*)(__attribute__((address_space(3))) char*)(K_lds) + wid * 256; lds_u32* vdst = (lds_u32*)(__attribute__((address_space(3))) char*)(V_lds) + wid * 256;
#define TILE(it) ((MODE == 2) ? (NT - 1 - (it)) : (it))
#define SDMA(k0, b) do { _Pragma("unroll") for (int i_ = 0; i_ < 2; ++i_) { \
    __builtin_amdgcn_global_load_lds((const unsigned*)(Kh + (long)(k0) * ldk + ksrc[i_]), kdst + (b) * (SHM_K / 4) + i_ * 2048, 16, 0, 0); \
    __builtin_amdgcn_global_load_lds((const unsigned*)(Vh + (long)(k0) * ldk + vsrc[i_]), vdst + (b) * (SHM_V / 4) + i_ * 2048, 16, 0, 0); } } while (0)
#define SDRAIN() asm volatile("s_waitcnt vmcnt(0)" ::: "memory")
  SDMA(TILE(0) * KVBLK, 0);
  unsigned selmask = 0u;
  if (MODE == 1) { if (tid < 256) *(f32x4*)(km_l + tid * 4) = *(const f32x4*)(kmean + tid * 4); }
  SDRAIN();
  __syncthreads();
  if (MODE == 1) {
    float g[8];
#pragma unroll
    for (int n = 0; n < 8; ++n) g[n] = 0.f;
#pragma unroll
    for (int d0 = 0; d0 < 8; ++d0) { float q[8];
#pragma unroll
      for (int j = 0; j < 8; ++j) q[j] = __uint_as_float(((unsigned)(unsigned short)qr[d0][j]) << 16);
#pragma unroll
      for (int n = 0; n < 7; ++n) { const f32x4 ka = *(const f32x4*)(km_l + n * 128 + d0 * 16 + hi * 8), kb2 = *(const f32x4*)(km_l + n * 128 + d0 * 16 + hi * 8 + 4);
        g[n] += (q[0] * ka[0] + q[1] * ka[1]) + (q[2] * ka[2] + q[3] * ka[3]) + (q[4] * kb2[0] + q[5] * kb2[1]) + (q[6] * kb2[2] + q[7] * kb2[3]); } }
#pragma unroll
    for (int n = 0; n < 7; ++n) { g[n] += xchg32(g[n], hi); if (n >= qb) g[n] = -INFINITY; }
    g[7] = -INFINITY;
#pragma unroll
    for (int n = 0; n < 7; ++n) { int cnt = 0;
#pragma unroll
      for (int mI = 0; mI < 7; ++mI) { if (mI != n) cnt += (g[mI] > g[n] || (g[mI] == g[n] && mI < n)) ? 1 : 0; }
      if (n < qb && cnt < 3) selmask |= (1u << n); }
  }
  for (int it = 0; it < NT; ++it) {
    const int j = TILE(it), buf = it & 1;
    if (it + 1 < NT) SDMA(TILE(it + 1) * KVBLK, buf ^ 1);
    const int jb = j - (NT - 4);
    bool skip = false;
    if (MODE == 1) skip = (jb >= 0) && (64 * jb > wid * 32 + 31);
    if (MODE == 2) skip = (jb >= 0) && (64 * jb >= wid * 32 + 31);
    if (!skip) {
      f32x16 p0, p1; bf16x8 pa0, pa1, pa2, pa3;
      qkt(p0, p1, K_lds + buf * SHM_K, qr, r32, hi);
      if (MODE == 2) {
        sb_tile(p0, p1, carry, jb >= 0, 64 * jb, qrel, hi);
      } else {
        if (MODE == 1) {
          if (jb < 0) { const bool s = (selmask >> (j >> 2)) & 1u;
#pragma unroll
            for (int r = 0; r < 16; ++r) { p0[r] = s ? p0[r] : -INFINITY; p1[r] = s ? p1[r] : -INFINITY; } }
          else {
#pragma unroll
            for (int r = 0; r < 16; ++r) { const int kr = 64 * jb + crow(r, hi); if (kr > qrel) p0[r] = -INFINITY; if (kr + 32 > qrel) p1[r] = -INFINITY; } }
        }
        float alpha; softmax_tile(p0, p1, m_reg, l_reg, alpha);
        if (__any(alpha < 1.f)) { if (hi == 0) al_l[r32] = alpha; asm volatile("s_waitcnt lgkmcnt(0)" ::: "memory");
#pragma unroll
          for (int d = 0; d < 4; ++d)
#pragma unroll
            for (int r = 0; r < 16; ++r) o[d][r] *= al_l[crow(r, hi)]; }
      }
      pack_p(p0, p1, pa0, pa1, pa2, pa3);
      pv_d0(o, vb0 + buf * SHM_V, pa0, pa1, pa2, pa3);
    }
    SDRAIN();
    __syncthreads();
  }
  float rli[16];
  if (MODE != 2) { if (hi == 0) li_l[r32] = l_reg; asm volatile("s_waitcnt lgkmcnt(0)" ::: "memory");
#pragma unroll
    for (int r = 0; r < 16; ++r) rli[r] = __builtin_amdgcn_rcpf(li_l[crow(r, hi)]); }
  else {
#pragma unroll
    for (int r = 0; r < 16; ++r) rli[r] = 1.f; }
  if (gain) {
    float gv[4];
#pragma unroll
    for (int d0 = 0; d0 < 4; ++d0) gv[d0] = gain[d0 * 32 + r32];
#pragma unroll
    for (int r = 0; r < 16; ++r) { float s = 0.f;
#pragma unroll
      for (int d0 = 0; d0 < 4; ++d0) { o[d0][r] *= rli[r]; s += o[d0][r] * o[d0][r]; }
      s += __shfl_xor(s, 1); s += __shfl_xor(s, 2); s += __shfl_xor(s, 4); s += __shfl_xor(s, 8); s += __shfl_xor(s, 16);
      rli[r] = __builtin_amdgcn_rsqf(s * (1.0f / 128.0f) + 1e-6f); }
#pragma unroll
    for (int r = 0; r < 16; ++r)
#pragma unroll
      for (int d0 = 0; d0 < 4; ++d0) o[d0][r] *= gv[d0];
  }
  { bf16* stg = (bf16*)lds + wid * 4096;
#pragma unroll
    for (int r = 0; r < 16; ++r) { const int orow = crow(r, hi);
#pragma unroll
      for (int d0 = 0; d0 < 4; ++d0) { const float v = o[d0][r] * rli[r]; unsigned u = __float_as_uint(v); u = (u + 0x7fffu + ((u >> 16) & 1u)) >> 16; stg[orow * 128 + d0 * 32 + r32] = (bf16)u; } }
    asm volatile("s_waitcnt lgkmcnt(0)" ::: "memory");
#pragma unroll
    for (int i = 0; i < 8; ++i) { const int row = i * 4 + (lane >> 4), ch = lane & 15; const u32x4 v = *(const u32x4*)(stg + row * 128 + ch * 8); *(u32x4*)(Ob + (long)(wid * 32 + row) * ldo + ch * 8) = v; } }
  __syncthreads();
#undef TILE
#undef SDMA
#undef SDRAIN
}
#undef KSWZ
#undef SBAR
}
#define GAS __attribute__((address_space(1)))
#define LAS __attribute__((address_space(3)))
typedef unsigned short bf16;
typedef unsigned v4u __attribute__((ext_vector_type(4)));
typedef float f32x4 __attribute__((ext_vector_type(4)));
#define LDS_WAIT() asm volatile("s_waitcnt lgkmcnt(0)" ::: "memory")
constexpr int NWAVES = 8;
constexpr int BATCH = 8, SEQ = 2048, DM = 2048, M = BATCH * SEQ, HD = 128, NH = 8;
constexpr int NQKV = 6144, FF = 5632, WX = 512, NMEM = 256, MMEM = BATCH * NMEM;
constexpr int QSB = 0, KSB = 1024, VSB = 2048, QMB = 3072, KMB = 4096, VMB = 5120;
constexpr float EPS = 1e-6f;
constexpr float QSCALE = 0.12751743082459868f;
constexpr size_t MiB = 1u << 20;
constexpr size_t WS_CTL = 0, CTL_ZERO_BYTES = 1 * MiB;
constexpr size_t WS_SSQ1 = 64 * 1024, WS_SSQ2 = 128 * 1024;
constexpr size_t WS_WIN = 1 * MiB, WS_WOUT = 25 * MiB, WS_WXQ = 33 * MiB, WS_WXKV = 35 * MiB, WS_WXO = 39 * MiB, WS_WGU = 41 * MiB, WS_WDN = 85 * MiB;
constexpr size_t WS_RA = 107 * MiB;
constexpr size_t WS_RB = 171 * MiB;
constexpr size_t WS_RC = 235 * MiB;
constexpr size_t WS_QX = 427 * MiB, WS_OX = 443 * MiB, WS_KVX = 459 * MiB, WS_MN = 463 * MiB, WS_KMEAN = 471 * MiB, WS_CS = 472 * MiB, WS_END = 474 * MiB;
constexpr int RING_BYTES = 131072, LDS_BYTES = 147456;

__device__ __forceinline__ float bf2f(unsigned short b) { return __uint_as_float((unsigned)b << 16); }
__device__ __forceinline__ unsigned f2bf(float f) { unsigned u = __builtin_bit_cast(unsigned, f); return (u + 0x7fffu + ((u >> 16) & 1u)) >> 16; }
__device__ __forceinline__ unsigned pk2(float lo, float hi) { return f2bf(lo) | (f2bf(hi) << 16); }
__device__ __forceinline__ float wave_sum(float v) {
#pragma unroll
    for (int o = 1; o < 64; o <<= 1) v += __shfl_xor(v, o);
    return v;
}
__device__ __forceinline__ float wave_max(float v) {
#pragma unroll
    for (int o = 1; o < 64; o <<= 1) v = fmaxf(v, __shfl_xor(v, o));
    return v;
}

typedef GAS unsigned gu32;
#define RLX_AGENT __ATOMIC_RELAXED, __HIP_MEMORY_SCOPE_AGENT
constexpr int CW_BAR = 4096;
constexpr int LDSCTL_OFF = RING_BYTES, MISC_OFF = LDSCTL_OFF + 320;
#define XB_TMO      128
#define XB_XCNT(j)  (256  + 64 * (j))
#define XB_XSUB(j)  (1280 + 64 * (j))
#define XB_XGEN(j)  (2304 + 64 * (j))
#define XB_TOP      3328
#define XB_TOPGEN   3392
#define XCD_BAR_WORDS 3456
#define XB_SPIN_CAP (1u << 18)

__device__ __forceinline__ unsigned xb_ld(unsigned* p)              { return __hip_atomic_load(p, __ATOMIC_RELAXED, __HIP_MEMORY_SCOPE_AGENT); }
__device__ __forceinline__ unsigned xb_add(unsigned* p, unsigned v) { return __hip_atomic_fetch_add(p, v, __ATOMIC_RELAXED, __HIP_MEMORY_SCOPE_AGENT); }
__device__ __forceinline__ unsigned xb_xcc_id() { return (unsigned)__builtin_amdgcn_s_getreg((3 << 11) | 20) & 0xFu; }
#define XB_SPIN(cond, bar) do { unsigned _sp = 0; while (cond) { __builtin_amdgcn_s_sleep(1); \
    if ((++_sp & 255u) == 0u) { if (xb_ld(&(bar)[XB_TMO])) break; if (_sp > XB_SPIN_CAP) { atomicAdd(&(bar)[XB_TMO], 1u); break; } } } } while (0)

struct XcdBarrier {
    unsigned* bar; unsigned x;
    volatile LAS unsigned* st;
};

__device__ __forceinline__ XcdBarrier xcd_barrier_post(unsigned* bar, volatile LAS unsigned* st) {
    XcdBarrier b; b.bar = bar; b.x = xb_xcc_id(); b.st = st;
    if (threadIdx.x == 0) (void)xb_add(&bar[XB_XCNT(b.x)], 1u);
    return b;
}
__device__ __forceinline__ void xcd_barrier_complete(unsigned* bar, unsigned x, unsigned& nloc, unsigned& nx) {
    const unsigned G = gridDim.x * gridDim.y * gridDim.z;
    unsigned sum, cnt, mine, sp = 0u;
    for (;;) {
        sum = 0u; cnt = 0u; mine = 0u;
#pragma unroll
        for (unsigned j = 0; j < 16; ++j) { const unsigned c = xb_ld(&bar[XB_XCNT(j)]); sum += c; cnt += (c > 0u) ? 1u : 0u; mine = (j == x) ? c : mine; }
        if (sum == G) break;
        __builtin_amdgcn_s_sleep(1);
        if ((++sp & 255u) == 0u) { if (xb_ld(&bar[XB_TMO])) break; if (sp > XB_SPIN_CAP) { atomicAdd(&bar[XB_TMO], 1u); break; } }
    }
    nloc = mine > 0u ? mine : 1u; nx = cnt > 0u ? cnt : 1u;
}

__device__ __forceinline__ void xcd_barrier(const XcdBarrier& b) {
    asm volatile("s_waitcnt vmcnt(0)" ::: "memory");
    __syncthreads();
    if (threadIdx.x == 0) {
        unsigned* bar = b.bar;
        __builtin_amdgcn_s_waitcnt(0);
        unsigned nloc = b.st[0], nx = b.st[1];
        if (nloc == 0u) { xcd_barrier_complete(bar, b.x, nloc, nx); b.st[0] = nloc; b.st[1] = nx; }
        const unsigned old = xb_add(&bar[XB_XSUB(b.x)], 1u);
        const unsigned gen = old / nloc;
        if (old + 1u == (gen + 1u) * nloc) {
            __builtin_amdgcn_fence(__ATOMIC_RELEASE, "agent");
            asm volatile("s_waitcnt vmcnt(0)" ::: "memory");
            const unsigned og = xb_add(&bar[XB_TOP], 1u);
            const unsigned tg = og / nx;
            if (og + 1u == (tg + 1u) * nx) xb_add(&bar[XB_TOPGEN], 1u);
            else XB_SPIN(xb_ld(&bar[XB_TOPGEN]) == tg, bar);
            __builtin_amdgcn_fence(__ATOMIC_ACQUIRE, "agent");
            xb_add(&bar[XB_XGEN(b.x)], 1u);
            asm volatile("s_waitcnt vmcnt(0)" ::: "memory");
        } else {
            XB_SPIN(xb_ld(&bar[XB_XGEN(b.x)]) == gen, bar);
            __builtin_amdgcn_fence(__ATOMIC_ACQUIRE, "agent");
            asm volatile("s_waitcnt vmcnt(0)" ::: "memory");
        }
    }
    __syncthreads();
}

struct Frame {
    LAS unsigned char* lds;
    int tid, lane, wave, vcu, G;
    const float *x, *mem; const int* pos;
    const float *g_mix, *w_in, *g_out_sb, *g_out_mb, *w_out, *g_xattn, *g_mem, *w_xq, *w_xkv, *w_xo, *g_ffn, *w_gu, *w_dn, *g_final;
    float* out; unsigned char* ws;
};

__device__ __forceinline__ void transpose_item(const float* W, int K, int N, bf16* WT, const float* gain, int inter, LAS float* scr, int item, int lane) {
    const int nblk = N / 32, kb = item / nblk, nb = item % nblk, k0 = 64 * kb, n0 = 32 * nb;
    int orow0 = n0;
    if (inter) orow0 = (n0 < FF) ? (n0 / 128) * 256 + (n0 % 128) : ((n0 - FF) / 128) * 256 + 128 + ((n0 - FF) % 128);
#pragma unroll 8
    for (int i = 0; i < 32; ++i) { const int kk = 2 * i + (lane >> 5); float v = W[(size_t)(k0 + kk) * N + n0 + (lane & 31)]; if (gain) v *= gain[k0 + kk]; scr[kk * 33 + (lane & 31)] = v; }
    LDS_WAIT(); asm volatile("" ::: "memory");
    const int c = lane & 7;
#pragma unroll
    for (int j = 0; j < 4; ++j) { const int n = (lane >> 3) + 8 * j; const LAS float* s = scr + (8 * c) * 33 + n;
        v4u o; o.x = pk2(s[0 * 33], s[1 * 33]); o.y = pk2(s[2 * 33], s[3 * 33]); o.z = pk2(s[4 * 33], s[5 * 33]); o.w = pk2(s[6 * 33], s[7 * 33]);
        *(GAS v4u*)(WT + (size_t)(orow0 + n) * K + k0 + 8 * c) = o; }
    LDS_WAIT(); asm volatile("" ::: "memory");
}
__device__ __forceinline__ void rms_row_to_bf16(const float* xrow, const float* g, bf16* orow, int lane) {
    const GAS f32x4* xr = (const GAS f32x4*)xrow + lane; const GAS f32x4* gr = (const GAS f32x4*)g + lane;
    f32x4 v[8]; float s = 0.f;
#pragma unroll
    for (int j = 0; j < 8; ++j) { v[j] = xr[64 * j]; s += (v[j].x * v[j].x + v[j].y * v[j].y) + (v[j].z * v[j].z + v[j].w * v[j].w); }
    const float rstd = 1.0f / sqrtf(wave_sum(s) * (1.f / DM) + EPS);
    GAS unsigned long long* o8 = (GAS unsigned long long*)orow + lane;
#pragma unroll
    for (int j = 0; j < 8; ++j) { const f32x4 gg = gr[64 * j];
        o8[64 * j] = (unsigned long long)pk2(v[j].x * rstd * gg.x, v[j].y * rstd * gg.y) | ((unsigned long long)pk2(v[j].z * rstd * gg.z, v[j].w * rstd * gg.w) << 32); }
}
__constant__ float INV_FREQ[16] = {1.000000000e+00f, 4.403665960e-01f, 1.939227432e-01f, 8.539710194e-02f, 3.760603070e-02f, 1.656043902e-02f, 7.292664610e-03f, 3.211445874e-03f,
                                   1.414213562e-03f, 6.227723788e-04f, 2.742481884e-04f, 1.207697351e-04f, 5.318296098e-05f, 2.341999971e-05f, 1.031338616e-05f, 4.541670478e-06f};

__device__ __forceinline__ void p0_prologue(Frame& F) {
    LAS float* scr = (LAS float*)(F.lds + F.wave * 16384);
    const int gw = F.vcu * NWAVES + F.wave, NGW = F.G * NWAVES;
    bf16* ws16 = (bf16*)F.ws;
    constexpr int I0 = (DM / 64) * (NQKV / 32), I1 = (DM / 64) * (DM / 32), I2 = (DM / 64) * (WX / 32), I3 = (DM / 64) * (2 * WX / 32), I4 = (WX / 64) * (DM / 32),
                  I5 = (DM / 64) * (2 * FF / 32), I6 = (FF / 64) * (DM / 32);
    constexpr int NITEMS = I0 + I1 + I2 + I3 + I4 + I5 + I6;
    for (int it = gw; it < NITEMS; it += NGW) {
        int r = it;
        if (r < I0) { transpose_item(F.w_in, DM, NQKV, (bf16*)(F.ws + WS_WIN), nullptr, 0, scr, r, F.lane); continue; } r -= I0;
        if (r < I1) { transpose_item(F.w_out, DM, DM, (bf16*)(F.ws + WS_WOUT), nullptr, 0, scr, r, F.lane); continue; } r -= I1;
        if (r < I2) { transpose_item(F.w_xq, DM, WX, (bf16*)(F.ws + WS_WXQ), F.g_xattn, 0, scr, r, F.lane); continue; } r -= I2;
        if (r < I3) { transpose_item(F.w_xkv, DM, 2 * WX, (bf16*)(F.ws + WS_WXKV), nullptr, 0, scr, r, F.lane); continue; } r -= I3;
        if (r < I4) { transpose_item(F.w_xo, WX, DM, (bf16*)(F.ws + WS_WXO), nullptr, 0, scr, r, F.lane); continue; } r -= I4;
        if (r < I5) { transpose_item(F.w_gu, DM, 2 * FF, (bf16*)(F.ws + WS_WGU), F.g_ffn, 1, scr, r, F.lane); continue; } r -= I5;
        transpose_item(F.w_dn, FF, DM, (bf16*)(F.ws + WS_WDN), nullptr, 0, scr, r, F.lane);
    }
    (void)ws16;
    for (int m = gw; m < M; m += NGW) rms_row_to_bf16(F.x + (size_t)m * DM, F.g_mix, (bf16*)(F.ws + WS_RA) + (size_t)m * DM, F.lane);
    for (int m = gw; m < MMEM; m += NGW) rms_row_to_bf16(F.mem + (size_t)m * DM, F.g_mem, (bf16*)(F.ws + WS_MN) + (size_t)m * DM, F.lane);
    float* cs = (float*)(F.ws + WS_CS);
    for (int e = (F.vcu * NWAVES + F.wave) * 64 + F.lane; e < M * 16; e += NGW * 64) {
        const int m = e >> 4, i = e & 15; const float ang = (float)F.pos[m] * INV_FREQ[i];
        double rev = (double)ang * 0.15915494309189535; rev -= floor(rev);
        const float a = (float)(rev * 6.283185307179586);
        cs[(size_t)m * 32 + i] = cosf(a); cs[(size_t)m * 32 + 16 + i] = sinf(a);
    }
}

__device__ __forceinline__ float dot128(const LAS float* qs, const bf16* krow) {
    float s = 0.f;
#pragma unroll
    for (int c = 0; c < 16; ++c) { const v4u kv = *(const v4u*)(krow + 8 * c); const LAS f32x4* q4 = (const LAS f32x4*)(qs + 8 * c); const f32x4 qa = q4[0], qb = q4[1];
        s += qa.x * __uint_as_float(kv.x << 16) + qa.y * __uint_as_float(kv.x & 0xffff0000u) + qa.z * __uint_as_float(kv.y << 16) + qa.w * __uint_as_float(kv.y & 0xffff0000u)
           + qb.x * __uint_as_float(kv.z << 16) + qb.y * __uint_as_float(kv.z & 0xffff0000u) + qb.z * __uint_as_float(kv.w << 16) + qb.w * __uint_as_float(kv.w & 0xffff0000u); }
    return s;
}
__device__ __forceinline__ void load_q_lds(LAS float* qs, const bf16* qp, int lane) { qs[lane] = bf2f(qp[lane]); qs[64 + lane] = bf2f(qp[64 + lane]); LDS_WAIT(); asm volatile("" ::: "memory"); }
__device__ __forceinline__ void pv64(float w, const bf16* vbase, size_t ld, int cnt, int lane, float& o0, float& o1) {
    for (int i = 0; i < cnt; ++i) { const float wi = __shfl(w, i); const unsigned vv = *(const unsigned*)(vbase + (size_t)i * ld + 2 * lane); o0 += wi * __uint_as_float(vv << 16); o1 += wi * __uint_as_float(vv & 0xffff0000u); }
}
__device__ __forceinline__ float softplus2(float y) { return fmaxf(y, 0.f) + __builtin_amdgcn_logf(1.0f + __builtin_amdgcn_exp2f(-fabsf(y))); }
__device__ __forceinline__ void store_head_norm(float o0, float o1, const float* g, bf16* op, int lane) {
    const float ssq = wave_sum(o0 * o0 + o1 * o1); const float r = 1.0f / sqrtf(ssq * (1.f / HD) + EPS);
    *(unsigned*)(op + 2 * lane) = pk2(o0 * r * g[2 * lane], o1 * r * g[2 * lane + 1]);
}
__device__ __forceinline__ void naive_sb_row(Frame& F, LAS float* qs, int bh, int t) {
    const int b = bh >> 3, h = bh & 7, lane = F.lane; const bf16* qkv = (const bf16*)(F.ws + WS_RC); const size_t rb = (size_t)b * SEQ;
    load_q_lds(qs, qkv + (rb + t) * NQKV + QSB + h * HD, lane);
    const bf16* kp = qkv + rb * NQKV + KSB + h * HD; const bf16* vp = qkv + rb * NQKV + VSB + h * HD;
    float o0 = 0.f, o1 = 0.f, carry = 0.f;
    for (int c = (t - 1) >> 6; c >= 0; --c) {
        const int key = c * 64 + lane; const bool valid = key < t;
        float y = 0.f; if (valid) y = dot128(qs, kp + (size_t)key * NQKV);
        const float sp = valid ? softplus2(y) : 0.f;
        float suf = sp;
#pragma unroll
        for (int off = 1; off < 64; off <<= 1) { const float tt = __shfl_down(suf, off); if (lane + off < 64) suf += tt; }
        const float w = valid ? __builtin_amdgcn_exp2f(y - (suf + carry)) : 0.f;
        carry += __shfl(suf, 0);
        const int cnt = (t - c * 64) < 64 ? (t - c * 64) : 64;
        pv64(w, vp + (size_t)(c * 64) * NQKV, NQKV, cnt, lane, o0, o1);
    }
    store_head_norm(o0, o1, F.g_out_sb + h * HD, (bf16*)(F.ws + WS_RA) + (rb + t) * DM + h * HD, lane);
    LDS_WAIT();
}
__device__ __forceinline__ void softmax_chunk(float s, bool valid, const bf16* vbase, size_t ld, int cnt, int lane, float& m, float& l, float& o0, float& o1) {
    const float cm = wave_max(valid ? s : -1e30f); const float mn = fmaxf(m, cm); const float alpha = __builtin_amdgcn_exp2f(m - mn);
    const float p = valid ? __builtin_amdgcn_exp2f(s - mn) : 0.f;
    l = l * alpha + wave_sum(p); o0 *= alpha; o1 *= alpha; m = mn;
    pv64(p, vbase, ld, cnt, lane, o0, o1);
}
__device__ __forceinline__ void naive_moba_row(Frame& F, LAS float* qs, int bh, int t) {
    const int b = bh >> 3, h = bh & 7, lane = F.lane; const bf16* qkv = (const bf16*)(F.ws + WS_RC); const size_t rb = (size_t)b * SEQ;
    load_q_lds(qs, qkv + (rb + t) * NQKV + QMB + h * HD, lane);
    const bf16* kp = qkv + rb * NQKV + KMB + h * HD; const bf16* vp = qkv + rb * NQKV + VMB + h * HD;
    const int blk = t >> 8;
    const float* km = (const float*)(F.ws + WS_KMEAN) + (size_t)bh * 8 * HD;
    float g = -INFINITY;
    { const int n = lane & 7; if (n < blk) { float a = 0.f; for (int d = 0; d < HD; ++d) a += qs[d] * km[n * HD + d]; g = a; } }
    int cnt = 0;
#pragma unroll
    for (int mI = 0; mI < 8; ++mI) { const float gm = __shfl(g, mI); cnt += (gm > g || (gm == g && mI < (lane & 7))) ? 1 : 0; }
    const bool sel = (lane < 8) && (lane < blk) && (cnt < 3);
    const unsigned selmask = (unsigned)(__ballot(sel) & 0xffull);
    float m = -1e30f, l = 0.f, o0 = 0.f, o1 = 0.f;
    for (int n = 0; n <= blk; ++n) {
        if (n < blk && !((selmask >> n) & 1u)) continue;
        for (int c = 0; c < 4; ++c) {
            const int key0 = n * 256 + c * 64; if (key0 > t) break;
            const int key = key0 + lane; const bool valid = key <= t;
            float s = 0.f; if (valid) s = dot128(qs, kp + (size_t)key * NQKV);
            const int cn = (t - key0 + 1) < 64 ? (t - key0 + 1) : 64;
            softmax_chunk(s, valid, vp + (size_t)key0 * NQKV, NQKV, cn, lane, m, l, o0, o1);
        }
    }
    const float il = 1.0f / l;
    store_head_norm(o0 * il, o1 * il, F.g_out_mb + h * HD, (bf16*)(F.ws + WS_RA) + (rb + t) * DM + NH * HD + h * HD, lane);
    LDS_WAIT();
}
__device__ __forceinline__ void naive_xattn_row(Frame& F, LAS float* qs, int b, int h, int t) {
    const int lane = F.lane; const bf16* qx = (const bf16*)(F.ws + WS_QX); const bf16* kv = (const bf16*)(F.ws + WS_KVX);
    load_q_lds(qs, qx + ((size_t)b * SEQ + t) * WX + h * HD, lane);
    const bf16* kp = kv + (size_t)b * NMEM * (2 * WX) + h * HD; const bf16* vp = kp + WX;
    float m = -1e30f, l = 0.f, o0 = 0.f, o1 = 0.f;
    for (int c = 0; c < 4; ++c) { const int key = c * 64 + lane; const float s = dot128(qs, kp + (size_t)key * (2 * WX));
        softmax_chunk(s, true, vp + (size_t)(c * 64) * (2 * WX), 2 * WX, 64, lane, m, l, o0, o1); }
    const float il = 1.0f / l;
    *(unsigned*)((bf16*)(F.ws + WS_OX) + ((size_t)b * SEQ + t) * WX + h * HD + 2 * lane) = pk2(o0 * il, o1 * il);
    LDS_WAIT();
}
__device__ __forceinline__ void kmean_phase(Frame& F) {
    LAS float* red = (LAS float*)F.lds;
    const bf16* qkv = (const bf16*)(F.ws + WS_RC); float* km = (float*)(F.ws + WS_KMEAN);
    const int cc = F.tid & 15, rg = F.tid >> 4;
    for (int item = F.vcu; item < 64 * 8; item += F.G) {
        const int bh = item >> 3, n = item & 7, b = bh >> 3, h = bh & 7;
        const bf16* kp = qkv + ((size_t)b * SEQ + n * 256 + rg * 8) * NQKV + KMB + h * HD + cc * 8;
        float a[8] = {0, 0, 0, 0, 0, 0, 0, 0};
#pragma unroll
        for (int r = 0; r < 8; ++r) { const v4u kv = *(const v4u*)(kp + (size_t)r * NQKV);
            a[0] += __uint_as_float(kv.x << 16); a[1] += __uint_as_float(kv.x & 0xffff0000u); a[2] += __uint_as_float(kv.y << 16); a[3] += __uint_as_float(kv.y & 0xffff0000u);
            a[4] += __uint_as_float(kv.z << 16); a[5] += __uint_as_float(kv.z & 0xffff0000u); a[6] += __uint_as_float(kv.w << 16); a[7] += __uint_as_float(kv.w & 0xffff0000u); }
#pragma unroll
        for (int j = 0; j < 8; ++j) red[rg * 128 + cc * 8 + j] = a[j];
        __syncthreads();
        if (F.tid < 128) { float s = 0.f; for (int r = 0; r < 32; ++r) s += red[r * 128 + F.tid]; km[(size_t)item * HD + F.tid] = s * (1.0f / 256.0f); }
        __syncthreads();
    }
}
__device__ __forceinline__ void final_norm_phase(Frame& F, float* dst) {
    const int gw = F.vcu * NWAVES + F.wave, NGW = F.G * NWAVES;
    for (int m = gw; m < M; m += NGW) {
        GAS f32x4* xr = (GAS f32x4*)(F.out + (size_t)m * DM) + F.lane; const GAS f32x4* gr = (const GAS f32x4*)F.g_final + F.lane;
        f32x4 v[8]; float s = 0.f;
#pragma unroll
        for (int j = 0; j < 8; ++j) { v[j] = xr[64 * j]; s += (v[j].x * v[j].x + v[j].y * v[j].y) + (v[j].z * v[j].z + v[j].w * v[j].w); }
        const float rstd = 1.0f / sqrtf(wave_sum(s) * (1.f / DM) + EPS);
        GAS f32x4* dr = (GAS f32x4*)(dst + (size_t)m * DM) + F.lane;
#pragma unroll
        for (int j = 0; j < 8; ++j) dr[64 * j] = v[j] * rstd * gr[64 * j];
    }
}

constexpr int NPH = 11;
#ifndef REPEAT_PHASE
#define REPEAT_PHASE -1
#endif
#ifndef REPEAT_MASK
#define REPEAT_MASK 0
#endif
#define REPS(k) (((REPEAT_PHASE == (k)) || ((REPEAT_MASK >> (k)) & 1)) ? 2 : 1)
#ifndef USE_MFMA_SB
#define USE_MFMA_SB 1
#endif
#ifndef USE_MFMA_MOBA
#define USE_MFMA_MOBA 1
#endif
#ifndef USE_MFMA_X
#define USE_MFMA_X 1
#endif
#ifndef MK_ONE_LAUNCH
#define MK_ONE_LAUNCH 1
#endif
struct Args { const void* in[17]; float* out; unsigned char* ws; int ph_lo, ph_hi; };
__global__ void __launch_bounds__(NWAVES * 64, 2) mk_fwd(Args args) {
    extern __shared__ __attribute__((aligned(16))) unsigned char lds[];
    Frame F;
    F.lds = (LAS unsigned char*)lds;
    F.tid = threadIdx.x; F.lane = F.tid & 63; F.wave = __builtin_amdgcn_readfirstlane(F.tid >> 6);
    F.G = gridDim.x; { const int bx = blockIdx.x; F.vcu = (F.G % 8 == 0) ? (bx % 8) * (F.G / 8) + bx / 8 : bx; }
    F.x = (const float*)args.in[0]; F.mem = (const float*)args.in[1]; F.pos = (const int*)args.in[2];
    F.g_mix = (const float*)args.in[3]; F.w_in = (const float*)args.in[4]; F.g_out_sb = (const float*)args.in[5]; F.g_out_mb = (const float*)args.in[6]; F.w_out = (const float*)args.in[7];
    F.g_xattn = (const float*)args.in[8]; F.g_mem = (const float*)args.in[9]; F.w_xq = (const float*)args.in[10]; F.w_xkv = (const float*)args.in[11]; F.w_xo = (const float*)args.in[12];
    F.g_ffn = (const float*)args.in[13]; F.w_gu = (const float*)args.in[14]; F.w_dn = (const float*)args.in[15]; F.g_final = (const float*)args.in[16];
    F.out = args.out; F.ws = args.ws;
    unsigned char* ws = args.ws;
    const int lo = args.ph_lo, hi = args.ph_hi;
    for (int u = F.tid; u < (LDS_BYTES - LDSCTL_OFF) / 4; u += NWAVES * 64) ((LAS unsigned*)(F.lds + LDSCTL_OFF))[u] = 0u;
    __syncthreads();
    if (hi - lo > 1) cg::this_grid().sync();
    XcdBarrier bar = xcd_barrier_post((unsigned*)(ws + WS_CTL) + CW_BAR, (volatile LAS unsigned*)(F.lds + MISC_OFF) + 8);
#define IN(k) (lo <= (k) && (k) < hi)
#define BOTH(k) (IN(k) && IN((k) + 1))
#define GRID_BAR() xcd_barrier(bar)
    float* ssq1 = (float*)(ws + WS_SSQ1); float* ssq2 = (float*)(ws + WS_SSQ2);
    pg8::bf16_t* RA = (pg8::bf16_t*)(ws + WS_RA); pg8::bf16_t* RB = (pg8::bf16_t*)(ws + WS_RB); pg8::bf16_t* RC = (pg8::bf16_t*)(ws + WS_RC);

    if (IN(0)) { for (int rep = 0; rep < REPS(0); ++rep) p0_prologue(F); if (BOTH(0)) GRID_BAR(); }
    if (IN(1)) {
        pg8::Gemm g{RA, (const pg8::bf16_t*)(ws + WS_WIN), M, NQKV, DM}; pg8::StaticOrder S; S.init(M, NQKV, F.G, (int)blockIdx.x);
        pg8::EpiQKV E{RC, (const float*)(ws + WS_CS), QSCALE};
        for (int rep = 0; rep < REPS(1); ++rep) pg8::gemm_phase<pg8::EpiQKV, pg8::StaticOrder, true, true>(F.lds, g, S, E);
        if (BOTH(1)) GRID_BAR();
    }
    if (IN(2)) { for (int rep = 0; rep < REPS(2); ++rep) kmean_phase(F); if (BOTH(2)) GRID_BAR(); }
    if (IN(3)) {
        const att::bf16* qkv = (const att::bf16*)RC; att::bf16* ob = (att::bf16*)RA; const float* kmean = (const float*)(ws + WS_KMEAN);
#if !(USE_MFMA_SB && USE_MFMA_MOBA)
        LAS float* qs = (LAS float*)(F.lds + F.wave * 1024);
        const int gw = F.vcu * NWAVES + F.wave, NGW = F.G * NWAVES;
#endif
#if !USE_MFMA_SB
        for (int i = gw; i < 64 * SEQ; i += NGW) { const int bh = i >> 11, t = (int)(((unsigned)i + (unsigned)(i >> 11) * 997u) & 2047u); naive_sb_row(F, qs, bh, t); }
#endif
#if !USE_MFMA_MOBA
        for (int i = gw; i < 64 * SEQ; i += NGW) { const int bh = i >> 11, t = (int)(((unsigned)i + (unsigned)(i >> 11) * 997u) & 2047u); naive_moba_row(F, qs, bh, t); }
        __syncthreads();
#endif
        for (int rep = 0; rep < REPS(3); ++rep) {
#if USE_MFMA_SB
        for (int vv = F.vcu; vv < 256; vv += F.G) { const int bh = vv >> 2, s = vv & 3, b = bh >> 3, h = bh & 7; const size_t rb = (size_t)b * SEQ;
            for (int i = 0; i < 2; ++i) { const int qb = i ? s : 7 - s; const size_t r0 = rb + (size_t)qb * 256;
                att::attn_unit<2>(qkv + r0 * NQKV + QSB + h * HD, NQKV, qkv + rb * NQKV + KSB + h * HD, qkv + rb * NQKV + VSB + h * HD, NQKV, ob + r0 * DM + h * HD, DM, F.g_out_sb + h * HD, nullptr, qb, 0, (char*)lds); } }
#endif
#if USE_MFMA_MOBA
        for (int vv = F.vcu; vv < 256; vv += F.G) { const int bh = vv >> 2, s = vv & 3, b = bh >> 3, h = bh & 7; const size_t rb = (size_t)b * SEQ;
            for (int i = 0; i < 2; ++i) { const int qb = i ? s : 7 - s; const size_t r0 = rb + (size_t)qb * 256;
                att::attn_unit<1>(qkv + r0 * NQKV + QMB + h * HD, NQKV, qkv + rb * NQKV + KMB + h * HD, qkv + rb * NQKV + VMB + h * HD, NQKV, ob + r0 * DM + NH * HD + h * HD, DM, F.g_out_mb + h * HD, kmean + (size_t)bh * 1024, qb, 0, (char*)lds); } }
#endif
        }
        if (BOTH(3)) GRID_BAR();
    }
    if (IN(4)) {
        pg8::Gemm g{RA, (const pg8::bf16_t*)(ws + WS_WOUT), M, DM, DM}; pg8::StaticOrder S; S.init(M, DM, F.G, (int)blockIdx.x);
        if (REPS(4) == 2) { pg8::EpiRes E0{F.x, F.out, RB, nullptr}; pg8::gemm_phase<pg8::EpiRes, pg8::StaticOrder, true, true>(F.lds, g, S, E0); }
        pg8::EpiRes E{F.x, F.out, RB, ssq1};
        pg8::gemm_phase<pg8::EpiRes, pg8::StaticOrder, true, true>(F.lds, g, S, E);
        if (BOTH(4)) GRID_BAR();
    }
    if (IN(5)) {
      for (int rep = 0; rep < REPS(5); ++rep) {
        { pg8::Gemm g{RB, (const pg8::bf16_t*)(ws + WS_WXQ), M, WX, DM}; pg8::StaticOrder S; S.init(M, WX, F.G, (int)blockIdx.x);
          pg8::EpiScale E{(pg8::bf16_t*)(ws + WS_QX), WX, ssq1, QSCALE};
          pg8::gemm_phase<pg8::EpiScale, pg8::StaticOrder, true, true>(F.lds, g, S, E); }
        { pg8::Gemm g{(const pg8::bf16_t*)(ws + WS_MN), (const pg8::bf16_t*)(ws + WS_WXKV), MMEM, 2 * WX, DM}; pg8::StaticOrder S; S.init(MMEM, 2 * WX, F.G, (int)((blockIdx.x + F.G - 128) % F.G));
          pg8::EpiScale E{(pg8::bf16_t*)(ws + WS_KVX), 2 * WX, nullptr, 1.0f};
          pg8::gemm_phase<pg8::EpiScale, pg8::StaticOrder, true, true>(F.lds, g, S, E); }
      }
        if (BOTH(5)) GRID_BAR();
    }
    if (IN(6)) {
#if USE_MFMA_X
        for (int rep = 0; rep < REPS(6); ++rep) {
        const att::bf16* qx = (const att::bf16*)(ws + WS_QX); const att::bf16* kvx = (const att::bf16*)(ws + WS_KVX); att::bf16* ox = (att::bf16*)(ws + WS_OX);
        for (int vv = F.vcu; vv < 256; vv += F.G) { const int b = vv >> 5, h = (vv >> 3) & 3, qb = vv & 7; const size_t r0 = (size_t)b * SEQ + (size_t)qb * 256;
            att::attn_unit<0>(qx + r0 * WX + h * HD, WX, kvx + (size_t)b * NMEM * (2 * WX) + h * HD, kvx + (size_t)b * NMEM * (2 * WX) + WX + h * HD, 2 * WX, ox + r0 * WX + h * HD, WX, nullptr, nullptr, qb, NMEM, (char*)lds); }
        }
#else
        LAS float* qs = (LAS float*)(F.lds + F.wave * 1024);
        const int gw = F.vcu * NWAVES + F.wave, NGW = F.G * NWAVES;
        for (int i = gw; i < BATCH * 4 * SEQ; i += NGW) { const int t = i & 2047, h = (i >> 11) & 3, b = i >> 13; naive_xattn_row(F, qs, b, h, t); }
#endif
        if (BOTH(6)) GRID_BAR();
    }
    if (IN(7)) {
        pg8::Gemm g{(const pg8::bf16_t*)(ws + WS_OX), (const pg8::bf16_t*)(ws + WS_WXO), M, DM, WX}; pg8::StaticOrder S; S.init(M, DM, F.G, (int)blockIdx.x);
        if (REPS(7) == 2) { pg8::EpiRes E0{F.out, (float*)RC, RB, nullptr}; pg8::gemm_phase<pg8::EpiRes, pg8::StaticOrder, true, true>(F.lds, g, S, E0); }
        pg8::EpiRes E{F.out, F.out, RA, ssq2};
        pg8::gemm_phase<pg8::EpiRes, pg8::StaticOrder, true, true>(F.lds, g, S, E);
        if (BOTH(7)) GRID_BAR();
    }
    if (IN(8)) {
        pg8::Gemm g{RA, (const pg8::bf16_t*)(ws + WS_WGU), M, 2 * FF, DM}; pg8::StaticOrder S; S.init(M, 2 * FF, F.G, (int)blockIdx.x);
        pg8::EpiSwiGLU E{RC, ssq2};
        for (int rep = 0; rep < REPS(8); ++rep) pg8::gemm_phase<pg8::EpiSwiGLU, pg8::StaticOrder, true, true>(F.lds, g, S, E);
        if (BOTH(8)) GRID_BAR();
    }
    if (IN(9)) {
        pg8::Gemm g{RC, (const pg8::bf16_t*)(ws + WS_WDN), M, DM, FF}; pg8::StaticOrder S; S.init(M, DM, F.G, (int)blockIdx.x);
        if (REPS(9) == 2) { pg8::EpiRes E0{F.out, (float*)RA, nullptr, nullptr}; pg8::gemm_phase<pg8::EpiRes, pg8::StaticOrder, true, true>(F.lds, g, S, E0); }
        pg8::EpiRes E{F.out, F.out, nullptr, nullptr};
        pg8::gemm_phase<pg8::EpiRes, pg8::StaticOrder, true, true>(F.lds, g, S, E);
        if (BOTH(9)) GRID_BAR();
    }
    if (IN(10)) { if (REPS(10) == 2) final_norm_phase(F, (float*)RA); final_norm_phase(F, F.out); }
#undef IN
#undef BOTH
}

extern "C" void kernel_launch(void* const* d_in, const int* in_sizes, int n_in, void* d_out, int out_size, void* d_ws, size_t ws_size, hipStream_t stream) {
    static int grid = 0;
    if (grid == 0) {
        if (n_in != 17 || in_sizes[0] != M * DM || out_size != M * DM || ws_size < WS_END) { fprintf(stderr, "kernel_launch: unexpected shapes (n_in %d in0 %d out %d ws %zu)\n", n_in, n_in > 0 ? in_sizes[0] : -1, out_size, ws_size); grid = -1; return; }
        int dev = 0, cus = 0, per_cu = 0;
        if (hipGetDevice(&dev) != hipSuccess || hipDeviceGetAttribute(&cus, hipDeviceAttributeMultiprocessorCount, dev) != hipSuccess) { grid = -1; return; }
        if (hipFuncSetAttribute((const void*)mk_fwd, hipFuncAttributeMaxDynamicSharedMemorySize, LDS_BYTES) != hipSuccess) { fprintf(stderr, "kernel_launch: hipFuncSetAttribute failed\n"); grid = -1; return; }
        if (hipOccupancyMaxActiveBlocksPerMultiprocessor(&per_cu, (const void*)mk_fwd, NWAVES * 64, LDS_BYTES) != hipSuccess || per_cu < 1) { fprintf(stderr, "kernel_launch: occupancy query failed (%d)\n", per_cu); per_cu = 1; }
        (void)hipGetLastError();
        grid = cus * (per_cu < 1 ? 1 : 1);
    }
    if (grid < 0) return;
    (void)hipMemsetAsync((char*)d_ws + WS_CTL, 0, CTL_ZERO_BYTES, stream);
    Args a{};
    for (int i = 0; i < 17; ++i) a.in[i] = d_in[i];
    a.out = (float*)d_out; a.ws = (unsigned char*)d_ws;
#if MK_ONE_LAUNCH
    a.ph_lo = 0; a.ph_hi = NPH;
    void* kargs[] = {&a};
    hipError_t e = hipLaunchCooperativeKernel((const void*)mk_fwd, dim3(grid), dim3(NWAVES * 64), kargs, LDS_BYTES, stream);
    if (e != hipSuccess) fprintf(stderr, "kernel_launch: cooperative launch failed: %s (grid %d)\n", hipGetErrorString(e), grid);
#else
    for (int p = 0; p < NPH; ++p) { a.ph_lo = p; a.ph_hi = p + 1; hipLaunchKernelGGL(mk_fwd, dim3(grid), dim3(NWAVES * 64), LDS_BYTES, stream, a); }
    const hipError_t le = hipPeekAtLastError();
    if (le != hipSuccess) fprintf(stderr, "kernel_launch: launch failed: %s\n", hipGetErrorName(le));
#endif
}
```

```cpp
#include <hip/hip_runtime.h>
#include <hip/hip_cooperative_groups.h>
#include <cstdio>
#include <cstdint>
namespace cg = cooperative_groups;
namespace pg8 {
#define PG8_LAS __attribute__((address_space(3)))
typedef unsigned short bf16_t;
typedef short bf16x8 __attribute__((ext_vector_type(8)));
typedef float f32x4 __attribute__((ext_vector_type(4)));
typedef unsigned u32x4 __attribute__((ext_vector_type(4)));
constexpr int BM = 256, BK = 64, HALF = 128, HTB = HALF * BK * 2  , STAGE_BYTES = 8 * HTB, NXCD = 8, WGM = 8;

__host__ __device__ __forceinline__ int lds_byte(int r, int c) { const int st = (r >> 4) * 2 + (c >> 5), rr = r & 15, cc = c & 31, ob = rr * 64 + cc * 2; return st * 1024 + (ob ^ (((ob >> 9) & 1) << 5)); }
__host__ __device__ __forceinline__ void stage_rc(int b, int& R, int& C) { const int st = b / 1024, sb = b % 1024, swz = sb ^ (((sb >> 9) & 1) << 5); R = (st >> 1) * 16 + swz / 64; C = (st & 1) * 32 + (swz % 64) / 2; }
__host__ __device__ __forceinline__ int perm32(int rho) { const int n = rho >> 4, i = rho & 15; return 8 * (i >> 2) + 4 * n + (i & 3); }

struct Unit { int pm, pn; };
struct Gemm { const bf16_t* A; const bf16_t* Bt; int M, N, K; };

struct StaticOrder {
    int nM, nN, nwg, G, c;
    __host__ __device__ void init(int M, int N, int G_, int c_) { nM = M / BM; nN = N / BM; nwg = nM * nN; G = G_; c = c_; }
    __host__ __device__ bool next(int i, Unit& u) const {
        const long L = (long)i * G + c; if (L >= nwg) return false;
        int wgid = (int)L; { const int q = nwg / NXCD, r = nwg % NXCD, xcd = wgid % NXCD, off = wgid / NXCD; wgid = (xcd < r ? xcd * (q + 1) : r * (q + 1) + (xcd - r) * q) + off; }
        const int nig = WGM * nN, gid = wgid / nig, fm = gid * WGM, gsz = (nM - fm) < WGM ? (nM - fm) : WGM;
        u.pm = fm + ((wgid % nig) % gsz); u.pn = (wgid % nig) / gsz; return true;
    }
    __device__ __forceinline__ void a_ready(const Unit&) const {}
    __device__ __forceinline__ void done(const Unit&) const {}
};

__device__ __forceinline__ unsigned cvt_pk_bf16(float lo, float hi) { unsigned r; asm volatile("v_cvt_pk_bf16_f32 %0, %1, %2" : "=v"(r) : "v"(lo), "v"(hi)); return r; }
typedef float f32x2 __attribute__((ext_vector_type(2)));
template <class Epi, class Sched, bool ALIGN_EPI = false, bool SP2 = false, bool FP8 = false>
__device__ __forceinline__ void gemm_phase(PG8_LAS unsigned char* lds, const Gemm g, const Sched& S, const Epi& E) {
    int tid_ = threadIdx.x; asm volatile("" : "+v"(tid_));
    const int tid = tid_, wid = __builtin_amdgcn_readfirstlane(tid >> 6), lane = tid & 63, wr = wid >> 2, wc = wid & 3, fr = lane & 15, fq = lane >> 4;
    const int K = g.K, nt = K / BK;
    unsigned voffA[2], voffB[2];
#pragma unroll
    for (int i = 0; i < 2; ++i) { int R, C; stage_rc(tid * 16 + i * 8192, R, C); const int Rb = Epi::PERM ? ((R & ~31) + perm32(R & 31)) : R;
        voffA[i] = (unsigned)(R * K + C) * 2u; voffB[i] = (unsigned)(Rb * K + C) * 2u; }
    const size_t kstep = (size_t)(BK * 2);
    const size_t hstep = (size_t)HALF * K * 2;
    const size_t tstep = 2 * hstep;
    const unsigned ldsw = (unsigned)wid * 1024u;
    const int aoff = lds_byte(wr * 64 + fr, fq * 8), boff = lds_byte(wc * 32 + fr, fq * 8);
#define PG8_SA(b, h) (((b) * 2 + (h)) * HTB)
#define PG8_SB(b, h) ((4 + (b) * 2 + (h)) * HTB)
#define PG8_STAGE(bufoff, gbase, voff) do { _Pragma("unroll") for (int _i = 0; _i < 2; ++_i) \
        __builtin_amdgcn_global_load_lds((const unsigned*)((const char*)(gbase) + (voff)[_i]), (PG8_LAS unsigned*)(lds + (bufoff) + ldsw + _i * 8192), 16, 0, 0); } while (0)
#define PG8_LD8(p) __builtin_shufflevector(*(const PG8_LAS i32x4_*)(p), *(const PG8_LAS i32x4_*)((p) + 1024), 0, 1, 2, 3, 4, 5, 6, 7)
#define PG8_LDA(dst, b, h) do { if constexpr (FP8) { _Pragma("unroll") for (int m = 0; m < 4; ++m) dst##8[m] = PG8_LD8(lds + PG8_SA(b, h) + aoff + m * 2048); } \
        else { _Pragma("unroll") for (int m = 0; m < 4; ++m) _Pragma("unroll") for (int k = 0; k < 2; ++k) dst[m][k] = *(const PG8_LAS bf16x8*)(lds + PG8_SA(b, h) + aoff + m * 2048 + k * 1024); } } while (0)
#define PG8_LDB(dst, b, h) do { if constexpr (FP8) { _Pragma("unroll") for (int n = 0; n < 2; ++n) dst##8[n] = PG8_LD8(lds + PG8_SB(b, h) + boff + n * 2048); } \
        else { _Pragma("unroll") for (int n = 0; n < 2; ++n) _Pragma("unroll") for (int k = 0; k < 2; ++k) dst[n][k] = *(const PG8_LAS bf16x8*)(lds + PG8_SB(b, h) + boff + n * 2048 + k * 1024); } } while (0)
#define PG8_MMA(ai, bj, At, Bt) do { __builtin_amdgcn_s_setprio(1); _Pragma("unroll") for (int m = 0; m < 4; ++m) _Pragma("unroll") for (int n = 0; n < 2; ++n) { \
        if constexpr (FP8) asm volatile("v_mfma_scale_f32_16x16x128_f8f6f4 %0, %1, %2, %0, %3, %3 op_sel_hi:[0,0,0]" : "+v"(acc[ai][bj][m][n]) : "v"(Bt##8[n]), "v"(At##8[m]), "v"(sc1_)); \
        else { _Pragma("unroll") for (int k = 0; k < 2; ++k) acc[ai][bj][m][n] = __builtin_amdgcn_mfma_f32_16x16x32_bf16(Bt[n][k], At[m][k], acc[ai][bj][m][n], 0, 0, 0); } } \
        __builtin_amdgcn_s_setprio(0); } while (0)
#define PG8_WAIT_V(n) asm volatile("s_waitcnt vmcnt(" #n ")" ::: "memory")
#define PG8_WAIT_L(n) asm volatile("s_waitcnt lgkmcnt(" #n ")" ::: "memory")
#define PG8_BAR __builtin_amdgcn_s_barrier()
#define PG8_SCHED __builtin_amdgcn_sched_barrier(0)
    Unit cur, nxt; int ui = 0;
    if (!S.next(0, cur)) return;
    f32x4 acc[2][2][4][2];
#pragma unroll
    for (int a = 0; a < 2; ++a)
#pragma unroll
        for (int b = 0; b < 2; ++b)
#pragma unroll
            for (int m = 0; m < 4; ++m)
#pragma unroll
                for (int n = 0; n < 2; ++n) acc[a][b][m][n] = (f32x4){0.f, 0.f, 0.f, 0.f};
    typedef int i32x4_ __attribute__((ext_vector_type(4))); typedef int i32x8_ __attribute__((ext_vector_type(8)));
    int sc1_ = 0x7F7F7F7F; asm volatile("" : "+v"(sc1_));
    bf16x8 At[4][2], B0[2][2], B1[2][2]; i32x8_ At8[4], B08[2], B18[2];
    const char* cA = (const char*)g.A + (size_t)cur.pm * tstep; const char* cB = (const char*)g.Bt + (size_t)cur.pn * tstep;
    S.a_ready(cur);
    if constexpr (SP2) {
        PG8_STAGE(PG8_SB(0, 0), cB, voffB); PG8_STAGE(PG8_SB(0, 1), cB + hstep, voffB); PG8_STAGE(PG8_SA(0, 0), cA, voffA); PG8_STAGE(PG8_SA(0, 1), cA + hstep, voffA);
        if (wr == 1) PG8_BAR;
        PG8_WAIT_V(2); PG8_BAR;
        PG8_STAGE(PG8_SB(1, 0), cB + kstep, voffB); PG8_STAGE(PG8_SA(1, 0), cA + kstep, voffA); PG8_STAGE(PG8_SB(1, 1), cB + hstep + kstep, voffB);
        PG8_WAIT_V(6); PG8_BAR;
    } else {
        PG8_STAGE(PG8_SB(0, 0), cB, voffB); PG8_STAGE(PG8_SA(0, 0), cA, voffA); PG8_STAGE(PG8_SB(0, 1), cB + hstep, voffB); PG8_STAGE(PG8_SA(0, 1), cA + hstep, voffA);
        if (wr == 1) PG8_BAR;
        PG8_WAIT_V(4); PG8_BAR;
        PG8_STAGE(PG8_SB(1, 0), cB + kstep, voffB); PG8_STAGE(PG8_SA(1, 0), cA + kstep, voffA); PG8_STAGE(PG8_SB(1, 1), cB + hstep + kstep, voffB);
        PG8_WAIT_V(6); PG8_BAR;
    }
    for (;;) {
        const bool has_next = S.next(ui + 1, nxt);
        const char* nA = has_next ? (const char*)g.A + (size_t)nxt.pm * tstep : cA; const char* nB = has_next ? (const char*)g.Bt + (size_t)nxt.pn * tstep : cB;
        for (int t = 0; t < nt; t += 2) {
            const bool last = (t == nt - 2);
            const char* a1 = cA + (size_t)(t + 1) * kstep;
            const char* a2 = last ? nA : cA + (size_t)(t + 2) * kstep; const char* b2 = last ? nB : cB + (size_t)(t + 2) * kstep;
            const char* a3 = a2 + kstep; const char* b3 = b2 + kstep;
            if (last && has_next) S.a_ready(nxt);
            if constexpr (SP2) {
            PG8_LDB(B0, 0, 0); PG8_LDB(B1, 0, 1); PG8_SCHED; PG8_LDA(At, 0, 0); PG8_STAGE(PG8_SA(1, 1), a1 + hstep, voffA);
            PG8_WAIT_V(8); PG8_WAIT_L(0); PG8_BAR; PG8_MMA(0, 0, At, B0); PG8_MMA(0, 1, At, B1); PG8_BAR; PG8_SCHED;
            PG8_LDA(At, 0, 1); PG8_STAGE(PG8_SB(0, 0), b2, voffB); PG8_STAGE(PG8_SB(0, 1), b2 + hstep, voffB); PG8_STAGE(PG8_SA(0, 0), a2, voffA);
            PG8_WAIT_V(8); PG8_WAIT_L(0); PG8_BAR; PG8_MMA(1, 0, At, B0); PG8_MMA(1, 1, At, B1); PG8_BAR; PG8_SCHED;
            PG8_LDB(B0, 1, 0); PG8_LDB(B1, 1, 1); PG8_SCHED; PG8_LDA(At, 1, 0); PG8_STAGE(PG8_SA(0, 1), a2 + hstep, voffA);
            PG8_WAIT_V(8); PG8_WAIT_L(0); PG8_BAR; PG8_MMA(0, 0, At, B0); PG8_MMA(0, 1, At, B1); PG8_BAR; PG8_SCHED;
            PG8_LDA(At, 1, 1); PG8_STAGE(PG8_SB(1, 0), b3, voffB); PG8_STAGE(PG8_SB(1, 1), b3 + hstep, voffB); PG8_STAGE(PG8_SA(1, 0), a3, voffA);
            PG8_WAIT_V(8); PG8_WAIT_L(0); PG8_BAR; PG8_MMA(1, 0, At, B0); PG8_MMA(1, 1, At, B1); PG8_BAR; PG8_SCHED;
            } else {
            PG8_LDB(B0, 0, 0); PG8_SCHED; PG8_LDA(At, 0, 0); PG8_STAGE(PG8_SA(1, 1), a1 + hstep, voffA);
            PG8_WAIT_L(8); PG8_BAR; PG8_WAIT_L(0); PG8_MMA(0, 0, At, B0); PG8_BAR; PG8_SCHED;
            PG8_LDB(B1, 0, 1); PG8_STAGE(PG8_SB(0, 0), b2, voffB);
            PG8_BAR; PG8_WAIT_L(0); PG8_MMA(0, 1, At, B1); PG8_BAR;
            PG8_LDA(At, 0, 1); PG8_STAGE(PG8_SA(0, 0), a2, voffA);
            PG8_BAR; PG8_WAIT_L(0); PG8_MMA(1, 0, At, B0); PG8_BAR; PG8_SCHED;
            PG8_STAGE(PG8_SB(0, 1), b2 + hstep, voffB);
            PG8_WAIT_V(6); PG8_BAR; PG8_MMA(1, 1, At, B1); PG8_BAR;
            PG8_LDB(B0, 1, 0); PG8_SCHED; PG8_LDA(At, 1, 0); PG8_STAGE(PG8_SA(0, 1), a2 + hstep, voffA);
            PG8_WAIT_L(8); PG8_BAR; PG8_WAIT_L(0); PG8_MMA(0, 0, At, B0); PG8_BAR; PG8_SCHED;
            PG8_LDB(B1, 1, 1); PG8_STAGE(PG8_SB(1, 0), b3, voffB);
            PG8_BAR; PG8_WAIT_L(0); PG8_MMA(0, 1, At, B1); PG8_BAR;
            PG8_LDA(At, 1, 1); PG8_STAGE(PG8_SA(1, 0), a3, voffA);
            PG8_BAR; PG8_WAIT_L(0); PG8_MMA(1, 0, At, B0); PG8_BAR; PG8_SCHED;
            PG8_STAGE(PG8_SB(1, 1), b3 + hstep, voffB);
            PG8_WAIT_V(6); PG8_BAR; PG8_MMA(1, 1, At, B1); PG8_BAR;
            }
        }
        if constexpr (ALIGN_EPI) { if (wr == 0) PG8_BAR; }
        if constexpr (FP8) asm volatile("s_nop 15\n\ts_nop 15" ::: "memory");
        if constexpr (!Epi::AFTER_DRAIN) { E(acc, cur, wr, wc, fr, fq); S.done(cur); }
        if (!has_next) break;
#pragma unroll
        for (int a = 0; a < 2; ++a)
#pragma unroll
            for (int b = 0; b < 2; ++b)
#pragma unroll
                for (int m = 0; m < 4; ++m)
#pragma unroll
                    for (int n = 0; n < 2; ++n) acc[a][b][m][n] = (f32x4){0.f, 0.f, 0.f, 0.f};
        cur = nxt; cA = nA; cB = nB; ++ui;
        if constexpr (ALIGN_EPI) { if (wr == 1) PG8_BAR; }
    }
    PG8_WAIT_V(0);
    if constexpr (!ALIGN_EPI) { if (wr == 0) PG8_BAR; }
    PG8_BAR;
    if constexpr (Epi::AFTER_DRAIN) { E.fused(acc, cur, wr, wc, fr, fq, lds, wid, lane); S.done(cur); }
#undef PG8_SA
#undef PG8_SB
#undef PG8_STAGE
#undef PG8_LDA
#undef PG8_LD8
#undef PG8_LDB
#undef PG8_MMA
#undef PG8_WAIT_V
#undef PG8_WAIT_L
#undef PG8_BAR
#undef PG8_SCHED
}
}
namespace pg8 {
typedef unsigned u32x2 __attribute__((ext_vector_type(2)));
constexpr int LDX = 2048;
constexpr float RMS_EPS = 1e-6f;
struct EpiQKV {
    static constexpr bool PERM = true, AFTER_DRAIN = false;
    bf16_t* O; const float* cs; float qscale;
    __device__ __forceinline__ void operator()(const f32x4 (&acc)[2][2][4][2], const Unit& u, int wr, int wc, int fr, int fq) const {
        const int row0 = u.pm * BM + wr * 64 + fr, col0 = u.pn * BM + wc * 32 + 8 * fq, pn = u.pn;
        const float sc = (pn < 4 || (pn >= 12 && pn < 16)) ? qscale : 1.f;
        const bool rot = (pn >= 12 && pn < 20) && (wc == 0);
#pragma unroll
        for (int ai = 0; ai < 2; ++ai)
#pragma unroll
            for (int m = 0; m < 4; ++m) { const int row = row0 + ai * HALF + m * 16; bf16_t* rowp = O + (size_t)row * 6144 + col0;
                f32x4 c0 = {1.f, 1.f, 1.f, 1.f}, c1 = c0, s0 = {0.f, 0.f, 0.f, 0.f}, s1 = s0;
                if (rot) { const float* cr = cs + (size_t)row * 32 + 8 * (fq & 1); c0 = *(const f32x4*)cr; c1 = *(const f32x4*)(cr + 4); s0 = *(const f32x4*)(cr + 16); s1 = *(const f32x4*)(cr + 20);
                    if (fq < 2) { s0 = -s0; s1 = -s1; } }
#pragma unroll
                for (int bj = 0; bj < 2; ++bj) { f32x4 v0 = acc[ai][bj][m][0], v1 = acc[ai][bj][m][1];
                    if (rot) { f32x4 p0, p1;
#pragma unroll
                        for (int j = 0; j < 4; ++j) { p0[j] = __shfl_xor(v0[j], 32); p1[j] = __shfl_xor(v1[j], 32); }
                        v0 = v0 * c0 + p0 * s0; v1 = v1 * c1 + p1 * s1; }
                    v0 = v0 * sc; v1 = v1 * sc; u32x4 w; w.x = cvt_pk_bf16(v0[0], v0[1]); w.y = cvt_pk_bf16(v0[2], v0[3]); w.z = cvt_pk_bf16(v1[0], v1[1]); w.w = cvt_pk_bf16(v1[2], v1[3]);
                    *(u32x4*)(rowp + bj * HALF) = w; } }
    }
};
__device__ __forceinline__ unsigned pk4_fp8(float a, float b, float c, float d) {
    a = __builtin_amdgcn_fmed3f(a, -448.f, 448.f); b = __builtin_amdgcn_fmed3f(b, -448.f, 448.f); c = __builtin_amdgcn_fmed3f(c, -448.f, 448.f); d = __builtin_amdgcn_fmed3f(d, -448.f, 448.f);
    int p = __builtin_amdgcn_cvt_pk_fp8_f32(a, b, 0, false); p = __builtin_amdgcn_cvt_pk_fp8_f32(c, d, p, true); return (unsigned)p; }
struct EpiRes {
    static constexpr bool PERM = false, AFTER_DRAIN = false;
    const float* base; float* out; bf16_t* xb; float* ssq; unsigned char* x8; float s8; float ascale;
    __device__ __forceinline__ void operator()(const f32x4 (&acc)[2][2][4][2], const Unit& u, int wr, int wc, int fr, int fq) const {
        const int row0 = u.pm * BM + wr * 64 + fr, col0 = u.pn * BM + wc * 32 + 4 * fq;
#pragma unroll
        for (int ai = 0; ai < 2; ++ai)
#pragma unroll
            for (int m = 0; m < 4; ++m) { const int row = row0 + ai * HALF + m * 16; const size_t off = (size_t)row * LDX + col0; float s = 0.f;
#pragma unroll
                for (int bj = 0; bj < 2; ++bj)
#pragma unroll
                    for (int n = 0; n < 2; ++n) { const f32x4 v = *(const f32x4*)(base + off + bj * HALF + n * 16) + acc[ai][bj][m][n] * ascale;
                        *(f32x4*)(out + off + bj * HALF + n * 16) = v; s += (v[0] * v[0] + v[1] * v[1]) + (v[2] * v[2] + v[3] * v[3]);
                        if (xb) { u32x2 w; w.x = cvt_pk_bf16(v[0], v[1]); w.y = cvt_pk_bf16(v[2], v[3]); *(u32x2*)(xb + off + bj * HALF + n * 16) = w; }
                        if (x8) { *(unsigned*)(x8 + off + bj * HALF + n * 16) = pk4_fp8(v[0] * s8, v[1] * s8, v[2] * s8, v[3] * s8); } }
                if (ssq) { s += __shfl_xor(s, 16); s += __shfl_xor(s, 32); if (fq == 0) atomicAdd(ssq + row, s); }
                asm volatile("" ::: "memory"); }
    }
};
struct EpiScale {
    static constexpr bool PERM = true, AFTER_DRAIN = false;
    bf16_t* O; int ldc; const float* ssq; float sc;
    __device__ __forceinline__ void operator()(const f32x4 (&acc)[2][2][4][2], const Unit& u, int wr, int wc, int fr, int fq) const {
        const int row0 = u.pm * BM + wr * 64 + fr, col0 = u.pn * BM + wc * 32 + 8 * fq;
#pragma unroll
        for (int ai = 0; ai < 2; ++ai)
#pragma unroll
            for (int m = 0; m < 4; ++m) { const int row = row0 + ai * HALF + m * 16; bf16_t* rowp = O + (size_t)row * ldc + col0;
                const float f = ssq ? sc * __builtin_amdgcn_rsqf(ssq[row] * (1.0f / 2048.0f) + RMS_EPS) : sc;
#pragma unroll
                for (int bj = 0; bj < 2; ++bj) { const f32x4 v0 = acc[ai][bj][m][0] * f, v1 = acc[ai][bj][m][1] * f;
                    u32x4 w; w.x = cvt_pk_bf16(v0[0], v0[1]); w.y = cvt_pk_bf16(v0[2], v0[3]); w.z = cvt_pk_bf16(v1[0], v1[1]); w.w = cvt_pk_bf16(v1[2], v1[3]);
                    *(u32x4*)(rowp + bj * HALF) = w; } }
    }
};
struct EpiSwiGLU {
    static constexpr bool PERM = true, AFTER_DRAIN = false;
    bf16_t* O; const float* ssq; unsigned char* O8; float ascale, oscale;
    __device__ __forceinline__ void operator()(const f32x4 (&acc)[2][2][4][2], const Unit& u, int wr, int wc, int fr, int fq) const {
        const int row0 = u.pm * BM + wr * 64 + fr, col0 = u.pn * HALF + wc * 32 + 8 * fq;
#pragma unroll
        for (int ai = 0; ai < 2; ++ai)
#pragma unroll
            for (int m = 0; m < 4; ++m) { const int row = row0 + ai * HALF + m * 16; bf16_t* rowp = O + (size_t)row * 5632 + col0;
                const float f = ascale * __builtin_amdgcn_rsqf(ssq[row] * (1.0f / 2048.0f) + RMS_EPS);
                float r[8];
#pragma unroll
                for (int n = 0; n < 2; ++n)
#pragma unroll
                    for (int j = 0; j < 4; ++j) { const float g = acc[ai][0][m][n][j] * f, uu = acc[ai][1][m][n][j] * f;
                        const float sg = g * __builtin_amdgcn_rcpf(1.0f + __builtin_amdgcn_exp2f(-1.4426950408889634f * g)); r[n * 4 + j] = sg * uu; }
                if (O8) { u32x2 w8; w8.x = pk4_fp8(r[0] * oscale, r[1] * oscale, r[2] * oscale, r[3] * oscale); w8.y = pk4_fp8(r[4] * oscale, r[5] * oscale, r[6] * oscale, r[7] * oscale);
                    *(u32x2*)(O8 + (size_t)row * 5632 + col0) = w8; }
                else { u32x4 w; w.x = cvt_pk_bf16(r[0], r[1]); w.y = cvt_pk_bf16(r[2], r[3]); w.z = cvt_pk_bf16(r[4], r[5]); w.w = cvt_pk_bf16(r[6], r[7]);
                *(u32x4*)rowp = w; } }
    }
};
}
namespace att {
using bf16x8 = __attribute__((ext_vector_type(8))) short;
using s16x4  = __attribute__((ext_vector_type(4))) short;
using f32x16 = __attribute__((ext_vector_type(16))) float;
using f32x4  = __attribute__((ext_vector_type(4))) float;
using u32x4  = __attribute__((ext_vector_type(4))) unsigned;
typedef unsigned short bf16;
constexpr int D = 128, KVBLK = 64;
constexpr int SHM_V = KVBLK * D * 2, SHM_K = KVBLK * D * 2;
constexpr int OFF_WS = 2 * SHM_V + 2 * SHM_K, OFF_KM = OFF_WS + 2048, ATT_LDS = OFF_KM + 4096;
constexpr float THR = 8.f;
#define KSWZ(row, colB) ((row) * 256 + ((colB) ^ (((row) & 7) << 4)))
#define SBAR() __builtin_amdgcn_sched_barrier(0)
__device__ __forceinline__ int crow(int r, int hi) { return (r & 3) + 8 * (r >> 2) + 4 * hi; }
__device__ __forceinline__ unsigned cvtpk(float lo, float hi) { unsigned r; asm volatile("v_cvt_pk_bf16_f32 %0, %1, %2" : "=v"(r) : "v"(lo), "v"(hi)); return r; }
__device__ __forceinline__ float xchg32(float x, int hi) { auto rr = __builtin_amdgcn_permlane32_swap(__float_as_uint(x), __float_as_uint(x), false, false); return __uint_as_float(hi ? rr[0] : rr[1]); }
__device__ __forceinline__ void qkt(f32x16& p0, f32x16& p1, const char* Ks, const bf16x8* qr, int r32, int hi) {
  p0 = f32x16{}; p1 = f32x16{};
#pragma unroll
  for (int d0 = 0; d0 < 8; ++d0) { int cb = (d0 * 16 + hi * 8) * 2;
    bf16x8 b0 = *reinterpret_cast<const bf16x8*>(Ks + KSWZ(r32, cb));
    bf16x8 b1 = *reinterpret_cast<const bf16x8*>(Ks + KSWZ(32 + r32, cb));
    p0 = __builtin_amdgcn_mfma_f32_32x32x16_bf16(b0, qr[d0], p0, 0, 0, 0);
    p1 = __builtin_amdgcn_mfma_f32_32x32x16_bf16(b1, qr[d0], p1, 0, 0, 0); }
}
__device__ __forceinline__ int v_st(int k, int c) { const int kk = (k & ~0xC) | ((k & 4) << 1) | ((k & 8) >> 1); return ((kk >> 3) * 4 + (c >> 5)) * 512 + ((kk & 7) * 32 + (c & 31)) * 2; }
__device__ __forceinline__ int v_rd_base(int lane) { return ((lane & 3) << 3) | (((lane >> 2) & 3) << 6) | (((lane >> 4) & 1) << 5) | (((lane >> 5) & 1) << 8); }
constexpr int v_rd_off(int d0, int ks, int half) { return d0 * 512 + ks * 4096 + half * 2048; }
template <int OFF> __device__ __forceinline__ s16x4 tr_read(int vb) { s16x4 r; asm volatile("ds_read_b64_tr_b16 %0, %1 offset:%2" : "=&v"(r) : "v"(vb), "i"(OFF) : "memory"); return r; }
template <int D0> __device__ __forceinline__ void pv_one(f32x16& od, int vb, bf16x8 pa0, bf16x8 pa1, bf16x8 pa2, bf16x8 pa3) {
  const s16x4 l0 = tr_read<v_rd_off(D0, 0, 0)>(vb), h0 = tr_read<v_rd_off(D0, 0, 1)>(vb), l1 = tr_read<v_rd_off(D0, 1, 0)>(vb), h1 = tr_read<v_rd_off(D0, 1, 1)>(vb);
  const s16x4 l2 = tr_read<v_rd_off(D0, 2, 0)>(vb), h2 = tr_read<v_rd_off(D0, 2, 1)>(vb), l3 = tr_read<v_rd_off(D0, 3, 0)>(vb), h3 = tr_read<v_rd_off(D0, 3, 1)>(vb);
  asm volatile("s_waitcnt lgkmcnt(0)" ::: "memory"); SBAR();
#define PK(L, H) (bf16x8){L[0], L[1], L[2], L[3], H[0], H[1], H[2], H[3]}
  od = __builtin_amdgcn_mfma_f32_32x32x16_bf16(pa0, PK(l0, h0), od, 0, 0, 0);
  od = __builtin_amdgcn_mfma_f32_32x32x16_bf16(pa1, PK(l1, h1), od, 0, 0, 0);
  od = __builtin_amdgcn_mfma_f32_32x32x16_bf16(pa2, PK(l2, h2), od, 0, 0, 0);
  od = __builtin_amdgcn_mfma_f32_32x32x16_bf16(pa3, PK(l3, h3), od, 0, 0, 0);
#undef PK
}
__device__ __forceinline__ void pv_d0(f32x16* o, int vb, bf16x8 pa0, bf16x8 pa1, bf16x8 pa2, bf16x8 pa3) {
  pv_one<0>(o[0], vb, pa0, pa1, pa2, pa3); pv_one<1>(o[1], vb, pa0, pa1, pa2, pa3); pv_one<2>(o[2], vb, pa0, pa1, pa2, pa3); pv_one<3>(o[3], vb, pa0, pa1, pa2, pa3);
}
__device__ __forceinline__ void pack_p(const f32x16& p0, const f32x16& p1, bf16x8& pa0, bf16x8& pa1, bf16x8& pa2, bf16x8& pa3) {
#define PK4(P, BASE, OUT) do { unsigned a0 = cvtpk(P[BASE + 0], P[BASE + 1]), a1 = cvtpk(P[BASE + 2], P[BASE + 3]);   \
    unsigned b0 = cvtpk(P[BASE + 4], P[BASE + 5]), b1 = cvtpk(P[BASE + 6], P[BASE + 7]);                              \
    auto r0 = __builtin_amdgcn_permlane32_swap(a0, b0, false, false); auto r1 = __builtin_amdgcn_permlane32_swap(a1, b1, false, false); \
    u32x4 w = {r0[0], r1[0], r0[1], r1[1]}; OUT = *reinterpret_cast<bf16x8*>(&w); } while (0)
  PK4(p0, 0, pa0); PK4(p0, 8, pa1); PK4(p1, 0, pa2); PK4(p1, 8, pa3);
#undef PK4
}
__device__ __forceinline__ void softmax_tile(f32x16& p0, f32x16& p1, float& m_reg, float& l_reg, float& alpha) {
  float pmax = p0[0];
#pragma unroll
  for (int r = 1; r < 16; ++r) pmax = fmaxf(pmax, p0[r]);
#pragma unroll
  for (int r = 0; r < 16; ++r) pmax = fmaxf(pmax, p1[r]);
  pmax = fmaxf(pmax, xchg32(pmax, (int)(threadIdx.x >> 5) & 1));
  if (__all(pmax - m_reg <= THR)) { alpha = 1.f; }
  else { const float mn = fmaxf(m_reg, pmax); alpha = __builtin_amdgcn_exp2f(m_reg - mn); m_reg = mn; }
  float ps = 0.f;
#pragma unroll
  for (int r = 0; r < 16; ++r) { p0[r] = __builtin_amdgcn_exp2f(p0[r] - m_reg); ps += p0[r]; }
#pragma unroll
  for (int r = 0; r < 16; ++r) { p1[r] = __builtin_amdgcn_exp2f(p1[r] - m_reg); ps += p1[r]; }
  ps += xchg32(ps, (int)(threadIdx.x >> 5) & 1);
  l_reg = l_reg * alpha + ps;
}
__device__ __forceinline__ float softplus2(float y) { return fmaxf(y, 0.f) + __builtin_amdgcn_logf(1.0f + __builtin_amdgcn_exp2f(-fabsf(y))); }
__device__ __forceinline__ void sb_tile(f32x16& p0, f32x16& p1, float& carry, bool band, int kb, int qrel, int hi) {
  float gs[8];
#pragma unroll
  for (int i = 0; i < 4; ++i) { float run = 0.f;
#pragma unroll
    for (int e = 3; e >= 0; --e) { const int r = 4 * i + e; const bool valid = !band || (kb + crow(r, hi) < qrel); const float y = p0[r];
      const float sp = valid ? softplus2(y) : 0.f; run += sp; p0[r] = valid ? (y - run) : -INFINITY; }
    gs[i] = run; }
#pragma unroll
  for (int i = 0; i < 4; ++i) { float run = 0.f;
#pragma unroll
    for (int e = 3; e >= 0; --e) { const int r = 4 * i + e; const bool valid = !band || (kb + 32 + crow(r, hi) < qrel); const float y = p1[r];
      const float sp = valid ? softplus2(y) : 0.f; run += sp; p1[r] = valid ? (y - run) : -INFINITY; }
    gs[4 + i] = run; }
  float acc = 0.f;
#pragma unroll
  for (int i = 7; i >= 0; --i) { const float so_i = acc; acc += gs[i]; const float x = hi ? acc : so_i; gs[i] = carry + so_i + xchg32(x, hi); }
  const float tot = acc, ptot = xchg32(acc, hi);
#pragma unroll
  for (int i = 0; i < 4; ++i)
#pragma unroll
    for (int e = 0; e < 4; ++e) { p0[4 * i + e] = __builtin_amdgcn_exp2f(p0[4 * i + e] - gs[i]); p1[4 * i + e] = __builtin_amdgcn_exp2f(p1[4 * i + e] - gs[4 + i]); }
  carry += tot + ptot;
}

template <int MODE>
__device__ __forceinline__ void attn_unit(const bf16* __restrict__ Qb, int ldq, const bf16* __restrict__ Kh, const bf16* __restrict__ Vh, int ldk, bf16* __restrict__ Ob, int ldo,
                                          const float* __restrict__ gain, const float* __restrict__ kmean, int qb, int nkeys, char* lds) {
  int tid_ = threadIdx.x; asm volatile("" : "+v"(tid_));
  const int tid = tid_, wid = __builtin_amdgcn_readfirstlane(tid >> 6), lane = tid & 63, r32 = lane & 31, hi = lane >> 5;
  char* V_lds = lds; char* K_lds = lds + 2 * SHM_V;
  float* ws = (float*)(lds + OFF_WS) + wid * 64; float* li_l = ws; float* al_l = ws + 32;
  float* km_l = (float*)(lds + OFF_KM);
  const int NT = (MODE == 0) ? nkeys / KVBLK : 4 * (qb + 1);
  const int qrel = wid * 32 + r32;
  float m_reg = -1e30f, l_reg = 0.f, carry = 0.f; f32x16 o[4] = {}; bf16x8 qr[8];
  const bf16* Qw = Qb + (long)(wid * 32 + r32) * ldq + hi * 8;
#pragma unroll
  for (int d0 = 0; d0 < 8; ++d0) qr[d0] = *reinterpret_cast<const bf16x8*>(Qw + d0 * 16);
  const int vb0 = (int)(uintptr_t)V_lds + v_rd_base(lane);
  long ksrc[2], vsrc[2];
#pragma unroll
  for (int i = 0; i < 2; ++i) { const int piece = wid + 8 * i;
    { const int row = piece * 4 + (lane >> 4), c = (lane & 15) ^ (row & 7); ksrc[i] = (long)row * ldk + c * 8; }
    { const int sub = piece * 2 + (lane >> 5), kk = (sub >> 2) * 8 + ((lane & 31) >> 2), k = (kk & ~0xC) | ((kk & 4) << 1) | ((kk & 8) >> 1), c = (sub & 3) * 32 + (lane & 3) * 8; vsrc[i] = (long)k * ldk + c; } }
  typedef __attribute__((address_space(3))) unsigned lds_u32;
  lds_u32* kdst = (lds_u32*)(__attribute__((address_space(3))) char*)(K_lds) + wid * 256; lds_u32* vdst = (lds_u32*)(__attribute__((address_space(3))) char*)(V_lds) + wid * 256;
#define TILE(it) ((MODE == 2) ? (NT - 1 - (it)) : (it))
#define SDMA(k0, b) do { _Pragma("unroll") for (int i_ = 0; i_ < 2; ++i_) { \
    __builtin_amdgcn_global_load_lds((const unsigned*)(Kh + (long)(k0) * ldk + ksrc[i_]), kdst + (b) * (SHM_K / 4) + i_ * 2048, 16, 0, 0); \
    __builtin_amdgcn_global_load_lds((const unsigned*)(Vh + (long)(k0) * ldk + vsrc[i_]), vdst + (b) * (SHM_V / 4) + i_ * 2048, 16, 0, 0); } } while (0)
#define SDRAIN() asm volatile("s_waitcnt vmcnt(0)" ::: "memory")
  SDMA(TILE(0) * KVBLK, 0);
  unsigned selmask = 0u;
  if (MODE == 1) { if (tid < 256) *(f32x4*)(km_l + tid * 4) = *(const f32x4*)(kmean + tid * 4); }
  SDRAIN();
  __syncthreads();
  if (MODE == 1) {
    float g[8];
#pragma unroll
    for (int n = 0; n < 8; ++n) g[n] = 0.f;
#pragma unroll
    for (int d0 = 0; d0 < 8; ++d0) { float q[8];
#pragma unroll
      for (int j = 0; j < 8; ++j) q[j] = __uint_as_float(((unsigned)(unsigned short)qr[d0][j]) << 16);
#pragma unroll
      for (int n = 0; n < 7; ++n) { const f32x4 ka = *(const f32x4*)(km_l + n * 128 + d0 * 16 + hi * 8), kb2 = *(const f32x4*)(km_l + n * 128 + d0 * 16 + hi * 8 + 4);
        g[n] += (q[0] * ka[0] + q[1] * ka[1]) + (q[2] * ka[2] + q[3] * ka[3]) + (q[4] * kb2[0] + q[5] * kb2[1]) + (q[6] * kb2[2] + q[7] * kb2[3]); } }
#pragma unroll
    for (int n = 0; n < 7; ++n) { g[n] += xchg32(g[n], hi); if (n >= qb) g[n] = -INFINITY; }
    g[7] = -INFINITY;
#pragma unroll
    for (int n = 0; n < 7; ++n) { int cnt = 0;
#pragma unroll
      for (int mI = 0; mI < 7; ++mI) { if (mI != n) cnt += (g[mI] > g[n] || (g[mI] == g[n] && mI < n)) ? 1 : 0; }
      if (n < qb && cnt < 3) selmask |= (1u << n); }
  }
  for (int it = 0; it < NT; ++it) {
    const int j = TILE(it), buf = it & 1;
    if (it + 1 < NT) SDMA(TILE(it + 1) * KVBLK, buf ^ 1);
    const int jb = j - (NT - 4);
    bool skip = false;
    if (MODE == 1) skip = (jb >= 0) && (64 * jb > wid * 32 + 31);
    if (MODE == 2) skip = (jb >= 0) && (64 * jb >= wid * 32 + 31);
    if (!skip) {
      f32x16 p0, p1; bf16x8 pa0, pa1, pa2, pa3;
      qkt(p0, p1, K_lds + buf * SHM_K, qr, r32, hi);
      if (MODE == 2) {
        sb_tile(p0, p1, carry, jb >= 0, 64 * jb, qrel, hi);
      } else {
        if (MODE == 1) {
          if (jb < 0) { const bool s = (selmask >> (j >> 2)) & 1u;
#pragma unroll
            for (int r = 0; r < 16; ++r) { p0[r] = s ? p0[r] : -INFINITY; p1[r] = s ? p1[r] : -INFINITY; } }
          else {
#pragma unroll
            for (int r = 0; r < 16; ++r) { const int kr = 64 * jb + crow(r, hi); if (kr > qrel) p0[r] = -INFINITY; if (kr + 32 > qrel) p1[r] = -INFINITY; } }
        }
        float alpha; softmax_tile(p0, p1, m_reg, l_reg, alpha);
        if (__any(alpha < 1.f)) { if (hi == 0) al_l[r32] = alpha; asm volatile("s_waitcnt lgkmcnt(0)" ::: "memory");
#pragma unroll
          for (int d = 0; d < 4; ++d)
#pragma unroll
            for (int r = 0; r < 16; ++r) o[d][r] *= al_l[crow(r, hi)]; }
      }
      pack_p(p0, p1, pa0, pa1, pa2, pa3);
      pv_d0(o, vb0 + buf * SHM_V, pa0, pa1, pa2, pa3);
    }
    SDRAIN();
    __syncthreads();
  }
  float rli[16];
  if (MODE != 2) { if (hi == 0) li_l[r32] = l_reg; asm volatile("s_waitcnt lgkmcnt(0)" ::: "memory");
#pragma unroll
    for (int r = 0; r < 16; ++r) rli[r] = __builtin_amdgcn_rcpf(li_l[crow(r, hi)]); }
  else {
#pragma unroll
    for (int r = 0; r < 16; ++r) rli[r] = 1.f; }
  if (gain) {
    float gv[4];
#pragma unroll
    for (int d0 = 0; d0 < 4; ++d0) gv[d0] = gain[d0 * 32 + r32];
#pragma unroll
    for (int r = 0; r < 16; ++r) { float s = 0.f;
#pragma unroll
      for (int d0 = 0; d0 < 4; ++d0) { o[d0][r] *= rli[r]; s += o[d0][r] * o[d0][r]; }
      s += __shfl_xor(s, 1); s += __shfl_xor(s, 2); s += __shfl_xor(s, 4); s += __shfl_xor(s, 8); s += __shfl_xor(s, 16);
      rli[r] = __builtin_amdgcn_rsqf(s * (1.0f / 128.0f) + 1e-6f); }
#pragma unroll
    for (int r = 0; r < 16; ++r)
#pragma unroll
      for (int d0 = 0; d0 < 4; ++d0) o[d0][r] *= gv[d0];
  }
  { bf16* stg = (bf16*)lds + wid * 4096;
#pragma unroll
    for (int r = 0; r < 16; ++r) { const int orow = crow(r, hi);
#pragma unroll
      for (int d0 = 0; d0 < 4; ++d0) { const float v = o[d0][r] * rli[r]; unsigned u = __float_as_uint(v); u = (u + 0x7fffu + ((u >> 16) & 1u)) >> 16; stg[orow * 128 + d0 * 32 + r32] = (bf16)u; } }
    asm volatile("s_waitcnt lgkmcnt(0)" ::: "memory");
#pragma unroll
    for (int i = 0; i < 8; ++i) { const int row = i * 4 + (lane >> 4), ch = lane & 15; const u32x4 v = *(const u32x4*)(stg + row * 128 + ch * 8); *(u32x4*)(Ob + (long)(wid * 32 + row) * ldo + ch * 8) = v; } }
  __syncthreads();
#undef TILE
#undef SDMA
#undef SDRAIN
}
#undef KSWZ
#undef SBAR
}
#define GAS __attribute__((address_space(1)))
#define LAS __attribute__((address_space(3)))
typedef unsigned short bf16;
typedef unsigned v4u __attribute__((ext_vector_type(4)));
typedef float f32x4 __attribute__((ext_vector_type(4)));
#define LDS_WAIT() asm volatile("s_waitcnt lgkmcnt(0)" ::: "memory")
constexpr int NWAVES = 8;
constexpr int BATCH = 8, SEQ = 2048, DM = 2048, M = BATCH * SEQ, HD = 128, NH = 8;
constexpr int NQKV = 6144, FF = 5632, WX = 512, NMEM = 256, MMEM = BATCH * NMEM;
constexpr int QSB = 0, KSB = 1024, VSB = 2048, QMB = 3072, KMB = 4096, VMB = 5120;
constexpr float EPS = 1e-6f;
constexpr float QSCALE = 0.12751743082459868f;
constexpr size_t MiB = 1u << 20;
constexpr size_t WS_CTL = 0, CTL_ZERO_BYTES = 1 * MiB;
constexpr size_t WS_SSQ1 = 64 * 1024, WS_SSQ2 = 128 * 1024;
constexpr size_t WS_WIN = 1 * MiB, WS_WOUT = 25 * MiB, WS_WXQ = 33 * MiB, WS_WXKV = 35 * MiB, WS_WXO = 39 * MiB, WS_WGU = 41 * MiB, WS_WDN = 85 * MiB;
constexpr size_t WS_RA = 107 * MiB;
constexpr size_t WS_RB = 171 * MiB;
constexpr size_t WS_RC = 235 * MiB;
constexpr size_t WS_QX = 427 * MiB, WS_OX = 443 * MiB, WS_KVX = 459 * MiB, WS_MN = 463 * MiB, WS_KMEAN = 471 * MiB, WS_CS = 472 * MiB, WS_END = 474 * MiB;
constexpr int RING_BYTES = 131072, LDS_BYTES = 147456;
#ifndef FFN_FP8
#define FFN_FP8 1
#endif
constexpr float S_X2 = 16.f, S_WGU = 32.f, S_ACT = 8.f, S_WDN = 64.f;

__device__ __forceinline__ float bf2f(unsigned short b) { return __uint_as_float((unsigned)b << 16); }
__device__ __forceinline__ unsigned f2bf(float f) { unsigned u = __builtin_bit_cast(unsigned, f); return (u + 0x7fffu + ((u >> 16) & 1u)) >> 16; }
__device__ __forceinline__ unsigned pk2(float lo, float hi) { return f2bf(lo) | (f2bf(hi) << 16); }
__device__ __forceinline__ float wave_sum(float v) {
#pragma unroll
    for (int o = 1; o < 64; o <<= 1) v += __shfl_xor(v, o);
    return v;
}
__device__ __forceinline__ float wave_max(float v) {
#pragma unroll
    for (int o = 1; o < 64; o <<= 1) v = fmaxf(v, __shfl_xor(v, o));
    return v;
}

typedef GAS unsigned gu32;
#define RLX_AGENT __ATOMIC_RELAXED, __HIP_MEMORY_SCOPE_AGENT
constexpr int CW_BAR = 4096;
constexpr int LDSCTL_OFF = RING_BYTES, MISC_OFF = LDSCTL_OFF + 320;
#define XB_TMO      128
#define XB_XCNT(j)  (256  + 64 * (j))
#define XB_XSUB(j)  (1280 + 64 * (j))
#define XB_XGEN(j)  (2304 + 64 * (j))
#define XB_TOP      3328
#define XB_TOPGEN   3392
#define XCD_BAR_WORDS 3456
#define XB_SPIN_CAP (1u << 18)

__device__ __forceinline__ unsigned xb_ld(unsigned* p)              { return __hip_atomic_load(p, __ATOMIC_RELAXED, __HIP_MEMORY_SCOPE_AGENT); }
__device__ __forceinline__ unsigned xb_add(unsigned* p, unsigned v) { return __hip_atomic_fetch_add(p, v, __ATOMIC_RELAXED, __HIP_MEMORY_SCOPE_AGENT); }
__device__ __forceinline__ unsigned xb_xcc_id() { return (unsigned)__builtin_amdgcn_s_getreg((3 << 11) | 20) & 0xFu; }
#define XB_SPIN(cond, bar) do { unsigned _sp = 0; while (cond) { __builtin_amdgcn_s_sleep(1); \
    if ((++_sp & 255u) == 0u) { if (xb_ld(&(bar)[XB_TMO])) break; if (_sp > XB_SPIN_CAP) { atomicAdd(&(bar)[XB_TMO], 1u); break; } } } } while (0)

struct XcdBarrier {
    unsigned* bar; unsigned x;
    volatile LAS unsigned* st;
};

__device__ __forceinline__ XcdBarrier xcd_barrier_post(unsigned* bar, volatile LAS unsigned* st) {
    XcdBarrier b; b.bar = bar; b.x = xb_xcc_id(); b.st = st;
    if (threadIdx.x == 0) (void)xb_add(&bar[XB_XCNT(b.x)], 1u);
    return b;
}
__device__ __forceinline__ void xcd_barrier_complete(unsigned* bar, unsigned x, unsigned& nloc, unsigned& nx) {
    const unsigned G = gridDim.x * gridDim.y * gridDim.z;
    unsigned sum, cnt, mine, sp = 0u;
    for (;;) {
        sum = 0u; cnt = 0u; mine = 0u;
#pragma unroll
        for (unsigned j = 0; j < 16; ++j) { const unsigned c = xb_ld(&bar[XB_XCNT(j)]); sum += c; cnt += (c > 0u) ? 1u : 0u; mine = (j == x) ? c : mine; }
        if (sum == G) break;
        __builtin_amdgcn_s_sleep(1);
        if ((++sp & 255u) == 0u) { if (xb_ld(&bar[XB_TMO])) break; if (sp > XB_SPIN_CAP) { atomicAdd(&bar[XB_TMO], 1u); break; } }
    }
    nloc = mine > 0u ? mine : 1u; nx = cnt > 0u ? cnt : 1u;
}

__device__ __forceinline__ void xcd_barrier(const XcdBarrier& b) {
    asm volatile("s_waitcnt vmcnt(0)" ::: "memory");
    __syncthreads();
    if (threadIdx.x == 0) {
        unsigned* bar = b.bar;
        __builtin_amdgcn_s_waitcnt(0);
        unsigned nloc = b.st[0], nx = b.st[1];
        if (nloc == 0u) { xcd_barrier_complete(bar, b.x, nloc, nx); b.st[0] = nloc; b.st[1] = nx; }
        const unsigned old = xb_add(&bar[XB_XSUB(b.x)], 1u);
        const unsigned gen = old / nloc;
        if (old + 1u == (gen + 1u) * nloc) {
            __builtin_amdgcn_fence(__ATOMIC_RELEASE, "agent");
            asm volatile("s_waitcnt vmcnt(0)" ::: "memory");
            const unsigned og = xb_add(&bar[XB_TOP], 1u);
            const unsigned tg = og / nx;
            if (og + 1u == (tg + 1u) * nx) xb_add(&bar[XB_TOPGEN], 1u);
            else XB_SPIN(xb_ld(&bar[XB_TOPGEN]) == tg, bar);
            __builtin_amdgcn_fence(__ATOMIC_ACQUIRE, "agent");
            xb_add(&bar[XB_XGEN(b.x)], 1u);
            asm volatile("s_waitcnt vmcnt(0)" ::: "memory");
        } else {
            XB_SPIN(xb_ld(&bar[XB_XGEN(b.x)]) == gen, bar);
            __builtin_amdgcn_fence(__ATOMIC_ACQUIRE, "agent");
            asm volatile("s_waitcnt vmcnt(0)" ::: "memory");
        }
    }
    __syncthreads();
}

struct Frame {
    LAS unsigned char* lds;
    int tid, lane, wave, vcu, G;
    const float *x, *mem; const int* pos;
    const float *g_mix, *w_in, *g_out_sb, *g_out_mb, *w_out, *g_xattn, *g_mem, *w_xq, *w_xkv, *w_xo, *g_ffn, *w_gu, *w_dn, *g_final;
    float* out; unsigned char* ws;
};

__device__ __forceinline__ void transpose_item(const float* W, int K, int N, bf16* WT, const float* gain, int inter, LAS float* scr, int item, int lane) {
    const int nblk = N / 32, kb = item / nblk, nb = item % nblk, k0 = 64 * kb, n0 = 32 * nb;
    int orow0 = n0;
    if (inter) orow0 = (n0 < FF) ? (n0 / 128) * 256 + (n0 % 128) : ((n0 - FF) / 128) * 256 + 128 + ((n0 - FF) % 128);
#pragma unroll 8
    for (int i = 0; i < 32; ++i) { const int kk = 2 * i + (lane >> 5); float v = W[(size_t)(k0 + kk) * N + n0 + (lane & 31)]; if (gain) v *= gain[k0 + kk]; scr[kk * 33 + (lane & 31)] = v; }
    LDS_WAIT(); asm volatile("" ::: "memory");
    const int c = lane & 7;
#pragma unroll
    for (int j = 0; j < 4; ++j) { const int n = (lane >> 3) + 8 * j; const LAS float* s = scr + (8 * c) * 33 + n;
        v4u o; o.x = pk2(s[0 * 33], s[1 * 33]); o.y = pk2(s[2 * 33], s[3 * 33]); o.z = pk2(s[4 * 33], s[5 * 33]); o.w = pk2(s[6 * 33], s[7 * 33]);
        *(GAS v4u*)(WT + (size_t)(orow0 + n) * K + k0 + 8 * c) = o; }
    LDS_WAIT(); asm volatile("" ::: "memory");
}
__device__ __forceinline__ void transpose_item_fp8(const float* W, int K, int N, unsigned char* WT, const float* gain, int inter, float scale, LAS float* scr, int item, int lane) {
    const int nblk = N / 32, kb = item / nblk, nb = item % nblk, k0 = 64 * kb, n0 = 32 * nb;
    int orow0 = n0;
    if (inter) orow0 = (n0 < FF) ? (n0 / 128) * 256 + (n0 % 128) : ((n0 - FF) / 128) * 256 + 128 + ((n0 - FF) % 128);
#pragma unroll 8
    for (int i = 0; i < 32; ++i) { const int kk = 2 * i + (lane >> 5); float v = W[(size_t)(k0 + kk) * N + n0 + (lane & 31)] * scale; if (gain) v *= gain[k0 + kk]; scr[kk * 33 + (lane & 31)] = v; }
    LDS_WAIT(); asm volatile("" ::: "memory");
    const int c = lane & 7;
#pragma unroll
    for (int j = 0; j < 4; ++j) { const int n = (lane >> 3) + 8 * j; const LAS float* s = scr + (8 * c) * 33 + n;
        pg8::u32x2 o; o.x = pg8::pk4_fp8(s[0 * 33], s[1 * 33], s[2 * 33], s[3 * 33]); o.y = pg8::pk4_fp8(s[4 * 33], s[5 * 33], s[6 * 33], s[7 * 33]);
        *(GAS pg8::u32x2*)(WT + (size_t)(orow0 + n) * K + k0 + 8 * c) = o; }
    LDS_WAIT(); asm volatile("" ::: "memory");
}
__device__ __forceinline__ void rms_row_to_bf16(const float* xrow, const float* g, bf16* orow, int lane) {
    const GAS f32x4* xr = (const GAS f32x4*)xrow + lane; const GAS f32x4* gr = (const GAS f32x4*)g + lane;
    f32x4 v[8]; float s = 0.f;
#pragma unroll
    for (int j = 0; j < 8; ++j) { v[j] = xr[64 * j]; s += (v[j].x * v[j].x + v[j].y * v[j].y) + (v[j].z * v[j].z + v[j].w * v[j].w); }
    const float rstd = 1.0f / sqrtf(wave_sum(s) * (1.f / DM) + EPS);
    GAS unsigned long long* o8 = (GAS unsigned long long*)orow + lane;
#pragma unroll
    for (int j = 0; j < 8; ++j) { const f32x4 gg = gr[64 * j];
        o8[64 * j] = (unsigned long long)pk2(v[j].x * rstd * gg.x, v[j].y * rstd * gg.y) | ((unsigned long long)pk2(v[j].z * rstd * gg.z, v[j].w * rstd * gg.w) << 32); }
}
__constant__ float INV_FREQ[16] = {1.000000000e+00f, 4.403665960e-01f, 1.939227432e-01f, 8.539710194e-02f, 3.760603070e-02f, 1.656043902e-02f, 7.292664610e-03f, 3.211445874e-03f,
                                   1.414213562e-03f, 6.227723788e-04f, 2.742481884e-04f, 1.207697351e-04f, 5.318296098e-05f, 2.341999971e-05f, 1.031338616e-05f, 4.541670478e-06f};

__device__ __forceinline__ void p0_prologue(Frame& F) {
    LAS float* scr = (LAS float*)(F.lds + F.wave * 16384);
    const int gw = F.vcu * NWAVES + F.wave, NGW = F.G * NWAVES;
    bf16* ws16 = (bf16*)F.ws;
    constexpr int I0 = (DM / 64) * (NQKV / 32), I1 = (DM / 64) * (DM / 32), I2 = (DM / 64) * (WX / 32), I3 = (DM / 64) * (2 * WX / 32), I4 = (WX / 64) * (DM / 32),
                  I5 = (DM / 64) * (2 * FF / 32), I6 = (FF / 64) * (DM / 32);
    constexpr int NITEMS = I0 + I1 + I2 + I3 + I4 + I5 + I6;
    for (int it = gw; it < NITEMS; it += NGW) {
        int r = it;
        if (r < I0) { transpose_item(F.w_in, DM, NQKV, (bf16*)(F.ws + WS_WIN), nullptr, 0, scr, r, F.lane); continue; } r -= I0;
        if (r < I1) { transpose_item(F.w_out, DM, DM, (bf16*)(F.ws + WS_WOUT), nullptr, 0, scr, r, F.lane); continue; } r -= I1;
        if (r < I2) { transpose_item(F.w_xq, DM, WX, (bf16*)(F.ws + WS_WXQ), F.g_xattn, 0, scr, r, F.lane); continue; } r -= I2;
        if (r < I3) { transpose_item(F.w_xkv, DM, 2 * WX, (bf16*)(F.ws + WS_WXKV), nullptr, 0, scr, r, F.lane); continue; } r -= I3;
        if (r < I4) { transpose_item(F.w_xo, WX, DM, (bf16*)(F.ws + WS_WXO), nullptr, 0, scr, r, F.lane); continue; } r -= I4;
#if FFN_FP8
        if (r < I5) { transpose_item_fp8(F.w_gu, DM, 2 * FF, F.ws + WS_WGU, F.g_ffn, 1, S_WGU, scr, r, F.lane); continue; } r -= I5;
        transpose_item_fp8(F.w_dn, FF, DM, F.ws + WS_WDN, nullptr, 0, S_WDN, scr, r, F.lane);
#else
        if (r < I5) { transpose_item(F.w_gu, DM, 2 * FF, (bf16*)(F.ws + WS_WGU), F.g_ffn, 1, scr, r, F.lane); continue; } r -= I5;
        transpose_item(F.w_dn, FF, DM, (bf16*)(F.ws + WS_WDN), nullptr, 0, scr, r, F.lane);
#endif
    }
    (void)ws16;
    for (int m = gw; m < M; m += NGW) rms_row_to_bf16(F.x + (size_t)m * DM, F.g_mix, (bf16*)(F.ws + WS_RA) + (size_t)m * DM, F.lane);
    for (int m = gw; m < MMEM; m += NGW) rms_row_to_bf16(F.mem + (size_t)m * DM, F.g_mem, (bf16*)(F.ws + WS_MN) + (size_t)m * DM, F.lane);
    float* cs = (float*)(F.ws + WS_CS);
    for (int e = (F.vcu * NWAVES + F.wave) * 64 + F.lane; e < M * 16; e += NGW * 64) {
        const int m = e >> 4, i = e & 15; const float ang = (float)F.pos[m] * INV_FREQ[i];
        double rev = (double)ang * 0.15915494309189535; rev -= floor(rev);
        const float a = (float)(rev * 6.283185307179586);
        cs[(size_t)m * 32 + i] = cosf(a); cs[(size_t)m * 32 + 16 + i] = sinf(a);
    }
}

__device__ __forceinline__ float dot128(const LAS float* qs, const bf16* krow) {
    float s = 0.f;
#pragma unroll
    for (int c = 0; c < 16; ++c) { const v4u kv = *(const v4u*)(krow + 8 * c); const LAS f32x4* q4 = (const LAS f32x4*)(qs + 8 * c); const f32x4 qa = q4[0], qb = q4[1];
        s += qa.x * __uint_as_float(kv.x << 16) + qa.y * __uint_as_float(kv.x & 0xffff0000u) + qa.z * __uint_as_float(kv.y << 16) + qa.w * __uint_as_float(kv.y & 0xffff0000u)
           + qb.x * __uint_as_float(kv.z << 16) + qb.y * __uint_as_float(kv.z & 0xffff0000u) + qb.z * __uint_as_float(kv.w << 16) + qb.w * __uint_as_float(kv.w & 0xffff0000u); }
    return s;
}
__device__ __forceinline__ void load_q_lds(LAS float* qs, const bf16* qp, int lane) { qs[lane] = bf2f(qp[lane]); qs[64 + lane] = bf2f(qp[64 + lane]); LDS_WAIT(); asm volatile("" ::: "memory"); }
__device__ __forceinline__ void pv64(float w, const bf16* vbase, size_t ld, int cnt, int lane, float& o0, float& o1) {
    for (int i = 0; i < cnt; ++i) { const float wi = __shfl(w, i); const unsigned vv = *(const unsigned*)(vbase + (size_t)i * ld + 2 * lane); o0 += wi * __uint_as_float(vv << 16); o1 += wi * __uint_as_float(vv & 0xffff0000u); }
}
__device__ __forceinline__ float softplus2(float y) { return fmaxf(y, 0.f) + __builtin_amdgcn_logf(1.0f + __builtin_amdgcn_exp2f(-fabsf(y))); }
__device__ __forceinline__ void store_head_norm(float o0, float o1, const float* g, bf16* op, int lane) {
    const float ssq = wave_sum(o0 * o0 + o1 * o1); const float r = 1.0f / sqrtf(ssq * (1.f / HD) + EPS);
    *(unsigned*)(op + 2 * lane) = pk2(o0 * r * g[2 * lane], o1 * r * g[2 * lane + 1]);
}
__device__ __forceinline__ void naive_sb_row(Frame& F, LAS float* qs, int bh, int t) {
    const int b = bh >> 3, h = bh & 7, lane = F.lane; const bf16* qkv = (const bf16*)(F.ws + WS_RC); const size_t rb = (size_t)b * SEQ;
    load_q_lds(qs, qkv + (rb + t) * NQKV + QSB + h * HD, lane);
    const bf16* kp = qkv + rb * NQKV + KSB + h * HD; const bf16* vp = qkv + rb * NQKV + VSB + h * HD;
    float o0 = 0.f, o1 = 0.f, carry = 0.f;
    for (int c = (t - 1) >> 6; c >= 0; --c) {
        const int key = c * 64 + lane; const bool valid = key < t;
        float y = 0.f; if (valid) y = dot128(qs, kp + (size_t)key * NQKV);
        const float sp = valid ? softplus2(y) : 0.f;
        float suf = sp;
#pragma unroll
        for (int off = 1; off < 64; off <<= 1) { const float tt = __shfl_down(suf, off); if (lane + off < 64) suf += tt; }
        const float w = valid ? __builtin_amdgcn_exp2f(y - (suf + carry)) : 0.f;
        carry += __shfl(suf, 0);
        const int cnt = (t - c * 64) < 64 ? (t - c * 64) : 64;
        pv64(w, vp + (size_t)(c * 64) * NQKV, NQKV, cnt, lane, o0, o1);
    }
    store_head_norm(o0, o1, F.g_out_sb + h * HD, (bf16*)(F.ws + WS_RA) + (rb + t) * DM + h * HD, lane);
    LDS_WAIT();
}
__device__ __forceinline__ void softmax_chunk(float s, bool valid, const bf16* vbase, size_t ld, int cnt, int lane, float& m, float& l, float& o0, float& o1) {
    const float cm = wave_max(valid ? s : -1e30f); const float mn = fmaxf(m, cm); const float alpha = __builtin_amdgcn_exp2f(m - mn);
    const float p = valid ? __builtin_amdgcn_exp2f(s - mn) : 0.f;
    l = l * alpha + wave_sum(p); o0 *= alpha; o1 *= alpha; m = mn;
    pv64(p, vbase, ld, cnt, lane, o0, o1);
}
__device__ __forceinline__ void naive_moba_row(Frame& F, LAS float* qs, int bh, int t) {
    const int b = bh >> 3, h = bh & 7, lane = F.lane; const bf16* qkv = (const bf16*)(F.ws + WS_RC); const size_t rb = (size_t)b * SEQ;
    load_q_lds(qs, qkv + (rb + t) * NQKV + QMB + h * HD, lane);
    const bf16* kp = qkv + rb * NQKV + KMB + h * HD; const bf16* vp = qkv + rb * NQKV + VMB + h * HD;
    const int blk = t >> 8;
    const float* km = (const float*)(F.ws + WS_KMEAN) + (size_t)bh * 8 * HD;
    float g = -INFINITY;
    { const int n = lane & 7; if (n < blk) { float a = 0.f; for (int d = 0; d < HD; ++d) a += qs[d] * km[n * HD + d]; g = a; } }
    int cnt = 0;
#pragma unroll
    for (int mI = 0; mI < 8; ++mI) { const float gm = __shfl(g, mI); cnt += (gm > g || (gm == g && mI < (lane & 7))) ? 1 : 0; }
    const bool sel = (lane < 8) && (lane < blk) && (cnt < 3);
    const unsigned selmask = (unsigned)(__ballot(sel) & 0xffull);
    float m = -1e30f, l = 0.f, o0 = 0.f, o1 = 0.f;
    for (int n = 0; n <= blk; ++n) {
        if (n < blk && !((selmask >> n) & 1u)) continue;
        for (int c = 0; c < 4; ++c) {
            const int key0 = n * 256 + c * 64; if (key0 > t) break;
            const int key = key0 + lane; const bool valid = key <= t;
            float s = 0.f; if (valid) s = dot128(qs, kp + (size_t)key * NQKV);
            const int cn = (t - key0 + 1) < 64 ? (t - key0 + 1) : 64;
            softmax_chunk(s, valid, vp + (size_t)key0 * NQKV, NQKV, cn, lane, m, l, o0, o1);
        }
    }
    const float il = 1.0f / l;
    store_head_norm(o0 * il, o1 * il, F.g_out_mb + h * HD, (bf16*)(F.ws + WS_RA) + (rb + t) * DM + NH * HD + h * HD, lane);
    LDS_WAIT();
}
__device__ __forceinline__ void naive_xattn_row(Frame& F, LAS float* qs, int b, int h, int t) {
    const int lane = F.lane; const bf16* qx = (const bf16*)(F.ws + WS_QX); const bf16* kv = (const bf16*)(F.ws + WS_KVX);
    load_q_lds(qs, qx + ((size_t)b * SEQ + t) * WX + h * HD, lane);
    const bf16* kp = kv + (size_t)b * NMEM * (2 * WX) + h * HD; const bf16* vp = kp + WX;
    float m = -1e30f, l = 0.f, o0 = 0.f, o1 = 0.f;
    for (int c = 0; c < 4; ++c) { const int key = c * 64 + lane; const float s = dot128(qs, kp + (size_t)key * (2 * WX));
        softmax_chunk(s, true, vp + (size_t)(c * 64) * (2 * WX), 2 * WX, 64, lane, m, l, o0, o1); }
    const float il = 1.0f / l;
    *(unsigned*)((bf16*)(F.ws + WS_OX) + ((size_t)b * SEQ + t) * WX + h * HD + 2 * lane) = pk2(o0 * il, o1 * il);
    LDS_WAIT();
}
__device__ __forceinline__ void kmean_phase(Frame& F) {
    LAS float* red = (LAS float*)F.lds;
    const bf16* qkv = (const bf16*)(F.ws + WS_RC); float* km = (float*)(F.ws + WS_KMEAN);
    const int cc = F.tid & 15, rg = F.tid >> 4;
    for (int item = F.vcu; item < 64 * 8; item += F.G) {
        const int bh = item >> 3, n = item & 7, b = bh >> 3, h = bh & 7;
        const bf16* kp = qkv + ((size_t)b * SEQ + n * 256 + rg * 8) * NQKV + KMB + h * HD + cc * 8;
        float a[8] = {0, 0, 0, 0, 0, 0, 0, 0};
#pragma unroll
        for (int r = 0; r < 8; ++r) { const v4u kv = *(const v4u*)(kp + (size_t)r * NQKV);
            a[0] += __uint_as_float(kv.x << 16); a[1] += __uint_as_float(kv.x & 0xffff0000u); a[2] += __uint_as_float(kv.y << 16); a[3] += __uint_as_float(kv.y & 0xffff0000u);
            a[4] += __uint_as_float(kv.z << 16); a[5] += __uint_as_float(kv.z & 0xffff0000u); a[6] += __uint_as_float(kv.w << 16); a[7] += __uint_as_float(kv.w & 0xffff0000u); }
#pragma unroll
        for (int j = 0; j < 8; ++j) red[rg * 128 + cc * 8 + j] = a[j];
        __syncthreads();
        if (F.tid < 128) { float s = 0.f; for (int r = 0; r < 32; ++r) s += red[r * 128 + F.tid]; km[(size_t)item * HD + F.tid] = s * (1.0f / 256.0f); }
        __syncthreads();
    }
}
__device__ __forceinline__ void final_norm_phase(Frame& F, float* dst) {
    const int gw = F.vcu * NWAVES + F.wave, NGW = F.G * NWAVES;
    for (int m = gw; m < M; m += NGW) {
        GAS f32x4* xr = (GAS f32x4*)(F.out + (size_t)m * DM) + F.lane; const GAS f32x4* gr = (const GAS f32x4*)F.g_final + F.lane;
        f32x4 v[8]; float s = 0.f;
#pragma unroll
        for (int j = 0; j < 8; ++j) { v[j] = xr[64 * j]; s += (v[j].x * v[j].x + v[j].y * v[j].y) + (v[j].z * v[j].z + v[j].w * v[j].w); }
        const float rstd = 1.0f / sqrtf(wave_sum(s) * (1.f / DM) + EPS);
        GAS f32x4* dr = (GAS f32x4*)(dst + (size_t)m * DM) + F.lane;
#pragma unroll
        for (int j = 0; j < 8; ++j) dr[64 * j] = v[j] * rstd * gr[64 * j];
    }
}

constexpr int NPH = 11;
#ifndef REPEAT_PHASE
#define REPEAT_PHASE -1
#endif
#ifndef REPEAT_MASK
#define REPEAT_MASK 0
#endif
#define REPS(k) (((REPEAT_PHASE == (k)) || ((REPEAT_MASK >> (k)) & 1)) ? 2 : 1)
#ifndef USE_MFMA_SB
#define USE_MFMA_SB 1
#endif
#ifndef USE_MFMA_MOBA
#define USE_MFMA_MOBA 1
#endif
#ifndef USE_MFMA_X
#define USE_MFMA_X 1
#endif
#ifndef MK_ONE_LAUNCH
#define MK_ONE_LAUNCH 1
#endif
struct Args { const void* in[17]; float* out; unsigned char* ws; int ph_lo, ph_hi; };
__global__ void __launch_bounds__(NWAVES * 64, 2) mk_fwd(Args args) {
    extern __shared__ __attribute__((aligned(16))) unsigned char lds[];
    Frame F;
    F.lds = (LAS unsigned char*)lds;
    F.tid = threadIdx.x; F.lane = F.tid & 63; F.wave = __builtin_amdgcn_readfirstlane(F.tid >> 6);
    F.G = gridDim.x; { const int bx = blockIdx.x; F.vcu = (F.G % 8 == 0) ? (bx % 8) * (F.G / 8) + bx / 8 : bx; }
    F.x = (const float*)args.in[0]; F.mem = (const float*)args.in[1]; F.pos = (const int*)args.in[2];
    F.g_mix = (const float*)args.in[3]; F.w_in = (const float*)args.in[4]; F.g_out_sb = (const float*)args.in[5]; F.g_out_mb = (const float*)args.in[6]; F.w_out = (const float*)args.in[7];
    F.g_xattn = (const float*)args.in[8]; F.g_mem = (const float*)args.in[9]; F.w_xq = (const float*)args.in[10]; F.w_xkv = (const float*)args.in[11]; F.w_xo = (const float*)args.in[12];
    F.g_ffn = (const float*)args.in[13]; F.w_gu = (const float*)args.in[14]; F.w_dn = (const float*)args.in[15]; F.g_final = (const float*)args.in[16];
    F.out = args.out; F.ws = args.ws;
    unsigned char* ws = args.ws;
    const int lo = args.ph_lo, hi = args.ph_hi;
    for (int u = F.tid; u < (LDS_BYTES - LDSCTL_OFF) / 4; u += NWAVES * 64) ((LAS unsigned*)(F.lds + LDSCTL_OFF))[u] = 0u;
    __syncthreads();
    if (hi - lo > 1) cg::this_grid().sync();
    XcdBarrier bar = xcd_barrier_post((unsigned*)(ws + WS_CTL) + CW_BAR, (volatile LAS unsigned*)(F.lds + MISC_OFF) + 8);
#ifndef ONLY_PHASE
#define ONLY_PHASE -1
#endif
#define IN(k) ((ONLY_PHASE < 0 || ONLY_PHASE == (k)) && lo <= (k) && (k) < hi)
#define BOTH(k) (IN(k) && IN((k) + 1))
#define GRID_BAR() xcd_barrier(bar)
    float* ssq1 = (float*)(ws + WS_SSQ1); float* ssq2 = (float*)(ws + WS_SSQ2);
    pg8::bf16_t* RA = (pg8::bf16_t*)(ws + WS_RA); pg8::bf16_t* RB = (pg8::bf16_t*)(ws + WS_RB); pg8::bf16_t* RC = (pg8::bf16_t*)(ws + WS_RC);

    if (IN(0)) { for (int rep = 0; rep < REPS(0); ++rep) p0_prologue(F); if (BOTH(0)) GRID_BAR(); }
    if (IN(1)) {
        pg8::Gemm g{RA, (const pg8::bf16_t*)(ws + WS_WIN), M, NQKV, DM}; pg8::StaticOrder S; S.init(M, NQKV, F.G, (int)blockIdx.x);
        pg8::EpiQKV E{RC, (const float*)(ws + WS_CS), QSCALE};
        for (int rep = 0; rep < REPS(1); ++rep) pg8::gemm_phase<pg8::EpiQKV, pg8::StaticOrder, true, true>(F.lds, g, S, E);
        if (BOTH(1)) GRID_BAR();
    }
    if (IN(2)) { for (int rep = 0; rep < REPS(2); ++rep) kmean_phase(F); if (BOTH(2)) GRID_BAR(); }
    if (IN(3)) {
        const att::bf16* qkv = (const att::bf16*)RC; att::bf16* ob = (att::bf16*)RA; const float* kmean = (const float*)(ws + WS_KMEAN);
#if !(USE_MFMA_SB && USE_MFMA_MOBA)
        LAS float* qs = (LAS float*)(F.lds + F.wave * 1024);
        const int gw = F.vcu * NWAVES + F.wave, NGW = F.G * NWAVES;
#endif
#if !USE_MFMA_SB
        for (int i = gw; i < 64 * SEQ; i += NGW) { const int bh = i >> 11, t = (int)(((unsigned)i + (unsigned)(i >> 11) * 997u) & 2047u); naive_sb_row(F, qs, bh, t); }
#endif
#if !USE_MFMA_MOBA
        for (int i = gw; i < 64 * SEQ; i += NGW) { const int bh = i >> 11, t = (int)(((unsigned)i + (unsigned)(i >> 11) * 997u) & 2047u); naive_moba_row(F, qs, bh, t); }
        __syncthreads();
#endif
        for (int rep = 0; rep < REPS(3); ++rep) {
#if USE_MFMA_SB
        for (int vv = F.vcu; vv < 256; vv += F.G) { const int bh = vv >> 2, s = vv & 3, b = bh >> 3, h = bh & 7; const size_t rb = (size_t)b * SEQ;
            for (int i = 0; i < 2; ++i) { const int qb = i ? s : 7 - s; const size_t r0 = rb + (size_t)qb * 256;
                att::attn_unit<2>(qkv + r0 * NQKV + QSB + h * HD, NQKV, qkv + rb * NQKV + KSB + h * HD, qkv + rb * NQKV + VSB + h * HD, NQKV, ob + r0 * DM + h * HD, DM, F.g_out_sb + h * HD, nullptr, qb, 0, (char*)lds); } }
#endif
#if USE_MFMA_MOBA
        for (int vv = F.vcu; vv < 256; vv += F.G) { const int bh = vv >> 2, s = vv & 3, b = bh >> 3, h = bh & 7; const size_t rb = (size_t)b * SEQ;
            for (int i = 0; i < 2; ++i) { const int qb = i ? s : 7 - s; const size_t r0 = rb + (size_t)qb * 256;
                att::attn_unit<1>(qkv + r0 * NQKV + QMB + h * HD, NQKV, qkv + rb * NQKV + KMB + h * HD, qkv + rb * NQKV + VMB + h * HD, NQKV, ob + r0 * DM + NH * HD + h * HD, DM, F.g_out_mb + h * HD, kmean + (size_t)bh * 1024, qb, 0, (char*)lds); } }
#endif
        }
        if (BOTH(3)) GRID_BAR();
    }
    if (IN(4)) {
        pg8::Gemm g{RA, (const pg8::bf16_t*)(ws + WS_WOUT), M, DM, DM}; pg8::StaticOrder S; S.init(M, DM, F.G, (int)blockIdx.x);
        if (REPS(4) == 2) { pg8::EpiRes E0{F.x, F.out, RB, nullptr, nullptr, 1.f, 1.f}; pg8::gemm_phase<pg8::EpiRes, pg8::StaticOrder, true, true>(F.lds, g, S, E0); }
        pg8::EpiRes E{F.x, F.out, RB, ssq1, nullptr, 1.f, 1.f};
        pg8::gemm_phase<pg8::EpiRes, pg8::StaticOrder, true, true>(F.lds, g, S, E);
        if (BOTH(4)) GRID_BAR();
    }
    if (IN(5)) {
      for (int rep = 0; rep < REPS(5); ++rep) {
        { pg8::Gemm g{RB, (const pg8::bf16_t*)(ws + WS_WXQ), M, WX, DM}; pg8::StaticOrder S; S.init(M, WX, F.G, (int)blockIdx.x);
          pg8::EpiScale E{(pg8::bf16_t*)(ws + WS_QX), WX, ssq1, QSCALE};
          pg8::gemm_phase<pg8::EpiScale, pg8::StaticOrder, true, true>(F.lds, g, S, E); }
        { pg8::Gemm g{(const pg8::bf16_t*)(ws + WS_MN), (const pg8::bf16_t*)(ws + WS_WXKV), MMEM, 2 * WX, DM}; pg8::StaticOrder S; S.init(MMEM, 2 * WX, F.G, (int)((blockIdx.x + F.G - 128) % F.G));
          pg8::EpiScale E{(pg8::bf16_t*)(ws + WS_KVX), 2 * WX, nullptr, 1.0f};
          pg8::gemm_phase<pg8::EpiScale, pg8::StaticOrder, true, true>(F.lds, g, S, E); }
      }
        if (BOTH(5)) GRID_BAR();
    }
    if (IN(6)) {
#if USE_MFMA_X
        for (int rep = 0; rep < REPS(6); ++rep) {
        const att::bf16* qx = (const att::bf16*)(ws + WS_QX); const att::bf16* kvx = (const att::bf16*)(ws + WS_KVX); att::bf16* ox = (att::bf16*)(ws + WS_OX);
        for (int vv = F.vcu; vv < 256; vv += F.G) { const int b = vv >> 5, h = (vv >> 3) & 3, qb = vv & 7; const size_t r0 = (size_t)b * SEQ + (size_t)qb * 256;
            att::attn_unit<0>(qx + r0 * WX + h * HD, WX, kvx + (size_t)b * NMEM * (2 * WX) + h * HD, kvx + (size_t)b * NMEM * (2 * WX) + WX + h * HD, 2 * WX, ox + r0 * WX + h * HD, WX, nullptr, nullptr, qb, NMEM, (char*)lds); }
        }
#else
        LAS float* qs = (LAS float*)(F.lds + F.wave * 1024);
        const int gw = F.vcu * NWAVES + F.wave, NGW = F.G * NWAVES;
        for (int i = gw; i < BATCH * 4 * SEQ; i += NGW) { const int t = i & 2047, h = (i >> 11) & 3, b = i >> 13; naive_xattn_row(F, qs, b, h, t); }
#endif
        if (BOTH(6)) GRID_BAR();
    }
    if (IN(7)) {
        pg8::Gemm g{(const pg8::bf16_t*)(ws + WS_OX), (const pg8::bf16_t*)(ws + WS_WXO), M, DM, WX}; pg8::StaticOrder S; S.init(M, DM, F.G, (int)blockIdx.x);
        if (REPS(7) == 2) { pg8::EpiRes E0{F.out, (float*)RC, RB, nullptr, nullptr, 1.f, 1.f}; pg8::gemm_phase<pg8::EpiRes, pg8::StaticOrder, true, true>(F.lds, g, S, E0); }
        pg8::EpiRes E{F.out, F.out, FFN_FP8 ? nullptr : RA, ssq2, FFN_FP8 ? (unsigned char*)RA : nullptr, S_X2, 1.f};
        pg8::gemm_phase<pg8::EpiRes, pg8::StaticOrder, true, true>(F.lds, g, S, E);
        if (BOTH(7)) GRID_BAR();
    }
    if (IN(8)) {
        pg8::Gemm g{RA, (const pg8::bf16_t*)(ws + WS_WGU), M, 2 * FF, FFN_FP8 ? DM / 2 : DM}; pg8::StaticOrder S; S.init(M, 2 * FF, F.G, (int)blockIdx.x);
        pg8::EpiSwiGLU E{RC, ssq2, FFN_FP8 ? (unsigned char*)RC : nullptr, FFN_FP8 ? 1.f / (S_X2 * S_WGU) : 1.f, S_ACT};
        for (int rep = 0; rep < REPS(8); ++rep) pg8::gemm_phase<pg8::EpiSwiGLU, pg8::StaticOrder, true, true, FFN_FP8 != 0>(F.lds, g, S, E);
        if (BOTH(8)) GRID_BAR();
    }
    if (IN(9)) {
        pg8::Gemm g{RC, (const pg8::bf16_t*)(ws + WS_WDN), M, DM, FFN_FP8 ? FF / 2 : FF}; pg8::StaticOrder S; S.init(M, DM, F.G, (int)blockIdx.x);
        if (REPS(9) == 2) { pg8::EpiRes E0{F.out, (float*)RA, nullptr, nullptr, nullptr, 1.f, FFN_FP8 ? 1.f / (S_ACT * S_WDN) : 1.f}; pg8::gemm_phase<pg8::EpiRes, pg8::StaticOrder, true, true, FFN_FP8 != 0>(F.lds, g, S, E0); }
        pg8::EpiRes E{F.out, F.out, nullptr, nullptr, nullptr, 1.f, FFN_FP8 ? 1.f / (S_ACT * S_WDN) : 1.f};
        pg8::gemm_phase<pg8::EpiRes, pg8::StaticOrder, true, true, FFN_FP8 != 0>(F.lds, g, S, E);
        if (BOTH(9)) GRID_BAR();
    }
    if (IN(10)) { if (REPS(10) == 2) final_norm_phase(F, (float*)RA); final_norm_phase(F, F.out); }
#undef IN
#undef BOTH
}

extern "C" void kernel_launch(void* const* d_in, const int* in_sizes, int n_in, void* d_out, int out_size, void* d_ws, size_t ws_size, hipStream_t stream) {
    static int grid = 0;
    if (grid == 0) {
        if (n_in != 17 || in_sizes[0] != M * DM || out_size != M * DM || ws_size < WS_END) { fprintf(stderr, "kernel_launch: unexpected shapes (n_in %d in0 %d out %d ws %zu)\n", n_in, n_in > 0 ? in_sizes[0] : -1, out_size, ws_size); grid = -1; return; }
        int dev = 0, cus = 0, per_cu = 0;
        if (hipGetDevice(&dev) != hipSuccess || hipDeviceGetAttribute(&cus, hipDeviceAttributeMultiprocessorCount, dev) != hipSuccess) { grid = -1; return; }
        if (hipFuncSetAttribute((const void*)mk_fwd, hipFuncAttributeMaxDynamicSharedMemorySize, LDS_BYTES) != hipSuccess) { fprintf(stderr, "kernel_launch: hipFuncSetAttribute failed\n"); grid = -1; return; }
        if (hipOccupancyMaxActiveBlocksPerMultiprocessor(&per_cu, (const void*)mk_fwd, NWAVES * 64, LDS_BYTES) != hipSuccess || per_cu < 1) { fprintf(stderr, "kernel_launch: occupancy query failed (%d)\n", per_cu); per_cu = 1; }
        (void)hipGetLastError();
        grid = cus * (per_cu < 1 ? 1 : 1);
    }
    if (grid < 0) return;
    (void)hipMemsetAsync((char*)d_ws + WS_CTL, 0, CTL_ZERO_BYTES, stream);
    Args a{};
    for (int i = 0; i < 17; ++i) a.in[i] = d_in[i];
    a.out = (float*)d_out; a.ws = (unsigned char*)d_ws;
#if MK_ONE_LAUNCH
    a.ph_lo = 0; a.ph_hi = NPH;
    void* kargs[] = {&a};
    hipError_t e = hipLaunchCooperativeKernel((const void*)mk_fwd, dim3(grid), dim3(NWAVES * 64), kargs, LDS_BYTES, stream);
    if (e != hipSuccess) fprintf(stderr, "kernel_launch: cooperative launch failed: %s (grid %d)\n", hipGetErrorString(e), grid);
#else
    for (int p = 0; p < NPH; ++p) { a.ph_lo = p; a.ph_hi = p + 1; hipLaunchKernelGGL(mk_fwd, dim3(grid), dim3(NWAVES * 64), LDS_BYTES, stream, a); }
    const hipError_t le = hipPeekAtLastError();
    if (le != hipSuccess) fprintf(stderr, "kernel_launch: launch failed: %s\n", hipGetErrorName(le));
#endif
}
```

```cpp
#include <hip/hip_runtime.h>
#include <hip/hip_cooperative_groups.h>
#include <cstdio>
#include <cstdint>
namespace cg = cooperative_groups;
namespace pg8 {
#define PG8_LAS __attribute__((address_space(3)))
typedef unsigned short bf16_t;
typedef short bf16x8 __attribute__((ext_vector_type(8)));
typedef float f32x4 __attribute__((ext_vector_type(4)));
typedef unsigned u32x4 __attribute__((ext_vector_type(4)));
constexpr int BM = 256, BK = 64, HALF = 128, HTB = HALF * BK * 2  , STAGE_BYTES = 8 * HTB, NXCD = 8, WGM = 8;

__host__ __device__ __forceinline__ int lds_byte(int r, int c) { const int st = (r >> 4) * 2 + (c >> 5), rr = r & 15, cc = c & 31, ob = rr * 64 + cc * 2; return st * 1024 + (ob ^ (((ob >> 9) & 1) << 5)); }
__host__ __device__ __forceinline__ void stage_rc(int b, int& R, int& C) { const int st = b / 1024, sb = b % 1024, swz = sb ^ (((sb >> 9) & 1) << 5); R = (st >> 1) * 16 + swz / 64; C = (st & 1) * 32 + (swz % 64) / 2; }
__host__ __device__ __forceinline__ int perm32(int rho) { const int n = rho >> 4, i = rho & 15; return 8 * (i >> 2) + 4 * n + (i & 3); }

struct Unit { int pm, pn; };
struct Gemm { const bf16_t* A; const bf16_t* Bt; int M, N, K; };

struct StaticOrder {
    int nM, nN, nwg, G, c;
    __host__ __device__ void init(int M, int N, int G_, int c_) { nM = M / BM; nN = N / BM; nwg = nM * nN; G = G_; c = c_; }
    __host__ __device__ bool next(int i, Unit& u) const {
        const long L = (long)i * G + c; if (L >= nwg) return false;
        int wgid = (int)L; { const int q = nwg / NXCD, r = nwg % NXCD, xcd = wgid % NXCD, off = wgid / NXCD; wgid = (xcd < r ? xcd * (q + 1) : r * (q + 1) + (xcd - r) * q) + off; }
        const int nig = WGM * nN, gid = wgid / nig, fm = gid * WGM, gsz = (nM - fm) < WGM ? (nM - fm) : WGM;
        u.pm = fm + ((wgid % nig) % gsz); u.pn = (wgid % nig) / gsz; return true;
    }
    __device__ __forceinline__ void a_ready(const Unit&) const {}
    __device__ __forceinline__ void done(const Unit&) const {}
};

__device__ __forceinline__ unsigned cvt_pk_bf16(float lo, float hi) { unsigned r; asm volatile("v_cvt_pk_bf16_f32 %0, %1, %2" : "=v"(r) : "v"(lo), "v"(hi)); return r; }
typedef float f32x2 __attribute__((ext_vector_type(2)));
template <class Epi, class Sched, bool ALIGN_EPI = false, bool SP2 = false, bool FP8 = false>
__device__ __forceinline__ void gemm_phase(PG8_LAS unsigned char* lds, const Gemm g, const Sched& S, const Epi& E) {
    int tid_ = threadIdx.x; asm volatile("" : "+v"(tid_));
    const int tid = tid_, wid = __builtin_amdgcn_readfirstlane(tid >> 6), lane = tid & 63, wr = wid >> 2, wc = wid & 3, fr = lane & 15, fq = lane >> 4;
    const int K = g.K, nt = K / BK;
    unsigned voffA[2], voffB[2];
#pragma unroll
    for (int i = 0; i < 2; ++i) { int R, C; stage_rc(tid * 16 + i * 8192, R, C); const int Rb = Epi::PERM ? ((R & ~31) + perm32(R & 31)) : R;
        voffA[i] = (unsigned)(R * K + C) * 2u; voffB[i] = (unsigned)(Rb * K + C) * 2u; }
    const size_t kstep = (size_t)(BK * 2);
    const size_t hstep = (size_t)HALF * K * 2;
    const size_t tstep = 2 * hstep;
    const unsigned ldsw = (unsigned)wid * 1024u;
    const int aoff = lds_byte(wr * 64 + fr, fq * 8), boff = lds_byte(wc * 32 + fr, fq * 8);
#define PG8_SA(b, h) (((b) * 2 + (h)) * HTB)
#define PG8_SB(b, h) ((4 + (b) * 2 + (h)) * HTB)
#define PG8_STAGE(bufoff, gbase, voff) do { _Pragma("unroll") for (int _i = 0; _i < 2; ++_i) \
        __builtin_amdgcn_global_load_lds((const unsigned*)((const char*)(gbase) + (voff)[_i]), (PG8_LAS unsigned*)(lds + (bufoff) + ldsw + _i * 8192), 16, 0, 0); } while (0)
#define PG8_LD8(p) __builtin_shufflevector(*(const PG8_LAS i32x4_*)(p), *(const PG8_LAS i32x4_*)((p) + 1024), 0, 1, 2, 3, 4, 5, 6, 7)
#define PG8_LDA(dst, b, h) do { if constexpr (FP8) { _Pragma("unroll") for (int m = 0; m < 4; ++m) dst##8[m] = PG8_LD8(lds + PG8_SA(b, h) + aoff + m * 2048); } \
        else { _Pragma("unroll") for (int m = 0; m < 4; ++m) _Pragma("unroll") for (int k = 0; k < 2; ++k) dst[m][k] = *(const PG8_LAS bf16x8*)(lds + PG8_SA(b, h) + aoff + m * 2048 + k * 1024); } } while (0)
#define PG8_LDB(dst, b, h) do { if constexpr (FP8) { _Pragma("unroll") for (int n = 0; n < 2; ++n) dst##8[n] = PG8_LD8(lds + PG8_SB(b, h) + boff + n * 2048); } \
        else { _Pragma("unroll") for (int n = 0; n < 2; ++n) _Pragma("unroll") for (int k = 0; k < 2; ++k) dst[n][k] = *(const PG8_LAS bf16x8*)(lds + PG8_SB(b, h) + boff + n * 2048 + k * 1024); } } while (0)
#define PG8_MMA(ai, bj, At, Bt) do { __builtin_amdgcn_s_setprio(1); _Pragma("unroll") for (int m = 0; m < 4; ++m) _Pragma("unroll") for (int n = 0; n < 2; ++n) { \
        if constexpr (FP8) asm volatile("v_mfma_scale_f32_16x16x128_f8f6f4 %0, %1, %2, %0, %3, %3 op_sel_hi:[0,0,0]" : "+v"(acc[ai][bj][m][n]) : "v"(Bt##8[n]), "v"(At##8[m]), "v"(sc1_)); \
        else { _Pragma("unroll") for (int k = 0; k < 2; ++k) acc[ai][bj][m][n] = __builtin_amdgcn_mfma_f32_16x16x32_bf16(Bt[n][k], At[m][k], acc[ai][bj][m][n], 0, 0, 0); } } \
        __builtin_amdgcn_s_setprio(0); } while (0)
#define PG8_WAIT_V(n) asm volatile("s_waitcnt vmcnt(" #n ")" ::: "memory")
#define PG8_WAIT_L(n) asm volatile("s_waitcnt lgkmcnt(" #n ")" ::: "memory")
#define PG8_BAR __builtin_amdgcn_s_barrier()
#define PG8_SCHED __builtin_amdgcn_sched_barrier(0)
    Unit cur, nxt; int ui = 0;
    if (!S.next(0, cur)) return;
    f32x4 acc[2][2][4][2];
#pragma unroll
    for (int a = 0; a < 2; ++a)
#pragma unroll
        for (int b = 0; b < 2; ++b)
#pragma unroll
            for (int m = 0; m < 4; ++m)
#pragma unroll
                for (int n = 0; n < 2; ++n) acc[a][b][m][n] = (f32x4){0.f, 0.f, 0.f, 0.f};
    typedef int i32x4_ __attribute__((ext_vector_type(4))); typedef int i32x8_ __attribute__((ext_vector_type(8)));
    int sc1_ = 0x7F7F7F7F; asm volatile("" : "+v"(sc1_));
    bf16x8 At[4][2], B0[2][2], B1[2][2]; i32x8_ At8[4], B08[2], B18[2];
    const char* cA = (const char*)g.A + (size_t)cur.pm * tstep; const char* cB = (const char*)g.Bt + (size_t)cur.pn * tstep;
    S.a_ready(cur);
    if constexpr (SP2) {
        PG8_STAGE(PG8_SB(0, 0), cB, voffB); PG8_STAGE(PG8_SB(0, 1), cB + hstep, voffB); PG8_STAGE(PG8_SA(0, 0), cA, voffA); PG8_STAGE(PG8_SA(0, 1), cA + hstep, voffA);
        if (wr == 1) PG8_BAR;
        PG8_WAIT_V(2); PG8_BAR;
        PG8_STAGE(PG8_SB(1, 0), cB + kstep, voffB); PG8_STAGE(PG8_SA(1, 0), cA + kstep, voffA); PG8_STAGE(PG8_SB(1, 1), cB + hstep + kstep, voffB);
        PG8_WAIT_V(6); PG8_BAR;
    } else {
        PG8_STAGE(PG8_SB(0, 0), cB, voffB); PG8_STAGE(PG8_SA(0, 0), cA, voffA); PG8_STAGE(PG8_SB(0, 1), cB + hstep, voffB); PG8_STAGE(PG8_SA(0, 1), cA + hstep, voffA);
        if (wr == 1) PG8_BAR;
        PG8_WAIT_V(4); PG8_BAR;
        PG8_STAGE(PG8_SB(1, 0), cB + kstep, voffB); PG8_STAGE(PG8_SA(1, 0), cA + kstep, voffA); PG8_STAGE(PG8_SB(1, 1), cB + hstep + kstep, voffB);
        PG8_WAIT_V(6); PG8_BAR;
    }
    for (;;) {
        const bool has_next = S.next(ui + 1, nxt);
        const char* nA = has_next ? (const char*)g.A + (size_t)nxt.pm * tstep : cA; const char* nB = has_next ? (const char*)g.Bt + (size_t)nxt.pn * tstep : cB;
        for (int t = 0; t < nt; t += 2) {
            const bool last = (t == nt - 2);
            const char* a1 = cA + (size_t)(t + 1) * kstep;
            const char* a2 = last ? nA : cA + (size_t)(t + 2) * kstep; const char* b2 = last ? nB : cB + (size_t)(t + 2) * kstep;
            const char* a3 = a2 + kstep; const char* b3 = b2 + kstep;
            if (last && has_next) S.a_ready(nxt);
            if constexpr (SP2) {
            PG8_LDB(B0, 0, 0); PG8_LDB(B1, 0, 1); PG8_SCHED; PG8_LDA(At, 0, 0); PG8_STAGE(PG8_SA(1, 1), a1 + hstep, voffA);
            PG8_WAIT_V(8); PG8_WAIT_L(0); PG8_BAR; PG8_MMA(0, 0, At, B0); PG8_MMA(0, 1, At, B1); PG8_BAR; PG8_SCHED;
            PG8_LDA(At, 0, 1); PG8_STAGE(PG8_SB(0, 0), b2, voffB); PG8_STAGE(PG8_SB(0, 1), b2 + hstep, voffB); PG8_STAGE(PG8_SA(0, 0), a2, voffA);
            PG8_WAIT_V(8); PG8_WAIT_L(0); PG8_BAR; PG8_MMA(1, 0, At, B0); PG8_MMA(1, 1, At, B1); PG8_BAR; PG8_SCHED;
            PG8_LDB(B0, 1, 0); PG8_LDB(B1, 1, 1); PG8_SCHED; PG8_LDA(At, 1, 0); PG8_STAGE(PG8_SA(0, 1), a2 + hstep, voffA);
            PG8_WAIT_V(8); PG8_WAIT_L(0); PG8_BAR; PG8_MMA(0, 0, At, B0); PG8_MMA(0, 1, At, B1); PG8_BAR; PG8_SCHED;
            PG8_LDA(At, 1, 1); PG8_STAGE(PG8_SB(1, 0), b3, voffB); PG8_STAGE(PG8_SB(1, 1), b3 + hstep, voffB); PG8_STAGE(PG8_SA(1, 0), a3, voffA);
            PG8_WAIT_V(8); PG8_WAIT_L(0); PG8_BAR; PG8_MMA(1, 0, At, B0); PG8_MMA(1, 1, At, B1); PG8_BAR; PG8_SCHED;
            } else {
            PG8_LDB(B0, 0, 0); PG8_SCHED; PG8_LDA(At, 0, 0); PG8_STAGE(PG8_SA(1, 1), a1 + hstep, voffA);
            PG8_WAIT_L(8); PG8_BAR; PG8_WAIT_L(0); PG8_MMA(0, 0, At, B0); PG8_BAR; PG8_SCHED;
            PG8_LDB(B1, 0, 1); PG8_STAGE(PG8_SB(0, 0), b2, voffB);
            PG8_BAR; PG8_WAIT_L(0); PG8_MMA(0, 1, At, B1); PG8_BAR;
            PG8_LDA(At, 0, 1); PG8_STAGE(PG8_SA(0, 0), a2, voffA);
            PG8_BAR; PG8_WAIT_L(0); PG8_MMA(1, 0, At, B0); PG8_BAR; PG8_SCHED;
            PG8_STAGE(PG8_SB(0, 1), b2 + hstep, voffB);
            PG8_WAIT_V(6); PG8_BAR; PG8_MMA(1, 1, At, B1); PG8_BAR;
            PG8_LDB(B0, 1, 0); PG8_SCHED; PG8_LDA(At, 1, 0); PG8_STAGE(PG8_SA(0, 1), a2 + hstep, voffA);
            PG8_WAIT_L(8); PG8_BAR; PG8_WAIT_L(0); PG8_MMA(0, 0, At, B0); PG8_BAR; PG8_SCHED;
            PG8_LDB(B1, 1, 1); PG8_STAGE(PG8_SB(1, 0), b3, voffB);
            PG8_BAR; PG8_WAIT_L(0); PG8_MMA(0, 1, At, B1); PG8_BAR;
            PG8_LDA(At, 1, 1); PG8_STAGE(PG8_SA(1, 0), a3, voffA);
            PG8_BAR; PG8_WAIT_L(0); PG8_MMA(1, 0, At, B0); PG8_BAR; PG8_SCHED;
            PG8_STAGE(PG8_SB(1, 1), b3 + hstep, voffB);
            PG8_WAIT_V(6); PG8_BAR; PG8_MMA(1, 1, At, B1); PG8_BAR;
            }
        }
        if constexpr (ALIGN_EPI) { if (wr == 0) PG8_BAR; }
        if constexpr (FP8) asm volatile("s_nop 15\n\ts_nop 15" ::: "memory");
        if constexpr (!Epi::AFTER_DRAIN) { E(acc, cur, wr, wc, fr, fq); S.done(cur); }
        if (!has_next) break;
#pragma unroll
        for (int a = 0; a < 2; ++a)
#pragma unroll
            for (int b = 0; b < 2; ++b)
#pragma unroll
                for (int m = 0; m < 4; ++m)
#pragma unroll
                    for (int n = 0; n < 2; ++n) acc[a][b][m][n] = (f32x4){0.f, 0.f, 0.f, 0.f};
        cur = nxt; cA = nA; cB = nB; ++ui;
        if constexpr (ALIGN_EPI) { if (wr == 1) PG8_BAR; }
    }
    PG8_WAIT_V(0);
    if constexpr (!ALIGN_EPI) { if (wr == 0) PG8_BAR; }
    PG8_BAR;
    if constexpr (Epi::AFTER_DRAIN) { E.fused(acc, cur, wr, wc, fr, fq, lds, wid, lane); S.done(cur); }
#undef PG8_SA
#undef PG8_SB
#undef PG8_STAGE
#undef PG8_LDA
#undef PG8_LD8
#undef PG8_LDB
#undef PG8_MMA
#undef PG8_WAIT_V
#undef PG8_WAIT_L
#undef PG8_BAR
#undef PG8_SCHED
}
}
namespace pg8 {
typedef unsigned u32x2 __attribute__((ext_vector_type(2)));
constexpr int LDX = 2048;
constexpr float RMS_EPS = 1e-6f;
struct EpiQKV {
    static constexpr bool PERM = true, AFTER_DRAIN = false;
    bf16_t* O; const float* cs; float qscale;
    __device__ __forceinline__ void operator()(const f32x4 (&acc)[2][2][4][2], const Unit& u, int wr, int wc, int fr, int fq) const {
        const int row0 = u.pm * BM + wr * 64 + fr, col0 = u.pn * BM + wc * 32 + 8 * fq, pn = u.pn;
        const float sc = (pn < 4 || (pn >= 12 && pn < 16)) ? qscale : 1.f;
        const bool rot = (pn >= 12 && pn < 20) && (wc == 0);
#pragma unroll
        for (int ai = 0; ai < 2; ++ai)
#pragma unroll
            for (int m = 0; m < 4; ++m) { const int row = row0 + ai * HALF + m * 16; bf16_t* rowp = O + (size_t)row * 6144 + col0;
                f32x4 c0 = {1.f, 1.f, 1.f, 1.f}, c1 = c0, s0 = {0.f, 0.f, 0.f, 0.f}, s1 = s0;
                if (rot) { const float* cr = cs + (size_t)row * 32 + 8 * (fq & 1); c0 = *(const f32x4*)cr; c1 = *(const f32x4*)(cr + 4); s0 = *(const f32x4*)(cr + 16); s1 = *(const f32x4*)(cr + 20);
                    if (fq < 2) { s0 = -s0; s1 = -s1; } }
#pragma unroll
                for (int bj = 0; bj < 2; ++bj) { f32x4 v0 = acc[ai][bj][m][0], v1 = acc[ai][bj][m][1];
                    if (rot) { f32x4 p0, p1;
#pragma unroll
                        for (int j = 0; j < 4; ++j) { p0[j] = __shfl_xor(v0[j], 32); p1[j] = __shfl_xor(v1[j], 32); }
                        v0 = v0 * c0 + p0 * s0; v1 = v1 * c1 + p1 * s1; }
                    v0 = v0 * sc; v1 = v1 * sc; u32x4 w; w.x = cvt_pk_bf16(v0[0], v0[1]); w.y = cvt_pk_bf16(v0[2], v0[3]); w.z = cvt_pk_bf16(v1[0], v1[1]); w.w = cvt_pk_bf16(v1[2], v1[3]);
                    *(u32x4*)(rowp + bj * HALF) = w; } }
    }
};
__device__ __forceinline__ unsigned pk4_fp8(float a, float b, float c, float d) {
    a = __builtin_amdgcn_fmed3f(a, -448.f, 448.f); b = __builtin_amdgcn_fmed3f(b, -448.f, 448.f); c = __builtin_amdgcn_fmed3f(c, -448.f, 448.f); d = __builtin_amdgcn_fmed3f(d, -448.f, 448.f);
    int p = __builtin_amdgcn_cvt_pk_fp8_f32(a, b, 0, false); p = __builtin_amdgcn_cvt_pk_fp8_f32(c, d, p, true); return (unsigned)p; }
struct EpiRes {
    static constexpr bool PERM = false, AFTER_DRAIN = false;
    const float* base; float* out; bf16_t* xb; float* ssq; unsigned char* x8; float s8; float ascale;
    __device__ __forceinline__ void operator()(const f32x4 (&acc)[2][2][4][2], const Unit& u, int wr, int wc, int fr, int fq) const {
        const int row0 = u.pm * BM + wr * 64 + fr, col0 = u.pn * BM + wc * 32 + 4 * fq;
#pragma unroll
        for (int ai = 0; ai < 2; ++ai)
#pragma unroll
            for (int m = 0; m < 4; ++m) { const int row = row0 + ai * HALF + m * 16; const size_t off = (size_t)row * LDX + col0; float s = 0.f;
#pragma unroll
                for (int bj = 0; bj < 2; ++bj)
#pragma unroll
                    for (int n = 0; n < 2; ++n) { const f32x4 v = *(const f32x4*)(base + off + bj * HALF + n * 16) + acc[ai][bj][m][n] * ascale;
                        *(f32x4*)(out + off + bj * HALF + n * 16) = v; s += (v[0] * v[0] + v[1] * v[1]) + (v[2] * v[2] + v[3] * v[3]);
                        if (xb) { u32x2 w; w.x = cvt_pk_bf16(v[0], v[1]); w.y = cvt_pk_bf16(v[2], v[3]); *(u32x2*)(xb + off + bj * HALF + n * 16) = w; }
                        if (x8) { *(unsigned*)(x8 + off + bj * HALF + n * 16) = pk4_fp8(v[0] * s8, v[1] * s8, v[2] * s8, v[3] * s8); } }
                if (ssq) { s += __shfl_xor(s, 16); s += __shfl_xor(s, 32); if (fq == 0) atomicAdd(ssq + row, s); }
                asm volatile("" ::: "memory"); }
    }
};
template <bool BASE_F32> struct EpiResB {
    static constexpr bool PERM = true, AFTER_DRAIN = false;
    const void* base; bf16_t* xo; float* ssq; unsigned char* x8; float s8; float ascale;
    __device__ __forceinline__ void operator()(const f32x4 (&acc)[2][2][4][2], const Unit& u, int wr, int wc, int fr, int fq) const {
        const int row0 = u.pm * BM + wr * 64 + fr, col0 = u.pn * BM + wc * 32 + 8 * fq;
#pragma unroll
        for (int ai = 0; ai < 2; ++ai)
#pragma unroll
            for (int m = 0; m < 4; ++m) { const int row = row0 + ai * HALF + m * 16; const size_t off = (size_t)row * LDX + col0; float s = 0.f;
#pragma unroll
                for (int bj = 0; bj < 2; ++bj) { f32x4 b0, b1;
                    if (BASE_F32) { const float* bp = (const float*)base + off + bj * HALF; b0 = *(const f32x4*)bp; b1 = *(const f32x4*)(bp + 4); }
                    else { const u32x4 w = *(const u32x4*)((const bf16_t*)base + off + bj * HALF);
                        b0 = (f32x4){__uint_as_float(w.x << 16), __uint_as_float(w.x & 0xffff0000u), __uint_as_float(w.y << 16), __uint_as_float(w.y & 0xffff0000u)};
                        b1 = (f32x4){__uint_as_float(w.z << 16), __uint_as_float(w.z & 0xffff0000u), __uint_as_float(w.w << 16), __uint_as_float(w.w & 0xffff0000u)}; }
                    const f32x4 v0 = b0 + acc[ai][bj][m][0] * ascale, v1 = b1 + acc[ai][bj][m][1] * ascale;
                    s += ((v0[0] * v0[0] + v0[1] * v0[1]) + (v0[2] * v0[2] + v0[3] * v0[3])) + ((v1[0] * v1[0] + v1[1] * v1[1]) + (v1[2] * v1[2] + v1[3] * v1[3]));
                    if (xo) { u32x4 w; w.x = cvt_pk_bf16(v0[0], v0[1]); w.y = cvt_pk_bf16(v0[2], v0[3]); w.z = cvt_pk_bf16(v1[0], v1[1]); w.w = cvt_pk_bf16(v1[2], v1[3]); *(u32x4*)(xo + off + bj * HALF) = w; }
                    if (x8) { u32x2 w8; w8.x = pk4_fp8(v0[0] * s8, v0[1] * s8, v0[2] * s8, v0[3] * s8); w8.y = pk4_fp8(v1[0] * s8, v1[1] * s8, v1[2] * s8, v1[3] * s8); *(u32x2*)(x8 + off + bj * HALF) = w8; } }
                if (ssq) { s += __shfl_xor(s, 16); s += __shfl_xor(s, 32); if (fq == 0) atomicAdd(ssq + row, s); }
                asm volatile("" ::: "memory"); }
    }
};
struct EpiScale {
    static constexpr bool PERM = true, AFTER_DRAIN = false;
    bf16_t* O; int ldc; const float* ssq; float sc;
    __device__ __forceinline__ void operator()(const f32x4 (&acc)[2][2][4][2], const Unit& u, int wr, int wc, int fr, int fq) const {
        const int row0 = u.pm * BM + wr * 64 + fr, col0 = u.pn * BM + wc * 32 + 8 * fq;
#pragma unroll
        for (int ai = 0; ai < 2; ++ai)
#pragma unroll
            for (int m = 0; m < 4; ++m) { const int row = row0 + ai * HALF + m * 16; bf16_t* rowp = O + (size_t)row * ldc + col0;
                const float f = ssq ? sc * __builtin_amdgcn_rsqf(ssq[row] * (1.0f / 2048.0f) + RMS_EPS) : sc;
#pragma unroll
                for (int bj = 0; bj < 2; ++bj) { const f32x4 v0 = acc[ai][bj][m][0] * f, v1 = acc[ai][bj][m][1] * f;
                    u32x4 w; w.x = cvt_pk_bf16(v0[0], v0[1]); w.y = cvt_pk_bf16(v0[2], v0[3]); w.z = cvt_pk_bf16(v1[0], v1[1]); w.w = cvt_pk_bf16(v1[2], v1[3]);
                    *(u32x4*)(rowp + bj * HALF) = w; } }
    }
};
struct EpiSwiGLU {
    static constexpr bool PERM = true, AFTER_DRAIN = false;
    bf16_t* O; const float* ssq; unsigned char* O8; float ascale, oscale;
    __device__ __forceinline__ void operator()(const f32x4 (&acc)[2][2][4][2], const Unit& u, int wr, int wc, int fr, int fq) const {
        const int row0 = u.pm * BM + wr * 64 + fr, col0 = u.pn * HALF + wc * 32 + 8 * fq;
#pragma unroll
        for (int ai = 0; ai < 2; ++ai)
#pragma unroll
            for (int m = 0; m < 4; ++m) { const int row = row0 + ai * HALF + m * 16; bf16_t* rowp = O + (size_t)row * 5632 + col0;
                const float f = ascale * __builtin_amdgcn_rsqf(ssq[row] * (1.0f / 2048.0f) + RMS_EPS);
                float r[8];
#pragma unroll
                for (int n = 0; n < 2; ++n)
#pragma unroll
                    for (int j = 0; j < 4; ++j) { const float g = acc[ai][0][m][n][j] * f, uu = acc[ai][1][m][n][j] * f;
                        const float sg = g * __builtin_amdgcn_rcpf(1.0f + __builtin_amdgcn_exp2f(-1.4426950408889634f * g)); r[n * 4 + j] = sg * uu; }
                if (O8) { u32x2 w8; w8.x = pk4_fp8(r[0] * oscale, r[1] * oscale, r[2] * oscale, r[3] * oscale); w8.y = pk4_fp8(r[4] * oscale, r[5] * oscale, r[6] * oscale, r[7] * oscale);
                    *(u32x2*)(O8 + (size_t)row * 5632 + col0) = w8; }
                else { u32x4 w; w.x = cvt_pk_bf16(r[0], r[1]); w.y = cvt_pk_bf16(r[2], r[3]); w.z = cvt_pk_bf16(r[4], r[5]); w.w = cvt_pk_bf16(r[6], r[7]);
                *(u32x4*)rowp = w; } }
    }
};
}
namespace att {
using bf16x8 = __attribute__((ext_vector_type(8))) short;
using s16x4  = __attribute__((ext_vector_type(4))) short;
using f32x16 = __attribute__((ext_vector_type(16))) float;
using f32x4  = __attribute__((ext_vector_type(4))) float;
using u32x4  = __attribute__((ext_vector_type(4))) unsigned;
typedef unsigned short bf16;
constexpr int D = 128, KVBLK = 64;
constexpr int SHM_V = KVBLK * D * 2, SHM_K = KVBLK * D * 2;
constexpr int OFF_WS = 2 * SHM_V + 2 * SHM_K, OFF_KM = OFF_WS + 2048, ATT_LDS = OFF_KM + 4096;
constexpr float THR = 8.f;
#define KSWZ(row, colB) ((row) * 256 + ((colB) ^ (((row) & 7) << 4)))
#define SBAR() __builtin_amdgcn_sched_barrier(0)
__device__ __forceinline__ int crow(int r, int hi) { return (r & 3) + 8 * (r >> 2) + 4 * hi; }
__device__ __forceinline__ unsigned cvtpk(float lo, float hi) { unsigned r; asm volatile("v_cvt_pk_bf16_f32 %0, %1, %2" : "=v"(r) : "v"(lo), "v"(hi)); return r; }
__device__ __forceinline__ float xchg32(float x, int hi) { auto rr = __builtin_amdgcn_permlane32_swap(__float_as_uint(x), __float_as_uint(x), false, false); return __uint_as_float(hi ? rr[0] : rr[1]); }
__device__ __forceinline__ void qkt(f32x16& p0, f32x16& p1, const char* Ks, const bf16x8* qr, int r32, int hi) {
  p0 = f32x16{}; p1 = f32x16{};
#pragma unroll
  for (int d0 = 0; d0 < 8; ++d0) { int cb = (d0 * 16 + hi * 8) * 2;
    bf16x8 b0 = *reinterpret_cast<const bf16x8*>(Ks + KSWZ(r32, cb));
    bf16x8 b1 = *reinterpret_cast<const bf16x8*>(Ks + KSWZ(32 + r32, cb));
    p0 = __builtin_amdgcn_mfma_f32_32x32x16_bf16(b0, qr[d0], p0, 0, 0, 0);
    p1 = __builtin_amdgcn_mfma_f32_32x32x16_bf16(b1, qr[d0], p1, 0, 0, 0); }
}
__device__ __forceinline__ int v_st(int k, int c) { const int kk = (k & ~0xC) | ((k & 4) << 1) | ((k & 8) >> 1); return ((kk >> 3) * 4 + (c >> 5)) * 512 + ((kk & 7) * 32 + (c & 31)) * 2; }
__device__ __forceinline__ int v_rd_base(int lane) { return ((lane & 3) << 3) | (((lane >> 2) & 3) << 6) | (((lane >> 4) & 1) << 5) | (((lane >> 5) & 1) << 8); }
constexpr int v_rd_off(int d0, int ks, int half) { return d0 * 512 + ks * 4096 + half * 2048; }
template <int OFF> __device__ __forceinline__ s16x4 tr_read(int vb) { s16x4 r; asm volatile("ds_read_b64_tr_b16 %0, %1 offset:%2" : "=&v"(r) : "v"(vb), "i"(OFF) : "memory"); return r; }
template <int D0> __device__ __forceinline__ void pv_one(f32x16& od, int vb, bf16x8 pa0, bf16x8 pa1, bf16x8 pa2, bf16x8 pa3) {
  const s16x4 l0 = tr_read<v_rd_off(D0, 0, 0)>(vb), h0 = tr_read<v_rd_off(D0, 0, 1)>(vb), l1 = tr_read<v_rd_off(D0, 1, 0)>(vb), h1 = tr_read<v_rd_off(D0, 1, 1)>(vb);
  const s16x4 l2 = tr_read<v_rd_off(D0, 2, 0)>(vb), h2 = tr_read<v_rd_off(D0, 2, 1)>(vb), l3 = tr_read<v_rd_off(D0, 3, 0)>(vb), h3 = tr_read<v_rd_off(D0, 3, 1)>(vb);
  asm volatile("s_waitcnt lgkmcnt(0)" ::: "memory"); SBAR();
#define PK(L, H) (bf16x8){L[0], L[1], L[2], L[3], H[0], H[1], H[2], H[3]}
  od = __builtin_amdgcn_mfma_f32_32x32x16_bf16(pa0, PK(l0, h0), od, 0, 0, 0);
  od = __builtin_amdgcn_mfma_f32_32x32x16_bf16(pa1, PK(l1, h1), od, 0, 0, 0);
  od = __builtin_amdgcn_mfma_f32_32x32x16_bf16(pa2, PK(l2, h2), od, 0, 0, 0);
  od = __builtin_amdgcn_mfma_f32_32x32x16_bf16(pa3, PK(l3, h3), od, 0, 0, 0);
#undef PK
}
__device__ __forceinline__ void pv_d0(f32x16* o, int vb, bf16x8 pa0, bf16x8 pa1, bf16x8 pa2, bf16x8 pa3) {
  pv_one<0>(o[0], vb, pa0, pa1, pa2, pa3); pv_one<1>(o[1], vb, pa0, pa1, pa2, pa3); pv_one<2>(o[2], vb, pa0, pa1, pa2, pa3); pv_one<3>(o[3], vb, pa0, pa1, pa2, pa3);
}
__device__ __forceinline__ void pack_p(const f32x16& p0, const f32x16& p1, bf16x8& pa0, bf16x8& pa1, bf16x8& pa2, bf16x8& pa3) {
#define PK4(P, BASE, OUT) do { unsigned a0 = cvtpk(P[BASE + 0], P[BASE + 1]), a1 = cvtpk(P[BASE + 2], P[BASE + 3]);   \
    unsigned b0 = cvtpk(P[BASE + 4], P[BASE + 5]), b1 = cvtpk(P[BASE + 6], P[BASE + 7]);                              \
    auto r0 = __builtin_amdgcn_permlane32_swap(a0, b0, false, false); auto r1 = __builtin_amdgcn_permlane32_swap(a1, b1, false, false); \
    u32x4 w = {r0[0], r1[0], r0[1], r1[1]}; OUT = *reinterpret_cast<bf16x8*>(&w); } while (0)
  PK4(p0, 0, pa0); PK4(p0, 8, pa1); PK4(p1, 0, pa2); PK4(p1, 8, pa3);
#undef PK4
}
__device__ __forceinline__ void softmax_tile(f32x16& p0, f32x16& p1, float& m_reg, float& l_reg, float& alpha) {
  float pmax = p0[0];
#pragma unroll
  for (int r = 1; r < 16; ++r) pmax = fmaxf(pmax, p0[r]);
#pragma unroll
  for (int r = 0; r < 16; ++r) pmax = fmaxf(pmax, p1[r]);
  pmax = fmaxf(pmax, xchg32(pmax, (int)(threadIdx.x >> 5) & 1));
  if (__all(pmax - m_reg <= THR)) { alpha = 1.f; }
  else { const float mn = fmaxf(m_reg, pmax); alpha = __builtin_amdgcn_exp2f(m_reg - mn); m_reg = mn; }
  float ps = 0.f;
#pragma unroll
  for (int r = 0; r < 16; ++r) { p0[r] = __builtin_amdgcn_exp2f(p0[r] - m_reg); ps += p0[r]; }
#pragma unroll
  for (int r = 0; r < 16; ++r) { p1[r] = __builtin_amdgcn_exp2f(p1[r] - m_reg); ps += p1[r]; }
  ps += xchg32(ps, (int)(threadIdx.x >> 5) & 1);
  l_reg = l_reg * alpha + ps;
}
__device__ __forceinline__ float softplus2(float y) { return fmaxf(y, 0.f) + __builtin_amdgcn_logf(1.0f + __builtin_amdgcn_exp2f(-fabsf(y))); }
__device__ __forceinline__ void sb_tile(f32x16& p0, f32x16& p1, float& carry, bool band, int kb, int qrel, int hi) {
  float gs[8];
#pragma unroll
  for (int i = 0; i < 4; ++i) { float run = 0.f;
#pragma unroll
    for (int e = 3; e >= 0; --e) { const int r = 4 * i + e; const bool valid = !band || (kb + crow(r, hi) < qrel); const float y = p0[r];
      const float sp = valid ? softplus2(y) : 0.f; run += sp; p0[r] = valid ? (y - run) : -INFINITY; }
    gs[i] = run; }
#pragma unroll
  for (int i = 0; i < 4; ++i) { float run = 0.f;
#pragma unroll
    for (int e = 3; e >= 0; --e) { const int r = 4 * i + e; const bool valid = !band || (kb + 32 + crow(r, hi) < qrel); const float y = p1[r];
      const float sp = valid ? softplus2(y) : 0.f; run += sp; p1[r] = valid ? (y - run) : -INFINITY; }
    gs[4 + i] = run; }
  float acc = 0.f;
#pragma unroll
  for (int i = 7; i >= 0; --i) { const float so_i = acc; acc += gs[i]; const float x = hi ? acc : so_i; gs[i] = carry + so_i + xchg32(x, hi); }
  const float tot = acc, ptot = xchg32(acc, hi);
#pragma unroll
  for (int i = 0; i < 4; ++i)
#pragma unroll
    for (int e = 0; e < 4; ++e) { p0[4 * i + e] = __builtin_amdgcn_exp2f(p0[4 * i + e] - gs[i]); p1[4 * i + e] = __builtin_amdgcn_exp2f(p1[4 * i + e] - gs[4 + i]); }
  carry += tot + ptot;
}

template <int MODE>
__device__ __forceinline__ void attn_unit(const bf16* __restrict__ Qb, int ldq, const bf16* __restrict__ Kh, const bf16* __restrict__ Vh, int ldk, bf16* __restrict__ Ob, int ldo,
                                          const float* __restrict__ gain, const float* __restrict__ kmean, int qb, int nkeys, char* lds) {
  int tid_ = threadIdx.x; asm volatile("" : "+v"(tid_));
  const int tid = tid_, wid = __builtin_amdgcn_readfirstlane(tid >> 6), lane = tid & 63, r32 = lane & 31, hi = lane >> 5;
  char* V_lds = lds; char* K_lds = lds + 2 * SHM_V;
  float* ws = (float*)(lds + OFF_WS) + wid * 64; float* li_l = ws; float* al_l = ws + 32;
  float* km_l = (float*)(lds + OFF_KM);
  const int NT = (MODE == 0) ? nkeys / KVBLK : 4 * (qb + 1);
  const int qrel = wid * 32 + r32;
  float m_reg = -1e30f, l_reg = 0.f, carry = 0.f; f32x16 o[4] = {}; bf16x8 qr[8];
  const bf16* Qw = Qb + (long)(wid * 32 + r32) * ldq + hi * 8;
#pragma unroll
  for (int d0 = 0; d0 < 8; ++d0) qr[d0] = *reinterpret_cast<const bf16x8*>(Qw + d0 * 16);
  const int vb0 = (int)(uintptr_t)V_lds + v_rd_base(lane);
  long ksrc[2], vsrc[2];
#pragma unroll
  for (int i = 0; i < 2; ++i) { const int piece = wid + 8 * i;
    { const int row = piece * 4 + (lane >> 4), c = (lane & 15) ^ (row & 7); ksrc[i] = (long)row * ldk + c * 8; }
    { const int sub = piece * 2 + (lane >> 5), kk = (sub >> 2) * 8 + ((lane & 31) >> 2), k = (kk & ~0xC) | ((kk & 4) << 1) | ((kk & 8) >> 1), c = (sub & 3) * 32 + (lane & 3) * 8; vsrc[i] = (long)k * ldk + c; } }
  typedef __attribute__((address_space(3))) unsigned lds_u32;
  lds_u32* kdst = (lds_u32*)(__attribute__((address_space(3))) char*)(K_lds) + wid * 256; lds_u32* vdst = (lds_u32*)(__attribute__((address_space(3))) char*)(V_lds) + wid * 256;
#define TILE(it) ((MODE == 2) ? (NT - 1 - (it)) : (it))
#define SDMA(k0, b) do { _Pragma("unroll") for (int i_ = 0; i_ < 2; ++i_) { \
    __builtin_amdgcn_global_load_lds((const unsigned*)(Kh + (long)(k0) * ldk + ksrc[i_]), kdst + (b) * (SHM_K / 4) + i_ * 2048, 16, 0, 0); \
    __builtin_amdgcn_global_load_lds((const unsigned*)(Vh + (long)(k0) * ldk + vsrc[i_]), vdst + (b) * (SHM_V / 4) + i_ * 2048, 16, 0, 0); } } while (0)
#define SDRAIN() asm volatile("s_waitcnt vmcnt(0)" ::: "memory")
  SDMA(TILE(0) * KVBLK, 0);
  unsigned selmask = 0u;
  if (MODE == 1) { if (tid < 256) *(f32x4*)(km_l + tid * 4) = *(const f32x4*)(kmean + tid * 4); }
  SDRAIN();
  __syncthreads();
  if (MODE == 1) {
    float g[8];
#pragma unroll
    for (int n = 0; n < 8; ++n) g[n] = 0.f;
#pragma unroll
    for (int d0 = 0; d0 < 8; ++d0) { float q[8];
#pragma unroll
      for (int j = 0; j < 8; ++j) q[j] = __uint_as_float(((unsigned)(unsigned short)qr[d0][j]) << 16);
#pragma unroll
      for (int n = 0; n < 7; ++n) { const f32x4 ka = *(const f32x4*)(km_l + n * 128 + d0 * 16 + hi * 8), kb2 = *(const f32x4*)(km_l + n * 128 + d0 * 16 + hi * 8 + 4);
        g[n] += (q[0] * ka[0] + q[1] * ka[1]) + (q[2] * ka[2] + q[3] * ka[3]) + (q[4] * kb2[0] + q[5] * kb2[1]) + (q[6] * kb2[2] + q[7] * kb2[3]); } }
#pragma unroll
    for (int n = 0; n < 7; ++n) { g[n] += xchg32(g[n], hi); if (n >= qb) g[n] = -INFINITY; }
    g[7] = -INFINITY;
#pragma unroll
    for (int n = 0; n < 7; ++n) { int cnt = 0;
#pragma unroll
      for (int mI = 0; mI < 7; ++mI) { if (mI != n) cnt += (g[mI] > g[n] || (g[mI] == g[n] && mI < n)) ? 1 : 0; }
      if (n < qb && cnt < 3) selmask |= (1u << n); }
  }
  for (int it = 0; it < NT; ++it) {
    const int j = TILE(it), buf = it & 1;
    if (it + 1 < NT) SDMA(TILE(it + 1) * KVBLK, buf ^ 1);
    const int jb = j - (NT - 4);
    bool skip = false;
    if (MODE == 1) skip = (jb >= 0) && (64 * jb > wid * 32 + 31);
    if (MODE == 2) skip = (jb >= 0) && (64 * jb >= wid * 32 + 31);
    if (!skip) {
      f32x16 p0, p1; bf16x8 pa0, pa1, pa2, pa3;
      qkt(p0, p1, K_lds + buf * SHM_K, qr, r32, hi);
      if (MODE == 2) {
        sb_tile(p0, p1, carry, jb >= 0, 64 * jb, qrel, hi);
      } else {
        if (MODE == 1) {
          if (jb < 0) { const bool s = (selmask >> (j >> 2)) & 1u;
#pragma unroll
            for (int r = 0; r < 16; ++r) { p0[r] = s ? p0[r] : -INFINITY; p1[r] = s ? p1[r] : -INFINITY; } }
          else {
#pragma unroll
            for (int r = 0; r < 16; ++r) { const int kr = 64 * jb + crow(r, hi); if (kr > qrel) p0[r] = -INFINITY; if (kr + 32 > qrel) p1[r] = -INFINITY; } }
        }
        float alpha; softmax_tile(p0, p1, m_reg, l_reg, alpha);
        if (__any(alpha < 1.f)) { if (hi == 0) al_l[r32] = alpha; asm volatile("s_waitcnt lgkmcnt(0)" ::: "memory");
#pragma unroll
          for (int d = 0; d < 4; ++d)
#pragma unroll
            for (int r = 0; r < 16; ++r) o[d][r] *= al_l[crow(r, hi)]; }
      }
      pack_p(p0, p1, pa0, pa1, pa2, pa3);
      pv_d0(o, vb0 + buf * SHM_V, pa0, pa1, pa2, pa3);
    }
    SDRAIN();
    __syncthreads();
  }
  float rli[16];
  if (MODE != 2) { if (hi == 0) li_l[r32] = l_reg; asm volatile("s_waitcnt lgkmcnt(0)" ::: "memory");
#pragma unroll
    for (int r = 0; r < 16; ++r) rli[r] = __builtin_amdgcn_rcpf(li_l[crow(r, hi)]); }
  else {
#pragma unroll
    for (int r = 0; r < 16; ++r) rli[r] = 1.f; }
  if (gain) {
    float gv[4];
#pragma unroll
    for (int d0 = 0; d0 < 4; ++d0) gv[d0] = gain[d0 * 32 + r32];
#pragma unroll
    for (int r = 0; r < 16; ++r) { float s = 0.f;
#pragma unroll
      for (int d0 = 0; d0 < 4; ++d0) { o[d0][r] *= rli[r]; s += o[d0][r] * o[d0][r]; }
      s += __shfl_xor(s, 1); s += __shfl_xor(s, 2); s += __shfl_xor(s, 4); s += __shfl_xor(s, 8); s += __shfl_xor(s, 16);
      rli[r] = __builtin_amdgcn_rsqf(s * (1.0f / 128.0f) + 1e-6f); }
#pragma unroll
    for (int r = 0; r < 16; ++r)
#pragma unroll
      for (int d0 = 0; d0 < 4; ++d0) o[d0][r] *= gv[d0];
  }
  { bf16* stg = (bf16*)lds + wid * 4096;
#pragma unroll
    for (int r = 0; r < 16; ++r) { const int orow = crow(r, hi);
#pragma unroll
      for (int d0 = 0; d0 < 4; ++d0) { const float v = o[d0][r] * rli[r]; unsigned u = __float_as_uint(v); u = (u + 0x7fffu + ((u >> 16) & 1u)) >> 16; stg[orow * 128 + d0 * 32 + r32] = (bf16)u; } }
    asm volatile("s_waitcnt lgkmcnt(0)" ::: "memory");
#pragma unroll
    for (int i = 0; i < 8; ++i) { const int row = i * 4 + (lane >> 4), ch = lane & 15; const u32x4 v = *(const u32x4*)(stg + row * 128 + ch * 8); *(u32x4*)(Ob + (long)(wid * 32 + row) * ldo + ch * 8) = v; } }
  __syncthreads();
#undef TILE
#undef SDMA
#undef SDRAIN
}
#undef KSWZ
#undef SBAR
}
#define GAS __attribute__((address_space(1)))
#define LAS __attribute__((address_space(3)))
typedef unsigned short bf16;
typedef unsigned v4u __attribute__((ext_vector_type(4)));
typedef float f32x4 __attribute__((ext_vector_type(4)));
#define LDS_WAIT() asm volatile("s_waitcnt lgkmcnt(0)" ::: "memory")
constexpr int NWAVES = 8;
constexpr int BATCH = 8, SEQ = 2048, DM = 2048, M = BATCH * SEQ, HD = 128, NH = 8;
constexpr int NQKV = 6144, FF = 5632, WX = 512, NMEM = 256, MMEM = BATCH * NMEM;
constexpr int QSB = 0, KSB = 1024, VSB = 2048, QMB = 3072, KMB = 4096, VMB = 5120;
constexpr float EPS = 1e-6f;
constexpr float QSCALE = 0.12751743082459868f;
constexpr size_t MiB = 1u << 20;
constexpr size_t WS_CTL = 0, CTL_ZERO_BYTES = 1 * MiB;
constexpr size_t WS_SSQ1 = 64 * 1024, WS_SSQ2 = 128 * 1024;
constexpr size_t WS_WIN = 1 * MiB, WS_WOUT = 25 * MiB, WS_WXQ = 33 * MiB, WS_WXKV = 35 * MiB, WS_WXO = 39 * MiB, WS_WGU = 41 * MiB, WS_WDN = 85 * MiB;
constexpr size_t WS_RA = 107 * MiB;
constexpr size_t WS_RB = 171 * MiB;
constexpr size_t WS_RC = 235 * MiB;
constexpr size_t WS_QX = 427 * MiB, WS_OX = 443 * MiB, WS_KVX = 459 * MiB, WS_MN = 463 * MiB, WS_KMEAN = 471 * MiB, WS_CS = 472 * MiB, WS_END = 474 * MiB;
constexpr int RING_BYTES = 131072, LDS_BYTES = 147456;
#ifndef FFN_FP8
#define FFN_FP8 1
#endif
constexpr float S_X2 = 16.f, S_WGU = 32.f, S_ACT = 8.f, S_WDN = 64.f;

__device__ __forceinline__ float bf2f(unsigned short b) { return __uint_as_float((unsigned)b << 16); }
__device__ __forceinline__ unsigned f2bf(float f) { unsigned u = __builtin_bit_cast(unsigned, f); return (u + 0x7fffu + ((u >> 16) & 1u)) >> 16; }
__device__ __forceinline__ unsigned pk2(float lo, float hi) { return f2bf(lo) | (f2bf(hi) << 16); }
__device__ __forceinline__ float wave_sum(float v) {
#pragma unroll
    for (int o = 1; o < 64; o <<= 1) v += __shfl_xor(v, o);
    return v;
}
__device__ __forceinline__ float wave_max(float v) {
#pragma unroll
    for (int o = 1; o < 64; o <<= 1) v = fmaxf(v, __shfl_xor(v, o));
    return v;
}

typedef GAS unsigned gu32;
#define RLX_AGENT __ATOMIC_RELAXED, __HIP_MEMORY_SCOPE_AGENT
constexpr int CW_BAR = 4096;
constexpr int LDSCTL_OFF = RING_BYTES, MISC_OFF = LDSCTL_OFF + 320;
#define XB_TMO      128
#define XB_XCNT(j)  (256  + 64 * (j))
#define XB_XSUB(j)  (1280 + 64 * (j))
#define XB_XGEN(j)  (2304 + 64 * (j))
#define XB_TOP      3328
#define XB_TOPGEN   3392
#define XCD_BAR_WORDS 3456
#define XB_SPIN_CAP (1u << 18)

__device__ __forceinline__ unsigned xb_ld(unsigned* p)              { return __hip_atomic_load(p, __ATOMIC_RELAXED, __HIP_MEMORY_SCOPE_AGENT); }
__device__ __forceinline__ unsigned xb_add(unsigned* p, unsigned v) { return __hip_atomic_fetch_add(p, v, __ATOMIC_RELAXED, __HIP_MEMORY_SCOPE_AGENT); }
__device__ __forceinline__ unsigned xb_xcc_id() { return (unsigned)__builtin_amdgcn_s_getreg((3 << 11) | 20) & 0xFu; }
#define XB_SPIN(cond, bar) do { unsigned _sp = 0; while (cond) { __builtin_amdgcn_s_sleep(1); \
    if ((++_sp & 255u) == 0u) { if (xb_ld(&(bar)[XB_TMO])) break; if (_sp > XB_SPIN_CAP) { atomicAdd(&(bar)[XB_TMO], 1u); break; } } } } while (0)

struct XcdBarrier {
    unsigned* bar; unsigned x;
    volatile LAS unsigned* st;
};

__device__ __forceinline__ XcdBarrier xcd_barrier_post(unsigned* bar, volatile LAS unsigned* st) {
    XcdBarrier b; b.bar = bar; b.x = xb_xcc_id(); b.st = st;
    if (threadIdx.x == 0) (void)xb_add(&bar[XB_XCNT(b.x)], 1u);
    return b;
}
__device__ __forceinline__ void xcd_barrier_complete(unsigned* bar, unsigned x, unsigned& nloc, unsigned& nx) {
    const unsigned G = gridDim.x * gridDim.y * gridDim.z;
    unsigned sum, cnt, mine, sp = 0u;
    for (;;) {
        sum = 0u; cnt = 0u; mine = 0u;
#pragma unroll
        for (unsigned j = 0; j < 16; ++j) { const unsigned c = xb_ld(&bar[XB_XCNT(j)]); sum += c; cnt += (c > 0u) ? 1u : 0u; mine = (j == x) ? c : mine; }
        if (sum == G) break;
        __builtin_amdgcn_s_sleep(1);
        if ((++sp & 255u) == 0u) { if (xb_ld(&bar[XB_TMO])) break; if (sp > XB_SPIN_CAP) { atomicAdd(&bar[XB_TMO], 1u); break; } }
    }
    nloc = mine > 0u ? mine : 1u; nx = cnt > 0u ? cnt : 1u;
}

__device__ __forceinline__ void xcd_barrier(const XcdBarrier& b) {
    asm volatile("s_waitcnt vmcnt(0)" ::: "memory");
    __syncthreads();
    if (threadIdx.x == 0) {
        unsigned* bar = b.bar;
        __builtin_amdgcn_s_waitcnt(0);
        unsigned nloc = b.st[0], nx = b.st[1];
        if (nloc == 0u) { xcd_barrier_complete(bar, b.x, nloc, nx); b.st[0] = nloc; b.st[1] = nx; }
        const unsigned old = xb_add(&bar[XB_XSUB(b.x)], 1u);
        const unsigned gen = old / nloc;
        if (old + 1u == (gen + 1u) * nloc) {
            __builtin_amdgcn_fence(__ATOMIC_RELEASE, "agent");
            asm volatile("s_waitcnt vmcnt(0)" ::: "memory");
            const unsigned og = xb_add(&bar[XB_TOP], 1u);
            const unsigned tg = og / nx;
            if (og + 1u == (tg + 1u) * nx) xb_add(&bar[XB_TOPGEN], 1u);
            else XB_SPIN(xb_ld(&bar[XB_TOPGEN]) == tg, bar);
            __builtin_amdgcn_fence(__ATOMIC_ACQUIRE, "agent");
            xb_add(&bar[XB_XGEN(b.x)], 1u);
            asm volatile("s_waitcnt vmcnt(0)" ::: "memory");
        } else {
            XB_SPIN(xb_ld(&bar[XB_XGEN(b.x)]) == gen, bar);
            __builtin_amdgcn_fence(__ATOMIC_ACQUIRE, "agent");
            asm volatile("s_waitcnt vmcnt(0)" ::: "memory");
        }
    }
    __syncthreads();
}

struct Frame {
    LAS unsigned char* lds;
    int tid, lane, wave, vcu, G;
    const float *x, *mem; const int* pos;
    const float *g_mix, *w_in, *g_out_sb, *g_out_mb, *w_out, *g_xattn, *g_mem, *w_xq, *w_xkv, *w_xo, *g_ffn, *w_gu, *w_dn, *g_final;
    float* out; unsigned char* ws;
};

__device__ __forceinline__ void transpose_item(const float* W, int K, int N, bf16* WT, const float* gain, int inter, LAS float* scr, int item, int lane) {
    const int nblk = N / 32, kb = item / nblk, nb = item % nblk, k0 = 64 * kb, n0 = 32 * nb;
    int orow0 = n0;
    if (inter) orow0 = (n0 < FF) ? (n0 / 128) * 256 + (n0 % 128) : ((n0 - FF) / 128) * 256 + 128 + ((n0 - FF) % 128);
    float v[32];
#pragma unroll
    for (int i = 0; i < 32; ++i) v[i] = W[(size_t)(k0 + 2 * i + (lane >> 5)) * N + n0 + (lane & 31)];
#pragma unroll
    for (int i = 0; i < 32; ++i) { const int kk = 2 * i + (lane >> 5); float t = v[i]; if (gain) t *= gain[k0 + kk]; scr[kk * 33 + (lane & 31)] = t; }
    LDS_WAIT(); asm volatile("" ::: "memory");
    const int c = lane & 7;
#pragma unroll
    for (int j = 0; j < 4; ++j) { const int n = (lane >> 3) + 8 * j; const LAS float* s = scr + (8 * c) * 33 + n;
        v4u o; o.x = pk2(s[0 * 33], s[1 * 33]); o.y = pk2(s[2 * 33], s[3 * 33]); o.z = pk2(s[4 * 33], s[5 * 33]); o.w = pk2(s[6 * 33], s[7 * 33]);
        *(GAS v4u*)(WT + (size_t)(orow0 + n) * K + k0 + 8 * c) = o; }
    LDS_WAIT(); asm volatile("" ::: "memory");
}
__device__ __forceinline__ void transpose_item_fp8(const float* W, int K, int N, unsigned char* WT, const float* gain, int inter, float scale, LAS float* scr, int item, int lane) {
    const int nblk = N / 32, kb = item / nblk, nb = item % nblk, k0 = 64 * kb, n0 = 32 * nb;
    int orow0 = n0;
    if (inter) orow0 = (n0 < FF) ? (n0 / 128) * 256 + (n0 % 128) : ((n0 - FF) / 128) * 256 + 128 + ((n0 - FF) % 128);
    float v[32];
#pragma unroll
    for (int i = 0; i < 32; ++i) v[i] = W[(size_t)(k0 + 2 * i + (lane >> 5)) * N + n0 + (lane & 31)];
#pragma unroll
    for (int i = 0; i < 32; ++i) { const int kk = 2 * i + (lane >> 5); float t = v[i] * scale; if (gain) t *= gain[k0 + kk]; scr[kk * 33 + (lane & 31)] = t; }
    LDS_WAIT(); asm volatile("" ::: "memory");
    const int c = lane & 7;
#pragma unroll
    for (int j = 0; j < 4; ++j) { const int n = (lane >> 3) + 8 * j; const LAS float* s = scr + (8 * c) * 33 + n;
        pg8::u32x2 o; o.x = pg8::pk4_fp8(s[0 * 33], s[1 * 33], s[2 * 33], s[3 * 33]); o.y = pg8::pk4_fp8(s[4 * 33], s[5 * 33], s[6 * 33], s[7 * 33]);
        *(GAS pg8::u32x2*)(WT + (size_t)(orow0 + n) * K + k0 + 8 * c) = o; }
    LDS_WAIT(); asm volatile("" ::: "memory");
}
__device__ __forceinline__ void rms_row_to_bf16(const float* xrow, const float* g, bf16* orow, int lane) {
    const GAS f32x4* xr = (const GAS f32x4*)xrow + lane; const GAS f32x4* gr = (const GAS f32x4*)g + lane;
    f32x4 v[8]; float s = 0.f;
#pragma unroll
    for (int j = 0; j < 8; ++j) { v[j] = xr[64 * j]; s += (v[j].x * v[j].x + v[j].y * v[j].y) + (v[j].z * v[j].z + v[j].w * v[j].w); }
    const float rstd = 1.0f / sqrtf(wave_sum(s) * (1.f / DM) + EPS);
    GAS unsigned long long* o8 = (GAS unsigned long long*)orow + lane;
#pragma unroll
    for (int j = 0; j < 8; ++j) { const f32x4 gg = gr[64 * j];
        o8[64 * j] = (unsigned long long)pk2(v[j].x * rstd * gg.x, v[j].y * rstd * gg.y) | ((unsigned long long)pk2(v[j].z * rstd * gg.z, v[j].w * rstd * gg.w) << 32); }
}
__constant__ float INV_FREQ[16] = {1.000000000e+00f, 4.403665960e-01f, 1.939227432e-01f, 8.539710194e-02f, 3.760603070e-02f, 1.656043902e-02f, 7.292664610e-03f, 3.211445874e-03f,
                                   1.414213562e-03f, 6.227723788e-04f, 2.742481884e-04f, 1.207697351e-04f, 5.318296098e-05f, 2.341999971e-05f, 1.031338616e-05f, 4.541670478e-06f};

__device__ __forceinline__ void p0_prologue(Frame& F) {
    LAS float* scr = (LAS float*)(F.lds + F.wave * 16384);
    const int gw = F.vcu * NWAVES + F.wave, NGW = F.G * NWAVES;
    bf16* ws16 = (bf16*)F.ws;
    constexpr int I0 = (DM / 64) * (NQKV / 32), I1 = (DM / 64) * (DM / 32), I2 = (DM / 64) * (WX / 32), I3 = (DM / 64) * (2 * WX / 32), I4 = (WX / 64) * (DM / 32),
                  I5 = (DM / 64) * (2 * FF / 32), I6 = (FF / 64) * (DM / 32);
    constexpr int NITEMS = I0 + I1 + I2 + I3 + I4 + I5 + I6;
    for (int it = gw; it < NITEMS; it += NGW) {
        int r = it;
        if (r < I0) { transpose_item(F.w_in, DM, NQKV, (bf16*)(F.ws + WS_WIN), nullptr, 0, scr, r, F.lane); continue; } r -= I0;
        if (r < I1) { transpose_item(F.w_out, DM, DM, (bf16*)(F.ws + WS_WOUT), nullptr, 0, scr, r, F.lane); continue; } r -= I1;
        if (r < I2) { transpose_item(F.w_xq, DM, WX, (bf16*)(F.ws + WS_WXQ), F.g_xattn, 0, scr, r, F.lane); continue; } r -= I2;
        if (r < I3) { transpose_item(F.w_xkv, DM, 2 * WX, (bf16*)(F.ws + WS_WXKV), nullptr, 0, scr, r, F.lane); continue; } r -= I3;
        if (r < I4) { transpose_item(F.w_xo, WX, DM, (bf16*)(F.ws + WS_WXO), nullptr, 0, scr, r, F.lane); continue; } r -= I4;
#if FFN_FP8
        if (r < I5) { transpose_item_fp8(F.w_gu, DM, 2 * FF, F.ws + WS_WGU, F.g_ffn, 1, S_WGU, scr, r, F.lane); continue; } r -= I5;
        transpose_item_fp8(F.w_dn, FF, DM, F.ws + WS_WDN, nullptr, 0, S_WDN, scr, r, F.lane);
#else
        if (r < I5) { transpose_item(F.w_gu, DM, 2 * FF, (bf16*)(F.ws + WS_WGU), F.g_ffn, 1, scr, r, F.lane); continue; } r -= I5;
        transpose_item(F.w_dn, FF, DM, (bf16*)(F.ws + WS_WDN), nullptr, 0, scr, r, F.lane);
#endif
    }
    (void)ws16;
    for (int m = gw; m < M; m += NGW) rms_row_to_bf16(F.x + (size_t)m * DM, F.g_mix, (bf16*)(F.ws + WS_RA) + (size_t)m * DM, F.lane);
    for (int m = gw; m < MMEM; m += NGW) rms_row_to_bf16(F.mem + (size_t)m * DM, F.g_mem, (bf16*)(F.ws + WS_MN) + (size_t)m * DM, F.lane);
    float* cs = (float*)(F.ws + WS_CS);
    for (int e = (F.vcu * NWAVES + F.wave) * 64 + F.lane; e < M * 16; e += NGW * 64) {
        const int m = e >> 4, i = e & 15; const float ang = (float)F.pos[m] * INV_FREQ[i];
        double rev = (double)ang * 0.15915494309189535; rev -= floor(rev);
        const float a = (float)(rev * 6.283185307179586);
        cs[(size_t)m * 32 + i] = cosf(a); cs[(size_t)m * 32 + 16 + i] = sinf(a);
    }
}

__device__ __forceinline__ float dot128(const LAS float* qs, const bf16* krow) {
    float s = 0.f;
#pragma unroll
    for (int c = 0; c < 16; ++c) { const v4u kv = *(const v4u*)(krow + 8 * c); const LAS f32x4* q4 = (const LAS f32x4*)(qs + 8 * c); const f32x4 qa = q4[0], qb = q4[1];
        s += qa.x * __uint_as_float(kv.x << 16) + qa.y * __uint_as_float(kv.x & 0xffff0000u) + qa.z * __uint_as_float(kv.y << 16) + qa.w * __uint_as_float(kv.y & 0xffff0000u)
           + qb.x * __uint_as_float(kv.z << 16) + qb.y * __uint_as_float(kv.z & 0xffff0000u) + qb.z * __uint_as_float(kv.w << 16) + qb.w * __uint_as_float(kv.w & 0xffff0000u); }
    return s;
}
__device__ __forceinline__ void load_q_lds(LAS float* qs, const bf16* qp, int lane) { qs[lane] = bf2f(qp[lane]); qs[64 + lane] = bf2f(qp[64 + lane]); LDS_WAIT(); asm volatile("" ::: "memory"); }
__device__ __forceinline__ void pv64(float w, const bf16* vbase, size_t ld, int cnt, int lane, float& o0, float& o1) {
    for (int i = 0; i < cnt; ++i) { const float wi = __shfl(w, i); const unsigned vv = *(const unsigned*)(vbase + (size_t)i * ld + 2 * lane); o0 += wi * __uint_as_float(vv << 16); o1 += wi * __uint_as_float(vv & 0xffff0000u); }
}
__device__ __forceinline__ float softplus2(float y) { return fmaxf(y, 0.f) + __builtin_amdgcn_logf(1.0f + __builtin_amdgcn_exp2f(-fabsf(y))); }
__device__ __forceinline__ void store_head_norm(float o0, float o1, const float* g, bf16* op, int lane) {
    const float ssq = wave_sum(o0 * o0 + o1 * o1); const float r = 1.0f / sqrtf(ssq * (1.f / HD) + EPS);
    *(unsigned*)(op + 2 * lane) = pk2(o0 * r * g[2 * lane], o1 * r * g[2 * lane + 1]);
}
__device__ __forceinline__ void naive_sb_row(Frame& F, LAS float* qs, int bh, int t) {
    const int b = bh >> 3, h = bh & 7, lane = F.lane; const bf16* qkv = (const bf16*)(F.ws + WS_RC); const size_t rb = (size_t)b * SEQ;
    load_q_lds(qs, qkv + (rb + t) * NQKV + QSB + h * HD, lane);
    const bf16* kp = qkv + rb * NQKV + KSB + h * HD; const bf16* vp = qkv + rb * NQKV + VSB + h * HD;
    float o0 = 0.f, o1 = 0.f, carry = 0.f;
    for (int c = (t - 1) >> 6; c >= 0; --c) {
        const int key = c * 64 + lane; const bool valid = key < t;
        float y = 0.f; if (valid) y = dot128(qs, kp + (size_t)key * NQKV);
        const float sp = valid ? softplus2(y) : 0.f;
        float suf = sp;
#pragma unroll
        for (int off = 1; off < 64; off <<= 1) { const float tt = __shfl_down(suf, off); if (lane + off < 64) suf += tt; }
        const float w = valid ? __builtin_amdgcn_exp2f(y - (suf + carry)) : 0.f;
        carry += __shfl(suf, 0);
        const int cnt = (t - c * 64) < 64 ? (t - c * 64) : 64;
        pv64(w, vp + (size_t)(c * 64) * NQKV, NQKV, cnt, lane, o0, o1);
    }
    store_head_norm(o0, o1, F.g_out_sb + h * HD, (bf16*)(F.ws + WS_RA) + (rb + t) * DM + h * HD, lane);
    LDS_WAIT();
}
__device__ __forceinline__ void softmax_chunk(float s, bool valid, const bf16* vbase, size_t ld, int cnt, int lane, float& m, float& l, float& o0, float& o1) {
    const float cm = wave_max(valid ? s : -1e30f); const float mn = fmaxf(m, cm); const float alpha = __builtin_amdgcn_exp2f(m - mn);
    const float p = valid ? __builtin_amdgcn_exp2f(s - mn) : 0.f;
    l = l * alpha + wave_sum(p); o0 *= alpha; o1 *= alpha; m = mn;
    pv64(p, vbase, ld, cnt, lane, o0, o1);
}
__device__ __forceinline__ void naive_moba_row(Frame& F, LAS float* qs, int bh, int t) {
    const int b = bh >> 3, h = bh & 7, lane = F.lane; const bf16* qkv = (const bf16*)(F.ws + WS_RC); const size_t rb = (size_t)b * SEQ;
    load_q_lds(qs, qkv + (rb + t) * NQKV + QMB + h * HD, lane);
    const bf16* kp = qkv + rb * NQKV + KMB + h * HD; const bf16* vp = qkv + rb * NQKV + VMB + h * HD;
    const int blk = t >> 8;
    const float* km = (const float*)(F.ws + WS_KMEAN) + (size_t)bh * 8 * HD;
    float g = -INFINITY;
    { const int n = lane & 7; if (n < blk) { float a = 0.f; for (int d = 0; d < HD; ++d) a += qs[d] * km[n * HD + d]; g = a; } }
    int cnt = 0;
#pragma unroll
    for (int mI = 0; mI < 8; ++mI) { const float gm = __shfl(g, mI); cnt += (gm > g || (gm == g && mI < (lane & 7))) ? 1 : 0; }
    const bool sel = (lane < 8) && (lane < blk) && (cnt < 3);
    const unsigned selmask = (unsigned)(__ballot(sel) & 0xffull);
    float m = -1e30f, l = 0.f, o0 = 0.f, o1 = 0.f;
    for (int n = 0; n <= blk; ++n) {
        if (n < blk && !((selmask >> n) & 1u)) continue;
        for (int c = 0; c < 4; ++c) {
            const int key0 = n * 256 + c * 64; if (key0 > t) break;
            const int key = key0 + lane; const bool valid = key <= t;
            float s = 0.f; if (valid) s = dot128(qs, kp + (size_t)key * NQKV);
            const int cn = (t - key0 + 1) < 64 ? (t - key0 + 1) : 64;
            softmax_chunk(s, valid, vp + (size_t)key0 * NQKV, NQKV, cn, lane, m, l, o0, o1);
        }
    }
    const float il = 1.0f / l;
    store_head_norm(o0 * il, o1 * il, F.g_out_mb + h * HD, (bf16*)(F.ws + WS_RA) + (rb + t) * DM + NH * HD + h * HD, lane);
    LDS_WAIT();
}
__device__ __forceinline__ void naive_xattn_row(Frame& F, LAS float* qs, int b, int h, int t) {
    const int lane = F.lane; const bf16* qx = (const bf16*)(F.ws + WS_QX); const bf16* kv = (const bf16*)(F.ws + WS_KVX);
    load_q_lds(qs, qx + ((size_t)b * SEQ + t) * WX + h * HD, lane);
    const bf16* kp = kv + (size_t)b * NMEM * (2 * WX) + h * HD; const bf16* vp = kp + WX;
    float m = -1e30f, l = 0.f, o0 = 0.f, o1 = 0.f;
    for (int c = 0; c < 4; ++c) { const int key = c * 64 + lane; const float s = dot128(qs, kp + (size_t)key * (2 * WX));
        softmax_chunk(s, true, vp + (size_t)(c * 64) * (2 * WX), 2 * WX, 64, lane, m, l, o0, o1); }
    const float il = 1.0f / l;
    *(unsigned*)((bf16*)(F.ws + WS_OX) + ((size_t)b * SEQ + t) * WX + h * HD + 2 * lane) = pk2(o0 * il, o1 * il);
    LDS_WAIT();
}
__device__ __forceinline__ void kmean_phase(Frame& F) {
    LAS float* red = (LAS float*)F.lds;
    const bf16* qkv = (const bf16*)(F.ws + WS_RC); float* km = (float*)(F.ws + WS_KMEAN);
    const int cc = F.tid & 15, rg = F.tid >> 4;
    for (int item = F.vcu; item < 64 * 8; item += F.G) {
        const int bh = item >> 3, n = item & 7, b = bh >> 3, h = bh & 7;
        const bf16* kp = qkv + ((size_t)b * SEQ + n * 256 + rg * 8) * NQKV + KMB + h * HD + cc * 8;
        float a[8] = {0, 0, 0, 0, 0, 0, 0, 0};
#pragma unroll
        for (int r = 0; r < 8; ++r) { const v4u kv = *(const v4u*)(kp + (size_t)r * NQKV);
            a[0] += __uint_as_float(kv.x << 16); a[1] += __uint_as_float(kv.x & 0xffff0000u); a[2] += __uint_as_float(kv.y << 16); a[3] += __uint_as_float(kv.y & 0xffff0000u);
            a[4] += __uint_as_float(kv.z << 16); a[5] += __uint_as_float(kv.z & 0xffff0000u); a[6] += __uint_as_float(kv.w << 16); a[7] += __uint_as_float(kv.w & 0xffff0000u); }
#pragma unroll
        for (int j = 0; j < 8; ++j) red[rg * 128 + cc * 8 + j] = a[j];
        __syncthreads();
        if (F.tid < 128) { float s = 0.f; for (int r = 0; r < 32; ++r) s += red[r * 128 + F.tid]; km[(size_t)item * HD + F.tid] = s * (1.0f / 256.0f); }
        __syncthreads();
    }
}
__device__ __forceinline__ void final_norm_phase(Frame& F, const bf16* src, float* dst) {
    const int gw = F.vcu * NWAVES + F.wave, NGW = F.G * NWAVES;
    for (int m = gw; m < M; m += NGW) {
        const GAS v4u* xr = (const GAS v4u*)(src + (size_t)m * DM) + F.lane; const GAS f32x4* gr = (const GAS f32x4*)F.g_final;
        v4u w[4]; float s = 0.f;
#pragma unroll
        for (int j = 0; j < 4; ++j) w[j] = xr[64 * j];
        f32x4 v[8];
#pragma unroll
        for (int j = 0; j < 4; ++j) { v[2 * j] = (f32x4){__uint_as_float(w[j].x << 16), __uint_as_float(w[j].x & 0xffff0000u), __uint_as_float(w[j].y << 16), __uint_as_float(w[j].y & 0xffff0000u)};
            v[2 * j + 1] = (f32x4){__uint_as_float(w[j].z << 16), __uint_as_float(w[j].z & 0xffff0000u), __uint_as_float(w[j].w << 16), __uint_as_float(w[j].w & 0xffff0000u)}; }
#pragma unroll
        for (int j = 0; j < 8; ++j) s += (v[j].x * v[j].x + v[j].y * v[j].y) + (v[j].z * v[j].z + v[j].w * v[j].w);
        const float rstd = 1.0f / sqrtf(wave_sum(s) * (1.f / DM) + EPS);
        GAS f32x4* dr = (GAS f32x4*)(dst + (size_t)m * DM);
#pragma unroll
        for (int j = 0; j < 4; ++j) { const int c4 = (64 * j + F.lane) * 2;
            dr[c4] = v[2 * j] * rstd * gr[c4]; dr[c4 + 1] = v[2 * j + 1] * rstd * gr[c4 + 1]; }
    }
}

constexpr int NPH = 11;
#ifndef REPEAT_PHASE
#define REPEAT_PHASE -1
#endif
#ifndef REPEAT_MASK
#define REPEAT_MASK 0
#endif
#define REPS(k) (((REPEAT_PHASE == (k)) || ((REPEAT_MASK >> (k)) & 1)) ? 2 : 1)
#ifndef USE_MFMA_SB
#define USE_MFMA_SB 1
#endif
#ifndef USE_MFMA_MOBA
#define USE_MFMA_MOBA 1
#endif
#ifndef USE_MFMA_X
#define USE_MFMA_X 1
#endif
#ifndef MK_ONE_LAUNCH
#define MK_ONE_LAUNCH 1
#endif
struct Args { const void* in[17]; float* out; unsigned char* ws; int ph_lo, ph_hi; };
__global__ void __launch_bounds__(NWAVES * 64, 2) mk_fwd(Args args) {
    extern __shared__ __attribute__((aligned(16))) unsigned char lds[];
    Frame F;
    F.lds = (LAS unsigned char*)lds;
    F.tid = threadIdx.x; F.lane = F.tid & 63; F.wave = __builtin_amdgcn_readfirstlane(F.tid >> 6);
    F.G = gridDim.x; { const int bx = blockIdx.x; F.vcu = (F.G % 8 == 0) ? (bx % 8) * (F.G / 8) + bx / 8 : bx; }
    F.x = (const float*)args.in[0]; F.mem = (const float*)args.in[1]; F.pos = (const int*)args.in[2];
    F.g_mix = (const float*)args.in[3]; F.w_in = (const float*)args.in[4]; F.g_out_sb = (const float*)args.in[5]; F.g_out_mb = (const float*)args.in[6]; F.w_out = (const float*)args.in[7];
    F.g_xattn = (const float*)args.in[8]; F.g_mem = (const float*)args.in[9]; F.w_xq = (const float*)args.in[10]; F.w_xkv = (const float*)args.in[11]; F.w_xo = (const float*)args.in[12];
    F.g_ffn = (const float*)args.in[13]; F.w_gu = (const float*)args.in[14]; F.w_dn = (const float*)args.in[15]; F.g_final = (const float*)args.in[16];
    F.out = args.out; F.ws = args.ws;
    unsigned char* ws = args.ws;
    const int lo = args.ph_lo, hi = args.ph_hi;
    for (int u = F.tid; u < (LDS_BYTES - LDSCTL_OFF) / 4; u += NWAVES * 64) ((LAS unsigned*)(F.lds + LDSCTL_OFF))[u] = 0u;
    __syncthreads();
    if (hi - lo > 1) cg::this_grid().sync();
    XcdBarrier bar = xcd_barrier_post((unsigned*)(ws + WS_CTL) + CW_BAR, (volatile LAS unsigned*)(F.lds + MISC_OFF) + 8);
#ifndef ONLY_PHASE
#define ONLY_PHASE -1
#endif
#define IN(k) ((ONLY_PHASE < 0 || ONLY_PHASE == (k)) && lo <= (k) && (k) < hi)
#define BOTH(k) (IN(k) && IN((k) + 1))
#define GRID_BAR() xcd_barrier(bar)
    float* ssq1 = (float*)(ws + WS_SSQ1); float* ssq2 = (float*)(ws + WS_SSQ2);
    pg8::bf16_t* RA = (pg8::bf16_t*)(ws + WS_RA); pg8::bf16_t* RB = (pg8::bf16_t*)(ws + WS_RB); pg8::bf16_t* RC = (pg8::bf16_t*)(ws + WS_RC);

    if (IN(0)) { for (int rep = 0; rep < REPS(0); ++rep) p0_prologue(F); if (BOTH(0)) GRID_BAR(); }
    if (IN(1)) {
        pg8::Gemm g{RA, (const pg8::bf16_t*)(ws + WS_WIN), M, NQKV, DM}; pg8::StaticOrder S; S.init(M, NQKV, F.G, (int)blockIdx.x);
        pg8::EpiQKV E{RC, (const float*)(ws + WS_CS), QSCALE};
        for (int rep = 0; rep < REPS(1); ++rep) pg8::gemm_phase<pg8::EpiQKV, pg8::StaticOrder, true, true>(F.lds, g, S, E);
        if (BOTH(1)) GRID_BAR();
    }
    if (IN(2)) { for (int rep = 0; rep < REPS(2); ++rep) kmean_phase(F); if (BOTH(2)) GRID_BAR(); }
    if (IN(3)) {
        const att::bf16* qkv = (const att::bf16*)RC; att::bf16* ob = (att::bf16*)RA; const float* kmean = (const float*)(ws + WS_KMEAN);
#if !(USE_MFMA_SB && USE_MFMA_MOBA)
        LAS float* qs = (LAS float*)(F.lds + F.wave * 1024);
        const int gw = F.vcu * NWAVES + F.wave, NGW = F.G * NWAVES;
#endif
#if !USE_MFMA_SB
        for (int i = gw; i < 64 * SEQ; i += NGW) { const int bh = i >> 11, t = (int)(((unsigned)i + (unsigned)(i >> 11) * 997u) & 2047u); naive_sb_row(F, qs, bh, t); }
#endif
#if !USE_MFMA_MOBA
        for (int i = gw; i < 64 * SEQ; i += NGW) { const int bh = i >> 11, t = (int)(((unsigned)i + (unsigned)(i >> 11) * 997u) & 2047u); naive_moba_row(F, qs, bh, t); }
        __syncthreads();
#endif
        for (int rep = 0; rep < REPS(3); ++rep) {
#if USE_MFMA_SB
        for (int vv = F.vcu; vv < 256; vv += F.G) { const int bh = vv >> 2, s = vv & 3, b = bh >> 3, h = bh & 7; const size_t rb = (size_t)b * SEQ;
            for (int i = 0; i < 2; ++i) { const int qb = i ? s : 7 - s; const size_t r0 = rb + (size_t)qb * 256;
                att::attn_unit<2>(qkv + r0 * NQKV + QSB + h * HD, NQKV, qkv + rb * NQKV + KSB + h * HD, qkv + rb * NQKV + VSB + h * HD, NQKV, ob + r0 * DM + h * HD, DM, F.g_out_sb + h * HD, nullptr, qb, 0, (char*)lds); } }
#endif
#if USE_MFMA_MOBA
        for (int vv = F.vcu; vv < 256; vv += F.G) { const int bh = vv >> 2, s = vv & 3, b = bh >> 3, h = bh & 7; const size_t rb = (size_t)b * SEQ;
            for (int i = 0; i < 2; ++i) { const int qb = i ? s : 7 - s; const size_t r0 = rb + (size_t)qb * 256;
                att::attn_unit<1>(qkv + r0 * NQKV + QMB + h * HD, NQKV, qkv + rb * NQKV + KMB + h * HD, qkv + rb * NQKV + VMB + h * HD, NQKV, ob + r0 * DM + NH * HD + h * HD, DM, F.g_out_mb + h * HD, kmean + (size_t)bh * 1024, qb, 0, (char*)lds); } }
#endif
        }
        if (BOTH(3)) GRID_BAR();
    }
    if (IN(4)) {
        pg8::Gemm g{RA, (const pg8::bf16_t*)(ws + WS_WOUT), M, DM, DM}; pg8::StaticOrder S; S.init(M, DM, F.G, (int)blockIdx.x);
        if (REPS(4) == 2) { pg8::EpiResB<true> E0{F.x, RB, nullptr, nullptr, 1.f, 1.f}; pg8::gemm_phase<pg8::EpiResB<true>, pg8::StaticOrder, true, true>(F.lds, g, S, E0); }
        pg8::EpiResB<true> E{F.x, RB, ssq1, nullptr, 1.f, 1.f};
        pg8::gemm_phase<pg8::EpiResB<true>, pg8::StaticOrder, true, true>(F.lds, g, S, E);
        if (BOTH(4)) GRID_BAR();
    }
    if (IN(5)) {
      for (int rep = 0; rep < REPS(5); ++rep) {
        { pg8::Gemm g{RB, (const pg8::bf16_t*)(ws + WS_WXQ), M, WX, DM}; pg8::StaticOrder S; S.init(M, WX, F.G, (int)blockIdx.x);
          pg8::EpiScale E{(pg8::bf16_t*)(ws + WS_QX), WX, ssq1, QSCALE};
          pg8::gemm_phase<pg8::EpiScale, pg8::StaticOrder, true, true>(F.lds, g, S, E); }
        { pg8::Gemm g{(const pg8::bf16_t*)(ws + WS_MN), (const pg8::bf16_t*)(ws + WS_WXKV), MMEM, 2 * WX, DM}; pg8::StaticOrder S; S.init(MMEM, 2 * WX, F.G, (int)((blockIdx.x + F.G - 128) % F.G));
          pg8::EpiScale E{(pg8::bf16_t*)(ws + WS_KVX), 2 * WX, nullptr, 1.0f};
          pg8::gemm_phase<pg8::EpiScale, pg8::StaticOrder, true, true>(F.lds, g, S, E); }
      }
        if (BOTH(5)) GRID_BAR();
    }
    if (IN(6)) {
#if USE_MFMA_X
        for (int rep = 0; rep < REPS(6); ++rep) {
        const att::bf16* qx = (const att::bf16*)(ws + WS_QX); const att::bf16* kvx = (const att::bf16*)(ws + WS_KVX); att::bf16* ox = (att::bf16*)(ws + WS_OX);
        for (int vv = F.vcu; vv < 256; vv += F.G) { const int b = vv >> 5, h = (vv >> 3) & 3, qb = vv & 7; const size_t r0 = (size_t)b * SEQ + (size_t)qb * 256;
            att::attn_unit<0>(qx + r0 * WX + h * HD, WX, kvx + (size_t)b * NMEM * (2 * WX) + h * HD, kvx + (size_t)b * NMEM * (2 * WX) + WX + h * HD, 2 * WX, ox + r0 * WX + h * HD, WX, nullptr, nullptr, qb, NMEM, (char*)lds); }
        }
#else
        LAS float* qs = (LAS float*)(F.lds + F.wave * 1024);
        const int gw = F.vcu * NWAVES + F.wave, NGW = F.G * NWAVES;
        for (int i = gw; i < BATCH * 4 * SEQ; i += NGW) { const int t = i & 2047, h = (i >> 11) & 3, b = i >> 13; naive_xattn_row(F, qs, b, h, t); }
#endif
        if (BOTH(6)) GRID_BAR();
    }
    if (IN(7)) {
        pg8::Gemm g{(const pg8::bf16_t*)(ws + WS_OX), (const pg8::bf16_t*)(ws + WS_WXO), M, DM, WX}; pg8::StaticOrder S; S.init(M, DM, F.G, (int)blockIdx.x);
        if (REPS(7) == 2) { pg8::EpiResB<false> E0{RB, RC, nullptr, nullptr, 1.f, 1.f}; pg8::gemm_phase<pg8::EpiResB<false>, pg8::StaticOrder, true, true>(F.lds, g, S, E0); }
        pg8::EpiResB<false> E{RB, RB, ssq2, (unsigned char*)RA, S_X2, 1.f};
        pg8::gemm_phase<pg8::EpiResB<false>, pg8::StaticOrder, true, true>(F.lds, g, S, E);
        if (BOTH(7)) GRID_BAR();
    }
    if (IN(8)) {
        pg8::Gemm g{RA, (const pg8::bf16_t*)(ws + WS_WGU), M, 2 * FF, FFN_FP8 ? DM / 2 : DM}; pg8::StaticOrder S; S.init(M, 2 * FF, F.G, (int)blockIdx.x);
        pg8::EpiSwiGLU E{RC, ssq2, FFN_FP8 ? (unsigned char*)RC : nullptr, FFN_FP8 ? 1.f / (S_X2 * S_WGU) : 1.f, S_ACT};
        for (int rep = 0; rep < REPS(8); ++rep) pg8::gemm_phase<pg8::EpiSwiGLU, pg8::StaticOrder, true, true, FFN_FP8 != 0>(F.lds, g, S, E);
        if (BOTH(8)) GRID_BAR();
    }
    if (IN(9)) {
        pg8::Gemm g{RC, (const pg8::bf16_t*)(ws + WS_WDN), M, DM, FF / 2}; pg8::StaticOrder S; S.init(M, DM, F.G, (int)blockIdx.x);
        if (REPS(9) == 2) { pg8::EpiResB<false> E0{RB, (pg8::bf16_t*)(ws + WS_RC + 96 * MiB), nullptr, nullptr, 1.f, 1.f / (S_ACT * S_WDN)}; pg8::gemm_phase<pg8::EpiResB<false>, pg8::StaticOrder, true, true, true>(F.lds, g, S, E0); }
        pg8::EpiResB<false> E{RB, RB, nullptr, nullptr, 1.f, 1.f / (S_ACT * S_WDN)};
        pg8::gemm_phase<pg8::EpiResB<false>, pg8::StaticOrder, true, true, true>(F.lds, g, S, E);
        if (BOTH(9)) GRID_BAR();
    }
    if (IN(10)) { if (REPS(10) == 2) final_norm_phase(F, RB, (float*)RC); final_norm_phase(F, RB, F.out); }
#undef IN
#undef BOTH
}

extern "C" void kernel_launch(void* const* d_in, const int* in_sizes, int n_in, void* d_out, int out_size, void* d_ws, size_t ws_size, hipStream_t stream) {
    static int grid = 0;
    if (grid == 0) {
        if (n_in != 17 || in_sizes[0] != M * DM || out_size != M * DM || ws_size < WS_END) { fprintf(stderr, "kernel_launch: unexpected shapes (n_in %d in0 %d out %d ws %zu)\n", n_in, n_in > 0 ? in_sizes[0] : -1, out_size, ws_size); grid = -1; return; }
        int dev = 0, cus = 0, per_cu = 0;
        if (hipGetDevice(&dev) != hipSuccess || hipDeviceGetAttribute(&cus, hipDeviceAttributeMultiprocessorCount, dev) != hipSuccess) { grid = -1; return; }
        if (hipFuncSetAttribute((const void*)mk_fwd, hipFuncAttributeMaxDynamicSharedMemorySize, LDS_BYTES) != hipSuccess) { fprintf(stderr, "kernel_launch: hipFuncSetAttribute failed\n"); grid = -1; return; }
        if (hipOccupancyMaxActiveBlocksPerMultiprocessor(&per_cu, (const void*)mk_fwd, NWAVES * 64, LDS_BYTES) != hipSuccess || per_cu < 1) { fprintf(stderr, "kernel_launch: occupancy query failed (%d)\n", per_cu); per_cu = 1; }
        (void)hipGetLastError();
        grid = cus * (per_cu < 1 ? 1 : 1);
    }
    if (grid < 0) return;
    (void)hipMemsetAsync((char*)d_ws + WS_CTL, 0, CTL_ZERO_BYTES, stream);
    Args a{};
    for (int i = 0; i < 17; ++i) a.in[i] = d_in[i];
    a.out = (float*)d_out; a.ws = (unsigned char*)d_ws;
#if MK_ONE_LAUNCH
    a.ph_lo = 0; a.ph_hi = NPH;
    void* kargs[] = {&a};
    hipError_t e = hipLaunchCooperativeKernel((const void*)mk_fwd, dim3(grid), dim3(NWAVES * 64), kargs, LDS_BYTES, stream);
    if (e != hipSuccess) fprintf(stderr, "kernel_launch: cooperative launch failed: %s (grid %d)\n", hipGetErrorString(e), grid);
#else
    for (int p = 0; p < NPH; ++p) { a.ph_lo = p; a.ph_hi = p + 1; hipLaunchKernelGGL(mk_fwd, dim3(grid), dim3(NWAVES * 64), LDS_BYTES, stream, a); }
    const hipError_t le = hipPeekAtLastError();
    if (le != hipSuccess) fprintf(stderr, "kernel_launch: launch failed: %s\n", hipGetErrorName(le));
#endif
}
```

```cpp
#include <hip/hip_runtime.h>
#include <hip/hip_cooperative_groups.h>
#include <cstdio>
#include <cstdint>
namespace cg = cooperative_groups;
namespace pg8 {
#define PG8_LAS __attribute__((address_space(3)))
typedef unsigned short bf16_t;
typedef short bf16x8 __attribute__((ext_vector_type(8)));
typedef float f32x4 __attribute__((ext_vector_type(4)));
typedef unsigned u32x4 __attribute__((ext_vector_type(4)));
constexpr int BM = 256, BK = 64, HALF = 128, HTB = HALF * BK * 2  , STAGE_BYTES = 8 * HTB, NXCD = 8, WGM = 8;

__host__ __device__ __forceinline__ int lds_byte(int r, int c) { const int st = (r >> 4) * 2 + (c >> 5), rr = r & 15, cc = c & 31, ob = rr * 64 + cc * 2; return st * 1024 + (ob ^ (((ob >> 9) & 1) << 5)); }
__host__ __device__ __forceinline__ void stage_rc(int b, int& R, int& C) { const int st = b / 1024, sb = b % 1024, swz = sb ^ (((sb >> 9) & 1) << 5); R = (st >> 1) * 16 + swz / 64; C = (st & 1) * 32 + (swz % 64) / 2; }
__host__ __device__ __forceinline__ int perm32(int rho) { const int n = rho >> 4, i = rho & 15; return 8 * (i >> 2) + 4 * n + (i & 3); }

struct Unit { int pm, pn; };
struct Gemm { const bf16_t* A; const bf16_t* Bt; int M, N, K; };

struct StaticOrder {
    int nM, nN, nwg, G, c;
    __host__ __device__ void init(int M, int N, int G_, int c_) { nM = M / BM; nN = N / BM; nwg = nM * nN; G = G_; c = c_; }
    __host__ __device__ bool next(int i, Unit& u) const {
        const long L = (long)i * G + c; if (L >= nwg) return false;
        int wgid = (int)L; { const int q = nwg / NXCD, r = nwg % NXCD, xcd = wgid % NXCD, off = wgid / NXCD; wgid = (xcd < r ? xcd * (q + 1) : r * (q + 1) + (xcd - r) * q) + off; }
        const int nig = WGM * nN, gid = wgid / nig, fm = gid * WGM, gsz = (nM - fm) < WGM ? (nM - fm) : WGM;
        u.pm = fm + ((wgid % nig) % gsz); u.pn = (wgid % nig) / gsz; return true;
    }
    __device__ __forceinline__ void a_ready(const Unit&) const {}
    __device__ __forceinline__ void done(const Unit&) const {}
};

__device__ __forceinline__ unsigned cvt_pk_bf16(float lo, float hi) { unsigned r; asm volatile("v_cvt_pk_bf16_f32 %0, %1, %2" : "=v"(r) : "v"(lo), "v"(hi)); return r; }
typedef float f32x2 __attribute__((ext_vector_type(2)));
template <class Epi, class Sched, bool ALIGN_EPI = false, bool SP2 = false, bool FP8 = false>
__device__ __forceinline__ void gemm_phase(PG8_LAS unsigned char* lds, const Gemm g, const Sched& S, const Epi& E) {
    int tid_ = threadIdx.x; asm volatile("" : "+v"(tid_));
    const int tid = tid_, wid = __builtin_amdgcn_readfirstlane(tid >> 6), lane = tid & 63, wr = wid >> 2, wc = wid & 3, fr = lane & 15, fq = lane >> 4;
    const int K = g.K, nt = K / BK;
    unsigned voffA[2], voffB[2];
#pragma unroll
    for (int i = 0; i < 2; ++i) { int R, C; stage_rc(tid * 16 + i * 8192, R, C); const int Rb = Epi::PERM ? ((R & ~31) + perm32(R & 31)) : R;
        voffA[i] = (unsigned)(R * K + C) * 2u; voffB[i] = (unsigned)(Rb * K + C) * 2u; }
    const size_t kstep = (size_t)(BK * 2);
    const size_t hstep = (size_t)HALF * K * 2;
    const size_t tstep = 2 * hstep;
    const unsigned ldsw = (unsigned)wid * 1024u;
    const int aoff = lds_byte(wr * 64 + fr, fq * 8), boff = lds_byte(wc * 32 + fr, fq * 8);
#define PG8_SA(b, h) (((b) * 2 + (h)) * HTB)
#define PG8_SB(b, h) ((4 + (b) * 2 + (h)) * HTB)
#define PG8_STAGE(bufoff, gbase, voff) do { _Pragma("unroll") for (int _i = 0; _i < 2; ++_i) \
        __builtin_amdgcn_global_load_lds((const unsigned*)((const char*)(gbase) + (voff)[_i]), (PG8_LAS unsigned*)(lds + (bufoff) + ldsw + _i * 8192), 16, 0, 0); } while (0)
#define PG8_LD8(p) __builtin_shufflevector(*(const PG8_LAS i32x4_*)(p), *(const PG8_LAS i32x4_*)((p) + 1024), 0, 1, 2, 3, 4, 5, 6, 7)
#define PG8_LDA(dst, b, h) do { if constexpr (FP8) { _Pragma("unroll") for (int m = 0; m < 4; ++m) dst##8[m] = PG8_LD8(lds + PG8_SA(b, h) + aoff + m * 2048); } \
        else { _Pragma("unroll") for (int m = 0; m < 4; ++m) _Pragma("unroll") for (int k = 0; k < 2; ++k) dst[m][k] = *(const PG8_LAS bf16x8*)(lds + PG8_SA(b, h) + aoff + m * 2048 + k * 1024); } } while (0)
#define PG8_LDB(dst, b, h) do { if constexpr (FP8) { _Pragma("unroll") for (int n = 0; n < 2; ++n) dst##8[n] = PG8_LD8(lds + PG8_SB(b, h) + boff + n * 2048); } \
        else { _Pragma("unroll") for (int n = 0; n < 2; ++n) _Pragma("unroll") for (int k = 0; k < 2; ++k) dst[n][k] = *(const PG8_LAS bf16x8*)(lds + PG8_SB(b, h) + boff + n * 2048 + k * 1024); } } while (0)
#define PG8_MMA(ai, bj, At, Bt) do { __builtin_amdgcn_s_setprio(1); _Pragma("unroll") for (int m = 0; m < 4; ++m) _Pragma("unroll") for (int n = 0; n < 2; ++n) { \
        if constexpr (FP8) asm volatile("v_mfma_scale_f32_16x16x128_f8f6f4 %0, %1, %2, %0, %3, %3 op_sel_hi:[0,0,0]" : "+v"(acc[ai][bj][m][n]) : "v"(Bt##8[n]), "v"(At##8[m]), "v"(sc1_)); \
        else { _Pragma("unroll") for (int k = 0; k < 2; ++k) acc[ai][bj][m][n] = __builtin_amdgcn_mfma_f32_16x16x32_bf16(Bt[n][k], At[m][k], acc[ai][bj][m][n], 0, 0, 0); } } \
        __builtin_amdgcn_s_setprio(0); } while (0)
#define PG8_WAIT_V(n) asm volatile("s_waitcnt vmcnt(" #n ")" ::: "memory")
#define PG8_WAIT_L(n) asm volatile("s_waitcnt lgkmcnt(" #n ")" ::: "memory")
#define PG8_BAR __builtin_amdgcn_s_barrier()
#define PG8_SCHED __builtin_amdgcn_sched_barrier(0)
    Unit cur, nxt; int ui = 0;
    if (!S.next(0, cur)) return;
    f32x4 acc[2][2][4][2];
#pragma unroll
    for (int a = 0; a < 2; ++a)
#pragma unroll
        for (int b = 0; b < 2; ++b)
#pragma unroll
            for (int m = 0; m < 4; ++m)
#pragma unroll
                for (int n = 0; n < 2; ++n) acc[a][b][m][n] = (f32x4){0.f, 0.f, 0.f, 0.f};
    typedef int i32x4_ __attribute__((ext_vector_type(4))); typedef int i32x8_ __attribute__((ext_vector_type(8)));
    int sc1_ = 0x7F7F7F7F; asm volatile("" : "+v"(sc1_));
    bf16x8 At[4][2], B0[2][2], B1[2][2]; i32x8_ At8[4], B08[2], B18[2];
    const char* cA = (const char*)g.A + (size_t)cur.pm * tstep; const char* cB = (const char*)g.Bt + (size_t)cur.pn * tstep;
    S.a_ready(cur);
    if constexpr (SP2) {
        PG8_STAGE(PG8_SB(0, 0), cB, voffB); PG8_STAGE(PG8_SB(0, 1), cB + hstep, voffB); PG8_STAGE(PG8_SA(0, 0), cA, voffA); PG8_STAGE(PG8_SA(0, 1), cA + hstep, voffA);
        if (wr == 1) PG8_BAR;
        PG8_WAIT_V(2); PG8_BAR;
        PG8_STAGE(PG8_SB(1, 0), cB + kstep, voffB); PG8_STAGE(PG8_SA(1, 0), cA + kstep, voffA); PG8_STAGE(PG8_SB(1, 1), cB + hstep + kstep, voffB);
        PG8_WAIT_V(6); PG8_BAR;
    } else {
        PG8_STAGE(PG8_SB(0, 0), cB, voffB); PG8_STAGE(PG8_SA(0, 0), cA, voffA); PG8_STAGE(PG8_SB(0, 1), cB + hstep, voffB); PG8_STAGE(PG8_SA(0, 1), cA + hstep, voffA);
        if (wr == 1) PG8_BAR;
        PG8_WAIT_V(4); PG8_BAR;
        PG8_STAGE(PG8_SB(1, 0), cB + kstep, voffB); PG8_STAGE(PG8_SA(1, 0), cA + kstep, voffA); PG8_STAGE(PG8_SB(1, 1), cB + hstep + kstep, voffB);
        PG8_WAIT_V(6); PG8_BAR;
    }
    for (;;) {
        const bool has_next = S.next(ui + 1, nxt);
        const char* nA = has_next ? (const char*)g.A + (size_t)nxt.pm * tstep : cA; const char* nB = has_next ? (const char*)g.Bt + (size_t)nxt.pn * tstep : cB;
        for (int t = 0; t < nt; t += 2) {
            const bool last = (t == nt - 2);
            const char* a1 = cA + (size_t)(t + 1) * kstep;
            const char* a2 = last ? nA : cA + (size_t)(t + 2) * kstep; const char* b2 = last ? nB : cB + (size_t)(t + 2) * kstep;
            const char* a3 = a2 + kstep; const char* b3 = b2 + kstep;
            if (last && has_next) S.a_ready(nxt);
            if constexpr (SP2) {
            PG8_LDB(B0, 0, 0); PG8_LDB(B1, 0, 1); PG8_SCHED; PG8_LDA(At, 0, 0); PG8_STAGE(PG8_SA(1, 1), a1 + hstep, voffA);
            PG8_WAIT_V(8); PG8_WAIT_L(0); PG8_BAR; PG8_MMA(0, 0, At, B0); PG8_MMA(0, 1, At, B1); PG8_BAR; PG8_SCHED;
            PG8_LDA(At, 0, 1); PG8_STAGE(PG8_SB(0, 0), b2, voffB); PG8_STAGE(PG8_SB(0, 1), b2 + hstep, voffB); PG8_STAGE(PG8_SA(0, 0), a2, voffA);
            PG8_WAIT_V(8); PG8_WAIT_L(0); PG8_BAR; PG8_MMA(1, 0, At, B0); PG8_MMA(1, 1, At, B1); PG8_BAR; PG8_SCHED;
            PG8_LDB(B0, 1, 0); PG8_LDB(B1, 1, 1); PG8_SCHED; PG8_LDA(At, 1, 0); PG8_STAGE(PG8_SA(0, 1), a2 + hstep, voffA);
            PG8_WAIT_V(8); PG8_WAIT_L(0); PG8_BAR; PG8_MMA(0, 0, At, B0); PG8_MMA(0, 1, At, B1); PG8_BAR; PG8_SCHED;
            PG8_LDA(At, 1, 1); PG8_STAGE(PG8_SB(1, 0), b3, voffB); PG8_STAGE(PG8_SB(1, 1), b3 + hstep, voffB); PG8_STAGE(PG8_SA(1, 0), a3, voffA);
            PG8_WAIT_V(8); PG8_WAIT_L(0); PG8_BAR; PG8_MMA(1, 0, At, B0); PG8_MMA(1, 1, At, B1); PG8_BAR; PG8_SCHED;
            } else {
            PG8_LDB(B0, 0, 0); PG8_SCHED; PG8_LDA(At, 0, 0); PG8_STAGE(PG8_SA(1, 1), a1 + hstep, voffA);
            PG8_WAIT_L(8); PG8_BAR; PG8_WAIT_L(0); PG8_MMA(0, 0, At, B0); PG8_BAR; PG8_SCHED;
            PG8_LDB(B1, 0, 1); PG8_STAGE(PG8_SB(0, 0), b2, voffB);
            PG8_BAR; PG8_WAIT_L(0); PG8_MMA(0, 1, At, B1); PG8_BAR;
            PG8_LDA(At, 0, 1); PG8_STAGE(PG8_SA(0, 0), a2, voffA);
            PG8_BAR; PG8_WAIT_L(0); PG8_MMA(1, 0, At, B0); PG8_BAR; PG8_SCHED;
            PG8_STAGE(PG8_SB(0, 1), b2 + hstep, voffB);
            PG8_WAIT_V(6); PG8_BAR; PG8_MMA(1, 1, At, B1); PG8_BAR;
            PG8_LDB(B0, 1, 0); PG8_SCHED; PG8_LDA(At, 1, 0); PG8_STAGE(PG8_SA(0, 1), a2 + hstep, voffA);
            PG8_WAIT_L(8); PG8_BAR; PG8_WAIT_L(0); PG8_MMA(0, 0, At, B0); PG8_BAR; PG8_SCHED;
            PG8_LDB(B1, 1, 1); PG8_STAGE(PG8_SB(1, 0), b3, voffB);
            PG8_BAR; PG8_WAIT_L(0); PG8_MMA(0, 1, At, B1); PG8_BAR;
            PG8_LDA(At, 1, 1); PG8_STAGE(PG8_SA(1, 0), a3, voffA);
            PG8_BAR; PG8_WAIT_L(0); PG8_MMA(1, 0, At, B0); PG8_BAR; PG8_SCHED;
            PG8_STAGE(PG8_SB(1, 1), b3 + hstep, voffB);
            PG8_WAIT_V(6); PG8_BAR; PG8_MMA(1, 1, At, B1); PG8_BAR;
            }
        }
        if constexpr (ALIGN_EPI) { if (wr == 0) PG8_BAR; }
        if constexpr (FP8) asm volatile("s_nop 15\n\ts_nop 15" ::: "memory");
        if constexpr (!Epi::AFTER_DRAIN) { E(acc, cur, wr, wc, fr, fq); S.done(cur); }
        if (!has_next) break;
#pragma unroll
        for (int a = 0; a < 2; ++a)
#pragma unroll
            for (int b = 0; b < 2; ++b)
#pragma unroll
                for (int m = 0; m < 4; ++m)
#pragma unroll
                    for (int n = 0; n < 2; ++n) acc[a][b][m][n] = (f32x4){0.f, 0.f, 0.f, 0.f};
        cur = nxt; cA = nA; cB = nB; ++ui;
        if constexpr (ALIGN_EPI) { if (wr == 1) PG8_BAR; }
    }
    PG8_WAIT_V(0);
    if constexpr (!ALIGN_EPI) { if (wr == 0) PG8_BAR; }
    PG8_BAR;
    if constexpr (Epi::AFTER_DRAIN) { E.fused(acc, cur, wr, wc, fr, fq, lds, wid, lane); S.done(cur); }
#undef PG8_SA
#undef PG8_SB
#undef PG8_STAGE
#undef PG8_LDA
#undef PG8_LD8
#undef PG8_LDB
#undef PG8_MMA
#undef PG8_WAIT_V
#undef PG8_WAIT_L
#undef PG8_BAR
#undef PG8_SCHED
}
}
namespace pg8 {
typedef unsigned u32x2 __attribute__((ext_vector_type(2)));
constexpr int LDX = 2048;
constexpr float RMS_EPS = 1e-6f;
struct EpiQKV {
    static constexpr bool PERM = true, AFTER_DRAIN = false;
    bf16_t* O; const float* cs; float qscale; float* ksum;
    __device__ __forceinline__ void operator()(const f32x4 (&acc)[2][2][4][2], const Unit& u, int wr, int wc, int fr, int fq) const {
        const int row0 = u.pm * BM + wr * 64 + fr, col0 = u.pn * BM + wc * 32 + 8 * fq, pn = u.pn;
        const float sc = (pn < 4 || (pn >= 12 && pn < 16)) ? qscale : 1.f;
        const bool rot = (pn >= 12 && pn < 20) && (wc == 0);
        const bool kacc = (pn >= 16 && pn < 20);
        f32x4 ks[2][2] = {{{0.f, 0.f, 0.f, 0.f}, {0.f, 0.f, 0.f, 0.f}}, {{0.f, 0.f, 0.f, 0.f}, {0.f, 0.f, 0.f, 0.f}}};
#pragma unroll
        for (int ai = 0; ai < 2; ++ai)
#pragma unroll
            for (int m = 0; m < 4; ++m) { const int row = row0 + ai * HALF + m * 16; bf16_t* rowp = O + (size_t)row * 6144 + col0;
                f32x4 c0 = {1.f, 1.f, 1.f, 1.f}, c1 = c0, s0 = {0.f, 0.f, 0.f, 0.f}, s1 = s0;
                if (rot) { const float* cr = cs + (size_t)row * 32 + 8 * (fq & 1); c0 = *(const f32x4*)cr; c1 = *(const f32x4*)(cr + 4); s0 = *(const f32x4*)(cr + 16); s1 = *(const f32x4*)(cr + 20);
                    if (fq < 2) { s0 = -s0; s1 = -s1; } }
#pragma unroll
                for (int bj = 0; bj < 2; ++bj) { f32x4 v0 = acc[ai][bj][m][0], v1 = acc[ai][bj][m][1];
                    if (rot) { f32x4 p0, p1;
#pragma unroll
                        for (int j = 0; j < 4; ++j) { p0[j] = __shfl_xor(v0[j], 32); p1[j] = __shfl_xor(v1[j], 32); }
                        v0 = v0 * c0 + p0 * s0; v1 = v1 * c1 + p1 * s1; }
                    if (kacc) { ks[bj][0] += v0; ks[bj][1] += v1; }
                    v0 = v0 * sc; v1 = v1 * sc; u32x4 w; w.x = cvt_pk_bf16(v0[0], v0[1]); w.y = cvt_pk_bf16(v0[2], v0[3]); w.z = cvt_pk_bf16(v1[0], v1[1]); w.w = cvt_pk_bf16(v1[2], v1[3]);
                    *(u32x4*)(rowp + bj * HALF) = w; } }
        if (kacc) {
            float* kp = ksum + (size_t)(((u.pm >> 3) * 8 + (pn - 16) * 2) * 8 + (u.pm & 7)) * 128 + wc * 32 + 8 * fq;
#pragma unroll
            for (int bj = 0; bj < 2; ++bj)
#pragma unroll
                for (int n = 0; n < 2; ++n)
#pragma unroll
                    for (int j = 0; j < 4; ++j) { float s = ks[bj][n][j]; s += __shfl_xor(s, 1); s += __shfl_xor(s, 2); s += __shfl_xor(s, 4); s += __shfl_xor(s, 8);
                        if (fr == 0) atomicAdd(kp + bj * 1024 + n * 4 + j, s); }
        }
    }
};
__device__ __forceinline__ unsigned pk4_fp8(float a, float b, float c, float d) {
    a = __builtin_amdgcn_fmed3f(a, -448.f, 448.f); b = __builtin_amdgcn_fmed3f(b, -448.f, 448.f); c = __builtin_amdgcn_fmed3f(c, -448.f, 448.f); d = __builtin_amdgcn_fmed3f(d, -448.f, 448.f);
    int p = __builtin_amdgcn_cvt_pk_fp8_f32(a, b, 0, false); p = __builtin_amdgcn_cvt_pk_fp8_f32(c, d, p, true); return (unsigned)p; }
struct EpiRes {
    static constexpr bool PERM = false, AFTER_DRAIN = false;
    const float* base; float* out; bf16_t* xb; float* ssq; unsigned char* x8; float s8; float ascale;
    __device__ __forceinline__ void operator()(const f32x4 (&acc)[2][2][4][2], const Unit& u, int wr, int wc, int fr, int fq) const {
        const int row0 = u.pm * BM + wr * 64 + fr, col0 = u.pn * BM + wc * 32 + 4 * fq;
#pragma unroll
        for (int ai = 0; ai < 2; ++ai)
#pragma unroll
            for (int m = 0; m < 4; ++m) { const int row = row0 + ai * HALF + m * 16; const size_t off = (size_t)row * LDX + col0; float s = 0.f;
#pragma unroll
                for (int bj = 0; bj < 2; ++bj)
#pragma unroll
                    for (int n = 0; n < 2; ++n) { const f32x4 v = *(const f32x4*)(base + off + bj * HALF + n * 16) + acc[ai][bj][m][n] * ascale;
                        *(f32x4*)(out + off + bj * HALF + n * 16) = v; s += (v[0] * v[0] + v[1] * v[1]) + (v[2] * v[2] + v[3] * v[3]);
                        if (xb) { u32x2 w; w.x = cvt_pk_bf16(v[0], v[1]); w.y = cvt_pk_bf16(v[2], v[3]); *(u32x2*)(xb + off + bj * HALF + n * 16) = w; }
                        if (x8) { *(unsigned*)(x8 + off + bj * HALF + n * 16) = pk4_fp8(v[0] * s8, v[1] * s8, v[2] * s8, v[3] * s8); } }
                if (ssq) { s += __shfl_xor(s, 16); s += __shfl_xor(s, 32); if (fq == 0) atomicAdd(ssq + row, s); }
                asm volatile("" ::: "memory"); }
    }
};
template <bool BASE_F32> struct EpiResB {
    static constexpr bool PERM = true, AFTER_DRAIN = false;
    const void* base; bf16_t* xo; float* ssq; unsigned char* x8; float s8; float ascale;
    __device__ __forceinline__ void operator()(const f32x4 (&acc)[2][2][4][2], const Unit& u, int wr, int wc, int fr, int fq) const {
        const int row0 = u.pm * BM + wr * 64 + fr, col0 = u.pn * BM + wc * 32 + 8 * fq;
#pragma unroll
        for (int ai = 0; ai < 2; ++ai)
#pragma unroll
            for (int m = 0; m < 4; ++m) { const int row = row0 + ai * HALF + m * 16; const size_t off = (size_t)row * LDX + col0; float s = 0.f;
#pragma unroll
                for (int bj = 0; bj < 2; ++bj) { f32x4 b0, b1;
                    if (BASE_F32) { const float* bp = (const float*)base + off + bj * HALF; b0 = *(const f32x4*)bp; b1 = *(const f32x4*)(bp + 4); }
                    else { const u32x4 w = *(const u32x4*)((const bf16_t*)base + off + bj * HALF);
                        b0 = (f32x4){__uint_as_float(w.x << 16), __uint_as_float(w.x & 0xffff0000u), __uint_as_float(w.y << 16), __uint_as_float(w.y & 0xffff0000u)};
                        b1 = (f32x4){__uint_as_float(w.z << 16), __uint_as_float(w.z & 0xffff0000u), __uint_as_float(w.w << 16), __uint_as_float(w.w & 0xffff0000u)}; }
                    const f32x4 v0 = b0 + acc[ai][bj][m][0] * ascale, v1 = b1 + acc[ai][bj][m][1] * ascale;
                    s += ((v0[0] * v0[0] + v0[1] * v0[1]) + (v0[2] * v0[2] + v0[3] * v0[3])) + ((v1[0] * v1[0] + v1[1] * v1[1]) + (v1[2] * v1[2] + v1[3] * v1[3]));
                    if (xo) { u32x4 w; w.x = cvt_pk_bf16(v0[0], v0[1]); w.y = cvt_pk_bf16(v0[2], v0[3]); w.z = cvt_pk_bf16(v1[0], v1[1]); w.w = cvt_pk_bf16(v1[2], v1[3]); *(u32x4*)(xo + off + bj * HALF) = w; }
                    if (x8) { u32x2 w8; w8.x = pk4_fp8(v0[0] * s8, v0[1] * s8, v0[2] * s8, v0[3] * s8); w8.y = pk4_fp8(v1[0] * s8, v1[1] * s8, v1[2] * s8, v1[3] * s8); *(u32x2*)(x8 + off + bj * HALF) = w8; } }
                if (ssq) { s += __shfl_xor(s, 16); s += __shfl_xor(s, 32); if (fq == 0) atomicAdd(ssq + row, s); }
                asm volatile("" ::: "memory"); }
    }
};
struct EpiScale {
    static constexpr bool PERM = true, AFTER_DRAIN = false;
    bf16_t* O; int ldc; const float* ssq; float sc;
    __device__ __forceinline__ void operator()(const f32x4 (&acc)[2][2][4][2], const Unit& u, int wr, int wc, int fr, int fq) const {
        const int row0 = u.pm * BM + wr * 64 + fr, col0 = u.pn * BM + wc * 32 + 8 * fq;
#pragma unroll
        for (int ai = 0; ai < 2; ++ai)
#pragma unroll
            for (int m = 0; m < 4; ++m) { const int row = row0 + ai * HALF + m * 16; bf16_t* rowp = O + (size_t)row * ldc + col0;
                const float f = ssq ? sc * __builtin_amdgcn_rsqf(ssq[row] * (1.0f / 2048.0f) + RMS_EPS) : sc;
#pragma unroll
                for (int bj = 0; bj < 2; ++bj) { const f32x4 v0 = acc[ai][bj][m][0] * f, v1 = acc[ai][bj][m][1] * f;
                    u32x4 w; w.x = cvt_pk_bf16(v0[0], v0[1]); w.y = cvt_pk_bf16(v0[2], v0[3]); w.z = cvt_pk_bf16(v1[0], v1[1]); w.w = cvt_pk_bf16(v1[2], v1[3]);
                    *(u32x4*)(rowp + bj * HALF) = w; } }
    }
};
struct EpiSwiGLU {
    static constexpr bool PERM = true, AFTER_DRAIN = false;
    bf16_t* O; const float* ssq; unsigned char* O8; float ascale, oscale;
    __device__ __forceinline__ void operator()(const f32x4 (&acc)[2][2][4][2], const Unit& u, int wr, int wc, int fr, int fq) const {
        const int row0 = u.pm * BM + wr * 64 + fr, col0 = u.pn * HALF + wc * 32 + 8 * fq;
#pragma unroll
        for (int ai = 0; ai < 2; ++ai)
#pragma unroll
            for (int m = 0; m < 4; ++m) { const int row = row0 + ai * HALF + m * 16; bf16_t* rowp = O + (size_t)row * 5632 + col0;
                const float f = ascale * __builtin_amdgcn_rsqf(ssq[row] * (1.0f / 2048.0f) + RMS_EPS);
                float r[8];
#pragma unroll
                for (int n = 0; n < 2; ++n)
#pragma unroll
                    for (int j = 0; j < 4; ++j) { const float g = acc[ai][0][m][n][j] * f, uu = acc[ai][1][m][n][j] * f;
                        const float sg = g * __builtin_amdgcn_rcpf(1.0f + __builtin_amdgcn_exp2f(-1.4426950408889634f * g)); r[n * 4 + j] = sg * uu; }
                if (O8) { u32x2 w8; w8.x = pk4_fp8(r[0] * oscale, r[1] * oscale, r[2] * oscale, r[3] * oscale); w8.y = pk4_fp8(r[4] * oscale, r[5] * oscale, r[6] * oscale, r[7] * oscale);
                    *(u32x2*)(O8 + (size_t)row * 5632 + col0) = w8; }
                else { u32x4 w; w.x = cvt_pk_bf16(r[0], r[1]); w.y = cvt_pk_bf16(r[2], r[3]); w.z = cvt_pk_bf16(r[4], r[5]); w.w = cvt_pk_bf16(r[6], r[7]);
                *(u32x4*)rowp = w; } }
    }
};
}
namespace att {
using bf16x8 = __attribute__((ext_vector_type(8))) short;
using s16x4  = __attribute__((ext_vector_type(4))) short;
using f32x16 = __attribute__((ext_vector_type(16))) float;
using f32x4  = __attribute__((ext_vector_type(4))) float;
using u32x4  = __attribute__((ext_vector_type(4))) unsigned;
typedef unsigned short bf16;
constexpr int D = 128, KVBLK = 64;
constexpr int SHM_V = KVBLK * D * 2, SHM_K = KVBLK * D * 2;
constexpr int OFF_Q = 2 * SHM_V + 2 * SHM_K, OFF_WS = 131072 + 1024, OFF_KM = OFF_WS + 2048, ATT_LDS = OFF_KM + 4096;
constexpr float THR = 8.f;
#ifndef PIPE_SOFTMAX
#define PIPE_SOFTMAX 0
#endif
#define KSWZ(row, colB) ((row) * 256 + ((colB) ^ (((row) & 7) << 4)))
#define SBAR() __builtin_amdgcn_sched_barrier(0)
__device__ __forceinline__ int crow(int r, int hi) { return (r & 3) + 8 * (r >> 2) + 4 * hi; }
__device__ __forceinline__ unsigned cvtpk(float lo, float hi) { unsigned r; asm volatile("v_cvt_pk_bf16_f32 %0, %1, %2" : "=v"(r) : "v"(lo), "v"(hi)); return r; }
__device__ __forceinline__ float xchg32(float x, int hi) { auto rr = __builtin_amdgcn_permlane32_swap(__float_as_uint(x), __float_as_uint(x), false, false); return __uint_as_float(hi ? rr[0] : rr[1]); }
typedef __attribute__((address_space(3))) const char* lds_cp;
template <int D0> __device__ __forceinline__ void qkt_part(f32x16& p0, f32x16& p1, const lds_cp (&ka)[4], int boff, const lds_cp (&qa)[4]) {
  const bf16x8 qf = *reinterpret_cast<const __attribute__((address_space(3))) bf16x8*>(qa[D0 & 3] + (D0 >> 2) * 128);
  const bf16x8 b0 = *reinterpret_cast<const __attribute__((address_space(3))) bf16x8*>(ka[D0 & 3] + boff + (D0 >> 2) * 128);
  const bf16x8 b1 = *reinterpret_cast<const __attribute__((address_space(3))) bf16x8*>(ka[D0 & 3] + boff + (D0 >> 2) * 128 + 8192);
  p0 = __builtin_amdgcn_mfma_f32_32x32x16_bf16(b0, qf, p0, 0, 0, 0);
  p1 = __builtin_amdgcn_mfma_f32_32x32x16_bf16(b1, qf, p1, 0, 0, 0);
}
__device__ __forceinline__ void qkt(f32x16& p0, f32x16& p1, const lds_cp (&ka)[4], int boff, const lds_cp (&qr)[4], float bias = 0.f) {
#pragma unroll
  for (int r = 0; r < 16; ++r) { p0[r] = bias; p1[r] = bias; }
  qkt_part<0>(p0, p1, ka, boff, qr); qkt_part<1>(p0, p1, ka, boff, qr); qkt_part<2>(p0, p1, ka, boff, qr); qkt_part<3>(p0, p1, ka, boff, qr);
  qkt_part<4>(p0, p1, ka, boff, qr); qkt_part<5>(p0, p1, ka, boff, qr); qkt_part<6>(p0, p1, ka, boff, qr); qkt_part<7>(p0, p1, ka, boff, qr);
}
__device__ __forceinline__ int v_st(int k, int c) { const int kk = (k & ~0xC) | ((k & 4) << 1) | ((k & 8) >> 1); return ((kk >> 3) * 4 + (c >> 5)) * 512 + ((kk & 7) * 32 + (c & 31)) * 2; }
__device__ __forceinline__ int v_rd_base(int lane) { return ((lane & 3) << 3) | (((lane >> 2) & 3) << 6) | (((lane >> 4) & 1) << 5) | (((lane >> 5) & 1) << 8); }
constexpr int v_rd_off(int d0, int ks, int half) { return d0 * 512 + ks * 4096 + half * 2048; }
template <int OFF> __device__ __forceinline__ s16x4 tr_read(int vb) { s16x4 r; asm volatile("ds_read_b64_tr_b16 %0, %1 offset:%2" : "=&v"(r) : "v"(vb), "i"(OFF) : "memory"); return r; }
template <int D0> __device__ __forceinline__ void pv_one(f32x16& od, int vb, bf16x8 pa0, bf16x8 pa1, bf16x8 pa2, bf16x8 pa3) {
  const s16x4 l0 = tr_read<v_rd_off(D0, 0, 0)>(vb), h0 = tr_read<v_rd_off(D0, 0, 1)>(vb), l1 = tr_read<v_rd_off(D0, 1, 0)>(vb), h1 = tr_read<v_rd_off(D0, 1, 1)>(vb);
  const s16x4 l2 = tr_read<v_rd_off(D0, 2, 0)>(vb), h2 = tr_read<v_rd_off(D0, 2, 1)>(vb), l3 = tr_read<v_rd_off(D0, 3, 0)>(vb), h3 = tr_read<v_rd_off(D0, 3, 1)>(vb);
  asm volatile("s_waitcnt lgkmcnt(0)" ::: "memory"); SBAR();
#define PK(L, H) (bf16x8){L[0], L[1], L[2], L[3], H[0], H[1], H[2], H[3]}
  od = __builtin_amdgcn_mfma_f32_32x32x16_bf16(pa0, PK(l0, h0), od, 0, 0, 0);
  od = __builtin_amdgcn_mfma_f32_32x32x16_bf16(pa1, PK(l1, h1), od, 0, 0, 0);
  od = __builtin_amdgcn_mfma_f32_32x32x16_bf16(pa2, PK(l2, h2), od, 0, 0, 0);
  od = __builtin_amdgcn_mfma_f32_32x32x16_bf16(pa3, PK(l3, h3), od, 0, 0, 0);
#undef PK
}
__device__ __forceinline__ void pv_d0(f32x16* o, int vb, bf16x8 pa0, bf16x8 pa1, bf16x8 pa2, bf16x8 pa3) {
  pv_one<0>(o[0], vb, pa0, pa1, pa2, pa3); pv_one<1>(o[1], vb, pa0, pa1, pa2, pa3); pv_one<2>(o[2], vb, pa0, pa1, pa2, pa3); pv_one<3>(o[3], vb, pa0, pa1, pa2, pa3);
}
__device__ __forceinline__ void pack_p(const f32x16& p0, const f32x16& p1, bf16x8& pa0, bf16x8& pa1, bf16x8& pa2, bf16x8& pa3) {
#define PK4(P, BASE, OUT) do { unsigned a0 = cvtpk(P[BASE + 0], P[BASE + 1]), a1 = cvtpk(P[BASE + 2], P[BASE + 3]);   \
    unsigned b0 = cvtpk(P[BASE + 4], P[BASE + 5]), b1 = cvtpk(P[BASE + 6], P[BASE + 7]);                              \
    auto r0 = __builtin_amdgcn_permlane32_swap(a0, b0, false, false); auto r1 = __builtin_amdgcn_permlane32_swap(a1, b1, false, false); \
    u32x4 w = {r0[0], r1[0], r0[1], r1[1]}; OUT = *reinterpret_cast<bf16x8*>(&w); } while (0)
  PK4(p0, 0, pa0); PK4(p0, 8, pa1); PK4(p1, 0, pa2); PK4(p1, 8, pa3);
#undef PK4
}
__device__ __forceinline__ void softmax_tile(f32x16& p0, f32x16& p1, float& m_reg, float& l_reg, float& alpha) {
  float pmax = p0[0];
#pragma unroll
  for (int r = 1; r < 16; ++r) pmax = fmaxf(pmax, p0[r]);
#pragma unroll
  for (int r = 0; r < 16; ++r) pmax = fmaxf(pmax, p1[r]);
  pmax = fmaxf(pmax, xchg32(pmax, (int)(threadIdx.x >> 5) & 1));
  if (__all(pmax - m_reg <= THR)) { alpha = 1.f; }
  else { const float mn = fmaxf(m_reg, pmax); alpha = __builtin_amdgcn_exp2f(m_reg - mn); m_reg = mn; }
  float ps = 0.f;
#pragma unroll
  for (int r = 0; r < 16; ++r) { p0[r] = __builtin_amdgcn_exp2f(p0[r] - m_reg); ps += p0[r]; }
#pragma unroll
  for (int r = 0; r < 16; ++r) { p1[r] = __builtin_amdgcn_exp2f(p1[r] - m_reg); ps += p1[r]; }
  ps += xchg32(ps, (int)(threadIdx.x >> 5) & 1);
  l_reg = l_reg * alpha + ps;
}
template <bool BAND, int I> __device__ __forceinline__ float sb_group(f32x16& P, int kb, int qrel, int hi) {
  float run = 1.f;
#pragma unroll
  for (int e = 3; e >= 0; --e) { const int r = 4 * I + e; float rr = __builtin_amdgcn_rcpf(1.0f + __builtin_amdgcn_exp2f(P[r]));
    if (BAND) rr = (kb + crow(r, hi) < qrel) ? rr : 1.f;
    P[r] = (1.0f - rr) * run; run *= rr; }
  return run;
}
__device__ __forceinline__ void sb_combine(f32x16& p0, f32x16& p1, float (&gs)[8], float& carry, int hi) {
  float acc = 1.f;
#pragma unroll
  for (int i = 7; i >= 0; --i) { const float so_i = acc; acc *= gs[i]; const float x = hi ? acc : so_i; gs[i] = carry * so_i * xchg32(x, hi); }
  carry *= acc * xchg32(acc, hi);
#pragma unroll
  for (int i = 0; i < 4; ++i)
#pragma unroll
    for (int e = 0; e < 4; ++e) { p0[4 * i + e] *= gs[i]; p1[4 * i + e] *= gs[4 + i]; }
}
template <bool BAND>
__device__ __forceinline__ void sb_tile(f32x16& p0, f32x16& p1, float& carry, int kb, int qrel, int hi) {
  float gs[8];
  gs[0] = sb_group<BAND, 0>(p0, kb, qrel, hi); SBAR(); gs[1] = sb_group<BAND, 1>(p0, kb, qrel, hi); SBAR(); gs[2] = sb_group<BAND, 2>(p0, kb, qrel, hi); SBAR(); gs[3] = sb_group<BAND, 3>(p0, kb, qrel, hi); SBAR();
  gs[4] = sb_group<BAND, 0>(p1, kb + 32, qrel, hi); SBAR(); gs[5] = sb_group<BAND, 1>(p1, kb + 32, qrel, hi); SBAR(); gs[6] = sb_group<BAND, 2>(p1, kb + 32, qrel, hi); SBAR(); gs[7] = sb_group<BAND, 3>(p1, kb + 32, qrel, hi); SBAR();
  sb_combine(p0, p1, gs, carry, hi);
}

template <int MODE>
__device__ __forceinline__ void attn_unit(const bf16* __restrict__ Qb, int ldq, const bf16* __restrict__ Kh, const bf16* __restrict__ Vh, int ldk, bf16* __restrict__ Ob, int ldo,
                                          const float* __restrict__ gain, const float* __restrict__ kmean, int qb, int nkeys, char* lds) {
  int tid_ = threadIdx.x; asm volatile("" : "+v"(tid_));
  const int tid = tid_, wid = __builtin_amdgcn_readfirstlane(tid >> 6), lane = tid & 63, r32 = lane & 31, hi = lane >> 5;
  char* V_lds = lds; char* K_lds = lds + 2 * SHM_V;
  float* ws = (float*)(lds + OFF_WS) + wid * 64; float* li_l = ws; float* al_l = ws + 32;
  float* km_l = (float*)(lds + OFF_KM);
  const int NT = (MODE == 0) ? nkeys / KVBLK : 4 * (qb + 1);
  const int qrel = wid * 32 + r32;
  float m_reg = -1e30f, l_reg = 0.f, carry = 1.f; f32x16 o[4] = {};
  const int vb0 = (int)(uintptr_t)V_lds + v_rd_base(lane);
  lds_cp ka[4];
#pragma unroll
  for (int x = 0; x < 4; ++x) ka[x] = (lds_cp)(__attribute__((address_space(3))) char*)K_lds + r32 * 256 + 32 * (x ^ ((r32 >> 1) & 3)) + 16 * (hi ^ (r32 & 1));
  lds_cp qr[4];
#pragma unroll
  for (int x = 0; x < 4; ++x) qr[x] = ka[x] + (OFF_Q - 2 * SHM_V) + wid * 8192;
  long ksrc[2], vsrc[2];
#pragma unroll
  for (int i = 0; i < 2; ++i) { const int piece = wid + 8 * i;
    { const int row = piece * 4 + (lane >> 4), c = (lane & 15) ^ (row & 7); ksrc[i] = (long)row * ldk + c * 8; }
    { const int sub = piece * 2 + (lane >> 5), kk = (sub >> 2) * 8 + ((lane & 31) >> 2), k = (kk & ~0xC) | ((kk & 4) << 1) | ((kk & 8) >> 1), c = (sub & 3) * 32 + (lane & 3) * 8; vsrc[i] = (long)k * ldk + c; } }
  typedef __attribute__((address_space(3))) unsigned lds_u32;
  lds_u32* kdst = (lds_u32*)(__attribute__((address_space(3))) char*)(K_lds) + wid * 256; lds_u32* vdst = (lds_u32*)(__attribute__((address_space(3))) char*)(V_lds) + wid * 256;
#define TILE(it) ((MODE == 2) ? (NT - 1 - (it)) : (it))
#define DMA_K(k0, b) do { _Pragma("unroll") for (int i_ = 0; i_ < 2; ++i_) __builtin_amdgcn_global_load_lds((const unsigned*)(Kh + (long)(k0) * ldk + ksrc[i_]), kdst + (b) * (SHM_K / 4) + i_ * 2048, 16, 0, 0); } while (0)
#define DMA_V(k0, b) do { _Pragma("unroll") for (int i_ = 0; i_ < 2; ++i_) __builtin_amdgcn_global_load_lds((const unsigned*)(Vh + (long)(k0) * ldk + vsrc[i_]), vdst + (b) * (SHM_V / 4) + i_ * 2048, 16, 0, 0); } while (0)
#define SDRAIN() asm volatile("s_waitcnt vmcnt(0)" ::: "memory")
  { lds_u32* qdst = (lds_u32*)(__attribute__((address_space(3))) char*)(lds + OFF_Q) + wid * 2048;
#pragma unroll
    for (int i = 0; i < 8; ++i) { const int row = 4 * i + (lane >> 4), c = (lane & 15) ^ (row & 7);
      __builtin_amdgcn_global_load_lds((const unsigned*)(Qb + (long)(wid * 32 + row) * ldq + c * 8), qdst + i * 256, 16, 0, 0); } }
  DMA_K(TILE(0) * KVBLK, 0); DMA_V(TILE(0) * KVBLK, 0); if (MODE == 2 || PIPE_SOFTMAX) DMA_K(TILE(1) * KVBLK, 1);
  unsigned selmask = 0u;
  if (MODE == 1) { if (tid < 256) *(f32x4*)(km_l + tid * 4) = *(const f32x4*)(kmean + tid * 4); }
  SDRAIN();
  __syncthreads();
  if (MODE == 1) {
    float g[8];
#pragma unroll
    for (int n = 0; n < 8; ++n) g[n] = 0.f;
    { const lds_cp qbase = qr[0] - 32 * ((r32 >> 1) & 3);
      const int rh = (r32 >> 1) & 3;
#pragma unroll 1
      for (int d0 = 0; d0 < 8; ++d0) {
        const bf16x8 qf = *reinterpret_cast<const __attribute__((address_space(3))) bf16x8*>(qbase + 32 * ((d0 & 3) ^ rh) + 128 * (d0 >> 2));
        float q[8];
#pragma unroll
        for (int j = 0; j < 8; ++j) q[j] = __uint_as_float(((unsigned)(unsigned short)qf[j]) << 16);
        const float* kmp = km_l + d0 * 16 + hi * 8;
#pragma unroll
        for (int n = 0; n < 7; ++n) { const f32x4 k0v = *(const f32x4*)(kmp + n * 128), k1v = *(const f32x4*)(kmp + n * 128 + 4);
          g[n] += (q[0] * k0v[0] + q[1] * k0v[1]) + (q[2] * k0v[2] + q[3] * k0v[3]) + (q[4] * k1v[0] + q[5] * k1v[1]) + (q[6] * k1v[2] + q[7] * k1v[3]); }
      } }
#pragma unroll
    for (int n = 0; n < 7; ++n) { g[n] += xchg32(g[n], hi); if (n >= qb) g[n] = -INFINITY; }
    g[7] = -INFINITY;
#pragma unroll
    for (int n = 0; n < 7; ++n) { int cnt = 0;
#pragma unroll
      for (int mI = 0; mI < 7; ++mI) { if (mI != n) cnt += (g[mI] > g[n] || (g[mI] == g[n] && mI < n)) ? 1 : 0; }
      if (n < qb && cnt < 3) selmask |= (1u << n); }
  }
  f32x16 pA0, pA1, pB0, pB1; bf16x8 pa0, pa1, pa2, pa3;
  if (MODE == 2 || PIPE_SOFTMAX) { float bias0 = 0.f; if (MODE == 1) { if (NT > 4) bias0 = (selmask & 1u) ? 0.f : -INFINITY; }
    qkt(pA0, pA1, ka, 0, qr, bias0);
    __syncthreads(); }
  int it = 0;
#define JB(i_) ((MODE == 2) ? (3 - (i_)) : ((i_) - (NT - 4)))
#define STEP(A0, A1, B0, B1, BAND, HASNEXT) do { \
    if (it + 2 < NT) DMA_K(TILE(it + 2) * KVBLK, it & 1); \
    if (it + 1 < NT) DMA_V(TILE(it + 1) * KVBLK, (it + 1) & 1); \
    bool skip = false; const int jb = JB(it); \
    if (BAND) { if (MODE == 1) skip = (64 * jb > wid * 32 + 31); if (MODE == 2) skip = (64 * jb >= wid * 32 + 31); } \
    if (HASNEXT) { float bias_ = 0.f; if (MODE == 1) { if (it + 1 < NT - 4) bias_ = ((selmask >> ((it + 1) >> 2)) & 1u) ? 0.f : -INFINITY; } \
      qkt(B0, B1, ka, ((it + 1) & 1) * SHM_K, qr, bias_); } \
    if (!skip) { \
      if (MODE == 2) { sb_tile<(BAND) != 0>(A0, A1, carry, 64 * jb, qrel, hi); } \
      else { \
        if (MODE == 1 && (BAND)) { _Pragma("unroll") for (int r = 0; r < 16; ++r) { const int kr = 64 * jb + crow(r, hi); if (kr > qrel) A0[r] = -INFINITY; if (kr + 32 > qrel) A1[r] = -INFINITY; } } \
        float alpha; softmax_tile(A0, A1, m_reg, l_reg, alpha); \
        if (__any(alpha < 1.f)) { if (hi == 0) al_l[r32] = alpha; asm volatile("s_waitcnt lgkmcnt(0)" ::: "memory"); \
          _Pragma("unroll") for (int d = 0; d < 4; ++d) _Pragma("unroll") for (int r = 0; r < 16; ++r) o[d][r] *= al_l[crow(r, hi)]; } \
      } \
      pack_p(A0, A1, pa0, pa1, pa2, pa3); \
      pv_d0(o, vb0 + (it & 1) * SHM_V, pa0, pa1, pa2, pa3); \
    } \
    SDRAIN(); __syncthreads(); ++it; } while (0)
#define SB_PART(G, P, I, B0, B1) do { qkt_part<G>(B0, B1, ka, ((it + 1) & 1) * SHM_K, qr); gs_[G] = sb_group<false, I>(P, 0, 0, hi); SBAR(); } while (0)
#define STEP_SB(A0, A1, B0, B1) do { \
    if (it + 2 < NT) DMA_K(TILE(it + 2) * KVBLK, it & 1); \
    DMA_V(TILE(it + 1) * KVBLK, (it + 1) & 1); \
    float gs_[8]; \
    _Pragma("unroll") for (int r = 0; r < 16; ++r) { B0[r] = 0.f; B1[r] = 0.f; } \
    SB_PART(0, A0, 0, B0, B1); SB_PART(1, A0, 1, B0, B1); SB_PART(2, A0, 2, B0, B1); SB_PART(3, A0, 3, B0, B1); \
    SB_PART(4, A1, 0, B0, B1); SB_PART(5, A1, 1, B0, B1); SB_PART(6, A1, 2, B0, B1); SB_PART(7, A1, 3, B0, B1); \
    sb_combine(A0, A1, gs_, carry, hi); \
    pack_p(A0, A1, pa0, pa1, pa2, pa3); \
    pv_d0(o, vb0 + (it & 1) * SHM_V, pa0, pa1, pa2, pa3); \
    SDRAIN(); __syncthreads(); ++it; } while (0)
#define SSTEP(BAND) do { \
    if (it + 1 < NT) { DMA_K(TILE(it + 1) * KVBLK, (it + 1) & 1); DMA_V(TILE(it + 1) * KVBLK, (it + 1) & 1); } \
    bool skip = false; const int jb = JB(it); \
    if (BAND) skip = (64 * jb > wid * 32 + 31); \
    if (!skip) { \
      float bias_ = 0.f; if (MODE == 1 && !(BAND)) bias_ = ((selmask >> (it >> 2)) & 1u) ? 0.f : -INFINITY; \
      qkt(pA0, pA1, ka, (it & 1) * SHM_K, qr, bias_); \
      if (MODE == 1 && (BAND)) { _Pragma("unroll") for (int r = 0; r < 16; ++r) { const int kr = 64 * jb + crow(r, hi); if (kr > qrel) pA0[r] = -INFINITY; if (kr + 32 > qrel) pA1[r] = -INFINITY; } } \
      float alpha; softmax_tile(pA0, pA1, m_reg, l_reg, alpha); \
      if (__any(alpha < 1.f)) { if (hi == 0) al_l[r32] = alpha; asm volatile("s_waitcnt lgkmcnt(0)" ::: "memory"); \
        _Pragma("unroll") for (int d = 0; d < 4; ++d) _Pragma("unroll") for (int r = 0; r < 16; ++r) o[d][r] *= al_l[crow(r, hi)]; } \
      pack_p(pA0, pA1, pa0, pa1, pa2, pa3); \
      pv_d0(o, vb0 + (it & 1) * SHM_V, pa0, pa1, pa2, pa3); \
    } \
    SDRAIN(); __syncthreads(); ++it; } while (0)
#define RESTART(BIASEXPR) do { qkt(pA0, pA1, ka, (it & 1) * SHM_K, qr, (BIASEXPR)); __syncthreads(); } while (0)
  if (MODE == 0) {
    if (PIPE_SOFTMAX) { STEP(pA0, pA1, pB0, pB1, 0, true); STEP(pB0, pB1, pA0, pA1, 0, true); STEP(pA0, pA1, pB0, pB1, 0, true); STEP(pB0, pB1, pA0, pA1, 0, false); }
    else { SSTEP(0); SSTEP(0); SSTEP(0); SSTEP(0); }
  } else if (MODE == 1) {
    if (PIPE_SOFTMAX) {
      if (NT > 4) { while (it < NT - 4) { STEP(pA0, pA1, pB0, pB1, 0, true); STEP(pB0, pB1, pA0, pA1, 0, (it + 1 < NT - 4)); }
        RESTART(0.f); }
      STEP(pA0, pA1, pB0, pB1, 1, true); STEP(pB0, pB1, pA0, pA1, 1, true); STEP(pA0, pA1, pB0, pB1, 1, true); STEP(pB0, pB1, pA0, pA1, 1, false);
    } else {
      while (it < NT - 4) SSTEP(0);
      SSTEP(1); SSTEP(1); SSTEP(1); SSTEP(1);
    }
  } else {
    STEP(pA0, pA1, pB0, pB1, 1, true); STEP(pB0, pB1, pA0, pA1, 1, true); STEP(pA0, pA1, pB0, pB1, 1, true); STEP(pB0, pB1, pA0, pA1, 1, false);
    if (NT > 4) {
      RESTART(0.f);
      while (it + 2 < NT) { STEP_SB(pA0, pA1, pB0, pB1); STEP_SB(pB0, pB1, pA0, pA1); }
      STEP_SB(pA0, pA1, pB0, pB1); STEP(pB0, pB1, pA0, pA1, 0, false);
    }
  }
#undef RESTART
#undef STEP
#undef SSTEP
#undef STEP_SB
#undef SB_PART
#undef JB
  float rli[16];
  if (MODE != 2) { if (hi == 0) li_l[r32] = l_reg; asm volatile("s_waitcnt lgkmcnt(0)" ::: "memory");
#pragma unroll
    for (int r = 0; r < 16; ++r) rli[r] = __builtin_amdgcn_rcpf(li_l[crow(r, hi)]); }
  else {
#pragma unroll
    for (int r = 0; r < 16; ++r) rli[r] = 1.f; }
  if (gain) {
    float gv[4];
#pragma unroll
    for (int d0 = 0; d0 < 4; ++d0) gv[d0] = gain[d0 * 32 + r32];
#pragma unroll
    for (int r = 0; r < 16; ++r) { float s = 0.f;
#pragma unroll
      for (int d0 = 0; d0 < 4; ++d0) { o[d0][r] *= rli[r]; s += o[d0][r] * o[d0][r]; }
      s += __shfl_xor(s, 1); s += __shfl_xor(s, 2); s += __shfl_xor(s, 4); s += __shfl_xor(s, 8); s += __shfl_xor(s, 16);
      rli[r] = __builtin_amdgcn_rsqf(s * (1.0f / 128.0f) + 1e-6f); }
#pragma unroll
    for (int r = 0; r < 16; ++r)
#pragma unroll
      for (int d0 = 0; d0 < 4; ++d0) o[d0][r] *= gv[d0];
  }
  { bf16* stg = (bf16*)lds + wid * 4096;
#pragma unroll
    for (int r = 0; r < 16; ++r) { const int orow = crow(r, hi);
#pragma unroll
      for (int d0 = 0; d0 < 4; ++d0) { const float v = o[d0][r] * rli[r]; unsigned u = __float_as_uint(v); u = (u + 0x7fffu + ((u >> 16) & 1u)) >> 16; stg[orow * 128 + d0 * 32 + r32] = (bf16)u; } }
    asm volatile("s_waitcnt lgkmcnt(0)" ::: "memory");
#pragma unroll
    for (int i = 0; i < 8; ++i) { const int row = i * 4 + (lane >> 4), ch = lane & 15; const u32x4 v = *(const u32x4*)(stg + row * 128 + ch * 8); *(u32x4*)(Ob + (long)(wid * 32 + row) * ldo + ch * 8) = v; } }
  __syncthreads();
#undef TILE
#undef DMA_K
#undef DMA_V
#undef SDRAIN
}
#undef KSWZ
#undef SBAR
}
#define GAS __attribute__((address_space(1)))
#define LAS __attribute__((address_space(3)))
typedef unsigned short bf16;
typedef unsigned v4u __attribute__((ext_vector_type(4)));
typedef float f32x4 __attribute__((ext_vector_type(4)));
#define LDS_WAIT() asm volatile("s_waitcnt lgkmcnt(0)" ::: "memory")
constexpr int NWAVES = 8;
constexpr int BATCH = 8, SEQ = 2048, DM = 2048, M = BATCH * SEQ, HD = 128, NH = 8;
constexpr int NQKV = 6144, FF = 5632, WX = 512, NMEM = 256, MMEM = BATCH * NMEM;
constexpr int QSB = 0, KSB = 1024, VSB = 2048, QMB = 3072, KMB = 4096, VMB = 5120;
constexpr float EPS = 1e-6f;
constexpr float QSCALE = 0.12751743082459868f;
constexpr size_t MiB = 1u << 20;
constexpr size_t WS_CTL = 0, CTL_ZERO_BYTES = 1 * MiB;
constexpr size_t WS_SSQ1 = 64 * 1024, WS_SSQ2 = 128 * 1024;
constexpr size_t WS_KSUM = 256 * 1024;
constexpr size_t WS_WIN = 1 * MiB, WS_WOUT = 25 * MiB, WS_WXQ = 33 * MiB, WS_WXKV = 35 * MiB, WS_WXO = 39 * MiB, WS_WGU = 41 * MiB, WS_WDN = 85 * MiB;
constexpr size_t WS_RA = 107 * MiB;
constexpr size_t WS_RB = 171 * MiB;
constexpr size_t WS_RC = 235 * MiB;
constexpr size_t WS_QX = 427 * MiB, WS_OX = 443 * MiB, WS_KVX = 459 * MiB, WS_MN = 463 * MiB, WS_KMEAN = 471 * MiB, WS_CS = 472 * MiB, WS_END = 474 * MiB;
constexpr int RING_BYTES = 131072, LDS_BYTES = 147456;
#ifndef FFN_FP8
#define FFN_FP8 1
#endif
constexpr float S_X2 = 16.f, S_WGU = 32.f, S_ACT = 8.f, S_WDN = 64.f;

__device__ __forceinline__ float bf2f(unsigned short b) { return __uint_as_float((unsigned)b << 16); }
__device__ __forceinline__ unsigned f2bf(float f) { unsigned u = __builtin_bit_cast(unsigned, f); return (u + 0x7fffu + ((u >> 16) & 1u)) >> 16; }
__device__ __forceinline__ unsigned pk2(float lo, float hi) { return f2bf(lo) | (f2bf(hi) << 16); }
__device__ __forceinline__ float wave_sum(float v) {
#pragma unroll
    for (int o = 1; o < 64; o <<= 1) v += __shfl_xor(v, o);
    return v;
}
__device__ __forceinline__ float wave_max(float v) {
#pragma unroll
    for (int o = 1; o < 64; o <<= 1) v = fmaxf(v, __shfl_xor(v, o));
    return v;
}

typedef GAS unsigned gu32;
#define RLX_AGENT __ATOMIC_RELAXED, __HIP_MEMORY_SCOPE_AGENT
constexpr int CW_BAR = 4096;
constexpr int LDSCTL_OFF = RING_BYTES, MISC_OFF = LDSCTL_OFF + 320;
#define XB_TMO      128
#define XB_XCNT(j)  (256  + 64 * (j))
#define XB_XSUB(j)  (1280 + 64 * (j))
#define XB_XGEN(j)  (2304 + 64 * (j))
#define XB_TOP      3328
#define XB_TOPGEN   3392
#define XCD_BAR_WORDS 3456
#define XB_SPIN_CAP (1u << 18)

__device__ __forceinline__ unsigned xb_ld(unsigned* p)              { return __hip_atomic_load(p, __ATOMIC_RELAXED, __HIP_MEMORY_SCOPE_AGENT); }
__device__ __forceinline__ unsigned xb_add(unsigned* p, unsigned v) { return __hip_atomic_fetch_add(p, v, __ATOMIC_RELAXED, __HIP_MEMORY_SCOPE_AGENT); }
__device__ __forceinline__ unsigned xb_xcc_id() { return (unsigned)__builtin_amdgcn_s_getreg((3 << 11) | 20) & 0xFu; }
#define XB_SPIN(cond, bar) do { unsigned _sp = 0; while (cond) { __builtin_amdgcn_s_sleep(1); \
    if ((++_sp & 255u) == 0u) { if (xb_ld(&(bar)[XB_TMO])) break; if (_sp > XB_SPIN_CAP) { atomicAdd(&(bar)[XB_TMO], 1u); break; } } } } while (0)

struct XcdBarrier {
    unsigned* bar; unsigned x;
    volatile LAS unsigned* st;
};

__device__ __forceinline__ XcdBarrier xcd_barrier_post(unsigned* bar, volatile LAS unsigned* st) {
    XcdBarrier b; b.bar = bar; b.x = xb_xcc_id(); b.st = st;
    if (threadIdx.x == 0) (void)xb_add(&bar[XB_XCNT(b.x)], 1u);
    return b;
}
__device__ __forceinline__ void xcd_barrier_complete(unsigned* bar, unsigned x, unsigned& nloc, unsigned& nx) {
    const unsigned G = gridDim.x * gridDim.y * gridDim.z;
    unsigned sum, cnt, mine, sp = 0u;
    for (;;) {
        sum = 0u; cnt = 0u; mine = 0u;
#pragma unroll
        for (unsigned j = 0; j < 16; ++j) { const unsigned c = xb_ld(&bar[XB_XCNT(j)]); sum += c; cnt += (c > 0u) ? 1u : 0u; mine = (j == x) ? c : mine; }
        if (sum == G) break;
        __builtin_amdgcn_s_sleep(1);
        if ((++sp & 255u) == 0u) { if (xb_ld(&bar[XB_TMO])) break; if (sp > XB_SPIN_CAP) { atomicAdd(&bar[XB_TMO], 1u); break; } }
    }
    nloc = mine > 0u ? mine : 1u; nx = cnt > 0u ? cnt : 1u;
}

__device__ __forceinline__ void xcd_barrier(const XcdBarrier& b) {
    asm volatile("s_waitcnt vmcnt(0)" ::: "memory");
    __syncthreads();
    if (threadIdx.x == 0) {
        unsigned* bar = b.bar;
        __builtin_amdgcn_s_waitcnt(0);
        unsigned nloc = b.st[0], nx = b.st[1];
        if (nloc == 0u) { xcd_barrier_complete(bar, b.x, nloc, nx); b.st[0] = nloc; b.st[1] = nx; }
        const unsigned old = xb_add(&bar[XB_XSUB(b.x)], 1u);
        const unsigned gen = old / nloc;
        if (old + 1u == (gen + 1u) * nloc) {
            __builtin_amdgcn_fence(__ATOMIC_RELEASE, "agent");
            asm volatile("s_waitcnt vmcnt(0)" ::: "memory");
            const unsigned og = xb_add(&bar[XB_TOP], 1u);
            const unsigned tg = og / nx;
            if (og + 1u == (tg + 1u) * nx) xb_add(&bar[XB_TOPGEN], 1u);
            else XB_SPIN(xb_ld(&bar[XB_TOPGEN]) == tg, bar);
            __builtin_amdgcn_fence(__ATOMIC_ACQUIRE, "agent");
            xb_add(&bar[XB_XGEN(b.x)], 1u);
            asm volatile("s_waitcnt vmcnt(0)" ::: "memory");
        } else {
            XB_SPIN(xb_ld(&bar[XB_XGEN(b.x)]) == gen, bar);
            __builtin_amdgcn_fence(__ATOMIC_ACQUIRE, "agent");
            asm volatile("s_waitcnt vmcnt(0)" ::: "memory");
        }
    }
    __syncthreads();
}

struct Frame {
    LAS unsigned char* lds;
    int tid, lane, wave, vcu, G;
    const float *x, *mem; const int* pos;
    const float *g_mix, *w_in, *g_out_sb, *g_out_mb, *w_out, *g_xattn, *g_mem, *w_xq, *w_xkv, *w_xo, *g_ffn, *w_gu, *w_dn, *g_final;
    float* out; unsigned char* ws;
};

__device__ __forceinline__ void transpose_item(const float* W, int K, int N, bf16* WT, const float* gain, int inter, LAS float* scr, int item, int lane) {
    const int nblk = N / 32, kb = item / nblk, nb = item % nblk, k0 = 64 * kb, n0 = 32 * nb;
    int orow0 = n0;
    if (inter) orow0 = (n0 < FF) ? (n0 / 128) * 256 + (n0 % 128) : ((n0 - FF) / 128) * 256 + 128 + ((n0 - FF) % 128);
    float v[32];
#pragma unroll
    for (int i = 0; i < 32; ++i) v[i] = W[(size_t)(k0 + 2 * i + (lane >> 5)) * N + n0 + (lane & 31)];
#pragma unroll
    for (int i = 0; i < 32; ++i) { const int kk = 2 * i + (lane >> 5); float t = v[i]; if (gain) t *= gain[k0 + kk]; scr[kk * 33 + (lane & 31)] = t; }
    LDS_WAIT(); asm volatile("" ::: "memory");
    const int c = lane & 7;
#pragma unroll
    for (int j = 0; j < 4; ++j) { const int n = (lane >> 3) + 8 * j; const LAS float* s = scr + (8 * c) * 33 + n;
        v4u o; o.x = pk2(s[0 * 33], s[1 * 33]); o.y = pk2(s[2 * 33], s[3 * 33]); o.z = pk2(s[4 * 33], s[5 * 33]); o.w = pk2(s[6 * 33], s[7 * 33]);
        *(GAS v4u*)(WT + (size_t)(orow0 + n) * K + k0 + 8 * c) = o; }
    LDS_WAIT(); asm volatile("" ::: "memory");
}
__device__ __forceinline__ void transpose_item_fp8(const float* W, int K, int N, unsigned char* WT, const float* gain, int inter, float scale, LAS float* scr, int item, int lane) {
    const int nblk = N / 32, kb = item / nblk, nb = item % nblk, k0 = 64 * kb, n0 = 32 * nb;
    int orow0 = n0;
    if (inter) orow0 = (n0 < FF) ? (n0 / 128) * 256 + (n0 % 128) : ((n0 - FF) / 128) * 256 + 128 + ((n0 - FF) % 128);
    float v[32];
#pragma unroll
    for (int i = 0; i < 32; ++i) v[i] = W[(size_t)(k0 + 2 * i + (lane >> 5)) * N + n0 + (lane & 31)];
#pragma unroll
    for (int i = 0; i < 32; ++i) { const int kk = 2 * i + (lane >> 5); float t = v[i] * scale; if (gain) t *= gain[k0 + kk]; scr[kk * 33 + (lane & 31)] = t; }
    LDS_WAIT(); asm volatile("" ::: "memory");
    const int c = lane & 7;
#pragma unroll
    for (int j = 0; j < 4; ++j) { const int n = (lane >> 3) + 8 * j; const LAS float* s = scr + (8 * c) * 33 + n;
        pg8::u32x2 o; o.x = pg8::pk4_fp8(s[0 * 33], s[1 * 33], s[2 * 33], s[3 * 33]); o.y = pg8::pk4_fp8(s[4 * 33], s[5 * 33], s[6 * 33], s[7 * 33]);
        *(GAS pg8::u32x2*)(WT + (size_t)(orow0 + n) * K + k0 + 8 * c) = o; }
    LDS_WAIT(); asm volatile("" ::: "memory");
}
__device__ __forceinline__ void rms_row_to_bf16(const float* xrow, const float* g, bf16* orow, int lane) {
    const GAS f32x4* xr = (const GAS f32x4*)xrow + lane; const GAS f32x4* gr = (const GAS f32x4*)g + lane;
    f32x4 v[8]; float s = 0.f;
#pragma unroll
    for (int j = 0; j < 8; ++j) { v[j] = xr[64 * j]; s += (v[j].x * v[j].x + v[j].y * v[j].y) + (v[j].z * v[j].z + v[j].w * v[j].w); }
    const float rstd = 1.0f / sqrtf(wave_sum(s) * (1.f / DM) + EPS);
    GAS unsigned long long* o8 = (GAS unsigned long long*)orow + lane;
#pragma unroll
    for (int j = 0; j < 8; ++j) { const f32x4 gg = gr[64 * j];
        o8[64 * j] = (unsigned long long)pk2(v[j].x * rstd * gg.x, v[j].y * rstd * gg.y) | ((unsigned long long)pk2(v[j].z * rstd * gg.z, v[j].w * rstd * gg.w) << 32); }
}
__constant__ float INV_FREQ[16] = {1.000000000e+00f, 4.403665960e-01f, 1.939227432e-01f, 8.539710194e-02f, 3.760603070e-02f, 1.656043902e-02f, 7.292664610e-03f, 3.211445874e-03f,
                                   1.414213562e-03f, 6.227723788e-04f, 2.742481884e-04f, 1.207697351e-04f, 5.318296098e-05f, 2.341999971e-05f, 1.031338616e-05f, 4.541670478e-06f};

__device__ __forceinline__ void p0_prologue(Frame& F) {
    LAS float* scr = (LAS float*)(F.lds + F.wave * 16384);
    const int gw = F.vcu * NWAVES + F.wave, NGW = F.G * NWAVES;
    bf16* ws16 = (bf16*)F.ws;
    constexpr int I0 = (DM / 64) * (NQKV / 32), I1 = (DM / 64) * (DM / 32), I2 = (DM / 64) * (WX / 32), I3 = (DM / 64) * (2 * WX / 32), I4 = (WX / 64) * (DM / 32),
                  I5 = (DM / 64) * (2 * FF / 32), I6 = (FF / 64) * (DM / 32);
    constexpr int I5H = I5 / 2;
    constexpr int NITEMS = I0 + I1 + I2 + I3 + I4 + I5H;
    for (int it = gw; it < NITEMS; it += NGW) {
        int r = it;
        if (r < I0) { transpose_item(F.w_in, DM, NQKV, (bf16*)(F.ws + WS_WIN), nullptr, 0, scr, r, F.lane); continue; } r -= I0;
        if (r < I1) { transpose_item(F.w_out, DM, DM, (bf16*)(F.ws + WS_WOUT), nullptr, 0, scr, r, F.lane); continue; } r -= I1;
        if (r < I2) { transpose_item(F.w_xq, DM, WX, (bf16*)(F.ws + WS_WXQ), F.g_xattn, 0, scr, r, F.lane); continue; } r -= I2;
        if (r < I3) { transpose_item(F.w_xkv, DM, 2 * WX, (bf16*)(F.ws + WS_WXKV), nullptr, 0, scr, r, F.lane); continue; } r -= I3;
        if (r < I4) { transpose_item(F.w_xo, WX, DM, (bf16*)(F.ws + WS_WXO), nullptr, 0, scr, r, F.lane); continue; } r -= I4;
        transpose_item_fp8(F.w_gu, DM, 2 * FF, F.ws + WS_WGU, F.g_ffn, 1, S_WGU, scr, r, F.lane);
    }
    (void)ws16;
    for (int m = gw; m < M; m += NGW) rms_row_to_bf16(F.x + (size_t)m * DM, F.g_mix, (bf16*)(F.ws + WS_RA) + (size_t)m * DM, F.lane);
    for (int m = gw; m < MMEM; m += NGW) rms_row_to_bf16(F.mem + (size_t)m * DM, F.g_mem, (bf16*)(F.ws + WS_MN) + (size_t)m * DM, F.lane);
    float* cs = (float*)(F.ws + WS_CS);
    for (int e = (F.vcu * NWAVES + F.wave) * 64 + F.lane; e < M * 16; e += NGW * 64) {
        const int m = e >> 4, i = e & 15; const float ang = (float)F.pos[m] * INV_FREQ[i];
        double rev = (double)ang * 0.15915494309189535; rev -= floor(rev);
        const float a = (float)(rev * 6.283185307179586);
        cs[(size_t)m * 32 + i] = cosf(a); cs[(size_t)m * 32 + 16 + i] = sinf(a);
    }
}

__device__ __forceinline__ void ffn_weight_items(Frame& F, int wi, int nw) {
    LAS float* scr = (LAS float*)(F.lds + F.wave * 16384);
    constexpr int I5 = (DM / 64) * (2 * FF / 32), I6 = (FF / 64) * (DM / 32);
    for (int it = wi + I5 / 2; it < I5 + I6; it += nw) {
        if (it < I5) transpose_item_fp8(F.w_gu, DM, 2 * FF, F.ws + WS_WGU, F.g_ffn, 1, S_WGU, scr, it, F.lane);
        else transpose_item_fp8(F.w_dn, FF, DM, F.ws + WS_WDN, nullptr, 0, S_WDN, scr, it - I5, F.lane);
    }
}

__device__ __forceinline__ float dot128(const LAS float* qs, const bf16* krow) {
    float s = 0.f;
#pragma unroll
    for (int c = 0; c < 16; ++c) { const v4u kv = *(const v4u*)(krow + 8 * c); const LAS f32x4* q4 = (const LAS f32x4*)(qs + 8 * c); const f32x4 qa = q4[0], qb = q4[1];
        s += qa.x * __uint_as_float(kv.x << 16) + qa.y * __uint_as_float(kv.x & 0xffff0000u) + qa.z * __uint_as_float(kv.y << 16) + qa.w * __uint_as_float(kv.y & 0xffff0000u)
           + qb.x * __uint_as_float(kv.z << 16) + qb.y * __uint_as_float(kv.z & 0xffff0000u) + qb.z * __uint_as_float(kv.w << 16) + qb.w * __uint_as_float(kv.w & 0xffff0000u); }
    return s;
}
__device__ __forceinline__ void load_q_lds(LAS float* qs, const bf16* qp, int lane) { qs[lane] = bf2f(qp[lane]); qs[64 + lane] = bf2f(qp[64 + lane]); LDS_WAIT(); asm volatile("" ::: "memory"); }
__device__ __forceinline__ void pv64(float w, const bf16* vbase, size_t ld, int cnt, int lane, float& o0, float& o1) {
    for (int i = 0; i < cnt; ++i) { const float wi = __shfl(w, i); const unsigned vv = *(const unsigned*)(vbase + (size_t)i * ld + 2 * lane); o0 += wi * __uint_as_float(vv << 16); o1 += wi * __uint_as_float(vv & 0xffff0000u); }
}
__device__ __forceinline__ float softplus2(float y) { return fmaxf(y, 0.f) + __builtin_amdgcn_logf(1.0f + __builtin_amdgcn_exp2f(-fabsf(y))); }
__device__ __forceinline__ void store_head_norm(float o0, float o1, const float* g, bf16* op, int lane) {
    const float ssq = wave_sum(o0 * o0 + o1 * o1); const float r = 1.0f / sqrtf(ssq * (1.f / HD) + EPS);
    *(unsigned*)(op + 2 * lane) = pk2(o0 * r * g[2 * lane], o1 * r * g[2 * lane + 1]);
}
__device__ __forceinline__ void naive_sb_row(Frame& F, LAS float* qs, int bh, int t) {
    const int b = bh >> 3, h = bh & 7, lane = F.lane; const bf16* qkv = (const bf16*)(F.ws + WS_RC); const size_t rb = (size_t)b * SEQ;
    load_q_lds(qs, qkv + (rb + t) * NQKV + QSB + h * HD, lane);
    const bf16* kp = qkv + rb * NQKV + KSB + h * HD; const bf16* vp = qkv + rb * NQKV + VSB + h * HD;
    float o0 = 0.f, o1 = 0.f, carry = 0.f;
    for (int c = (t - 1) >> 6; c >= 0; --c) {
        const int key = c * 64 + lane; const bool valid = key < t;
        float y = 0.f; if (valid) y = dot128(qs, kp + (size_t)key * NQKV);
        const float sp = valid ? softplus2(y) : 0.f;
        float suf = sp;
#pragma unroll
        for (int off = 1; off < 64; off <<= 1) { const float tt = __shfl_down(suf, off); if (lane + off < 64) suf += tt; }
        const float w = valid ? __builtin_amdgcn_exp2f(y - (suf + carry)) : 0.f;
        carry += __shfl(suf, 0);
        const int cnt = (t - c * 64) < 64 ? (t - c * 64) : 64;
        pv64(w, vp + (size_t)(c * 64) * NQKV, NQKV, cnt, lane, o0, o1);
    }
    store_head_norm(o0, o1, F.g_out_sb + h * HD, (bf16*)(F.ws + WS_RA) + (rb + t) * DM + h * HD, lane);
    LDS_WAIT();
}
__device__ __forceinline__ void softmax_chunk(float s, bool valid, const bf16* vbase, size_t ld, int cnt, int lane, float& m, float& l, float& o0, float& o1) {
    const float cm = wave_max(valid ? s : -1e30f); const float mn = fmaxf(m, cm); const float alpha = __builtin_amdgcn_exp2f(m - mn);
    const float p = valid ? __builtin_amdgcn_exp2f(s - mn) : 0.f;
    l = l * alpha + wave_sum(p); o0 *= alpha; o1 *= alpha; m = mn;
    pv64(p, vbase, ld, cnt, lane, o0, o1);
}
__device__ __forceinline__ void naive_moba_row(Frame& F, LAS float* qs, int bh, int t) {
    const int b = bh >> 3, h = bh & 7, lane = F.lane; const bf16* qkv = (const bf16*)(F.ws + WS_RC); const size_t rb = (size_t)b * SEQ;
    load_q_lds(qs, qkv + (rb + t) * NQKV + QMB + h * HD, lane);
    const bf16* kp = qkv + rb * NQKV + KMB + h * HD; const bf16* vp = qkv + rb * NQKV + VMB + h * HD;
    const int blk = t >> 8;
    const float* km = (const float*)(F.ws + WS_KMEAN) + (size_t)bh * 8 * HD;
    float g = -INFINITY;
    { const int n = lane & 7; if (n < blk) { float a = 0.f; for (int d = 0; d < HD; ++d) a += qs[d] * km[n * HD + d]; g = a; } }
    int cnt = 0;
#pragma unroll
    for (int mI = 0; mI < 8; ++mI) { const float gm = __shfl(g, mI); cnt += (gm > g || (gm == g && mI < (lane & 7))) ? 1 : 0; }
    const bool sel = (lane < 8) && (lane < blk) && (cnt < 3);
    const unsigned selmask = (unsigned)(__ballot(sel) & 0xffull);
    float m = -1e30f, l = 0.f, o0 = 0.f, o1 = 0.f;
    for (int n = 0; n <= blk; ++n) {
        if (n < blk && !((selmask >> n) & 1u)) continue;
        for (int c = 0; c < 4; ++c) {
            const int key0 = n * 256 + c * 64; if (key0 > t) break;
            const int key = key0 + lane; const bool valid = key <= t;
            float s = 0.f; if (valid) s = dot128(qs, kp + (size_t)key * NQKV);
            const int cn = (t - key0 + 1) < 64 ? (t - key0 + 1) : 64;
            softmax_chunk(s, valid, vp + (size_t)key0 * NQKV, NQKV, cn, lane, m, l, o0, o1);
        }
    }
    const float il = 1.0f / l;
    store_head_norm(o0 * il, o1 * il, F.g_out_mb + h * HD, (bf16*)(F.ws + WS_RA) + (rb + t) * DM + NH * HD + h * HD, lane);
    LDS_WAIT();
}
__device__ __forceinline__ void naive_xattn_row(Frame& F, LAS float* qs, int b, int h, int t) {
    const int lane = F.lane; const bf16* qx = (const bf16*)(F.ws + WS_QX); const bf16* kv = (const bf16*)(F.ws + WS_KVX);
    load_q_lds(qs, qx + ((size_t)b * SEQ + t) * WX + h * HD, lane);
    const bf16* kp = kv + (size_t)b * NMEM * (2 * WX) + h * HD; const bf16* vp = kp + WX;
    float m = -1e30f, l = 0.f, o0 = 0.f, o1 = 0.f;
    for (int c = 0; c < 4; ++c) { const int key = c * 64 + lane; const float s = dot128(qs, kp + (size_t)key * (2 * WX));
        softmax_chunk(s, true, vp + (size_t)(c * 64) * (2 * WX), 2 * WX, 64, lane, m, l, o0, o1); }
    const float il = 1.0f / l;
    *(unsigned*)((bf16*)(F.ws + WS_OX) + ((size_t)b * SEQ + t) * WX + h * HD + 2 * lane) = pk2(o0 * il, o1 * il);
    LDS_WAIT();
}
__device__ __forceinline__ void kmean_phase(Frame& F) {
    LAS float* red = (LAS float*)F.lds;
    const bf16* qkv = (const bf16*)(F.ws + WS_RC); float* km = (float*)(F.ws + WS_KMEAN);
    const int cc = F.tid & 15, rg = F.tid >> 4;
    for (int item = F.vcu; item < 64 * 8; item += F.G) {
        const int bh = item >> 3, n = item & 7, b = bh >> 3, h = bh & 7;
        const bf16* kp = qkv + ((size_t)b * SEQ + n * 256 + rg * 8) * NQKV + KMB + h * HD + cc * 8;
        float a[8] = {0, 0, 0, 0, 0, 0, 0, 0};
#pragma unroll
        for (int r = 0; r < 8; ++r) { const v4u kv = *(const v4u*)(kp + (size_t)r * NQKV);
            a[0] += __uint_as_float(kv.x << 16); a[1] += __uint_as_float(kv.x & 0xffff0000u); a[2] += __uint_as_float(kv.y << 16); a[3] += __uint_as_float(kv.y & 0xffff0000u);
            a[4] += __uint_as_float(kv.z << 16); a[5] += __uint_as_float(kv.z & 0xffff0000u); a[6] += __uint_as_float(kv.w << 16); a[7] += __uint_as_float(kv.w & 0xffff0000u); }
#pragma unroll
        for (int j = 0; j < 8; ++j) red[rg * 128 + cc * 8 + j] = a[j];
        __syncthreads();
        if (F.tid < 128) { float s = 0.f; for (int r = 0; r < 32; ++r) s += red[r * 128 + F.tid]; km[(size_t)item * HD + F.tid] = s * (1.0f / 256.0f); }
        __syncthreads();
    }
}
__device__ __forceinline__ void final_norm_phase(Frame& F, const bf16* src, float* dst) {
    const int gw = F.vcu * NWAVES + F.wave, NGW = F.G * NWAVES;
    for (int m = gw; m < M; m += NGW) {
        const GAS v4u* xr = (const GAS v4u*)(src + (size_t)m * DM) + F.lane; const GAS f32x4* gr = (const GAS f32x4*)F.g_final;
        v4u w[4]; float s = 0.f;
#pragma unroll
        for (int j = 0; j < 4; ++j) w[j] = xr[64 * j];
        f32x4 v[8];
#pragma unroll
        for (int j = 0; j < 4; ++j) { v[2 * j] = (f32x4){__uint_as_float(w[j].x << 16), __uint_as_float(w[j].x & 0xffff0000u), __uint_as_float(w[j].y << 16), __uint_as_float(w[j].y & 0xffff0000u)};
            v[2 * j + 1] = (f32x4){__uint_as_float(w[j].z << 16), __uint_as_float(w[j].z & 0xffff0000u), __uint_as_float(w[j].w << 16), __uint_as_float(w[j].w & 0xffff0000u)}; }
#pragma unroll
        for (int j = 0; j < 8; ++j) s += (v[j].x * v[j].x + v[j].y * v[j].y) + (v[j].z * v[j].z + v[j].w * v[j].w);
        const float rstd = 1.0f / sqrtf(wave_sum(s) * (1.f / DM) + EPS);
        GAS f32x4* dr = (GAS f32x4*)(dst + (size_t)m * DM);
#pragma unroll
        for (int j = 0; j < 4; ++j) { const int c4 = (64 * j + F.lane) * 2;
            dr[c4] = v[2 * j] * rstd * gr[c4]; dr[c4 + 1] = v[2 * j + 1] * rstd * gr[c4 + 1]; }
    }
}

constexpr int NPH = 11;
#ifndef FOLD_KMEAN
#define FOLD_KMEAN 1
#endif
#ifndef REPEAT_PHASE
#define REPEAT_PHASE -1
#endif
#ifndef REPEAT_MASK
#define REPEAT_MASK 0
#endif
#define REPS(k) (((REPEAT_PHASE == (k)) || ((REPEAT_MASK >> (k)) & 1)) ? 2 : 1)
#ifndef USE_MFMA_SB
#define USE_MFMA_SB 1
#endif
#ifndef USE_MFMA_MOBA
#define USE_MFMA_MOBA 1
#endif
#ifndef USE_MFMA_X
#define USE_MFMA_X 1
#endif
#ifndef MK_ONE_LAUNCH
#define MK_ONE_LAUNCH 1
#endif
struct Args { const void* in[17]; float* out; unsigned char* ws; int ph_lo, ph_hi; };
__global__ void __launch_bounds__(NWAVES * 64, 2) mk_fwd(Args args) {
    extern __shared__ __attribute__((aligned(16))) unsigned char lds[];
    Frame F;
    F.lds = (LAS unsigned char*)lds;
    F.tid = threadIdx.x; F.lane = F.tid & 63; F.wave = __builtin_amdgcn_readfirstlane(F.tid >> 6);
    F.G = gridDim.x; { const int bx = blockIdx.x; F.vcu = (F.G % 8 == 0) ? (bx % 8) * (F.G / 8) + bx / 8 : bx; }
    F.x = (const float*)args.in[0]; F.mem = (const float*)args.in[1]; F.pos = (const int*)args.in[2];
    F.g_mix = (const float*)args.in[3]; F.w_in = (const float*)args.in[4]; F.g_out_sb = (const float*)args.in[5]; F.g_out_mb = (const float*)args.in[6]; F.w_out = (const float*)args.in[7];
    F.g_xattn = (const float*)args.in[8]; F.g_mem = (const float*)args.in[9]; F.w_xq = (const float*)args.in[10]; F.w_xkv = (const float*)args.in[11]; F.w_xo = (const float*)args.in[12];
    F.g_ffn = (const float*)args.in[13]; F.w_gu = (const float*)args.in[14]; F.w_dn = (const float*)args.in[15]; F.g_final = (const float*)args.in[16];
    F.out = args.out; F.ws = args.ws;
    unsigned char* ws = args.ws;
    const int lo = args.ph_lo, hi = args.ph_hi;
    for (int u = F.tid; u < (LDS_BYTES - LDSCTL_OFF) / 4; u += NWAVES * 64) ((LAS unsigned*)(F.lds + LDSCTL_OFF))[u] = 0u;
    __syncthreads();
    if (hi - lo > 1) cg::this_grid().sync();
    XcdBarrier bar = xcd_barrier_post((unsigned*)(ws + WS_CTL) + CW_BAR, (volatile LAS unsigned*)(F.lds + MISC_OFF) + 8);
#ifndef ONLY_PHASE
#define ONLY_PHASE -1
#endif
#define IN(k) ((ONLY_PHASE < 0 || ONLY_PHASE == (k)) && lo <= (k) && (k) < hi)
#define BOTH(k) (IN(k) && IN((k) + 1))
#define GRID_BAR() xcd_barrier(bar)
    float* ssq1 = (float*)(ws + WS_SSQ1); float* ssq2 = (float*)(ws + WS_SSQ2);
    pg8::bf16_t* RA = (pg8::bf16_t*)(ws + WS_RA); pg8::bf16_t* RB = (pg8::bf16_t*)(ws + WS_RB); pg8::bf16_t* RC = (pg8::bf16_t*)(ws + WS_RC);

    if (IN(0)) { for (int rep = 0; rep < REPS(0); ++rep) p0_prologue(F); if (BOTH(0)) GRID_BAR(); }
    if (IN(1)) {
        pg8::Gemm g{RA, (const pg8::bf16_t*)(ws + WS_WIN), M, NQKV, DM}; pg8::StaticOrder S; S.init(M, NQKV, F.G, (int)blockIdx.x);
        pg8::EpiQKV E{RC, (const float*)(ws + WS_CS), QSCALE, (float*)(ws + WS_KSUM)};
        for (int rep = 0; rep < REPS(1); ++rep) pg8::gemm_phase<pg8::EpiQKV, pg8::StaticOrder, true, true>(F.lds, g, S, E);
        if (BOTH(1)) GRID_BAR();
    }
#if !FOLD_KMEAN
    if (IN(2)) { for (int rep = 0; rep < REPS(2); ++rep) kmean_phase(F); if (BOTH(2)) GRID_BAR(); }
#endif
    if (IN(3)) {
        const att::bf16* qkv = (const att::bf16*)RC; att::bf16* ob = (att::bf16*)RA; const float* kmean = (const float*)(ws + (FOLD_KMEAN ? WS_KSUM : WS_KMEAN));
#if !(USE_MFMA_SB && USE_MFMA_MOBA)
        LAS float* qs = (LAS float*)(F.lds + F.wave * 1024);
        const int gw = F.vcu * NWAVES + F.wave, NGW = F.G * NWAVES;
#endif
#if !USE_MFMA_SB
        for (int i = gw; i < 64 * SEQ; i += NGW) { const int bh = i >> 11, t = (int)(((unsigned)i + (unsigned)(i >> 11) * 997u) & 2047u); naive_sb_row(F, qs, bh, t); }
#endif
#if !USE_MFMA_MOBA
        for (int i = gw; i < 64 * SEQ; i += NGW) { const int bh = i >> 11, t = (int)(((unsigned)i + (unsigned)(i >> 11) * 997u) & 2047u); naive_moba_row(F, qs, bh, t); }
        __syncthreads();
#endif
        for (int rep = 0; rep < REPS(3); ++rep) {
#if USE_MFMA_SB
        for (int vv = F.vcu; vv < 256; vv += F.G) { const int bh = vv >> 2, s = vv & 3, b = bh >> 3, h = bh & 7; const size_t rb = (size_t)b * SEQ;
            for (int i = 0; i < 2; ++i) { const int qb = i ? s : 7 - s; const size_t r0 = rb + (size_t)qb * 256;
                att::attn_unit<2>(qkv + r0 * NQKV + QSB + h * HD, NQKV, qkv + rb * NQKV + KSB + h * HD, qkv + rb * NQKV + VSB + h * HD, NQKV, ob + r0 * DM + h * HD, DM, F.g_out_sb + h * HD, nullptr, qb, 0, (char*)lds); } }
#endif
#if USE_MFMA_MOBA
        for (int vv = F.vcu; vv < 256; vv += F.G) { const int bh = vv >> 2, s = vv & 3, b = bh >> 3, h = bh & 7; const size_t rb = (size_t)b * SEQ;
            for (int i = 0; i < 2; ++i) { const int qb = i ? s : 7 - s; const size_t r0 = rb + (size_t)qb * 256;
                att::attn_unit<1>(qkv + r0 * NQKV + QMB + h * HD, NQKV, qkv + rb * NQKV + KMB + h * HD, qkv + rb * NQKV + VMB + h * HD, NQKV, ob + r0 * DM + NH * HD + h * HD, DM, F.g_out_mb + h * HD, kmean + (size_t)bh * 1024, qb, 0, (char*)lds); } }
#endif
        }
        if (BOTH(3)) GRID_BAR();
    }
    if (IN(4)) {
        pg8::Gemm g{RA, (const pg8::bf16_t*)(ws + WS_WOUT), M, DM, DM}; pg8::StaticOrder S; S.init(M, DM, F.G, (int)blockIdx.x);
        if (REPS(4) == 2) { pg8::EpiResB<true> E0{F.x, RB, nullptr, nullptr, 1.f, 1.f}; pg8::gemm_phase<pg8::EpiResB<true>, pg8::StaticOrder, true, true>(F.lds, g, S, E0); }
        pg8::EpiResB<true> E{F.x, RB, ssq1, nullptr, 1.f, 1.f};
        pg8::gemm_phase<pg8::EpiResB<true>, pg8::StaticOrder, true, true>(F.lds, g, S, E);
        if (BOTH(4)) GRID_BAR();
    }
    if (IN(5)) {
      for (int rep = 0; rep < REPS(5); ++rep) {
        { pg8::Gemm g{RB, (const pg8::bf16_t*)(ws + WS_WXQ), M, WX, DM}; pg8::StaticOrder S; S.init(M, WX, F.G, (int)blockIdx.x);
          pg8::EpiScale E{(pg8::bf16_t*)(ws + WS_QX), WX, ssq1, QSCALE};
          pg8::gemm_phase<pg8::EpiScale, pg8::StaticOrder, true, true>(F.lds, g, S, E); }
        { pg8::Gemm g{(const pg8::bf16_t*)(ws + WS_MN), (const pg8::bf16_t*)(ws + WS_WXKV), MMEM, 2 * WX, DM}; pg8::StaticOrder S; S.init(MMEM, 2 * WX, F.G, (int)((blockIdx.x + F.G - 128) % F.G));
          pg8::EpiScale E{(pg8::bf16_t*)(ws + WS_KVX), 2 * WX, nullptr, 1.0f};
          pg8::gemm_phase<pg8::EpiScale, pg8::StaticOrder, true, true>(F.lds, g, S, E); }
        if (F.G > 160) { if ((int)blockIdx.x >= 160) ffn_weight_items(F, ((int)blockIdx.x - 160) * NWAVES + F.wave, (F.G - 160) * NWAVES); }
        else ffn_weight_items(F, (int)blockIdx.x * NWAVES + F.wave, F.G * NWAVES);
      }
        if (BOTH(5)) GRID_BAR();
    }
    if (IN(6)) {
#if USE_MFMA_X
        for (int rep = 0; rep < REPS(6); ++rep) {
        const att::bf16* qx = (const att::bf16*)(ws + WS_QX); const att::bf16* kvx = (const att::bf16*)(ws + WS_KVX); att::bf16* ox = (att::bf16*)(ws + WS_OX);
        for (int vv = F.vcu; vv < 256; vv += F.G) { const int b = vv >> 5, h = (vv >> 3) & 3, qb = vv & 7; const size_t r0 = (size_t)b * SEQ + (size_t)qb * 256;
            att::attn_unit<0>(qx + r0 * WX + h * HD, WX, kvx + (size_t)b * NMEM * (2 * WX) + h * HD, kvx + (size_t)b * NMEM * (2 * WX) + WX + h * HD, 2 * WX, ox + r0 * WX + h * HD, WX, nullptr, nullptr, qb, NMEM, (char*)lds); }
        }
#else
        LAS float* qs = (LAS float*)(F.lds + F.wave * 1024);
        const int gw = F.vcu * NWAVES + F.wave, NGW = F.G * NWAVES;
        for (int i = gw; i < BATCH * 4 * SEQ; i += NGW) { const int t = i & 2047, h = (i >> 11) & 3, b = i >> 13; naive_xattn_row(F, qs, b, h, t); }
#endif
        if (BOTH(6)) GRID_BAR();
    }
    if (IN(7)) {
        pg8::Gemm g{(const pg8::bf16_t*)(ws + WS_OX), (const pg8::bf16_t*)(ws + WS_WXO), M, DM, WX}; pg8::StaticOrder S; S.init(M, DM, F.G, (int)blockIdx.x);
        if (REPS(7) == 2) { pg8::EpiResB<false> E0{RB, RC, nullptr, nullptr, 1.f, 1.f}; pg8::gemm_phase<pg8::EpiResB<false>, pg8::StaticOrder, true, true>(F.lds, g, S, E0); }
        pg8::EpiResB<false> E{RB, RB, ssq2, (unsigned char*)RA, S_X2, 1.f};
        pg8::gemm_phase<pg8::EpiResB<false>, pg8::StaticOrder, true, true>(F.lds, g, S, E);
        if (BOTH(7)) GRID_BAR();
    }
    if (IN(8)) {
        pg8::Gemm g{RA, (const pg8::bf16_t*)(ws + WS_WGU), M, 2 * FF, FFN_FP8 ? DM / 2 : DM}; pg8::StaticOrder S; S.init(M, 2 * FF, F.G, (int)blockIdx.x);
        pg8::EpiSwiGLU E{RC, ssq2, FFN_FP8 ? (unsigned char*)RC : nullptr, FFN_FP8 ? 1.f / (S_X2 * S_WGU) : 1.f, S_ACT};
        for (int rep = 0; rep < REPS(8); ++rep) pg8::gemm_phase<pg8::EpiSwiGLU, pg8::StaticOrder, true, true, FFN_FP8 != 0>(F.lds, g, S, E);
        if (BOTH(8)) GRID_BAR();
    }
    if (IN(9)) {
        pg8::Gemm g{RC, (const pg8::bf16_t*)(ws + WS_WDN), M, DM, FF / 2}; pg8::StaticOrder S; S.init(M, DM, F.G, (int)blockIdx.x);
        if (REPS(9) == 2) { pg8::EpiResB<false> E0{RB, (pg8::bf16_t*)(ws + WS_RC + 96 * MiB), nullptr, nullptr, 1.f, 1.f / (S_ACT * S_WDN)}; pg8::gemm_phase<pg8::EpiResB<false>, pg8::StaticOrder, true, true, true>(F.lds, g, S, E0); }
        pg8::EpiResB<false> E{RB, RB, nullptr, nullptr, 1.f, 1.f / (S_ACT * S_WDN)};
        pg8::gemm_phase<pg8::EpiResB<false>, pg8::StaticOrder, true, true, true>(F.lds, g, S, E);
        if (BOTH(9)) GRID_BAR();
    }
    if (IN(10)) { if (REPS(10) == 2) final_norm_phase(F, RB, (float*)RC); final_norm_phase(F, RB, F.out); }
#undef IN
#undef BOTH
}

extern "C" void kernel_launch(void* const* d_in, const int* in_sizes, int n_in, void* d_out, int out_size, void* d_ws, size_t ws_size, hipStream_t stream) {
    static int grid = 0;
    if (grid == 0) {
        if (n_in != 17 || in_sizes[0] != M * DM || out_size != M * DM || ws_size < WS_END) { fprintf(stderr, "kernel_launch: unexpected shapes (n_in %d in0 %d out %d ws %zu)\n", n_in, n_in > 0 ? in_sizes[0] : -1, out_size, ws_size); grid = -1; return; }
        int dev = 0, cus = 0, per_cu = 0;
        if (hipGetDevice(&dev) != hipSuccess || hipDeviceGetAttribute(&cus, hipDeviceAttributeMultiprocessorCount, dev) != hipSuccess) { grid = -1; return; }
        if (hipFuncSetAttribute((const void*)mk_fwd, hipFuncAttributeMaxDynamicSharedMemorySize, LDS_BYTES) != hipSuccess) { fprintf(stderr, "kernel_launch: hipFuncSetAttribute failed\n"); grid = -1; return; }
        if (hipOccupancyMaxActiveBlocksPerMultiprocessor(&per_cu, (const void*)mk_fwd, NWAVES * 64, LDS_BYTES) != hipSuccess || per_cu < 1) { fprintf(stderr, "kernel_launch: occupancy query failed (%d)\n", per_cu); per_cu = 1; }
        (void)hipGetLastError();
        grid = cus * (per_cu < 1 ? 1 : 1);
    }
    if (grid < 0) return;
    (void)hipMemsetAsync((char*)d_ws + WS_CTL, 0, CTL_ZERO_BYTES, stream);
    Args a{};
    for (int i = 0; i < 17; ++i) a.in[i] = d_in[i];
    a.out = (float*)d_out; a.ws = (unsigned char*)d_ws;
#if MK_ONE_LAUNCH
    a.ph_lo = 0; a.ph_hi = NPH;
    void* kargs[] = {&a};
    hipError_t e = hipLaunchCooperativeKernel((const void*)mk_fwd, dim3(grid), dim3(NWAVES * 64), kargs, LDS_BYTES, stream);
    if (e != hipSuccess) fprintf(stderr, "kernel_launch: cooperative launch failed: %s (grid %d)\n", hipGetErrorString(e), grid);
#else
    for (int p = 0; p < NPH; ++p) { a.ph_lo = p; a.ph_hi = p + 1; hipLaunchKernelGGL(mk_fwd, dim3(grid), dim3(NWAVES * 64), LDS_BYTES, stream, a); }
    const hipError_t le = hipPeekAtLastError();
    if (le != hipSuccess) fprintf(stderr, "kernel_launch: launch failed: %s\n", hipGetErrorName(le));
#endif
}
```

```cpp
#include <hip/hip_runtime.h>
#include <hip/hip_cooperative_groups.h>
#include <cstdio>
#include <cstdint>
namespace cg = cooperative_groups;
namespace pg8 {
#define PG8_LAS __attribute__((address_space(3)))
typedef unsigned short bf16_t;
typedef short bf16x8 __attribute__((ext_vector_type(8)));
typedef float f32x4 __attribute__((ext_vector_type(4)));
typedef unsigned u32x4 __attribute__((ext_vector_type(4)));
constexpr int BM = 256, BK = 64, HALF = 128, HTB = HALF * BK * 2  , STAGE_BYTES = 8 * HTB, NXCD = 8, WGM = 8;

__host__ __device__ __forceinline__ int lds_byte(int r, int c) { const int st = (r >> 4) * 2 + (c >> 5), rr = r & 15, cc = c & 31, ob = rr * 64 + cc * 2; return st * 1024 + (ob ^ (((ob >> 9) & 1) << 5)); }
__host__ __device__ __forceinline__ void stage_rc(int b, int& R, int& C) { const int st = b / 1024, sb = b % 1024, swz = sb ^ (((sb >> 9) & 1) << 5); R = (st >> 1) * 16 + swz / 64; C = (st & 1) * 32 + (swz % 64) / 2; }
__host__ __device__ __forceinline__ int perm32(int rho) { const int n = rho >> 4, i = rho & 15; return 8 * (i >> 2) + 4 * n + (i & 3); }

struct Unit { int pm, pn; };
struct Gemm { const bf16_t* A; const bf16_t* Bt; int M, N, K; };

struct StaticOrder {
    int nM, nN, nwg, G, c;
    __host__ __device__ void init(int M, int N, int G_, int c_) { nM = M / BM; nN = N / BM; nwg = nM * nN; G = G_; c = c_; }
    __host__ __device__ bool next(int i, Unit& u) const {
        const long L = (long)i * G + c; if (L >= nwg) return false;
        int wgid = (int)L; { const int q = nwg / NXCD, r = nwg % NXCD, xcd = wgid % NXCD, off = wgid / NXCD; wgid = (xcd < r ? xcd * (q + 1) : r * (q + 1) + (xcd - r) * q) + off; }
        const int nig = WGM * nN, gid = wgid / nig, fm = gid * WGM, gsz = (nM - fm) < WGM ? (nM - fm) : WGM;
        u.pm = fm + ((wgid % nig) % gsz); u.pn = (wgid % nig) / gsz; return true;
    }
    __device__ __forceinline__ void a_ready(const Unit&) const {}
    __device__ __forceinline__ void done(const Unit&) const {}
};

__device__ __forceinline__ unsigned cvt_pk_bf16(float lo, float hi) { unsigned r; asm volatile("v_cvt_pk_bf16_f32 %0, %1, %2" : "=v"(r) : "v"(lo), "v"(hi)); return r; }
typedef float f32x2 __attribute__((ext_vector_type(2)));
template <class Epi, class Sched, bool ALIGN_EPI = false, bool SP2 = false, bool FP8 = false>
__device__ __forceinline__ void gemm_phase(PG8_LAS unsigned char* lds, const Gemm g, const Sched& S, const Epi& E) {
    int tid_ = threadIdx.x; asm volatile("" : "+v"(tid_));
    const int tid = tid_, wid = __builtin_amdgcn_readfirstlane(tid >> 6), lane = tid & 63, wr = wid >> 2, wc = wid & 3, fr = lane & 15, fq = lane >> 4;
    const int K = g.K, nt = K / BK;
    unsigned voffA[2], voffB[2];
#pragma unroll
    for (int i = 0; i < 2; ++i) { int R, C; stage_rc(tid * 16 + i * 8192, R, C); const int Rb = Epi::PERM ? ((R & ~31) + perm32(R & 31)) : R;
        voffA[i] = (unsigned)(R * K + C) * 2u; voffB[i] = (unsigned)(Rb * K + C) * 2u; }
    const size_t kstep = (size_t)(BK * 2);
    const size_t hstep = (size_t)HALF * K * 2;
    const size_t tstep = 2 * hstep;
    const unsigned ldsw = (unsigned)wid * 1024u;
    const int aoff = lds_byte(wr * 64 + fr, fq * 8), boff = lds_byte(wc * 32 + fr, fq * 8);
#define PG8_SA(b, h) (((b) * 2 + (h)) * HTB)
#define PG8_SB(b, h) ((4 + (b) * 2 + (h)) * HTB)
#define PG8_STAGE(bufoff, gbase, voff) do { _Pragma("unroll") for (int _i = 0; _i < 2; ++_i) \
        __builtin_amdgcn_global_load_lds((const unsigned*)((const char*)(gbase) + (voff)[_i]), (PG8_LAS unsigned*)(lds + (bufoff) + ldsw + _i * 8192), 16, 0, 0); } while (0)
#define PG8_LD8(p) __builtin_shufflevector(*(const PG8_LAS i32x4_*)(p), *(const PG8_LAS i32x4_*)((p) + 1024), 0, 1, 2, 3, 4, 5, 6, 7)
#define PG8_LDA(dst, b, h) do { if constexpr (FP8) { _Pragma("unroll") for (int m = 0; m < 4; ++m) dst##8[m] = PG8_LD8(lds + PG8_SA(b, h) + aoff + m * 2048); } \
        else { _Pragma("unroll") for (int m = 0; m < 4; ++m) _Pragma("unroll") for (int k = 0; k < 2; ++k) dst[m][k] = *(const PG8_LAS bf16x8*)(lds + PG8_SA(b, h) + aoff + m * 2048 + k * 1024); } } while (0)
#define PG8_LDB(dst, b, h) do { if constexpr (FP8) { _Pragma("unroll") for (int n = 0; n < 2; ++n) dst##8[n] = PG8_LD8(lds + PG8_SB(b, h) + boff + n * 2048); } \
        else { _Pragma("unroll") for (int n = 0; n < 2; ++n) _Pragma("unroll") for (int k = 0; k < 2; ++k) dst[n][k] = *(const PG8_LAS bf16x8*)(lds + PG8_SB(b, h) + boff + n * 2048 + k * 1024); } } while (0)
#define PG8_MMA(ai, bj, At, Bt) do { __builtin_amdgcn_s_setprio(1); _Pragma("unroll") for (int m = 0; m < 4; ++m) _Pragma("unroll") for (int n = 0; n < 2; ++n) { \
        if constexpr (FP8) asm volatile("v_mfma_scale_f32_16x16x128_f8f6f4 %0, %1, %2, %0, %3, %3 op_sel_hi:[0,0,0]" : "+v"(acc[ai][bj][m][n]) : "v"(Bt##8[n]), "v"(At##8[m]), "v"(sc1_)); \
        else { _Pragma("unroll") for (int k = 0; k < 2; ++k) acc[ai][bj][m][n] = __builtin_amdgcn_mfma_f32_16x16x32_bf16(Bt[n][k], At[m][k], acc[ai][bj][m][n], 0, 0, 0); } } \
        __builtin_amdgcn_s_setprio(0); } while (0)
#define PG8_WAIT_V(n) asm volatile("s_waitcnt vmcnt(" #n ")" ::: "memory")
#define PG8_WAIT_L(n) asm volatile("s_waitcnt lgkmcnt(" #n ")" ::: "memory")
#define PG8_BAR __builtin_amdgcn_s_barrier()
#define PG8_SCHED __builtin_amdgcn_sched_barrier(0)
    Unit cur, nxt; int ui = 0;
    if (!S.next(0, cur)) return;
    f32x4 acc[2][2][4][2];
#pragma unroll
    for (int a = 0; a < 2; ++a)
#pragma unroll
        for (int b = 0; b < 2; ++b)
#pragma unroll
            for (int m = 0; m < 4; ++m)
#pragma unroll
                for (int n = 0; n < 2; ++n) acc[a][b][m][n] = (f32x4){0.f, 0.f, 0.f, 0.f};
    typedef int i32x4_ __attribute__((ext_vector_type(4))); typedef int i32x8_ __attribute__((ext_vector_type(8)));
    int sc1_ = 0x7F7F7F7F; asm volatile("" : "+v"(sc1_));
    bf16x8 At[4][2], B0[2][2], B1[2][2]; i32x8_ At8[4], B08[2], B18[2];
    const char* cA = (const char*)g.A + (size_t)cur.pm * tstep; const char* cB = (const char*)g.Bt + (size_t)cur.pn * tstep;
    S.a_ready(cur);
    if constexpr (SP2) {
        PG8_STAGE(PG8_SB(0, 0), cB, voffB); PG8_STAGE(PG8_SB(0, 1), cB + hstep, voffB); PG8_STAGE(PG8_SA(0, 0), cA, voffA); PG8_STAGE(PG8_SA(0, 1), cA + hstep, voffA);
        if (wr == 1) PG8_BAR;
        PG8_WAIT_V(2); PG8_BAR;
        PG8_STAGE(PG8_SB(1, 0), cB + kstep, voffB); PG8_STAGE(PG8_SA(1, 0), cA + kstep, voffA); PG8_STAGE(PG8_SB(1, 1), cB + hstep + kstep, voffB);
        PG8_WAIT_V(6); PG8_BAR;
    } else {
        PG8_STAGE(PG8_SB(0, 0), cB, voffB); PG8_STAGE(PG8_SA(0, 0), cA, voffA); PG8_STAGE(PG8_SB(0, 1), cB + hstep, voffB); PG8_STAGE(PG8_SA(0, 1), cA + hstep, voffA);
        if (wr == 1) PG8_BAR;
        PG8_WAIT_V(4); PG8_BAR;
        PG8_STAGE(PG8_SB(1, 0), cB + kstep, voffB); PG8_STAGE(PG8_SA(1, 0), cA + kstep, voffA); PG8_STAGE(PG8_SB(1, 1), cB + hstep + kstep, voffB);
        PG8_WAIT_V(6); PG8_BAR;
    }
    for (;;) {
        const bool has_next = S.next(ui + 1, nxt);
        const char* nA = has_next ? (const char*)g.A + (size_t)nxt.pm * tstep : cA; const char* nB = has_next ? (const char*)g.Bt + (size_t)nxt.pn * tstep : cB;
        for (int t = 0; t < nt; t += 2) {
            const bool last = (t == nt - 2);
            const char* a1 = cA + (size_t)(t + 1) * kstep;
            const char* a2 = last ? nA : cA + (size_t)(t + 2) * kstep; const char* b2 = last ? nB : cB + (size_t)(t + 2) * kstep;
            const char* a3 = a2 + kstep; const char* b3 = b2 + kstep;
            if (last && has_next) S.a_ready(nxt);
            if constexpr (SP2) {
            PG8_LDB(B0, 0, 0); PG8_LDB(B1, 0, 1); PG8_SCHED; PG8_LDA(At, 0, 0); PG8_STAGE(PG8_SA(1, 1), a1 + hstep, voffA);
            PG8_WAIT_V(8); PG8_WAIT_L(0); PG8_BAR; PG8_MMA(0, 0, At, B0); PG8_MMA(0, 1, At, B1); PG8_BAR; PG8_SCHED;
            PG8_LDA(At, 0, 1); PG8_STAGE(PG8_SB(0, 0), b2, voffB); PG8_STAGE(PG8_SB(0, 1), b2 + hstep, voffB); PG8_STAGE(PG8_SA(0, 0), a2, voffA);
            PG8_WAIT_V(8); PG8_WAIT_L(0); PG8_BAR; PG8_MMA(1, 0, At, B0); PG8_MMA(1, 1, At, B1); PG8_BAR; PG8_SCHED;
            PG8_LDB(B0, 1, 0); PG8_LDB(B1, 1, 1); PG8_SCHED; PG8_LDA(At, 1, 0); PG8_STAGE(PG8_SA(0, 1), a2 + hstep, voffA);
            PG8_WAIT_V(8); PG8_WAIT_L(0); PG8_BAR; PG8_MMA(0, 0, At, B0); PG8_MMA(0, 1, At, B1); PG8_BAR; PG8_SCHED;
            PG8_LDA(At, 1, 1); PG8_STAGE(PG8_SB(1, 0), b3, voffB); PG8_STAGE(PG8_SB(1, 1), b3 + hstep, voffB); PG8_STAGE(PG8_SA(1, 0), a3, voffA);
            PG8_WAIT_V(8); PG8_WAIT_L(0); PG8_BAR; PG8_MMA(1, 0, At, B0); PG8_MMA(1, 1, At, B1); PG8_BAR; PG8_SCHED;
            } else {
            PG8_LDB(B0, 0, 0); PG8_SCHED; PG8_LDA(At, 0, 0); PG8_STAGE(PG8_SA(1, 1), a1 + hstep, voffA);
            PG8_WAIT_L(8); PG8_BAR; PG8_WAIT_L(0); PG8_MMA(0, 0, At, B0); PG8_BAR; PG8_SCHED;
            PG8_LDB(B1, 0, 1); PG8_STAGE(PG8_SB(0, 0), b2, voffB);
            PG8_BAR; PG8_WAIT_L(0); PG8_MMA(0, 1, At, B1); PG8_BAR;
            PG8_LDA(At, 0, 1); PG8_STAGE(PG8_SA(0, 0), a2, voffA);
            PG8_BAR; PG8_WAIT_L(0); PG8_MMA(1, 0, At, B0); PG8_BAR; PG8_SCHED;
            PG8_STAGE(PG8_SB(0, 1), b2 + hstep, voffB);
            PG8_WAIT_V(6); PG8_BAR; PG8_MMA(1, 1, At, B1); PG8_BAR;
            PG8_LDB(B0, 1, 0); PG8_SCHED; PG8_LDA(At, 1, 0); PG8_STAGE(PG8_SA(0, 1), a2 + hstep, voffA);
            PG8_WAIT_L(8); PG8_BAR; PG8_WAIT_L(0); PG8_MMA(0, 0, At, B0); PG8_BAR; PG8_SCHED;
            PG8_LDB(B1, 1, 1); PG8_STAGE(PG8_SB(1, 0), b3, voffB);
            PG8_BAR; PG8_WAIT_L(0); PG8_MMA(0, 1, At, B1); PG8_BAR;
            PG8_LDA(At, 1, 1); PG8_STAGE(PG8_SA(1, 0), a3, voffA);
            PG8_BAR; PG8_WAIT_L(0); PG8_MMA(1, 0, At, B0); PG8_BAR; PG8_SCHED;
            PG8_STAGE(PG8_SB(1, 1), b3 + hstep, voffB);
            PG8_WAIT_V(6); PG8_BAR; PG8_MMA(1, 1, At, B1); PG8_BAR;
            }
        }
        if constexpr (ALIGN_EPI) { if (wr == 0) PG8_BAR; }
        if constexpr (FP8) asm volatile("s_nop 15\n\ts_nop 15" ::: "memory");
        if constexpr (!Epi::AFTER_DRAIN) { E(acc, cur, wr, wc, fr, fq); S.done(cur); }
        if (!has_next) break;
#pragma unroll
        for (int a = 0; a < 2; ++a)
#pragma unroll
            for (int b = 0; b < 2; ++b)
#pragma unroll
                for (int m = 0; m < 4; ++m)
#pragma unroll
                    for (int n = 0; n < 2; ++n) acc[a][b][m][n] = (f32x4){0.f, 0.f, 0.f, 0.f};
        cur = nxt; cA = nA; cB = nB; ++ui;
        if constexpr (ALIGN_EPI) { if (wr == 1) PG8_BAR; }
    }
    PG8_WAIT_V(0);
    if constexpr (!ALIGN_EPI) { if (wr == 0) PG8_BAR; }
    PG8_BAR;
    if constexpr (Epi::AFTER_DRAIN) { E.fused(acc, cur, wr, wc, fr, fq, lds, wid, lane); S.done(cur); }
#undef PG8_SA
#undef PG8_SB
#undef PG8_STAGE
#undef PG8_LDA
#undef PG8_LD8
#undef PG8_LDB
#undef PG8_MMA
#undef PG8_WAIT_V
#undef PG8_WAIT_L
#undef PG8_BAR
#undef PG8_SCHED
}
}
namespace pg8 {
typedef unsigned u32x2 __attribute__((ext_vector_type(2)));
constexpr int LDX = 2048;
constexpr float RMS_EPS = 1e-6f;
#ifndef EPI_SC1
#define EPI_SC1 1
#endif
__device__ __forceinline__ void store16(void* p, u32x4 w) {
#if EPI_SC1
    asm volatile("global_store_dwordx4 %0, %1, off sc1\n\ts_nop 1" :: "v"(p), "v"(w) : "memory");
#else
    *(u32x4*)p = w;
#endif
}
struct EpiQKV {
    static constexpr bool PERM = true, AFTER_DRAIN = false;
    bf16_t* O; const float* cs; float qscale; float* ksum; int vmode; float vscale;
    __device__ __forceinline__ void operator()(const f32x4 (&acc)[2][2][4][2], const Unit& u, int wr, int wc, int fr, int fq) const {
        const int row0 = u.pm * BM + wr * 64 + fr, pn = vmode ? (u.pn < 4 ? u.pn + 8 : u.pn + 16) : (u.pn < 8 ? u.pn : u.pn + 4);
        const float sc = (pn < 4 || (pn >= 12 && pn < 16)) ? qscale : vscale;
        const bool rot = (pn >= 12 && pn < 20) && (wc == 0);
        bf16_t* Ot = O + ((size_t)((u.pm >> 3) * 6 + (pn >> 2)) * 8 + (pn & 3) * 2) * (2048 * 128) + wc * 32 + 8 * fq;
        const bool kacc = (pn >= 16 && pn < 20);
        f32x4 ks[2][2] = {{{0.f, 0.f, 0.f, 0.f}, {0.f, 0.f, 0.f, 0.f}}, {{0.f, 0.f, 0.f, 0.f}, {0.f, 0.f, 0.f, 0.f}}};
#pragma unroll
        for (int ai = 0; ai < 2; ++ai)
#pragma unroll
            for (int m = 0; m < 4; ++m) { const int row = row0 + ai * HALF + m * 16; bf16_t* rowp = Ot + (size_t)(row & 2047) * 128;
                f32x4 c0 = {1.f, 1.f, 1.f, 1.f}, c1 = c0, s0 = {0.f, 0.f, 0.f, 0.f}, s1 = s0;
                if (rot) { const float* cr = cs + (size_t)row * 32 + 8 * (fq & 1); c0 = *(const f32x4*)cr; c1 = *(const f32x4*)(cr + 4); s0 = *(const f32x4*)(cr + 16); s1 = *(const f32x4*)(cr + 20);
                    if (fq < 2) { s0 = -s0; s1 = -s1; } }
#pragma unroll
                for (int bj = 0; bj < 2; ++bj) { f32x4 v0 = acc[ai][bj][m][0], v1 = acc[ai][bj][m][1];
                    if (rot) { f32x4 p0, p1;
#pragma unroll
                        for (int j = 0; j < 4; ++j) { p0[j] = __shfl_xor(v0[j], 32); p1[j] = __shfl_xor(v1[j], 32); }
                        v0 = v0 * c0 + p0 * s0; v1 = v1 * c1 + p1 * s1; }
                    if (kacc) { ks[bj][0] += v0; ks[bj][1] += v1; }
                    v0 = v0 * sc; v1 = v1 * sc; u32x4 w; w.x = cvt_pk_bf16(v0[0], v0[1]); w.y = cvt_pk_bf16(v0[2], v0[3]); w.z = cvt_pk_bf16(v1[0], v1[1]); w.w = cvt_pk_bf16(v1[2], v1[3]);
                    store16(rowp + (size_t)bj * (2048 * 128), w); } }
        if (kacc) {
            float* kp = ksum + (size_t)(((u.pm >> 3) * 8 + (pn - 16) * 2) * 8 + (u.pm & 7)) * 128 + wc * 32 + 8 * fq;
#pragma unroll
            for (int bj = 0; bj < 2; ++bj)
#pragma unroll
                for (int n = 0; n < 2; ++n)
#pragma unroll
                    for (int j = 0; j < 4; ++j) { float s = ks[bj][n][j]; s += __shfl_xor(s, 1); s += __shfl_xor(s, 2); s += __shfl_xor(s, 4); s += __shfl_xor(s, 8);
                        if (fr == 0) atomicAdd(kp + bj * 1024 + n * 4 + j, s); }
        }
    }
};
__device__ __forceinline__ unsigned pk4_fp8(float a, float b, float c, float d) {
    a = __builtin_amdgcn_fmed3f(a, -448.f, 448.f); b = __builtin_amdgcn_fmed3f(b, -448.f, 448.f); c = __builtin_amdgcn_fmed3f(c, -448.f, 448.f); d = __builtin_amdgcn_fmed3f(d, -448.f, 448.f);
    int p = __builtin_amdgcn_cvt_pk_fp8_f32(a, b, 0, false); p = __builtin_amdgcn_cvt_pk_fp8_f32(c, d, p, true); return (unsigned)p; }
struct EpiRes {
    static constexpr bool PERM = false, AFTER_DRAIN = false;
    const float* base; float* out; bf16_t* xb; float* ssq; unsigned char* x8; float s8; float ascale;
    __device__ __forceinline__ void operator()(const f32x4 (&acc)[2][2][4][2], const Unit& u, int wr, int wc, int fr, int fq) const {
        const int row0 = u.pm * BM + wr * 64 + fr, col0 = u.pn * BM + wc * 32 + 4 * fq;
#pragma unroll
        for (int ai = 0; ai < 2; ++ai)
#pragma unroll
            for (int m = 0; m < 4; ++m) { const int row = row0 + ai * HALF + m * 16; const size_t off = (size_t)row * LDX + col0; float s = 0.f;
#pragma unroll
                for (int bj = 0; bj < 2; ++bj)
#pragma unroll
                    for (int n = 0; n < 2; ++n) { const f32x4 v = *(const f32x4*)(base + off + bj * HALF + n * 16) + acc[ai][bj][m][n] * ascale;
                        *(f32x4*)(out + off + bj * HALF + n * 16) = v; s += (v[0] * v[0] + v[1] * v[1]) + (v[2] * v[2] + v[3] * v[3]);
                        if (xb) { u32x2 w; w.x = cvt_pk_bf16(v[0], v[1]); w.y = cvt_pk_bf16(v[2], v[3]); *(u32x2*)(xb + off + bj * HALF + n * 16) = w; }
                        if (x8) { *(unsigned*)(x8 + off + bj * HALF + n * 16) = pk4_fp8(v[0] * s8, v[1] * s8, v[2] * s8, v[3] * s8); } }
                if (ssq) { s += __shfl_xor(s, 16); s += __shfl_xor(s, 32); if (fq == 0) atomicAdd(ssq + row, s); }
                asm volatile("" ::: "memory"); }
    }
};
template <bool BASE_F32> struct EpiResB {
    static constexpr bool PERM = true, AFTER_DRAIN = false;
    const void* base; bf16_t* xo; float* ssq; unsigned char* x8; float s8; float ascale;
    __device__ __forceinline__ void operator()(const f32x4 (&acc)[2][2][4][2], const Unit& u, int wr, int wc, int fr, int fq) const {
        const int row0 = u.pm * BM + wr * 64 + fr, col0 = u.pn * BM + wc * 32 + 8 * fq;
#pragma unroll
        for (int ai = 0; ai < 2; ++ai)
#pragma unroll
            for (int m = 0; m < 4; ++m) { const int row = row0 + ai * HALF + m * 16; const size_t off = (size_t)row * LDX + col0; float s = 0.f;
#pragma unroll
                for (int bj = 0; bj < 2; ++bj) { f32x4 b0, b1;
                    if (BASE_F32) { const float* bp = (const float*)base + off + bj * HALF; b0 = *(const f32x4*)bp; b1 = *(const f32x4*)(bp + 4); }
                    else { const u32x4 w = *(const u32x4*)((const bf16_t*)base + off + bj * HALF);
                        b0 = (f32x4){__uint_as_float(w.x << 16), __uint_as_float(w.x & 0xffff0000u), __uint_as_float(w.y << 16), __uint_as_float(w.y & 0xffff0000u)};
                        b1 = (f32x4){__uint_as_float(w.z << 16), __uint_as_float(w.z & 0xffff0000u), __uint_as_float(w.w << 16), __uint_as_float(w.w & 0xffff0000u)}; }
                    const f32x4 v0 = b0 + acc[ai][bj][m][0] * ascale, v1 = b1 + acc[ai][bj][m][1] * ascale;
                    s += ((v0[0] * v0[0] + v0[1] * v0[1]) + (v0[2] * v0[2] + v0[3] * v0[3])) + ((v1[0] * v1[0] + v1[1] * v1[1]) + (v1[2] * v1[2] + v1[3] * v1[3]));
                    if (xo) { u32x4 w; w.x = cvt_pk_bf16(v0[0], v0[1]); w.y = cvt_pk_bf16(v0[2], v0[3]); w.z = cvt_pk_bf16(v1[0], v1[1]); w.w = cvt_pk_bf16(v1[2], v1[3]); *(u32x4*)(xo + off + bj * HALF) = w; }
                    if (x8) { u32x2 w8; w8.x = pk4_fp8(v0[0] * s8, v0[1] * s8, v0[2] * s8, v0[3] * s8); w8.y = pk4_fp8(v1[0] * s8, v1[1] * s8, v1[2] * s8, v1[3] * s8); *(u32x2*)(x8 + off + bj * HALF) = w8; } }
                if (ssq) { s += __shfl_xor(s, 16); s += __shfl_xor(s, 32); if (fq == 0) atomicAdd(ssq + row, s); }
                if (BASE_F32 ? (m & 1) : (m == 3)) asm volatile("" ::: "memory"); }
    }
};
struct EpiScale {
    static constexpr bool PERM = true, AFTER_DRAIN = false;
    bf16_t* O; int ldc; const float* ssq; float sc;
    __device__ __forceinline__ void operator()(const f32x4 (&acc)[2][2][4][2], const Unit& u, int wr, int wc, int fr, int fq) const {
        const int row0 = u.pm * BM + wr * 64 + fr, col0 = u.pn * BM + wc * 32 + 8 * fq;
        float sv[2][4];
#pragma unroll
        for (int ai = 0; ai < 2; ++ai)
#pragma unroll
            for (int m = 0; m < 4; ++m) sv[ai][m] = ssq ? ssq[row0 + ai * HALF + m * 16] : 0.f;
#pragma unroll
        for (int ai = 0; ai < 2; ++ai)
#pragma unroll
            for (int m = 0; m < 4; ++m) { const int row = row0 + ai * HALF + m * 16; bf16_t* rowp = O + (size_t)row * ldc + col0;
                const float f = ssq ? sc * __builtin_amdgcn_rsqf(sv[ai][m] * (1.0f / 2048.0f) + RMS_EPS) : sc;
#pragma unroll
                for (int bj = 0; bj < 2; ++bj) { const f32x4 v0 = acc[ai][bj][m][0] * f, v1 = acc[ai][bj][m][1] * f;
                    u32x4 w; w.x = cvt_pk_bf16(v0[0], v0[1]); w.y = cvt_pk_bf16(v0[2], v0[3]); w.z = cvt_pk_bf16(v1[0], v1[1]); w.w = cvt_pk_bf16(v1[2], v1[3]);
                    *(u32x4*)(rowp + bj * HALF) = w; } }
    }
};
struct EpiNull { static constexpr bool PERM = true, AFTER_DRAIN = false; float* sink;
    __device__ __forceinline__ void operator()(const f32x4 (&acc)[2][2][4][2], const Unit& u, int wr, int wc, int fr, int fq) const {
#pragma unroll
        for (int ai = 0; ai < 2; ++ai)
#pragma unroll
            for (int bj = 0; bj < 2; ++bj)
#pragma unroll
                for (int m = 0; m < 4; ++m)
#pragma unroll
                    for (int n = 0; n < 2; ++n) asm volatile("" :: "v"(acc[ai][bj][m][n])); } };
struct EpiSwiGLU {
    static constexpr bool PERM = true, AFTER_DRAIN = false;
    bf16_t* O; const float* ssq; unsigned char* O8; float ascale, oscale;
    __device__ __forceinline__ void operator()(const f32x4 (&acc)[2][2][4][2], const Unit& u, int wr, int wc, int fr, int fq) const {
        const int row0 = u.pm * BM + wr * 64 + fr, col0 = u.pn * HALF + wc * 32 + 8 * fq;
        float sv[2][4];
#pragma unroll
        for (int ai = 0; ai < 2; ++ai)
#pragma unroll
            for (int m = 0; m < 4; ++m) sv[ai][m] = ssq[row0 + ai * HALF + m * 16];
#pragma unroll
        for (int ai = 0; ai < 2; ++ai)
#pragma unroll
            for (int m = 0; m < 4; ++m) { const int row = row0 + ai * HALF + m * 16; bf16_t* rowp = O + (size_t)row * 5632 + col0;
                const float f = ascale * __builtin_amdgcn_rsqf(sv[ai][m] * (1.0f / 2048.0f) + RMS_EPS);
                float r[8];
#pragma unroll
                for (int n = 0; n < 2; ++n)
#pragma unroll
                    for (int j = 0; j < 4; ++j) { const float g = acc[ai][0][m][n][j] * f, uu = acc[ai][1][m][n][j] * f;
                        const float sg = g * __builtin_amdgcn_rcpf(1.0f + __builtin_amdgcn_exp2f(-1.4426950408889634f * g)); r[n * 4 + j] = sg * uu; }
                if (O8) { u32x2 w8; w8.x = pk4_fp8(r[0] * oscale, r[1] * oscale, r[2] * oscale, r[3] * oscale); w8.y = pk4_fp8(r[4] * oscale, r[5] * oscale, r[6] * oscale, r[7] * oscale);
                    *(u32x2*)(O8 + (size_t)row * 5632 + col0) = w8; }
                else { u32x4 w; w.x = cvt_pk_bf16(r[0], r[1]); w.y = cvt_pk_bf16(r[2], r[3]); w.z = cvt_pk_bf16(r[4], r[5]); w.w = cvt_pk_bf16(r[6], r[7]);
                *(u32x4*)rowp = w; } }
    }
};
}
namespace att {
using bf16x8 = __attribute__((ext_vector_type(8))) short;
using s16x4  = __attribute__((ext_vector_type(4))) short;
using f32x16 = __attribute__((ext_vector_type(16))) float;
using f32x4  = __attribute__((ext_vector_type(4))) float;
using u32x4  = __attribute__((ext_vector_type(4))) unsigned;
typedef unsigned short bf16;
constexpr int D = 128, KVBLK = 64;
constexpr int SHM_V = KVBLK * D * 2, SHM_K = KVBLK * D * 2;
constexpr int OFF_Q = 2 * SHM_V + 2 * SHM_K, OFF_WS = 131072 + 1024, OFF_KM = OFF_WS + 2048, ATT_LDS = OFF_KM + 4096;
constexpr float THR = 8.f;
#ifndef QREG_SOFTMAX
#define QREG_SOFTMAX 1
#endif
#ifndef PIPE_SOFTMAX
#define PIPE_SOFTMAX 0
#endif
#define KSWZ(row, colB) ((row) * 256 + ((colB) ^ (((row) & 7) << 4)))
#define SBAR() __builtin_amdgcn_sched_barrier(0)
__device__ __forceinline__ int crow(int r, int hi) { return (r & 3) + 8 * (r >> 2) + 4 * hi; }
__device__ __forceinline__ unsigned cvtpk(float lo, float hi) { unsigned r; asm volatile("v_cvt_pk_bf16_f32 %0, %1, %2" : "=v"(r) : "v"(lo), "v"(hi)); return r; }
__device__ __forceinline__ float xchg32(float x, int hi) { auto rr = __builtin_amdgcn_permlane32_swap(__float_as_uint(x), __float_as_uint(x), false, false); return __uint_as_float(hi ? rr[0] : rr[1]); }
typedef __attribute__((address_space(3))) const char* lds_cp;
template <int D0> __device__ __forceinline__ void qkt_part(f32x16& p0, f32x16& p1, const lds_cp (&ka)[2][4], int boff, const lds_cp (&qa)[2][4]) {
  const bf16x8 qf = *reinterpret_cast<const __attribute__((address_space(3))) bf16x8*>(qa[D0 >> 2][D0 & 3]);
  const bf16x8 b0 = *reinterpret_cast<const __attribute__((address_space(3))) bf16x8*>(ka[D0 >> 2][D0 & 3] + boff);
  const bf16x8 b1 = *reinterpret_cast<const __attribute__((address_space(3))) bf16x8*>(ka[D0 >> 2][D0 & 3] + boff + 8192);
  p0 = __builtin_amdgcn_mfma_f32_32x32x16_bf16(b0, qf, p0, 0, 0, 0);
  p1 = __builtin_amdgcn_mfma_f32_32x32x16_bf16(b1, qf, p1, 0, 0, 0);
}
template <int D0> __device__ __forceinline__ void qkt_part(f32x16& p0, f32x16& p1, const lds_cp (&ka)[2][4], int boff, const bf16x8 (&qg)[8]) {
  const bf16x8 b0 = *reinterpret_cast<const __attribute__((address_space(3))) bf16x8*>(ka[D0 >> 2][D0 & 3] + boff);
  const bf16x8 b1 = *reinterpret_cast<const __attribute__((address_space(3))) bf16x8*>(ka[D0 >> 2][D0 & 3] + boff + 8192);
  p0 = __builtin_amdgcn_mfma_f32_32x32x16_bf16(b0, qg[D0], p0, 0, 0, 0);
  p1 = __builtin_amdgcn_mfma_f32_32x32x16_bf16(b1, qg[D0], p1, 0, 0, 0);
}
__device__ __forceinline__ void qkt(f32x16& p0, f32x16& p1, const lds_cp (&ka)[2][4], int boff, const bf16x8 (&qg)[8], float bias = 0.f) {
#pragma unroll
  for (int r = 0; r < 16; ++r) { p0[r] = bias; p1[r] = bias; }
  qkt_part<0>(p0, p1, ka, boff, qg); qkt_part<1>(p0, p1, ka, boff, qg); qkt_part<2>(p0, p1, ka, boff, qg); qkt_part<3>(p0, p1, ka, boff, qg);
  qkt_part<4>(p0, p1, ka, boff, qg); qkt_part<5>(p0, p1, ka, boff, qg); qkt_part<6>(p0, p1, ka, boff, qg); qkt_part<7>(p0, p1, ka, boff, qg);
}
__device__ __forceinline__ void qkt(f32x16& p0, f32x16& p1, const lds_cp (&ka)[2][4], int boff, const lds_cp (&qr)[2][4], float bias = 0.f) {
#pragma unroll
  for (int r = 0; r < 16; ++r) { p0[r] = bias; p1[r] = bias; }
  qkt_part<0>(p0, p1, ka, boff, qr); qkt_part<1>(p0, p1, ka, boff, qr); qkt_part<2>(p0, p1, ka, boff, qr); qkt_part<3>(p0, p1, ka, boff, qr);
  qkt_part<4>(p0, p1, ka, boff, qr); qkt_part<5>(p0, p1, ka, boff, qr); qkt_part<6>(p0, p1, ka, boff, qr); qkt_part<7>(p0, p1, ka, boff, qr);
}
__device__ __forceinline__ int v_st(int k, int c) { const int kk = (k & ~0xC) | ((k & 4) << 1) | ((k & 8) >> 1); return ((kk >> 3) * 4 + (c >> 5)) * 512 + ((kk & 7) * 32 + (c & 31)) * 2; }
__device__ __forceinline__ int v_rd_base(int lane) { return ((lane & 3) << 3) | (((lane >> 2) & 3) << 6) | (((lane >> 4) & 1) << 5) | (((lane >> 5) & 1) << 8); }
constexpr int v_rd_off(int d0, int ks, int half) { return d0 * 512 + ks * 4096 + half * 2048; }
template <int OFF> __device__ __forceinline__ s16x4 tr_read(int vb) { s16x4 r; asm volatile("ds_read_b64_tr_b16 %0, %1 offset:%2" : "=&v"(r) : "v"(vb), "i"(OFF) : "memory"); return r; }
struct VFrag { s16x4 l0, h0, l1, h1, l2, h2, l3, h3; };
template <int D0> __device__ __forceinline__ void v_read(VFrag& f, int vb) {
  f.l0 = tr_read<v_rd_off(D0, 0, 0)>(vb); f.h0 = tr_read<v_rd_off(D0, 0, 1)>(vb); f.l1 = tr_read<v_rd_off(D0, 1, 0)>(vb); f.h1 = tr_read<v_rd_off(D0, 1, 1)>(vb);
  f.l2 = tr_read<v_rd_off(D0, 2, 0)>(vb); f.h2 = tr_read<v_rd_off(D0, 2, 1)>(vb); f.l3 = tr_read<v_rd_off(D0, 3, 0)>(vb); f.h3 = tr_read<v_rd_off(D0, 3, 1)>(vb);
}
__device__ __forceinline__ void pv_mma(f32x16& od, const VFrag& f, bf16x8 pa0, bf16x8 pa1, bf16x8 pa2, bf16x8 pa3) {
#define PK(L, H) (bf16x8){L[0], L[1], L[2], L[3], H[0], H[1], H[2], H[3]}
  od = __builtin_amdgcn_mfma_f32_32x32x16_bf16(pa0, PK(f.l0, f.h0), od, 0, 0, 0);
  od = __builtin_amdgcn_mfma_f32_32x32x16_bf16(pa1, PK(f.l1, f.h1), od, 0, 0, 0);
  od = __builtin_amdgcn_mfma_f32_32x32x16_bf16(pa2, PK(f.l2, f.h2), od, 0, 0, 0);
  od = __builtin_amdgcn_mfma_f32_32x32x16_bf16(pa3, PK(f.l3, f.h3), od, 0, 0, 0);
#undef PK
}
__device__ __forceinline__ void pv_d0(f32x16* o, int vb, bf16x8 pa0, bf16x8 pa1, bf16x8 pa2, bf16x8 pa3) {
  VFrag fa, fb;
  v_read<0>(fa, vb);
  v_read<1>(fb, vb); asm volatile("s_waitcnt lgkmcnt(8)" ::: "memory"); SBAR(); pv_mma(o[0], fa, pa0, pa1, pa2, pa3); SBAR();
  v_read<2>(fa, vb); asm volatile("s_waitcnt lgkmcnt(8)" ::: "memory"); SBAR(); pv_mma(o[1], fb, pa0, pa1, pa2, pa3); SBAR();
  v_read<3>(fb, vb); asm volatile("s_waitcnt lgkmcnt(8)" ::: "memory"); SBAR(); pv_mma(o[2], fa, pa0, pa1, pa2, pa3); SBAR();
  asm volatile("s_waitcnt lgkmcnt(0)" ::: "memory"); SBAR(); pv_mma(o[3], fb, pa0, pa1, pa2, pa3);
}
__device__ __forceinline__ void pack_p(const f32x16& p0, const f32x16& p1, bf16x8& pa0, bf16x8& pa1, bf16x8& pa2, bf16x8& pa3) {
#define PK4(P, BASE, OUT) do { unsigned a0 = cvtpk(P[BASE + 0], P[BASE + 1]), a1 = cvtpk(P[BASE + 2], P[BASE + 3]);   \
    unsigned b0 = cvtpk(P[BASE + 4], P[BASE + 5]), b1 = cvtpk(P[BASE + 6], P[BASE + 7]);                              \
    auto r0 = __builtin_amdgcn_permlane32_swap(a0, b0, false, false); auto r1 = __builtin_amdgcn_permlane32_swap(a1, b1, false, false); \
    u32x4 w = {r0[0], r1[0], r0[1], r1[1]}; OUT = *reinterpret_cast<bf16x8*>(&w); } while (0)
  PK4(p0, 0, pa0); PK4(p0, 8, pa1); PK4(p1, 0, pa2); PK4(p1, 8, pa3);
#undef PK4
}
__device__ __forceinline__ void softmax_tile(f32x16& p0, f32x16& p1, float& m_reg, float& l_reg, float& alpha) {
  float pmax = p0[0];
#pragma unroll
  for (int r = 1; r < 16; ++r) pmax = fmaxf(pmax, p0[r]);
#pragma unroll
  for (int r = 0; r < 16; ++r) pmax = fmaxf(pmax, p1[r]);
  pmax = fmaxf(pmax, xchg32(pmax, (int)(threadIdx.x >> 5) & 1));
  if (__all(pmax - m_reg <= THR)) { alpha = 1.f; }
  else { const float mn = fmaxf(m_reg, pmax); alpha = __builtin_amdgcn_exp2f(m_reg - mn); m_reg = mn; }
  float ps = 0.f;
#pragma unroll
  for (int r = 0; r < 16; ++r) { p0[r] = __builtin_amdgcn_exp2f(p0[r] - m_reg); ps += p0[r]; }
#pragma unroll
  for (int r = 0; r < 16; ++r) { p1[r] = __builtin_amdgcn_exp2f(p1[r] - m_reg); ps += p1[r]; }
  ps += xchg32(ps, (int)(threadIdx.x >> 5) & 1);
  l_reg = l_reg * alpha + ps;
}
template <bool BAND, int I> __device__ __forceinline__ float sb_group(f32x16& P, int kb, int qrel, int hi) {
  float run = 1.f;
#pragma unroll
  for (int e = 3; e >= 0; --e) { const int r = 4 * I + e; float rr = __builtin_amdgcn_rcpf(1.0f + __builtin_amdgcn_exp2f(P[r]));
    if (BAND) rr = (kb + crow(r, hi) < qrel) ? rr : 1.f;
    P[r] = (1.0f - rr) * run; run *= rr; }
  return run;
}
__device__ __forceinline__ void sb_combine(f32x16& p0, f32x16& p1, float (&gs)[8], float& carry, int hi) {
  float acc = 1.f;
#pragma unroll
  for (int i = 7; i >= 0; --i) { const float so_i = acc; acc *= gs[i]; const float x = hi ? acc : so_i; gs[i] = carry * so_i * xchg32(x, hi); }
  carry *= acc * xchg32(acc, hi);
#pragma unroll
  for (int i = 0; i < 4; ++i)
#pragma unroll
    for (int e = 0; e < 4; ++e) { p0[4 * i + e] *= gs[i]; p1[4 * i + e] *= gs[4 + i]; }
}
template <bool BAND>
__device__ __forceinline__ void sb_tile(f32x16& p0, f32x16& p1, float& carry, int kb, int qrel, int hi) {
  float gs[8];
  gs[0] = sb_group<BAND, 0>(p0, kb, qrel, hi); SBAR(); gs[1] = sb_group<BAND, 1>(p0, kb, qrel, hi); SBAR(); gs[2] = sb_group<BAND, 2>(p0, kb, qrel, hi); SBAR(); gs[3] = sb_group<BAND, 3>(p0, kb, qrel, hi); SBAR();
  gs[4] = sb_group<BAND, 0>(p1, kb + 32, qrel, hi); SBAR(); gs[5] = sb_group<BAND, 1>(p1, kb + 32, qrel, hi); SBAR(); gs[6] = sb_group<BAND, 2>(p1, kb + 32, qrel, hi); SBAR(); gs[7] = sb_group<BAND, 3>(p1, kb + 32, qrel, hi); SBAR();
  sb_combine(p0, p1, gs, carry, hi);
}

template <int MODE>
__device__ __forceinline__ void attn_unit(const bf16* __restrict__ Qb, int ldq, const bf16* __restrict__ Kh, const bf16* __restrict__ Vh, int ldk, bf16* __restrict__ Ob, int ldo,
                                          const float* __restrict__ gain, const float* __restrict__ kmean, int qb, int nkeys, char* lds) {
  int tid_ = threadIdx.x; asm volatile("" : "+v"(tid_));
  const int tid = tid_, wid = __builtin_amdgcn_readfirstlane(tid >> 6), lane = tid & 63, r32 = lane & 31, hi = lane >> 5;
  char* V_lds = lds; char* K_lds = lds + 2 * SHM_V;
  float* ws = (float*)(lds + OFF_WS) + wid * 64; float* li_l = ws; float* al_l = ws + 32;
  float* km_l = (float*)(lds + OFF_KM);
  const int NT = (MODE == 0) ? nkeys / KVBLK : 4 * (qb + 1);
  const int qrel = wid * 32 + r32;
  float m_reg = -1e30f, l_reg = 0.f, carry = 1.f; f32x16 o[4] = {};
  const int vb0 = (int)(uintptr_t)V_lds + v_rd_base(lane);
  lds_cp ka[2][4];
#pragma unroll
  for (int y = 0; y < 2; ++y)
#pragma unroll
    for (int x = 0; x < 4; ++x) ka[y][x] = (lds_cp)(__attribute__((address_space(3))) char*)K_lds + r32 * 256 + 128 * (y ^ ((r32 >> 3) & 1)) + 32 * (x ^ ((r32 >> 1) & 3)) + 16 * (hi ^ (r32 & 1));
  lds_cp qr[2][4];
#pragma unroll
  for (int y = 0; y < 2; ++y)
#pragma unroll
    for (int x = 0; x < 4; ++x) qr[y][x] = ka[y][x] + (OFF_Q - 2 * SHM_V) + wid * 8192;
  long ksrc[2], vsrc[2];
#pragma unroll
  for (int i = 0; i < 2; ++i) { const int piece = wid + 8 * i;
    { const int row = piece * 4 + (lane >> 4), c = (lane & 15) ^ (row & 15); ksrc[i] = (long)row * ldk + c * 8; }
    { const int sub = piece * 2 + (lane >> 5), kk = (sub >> 2) * 8 + ((lane & 31) >> 2), k = (kk & ~0xC) | ((kk & 4) << 1) | ((kk & 8) >> 1), c = (sub & 3) * 32 + (lane & 3) * 8; vsrc[i] = (long)k * ldk + c; } }
  typedef __attribute__((address_space(3))) unsigned lds_u32;
  lds_u32* kdst = (lds_u32*)(__attribute__((address_space(3))) char*)(K_lds) + wid * 256; lds_u32* vdst = (lds_u32*)(__attribute__((address_space(3))) char*)(V_lds) + wid * 256;
#define TILE(it) ((MODE == 2) ? (NT - 1 - (it)) : (it))
#define DMA_K(k0, b) do { _Pragma("unroll") for (int i_ = 0; i_ < 2; ++i_) __builtin_amdgcn_global_load_lds((const unsigned*)(Kh + (long)(k0) * ldk + ksrc[i_]), kdst + (b) * (SHM_K / 4) + i_ * 2048, 16, 0, 0); } while (0)
#define DMA_V(k0, b) do { _Pragma("unroll") for (int i_ = 0; i_ < 2; ++i_) __builtin_amdgcn_global_load_lds((const unsigned*)(Vh + (long)(k0) * ldk + vsrc[i_]), vdst + (b) * (SHM_V / 4) + i_ * 2048, 16, 0, 0); } while (0)
#define SDRAIN() asm volatile("s_waitcnt vmcnt(0)" ::: "memory")
#define KSLOT(i_) ((i_) == 2 ? (OFF_Q - 2 * SHM_V) : (i_) * SHM_K)
#define VSLOT(i_) ((i_) == 2 ? (OFF_Q + SHM_K) : (i_) * SHM_V)
#define DMA_K3(k0, so) do { _Pragma("unroll") for (int i_ = 0; i_ < 2; ++i_) __builtin_amdgcn_global_load_lds((const unsigned*)(Kh + (long)(k0) * ldk + ksrc[i_]), kdst + (so) / 4 + i_ * 2048, 16, 0, 0); } while (0)
#define DMA_V3(k0, so) do { _Pragma("unroll") for (int i_ = 0; i_ < 2; ++i_) __builtin_amdgcn_global_load_lds((const unsigned*)(Vh + (long)(k0) * ldk + vsrc[i_]), vdst + (so) / 4 + i_ * 2048, 16, 0, 0); } while (0)
  { lds_u32* qdst = (lds_u32*)(__attribute__((address_space(3))) char*)(lds + OFF_Q) + wid * 2048;
#pragma unroll
    for (int i = 0; i < 8; ++i) { const int row = 4 * i + (lane >> 4), c = (lane & 15) ^ (row & 15);
      __builtin_amdgcn_global_load_lds((const unsigned*)(Qb + (long)(wid * 32 + row) * ldq + c * 8), qdst + i * 256, 16, 0, 0); } }
  DMA_K(TILE(0) * KVBLK, 0); DMA_V(TILE(0) * KVBLK, 0); if (MODE == 2 || PIPE_SOFTMAX) DMA_K(TILE(1) * KVBLK, 1);
  constexpr bool RING3 = (MODE != 2) && QREG_SOFTMAX && !PIPE_SOFTMAX;
  unsigned selmask = 0u;
  if (MODE == 1) { if (tid < 256) *(f32x4*)(km_l + tid * 4) = *(const f32x4*)(kmean + tid * 4); }
  SDRAIN();
  __syncthreads();
  if (MODE == 1) {
    float g[8];
#pragma unroll
    for (int n = 0; n < 8; ++n) g[n] = 0.f;
    { const int rh = (r32 >> 1) & 3, r3 = (r32 >> 3) & 1;
      const lds_cp qbase = qr[0][0] - 32 * rh - 128 * r3;
#pragma unroll 1
      for (int d0 = 0; d0 < 8; ++d0) {
        const bf16x8 qf = *reinterpret_cast<const __attribute__((address_space(3))) bf16x8*>(qbase + 32 * ((d0 & 3) ^ rh) + 128 * ((d0 >> 2) ^ r3));
        float q[8];
#pragma unroll
        for (int j = 0; j < 8; ++j) q[j] = __uint_as_float(((unsigned)(unsigned short)qf[j]) << 16);
        const float* kmp = km_l + d0 * 16 + hi * 8;
#pragma unroll
        for (int n = 0; n < 7; ++n) { const f32x4 k0v = *(const f32x4*)(kmp + n * 128), k1v = *(const f32x4*)(kmp + n * 128 + 4);
          g[n] += (q[0] * k0v[0] + q[1] * k0v[1]) + (q[2] * k0v[2] + q[3] * k0v[3]) + (q[4] * k1v[0] + q[5] * k1v[1]) + (q[6] * k1v[2] + q[7] * k1v[3]); }
      } }
#pragma unroll
    for (int n = 0; n < 7; ++n) { g[n] += xchg32(g[n], hi); if (n >= qb) g[n] = -INFINITY; }
    g[7] = -INFINITY;
#pragma unroll
    for (int n = 0; n < 7; ++n) { int cnt = 0;
#pragma unroll
      for (int mI = 0; mI < 7; ++mI) { if (mI != n) cnt += (g[mI] > g[n] || (g[mI] == g[n] && mI < n)) ? 1 : 0; }
      if (n < qb && cnt < 3) selmask |= (1u << n); }
  }
  bf16x8 qg[8];
  if (QREG_SOFTMAX && MODE != 2) {
#pragma unroll
    for (int d0 = 0; d0 < 8; ++d0) qg[d0] = *reinterpret_cast<const __attribute__((address_space(3))) bf16x8*>(qr[d0 >> 2][d0 & 3]); }
  int kc = KSLOT(0), kn = KSLOT(1), kn2 = KSLOT(2), vc = VSLOT(0), vn = VSLOT(1), vn2 = VSLOT(2);
  if (RING3) { DMA_K3(TILE(1) * KVBLK, kn); DMA_V3(TILE(1) * KVBLK, vn);
    asm volatile("s_waitcnt lgkmcnt(0)" ::: "memory"); __syncthreads(); }
  f32x16 pA0, pA1, pB0, pB1; bf16x8 pa0, pa1, pa2, pa3;
  if (MODE == 2 || PIPE_SOFTMAX) { float bias0 = 0.f; if (MODE == 1) { if (NT > 4) bias0 = (selmask & 1u) ? 0.f : -INFINITY; }
    qkt(pA0, pA1, ka, 0, qr, bias0);
    __syncthreads(); }
  int it = 0;
#define JB(i_) ((MODE == 2) ? (3 - (i_)) : ((i_) - (NT - 4)))
#define STEP(A0, A1, B0, B1, BAND, HASNEXT) do { \
    if (it + 2 < NT) DMA_K(TILE(it + 2) * KVBLK, it & 1); \
    if (it + 1 < NT) DMA_V(TILE(it + 1) * KVBLK, (it + 1) & 1); \
    bool skip = false; const int jb = JB(it); \
    if (BAND) { if (MODE == 1) skip = (64 * jb > wid * 32 + 31); if (MODE == 2) skip = (64 * jb >= wid * 32 + 31); } \
    if (HASNEXT) { float bias_ = 0.f; if (MODE == 1) { if (it + 1 < NT - 4) bias_ = ((selmask >> ((it + 1) >> 2)) & 1u) ? 0.f : -INFINITY; } \
      qkt(B0, B1, ka, ((it + 1) & 1) * SHM_K, qr, bias_); } \
    if (!skip) { \
      if (MODE == 2) { sb_tile<(BAND) != 0>(A0, A1, carry, 64 * jb, qrel, hi); } \
      else { \
        if (MODE == 1 && (BAND)) { _Pragma("unroll") for (int r = 0; r < 16; ++r) { const int kr = 64 * jb + crow(r, hi); if (kr > qrel) A0[r] = -INFINITY; if (kr + 32 > qrel) A1[r] = -INFINITY; } } \
        float alpha; softmax_tile(A0, A1, m_reg, l_reg, alpha); \
        if (__any(alpha < 1.f)) { if (hi == 0) al_l[r32] = alpha; asm volatile("s_waitcnt lgkmcnt(0)" ::: "memory"); \
          _Pragma("unroll") for (int d = 0; d < 4; ++d) _Pragma("unroll") for (int r = 0; r < 16; ++r) o[d][r] *= al_l[crow(r, hi)]; } \
      } \
      pack_p(A0, A1, pa0, pa1, pa2, pa3); \
      pv_d0(o, vb0 + (it & 1) * SHM_V, pa0, pa1, pa2, pa3); \
    } \
    SDRAIN(); __syncthreads(); ++it; } while (0)
#define SB_PART(G, P, I, B0, B1) do { qkt_part<G>(B0, B1, ka, ((it + 1) & 1) * SHM_K, qr); gs_[G] = sb_group<false, I>(P, 0, 0, hi); SBAR(); } while (0)
#define STEP_SB(A0, A1, B0, B1) do { \
    if (it + 2 < NT) DMA_K(TILE(it + 2) * KVBLK, it & 1); \
    DMA_V(TILE(it + 1) * KVBLK, (it + 1) & 1); \
    float gs_[8]; \
    _Pragma("unroll") for (int r = 0; r < 16; ++r) { B0[r] = 0.f; B1[r] = 0.f; } \
    SB_PART(0, A0, 0, B0, B1); SB_PART(1, A0, 1, B0, B1); SB_PART(2, A0, 2, B0, B1); SB_PART(3, A0, 3, B0, B1); \
    SB_PART(4, A1, 0, B0, B1); SB_PART(5, A1, 1, B0, B1); SB_PART(6, A1, 2, B0, B1); SB_PART(7, A1, 3, B0, B1); \
    sb_combine(A0, A1, gs_, carry, hi); \
    pack_p(A0, A1, pa0, pa1, pa2, pa3); \
    pv_d0(o, vb0 + (it & 1) * SHM_V, pa0, pa1, pa2, pa3); \
    SDRAIN(); __syncthreads(); ++it; } while (0)
#define SSTEP(BAND) do { \
    if (RING3) { if (it + 2 < NT) { DMA_K3(TILE(it + 2) * KVBLK, kn2); DMA_V3(TILE(it + 2) * KVBLK, vn2); } } \
    else if (it + 1 < NT) { DMA_K(TILE(it + 1) * KVBLK, (it + 1) & 1); DMA_V(TILE(it + 1) * KVBLK, (it + 1) & 1); } \
    bool skip = false; const int jb = JB(it); \
    if (BAND) skip = (64 * jb > wid * 32 + 31); \
    if (!skip) { \
      float bias_ = 0.f; if (MODE == 1 && !(BAND)) bias_ = ((selmask >> (it >> 2)) & 1u) ? 0.f : -INFINITY; \
      const int kb_ = RING3 ? kc : (it & 1) * SHM_K; \
      if (QREG_SOFTMAX) qkt(pA0, pA1, ka, kb_, qg, bias_); else qkt(pA0, pA1, ka, kb_, qr, bias_); \
      if (MODE == 1 && (BAND)) { _Pragma("unroll") for (int r = 0; r < 16; ++r) { const int kr = 64 * jb + crow(r, hi); if (kr > qrel) pA0[r] = -INFINITY; if (kr + 32 > qrel) pA1[r] = -INFINITY; } } \
      float alpha; softmax_tile(pA0, pA1, m_reg, l_reg, alpha); \
      if (__any(alpha < 1.f)) { if (hi == 0) al_l[r32] = alpha; asm volatile("s_waitcnt lgkmcnt(0)" ::: "memory"); \
        _Pragma("unroll") for (int d = 0; d < 4; ++d) _Pragma("unroll") for (int r = 0; r < 16; ++r) o[d][r] *= al_l[crow(r, hi)]; } \
      pack_p(pA0, pA1, pa0, pa1, pa2, pa3); \
      pv_d0(o, vb0 + (RING3 ? vc : (it & 1) * SHM_V), pa0, pa1, pa2, pa3); \
    } \
    if (RING3) { if (it + 2 < NT) asm volatile("s_waitcnt vmcnt(4)" ::: "memory"); else SDRAIN();        \
      { const int t_ = kc; kc = kn; kn = kn2; kn2 = t_; } { const int t_ = vc; vc = vn; vn = vn2; vn2 = t_; } } \
    else SDRAIN(); \
    if (RING3) { asm volatile("s_waitcnt lgkmcnt(0)" ::: "memory"); __builtin_amdgcn_s_barrier(); asm volatile("" ::: "memory"); }     \
    else __syncthreads(); \
    ++it; } while (0)
#define RESTART(BIASEXPR) do { qkt(pA0, pA1, ka, (it & 1) * SHM_K, qr, (BIASEXPR)); __syncthreads(); } while (0)
  if (MODE == 0) {
    if (PIPE_SOFTMAX) { STEP(pA0, pA1, pB0, pB1, 0, true); STEP(pB0, pB1, pA0, pA1, 0, true); STEP(pA0, pA1, pB0, pB1, 0, true); STEP(pB0, pB1, pA0, pA1, 0, false); }
    else { SSTEP(0); SSTEP(0); SSTEP(0); SSTEP(0); }
  } else if (MODE == 1) {
    if (PIPE_SOFTMAX) {
      if (NT > 4) { while (it < NT - 4) { STEP(pA0, pA1, pB0, pB1, 0, true); STEP(pB0, pB1, pA0, pA1, 0, (it + 1 < NT - 4)); }
        RESTART(0.f); }
      STEP(pA0, pA1, pB0, pB1, 1, true); STEP(pB0, pB1, pA0, pA1, 1, true); STEP(pA0, pA1, pB0, pB1, 1, true); STEP(pB0, pB1, pA0, pA1, 1, false);
    } else {
      while (it < NT - 4) SSTEP(0);
      SSTEP(1); SSTEP(1); SSTEP(1); SSTEP(1);
    }
  } else {
    STEP(pA0, pA1, pB0, pB1, 1, true); STEP(pB0, pB1, pA0, pA1, 1, true); STEP(pA0, pA1, pB0, pB1, 1, true); STEP(pB0, pB1, pA0, pA1, 1, false);
    if (NT > 4) {
      RESTART(0.f);
      while (it + 2 < NT) { STEP_SB(pA0, pA1, pB0, pB1); STEP_SB(pB0, pB1, pA0, pA1); }
      STEP_SB(pA0, pA1, pB0, pB1); STEP(pB0, pB1, pA0, pA1, 0, false);
    }
  }
#undef RESTART
#undef STEP
#undef SSTEP
#undef STEP_SB
#undef SB_PART
#undef JB
  float rli[16];
  if (MODE != 2) { if (hi == 0) li_l[r32] = l_reg; asm volatile("s_waitcnt lgkmcnt(0)" ::: "memory");
#pragma unroll
    for (int r = 0; r < 16; ++r) rli[r] = __builtin_amdgcn_rcpf(li_l[crow(r, hi)]); }
  else {
#pragma unroll
    for (int r = 0; r < 16; ++r) rli[r] = 1.f; }
  if (gain) {
    float gv[4];
#pragma unroll
    for (int d0 = 0; d0 < 4; ++d0) gv[d0] = gain[d0 * 32 + r32];
#pragma unroll
    for (int r = 0; r < 16; ++r) { float s = 0.f;
#pragma unroll
      for (int d0 = 0; d0 < 4; ++d0) { o[d0][r] *= rli[r]; s += o[d0][r] * o[d0][r]; }
      s += __shfl_xor(s, 1); s += __shfl_xor(s, 2); s += __shfl_xor(s, 4); s += __shfl_xor(s, 8); s += __shfl_xor(s, 16);
      rli[r] = __builtin_amdgcn_rsqf(s * (1.0f / 128.0f) + 1e-6f); }
#pragma unroll
    for (int r = 0; r < 16; ++r)
#pragma unroll
      for (int d0 = 0; d0 < 4; ++d0) o[d0][r] *= gv[d0];
  }
  { bf16* stg = (bf16*)lds + wid * 4096;
#pragma unroll
    for (int r = 0; r < 16; ++r) { const int orow = crow(r, hi);
#pragma unroll
      for (int d0 = 0; d0 < 4; ++d0) { const float v = o[d0][r] * rli[r]; unsigned u = __float_as_uint(v); u = (u + 0x7fffu + ((u >> 16) & 1u)) >> 16; stg[orow * 128 + d0 * 32 + r32] = (bf16)u; } }
    asm volatile("s_waitcnt lgkmcnt(0)" ::: "memory");
#pragma unroll
    for (int i = 0; i < 8; ++i) { const int row = i * 4 + (lane >> 4), ch = lane & 15; const u32x4 v = *(const u32x4*)(stg + row * 128 + ch * 8); *(u32x4*)(Ob + (long)(wid * 32 + row) * ldo + ch * 8) = v; } }
  __syncthreads();
#undef TILE
#undef DMA_K
#undef DMA_V
#undef DMA_K3
#undef DMA_V3
#undef KSLOT
#undef VSLOT
#undef SDRAIN
}
#undef KSWZ
#undef SBAR
}
#define GAS __attribute__((address_space(1)))
#define LAS __attribute__((address_space(3)))
typedef unsigned short bf16;
typedef unsigned v4u __attribute__((ext_vector_type(4)));
typedef float f32x4 __attribute__((ext_vector_type(4)));
#define LDS_WAIT() asm volatile("s_waitcnt lgkmcnt(0)" ::: "memory")
constexpr int NWAVES = 8;
constexpr int BATCH = 8, SEQ = 2048, DM = 2048, M = BATCH * SEQ, HD = 128, NH = 8;
constexpr int NQKV = 6144, FF = 5632, WX = 512, NMEM = 256, MMEM = BATCH * NMEM;
constexpr int QSB = 0, KSB = 1024, VSB = 2048, QMB = 3072, KMB = 4096, VMB = 5120;
constexpr float EPS = 1e-6f;
constexpr float QSCALE = 0.12751743082459868f;
constexpr size_t MiB = 1u << 20;
constexpr size_t WS_CTL = 0, CTL_ZERO_BYTES = 1 * MiB;
constexpr size_t WS_SSQ1 = 64 * 1024, WS_SSQ2 = 128 * 1024;
constexpr size_t WS_KSUM = 256 * 1024;
constexpr size_t WS_WIN = 1 * MiB, WS_WOUT = 25 * MiB, WS_WXQ = 33 * MiB, WS_WXKV = 35 * MiB, WS_WXO = 39 * MiB, WS_WGU = 41 * MiB, WS_WDN = 85 * MiB;
constexpr size_t WS_RA = 107 * MiB;
constexpr size_t WS_RB = 171 * MiB;
constexpr size_t WS_RC = 235 * MiB;
constexpr size_t WS_QX = 427 * MiB, WS_OX = 443 * MiB, WS_KVX = 459 * MiB, WS_MN = 463 * MiB, WS_KMEAN = 471 * MiB, WS_CS = 472 * MiB, WS_END = 474 * MiB;
constexpr int RING_BYTES = 131072, LDS_BYTES = 147456;
#ifndef FFN_FP8
#define FFN_FP8 1
#endif
constexpr float S_X2 = 16.f, S_WGU = 32.f, S_ACT = 8.f, S_WDN = 64.f, S_XN = 16.f, S_WV = 32.f;
constexpr size_t WS_WV8 = WS_WIN + 16 * MiB;

__device__ __forceinline__ float bf2f(unsigned short b) { return __uint_as_float((unsigned)b << 16); }
__device__ __forceinline__ unsigned f2bf(float f) { unsigned u = __builtin_bit_cast(unsigned, f); return (u + 0x7fffu + ((u >> 16) & 1u)) >> 16; }
__device__ __forceinline__ unsigned pk2(float lo, float hi) { return f2bf(lo) | (f2bf(hi) << 16); }
__device__ __forceinline__ float wave_sum(float v) {
#pragma unroll
    for (int o = 1; o < 64; o <<= 1) v += __shfl_xor(v, o);
    return v;
}
__device__ __forceinline__ float wave_max(float v) {
#pragma unroll
    for (int o = 1; o < 64; o <<= 1) v = fmaxf(v, __shfl_xor(v, o));
    return v;
}

typedef GAS unsigned gu32;
#define RLX_AGENT __ATOMIC_RELAXED, __HIP_MEMORY_SCOPE_AGENT
constexpr int CW_BAR = 4096;
constexpr int LDSCTL_OFF = RING_BYTES, MISC_OFF = LDSCTL_OFF + 320;
#define XB_TMO      128
#define XB_XCNT(j)  (256  + 64 * (j))
#define XB_XSUB(j)  (1280 + 64 * (j))
#define XB_XGEN(j)  (2304 + 64 * (j))
#define XB_TOP      3328
#define XB_TOPGEN   3392
#define XCD_BAR_WORDS 3456
#define XB_SPIN_CAP (1u << 18)

__device__ __forceinline__ unsigned xb_ld(unsigned* p)              { return __hip_atomic_load(p, __ATOMIC_RELAXED, __HIP_MEMORY_SCOPE_AGENT); }
__device__ __forceinline__ unsigned xb_add(unsigned* p, unsigned v) { return __hip_atomic_fetch_add(p, v, __ATOMIC_RELAXED, __HIP_MEMORY_SCOPE_AGENT); }
__device__ __forceinline__ unsigned xb_xcc_id() { return (unsigned)__builtin_amdgcn_s_getreg((3 << 11) | 20) & 0xFu; }
#define XB_SPIN(cond, bar) do { unsigned _sp = 0; while (cond) { __builtin_amdgcn_s_sleep(1); \
    if ((++_sp & 255u) == 0u) { if (xb_ld(&(bar)[XB_TMO])) break; if (_sp > XB_SPIN_CAP) { atomicAdd(&(bar)[XB_TMO], 1u); break; } } } } while (0)

struct XcdBarrier {
    unsigned* bar; unsigned x;
    volatile LAS unsigned* st;
};

__device__ __forceinline__ XcdBarrier xcd_barrier_post(unsigned* bar, volatile LAS unsigned* st) {
    XcdBarrier b; b.bar = bar; b.x = xb_xcc_id(); b.st = st;
    if (threadIdx.x == 0) (void)xb_add(&bar[XB_XCNT(b.x)], 1u);
    return b;
}
__device__ __forceinline__ void xcd_barrier_complete(unsigned* bar, unsigned x, unsigned& nloc, unsigned& nx) {
    const unsigned G = gridDim.x * gridDim.y * gridDim.z;
    unsigned sum, cnt, mine, sp = 0u;
    for (;;) {
        sum = 0u; cnt = 0u; mine = 0u;
#pragma unroll
        for (unsigned j = 0; j < 16; ++j) { const unsigned c = xb_ld(&bar[XB_XCNT(j)]); sum += c; cnt += (c > 0u) ? 1u : 0u; mine = (j == x) ? c : mine; }
        if (sum == G) break;
        __builtin_amdgcn_s_sleep(1);
        if ((++sp & 255u) == 0u) { if (xb_ld(&bar[XB_TMO])) break; if (sp > XB_SPIN_CAP) { atomicAdd(&bar[XB_TMO], 1u); break; } }
    }
    nloc = mine > 0u ? mine : 1u; nx = cnt > 0u ? cnt : 1u;
}

__device__ __forceinline__ void xcd_barrier(const XcdBarrier& b) {
    asm volatile("s_waitcnt vmcnt(0)" ::: "memory");
    __syncthreads();
    if (threadIdx.x == 0) {
        unsigned* bar = b.bar;
        __builtin_amdgcn_s_waitcnt(0);
        unsigned nloc = b.st[0], nx = b.st[1];
        if (nloc == 0u) { xcd_barrier_complete(bar, b.x, nloc, nx); b.st[0] = nloc; b.st[1] = nx; }
        const unsigned old = xb_add(&bar[XB_XSUB(b.x)], 1u);
        const unsigned gen = old / nloc;
        if (old + 1u == (gen + 1u) * nloc) {
            __builtin_amdgcn_fence(__ATOMIC_RELEASE, "agent");
            asm volatile("s_waitcnt vmcnt(0)" ::: "memory");
            const unsigned og = xb_add(&bar[XB_TOP], 1u);
            const unsigned tg = og / nx;
            if (og + 1u == (tg + 1u) * nx) xb_add(&bar[XB_TOPGEN], 1u);
            else XB_SPIN(xb_ld(&bar[XB_TOPGEN]) == tg, bar);
            __builtin_amdgcn_fence(__ATOMIC_ACQUIRE, "agent");
            xb_add(&bar[XB_XGEN(b.x)], 1u);
            asm volatile("s_waitcnt vmcnt(0)" ::: "memory");
        } else {
            XB_SPIN(xb_ld(&bar[XB_XGEN(b.x)]) == gen, bar);
            __builtin_amdgcn_fence(__ATOMIC_ACQUIRE, "agent");
            asm volatile("s_waitcnt vmcnt(0)" ::: "memory");
        }
    }
    __syncthreads();
}

struct Frame {
    LAS unsigned char* lds;
    int tid, lane, wave, vcu, G;
    const float *x, *mem; const int* pos;
    const float *g_mix, *w_in, *g_out_sb, *g_out_mb, *w_out, *g_xattn, *g_mem, *w_xq, *w_xkv, *w_xo, *g_ffn, *w_gu, *w_dn, *g_final;
    float* out; unsigned char* ws;
};

__device__ __forceinline__ void transpose_item(const float* W, int K, int N, bf16* WT, const float* gain, int inter, LAS float* scr, int item, int lane) {
    const int nblk = N / 32, kb = item / nblk, nb = item % nblk, k0 = 64 * kb, n0 = 32 * nb;
    int orow0 = n0;
    if (inter == 1) orow0 = (n0 < FF) ? (n0 / 128) * 256 + (n0 % 128) : ((n0 - FF) / 128) * 256 + 128 + ((n0 - FF) % 128);
    if (inter == 2) { const int reg = n0 / 1024, c = n0 % 1024; orow0 = (reg == 2) ? c : (reg == 5) ? 1024 + c : (reg < 2 ? reg : reg - 1) * 1024 + c; }
    float v[32];
#pragma unroll
    for (int i = 0; i < 32; ++i) v[i] = W[(size_t)(k0 + 2 * i + (lane >> 5)) * N + n0 + (lane & 31)];
#pragma unroll
    for (int i = 0; i < 32; ++i) { const int kk = 2 * i + (lane >> 5); float t = v[i]; if (gain) t *= gain[k0 + kk]; scr[kk * 33 + (lane & 31)] = t; }
    LDS_WAIT(); asm volatile("" ::: "memory");
    const int c = lane & 7;
#pragma unroll
    for (int j = 0; j < 4; ++j) { const int n = (lane >> 3) + 8 * j; const LAS float* s = scr + (8 * c) * 33 + n;
        v4u o; o.x = pk2(s[0 * 33], s[1 * 33]); o.y = pk2(s[2 * 33], s[3 * 33]); o.z = pk2(s[4 * 33], s[5 * 33]); o.w = pk2(s[6 * 33], s[7 * 33]);
        *(GAS v4u*)(WT + (size_t)(orow0 + n) * K + k0 + 8 * c) = o; }
    LDS_WAIT(); asm volatile("" ::: "memory");
}
__device__ __forceinline__ void transpose_item_fp8(const float* W, int K, int N, unsigned char* WT, const float* gain, int inter, float scale, LAS float* scr, int item, int lane) {
    const int nblk = N / 32, kb = item / nblk, nb = item % nblk, k0 = 64 * kb, n0 = 32 * nb;
    int orow0 = n0;
    if (inter == 1) orow0 = (n0 < FF) ? (n0 / 128) * 256 + (n0 % 128) : ((n0 - FF) / 128) * 256 + 128 + ((n0 - FF) % 128);
    if (inter == 2) { const int reg = n0 / 1024, c = n0 % 1024; orow0 = (reg == 2) ? c : (reg == 5) ? 1024 + c : (reg < 2 ? reg : reg - 1) * 1024 + c; }
    float v[32];
#pragma unroll
    for (int i = 0; i < 32; ++i) v[i] = W[(size_t)(k0 + 2 * i + (lane >> 5)) * N + n0 + (lane & 31)];
#pragma unroll
    for (int i = 0; i < 32; ++i) { const int kk = 2 * i + (lane >> 5); float t = v[i] * scale; if (gain) t *= gain[k0 + kk]; scr[kk * 33 + (lane & 31)] = t; }
    LDS_WAIT(); asm volatile("" ::: "memory");
    const int c = lane & 7;
#pragma unroll
    for (int j = 0; j < 4; ++j) { const int n = (lane >> 3) + 8 * j; const LAS float* s = scr + (8 * c) * 33 + n;
        pg8::u32x2 o; o.x = pg8::pk4_fp8(s[0 * 33], s[1 * 33], s[2 * 33], s[3 * 33]); o.y = pg8::pk4_fp8(s[4 * 33], s[5 * 33], s[6 * 33], s[7 * 33]);
        *(GAS pg8::u32x2*)(WT + (size_t)(orow0 + n) * K + k0 + 8 * c) = o; }
    LDS_WAIT(); asm volatile("" ::: "memory");
}
__device__ __forceinline__ void rms_row_to_bf16(const float* xrow, const float* g, bf16* orow, int lane, unsigned char* o8 = nullptr, float s8 = 1.f) {
    const GAS f32x4* xr = (const GAS f32x4*)xrow + lane; const GAS f32x4* gr = (const GAS f32x4*)g + lane;
    f32x4 v[8]; float s = 0.f;
#pragma unroll
    for (int j = 0; j < 8; ++j) { v[j] = xr[64 * j]; s += (v[j].x * v[j].x + v[j].y * v[j].y) + (v[j].z * v[j].z + v[j].w * v[j].w); }
    const float rstd = 1.0f / sqrtf(wave_sum(s) * (1.f / DM) + EPS);
    GAS unsigned long long* ob8 = (GAS unsigned long long*)orow + lane;
#pragma unroll
    for (int j = 0; j < 8; ++j) { const f32x4 gg = gr[64 * j];
        const float a0 = v[j].x * rstd * gg.x, a1 = v[j].y * rstd * gg.y, a2 = v[j].z * rstd * gg.z, a3 = v[j].w * rstd * gg.w;
        ob8[64 * j] = (unsigned long long)pk2(a0, a1) | ((unsigned long long)pk2(a2, a3) << 32);
        if (o8) ((GAS unsigned*)o8)[64 * j + lane] = pg8::pk4_fp8(a0 * s8, a1 * s8, a2 * s8, a3 * s8); }
}
__constant__ float INV_FREQ[16] = {1.000000000e+00f, 4.403665960e-01f, 1.939227432e-01f, 8.539710194e-02f, 3.760603070e-02f, 1.656043902e-02f, 7.292664610e-03f, 3.211445874e-03f,
                                   1.414213562e-03f, 6.227723788e-04f, 2.742481884e-04f, 1.207697351e-04f, 5.318296098e-05f, 2.341999971e-05f, 1.031338616e-05f, 4.541670478e-06f};

__device__ __forceinline__ void p0_prologue(Frame& F) {
    LAS float* scr = (LAS float*)(F.lds + F.wave * 16384);
    const int gw = F.vcu * NWAVES + F.wave, NGW = F.G * NWAVES;
    bf16* ws16 = (bf16*)F.ws;
    constexpr int I0 = (DM / 64) * (NQKV / 32), I1 = (DM / 64) * (DM / 32), I2 = (DM / 64) * (WX / 32), I3 = (DM / 64) * (2 * WX / 32), I4 = (WX / 64) * (DM / 32),
                  I5 = (DM / 64) * (2 * FF / 32), I6 = (FF / 64) * (DM / 32);
    constexpr int I5H = I5 / 2;
    constexpr int NITEMS = I0 + I1 + I2 + I3 + I4 + I5H;
    for (int it = gw; it < NITEMS; it += NGW) {
        int r = it;
        if (r < I0) { const int reg = ((r % (NQKV / 32)) * 32) / 1024;
            if (reg == 2 || reg == 5) transpose_item_fp8(F.w_in, DM, NQKV, F.ws + WS_WV8, nullptr, 2, S_WV, scr, r, F.lane);
            else transpose_item(F.w_in, DM, NQKV, (bf16*)(F.ws + WS_WIN), nullptr, 2, scr, r, F.lane);
            continue; } r -= I0;
        if (r < I1) { transpose_item(F.w_out, DM, DM, (bf16*)(F.ws + WS_WOUT), nullptr, 0, scr, r, F.lane); continue; } r -= I1;
        if (r < I2) { transpose_item(F.w_xq, DM, WX, (bf16*)(F.ws + WS_WXQ), F.g_xattn, 0, scr, r, F.lane); continue; } r -= I2;
        if (r < I3) { transpose_item(F.w_xkv, DM, 2 * WX, (bf16*)(F.ws + WS_WXKV), nullptr, 0, scr, r, F.lane); continue; } r -= I3;
        if (r < I4) { transpose_item(F.w_xo, WX, DM, (bf16*)(F.ws + WS_WXO), nullptr, 0, scr, r, F.lane); continue; } r -= I4;
        transpose_item_fp8(F.w_gu, DM, 2 * FF, F.ws + WS_WGU, F.g_ffn, 1, S_WGU, scr, r, F.lane);
    }
    (void)ws16;
    for (int m = gw; m < M; m += NGW) rms_row_to_bf16(F.x + (size_t)m * DM, F.g_mix, (bf16*)(F.ws + WS_RA) + (size_t)m * DM, F.lane, F.ws + WS_RB + (size_t)m * DM, S_XN);
    for (int m = gw; m < MMEM; m += NGW) rms_row_to_bf16(F.mem + (size_t)m * DM, F.g_mem, (bf16*)(F.ws + WS_MN) + (size_t)m * DM, F.lane);
    float* cs = (float*)(F.ws + WS_CS);
    for (int e = (F.vcu * NWAVES + F.wave) * 64 + F.lane; e < M * 16; e += NGW * 64) {
        const int m = e >> 4, i = e & 15; const float ang = (float)F.pos[m] * INV_FREQ[i];
        double rev = (double)ang * 0.15915494309189535; rev -= floor(rev);
        const float a = (float)(rev * 6.283185307179586);
        cs[(size_t)m * 32 + i] = cosf(a); cs[(size_t)m * 32 + 16 + i] = sinf(a);
    }
}

__device__ __forceinline__ void ffn_weight_items(Frame& F, int wi, int nw) {
    LAS float* scr = (LAS float*)(F.lds + F.wave * 16384);
    constexpr int I5 = (DM / 64) * (2 * FF / 32), I6 = (FF / 64) * (DM / 32);
    for (int it = wi + I5 / 2; it < I5 + I6; it += nw) {
        if (it < I5) transpose_item_fp8(F.w_gu, DM, 2 * FF, F.ws + WS_WGU, F.g_ffn, 1, S_WGU, scr, it, F.lane);
        else transpose_item_fp8(F.w_dn, FF, DM, F.ws + WS_WDN, nullptr, 0, S_WDN, scr, it - I5, F.lane);
    }
}

__device__ __forceinline__ void final_norm_phase(Frame& F, const bf16* src, float* dst) {
    const int gw = F.vcu * NWAVES + F.wave, NGW = F.G * NWAVES;
    for (int m = gw; m < M; m += NGW) {
        const GAS v4u* xr = (const GAS v4u*)(src + (size_t)m * DM) + F.lane; const GAS f32x4* gr = (const GAS f32x4*)F.g_final;
        v4u w[4]; float s = 0.f;
#pragma unroll
        for (int j = 0; j < 4; ++j) w[j] = xr[64 * j];
        f32x4 v[8];
#pragma unroll
        for (int j = 0; j < 4; ++j) { v[2 * j] = (f32x4){__uint_as_float(w[j].x << 16), __uint_as_float(w[j].x & 0xffff0000u), __uint_as_float(w[j].y << 16), __uint_as_float(w[j].y & 0xffff0000u)};
            v[2 * j + 1] = (f32x4){__uint_as_float(w[j].z << 16), __uint_as_float(w[j].z & 0xffff0000u), __uint_as_float(w[j].w << 16), __uint_as_float(w[j].w & 0xffff0000u)}; }
#pragma unroll
        for (int j = 0; j < 8; ++j) s += (v[j].x * v[j].x + v[j].y * v[j].y) + (v[j].z * v[j].z + v[j].w * v[j].w);
        const float rstd = 1.0f / sqrtf(wave_sum(s) * (1.f / DM) + EPS);
        GAS f32x4* dr = (GAS f32x4*)(dst + (size_t)m * DM);
#pragma unroll
        for (int j = 0; j < 4; ++j) { const int c4 = (64 * j + F.lane) * 2;
            dr[c4] = v[2 * j] * rstd * gr[c4]; dr[c4 + 1] = v[2 * j + 1] * rstd * gr[c4 + 1]; }
    }
}

constexpr int NPH = 11;
#ifndef REPEAT_WHICH
#define REPEAT_WHICH 3
#endif
#ifndef NULL_EPI_PROBE
#define NULL_EPI_PROBE 0
#endif
#ifndef FOLD_KMEAN
#define FOLD_KMEAN 1
#endif
#ifndef REPEAT_PHASE
#define REPEAT_PHASE -1
#endif
#ifndef REPEAT_MASK
#define REPEAT_MASK 0
#endif
#define REPS(k) (((REPEAT_PHASE == (k)) || ((REPEAT_MASK >> (k)) & 1)) ? 2 : 1)
#ifndef USE_MFMA_SB
#define USE_MFMA_SB 1
#endif
#ifndef USE_MFMA_MOBA
#define USE_MFMA_MOBA 1
#endif
#ifndef USE_MFMA_X
#define USE_MFMA_X 1
#endif
#ifndef MK_ONE_LAUNCH
#define MK_ONE_LAUNCH 1
#endif
struct Args { const void* in[17]; float* out; unsigned char* ws; int ph_lo, ph_hi; };
__global__ void __launch_bounds__(NWAVES * 64, 2) mk_fwd(Args args) {
    extern __shared__ __attribute__((aligned(16))) unsigned char lds[];
    Frame F;
    F.lds = (LAS unsigned char*)lds;
    F.tid = threadIdx.x; F.lane = F.tid & 63; F.wave = __builtin_amdgcn_readfirstlane(F.tid >> 6);
    F.G = gridDim.x; { const int bx = blockIdx.x; F.vcu = (F.G % 8 == 0) ? (bx % 8) * (F.G / 8) + bx / 8 : bx; }
    F.x = (const float*)args.in[0]; F.mem = (const float*)args.in[1]; F.pos = (const int*)args.in[2];
    F.g_mix = (const float*)args.in[3]; F.w_in = (const float*)args.in[4]; F.g_out_sb = (const float*)args.in[5]; F.g_out_mb = (const float*)args.in[6]; F.w_out = (const float*)args.in[7];
    F.g_xattn = (const float*)args.in[8]; F.g_mem = (const float*)args.in[9]; F.w_xq = (const float*)args.in[10]; F.w_xkv = (const float*)args.in[11]; F.w_xo = (const float*)args.in[12];
    F.g_ffn = (const float*)args.in[13]; F.w_gu = (const float*)args.in[14]; F.w_dn = (const float*)args.in[15]; F.g_final = (const float*)args.in[16];
    F.out = args.out; F.ws = args.ws;
    unsigned char* ws = args.ws;
    const int lo = args.ph_lo, hi = args.ph_hi;
    for (int u = F.tid; u < (LDS_BYTES - LDSCTL_OFF) / 4; u += NWAVES * 64) ((LAS unsigned*)(F.lds + LDSCTL_OFF))[u] = 0u;
    __syncthreads();
    if (hi - lo > 1) cg::this_grid().sync();
    XcdBarrier bar = xcd_barrier_post((unsigned*)(ws + WS_CTL) + CW_BAR, (volatile LAS unsigned*)(F.lds + MISC_OFF) + 8);
#ifndef ONLY_PHASE
#define ONLY_PHASE -1
#endif
#define IN(k) ((ONLY_PHASE < 0 || ONLY_PHASE == (k)) && lo <= (k) && (k) < hi)
#define BOTH(k) (IN(k) && IN((k) + 1))
#define GRID_BAR() xcd_barrier(bar)
    float* ssq1 = (float*)(ws + WS_SSQ1); float* ssq2 = (float*)(ws + WS_SSQ2);
    pg8::bf16_t* RA = (pg8::bf16_t*)(ws + WS_RA); pg8::bf16_t* RB = (pg8::bf16_t*)(ws + WS_RB); pg8::bf16_t* RC = (pg8::bf16_t*)(ws + WS_RC);

    if (IN(0)) { for (int rep = 0; rep < REPS(0); ++rep) p0_prologue(F); if (BOTH(0)) GRID_BAR(); }
    if (IN(1)) {
        for (int rep = 0; rep < REPS(1); ++rep) {
        { pg8::Gemm g{RA, (const pg8::bf16_t*)(ws + WS_WIN), M, 4096, DM}; pg8::StaticOrder S; S.init(M, 4096, F.G, (int)blockIdx.x);
          pg8::EpiQKV E{RC, (const float*)(ws + WS_CS), QSCALE, (float*)(ws + WS_KSUM), 0, 1.f};
          pg8::gemm_phase<pg8::EpiQKV, pg8::StaticOrder, true, true>(F.lds, g, S, E); }
        { pg8::Gemm g{RB, (const pg8::bf16_t*)(ws + WS_WV8), M, 2048, DM / 2}; pg8::StaticOrder S; S.init(M, 2048, F.G, (int)blockIdx.x);
          pg8::EpiQKV E{RC, (const float*)(ws + WS_CS), QSCALE, (float*)(ws + WS_KSUM), 1, 1.f / (S_XN * S_WV)};
          pg8::gemm_phase<pg8::EpiQKV, pg8::StaticOrder, true, true, true>(F.lds, g, S, E); }
        }
        if (BOTH(1)) GRID_BAR();
    }
    if (IN(3)) {
        const att::bf16* qkv = (const att::bf16*)RC; att::bf16* ob = (att::bf16*)RA; const float* kmean = (const float*)(ws + WS_KSUM);
        constexpr size_t HSZ = (size_t)SEQ * HD;
        for (int rep = 0; rep < REPS(3); ++rep) {
        if (rep == 0 || (REPEAT_WHICH & 1))
        for (int vv = F.vcu; vv < 256; vv += F.G) { const int bh = vv >> 2, s = vv & 3, b = bh >> 3, h = bh & 7; const size_t rb = (size_t)b * SEQ; const att::bf16* hb = qkv + ((size_t)b * 48 + h) * HSZ;
            for (int i = 0; i < 2; ++i) { const int qb = i ? s : 7 - s; const size_t r0 = rb + (size_t)qb * 256;
                att::attn_unit<2>(hb + (size_t)qb * 256 * HD, HD, hb + 8 * HSZ, hb + 16 * HSZ, HD, ob + r0 * DM + h * HD, DM, F.g_out_sb + h * HD, nullptr, qb, 0, (char*)lds); } }
        if (rep == 0 || (REPEAT_WHICH & 2))
        for (int vv = F.vcu; vv < 256; vv += F.G) { const int bh = vv >> 2, s = vv & 3, b = bh >> 3, h = bh & 7; const size_t rb = (size_t)b * SEQ; const att::bf16* hb = qkv + ((size_t)b * 48 + 24 + h) * HSZ;
            for (int i = 0; i < 2; ++i) { const int qb = i ? s : 7 - s; const size_t r0 = rb + (size_t)qb * 256;
                att::attn_unit<1>(hb + (size_t)qb * 256 * HD, HD, hb + 8 * HSZ, hb + 16 * HSZ, HD, ob + r0 * DM + NH * HD + h * HD, DM, F.g_out_mb + h * HD, kmean + (size_t)bh * 1024, qb, 0, (char*)lds); } }
        }
        if (BOTH(3)) GRID_BAR();
    }
    if (IN(4)) {
        pg8::Gemm g{RA, (const pg8::bf16_t*)(ws + WS_WOUT), M, DM, DM}; pg8::StaticOrder S; S.init(M, DM, F.G, (int)blockIdx.x);
        if (REPS(4) == 2) { pg8::EpiResB<true> E0{F.x, RB, nullptr, nullptr, 1.f, 1.f}; pg8::gemm_phase<pg8::EpiResB<true>, pg8::StaticOrder, true, true>(F.lds, g, S, E0); }
        pg8::EpiResB<true> E{F.x, RB, ssq1, nullptr, 1.f, 1.f};
        pg8::gemm_phase<pg8::EpiResB<true>, pg8::StaticOrder, true, true>(F.lds, g, S, E);
        if (BOTH(4)) GRID_BAR();
    }
    if (IN(5)) {
      for (int rep = 0; rep < REPS(5); ++rep) {
        { pg8::Gemm g{RB, (const pg8::bf16_t*)(ws + WS_WXQ), M, WX, DM}; pg8::StaticOrder S; S.init(M, WX, F.G, (int)blockIdx.x);
          pg8::EpiScale E{(pg8::bf16_t*)(ws + WS_QX), WX, ssq1, QSCALE};
          pg8::gemm_phase<pg8::EpiScale, pg8::StaticOrder, true, true>(F.lds, g, S, E); }
        { pg8::Gemm g{(const pg8::bf16_t*)(ws + WS_MN), (const pg8::bf16_t*)(ws + WS_WXKV), MMEM, 2 * WX, DM}; pg8::StaticOrder S; S.init(MMEM, 2 * WX, F.G, (int)((blockIdx.x + F.G - 128) % F.G));
          pg8::EpiScale E{(pg8::bf16_t*)(ws + WS_KVX), 2 * WX, nullptr, 1.0f};
          pg8::gemm_phase<pg8::EpiScale, pg8::StaticOrder, true, true>(F.lds, g, S, E); }
        if (F.G > 160) { if ((int)blockIdx.x >= 160) ffn_weight_items(F, ((int)blockIdx.x - 160) * NWAVES + F.wave, (F.G - 160) * NWAVES); }
        else ffn_weight_items(F, (int)blockIdx.x * NWAVES + F.wave, F.G * NWAVES);
      }
        if (BOTH(5)) GRID_BAR();
    }
    if (IN(6)) {
        const att::bf16* qx = (const att::bf16*)(ws + WS_QX); const att::bf16* kvx = (const att::bf16*)(ws + WS_KVX); att::bf16* ox = (att::bf16*)(ws + WS_OX);
        for (int rep = 0; rep < REPS(6); ++rep) {
        for (int vv = F.vcu; vv < 256; vv += F.G) { const int b = vv >> 5, h = (vv >> 3) & 3, qb = vv & 7; const size_t r0 = (size_t)b * SEQ + (size_t)qb * 256;
            att::attn_unit<0>(qx + r0 * WX + h * HD, WX, kvx + (size_t)b * NMEM * (2 * WX) + h * HD, kvx + (size_t)b * NMEM * (2 * WX) + WX + h * HD, 2 * WX, ox + r0 * WX + h * HD, WX, nullptr, nullptr, qb, NMEM, (char*)lds); }
        }
        if (BOTH(6)) GRID_BAR();
    }
    if (IN(7)) {
        pg8::Gemm g{(const pg8::bf16_t*)(ws + WS_OX), (const pg8::bf16_t*)(ws + WS_WXO), M, DM, WX}; pg8::StaticOrder S; S.init(M, DM, F.G, (int)blockIdx.x);
        if (REPS(7) == 2) { pg8::EpiResB<false> E0{RB, RC, nullptr, nullptr, 1.f, 1.f}; pg8::gemm_phase<pg8::EpiResB<false>, pg8::StaticOrder, true, true>(F.lds, g, S, E0); }
        pg8::EpiResB<false> E{RB, RB, ssq2, (unsigned char*)RA, S_X2, 1.f};
        pg8::gemm_phase<pg8::EpiResB<false>, pg8::StaticOrder, true, true>(F.lds, g, S, E);
        if (BOTH(7)) GRID_BAR();
    }
    if (IN(8)) {
        pg8::Gemm g{RA, (const pg8::bf16_t*)(ws + WS_WGU), M, 2 * FF, FFN_FP8 ? DM / 2 : DM}; pg8::StaticOrder S; S.init(M, 2 * FF, F.G, (int)blockIdx.x);
        pg8::EpiSwiGLU E{RC, ssq2, FFN_FP8 ? (unsigned char*)RC : nullptr, FFN_FP8 ? 1.f / (S_X2 * S_WGU) : 1.f, S_ACT};
#if NULL_EPI_PROBE
        if (REPS(8) == 2) { pg8::EpiNull EN{nullptr}; pg8::gemm_phase<pg8::EpiNull, pg8::StaticOrder, true, true, FFN_FP8 != 0>(F.lds, g, S, EN); }
        pg8::gemm_phase<pg8::EpiSwiGLU, pg8::StaticOrder, true, true, FFN_FP8 != 0>(F.lds, g, S, E);
#else
        for (int rep = 0; rep < REPS(8); ++rep) pg8::gemm_phase<pg8::EpiSwiGLU, pg8::StaticOrder, true, true, FFN_FP8 != 0>(F.lds, g, S, E);
#endif
        if (BOTH(8)) GRID_BAR();
    }
    if (IN(9)) {
        pg8::Gemm g{RC, (const pg8::bf16_t*)(ws + WS_WDN), M, DM, FF / 2}; pg8::StaticOrder S; S.init(M, DM, F.G, (int)blockIdx.x);
        if (REPS(9) == 2) { pg8::EpiResB<false> E0{RB, (pg8::bf16_t*)(ws + WS_RC + 96 * MiB), nullptr, nullptr, 1.f, 1.f / (S_ACT * S_WDN)}; pg8::gemm_phase<pg8::EpiResB<false>, pg8::StaticOrder, true, true, true>(F.lds, g, S, E0); }
        pg8::EpiResB<false> E{RB, RB, nullptr, nullptr, 1.f, 1.f / (S_ACT * S_WDN)};
        pg8::gemm_phase<pg8::EpiResB<false>, pg8::StaticOrder, true, true, true>(F.lds, g, S, E);
        if (BOTH(9)) GRID_BAR();
    }
    if (IN(10)) { if (REPS(10) == 2) final_norm_phase(F, RB, (float*)RC); final_norm_phase(F, RB, F.out); }
#undef IN
#undef BOTH
}

extern "C" void kernel_launch(void* const* d_in, const int* in_sizes, int n_in, void* d_out, int out_size, void* d_ws, size_t ws_size, hipStream_t stream) {
    static int grid = 0;
    if (grid == 0) {
        if (n_in != 17 || in_sizes[0] != M * DM || out_size != M * DM || ws_size < WS_END) { fprintf(stderr, "kernel_launch: unexpected shapes (n_in %d in0 %d out %d ws %zu)\n", n_in, n_in > 0 ? in_sizes[0] : -1, out_size, ws_size); grid = -1; return; }
        int dev = 0, cus = 0, per_cu = 0;
        if (hipGetDevice(&dev) != hipSuccess || hipDeviceGetAttribute(&cus, hipDeviceAttributeMultiprocessorCount, dev) != hipSuccess) { grid = -1; return; }
        if (hipFuncSetAttribute((const void*)mk_fwd, hipFuncAttributeMaxDynamicSharedMemorySize, LDS_BYTES) != hipSuccess) { fprintf(stderr, "kernel_launch: hipFuncSetAttribute failed\n"); grid = -1; return; }
        if (hipOccupancyMaxActiveBlocksPerMultiprocessor(&per_cu, (const void*)mk_fwd, NWAVES * 64, LDS_BYTES) != hipSuccess || per_cu < 1) { fprintf(stderr, "kernel_launch: occupancy query failed (%d)\n", per_cu); per_cu = 1; }
        (void)hipGetLastError();
        grid = cus * (per_cu < 1 ? 1 : 1);
    }
    if (grid < 0) return;
    (void)hipMemsetAsync((char*)d_ws + WS_CTL, 0, CTL_ZERO_BYTES, stream);
    Args a{};
    for (int i = 0; i < 17; ++i) a.in[i] = d_in[i];
    a.out = (float*)d_out; a.ws = (unsigned char*)d_ws;
#if MK_ONE_LAUNCH
    a.ph_lo = 0; a.ph_hi = NPH;
    void* kargs[] = {&a};
    hipError_t e = hipLaunchCooperativeKernel((const void*)mk_fwd, dim3(grid), dim3(NWAVES * 64), kargs, LDS_BYTES, stream);
    if (e != hipSuccess) fprintf(stderr, "kernel_launch: cooperative launch failed: %s (grid %d)\n", hipGetErrorString(e), grid);
#else
    for (int p = 0; p < NPH; ++p) { a.ph_lo = p; a.ph_hi = p + 1; hipLaunchKernelGGL(mk_fwd, dim3(grid), dim3(NWAVES * 64), LDS_BYTES, stream, a); }
    const hipError_t le = hipPeekAtLastError();
    if (le != hipSuccess) fprintf(stderr, "kernel_launch: launch failed: %s\n", hipGetErrorName(le));
#endif
}
```

```cpp
#include <hip/hip_runtime.h>
#include <hip/hip_cooperative_groups.h>
#include <cstdio>
#include <cstdint>
namespace cg = cooperative_groups;
namespace pg8 {
#define PG8_LAS __attribute__((address_space(3)))
typedef unsigned short bf16_t;
typedef short bf16x8 __attribute__((ext_vector_type(8)));
typedef float f32x4 __attribute__((ext_vector_type(4)));
typedef unsigned u32x4 __attribute__((ext_vector_type(4)));
constexpr int BM = 256, BK = 64, HALF = 128, HTB = HALF * BK * 2  , STAGE_BYTES = 8 * HTB, NXCD = 8, WGM = 8;

__host__ __device__ __forceinline__ int lds_byte(int r, int c) { const int st = (r >> 4) * 2 + (c >> 5), rr = r & 15, cc = c & 31, ob = rr * 64 + cc * 2; return st * 1024 + (ob ^ (((ob >> 9) & 1) << 5)); }
__host__ __device__ __forceinline__ void stage_rc(int b, int& R, int& C) { const int st = b / 1024, sb = b % 1024, swz = sb ^ (((sb >> 9) & 1) << 5); R = (st >> 1) * 16 + swz / 64; C = (st & 1) * 32 + (swz % 64) / 2; }
__host__ __device__ __forceinline__ int perm32(int rho) { const int n = rho >> 4, i = rho & 15; return 8 * (i >> 2) + 4 * n + (i & 3); }

struct Unit { int pm, pn; };
struct Gemm { const bf16_t* A; const bf16_t* Bt; int M, N, K; };

struct StaticOrder {
    int nM, nN, nwg, G, c;
    __host__ __device__ void init(int M, int N, int G_, int c_) { nM = M / BM; nN = N / BM; nwg = nM * nN; G = G_; c = c_; }
    __host__ __device__ bool next(int i, Unit& u) const {
        const long L = (long)i * G + c; if (L >= nwg) return false;
        int wgid = (int)L; { const int q = nwg / NXCD, r = nwg % NXCD, xcd = wgid % NXCD, off = wgid / NXCD; wgid = (xcd < r ? xcd * (q + 1) : r * (q + 1) + (xcd - r) * q) + off; }
        const int nig = WGM * nN, gid = wgid / nig, fm = gid * WGM, gsz = (nM - fm) < WGM ? (nM - fm) : WGM;
        u.pm = fm + ((wgid % nig) % gsz); u.pn = (wgid % nig) / gsz; return true;
    }
    __device__ __forceinline__ void a_ready(const Unit&) const {}
    __device__ __forceinline__ void done(const Unit&) const {}
};

__device__ __forceinline__ unsigned cvt_pk_bf16(float lo, float hi) { unsigned r; asm volatile("v_cvt_pk_bf16_f32 %0, %1, %2" : "=v"(r) : "v"(lo), "v"(hi)); return r; }
typedef float f32x2 __attribute__((ext_vector_type(2)));
template <class Epi, class Sched, bool ALIGN_EPI = false, bool SP2 = false, bool FP8 = false>
__device__ __forceinline__ void gemm_phase(PG8_LAS unsigned char* lds, const Gemm g, const Sched& S, const Epi& E) {
    int tid_ = threadIdx.x; asm volatile("" : "+v"(tid_));
    const int tid = tid_, wid = __builtin_amdgcn_readfirstlane(tid >> 6), lane = tid & 63, wr = wid >> 2, wc = wid & 3, fr = lane & 15, fq = lane >> 4;
    const int K = g.K, nt = K / BK;
    unsigned voffA[2], voffB[2];
#pragma unroll
    for (int i = 0; i < 2; ++i) { int R, C; stage_rc(tid * 16 + i * 8192, R, C); const int Rb = Epi::PERM ? ((R & ~31) + perm32(R & 31)) : R;
        voffA[i] = (unsigned)(R * K + C) * 2u; voffB[i] = (unsigned)(Rb * K + C) * 2u; }
    const size_t kstep = (size_t)(BK * 2);
    const size_t hstep = (size_t)HALF * K * 2;
    const size_t tstep = 2 * hstep;
    const unsigned ldsw = (unsigned)wid * 1024u;
    const int aoff = lds_byte(wr * 64 + fr, fq * 8), boff = lds_byte(wc * 32 + fr, fq * 8);
#define PG8_SA(b, h) (((b) * 2 + (h)) * HTB)
#define PG8_SB(b, h) ((4 + (b) * 2 + (h)) * HTB)
#define PG8_STAGE(bufoff, gbase, voff) do { _Pragma("unroll") for (int _i = 0; _i < 2; ++_i) \
        __builtin_amdgcn_global_load_lds((const unsigned*)((const char*)(gbase) + (voff)[_i]), (PG8_LAS unsigned*)(lds + (bufoff) + ldsw + _i * 8192), 16, 0, 0); } while (0)
#define PG8_LD8(p) __builtin_shufflevector(*(const PG8_LAS i32x4_*)(p), *(const PG8_LAS i32x4_*)((p) + 1024), 0, 1, 2, 3, 4, 5, 6, 7)
#define PG8_LDA(dst, b, h) do { if constexpr (FP8) { _Pragma("unroll") for (int m = 0; m < 4; ++m) dst##8[m] = PG8_LD8(lds + PG8_SA(b, h) + aoff + m * 2048); } \
        else { _Pragma("unroll") for (int m = 0; m < 4; ++m) _Pragma("unroll") for (int k = 0; k < 2; ++k) dst[m][k] = *(const PG8_LAS bf16x8*)(lds + PG8_SA(b, h) + aoff + m * 2048 + k * 1024); } } while (0)
#define PG8_LDB(dst, b, h) do { if constexpr (FP8) { _Pragma("unroll") for (int n = 0; n < 2; ++n) dst##8[n] = PG8_LD8(lds + PG8_SB(b, h) + boff + n * 2048); } \
        else { _Pragma("unroll") for (int n = 0; n < 2; ++n) _Pragma("unroll") for (int k = 0; k < 2; ++k) dst[n][k] = *(const PG8_LAS bf16x8*)(lds + PG8_SB(b, h) + boff + n * 2048 + k * 1024); } } while (0)
#define PG8_MMA(ai, bj, At, Bt) do { __builtin_amdgcn_s_setprio(1); _Pragma("unroll") for (int m = 0; m < 4; ++m) _Pragma("unroll") for (int n = 0; n < 2; ++n) { \
        if constexpr (FP8) asm volatile("v_mfma_scale_f32_16x16x128_f8f6f4 %0, %1, %2, %0, %3, %3 op_sel_hi:[0,0,0]" : "+v"(acc[ai][bj][m][n]) : "v"(Bt##8[n]), "v"(At##8[m]), "v"(sc1_)); \
        else { _Pragma("unroll") for (int k = 0; k < 2; ++k) acc[ai][bj][m][n] = __builtin_amdgcn_mfma_f32_16x16x32_bf16(Bt[n][k], At[m][k], acc[ai][bj][m][n], 0, 0, 0); } } \
        __builtin_amdgcn_s_setprio(0); } while (0)
#define PG8_WAIT_V(n) asm volatile("s_waitcnt vmcnt(" #n ")" ::: "memory")
#define PG8_WAIT_L(n) asm volatile("s_waitcnt lgkmcnt(" #n ")" ::: "memory")
#define PG8_BAR __builtin_amdgcn_s_barrier()
#define PG8_SCHED __builtin_amdgcn_sched_barrier(0)
    Unit cur, nxt; int ui = 0;
    if (!S.next(0, cur)) return;
    f32x4 acc[2][2][4][2];
#pragma unroll
    for (int a = 0; a < 2; ++a)
#pragma unroll
        for (int b = 0; b < 2; ++b)
#pragma unroll
            for (int m = 0; m < 4; ++m)
#pragma unroll
                for (int n = 0; n < 2; ++n) acc[a][b][m][n] = (f32x4){0.f, 0.f, 0.f, 0.f};
    typedef int i32x4_ __attribute__((ext_vector_type(4))); typedef int i32x8_ __attribute__((ext_vector_type(8)));
    int sc1_ = 0x7F7F7F7F; asm volatile("" : "+v"(sc1_));
    bf16x8 At[4][2], B0[2][2], B1[2][2]; i32x8_ At8[4], B08[2], B18[2];
    const char* cA = (const char*)g.A + (size_t)cur.pm * tstep; const char* cB = (const char*)g.Bt + (size_t)cur.pn * tstep;
    S.a_ready(cur);
    if constexpr (SP2) {
        PG8_STAGE(PG8_SB(0, 0), cB, voffB); PG8_STAGE(PG8_SB(0, 1), cB + hstep, voffB); PG8_STAGE(PG8_SA(0, 0), cA, voffA); PG8_STAGE(PG8_SA(0, 1), cA + hstep, voffA);
        if (wr == 1) PG8_BAR;
        PG8_WAIT_V(2); PG8_BAR;
        PG8_STAGE(PG8_SB(1, 0), cB + kstep, voffB); PG8_STAGE(PG8_SA(1, 0), cA + kstep, voffA); PG8_STAGE(PG8_SB(1, 1), cB + hstep + kstep, voffB);
        PG8_WAIT_V(6); PG8_BAR;
    } else {
        PG8_STAGE(PG8_SB(0, 0), cB, voffB); PG8_STAGE(PG8_SA(0, 0), cA, voffA); PG8_STAGE(PG8_SB(0, 1), cB + hstep, voffB); PG8_STAGE(PG8_SA(0, 1), cA + hstep, voffA);
        if (wr == 1) PG8_BAR;
        PG8_WAIT_V(4); PG8_BAR;
        PG8_STAGE(PG8_SB(1, 0), cB + kstep, voffB); PG8_STAGE(PG8_SA(1, 0), cA + kstep, voffA); PG8_STAGE(PG8_SB(1, 1), cB + hstep + kstep, voffB);
        PG8_WAIT_V(6); PG8_BAR;
    }
    for (;;) {
        const bool has_next = S.next(ui + 1, nxt);
        const char* nA = has_next ? (const char*)g.A + (size_t)nxt.pm * tstep : cA; const char* nB = has_next ? (const char*)g.Bt + (size_t)nxt.pn * tstep : cB;
        for (int t = 0; t < nt; t += 2) {
            const bool last = (t == nt - 2);
            const char* a1 = cA + (size_t)(t + 1) * kstep;
            const char* a2 = last ? nA : cA + (size_t)(t + 2) * kstep; const char* b2 = last ? nB : cB + (size_t)(t + 2) * kstep;
            const char* a3 = a2 + kstep; const char* b3 = b2 + kstep;
            if (last && has_next) S.a_ready(nxt);
            if constexpr (SP2) {
            PG8_LDB(B0, 0, 0); PG8_LDB(B1, 0, 1); PG8_SCHED; PG8_LDA(At, 0, 0); PG8_STAGE(PG8_SA(1, 1), a1 + hstep, voffA);
            PG8_WAIT_V(8); PG8_WAIT_L(0); PG8_BAR; PG8_MMA(0, 0, At, B0); PG8_MMA(0, 1, At, B1); PG8_BAR; PG8_SCHED;
            PG8_LDA(At, 0, 1); PG8_STAGE(PG8_SB(0, 0), b2, voffB); PG8_STAGE(PG8_SB(0, 1), b2 + hstep, voffB); PG8_STAGE(PG8_SA(0, 0), a2, voffA);
            PG8_WAIT_V(8); PG8_WAIT_L(0); PG8_BAR; PG8_MMA(1, 0, At, B0); PG8_MMA(1, 1, At, B1); PG8_BAR; PG8_SCHED;
            PG8_LDB(B0, 1, 0); PG8_LDB(B1, 1, 1); PG8_SCHED; PG8_LDA(At, 1, 0); PG8_STAGE(PG8_SA(0, 1), a2 + hstep, voffA);
            PG8_WAIT_V(8); PG8_WAIT_L(0); PG8_BAR; PG8_MMA(0, 0, At, B0); PG8_MMA(0, 1, At, B1); PG8_BAR; PG8_SCHED;
            PG8_LDA(At, 1, 1); PG8_STAGE(PG8_SB(1, 0), b3, voffB); PG8_STAGE(PG8_SB(1, 1), b3 + hstep, voffB); PG8_STAGE(PG8_SA(1, 0), a3, voffA);
            PG8_WAIT_V(8); PG8_WAIT_L(0); PG8_BAR; PG8_MMA(1, 0, At, B0); PG8_MMA(1, 1, At, B1); PG8_BAR; PG8_SCHED;
            } else {
            PG8_LDB(B0, 0, 0); PG8_SCHED; PG8_LDA(At, 0, 0); PG8_STAGE(PG8_SA(1, 1), a1 + hstep, voffA);
            PG8_WAIT_L(8); PG8_BAR; PG8_WAIT_L(0); PG8_MMA(0, 0, At, B0); PG8_BAR; PG8_SCHED;
            PG8_LDB(B1, 0, 1); PG8_STAGE(PG8_SB(0, 0), b2, voffB);
            PG8_BAR; PG8_WAIT_L(0); PG8_MMA(0, 1, At, B1); PG8_BAR;
            PG8_LDA(At, 0, 1); PG8_STAGE(PG8_SA(0, 0), a2, voffA);
            PG8_BAR; PG8_WAIT_L(0); PG8_MMA(1, 0, At, B0); PG8_BAR; PG8_SCHED;
            PG8_STAGE(PG8_SB(0, 1), b2 + hstep, voffB);
            PG8_WAIT_V(6); PG8_BAR; PG8_MMA(1, 1, At, B1); PG8_BAR;
            PG8_LDB(B0, 1, 0); PG8_SCHED; PG8_LDA(At, 1, 0); PG8_STAGE(PG8_SA(0, 1), a2 + hstep, voffA);
            PG8_WAIT_L(8); PG8_BAR; PG8_WAIT_L(0); PG8_MMA(0, 0, At, B0); PG8_BAR; PG8_SCHED;
            PG8_LDB(B1, 1, 1); PG8_STAGE(PG8_SB(1, 0), b3, voffB);
            PG8_BAR; PG8_WAIT_L(0); PG8_MMA(0, 1, At, B1); PG8_BAR;
            PG8_LDA(At, 1, 1); PG8_STAGE(PG8_SA(1, 0), a3, voffA);
            PG8_BAR; PG8_WAIT_L(0); PG8_MMA(1, 0, At, B0); PG8_BAR; PG8_SCHED;
            PG8_STAGE(PG8_SB(1, 1), b3 + hstep, voffB);
            PG8_WAIT_V(6); PG8_BAR; PG8_MMA(1, 1, At, B1); PG8_BAR;
            }
        }
        if constexpr (ALIGN_EPI) { if (wr == 0) PG8_BAR; }
        if constexpr (FP8) asm volatile("s_nop 15\n\ts_nop 15" ::: "memory");
        if constexpr (!Epi::AFTER_DRAIN) { E(acc, cur, wr, wc, fr, fq); S.done(cur); }
        if (!has_next) break;
#pragma unroll
        for (int a = 0; a < 2; ++a)
#pragma unroll
            for (int b = 0; b < 2; ++b)
#pragma unroll
                for (int m = 0; m < 4; ++m)
#pragma unroll
                    for (int n = 0; n < 2; ++n) acc[a][b][m][n] = (f32x4){0.f, 0.f, 0.f, 0.f};
        cur = nxt; cA = nA; cB = nB; ++ui;
        if constexpr (ALIGN_EPI) { if (wr == 1) PG8_BAR; }
    }
    PG8_WAIT_V(0);
    if constexpr (!ALIGN_EPI) { if (wr == 0) PG8_BAR; }
    PG8_BAR;
    if constexpr (Epi::AFTER_DRAIN) { E.fused(acc, cur, wr, wc, fr, fq, lds, wid, lane); S.done(cur); }
#undef PG8_SA
#undef PG8_SB
#undef PG8_STAGE
#undef PG8_LDA
#undef PG8_LD8
#undef PG8_LDB
#undef PG8_MMA
#undef PG8_WAIT_V
#undef PG8_WAIT_L
#undef PG8_BAR
#undef PG8_SCHED
}
}
namespace pg8 {
typedef unsigned u32x2 __attribute__((ext_vector_type(2)));
constexpr int LDX = 2048;
constexpr float RMS_EPS = 1e-6f;
#ifndef EPI_SC1
#define EPI_SC1 1
#endif
__device__ __forceinline__ void store16(void* p, u32x4 w) {
#if EPI_SC1
    asm volatile("global_store_dwordx4 %0, %1, off sc1\n\ts_nop 1" :: "v"(p), "v"(w) : "memory");
#else
    *(u32x4*)p = w;
#endif
}
struct EpiQKV {
    static constexpr bool PERM = true, AFTER_DRAIN = false;
    bf16_t* O; const float* cs; float qscale; float* ksum; int vmode; float vscale;
    __device__ __forceinline__ void operator()(const f32x4 (&acc)[2][2][4][2], const Unit& u, int wr, int wc, int fr, int fq) const {
        const int row0 = u.pm * BM + wr * 64 + fr, pn = vmode ? (u.pn < 4 ? u.pn + 8 : u.pn + 16) : (u.pn < 8 ? u.pn : u.pn + 4);
        const float sc = (pn < 4 || (pn >= 12 && pn < 16)) ? qscale : vscale;
        const bool rot = (pn >= 12 && pn < 20) && (wc == 0);
        bf16_t* Ot = O + ((size_t)((u.pm >> 3) * 6 + (pn >> 2)) * 8 + (pn & 3) * 2) * (2048 * 128) + wc * 32 + 8 * fq;
        const bool kacc = (pn >= 16 && pn < 20);
        f32x4 ks[2][2] = {{{0.f, 0.f, 0.f, 0.f}, {0.f, 0.f, 0.f, 0.f}}, {{0.f, 0.f, 0.f, 0.f}, {0.f, 0.f, 0.f, 0.f}}};
#pragma unroll
        for (int ai = 0; ai < 2; ++ai)
#pragma unroll
            for (int m = 0; m < 4; ++m) { const int row = row0 + ai * HALF + m * 16; bf16_t* rowp = Ot + (size_t)(row & 2047) * 128;
                f32x4 c0 = {1.f, 1.f, 1.f, 1.f}, c1 = c0, s0 = {0.f, 0.f, 0.f, 0.f}, s1 = s0;
                if (rot) { const float* cr = cs + (size_t)row * 32 + 8 * (fq & 1); c0 = *(const f32x4*)cr; c1 = *(const f32x4*)(cr + 4); s0 = *(const f32x4*)(cr + 16); s1 = *(const f32x4*)(cr + 20);
                    if (fq < 2) { s0 = -s0; s1 = -s1; } }
#pragma unroll
                for (int bj = 0; bj < 2; ++bj) { f32x4 v0 = acc[ai][bj][m][0], v1 = acc[ai][bj][m][1];
                    if (rot) { f32x4 p0, p1;
#pragma unroll
                        for (int j = 0; j < 4; ++j) { p0[j] = __shfl_xor(v0[j], 32); p1[j] = __shfl_xor(v1[j], 32); }
                        v0 = v0 * c0 + p0 * s0; v1 = v1 * c1 + p1 * s1; }
                    if (kacc) { ks[bj][0] += v0; ks[bj][1] += v1; }
                    v0 = v0 * sc; v1 = v1 * sc; u32x4 w; w.x = cvt_pk_bf16(v0[0], v0[1]); w.y = cvt_pk_bf16(v0[2], v0[3]); w.z = cvt_pk_bf16(v1[0], v1[1]); w.w = cvt_pk_bf16(v1[2], v1[3]);
                    store16(rowp + (size_t)bj * (2048 * 128), w); } }
        if (kacc) {
            float* kp = ksum + (size_t)(((u.pm >> 3) * 8 + (pn - 16) * 2) * 8 + (u.pm & 7)) * 128 + wc * 32 + 8 * fq;
#pragma unroll
            for (int bj = 0; bj < 2; ++bj)
#pragma unroll
                for (int n = 0; n < 2; ++n)
#pragma unroll
                    for (int j = 0; j < 4; ++j) { float s = ks[bj][n][j]; s += __shfl_xor(s, 1); s += __shfl_xor(s, 2); s += __shfl_xor(s, 4); s += __shfl_xor(s, 8);
                        if (fr == 0) atomicAdd(kp + bj * 1024 + n * 4 + j, s); }
        }
    }
};
__device__ __forceinline__ unsigned pk4_fp8(float a, float b, float c, float d) {
    a = __builtin_amdgcn_fmed3f(a, -448.f, 448.f); b = __builtin_amdgcn_fmed3f(b, -448.f, 448.f); c = __builtin_amdgcn_fmed3f(c, -448.f, 448.f); d = __builtin_amdgcn_fmed3f(d, -448.f, 448.f);
    int p = __builtin_amdgcn_cvt_pk_fp8_f32(a, b, 0, false); p = __builtin_amdgcn_cvt_pk_fp8_f32(c, d, p, true); return (unsigned)p; }
struct EpiRes {
    static constexpr bool PERM = false, AFTER_DRAIN = false;
    const float* base; float* out; bf16_t* xb; float* ssq; unsigned char* x8; float s8; float ascale;
    __device__ __forceinline__ void operator()(const f32x4 (&acc)[2][2][4][2], const Unit& u, int wr, int wc, int fr, int fq) const {
        const int row0 = u.pm * BM + wr * 64 + fr, col0 = u.pn * BM + wc * 32 + 4 * fq;
#pragma unroll
        for (int ai = 0; ai < 2; ++ai)
#pragma unroll
            for (int m = 0; m < 4; ++m) { const int row = row0 + ai * HALF + m * 16; const size_t off = (size_t)row * LDX + col0; float s = 0.f;
#pragma unroll
                for (int bj = 0; bj < 2; ++bj)
#pragma unroll
                    for (int n = 0; n < 2; ++n) { const f32x4 v = *(const f32x4*)(base + off + bj * HALF + n * 16) + acc[ai][bj][m][n] * ascale;
                        *(f32x4*)(out + off + bj * HALF + n * 16) = v; s += (v[0] * v[0] + v[1] * v[1]) + (v[2] * v[2] + v[3] * v[3]);
                        if (xb) { u32x2 w; w.x = cvt_pk_bf16(v[0], v[1]); w.y = cvt_pk_bf16(v[2], v[3]); *(u32x2*)(xb + off + bj * HALF + n * 16) = w; }
                        if (x8) { *(unsigned*)(x8 + off + bj * HALF + n * 16) = pk4_fp8(v[0] * s8, v[1] * s8, v[2] * s8, v[3] * s8); } }
                if (ssq) { s += __shfl_xor(s, 16); s += __shfl_xor(s, 32); if (fq == 0) atomicAdd(ssq + row, s); }
                asm volatile("" ::: "memory"); }
    }
};
template <bool BASE_F32> struct EpiResB {
    static constexpr bool PERM = true, AFTER_DRAIN = false;
    const void* base; bf16_t* xo; float* ssq; unsigned char* x8; float s8; float ascale;
    __device__ __forceinline__ void operator()(const f32x4 (&acc)[2][2][4][2], const Unit& u, int wr, int wc, int fr, int fq) const {
        const int row0 = u.pm * BM + wr * 64 + fr, col0 = u.pn * BM + wc * 32 + 8 * fq;
#pragma unroll
        for (int ai = 0; ai < 2; ++ai)
#pragma unroll
            for (int m = 0; m < 4; ++m) { const int row = row0 + ai * HALF + m * 16; const size_t off = (size_t)row * LDX + col0; float s = 0.f;
#pragma unroll
                for (int bj = 0; bj < 2; ++bj) { f32x4 b0, b1;
                    if (BASE_F32) { const float* bp = (const float*)base + off + bj * HALF; b0 = *(const f32x4*)bp; b1 = *(const f32x4*)(bp + 4); }
                    else { const u32x4 w = *(const u32x4*)((const bf16_t*)base + off + bj * HALF);
                        b0 = (f32x4){__uint_as_float(w.x << 16), __uint_as_float(w.x & 0xffff0000u), __uint_as_float(w.y << 16), __uint_as_float(w.y & 0xffff0000u)};
                        b1 = (f32x4){__uint_as_float(w.z << 16), __uint_as_float(w.z & 0xffff0000u), __uint_as_float(w.w << 16), __uint_as_float(w.w & 0xffff0000u)}; }
                    const f32x4 v0 = b0 + acc[ai][bj][m][0] * ascale, v1 = b1 + acc[ai][bj][m][1] * ascale;
                    s += ((v0[0] * v0[0] + v0[1] * v0[1]) + (v0[2] * v0[2] + v0[3] * v0[3])) + ((v1[0] * v1[0] + v1[1] * v1[1]) + (v1[2] * v1[2] + v1[3] * v1[3]));
                    if (xo) { u32x4 w; w.x = cvt_pk_bf16(v0[0], v0[1]); w.y = cvt_pk_bf16(v0[2], v0[3]); w.z = cvt_pk_bf16(v1[0], v1[1]); w.w = cvt_pk_bf16(v1[2], v1[3]); *(u32x4*)(xo + off + bj * HALF) = w; }
                    if (x8) { u32x2 w8; w8.x = pk4_fp8(v0[0] * s8, v0[1] * s8, v0[2] * s8, v0[3] * s8); w8.y = pk4_fp8(v1[0] * s8, v1[1] * s8, v1[2] * s8, v1[3] * s8); *(u32x2*)(x8 + off + bj * HALF) = w8; } }
                if (ssq) { s += __shfl_xor(s, 16); s += __shfl_xor(s, 32); if (fq == 0) atomicAdd(ssq + row, s); }
                if (BASE_F32 ? (m & 1) : (m == 3)) asm volatile("" ::: "memory"); }
    }
};
struct EpiScale {
    static constexpr bool PERM = true, AFTER_DRAIN = false;
    bf16_t* O; int ldc; const float* ssq; float sc;
    __device__ __forceinline__ void operator()(const f32x4 (&acc)[2][2][4][2], const Unit& u, int wr, int wc, int fr, int fq) const {
        const int row0 = u.pm * BM + wr * 64 + fr, col0 = u.pn * BM + wc * 32 + 8 * fq;
        float sv[2][4];
#pragma unroll
        for (int ai = 0; ai < 2; ++ai)
#pragma unroll
            for (int m = 0; m < 4; ++m) sv[ai][m] = ssq ? ssq[row0 + ai * HALF + m * 16] : 0.f;
#pragma unroll
        for (int ai = 0; ai < 2; ++ai)
#pragma unroll
            for (int m = 0; m < 4; ++m) { const int row = row0 + ai * HALF + m * 16; bf16_t* rowp = O + (size_t)row * ldc + col0;
                const float f = ssq ? sc * __builtin_amdgcn_rsqf(sv[ai][m] * (1.0f / 2048.0f) + RMS_EPS) : sc;
#pragma unroll
                for (int bj = 0; bj < 2; ++bj) { const f32x4 v0 = acc[ai][bj][m][0] * f, v1 = acc[ai][bj][m][1] * f;
                    u32x4 w; w.x = cvt_pk_bf16(v0[0], v0[1]); w.y = cvt_pk_bf16(v0[2], v0[3]); w.z = cvt_pk_bf16(v1[0], v1[1]); w.w = cvt_pk_bf16(v1[2], v1[3]);
                    *(u32x4*)(rowp + bj * HALF) = w; } }
    }
};
struct EpiNull { static constexpr bool PERM = true, AFTER_DRAIN = false; float* sink;
    __device__ __forceinline__ void operator()(const f32x4 (&acc)[2][2][4][2], const Unit& u, int wr, int wc, int fr, int fq) const {
#pragma unroll
        for (int ai = 0; ai < 2; ++ai)
#pragma unroll
            for (int bj = 0; bj < 2; ++bj)
#pragma unroll
                for (int m = 0; m < 4; ++m)
#pragma unroll
                    for (int n = 0; n < 2; ++n) asm volatile("" :: "v"(acc[ai][bj][m][n])); } };
struct EpiSwiGLU {
    static constexpr bool PERM = true, AFTER_DRAIN = false;
    bf16_t* O; const float* ssq; unsigned char* O8; float ascale, oscale;
    __device__ __forceinline__ void operator()(const f32x4 (&acc)[2][2][4][2], const Unit& u, int wr, int wc, int fr, int fq) const {
        const int row0 = u.pm * BM + wr * 64 + fr, col0 = u.pn * HALF + wc * 32 + 8 * fq;
        float sv[2][4];
#pragma unroll
        for (int ai = 0; ai < 2; ++ai)
#pragma unroll
            for (int m = 0; m < 4; ++m) sv[ai][m] = ssq[row0 + ai * HALF + m * 16];
#pragma unroll
        for (int ai = 0; ai < 2; ++ai)
#pragma unroll
            for (int m = 0; m < 4; ++m) { const int row = row0 + ai * HALF + m * 16; bf16_t* rowp = O + (size_t)row * 5632 + col0;
                const float f = ascale * __builtin_amdgcn_rsqf(sv[ai][m] * (1.0f / 2048.0f) + RMS_EPS);
                float r[8];
#pragma unroll
                for (int n = 0; n < 2; ++n)
#pragma unroll
                    for (int j = 0; j < 4; ++j) { const float g = acc[ai][0][m][n][j] * f, uu = acc[ai][1][m][n][j] * f;
                        const float sg = g * __builtin_amdgcn_rcpf(1.0f + __builtin_amdgcn_exp2f(-1.4426950408889634f * g)); r[n * 4 + j] = sg * uu; }
                if (O8) { u32x2 w8; w8.x = pk4_fp8(r[0] * oscale, r[1] * oscale, r[2] * oscale, r[3] * oscale); w8.y = pk4_fp8(r[4] * oscale, r[5] * oscale, r[6] * oscale, r[7] * oscale);
                    *(u32x2*)(O8 + (size_t)row * 5632 + col0) = w8; }
                else { u32x4 w; w.x = cvt_pk_bf16(r[0], r[1]); w.y = cvt_pk_bf16(r[2], r[3]); w.z = cvt_pk_bf16(r[4], r[5]); w.w = cvt_pk_bf16(r[6], r[7]);
                *(u32x4*)rowp = w; } }
    }
};
}
namespace att {
using bf16x8 = __attribute__((ext_vector_type(8))) short;
using s16x4  = __attribute__((ext_vector_type(4))) short;
using f32x16 = __attribute__((ext_vector_type(16))) float;
using f32x4  = __attribute__((ext_vector_type(4))) float;
using u32x4  = __attribute__((ext_vector_type(4))) unsigned;
typedef unsigned short bf16;
constexpr int D = 128, KVBLK = 64;
constexpr int SHM_V = KVBLK * D * 2, SHM_K = KVBLK * D * 2;
constexpr int OFF_Q = 2 * SHM_V + 2 * SHM_K, OFF_WS = 131072 + 1024, OFF_KM = OFF_WS + 2048, ATT_LDS = OFF_KM + 4096;
constexpr float THR = 8.f;
constexpr float SB_DONE = 7.8886e-31f;
#ifndef QREG_SOFTMAX
#define QREG_SOFTMAX 1
#endif
#ifndef PIPE_SOFTMAX
#define PIPE_SOFTMAX 0
#endif
#define KSWZ(row, colB) ((row) * 256 + ((colB) ^ (((row) & 7) << 4)))
#define SBAR() __builtin_amdgcn_sched_barrier(0)
__device__ __forceinline__ int crow(int r, int hi) { return (r & 3) + 8 * (r >> 2) + 4 * hi; }
__device__ __forceinline__ unsigned cvtpk(float lo, float hi) { unsigned r; asm volatile("v_cvt_pk_bf16_f32 %0, %1, %2" : "=v"(r) : "v"(lo), "v"(hi)); return r; }
__device__ __forceinline__ float xchg32(float x, int hi) { auto rr = __builtin_amdgcn_permlane32_swap(__float_as_uint(x), __float_as_uint(x), false, false); return __uint_as_float(hi ? rr[0] : rr[1]); }
typedef __attribute__((address_space(3))) const char* lds_cp;
template <int D0> __device__ __forceinline__ void qkt_part(f32x16& p0, f32x16& p1, const lds_cp (&ka)[2][4], int boff, const lds_cp (&qa)[2][4]) {
  const bf16x8 qf = *reinterpret_cast<const __attribute__((address_space(3))) bf16x8*>(qa[D0 >> 2][D0 & 3]);
  const bf16x8 b0 = *reinterpret_cast<const __attribute__((address_space(3))) bf16x8*>(ka[D0 >> 2][D0 & 3] + boff);
  const bf16x8 b1 = *reinterpret_cast<const __attribute__((address_space(3))) bf16x8*>(ka[D0 >> 2][D0 & 3] + boff + 8192);
  p0 = __builtin_amdgcn_mfma_f32_32x32x16_bf16(b0, qf, p0, 0, 0, 0);
  p1 = __builtin_amdgcn_mfma_f32_32x32x16_bf16(b1, qf, p1, 0, 0, 0);
}
template <int D0> __device__ __forceinline__ void qkt_part(f32x16& p0, f32x16& p1, const lds_cp (&ka)[2][4], int boff, const bf16x8 (&qg)[8]) {
  const bf16x8 b0 = *reinterpret_cast<const __attribute__((address_space(3))) bf16x8*>(ka[D0 >> 2][D0 & 3] + boff);
  const bf16x8 b1 = *reinterpret_cast<const __attribute__((address_space(3))) bf16x8*>(ka[D0 >> 2][D0 & 3] + boff + 8192);
  p0 = __builtin_amdgcn_mfma_f32_32x32x16_bf16(b0, qg[D0], p0, 0, 0, 0);
  p1 = __builtin_amdgcn_mfma_f32_32x32x16_bf16(b1, qg[D0], p1, 0, 0, 0);
}
__device__ __forceinline__ void qkt(f32x16& p0, f32x16& p1, const lds_cp (&ka)[2][4], int boff, const bf16x8 (&qg)[8], float bias = 0.f) {
#pragma unroll
  for (int r = 0; r < 16; ++r) { p0[r] = bias; p1[r] = bias; }
  qkt_part<0>(p0, p1, ka, boff, qg); qkt_part<1>(p0, p1, ka, boff, qg); qkt_part<2>(p0, p1, ka, boff, qg); qkt_part<3>(p0, p1, ka, boff, qg);
  qkt_part<4>(p0, p1, ka, boff, qg); qkt_part<5>(p0, p1, ka, boff, qg); qkt_part<6>(p0, p1, ka, boff, qg); qkt_part<7>(p0, p1, ka, boff, qg);
}
__device__ __forceinline__ void qkt(f32x16& p0, f32x16& p1, const lds_cp (&ka)[2][4], int boff, const lds_cp (&qr)[2][4], float bias = 0.f) {
#pragma unroll
  for (int r = 0; r < 16; ++r) { p0[r] = bias; p1[r] = bias; }
  qkt_part<0>(p0, p1, ka, boff, qr); qkt_part<1>(p0, p1, ka, boff, qr); qkt_part<2>(p0, p1, ka, boff, qr); qkt_part<3>(p0, p1, ka, boff, qr);
  qkt_part<4>(p0, p1, ka, boff, qr); qkt_part<5>(p0, p1, ka, boff, qr); qkt_part<6>(p0, p1, ka, boff, qr); qkt_part<7>(p0, p1, ka, boff, qr);
}
__device__ __forceinline__ int v_st(int k, int c) { const int kk = (k & ~0xC) | ((k & 4) << 1) | ((k & 8) >> 1); return ((kk >> 3) * 4 + (c >> 5)) * 512 + ((kk & 7) * 32 + (c & 31)) * 2; }
__device__ __forceinline__ int v_rd_base(int lane) { return ((lane & 3) << 3) | (((lane >> 2) & 3) << 6) | (((lane >> 4) & 1) << 5) | (((lane >> 5) & 1) << 8); }
constexpr int v_rd_off(int d0, int ks, int half) { return d0 * 512 + ks * 4096 + half * 2048; }
template <int OFF> __device__ __forceinline__ s16x4 tr_read(int vb) { s16x4 r; asm volatile("ds_read_b64_tr_b16 %0, %1 offset:%2" : "=&v"(r) : "v"(vb), "i"(OFF) : "memory"); return r; }
struct VFrag { s16x4 l0, h0, l1, h1, l2, h2, l3, h3; };
template <int D0> __device__ __forceinline__ void v_read(VFrag& f, int vb) {
  f.l0 = tr_read<v_rd_off(D0, 0, 0)>(vb); f.h0 = tr_read<v_rd_off(D0, 0, 1)>(vb); f.l1 = tr_read<v_rd_off(D0, 1, 0)>(vb); f.h1 = tr_read<v_rd_off(D0, 1, 1)>(vb);
  f.l2 = tr_read<v_rd_off(D0, 2, 0)>(vb); f.h2 = tr_read<v_rd_off(D0, 2, 1)>(vb); f.l3 = tr_read<v_rd_off(D0, 3, 0)>(vb); f.h3 = tr_read<v_rd_off(D0, 3, 1)>(vb);
}
__device__ __forceinline__ void pv_mma(f32x16& od, const VFrag& f, bf16x8 pa0, bf16x8 pa1, bf16x8 pa2, bf16x8 pa3) {
#define PK(L, H) (bf16x8){L[0], L[1], L[2], L[3], H[0], H[1], H[2], H[3]}
  od = __builtin_amdgcn_mfma_f32_32x32x16_bf16(pa0, PK(f.l0, f.h0), od, 0, 0, 0);
  od = __builtin_amdgcn_mfma_f32_32x32x16_bf16(pa1, PK(f.l1, f.h1), od, 0, 0, 0);
  od = __builtin_amdgcn_mfma_f32_32x32x16_bf16(pa2, PK(f.l2, f.h2), od, 0, 0, 0);
  od = __builtin_amdgcn_mfma_f32_32x32x16_bf16(pa3, PK(f.l3, f.h3), od, 0, 0, 0);
#undef PK
}
__device__ __forceinline__ void pv_d0(f32x16* o, int vb, bf16x8 pa0, bf16x8 pa1, bf16x8 pa2, bf16x8 pa3) {
  VFrag fa, fb;
  v_read<0>(fa, vb);
  v_read<1>(fb, vb); asm volatile("s_waitcnt lgkmcnt(8)" ::: "memory"); SBAR(); pv_mma(o[0], fa, pa0, pa1, pa2, pa3); SBAR();
  v_read<2>(fa, vb); asm volatile("s_waitcnt lgkmcnt(8)" ::: "memory"); SBAR(); pv_mma(o[1], fb, pa0, pa1, pa2, pa3); SBAR();
  v_read<3>(fb, vb); asm volatile("s_waitcnt lgkmcnt(8)" ::: "memory"); SBAR(); pv_mma(o[2], fa, pa0, pa1, pa2, pa3); SBAR();
  asm volatile("s_waitcnt lgkmcnt(0)" ::: "memory"); SBAR(); pv_mma(o[3], fb, pa0, pa1, pa2, pa3);
}
__device__ __forceinline__ void pack_p(const f32x16& p0, const f32x16& p1, bf16x8& pa0, bf16x8& pa1, bf16x8& pa2, bf16x8& pa3) {
#define PK4(P, BASE, OUT) do { unsigned a0 = cvtpk(P[BASE + 0], P[BASE + 1]), a1 = cvtpk(P[BASE + 2], P[BASE + 3]);   \
    unsigned b0 = cvtpk(P[BASE + 4], P[BASE + 5]), b1 = cvtpk(P[BASE + 6], P[BASE + 7]);                              \
    auto r0 = __builtin_amdgcn_permlane32_swap(a0, b0, false, false); auto r1 = __builtin_amdgcn_permlane32_swap(a1, b1, false, false); \
    u32x4 w = {r0[0], r1[0], r0[1], r1[1]}; OUT = *reinterpret_cast<bf16x8*>(&w); } while (0)
  PK4(p0, 0, pa0); PK4(p0, 8, pa1); PK4(p1, 0, pa2); PK4(p1, 8, pa3);
#undef PK4
}
__device__ __forceinline__ void softmax_tile(f32x16& p0, f32x16& p1, float& m_reg, float& l_reg, float& alpha) {
  float pmax = p0[0];
#pragma unroll
  for (int r = 1; r < 16; ++r) pmax = fmaxf(pmax, p0[r]);
#pragma unroll
  for (int r = 0; r < 16; ++r) pmax = fmaxf(pmax, p1[r]);
  pmax = fmaxf(pmax, xchg32(pmax, (int)(threadIdx.x >> 5) & 1));
  if (__all(pmax - m_reg <= THR)) { alpha = 1.f; }
  else { const float mn = fmaxf(m_reg, pmax); alpha = __builtin_amdgcn_exp2f(m_reg - mn); m_reg = mn; }
  float ps = 0.f;
#pragma unroll
  for (int r = 0; r < 16; ++r) { p0[r] = __builtin_amdgcn_exp2f(p0[r] - m_reg); ps += p0[r]; }
#pragma unroll
  for (int r = 0; r < 16; ++r) { p1[r] = __builtin_amdgcn_exp2f(p1[r] - m_reg); ps += p1[r]; }
  ps += xchg32(ps, (int)(threadIdx.x >> 5) & 1);
  l_reg = l_reg * alpha + ps;
}
template <bool BAND, int I> __device__ __forceinline__ float sb_group(f32x16& P, int kb, int qrel, int hi) {
  float run = 1.f;
#pragma unroll
  for (int e = 3; e >= 0; --e) { const int r = 4 * I + e; float rr = __builtin_amdgcn_rcpf(1.0f + __builtin_amdgcn_exp2f(P[r]));
    if (BAND) rr = (kb + crow(r, hi) < qrel) ? rr : 1.f;
    P[r] = (1.0f - rr) * run; run *= rr; }
  return run;
}
__device__ __forceinline__ void sb_combine(f32x16& p0, f32x16& p1, float (&gs)[8], float& carry, int hi) {
  float acc = 1.f;
#pragma unroll
  for (int i = 7; i >= 0; --i) { const float so_i = acc; acc *= gs[i]; const float x = hi ? acc : so_i; gs[i] = carry * so_i * xchg32(x, hi); }
  carry *= acc * xchg32(acc, hi);
#pragma unroll
  for (int i = 0; i < 4; ++i)
#pragma unroll
    for (int e = 0; e < 4; ++e) { p0[4 * i + e] *= gs[i]; p1[4 * i + e] *= gs[4 + i]; }
}
template <bool BAND>
__device__ __forceinline__ void sb_tile(f32x16& p0, f32x16& p1, float& carry, int kb, int qrel, int hi) {
  float gs[8];
  gs[0] = sb_group<BAND, 0>(p0, kb, qrel, hi); SBAR(); gs[1] = sb_group<BAND, 1>(p0, kb, qrel, hi); SBAR(); gs[2] = sb_group<BAND, 2>(p0, kb, qrel, hi); SBAR(); gs[3] = sb_group<BAND, 3>(p0, kb, qrel, hi); SBAR();
  gs[4] = sb_group<BAND, 0>(p1, kb + 32, qrel, hi); SBAR(); gs[5] = sb_group<BAND, 1>(p1, kb + 32, qrel, hi); SBAR(); gs[6] = sb_group<BAND, 2>(p1, kb + 32, qrel, hi); SBAR(); gs[7] = sb_group<BAND, 3>(p1, kb + 32, qrel, hi); SBAR();
  sb_combine(p0, p1, gs, carry, hi);
}

template <int MODE>
__device__ __forceinline__ void attn_unit(const bf16* __restrict__ Qb, int ldq, const bf16* __restrict__ Kh, const bf16* __restrict__ Vh, int ldk, bf16* __restrict__ Ob, int ldo,
                                          const float* __restrict__ gain, const float* __restrict__ kmean, int qb, int nkeys, char* lds) {
  int tid_ = threadIdx.x; asm volatile("" : "+v"(tid_));
  const int tid = tid_, wid = __builtin_amdgcn_readfirstlane(tid >> 6), lane = tid & 63, r32 = lane & 31, hi = lane >> 5;
  char* V_lds = lds; char* K_lds = lds + 2 * SHM_V;
  float* ws = (float*)(lds + OFF_WS) + wid * 64; float* li_l = ws; float* al_l = ws + 32;
  float* km_l = (float*)(lds + OFF_KM);
  int* flg = (int*)(lds + OFF_KM);
  const int NT = (MODE == 0) ? nkeys / KVBLK : 4 * (qb + 1);
  const int qrel = wid * 32 + r32;
  float m_reg = -1e30f, l_reg = 0.f, carry = 1.f; f32x16 o[4] = {};
  const int vb0 = (int)(uintptr_t)V_lds + v_rd_base(lane);
  lds_cp ka[2][4];
#pragma unroll
  for (int y = 0; y < 2; ++y)
#pragma unroll
    for (int x = 0; x < 4; ++x) ka[y][x] = (lds_cp)(__attribute__((address_space(3))) char*)K_lds + r32 * 256 + 128 * (y ^ ((r32 >> 3) & 1)) + 32 * (x ^ ((r32 >> 1) & 3)) + 16 * (hi ^ (r32 & 1));
  lds_cp qr[2][4];
#pragma unroll
  for (int y = 0; y < 2; ++y)
#pragma unroll
    for (int x = 0; x < 4; ++x) qr[y][x] = ka[y][x] + (OFF_Q - 2 * SHM_V) + wid * 8192;
  long ksrc[2], vsrc[2];
#pragma unroll
  for (int i = 0; i < 2; ++i) { const int piece = wid + 8 * i;
    { const int row = piece * 4 + (lane >> 4), c = (lane & 15) ^ (row & 15); ksrc[i] = (long)row * ldk + c * 8; }
    { const int sub = piece * 2 + (lane >> 5), kk = (sub >> 2) * 8 + ((lane & 31) >> 2), k = (kk & ~0xC) | ((kk & 4) << 1) | ((kk & 8) >> 1), c = (sub & 3) * 32 + (lane & 3) * 8; vsrc[i] = (long)k * ldk + c; } }
  typedef __attribute__((address_space(3))) unsigned lds_u32;
  lds_u32* kdst = (lds_u32*)(__attribute__((address_space(3))) char*)(K_lds) + wid * 256; lds_u32* vdst = (lds_u32*)(__attribute__((address_space(3))) char*)(V_lds) + wid * 256;
#define TILE(it) ((MODE == 2) ? (NT - 1 - (it)) : (it))
#define DMA_K(k0, b) do { _Pragma("unroll") for (int i_ = 0; i_ < 2; ++i_) __builtin_amdgcn_global_load_lds((const unsigned*)(Kh + (long)(k0) * ldk + ksrc[i_]), kdst + (b) * (SHM_K / 4) + i_ * 2048, 16, 0, 0); } while (0)
#define DMA_V(k0, b) do { _Pragma("unroll") for (int i_ = 0; i_ < 2; ++i_) __builtin_amdgcn_global_load_lds((const unsigned*)(Vh + (long)(k0) * ldk + vsrc[i_]), vdst + (b) * (SHM_V / 4) + i_ * 2048, 16, 0, 0); } while (0)
#define SDRAIN() asm volatile("s_waitcnt vmcnt(0)" ::: "memory")
#define KSLOT(i_) ((i_) == 2 ? (OFF_Q - 2 * SHM_V) : (i_) * SHM_K)
#define VSLOT(i_) ((i_) == 2 ? (OFF_Q + SHM_K) : (i_) * SHM_V)
#define DMA_K3(k0, so) do { _Pragma("unroll") for (int i_ = 0; i_ < 2; ++i_) __builtin_amdgcn_global_load_lds((const unsigned*)(Kh + (long)(k0) * ldk + ksrc[i_]), kdst + (so) / 4 + i_ * 2048, 16, 0, 0); } while (0)
#define DMA_V3(k0, so) do { _Pragma("unroll") for (int i_ = 0; i_ < 2; ++i_) __builtin_amdgcn_global_load_lds((const unsigned*)(Vh + (long)(k0) * ldk + vsrc[i_]), vdst + (so) / 4 + i_ * 2048, 16, 0, 0); } while (0)
  { lds_u32* qdst = (lds_u32*)(__attribute__((address_space(3))) char*)(lds + OFF_Q) + wid * 2048;
#pragma unroll
    for (int i = 0; i < 8; ++i) { const int row = 4 * i + (lane >> 4), c = (lane & 15) ^ (row & 15);
      __builtin_amdgcn_global_load_lds((const unsigned*)(Qb + (long)(wid * 32 + row) * ldq + c * 8), qdst + i * 256, 16, 0, 0); } }
  DMA_K(TILE(0) * KVBLK, 0); DMA_V(TILE(0) * KVBLK, 0); if (MODE == 2 || PIPE_SOFTMAX) DMA_K(TILE(1) * KVBLK, 1);
  constexpr bool RING3 = (MODE != 2) && QREG_SOFTMAX && !PIPE_SOFTMAX;
  unsigned selmask = 0u;
  if (MODE == 1) { if (tid < 256) *(f32x4*)(km_l + tid * 4) = *(const f32x4*)(kmean + tid * 4); }
  SDRAIN();
  __syncthreads();
  if (MODE == 1) {
    float g[8];
#pragma unroll
    for (int n = 0; n < 8; ++n) g[n] = 0.f;
    { const int rh = (r32 >> 1) & 3, r3 = (r32 >> 3) & 1;
      const lds_cp qbase = qr[0][0] - 32 * rh - 128 * r3;
#pragma unroll 1
      for (int d0 = 0; d0 < 8; ++d0) {
        const bf16x8 qf = *reinterpret_cast<const __attribute__((address_space(3))) bf16x8*>(qbase + 32 * ((d0 & 3) ^ rh) + 128 * ((d0 >> 2) ^ r3));
        float q[8];
#pragma unroll
        for (int j = 0; j < 8; ++j) q[j] = __uint_as_float(((unsigned)(unsigned short)qf[j]) << 16);
        const float* kmp = km_l + d0 * 16 + hi * 8;
#pragma unroll
        for (int n = 0; n < 7; ++n) { const f32x4 k0v = *(const f32x4*)(kmp + n * 128), k1v = *(const f32x4*)(kmp + n * 128 + 4);
          g[n] += (q[0] * k0v[0] + q[1] * k0v[1]) + (q[2] * k0v[2] + q[3] * k0v[3]) + (q[4] * k1v[0] + q[5] * k1v[1]) + (q[6] * k1v[2] + q[7] * k1v[3]); }
      } }
#pragma unroll
    for (int n = 0; n < 7; ++n) { g[n] += xchg32(g[n], hi); if (n >= qb) g[n] = -INFINITY; }
    g[7] = -INFINITY;
#pragma unroll
    for (int n = 0; n < 7; ++n) { int cnt = 0;
#pragma unroll
      for (int mI = 0; mI < 7; ++mI) { if (mI != n) cnt += (g[mI] > g[n] || (g[mI] == g[n] && mI < n)) ? 1 : 0; }
      if (n < qb && cnt < 3) selmask |= (1u << n); }
  }
  bf16x8 qg[8];
  if (QREG_SOFTMAX && MODE != 2) {
#pragma unroll
    for (int d0 = 0; d0 < 8; ++d0) qg[d0] = *reinterpret_cast<const __attribute__((address_space(3))) bf16x8*>(qr[d0 >> 2][d0 & 3]); }
  int kc = KSLOT(0), kn = KSLOT(1), kn2 = KSLOT(2), vc = VSLOT(0), vn = VSLOT(1), vn2 = VSLOT(2);
  if (RING3) { DMA_K3(TILE(1) * KVBLK, kn); DMA_V3(TILE(1) * KVBLK, vn);
    asm volatile("s_waitcnt lgkmcnt(0)" ::: "memory"); __syncthreads(); }
  f32x16 pA0, pA1, pB0, pB1; bf16x8 pa0, pa1, pa2, pa3;
  if (MODE == 2 || PIPE_SOFTMAX) { float bias0 = 0.f; if (MODE == 1) { if (NT > 4) bias0 = (selmask & 1u) ? 0.f : -INFINITY; }
    qkt(pA0, pA1, ka, 0, qr, bias0);
    __syncthreads(); }
  int it = 0;
#define JB(i_) ((MODE == 2) ? (3 - (i_)) : ((i_) - (NT - 4)))
#define STEP(A0, A1, B0, B1, BAND, HASNEXT) do { \
    if (it + 2 < NT) DMA_K(TILE(it + 2) * KVBLK, it & 1); \
    if (it + 1 < NT) DMA_V(TILE(it + 1) * KVBLK, (it + 1) & 1); \
    bool skip = false; const int jb = JB(it); \
    if (BAND) { if (MODE == 1) skip = (64 * jb > wid * 32 + 31); if (MODE == 2) skip = (64 * jb >= wid * 32 + 31); } \
    if (HASNEXT) { float bias_ = 0.f; if (MODE == 1) { if (it + 1 < NT - 4) bias_ = ((selmask >> ((it + 1) >> 2)) & 1u) ? 0.f : -INFINITY; } \
      qkt(B0, B1, ka, ((it + 1) & 1) * SHM_K, qr, bias_); } \
    if (!skip) { \
      if (MODE == 2) { sb_tile<(BAND) != 0>(A0, A1, carry, 64 * jb, qrel, hi); } \
      else { \
        if (MODE == 1 && (BAND)) { _Pragma("unroll") for (int r = 0; r < 16; ++r) { const int kr = 64 * jb + crow(r, hi); if (kr > qrel) A0[r] = -INFINITY; if (kr + 32 > qrel) A1[r] = -INFINITY; } } \
        float alpha; softmax_tile(A0, A1, m_reg, l_reg, alpha); \
        if (__any(alpha < 1.f)) { if (hi == 0) al_l[r32] = alpha; asm volatile("s_waitcnt lgkmcnt(0)" ::: "memory"); \
          _Pragma("unroll") for (int d = 0; d < 4; ++d) _Pragma("unroll") for (int r = 0; r < 16; ++r) o[d][r] *= al_l[crow(r, hi)]; } \
      } \
      pack_p(A0, A1, pa0, pa1, pa2, pa3); \
      pv_d0(o, vb0 + (it & 1) * SHM_V, pa0, pa1, pa2, pa3); \
    } \
    SDRAIN(); __syncthreads(); ++it; } while (0)
#define SB_PART(G, P, I, B0, B1) do { qkt_part<G>(B0, B1, ka, ((it + 1) & 1) * SHM_K, qr); gs_[G] = sb_group<false, I>(P, 0, 0, hi); SBAR(); } while (0)
#define STEP_SB(A0, A1, B0, B1) do { \
    if (it + 2 < NT) DMA_K(TILE(it + 2) * KVBLK, it & 1); \
    DMA_V(TILE(it + 1) * KVBLK, (it + 1) & 1); \
    float gs_[8]; \
    _Pragma("unroll") for (int r = 0; r < 16; ++r) { B0[r] = 0.f; B1[r] = 0.f; } \
    SB_PART(0, A0, 0, B0, B1); SB_PART(1, A0, 1, B0, B1); SB_PART(2, A0, 2, B0, B1); SB_PART(3, A0, 3, B0, B1); \
    SB_PART(4, A1, 0, B0, B1); SB_PART(5, A1, 1, B0, B1); SB_PART(6, A1, 2, B0, B1); SB_PART(7, A1, 3, B0, B1); \
    sb_combine(A0, A1, gs_, carry, hi); \
    { const bool dn_ = __all(carry < SB_DONE); if (lane == 0) flg[(it & 1) * 8 + wid] = dn_ ? 1 : 0; } \
    pack_p(A0, A1, pa0, pa1, pa2, pa3); \
    pv_d0(o, vb0 + (it & 1) * SHM_V, pa0, pa1, pa2, pa3); \
    SDRAIN(); __syncthreads(); \
    { const int* f_ = flg + (it & 1) * 8; stop = (f_[0] + f_[1] + f_[2] + f_[3] + f_[4] + f_[5] + f_[6] + f_[7]) == 8; } \
    ++it; } while (0)
#define SSTEP(BAND) do { \
    if (RING3) { if (it + 2 < NT) { DMA_K3(TILE(it + 2) * KVBLK, kn2); DMA_V3(TILE(it + 2) * KVBLK, vn2); } } \
    else if (it + 1 < NT) { DMA_K(TILE(it + 1) * KVBLK, (it + 1) & 1); DMA_V(TILE(it + 1) * KVBLK, (it + 1) & 1); } \
    bool skip = false; const int jb = JB(it); \
    if (BAND) skip = (64 * jb > wid * 32 + 31); \
    if (!skip) { \
      float bias_ = 0.f; if (MODE == 1 && !(BAND)) bias_ = ((selmask >> (it >> 2)) & 1u) ? 0.f : -INFINITY; \
      const int kb_ = RING3 ? kc : (it & 1) * SHM_K; \
      if (QREG_SOFTMAX) qkt(pA0, pA1, ka, kb_, qg, bias_); else qkt(pA0, pA1, ka, kb_, qr, bias_); \
      if (MODE == 1 && (BAND)) { _Pragma("unroll") for (int r = 0; r < 16; ++r) { const int kr = 64 * jb + crow(r, hi); if (kr > qrel) pA0[r] = -INFINITY; if (kr + 32 > qrel) pA1[r] = -INFINITY; } } \
      float alpha; softmax_tile(pA0, pA1, m_reg, l_reg, alpha); \
      if (__any(alpha < 1.f)) { if (hi == 0) al_l[r32] = alpha; asm volatile("s_waitcnt lgkmcnt(0)" ::: "memory"); \
        _Pragma("unroll") for (int d = 0; d < 4; ++d) _Pragma("unroll") for (int r = 0; r < 16; ++r) o[d][r] *= al_l[crow(r, hi)]; } \
      pack_p(pA0, pA1, pa0, pa1, pa2, pa3); \
      pv_d0(o, vb0 + (RING3 ? vc : (it & 1) * SHM_V), pa0, pa1, pa2, pa3); \
    } \
    if (RING3) { if (it + 2 < NT) asm volatile("s_waitcnt vmcnt(4)" ::: "memory"); else SDRAIN();        \
      { const int t_ = kc; kc = kn; kn = kn2; kn2 = t_; } { const int t_ = vc; vc = vn; vn = vn2; vn2 = t_; } } \
    else SDRAIN(); \
    if (RING3) { asm volatile("s_waitcnt lgkmcnt(0)" ::: "memory"); __builtin_amdgcn_s_barrier(); asm volatile("" ::: "memory"); }     \
    else __syncthreads(); \
    ++it; } while (0)
#define RESTART(BIASEXPR) do { qkt(pA0, pA1, ka, (it & 1) * SHM_K, qr, (BIASEXPR)); __syncthreads(); } while (0)
  if (MODE == 0) {
    if (PIPE_SOFTMAX) { STEP(pA0, pA1, pB0, pB1, 0, true); STEP(pB0, pB1, pA0, pA1, 0, true); STEP(pA0, pA1, pB0, pB1, 0, true); STEP(pB0, pB1, pA0, pA1, 0, false); }
    else { SSTEP(0); SSTEP(0); SSTEP(0); SSTEP(0); }
  } else if (MODE == 1) {
    if (PIPE_SOFTMAX) {
      if (NT > 4) { while (it < NT - 4) { STEP(pA0, pA1, pB0, pB1, 0, true); STEP(pB0, pB1, pA0, pA1, 0, (it + 1 < NT - 4)); }
        RESTART(0.f); }
      STEP(pA0, pA1, pB0, pB1, 1, true); STEP(pB0, pB1, pA0, pA1, 1, true); STEP(pA0, pA1, pB0, pB1, 1, true); STEP(pB0, pB1, pA0, pA1, 1, false);
    } else {
      while (it < NT - 4) SSTEP(0);
      SSTEP(1); SSTEP(1); SSTEP(1); SSTEP(1);
    }
  } else {
    STEP(pA0, pA1, pB0, pB1, 1, true); STEP(pB0, pB1, pA0, pA1, 1, true); STEP(pA0, pA1, pB0, pB1, 1, true); STEP(pB0, pB1, pA0, pA1, 1, false);
    if (NT > 4) {
      RESTART(0.f);
      bool stop = false;
      while (it + 2 < NT && !stop) { STEP_SB(pA0, pA1, pB0, pB1); STEP_SB(pB0, pB1, pA0, pA1); }
      if (!stop) { STEP_SB(pA0, pA1, pB0, pB1); STEP(pB0, pB1, pA0, pA1, 0, false); }
    }
  }
#undef RESTART
#undef STEP
#undef SSTEP
#undef STEP_SB
#undef SB_PART
#undef JB
  float rli[16];
  if (MODE != 2) { if (hi == 0) li_l[r32] = l_reg; asm volatile("s_waitcnt lgkmcnt(0)" ::: "memory");
#pragma unroll
    for (int r = 0; r < 16; ++r) rli[r] = __builtin_amdgcn_rcpf(li_l[crow(r, hi)]); }
  else {
#pragma unroll
    for (int r = 0; r < 16; ++r) rli[r] = 1.f; }
  if (gain) {
    float gv[4];
#pragma unroll
    for (int d0 = 0; d0 < 4; ++d0) gv[d0] = gain[d0 * 32 + r32];
#pragma unroll
    for (int r = 0; r < 16; ++r) { float s = 0.f;
#pragma unroll
      for (int d0 = 0; d0 < 4; ++d0) { o[d0][r] *= rli[r]; s += o[d0][r] * o[d0][r]; }
      s += __shfl_xor(s, 1); s += __shfl_xor(s, 2); s += __shfl_xor(s, 4); s += __shfl_xor(s, 8); s += __shfl_xor(s, 16);
      rli[r] = __builtin_amdgcn_rsqf(s * (1.0f / 128.0f) + 1e-6f); }
#pragma unroll
    for (int r = 0; r < 16; ++r)
#pragma unroll
      for (int d0 = 0; d0 < 4; ++d0) o[d0][r] *= gv[d0];
  }
  { bf16* stg = (bf16*)lds + wid * 4096;
#pragma unroll
    for (int r = 0; r < 16; ++r) { const int orow = crow(r, hi);
#pragma unroll
      for (int d0 = 0; d0 < 4; ++d0) { const float v = o[d0][r] * rli[r]; unsigned u = __float_as_uint(v); u = (u + 0x7fffu + ((u >> 16) & 1u)) >> 16; stg[orow * 128 + d0 * 32 + r32] = (bf16)u; } }
    asm volatile("s_waitcnt lgkmcnt(0)" ::: "memory");
#pragma unroll
    for (int i = 0; i < 8; ++i) { const int row = i * 4 + (lane >> 4), ch = lane & 15; const u32x4 v = *(const u32x4*)(stg + row * 128 + ch * 8); *(u32x4*)(Ob + (long)(wid * 32 + row) * ldo + ch * 8) = v; } }
  __syncthreads();
#undef TILE
#undef DMA_K
#undef DMA_V
#undef DMA_K3
#undef DMA_V3
#undef KSLOT
#undef VSLOT
#undef SDRAIN
}
#undef KSWZ
#undef SBAR
}
#define GAS __attribute__((address_space(1)))
#define LAS __attribute__((address_space(3)))
typedef unsigned short bf16;
typedef unsigned v4u __attribute__((ext_vector_type(4)));
typedef float f32x4 __attribute__((ext_vector_type(4)));
#define LDS_WAIT() asm volatile("s_waitcnt lgkmcnt(0)" ::: "memory")
constexpr int NWAVES = 8;
constexpr int BATCH = 8, SEQ = 2048, DM = 2048, M = BATCH * SEQ, HD = 128, NH = 8;
constexpr int NQKV = 6144, FF = 5632, WX = 512, NMEM = 256, MMEM = BATCH * NMEM;
constexpr int QSB = 0, KSB = 1024, VSB = 2048, QMB = 3072, KMB = 4096, VMB = 5120;
constexpr float EPS = 1e-6f;
constexpr float QSCALE = 0.12751743082459868f;
constexpr size_t MiB = 1u << 20;
constexpr size_t WS_CTL = 0, CTL_ZERO_BYTES = 1 * MiB;
constexpr size_t WS_SSQ1 = 64 * 1024, WS_SSQ2 = 128 * 1024;
constexpr size_t WS_KSUM = 256 * 1024;
constexpr size_t WS_WIN = 1 * MiB, WS_WOUT = 25 * MiB, WS_WXQ = 33 * MiB, WS_WXKV = 35 * MiB, WS_WXO = 39 * MiB, WS_WGU = 41 * MiB, WS_WDN = 85 * MiB;
constexpr size_t WS_RA = 107 * MiB;
constexpr size_t WS_RB = 171 * MiB;
constexpr size_t WS_RC = 235 * MiB;
constexpr size_t WS_QX = 427 * MiB, WS_OX = 443 * MiB, WS_KVX = 459 * MiB, WS_MN = 463 * MiB, WS_KMEAN = 471 * MiB, WS_CS = 472 * MiB, WS_END = 474 * MiB;
constexpr int RING_BYTES = 131072, LDS_BYTES = 147456;
#ifndef FFN_FP8
#define FFN_FP8 1
#endif
constexpr float S_X2 = 16.f, S_WGU = 32.f, S_ACT = 8.f, S_WDN = 64.f, S_XN = 16.f, S_WV = 32.f;
constexpr size_t WS_WV8 = WS_WIN + 16 * MiB;

__device__ __forceinline__ float bf2f(unsigned short b) { return __uint_as_float((unsigned)b << 16); }
__device__ __forceinline__ unsigned f2bf(float f) { unsigned u = __builtin_bit_cast(unsigned, f); return (u + 0x7fffu + ((u >> 16) & 1u)) >> 16; }
__device__ __forceinline__ unsigned pk2(float lo, float hi) { return f2bf(lo) | (f2bf(hi) << 16); }
__device__ __forceinline__ float wave_sum(float v) {
#pragma unroll
    for (int o = 1; o < 64; o <<= 1) v += __shfl_xor(v, o);
    return v;
}
__device__ __forceinline__ float wave_max(float v) {
#pragma unroll
    for (int o = 1; o < 64; o <<= 1) v = fmaxf(v, __shfl_xor(v, o));
    return v;
}

typedef GAS unsigned gu32;
#define RLX_AGENT __ATOMIC_RELAXED, __HIP_MEMORY_SCOPE_AGENT
constexpr int CW_BAR = 4096;
constexpr int LDSCTL_OFF = RING_BYTES, MISC_OFF = LDSCTL_OFF + 320;
#define XB_TMO      128
#define XB_XCNT(j)  (256  + 64 * (j))
#define XB_XSUB(j)  (1280 + 64 * (j))
#define XB_XGEN(j)  (2304 + 64 * (j))
#define XB_TOP      3328
#define XB_TOPGEN   3392
#define XCD_BAR_WORDS 3456
#define XB_SPIN_CAP (1u << 18)

__device__ __forceinline__ unsigned xb_ld(unsigned* p)              { return __hip_atomic_load(p, __ATOMIC_RELAXED, __HIP_MEMORY_SCOPE_AGENT); }
__device__ __forceinline__ unsigned xb_add(unsigned* p, unsigned v) { return __hip_atomic_fetch_add(p, v, __ATOMIC_RELAXED, __HIP_MEMORY_SCOPE_AGENT); }
__device__ __forceinline__ unsigned xb_xcc_id() { return (unsigned)__builtin_amdgcn_s_getreg((3 << 11) | 20) & 0xFu; }
#define XB_SPIN(cond, bar) do { unsigned _sp = 0; while (cond) { __builtin_amdgcn_s_sleep(1); \
    if ((++_sp & 255u) == 0u) { if (xb_ld(&(bar)[XB_TMO])) break; if (_sp > XB_SPIN_CAP) { atomicAdd(&(bar)[XB_TMO], 1u); break; } } } } while (0)

struct XcdBarrier {
    unsigned* bar; unsigned x;
    volatile LAS unsigned* st;
};

__device__ __forceinline__ XcdBarrier xcd_barrier_post(unsigned* bar, volatile LAS unsigned* st) {
    XcdBarrier b; b.bar = bar; b.x = xb_xcc_id(); b.st = st;
    if (threadIdx.x == 0) (void)xb_add(&bar[XB_XCNT(b.x)], 1u);
    return b;
}
__device__ __forceinline__ void xcd_barrier_complete(unsigned* bar, unsigned x, unsigned& nloc, unsigned& nx) {
    const unsigned G = gridDim.x * gridDim.y * gridDim.z;
    unsigned sum, cnt, mine, sp = 0u;
    for (;;) {
        sum = 0u; cnt = 0u; mine = 0u;
#pragma unroll
        for (unsigned j = 0; j < 16; ++j) { const unsigned c = xb_ld(&bar[XB_XCNT(j)]); sum += c; cnt += (c > 0u) ? 1u : 0u; mine = (j == x) ? c : mine; }
        if (sum == G) break;
        __builtin_amdgcn_s_sleep(1);
        if ((++sp & 255u) == 0u) { if (xb_ld(&bar[XB_TMO])) break; if (sp > XB_SPIN_CAP) { atomicAdd(&bar[XB_TMO], 1u); break; } }
    }
    nloc = mine > 0u ? mine : 1u; nx = cnt > 0u ? cnt : 1u;
}

__device__ __forceinline__ void xcd_barrier(const XcdBarrier& b) {
    asm volatile("s_waitcnt vmcnt(0)" ::: "memory");
    __syncthreads();
    if (threadIdx.x == 0) {
        unsigned* bar = b.bar;
        __builtin_amdgcn_s_waitcnt(0);
        unsigned nloc = b.st[0], nx = b.st[1];
        if (nloc == 0u) { xcd_barrier_complete(bar, b.x, nloc, nx); b.st[0] = nloc; b.st[1] = nx; }
        const unsigned old = xb_add(&bar[XB_XSUB(b.x)], 1u);
        const unsigned gen = old / nloc;
        if (old + 1u == (gen + 1u) * nloc) {
            __builtin_amdgcn_fence(__ATOMIC_RELEASE, "agent");
            asm volatile("s_waitcnt vmcnt(0)" ::: "memory");
            const unsigned og = xb_add(&bar[XB_TOP], 1u);
            const unsigned tg = og / nx;
            if (og + 1u == (tg + 1u) * nx) xb_add(&bar[XB_TOPGEN], 1u);
            else XB_SPIN(xb_ld(&bar[XB_TOPGEN]) == tg, bar);
            __builtin_amdgcn_fence(__ATOMIC_ACQUIRE, "agent");
            xb_add(&bar[XB_XGEN(b.x)], 1u);
            asm volatile("s_waitcnt vmcnt(0)" ::: "memory");
        } else {
            XB_SPIN(xb_ld(&bar[XB_XGEN(b.x)]) == gen, bar);
            __builtin_amdgcn_fence(__ATOMIC_ACQUIRE, "agent");
            asm volatile("s_waitcnt vmcnt(0)" ::: "memory");
        }
    }
    __syncthreads();
}

struct Frame {
    LAS unsigned char* lds;
    int tid, lane, wave, vcu, G;
    const float *x, *mem; const int* pos;
    const float *g_mix, *w_in, *g_out_sb, *g_out_mb, *w_out, *g_xattn, *g_mem, *w_xq, *w_xkv, *w_xo, *g_ffn, *w_gu, *w_dn, *g_final;
    float* out; unsigned char* ws;
};

__device__ __forceinline__ void transpose_item(const float* W, int K, int N, bf16* WT, const float* gain, int inter, LAS float* scr, int item, int lane) {
    const int nblk = N / 32, kb = item / nblk, nb = item % nblk, k0 = 64 * kb, n0 = 32 * nb;
    int orow0 = n0;
    if (inter == 1) orow0 = (n0 < FF) ? (n0 / 128) * 256 + (n0 % 128) : ((n0 - FF) / 128) * 256 + 128 + ((n0 - FF) % 128);
    if (inter == 2) { const int reg = n0 / 1024, c = n0 % 1024; orow0 = (reg == 2) ? c : (reg == 5) ? 1024 + c : (reg < 2 ? reg : reg - 1) * 1024 + c; }
    float v[32];
#pragma unroll
    for (int i = 0; i < 32; ++i) v[i] = W[(size_t)(k0 + 2 * i + (lane >> 5)) * N + n0 + (lane & 31)];
#pragma unroll
    for (int i = 0; i < 32; ++i) { const int kk = 2 * i + (lane >> 5); float t = v[i]; if (gain) t *= gain[k0 + kk]; scr[kk * 33 + (lane & 31)] = t; }
    LDS_WAIT(); asm volatile("" ::: "memory");
    const int c = lane & 7;
#pragma unroll
    for (int j = 0; j < 4; ++j) { const int n = (lane >> 3) + 8 * j; const LAS float* s = scr + (8 * c) * 33 + n;
        v4u o; o.x = pk2(s[0 * 33], s[1 * 33]); o.y = pk2(s[2 * 33], s[3 * 33]); o.z = pk2(s[4 * 33], s[5 * 33]); o.w = pk2(s[6 * 33], s[7 * 33]);
        *(GAS v4u*)(WT + (size_t)(orow0 + n) * K + k0 + 8 * c) = o; }
    LDS_WAIT(); asm volatile("" ::: "memory");
}
__device__ __forceinline__ void transpose_item_fp8(const float* W, int K, int N, unsigned char* WT, const float* gain, int inter, float scale, LAS float* scr, int item, int lane) {
    const int nblk = N / 32, kb = item / nblk, nb = item % nblk, k0 = 64 * kb, n0 = 32 * nb;
    int orow0 = n0;
    if (inter == 1) orow0 = (n0 < FF) ? (n0 / 128) * 256 + (n0 % 128) : ((n0 - FF) / 128) * 256 + 128 + ((n0 - FF) % 128);
    if (inter == 2) { const int reg = n0 / 1024, c = n0 % 1024; orow0 = (reg == 2) ? c : (reg == 5) ? 1024 + c : (reg < 2 ? reg : reg - 1) * 1024 + c; }
    float v[32];
#pragma unroll
    for (int i = 0; i < 32; ++i) v[i] = W[(size_t)(k0 + 2 * i + (lane >> 5)) * N + n0 + (lane & 31)];
#pragma unroll
    for (int i = 0; i < 32; ++i) { const int kk = 2 * i + (lane >> 5); float t = v[i] * scale; if (gain) t *= gain[k0 + kk]; scr[kk * 33 + (lane & 31)] = t; }
    LDS_WAIT(); asm volatile("" ::: "memory");
    const int c = lane & 7;
#pragma unroll
    for (int j = 0; j < 4; ++j) { const int n = (lane >> 3) + 8 * j; const LAS float* s = scr + (8 * c) * 33 + n;
        pg8::u32x2 o; o.x = pg8::pk4_fp8(s[0 * 33], s[1 * 33], s[2 * 33], s[3 * 33]); o.y = pg8::pk4_fp8(s[4 * 33], s[5 * 33], s[6 * 33], s[7 * 33]);
        *(GAS pg8::u32x2*)(WT + (size_t)(orow0 + n) * K + k0 + 8 * c) = o; }
    LDS_WAIT(); asm volatile("" ::: "memory");
}
__device__ __forceinline__ void rms_row_to_bf16(const float* xrow, const float* g, bf16* orow, int lane, unsigned char* o8 = nullptr, float s8 = 1.f) {
    const GAS f32x4* xr = (const GAS f32x4*)xrow + lane; const GAS f32x4* gr = (const GAS f32x4*)g + lane;
    f32x4 v[8]; float s = 0.f;
#pragma unroll
    for (int j = 0; j < 8; ++j) { v[j] = xr[64 * j]; s += (v[j].x * v[j].x + v[j].y * v[j].y) + (v[j].z * v[j].z + v[j].w * v[j].w); }
    const float rstd = 1.0f / sqrtf(wave_sum(s) * (1.f / DM) + EPS);
    GAS unsigned long long* ob8 = (GAS unsigned long long*)orow + lane;
#pragma unroll
    for (int j = 0; j < 8; ++j) { const f32x4 gg = gr[64 * j];
        const float a0 = v[j].x * rstd * gg.x, a1 = v[j].y * rstd * gg.y, a2 = v[j].z * rstd * gg.z, a3 = v[j].w * rstd * gg.w;
        ob8[64 * j] = (unsigned long long)pk2(a0, a1) | ((unsigned long long)pk2(a2, a3) << 32);
        if (o8) ((GAS unsigned*)o8)[64 * j + lane] = pg8::pk4_fp8(a0 * s8, a1 * s8, a2 * s8, a3 * s8); }
}
__constant__ float INV_FREQ[16] = {1.000000000e+00f, 4.403665960e-01f, 1.939227432e-01f, 8.539710194e-02f, 3.760603070e-02f, 1.656043902e-02f, 7.292664610e-03f, 3.211445874e-03f,
                                   1.414213562e-03f, 6.227723788e-04f, 2.742481884e-04f, 1.207697351e-04f, 5.318296098e-05f, 2.341999971e-05f, 1.031338616e-05f, 4.541670478e-06f};

__device__ __forceinline__ void p0_prologue(Frame& F) {
    LAS float* scr = (LAS float*)(F.lds + F.wave * 16384);
    const int gw = F.vcu * NWAVES + F.wave, NGW = F.G * NWAVES;
    bf16* ws16 = (bf16*)F.ws;
    constexpr int I0 = (DM / 64) * (NQKV / 32), I1 = (DM / 64) * (DM / 32), I2 = (DM / 64) * (WX / 32), I3 = (DM / 64) * (2 * WX / 32), I4 = (WX / 64) * (DM / 32),
                  I5 = (DM / 64) * (2 * FF / 32), I6 = (FF / 64) * (DM / 32);
    constexpr int I5H = I5 / 2;
    constexpr int NITEMS = I0 + I1 + I2 + I3 + I4 + I5H;
    for (int it = gw; it < NITEMS; it += NGW) {
        int r = it;
        if (r < I0) { const int reg = ((r % (NQKV / 32)) * 32) / 1024;
            if (reg == 2 || reg == 5) transpose_item_fp8(F.w_in, DM, NQKV, F.ws + WS_WV8, nullptr, 2, S_WV, scr, r, F.lane);
            else transpose_item(F.w_in, DM, NQKV, (bf16*)(F.ws + WS_WIN), nullptr, 2, scr, r, F.lane);
            continue; } r -= I0;
        if (r < I1) { transpose_item(F.w_out, DM, DM, (bf16*)(F.ws + WS_WOUT), nullptr, 0, scr, r, F.lane); continue; } r -= I1;
        if (r < I2) { transpose_item(F.w_xq, DM, WX, (bf16*)(F.ws + WS_WXQ), F.g_xattn, 0, scr, r, F.lane); continue; } r -= I2;
        if (r < I3) { transpose_item(F.w_xkv, DM, 2 * WX, (bf16*)(F.ws + WS_WXKV), nullptr, 0, scr, r, F.lane); continue; } r -= I3;
        if (r < I4) { transpose_item(F.w_xo, WX, DM, (bf16*)(F.ws + WS_WXO), nullptr, 0, scr, r, F.lane); continue; } r -= I4;
        transpose_item_fp8(F.w_gu, DM, 2 * FF, F.ws + WS_WGU, F.g_ffn, 1, S_WGU, scr, r, F.lane);
    }
    (void)ws16;
    for (int m = gw; m < M; m += NGW) rms_row_to_bf16(F.x + (size_t)m * DM, F.g_mix, (bf16*)(F.ws + WS_RA) + (size_t)m * DM, F.lane, F.ws + WS_RB + (size_t)m * DM, S_XN);
    for (int m = gw; m < MMEM; m += NGW) rms_row_to_bf16(F.mem + (size_t)m * DM, F.g_mem, (bf16*)(F.ws + WS_MN) + (size_t)m * DM, F.lane);
    float* cs = (float*)(F.ws + WS_CS);
    for (int e = (F.vcu * NWAVES + F.wave) * 64 + F.lane; e < M * 16; e += NGW * 64) {
        const int m = e >> 4, i = e & 15; const float ang = (float)F.pos[m] * INV_FREQ[i];
        double rev = (double)ang * 0.15915494309189535; rev -= floor(rev);
        const float a = (float)(rev * 6.283185307179586);
        cs[(size_t)m * 32 + i] = cosf(a); cs[(size_t)m * 32 + 16 + i] = sinf(a);
    }
}

__device__ __forceinline__ void ffn_weight_items(Frame& F, int wi, int nw) {
    LAS float* scr = (LAS float*)(F.lds + F.wave * 16384);
    constexpr int I5 = (DM / 64) * (2 * FF / 32), I6 = (FF / 64) * (DM / 32);
    for (int it = wi + I5 / 2; it < I5 + I6; it += nw) {
        if (it < I5) transpose_item_fp8(F.w_gu, DM, 2 * FF, F.ws + WS_WGU, F.g_ffn, 1, S_WGU, scr, it, F.lane);
        else transpose_item_fp8(F.w_dn, FF, DM, F.ws + WS_WDN, nullptr, 0, S_WDN, scr, it - I5, F.lane);
    }
}

__device__ __forceinline__ void final_norm_phase(Frame& F, const bf16* src, float* dst) {
    const int gw = F.vcu * NWAVES + F.wave, NGW = F.G * NWAVES;
    for (int m = gw; m < M; m += NGW) {
        const GAS v4u* xr = (const GAS v4u*)(src + (size_t)m * DM) + F.lane; const GAS f32x4* gr = (const GAS f32x4*)F.g_final;
        v4u w[4]; float s = 0.f;
#pragma unroll
        for (int j = 0; j < 4; ++j) w[j] = xr[64 * j];
        f32x4 v[8];
#pragma unroll
        for (int j = 0; j < 4; ++j) { v[2 * j] = (f32x4){__uint_as_float(w[j].x << 16), __uint_as_float(w[j].x & 0xffff0000u), __uint_as_float(w[j].y << 16), __uint_as_float(w[j].y & 0xffff0000u)};
            v[2 * j + 1] = (f32x4){__uint_as_float(w[j].z << 16), __uint_as_float(w[j].z & 0xffff0000u), __uint_as_float(w[j].w << 16), __uint_as_float(w[j].w & 0xffff0000u)}; }
#pragma unroll
        for (int j = 0; j < 8; ++j) s += (v[j].x * v[j].x + v[j].y * v[j].y) + (v[j].z * v[j].z + v[j].w * v[j].w);
        const float rstd = 1.0f / sqrtf(wave_sum(s) * (1.f / DM) + EPS);
        GAS f32x4* dr = (GAS f32x4*)(dst + (size_t)m * DM);
#pragma unroll
        for (int j = 0; j < 4; ++j) { const int c4 = (64 * j + F.lane) * 2;
            dr[c4] = v[2 * j] * rstd * gr[c4]; dr[c4 + 1] = v[2 * j + 1] * rstd * gr[c4 + 1]; }
    }
}

constexpr int NPH = 11;
#ifndef REPEAT_WHICH
#define REPEAT_WHICH 3
#endif
#ifndef NULL_EPI_PROBE
#define NULL_EPI_PROBE 0
#endif
#ifndef FOLD_KMEAN
#define FOLD_KMEAN 1
#endif
#ifndef REPEAT_PHASE
#define REPEAT_PHASE -1
#endif
#ifndef REPEAT_MASK
#define REPEAT_MASK 0
#endif
#define REPS(k) (((REPEAT_PHASE == (k)) || ((REPEAT_MASK >> (k)) & 1)) ? 2 : 1)
#ifndef USE_MFMA_SB
#define USE_MFMA_SB 1
#endif
#ifndef USE_MFMA_MOBA
#define USE_MFMA_MOBA 1
#endif
#ifndef USE_MFMA_X
#define USE_MFMA_X 1
#endif
#ifndef MK_ONE_LAUNCH
#define MK_ONE_LAUNCH 1
#endif
struct Args { const void* in[17]; float* out; unsigned char* ws; int ph_lo, ph_hi; };
__global__ void __launch_bounds__(NWAVES * 64, 2) mk_fwd(Args args) {
    extern __shared__ __attribute__((aligned(16))) unsigned char lds[];
    Frame F;
    F.lds = (LAS unsigned char*)lds;
    F.tid = threadIdx.x; F.lane = F.tid & 63; F.wave = __builtin_amdgcn_readfirstlane(F.tid >> 6);
    F.G = gridDim.x; { const int bx = blockIdx.x; F.vcu = (F.G % 8 == 0) ? (bx % 8) * (F.G / 8) + bx / 8 : bx; }
    F.x = (const float*)args.in[0]; F.mem = (const float*)args.in[1]; F.pos = (const int*)args.in[2];
    F.g_mix = (const float*)args.in[3]; F.w_in = (const float*)args.in[4]; F.g_out_sb = (const float*)args.in[5]; F.g_out_mb = (const float*)args.in[6]; F.w_out = (const float*)args.in[7];
    F.g_xattn = (const float*)args.in[8]; F.g_mem = (const float*)args.in[9]; F.w_xq = (const float*)args.in[10]; F.w_xkv = (const float*)args.in[11]; F.w_xo = (const float*)args.in[12];
    F.g_ffn = (const float*)args.in[13]; F.w_gu = (const float*)args.in[14]; F.w_dn = (const float*)args.in[15]; F.g_final = (const float*)args.in[16];
    F.out = args.out; F.ws = args.ws;
    unsigned char* ws = args.ws;
    const int lo = args.ph_lo, hi = args.ph_hi;
    for (int u = F.tid; u < (LDS_BYTES - LDSCTL_OFF) / 4; u += NWAVES * 64) ((LAS unsigned*)(F.lds + LDSCTL_OFF))[u] = 0u;
    __syncthreads();
    if (hi - lo > 1) cg::this_grid().sync();
    XcdBarrier bar = xcd_barrier_post((unsigned*)(ws + WS_CTL) + CW_BAR, (volatile LAS unsigned*)(F.lds + MISC_OFF) + 8);
#ifndef ONLY_PHASE
#define ONLY_PHASE -1
#endif
#define IN(k) ((ONLY_PHASE < 0 || ONLY_PHASE == (k)) && lo <= (k) && (k) < hi)
#define BOTH(k) (IN(k) && IN((k) + 1))
#define GRID_BAR() xcd_barrier(bar)
    float* ssq1 = (float*)(ws + WS_SSQ1); float* ssq2 = (float*)(ws + WS_SSQ2);
    pg8::bf16_t* RA = (pg8::bf16_t*)(ws + WS_RA); pg8::bf16_t* RB = (pg8::bf16_t*)(ws + WS_RB); pg8::bf16_t* RC = (pg8::bf16_t*)(ws + WS_RC);

    if (IN(0)) { for (int rep = 0; rep < REPS(0); ++rep) p0_prologue(F); if (BOTH(0)) GRID_BAR(); }
    if (IN(1)) {
        for (int rep = 0; rep < REPS(1); ++rep) {
        { pg8::Gemm g{RA, (const pg8::bf16_t*)(ws + WS_WIN), M, 4096, DM}; pg8::StaticOrder S; S.init(M, 4096, F.G, (int)blockIdx.x);
          pg8::EpiQKV E{RC, (const float*)(ws + WS_CS), QSCALE, (float*)(ws + WS_KSUM), 0, 1.f};
          pg8::gemm_phase<pg8::EpiQKV, pg8::StaticOrder, true, true>(F.lds, g, S, E); }
        { pg8::Gemm g{RB, (const pg8::bf16_t*)(ws + WS_WV8), M, 2048, DM / 2}; pg8::StaticOrder S; S.init(M, 2048, F.G, (int)blockIdx.x);
          pg8::EpiQKV E{RC, (const float*)(ws + WS_CS), QSCALE, (float*)(ws + WS_KSUM), 1, 1.f / (S_XN * S_WV)};
          pg8::gemm_phase<pg8::EpiQKV, pg8::StaticOrder, true, true, true>(F.lds, g, S, E); }
        }
        if (BOTH(1)) GRID_BAR();
    }
    if (IN(3)) {
        const att::bf16* qkv = (const att::bf16*)RC; att::bf16* ob = (att::bf16*)RA; const float* kmean = (const float*)(ws + WS_KSUM);
        constexpr size_t HSZ = (size_t)SEQ * HD;
        for (int rep = 0; rep < REPS(3); ++rep) {
        if (rep == 0 || (REPEAT_WHICH & 1))
        for (int vv = F.vcu; vv < 256; vv += F.G) { const int bh = vv >> 2, s = vv & 3, b = bh >> 3, h = bh & 7; const size_t rb = (size_t)b * SEQ; const att::bf16* hb = qkv + ((size_t)b * 48 + h) * HSZ;
            for (int i = 0; i < 2; ++i) { const int qb = i ? s : 7 - s; const size_t r0 = rb + (size_t)qb * 256;
                att::attn_unit<2>(hb + (size_t)qb * 256 * HD, HD, hb + 8 * HSZ, hb + 16 * HSZ, HD, ob + r0 * DM + h * HD, DM, F.g_out_sb + h * HD, nullptr, qb, 0, (char*)lds); } }
        if (rep == 0 || (REPEAT_WHICH & 2))
        for (int vv = F.vcu; vv < 256; vv += F.G) { const int bh = vv >> 2, s = vv & 3, b = bh >> 3, h = bh & 7; const size_t rb = (size_t)b * SEQ; const att::bf16* hb = qkv + ((size_t)b * 48 + 24 + h) * HSZ;
            for (int i = 0; i < 2; ++i) { const int qb = i ? s : 7 - s; const size_t r0 = rb + (size_t)qb * 256;
                att::attn_unit<1>(hb + (size_t)qb * 256 * HD, HD, hb + 8 * HSZ, hb + 16 * HSZ, HD, ob + r0 * DM + NH * HD + h * HD, DM, F.g_out_mb + h * HD, kmean + (size_t)bh * 1024, qb, 0, (char*)lds); } }
        }
        if (BOTH(3)) GRID_BAR();
    }
    if (IN(4)) {
        pg8::Gemm g{RA, (const pg8::bf16_t*)(ws + WS_WOUT), M, DM, DM}; pg8::StaticOrder S; S.init(M, DM, F.G, (int)blockIdx.x);
        if (REPS(4) == 2) { pg8::EpiResB<true> E0{F.x, RB, nullptr, nullptr, 1.f, 1.f}; pg8::gemm_phase<pg8::EpiResB<true>, pg8::StaticOrder, true, true>(F.lds, g, S, E0); }
        pg8::EpiResB<true> E{F.x, RB, ssq1, nullptr, 1.f, 1.f};
        pg8::gemm_phase<pg8::EpiResB<true>, pg8::StaticOrder, true, true>(F.lds, g, S, E);
        if (BOTH(4)) GRID_BAR();
    }
    if (IN(5)) {
      for (int rep = 0; rep < REPS(5); ++rep) {
        { pg8::Gemm g{RB, (const pg8::bf16_t*)(ws + WS_WXQ), M, WX, DM}; pg8::StaticOrder S; S.init(M, WX, F.G, (int)blockIdx.x);
          pg8::EpiScale E{(pg8::bf16_t*)(ws + WS_QX), WX, ssq1, QSCALE};
          pg8::gemm_phase<pg8::EpiScale, pg8::StaticOrder, true, true>(F.lds, g, S, E); }
        { pg8::Gemm g{(const pg8::bf16_t*)(ws + WS_MN), (const pg8::bf16_t*)(ws + WS_WXKV), MMEM, 2 * WX, DM}; pg8::StaticOrder S; S.init(MMEM, 2 * WX, F.G, (int)((blockIdx.x + F.G - 128) % F.G));
          pg8::EpiScale E{(pg8::bf16_t*)(ws + WS_KVX), 2 * WX, nullptr, 1.0f};
          pg8::gemm_phase<pg8::EpiScale, pg8::StaticOrder, true, true>(F.lds, g, S, E); }
        if (F.G > 160) { if ((int)blockIdx.x >= 160) ffn_weight_items(F, ((int)blockIdx.x - 160) * NWAVES + F.wave, (F.G - 160) * NWAVES); }
        else ffn_weight_items(F, (int)blockIdx.x * NWAVES + F.wave, F.G * NWAVES);
      }
        if (BOTH(5)) GRID_BAR();
    }
    if (IN(6)) {
        const att::bf16* qx = (const att::bf16*)(ws + WS_QX); const att::bf16* kvx = (const att::bf16*)(ws + WS_KVX); att::bf16* ox = (att::bf16*)(ws + WS_OX);
        for (int rep = 0; rep < REPS(6); ++rep) {
        for (int vv = F.vcu; vv < 256; vv += F.G) { const int b = vv >> 5, h = (vv >> 3) & 3, qb = vv & 7; const size_t r0 = (size_t)b * SEQ + (size_t)qb * 256;
            att::attn_unit<0>(qx + r0 * WX + h * HD, WX, kvx + (size_t)b * NMEM * (2 * WX) + h * HD, kvx + (size_t)b * NMEM * (2 * WX) + WX + h * HD, 2 * WX, ox + r0 * WX + h * HD, WX, nullptr, nullptr, qb, NMEM, (char*)lds); }
        }
        if (BOTH(6)) GRID_BAR();
    }
    if (IN(7)) {
        pg8::Gemm g{(const pg8::bf16_t*)(ws + WS_OX), (const pg8::bf16_t*)(ws + WS_WXO), M, DM, WX}; pg8::StaticOrder S; S.init(M, DM, F.G, (int)blockIdx.x);
        if (REPS(7) == 2) { pg8::EpiResB<false> E0{RB, RC, nullptr, nullptr, 1.f, 1.f}; pg8::gemm_phase<pg8::EpiResB<false>, pg8::StaticOrder, true, true>(F.lds, g, S, E0); }
        pg8::EpiResB<false> E{RB, RB, ssq2, (unsigned char*)RA, S_X2, 1.f};
        pg8::gemm_phase<pg8::EpiResB<false>, pg8::StaticOrder, true, true>(F.lds, g, S, E);
        if (BOTH(7)) GRID_BAR();
    }
    if (IN(8)) {
        pg8::Gemm g{RA, (const pg8::bf16_t*)(ws + WS_WGU), M, 2 * FF, FFN_FP8 ? DM / 2 : DM}; pg8::StaticOrder S; S.init(M, 2 * FF, F.G, (int)blockIdx.x);
        pg8::EpiSwiGLU E{RC, ssq2, FFN_FP8 ? (unsigned char*)RC : nullptr, FFN_FP8 ? 1.f / (S_X2 * S_WGU) : 1.f, S_ACT};
#if NULL_EPI_PROBE
        if (REPS(8) == 2) { pg8::EpiNull EN{nullptr}; pg8::gemm_phase<pg8::EpiNull, pg8::StaticOrder, true, true, FFN_FP8 != 0>(F.lds, g, S, EN); }
        pg8::gemm_phase<pg8::EpiSwiGLU, pg8::StaticOrder, true, true, FFN_FP8 != 0>(F.lds, g, S, E);
#else
        for (int rep = 0; rep < REPS(8); ++rep) pg8::gemm_phase<pg8::EpiSwiGLU, pg8::StaticOrder, true, true, FFN_FP8 != 0>(F.lds, g, S, E);
#endif
        if (BOTH(8)) GRID_BAR();
    }
    if (IN(9)) {
        pg8::Gemm g{RC, (const pg8::bf16_t*)(ws + WS_WDN), M, DM, FF / 2}; pg8::StaticOrder S; S.init(M, DM, F.G, (int)blockIdx.x);
        if (REPS(9) == 2) { pg8::EpiResB<false> E0{RB, (pg8::bf16_t*)(ws + WS_RC + 96 * MiB), nullptr, nullptr, 1.f, 1.f / (S_ACT * S_WDN)}; pg8::gemm_phase<pg8::EpiResB<false>, pg8::StaticOrder, true, true, true>(F.lds, g, S, E0); }
        pg8::EpiResB<false> E{RB, RB, nullptr, nullptr, 1.f, 1.f / (S_ACT * S_WDN)};
        pg8::gemm_phase<pg8::EpiResB<false>, pg8::StaticOrder, true, true, true>(F.lds, g, S, E);
        if (BOTH(9)) GRID_BAR();
    }
    if (IN(10)) { if (REPS(10) == 2) final_norm_phase(F, RB, (float*)RC); final_norm_phase(F, RB, F.out); }
#undef IN
#undef BOTH
}

extern "C" void kernel_launch(void* const* d_in, const int* in_sizes, int n_in, void* d_out, int out_size, void* d_ws, size_t ws_size, hipStream_t stream) {
    static int grid = 0;
    if (grid == 0) {
        if (n_in != 17 || in_sizes[0] != M * DM || out_size != M * DM || ws_size < WS_END) { fprintf(stderr, "kernel_launch: unexpected shapes (n_in %d in0 %d out %d ws %zu)\n", n_in, n_in > 0 ? in_sizes[0] : -1, out_size, ws_size); grid = -1; return; }
        int dev = 0, cus = 0, per_cu = 0;
        if (hipGetDevice(&dev) != hipSuccess || hipDeviceGetAttribute(&cus, hipDeviceAttributeMultiprocessorCount, dev) != hipSuccess) { grid = -1; return; }
        if (hipFuncSetAttribute((const void*)mk_fwd, hipFuncAttributeMaxDynamicSharedMemorySize, LDS_BYTES) != hipSuccess) { fprintf(stderr, "kernel_launch: hipFuncSetAttribute failed\n"); grid = -1; return; }
        if (hipOccupancyMaxActiveBlocksPerMultiprocessor(&per_cu, (const void*)mk_fwd, NWAVES * 64, LDS_BYTES) != hipSuccess || per_cu < 1) { fprintf(stderr, "kernel_launch: occupancy query failed (%d)\n", per_cu); per_cu = 1; }
        (void)hipGetLastError();
        grid = cus * (per_cu < 1 ? 1 : 1);
    }
    if (grid < 0) return;
    (void)hipMemsetAsync((char*)d_ws + WS_CTL, 0, CTL_ZERO_BYTES, stream);
    Args a{};
    for (int i = 0; i < 17; ++i) a.in[i] = d_in[i];
    a.out = (float*)d_out; a.ws = (unsigned char*)d_ws;
#if MK_ONE_LAUNCH
    a.ph_lo = 0; a.ph_hi = NPH;
    void* kargs[] = {&a};
    hipError_t e = hipLaunchCooperativeKernel((const void*)mk_fwd, dim3(grid), dim3(NWAVES * 64), kargs, LDS_BYTES, stream);
    if (e != hipSuccess) fprintf(stderr, "kernel_launch: cooperative launch failed: %s (grid %d)\n", hipGetErrorString(e), grid);
#else
    for (int p = 0; p < NPH; ++p) { a.ph_lo = p; a.ph_hi = p + 1; hipLaunchKernelGGL(mk_fwd, dim3(grid), dim3(NWAVES * 64), LDS_BYTES, stream, a); }
    const hipError_t le = hipPeekAtLastError();
    if (le != hipSuccess) fprintf(stderr, "kernel_launch: launch failed: %s\n", hipGetErrorName(le));
#endif
}
```

```cpp
#include <hip/hip_runtime.h>
#include <hip/hip_cooperative_groups.h>
#include <cstdio>
#include <cstdint>
namespace cg = cooperative_groups;
namespace pg8 {
#define PG8_LAS __attribute__((address_space(3)))
typedef unsigned short bf16_t;
typedef short bf16x8 __attribute__((ext_vector_type(8)));
typedef float f32x4 __attribute__((ext_vector_type(4)));
typedef unsigned u32x4 __attribute__((ext_vector_type(4)));
constexpr int BM = 256, BK = 64, HALF = 128, HTB = HALF * BK * 2  , STAGE_BYTES = 8 * HTB, NXCD = 8, WGM = 8;

__host__ __device__ __forceinline__ int lds_byte(int r, int c) { const int st = (r >> 4) * 2 + (c >> 5), rr = r & 15, cc = c & 31, ob = rr * 64 + cc * 2; return st * 1024 + (ob ^ (((ob >> 9) & 1) << 5)); }
__host__ __device__ __forceinline__ void stage_rc(int b, int& R, int& C) { const int st = b / 1024, sb = b % 1024, swz = sb ^ (((sb >> 9) & 1) << 5); R = (st >> 1) * 16 + swz / 64; C = (st & 1) * 32 + (swz % 64) / 2; }
__host__ __device__ __forceinline__ int perm32(int rho) { const int n = rho >> 4, i = rho & 15; return 8 * (i >> 2) + 4 * n + (i & 3); }

struct Unit { int pm, pn; };
struct Gemm { const bf16_t* A; const bf16_t* Bt; int M, N, K; };

struct StaticOrder {
    int nM, nN, nwg, G, c;
    __host__ __device__ void init(int M, int N, int G_, int c_) { nM = M / BM; nN = N / BM; nwg = nM * nN; G = G_; c = c_; }
    __host__ __device__ bool next(int i, Unit& u) const {
        const long L = (long)i * G + c; if (L >= nwg) return false;
        int wgid = (int)L; { const int q = nwg / NXCD, r = nwg % NXCD, xcd = wgid % NXCD, off = wgid / NXCD; wgid = (xcd < r ? xcd * (q + 1) : r * (q + 1) + (xcd - r) * q) + off; }
        const int nig = WGM * nN, gid = wgid / nig, fm = gid * WGM, gsz = (nM - fm) < WGM ? (nM - fm) : WGM;
        u.pm = fm + ((wgid % nig) % gsz); u.pn = (wgid % nig) / gsz; return true;
    }
    __device__ __forceinline__ void a_ready(const Unit&) const {}
    __device__ __forceinline__ void done(const Unit&) const {}
};

__device__ __forceinline__ unsigned cvt_pk_bf16(float lo, float hi) { unsigned r; asm volatile("v_cvt_pk_bf16_f32 %0, %1, %2" : "=v"(r) : "v"(lo), "v"(hi)); return r; }
typedef float f32x2 __attribute__((ext_vector_type(2)));
template <class Epi, class Sched, bool ALIGN_EPI = false, bool SP2 = false, bool FP8 = false>
__device__ __forceinline__ void gemm_phase(PG8_LAS unsigned char* lds, const Gemm g, const Sched& S, const Epi& E) {
    int tid_ = threadIdx.x; asm volatile("" : "+v"(tid_));
    const int tid = tid_, wid = __builtin_amdgcn_readfirstlane(tid >> 6), lane = tid & 63, wr = wid >> 2, wc = wid & 3, fr = lane & 15, fq = lane >> 4;
    const int K = g.K, nt = K / BK;
    unsigned voffA[2], voffB[2];
#pragma unroll
    for (int i = 0; i < 2; ++i) { int R, C; stage_rc(tid * 16 + i * 8192, R, C); const int Rb = Epi::PERM ? ((R & ~31) + perm32(R & 31)) : R;
        voffA[i] = (unsigned)(R * K + C) * 2u; voffB[i] = (unsigned)(Rb * K + C) * 2u; }
    const size_t kstep = (size_t)(BK * 2);
    const size_t hstep = (size_t)HALF * K * 2;
    const size_t tstep = 2 * hstep;
    const unsigned ldsw = (unsigned)wid * 1024u;
    const int aoff = lds_byte(wr * 64 + fr, fq * 8), boff = lds_byte(wc * 32 + fr, fq * 8);
#define PG8_SA(b, h) (((b) * 2 + (h)) * HTB)
#define PG8_SB(b, h) ((4 + (b) * 2 + (h)) * HTB)
#define PG8_STAGE(bufoff, gbase, voff) do { _Pragma("unroll") for (int _i = 0; _i < 2; ++_i) \
        __builtin_amdgcn_global_load_lds((const unsigned*)((const char*)(gbase) + (voff)[_i]), (PG8_LAS unsigned*)(lds + (bufoff) + ldsw + _i * 8192), 16, 0, 0); } while (0)
#define PG8_LD8(p) __builtin_shufflevector(*(const PG8_LAS i32x4_*)(p), *(const PG8_LAS i32x4_*)((p) + 1024), 0, 1, 2, 3, 4, 5, 6, 7)
#define PG8_LDA(dst, b, h) do { if constexpr (FP8) { _Pragma("unroll") for (int m = 0; m < 4; ++m) dst##8[m] = PG8_LD8(lds + PG8_SA(b, h) + aoff + m * 2048); } \
        else { _Pragma("unroll") for (int m = 0; m < 4; ++m) _Pragma("unroll") for (int k = 0; k < 2; ++k) dst[m][k] = *(const PG8_LAS bf16x8*)(lds + PG8_SA(b, h) + aoff + m * 2048 + k * 1024); } } while (0)
#define PG8_LDB(dst, b, h) do { if constexpr (FP8) { _Pragma("unroll") for (int n = 0; n < 2; ++n) dst##8[n] = PG8_LD8(lds + PG8_SB(b, h) + boff + n * 2048); } \
        else { _Pragma("unroll") for (int n = 0; n < 2; ++n) _Pragma("unroll") for (int k = 0; k < 2; ++k) dst[n][k] = *(const PG8_LAS bf16x8*)(lds + PG8_SB(b, h) + boff + n * 2048 + k * 1024); } } while (0)
#define PG8_MMA(ai, bj, At, Bt) do { __builtin_amdgcn_s_setprio(1); _Pragma("unroll") for (int m = 0; m < 4; ++m) _Pragma("unroll") for (int n = 0; n < 2; ++n) { \
        if constexpr (FP8) asm volatile("v_mfma_scale_f32_16x16x128_f8f6f4 %0, %1, %2, %0, %3, %3 op_sel_hi:[0,0,0]" : "+v"(acc[ai][bj][m][n]) : "v"(Bt##8[n]), "v"(At##8[m]), "v"(sc1_)); \
        else { _Pragma("unroll") for (int k = 0; k < 2; ++k) acc[ai][bj][m][n] = __builtin_amdgcn_mfma_f32_16x16x32_bf16(Bt[n][k], At[m][k], acc[ai][bj][m][n], 0, 0, 0); } } \
        __builtin_amdgcn_s_setprio(0); } while (0)
#define PG8_WAIT_V(n) asm volatile("s_waitcnt vmcnt(" #n ")" ::: "memory")
#define PG8_WAIT_L(n) asm volatile("s_waitcnt lgkmcnt(" #n ")" ::: "memory")
#define PG8_BAR __builtin_amdgcn_s_barrier()
#define PG8_SCHED __builtin_amdgcn_sched_barrier(0)
    Unit cur, nxt; int ui = 0;
    if (!S.next(0, cur)) return;
    f32x4 acc[2][2][4][2];
#pragma unroll
    for (int a = 0; a < 2; ++a)
#pragma unroll
        for (int b = 0; b < 2; ++b)
#pragma unroll
            for (int m = 0; m < 4; ++m)
#pragma unroll
                for (int n = 0; n < 2; ++n) acc[a][b][m][n] = (f32x4){0.f, 0.f, 0.f, 0.f};
    typedef int i32x4_ __attribute__((ext_vector_type(4))); typedef int i32x8_ __attribute__((ext_vector_type(8)));
    int sc1_ = 0x7F7F7F7F; asm volatile("" : "+v"(sc1_));
    bf16x8 At[4][2], B0[2][2], B1[2][2]; i32x8_ At8[4], B08[2], B18[2];
    const char* cA = (const char*)g.A + (size_t)cur.pm * tstep; const char* cB = (const char*)g.Bt + (size_t)cur.pn * tstep;
    S.a_ready(cur);
    if constexpr (SP2) {
        PG8_STAGE(PG8_SB(0, 0), cB, voffB); PG8_STAGE(PG8_SB(0, 1), cB + hstep, voffB); PG8_STAGE(PG8_SA(0, 0), cA, voffA); PG8_STAGE(PG8_SA(0, 1), cA + hstep, voffA);
        if (wr == 1) PG8_BAR;
        PG8_WAIT_V(2); PG8_BAR;
        PG8_STAGE(PG8_SB(1, 0), cB + kstep, voffB); PG8_STAGE(PG8_SA(1, 0), cA + kstep, voffA); PG8_STAGE(PG8_SB(1, 1), cB + hstep + kstep, voffB);
        PG8_WAIT_V(6); PG8_BAR;
    } else {
        PG8_STAGE(PG8_SB(0, 0), cB, voffB); PG8_STAGE(PG8_SA(0, 0), cA, voffA); PG8_STAGE(PG8_SB(0, 1), cB + hstep, voffB); PG8_STAGE(PG8_SA(0, 1), cA + hstep, voffA);
        if (wr == 1) PG8_BAR;
        PG8_WAIT_V(4); PG8_BAR;
        PG8_STAGE(PG8_SB(1, 0), cB + kstep, voffB); PG8_STAGE(PG8_SA(1, 0), cA + kstep, voffA); PG8_STAGE(PG8_SB(1, 1), cB + hstep + kstep, voffB);
        PG8_WAIT_V(6); PG8_BAR;
    }
    for (;;) {
        const bool has_next = S.next(ui + 1, nxt);
        const char* nA = has_next ? (const char*)g.A + (size_t)nxt.pm * tstep : cA; const char* nB = has_next ? (const char*)g.Bt + (size_t)nxt.pn * tstep : cB;
        for (int t = 0; t < nt; t += 2) {
            const bool last = (t == nt - 2);
            const char* a1 = cA + (size_t)(t + 1) * kstep;
            const char* a2 = last ? nA : cA + (size_t)(t + 2) * kstep; const char* b2 = last ? nB : cB + (size_t)(t + 2) * kstep;
            const char* a3 = a2 + kstep; const char* b3 = b2 + kstep;
            if (last && has_next) S.a_ready(nxt);
            if constexpr (SP2) {
            PG8_LDB(B0, 0, 0); PG8_LDB(B1, 0, 1); PG8_SCHED; PG8_LDA(At, 0, 0); PG8_STAGE(PG8_SA(1, 1), a1 + hstep, voffA);
            PG8_WAIT_V(8); PG8_WAIT_L(0); PG8_BAR; PG8_MMA(0, 0, At, B0); PG8_MMA(0, 1, At, B1); PG8_BAR; PG8_SCHED;
            PG8_LDA(At, 0, 1); PG8_STAGE(PG8_SB(0, 0), b2, voffB); PG8_STAGE(PG8_SB(0, 1), b2 + hstep, voffB); PG8_STAGE(PG8_SA(0, 0), a2, voffA);
            PG8_WAIT_V(8); PG8_WAIT_L(0); PG8_BAR; PG8_MMA(1, 0, At, B0); PG8_MMA(1, 1, At, B1); PG8_BAR; PG8_SCHED;
            PG8_LDB(B0, 1, 0); PG8_LDB(B1, 1, 1); PG8_SCHED; PG8_LDA(At, 1, 0); PG8_STAGE(PG8_SA(0, 1), a2 + hstep, voffA);
            PG8_WAIT_V(8); PG8_WAIT_L(0); PG8_BAR; PG8_MMA(0, 0, At, B0); PG8_MMA(0, 1, At, B1); PG8_BAR; PG8_SCHED;
            PG8_LDA(At, 1, 1); PG8_STAGE(PG8_SB(1, 0), b3, voffB); PG8_STAGE(PG8_SB(1, 1), b3 + hstep, voffB); PG8_STAGE(PG8_SA(1, 0), a3, voffA);
            PG8_WAIT_V(8); PG8_WAIT_L(0); PG8_BAR; PG8_MMA(1, 0, At, B0); PG8_MMA(1, 1, At, B1); PG8_BAR; PG8_SCHED;
            } else {
            PG8_LDB(B0, 0, 0); PG8_SCHED; PG8_LDA(At, 0, 0); PG8_STAGE(PG8_SA(1, 1), a1 + hstep, voffA);
            PG8_WAIT_L(8); PG8_BAR; PG8_WAIT_L(0); PG8_MMA(0, 0, At, B0); PG8_BAR; PG8_SCHED;
            PG8_LDB(B1, 0, 1); PG8_STAGE(PG8_SB(0, 0), b2, voffB);
            PG8_BAR; PG8_WAIT_L(0); PG8_MMA(0, 1, At, B1); PG8_BAR;
            PG8_LDA(At, 0, 1); PG8_STAGE(PG8_SA(0, 0), a2, voffA);
            PG8_BAR; PG8_WAIT_L(0); PG8_MMA(1, 0, At, B0); PG8_BAR; PG8_SCHED;
            PG8_STAGE(PG8_SB(0, 1), b2 + hstep, voffB);
            PG8_WAIT_V(6); PG8_BAR; PG8_MMA(1, 1, At, B1); PG8_BAR;
            PG8_LDB(B0, 1, 0); PG8_SCHED; PG8_LDA(At, 1, 0); PG8_STAGE(PG8_SA(0, 1), a2 + hstep, voffA);
            PG8_WAIT_L(8); PG8_BAR; PG8_WAIT_L(0); PG8_MMA(0, 0, At, B0); PG8_BAR; PG8_SCHED;
            PG8_LDB(B1, 1, 1); PG8_STAGE(PG8_SB(1, 0), b3, voffB);
            PG8_BAR; PG8_WAIT_L(0); PG8_MMA(0, 1, At, B1); PG8_BAR;
            PG8_LDA(At, 1, 1); PG8_STAGE(PG8_SA(1, 0), a3, voffA);
            PG8_BAR; PG8_WAIT_L(0); PG8_MMA(1, 0, At, B0); PG8_BAR; PG8_SCHED;
            PG8_STAGE(PG8_SB(1, 1), b3 + hstep, voffB);
            PG8_WAIT_V(6); PG8_BAR; PG8_MMA(1, 1, At, B1); PG8_BAR;
            }
        }
        if constexpr (ALIGN_EPI) { if (wr == 0) PG8_BAR; }
        if constexpr (FP8) asm volatile("s_nop 15\n\ts_nop 15" ::: "memory");
        if constexpr (!Epi::AFTER_DRAIN) { E(acc, cur, wr, wc, fr, fq); S.done(cur); }
        if (!has_next) break;
#pragma unroll
        for (int a = 0; a < 2; ++a)
#pragma unroll
            for (int b = 0; b < 2; ++b)
#pragma unroll
                for (int m = 0; m < 4; ++m)
#pragma unroll
                    for (int n = 0; n < 2; ++n) acc[a][b][m][n] = (f32x4){0.f, 0.f, 0.f, 0.f};
        cur = nxt; cA = nA; cB = nB; ++ui;
        if constexpr (ALIGN_EPI) { if (wr == 1) PG8_BAR; }
    }
    PG8_WAIT_V(0);
    if constexpr (!ALIGN_EPI) { if (wr == 0) PG8_BAR; }
    PG8_BAR;
    if constexpr (Epi::AFTER_DRAIN) { E.fused(acc, cur, wr, wc, fr, fq, lds, wid, lane); S.done(cur); }
#undef PG8_SA
#undef PG8_SB
#undef PG8_STAGE
#undef PG8_LDA
#undef PG8_LD8
#undef PG8_LDB
#undef PG8_MMA
#undef PG8_WAIT_V
#undef PG8_WAIT_L
#undef PG8_BAR
#undef PG8_SCHED
}
}
namespace pg8 {
typedef unsigned u32x2 __attribute__((ext_vector_type(2)));
constexpr int LDX = 2048;
constexpr float RMS_EPS = 1e-6f;
#ifndef EPI_SC1
#define EPI_SC1 1
#endif
__device__ __forceinline__ void store16(void* p, u32x4 w) {
#if EPI_SC1
    asm volatile("global_store_dwordx4 %0, %1, off sc1\n\ts_nop 1" :: "v"(p), "v"(w) : "memory");
#else
    *(u32x4*)p = w;
#endif
}
struct EpiQKV {
    static constexpr bool PERM = true, AFTER_DRAIN = false;
    bf16_t* O; const float* cs; float qscale; float* ksum; int vmode; float vscale;
    __device__ __forceinline__ void operator()(const f32x4 (&acc)[2][2][4][2], const Unit& u, int wr, int wc, int fr, int fq) const {
        const int row0 = u.pm * BM + wr * 64 + fr, pn = vmode ? (u.pn < 4 ? u.pn + 8 : u.pn + 16) : (u.pn < 8 ? u.pn : u.pn + 4);
        const float sc = (pn < 4 || (pn >= 12 && pn < 16)) ? qscale : vscale;
        const bool rot = (pn >= 12 && pn < 20) && (wc == 0);
        bf16_t* Ot = O + ((size_t)((u.pm >> 3) * 6 + (pn >> 2)) * 8 + (pn & 3) * 2) * (2048 * 128) + wc * 32 + 8 * fq;
        const bool kacc = (pn >= 16 && pn < 20);
        f32x4 ks[2][2] = {{{0.f, 0.f, 0.f, 0.f}, {0.f, 0.f, 0.f, 0.f}}, {{0.f, 0.f, 0.f, 0.f}, {0.f, 0.f, 0.f, 0.f}}};
#pragma unroll
        for (int ai = 0; ai < 2; ++ai)
#pragma unroll
            for (int m = 0; m < 4; ++m) { const int row = row0 + ai * HALF + m * 16; bf16_t* rowp = Ot + (size_t)(row & 2047) * 128;
                f32x4 c0 = {1.f, 1.f, 1.f, 1.f}, c1 = c0, s0 = {0.f, 0.f, 0.f, 0.f}, s1 = s0;
                if (rot) { const float* cr = cs + (size_t)row * 32 + 8 * (fq & 1); c0 = *(const f32x4*)cr; c1 = *(const f32x4*)(cr + 4); s0 = *(const f32x4*)(cr + 16); s1 = *(const f32x4*)(cr + 20);
                    if (fq < 2) { s0 = -s0; s1 = -s1; } }
#pragma unroll
                for (int bj = 0; bj < 2; ++bj) { f32x4 v0 = acc[ai][bj][m][0], v1 = acc[ai][bj][m][1];
                    if (rot) { f32x4 p0, p1;
#pragma unroll
                        for (int j = 0; j < 4; ++j) { p0[j] = __shfl_xor(v0[j], 32); p1[j] = __shfl_xor(v1[j], 32); }
                        v0 = v0 * c0 + p0 * s0; v1 = v1 * c1 + p1 * s1; }
                    if (kacc) { ks[bj][0] += v0; ks[bj][1] += v1; }
                    v0 = v0 * sc; v1 = v1 * sc; u32x4 w; w.x = cvt_pk_bf16(v0[0], v0[1]); w.y = cvt_pk_bf16(v0[2], v0[3]); w.z = cvt_pk_bf16(v1[0], v1[1]); w.w = cvt_pk_bf16(v1[2], v1[3]);
                    store16(rowp + (size_t)bj * (2048 * 128), w); } }
        if (kacc) {
            float* kp = ksum + (size_t)(((u.pm >> 3) * 8 + (pn - 16) * 2) * 8 + (u.pm & 7)) * 128 + wc * 32 + 8 * fq;
#pragma unroll
            for (int bj = 0; bj < 2; ++bj)
#pragma unroll
                for (int n = 0; n < 2; ++n)
#pragma unroll
                    for (int j = 0; j < 4; ++j) { float s = ks[bj][n][j]; s += __shfl_xor(s, 1); s += __shfl_xor(s, 2); s += __shfl_xor(s, 4); s += __shfl_xor(s, 8);
                        if (fr == 0) atomicAdd(kp + bj * 1024 + n * 4 + j, s); }
        }
    }
};
__device__ __forceinline__ unsigned pk4_fp8(float a, float b, float c, float d) {
    a = __builtin_amdgcn_fmed3f(a, -448.f, 448.f); b = __builtin_amdgcn_fmed3f(b, -448.f, 448.f); c = __builtin_amdgcn_fmed3f(c, -448.f, 448.f); d = __builtin_amdgcn_fmed3f(d, -448.f, 448.f);
    int p = __builtin_amdgcn_cvt_pk_fp8_f32(a, b, 0, false); p = __builtin_amdgcn_cvt_pk_fp8_f32(c, d, p, true); return (unsigned)p; }
struct EpiRes {
    static constexpr bool PERM = false, AFTER_DRAIN = false;
    const float* base; float* out; bf16_t* xb; float* ssq; unsigned char* x8; float s8; float ascale;
    __device__ __forceinline__ void operator()(const f32x4 (&acc)[2][2][4][2], const Unit& u, int wr, int wc, int fr, int fq) const {
        const int row0 = u.pm * BM + wr * 64 + fr, col0 = u.pn * BM + wc * 32 + 4 * fq;
#pragma unroll
        for (int ai = 0; ai < 2; ++ai)
#pragma unroll
            for (int m = 0; m < 4; ++m) { const int row = row0 + ai * HALF + m * 16; const size_t off = (size_t)row * LDX + col0; float s = 0.f;
#pragma unroll
                for (int bj = 0; bj < 2; ++bj)
#pragma unroll
                    for (int n = 0; n < 2; ++n) { const f32x4 v = *(const f32x4*)(base + off + bj * HALF + n * 16) + acc[ai][bj][m][n] * ascale;
                        *(f32x4*)(out + off + bj * HALF + n * 16) = v; s += (v[0] * v[0] + v[1] * v[1]) + (v[2] * v[2] + v[3] * v[3]);
                        if (xb) { u32x2 w; w.x = cvt_pk_bf16(v[0], v[1]); w.y = cvt_pk_bf16(v[2], v[3]); *(u32x2*)(xb + off + bj * HALF + n * 16) = w; }
                        if (x8) { *(unsigned*)(x8 + off + bj * HALF + n * 16) = pk4_fp8(v[0] * s8, v[1] * s8, v[2] * s8, v[3] * s8); } }
                if (ssq) { s += __shfl_xor(s, 16); s += __shfl_xor(s, 32); if (fq == 0) atomicAdd(ssq + row, s); }
                asm volatile("" ::: "memory"); }
    }
};
template <bool BASE_F32> struct EpiResB {
    static constexpr bool PERM = true, AFTER_DRAIN = false;
    const void* base; bf16_t* xo; float* ssq; unsigned char* x8; float s8; float ascale;
    __device__ __forceinline__ void operator()(const f32x4 (&acc)[2][2][4][2], const Unit& u, int wr, int wc, int fr, int fq) const {
        const int row0 = u.pm * BM + wr * 64 + fr, col0 = u.pn * BM + wc * 32 + 8 * fq;
#pragma unroll
        for (int ai = 0; ai < 2; ++ai)
#pragma unroll
            for (int m = 0; m < 4; ++m) { const int row = row0 + ai * HALF + m * 16; const size_t off = (size_t)row * LDX + col0; float s = 0.f;
#pragma unroll
                for (int bj = 0; bj < 2; ++bj) { f32x4 b0, b1;
                    if (BASE_F32) { const float* bp = (const float*)base + off + bj * HALF; b0 = *(const f32x4*)bp; b1 = *(const f32x4*)(bp + 4); }
                    else { const u32x4 w = *(const u32x4*)((const bf16_t*)base + off + bj * HALF);
                        b0 = (f32x4){__uint_as_float(w.x << 16), __uint_as_float(w.x & 0xffff0000u), __uint_as_float(w.y << 16), __uint_as_float(w.y & 0xffff0000u)};
                        b1 = (f32x4){__uint_as_float(w.z << 16), __uint_as_float(w.z & 0xffff0000u), __uint_as_float(w.w << 16), __uint_as_float(w.w & 0xffff0000u)}; }
                    const f32x4 v0 = b0 + acc[ai][bj][m][0] * ascale, v1 = b1 + acc[ai][bj][m][1] * ascale;
                    s += ((v0[0] * v0[0] + v0[1] * v0[1]) + (v0[2] * v0[2] + v0[3] * v0[3])) + ((v1[0] * v1[0] + v1[1] * v1[1]) + (v1[2] * v1[2] + v1[3] * v1[3]));
                    if (xo) { u32x4 w; w.x = cvt_pk_bf16(v0[0], v0[1]); w.y = cvt_pk_bf16(v0[2], v0[3]); w.z = cvt_pk_bf16(v1[0], v1[1]); w.w = cvt_pk_bf16(v1[2], v1[3]); store16(xo + off + bj * HALF, w); }
                    if (x8) { u32x2 w8; w8.x = pk4_fp8(v0[0] * s8, v0[1] * s8, v0[2] * s8, v0[3] * s8); w8.y = pk4_fp8(v1[0] * s8, v1[1] * s8, v1[2] * s8, v1[3] * s8); *(u32x2*)(x8 + off + bj * HALF) = w8; } }
                if (ssq) { s += __shfl_xor(s, 16); s += __shfl_xor(s, 32); if (fq == 0) atomicAdd(ssq + row, s); }
                if (BASE_F32 ? (m & 1) : (m == 3)) asm volatile("" ::: "memory"); }
    }
};
struct EpiScale {
    static constexpr bool PERM = true, AFTER_DRAIN = false;
    bf16_t* O; int ldc; const float* ssq; float sc;
    __device__ __forceinline__ void operator()(const f32x4 (&acc)[2][2][4][2], const Unit& u, int wr, int wc, int fr, int fq) const {
        const int row0 = u.pm * BM + wr * 64 + fr, col0 = u.pn * BM + wc * 32 + 8 * fq;
        float sv[2][4];
#pragma unroll
        for (int ai = 0; ai < 2; ++ai)
#pragma unroll
            for (int m = 0; m < 4; ++m) sv[ai][m] = ssq ? ssq[row0 + ai * HALF + m * 16] : 0.f;
#pragma unroll
        for (int ai = 0; ai < 2; ++ai)
#pragma unroll
            for (int m = 0; m < 4; ++m) { const int row = row0 + ai * HALF + m * 16; bf16_t* rowp = O + (size_t)row * ldc + col0;
                const float f = ssq ? sc * __builtin_amdgcn_rsqf(sv[ai][m] * (1.0f / 2048.0f) + RMS_EPS) : sc;
#pragma unroll
                for (int bj = 0; bj < 2; ++bj) { const f32x4 v0 = acc[ai][bj][m][0] * f, v1 = acc[ai][bj][m][1] * f;
                    u32x4 w; w.x = cvt_pk_bf16(v0[0], v0[1]); w.y = cvt_pk_bf16(v0[2], v0[3]); w.z = cvt_pk_bf16(v1[0], v1[1]); w.w = cvt_pk_bf16(v1[2], v1[3]);
                    *(u32x4*)(rowp + bj * HALF) = w; } }
    }
};
struct EpiNull { static constexpr bool PERM = true, AFTER_DRAIN = false; float* sink;
    __device__ __forceinline__ void operator()(const f32x4 (&acc)[2][2][4][2], const Unit& u, int wr, int wc, int fr, int fq) const {
#pragma unroll
        for (int ai = 0; ai < 2; ++ai)
#pragma unroll
            for (int bj = 0; bj < 2; ++bj)
#pragma unroll
                for (int m = 0; m < 4; ++m)
#pragma unroll
                    for (int n = 0; n < 2; ++n) asm volatile("" :: "v"(acc[ai][bj][m][n])); } };
struct EpiSwiGLU {
    static constexpr bool PERM = true, AFTER_DRAIN = false;
    bf16_t* O; const float* ssq; unsigned char* O8; float ascale, oscale;
    __device__ __forceinline__ void operator()(const f32x4 (&acc)[2][2][4][2], const Unit& u, int wr, int wc, int fr, int fq) const {
        const int row0 = u.pm * BM + wr * 64 + fr, col0 = u.pn * HALF + wc * 32 + 8 * fq;
        float sv[2][4];
#pragma unroll
        for (int ai = 0; ai < 2; ++ai)
#pragma unroll
            for (int m = 0; m < 4; ++m) sv[ai][m] = ssq[row0 + ai * HALF + m * 16];
#pragma unroll
        for (int ai = 0; ai < 2; ++ai)
#pragma unroll
            for (int m = 0; m < 4; ++m) { const int row = row0 + ai * HALF + m * 16; bf16_t* rowp = O + (size_t)row * 5632 + col0;
                const float f = ascale * __builtin_amdgcn_rsqf(sv[ai][m] * (1.0f / 2048.0f) + RMS_EPS);
                const float fneg = -1.4426950408889634f * f, f2o = f * f * (O8 ? oscale : 1.0f);
                float r[8];
#pragma unroll
                for (int n = 0; n < 2; ++n)
#pragma unroll
                    for (int j = 0; j < 4; ++j) { const float ag = acc[ai][0][m][n][j], au = acc[ai][1][m][n][j];
                        r[n * 4 + j] = (ag * au) * (f2o * __builtin_amdgcn_rcpf(1.0f + __builtin_amdgcn_exp2f(fneg * ag))); }
                if (O8) { u32x2 w8; w8.x = pk4_fp8(r[0], r[1], r[2], r[3]); w8.y = pk4_fp8(r[4], r[5], r[6], r[7]);
                    *(u32x2*)(O8 + (size_t)row * 5632 + col0) = w8; }
                else { u32x4 w; w.x = cvt_pk_bf16(r[0], r[1]); w.y = cvt_pk_bf16(r[2], r[3]); w.z = cvt_pk_bf16(r[4], r[5]); w.w = cvt_pk_bf16(r[6], r[7]);
                *(u32x4*)rowp = w; } }
    }
};
}
namespace att {
using bf16x8 = __attribute__((ext_vector_type(8))) short;
using s16x4  = __attribute__((ext_vector_type(4))) short;
using f32x16 = __attribute__((ext_vector_type(16))) float;
using f32x4  = __attribute__((ext_vector_type(4))) float;
using u32x4  = __attribute__((ext_vector_type(4))) unsigned;
typedef unsigned short bf16;
constexpr int D = 128, KVBLK = 64;
constexpr int SHM_V = KVBLK * D * 2, SHM_K = KVBLK * D * 2;
constexpr int OFF_Q = 2 * SHM_V + 2 * SHM_K, OFF_WS = 131072 + 1024, OFF_KM = OFF_WS + 2048, ATT_LDS = OFF_KM + 4096;
constexpr float THR = 8.f;
constexpr float SB_DONE = 7.8886e-31f;
#ifndef QREG_SOFTMAX
#define QREG_SOFTMAX 1
#endif
#ifndef PIPE_SOFTMAX
#define PIPE_SOFTMAX 0
#endif
#define KSWZ(row, colB) ((row) * 256 + ((colB) ^ (((row) & 7) << 4)))
#define SBAR() __builtin_amdgcn_sched_barrier(0)
__device__ __forceinline__ int crow(int r, int hi) { return (r & 3) + 8 * (r >> 2) + 4 * hi; }
__device__ __forceinline__ unsigned cvtpk(float lo, float hi) { unsigned r; asm volatile("v_cvt_pk_bf16_f32 %0, %1, %2" : "=v"(r) : "v"(lo), "v"(hi)); return r; }
__device__ __forceinline__ float xchg32(float x, int hi) { auto rr = __builtin_amdgcn_permlane32_swap(__float_as_uint(x), __float_as_uint(x), false, false); return __uint_as_float(hi ? rr[0] : rr[1]); }
typedef __attribute__((address_space(3))) const char* lds_cp;
template <int D0> __device__ __forceinline__ void qkt_part(f32x16& p0, f32x16& p1, const lds_cp (&ka)[2][4], int boff, const lds_cp (&qa)[2][4]) {
  const bf16x8 qf = *reinterpret_cast<const __attribute__((address_space(3))) bf16x8*>(qa[D0 >> 2][D0 & 3]);
  const bf16x8 b0 = *reinterpret_cast<const __attribute__((address_space(3))) bf16x8*>(ka[D0 >> 2][D0 & 3] + boff);
  const bf16x8 b1 = *reinterpret_cast<const __attribute__((address_space(3))) bf16x8*>(ka[D0 >> 2][D0 & 3] + boff + 8192);
  p0 = __builtin_amdgcn_mfma_f32_32x32x16_bf16(b0, qf, p0, 0, 0, 0);
  p1 = __builtin_amdgcn_mfma_f32_32x32x16_bf16(b1, qf, p1, 0, 0, 0);
}
template <int D0> __device__ __forceinline__ void qkt_part(f32x16& p0, f32x16& p1, const lds_cp (&ka)[2][4], int boff, const bf16x8 (&qg)[8]) {
  const bf16x8 b0 = *reinterpret_cast<const __attribute__((address_space(3))) bf16x8*>(ka[D0 >> 2][D0 & 3] + boff);
  const bf16x8 b1 = *reinterpret_cast<const __attribute__((address_space(3))) bf16x8*>(ka[D0 >> 2][D0 & 3] + boff + 8192);
  p0 = __builtin_amdgcn_mfma_f32_32x32x16_bf16(b0, qg[D0], p0, 0, 0, 0);
  p1 = __builtin_amdgcn_mfma_f32_32x32x16_bf16(b1, qg[D0], p1, 0, 0, 0);
}
#define KLD(G, A0, A1) do { A0 = *reinterpret_cast<const __attribute__((address_space(3))) bf16x8*>(ka[(G) >> 2][(G) & 3] + boff); A1 = *reinterpret_cast<const __attribute__((address_space(3))) bf16x8*>(ka[(G) >> 2][(G) & 3] + boff + 8192); } while (0)
#define KMM(G, A0, A1) do { p0 = __builtin_amdgcn_mfma_f32_32x32x16_bf16(A0, qg[G], p0, 0, 0, 0); p1 = __builtin_amdgcn_mfma_f32_32x32x16_bf16(A1, qg[G], p1, 0, 0, 0); } while (0)
__device__ __forceinline__ void qkt(f32x16& p0, f32x16& p1, const lds_cp (&ka)[2][4], int boff, const bf16x8 (&qg)[8], float bias = 0.f) {
#pragma unroll
  for (int r = 0; r < 16; ++r) { p0[r] = bias; p1[r] = bias; }
  bf16x8 a0, a1, b0, b1, c0, c1, d0, d1;
  KLD(0, a0, a1); KLD(1, b0, b1); KLD(2, c0, c1); KLD(3, d0, d1); SBAR();
  KMM(0, a0, a1); SBAR(); KLD(4, a0, a1); SBAR();
  KMM(1, b0, b1); SBAR(); KLD(5, b0, b1); SBAR();
  KMM(2, c0, c1); SBAR(); KLD(6, c0, c1); SBAR();
  KMM(3, d0, d1); SBAR(); KLD(7, d0, d1); SBAR();
  KMM(4, a0, a1); KMM(5, b0, b1); KMM(6, c0, c1); KMM(7, d0, d1);
}
#undef KLD
#undef KMM
__device__ __forceinline__ void qkt(f32x16& p0, f32x16& p1, const lds_cp (&ka)[2][4], int boff, const lds_cp (&qr)[2][4], float bias = 0.f) {
#pragma unroll
  for (int r = 0; r < 16; ++r) { p0[r] = bias; p1[r] = bias; }
  qkt_part<0>(p0, p1, ka, boff, qr); qkt_part<1>(p0, p1, ka, boff, qr); qkt_part<2>(p0, p1, ka, boff, qr); qkt_part<3>(p0, p1, ka, boff, qr);
  qkt_part<4>(p0, p1, ka, boff, qr); qkt_part<5>(p0, p1, ka, boff, qr); qkt_part<6>(p0, p1, ka, boff, qr); qkt_part<7>(p0, p1, ka, boff, qr);
}
__device__ __forceinline__ int v_st(int k, int c) { const int kk = (k & ~0xC) | ((k & 4) << 1) | ((k & 8) >> 1); return ((kk >> 3) * 4 + (c >> 5)) * 512 + ((kk & 7) * 32 + (c & 31)) * 2; }
__device__ __forceinline__ int v_rd_base(int lane) { return ((lane & 3) << 3) | (((lane >> 2) & 3) << 6) | (((lane >> 4) & 1) << 5) | (((lane >> 5) & 1) << 8); }
constexpr int v_rd_off(int d0, int ks, int half) { return d0 * 512 + ks * 4096 + half * 2048; }
template <int OFF> __device__ __forceinline__ s16x4 tr_read(int vb) { s16x4 r; asm volatile("ds_read_b64_tr_b16 %0, %1 offset:%2" : "=&v"(r) : "v"(vb), "i"(OFF) : "memory"); return r; }
struct VFrag { s16x4 l0, h0, l1, h1, l2, h2, l3, h3; };
template <int D0> __device__ __forceinline__ void v_read(VFrag& f, int vb) {
  f.l0 = tr_read<v_rd_off(D0, 0, 0)>(vb); f.h0 = tr_read<v_rd_off(D0, 0, 1)>(vb); f.l1 = tr_read<v_rd_off(D0, 1, 0)>(vb); f.h1 = tr_read<v_rd_off(D0, 1, 1)>(vb);
  f.l2 = tr_read<v_rd_off(D0, 2, 0)>(vb); f.h2 = tr_read<v_rd_off(D0, 2, 1)>(vb); f.l3 = tr_read<v_rd_off(D0, 3, 0)>(vb); f.h3 = tr_read<v_rd_off(D0, 3, 1)>(vb);
}
__device__ __forceinline__ void pv_mma(f32x16& od, const VFrag& f, bf16x8 pa0, bf16x8 pa1, bf16x8 pa2, bf16x8 pa3) {
#define PK(L, H) (bf16x8){L[0], L[1], L[2], L[3], H[0], H[1], H[2], H[3]}
  od = __builtin_amdgcn_mfma_f32_32x32x16_bf16(pa0, PK(f.l0, f.h0), od, 0, 0, 0);
  od = __builtin_amdgcn_mfma_f32_32x32x16_bf16(pa1, PK(f.l1, f.h1), od, 0, 0, 0);
  od = __builtin_amdgcn_mfma_f32_32x32x16_bf16(pa2, PK(f.l2, f.h2), od, 0, 0, 0);
  od = __builtin_amdgcn_mfma_f32_32x32x16_bf16(pa3, PK(f.l3, f.h3), od, 0, 0, 0);
#undef PK
}
__device__ __forceinline__ void pv_d0(f32x16* o, int vb, bf16x8 pa0, bf16x8 pa1, bf16x8 pa2, bf16x8 pa3) {
  VFrag fa, fb;
  v_read<0>(fa, vb);
  v_read<1>(fb, vb); asm volatile("s_waitcnt lgkmcnt(8)" ::: "memory"); SBAR(); pv_mma(o[0], fa, pa0, pa1, pa2, pa3); SBAR();
  v_read<2>(fa, vb); asm volatile("s_waitcnt lgkmcnt(8)" ::: "memory"); SBAR(); pv_mma(o[1], fb, pa0, pa1, pa2, pa3); SBAR();
  v_read<3>(fb, vb); asm volatile("s_waitcnt lgkmcnt(8)" ::: "memory"); SBAR(); pv_mma(o[2], fa, pa0, pa1, pa2, pa3); SBAR();
  asm volatile("s_waitcnt lgkmcnt(0)" ::: "memory"); SBAR(); pv_mma(o[3], fb, pa0, pa1, pa2, pa3);
}
__device__ __forceinline__ void pack_p(const f32x16& p0, const f32x16& p1, bf16x8& pa0, bf16x8& pa1, bf16x8& pa2, bf16x8& pa3) {
#define PK4(P, BASE, OUT) do { unsigned a0 = cvtpk(P[BASE + 0], P[BASE + 1]), a1 = cvtpk(P[BASE + 2], P[BASE + 3]);   \
    unsigned b0 = cvtpk(P[BASE + 4], P[BASE + 5]), b1 = cvtpk(P[BASE + 6], P[BASE + 7]);                              \
    auto r0 = __builtin_amdgcn_permlane32_swap(a0, b0, false, false); auto r1 = __builtin_amdgcn_permlane32_swap(a1, b1, false, false); \
    u32x4 w = {r0[0], r1[0], r0[1], r1[1]}; OUT = *reinterpret_cast<bf16x8*>(&w); } while (0)
  PK4(p0, 0, pa0); PK4(p0, 8, pa1); PK4(p1, 0, pa2); PK4(p1, 8, pa3);
#undef PK4
}
__device__ __forceinline__ void softmax_tile(f32x16& p0, f32x16& p1, float& m_reg, float& l_reg, float& alpha) {
  float pmax = p0[0];
#pragma unroll
  for (int r = 1; r < 16; ++r) pmax = fmaxf(pmax, p0[r]);
#pragma unroll
  for (int r = 0; r < 16; ++r) pmax = fmaxf(pmax, p1[r]);
  pmax = fmaxf(pmax, xchg32(pmax, (int)(threadIdx.x >> 5) & 1));
  if (__all(pmax - m_reg <= THR)) { alpha = 1.f; }
  else { const float mn = fmaxf(m_reg, pmax); alpha = __builtin_amdgcn_exp2f(m_reg - mn); m_reg = mn; }
  float ps = 0.f;
#pragma unroll
  for (int r = 0; r < 16; ++r) { p0[r] = __builtin_amdgcn_exp2f(p0[r] - m_reg); ps += p0[r]; }
#pragma unroll
  for (int r = 0; r < 16; ++r) { p1[r] = __builtin_amdgcn_exp2f(p1[r] - m_reg); ps += p1[r]; }
  ps += xchg32(ps, (int)(threadIdx.x >> 5) & 1);
  l_reg = l_reg * alpha + ps;
}
template <bool BAND, int I> __device__ __forceinline__ float sb_group(f32x16& P, int kb, int qrel, int hi) {
  float run = 1.f;
#pragma unroll
  for (int e = 3; e >= 0; --e) { const int r = 4 * I + e; float rr = __builtin_amdgcn_rcpf(1.0f + __builtin_amdgcn_exp2f(P[r]));
    if (BAND) rr = (kb + crow(r, hi) < qrel) ? rr : 1.f;
    P[r] = (1.0f - rr) * run; run *= rr; }
  return run;
}
__device__ __forceinline__ void sb_combine(f32x16& p0, f32x16& p1, float (&gs)[8], float& carry, int hi) {
  float acc = 1.f;
#pragma unroll
  for (int i = 7; i >= 0; --i) { const float so_i = acc; acc *= gs[i]; const float x = hi ? acc : so_i; gs[i] = carry * so_i * xchg32(x, hi); }
  carry *= acc * xchg32(acc, hi);
#pragma unroll
  for (int i = 0; i < 4; ++i)
#pragma unroll
    for (int e = 0; e < 4; ++e) { p0[4 * i + e] *= gs[i]; p1[4 * i + e] *= gs[4 + i]; }
}
template <bool BAND>
__device__ __forceinline__ void sb_tile(f32x16& p0, f32x16& p1, float& carry, int kb, int qrel, int hi) {
  float gs[8];
  gs[0] = sb_group<BAND, 0>(p0, kb, qrel, hi); SBAR(); gs[1] = sb_group<BAND, 1>(p0, kb, qrel, hi); SBAR(); gs[2] = sb_group<BAND, 2>(p0, kb, qrel, hi); SBAR(); gs[3] = sb_group<BAND, 3>(p0, kb, qrel, hi); SBAR();
  gs[4] = sb_group<BAND, 0>(p1, kb + 32, qrel, hi); SBAR(); gs[5] = sb_group<BAND, 1>(p1, kb + 32, qrel, hi); SBAR(); gs[6] = sb_group<BAND, 2>(p1, kb + 32, qrel, hi); SBAR(); gs[7] = sb_group<BAND, 3>(p1, kb + 32, qrel, hi); SBAR();
  sb_combine(p0, p1, gs, carry, hi);
}

template <int MODE, bool OUT8 = false>
__device__ __forceinline__ void attn_unit(const bf16* __restrict__ Qb, int ldq, const bf16* __restrict__ Kh, const bf16* __restrict__ Vh, int ldk, bf16* __restrict__ Ob, int ldo,
                                          const float* __restrict__ gain, const float* __restrict__ kmean, int qb, int nkeys, char* lds, float s8 = 1.f) {
  int tid_ = threadIdx.x; asm volatile("" : "+v"(tid_));
  const int tid = tid_, wid = __builtin_amdgcn_readfirstlane(tid >> 6), lane = tid & 63, r32 = lane & 31, hi = lane >> 5;
  char* V_lds = lds; char* K_lds = lds + 2 * SHM_V;
  float* ws = (float*)(lds + OFF_WS) + wid * 64; float* li_l = ws; float* al_l = ws + 32;
  float* km_l = (float*)(lds + OFF_KM);
  int* flg = (int*)(lds + OFF_KM);
  const int NT = (MODE == 0) ? nkeys / KVBLK : 4 * (qb + 1);
  const int qrel = wid * 32 + r32;
  float m_reg = -1e30f, l_reg = 0.f, carry = 1.f; f32x16 o[4] = {};
  const int vb0 = (int)(uintptr_t)V_lds + v_rd_base(lane);
  lds_cp ka[2][4];
#pragma unroll
  for (int y = 0; y < 2; ++y)
#pragma unroll
    for (int x = 0; x < 4; ++x) ka[y][x] = (lds_cp)(__attribute__((address_space(3))) char*)K_lds + r32 * 256 + 128 * (y ^ ((r32 >> 3) & 1)) + 32 * (x ^ ((r32 >> 1) & 3)) + 16 * (hi ^ (r32 & 1));
  lds_cp qr[2][4];
#pragma unroll
  for (int y = 0; y < 2; ++y)
#pragma unroll
    for (int x = 0; x < 4; ++x) qr[y][x] = ka[y][x] + (OFF_Q - 2 * SHM_V) + wid * 8192;
  long ksrc[2], vsrc[2];
#pragma unroll
  for (int i = 0; i < 2; ++i) { const int piece = wid + 8 * i;
    { const int row = piece * 4 + (lane >> 4), c = (lane & 15) ^ (row & 15); ksrc[i] = (long)row * ldk + c * 8; }
    { const int sub = piece * 2 + (lane >> 5), kk = (sub >> 2) * 8 + ((lane & 31) >> 2), k = (kk & ~0xC) | ((kk & 4) << 1) | ((kk & 8) >> 1), c = (sub & 3) * 32 + (lane & 3) * 8; vsrc[i] = (long)k * ldk + c; } }
  typedef __attribute__((address_space(3))) unsigned lds_u32;
  lds_u32* kdst = (lds_u32*)(__attribute__((address_space(3))) char*)(K_lds) + wid * 256; lds_u32* vdst = (lds_u32*)(__attribute__((address_space(3))) char*)(V_lds) + wid * 256;
#define TILE(it) ((MODE == 2) ? (NT - 1 - (it)) : (it))
#define DMA_K(k0, b) do { _Pragma("unroll") for (int i_ = 0; i_ < 2; ++i_) __builtin_amdgcn_global_load_lds((const unsigned*)(Kh + (long)(k0) * ldk + ksrc[i_]), kdst + (b) * (SHM_K / 4) + i_ * 2048, 16, 0, 0); } while (0)
#define DMA_V(k0, b) do { _Pragma("unroll") for (int i_ = 0; i_ < 2; ++i_) __builtin_amdgcn_global_load_lds((const unsigned*)(Vh + (long)(k0) * ldk + vsrc[i_]), vdst + (b) * (SHM_V / 4) + i_ * 2048, 16, 0, 0); } while (0)
#define SDRAIN() asm volatile("s_waitcnt vmcnt(0)" ::: "memory")
#define KSLOT(i_) ((i_) == 2 ? (OFF_Q - 2 * SHM_V) : (i_) * SHM_K)
#define VSLOT(i_) ((i_) == 2 ? (OFF_Q + SHM_K) : (i_) * SHM_V)
#define DMA_K3(k0, so) do { _Pragma("unroll") for (int i_ = 0; i_ < 2; ++i_) __builtin_amdgcn_global_load_lds((const unsigned*)(Kh + (long)(k0) * ldk + ksrc[i_]), kdst + (so) / 4 + i_ * 2048, 16, 0, 0); } while (0)
#define DMA_V3(k0, so) do { _Pragma("unroll") for (int i_ = 0; i_ < 2; ++i_) __builtin_amdgcn_global_load_lds((const unsigned*)(Vh + (long)(k0) * ldk + vsrc[i_]), vdst + (so) / 4 + i_ * 2048, 16, 0, 0); } while (0)
  { lds_u32* qdst = (lds_u32*)(__attribute__((address_space(3))) char*)(lds + OFF_Q) + wid * 2048;
#pragma unroll
    for (int i = 0; i < 8; ++i) { const int row = 4 * i + (lane >> 4), c = (lane & 15) ^ (row & 15);
      __builtin_amdgcn_global_load_lds((const unsigned*)(Qb + (long)(wid * 32 + row) * ldq + c * 8), qdst + i * 256, 16, 0, 0); } }
  DMA_K(TILE(0) * KVBLK, 0); DMA_V(TILE(0) * KVBLK, 0); if (MODE == 2 || PIPE_SOFTMAX) DMA_K(TILE(1) * KVBLK, 1);
  constexpr bool RING3 = (MODE != 2) && QREG_SOFTMAX && !PIPE_SOFTMAX;
  unsigned selmask = 0u;
  if (MODE == 1) { if (tid < 256) *(f32x4*)(km_l + tid * 4) = *(const f32x4*)(kmean + tid * 4); }
  SDRAIN();
  __syncthreads();
  if (MODE == 1) {
    float g[8];
#pragma unroll
    for (int n = 0; n < 8; ++n) g[n] = 0.f;
    { const int rh = (r32 >> 1) & 3, r3 = (r32 >> 3) & 1;
      const lds_cp qbase = qr[0][0] - 32 * rh - 128 * r3;
#pragma unroll 1
      for (int d0 = 0; d0 < 8; ++d0) {
        const bf16x8 qf = *reinterpret_cast<const __attribute__((address_space(3))) bf16x8*>(qbase + 32 * ((d0 & 3) ^ rh) + 128 * ((d0 >> 2) ^ r3));
        float q[8];
#pragma unroll
        for (int j = 0; j < 8; ++j) q[j] = __uint_as_float(((unsigned)(unsigned short)qf[j]) << 16);
        const float* kmp = km_l + d0 * 16 + hi * 8;
#pragma unroll
        for (int n = 0; n < 7; ++n) { const f32x4 k0v = *(const f32x4*)(kmp + n * 128), k1v = *(const f32x4*)(kmp + n * 128 + 4);
          g[n] += (q[0] * k0v[0] + q[1] * k0v[1]) + (q[2] * k0v[2] + q[3] * k0v[3]) + (q[4] * k1v[0] + q[5] * k1v[1]) + (q[6] * k1v[2] + q[7] * k1v[3]); }
      } }
#pragma unroll
    for (int n = 0; n < 7; ++n) { g[n] += xchg32(g[n], hi); if (n >= qb) g[n] = -INFINITY; }
    g[7] = -INFINITY;
#pragma unroll
    for (int n = 0; n < 7; ++n) { int cnt = 0;
#pragma unroll
      for (int mI = 0; mI < 7; ++mI) { if (mI != n) cnt += (g[mI] > g[n] || (g[mI] == g[n] && mI < n)) ? 1 : 0; }
      if (n < qb && cnt < 3) selmask |= (1u << n); }
  }
  bf16x8 qg[8];
  if (QREG_SOFTMAX && MODE != 2) {
#pragma unroll
    for (int d0 = 0; d0 < 8; ++d0) qg[d0] = *reinterpret_cast<const __attribute__((address_space(3))) bf16x8*>(qr[d0 >> 2][d0 & 3]); }
  int kc = KSLOT(0), kn = KSLOT(1), kn2 = KSLOT(2), vc = VSLOT(0), vn = VSLOT(1), vn2 = VSLOT(2);
  if (RING3) { DMA_K3(TILE(1) * KVBLK, kn); DMA_V3(TILE(1) * KVBLK, vn);
    asm volatile("s_waitcnt lgkmcnt(0)" ::: "memory"); __syncthreads(); }
  f32x16 pA0, pA1, pB0, pB1; bf16x8 pa0, pa1, pa2, pa3;
  if (MODE == 2 || PIPE_SOFTMAX) { float bias0 = 0.f; if (MODE == 1) { if (NT > 4) bias0 = (selmask & 1u) ? 0.f : -INFINITY; }
    qkt(pA0, pA1, ka, 0, qr, bias0);
    __syncthreads(); }
  int it = 0;
#define JB(i_) ((MODE == 2) ? (3 - (i_)) : ((i_) - (NT - 4)))
#define STEP(A0, A1, B0, B1, BAND, HASNEXT) do { \
    if (it + 2 < NT) DMA_K(TILE(it + 2) * KVBLK, it & 1); \
    if (it + 1 < NT) DMA_V(TILE(it + 1) * KVBLK, (it + 1) & 1); \
    bool skip = false; const int jb = JB(it); \
    if (BAND) { if (MODE == 1) skip = (64 * jb > wid * 32 + 31); if (MODE == 2) skip = (64 * jb >= wid * 32 + 31); } \
    if (MODE == 2) skip = skip || __all(carry < SB_DONE);        \
    if (HASNEXT) { float bias_ = 0.f; if (MODE == 1) { if (it + 1 < NT - 4) bias_ = ((selmask >> ((it + 1) >> 2)) & 1u) ? 0.f : -INFINITY; } \
      qkt(B0, B1, ka, ((it + 1) & 1) * SHM_K, qr, bias_); } \
    if (!skip) { \
      if (MODE == 2) { sb_tile<(BAND) != 0>(A0, A1, carry, 64 * jb, qrel, hi); } \
      else { \
        if (MODE == 1 && (BAND)) { _Pragma("unroll") for (int r = 0; r < 16; ++r) { const int kr = 64 * jb + crow(r, hi); if (kr > qrel) A0[r] = -INFINITY; if (kr + 32 > qrel) A1[r] = -INFINITY; } } \
        float alpha; softmax_tile(A0, A1, m_reg, l_reg, alpha); \
        if (__any(alpha < 1.f)) { if (hi == 0) al_l[r32] = alpha; asm volatile("s_waitcnt lgkmcnt(0)" ::: "memory"); \
          _Pragma("unroll") for (int d = 0; d < 4; ++d) _Pragma("unroll") for (int r = 0; r < 16; ++r) o[d][r] *= al_l[crow(r, hi)]; } \
      } \
      pack_p(A0, A1, pa0, pa1, pa2, pa3); \
      pv_d0(o, vb0 + (it & 1) * SHM_V, pa0, pa1, pa2, pa3); \
    } \
    SDRAIN(); __syncthreads(); ++it; } while (0)
#define SB_LD(G, F) do { F##q = *reinterpret_cast<const __attribute__((address_space(3))) bf16x8*>(qr[(G) >> 2][(G) & 3]); \
      F##0 = *reinterpret_cast<const __attribute__((address_space(3))) bf16x8*>(ka[(G) >> 2][(G) & 3] + kb_); F##1 = *reinterpret_cast<const __attribute__((address_space(3))) bf16x8*>(ka[(G) >> 2][(G) & 3] + kb_ + 8192); } while (0)
#define SB_PART(G, P, I, B0, B1, FC, FN) do { if ((G) < 7) SB_LD(((G) + 1) & 7, FN);              \
      B0 = __builtin_amdgcn_mfma_f32_32x32x16_bf16(FC##0, FC##q, B0, 0, 0, 0); B1 = __builtin_amdgcn_mfma_f32_32x32x16_bf16(FC##1, FC##q, B1, 0, 0, 0); \
      gs_[G] = sb_group<false, I>(P, 0, 0, hi); SBAR(); } while (0)
#define STEP_SB(A0, A1, B0, B1) do { \
    if (it + 2 < NT) DMA_K(TILE(it + 2) * KVBLK, it & 1); \
    DMA_V(TILE(it + 1) * KVBLK, (it + 1) & 1); \
    float gs_[8]; \
    _Pragma("unroll") for (int r = 0; r < 16; ++r) { B0[r] = 0.f; B1[r] = 0.f; } \
    const int kb_ = ((it + 1) & 1) * SHM_K; bf16x8 fx0, fx1, fxq, fy0, fy1, fyq; SB_LD(0, fx); SBAR(); \
    SB_PART(0, A0, 0, B0, B1, fx, fy); SB_PART(1, A0, 1, B0, B1, fy, fx); SB_PART(2, A0, 2, B0, B1, fx, fy); SB_PART(3, A0, 3, B0, B1, fy, fx); \
    SB_PART(4, A1, 0, B0, B1, fx, fy); SB_PART(5, A1, 1, B0, B1, fy, fx); SB_PART(6, A1, 2, B0, B1, fx, fy); SB_PART(7, A1, 3, B0, B1, fy, fx); \
    sb_combine(A0, A1, gs_, carry, hi); \
    { const bool dn_ = __all(carry < SB_DONE); if (lane == 0) flg[(it & 1) * 8 + wid] = dn_ ? 1 : 0; } \
    pack_p(A0, A1, pa0, pa1, pa2, pa3); \
    pv_d0(o, vb0 + (it & 1) * SHM_V, pa0, pa1, pa2, pa3); \
    SDRAIN(); __syncthreads(); \
    { const int* f_ = flg + (it & 1) * 8; stop = (f_[0] + f_[1] + f_[2] + f_[3] + f_[4] + f_[5] + f_[6] + f_[7]) == 8; } \
    ++it; } while (0)
#define SSTEP(BAND) do { \
    if (RING3) { if (it + 2 < NT) { DMA_K3(TILE(it + 2) * KVBLK, kn2); DMA_V3(TILE(it + 2) * KVBLK, vn2); } } \
    else if (it + 1 < NT) { DMA_K(TILE(it + 1) * KVBLK, (it + 1) & 1); DMA_V(TILE(it + 1) * KVBLK, (it + 1) & 1); } \
    bool skip = false; const int jb = JB(it); \
    if (BAND) skip = (64 * jb > wid * 32 + 31); \
    if (!skip) { \
      float bias_ = 0.f; if (MODE == 1 && !(BAND)) bias_ = ((selmask >> (it >> 2)) & 1u) ? 0.f : -INFINITY; \
      const int kb_ = RING3 ? kc : (it & 1) * SHM_K; \
      if (QREG_SOFTMAX) qkt(pA0, pA1, ka, kb_, qg, bias_); else qkt(pA0, pA1, ka, kb_, qr, bias_); \
      if (MODE == 1 && (BAND)) { _Pragma("unroll") for (int r = 0; r < 16; ++r) { const int kr = 64 * jb + crow(r, hi); if (kr > qrel) pA0[r] = -INFINITY; if (kr + 32 > qrel) pA1[r] = -INFINITY; } } \
      float alpha; softmax_tile(pA0, pA1, m_reg, l_reg, alpha); \
      if (__any(alpha < 1.f)) { if (hi == 0) al_l[r32] = alpha; asm volatile("s_waitcnt lgkmcnt(0)" ::: "memory"); \
        _Pragma("unroll") for (int d = 0; d < 4; ++d) _Pragma("unroll") for (int r = 0; r < 16; ++r) o[d][r] *= al_l[crow(r, hi)]; } \
      pack_p(pA0, pA1, pa0, pa1, pa2, pa3); \
      pv_d0(o, vb0 + (RING3 ? vc : (it & 1) * SHM_V), pa0, pa1, pa2, pa3); \
    } \
    if (RING3) { if (it + 2 < NT) asm volatile("s_waitcnt vmcnt(4)" ::: "memory"); else SDRAIN();        \
      { const int t_ = kc; kc = kn; kn = kn2; kn2 = t_; } { const int t_ = vc; vc = vn; vn = vn2; vn2 = t_; } } \
    else SDRAIN(); \
    if (RING3) { asm volatile("s_waitcnt lgkmcnt(0)" ::: "memory"); __builtin_amdgcn_s_barrier(); asm volatile("" ::: "memory"); }     \
    else __syncthreads(); \
    ++it; } while (0)
#define RESTART(BIASEXPR) do { qkt(pA0, pA1, ka, (it & 1) * SHM_K, qr, (BIASEXPR)); __syncthreads(); } while (0)
  if (MODE == 0) {
    if (PIPE_SOFTMAX) { STEP(pA0, pA1, pB0, pB1, 0, true); STEP(pB0, pB1, pA0, pA1, 0, true); STEP(pA0, pA1, pB0, pB1, 0, true); STEP(pB0, pB1, pA0, pA1, 0, false); }
    else { SSTEP(0); SSTEP(0); SSTEP(0); SSTEP(0); }
  } else if (MODE == 1) {
    if (PIPE_SOFTMAX) {
      if (NT > 4) { while (it < NT - 4) { STEP(pA0, pA1, pB0, pB1, 0, true); STEP(pB0, pB1, pA0, pA1, 0, (it + 1 < NT - 4)); }
        RESTART(0.f); }
      STEP(pA0, pA1, pB0, pB1, 1, true); STEP(pB0, pB1, pA0, pA1, 1, true); STEP(pA0, pA1, pB0, pB1, 1, true); STEP(pB0, pB1, pA0, pA1, 1, false);
    } else {
      while (it < NT - 4) SSTEP(0);
      SSTEP(1); SSTEP(1); SSTEP(1); SSTEP(1);
    }
  } else {
    STEP(pA0, pA1, pB0, pB1, 1, true); STEP(pB0, pB1, pA0, pA1, 1, true); STEP(pA0, pA1, pB0, pB1, 1, true); STEP(pB0, pB1, pA0, pA1, 1, false);
    if (NT > 4) {
      RESTART(0.f);
      bool stop = false;
      while (it + 2 < NT && !stop) { STEP_SB(pA0, pA1, pB0, pB1); STEP_SB(pB0, pB1, pA0, pA1); }
      if (!stop) { STEP_SB(pA0, pA1, pB0, pB1); STEP(pB0, pB1, pA0, pA1, 0, false); }
    }
  }
#undef RESTART
#undef STEP
#undef SSTEP
#undef STEP_SB
#undef SB_LD
#undef SB_PART
#undef JB
  float rli[16];
  if (MODE != 2) { if (hi == 0) li_l[r32] = l_reg; asm volatile("s_waitcnt lgkmcnt(0)" ::: "memory");
#pragma unroll
    for (int r = 0; r < 16; ++r) rli[r] = __builtin_amdgcn_rcpf(li_l[crow(r, hi)]); }
  else {
#pragma unroll
    for (int r = 0; r < 16; ++r) rli[r] = 1.f; }
  if (gain) {
    float gv[4];
#pragma unroll
    for (int d0 = 0; d0 < 4; ++d0) gv[d0] = gain[d0 * 32 + r32];
#pragma unroll
    for (int r = 0; r < 16; ++r) { float s = 0.f;
#pragma unroll
      for (int d0 = 0; d0 < 4; ++d0) { o[d0][r] *= rli[r]; s += o[d0][r] * o[d0][r]; }
      s += __shfl_xor(s, 1); s += __shfl_xor(s, 2); s += __shfl_xor(s, 4); s += __shfl_xor(s, 8); s += __shfl_xor(s, 16);
      rli[r] = __builtin_amdgcn_rsqf(s * (1.0f / 128.0f) + 1e-6f); }
#pragma unroll
    for (int r = 0; r < 16; ++r)
#pragma unroll
      for (int d0 = 0; d0 < 4; ++d0) o[d0][r] *= gv[d0];
  }
  if (OUT8) { unsigned char* stg = (unsigned char*)lds + wid * 4096;
#pragma unroll
    for (int r = 0; r < 16; ++r) { const int orow = crow(r, hi);
#pragma unroll
      for (int d0 = 0; d0 < 4; ++d0) { const float v = __builtin_amdgcn_fmed3f(o[d0][r] * rli[r] * s8, -448.f, 448.f); stg[orow * 128 + d0 * 32 + r32] = (unsigned char)(__builtin_amdgcn_cvt_pk_fp8_f32(v, v, 0, false) & 0xff); } }
    asm volatile("s_waitcnt lgkmcnt(0)" ::: "memory");
#pragma unroll
    for (int i = 0; i < 4; ++i) { const int row = i * 8 + (lane >> 3), ch = lane & 7; const u32x4 v = *(const u32x4*)(stg + row * 128 + ch * 16); *(u32x4*)((unsigned char*)Ob + (long)(wid * 32 + row) * ldo + ch * 16) = v; } }
  else { bf16* stg = (bf16*)lds + wid * 4096;
#pragma unroll
    for (int r = 0; r < 16; ++r) { const int orow = crow(r, hi);
#pragma unroll
      for (int d0 = 0; d0 < 4; ++d0) { const float v = o[d0][r] * rli[r]; unsigned u = __float_as_uint(v); u = (u + 0x7fffu + ((u >> 16) & 1u)) >> 16; stg[orow * 128 + d0 * 32 + r32] = (bf16)u; } }
    asm volatile("s_waitcnt lgkmcnt(0)" ::: "memory");
#pragma unroll
    for (int i = 0; i < 8; ++i) { const int row = i * 4 + (lane >> 4), ch = lane & 15; const u32x4 v = *(const u32x4*)(stg + row * 128 + ch * 8); *(u32x4*)(Ob + (long)(wid * 32 + row) * ldo + ch * 8) = v; } }
  __syncthreads();
#undef TILE
#undef DMA_K
#undef DMA_V
#undef DMA_K3
#undef DMA_V3
#undef KSLOT
#undef VSLOT
#undef SDRAIN
}
#undef KSWZ
#undef SBAR
}
#define GAS __attribute__((address_space(1)))
#define LAS __attribute__((address_space(3)))
typedef unsigned short bf16;
typedef unsigned v4u __attribute__((ext_vector_type(4)));
typedef float f32x4 __attribute__((ext_vector_type(4)));
#define LDS_WAIT() asm volatile("s_waitcnt lgkmcnt(0)" ::: "memory")
constexpr int NWAVES = 8;
constexpr int BATCH = 8, SEQ = 2048, DM = 2048, M = BATCH * SEQ, HD = 128, NH = 8;
constexpr int NQKV = 6144, FF = 5632, WX = 512, NMEM = 256, MMEM = BATCH * NMEM;
constexpr int QSB = 0, KSB = 1024, VSB = 2048, QMB = 3072, KMB = 4096, VMB = 5120;
constexpr float EPS = 1e-6f;
constexpr float QSCALE = 0.12751743082459868f;
constexpr size_t MiB = 1u << 20;
constexpr size_t WS_CTL = 0, CTL_ZERO_BYTES = 512 * 1024;
constexpr size_t WS_SSQ1 = 64 * 1024, WS_SSQ2 = 128 * 1024;
constexpr size_t WS_KSUM = 256 * 1024;
constexpr size_t WS_WIN = 1 * MiB, WS_WOUT = 25 * MiB, WS_WXQ = 33 * MiB, WS_WXKV = 35 * MiB, WS_WXO = 39 * MiB, WS_WGU = 41 * MiB, WS_WDN = 85 * MiB;
constexpr size_t WS_RA = 107 * MiB;
constexpr size_t WS_RB = 171 * MiB;
constexpr size_t WS_RC = 235 * MiB;
constexpr size_t WS_QX = 427 * MiB, WS_OX = 443 * MiB, WS_KVX = 459 * MiB, WS_MN = 463 * MiB, WS_KMEAN = 471 * MiB, WS_CS = 472 * MiB, WS_END = 474 * MiB;
constexpr int RING_BYTES = 131072, LDS_BYTES = 147456;
#ifndef FFN_FP8
#define FFN_FP8 1
#endif
constexpr float S_X2 = 16.f, S_WGU = 32.f, S_ACT = 8.f, S_WDN = 64.f, S_XN = 16.f, S_WV = 32.f, S_O = 16.f, S_WO = 32.f;
#ifndef WOUT_FP8
#define WOUT_FP8 1
#endif
constexpr size_t WS_WV8 = WS_WIN + 16 * MiB;

__device__ __forceinline__ float bf2f(unsigned short b) { return __uint_as_float((unsigned)b << 16); }
__device__ __forceinline__ unsigned f2bf(float f) { unsigned u = __builtin_bit_cast(unsigned, f); return (u + 0x7fffu + ((u >> 16) & 1u)) >> 16; }
__device__ __forceinline__ unsigned pk2(float lo, float hi) { return f2bf(lo) | (f2bf(hi) << 16); }
__device__ __forceinline__ float wave_sum(float v) {
#pragma unroll
    for (int o = 1; o < 64; o <<= 1) v += __shfl_xor(v, o);
    return v;
}
__device__ __forceinline__ float wave_max(float v) {
#pragma unroll
    for (int o = 1; o < 64; o <<= 1) v = fmaxf(v, __shfl_xor(v, o));
    return v;
}

typedef GAS unsigned gu32;
#define RLX_AGENT __ATOMIC_RELAXED, __HIP_MEMORY_SCOPE_AGENT
constexpr int CW_BAR = 4096;
constexpr int LDSCTL_OFF = RING_BYTES, MISC_OFF = LDSCTL_OFF + 320;
#define XB_TMO      128
#define XB_XCNT(j)  (256  + 64 * (j))
#define XB_XSUB(j)  (1280 + 64 * (j))
#define XB_XGEN(j)  (2304 + 64 * (j))
#define XB_TOP      3328
#define XB_TOPGEN   3392
#define XCD_BAR_WORDS 3456
#define XB_SPIN_CAP (1u << 18)

__device__ __forceinline__ unsigned xb_ld(unsigned* p)              { return __hip_atomic_load(p, __ATOMIC_RELAXED, __HIP_MEMORY_SCOPE_AGENT); }
__device__ __forceinline__ unsigned xb_add(unsigned* p, unsigned v) { return __hip_atomic_fetch_add(p, v, __ATOMIC_RELAXED, __HIP_MEMORY_SCOPE_AGENT); }
__device__ __forceinline__ unsigned xb_xcc_id() { return (unsigned)__builtin_amdgcn_s_getreg((3 << 11) | 20) & 0xFu; }
#define XB_SPIN(cond, bar) do { unsigned _sp = 0; while (cond) { __builtin_amdgcn_s_sleep(1); \
    if ((++_sp & 255u) == 0u) { if (xb_ld(&(bar)[XB_TMO])) break; if (_sp > XB_SPIN_CAP) { atomicAdd(&(bar)[XB_TMO], 1u); break; } } } } while (0)

struct XcdBarrier {
    unsigned* bar; unsigned x;
    volatile LAS unsigned* st;
};

__device__ __forceinline__ XcdBarrier xcd_barrier_post(unsigned* bar, volatile LAS unsigned* st) {
    XcdBarrier b; b.bar = bar; b.x = xb_xcc_id(); b.st = st;
    if (threadIdx.x == 0) (void)xb_add(&bar[XB_XCNT(b.x)], 1u);
    return b;
}
__device__ __forceinline__ void xcd_barrier_complete(unsigned* bar, unsigned x, unsigned& nloc, unsigned& nx) {
    const unsigned G = gridDim.x * gridDim.y * gridDim.z;
    unsigned sum, cnt, mine, sp = 0u;
    for (;;) {
        sum = 0u; cnt = 0u; mine = 0u;
#pragma unroll
        for (unsigned j = 0; j < 16; ++j) { const unsigned c = xb_ld(&bar[XB_XCNT(j)]); sum += c; cnt += (c > 0u) ? 1u : 0u; mine = (j == x) ? c : mine; }
        if (sum == G) break;
        __builtin_amdgcn_s_sleep(1);
        if ((++sp & 255u) == 0u) { if (xb_ld(&bar[XB_TMO])) break; if (sp > XB_SPIN_CAP) { atomicAdd(&bar[XB_TMO], 1u); break; } }
    }
    nloc = mine > 0u ? mine : 1u; nx = cnt > 0u ? cnt : 1u;
}

__device__ __forceinline__ void xcd_barrier(const XcdBarrier& b) {
    asm volatile("s_waitcnt vmcnt(0)" ::: "memory");
    __syncthreads();
    if (threadIdx.x == 0) {
        unsigned* bar = b.bar;
        __builtin_amdgcn_s_waitcnt(0);
        unsigned nloc = b.st[0], nx = b.st[1];
        if (nloc == 0u) { xcd_barrier_complete(bar, b.x, nloc, nx); b.st[0] = nloc; b.st[1] = nx; }
        const unsigned old = xb_add(&bar[XB_XSUB(b.x)], 1u);
        const unsigned gen = old / nloc;
        if (old + 1u == (gen + 1u) * nloc) {
            __builtin_amdgcn_fence(__ATOMIC_RELEASE, "agent");
            asm volatile("s_waitcnt vmcnt(0)" ::: "memory");
            const unsigned og = xb_add(&bar[XB_TOP], 1u);
            const unsigned tg = og / nx;
            if (og + 1u == (tg + 1u) * nx) xb_add(&bar[XB_TOPGEN], 1u);
            else XB_SPIN(xb_ld(&bar[XB_TOPGEN]) == tg, bar);
            __builtin_amdgcn_fence(__ATOMIC_ACQUIRE, "agent");
            xb_add(&bar[XB_XGEN(b.x)], 1u);
            asm volatile("s_waitcnt vmcnt(0)" ::: "memory");
        } else {
            XB_SPIN(xb_ld(&bar[XB_XGEN(b.x)]) == gen, bar);
            __builtin_amdgcn_fence(__ATOMIC_ACQUIRE, "agent");
            asm volatile("s_waitcnt vmcnt(0)" ::: "memory");
        }
    }
    __syncthreads();
}

struct Frame {
    LAS unsigned char* lds;
    int tid, lane, wave, vcu, G;
    const float *x, *mem; const int* pos;
    const float *g_mix, *w_in, *g_out_sb, *g_out_mb, *w_out, *g_xattn, *g_mem, *w_xq, *w_xkv, *w_xo, *g_ffn, *w_gu, *w_dn, *g_final;
    float* out; unsigned char* ws;
};

__device__ __forceinline__ void transpose_item(const float* W, int K, int N, bf16* WT, const float* gain, int inter, LAS float* scr, int item, int lane) {
    const int nblk = N / 32, kb = item / nblk, nb = item % nblk, k0 = 64 * kb, n0 = 32 * nb;
    int orow0 = n0;
    if (inter == 1) orow0 = (n0 < FF) ? (n0 / 128) * 256 + (n0 % 128) : ((n0 - FF) / 128) * 256 + 128 + ((n0 - FF) % 128);
    if (inter == 2) { const int reg = n0 / 1024, c = n0 % 1024; orow0 = (reg == 2) ? c : (reg == 5) ? 1024 + c : (reg < 2 ? reg : reg - 1) * 1024 + c; }
    float v[32];
#pragma unroll
    for (int i = 0; i < 32; ++i) v[i] = W[(size_t)(k0 + 2 * i + (lane >> 5)) * N + n0 + (lane & 31)];
#pragma unroll
    for (int i = 0; i < 32; ++i) { const int kk = 2 * i + (lane >> 5); float t = v[i]; if (gain) t *= gain[k0 + kk]; scr[kk * 33 + (lane & 31)] = t; }
    LDS_WAIT(); asm volatile("" ::: "memory");
    const int c = lane & 7;
#pragma unroll
    for (int j = 0; j < 4; ++j) { const int n = (lane >> 3) + 8 * j; const LAS float* s = scr + (8 * c) * 33 + n;
        v4u o; o.x = pk2(s[0 * 33], s[1 * 33]); o.y = pk2(s[2 * 33], s[3 * 33]); o.z = pk2(s[4 * 33], s[5 * 33]); o.w = pk2(s[6 * 33], s[7 * 33]);
        *(GAS v4u*)(WT + (size_t)(orow0 + n) * K + k0 + 8 * c) = o; }
    LDS_WAIT(); asm volatile("" ::: "memory");
}
__device__ __forceinline__ void transpose_item_fp8(const float* W, int K, int N, unsigned char* WT, const float* gain, int inter, float scale, LAS float* scr, int item, int lane) {
    const int nblk = N / 32, kb = item / nblk, nb = item % nblk, k0 = 64 * kb, n0 = 32 * nb;
    int orow0 = n0;
    if (inter == 1) orow0 = (n0 < FF) ? (n0 / 128) * 256 + (n0 % 128) : ((n0 - FF) / 128) * 256 + 128 + ((n0 - FF) % 128);
    if (inter == 2) { const int reg = n0 / 1024, c = n0 % 1024; orow0 = (reg == 2) ? c : (reg == 5) ? 1024 + c : (reg < 2 ? reg : reg - 1) * 1024 + c; }
    float v[32];
#pragma unroll
    for (int i = 0; i < 32; ++i) v[i] = W[(size_t)(k0 + 2 * i + (lane >> 5)) * N + n0 + (lane & 31)];
#pragma unroll
    for (int i = 0; i < 32; ++i) { const int kk = 2 * i + (lane >> 5); float t = v[i] * scale; if (gain) t *= gain[k0 + kk]; scr[kk * 33 + (lane & 31)] = t; }
    LDS_WAIT(); asm volatile("" ::: "memory");
    const int c = lane & 7;
#pragma unroll
    for (int j = 0; j < 4; ++j) { const int n = (lane >> 3) + 8 * j; const LAS float* s = scr + (8 * c) * 33 + n;
        pg8::u32x2 o; o.x = pg8::pk4_fp8(s[0 * 33], s[1 * 33], s[2 * 33], s[3 * 33]); o.y = pg8::pk4_fp8(s[4 * 33], s[5 * 33], s[6 * 33], s[7 * 33]);
        *(GAS pg8::u32x2*)(WT + (size_t)(orow0 + n) * K + k0 + 8 * c) = o; }
    LDS_WAIT(); asm volatile("" ::: "memory");
}
__device__ __forceinline__ void rms_row_to_bf16(const float* xrow, const float* g, bf16* orow, int lane, unsigned char* o8 = nullptr, float s8 = 1.f) {
    const GAS f32x4* xr = (const GAS f32x4*)xrow + lane; const GAS f32x4* gr = (const GAS f32x4*)g + lane;
    f32x4 v[8]; float s = 0.f;
#pragma unroll
    for (int j = 0; j < 8; ++j) { v[j] = xr[64 * j]; s += (v[j].x * v[j].x + v[j].y * v[j].y) + (v[j].z * v[j].z + v[j].w * v[j].w); }
    const float rstd = 1.0f / sqrtf(wave_sum(s) * (1.f / DM) + EPS);
    GAS unsigned long long* ob8 = (GAS unsigned long long*)orow + lane;
#pragma unroll
    for (int j = 0; j < 8; ++j) { const f32x4 gg = gr[64 * j];
        const float a0 = v[j].x * rstd * gg.x, a1 = v[j].y * rstd * gg.y, a2 = v[j].z * rstd * gg.z, a3 = v[j].w * rstd * gg.w;
        ob8[64 * j] = (unsigned long long)pk2(a0, a1) | ((unsigned long long)pk2(a2, a3) << 32);
        if (o8) ((GAS unsigned*)o8)[64 * j + lane] = pg8::pk4_fp8(a0 * s8, a1 * s8, a2 * s8, a3 * s8); }
}
__constant__ float INV_FREQ[16] = {1.000000000e+00f, 4.403665960e-01f, 1.939227432e-01f, 8.539710194e-02f, 3.760603070e-02f, 1.656043902e-02f, 7.292664610e-03f, 3.211445874e-03f,
                                   1.414213562e-03f, 6.227723788e-04f, 2.742481884e-04f, 1.207697351e-04f, 5.318296098e-05f, 2.341999971e-05f, 1.031338616e-05f, 4.541670478e-06f};

__device__ __forceinline__ void p0_prologue(Frame& F) {
    LAS float* scr = (LAS float*)(F.lds + F.wave * 16384);
    const int gw = F.vcu * NWAVES + F.wave, NGW = F.G * NWAVES;
    bf16* ws16 = (bf16*)F.ws;
    constexpr int I0 = (DM / 64) * (NQKV / 32), I1 = (DM / 64) * (DM / 32), I2 = (DM / 64) * (WX / 32), I3 = (DM / 64) * (2 * WX / 32), I4 = (WX / 64) * (DM / 32),
                  I5 = (DM / 64) * (2 * FF / 32), I6 = (FF / 64) * (DM / 32);
    constexpr int I5H = I5 / 2;
    constexpr int NITEMS = I0 + I1 + I2 + I3 + I4 + I5H;
    for (int it = gw; it < NITEMS; it += NGW) {
        int r = it;
        if (r < I0) { const int reg = ((r % (NQKV / 32)) * 32) / 1024;
            if (reg == 2 || reg == 5) transpose_item_fp8(F.w_in, DM, NQKV, F.ws + WS_WV8, nullptr, 2, S_WV, scr, r, F.lane);
            else transpose_item(F.w_in, DM, NQKV, (bf16*)(F.ws + WS_WIN), nullptr, 2, scr, r, F.lane);
            continue; } r -= I0;
        if (r < I1) { if (WOUT_FP8) transpose_item_fp8(F.w_out, DM, DM, F.ws + WS_WOUT, nullptr, 0, S_WO, scr, r, F.lane); else transpose_item(F.w_out, DM, DM, (bf16*)(F.ws + WS_WOUT), nullptr, 0, scr, r, F.lane); continue; } r -= I1;
        if (r < I2) { transpose_item(F.w_xq, DM, WX, (bf16*)(F.ws + WS_WXQ), F.g_xattn, 0, scr, r, F.lane); continue; } r -= I2;
        if (r < I3) { transpose_item(F.w_xkv, DM, 2 * WX, (bf16*)(F.ws + WS_WXKV), nullptr, 0, scr, r, F.lane); continue; } r -= I3;
        if (r < I4) { transpose_item(F.w_xo, WX, DM, (bf16*)(F.ws + WS_WXO), nullptr, 0, scr, r, F.lane); continue; } r -= I4;
        transpose_item_fp8(F.w_gu, DM, 2 * FF, F.ws + WS_WGU, F.g_ffn, 1, S_WGU, scr, r, F.lane);
    }
    (void)ws16;
    for (int m = gw; m < M; m += NGW) rms_row_to_bf16(F.x + (size_t)m * DM, F.g_mix, (bf16*)(F.ws + WS_RA) + (size_t)m * DM, F.lane, F.ws + WS_RB + (size_t)m * DM, S_XN);
    for (int m = gw; m < MMEM; m += NGW) rms_row_to_bf16(F.mem + (size_t)m * DM, F.g_mem, (bf16*)(F.ws + WS_MN) + (size_t)m * DM, F.lane);
    float* cs = (float*)(F.ws + WS_CS);
    for (int e = (F.vcu * NWAVES + F.wave) * 64 + F.lane; e < M * 16; e += NGW * 64) {
        const int m = e >> 4, i = e & 15; const float ang = (float)F.pos[m] * INV_FREQ[i];
        double rev = (double)ang * 0.15915494309189535; rev -= floor(rev);
        const float a = (float)(rev * 6.283185307179586);
        cs[(size_t)m * 32 + i] = cosf(a); cs[(size_t)m * 32 + 16 + i] = sinf(a);
    }
}

__device__ __forceinline__ void ffn_weight_items(Frame& F, int wi, int nw) {
    LAS float* scr = (LAS float*)(F.lds + F.wave * 16384);
    constexpr int I5 = (DM / 64) * (2 * FF / 32), I6 = (FF / 64) * (DM / 32);
    for (int it = wi + I5 / 2; it < I5 + I6; it += nw) {
        if (it < I5) transpose_item_fp8(F.w_gu, DM, 2 * FF, F.ws + WS_WGU, F.g_ffn, 1, S_WGU, scr, it, F.lane);
        else transpose_item_fp8(F.w_dn, FF, DM, F.ws + WS_WDN, nullptr, 0, S_WDN, scr, it - I5, F.lane);
    }
}

__device__ __forceinline__ void final_norm_phase(Frame& F, const bf16* src, float* dst) {
    const int gw = F.vcu * NWAVES + F.wave, NGW = F.G * NWAVES;
    for (int m = gw; m < M; m += NGW) {
        const GAS v4u* xr = (const GAS v4u*)(src + (size_t)m * DM) + F.lane; const GAS f32x4* gr = (const GAS f32x4*)F.g_final;
        v4u w[4]; float s = 0.f;
#pragma unroll
        for (int j = 0; j < 4; ++j) w[j] = xr[64 * j];
        f32x4 v[8];
#pragma unroll
        for (int j = 0; j < 4; ++j) { v[2 * j] = (f32x4){__uint_as_float(w[j].x << 16), __uint_as_float(w[j].x & 0xffff0000u), __uint_as_float(w[j].y << 16), __uint_as_float(w[j].y & 0xffff0000u)};
            v[2 * j + 1] = (f32x4){__uint_as_float(w[j].z << 16), __uint_as_float(w[j].z & 0xffff0000u), __uint_as_float(w[j].w << 16), __uint_as_float(w[j].w & 0xffff0000u)}; }
#pragma unroll
        for (int j = 0; j < 8; ++j) s += (v[j].x * v[j].x + v[j].y * v[j].y) + (v[j].z * v[j].z + v[j].w * v[j].w);
        const float rstd = 1.0f / sqrtf(wave_sum(s) * (1.f / DM) + EPS);
        GAS f32x4* dr = (GAS f32x4*)(dst + (size_t)m * DM);
#pragma unroll
        for (int j = 0; j < 4; ++j) { const int c4 = (64 * j + F.lane) * 2;
            dr[c4] = v[2 * j] * rstd * gr[c4]; dr[c4 + 1] = v[2 * j + 1] * rstd * gr[c4 + 1]; }
    }
}

constexpr int NPH = 11;
#ifndef REPEAT_WHICH
#define REPEAT_WHICH 3
#endif
#ifndef NULL_EPI_PROBE
#define NULL_EPI_PROBE 0
#endif
#ifndef FOLD_KMEAN
#define FOLD_KMEAN 1
#endif
#ifndef REPEAT_PHASE
#define REPEAT_PHASE -1
#endif
#ifndef REPEAT_MASK
#define REPEAT_MASK 0
#endif
#define REPS(k) (((REPEAT_PHASE == (k)) || ((REPEAT_MASK >> (k)) & 1)) ? 2 : 1)
#ifndef USE_MFMA_SB
#define USE_MFMA_SB 1
#endif
#ifndef USE_MFMA_MOBA
#define USE_MFMA_MOBA 1
#endif
#ifndef USE_MFMA_X
#define USE_MFMA_X 1
#endif
#ifndef MK_ONE_LAUNCH
#define MK_ONE_LAUNCH 1
#endif
struct Args { const void* in[17]; float* out; unsigned char* ws; int ph_lo, ph_hi; };
__global__ void __launch_bounds__(NWAVES * 64, 2) mk_fwd(Args args) {
    extern __shared__ __attribute__((aligned(16))) unsigned char lds[];
    Frame F;
    F.lds = (LAS unsigned char*)lds;
    F.tid = threadIdx.x; F.lane = F.tid & 63; F.wave = __builtin_amdgcn_readfirstlane(F.tid >> 6);
    F.G = gridDim.x; { const int bx = blockIdx.x; F.vcu = (F.G % 8 == 0) ? (bx % 8) * (F.G / 8) + bx / 8 : bx; }
    F.x = (const float*)args.in[0]; F.mem = (const float*)args.in[1]; F.pos = (const int*)args.in[2];
    F.g_mix = (const float*)args.in[3]; F.w_in = (const float*)args.in[4]; F.g_out_sb = (const float*)args.in[5]; F.g_out_mb = (const float*)args.in[6]; F.w_out = (const float*)args.in[7];
    F.g_xattn = (const float*)args.in[8]; F.g_mem = (const float*)args.in[9]; F.w_xq = (const float*)args.in[10]; F.w_xkv = (const float*)args.in[11]; F.w_xo = (const float*)args.in[12];
    F.g_ffn = (const float*)args.in[13]; F.w_gu = (const float*)args.in[14]; F.w_dn = (const float*)args.in[15]; F.g_final = (const float*)args.in[16];
    F.out = args.out; F.ws = args.ws;
    unsigned char* ws = args.ws;
    const int lo = args.ph_lo, hi = args.ph_hi;
    for (int u = F.tid; u < (LDS_BYTES - LDSCTL_OFF) / 4; u += NWAVES * 64) ((LAS unsigned*)(F.lds + LDSCTL_OFF))[u] = 0u;
    __syncthreads();
    if (hi - lo > 1) {
        { GAS v4u* z = (GAS v4u*)(ws + WS_CTL); const int n16 = (int)(CTL_ZERO_BYTES / 16);
          for (int i = (int)blockIdx.x * (NWAVES * 64) + F.tid; i < n16; i += F.G * NWAVES * 64) z[i] = (v4u){0u, 0u, 0u, 0u}; }
        cg::this_grid().sync();
    }
    XcdBarrier bar = xcd_barrier_post((unsigned*)(ws + WS_CTL) + CW_BAR, (volatile LAS unsigned*)(F.lds + MISC_OFF) + 8);
#ifndef ONLY_PHASE
#define ONLY_PHASE -1
#endif
#define IN(k) ((ONLY_PHASE < 0 || ONLY_PHASE == (k)) && lo <= (k) && (k) < hi)
#define BOTH(k) (IN(k) && IN((k) + 1))
#define GRID_BAR() xcd_barrier(bar)
    float* ssq1 = (float*)(ws + WS_SSQ1); float* ssq2 = (float*)(ws + WS_SSQ2);
    pg8::bf16_t* RA = (pg8::bf16_t*)(ws + WS_RA); pg8::bf16_t* RB = (pg8::bf16_t*)(ws + WS_RB); pg8::bf16_t* RC = (pg8::bf16_t*)(ws + WS_RC);

    if (IN(0)) { for (int rep = 0; rep < REPS(0); ++rep) p0_prologue(F); if (BOTH(0)) GRID_BAR(); }
    if (IN(1)) {
        for (int rep = 0; rep < REPS(1); ++rep) {
        { pg8::Gemm g{RA, (const pg8::bf16_t*)(ws + WS_WIN), M, 4096, DM}; pg8::StaticOrder S; S.init(M, 4096, F.G, (int)blockIdx.x);
          pg8::EpiQKV E{RC, (const float*)(ws + WS_CS), QSCALE, (float*)(ws + WS_KSUM), 0, 1.f};
          pg8::gemm_phase<pg8::EpiQKV, pg8::StaticOrder, true, true>(F.lds, g, S, E); }
        { pg8::Gemm g{RB, (const pg8::bf16_t*)(ws + WS_WV8), M, 2048, DM / 2}; pg8::StaticOrder S; S.init(M, 2048, F.G, (int)blockIdx.x);
          pg8::EpiQKV E{RC, (const float*)(ws + WS_CS), QSCALE, (float*)(ws + WS_KSUM), 1, 1.f / (S_XN * S_WV)};
          pg8::gemm_phase<pg8::EpiQKV, pg8::StaticOrder, true, true, true>(F.lds, g, S, E); }
        }
        if (BOTH(1)) GRID_BAR();
    }
    if (IN(3)) {
        const att::bf16* qkv = (const att::bf16*)RC; att::bf16* ob = (att::bf16*)RA; const float* kmean = (const float*)(ws + WS_KSUM);
        constexpr size_t HSZ = (size_t)SEQ * HD;
        for (int rep = 0; rep < REPS(3); ++rep) {
        if (rep == 0 || (REPEAT_WHICH & 1))
        for (int vv = F.vcu; vv < 256; vv += F.G) { const int bh = vv >> 2, s = vv & 3, b = bh >> 3, h = bh & 7; const size_t rb = (size_t)b * SEQ; const att::bf16* hb = qkv + ((size_t)b * 48 + h) * HSZ;
            for (int i = 0; i < 2; ++i) { const int qb = i ? s : 7 - s; const size_t r0 = rb + (size_t)qb * 256;
                if (WOUT_FP8) att::attn_unit<2, true>(hb + (size_t)qb * 256 * HD, HD, hb + 8 * HSZ, hb + 16 * HSZ, HD, (att::bf16*)((unsigned char*)ob + r0 * DM + h * HD), DM, F.g_out_sb + h * HD, nullptr, qb, 0, (char*)lds, S_O);
                else att::attn_unit<2>(hb + (size_t)qb * 256 * HD, HD, hb + 8 * HSZ, hb + 16 * HSZ, HD, ob + r0 * DM + h * HD, DM, F.g_out_sb + h * HD, nullptr, qb, 0, (char*)lds); } }
        if (rep == 0 || (REPEAT_WHICH & 2))
        for (int vv = F.vcu; vv < 256; vv += F.G) { const int bh = vv >> 2, s = vv & 3, b = bh >> 3, h = bh & 7; const size_t rb = (size_t)b * SEQ; const att::bf16* hb = qkv + ((size_t)b * 48 + 24 + h) * HSZ;
            for (int i = 0; i < 2; ++i) { const int qb = i ? s : 7 - s; const size_t r0 = rb + (size_t)qb * 256;
                if (WOUT_FP8) att::attn_unit<1, true>(hb + (size_t)qb * 256 * HD, HD, hb + 8 * HSZ, hb + 16 * HSZ, HD, (att::bf16*)((unsigned char*)ob + r0 * DM + NH * HD + h * HD), DM, F.g_out_mb + h * HD, kmean + (size_t)bh * 1024, qb, 0, (char*)lds, S_O);
                else att::attn_unit<1>(hb + (size_t)qb * 256 * HD, HD, hb + 8 * HSZ, hb + 16 * HSZ, HD, ob + r0 * DM + NH * HD + h * HD, DM, F.g_out_mb + h * HD, kmean + (size_t)bh * 1024, qb, 0, (char*)lds); } }
        }
        if (BOTH(3)) GRID_BAR();
    }
    if (IN(4)) {
        pg8::Gemm g{RA, (const pg8::bf16_t*)(ws + WS_WOUT), M, DM, WOUT_FP8 ? DM / 2 : DM}; pg8::StaticOrder S; S.init(M, DM, F.G, (int)blockIdx.x);
        const float asc = WOUT_FP8 ? 1.f / (S_O * S_WO) : 1.f;
        if (REPS(4) == 2) { pg8::EpiResB<true> E0{F.x, RB, nullptr, nullptr, 1.f, asc}; pg8::gemm_phase<pg8::EpiResB<true>, pg8::StaticOrder, true, true, WOUT_FP8 != 0>(F.lds, g, S, E0); }
        pg8::EpiResB<true> E{F.x, RB, ssq1, nullptr, 1.f, asc};
        pg8::gemm_phase<pg8::EpiResB<true>, pg8::StaticOrder, true, true, WOUT_FP8 != 0>(F.lds, g, S, E);
        if (BOTH(4)) GRID_BAR();
    }
    if (IN(5)) {
      for (int rep = 0; rep < REPS(5); ++rep) {
        { pg8::Gemm g{RB, (const pg8::bf16_t*)(ws + WS_WXQ), M, WX, DM}; pg8::StaticOrder S; S.init(M, WX, F.G, (int)blockIdx.x);
          pg8::EpiScale E{(pg8::bf16_t*)(ws + WS_QX), WX, ssq1, QSCALE};
          pg8::gemm_phase<pg8::EpiScale, pg8::StaticOrder, true, true>(F.lds, g, S, E); }
        { pg8::Gemm g{(const pg8::bf16_t*)(ws + WS_MN), (const pg8::bf16_t*)(ws + WS_WXKV), MMEM, 2 * WX, DM}; pg8::StaticOrder S; S.init(MMEM, 2 * WX, F.G, (int)((blockIdx.x + F.G - 128) % F.G));
          pg8::EpiScale E{(pg8::bf16_t*)(ws + WS_KVX), 2 * WX, nullptr, 1.0f};
          pg8::gemm_phase<pg8::EpiScale, pg8::StaticOrder, true, true>(F.lds, g, S, E); }
        if (F.G > 160) { if ((int)blockIdx.x >= 160) ffn_weight_items(F, ((int)blockIdx.x - 160) * NWAVES + F.wave, (F.G - 160) * NWAVES); }
        else ffn_weight_items(F, (int)blockIdx.x * NWAVES + F.wave, F.G * NWAVES);
      }
        if (BOTH(5)) GRID_BAR();
    }
    if (IN(6)) {
        const att::bf16* qx = (const att::bf16*)(ws + WS_QX); const att::bf16* kvx = (const att::bf16*)(ws + WS_KVX); att::bf16* ox = (att::bf16*)(ws + WS_OX);
        for (int rep = 0; rep < REPS(6); ++rep) {
        for (int vv = F.vcu; vv < 256; vv += F.G) { const int b = vv >> 5, h = (vv >> 3) & 3, qb = vv & 7; const size_t r0 = (size_t)b * SEQ + (size_t)qb * 256;
            att::attn_unit<0>(qx + r0 * WX + h * HD, WX, kvx + (size_t)b * NMEM * (2 * WX) + h * HD, kvx + (size_t)b * NMEM * (2 * WX) + WX + h * HD, 2 * WX, ox + r0 * WX + h * HD, WX, nullptr, nullptr, qb, NMEM, (char*)lds); }
        }
        if (BOTH(6)) GRID_BAR();
    }
    if (IN(7)) {
        pg8::Gemm g{(const pg8::bf16_t*)(ws + WS_OX), (const pg8::bf16_t*)(ws + WS_WXO), M, DM, WX}; pg8::StaticOrder S; S.init(M, DM, F.G, (int)blockIdx.x);
        if (REPS(7) == 2) { pg8::EpiResB<false> E0{RB, RC, nullptr, nullptr, 1.f, 1.f}; pg8::gemm_phase<pg8::EpiResB<false>, pg8::StaticOrder, true, true>(F.lds, g, S, E0); }
        pg8::EpiResB<false> E{RB, RB, ssq2, (unsigned char*)RA, S_X2, 1.f};
        pg8::gemm_phase<pg8::EpiResB<false>, pg8::StaticOrder, true, true>(F.lds, g, S, E);
        if (BOTH(7)) GRID_BAR();
    }
    if (IN(8)) {
        pg8::Gemm g{RA, (const pg8::bf16_t*)(ws + WS_WGU), M, 2 * FF, FFN_FP8 ? DM / 2 : DM}; pg8::StaticOrder S; S.init(M, 2 * FF, F.G, (int)blockIdx.x);
        pg8::EpiSwiGLU E{RC, ssq2, FFN_FP8 ? (unsigned char*)RC : nullptr, FFN_FP8 ? 1.f / (S_X2 * S_WGU) : 1.f, S_ACT};
#if NULL_EPI_PROBE
        if (REPS(8) == 2) { pg8::EpiNull EN{nullptr}; pg8::gemm_phase<pg8::EpiNull, pg8::StaticOrder, true, true, FFN_FP8 != 0>(F.lds, g, S, EN); }
        pg8::gemm_phase<pg8::EpiSwiGLU, pg8::StaticOrder, true, true, FFN_FP8 != 0>(F.lds, g, S, E);
#else
        for (int rep = 0; rep < REPS(8); ++rep) pg8::gemm_phase<pg8::EpiSwiGLU, pg8::StaticOrder, true, true, FFN_FP8 != 0>(F.lds, g, S, E);
#endif
        if (BOTH(8)) GRID_BAR();
    }
    if (IN(9)) {
        pg8::Gemm g{RC, (const pg8::bf16_t*)(ws + WS_WDN), M, DM, FF / 2}; pg8::StaticOrder S; S.init(M, DM, F.G, (int)blockIdx.x);
        if (REPS(9) == 2) { pg8::EpiResB<false> E0{RB, (pg8::bf16_t*)(ws + WS_RC + 96 * MiB), nullptr, nullptr, 1.f, 1.f / (S_ACT * S_WDN)}; pg8::gemm_phase<pg8::EpiResB<false>, pg8::StaticOrder, true, true, true>(F.lds, g, S, E0); }
        pg8::EpiResB<false> E{RB, RB, nullptr, nullptr, 1.f, 1.f / (S_ACT * S_WDN)};
        pg8::gemm_phase<pg8::EpiResB<false>, pg8::StaticOrder, true, true, true>(F.lds, g, S, E);
        if (BOTH(9)) GRID_BAR();
    }
    if (IN(10)) { if (REPS(10) == 2) final_norm_phase(F, RB, (float*)RC); final_norm_phase(F, RB, F.out); }
#undef IN
#undef BOTH
}

extern "C" void kernel_launch(void* const* d_in, const int* in_sizes, int n_in, void* d_out, int out_size, void* d_ws, size_t ws_size, hipStream_t stream) {
    static int grid = 0;
    if (grid == 0) {
        if (n_in != 17 || in_sizes[0] != M * DM || out_size != M * DM || ws_size < WS_END) { fprintf(stderr, "kernel_launch: unexpected shapes (n_in %d in0 %d out %d ws %zu)\n", n_in, n_in > 0 ? in_sizes[0] : -1, out_size, ws_size); grid = -1; return; }
        int dev = 0, cus = 0, per_cu = 0;
        if (hipGetDevice(&dev) != hipSuccess || hipDeviceGetAttribute(&cus, hipDeviceAttributeMultiprocessorCount, dev) != hipSuccess) { grid = -1; return; }
        if (hipFuncSetAttribute((const void*)mk_fwd, hipFuncAttributeMaxDynamicSharedMemorySize, LDS_BYTES) != hipSuccess) { fprintf(stderr, "kernel_launch: hipFuncSetAttribute failed\n"); grid = -1; return; }
        if (hipOccupancyMaxActiveBlocksPerMultiprocessor(&per_cu, (const void*)mk_fwd, NWAVES * 64, LDS_BYTES) != hipSuccess || per_cu < 1) { fprintf(stderr, "kernel_launch: occupancy query failed (%d)\n", per_cu); per_cu = 1; }
        (void)hipGetLastError();
        grid = cus * (per_cu < 1 ? 1 : 1);
    }
    if (grid < 0) return;
#if !MK_ONE_LAUNCH
    (void)hipMemsetAsync((char*)d_ws + WS_CTL, 0, CTL_ZERO_BYTES, stream);
#endif
    Args a{};
    for (int i = 0; i < 17; ++i) a.in[i] = d_in[i];
    a.out = (float*)d_out; a.ws = (unsigned char*)d_ws;
#if MK_ONE_LAUNCH
    a.ph_lo = 0; a.ph_hi = NPH;
    void* kargs[] = {&a};
    hipError_t e = hipLaunchCooperativeKernel((const void*)mk_fwd, dim3(grid), dim3(NWAVES * 64), kargs, LDS_BYTES, stream);
    if (e != hipSuccess) fprintf(stderr, "kernel_launch: cooperative launch failed: %s (grid %d)\n", hipGetErrorString(e), grid);
#else
    for (int p = 0; p < NPH; ++p) { a.ph_lo = p; a.ph_hi = p + 1; hipLaunchKernelGGL(mk_fwd, dim3(grid), dim3(NWAVES * 64), LDS_BYTES, stream, a); }
    const hipError_t le = hipPeekAtLastError();
    if (le != hipSuccess) fprintf(stderr, "kernel_launch: launch failed: %s\n", hipGetErrorName(le));
#endif
}
```

```cpp
#include <hip/hip_runtime.h>
#include <hip/hip_cooperative_groups.h>
#include <cstdio>
#include <cstdint>
namespace cg = cooperative_groups;
namespace pg8 {
#define PG8_LAS __attribute__((address_space(3)))
typedef unsigned short bf16_t;
typedef short bf16x8 __attribute__((ext_vector_type(8)));
typedef float f32x4 __attribute__((ext_vector_type(4)));
typedef unsigned u32x4 __attribute__((ext_vector_type(4)));
constexpr int BM = 256, BK = 64, HALF = 128, HTB = HALF * BK * 2  , STAGE_BYTES = 8 * HTB, NXCD = 8, WGM = 8;

__host__ __device__ __forceinline__ int lds_byte(int r, int c) { const int st = (r >> 4) * 2 + (c >> 5), rr = r & 15, cc = c & 31, ob = rr * 64 + cc * 2; return st * 1024 + (ob ^ (((ob >> 9) & 1) << 5)); }
__host__ __device__ __forceinline__ void stage_rc(int b, int& R, int& C) { const int st = b / 1024, sb = b % 1024, swz = sb ^ (((sb >> 9) & 1) << 5); R = (st >> 1) * 16 + swz / 64; C = (st & 1) * 32 + (swz % 64) / 2; }
__host__ __device__ __forceinline__ int perm32(int rho) { const int n = rho >> 4, i = rho & 15; return 8 * (i >> 2) + 4 * n + (i & 3); }

struct Unit { int pm, pn; };
struct Gemm { const bf16_t* A; const bf16_t* Bt; int M, N, K; };

struct StaticOrder {
    int nM, nN, nwg, G, c;
    __host__ __device__ void init(int M, int N, int G_, int c_) { nM = M / BM; nN = N / BM; nwg = nM * nN; G = G_; c = c_; }
    __host__ __device__ bool next(int i, Unit& u) const {
        const long L = (long)i * G + c; if (L >= nwg) return false;
        int wgid = (int)L; { const int q = nwg / NXCD, r = nwg % NXCD, xcd = wgid % NXCD, off = wgid / NXCD; wgid = (xcd < r ? xcd * (q + 1) : r * (q + 1) + (xcd - r) * q) + off; }
        const int nig = WGM * nN, gid = wgid / nig, fm = gid * WGM, gsz = (nM - fm) < WGM ? (nM - fm) : WGM;
        u.pm = fm + ((wgid % nig) % gsz); u.pn = (wgid % nig) / gsz; return true;
    }
    __device__ __forceinline__ void a_ready(const Unit&) const {}
    __device__ __forceinline__ void done(const Unit&) const {}
};

__device__ __forceinline__ unsigned cvt_pk_bf16(float lo, float hi) { unsigned r; asm volatile("v_cvt_pk_bf16_f32 %0, %1, %2" : "=v"(r) : "v"(lo), "v"(hi)); return r; }
typedef float f32x2 __attribute__((ext_vector_type(2)));
template <class Epi, class Sched, bool ALIGN_EPI = false, bool SP2 = false, bool FP8 = false>
__device__ __forceinline__ void gemm_phase(PG8_LAS unsigned char* lds, const Gemm g, const Sched& S, const Epi& E) {
    int tid_ = threadIdx.x; asm volatile("" : "+v"(tid_));
    const int tid = tid_, wid = __builtin_amdgcn_readfirstlane(tid >> 6), lane = tid & 63, wr = wid >> 2, wc = wid & 3, fr = lane & 15, fq = lane >> 4;
    const int K = g.K, nt = K / BK;
    unsigned voffA[2], voffB[2];
#pragma unroll
    for (int i = 0; i < 2; ++i) { int R, C; stage_rc(tid * 16 + i * 8192, R, C); const int Rb = Epi::PERM ? ((R & ~31) + perm32(R & 31)) : R;
        voffA[i] = (unsigned)(R * K + C) * 2u; voffB[i] = (unsigned)(Rb * K + C) * 2u; }
    const size_t kstep = (size_t)(BK * 2);
    const size_t hstep = (size_t)HALF * K * 2;
    const size_t tstep = 2 * hstep;
    const unsigned ldsw = (unsigned)wid * 1024u;
    const int aoff = lds_byte(wr * 64 + fr, fq * 8), boff = lds_byte(wc * 32 + fr, fq * 8);
#define PG8_SA(b, h) (((b) * 2 + (h)) * HTB)
#define PG8_SB(b, h) ((4 + (b) * 2 + (h)) * HTB)
#define PG8_STAGE(bufoff, gbase, voff) do { _Pragma("unroll") for (int _i = 0; _i < 2; ++_i) \
        __builtin_amdgcn_global_load_lds((const unsigned*)((const char*)(gbase) + (voff)[_i]), (PG8_LAS unsigned*)(lds + (bufoff) + ldsw + _i * 8192), 16, 0, 0); } while (0)
#define PG8_LD8(p) __builtin_shufflevector(*(const PG8_LAS i32x4_*)(p), *(const PG8_LAS i32x4_*)((p) + 1024), 0, 1, 2, 3, 4, 5, 6, 7)
#define PG8_LDA(dst, b, h) do { if constexpr (FP8) { _Pragma("unroll") for (int m = 0; m < 4; ++m) dst##8[m] = PG8_LD8(lds + PG8_SA(b, h) + aoff + m * 2048); } \
        else { _Pragma("unroll") for (int m = 0; m < 4; ++m) _Pragma("unroll") for (int k = 0; k < 2; ++k) dst[m][k] = *(const PG8_LAS bf16x8*)(lds + PG8_SA(b, h) + aoff + m * 2048 + k * 1024); } } while (0)
#define PG8_LDB(dst, b, h) do { if constexpr (FP8) { _Pragma("unroll") for (int n = 0; n < 2; ++n) dst##8[n] = PG8_LD8(lds + PG8_SB(b, h) + boff + n * 2048); } \
        else { _Pragma("unroll") for (int n = 0; n < 2; ++n) _Pragma("unroll") for (int k = 0; k < 2; ++k) dst[n][k] = *(const PG8_LAS bf16x8*)(lds + PG8_SB(b, h) + boff + n * 2048 + k * 1024); } } while (0)
#define PG8_MMA(ai, bj, At, Bt) do { __builtin_amdgcn_s_setprio(1); _Pragma("unroll") for (int m = 0; m < 4; ++m) _Pragma("unroll") for (int n = 0; n < 2; ++n) { \
        if constexpr (FP8) asm volatile("v_mfma_scale_f32_16x16x128_f8f6f4 %0, %1, %2, %0, %3, %3 op_sel_hi:[0,0,0]" : "+v"(acc[ai][bj][m][n]) : "v"(Bt##8[n]), "v"(At##8[m]), "v"(sc1_)); \
        else { _Pragma("unroll") for (int k = 0; k < 2; ++k) acc[ai][bj][m][n] = __builtin_amdgcn_mfma_f32_16x16x32_bf16(Bt[n][k], At[m][k], acc[ai][bj][m][n], 0, 0, 0); } } \
        __builtin_amdgcn_s_setprio(0); } while (0)
#define PG8_WAIT_V(n) asm volatile("s_waitcnt vmcnt(" #n ")" ::: "memory")
#define PG8_WAIT_L(n) asm volatile("s_waitcnt lgkmcnt(" #n ")" ::: "memory")
#define PG8_BAR __builtin_amdgcn_s_barrier()
#define PG8_SCHED __builtin_amdgcn_sched_barrier(0)
    Unit cur, nxt; int ui = 0;
    if (!S.next(0, cur)) return;
    f32x4 acc[2][2][4][2];
#pragma unroll
    for (int a = 0; a < 2; ++a)
#pragma unroll
        for (int b = 0; b < 2; ++b)
#pragma unroll
            for (int m = 0; m < 4; ++m)
#pragma unroll
                for (int n = 0; n < 2; ++n) acc[a][b][m][n] = (f32x4){0.f, 0.f, 0.f, 0.f};
    typedef int i32x4_ __attribute__((ext_vector_type(4))); typedef int i32x8_ __attribute__((ext_vector_type(8)));
    int sc1_ = 0x7F7F7F7F; asm volatile("" : "+v"(sc1_));
    bf16x8 At[4][2], B0[2][2], B1[2][2]; i32x8_ At8[4], B08[2], B18[2];
    const char* cA = (const char*)g.A + (size_t)cur.pm * tstep; const char* cB = (const char*)g.Bt + (size_t)cur.pn * tstep;
    S.a_ready(cur);
    if constexpr (SP2) {
        PG8_STAGE(PG8_SB(0, 0), cB, voffB); PG8_STAGE(PG8_SB(0, 1), cB + hstep, voffB); PG8_STAGE(PG8_SA(0, 0), cA, voffA); PG8_STAGE(PG8_SA(0, 1), cA + hstep, voffA);
        if (wr == 1) PG8_BAR;
        PG8_WAIT_V(2); PG8_BAR;
        PG8_STAGE(PG8_SB(1, 0), cB + kstep, voffB); PG8_STAGE(PG8_SA(1, 0), cA + kstep, voffA); PG8_STAGE(PG8_SB(1, 1), cB + hstep + kstep, voffB);
        PG8_WAIT_V(6); PG8_BAR;
    } else {
        PG8_STAGE(PG8_SB(0, 0), cB, voffB); PG8_STAGE(PG8_SA(0, 0), cA, voffA); PG8_STAGE(PG8_SB(0, 1), cB + hstep, voffB); PG8_STAGE(PG8_SA(0, 1), cA + hstep, voffA);
        if (wr == 1) PG8_BAR;
        PG8_WAIT_V(4); PG8_BAR;
        PG8_STAGE(PG8_SB(1, 0), cB + kstep, voffB); PG8_STAGE(PG8_SA(1, 0), cA + kstep, voffA); PG8_STAGE(PG8_SB(1, 1), cB + hstep + kstep, voffB);
        PG8_WAIT_V(6); PG8_BAR;
    }
    for (;;) {
        const bool has_next = S.next(ui + 1, nxt);
        const char* nA = has_next ? (const char*)g.A + (size_t)nxt.pm * tstep : cA; const char* nB = has_next ? (const char*)g.Bt + (size_t)nxt.pn * tstep : cB;
        for (int t = 0; t < nt; t += 2) {
            const bool last = (t == nt - 2);
            const char* a1 = cA + (size_t)(t + 1) * kstep;
            const char* a2 = last ? nA : cA + (size_t)(t + 2) * kstep; const char* b2 = last ? nB : cB + (size_t)(t + 2) * kstep;
            const char* a3 = a2 + kstep; const char* b3 = b2 + kstep;
            if (last && has_next) S.a_ready(nxt);
            if constexpr (SP2) {
            PG8_LDB(B0, 0, 0); PG8_LDB(B1, 0, 1); PG8_SCHED; PG8_LDA(At, 0, 0); PG8_STAGE(PG8_SA(1, 1), a1 + hstep, voffA);
            PG8_WAIT_V(8); PG8_WAIT_L(0); PG8_BAR; PG8_MMA(0, 0, At, B0); PG8_MMA(0, 1, At, B1); PG8_BAR; PG8_SCHED;
            PG8_LDA(At, 0, 1); PG8_STAGE(PG8_SB(0, 0), b2, voffB); PG8_STAGE(PG8_SB(0, 1), b2 + hstep, voffB); PG8_STAGE(PG8_SA(0, 0), a2, voffA);
            PG8_WAIT_V(8); PG8_WAIT_L(0); PG8_BAR; PG8_MMA(1, 0, At, B0); PG8_MMA(1, 1, At, B1); PG8_BAR; PG8_SCHED;
            PG8_LDB(B0, 1, 0); PG8_LDB(B1, 1, 1); PG8_SCHED; PG8_LDA(At, 1, 0); PG8_STAGE(PG8_SA(0, 1), a2 + hstep, voffA);
            PG8_WAIT_V(8); PG8_WAIT_L(0); PG8_BAR; PG8_MMA(0, 0, At, B0); PG8_MMA(0, 1, At, B1); PG8_BAR; PG8_SCHED;
            PG8_LDA(At, 1, 1); PG8_STAGE(PG8_SB(1, 0), b3, voffB); PG8_STAGE(PG8_SB(1, 1), b3 + hstep, voffB); PG8_STAGE(PG8_SA(1, 0), a3, voffA);
            PG8_WAIT_V(8); PG8_WAIT_L(0); PG8_BAR; PG8_MMA(1, 0, At, B0); PG8_MMA(1, 1, At, B1); PG8_BAR; PG8_SCHED;
            } else {
            PG8_LDB(B0, 0, 0); PG8_SCHED; PG8_LDA(At, 0, 0); PG8_STAGE(PG8_SA(1, 1), a1 + hstep, voffA);
            PG8_WAIT_L(8); PG8_BAR; PG8_WAIT_L(0); PG8_MMA(0, 0, At, B0); PG8_BAR; PG8_SCHED;
            PG8_LDB(B1, 0, 1); PG8_STAGE(PG8_SB(0, 0), b2, voffB);
            PG8_BAR; PG8_WAIT_L(0); PG8_MMA(0, 1, At, B1); PG8_BAR;
            PG8_LDA(At, 0, 1); PG8_STAGE(PG8_SA(0, 0), a2, voffA);
            PG8_BAR; PG8_WAIT_L(0); PG8_MMA(1, 0, At, B0); PG8_BAR; PG8_SCHED;
            PG8_STAGE(PG8_SB(0, 1), b2 + hstep, voffB);
            PG8_WAIT_V(6); PG8_BAR; PG8_MMA(1, 1, At, B1); PG8_BAR;
            PG8_LDB(B0, 1, 0); PG8_SCHED; PG8_LDA(At, 1, 0); PG8_STAGE(PG8_SA(0, 1), a2 + hstep, voffA);
            PG8_WAIT_L(8); PG8_BAR; PG8_WAIT_L(0); PG8_MMA(0, 0, At, B0); PG8_BAR; PG8_SCHED;
            PG8_LDB(B1, 1, 1); PG8_STAGE(PG8_SB(1, 0), b3, voffB);
            PG8_BAR; PG8_WAIT_L(0); PG8_MMA(0, 1, At, B1); PG8_BAR;
            PG8_LDA(At, 1, 1); PG8_STAGE(PG8_SA(1, 0), a3, voffA);
            PG8_BAR; PG8_WAIT_L(0); PG8_MMA(1, 0, At, B0); PG8_BAR; PG8_SCHED;
            PG8_STAGE(PG8_SB(1, 1), b3 + hstep, voffB);
            PG8_WAIT_V(6); PG8_BAR; PG8_MMA(1, 1, At, B1); PG8_BAR;
            }
        }
        if constexpr (ALIGN_EPI) { if (wr == 0) PG8_BAR; }
        if constexpr (FP8) asm volatile("s_nop 15\n\ts_nop 15" ::: "memory");
        if constexpr (!Epi::AFTER_DRAIN) { E(acc, cur, wr, wc, fr, fq); S.done(cur); }
        if (!has_next) break;
#pragma unroll
        for (int a = 0; a < 2; ++a)
#pragma unroll
            for (int b = 0; b < 2; ++b)
#pragma unroll
                for (int m = 0; m < 4; ++m)
#pragma unroll
                    for (int n = 0; n < 2; ++n) acc[a][b][m][n] = (f32x4){0.f, 0.f, 0.f, 0.f};
        cur = nxt; cA = nA; cB = nB; ++ui;
        if constexpr (ALIGN_EPI) { if (wr == 1) PG8_BAR; }
    }
    PG8_WAIT_V(0);
    if constexpr (!ALIGN_EPI) { if (wr == 0) PG8_BAR; }
    PG8_BAR;
    if constexpr (Epi::AFTER_DRAIN) { E.fused(acc, cur, wr, wc, fr, fq, lds, wid, lane); S.done(cur); }
#undef PG8_SA
#undef PG8_SB
#undef PG8_STAGE
#undef PG8_LDA
#undef PG8_LD8
#undef PG8_LDB
#undef PG8_MMA
#undef PG8_WAIT_V
#undef PG8_WAIT_L
#undef PG8_BAR
#undef PG8_SCHED
}
}
namespace pg8 {
typedef unsigned u32x2 __attribute__((ext_vector_type(2)));
constexpr int LDX = 2048;
constexpr float RMS_EPS = 1e-6f;
#ifndef EPI_SC1
#define EPI_SC1 1
#endif
__device__ __forceinline__ void store16(void* p, u32x4 w) {
#if EPI_SC1
    asm volatile("global_store_dwordx4 %0, %1, off sc1\n\ts_nop 1" :: "v"(p), "v"(w) : "memory");
#else
    *(u32x4*)p = w;
#endif
}
struct EpiQKV {
    static constexpr bool PERM = true, AFTER_DRAIN = false;
    bf16_t* O; const float* cs; float qscale; float* ksum; int vmode; float vscale;
    __device__ __forceinline__ void operator()(const f32x4 (&acc)[2][2][4][2], const Unit& u, int wr, int wc, int fr, int fq) const {
        const int row0 = u.pm * BM + wr * 64 + fr, pn = vmode ? (u.pn < 4 ? u.pn + 8 : u.pn + 16) : (u.pn < 8 ? u.pn : u.pn + 4);
        const float sc = (pn < 4 || (pn >= 12 && pn < 16)) ? qscale : vscale;
        const bool rot = (pn >= 12 && pn < 20) && (wc == 0);
        bf16_t* Ot = O + ((size_t)((u.pm >> 3) * 6 + (pn >> 2)) * 8 + (pn & 3) * 2) * (2048 * 128) + wc * 32 + 8 * fq;
        const bool kacc = (pn >= 16 && pn < 20);
        f32x4 ks[2][2] = {{{0.f, 0.f, 0.f, 0.f}, {0.f, 0.f, 0.f, 0.f}}, {{0.f, 0.f, 0.f, 0.f}, {0.f, 0.f, 0.f, 0.f}}};
#pragma unroll
        for (int ai = 0; ai < 2; ++ai)
#pragma unroll
            for (int m = 0; m < 4; ++m) { const int row = row0 + ai * HALF + m * 16; bf16_t* rowp = Ot + (size_t)(row & 2047) * 128;
                f32x4 c0 = {1.f, 1.f, 1.f, 1.f}, c1 = c0, s0 = {0.f, 0.f, 0.f, 0.f}, s1 = s0;
                if (rot) { const float* cr = cs + (size_t)row * 32 + 8 * (fq & 1); c0 = *(const f32x4*)cr; c1 = *(const f32x4*)(cr + 4); s0 = *(const f32x4*)(cr + 16); s1 = *(const f32x4*)(cr + 20);
                    if (fq < 2) { s0 = -s0; s1 = -s1; } }
#pragma unroll
                for (int bj = 0; bj < 2; ++bj) { f32x4 v0 = acc[ai][bj][m][0], v1 = acc[ai][bj][m][1];
                    if (rot) { f32x4 p0, p1;
#pragma unroll
                        for (int j = 0; j < 4; ++j) { p0[j] = __shfl_xor(v0[j], 32); p1[j] = __shfl_xor(v1[j], 32); }
                        v0 = v0 * c0 + p0 * s0; v1 = v1 * c1 + p1 * s1; }
                    if (kacc) { ks[bj][0] += v0; ks[bj][1] += v1; }
                    v0 = v0 * sc; v1 = v1 * sc; u32x4 w; w.x = cvt_pk_bf16(v0[0], v0[1]); w.y = cvt_pk_bf16(v0[2], v0[3]); w.z = cvt_pk_bf16(v1[0], v1[1]); w.w = cvt_pk_bf16(v1[2], v1[3]);
                    store16(rowp + (size_t)bj * (2048 * 128), w); } }
        if (kacc) {
            float* kp = ksum + (size_t)(((u.pm >> 3) * 8 + (pn - 16) * 2) * 8 + (u.pm & 7)) * 128 + wc * 32 + 8 * fq;
#pragma unroll
            for (int bj = 0; bj < 2; ++bj)
#pragma unroll
                for (int n = 0; n < 2; ++n)
#pragma unroll
                    for (int j = 0; j < 4; ++j) { float s = ks[bj][n][j]; s += __shfl_xor(s, 1); s += __shfl_xor(s, 2); s += __shfl_xor(s, 4); s += __shfl_xor(s, 8);
                        if (fr == 0) atomicAdd(kp + bj * 1024 + n * 4 + j, s); }
        }
    }
};
__device__ __forceinline__ unsigned pk4_fp8(float a, float b, float c, float d) {
    a = __builtin_amdgcn_fmed3f(a, -448.f, 448.f); b = __builtin_amdgcn_fmed3f(b, -448.f, 448.f); c = __builtin_amdgcn_fmed3f(c, -448.f, 448.f); d = __builtin_amdgcn_fmed3f(d, -448.f, 448.f);
    int p = __builtin_amdgcn_cvt_pk_fp8_f32(a, b, 0, false); p = __builtin_amdgcn_cvt_pk_fp8_f32(c, d, p, true); return (unsigned)p; }
struct EpiRes {
    static constexpr bool PERM = false, AFTER_DRAIN = false;
    const float* base; float* out; bf16_t* xb; float* ssq; unsigned char* x8; float s8; float ascale;
    __device__ __forceinline__ void operator()(const f32x4 (&acc)[2][2][4][2], const Unit& u, int wr, int wc, int fr, int fq) const {
        const int row0 = u.pm * BM + wr * 64 + fr, col0 = u.pn * BM + wc * 32 + 4 * fq;
#pragma unroll
        for (int ai = 0; ai < 2; ++ai)
#pragma unroll
            for (int m = 0; m < 4; ++m) { const int row = row0 + ai * HALF + m * 16; const size_t off = (size_t)row * LDX + col0; float s = 0.f;
#pragma unroll
                for (int bj = 0; bj < 2; ++bj)
#pragma unroll
                    for (int n = 0; n < 2; ++n) { const f32x4 v = *(const f32x4*)(base + off + bj * HALF + n * 16) + acc[ai][bj][m][n] * ascale;
                        *(f32x4*)(out + off + bj * HALF + n * 16) = v; s += (v[0] * v[0] + v[1] * v[1]) + (v[2] * v[2] + v[3] * v[3]);
                        if (xb) { u32x2 w; w.x = cvt_pk_bf16(v[0], v[1]); w.y = cvt_pk_bf16(v[2], v[3]); *(u32x2*)(xb + off + bj * HALF + n * 16) = w; }
                        if (x8) { *(unsigned*)(x8 + off + bj * HALF + n * 16) = pk4_fp8(v[0] * s8, v[1] * s8, v[2] * s8, v[3] * s8); } }
                if (ssq) { s += __shfl_xor(s, 16); s += __shfl_xor(s, 32); if (fq == 0) atomicAdd(ssq + row, s); }
                asm volatile("" ::: "memory"); }
    }
};
template <bool BASE_F32> struct EpiResB {
    static constexpr bool PERM = true, AFTER_DRAIN = false;
    const void* base; bf16_t* xo; float* ssq; unsigned char* x8; float s8; float ascale;
    __device__ __forceinline__ void operator()(const f32x4 (&acc)[2][2][4][2], const Unit& u, int wr, int wc, int fr, int fq) const {
        const int row0 = u.pm * BM + wr * 64 + fr, col0 = u.pn * BM + wc * 32 + 8 * fq;
#pragma unroll
        for (int ai = 0; ai < 2; ++ai)
#pragma unroll
            for (int m = 0; m < 4; ++m) { const int row = row0 + ai * HALF + m * 16; const size_t off = (size_t)row * LDX + col0; float s = 0.f;
#pragma unroll
                for (int bj = 0; bj < 2; ++bj) { f32x4 b0, b1;
                    if (BASE_F32) { const float* bp = (const float*)base + off + bj * HALF; b0 = *(const f32x4*)bp; b1 = *(const f32x4*)(bp + 4); }
                    else { const u32x4 w = *(const u32x4*)((const bf16_t*)base + off + bj * HALF);
                        b0 = (f32x4){__uint_as_float(w.x << 16), __uint_as_float(w.x & 0xffff0000u), __uint_as_float(w.y << 16), __uint_as_float(w.y & 0xffff0000u)};
                        b1 = (f32x4){__uint_as_float(w.z << 16), __uint_as_float(w.z & 0xffff0000u), __uint_as_float(w.w << 16), __uint_as_float(w.w & 0xffff0000u)}; }
                    const f32x4 v0 = b0 + acc[ai][bj][m][0] * ascale, v1 = b1 + acc[ai][bj][m][1] * ascale;
                    s += ((v0[0] * v0[0] + v0[1] * v0[1]) + (v0[2] * v0[2] + v0[3] * v0[3])) + ((v1[0] * v1[0] + v1[1] * v1[1]) + (v1[2] * v1[2] + v1[3] * v1[3]));
                    if (xo) { u32x4 w; w.x = cvt_pk_bf16(v0[0], v0[1]); w.y = cvt_pk_bf16(v0[2], v0[3]); w.z = cvt_pk_bf16(v1[0], v1[1]); w.w = cvt_pk_bf16(v1[2], v1[3]); store16(xo + off + bj * HALF, w); }
                    if (x8) { u32x2 w8; w8.x = pk4_fp8(v0[0] * s8, v0[1] * s8, v0[2] * s8, v0[3] * s8); w8.y = pk4_fp8(v1[0] * s8, v1[1] * s8, v1[2] * s8, v1[3] * s8); *(u32x2*)(x8 + off + bj * HALF) = w8; } }
                if (ssq) { s += __shfl_xor(s, 16); s += __shfl_xor(s, 32); if (fq == 0) atomicAdd(ssq + row, s); }
                if (BASE_F32 ? (m & 1) : (m == 3)) asm volatile("" ::: "memory"); }
    }
};
struct EpiScale {
    static constexpr bool PERM = true, AFTER_DRAIN = false;
    bf16_t* O; int ldc; const float* ssq; float sc;
    __device__ __forceinline__ void operator()(const f32x4 (&acc)[2][2][4][2], const Unit& u, int wr, int wc, int fr, int fq) const {
        const int row0 = u.pm * BM + wr * 64 + fr, col0 = u.pn * BM + wc * 32 + 8 * fq;
        float sv[2][4];
#pragma unroll
        for (int ai = 0; ai < 2; ++ai)
#pragma unroll
            for (int m = 0; m < 4; ++m) sv[ai][m] = ssq ? ssq[row0 + ai * HALF + m * 16] : 0.f;
#pragma unroll
        for (int ai = 0; ai < 2; ++ai)
#pragma unroll
            for (int m = 0; m < 4; ++m) { const int row = row0 + ai * HALF + m * 16; bf16_t* rowp = O + (size_t)row * ldc + col0;
                const float f = ssq ? sc * __builtin_amdgcn_rsqf(sv[ai][m] * (1.0f / 2048.0f) + RMS_EPS) : sc;
#pragma unroll
                for (int bj = 0; bj < 2; ++bj) { const f32x4 v0 = acc[ai][bj][m][0] * f, v1 = acc[ai][bj][m][1] * f;
                    u32x4 w; w.x = cvt_pk_bf16(v0[0], v0[1]); w.y = cvt_pk_bf16(v0[2], v0[3]); w.z = cvt_pk_bf16(v1[0], v1[1]); w.w = cvt_pk_bf16(v1[2], v1[3]);
                    *(u32x4*)(rowp + bj * HALF) = w; } }
    }
};
struct EpiNull { static constexpr bool PERM = true, AFTER_DRAIN = false; float* sink;
    __device__ __forceinline__ void operator()(const f32x4 (&acc)[2][2][4][2], const Unit& u, int wr, int wc, int fr, int fq) const {
#pragma unroll
        for (int ai = 0; ai < 2; ++ai)
#pragma unroll
            for (int bj = 0; bj < 2; ++bj)
#pragma unroll
                for (int m = 0; m < 4; ++m)
#pragma unroll
                    for (int n = 0; n < 2; ++n) asm volatile("" :: "v"(acc[ai][bj][m][n])); } };
struct EpiSwiGLU {
    static constexpr bool PERM = true, AFTER_DRAIN = false;
    bf16_t* O; const float* ssq; unsigned char* O8; float ascale, oscale;
    __device__ __forceinline__ void operator()(const f32x4 (&acc)[2][2][4][2], const Unit& u, int wr, int wc, int fr, int fq) const {
        const int row0 = u.pm * BM + wr * 64 + fr, col0 = u.pn * HALF + wc * 32 + 8 * fq;
        float sv[2][4];
#pragma unroll
        for (int ai = 0; ai < 2; ++ai)
#pragma unroll
            for (int m = 0; m < 4; ++m) sv[ai][m] = ssq[row0 + ai * HALF + m * 16];
#pragma unroll
        for (int ai = 0; ai < 2; ++ai)
#pragma unroll
            for (int m = 0; m < 4; ++m) { const int row = row0 + ai * HALF + m * 16; bf16_t* rowp = O + (size_t)row * 5632 + col0;
                const float f = ascale * __builtin_amdgcn_rsqf(sv[ai][m] * (1.0f / 2048.0f) + RMS_EPS);
                const float fneg = -1.4426950408889634f * f, f2o = f * f * (O8 ? oscale : 1.0f);
                float r[8];
#pragma unroll
                for (int n = 0; n < 2; ++n)
#pragma unroll
                    for (int j = 0; j < 4; ++j) { const float ag = acc[ai][0][m][n][j], au = acc[ai][1][m][n][j];
                        r[n * 4 + j] = (ag * au) * (f2o * __builtin_amdgcn_rcpf(1.0f + __builtin_amdgcn_exp2f(fneg * ag))); }
                if (O8) { u32x2 w8; w8.x = pk4_fp8(r[0], r[1], r[2], r[3]); w8.y = pk4_fp8(r[4], r[5], r[6], r[7]);
                    *(u32x2*)(O8 + (size_t)row * 5632 + col0) = w8; }
                else { u32x4 w; w.x = cvt_pk_bf16(r[0], r[1]); w.y = cvt_pk_bf16(r[2], r[3]); w.z = cvt_pk_bf16(r[4], r[5]); w.w = cvt_pk_bf16(r[6], r[7]);
                *(u32x4*)rowp = w; } }
    }
};
}
namespace att {
using bf16x8 = __attribute__((ext_vector_type(8))) short;
using s16x4  = __attribute__((ext_vector_type(4))) short;
using f32x16 = __attribute__((ext_vector_type(16))) float;
using f32x4  = __attribute__((ext_vector_type(4))) float;
using u32x4  = __attribute__((ext_vector_type(4))) unsigned;
typedef unsigned short bf16;
constexpr int D = 128, KVBLK = 64;
constexpr int SHM_V = KVBLK * D * 2, SHM_K = KVBLK * D * 2;
constexpr int OFF_Q = 2 * SHM_V + 2 * SHM_K, OFF_WS = 131072 + 1024, OFF_KM = OFF_WS + 2048, ATT_LDS = OFF_KM + 4096;
constexpr float THR = 8.f;
constexpr float SB_DONE = 7.8886e-31f;
#ifndef QREG_SOFTMAX
#define QREG_SOFTMAX 1
#endif
#ifndef PIPE_SOFTMAX
#define PIPE_SOFTMAX 0
#endif
#define KSWZ(row, colB) ((row) * 256 + ((colB) ^ (((row) & 7) << 4)))
#define SBAR() __builtin_amdgcn_sched_barrier(0)
__device__ __forceinline__ int crow(int r, int hi) { return (r & 3) + 8 * (r >> 2) + 4 * hi; }
__device__ __forceinline__ unsigned cvtpk(float lo, float hi) { unsigned r; asm volatile("v_cvt_pk_bf16_f32 %0, %1, %2" : "=v"(r) : "v"(lo), "v"(hi)); return r; }
__device__ __forceinline__ float xchg32(float x, int hi) { auto rr = __builtin_amdgcn_permlane32_swap(__float_as_uint(x), __float_as_uint(x), false, false); return __uint_as_float(hi ? rr[0] : rr[1]); }
typedef __attribute__((address_space(3))) const char* lds_cp;
template <int D0> __device__ __forceinline__ void qkt_part(f32x16& p0, f32x16& p1, const lds_cp (&ka)[2][4], int boff, const lds_cp (&qa)[2][4]) {
  const bf16x8 qf = *reinterpret_cast<const __attribute__((address_space(3))) bf16x8*>(qa[D0 >> 2][D0 & 3]);
  const bf16x8 b0 = *reinterpret_cast<const __attribute__((address_space(3))) bf16x8*>(ka[D0 >> 2][D0 & 3] + boff);
  const bf16x8 b1 = *reinterpret_cast<const __attribute__((address_space(3))) bf16x8*>(ka[D0 >> 2][D0 & 3] + boff + 8192);
  p0 = __builtin_amdgcn_mfma_f32_32x32x16_bf16(b0, qf, p0, 0, 0, 0);
  p1 = __builtin_amdgcn_mfma_f32_32x32x16_bf16(b1, qf, p1, 0, 0, 0);
}
template <int D0> __device__ __forceinline__ void qkt_part(f32x16& p0, f32x16& p1, const lds_cp (&ka)[2][4], int boff, const bf16x8 (&qg)[8]) {
  const bf16x8 b0 = *reinterpret_cast<const __attribute__((address_space(3))) bf16x8*>(ka[D0 >> 2][D0 & 3] + boff);
  const bf16x8 b1 = *reinterpret_cast<const __attribute__((address_space(3))) bf16x8*>(ka[D0 >> 2][D0 & 3] + boff + 8192);
  p0 = __builtin_amdgcn_mfma_f32_32x32x16_bf16(b0, qg[D0], p0, 0, 0, 0);
  p1 = __builtin_amdgcn_mfma_f32_32x32x16_bf16(b1, qg[D0], p1, 0, 0, 0);
}
#define KLD(G, A0, A1) do { A0 = *reinterpret_cast<const __attribute__((address_space(3))) bf16x8*>(ka[(G) >> 2][(G) & 3] + boff); A1 = *reinterpret_cast<const __attribute__((address_space(3))) bf16x8*>(ka[(G) >> 2][(G) & 3] + boff + 8192); } while (0)
#define KMM(G, A0, A1) do { p0 = __builtin_amdgcn_mfma_f32_32x32x16_bf16(A0, qg[G], p0, 0, 0, 0); p1 = __builtin_amdgcn_mfma_f32_32x32x16_bf16(A1, qg[G], p1, 0, 0, 0); } while (0)
__device__ __forceinline__ void qkt(f32x16& p0, f32x16& p1, const lds_cp (&ka)[2][4], int boff, const bf16x8 (&qg)[8], float bias = 0.f) {
#pragma unroll
  for (int r = 0; r < 16; ++r) { p0[r] = bias; p1[r] = bias; }
  bf16x8 a0, a1, b0, b1, c0, c1, d0, d1;
  KLD(0, a0, a1); KLD(1, b0, b1); KLD(2, c0, c1); KLD(3, d0, d1); SBAR();
  KMM(0, a0, a1); SBAR(); KLD(4, a0, a1); SBAR();
  KMM(1, b0, b1); SBAR(); KLD(5, b0, b1); SBAR();
  KMM(2, c0, c1); SBAR(); KLD(6, c0, c1); SBAR();
  KMM(3, d0, d1); SBAR(); KLD(7, d0, d1); SBAR();
  KMM(4, a0, a1); KMM(5, b0, b1); KMM(6, c0, c1); KMM(7, d0, d1);
}
#undef KLD
#undef KMM
__device__ __forceinline__ void qkt(f32x16& p0, f32x16& p1, const lds_cp (&ka)[2][4], int boff, const lds_cp (&qr)[2][4], float bias = 0.f) {
#pragma unroll
  for (int r = 0; r < 16; ++r) { p0[r] = bias; p1[r] = bias; }
  qkt_part<0>(p0, p1, ka, boff, qr); qkt_part<1>(p0, p1, ka, boff, qr); qkt_part<2>(p0, p1, ka, boff, qr); qkt_part<3>(p0, p1, ka, boff, qr);
  qkt_part<4>(p0, p1, ka, boff, qr); qkt_part<5>(p0, p1, ka, boff, qr); qkt_part<6>(p0, p1, ka, boff, qr); qkt_part<7>(p0, p1, ka, boff, qr);
}
__device__ __forceinline__ int v_st(int k, int c) { const int kk = (k & ~0xC) | ((k & 4) << 1) | ((k & 8) >> 1); return ((kk >> 3) * 4 + (c >> 5)) * 512 + ((kk & 7) * 32 + (c & 31)) * 2; }
__device__ __forceinline__ int v_rd_base(int lane) { return ((lane & 3) << 3) | (((lane >> 2) & 3) << 6) | (((lane >> 4) & 1) << 5) | (((lane >> 5) & 1) << 8); }
constexpr int v_rd_off(int d0, int ks, int half) { return d0 * 512 + ks * 4096 + half * 2048; }
template <int OFF> __device__ __forceinline__ s16x4 tr_read(int vb) { s16x4 r; asm volatile("ds_read_b64_tr_b16 %0, %1 offset:%2" : "=&v"(r) : "v"(vb), "i"(OFF) : "memory"); return r; }
struct VFrag { s16x4 l0, h0, l1, h1, l2, h2, l3, h3; };
template <int D0> __device__ __forceinline__ void v_read(VFrag& f, int vb) {
  f.l0 = tr_read<v_rd_off(D0, 0, 0)>(vb); f.h0 = tr_read<v_rd_off(D0, 0, 1)>(vb); f.l1 = tr_read<v_rd_off(D0, 1, 0)>(vb); f.h1 = tr_read<v_rd_off(D0, 1, 1)>(vb);
  f.l2 = tr_read<v_rd_off(D0, 2, 0)>(vb); f.h2 = tr_read<v_rd_off(D0, 2, 1)>(vb); f.l3 = tr_read<v_rd_off(D0, 3, 0)>(vb); f.h3 = tr_read<v_rd_off(D0, 3, 1)>(vb);
}
__device__ __forceinline__ void pv_mma(f32x16& od, const VFrag& f, bf16x8 pa0, bf16x8 pa1, bf16x8 pa2, bf16x8 pa3) {
#define PK(L, H) (bf16x8){L[0], L[1], L[2], L[3], H[0], H[1], H[2], H[3]}
  od = __builtin_amdgcn_mfma_f32_32x32x16_bf16(pa0, PK(f.l0, f.h0), od, 0, 0, 0);
  od = __builtin_amdgcn_mfma_f32_32x32x16_bf16(pa1, PK(f.l1, f.h1), od, 0, 0, 0);
  od = __builtin_amdgcn_mfma_f32_32x32x16_bf16(pa2, PK(f.l2, f.h2), od, 0, 0, 0);
  od = __builtin_amdgcn_mfma_f32_32x32x16_bf16(pa3, PK(f.l3, f.h3), od, 0, 0, 0);
#undef PK
}
__device__ __forceinline__ void pv_d0(f32x16* o, int vb, bf16x8 pa0, bf16x8 pa1, bf16x8 pa2, bf16x8 pa3) {
  VFrag fa, fb;
  v_read<0>(fa, vb);
  v_read<1>(fb, vb); asm volatile("s_waitcnt lgkmcnt(8)" ::: "memory"); SBAR(); pv_mma(o[0], fa, pa0, pa1, pa2, pa3); SBAR();
  v_read<2>(fa, vb); asm volatile("s_waitcnt lgkmcnt(8)" ::: "memory"); SBAR(); pv_mma(o[1], fb, pa0, pa1, pa2, pa3); SBAR();
  v_read<3>(fb, vb); asm volatile("s_waitcnt lgkmcnt(8)" ::: "memory"); SBAR(); pv_mma(o[2], fa, pa0, pa1, pa2, pa3); SBAR();
  asm volatile("s_waitcnt lgkmcnt(0)" ::: "memory"); SBAR(); pv_mma(o[3], fb, pa0, pa1, pa2, pa3);
}
__device__ __forceinline__ void pack_p(const f32x16& p0, const f32x16& p1, bf16x8& pa0, bf16x8& pa1, bf16x8& pa2, bf16x8& pa3) {
#define PK4(P, BASE, OUT) do { unsigned a0 = cvtpk(P[BASE + 0], P[BASE + 1]), a1 = cvtpk(P[BASE + 2], P[BASE + 3]);   \
    unsigned b0 = cvtpk(P[BASE + 4], P[BASE + 5]), b1 = cvtpk(P[BASE + 6], P[BASE + 7]);                              \
    auto r0 = __builtin_amdgcn_permlane32_swap(a0, b0, false, false); auto r1 = __builtin_amdgcn_permlane32_swap(a1, b1, false, false); \
    u32x4 w = {r0[0], r1[0], r0[1], r1[1]}; OUT = *reinterpret_cast<bf16x8*>(&w); } while (0)
  PK4(p0, 0, pa0); PK4(p0, 8, pa1); PK4(p1, 0, pa2); PK4(p1, 8, pa3);
#undef PK4
}
__device__ __forceinline__ void softmax_tile(f32x16& p0, f32x16& p1, float& m_reg, float& l_reg, float& alpha) {
  float pmax = p0[0];
#pragma unroll
  for (int r = 1; r < 16; ++r) pmax = fmaxf(pmax, p0[r]);
#pragma unroll
  for (int r = 0; r < 16; ++r) pmax = fmaxf(pmax, p1[r]);
  pmax = fmaxf(pmax, xchg32(pmax, (int)(threadIdx.x >> 5) & 1));
  if (__all(pmax - m_reg <= THR)) { alpha = 1.f; }
  else { const float mn = fmaxf(m_reg, pmax); alpha = __builtin_amdgcn_exp2f(m_reg - mn); m_reg = mn; }
  float ps = 0.f;
#pragma unroll
  for (int r = 0; r < 16; ++r) { p0[r] = __builtin_amdgcn_exp2f(p0[r] - m_reg); ps += p0[r]; }
#pragma unroll
  for (int r = 0; r < 16; ++r) { p1[r] = __builtin_amdgcn_exp2f(p1[r] - m_reg); ps += p1[r]; }
  ps += xchg32(ps, (int)(threadIdx.x >> 5) & 1);
  l_reg = l_reg * alpha + ps;
}
template <bool BAND, int I> __device__ __forceinline__ float sb_group(f32x16& P, int kb, int qrel, int hi) {
  float run = 1.f;
#pragma unroll
  for (int e = 3; e >= 0; --e) { const int r = 4 * I + e; float rr = __builtin_amdgcn_rcpf(1.0f + __builtin_amdgcn_exp2f(P[r]));
    if (BAND) rr = (kb + crow(r, hi) < qrel) ? rr : 1.f;
    P[r] = (1.0f - rr) * run; run *= rr; }
  return run;
}
__device__ __forceinline__ void sb_combine(f32x16& p0, f32x16& p1, float (&gs)[8], float& carry, int hi) {
  float acc = 1.f;
#pragma unroll
  for (int i = 7; i >= 0; --i) { const float so_i = acc; acc *= gs[i]; const float x = hi ? acc : so_i; gs[i] = carry * so_i * xchg32(x, hi); }
  carry *= acc * xchg32(acc, hi);
#pragma unroll
  for (int i = 0; i < 4; ++i)
#pragma unroll
    for (int e = 0; e < 4; ++e) { p0[4 * i + e] *= gs[i]; p1[4 * i + e] *= gs[4 + i]; }
}
template <bool BAND>
__device__ __forceinline__ void sb_tile(f32x16& p0, f32x16& p1, float& carry, int kb, int qrel, int hi) {
  float gs[8];
  gs[0] = sb_group<BAND, 0>(p0, kb, qrel, hi); SBAR(); gs[1] = sb_group<BAND, 1>(p0, kb, qrel, hi); SBAR(); gs[2] = sb_group<BAND, 2>(p0, kb, qrel, hi); SBAR(); gs[3] = sb_group<BAND, 3>(p0, kb, qrel, hi); SBAR();
  gs[4] = sb_group<BAND, 0>(p1, kb + 32, qrel, hi); SBAR(); gs[5] = sb_group<BAND, 1>(p1, kb + 32, qrel, hi); SBAR(); gs[6] = sb_group<BAND, 2>(p1, kb + 32, qrel, hi); SBAR(); gs[7] = sb_group<BAND, 3>(p1, kb + 32, qrel, hi); SBAR();
  sb_combine(p0, p1, gs, carry, hi);
}

template <int MODE, bool OUT8 = false>
__device__ __forceinline__ void attn_unit(const bf16* __restrict__ Qb, int ldq, const bf16* __restrict__ Kh, const bf16* __restrict__ Vh, int ldk, bf16* __restrict__ Ob, int ldo,
                                          const float* __restrict__ gain, const float* __restrict__ kmean, int qb, int nkeys, char* lds, float s8 = 1.f) {
  int tid_ = threadIdx.x; asm volatile("" : "+v"(tid_));
  const int tid = tid_, wid = __builtin_amdgcn_readfirstlane(tid >> 6), lane = tid & 63, r32 = lane & 31, hi = lane >> 5;
  char* V_lds = lds; char* K_lds = lds + 2 * SHM_V;
  float* ws = (float*)(lds + OFF_WS) + wid * 64; float* li_l = ws; float* al_l = ws + 32;
  float* km_l = (float*)(lds + OFF_KM);
  int* flg = (int*)(lds + OFF_KM);
  const int NT = (MODE == 0) ? nkeys / KVBLK : 4 * (qb + 1);
  const int qrel = wid * 32 + r32;
  float m_reg = -1e30f, l_reg = 0.f, carry = 1.f; f32x16 o[4] = {};
  const int vb0 = (int)(uintptr_t)V_lds + v_rd_base(lane);
  lds_cp ka[2][4];
#pragma unroll
  for (int y = 0; y < 2; ++y)
#pragma unroll
    for (int x = 0; x < 4; ++x) ka[y][x] = (lds_cp)(__attribute__((address_space(3))) char*)K_lds + r32 * 256 + 128 * (y ^ ((r32 >> 3) & 1)) + 32 * (x ^ ((r32 >> 1) & 3)) + 16 * (hi ^ (r32 & 1));
  lds_cp qr[2][4];
#pragma unroll
  for (int y = 0; y < 2; ++y)
#pragma unroll
    for (int x = 0; x < 4; ++x) qr[y][x] = ka[y][x] + (OFF_Q - 2 * SHM_V) + wid * 8192;
  long ksrc[2], vsrc[2];
#pragma unroll
  for (int i = 0; i < 2; ++i) { const int piece = wid + 8 * i;
    { const int row = piece * 4 + (lane >> 4), c = (lane & 15) ^ (row & 15); ksrc[i] = (long)row * ldk + c * 8; }
    { const int sub = piece * 2 + (lane >> 5), kk = (sub >> 2) * 8 + ((lane & 31) >> 2), k = (kk & ~0xC) | ((kk & 4) << 1) | ((kk & 8) >> 1), c = (sub & 3) * 32 + (lane & 3) * 8; vsrc[i] = (long)k * ldk + c; } }
  typedef __attribute__((address_space(3))) unsigned lds_u32;
  lds_u32* kdst = (lds_u32*)(__attribute__((address_space(3))) char*)(K_lds) + wid * 256; lds_u32* vdst = (lds_u32*)(__attribute__((address_space(3))) char*)(V_lds) + wid * 256;
#define TILE(it) ((MODE == 2) ? (NT - 1 - (it)) : (it))
#define DMA_K(k0, b) do { _Pragma("unroll") for (int i_ = 0; i_ < 2; ++i_) __builtin_amdgcn_global_load_lds((const unsigned*)(Kh + (long)(k0) * ldk + ksrc[i_]), kdst + (b) * (SHM_K / 4) + i_ * 2048, 16, 0, 0); } while (0)
#define DMA_V(k0, b) do { _Pragma("unroll") for (int i_ = 0; i_ < 2; ++i_) __builtin_amdgcn_global_load_lds((const unsigned*)(Vh + (long)(k0) * ldk + vsrc[i_]), vdst + (b) * (SHM_V / 4) + i_ * 2048, 16, 0, 0); } while (0)
#define SDRAIN() asm volatile("s_waitcnt vmcnt(0)" ::: "memory")
#define KSLOT(i_) ((i_) == 2 ? (OFF_Q - 2 * SHM_V) : (i_) * SHM_K)
#define VSLOT(i_) ((i_) == 2 ? (OFF_Q + SHM_K) : (i_) * SHM_V)
#define DMA_K3(k0, so) do { _Pragma("unroll") for (int i_ = 0; i_ < 2; ++i_) __builtin_amdgcn_global_load_lds((const unsigned*)(Kh + (long)(k0) * ldk + ksrc[i_]), kdst + (so) / 4 + i_ * 2048, 16, 0, 0); } while (0)
#define DMA_V3(k0, so) do { _Pragma("unroll") for (int i_ = 0; i_ < 2; ++i_) __builtin_amdgcn_global_load_lds((const unsigned*)(Vh + (long)(k0) * ldk + vsrc[i_]), vdst + (so) / 4 + i_ * 2048, 16, 0, 0); } while (0)
  { lds_u32* qdst = (lds_u32*)(__attribute__((address_space(3))) char*)(lds + OFF_Q) + wid * 2048;
#pragma unroll
    for (int i = 0; i < 8; ++i) { const int row = 4 * i + (lane >> 4), c = (lane & 15) ^ (row & 15);
      __builtin_amdgcn_global_load_lds((const unsigned*)(Qb + (long)(wid * 32 + row) * ldq + c * 8), qdst + i * 256, 16, 0, 0); } }
  DMA_K(TILE(0) * KVBLK, 0); DMA_V(TILE(0) * KVBLK, 0); if (MODE == 2 || PIPE_SOFTMAX) DMA_K(TILE(1) * KVBLK, 1);
  constexpr bool RING3 = (MODE != 2) && QREG_SOFTMAX && !PIPE_SOFTMAX;
  unsigned selmask = 0u;
  if (MODE == 1) { if (tid < 256) *(f32x4*)(km_l + tid * 4) = *(const f32x4*)(kmean + tid * 4); }
  SDRAIN();
  __syncthreads();
  if (MODE == 1) {
    float g[8];
#pragma unroll
    for (int n = 0; n < 8; ++n) g[n] = 0.f;
    { const int rh = (r32 >> 1) & 3, r3 = (r32 >> 3) & 1;
      const lds_cp qbase = qr[0][0] - 32 * rh - 128 * r3;
#pragma unroll 1
      for (int d0 = 0; d0 < 8; ++d0) {
        const bf16x8 qf = *reinterpret_cast<const __attribute__((address_space(3))) bf16x8*>(qbase + 32 * ((d0 & 3) ^ rh) + 128 * ((d0 >> 2) ^ r3));
        float q[8];
#pragma unroll
        for (int j = 0; j < 8; ++j) q[j] = __uint_as_float(((unsigned)(unsigned short)qf[j]) << 16);
        const float* kmp = km_l + d0 * 16 + hi * 8;
#pragma unroll
        for (int n = 0; n < 7; ++n) { const f32x4 k0v = *(const f32x4*)(kmp + n * 128), k1v = *(const f32x4*)(kmp + n * 128 + 4);
          g[n] += (q[0] * k0v[0] + q[1] * k0v[1]) + (q[2] * k0v[2] + q[3] * k0v[3]) + (q[4] * k1v[0] + q[5] * k1v[1]) + (q[6] * k1v[2] + q[7] * k1v[3]); }
      } }
#pragma unroll
    for (int n = 0; n < 7; ++n) { g[n] += xchg32(g[n], hi); if (n >= qb) g[n] = -INFINITY; }
    g[7] = -INFINITY;
#pragma unroll
    for (int n = 0; n < 7; ++n) { int cnt = 0;
#pragma unroll
      for (int mI = 0; mI < 7; ++mI) { if (mI != n) cnt += (g[mI] > g[n] || (g[mI] == g[n] && mI < n)) ? 1 : 0; }
      if (n < qb && cnt < 3) selmask |= (1u << n); }
  }
  bf16x8 qg[8];
  if (QREG_SOFTMAX && MODE != 2) {
#pragma unroll
    for (int d0 = 0; d0 < 8; ++d0) qg[d0] = *reinterpret_cast<const __attribute__((address_space(3))) bf16x8*>(qr[d0 >> 2][d0 & 3]); }
  int kc = KSLOT(0), kn = KSLOT(1), kn2 = KSLOT(2), vc = VSLOT(0), vn = VSLOT(1), vn2 = VSLOT(2);
  if (RING3) { DMA_K3(TILE(1) * KVBLK, kn); DMA_V3(TILE(1) * KVBLK, vn);
    asm volatile("s_waitcnt lgkmcnt(0)" ::: "memory"); __syncthreads(); }
  f32x16 pA0, pA1, pB0, pB1; bf16x8 pa0, pa1, pa2, pa3;
  if (MODE == 2 || PIPE_SOFTMAX) { float bias0 = 0.f; if (MODE == 1) { if (NT > 4) bias0 = (selmask & 1u) ? 0.f : -INFINITY; }
    qkt(pA0, pA1, ka, 0, qr, bias0);
    __syncthreads(); }
  int it = 0;
#define JB(i_) ((MODE == 2) ? (3 - (i_)) : ((i_) - (NT - 4)))
#define STEP(A0, A1, B0, B1, BAND, HASNEXT) do { \
    if (it + 2 < NT) DMA_K(TILE(it + 2) * KVBLK, it & 1); \
    if (it + 1 < NT) DMA_V(TILE(it + 1) * KVBLK, (it + 1) & 1); \
    bool skip = false; const int jb = JB(it); \
    if (BAND) { if (MODE == 1) skip = (64 * jb > wid * 32 + 31); if (MODE == 2) skip = (64 * jb >= wid * 32 + 31); } \
    if (MODE == 2) skip = skip || __all(carry < SB_DONE);        \
    if (HASNEXT) { float bias_ = 0.f; if (MODE == 1) { if (it + 1 < NT - 4) bias_ = ((selmask >> ((it + 1) >> 2)) & 1u) ? 0.f : -INFINITY; } \
      qkt(B0, B1, ka, ((it + 1) & 1) * SHM_K, qr, bias_); } \
    if (!skip) { \
      if (MODE == 2) { sb_tile<(BAND) != 0>(A0, A1, carry, 64 * jb, qrel, hi); } \
      else { \
        if (MODE == 1 && (BAND)) { _Pragma("unroll") for (int r = 0; r < 16; ++r) { const int kr = 64 * jb + crow(r, hi); if (kr > qrel) A0[r] = -INFINITY; if (kr + 32 > qrel) A1[r] = -INFINITY; } } \
        float alpha; softmax_tile(A0, A1, m_reg, l_reg, alpha); \
        if (__any(alpha < 1.f)) { if (hi == 0) al_l[r32] = alpha; asm volatile("s_waitcnt lgkmcnt(0)" ::: "memory"); \
          _Pragma("unroll") for (int d = 0; d < 4; ++d) _Pragma("unroll") for (int r = 0; r < 16; ++r) o[d][r] *= al_l[crow(r, hi)]; } \
      } \
      pack_p(A0, A1, pa0, pa1, pa2, pa3); \
      pv_d0(o, vb0 + (it & 1) * SHM_V, pa0, pa1, pa2, pa3); \
    } \
    SDRAIN(); __syncthreads(); ++it; } while (0)
#define SB_LD(G, F) do { F##q = *reinterpret_cast<const __attribute__((address_space(3))) bf16x8*>(qr[(G) >> 2][(G) & 3]); \
      F##0 = *reinterpret_cast<const __attribute__((address_space(3))) bf16x8*>(ka[(G) >> 2][(G) & 3] + kb_); F##1 = *reinterpret_cast<const __attribute__((address_space(3))) bf16x8*>(ka[(G) >> 2][(G) & 3] + kb_ + 8192); } while (0)
#define SB_PART(G, P, I, B0, B1, FC, FN) do { if ((G) < 7) SB_LD(((G) + 1) & 7, FN);              \
      B0 = __builtin_amdgcn_mfma_f32_32x32x16_bf16(FC##0, FC##q, B0, 0, 0, 0); B1 = __builtin_amdgcn_mfma_f32_32x32x16_bf16(FC##1, FC##q, B1, 0, 0, 0); \
      gs_[G] = sb_group<false, I>(P, 0, 0, hi); SBAR(); } while (0)
#define STEP_SB(A0, A1, B0, B1) do { \
    if (it + 2 < NT) DMA_K(TILE(it + 2) * KVBLK, it & 1); \
    DMA_V(TILE(it + 1) * KVBLK, (it + 1) & 1); \
    float gs_[8]; \
    _Pragma("unroll") for (int r = 0; r < 16; ++r) { B0[r] = 0.f; B1[r] = 0.f; } \
    const int kb_ = ((it + 1) & 1) * SHM_K; bf16x8 fx0, fx1, fxq, fy0, fy1, fyq; SB_LD(0, fx); SBAR(); \
    SB_PART(0, A0, 0, B0, B1, fx, fy); SB_PART(1, A0, 1, B0, B1, fy, fx); SB_PART(2, A0, 2, B0, B1, fx, fy); SB_PART(3, A0, 3, B0, B1, fy, fx); \
    SB_PART(4, A1, 0, B0, B1, fx, fy); SB_PART(5, A1, 1, B0, B1, fy, fx); SB_PART(6, A1, 2, B0, B1, fx, fy); SB_PART(7, A1, 3, B0, B1, fy, fx); \
    sb_combine(A0, A1, gs_, carry, hi); \
    { const bool dn_ = __all(carry < SB_DONE); if (lane == 0) flg[(it & 1) * 8 + wid] = dn_ ? 1 : 0; } \
    pack_p(A0, A1, pa0, pa1, pa2, pa3); \
    pv_d0(o, vb0 + (it & 1) * SHM_V, pa0, pa1, pa2, pa3); \
    SDRAIN(); __syncthreads(); \
    { const int* f_ = flg + (it & 1) * 8; stop = (f_[0] + f_[1] + f_[2] + f_[3] + f_[4] + f_[5] + f_[6] + f_[7]) == 8; } \
    ++it; } while (0)
#define SSTEP(BAND) do { \
    if (RING3) { if (it + 2 < NT) { DMA_K3(TILE(it + 2) * KVBLK, kn2); DMA_V3(TILE(it + 2) * KVBLK, vn2); } } \
    else if (it + 1 < NT) { DMA_K(TILE(it + 1) * KVBLK, (it + 1) & 1); DMA_V(TILE(it + 1) * KVBLK, (it + 1) & 1); } \
    bool skip = false; const int jb = JB(it); \
    if (BAND) skip = (64 * jb > wid * 32 + 31); \
    if (!skip) { \
      float bias_ = 0.f; if (MODE == 1 && !(BAND)) bias_ = ((selmask >> (it >> 2)) & 1u) ? 0.f : -INFINITY; \
      const int kb_ = RING3 ? kc : (it & 1) * SHM_K; \
      if (QREG_SOFTMAX) qkt(pA0, pA1, ka, kb_, qg, bias_); else qkt(pA0, pA1, ka, kb_, qr, bias_); \
      if (MODE == 1 && (BAND)) { _Pragma("unroll") for (int r = 0; r < 16; ++r) { const int kr = 64 * jb + crow(r, hi); if (kr > qrel) pA0[r] = -INFINITY; if (kr + 32 > qrel) pA1[r] = -INFINITY; } } \
      float alpha; softmax_tile(pA0, pA1, m_reg, l_reg, alpha); \
      if (__any(alpha < 1.f)) { if (hi == 0) al_l[r32] = alpha; asm volatile("s_waitcnt lgkmcnt(0)" ::: "memory"); \
        _Pragma("unroll") for (int d = 0; d < 4; ++d) _Pragma("unroll") for (int r = 0; r < 16; ++r) o[d][r] *= al_l[crow(r, hi)]; } \
      pack_p(pA0, pA1, pa0, pa1, pa2, pa3); \
      pv_d0(o, vb0 + (RING3 ? vc : (it & 1) * SHM_V), pa0, pa1, pa2, pa3); \
    } \
    if (RING3) { if (it + 2 < NT) asm volatile("s_waitcnt vmcnt(4)" ::: "memory"); else SDRAIN();        \
      { const int t_ = kc; kc = kn; kn = kn2; kn2 = t_; } { const int t_ = vc; vc = vn; vn = vn2; vn2 = t_; } } \
    else SDRAIN(); \
    if (RING3) { asm volatile("s_waitcnt lgkmcnt(0)" ::: "memory"); __builtin_amdgcn_s_barrier(); asm volatile("" ::: "memory"); }     \
    else __syncthreads(); \
    ++it; } while (0)
#define RESTART(BIASEXPR) do { qkt(pA0, pA1, ka, (it & 1) * SHM_K, qr, (BIASEXPR)); __syncthreads(); } while (0)
  if (MODE == 0) {
    if (PIPE_SOFTMAX) { STEP(pA0, pA1, pB0, pB1, 0, true); STEP(pB0, pB1, pA0, pA1, 0, true); STEP(pA0, pA1, pB0, pB1, 0, true); STEP(pB0, pB1, pA0, pA1, 0, false); }
    else { SSTEP(0); SSTEP(0); SSTEP(0); SSTEP(0); }
  } else if (MODE == 1) {
    if (PIPE_SOFTMAX) {
      if (NT > 4) { while (it < NT - 4) { STEP(pA0, pA1, pB0, pB1, 0, true); STEP(pB0, pB1, pA0, pA1, 0, (it + 1 < NT - 4)); }
        RESTART(0.f); }
      STEP(pA0, pA1, pB0, pB1, 1, true); STEP(pB0, pB1, pA0, pA1, 1, true); STEP(pA0, pA1, pB0, pB1, 1, true); STEP(pB0, pB1, pA0, pA1, 1, false);
    } else {
      while (it < NT - 4) SSTEP(0);
      SSTEP(1); SSTEP(1); SSTEP(1); SSTEP(1);
    }
  } else {
    STEP(pA0, pA1, pB0, pB1, 1, true); STEP(pB0, pB1, pA0, pA1, 1, true); STEP(pA0, pA1, pB0, pB1, 1, true); STEP(pB0, pB1, pA0, pA1, 1, false);
    if (NT > 4) {
      RESTART(0.f);
      bool stop = false;
      while (it + 2 < NT && !stop) { STEP_SB(pA0, pA1, pB0, pB1); STEP_SB(pB0, pB1, pA0, pA1); }
      if (!stop) { STEP_SB(pA0, pA1, pB0, pB1); STEP(pB0, pB1, pA0, pA1, 0, false); }
    }
  }
#undef RESTART
#undef STEP
#undef SSTEP
#undef STEP_SB
#undef SB_LD
#undef SB_PART
#undef JB
  float rli[16];
  if (MODE != 2) { if (hi == 0) li_l[r32] = l_reg; asm volatile("s_waitcnt lgkmcnt(0)" ::: "memory");
#pragma unroll
    for (int r = 0; r < 16; ++r) rli[r] = __builtin_amdgcn_rcpf(li_l[crow(r, hi)]); }
  else {
#pragma unroll
    for (int r = 0; r < 16; ++r) rli[r] = 1.f; }
  if (gain) {
    float gv[4];
#pragma unroll
    for (int d0 = 0; d0 < 4; ++d0) gv[d0] = gain[d0 * 32 + r32];
#pragma unroll
    for (int r = 0; r < 16; ++r) { float s = 0.f;
#pragma unroll
      for (int d0 = 0; d0 < 4; ++d0) { o[d0][r] *= rli[r]; s += o[d0][r] * o[d0][r]; }
      s += __shfl_xor(s, 1); s += __shfl_xor(s, 2); s += __shfl_xor(s, 4); s += __shfl_xor(s, 8); s += __shfl_xor(s, 16);
      rli[r] = __builtin_amdgcn_rsqf(s * (1.0f / 128.0f) + 1e-6f); }
#pragma unroll
    for (int r = 0; r < 16; ++r)
#pragma unroll
      for (int d0 = 0; d0 < 4; ++d0) o[d0][r] *= gv[d0];
  }
  if (OUT8) { unsigned char* stg = (unsigned char*)lds + wid * 4096;
#pragma unroll
    for (int r = 0; r < 16; ++r) { const int orow = crow(r, hi);
#pragma unroll
      for (int d0 = 0; d0 < 4; ++d0) { const float v = __builtin_amdgcn_fmed3f(o[d0][r] * rli[r] * s8, -448.f, 448.f); stg[orow * 128 + d0 * 32 + r32] = (unsigned char)(__builtin_amdgcn_cvt_pk_fp8_f32(v, v, 0, false) & 0xff); } }
    asm volatile("s_waitcnt lgkmcnt(0)" ::: "memory");
#pragma unroll
    for (int i = 0; i < 4; ++i) { const int row = i * 8 + (lane >> 3), ch = lane & 7; const u32x4 v = *(const u32x4*)(stg + row * 128 + ch * 16); *(u32x4*)((unsigned char*)Ob + (long)(wid * 32 + row) * ldo + ch * 16) = v; } }
  else { bf16* stg = (bf16*)lds + wid * 4096;
#pragma unroll
    for (int r = 0; r < 16; ++r) { const int orow = crow(r, hi);
#pragma unroll
      for (int d0 = 0; d0 < 4; ++d0) { const float v = o[d0][r] * rli[r]; unsigned u = __float_as_uint(v); u = (u + 0x7fffu + ((u >> 16) & 1u)) >> 16; stg[orow * 128 + d0 * 32 + r32] = (bf16)u; } }
    asm volatile("s_waitcnt lgkmcnt(0)" ::: "memory");
#pragma unroll
    for (int i = 0; i < 8; ++i) { const int row = i * 4 + (lane >> 4), ch = lane & 15; const u32x4 v = *(const u32x4*)(stg + row * 128 + ch * 8); *(u32x4*)(Ob + (long)(wid * 32 + row) * ldo + ch * 8) = v; } }
  __syncthreads();
#undef TILE
#undef DMA_K
#undef DMA_V
#undef DMA_K3
#undef DMA_V3
#undef KSLOT
#undef VSLOT
#undef SDRAIN
}
#undef KSWZ
#undef SBAR
}
#define GAS __attribute__((address_space(1)))
#define LAS __attribute__((address_space(3)))
typedef unsigned short bf16;
typedef unsigned v4u __attribute__((ext_vector_type(4)));
typedef float f32x4 __attribute__((ext_vector_type(4)));
#define LDS_WAIT() asm volatile("s_waitcnt lgkmcnt(0)" ::: "memory")
constexpr int NWAVES = 8;
constexpr int BATCH = 8, SEQ = 2048, DM = 2048, M = BATCH * SEQ, HD = 128, NH = 8;
constexpr int NQKV = 6144, FF = 5632, WX = 512, NMEM = 256, MMEM = BATCH * NMEM;
constexpr int QSB = 0, KSB = 1024, VSB = 2048, QMB = 3072, KMB = 4096, VMB = 5120;
constexpr float EPS = 1e-6f;
constexpr float QSCALE = 0.12751743082459868f;
constexpr size_t MiB = 1u << 20;
constexpr size_t WS_CTL = 0, CTL_ZERO_BYTES = 512 * 1024;
constexpr size_t WS_SSQ1 = 64 * 1024, WS_SSQ2 = 128 * 1024;
constexpr size_t WS_KSUM = 256 * 1024;
constexpr size_t WS_WIN = 1 * MiB, WS_WOUT = 25 * MiB, WS_WXQ = 33 * MiB, WS_WXKV = 35 * MiB, WS_WXO = 39 * MiB, WS_WGU = 41 * MiB, WS_WDN = 85 * MiB;
constexpr size_t WS_RA = 107 * MiB;
constexpr size_t WS_RB = 171 * MiB;
constexpr size_t WS_RC = 235 * MiB;
constexpr size_t WS_QX = 427 * MiB, WS_OX = 443 * MiB, WS_KVX = 459 * MiB, WS_MN = 463 * MiB, WS_KMEAN = 471 * MiB, WS_CS = 472 * MiB, WS_END = 474 * MiB;
constexpr int RING_BYTES = 131072, LDS_BYTES = 147456;
#ifndef FFN_FP8
#define FFN_FP8 1
#endif
constexpr float S_X2 = 16.f, S_WGU = 32.f, S_ACT = 8.f, S_WDN = 64.f, S_XN = 16.f, S_WV = 32.f, S_O = 16.f, S_WO = 32.f;
constexpr float S_OX = 16.f, S_WXO = 16.f;
#ifndef WXO_FP8
#define WXO_FP8 1
#endif
#ifndef WOUT_FP8
#define WOUT_FP8 1
#endif
constexpr size_t WS_WV8 = WS_WIN + 16 * MiB;

__device__ __forceinline__ float bf2f(unsigned short b) { return __uint_as_float((unsigned)b << 16); }
__device__ __forceinline__ unsigned f2bf(float f) { unsigned u = __builtin_bit_cast(unsigned, f); return (u + 0x7fffu + ((u >> 16) & 1u)) >> 16; }
__device__ __forceinline__ unsigned pk2(float lo, float hi) { return f2bf(lo) | (f2bf(hi) << 16); }
__device__ __forceinline__ float wave_sum(float v) {
#pragma unroll
    for (int o = 1; o < 64; o <<= 1) v += __shfl_xor(v, o);
    return v;
}
__device__ __forceinline__ float wave_max(float v) {
#pragma unroll
    for (int o = 1; o < 64; o <<= 1) v = fmaxf(v, __shfl_xor(v, o));
    return v;
}

typedef GAS unsigned gu32;
#define RLX_AGENT __ATOMIC_RELAXED, __HIP_MEMORY_SCOPE_AGENT
constexpr int CW_BAR = 4096;
constexpr int LDSCTL_OFF = RING_BYTES, MISC_OFF = LDSCTL_OFF + 320;
#define XB_TMO      128
#define XB_XCNT(j)  (256  + 64 * (j))
#define XB_XSUB(j)  (1280 + 64 * (j))
#define XB_XGEN(j)  (2304 + 64 * (j))
#define XB_TOP      3328
#define XB_TOPGEN   3392
#define XCD_BAR_WORDS 3456
#define XB_SPIN_CAP (1u << 18)

__device__ __forceinline__ unsigned xb_ld(unsigned* p)              { return __hip_atomic_load(p, __ATOMIC_RELAXED, __HIP_MEMORY_SCOPE_AGENT); }
__device__ __forceinline__ unsigned xb_add(unsigned* p, unsigned v) { return __hip_atomic_fetch_add(p, v, __ATOMIC_RELAXED, __HIP_MEMORY_SCOPE_AGENT); }
__device__ __forceinline__ unsigned xb_xcc_id() { return (unsigned)__builtin_amdgcn_s_getreg((3 << 11) | 20) & 0xFu; }
#define XB_SPIN(cond, bar) do { unsigned _sp = 0; while (cond) { __builtin_amdgcn_s_sleep(1); \
    if ((++_sp & 255u) == 0u) { if (xb_ld(&(bar)[XB_TMO])) break; if (_sp > XB_SPIN_CAP) { atomicAdd(&(bar)[XB_TMO], 1u); break; } } } } while (0)

struct XcdBarrier {
    unsigned* bar; unsigned x;
    volatile LAS unsigned* st;
};

__device__ __forceinline__ XcdBarrier xcd_barrier_post(unsigned* bar, volatile LAS unsigned* st) {
    XcdBarrier b; b.bar = bar; b.x = xb_xcc_id(); b.st = st;
    if (threadIdx.x == 0) (void)xb_add(&bar[XB_XCNT(b.x)], 1u);
    return b;
}
__device__ __forceinline__ void xcd_barrier_complete(unsigned* bar, unsigned x, unsigned& nloc, unsigned& nx) {
    const unsigned G = gridDim.x * gridDim.y * gridDim.z;
    unsigned sum, cnt, mine, sp = 0u;
    for (;;) {
        sum = 0u; cnt = 0u; mine = 0u;
#pragma unroll
        for (unsigned j = 0; j < 16; ++j) { const unsigned c = xb_ld(&bar[XB_XCNT(j)]); sum += c; cnt += (c > 0u) ? 1u : 0u; mine = (j == x) ? c : mine; }
        if (sum == G) break;
        __builtin_amdgcn_s_sleep(1);
        if ((++sp & 255u) == 0u) { if (xb_ld(&bar[XB_TMO])) break; if (sp > XB_SPIN_CAP) { atomicAdd(&bar[XB_TMO], 1u); break; } }
    }
    nloc = mine > 0u ? mine : 1u; nx = cnt > 0u ? cnt : 1u;
}

__device__ __forceinline__ void xcd_barrier(const XcdBarrier& b) {
    asm volatile("s_waitcnt vmcnt(0)" ::: "memory");
    __syncthreads();
    if (threadIdx.x == 0) {
        unsigned* bar = b.bar;
        __builtin_amdgcn_s_waitcnt(0);
        unsigned nloc = b.st[0], nx = b.st[1];
        if (nloc == 0u) { xcd_barrier_complete(bar, b.x, nloc, nx); b.st[0] = nloc; b.st[1] = nx; }
        const unsigned old = xb_add(&bar[XB_XSUB(b.x)], 1u);
        const unsigned gen = old / nloc;
        if (old + 1u == (gen + 1u) * nloc) {
            __builtin_amdgcn_fence(__ATOMIC_RELEASE, "agent");
            asm volatile("s_waitcnt vmcnt(0)" ::: "memory");
            const unsigned og = xb_add(&bar[XB_TOP], 1u);
            const unsigned tg = og / nx;
            if (og + 1u == (tg + 1u) * nx) xb_add(&bar[XB_TOPGEN], 1u);
            else XB_SPIN(xb_ld(&bar[XB_TOPGEN]) == tg, bar);
            __builtin_amdgcn_fence(__ATOMIC_ACQUIRE, "agent");
            xb_add(&bar[XB_XGEN(b.x)], 1u);
            asm volatile("s_waitcnt vmcnt(0)" ::: "memory");
        } else {
            XB_SPIN(xb_ld(&bar[XB_XGEN(b.x)]) == gen, bar);
            __builtin_amdgcn_fence(__ATOMIC_ACQUIRE, "agent");
            asm volatile("s_waitcnt vmcnt(0)" ::: "memory");
        }
    }
    __syncthreads();
}

struct Frame {
    LAS unsigned char* lds;
    int tid, lane, wave, vcu, G;
    const float *x, *mem; const int* pos;
    const float *g_mix, *w_in, *g_out_sb, *g_out_mb, *w_out, *g_xattn, *g_mem, *w_xq, *w_xkv, *w_xo, *g_ffn, *w_gu, *w_dn, *g_final;
    float* out; unsigned char* ws;
};

__device__ __forceinline__ void transpose_item(const float* W, int K, int N, bf16* WT, const float* gain, int inter, LAS float* scr, int item, int lane) {
    const int nblk = N / 32, kb = item / nblk, nb = item % nblk, k0 = 64 * kb, n0 = 32 * nb;
    int orow0 = n0;
    if (inter == 1) orow0 = (n0 < FF) ? (n0 / 128) * 256 + (n0 % 128) : ((n0 - FF) / 128) * 256 + 128 + ((n0 - FF) % 128);
    if (inter == 2) { const int reg = n0 / 1024, c = n0 % 1024; orow0 = (reg == 2) ? c : (reg == 5) ? 1024 + c : (reg < 2 ? reg : reg - 1) * 1024 + c; }
    float v[32];
#pragma unroll
    for (int i = 0; i < 32; ++i) v[i] = W[(size_t)(k0 + 2 * i + (lane >> 5)) * N + n0 + (lane & 31)];
#pragma unroll
    for (int i = 0; i < 32; ++i) { const int kk = 2 * i + (lane >> 5); float t = v[i]; if (gain) t *= gain[k0 + kk]; scr[kk * 33 + (lane & 31)] = t; }
    LDS_WAIT(); asm volatile("" ::: "memory");
    const int c = lane & 7;
#pragma unroll
    for (int j = 0; j < 4; ++j) { const int n = (lane >> 3) + 8 * j; const LAS float* s = scr + (8 * c) * 33 + n;
        v4u o; o.x = pk2(s[0 * 33], s[1 * 33]); o.y = pk2(s[2 * 33], s[3 * 33]); o.z = pk2(s[4 * 33], s[5 * 33]); o.w = pk2(s[6 * 33], s[7 * 33]);
        *(GAS v4u*)(WT + (size_t)(orow0 + n) * K + k0 + 8 * c) = o; }
    LDS_WAIT(); asm volatile("" ::: "memory");
}
__device__ __forceinline__ void transpose_item_fp8(const float* W, int K, int N, unsigned char* WT, const float* gain, int inter, float scale, LAS float* scr, int item, int lane) {
    const int nblk = N / 32, kb = item / nblk, nb = item % nblk, k0 = 64 * kb, n0 = 32 * nb;
    int orow0 = n0;
    if (inter == 1) orow0 = (n0 < FF) ? (n0 / 128) * 256 + (n0 % 128) : ((n0 - FF) / 128) * 256 + 128 + ((n0 - FF) % 128);
    if (inter == 2) { const int reg = n0 / 1024, c = n0 % 1024; orow0 = (reg == 2) ? c : (reg == 5) ? 1024 + c : (reg < 2 ? reg : reg - 1) * 1024 + c; }
    float v[32];
#pragma unroll
    for (int i = 0; i < 32; ++i) v[i] = W[(size_t)(k0 + 2 * i + (lane >> 5)) * N + n0 + (lane & 31)];
#pragma unroll
    for (int i = 0; i < 32; ++i) { const int kk = 2 * i + (lane >> 5); float t = v[i] * scale; if (gain) t *= gain[k0 + kk]; scr[kk * 33 + (lane & 31)] = t; }
    LDS_WAIT(); asm volatile("" ::: "memory");
    const int c = lane & 7;
#pragma unroll
    for (int j = 0; j < 4; ++j) { const int n = (lane >> 3) + 8 * j; const LAS float* s = scr + (8 * c) * 33 + n;
        pg8::u32x2 o; o.x = pg8::pk4_fp8(s[0 * 33], s[1 * 33], s[2 * 33], s[3 * 33]); o.y = pg8::pk4_fp8(s[4 * 33], s[5 * 33], s[6 * 33], s[7 * 33]);
        *(GAS pg8::u32x2*)(WT + (size_t)(orow0 + n) * K + k0 + 8 * c) = o; }
    LDS_WAIT(); asm volatile("" ::: "memory");
}
__device__ __forceinline__ void rms_row_to_bf16(const float* xrow, const float* g, bf16* orow, int lane, unsigned char* o8 = nullptr, float s8 = 1.f) {
    const GAS f32x4* xr = (const GAS f32x4*)xrow + lane; const GAS f32x4* gr = (const GAS f32x4*)g + lane;
    f32x4 v[8]; float s = 0.f;
#pragma unroll
    for (int j = 0; j < 8; ++j) { v[j] = xr[64 * j]; s += (v[j].x * v[j].x + v[j].y * v[j].y) + (v[j].z * v[j].z + v[j].w * v[j].w); }
    const float rstd = 1.0f / sqrtf(wave_sum(s) * (1.f / DM) + EPS);
    GAS unsigned long long* ob8 = (GAS unsigned long long*)orow + lane;
#pragma unroll
    for (int j = 0; j < 8; ++j) { const f32x4 gg = gr[64 * j];
        const float a0 = v[j].x * rstd * gg.x, a1 = v[j].y * rstd * gg.y, a2 = v[j].z * rstd * gg.z, a3 = v[j].w * rstd * gg.w;
        ob8[64 * j] = (unsigned long long)pk2(a0, a1) | ((unsigned long long)pk2(a2, a3) << 32);
        if (o8) ((GAS unsigned*)o8)[64 * j + lane] = pg8::pk4_fp8(a0 * s8, a1 * s8, a2 * s8, a3 * s8); }
}
__constant__ float INV_FREQ[16] = {1.000000000e+00f, 4.403665960e-01f, 1.939227432e-01f, 8.539710194e-02f, 3.760603070e-02f, 1.656043902e-02f, 7.292664610e-03f, 3.211445874e-03f,
                                   1.414213562e-03f, 6.227723788e-04f, 2.742481884e-04f, 1.207697351e-04f, 5.318296098e-05f, 2.341999971e-05f, 1.031338616e-05f, 4.541670478e-06f};

__device__ __forceinline__ void p0_prologue(Frame& F) {
    LAS float* scr = (LAS float*)(F.lds + F.wave * 16384);
    const int gw = F.vcu * NWAVES + F.wave, NGW = F.G * NWAVES;
    bf16* ws16 = (bf16*)F.ws;
    constexpr int I0 = (DM / 64) * (NQKV / 32), I1 = (DM / 64) * (DM / 32), I2 = (DM / 64) * (WX / 32), I3 = (DM / 64) * (2 * WX / 32), I4 = (WX / 64) * (DM / 32),
                  I5 = (DM / 64) * (2 * FF / 32), I6 = (FF / 64) * (DM / 32);
    constexpr int I5H = I5 / 2;
    constexpr int NITEMS = I0 + I1 + I2 + I3 + I4 + I5H;
    for (int it = gw; it < NITEMS; it += NGW) {
        int r = it;
        if (r < I0) { const int reg = ((r % (NQKV / 32)) * 32) / 1024;
            if (reg == 2 || reg == 5) transpose_item_fp8(F.w_in, DM, NQKV, F.ws + WS_WV8, nullptr, 2, S_WV, scr, r, F.lane);
            else transpose_item(F.w_in, DM, NQKV, (bf16*)(F.ws + WS_WIN), nullptr, 2, scr, r, F.lane);
            continue; } r -= I0;
        if (r < I1) { if (WOUT_FP8) transpose_item_fp8(F.w_out, DM, DM, F.ws + WS_WOUT, nullptr, 0, S_WO, scr, r, F.lane); else transpose_item(F.w_out, DM, DM, (bf16*)(F.ws + WS_WOUT), nullptr, 0, scr, r, F.lane); continue; } r -= I1;
        if (r < I2) { transpose_item(F.w_xq, DM, WX, (bf16*)(F.ws + WS_WXQ), F.g_xattn, 0, scr, r, F.lane); continue; } r -= I2;
        if (r < I3) { transpose_item(F.w_xkv, DM, 2 * WX, (bf16*)(F.ws + WS_WXKV), nullptr, 0, scr, r, F.lane); continue; } r -= I3;
        if (r < I4) { if (WXO_FP8) transpose_item_fp8(F.w_xo, WX, DM, F.ws + WS_WXO, nullptr, 0, S_WXO, scr, r, F.lane); else transpose_item(F.w_xo, WX, DM, (bf16*)(F.ws + WS_WXO), nullptr, 0, scr, r, F.lane); continue; } r -= I4;
        transpose_item_fp8(F.w_gu, DM, 2 * FF, F.ws + WS_WGU, F.g_ffn, 1, S_WGU, scr, r, F.lane);
    }
    (void)ws16;
    for (int m = gw; m < M; m += NGW) rms_row_to_bf16(F.x + (size_t)m * DM, F.g_mix, (bf16*)(F.ws + WS_RA) + (size_t)m * DM, F.lane, F.ws + WS_RB + (size_t)m * DM, S_XN);
    for (int m = gw; m < MMEM; m += NGW) rms_row_to_bf16(F.mem + (size_t)m * DM, F.g_mem, (bf16*)(F.ws + WS_MN) + (size_t)m * DM, F.lane);
    float* cs = (float*)(F.ws + WS_CS);
    for (int e = (F.vcu * NWAVES + F.wave) * 64 + F.lane; e < M * 16; e += NGW * 64) {
        const int m = e >> 4, i = e & 15; const float ang = (float)F.pos[m] * INV_FREQ[i];
        double rev = (double)ang * 0.15915494309189535; rev -= floor(rev);
        const float a = (float)(rev * 6.283185307179586);
        cs[(size_t)m * 32 + i] = cosf(a); cs[(size_t)m * 32 + 16 + i] = sinf(a);
    }
}

__device__ __forceinline__ void ffn_weight_items(Frame& F, int wi, int nw) {
    LAS float* scr = (LAS float*)(F.lds + F.wave * 16384);
    constexpr int I5 = (DM / 64) * (2 * FF / 32), I6 = (FF / 64) * (DM / 32);
    for (int it = wi + I5 / 2; it < I5 + I6; it += nw) {
        if (it < I5) transpose_item_fp8(F.w_gu, DM, 2 * FF, F.ws + WS_WGU, F.g_ffn, 1, S_WGU, scr, it, F.lane);
        else transpose_item_fp8(F.w_dn, FF, DM, F.ws + WS_WDN, nullptr, 0, S_WDN, scr, it - I5, F.lane);
    }
}

__device__ __forceinline__ void final_norm_phase(Frame& F, const bf16* src, float* dst) {
    const int gw = F.vcu * NWAVES + F.wave, NGW = F.G * NWAVES;
    for (int m = gw; m < M; m += NGW) {
        const GAS v4u* xr = (const GAS v4u*)(src + (size_t)m * DM) + F.lane; const GAS f32x4* gr = (const GAS f32x4*)F.g_final;
        v4u w[4]; float s = 0.f;
#pragma unroll
        for (int j = 0; j < 4; ++j) w[j] = xr[64 * j];
        f32x4 v[8];
#pragma unroll
        for (int j = 0; j < 4; ++j) { v[2 * j] = (f32x4){__uint_as_float(w[j].x << 16), __uint_as_float(w[j].x & 0xffff0000u), __uint_as_float(w[j].y << 16), __uint_as_float(w[j].y & 0xffff0000u)};
            v[2 * j + 1] = (f32x4){__uint_as_float(w[j].z << 16), __uint_as_float(w[j].z & 0xffff0000u), __uint_as_float(w[j].w << 16), __uint_as_float(w[j].w & 0xffff0000u)}; }
#pragma unroll
        for (int j = 0; j < 8; ++j) s += (v[j].x * v[j].x + v[j].y * v[j].y) + (v[j].z * v[j].z + v[j].w * v[j].w);
        const float rstd = 1.0f / sqrtf(wave_sum(s) * (1.f / DM) + EPS);
        GAS f32x4* dr = (GAS f32x4*)(dst + (size_t)m * DM);
#pragma unroll
        for (int j = 0; j < 4; ++j) { const int c4 = (64 * j + F.lane) * 2;
            dr[c4] = v[2 * j] * rstd * gr[c4]; dr[c4 + 1] = v[2 * j + 1] * rstd * gr[c4 + 1]; }
    }
}

constexpr int NPH = 11;
#ifndef REPEAT_WHICH
#define REPEAT_WHICH 3
#endif
#ifndef NULL_EPI_PROBE
#define NULL_EPI_PROBE 0
#endif
#ifndef FOLD_KMEAN
#define FOLD_KMEAN 1
#endif
#ifndef REPEAT_PHASE
#define REPEAT_PHASE -1
#endif
#ifndef REPEAT_MASK
#define REPEAT_MASK 0
#endif
#define REPS(k) (((REPEAT_PHASE == (k)) || ((REPEAT_MASK >> (k)) & 1)) ? 2 : 1)
#ifndef USE_MFMA_SB
#define USE_MFMA_SB 1
#endif
#ifndef USE_MFMA_MOBA
#define USE_MFMA_MOBA 1
#endif
#ifndef USE_MFMA_X
#define USE_MFMA_X 1
#endif
#ifndef MK_ONE_LAUNCH
#define MK_ONE_LAUNCH 1
#endif
struct Args { const void* in[17]; float* out; unsigned char* ws; int ph_lo, ph_hi; };
__global__ void __launch_bounds__(NWAVES * 64, 2) mk_fwd(Args args) {
    extern __shared__ __attribute__((aligned(16))) unsigned char lds[];
    Frame F;
    F.lds = (LAS unsigned char*)lds;
    F.tid = threadIdx.x; F.lane = F.tid & 63; F.wave = __builtin_amdgcn_readfirstlane(F.tid >> 6);
    F.G = gridDim.x; { const int bx = blockIdx.x; F.vcu = (F.G % 8 == 0) ? (bx % 8) * (F.G / 8) + bx / 8 : bx; }
    F.x = (const float*)args.in[0]; F.mem = (const float*)args.in[1]; F.pos = (const int*)args.in[2];
    F.g_mix = (const float*)args.in[3]; F.w_in = (const float*)args.in[4]; F.g_out_sb = (const float*)args.in[5]; F.g_out_mb = (const float*)args.in[6]; F.w_out = (const float*)args.in[7];
    F.g_xattn = (const float*)args.in[8]; F.g_mem = (const float*)args.in[9]; F.w_xq = (const float*)args.in[10]; F.w_xkv = (const float*)args.in[11]; F.w_xo = (const float*)args.in[12];
    F.g_ffn = (const float*)args.in[13]; F.w_gu = (const float*)args.in[14]; F.w_dn = (const float*)args.in[15]; F.g_final = (const float*)args.in[16];
    F.out = args.out; F.ws = args.ws;
    unsigned char* ws = args.ws;
    const int lo = args.ph_lo, hi = args.ph_hi;
    for (int u = F.tid; u < (LDS_BYTES - LDSCTL_OFF) / 4; u += NWAVES * 64) ((LAS unsigned*)(F.lds + LDSCTL_OFF))[u] = 0u;
    __syncthreads();
    if (hi - lo > 1) {
        { GAS v4u* z = (GAS v4u*)(ws + WS_CTL); const int n16 = (int)(CTL_ZERO_BYTES / 16);
          for (int i = (int)blockIdx.x * (NWAVES * 64) + F.tid; i < n16; i += F.G * NWAVES * 64) z[i] = (v4u){0u, 0u, 0u, 0u}; }
        cg::this_grid().sync();
    }
    XcdBarrier bar = xcd_barrier_post((unsigned*)(ws + WS_CTL) + CW_BAR, (volatile LAS unsigned*)(F.lds + MISC_OFF) + 8);
#ifndef ONLY_PHASE
#define ONLY_PHASE -1
#endif
#define IN(k) ((ONLY_PHASE < 0 || ONLY_PHASE == (k)) && lo <= (k) && (k) < hi)
#define BOTH(k) (IN(k) && IN((k) + 1))
#define GRID_BAR() xcd_barrier(bar)
    float* ssq1 = (float*)(ws + WS_SSQ1); float* ssq2 = (float*)(ws + WS_SSQ2);
    pg8::bf16_t* RA = (pg8::bf16_t*)(ws + WS_RA); pg8::bf16_t* RB = (pg8::bf16_t*)(ws + WS_RB); pg8::bf16_t* RC = (pg8::bf16_t*)(ws + WS_RC);

    if (IN(0)) { for (int rep = 0; rep < REPS(0); ++rep) p0_prologue(F); if (BOTH(0)) GRID_BAR(); }
    if (IN(1)) {
        for (int rep = 0; rep < REPS(1); ++rep) {
        { pg8::Gemm g{RA, (const pg8::bf16_t*)(ws + WS_WIN), M, 4096, DM}; pg8::StaticOrder S; S.init(M, 4096, F.G, (int)blockIdx.x);
          pg8::EpiQKV E{RC, (const float*)(ws + WS_CS), QSCALE, (float*)(ws + WS_KSUM), 0, 1.f};
          pg8::gemm_phase<pg8::EpiQKV, pg8::StaticOrder, true, true>(F.lds, g, S, E); }
        { pg8::Gemm g{RB, (const pg8::bf16_t*)(ws + WS_WV8), M, 2048, DM / 2}; pg8::StaticOrder S; S.init(M, 2048, F.G, (int)blockIdx.x);
          pg8::EpiQKV E{RC, (const float*)(ws + WS_CS), QSCALE, (float*)(ws + WS_KSUM), 1, 1.f / (S_XN * S_WV)};
          pg8::gemm_phase<pg8::EpiQKV, pg8::StaticOrder, true, true, true>(F.lds, g, S, E); }
        }
        if (BOTH(1)) GRID_BAR();
    }
    if (IN(3)) {
        const att::bf16* qkv = (const att::bf16*)RC; att::bf16* ob = (att::bf16*)RA; const float* kmean = (const float*)(ws + WS_KSUM);
        constexpr size_t HSZ = (size_t)SEQ * HD;
        for (int rep = 0; rep < REPS(3); ++rep) {
        if (rep == 0 || (REPEAT_WHICH & 1))
        for (int vv = F.vcu; vv < 256; vv += F.G) { const int bh = vv >> 2, s = vv & 3, b = bh >> 3, h = bh & 7; const size_t rb = (size_t)b * SEQ; const att::bf16* hb = qkv + ((size_t)b * 48 + h) * HSZ;
            for (int i = 0; i < 2; ++i) { const int qb = i ? s : 7 - s; const size_t r0 = rb + (size_t)qb * 256;
                if (WOUT_FP8) att::attn_unit<2, true>(hb + (size_t)qb * 256 * HD, HD, hb + 8 * HSZ, hb + 16 * HSZ, HD, (att::bf16*)((unsigned char*)ob + r0 * DM + h * HD), DM, F.g_out_sb + h * HD, nullptr, qb, 0, (char*)lds, S_O);
                else att::attn_unit<2>(hb + (size_t)qb * 256 * HD, HD, hb + 8 * HSZ, hb + 16 * HSZ, HD, ob + r0 * DM + h * HD, DM, F.g_out_sb + h * HD, nullptr, qb, 0, (char*)lds); } }
        if (rep == 0 || (REPEAT_WHICH & 2))
        for (int vv = F.vcu; vv < 256; vv += F.G) { const int bh = vv >> 2, s = vv & 3, b = bh >> 3, h = bh & 7; const size_t rb = (size_t)b * SEQ; const att::bf16* hb = qkv + ((size_t)b * 48 + 24 + h) * HSZ;
            for (int i = 0; i < 2; ++i) { const int qb = i ? s : 7 - s; const size_t r0 = rb + (size_t)qb * 256;
                if (WOUT_FP8) att::attn_unit<1, true>(hb + (size_t)qb * 256 * HD, HD, hb + 8 * HSZ, hb + 16 * HSZ, HD, (att::bf16*)((unsigned char*)ob + r0 * DM + NH * HD + h * HD), DM, F.g_out_mb + h * HD, kmean + (size_t)bh * 1024, qb, 0, (char*)lds, S_O);
                else att::attn_unit<1>(hb + (size_t)qb * 256 * HD, HD, hb + 8 * HSZ, hb + 16 * HSZ, HD, ob + r0 * DM + NH * HD + h * HD, DM, F.g_out_mb + h * HD, kmean + (size_t)bh * 1024, qb, 0, (char*)lds); } }
        }
        if (BOTH(3)) GRID_BAR();
    }
    if (IN(4)) {
        pg8::Gemm g{RA, (const pg8::bf16_t*)(ws + WS_WOUT), M, DM, WOUT_FP8 ? DM / 2 : DM}; pg8::StaticOrder S; S.init(M, DM, F.G, (int)blockIdx.x);
        const float asc = WOUT_FP8 ? 1.f / (S_O * S_WO) : 1.f;
        if (REPS(4) == 2) { pg8::EpiResB<true> E0{F.x, RB, nullptr, nullptr, 1.f, asc}; pg8::gemm_phase<pg8::EpiResB<true>, pg8::StaticOrder, true, true, WOUT_FP8 != 0>(F.lds, g, S, E0); }
        pg8::EpiResB<true> E{F.x, RB, ssq1, nullptr, 1.f, asc};
        pg8::gemm_phase<pg8::EpiResB<true>, pg8::StaticOrder, true, true, WOUT_FP8 != 0>(F.lds, g, S, E);
        if (BOTH(4)) GRID_BAR();
    }
    if (IN(5)) {
      for (int rep = 0; rep < REPS(5); ++rep) {
        { pg8::Gemm g{RB, (const pg8::bf16_t*)(ws + WS_WXQ), M, WX, DM}; pg8::StaticOrder S; S.init(M, WX, F.G, (int)blockIdx.x);
          pg8::EpiScale E{(pg8::bf16_t*)(ws + WS_QX), WX, ssq1, QSCALE};
          pg8::gemm_phase<pg8::EpiScale, pg8::StaticOrder, true, true>(F.lds, g, S, E); }
        { pg8::Gemm g{(const pg8::bf16_t*)(ws + WS_MN), (const pg8::bf16_t*)(ws + WS_WXKV), MMEM, 2 * WX, DM}; pg8::StaticOrder S; S.init(MMEM, 2 * WX, F.G, (int)((blockIdx.x + F.G - 128) % F.G));
          pg8::EpiScale E{(pg8::bf16_t*)(ws + WS_KVX), 2 * WX, nullptr, 1.0f};
          pg8::gemm_phase<pg8::EpiScale, pg8::StaticOrder, true, true>(F.lds, g, S, E); }
        if (F.G > 160) { if ((int)blockIdx.x >= 160) ffn_weight_items(F, ((int)blockIdx.x - 160) * NWAVES + F.wave, (F.G - 160) * NWAVES); }
        else ffn_weight_items(F, (int)blockIdx.x * NWAVES + F.wave, F.G * NWAVES);
      }
        if (BOTH(5)) GRID_BAR();
    }
    if (IN(6)) {
        const att::bf16* qx = (const att::bf16*)(ws + WS_QX); const att::bf16* kvx = (const att::bf16*)(ws + WS_KVX); att::bf16* ox = (att::bf16*)(ws + WS_OX);
        for (int rep = 0; rep < REPS(6); ++rep) {
        for (int vv = F.vcu; vv < 256; vv += F.G) { const int b = vv >> 5, h = (vv >> 3) & 3, qb = vv & 7; const size_t r0 = (size_t)b * SEQ + (size_t)qb * 256;
            if (WXO_FP8) att::attn_unit<0, true>(qx + r0 * WX + h * HD, WX, kvx + (size_t)b * NMEM * (2 * WX) + h * HD, kvx + (size_t)b * NMEM * (2 * WX) + WX + h * HD, 2 * WX, (att::bf16*)((unsigned char*)ox + r0 * WX + h * HD), WX, nullptr, nullptr, qb, NMEM, (char*)lds, S_OX);
            else att::attn_unit<0>(qx + r0 * WX + h * HD, WX, kvx + (size_t)b * NMEM * (2 * WX) + h * HD, kvx + (size_t)b * NMEM * (2 * WX) + WX + h * HD, 2 * WX, ox + r0 * WX + h * HD, WX, nullptr, nullptr, qb, NMEM, (char*)lds); }
        }
        if (BOTH(6)) GRID_BAR();
    }
    if (IN(7)) {
        pg8::Gemm g{(const pg8::bf16_t*)(ws + WS_OX), (const pg8::bf16_t*)(ws + WS_WXO), M, DM, WXO_FP8 ? WX / 2 : WX}; pg8::StaticOrder S; S.init(M, DM, F.G, (int)blockIdx.x);
        const float asc7 = WXO_FP8 ? 1.f / (S_OX * S_WXO) : 1.f;
        if (REPS(7) == 2) { pg8::EpiResB<false> E0{RB, RC, nullptr, nullptr, 1.f, asc7}; pg8::gemm_phase<pg8::EpiResB<false>, pg8::StaticOrder, true, true, WXO_FP8 != 0>(F.lds, g, S, E0); }
        pg8::EpiResB<false> E{RB, RB, ssq2, (unsigned char*)RA, S_X2, asc7};
        pg8::gemm_phase<pg8::EpiResB<false>, pg8::StaticOrder, true, true, WXO_FP8 != 0>(F.lds, g, S, E);
        if (BOTH(7)) GRID_BAR();
    }
    if (IN(8)) {
        pg8::Gemm g{RA, (const pg8::bf16_t*)(ws + WS_WGU), M, 2 * FF, FFN_FP8 ? DM / 2 : DM}; pg8::StaticOrder S; S.init(M, 2 * FF, F.G, (int)blockIdx.x);
        pg8::EpiSwiGLU E{RC, ssq2, FFN_FP8 ? (unsigned char*)RC : nullptr, FFN_FP8 ? 1.f / (S_X2 * S_WGU) : 1.f, S_ACT};
#if NULL_EPI_PROBE
        if (REPS(8) == 2) { pg8::EpiNull EN{nullptr}; pg8::gemm_phase<pg8::EpiNull, pg8::StaticOrder, true, true, FFN_FP8 != 0>(F.lds, g, S, EN); }
        pg8::gemm_phase<pg8::EpiSwiGLU, pg8::StaticOrder, true, true, FFN_FP8 != 0>(F.lds, g, S, E);
#else
        for (int rep = 0; rep < REPS(8); ++rep) pg8::gemm_phase<pg8::EpiSwiGLU, pg8::StaticOrder, true, true, FFN_FP8 != 0>(F.lds, g, S, E);
#endif
        if (BOTH(8)) GRID_BAR();
    }
    if (IN(9)) {
        pg8::Gemm g{RC, (const pg8::bf16_t*)(ws + WS_WDN), M, DM, FF / 2}; pg8::StaticOrder S; S.init(M, DM, F.G, (int)blockIdx.x);
        if (REPS(9) == 2) { pg8::EpiResB<false> E0{RB, (pg8::bf16_t*)(ws + WS_RC + 96 * MiB), nullptr, nullptr, 1.f, 1.f / (S_ACT * S_WDN)}; pg8::gemm_phase<pg8::EpiResB<false>, pg8::StaticOrder, true, true, true>(F.lds, g, S, E0); }
        pg8::EpiResB<false> E{RB, RB, nullptr, nullptr, 1.f, 1.f / (S_ACT * S_WDN)};
        pg8::gemm_phase<pg8::EpiResB<false>, pg8::StaticOrder, true, true, true>(F.lds, g, S, E);
        if (BOTH(9)) GRID_BAR();
    }
    if (IN(10)) { if (REPS(10) == 2) final_norm_phase(F, RB, (float*)RC); final_norm_phase(F, RB, F.out); }
#undef IN
#undef BOTH
}

extern "C" void kernel_launch(void* const* d_in, const int* in_sizes, int n_in, void* d_out, int out_size, void* d_ws, size_t ws_size, hipStream_t stream) {
    static int grid = 0;
    if (grid == 0) {
        if (n_in != 17 || in_sizes[0] != M * DM || out_size != M * DM || ws_size < WS_END) { fprintf(stderr, "kernel_launch: unexpected shapes (n_in %d in0 %d out %d ws %zu)\n", n_in, n_in > 0 ? in_sizes[0] : -1, out_size, ws_size); grid = -1; return; }
        int dev = 0, cus = 0, per_cu = 0;
        if (hipGetDevice(&dev) != hipSuccess || hipDeviceGetAttribute(&cus, hipDeviceAttributeMultiprocessorCount, dev) != hipSuccess) { grid = -1; return; }
        if (hipFuncSetAttribute((const void*)mk_fwd, hipFuncAttributeMaxDynamicSharedMemorySize, LDS_BYTES) != hipSuccess) { fprintf(stderr, "kernel_launch: hipFuncSetAttribute failed\n"); grid = -1; return; }
        if (hipOccupancyMaxActiveBlocksPerMultiprocessor(&per_cu, (const void*)mk_fwd, NWAVES * 64, LDS_BYTES) != hipSuccess || per_cu < 1) { fprintf(stderr, "kernel_launch: occupancy query failed (%d)\n", per_cu); per_cu = 1; }
        (void)hipGetLastError();
        grid = cus * (per_cu < 1 ? 1 : 1);
    }
    if (grid < 0) return;
#if !MK_ONE_LAUNCH
    (void)hipMemsetAsync((char*)d_ws + WS_CTL, 0, CTL_ZERO_BYTES, stream);
#endif
    Args a{};
    for (int i = 0; i < 17; ++i) a.in[i] = d_in[i];
    a.out = (float*)d_out; a.ws = (unsigned char*)d_ws;
#if MK_ONE_LAUNCH
    a.ph_lo = 0; a.ph_hi = NPH;
    void* kargs[] = {&a};
    hipError_t e = hipLaunchCooperativeKernel((const void*)mk_fwd, dim3(grid), dim3(NWAVES * 64), kargs, LDS_BYTES, stream);
    if (e != hipSuccess) fprintf(stderr, "kernel_launch: cooperative launch failed: %s (grid %d)\n", hipGetErrorString(e), grid);
#else
    for (int p = 0; p < NPH; ++p) { a.ph_lo = p; a.ph_hi = p + 1; hipLaunchKernelGGL(mk_fwd, dim3(grid), dim3(NWAVES * 64), LDS_BYTES, stream, a); }
    const hipError_t le = hipPeekAtLastError();
    if (le != hipSuccess) fprintf(stderr, "kernel_launch: launch failed: %s\n", hipGetErrorName(le));
#endif
}
```

```cpp
#include <hip/hip_runtime.h>
#include <hip/hip_cooperative_groups.h>
#include <cstdio>
#include <cstdint>
namespace cg = cooperative_groups;
namespace pg8 {
#define PG8_LAS __attribute__((address_space(3)))
typedef unsigned short bf16_t;
typedef short bf16x8 __attribute__((ext_vector_type(8)));
typedef float f32x4 __attribute__((ext_vector_type(4)));
typedef unsigned u32x4 __attribute__((ext_vector_type(4)));
constexpr int BM = 256, BK = 64, HALF = 128, HTB = HALF * BK * 2  , STAGE_BYTES = 8 * HTB, NXCD = 8, WGM = 8;

__host__ __device__ __forceinline__ int lds_byte(int r, int c) { const int st = (r >> 4) * 2 + (c >> 5), rr = r & 15, cc = c & 31, ob = rr * 64 + cc * 2; return st * 1024 + (ob ^ (((ob >> 9) & 1) << 5)); }
__host__ __device__ __forceinline__ void stage_rc(int b, int& R, int& C) { const int st = b / 1024, sb = b % 1024, swz = sb ^ (((sb >> 9) & 1) << 5); R = (st >> 1) * 16 + swz / 64; C = (st & 1) * 32 + (swz % 64) / 2; }
__host__ __device__ __forceinline__ int perm32(int rho) { const int n = rho >> 4, i = rho & 15; return 8 * (i >> 2) + 4 * n + (i & 3); }

struct Unit { int pm, pn; };
struct Gemm { const bf16_t* A; const bf16_t* Bt; int M, N, K; };

struct StaticOrder {
    int nM, nN, nwg, G, c;
    __host__ __device__ void init(int M, int N, int G_, int c_) { nM = M / BM; nN = N / BM; nwg = nM * nN; G = G_; c = c_; }
    __host__ __device__ bool next(int i, Unit& u) const {
        const long L = (long)i * G + c; if (L >= nwg) return false;
        int wgid = (int)L; { const int q = nwg / NXCD, r = nwg % NXCD, xcd = wgid % NXCD, off = wgid / NXCD; wgid = (xcd < r ? xcd * (q + 1) : r * (q + 1) + (xcd - r) * q) + off; }
        const int nig = WGM * nN, gid = wgid / nig, fm = gid * WGM, gsz = (nM - fm) < WGM ? (nM - fm) : WGM;
        u.pm = fm + ((wgid % nig) % gsz); u.pn = (wgid % nig) / gsz; return true;
    }
    __device__ __forceinline__ void a_ready(const Unit&) const {}
    __device__ __forceinline__ void done(const Unit&) const {}
};

__device__ __forceinline__ unsigned cvt_pk_bf16(float lo, float hi) { unsigned r; asm volatile("v_cvt_pk_bf16_f32 %0, %1, %2" : "=v"(r) : "v"(lo), "v"(hi)); return r; }
typedef float f32x2 __attribute__((ext_vector_type(2)));
template <class Epi, class Sched, bool ALIGN_EPI = false, bool SP2 = false, bool FP8 = false>
__device__ __forceinline__ void gemm_phase(PG8_LAS unsigned char* lds, const Gemm g, const Sched& S, const Epi& E) {
    int tid_ = threadIdx.x; asm volatile("" : "+v"(tid_));
    const int tid = tid_, wid = __builtin_amdgcn_readfirstlane(tid >> 6), lane = tid & 63, wr = wid >> 2, wc = wid & 3, fr = lane & 15, fq = lane >> 4;
    const int K = g.K, nt = K / BK;
    unsigned voffA[2], voffB[2];
#pragma unroll
    for (int i = 0; i < 2; ++i) { int R, C; stage_rc(tid * 16 + i * 8192, R, C); const int Rb = Epi::PERM ? ((R & ~31) + perm32(R & 31)) : R;
        voffA[i] = (unsigned)(R * K + C) * 2u; voffB[i] = (unsigned)(Rb * K + C) * 2u; }
    const size_t kstep = (size_t)(BK * 2);
    const size_t hstep = (size_t)HALF * K * 2;
    const size_t tstep = 2 * hstep;
    const unsigned ldsw = (unsigned)wid * 1024u;
    const int aoff = lds_byte(wr * 64 + fr, fq * 8), boff = lds_byte(wc * 32 + fr, fq * 8);
#define PG8_SA(b, h) (((b) * 2 + (h)) * HTB)
#define PG8_SB(b, h) ((4 + (b) * 2 + (h)) * HTB)
#define PG8_STAGE(bufoff, gbase, voff) do { _Pragma("unroll") for (int _i = 0; _i < 2; ++_i) \
        __builtin_amdgcn_global_load_lds((const unsigned*)((const char*)(gbase) + (voff)[_i]), (PG8_LAS unsigned*)(lds + (bufoff) + ldsw + _i * 8192), 16, 0, 0); } while (0)
#define PG8_LD8(p) __builtin_shufflevector(*(const PG8_LAS i32x4_*)(p), *(const PG8_LAS i32x4_*)((p) + 1024), 0, 1, 2, 3, 4, 5, 6, 7)
#define PG8_LDA(dst, b, h) do { if constexpr (FP8) { _Pragma("unroll") for (int m = 0; m < 4; ++m) dst##8[m] = PG8_LD8(lds + PG8_SA(b, h) + aoff + m * 2048); } \
        else { _Pragma("unroll") for (int m = 0; m < 4; ++m) _Pragma("unroll") for (int k = 0; k < 2; ++k) dst[m][k] = *(const PG8_LAS bf16x8*)(lds + PG8_SA(b, h) + aoff + m * 2048 + k * 1024); } } while (0)
#define PG8_LDB(dst, b, h) do { if constexpr (FP8) { _Pragma("unroll") for (int n = 0; n < 2; ++n) dst##8[n] = PG8_LD8(lds + PG8_SB(b, h) + boff + n * 2048); } \
        else { _Pragma("unroll") for (int n = 0; n < 2; ++n) _Pragma("unroll") for (int k = 0; k < 2; ++k) dst[n][k] = *(const PG8_LAS bf16x8*)(lds + PG8_SB(b, h) + boff + n * 2048 + k * 1024); } } while (0)
#define PG8_MMA(ai, bj, At, Bt) do { __builtin_amdgcn_s_setprio(1); _Pragma("unroll") for (int m = 0; m < 4; ++m) _Pragma("unroll") for (int n = 0; n < 2; ++n) { \
        if constexpr (FP8) asm volatile("v_mfma_scale_f32_16x16x128_f8f6f4 %0, %1, %2, %0, %3, %3 op_sel_hi:[0,0,0]" : "+v"(acc[ai][bj][m][n]) : "v"(Bt##8[n]), "v"(At##8[m]), "v"(sc1_)); \
        else { _Pragma("unroll") for (int k = 0; k < 2; ++k) acc[ai][bj][m][n] = __builtin_amdgcn_mfma_f32_16x16x32_bf16(Bt[n][k], At[m][k], acc[ai][bj][m][n], 0, 0, 0); } } \
        __builtin_amdgcn_s_setprio(0); } while (0)
#define PG8_WAIT_V(n) asm volatile("s_waitcnt vmcnt(" #n ")" ::: "memory")
#define PG8_WAIT_L(n) asm volatile("s_waitcnt lgkmcnt(" #n ")" ::: "memory")
#define PG8_BAR __builtin_amdgcn_s_barrier()
#define PG8_SCHED __builtin_amdgcn_sched_barrier(0)
    Unit cur, nxt; int ui = 0;
    if (!S.next(0, cur)) return;
    f32x4 acc[2][2][4][2];
#pragma unroll
    for (int a = 0; a < 2; ++a)
#pragma unroll
        for (int b = 0; b < 2; ++b)
#pragma unroll
            for (int m = 0; m < 4; ++m)
#pragma unroll
                for (int n = 0; n < 2; ++n) acc[a][b][m][n] = (f32x4){0.f, 0.f, 0.f, 0.f};
    typedef int i32x4_ __attribute__((ext_vector_type(4))); typedef int i32x8_ __attribute__((ext_vector_type(8)));
    int sc1_ = 0x7F7F7F7F; asm volatile("" : "+v"(sc1_));
    bf16x8 At[4][2], B0[2][2], B1[2][2]; i32x8_ At8[4], B08[2], B18[2];
    const char* cA = (const char*)g.A + (size_t)cur.pm * tstep; const char* cB = (const char*)g.Bt + (size_t)cur.pn * tstep;
    S.a_ready(cur);
    if constexpr (SP2) {
        PG8_STAGE(PG8_SB(0, 0), cB, voffB); PG8_STAGE(PG8_SB(0, 1), cB + hstep, voffB); PG8_STAGE(PG8_SA(0, 0), cA, voffA); PG8_STAGE(PG8_SA(0, 1), cA + hstep, voffA);
        if (wr == 1) PG8_BAR;
        PG8_WAIT_V(2); PG8_BAR;
        PG8_STAGE(PG8_SB(1, 0), cB + kstep, voffB); PG8_STAGE(PG8_SA(1, 0), cA + kstep, voffA); PG8_STAGE(PG8_SB(1, 1), cB + hstep + kstep, voffB);
        PG8_WAIT_V(6); PG8_BAR;
    } else {
        PG8_STAGE(PG8_SB(0, 0), cB, voffB); PG8_STAGE(PG8_SA(0, 0), cA, voffA); PG8_STAGE(PG8_SB(0, 1), cB + hstep, voffB); PG8_STAGE(PG8_SA(0, 1), cA + hstep, voffA);
        if (wr == 1) PG8_BAR;
        PG8_WAIT_V(4); PG8_BAR;
        PG8_STAGE(PG8_SB(1, 0), cB + kstep, voffB); PG8_STAGE(PG8_SA(1, 0), cA + kstep, voffA); PG8_STAGE(PG8_SB(1, 1), cB + hstep + kstep, voffB);
        PG8_WAIT_V(6); PG8_BAR;
    }
    for (;;) {
        const bool has_next = S.next(ui + 1, nxt);
        const char* nA = has_next ? (const char*)g.A + (size_t)nxt.pm * tstep : cA; const char* nB = has_next ? (const char*)g.Bt + (size_t)nxt.pn * tstep : cB;
        for (int t = 0; t < nt; t += 2) {
            const bool last = (t == nt - 2);
            const char* a1 = cA + (size_t)(t + 1) * kstep;
            const char* a2 = last ? nA : cA + (size_t)(t + 2) * kstep; const char* b2 = last ? nB : cB + (size_t)(t + 2) * kstep;
            const char* a3 = a2 + kstep; const char* b3 = b2 + kstep;
            if (last && has_next) S.a_ready(nxt);
            if constexpr (SP2) {
            PG8_LDB(B0, 0, 0); PG8_LDB(B1, 0, 1); PG8_SCHED; PG8_LDA(At, 0, 0); PG8_STAGE(PG8_SA(1, 1), a1 + hstep, voffA);
            PG8_WAIT_V(8); PG8_WAIT_L(0); PG8_BAR; PG8_MMA(0, 0, At, B0); PG8_MMA(0, 1, At, B1); PG8_BAR; PG8_SCHED;
            PG8_LDA(At, 0, 1); PG8_STAGE(PG8_SB(0, 0), b2, voffB); PG8_STAGE(PG8_SB(0, 1), b2 + hstep, voffB); PG8_STAGE(PG8_SA(0, 0), a2, voffA);
            PG8_WAIT_V(8); PG8_WAIT_L(0); PG8_BAR; PG8_MMA(1, 0, At, B0); PG8_MMA(1, 1, At, B1); PG8_BAR; PG8_SCHED;
            PG8_LDB(B0, 1, 0); PG8_LDB(B1, 1, 1); PG8_SCHED; PG8_LDA(At, 1, 0); PG8_STAGE(PG8_SA(0, 1), a2 + hstep, voffA);
            PG8_WAIT_V(8); PG8_WAIT_L(0); PG8_BAR; PG8_MMA(0, 0, At, B0); PG8_MMA(0, 1, At, B1); PG8_BAR; PG8_SCHED;
            PG8_LDA(At, 1, 1); PG8_STAGE(PG8_SB(1, 0), b3, voffB); PG8_STAGE(PG8_SB(1, 1), b3 + hstep, voffB); PG8_STAGE(PG8_SA(1, 0), a3, voffA);
            PG8_WAIT_V(8); PG8_WAIT_L(0); PG8_BAR; PG8_MMA(1, 0, At, B0); PG8_MMA(1, 1, At, B1); PG8_BAR; PG8_SCHED;
            } else {
            PG8_LDB(B0, 0, 0); PG8_SCHED; PG8_LDA(At, 0, 0); PG8_STAGE(PG8_SA(1, 1), a1 + hstep, voffA);
            PG8_WAIT_L(8); PG8_BAR; PG8_WAIT_L(0); PG8_MMA(0, 0, At, B0); PG8_BAR; PG8_SCHED;
            PG8_LDB(B1, 0, 1); PG8_STAGE(PG8_SB(0, 0), b2, voffB);
            PG8_BAR; PG8_WAIT_L(0); PG8_MMA(0, 1, At, B1); PG8_BAR;
            PG8_LDA(At, 0, 1); PG8_STAGE(PG8_SA(0, 0), a2, voffA);
            PG8_BAR; PG8_WAIT_L(0); PG8_MMA(1, 0, At, B0); PG8_BAR; PG8_SCHED;
            PG8_STAGE(PG8_SB(0, 1), b2 + hstep, voffB);
            PG8_WAIT_V(6); PG8_BAR; PG8_MMA(1, 1, At, B1); PG8_BAR;
            PG8_LDB(B0, 1, 0); PG8_SCHED; PG8_LDA(At, 1, 0); PG8_STAGE(PG8_SA(0, 1), a2 + hstep, voffA);
            PG8_WAIT_L(8); PG8_BAR; PG8_WAIT_L(0); PG8_MMA(0, 0, At, B0); PG8_BAR; PG8_SCHED;
            PG8_LDB(B1, 1, 1); PG8_STAGE(PG8_SB(1, 0), b3, voffB);
            PG8_BAR; PG8_WAIT_L(0); PG8_MMA(0, 1, At, B1); PG8_BAR;
            PG8_LDA(At, 1, 1); PG8_STAGE(PG8_SA(1, 0), a3, voffA);
            PG8_BAR; PG8_WAIT_L(0); PG8_MMA(1, 0, At, B0); PG8_BAR; PG8_SCHED;
            PG8_STAGE(PG8_SB(1, 1), b3 + hstep, voffB);
            PG8_WAIT_V(6); PG8_BAR; PG8_MMA(1, 1, At, B1); PG8_BAR;
            }
        }
        if constexpr (ALIGN_EPI) { if (wr == 0) PG8_BAR; }
        if constexpr (FP8) asm volatile("s_nop 15\n\ts_nop 15" ::: "memory");
        if constexpr (!Epi::AFTER_DRAIN) { E(acc, cur, wr, wc, fr, fq); S.done(cur); }
        if (!has_next) break;
#pragma unroll
        for (int a = 0; a < 2; ++a)
#pragma unroll
            for (int b = 0; b < 2; ++b)
#pragma unroll
                for (int m = 0; m < 4; ++m)
#pragma unroll
                    for (int n = 0; n < 2; ++n) acc[a][b][m][n] = (f32x4){0.f, 0.f, 0.f, 0.f};
        cur = nxt; cA = nA; cB = nB; ++ui;
        if constexpr (ALIGN_EPI) { if (wr == 1) PG8_BAR; }
    }
    PG8_WAIT_V(0);
    if constexpr (!ALIGN_EPI) { if (wr == 0) PG8_BAR; }
    PG8_BAR;
    if constexpr (Epi::AFTER_DRAIN) { E.fused(acc, cur, wr, wc, fr, fq, lds, wid, lane); S.done(cur); }
#undef PG8_SA
#undef PG8_SB
#undef PG8_STAGE
#undef PG8_LDA
#undef PG8_LD8
#undef PG8_LDB
#undef PG8_MMA
#undef PG8_WAIT_V
#undef PG8_WAIT_L
#undef PG8_BAR
#undef PG8_SCHED
}
}
namespace pg8 {
typedef unsigned u32x2 __attribute__((ext_vector_type(2)));
constexpr int LDX = 2048;
constexpr float RMS_EPS = 1e-6f;
#ifndef EPI_SC1
#define EPI_SC1 1
#endif
__device__ __forceinline__ void store16(void* p, u32x4 w) {
#if EPI_SC1
    asm volatile("global_store_dwordx4 %0, %1, off sc1\n\ts_nop 1" :: "v"(p), "v"(w) : "memory");
#else
    *(u32x4*)p = w;
#endif
}
struct EpiQKV {
    static constexpr bool PERM = true, AFTER_DRAIN = false;
    bf16_t* O; const float* cs; float qscale; float* ksum; int vmode; float vscale; const float* rinv;
    __device__ __forceinline__ void operator()(const f32x4 (&acc)[2][2][4][2], const Unit& u, int wr, int wc, int fr, int fq) const {
        const int row0 = u.pm * BM + wr * 64 + fr, pn = vmode ? (u.pn < 4 ? u.pn + 8 : u.pn + 16) : (u.pn < 8 ? u.pn : u.pn + 4);
        const float sc = (pn < 4 || (pn >= 12 && pn < 16)) ? qscale : vscale;
        const bool rot = (pn >= 12 && pn < 20) && (wc == 0);
        bf16_t* Ot = O + ((size_t)((u.pm >> 3) * 6 + (pn >> 2)) * 8 + (pn & 3) * 2) * (2048 * 128) + wc * 32 + 8 * fq;
        const bool kacc = (pn >= 16 && pn < 20);
        float rf[2][4];
#pragma unroll
        for (int ai = 0; ai < 2; ++ai)
#pragma unroll
            for (int m = 0; m < 4; ++m) rf[ai][m] = rinv[row0 + ai * HALF + m * 16];
        f32x4 ks[2][2] = {{{0.f, 0.f, 0.f, 0.f}, {0.f, 0.f, 0.f, 0.f}}, {{0.f, 0.f, 0.f, 0.f}, {0.f, 0.f, 0.f, 0.f}}};
#pragma unroll
        for (int ai = 0; ai < 2; ++ai)
#pragma unroll
            for (int m = 0; m < 4; ++m) { const int row = row0 + ai * HALF + m * 16; bf16_t* rowp = Ot + (size_t)(row & 2047) * 128;
                f32x4 c0 = {1.f, 1.f, 1.f, 1.f}, c1 = c0, s0 = {0.f, 0.f, 0.f, 0.f}, s1 = s0;
                if (rot) { const float* cr = cs + (size_t)row * 32 + 8 * (fq & 1); c0 = *(const f32x4*)cr; c1 = *(const f32x4*)(cr + 4); s0 = *(const f32x4*)(cr + 16); s1 = *(const f32x4*)(cr + 20);
                    if (fq < 2) { s0 = -s0; s1 = -s1; } }
#pragma unroll
                for (int bj = 0; bj < 2; ++bj) { f32x4 v0 = acc[ai][bj][m][0] * rf[ai][m], v1 = acc[ai][bj][m][1] * rf[ai][m];
                    if (rot) { f32x4 p0, p1;
#pragma unroll
                        for (int j = 0; j < 4; ++j) { p0[j] = __shfl_xor(v0[j], 32); p1[j] = __shfl_xor(v1[j], 32); }
                        v0 = v0 * c0 + p0 * s0; v1 = v1 * c1 + p1 * s1; }
                    if (kacc) { ks[bj][0] += v0; ks[bj][1] += v1; }
                    v0 = v0 * sc; v1 = v1 * sc; u32x4 w; w.x = cvt_pk_bf16(v0[0], v0[1]); w.y = cvt_pk_bf16(v0[2], v0[3]); w.z = cvt_pk_bf16(v1[0], v1[1]); w.w = cvt_pk_bf16(v1[2], v1[3]);
                    store16(rowp + (size_t)bj * (2048 * 128), w); } }
        if (kacc) {
            float* kp = ksum + (size_t)(((u.pm >> 3) * 8 + (pn - 16) * 2) * 8 + (u.pm & 7)) * 128 + wc * 32 + 8 * fq;
#pragma unroll
            for (int bj = 0; bj < 2; ++bj)
#pragma unroll
                for (int n = 0; n < 2; ++n)
#pragma unroll
                    for (int j = 0; j < 4; ++j) { float s = ks[bj][n][j]; s += __shfl_xor(s, 1); s += __shfl_xor(s, 2); s += __shfl_xor(s, 4); s += __shfl_xor(s, 8);
                        if (fr == 0) atomicAdd(kp + bj * 1024 + n * 4 + j, s); }
        }
    }
};
__device__ __forceinline__ unsigned pk4_fp8(float a, float b, float c, float d) {
    a = __builtin_amdgcn_fmed3f(a, -448.f, 448.f); b = __builtin_amdgcn_fmed3f(b, -448.f, 448.f); c = __builtin_amdgcn_fmed3f(c, -448.f, 448.f); d = __builtin_amdgcn_fmed3f(d, -448.f, 448.f);
    int p = __builtin_amdgcn_cvt_pk_fp8_f32(a, b, 0, false); p = __builtin_amdgcn_cvt_pk_fp8_f32(c, d, p, true); return (unsigned)p; }
struct EpiRes {
    static constexpr bool PERM = false, AFTER_DRAIN = false;
    const float* base; float* out; bf16_t* xb; float* ssq; unsigned char* x8; float s8; float ascale;
    __device__ __forceinline__ void operator()(const f32x4 (&acc)[2][2][4][2], const Unit& u, int wr, int wc, int fr, int fq) const {
        const int row0 = u.pm * BM + wr * 64 + fr, col0 = u.pn * BM + wc * 32 + 4 * fq;
#pragma unroll
        for (int ai = 0; ai < 2; ++ai)
#pragma unroll
            for (int m = 0; m < 4; ++m) { const int row = row0 + ai * HALF + m * 16; const size_t off = (size_t)row * LDX + col0; float s = 0.f;
#pragma unroll
                for (int bj = 0; bj < 2; ++bj)
#pragma unroll
                    for (int n = 0; n < 2; ++n) { const f32x4 v = *(const f32x4*)(base + off + bj * HALF + n * 16) + acc[ai][bj][m][n] * ascale;
                        *(f32x4*)(out + off + bj * HALF + n * 16) = v; s += (v[0] * v[0] + v[1] * v[1]) + (v[2] * v[2] + v[3] * v[3]);
                        if (xb) { u32x2 w; w.x = cvt_pk_bf16(v[0], v[1]); w.y = cvt_pk_bf16(v[2], v[3]); *(u32x2*)(xb + off + bj * HALF + n * 16) = w; }
                        if (x8) { *(unsigned*)(x8 + off + bj * HALF + n * 16) = pk4_fp8(v[0] * s8, v[1] * s8, v[2] * s8, v[3] * s8); } }
                if (ssq) { s += __shfl_xor(s, 16); s += __shfl_xor(s, 32); if (fq == 0) atomicAdd(ssq + row, s); }
                asm volatile("" ::: "memory"); }
    }
};
template <bool BASE_F32> struct EpiResB {
    static constexpr bool PERM = true, AFTER_DRAIN = false;
    const void* base; bf16_t* xo; float* ssq; unsigned char* x8; float s8; float ascale;
    __device__ __forceinline__ void operator()(const f32x4 (&acc)[2][2][4][2], const Unit& u, int wr, int wc, int fr, int fq) const {
        const int row0 = u.pm * BM + wr * 64 + fr, col0 = u.pn * BM + wc * 32 + 8 * fq;
#pragma unroll
        for (int ai = 0; ai < 2; ++ai)
#pragma unroll
            for (int m = 0; m < 4; ++m) { const int row = row0 + ai * HALF + m * 16; const size_t off = (size_t)row * LDX + col0; float s = 0.f;
#pragma unroll
                for (int bj = 0; bj < 2; ++bj) { f32x4 b0, b1;
                    if (BASE_F32) { const float* bp = (const float*)base + off + bj * HALF; b0 = *(const f32x4*)bp; b1 = *(const f32x4*)(bp + 4); }
                    else { const u32x4 w = *(const u32x4*)((const bf16_t*)base + off + bj * HALF);
                        b0 = (f32x4){__uint_as_float(w.x << 16), __uint_as_float(w.x & 0xffff0000u), __uint_as_float(w.y << 16), __uint_as_float(w.y & 0xffff0000u)};
                        b1 = (f32x4){__uint_as_float(w.z << 16), __uint_as_float(w.z & 0xffff0000u), __uint_as_float(w.w << 16), __uint_as_float(w.w & 0xffff0000u)}; }
                    const f32x4 v0 = b0 + acc[ai][bj][m][0] * ascale, v1 = b1 + acc[ai][bj][m][1] * ascale;
                    s += ((v0[0] * v0[0] + v0[1] * v0[1]) + (v0[2] * v0[2] + v0[3] * v0[3])) + ((v1[0] * v1[0] + v1[1] * v1[1]) + (v1[2] * v1[2] + v1[3] * v1[3]));
                    if (xo) { u32x4 w; w.x = cvt_pk_bf16(v0[0], v0[1]); w.y = cvt_pk_bf16(v0[2], v0[3]); w.z = cvt_pk_bf16(v1[0], v1[1]); w.w = cvt_pk_bf16(v1[2], v1[3]); store16(xo + off + bj * HALF, w); }
                    if (x8) { u32x2 w8; w8.x = pk4_fp8(v0[0] * s8, v0[1] * s8, v0[2] * s8, v0[3] * s8); w8.y = pk4_fp8(v1[0] * s8, v1[1] * s8, v1[2] * s8, v1[3] * s8); *(u32x2*)(x8 + off + bj * HALF) = w8; } }
                if (ssq) { s += __shfl_xor(s, 16); s += __shfl_xor(s, 32); if (fq == 0) atomicAdd(ssq + row, s); }
                if (BASE_F32 ? (m & 1) : (m == 3)) asm volatile("" ::: "memory"); }
    }
};
struct EpiScale {
    static constexpr bool PERM = true, AFTER_DRAIN = false;
    bf16_t* O; int ldc; const float* ssq; float sc;
    __device__ __forceinline__ void operator()(const f32x4 (&acc)[2][2][4][2], const Unit& u, int wr, int wc, int fr, int fq) const {
        const int row0 = u.pm * BM + wr * 64 + fr, col0 = u.pn * BM + wc * 32 + 8 * fq;
        float sv[2][4];
#pragma unroll
        for (int ai = 0; ai < 2; ++ai)
#pragma unroll
            for (int m = 0; m < 4; ++m) sv[ai][m] = ssq ? ssq[row0 + ai * HALF + m * 16] : 0.f;
#pragma unroll
        for (int ai = 0; ai < 2; ++ai)
#pragma unroll
            for (int m = 0; m < 4; ++m) { const int row = row0 + ai * HALF + m * 16; bf16_t* rowp = O + (size_t)row * ldc + col0;
                const float f = ssq ? sc * __builtin_amdgcn_rsqf(sv[ai][m] * (1.0f / 2048.0f) + RMS_EPS) : sc;
#pragma unroll
                for (int bj = 0; bj < 2; ++bj) { const f32x4 v0 = acc[ai][bj][m][0] * f, v1 = acc[ai][bj][m][1] * f;
                    u32x4 w; w.x = cvt_pk_bf16(v0[0], v0[1]); w.y = cvt_pk_bf16(v0[2], v0[3]); w.z = cvt_pk_bf16(v1[0], v1[1]); w.w = cvt_pk_bf16(v1[2], v1[3]);
                    *(u32x4*)(rowp + bj * HALF) = w; } }
    }
};
struct EpiNull { static constexpr bool PERM = true, AFTER_DRAIN = false; float* sink;
    __device__ __forceinline__ void operator()(const f32x4 (&acc)[2][2][4][2], const Unit& u, int wr, int wc, int fr, int fq) const {
#pragma unroll
        for (int ai = 0; ai < 2; ++ai)
#pragma unroll
            for (int bj = 0; bj < 2; ++bj)
#pragma unroll
                for (int m = 0; m < 4; ++m)
#pragma unroll
                    for (int n = 0; n < 2; ++n) asm volatile("" :: "v"(acc[ai][bj][m][n])); } };
struct EpiSwiGLU {
    static constexpr bool PERM = true, AFTER_DRAIN = false;
    bf16_t* O; const float* ssq; unsigned char* O8; float ascale, oscale;
    __device__ __forceinline__ void operator()(const f32x4 (&acc)[2][2][4][2], const Unit& u, int wr, int wc, int fr, int fq) const {
        const int row0 = u.pm * BM + wr * 64 + fr, col0 = u.pn * HALF + wc * 32 + 8 * fq;
        float sv[2][4];
#pragma unroll
        for (int ai = 0; ai < 2; ++ai)
#pragma unroll
            for (int m = 0; m < 4; ++m) sv[ai][m] = ssq[row0 + ai * HALF + m * 16];
#pragma unroll
        for (int ai = 0; ai < 2; ++ai)
#pragma unroll
            for (int m = 0; m < 4; ++m) { const int row = row0 + ai * HALF + m * 16; bf16_t* rowp = O + (size_t)row * 5632 + col0;
                const float f = ascale * __builtin_amdgcn_rsqf(sv[ai][m] * (1.0f / 2048.0f) + RMS_EPS);
                const float fneg = -1.4426950408889634f * f, f2o = f * f * (O8 ? oscale : 1.0f);
                float r[8];
#pragma unroll
                for (int n = 0; n < 2; ++n)
#pragma unroll
                    for (int j = 0; j < 4; ++j) { const float ag = acc[ai][0][m][n][j], au = acc[ai][1][m][n][j];
                        r[n * 4 + j] = (ag * au) * (f2o * __builtin_amdgcn_rcpf(1.0f + __builtin_amdgcn_exp2f(fneg * ag))); }
                if (O8) { u32x2 w8; w8.x = pk4_fp8(r[0], r[1], r[2], r[3]); w8.y = pk4_fp8(r[4], r[5], r[6], r[7]);
                    *(u32x2*)(O8 + (size_t)row * 5632 + col0) = w8; }
                else { u32x4 w; w.x = cvt_pk_bf16(r[0], r[1]); w.y = cvt_pk_bf16(r[2], r[3]); w.z = cvt_pk_bf16(r[4], r[5]); w.w = cvt_pk_bf16(r[6], r[7]);
                *(u32x4*)rowp = w; } }
    }
};
}
namespace att {
using bf16x8 = __attribute__((ext_vector_type(8))) short;
using s16x4  = __attribute__((ext_vector_type(4))) short;
using f32x16 = __attribute__((ext_vector_type(16))) float;
using f32x4  = __attribute__((ext_vector_type(4))) float;
using u32x4  = __attribute__((ext_vector_type(4))) unsigned;
typedef unsigned short bf16;
constexpr int D = 128, KVBLK = 64;
constexpr int SHM_V = KVBLK * D * 2, SHM_K = KVBLK * D * 2;
constexpr int OFF_Q = 2 * SHM_V + 2 * SHM_K, OFF_WS = 131072 + 1024, OFF_KM = OFF_WS + 2048, ATT_LDS = OFF_KM + 4096;
constexpr float THR = 8.f;
constexpr float SB_DONE = 7.8886e-31f;
#ifndef QREG_SOFTMAX
#define QREG_SOFTMAX 1
#endif
#ifndef PIPE_SOFTMAX
#define PIPE_SOFTMAX 0
#endif
#define KSWZ(row, colB) ((row) * 256 + ((colB) ^ (((row) & 7) << 4)))
#define SBAR() __builtin_amdgcn_sched_barrier(0)
__device__ __forceinline__ int crow(int r, int hi) { return (r & 3) + 8 * (r >> 2) + 4 * hi; }
__device__ __forceinline__ unsigned cvtpk(float lo, float hi) { unsigned r; asm volatile("v_cvt_pk_bf16_f32 %0, %1, %2" : "=v"(r) : "v"(lo), "v"(hi)); return r; }
__device__ __forceinline__ float xchg32(float x, int hi) { auto rr = __builtin_amdgcn_permlane32_swap(__float_as_uint(x), __float_as_uint(x), false, false); return __uint_as_float(hi ? rr[0] : rr[1]); }
typedef __attribute__((address_space(3))) const char* lds_cp;
template <int D0> __device__ __forceinline__ void qkt_part(f32x16& p0, f32x16& p1, const lds_cp (&ka)[2][4], int boff, const lds_cp (&qa)[2][4]) {
  const bf16x8 qf = *reinterpret_cast<const __attribute__((address_space(3))) bf16x8*>(qa[D0 >> 2][D0 & 3]);
  const bf16x8 b0 = *reinterpret_cast<const __attribute__((address_space(3))) bf16x8*>(ka[D0 >> 2][D0 & 3] + boff);
  const bf16x8 b1 = *reinterpret_cast<const __attribute__((address_space(3))) bf16x8*>(ka[D0 >> 2][D0 & 3] + boff + 8192);
  p0 = __builtin_amdgcn_mfma_f32_32x32x16_bf16(b0, qf, p0, 0, 0, 0);
  p1 = __builtin_amdgcn_mfma_f32_32x32x16_bf16(b1, qf, p1, 0, 0, 0);
}
template <int D0> __device__ __forceinline__ void qkt_part(f32x16& p0, f32x16& p1, const lds_cp (&ka)[2][4], int boff, const bf16x8 (&qg)[8]) {
  const bf16x8 b0 = *reinterpret_cast<const __attribute__((address_space(3))) bf16x8*>(ka[D0 >> 2][D0 & 3] + boff);
  const bf16x8 b1 = *reinterpret_cast<const __attribute__((address_space(3))) bf16x8*>(ka[D0 >> 2][D0 & 3] + boff + 8192);
  p0 = __builtin_amdgcn_mfma_f32_32x32x16_bf16(b0, qg[D0], p0, 0, 0, 0);
  p1 = __builtin_amdgcn_mfma_f32_32x32x16_bf16(b1, qg[D0], p1, 0, 0, 0);
}
#define KLD(G, A0, A1) do { A0 = *reinterpret_cast<const __attribute__((address_space(3))) bf16x8*>(ka[(G) >> 2][(G) & 3] + boff); A1 = *reinterpret_cast<const __attribute__((address_space(3))) bf16x8*>(ka[(G) >> 2][(G) & 3] + boff + 8192); } while (0)
#define KMM(G, A0, A1) do { p0 = __builtin_amdgcn_mfma_f32_32x32x16_bf16(A0, qg[G], p0, 0, 0, 0); p1 = __builtin_amdgcn_mfma_f32_32x32x16_bf16(A1, qg[G], p1, 0, 0, 0); } while (0)
__device__ __forceinline__ void qkt(f32x16& p0, f32x16& p1, const lds_cp (&ka)[2][4], int boff, const bf16x8 (&qg)[8], float bias = 0.f) {
#pragma unroll
  for (int r = 0; r < 16; ++r) { p0[r] = bias; p1[r] = bias; }
  bf16x8 a0, a1, b0, b1, c0, c1, d0, d1;
  KLD(0, a0, a1); KLD(1, b0, b1); KLD(2, c0, c1); KLD(3, d0, d1); SBAR();
  KMM(0, a0, a1); SBAR(); KLD(4, a0, a1); SBAR();
  KMM(1, b0, b1); SBAR(); KLD(5, b0, b1); SBAR();
  KMM(2, c0, c1); SBAR(); KLD(6, c0, c1); SBAR();
  KMM(3, d0, d1); SBAR(); KLD(7, d0, d1); SBAR();
  KMM(4, a0, a1); KMM(5, b0, b1); KMM(6, c0, c1); KMM(7, d0, d1);
}
#undef KLD
#undef KMM
__device__ __forceinline__ void qkt(f32x16& p0, f32x16& p1, const lds_cp (&ka)[2][4], int boff, const lds_cp (&qr)[2][4], float bias = 0.f) {
#pragma unroll
  for (int r = 0; r < 16; ++r) { p0[r] = bias; p1[r] = bias; }
  qkt_part<0>(p0, p1, ka, boff, qr); qkt_part<1>(p0, p1, ka, boff, qr); qkt_part<2>(p0, p1, ka, boff, qr); qkt_part<3>(p0, p1, ka, boff, qr);
  qkt_part<4>(p0, p1, ka, boff, qr); qkt_part<5>(p0, p1, ka, boff, qr); qkt_part<6>(p0, p1, ka, boff, qr); qkt_part<7>(p0, p1, ka, boff, qr);
}
__device__ __forceinline__ int v_st(int k, int c) { const int kk = (k & ~0xC) | ((k & 4) << 1) | ((k & 8) >> 1); return ((kk >> 3) * 4 + (c >> 5)) * 512 + ((kk & 7) * 32 + (c & 31)) * 2; }
__device__ __forceinline__ int v_rd_base(int lane) { return ((lane & 3) << 3) | (((lane >> 2) & 3) << 6) | (((lane >> 4) & 1) << 5) | (((lane >> 5) & 1) << 8); }
constexpr int v_rd_off(int d0, int ks, int half) { return d0 * 512 + ks * 4096 + half * 2048; }
template <int OFF> __device__ __forceinline__ s16x4 tr_read(int vb) { s16x4 r; asm volatile("ds_read_b64_tr_b16 %0, %1 offset:%2" : "=&v"(r) : "v"(vb), "i"(OFF) : "memory"); return r; }
struct VFrag { s16x4 l0, h0, l1, h1, l2, h2, l3, h3; };
template <int D0> __device__ __forceinline__ void v_read(VFrag& f, int vb) {
  f.l0 = tr_read<v_rd_off(D0, 0, 0)>(vb); f.h0 = tr_read<v_rd_off(D0, 0, 1)>(vb); f.l1 = tr_read<v_rd_off(D0, 1, 0)>(vb); f.h1 = tr_read<v_rd_off(D0, 1, 1)>(vb);
  f.l2 = tr_read<v_rd_off(D0, 2, 0)>(vb); f.h2 = tr_read<v_rd_off(D0, 2, 1)>(vb); f.l3 = tr_read<v_rd_off(D0, 3, 0)>(vb); f.h3 = tr_read<v_rd_off(D0, 3, 1)>(vb);
}
__device__ __forceinline__ void pv_mma(f32x16& od, const VFrag& f, bf16x8 pa0, bf16x8 pa1, bf16x8 pa2, bf16x8 pa3) {
#define PK(L, H) (bf16x8){L[0], L[1], L[2], L[3], H[0], H[1], H[2], H[3]}
  od = __builtin_amdgcn_mfma_f32_32x32x16_bf16(pa0, PK(f.l0, f.h0), od, 0, 0, 0);
  od = __builtin_amdgcn_mfma_f32_32x32x16_bf16(pa1, PK(f.l1, f.h1), od, 0, 0, 0);
  od = __builtin_amdgcn_mfma_f32_32x32x16_bf16(pa2, PK(f.l2, f.h2), od, 0, 0, 0);
  od = __builtin_amdgcn_mfma_f32_32x32x16_bf16(pa3, PK(f.l3, f.h3), od, 0, 0, 0);
#undef PK
}
__device__ __forceinline__ void pv_d0(f32x16* o, int vb, bf16x8 pa0, bf16x8 pa1, bf16x8 pa2, bf16x8 pa3) {
  VFrag fa, fb;
  v_read<0>(fa, vb);
  v_read<1>(fb, vb); asm volatile("s_waitcnt lgkmcnt(8)" ::: "memory"); SBAR(); pv_mma(o[0], fa, pa0, pa1, pa2, pa3); SBAR();
  v_read<2>(fa, vb); asm volatile("s_waitcnt lgkmcnt(8)" ::: "memory"); SBAR(); pv_mma(o[1], fb, pa0, pa1, pa2, pa3); SBAR();
  v_read<3>(fb, vb); asm volatile("s_waitcnt lgkmcnt(8)" ::: "memory"); SBAR(); pv_mma(o[2], fa, pa0, pa1, pa2, pa3); SBAR();
  asm volatile("s_waitcnt lgkmcnt(0)" ::: "memory"); SBAR(); pv_mma(o[3], fb, pa0, pa1, pa2, pa3);
}
__device__ __forceinline__ void pack_p(const f32x16& p0, const f32x16& p1, bf16x8& pa0, bf16x8& pa1, bf16x8& pa2, bf16x8& pa3) {
#define PK4(P, BASE, OUT) do { unsigned a0 = cvtpk(P[BASE + 0], P[BASE + 1]), a1 = cvtpk(P[BASE + 2], P[BASE + 3]);   \
    unsigned b0 = cvtpk(P[BASE + 4], P[BASE + 5]), b1 = cvtpk(P[BASE + 6], P[BASE + 7]);                              \
    auto r0 = __builtin_amdgcn_permlane32_swap(a0, b0, false, false); auto r1 = __builtin_amdgcn_permlane32_swap(a1, b1, false, false); \
    u32x4 w = {r0[0], r1[0], r0[1], r1[1]}; OUT = *reinterpret_cast<bf16x8*>(&w); } while (0)
  PK4(p0, 0, pa0); PK4(p0, 8, pa1); PK4(p1, 0, pa2); PK4(p1, 8, pa3);
#undef PK4
}
__device__ __forceinline__ void softmax_tile(f32x16& p0, f32x16& p1, float& m_reg, float& l_reg, float& alpha) {
  float pmax = p0[0];
#pragma unroll
  for (int r = 1; r < 16; ++r) pmax = fmaxf(pmax, p0[r]);
#pragma unroll
  for (int r = 0; r < 16; ++r) pmax = fmaxf(pmax, p1[r]);
  pmax = fmaxf(pmax, xchg32(pmax, (int)(threadIdx.x >> 5) & 1));
  if (__all(pmax - m_reg <= THR)) { alpha = 1.f; }
  else { const float mn = fmaxf(m_reg, pmax); alpha = __builtin_amdgcn_exp2f(m_reg - mn); m_reg = mn; }
  float ps = 0.f;
#pragma unroll
  for (int r = 0; r < 16; ++r) { p0[r] = __builtin_amdgcn_exp2f(p0[r] - m_reg); ps += p0[r]; }
#pragma unroll
  for (int r = 0; r < 16; ++r) { p1[r] = __builtin_amdgcn_exp2f(p1[r] - m_reg); ps += p1[r]; }
  ps += xchg32(ps, (int)(threadIdx.x >> 5) & 1);
  l_reg = l_reg * alpha + ps;
}
template <bool BAND, int I> __device__ __forceinline__ float sb_group(f32x16& P, int kb, int qrel, int hi) {
  float run = 1.f;
#pragma unroll
  for (int e = 3; e >= 0; --e) { const int r = 4 * I + e; float rr = __builtin_amdgcn_rcpf(1.0f + __builtin_amdgcn_exp2f(P[r]));
    if (BAND) rr = (kb + crow(r, hi) < qrel) ? rr : 1.f;
    P[r] = (1.0f - rr) * run; run *= rr; }
  return run;
}
__device__ __forceinline__ void sb_combine(f32x16& p0, f32x16& p1, float (&gs)[8], float& carry, int hi) {
  float acc = 1.f;
#pragma unroll
  for (int i = 7; i >= 0; --i) { const float so_i = acc; acc *= gs[i]; const float x = hi ? acc : so_i; gs[i] = carry * so_i * xchg32(x, hi); }
  carry *= acc * xchg32(acc, hi);
#pragma unroll
  for (int i = 0; i < 4; ++i)
#pragma unroll
    for (int e = 0; e < 4; ++e) { p0[4 * i + e] *= gs[i]; p1[4 * i + e] *= gs[4 + i]; }
}
template <bool BAND>
__device__ __forceinline__ void sb_tile(f32x16& p0, f32x16& p1, float& carry, int kb, int qrel, int hi) {
  float gs[8];
  gs[0] = sb_group<BAND, 0>(p0, kb, qrel, hi); SBAR(); gs[1] = sb_group<BAND, 1>(p0, kb, qrel, hi); SBAR(); gs[2] = sb_group<BAND, 2>(p0, kb, qrel, hi); SBAR(); gs[3] = sb_group<BAND, 3>(p0, kb, qrel, hi); SBAR();
  gs[4] = sb_group<BAND, 0>(p1, kb + 32, qrel, hi); SBAR(); gs[5] = sb_group<BAND, 1>(p1, kb + 32, qrel, hi); SBAR(); gs[6] = sb_group<BAND, 2>(p1, kb + 32, qrel, hi); SBAR(); gs[7] = sb_group<BAND, 3>(p1, kb + 32, qrel, hi); SBAR();
  sb_combine(p0, p1, gs, carry, hi);
}

template <int MODE, bool OUT8 = false>
__device__ __forceinline__ void attn_unit(const bf16* __restrict__ Qb, int ldq, const bf16* __restrict__ Kh, const bf16* __restrict__ Vh, int ldk, bf16* __restrict__ Ob, int ldo,
                                          const float* __restrict__ gain, const float* __restrict__ kmean, int qb, int nkeys, char* lds, float s8 = 1.f) {
  int tid_ = threadIdx.x; asm volatile("" : "+v"(tid_));
  const int tid = tid_, wid = __builtin_amdgcn_readfirstlane(tid >> 6), lane = tid & 63, r32 = lane & 31, hi = lane >> 5;
  char* V_lds = lds; char* K_lds = lds + 2 * SHM_V;
  float* ws = (float*)(lds + OFF_WS) + wid * 64; float* li_l = ws; float* al_l = ws + 32;
  float* km_l = (float*)(lds + OFF_KM);
  int* flg = (int*)(lds + OFF_KM);
  const int NT = (MODE == 0) ? nkeys / KVBLK : 4 * (qb + 1);
  const int qrel = wid * 32 + r32;
  float m_reg = -1e30f, l_reg = 0.f, carry = 1.f; f32x16 o[4] = {};
  const int vb0 = (int)(uintptr_t)V_lds + v_rd_base(lane);
  lds_cp ka[2][4];
#pragma unroll
  for (int y = 0; y < 2; ++y)
#pragma unroll
    for (int x = 0; x < 4; ++x) ka[y][x] = (lds_cp)(__attribute__((address_space(3))) char*)K_lds + r32 * 256 + 128 * (y ^ ((r32 >> 3) & 1)) + 32 * (x ^ ((r32 >> 1) & 3)) + 16 * (hi ^ (r32 & 1));
  lds_cp qr[2][4];
#pragma unroll
  for (int y = 0; y < 2; ++y)
#pragma unroll
    for (int x = 0; x < 4; ++x) qr[y][x] = ka[y][x] + (OFF_Q - 2 * SHM_V) + wid * 8192;
  long ksrc[2], vsrc[2];
#pragma unroll
  for (int i = 0; i < 2; ++i) { const int piece = wid + 8 * i;
    { const int row = piece * 4 + (lane >> 4), c = (lane & 15) ^ (row & 15); ksrc[i] = (long)row * ldk + c * 8; }
    { const int sub = piece * 2 + (lane >> 5), kk = (sub >> 2) * 8 + ((lane & 31) >> 2), k = (kk & ~0xC) | ((kk & 4) << 1) | ((kk & 8) >> 1), c = (sub & 3) * 32 + (lane & 3) * 8; vsrc[i] = (long)k * ldk + c; } }
  typedef __attribute__((address_space(3))) unsigned lds_u32;
  lds_u32* kdst = (lds_u32*)(__attribute__((address_space(3))) char*)(K_lds) + wid * 256; lds_u32* vdst = (lds_u32*)(__attribute__((address_space(3))) char*)(V_lds) + wid * 256;
#define TILE(it) ((MODE == 2) ? (NT - 1 - (it)) : (it))
#define DMA_K(k0, b) do { _Pragma("unroll") for (int i_ = 0; i_ < 2; ++i_) __builtin_amdgcn_global_load_lds((const unsigned*)(Kh + (long)(k0) * ldk + ksrc[i_]), kdst + (b) * (SHM_K / 4) + i_ * 2048, 16, 0, 0); } while (0)
#define DMA_V(k0, b) do { _Pragma("unroll") for (int i_ = 0; i_ < 2; ++i_) __builtin_amdgcn_global_load_lds((const unsigned*)(Vh + (long)(k0) * ldk + vsrc[i_]), vdst + (b) * (SHM_V / 4) + i_ * 2048, 16, 0, 0); } while (0)
#define SDRAIN() asm volatile("s_waitcnt vmcnt(0)" ::: "memory")
#define KSLOT(i_) ((i_) == 2 ? (OFF_Q - 2 * SHM_V) : (i_) * SHM_K)
#define VSLOT(i_) ((i_) == 2 ? (OFF_Q + SHM_K) : (i_) * SHM_V)
#define DMA_K3(k0, so) do { _Pragma("unroll") for (int i_ = 0; i_ < 2; ++i_) __builtin_amdgcn_global_load_lds((const unsigned*)(Kh + (long)(k0) * ldk + ksrc[i_]), kdst + (so) / 4 + i_ * 2048, 16, 0, 0); } while (0)
#define DMA_V3(k0, so) do { _Pragma("unroll") for (int i_ = 0; i_ < 2; ++i_) __builtin_amdgcn_global_load_lds((const unsigned*)(Vh + (long)(k0) * ldk + vsrc[i_]), vdst + (so) / 4 + i_ * 2048, 16, 0, 0); } while (0)
  { lds_u32* qdst = (lds_u32*)(__attribute__((address_space(3))) char*)(lds + OFF_Q) + wid * 2048;
#pragma unroll
    for (int i = 0; i < 8; ++i) { const int row = 4 * i + (lane >> 4), c = (lane & 15) ^ (row & 15);
      __builtin_amdgcn_global_load_lds((const unsigned*)(Qb + (long)(wid * 32 + row) * ldq + c * 8), qdst + i * 256, 16, 0, 0); } }
  DMA_K(TILE(0) * KVBLK, 0); DMA_V(TILE(0) * KVBLK, 0); if (MODE == 2 || PIPE_SOFTMAX) DMA_K(TILE(1) * KVBLK, 1);
  constexpr bool RING3 = (MODE != 2) && QREG_SOFTMAX && !PIPE_SOFTMAX;
  unsigned selmask = 0u;
  if (MODE == 1) { if (tid < 256) *(f32x4*)(km_l + tid * 4) = *(const f32x4*)(kmean + tid * 4); }
  SDRAIN();
  __syncthreads();
  if (MODE == 1) {
    float g[8];
#pragma unroll
    for (int n = 0; n < 8; ++n) g[n] = 0.f;
    { const int rh = (r32 >> 1) & 3, r3 = (r32 >> 3) & 1;
      const lds_cp qbase = qr[0][0] - 32 * rh - 128 * r3;
#pragma unroll 1
      for (int d0 = 0; d0 < 8; ++d0) {
        const bf16x8 qf = *reinterpret_cast<const __attribute__((address_space(3))) bf16x8*>(qbase + 32 * ((d0 & 3) ^ rh) + 128 * ((d0 >> 2) ^ r3));
        float q[8];
#pragma unroll
        for (int j = 0; j < 8; ++j) q[j] = __uint_as_float(((unsigned)(unsigned short)qf[j]) << 16);
        const float* kmp = km_l + d0 * 16 + hi * 8;
#pragma unroll
        for (int n = 0; n < 7; ++n) { const f32x4 k0v = *(const f32x4*)(kmp + n * 128), k1v = *(const f32x4*)(kmp + n * 128 + 4);
          g[n] += (q[0] * k0v[0] + q[1] * k0v[1]) + (q[2] * k0v[2] + q[3] * k0v[3]) + (q[4] * k1v[0] + q[5] * k1v[1]) + (q[6] * k1v[2] + q[7] * k1v[3]); }
      } }
#pragma unroll
    for (int n = 0; n < 7; ++n) { g[n] += xchg32(g[n], hi); if (n >= qb) g[n] = -INFINITY; }
    g[7] = -INFINITY;
#pragma unroll
    for (int n = 0; n < 7; ++n) { int cnt = 0;
#pragma unroll
      for (int mI = 0; mI < 7; ++mI) { if (mI != n) cnt += (g[mI] > g[n] || (g[mI] == g[n] && mI < n)) ? 1 : 0; }
      if (n < qb && cnt < 3) selmask |= (1u << n); }
  }
  bf16x8 qg[8];
  if (QREG_SOFTMAX && MODE != 2) {
#pragma unroll
    for (int d0 = 0; d0 < 8; ++d0) qg[d0] = *reinterpret_cast<const __attribute__((address_space(3))) bf16x8*>(qr[d0 >> 2][d0 & 3]); }
  int kc = KSLOT(0), kn = KSLOT(1), kn2 = KSLOT(2), vc = VSLOT(0), vn = VSLOT(1), vn2 = VSLOT(2);
  if (RING3) { DMA_K3(TILE(1) * KVBLK, kn); DMA_V3(TILE(1) * KVBLK, vn);
    asm volatile("s_waitcnt lgkmcnt(0)" ::: "memory"); __syncthreads(); }
  f32x16 pA0, pA1, pB0, pB1; bf16x8 pa0, pa1, pa2, pa3;
  if (MODE == 2 || PIPE_SOFTMAX) { float bias0 = 0.f; if (MODE == 1) { if (NT > 4) bias0 = (selmask & 1u) ? 0.f : -INFINITY; }
    qkt(pA0, pA1, ka, 0, qr, bias0);
    __syncthreads(); }
  int it = 0;
#define JB(i_) ((MODE == 2) ? (3 - (i_)) : ((i_) - (NT - 4)))
#define STEP(A0, A1, B0, B1, BAND, HASNEXT) do { \
    if (it + 2 < NT) DMA_K(TILE(it + 2) * KVBLK, it & 1); \
    if (it + 1 < NT) DMA_V(TILE(it + 1) * KVBLK, (it + 1) & 1); \
    bool skip = false; const int jb = JB(it); \
    if (BAND) { if (MODE == 1) skip = (64 * jb > wid * 32 + 31); if (MODE == 2) skip = (64 * jb >= wid * 32 + 31); } \
    if (MODE == 2) skip = skip || __all(carry < SB_DONE);        \
    if (HASNEXT) { float bias_ = 0.f; if (MODE == 1) { if (it + 1 < NT - 4) bias_ = ((selmask >> ((it + 1) >> 2)) & 1u) ? 0.f : -INFINITY; } \
      qkt(B0, B1, ka, ((it + 1) & 1) * SHM_K, qr, bias_); } \
    if (!skip) { \
      if (MODE == 2) { sb_tile<(BAND) != 0>(A0, A1, carry, 64 * jb, qrel, hi); } \
      else { \
        if (MODE == 1 && (BAND)) { _Pragma("unroll") for (int r = 0; r < 16; ++r) { const int kr = 64 * jb + crow(r, hi); if (kr > qrel) A0[r] = -INFINITY; if (kr + 32 > qrel) A1[r] = -INFINITY; } } \
        float alpha; softmax_tile(A0, A1, m_reg, l_reg, alpha); \
        if (__any(alpha < 1.f)) { if (hi == 0) al_l[r32] = alpha; asm volatile("s_waitcnt lgkmcnt(0)" ::: "memory"); \
          _Pragma("unroll") for (int d = 0; d < 4; ++d) _Pragma("unroll") for (int r = 0; r < 16; ++r) o[d][r] *= al_l[crow(r, hi)]; } \
      } \
      pack_p(A0, A1, pa0, pa1, pa2, pa3); \
      pv_d0(o, vb0 + (it & 1) * SHM_V, pa0, pa1, pa2, pa3); \
    } \
    SDRAIN(); __syncthreads(); ++it; } while (0)
#define SB_LD(G, F) do { F##q = *reinterpret_cast<const __attribute__((address_space(3))) bf16x8*>(qr[(G) >> 2][(G) & 3]); \
      F##0 = *reinterpret_cast<const __attribute__((address_space(3))) bf16x8*>(ka[(G) >> 2][(G) & 3] + kb_); F##1 = *reinterpret_cast<const __attribute__((address_space(3))) bf16x8*>(ka[(G) >> 2][(G) & 3] + kb_ + 8192); } while (0)
#define SB_PART(G, P, I, B0, B1, FC, FN) do { if ((G) < 7) SB_LD(((G) + 1) & 7, FN);              \
      B0 = __builtin_amdgcn_mfma_f32_32x32x16_bf16(FC##0, FC##q, B0, 0, 0, 0); B1 = __builtin_amdgcn_mfma_f32_32x32x16_bf16(FC##1, FC##q, B1, 0, 0, 0); \
      gs_[G] = sb_group<false, I>(P, 0, 0, hi); SBAR(); } while (0)
#define STEP_SB(A0, A1, B0, B1) do { \
    if (it + 2 < NT) DMA_K(TILE(it + 2) * KVBLK, it & 1); \
    DMA_V(TILE(it + 1) * KVBLK, (it + 1) & 1); \
    float gs_[8]; \
    _Pragma("unroll") for (int r = 0; r < 16; ++r) { B0[r] = 0.f; B1[r] = 0.f; } \
    const int kb_ = ((it + 1) & 1) * SHM_K; bf16x8 fx0, fx1, fxq, fy0, fy1, fyq; SB_LD(0, fx); SBAR(); \
    SB_PART(0, A0, 0, B0, B1, fx, fy); SB_PART(1, A0, 1, B0, B1, fy, fx); SB_PART(2, A0, 2, B0, B1, fx, fy); SB_PART(3, A0, 3, B0, B1, fy, fx); \
    SB_PART(4, A1, 0, B0, B1, fx, fy); SB_PART(5, A1, 1, B0, B1, fy, fx); SB_PART(6, A1, 2, B0, B1, fx, fy); SB_PART(7, A1, 3, B0, B1, fy, fx); \
    sb_combine(A0, A1, gs_, carry, hi); \
    { const bool dn_ = __all(carry < SB_DONE); if (lane == 0) flg[(it & 1) * 8 + wid] = dn_ ? 1 : 0; } \
    pack_p(A0, A1, pa0, pa1, pa2, pa3); \
    pv_d0(o, vb0 + (it & 1) * SHM_V, pa0, pa1, pa2, pa3); \
    SDRAIN(); __syncthreads(); \
    { const int* f_ = flg + (it & 1) * 8; stop = (f_[0] + f_[1] + f_[2] + f_[3] + f_[4] + f_[5] + f_[6] + f_[7]) == 8; } \
    ++it; } while (0)
#define SSTEP(BAND) do { \
    if (RING3) { if (it + 2 < NT) { DMA_K3(TILE(it + 2) * KVBLK, kn2); DMA_V3(TILE(it + 2) * KVBLK, vn2); } } \
    else if (it + 1 < NT) { DMA_K(TILE(it + 1) * KVBLK, (it + 1) & 1); DMA_V(TILE(it + 1) * KVBLK, (it + 1) & 1); } \
    bool skip = false; const int jb = JB(it); \
    if (BAND) skip = (64 * jb > wid * 32 + 31); \
    if (!skip) { \
      float bias_ = 0.f; if (MODE == 1 && !(BAND)) bias_ = ((selmask >> (it >> 2)) & 1u) ? 0.f : -INFINITY; \
      const int kb_ = RING3 ? kc : (it & 1) * SHM_K; \
      if (QREG_SOFTMAX) qkt(pA0, pA1, ka, kb_, qg, bias_); else qkt(pA0, pA1, ka, kb_, qr, bias_); \
      if (MODE == 1 && (BAND)) { _Pragma("unroll") for (int r = 0; r < 16; ++r) { const int kr = 64 * jb + crow(r, hi); if (kr > qrel) pA0[r] = -INFINITY; if (kr + 32 > qrel) pA1[r] = -INFINITY; } } \
      float alpha; softmax_tile(pA0, pA1, m_reg, l_reg, alpha); \
      if (__any(alpha < 1.f)) { if (hi == 0) al_l[r32] = alpha; asm volatile("s_waitcnt lgkmcnt(0)" ::: "memory"); \
        _Pragma("unroll") for (int d = 0; d < 4; ++d) _Pragma("unroll") for (int r = 0; r < 16; ++r) o[d][r] *= al_l[crow(r, hi)]; } \
      pack_p(pA0, pA1, pa0, pa1, pa2, pa3); \
      pv_d0(o, vb0 + (RING3 ? vc : (it & 1) * SHM_V), pa0, pa1, pa2, pa3); \
    } \
    if (RING3) { if (it + 2 < NT) asm volatile("s_waitcnt vmcnt(4)" ::: "memory"); else SDRAIN();        \
      { const int t_ = kc; kc = kn; kn = kn2; kn2 = t_; } { const int t_ = vc; vc = vn; vn = vn2; vn2 = t_; } } \
    else SDRAIN(); \
    if (RING3) { asm volatile("s_waitcnt lgkmcnt(0)" ::: "memory"); __builtin_amdgcn_s_barrier(); asm volatile("" ::: "memory"); }     \
    else __syncthreads(); \
    ++it; } while (0)
#define RESTART(BIASEXPR) do { qkt(pA0, pA1, ka, (it & 1) * SHM_K, qr, (BIASEXPR)); __syncthreads(); } while (0)
  if (MODE == 0) {
    if (PIPE_SOFTMAX) { STEP(pA0, pA1, pB0, pB1, 0, true); STEP(pB0, pB1, pA0, pA1, 0, true); STEP(pA0, pA1, pB0, pB1, 0, true); STEP(pB0, pB1, pA0, pA1, 0, false); }
    else { SSTEP(0); SSTEP(0); SSTEP(0); SSTEP(0); }
  } else if (MODE == 1) {
    if (PIPE_SOFTMAX) {
      if (NT > 4) { while (it < NT - 4) { STEP(pA0, pA1, pB0, pB1, 0, true); STEP(pB0, pB1, pA0, pA1, 0, (it + 1 < NT - 4)); }
        RESTART(0.f); }
      STEP(pA0, pA1, pB0, pB1, 1, true); STEP(pB0, pB1, pA0, pA1, 1, true); STEP(pA0, pA1, pB0, pB1, 1, true); STEP(pB0, pB1, pA0, pA1, 1, false);
    } else {
      while (it < NT - 4) SSTEP(0);
      SSTEP(1); SSTEP(1); SSTEP(1); SSTEP(1);
    }
  } else {
    STEP(pA0, pA1, pB0, pB1, 1, true); STEP(pB0, pB1, pA0, pA1, 1, true); STEP(pA0, pA1, pB0, pB1, 1, true); STEP(pB0, pB1, pA0, pA1, 1, false);
    if (NT > 4) {
      RESTART(0.f);
      bool stop = false;
      while (it + 2 < NT && !stop) { STEP_SB(pA0, pA1, pB0, pB1); STEP_SB(pB0, pB1, pA0, pA1); }
      if (!stop) { STEP_SB(pA0, pA1, pB0, pB1); STEP(pB0, pB1, pA0, pA1, 0, false); }
    }
  }
#undef RESTART
#undef STEP
#undef SSTEP
#undef STEP_SB
#undef SB_LD
#undef SB_PART
#undef JB
  float rli[16];
  if (MODE != 2) { if (hi == 0) li_l[r32] = l_reg; asm volatile("s_waitcnt lgkmcnt(0)" ::: "memory");
#pragma unroll
    for (int r = 0; r < 16; ++r) rli[r] = __builtin_amdgcn_rcpf(li_l[crow(r, hi)]); }
  else {
#pragma unroll
    for (int r = 0; r < 16; ++r) rli[r] = 1.f; }
  if (gain) {
    float gv[4];
#pragma unroll
    for (int d0 = 0; d0 < 4; ++d0) gv[d0] = gain[d0 * 32 + r32];
#pragma unroll
    for (int r = 0; r < 16; ++r) { float s = 0.f;
#pragma unroll
      for (int d0 = 0; d0 < 4; ++d0) { o[d0][r] *= rli[r]; s += o[d0][r] * o[d0][r]; }
      s += __shfl_xor(s, 1); s += __shfl_xor(s, 2); s += __shfl_xor(s, 4); s += __shfl_xor(s, 8); s += __shfl_xor(s, 16);
      rli[r] = __builtin_amdgcn_rsqf(s * (1.0f / 128.0f) + 1e-6f); }
#pragma unroll
    for (int r = 0; r < 16; ++r)
#pragma unroll
      for (int d0 = 0; d0 < 4; ++d0) o[d0][r] *= gv[d0];
  }
  if (OUT8) { unsigned char* stg = (unsigned char*)lds + wid * 4096;
#pragma unroll
    for (int r = 0; r < 16; ++r) { const int orow = crow(r, hi);
#pragma unroll
      for (int d0 = 0; d0 < 4; ++d0) { const float v = __builtin_amdgcn_fmed3f(o[d0][r] * rli[r] * s8, -448.f, 448.f); stg[orow * 128 + d0 * 32 + r32] = (unsigned char)(__builtin_amdgcn_cvt_pk_fp8_f32(v, v, 0, false) & 0xff); } }
    asm volatile("s_waitcnt lgkmcnt(0)" ::: "memory");
#pragma unroll
    for (int i = 0; i < 4; ++i) { const int row = i * 8 + (lane >> 3), ch = lane & 7; const u32x4 v = *(const u32x4*)(stg + row * 128 + ch * 16); *(u32x4*)((unsigned char*)Ob + (long)(wid * 32 + row) * ldo + ch * 16) = v; } }
  else { bf16* stg = (bf16*)lds + wid * 4096;
#pragma unroll
    for (int r = 0; r < 16; ++r) { const int orow = crow(r, hi);
#pragma unroll
      for (int d0 = 0; d0 < 4; ++d0) { const float v = o[d0][r] * rli[r]; unsigned u = __float_as_uint(v); u = (u + 0x7fffu + ((u >> 16) & 1u)) >> 16; stg[orow * 128 + d0 * 32 + r32] = (bf16)u; } }
    asm volatile("s_waitcnt lgkmcnt(0)" ::: "memory");
#pragma unroll
    for (int i = 0; i < 8; ++i) { const int row = i * 4 + (lane >> 4), ch = lane & 15; const u32x4 v = *(const u32x4*)(stg + row * 128 + ch * 8); *(u32x4*)(Ob + (long)(wid * 32 + row) * ldo + ch * 8) = v; } }
  __syncthreads();
#undef TILE
#undef DMA_K
#undef DMA_V
#undef DMA_K3
#undef DMA_V3
#undef KSLOT
#undef VSLOT
#undef SDRAIN
}
#undef KSWZ
#undef SBAR
}
#define GAS __attribute__((address_space(1)))
#define LAS __attribute__((address_space(3)))
typedef unsigned short bf16;
typedef unsigned v4u __attribute__((ext_vector_type(4)));
typedef float f32x4 __attribute__((ext_vector_type(4)));
#define LDS_WAIT() asm volatile("s_waitcnt lgkmcnt(0)" ::: "memory")
constexpr int NWAVES = 8;
constexpr int BATCH = 8, SEQ = 2048, DM = 2048, M = BATCH * SEQ, HD = 128, NH = 8;
constexpr int NQKV = 6144, FF = 5632, WX = 512, NMEM = 256, MMEM = BATCH * NMEM;
constexpr int QSB = 0, KSB = 1024, VSB = 2048, QMB = 3072, KMB = 4096, VMB = 5120;
constexpr float EPS = 1e-6f;
constexpr float QSCALE = 0.12751743082459868f;
constexpr size_t MiB = 1u << 20;
constexpr size_t WS_CTL = 0, CTL_ZERO_BYTES = 512 * 1024;
constexpr size_t WS_SSQ1 = 64 * 1024, WS_SSQ2 = 128 * 1024;
constexpr size_t WS_KSUM = 256 * 1024;
constexpr size_t WS_WIN = 1 * MiB, WS_WOUT = 25 * MiB, WS_WXQ = 33 * MiB, WS_WXKV = 35 * MiB, WS_WXO = 39 * MiB, WS_WGU = 41 * MiB, WS_WDN = 85 * MiB;
constexpr size_t WS_RA = 107 * MiB;
constexpr size_t WS_RB = 171 * MiB;
constexpr size_t WS_RC = 235 * MiB;
constexpr size_t WS_QX = 427 * MiB, WS_OX = 443 * MiB, WS_KVX = 459 * MiB, WS_MN = 463 * MiB, WS_KMEAN = 471 * MiB, WS_RINV0 = 471 * MiB  , WS_CS = 472 * MiB, WS_END = 474 * MiB;
constexpr int RING_BYTES = 131072, LDS_BYTES = 147456;
#ifndef FFN_FP8
#define FFN_FP8 1
#endif
constexpr float S_X2 = 16.f, S_WGU = 32.f, S_ACT = 8.f, S_WDN = 64.f, S_XN = 16.f, S_WV = 32.f, S_O = 16.f, S_WO = 32.f;
constexpr float S_OX = 16.f, S_WXO = 16.f;
#ifndef WXO_FP8
#define WXO_FP8 1
#endif
#ifndef WOUT_FP8
#define WOUT_FP8 1
#endif
constexpr size_t WS_WV8 = WS_WIN + 16 * MiB;

__device__ __forceinline__ float bf2f(unsigned short b) { return __uint_as_float((unsigned)b << 16); }
__device__ __forceinline__ unsigned f2bf(float f) { unsigned u = __builtin_bit_cast(unsigned, f); return (u + 0x7fffu + ((u >> 16) & 1u)) >> 16; }
__device__ __forceinline__ unsigned pk2(float lo, float hi) { return f2bf(lo) | (f2bf(hi) << 16); }
__device__ __forceinline__ float wave_sum(float v) {
#pragma unroll
    for (int o = 1; o < 64; o <<= 1) v += __shfl_xor(v, o);
    return v;
}
__device__ __forceinline__ float wave_max(float v) {
#pragma unroll
    for (int o = 1; o < 64; o <<= 1) v = fmaxf(v, __shfl_xor(v, o));
    return v;
}

typedef GAS unsigned gu32;
#define RLX_AGENT __ATOMIC_RELAXED, __HIP_MEMORY_SCOPE_AGENT
constexpr int CW_BAR = 4096;
constexpr int LDSCTL_OFF = RING_BYTES, MISC_OFF = LDSCTL_OFF + 320;
#define XB_TMO      128
#define XB_XCNT(j)  (256  + 64 * (j))
#define XB_XSUB(j)  (1280 + 64 * (j))
#define XB_XGEN(j)  (2304 + 64 * (j))
#define XB_TOP      3328
#define XB_TOPGEN   3392
#define XCD_BAR_WORDS 3456
#define XB_SPIN_CAP (1u << 18)

__device__ __forceinline__ unsigned xb_ld(unsigned* p)              { return __hip_atomic_load(p, __ATOMIC_RELAXED, __HIP_MEMORY_SCOPE_AGENT); }
__device__ __forceinline__ unsigned xb_add(unsigned* p, unsigned v) { return __hip_atomic_fetch_add(p, v, __ATOMIC_RELAXED, __HIP_MEMORY_SCOPE_AGENT); }
__device__ __forceinline__ unsigned xb_xcc_id() { return (unsigned)__builtin_amdgcn_s_getreg((3 << 11) | 20) & 0xFu; }
#define XB_SPIN(cond, bar) do { unsigned _sp = 0; while (cond) { __builtin_amdgcn_s_sleep(1); \
    if ((++_sp & 255u) == 0u) { if (xb_ld(&(bar)[XB_TMO])) break; if (_sp > XB_SPIN_CAP) { atomicAdd(&(bar)[XB_TMO], 1u); break; } } } } while (0)

struct XcdBarrier {
    unsigned* bar; unsigned x;
    volatile LAS unsigned* st;
};

__device__ __forceinline__ XcdBarrier xcd_barrier_post(unsigned* bar, volatile LAS unsigned* st) {
    XcdBarrier b; b.bar = bar; b.x = xb_xcc_id(); b.st = st;
    if (threadIdx.x == 0) (void)xb_add(&bar[XB_XCNT(b.x)], 1u);
    return b;
}
__device__ __forceinline__ void xcd_barrier_complete(unsigned* bar, unsigned x, unsigned& nloc, unsigned& nx) {
    const unsigned G = gridDim.x * gridDim.y * gridDim.z;
    unsigned sum, cnt, mine, sp = 0u;
    for (;;) {
        sum = 0u; cnt = 0u; mine = 0u;
#pragma unroll
        for (unsigned j = 0; j < 16; ++j) { const unsigned c = xb_ld(&bar[XB_XCNT(j)]); sum += c; cnt += (c > 0u) ? 1u : 0u; mine = (j == x) ? c : mine; }
        if (sum == G) break;
        __builtin_amdgcn_s_sleep(1);
        if ((++sp & 255u) == 0u) { if (xb_ld(&bar[XB_TMO])) break; if (sp > XB_SPIN_CAP) { atomicAdd(&bar[XB_TMO], 1u); break; } }
    }
    nloc = mine > 0u ? mine : 1u; nx = cnt > 0u ? cnt : 1u;
}

__device__ __forceinline__ void xcd_barrier(const XcdBarrier& b) {
    asm volatile("s_waitcnt vmcnt(0)" ::: "memory");
    __syncthreads();
    if (threadIdx.x == 0) {
        unsigned* bar = b.bar;
        __builtin_amdgcn_s_waitcnt(0);
        unsigned nloc = b.st[0], nx = b.st[1];
        if (nloc == 0u) { xcd_barrier_complete(bar, b.x, nloc, nx); b.st[0] = nloc; b.st[1] = nx; }
        const unsigned old = xb_add(&bar[XB_XSUB(b.x)], 1u);
        const unsigned gen = old / nloc;
        if (old + 1u == (gen + 1u) * nloc) {
            __builtin_amdgcn_fence(__ATOMIC_RELEASE, "agent");
            asm volatile("s_waitcnt vmcnt(0)" ::: "memory");
            const unsigned og = xb_add(&bar[XB_TOP], 1u);
            const unsigned tg = og / nx;
            if (og + 1u == (tg + 1u) * nx) xb_add(&bar[XB_TOPGEN], 1u);
            else XB_SPIN(xb_ld(&bar[XB_TOPGEN]) == tg, bar);
            __builtin_amdgcn_fence(__ATOMIC_ACQUIRE, "agent");
            xb_add(&bar[XB_XGEN(b.x)], 1u);
            asm volatile("s_waitcnt vmcnt(0)" ::: "memory");
        } else {
            XB_SPIN(xb_ld(&bar[XB_XGEN(b.x)]) == gen, bar);
            __builtin_amdgcn_fence(__ATOMIC_ACQUIRE, "agent");
            asm volatile("s_waitcnt vmcnt(0)" ::: "memory");
        }
    }
    __syncthreads();
}

struct Frame {
    LAS unsigned char* lds;
    int tid, lane, wave, vcu, G;
    const float *x, *mem; const int* pos;
    const float *g_mix, *w_in, *g_out_sb, *g_out_mb, *w_out, *g_xattn, *g_mem, *w_xq, *w_xkv, *w_xo, *g_ffn, *w_gu, *w_dn, *g_final;
    float* out; unsigned char* ws;
};

__device__ __forceinline__ void transpose_item(const float* W, int K, int N, bf16* WT, const float* gain, int inter, LAS float* scr, int item, int lane) {
    const int nblk = N / 32, kb = item / nblk, nb = item % nblk, k0 = 64 * kb, n0 = 32 * nb;
    int orow0 = n0;
    if (inter == 1) orow0 = (n0 < FF) ? (n0 / 128) * 256 + (n0 % 128) : ((n0 - FF) / 128) * 256 + 128 + ((n0 - FF) % 128);
    if (inter == 2) { const int reg = n0 / 1024, c = n0 % 1024; orow0 = (reg == 2) ? c : (reg == 5) ? 1024 + c : (reg < 2 ? reg : reg - 1) * 1024 + c; }
    float v[32];
#pragma unroll
    for (int i = 0; i < 32; ++i) v[i] = W[(size_t)(k0 + 2 * i + (lane >> 5)) * N + n0 + (lane & 31)];
#pragma unroll
    for (int i = 0; i < 32; ++i) { const int kk = 2 * i + (lane >> 5); float t = v[i]; if (gain) t *= gain[k0 + kk]; scr[kk * 33 + (lane & 31)] = t; }
    LDS_WAIT(); asm volatile("" ::: "memory");
    const int c = lane & 7;
#pragma unroll
    for (int j = 0; j < 4; ++j) { const int n = (lane >> 3) + 8 * j; const LAS float* s = scr + (8 * c) * 33 + n;
        v4u o; o.x = pk2(s[0 * 33], s[1 * 33]); o.y = pk2(s[2 * 33], s[3 * 33]); o.z = pk2(s[4 * 33], s[5 * 33]); o.w = pk2(s[6 * 33], s[7 * 33]);
        *(GAS v4u*)(WT + (size_t)(orow0 + n) * K + k0 + 8 * c) = o; }
    LDS_WAIT(); asm volatile("" ::: "memory");
}
__device__ __forceinline__ void transpose_item_fp8(const float* W, int K, int N, unsigned char* WT, const float* gain, int inter, float scale, LAS float* scr, int item, int lane) {
    const int nblk = N / 32, kb = item / nblk, nb = item % nblk, k0 = 64 * kb, n0 = 32 * nb;
    int orow0 = n0;
    if (inter == 1) orow0 = (n0 < FF) ? (n0 / 128) * 256 + (n0 % 128) : ((n0 - FF) / 128) * 256 + 128 + ((n0 - FF) % 128);
    if (inter == 2) { const int reg = n0 / 1024, c = n0 % 1024; orow0 = (reg == 2) ? c : (reg == 5) ? 1024 + c : (reg < 2 ? reg : reg - 1) * 1024 + c; }
    float v[32];
#pragma unroll
    for (int i = 0; i < 32; ++i) v[i] = W[(size_t)(k0 + 2 * i + (lane >> 5)) * N + n0 + (lane & 31)];
#pragma unroll
    for (int i = 0; i < 32; ++i) { const int kk = 2 * i + (lane >> 5); float t = v[i] * scale; if (gain) t *= gain[k0 + kk]; scr[kk * 33 + (lane & 31)] = t; }
    LDS_WAIT(); asm volatile("" ::: "memory");
    const int c = lane & 7;
#pragma unroll
    for (int j = 0; j < 4; ++j) { const int n = (lane >> 3) + 8 * j; const LAS float* s = scr + (8 * c) * 33 + n;
        pg8::u32x2 o; o.x = pg8::pk4_fp8(s[0 * 33], s[1 * 33], s[2 * 33], s[3 * 33]); o.y = pg8::pk4_fp8(s[4 * 33], s[5 * 33], s[6 * 33], s[7 * 33]);
        *(GAS pg8::u32x2*)(WT + (size_t)(orow0 + n) * K + k0 + 8 * c) = o; }
    LDS_WAIT(); asm volatile("" ::: "memory");
}
__device__ __forceinline__ void rms_row_to_bf16(const float* xrow, const float* g, bf16* orow, int lane, unsigned char* o8 = nullptr, float s8 = 1.f) {
    const GAS f32x4* xr = (const GAS f32x4*)xrow + lane; const GAS f32x4* gr = (const GAS f32x4*)g + lane;
    f32x4 v[8]; float s = 0.f;
#pragma unroll
    for (int j = 0; j < 8; ++j) { v[j] = xr[64 * j]; s += (v[j].x * v[j].x + v[j].y * v[j].y) + (v[j].z * v[j].z + v[j].w * v[j].w); }
    const float rstd = 1.0f / sqrtf(wave_sum(s) * (1.f / DM) + EPS);
    GAS unsigned long long* ob8 = (GAS unsigned long long*)orow + lane;
#pragma unroll
    for (int j = 0; j < 8; ++j) { const f32x4 gg = gr[64 * j];
        const float a0 = v[j].x * rstd * gg.x, a1 = v[j].y * rstd * gg.y, a2 = v[j].z * rstd * gg.z, a3 = v[j].w * rstd * gg.w;
        ob8[64 * j] = (unsigned long long)pk2(a0, a1) | ((unsigned long long)pk2(a2, a3) << 32);
        if (o8) ((GAS unsigned*)o8)[64 * j + lane] = pg8::pk4_fp8(a0 * s8, a1 * s8, a2 * s8, a3 * s8); }
}
__device__ __forceinline__ void x_row_convert(const float* xrow, bf16* orow, unsigned char* o8, float s8, float* rinv, int lane) {
    const GAS f32x4* xr = (const GAS f32x4*)xrow + lane;
    f32x4 v[8]; float s = 0.f;
#pragma unroll
    for (int j = 0; j < 8; ++j) { v[j] = xr[64 * j]; s += (v[j].x * v[j].x + v[j].y * v[j].y) + (v[j].z * v[j].z + v[j].w * v[j].w); }
    const float rstd = 1.0f / sqrtf(wave_sum(s) * (1.f / DM) + EPS);
    if (lane == 0) *rinv = rstd;
    GAS unsigned long long* ob8 = (GAS unsigned long long*)orow + lane;
#pragma unroll
    for (int j = 0; j < 8; ++j) { ob8[64 * j] = (unsigned long long)pk2(v[j].x, v[j].y) | ((unsigned long long)pk2(v[j].z, v[j].w) << 32);
        ((GAS unsigned*)o8)[64 * j + lane] = pg8::pk4_fp8(v[j].x * s8, v[j].y * s8, v[j].z * s8, v[j].w * s8); }
}
__constant__ float INV_FREQ[16] = {1.000000000e+00f, 4.403665960e-01f, 1.939227432e-01f, 8.539710194e-02f, 3.760603070e-02f, 1.656043902e-02f, 7.292664610e-03f, 3.211445874e-03f,
                                   1.414213562e-03f, 6.227723788e-04f, 2.742481884e-04f, 1.207697351e-04f, 5.318296098e-05f, 2.341999971e-05f, 1.031338616e-05f, 4.541670478e-06f};

__device__ __forceinline__ void p0_prologue(Frame& F) {
    LAS float* scr = (LAS float*)(F.lds + F.wave * 16384);
    const int gw = F.vcu * NWAVES + F.wave, NGW = F.G * NWAVES;
    bf16* ws16 = (bf16*)F.ws;
    constexpr int I0 = (DM / 64) * (NQKV / 32), I1 = (DM / 64) * (DM / 32), I2 = (DM / 64) * (WX / 32), I3 = (DM / 64) * (2 * WX / 32), I4 = (WX / 64) * (DM / 32),
                  I5 = (DM / 64) * (2 * FF / 32), I6 = (FF / 64) * (DM / 32);
    constexpr int I5H = I5 / 2;
    constexpr int NITEMS = I0 + I1 + I2 + I3 + I4 + I5H;
    for (int it = gw; it < NITEMS; it += NGW) {
        int r = it;
        if (r < I0) { const int reg = ((r % (NQKV / 32)) * 32) / 1024;
            if (reg == 2 || reg == 5) transpose_item_fp8(F.w_in, DM, NQKV, F.ws + WS_WV8, F.g_mix, 2, S_WV, scr, r, F.lane);
            else transpose_item(F.w_in, DM, NQKV, (bf16*)(F.ws + WS_WIN), F.g_mix, 2, scr, r, F.lane);
            continue; } r -= I0;
        if (r < I1) { if (WOUT_FP8) transpose_item_fp8(F.w_out, DM, DM, F.ws + WS_WOUT, nullptr, 0, S_WO, scr, r, F.lane); else transpose_item(F.w_out, DM, DM, (bf16*)(F.ws + WS_WOUT), nullptr, 0, scr, r, F.lane); continue; } r -= I1;
        if (r < I2) { transpose_item(F.w_xq, DM, WX, (bf16*)(F.ws + WS_WXQ), F.g_xattn, 0, scr, r, F.lane); continue; } r -= I2;
        if (r < I3) { transpose_item(F.w_xkv, DM, 2 * WX, (bf16*)(F.ws + WS_WXKV), nullptr, 0, scr, r, F.lane); continue; } r -= I3;
        if (r < I4) { if (WXO_FP8) transpose_item_fp8(F.w_xo, WX, DM, F.ws + WS_WXO, nullptr, 0, S_WXO, scr, r, F.lane); else transpose_item(F.w_xo, WX, DM, (bf16*)(F.ws + WS_WXO), nullptr, 0, scr, r, F.lane); continue; } r -= I4;
        transpose_item_fp8(F.w_gu, DM, 2 * FF, F.ws + WS_WGU, F.g_ffn, 1, S_WGU, scr, r, F.lane);
    }
    (void)ws16;
    for (int m = gw; m < M; m += NGW) x_row_convert(F.x + (size_t)m * DM, (bf16*)(F.ws + WS_RA) + (size_t)m * DM, F.ws + WS_RB + (size_t)m * DM, S_XN, (float*)(F.ws + WS_RINV0) + m, F.lane);
    for (int m = gw; m < MMEM; m += NGW) rms_row_to_bf16(F.mem + (size_t)m * DM, F.g_mem, (bf16*)(F.ws + WS_MN) + (size_t)m * DM, F.lane);
    float* cs = (float*)(F.ws + WS_CS);
    for (int e = (F.vcu * NWAVES + F.wave) * 64 + F.lane; e < M * 16; e += NGW * 64) {
        const int m = e >> 4, i = e & 15; const float ang = (float)F.pos[m] * INV_FREQ[i];
        double rev = (double)ang * 0.15915494309189535; rev -= floor(rev);
        const float a = (float)(rev * 6.283185307179586);
        cs[(size_t)m * 32 + i] = cosf(a); cs[(size_t)m * 32 + 16 + i] = sinf(a);
    }
}

__device__ __forceinline__ void ffn_weight_items(Frame& F, int wi, int nw) {
    LAS float* scr = (LAS float*)(F.lds + F.wave * 16384);
    constexpr int I5 = (DM / 64) * (2 * FF / 32), I6 = (FF / 64) * (DM / 32);
    for (int it = wi + I5 / 2; it < I5 + I6; it += nw) {
        if (it < I5) transpose_item_fp8(F.w_gu, DM, 2 * FF, F.ws + WS_WGU, F.g_ffn, 1, S_WGU, scr, it, F.lane);
        else transpose_item_fp8(F.w_dn, FF, DM, F.ws + WS_WDN, nullptr, 0, S_WDN, scr, it - I5, F.lane);
    }
}

__device__ __forceinline__ void final_norm_phase(Frame& F, const bf16* src, float* dst) {
    const int gw = F.vcu * NWAVES + F.wave, NGW = F.G * NWAVES;
    for (int m = gw; m < M; m += NGW) {
        const GAS v4u* xr = (const GAS v4u*)(src + (size_t)m * DM) + F.lane; const GAS f32x4* gr = (const GAS f32x4*)F.g_final;
        v4u w[4]; float s = 0.f;
#pragma unroll
        for (int j = 0; j < 4; ++j) w[j] = xr[64 * j];
        f32x4 v[8];
#pragma unroll
        for (int j = 0; j < 4; ++j) { v[2 * j] = (f32x4){__uint_as_float(w[j].x << 16), __uint_as_float(w[j].x & 0xffff0000u), __uint_as_float(w[j].y << 16), __uint_as_float(w[j].y & 0xffff0000u)};
            v[2 * j + 1] = (f32x4){__uint_as_float(w[j].z << 16), __uint_as_float(w[j].z & 0xffff0000u), __uint_as_float(w[j].w << 16), __uint_as_float(w[j].w & 0xffff0000u)}; }
#pragma unroll
        for (int j = 0; j < 8; ++j) s += (v[j].x * v[j].x + v[j].y * v[j].y) + (v[j].z * v[j].z + v[j].w * v[j].w);
        const float rstd = 1.0f / sqrtf(wave_sum(s) * (1.f / DM) + EPS);
        GAS f32x4* dr = (GAS f32x4*)(dst + (size_t)m * DM);
#pragma unroll
        for (int j = 0; j < 4; ++j) { const int c4 = (64 * j + F.lane) * 2;
            dr[c4] = v[2 * j] * rstd * gr[c4]; dr[c4 + 1] = v[2 * j + 1] * rstd * gr[c4 + 1]; }
    }
}

struct RangeOrder : pg8::StaticOrder {
    int i0, n;
    __device__ __forceinline__ bool next(int i, pg8::Unit& u) const { return i < n && pg8::StaticOrder::next(i + i0, u); }
};
constexpr int NPH = 11;
#ifndef REPEAT_WHICH
#define REPEAT_WHICH 3
#endif
#ifndef NULL_EPI_PROBE
#define NULL_EPI_PROBE 0
#endif
#ifndef FOLD_KMEAN
#define FOLD_KMEAN 1
#endif
#ifndef REPEAT_PHASE
#define REPEAT_PHASE -1
#endif
#ifndef REPEAT_MASK
#define REPEAT_MASK 0
#endif
#define REPS(k) (((REPEAT_PHASE == (k)) || ((REPEAT_MASK >> (k)) & 1)) ? 2 : 1)
#ifndef USE_MFMA_SB
#define USE_MFMA_SB 1
#endif
#ifndef USE_MFMA_MOBA
#define USE_MFMA_MOBA 1
#endif
#ifndef USE_MFMA_X
#define USE_MFMA_X 1
#endif
#ifndef MK_ONE_LAUNCH
#define MK_ONE_LAUNCH 1
#endif
struct Args { const void* in[17]; float* out; unsigned char* ws; int ph_lo, ph_hi; };
__global__ void __launch_bounds__(NWAVES * 64, 2) mk_fwd(Args args) {
    extern __shared__ __attribute__((aligned(16))) unsigned char lds[];
    Frame F;
    F.lds = (LAS unsigned char*)lds;
    F.tid = threadIdx.x; F.lane = F.tid & 63; F.wave = __builtin_amdgcn_readfirstlane(F.tid >> 6);
    F.G = gridDim.x; { const int bx = blockIdx.x; F.vcu = (F.G % 8 == 0) ? (bx % 8) * (F.G / 8) + bx / 8 : bx; }
    F.x = (const float*)args.in[0]; F.mem = (const float*)args.in[1]; F.pos = (const int*)args.in[2];
    F.g_mix = (const float*)args.in[3]; F.w_in = (const float*)args.in[4]; F.g_out_sb = (const float*)args.in[5]; F.g_out_mb = (const float*)args.in[6]; F.w_out = (const float*)args.in[7];
    F.g_xattn = (const float*)args.in[8]; F.g_mem = (const float*)args.in[9]; F.w_xq = (const float*)args.in[10]; F.w_xkv = (const float*)args.in[11]; F.w_xo = (const float*)args.in[12];
    F.g_ffn = (const float*)args.in[13]; F.w_gu = (const float*)args.in[14]; F.w_dn = (const float*)args.in[15]; F.g_final = (const float*)args.in[16];
    F.out = args.out; F.ws = args.ws;
    unsigned char* ws = args.ws;
    const int lo = args.ph_lo, hi = args.ph_hi;
    for (int u = F.tid; u < (LDS_BYTES - LDSCTL_OFF) / 4; u += NWAVES * 64) ((LAS unsigned*)(F.lds + LDSCTL_OFF))[u] = 0u;
    __syncthreads();
    if (hi - lo > 1) {
        { GAS v4u* z = (GAS v4u*)(ws + WS_CTL); const int n16 = (int)(CTL_ZERO_BYTES / 16);
          for (int i = (int)blockIdx.x * (NWAVES * 64) + F.tid; i < n16; i += F.G * NWAVES * 64) z[i] = (v4u){0u, 0u, 0u, 0u}; }
        cg::this_grid().sync();
    }
    XcdBarrier bar = xcd_barrier_post((unsigned*)(ws + WS_CTL) + CW_BAR, (volatile LAS unsigned*)(F.lds + MISC_OFF) + 8);
#ifndef ONLY_PHASE
#define ONLY_PHASE -1
#endif
#define IN(k) ((ONLY_PHASE < 0 || ONLY_PHASE == (k)) && lo <= (k) && (k) < hi)
#define BOTH(k) (IN(k) && IN((k) + 1))
#define GRID_BAR() xcd_barrier(bar)
    float* ssq1 = (float*)(ws + WS_SSQ1); float* ssq2 = (float*)(ws + WS_SSQ2);
    pg8::bf16_t* ACT = (pg8::bf16_t*)(ws + WS_RC + 64 * MiB);
    pg8::bf16_t* RA = (pg8::bf16_t*)(ws + WS_RA); pg8::bf16_t* RB = (pg8::bf16_t*)(ws + WS_RB); pg8::bf16_t* RC = (pg8::bf16_t*)(ws + WS_RC);

    if (IN(0)) { for (int rep = 0; rep < REPS(0); ++rep) p0_prologue(F); if (BOTH(0)) GRID_BAR(); }
    if (IN(1)) {
        pg8::Gemm gq{RA, (const pg8::bf16_t*)(ws + WS_WIN), M, 4096, DM}; RangeOrder Sq; Sq.init(M, 4096, F.G, (int)blockIdx.x);
        pg8::EpiQKV Eq{RC, (const float*)(ws + WS_CS), QSCALE, (float*)(ws + WS_KSUM), 0, 1.f, (const float*)(ws + WS_RINV0)};
        pg8::Gemm gv{RB, (const pg8::bf16_t*)(ws + WS_WV8), M, 2048, DM / 2}; RangeOrder Sv; Sv.init(M, 2048, F.G, (int)blockIdx.x);
        pg8::EpiQKV Ev{RC, (const float*)(ws + WS_CS), QSCALE, (float*)(ws + WS_KSUM), 1, 1.f / (S_XN * S_WV), (const float*)(ws + WS_RINV0)};
        for (int rep = 0; rep < REPS(1); ++rep) {
        const bool grp = ((blockIdx.x >> 3) & 1) != 0;
        Sq.i0 = 0; Sq.n = 1 << 20;
        if (grp) { Sv.i0 = 0; Sv.n = 1; pg8::gemm_phase<pg8::EpiQKV, RangeOrder, true, true, true>(F.lds, gv, Sv, Ev); }
        pg8::gemm_phase<pg8::EpiQKV, RangeOrder, true, true>(F.lds, gq, Sq, Eq);
        Sv.i0 = grp ? 1 : 0; Sv.n = 1 << 20;
        pg8::gemm_phase<pg8::EpiQKV, RangeOrder, true, true, true>(F.lds, gv, Sv, Ev);
        }
        if (BOTH(1)) GRID_BAR();
    }
    if (IN(3)) {
        const att::bf16* qkv = (const att::bf16*)RC; att::bf16* ob = (att::bf16*)RB; const float* kmean = (const float*)(ws + WS_KSUM);
        constexpr size_t HSZ = (size_t)SEQ * HD;
        for (int rep = 0; rep < REPS(3); ++rep) {
        if (rep == 0 || (REPEAT_WHICH & 1))
        for (int vv = F.vcu; vv < 256; vv += F.G) { const int bh = vv >> 2, s = vv & 3, b = bh >> 3, h = bh & 7; const size_t rb = (size_t)b * SEQ; const att::bf16* hb = qkv + ((size_t)b * 48 + h) * HSZ;
            for (int i = 0; i < 2; ++i) { const int qb = i ? s : 7 - s; const size_t r0 = rb + (size_t)qb * 256;
                if (WOUT_FP8) att::attn_unit<2, true>(hb + (size_t)qb * 256 * HD, HD, hb + 8 * HSZ, hb + 16 * HSZ, HD, (att::bf16*)((unsigned char*)ob + r0 * DM + h * HD), DM, F.g_out_sb + h * HD, nullptr, qb, 0, (char*)lds, S_O);
                else att::attn_unit<2>(hb + (size_t)qb * 256 * HD, HD, hb + 8 * HSZ, hb + 16 * HSZ, HD, ob + r0 * DM + h * HD, DM, F.g_out_sb + h * HD, nullptr, qb, 0, (char*)lds); } }
        if (rep == 0 || (REPEAT_WHICH & 2))
        for (int vv = F.vcu; vv < 256; vv += F.G) { const int bh = vv >> 2, s = vv & 3, b = bh >> 3, h = bh & 7; const size_t rb = (size_t)b * SEQ; const att::bf16* hb = qkv + ((size_t)b * 48 + 24 + h) * HSZ;
            for (int i = 0; i < 2; ++i) { const int qb = i ? s : 7 - s; const size_t r0 = rb + (size_t)qb * 256;
                if (WOUT_FP8) att::attn_unit<1, true>(hb + (size_t)qb * 256 * HD, HD, hb + 8 * HSZ, hb + 16 * HSZ, HD, (att::bf16*)((unsigned char*)ob + r0 * DM + NH * HD + h * HD), DM, F.g_out_mb + h * HD, kmean + (size_t)bh * 1024, qb, 0, (char*)lds, S_O);
                else att::attn_unit<1>(hb + (size_t)qb * 256 * HD, HD, hb + 8 * HSZ, hb + 16 * HSZ, HD, ob + r0 * DM + NH * HD + h * HD, DM, F.g_out_mb + h * HD, kmean + (size_t)bh * 1024, qb, 0, (char*)lds); } }
        }
        if (BOTH(3)) GRID_BAR();
    }
    if (IN(4)) {
        pg8::Gemm g{RB, (const pg8::bf16_t*)(ws + WS_WOUT), M, DM, WOUT_FP8 ? DM / 2 : DM}; pg8::StaticOrder S; S.init(M, DM, F.G, (int)blockIdx.x);
        pg8::EpiResB<false> E{RA, RC, ssq1, nullptr, 1.f, WOUT_FP8 ? 1.f / (S_O * S_WO) : 1.f};
        pg8::gemm_phase<pg8::EpiResB<false>, pg8::StaticOrder, true, true, WOUT_FP8 != 0>(F.lds, g, S, E);
        if (BOTH(4)) GRID_BAR();
    }
    if (IN(5)) {
      for (int rep = 0; rep < REPS(5); ++rep) {
        { pg8::Gemm g{RC, (const pg8::bf16_t*)(ws + WS_WXQ), M, WX, DM}; pg8::StaticOrder S; S.init(M, WX, F.G, (int)blockIdx.x);
          pg8::EpiScale E{(pg8::bf16_t*)(ws + WS_QX), WX, ssq1, QSCALE};
          pg8::gemm_phase<pg8::EpiScale, pg8::StaticOrder, true, true>(F.lds, g, S, E); }
        { pg8::Gemm g{(const pg8::bf16_t*)(ws + WS_MN), (const pg8::bf16_t*)(ws + WS_WXKV), MMEM, 2 * WX, DM}; pg8::StaticOrder S; S.init(MMEM, 2 * WX, F.G, (int)((blockIdx.x + F.G - 128) % F.G));
          pg8::EpiScale E{(pg8::bf16_t*)(ws + WS_KVX), 2 * WX, nullptr, 1.0f};
          pg8::gemm_phase<pg8::EpiScale, pg8::StaticOrder, true, true>(F.lds, g, S, E); }
        if (F.G > 160) { if ((int)blockIdx.x >= 160) ffn_weight_items(F, ((int)blockIdx.x - 160) * NWAVES + F.wave, (F.G - 160) * NWAVES); }
        else ffn_weight_items(F, (int)blockIdx.x * NWAVES + F.wave, F.G * NWAVES);
      }
        if (BOTH(5)) GRID_BAR();
    }
    if (IN(6)) {
        const att::bf16* qx = (const att::bf16*)(ws + WS_QX); const att::bf16* kvx = (const att::bf16*)(ws + WS_KVX); att::bf16* ox = (att::bf16*)(ws + WS_OX);
        for (int rep = 0; rep < REPS(6); ++rep) {
        for (int vv = F.vcu; vv < 256; vv += F.G) { const int b = vv >> 5, h = (vv >> 3) & 3, qb = vv & 7; const size_t r0 = (size_t)b * SEQ + (size_t)qb * 256;
            if (WXO_FP8) att::attn_unit<0, true>(qx + r0 * WX + h * HD, WX, kvx + (size_t)b * NMEM * (2 * WX) + h * HD, kvx + (size_t)b * NMEM * (2 * WX) + WX + h * HD, 2 * WX, (att::bf16*)((unsigned char*)ox + r0 * WX + h * HD), WX, nullptr, nullptr, qb, NMEM, (char*)lds, S_OX);
            else att::attn_unit<0>(qx + r0 * WX + h * HD, WX, kvx + (size_t)b * NMEM * (2 * WX) + h * HD, kvx + (size_t)b * NMEM * (2 * WX) + WX + h * HD, 2 * WX, ox + r0 * WX + h * HD, WX, nullptr, nullptr, qb, NMEM, (char*)lds); }
        }
        if (BOTH(6)) GRID_BAR();
    }
    if (IN(7)) {
        pg8::Gemm g{(const pg8::bf16_t*)(ws + WS_OX), (const pg8::bf16_t*)(ws + WS_WXO), M, DM, WXO_FP8 ? WX / 2 : WX}; pg8::StaticOrder S; S.init(M, DM, F.G, (int)blockIdx.x);
        pg8::EpiResB<false> E{RC, RC, ssq2, (unsigned char*)RA, S_X2, WXO_FP8 ? 1.f / (S_OX * S_WXO) : 1.f};
        pg8::gemm_phase<pg8::EpiResB<false>, pg8::StaticOrder, true, true, WXO_FP8 != 0>(F.lds, g, S, E);
        if (BOTH(7)) GRID_BAR();
    }
    if (IN(8)) {
        pg8::Gemm g{RA, (const pg8::bf16_t*)(ws + WS_WGU), M, 2 * FF, FFN_FP8 ? DM / 2 : DM}; pg8::StaticOrder S; S.init(M, 2 * FF, F.G, (int)blockIdx.x);
        pg8::EpiSwiGLU E{ACT, ssq2, FFN_FP8 ? (unsigned char*)ACT : nullptr, FFN_FP8 ? 1.f / (S_X2 * S_WGU) : 1.f, S_ACT};
#if NULL_EPI_PROBE
        if (REPS(8) == 2) { pg8::EpiNull EN{nullptr}; pg8::gemm_phase<pg8::EpiNull, pg8::StaticOrder, true, true, FFN_FP8 != 0>(F.lds, g, S, EN); }
        pg8::gemm_phase<pg8::EpiSwiGLU, pg8::StaticOrder, true, true, FFN_FP8 != 0>(F.lds, g, S, E);
#else
        for (int rep = 0; rep < REPS(8); ++rep) pg8::gemm_phase<pg8::EpiSwiGLU, pg8::StaticOrder, true, true, FFN_FP8 != 0>(F.lds, g, S, E);
#endif
        if (BOTH(8)) GRID_BAR();
    }
    if (IN(9)) {
        pg8::Gemm g{ACT, (const pg8::bf16_t*)(ws + WS_WDN), M, DM, FF / 2}; pg8::StaticOrder S; S.init(M, DM, F.G, (int)blockIdx.x);
        pg8::EpiResB<false> E{RC, RC, nullptr, nullptr, 1.f, 1.f / (S_ACT * S_WDN)};
        pg8::gemm_phase<pg8::EpiResB<false>, pg8::StaticOrder, true, true, true>(F.lds, g, S, E);
        if (BOTH(9)) GRID_BAR();
    }
    if (IN(10)) final_norm_phase(F, RC, F.out);
#undef IN
#undef BOTH
}

extern "C" void kernel_launch(void* const* d_in, const int* in_sizes, int n_in, void* d_out, int out_size, void* d_ws, size_t ws_size, hipStream_t stream) {
    static int grid = 0;
    if (grid == 0) {
        if (n_in != 17 || in_sizes[0] != M * DM || out_size != M * DM || ws_size < WS_END) { fprintf(stderr, "kernel_launch: unexpected shapes (n_in %d in0 %d out %d ws %zu)\n", n_in, n_in > 0 ? in_sizes[0] : -1, out_size, ws_size); grid = -1; return; }
        int dev = 0, cus = 0, per_cu = 0;
        if (hipGetDevice(&dev) != hipSuccess || hipDeviceGetAttribute(&cus, hipDeviceAttributeMultiprocessorCount, dev) != hipSuccess) { grid = -1; return; }
        if (hipFuncSetAttribute((const void*)mk_fwd, hipFuncAttributeMaxDynamicSharedMemorySize, LDS_BYTES) != hipSuccess) { fprintf(stderr, "kernel_launch: hipFuncSetAttribute failed\n"); grid = -1; return; }
        if (hipOccupancyMaxActiveBlocksPerMultiprocessor(&per_cu, (const void*)mk_fwd, NWAVES * 64, LDS_BYTES) != hipSuccess || per_cu < 1) { fprintf(stderr, "kernel_launch: occupancy query failed (%d)\n", per_cu); per_cu = 1; }
        (void)hipGetLastError();
        grid = cus * (per_cu < 1 ? 1 : 1);
    }
    if (grid < 0) return;
#if !MK_ONE_LAUNCH
    (void)hipMemsetAsync((char*)d_ws + WS_CTL, 0, CTL_ZERO_BYTES, stream);
#endif
    Args a{};
    for (int i = 0; i < 17; ++i) a.in[i] = d_in[i];
    a.out = (float*)d_out; a.ws = (unsigned char*)d_ws;
#if MK_ONE_LAUNCH
    a.ph_lo = 0; a.ph_hi = NPH;
    void* kargs[] = {&a};
    hipError_t e = hipLaunchCooperativeKernel((const void*)mk_fwd, dim3(grid), dim3(NWAVES * 64), kargs, LDS_BYTES, stream);
    if (e != hipSuccess) fprintf(stderr, "kernel_launch: cooperative launch failed: %s (grid %d)\n", hipGetErrorString(e), grid);
#else
    for (int p = 0; p < NPH; ++p) { a.ph_lo = p; a.ph_hi = p + 1; hipLaunchKernelGGL(mk_fwd, dim3(grid), dim3(NWAVES * 64), LDS_BYTES, stream, a); }
    const hipError_t le = hipPeekAtLastError();
    if (le != hipSuccess) fprintf(stderr, "kernel_launch: launch failed: %s\n", hipGetErrorName(le));
#endif
}
```

```cpp
#include <hip/hip_runtime.h>
#include <hip/hip_cooperative_groups.h>
#include <cstdio>
#include <cstdint>
namespace cg = cooperative_groups;
namespace pg8 {
#define PG8_LAS __attribute__((address_space(3)))
typedef unsigned short bf16_t;
typedef short bf16x8 __attribute__((ext_vector_type(8)));
typedef float f32x4 __attribute__((ext_vector_type(4)));
typedef unsigned u32x4 __attribute__((ext_vector_type(4)));
constexpr int BM = 256, BK = 64, HALF = 128, HTB = HALF * BK * 2  , STAGE_BYTES = 8 * HTB, NXCD = 8, WGM = 8;

__host__ __device__ __forceinline__ int lds_byte(int r, int c) { const int st = (r >> 4) * 2 + (c >> 5), rr = r & 15, cc = c & 31, ob = rr * 64 + cc * 2; return st * 1024 + (ob ^ (((ob >> 9) & 1) << 5)); }
__host__ __device__ __forceinline__ void stage_rc(int b, int& R, int& C) { const int st = b / 1024, sb = b % 1024, swz = sb ^ (((sb >> 9) & 1) << 5); R = (st >> 1) * 16 + swz / 64; C = (st & 1) * 32 + (swz % 64) / 2; }
__host__ __device__ __forceinline__ int perm32(int rho) { const int n = rho >> 4, i = rho & 15; return 8 * (i >> 2) + 4 * n + (i & 3); }

struct Unit { int pm, pn; };
struct Gemm { const bf16_t* A; const bf16_t* Bt; int M, N, K; };

struct StaticOrder {
    int nM, nN, nwg, G, c;
    __host__ __device__ void init(int M, int N, int G_, int c_) { nM = M / BM; nN = N / BM; nwg = nM * nN; G = G_; c = c_; }
    __host__ __device__ bool next(int i, Unit& u) const {
        const long L = (long)i * G + c; if (L >= nwg) return false;
        int wgid = (int)L; { const int q = nwg / NXCD, r = nwg % NXCD, xcd = wgid % NXCD, off = wgid / NXCD; wgid = (xcd < r ? xcd * (q + 1) : r * (q + 1) + (xcd - r) * q) + off; }
        const int nig = WGM * nN, gid = wgid / nig, fm = gid * WGM, gsz = (nM - fm) < WGM ? (nM - fm) : WGM;
        u.pm = fm + ((wgid % nig) % gsz); u.pn = (wgid % nig) / gsz; return true;
    }
    __device__ __forceinline__ void a_ready(const Unit&) const {}
    __device__ __forceinline__ void done(const Unit&) const {}
};

__device__ __forceinline__ unsigned cvt_pk_bf16(float lo, float hi) { unsigned r; asm volatile("v_cvt_pk_bf16_f32 %0, %1, %2" : "=v"(r) : "v"(lo), "v"(hi)); return r; }
typedef float f32x2 __attribute__((ext_vector_type(2)));
template <class Epi, class Sched, bool ALIGN_EPI = false, bool SP2 = false, bool FP8 = false>
__device__ __forceinline__ void gemm_phase(PG8_LAS unsigned char* lds, const Gemm g, const Sched& S, const Epi& E) {
    int tid_ = threadIdx.x; asm volatile("" : "+v"(tid_));
    const int tid = tid_, wid = __builtin_amdgcn_readfirstlane(tid >> 6), lane = tid & 63, wr = wid >> 2, wc = wid & 3, fr = lane & 15, fq = lane >> 4;
    const int K = g.K, nt = K / BK;
    unsigned voffA[2], voffB[2];
#pragma unroll
    for (int i = 0; i < 2; ++i) { int R, C; stage_rc(tid * 16 + i * 8192, R, C); const int Rb = Epi::PERM ? ((R & ~31) + perm32(R & 31)) : R;
        voffA[i] = (unsigned)(R * K + C) * 2u; voffB[i] = (unsigned)(Rb * K + C) * 2u; }
    const size_t kstep = (size_t)(BK * 2);
    const size_t hstep = (size_t)HALF * K * 2;
    const size_t tstep = 2 * hstep;
    const unsigned ldsw = (unsigned)wid * 1024u;
    const int aoff = lds_byte(wr * 64 + fr, fq * 8), boff = lds_byte(wc * 32 + fr, fq * 8);
#define PG8_SA(b, h) (((b) * 2 + (h)) * HTB)
#define PG8_SB(b, h) ((4 + (b) * 2 + (h)) * HTB)
#define PG8_STAGE(bufoff, gbase, voff) do { _Pragma("unroll") for (int _i = 0; _i < 2; ++_i) \
        __builtin_amdgcn_global_load_lds((const unsigned*)((const char*)(gbase) + (voff)[_i]), (PG8_LAS unsigned*)(lds + (bufoff) + ldsw + _i * 8192), 16, 0, 0); } while (0)
#define PG8_LD8(p) __builtin_shufflevector(*(const PG8_LAS i32x4_*)(p), *(const PG8_LAS i32x4_*)((p) + 1024), 0, 1, 2, 3, 4, 5, 6, 7)
#define PG8_LDA(dst, b, h) do { if constexpr (FP8) { _Pragma("unroll") for (int m = 0; m < 4; ++m) dst##8[m] = PG8_LD8(lds + PG8_SA(b, h) + aoff + m * 2048); } \
        else { _Pragma("unroll") for (int m = 0; m < 4; ++m) _Pragma("unroll") for (int k = 0; k < 2; ++k) dst[m][k] = *(const PG8_LAS bf16x8*)(lds + PG8_SA(b, h) + aoff + m * 2048 + k * 1024); } } while (0)
#define PG8_LDB(dst, b, h) do { if constexpr (FP8) { _Pragma("unroll") for (int n = 0; n < 2; ++n) dst##8[n] = PG8_LD8(lds + PG8_SB(b, h) + boff + n * 2048); } \
        else { _Pragma("unroll") for (int n = 0; n < 2; ++n) _Pragma("unroll") for (int k = 0; k < 2; ++k) dst[n][k] = *(const PG8_LAS bf16x8*)(lds + PG8_SB(b, h) + boff + n * 2048 + k * 1024); } } while (0)
#define PG8_MMA(ai, bj, At, Bt) do { __builtin_amdgcn_s_setprio(1); _Pragma("unroll") for (int m = 0; m < 4; ++m) _Pragma("unroll") for (int n = 0; n < 2; ++n) { \
        if constexpr (FP8) asm volatile("v_mfma_scale_f32_16x16x128_f8f6f4 %0, %1, %2, %0, %3, %3 op_sel_hi:[0,0,0]" : "+v"(acc[ai][bj][m][n]) : "v"(Bt##8[n]), "v"(At##8[m]), "v"(sc1_)); \
        else { _Pragma("unroll") for (int k = 0; k < 2; ++k) acc[ai][bj][m][n] = __builtin_amdgcn_mfma_f32_16x16x32_bf16(Bt[n][k], At[m][k], acc[ai][bj][m][n], 0, 0, 0); } } \
        __builtin_amdgcn_s_setprio(0); } while (0)
#define PG8_WAIT_V(n) asm volatile("s_waitcnt vmcnt(" #n ")" ::: "memory")
#define PG8_WAIT_L(n) asm volatile("s_waitcnt lgkmcnt(" #n ")" ::: "memory")
#define PG8_BAR __builtin_amdgcn_s_barrier()
#define PG8_SCHED __builtin_amdgcn_sched_barrier(0)
    Unit cur, nxt; int ui = 0;
    if (!S.next(0, cur)) return;
    f32x4 acc[2][2][4][2];
#pragma unroll
    for (int a = 0; a < 2; ++a)
#pragma unroll
        for (int b = 0; b < 2; ++b)
#pragma unroll
            for (int m = 0; m < 4; ++m)
#pragma unroll
                for (int n = 0; n < 2; ++n) acc[a][b][m][n] = (f32x4){0.f, 0.f, 0.f, 0.f};
    typedef int i32x4_ __attribute__((ext_vector_type(4))); typedef int i32x8_ __attribute__((ext_vector_type(8)));
    int sc1_ = 0x7F7F7F7F; asm volatile("" : "+v"(sc1_));
    bf16x8 At[4][2], B0[2][2], B1[2][2]; i32x8_ At8[4], B08[2], B18[2];
    const char* cA = (const char*)g.A + (size_t)cur.pm * tstep; const char* cB = (const char*)g.Bt + (size_t)cur.pn * tstep;
    S.a_ready(cur);
    if constexpr (SP2) {
        PG8_STAGE(PG8_SB(0, 0), cB, voffB); PG8_STAGE(PG8_SB(0, 1), cB + hstep, voffB); PG8_STAGE(PG8_SA(0, 0), cA, voffA); PG8_STAGE(PG8_SA(0, 1), cA + hstep, voffA);
        if (wr == 1) PG8_BAR;
        PG8_WAIT_V(2); PG8_BAR;
        PG8_STAGE(PG8_SB(1, 0), cB + kstep, voffB); PG8_STAGE(PG8_SA(1, 0), cA + kstep, voffA); PG8_STAGE(PG8_SB(1, 1), cB + hstep + kstep, voffB);
        PG8_WAIT_V(6); PG8_BAR;
    } else {
        PG8_STAGE(PG8_SB(0, 0), cB, voffB); PG8_STAGE(PG8_SA(0, 0), cA, voffA); PG8_STAGE(PG8_SB(0, 1), cB + hstep, voffB); PG8_STAGE(PG8_SA(0, 1), cA + hstep, voffA);
        if (wr == 1) PG8_BAR;
        PG8_WAIT_V(4); PG8_BAR;
        PG8_STAGE(PG8_SB(1, 0), cB + kstep, voffB); PG8_STAGE(PG8_SA(1, 0), cA + kstep, voffA); PG8_STAGE(PG8_SB(1, 1), cB + hstep + kstep, voffB);
        PG8_WAIT_V(6); PG8_BAR;
    }
    for (;;) {
        const bool has_next = S.next(ui + 1, nxt);
        const char* nA = has_next ? (const char*)g.A + (size_t)nxt.pm * tstep : cA; const char* nB = has_next ? (const char*)g.Bt + (size_t)nxt.pn * tstep : cB;
        for (int t = 0; t < nt; t += 2) {
            const bool last = (t == nt - 2);
            const char* a1 = cA + (size_t)(t + 1) * kstep;
            const char* a2 = last ? nA : cA + (size_t)(t + 2) * kstep; const char* b2 = last ? nB : cB + (size_t)(t + 2) * kstep;
            const char* a3 = a2 + kstep; const char* b3 = b2 + kstep;
            if (last && has_next) S.a_ready(nxt);
            if constexpr (SP2) {
            PG8_LDB(B0, 0, 0); PG8_LDB(B1, 0, 1); PG8_SCHED; PG8_LDA(At, 0, 0); PG8_STAGE(PG8_SA(1, 1), a1 + hstep, voffA);
            PG8_WAIT_V(8); PG8_WAIT_L(0); PG8_BAR; PG8_MMA(0, 0, At, B0); PG8_MMA(0, 1, At, B1); PG8_BAR; PG8_SCHED;
            PG8_LDA(At, 0, 1); PG8_STAGE(PG8_SB(0, 0), b2, voffB); PG8_STAGE(PG8_SB(0, 1), b2 + hstep, voffB); PG8_STAGE(PG8_SA(0, 0), a2, voffA);
            PG8_WAIT_V(8); PG8_WAIT_L(0); PG8_BAR; PG8_MMA(1, 0, At, B0); PG8_MMA(1, 1, At, B1); PG8_BAR; PG8_SCHED;
            PG8_LDB(B0, 1, 0); PG8_LDB(B1, 1, 1); PG8_SCHED; PG8_LDA(At, 1, 0); PG8_STAGE(PG8_SA(0, 1), a2 + hstep, voffA);
            PG8_WAIT_V(8); PG8_WAIT_L(0); PG8_BAR; PG8_MMA(0, 0, At, B0); PG8_MMA(0, 1, At, B1); PG8_BAR; PG8_SCHED;
            PG8_LDA(At, 1, 1); PG8_STAGE(PG8_SB(1, 0), b3, voffB); PG8_STAGE(PG8_SB(1, 1), b3 + hstep, voffB); PG8_STAGE(PG8_SA(1, 0), a3, voffA);
            PG8_WAIT_V(8); PG8_WAIT_L(0); PG8_BAR; PG8_MMA(1, 0, At, B0); PG8_MMA(1, 1, At, B1); PG8_BAR; PG8_SCHED;
            } else {
            PG8_LDB(B0, 0, 0); PG8_SCHED; PG8_LDA(At, 0, 0); PG8_STAGE(PG8_SA(1, 1), a1 + hstep, voffA);
            PG8_WAIT_L(8); PG8_BAR; PG8_WAIT_L(0); PG8_MMA(0, 0, At, B0); PG8_BAR; PG8_SCHED;
            PG8_LDB(B1, 0, 1); PG8_STAGE(PG8_SB(0, 0), b2, voffB);
            PG8_BAR; PG8_WAIT_L(0); PG8_MMA(0, 1, At, B1); PG8_BAR;
            PG8_LDA(At, 0, 1); PG8_STAGE(PG8_SA(0, 0), a2, voffA);
            PG8_BAR; PG8_WAIT_L(0); PG8_MMA(1, 0, At, B0); PG8_BAR; PG8_SCHED;
            PG8_STAGE(PG8_SB(0, 1), b2 + hstep, voffB);
            PG8_WAIT_V(6); PG8_BAR; PG8_MMA(1, 1, At, B1); PG8_BAR;
            PG8_LDB(B0, 1, 0); PG8_SCHED; PG8_LDA(At, 1, 0); PG8_STAGE(PG8_SA(0, 1), a2 + hstep, voffA);
            PG8_WAIT_L(8); PG8_BAR; PG8_WAIT_L(0); PG8_MMA(0, 0, At, B0); PG8_BAR; PG8_SCHED;
            PG8_LDB(B1, 1, 1); PG8_STAGE(PG8_SB(1, 0), b3, voffB);
            PG8_BAR; PG8_WAIT_L(0); PG8_MMA(0, 1, At, B1); PG8_BAR;
            PG8_LDA(At, 1, 1); PG8_STAGE(PG8_SA(1, 0), a3, voffA);
            PG8_BAR; PG8_WAIT_L(0); PG8_MMA(1, 0, At, B0); PG8_BAR; PG8_SCHED;
            PG8_STAGE(PG8_SB(1, 1), b3 + hstep, voffB);
            PG8_WAIT_V(6); PG8_BAR; PG8_MMA(1, 1, At, B1); PG8_BAR;
            }
        }
        if constexpr (ALIGN_EPI) { if (wr == 0) PG8_BAR; }
        if constexpr (FP8) asm volatile("s_nop 15\n\ts_nop 15" ::: "memory");
        if constexpr (!Epi::AFTER_DRAIN) { E(acc, cur, wr, wc, fr, fq); S.done(cur); }
        if (!has_next) break;
#pragma unroll
        for (int a = 0; a < 2; ++a)
#pragma unroll
            for (int b = 0; b < 2; ++b)
#pragma unroll
                for (int m = 0; m < 4; ++m)
#pragma unroll
                    for (int n = 0; n < 2; ++n) acc[a][b][m][n] = (f32x4){0.f, 0.f, 0.f, 0.f};
        cur = nxt; cA = nA; cB = nB; ++ui;
        if constexpr (ALIGN_EPI) { if (wr == 1) PG8_BAR; }
    }
    PG8_WAIT_V(0);
    if constexpr (!ALIGN_EPI) { if (wr == 0) PG8_BAR; }
    PG8_BAR;
    if constexpr (Epi::AFTER_DRAIN) { E.fused(acc, cur, wr, wc, fr, fq, lds, wid, lane); S.done(cur); }
#undef PG8_SA
#undef PG8_SB
#undef PG8_STAGE
#undef PG8_LDA
#undef PG8_LD8
#undef PG8_LDB
#undef PG8_MMA
#undef PG8_WAIT_V
#undef PG8_WAIT_L
#undef PG8_BAR
#undef PG8_SCHED
}
}
namespace pg8 {
typedef unsigned u32x2 __attribute__((ext_vector_type(2)));
constexpr int LDX = 2048;
constexpr float RMS_EPS = 1e-6f;
#ifndef EPI_SC1
#define EPI_SC1 1
#endif
__device__ __forceinline__ void store16(void* p, u32x4 w) {
#if EPI_SC1
    asm volatile("global_store_dwordx4 %0, %1, off sc1\n\ts_nop 1" :: "v"(p), "v"(w) : "memory");
#else
    *(u32x4*)p = w;
#endif
}
struct EpiQKV {
    static constexpr bool PERM = true, AFTER_DRAIN = false;
    bf16_t* O; const float* cs; float qscale; float* ksum; int vmode; float vscale; const float* rinv;
    __device__ __forceinline__ void operator()(const f32x4 (&acc)[2][2][4][2], const Unit& u, int wr, int wc, int fr, int fq) const {
        const int row0 = u.pm * BM + wr * 64 + fr, pn = vmode ? (u.pn < 4 ? u.pn + 8 : u.pn + 16) : (u.pn < 8 ? u.pn : u.pn + 4);
        const float sc = (pn < 4 || (pn >= 12 && pn < 16)) ? qscale : vscale;
        const bool rot = (pn >= 12 && pn < 20) && (wc == 0);
        bf16_t* Ot = O + ((size_t)((u.pm >> 3) * 6 + (pn >> 2)) * 8 + (pn & 3) * 2) * (2048 * 128) + wc * 32 + 8 * fq;
        const bool kacc = (pn >= 16 && pn < 20);
        float rf[2][4];
#pragma unroll
        for (int ai = 0; ai < 2; ++ai)
#pragma unroll
            for (int m = 0; m < 4; ++m) rf[ai][m] = rinv[row0 + ai * HALF + m * 16];
        f32x4 ks[2][2] = {{{0.f, 0.f, 0.f, 0.f}, {0.f, 0.f, 0.f, 0.f}}, {{0.f, 0.f, 0.f, 0.f}, {0.f, 0.f, 0.f, 0.f}}};
#pragma unroll
        for (int ai = 0; ai < 2; ++ai)
#pragma unroll
            for (int m = 0; m < 4; ++m) { const int row = row0 + ai * HALF + m * 16; bf16_t* rowp = Ot + (size_t)(row & 2047) * 128;
                f32x4 c0 = {1.f, 1.f, 1.f, 1.f}, c1 = c0, s0 = {0.f, 0.f, 0.f, 0.f}, s1 = s0;
                if (rot) { const float* cr = cs + (size_t)row * 32 + 8 * (fq & 1); c0 = *(const f32x4*)cr; c1 = *(const f32x4*)(cr + 4); s0 = *(const f32x4*)(cr + 16); s1 = *(const f32x4*)(cr + 20);
                    if (fq < 2) { s0 = -s0; s1 = -s1; } }
#pragma unroll
                for (int bj = 0; bj < 2; ++bj) { f32x4 v0 = acc[ai][bj][m][0] * rf[ai][m], v1 = acc[ai][bj][m][1] * rf[ai][m];
                    if (rot) { f32x4 p0, p1;
#pragma unroll
                        for (int j = 0; j < 4; ++j) { p0[j] = __shfl_xor(v0[j], 32); p1[j] = __shfl_xor(v1[j], 32); }
                        v0 = v0 * c0 + p0 * s0; v1 = v1 * c1 + p1 * s1; }
                    if (kacc) { ks[bj][0] += v0; ks[bj][1] += v1; }
                    v0 = v0 * sc; v1 = v1 * sc; u32x4 w; w.x = cvt_pk_bf16(v0[0], v0[1]); w.y = cvt_pk_bf16(v0[2], v0[3]); w.z = cvt_pk_bf16(v1[0], v1[1]); w.w = cvt_pk_bf16(v1[2], v1[3]);
                    store16(rowp + (size_t)bj * (2048 * 128), w); } }
        if (kacc) {
            float* kp = ksum + (size_t)(((u.pm >> 3) * 8 + (pn - 16) * 2) * 8 + (u.pm & 7)) * 128 + wc * 32 + 8 * fq;
#pragma unroll
            for (int bj = 0; bj < 2; ++bj)
#pragma unroll
                for (int n = 0; n < 2; ++n)
#pragma unroll
                    for (int j = 0; j < 4; ++j) { float s = ks[bj][n][j]; s += __shfl_xor(s, 1); s += __shfl_xor(s, 2); s += __shfl_xor(s, 4); s += __shfl_xor(s, 8);
                        if (fr == 0) atomicAdd(kp + bj * 1024 + n * 4 + j, s); }
        }
    }
};
__device__ __forceinline__ unsigned pk4_fp8(float a, float b, float c, float d) {
    a = __builtin_amdgcn_fmed3f(a, -448.f, 448.f); b = __builtin_amdgcn_fmed3f(b, -448.f, 448.f); c = __builtin_amdgcn_fmed3f(c, -448.f, 448.f); d = __builtin_amdgcn_fmed3f(d, -448.f, 448.f);
    int p = __builtin_amdgcn_cvt_pk_fp8_f32(a, b, 0, false); p = __builtin_amdgcn_cvt_pk_fp8_f32(c, d, p, true); return (unsigned)p; }
struct EpiRes {
    static constexpr bool PERM = false, AFTER_DRAIN = false;
    const float* base; float* out; bf16_t* xb; float* ssq; unsigned char* x8; float s8; float ascale;
    __device__ __forceinline__ void operator()(const f32x4 (&acc)[2][2][4][2], const Unit& u, int wr, int wc, int fr, int fq) const {
        const int row0 = u.pm * BM + wr * 64 + fr, col0 = u.pn * BM + wc * 32 + 4 * fq;
#pragma unroll
        for (int ai = 0; ai < 2; ++ai)
#pragma unroll
            for (int m = 0; m < 4; ++m) { const int row = row0 + ai * HALF + m * 16; const size_t off = (size_t)row * LDX + col0; float s = 0.f;
#pragma unroll
                for (int bj = 0; bj < 2; ++bj)
#pragma unroll
                    for (int n = 0; n < 2; ++n) { const f32x4 v = *(const f32x4*)(base + off + bj * HALF + n * 16) + acc[ai][bj][m][n] * ascale;
                        *(f32x4*)(out + off + bj * HALF + n * 16) = v; s += (v[0] * v[0] + v[1] * v[1]) + (v[2] * v[2] + v[3] * v[3]);
                        if (xb) { u32x2 w; w.x = cvt_pk_bf16(v[0], v[1]); w.y = cvt_pk_bf16(v[2], v[3]); *(u32x2*)(xb + off + bj * HALF + n * 16) = w; }
                        if (x8) { *(unsigned*)(x8 + off + bj * HALF + n * 16) = pk4_fp8(v[0] * s8, v[1] * s8, v[2] * s8, v[3] * s8); } }
                if (ssq) { s += __shfl_xor(s, 16); s += __shfl_xor(s, 32); if (fq == 0) atomicAdd(ssq + row, s); }
                asm volatile("" ::: "memory"); }
    }
};
template <bool BASE_F32> struct EpiResB {
    static constexpr bool PERM = true, AFTER_DRAIN = false;
    const void* base; bf16_t* xo; float* ssq; unsigned char* x8; float s8; float ascale;
    __device__ __forceinline__ void operator()(const f32x4 (&acc)[2][2][4][2], const Unit& u, int wr, int wc, int fr, int fq) const {
        const int row0 = u.pm * BM + wr * 64 + fr, col0 = u.pn * BM + wc * 32 + 8 * fq;
#pragma unroll
        for (int ai = 0; ai < 2; ++ai)
#pragma unroll
            for (int m = 0; m < 4; ++m) { const int row = row0 + ai * HALF + m * 16; const size_t off = (size_t)row * LDX + col0; float s = 0.f;
#pragma unroll
                for (int bj = 0; bj < 2; ++bj) { f32x4 b0, b1;
                    if (BASE_F32) { const float* bp = (const float*)base + off + bj * HALF; b0 = *(const f32x4*)bp; b1 = *(const f32x4*)(bp + 4); }
                    else { const u32x4 w = *(const u32x4*)((const bf16_t*)base + off + bj * HALF);
                        b0 = (f32x4){__uint_as_float(w.x << 16), __uint_as_float(w.x & 0xffff0000u), __uint_as_float(w.y << 16), __uint_as_float(w.y & 0xffff0000u)};
                        b1 = (f32x4){__uint_as_float(w.z << 16), __uint_as_float(w.z & 0xffff0000u), __uint_as_float(w.w << 16), __uint_as_float(w.w & 0xffff0000u)}; }
                    const f32x4 v0 = b0 + acc[ai][bj][m][0] * ascale, v1 = b1 + acc[ai][bj][m][1] * ascale;
                    s += ((v0[0] * v0[0] + v0[1] * v0[1]) + (v0[2] * v0[2] + v0[3] * v0[3])) + ((v1[0] * v1[0] + v1[1] * v1[1]) + (v1[2] * v1[2] + v1[3] * v1[3]));
                    if (xo) { u32x4 w; w.x = cvt_pk_bf16(v0[0], v0[1]); w.y = cvt_pk_bf16(v0[2], v0[3]); w.z = cvt_pk_bf16(v1[0], v1[1]); w.w = cvt_pk_bf16(v1[2], v1[3]); store16(xo + off + bj * HALF, w); }
                    if (x8) { u32x2 w8; w8.x = pk4_fp8(v0[0] * s8, v0[1] * s8, v0[2] * s8, v0[3] * s8); w8.y = pk4_fp8(v1[0] * s8, v1[1] * s8, v1[2] * s8, v1[3] * s8); *(u32x2*)(x8 + off + bj * HALF) = w8; } }
                if (ssq) { s += __shfl_xor(s, 16); s += __shfl_xor(s, 32); if (fq == 0) atomicAdd(ssq + row, s); }
                if (BASE_F32 ? (m & 1) : (m == 3)) asm volatile("" ::: "memory"); }
    }
};
struct EpiScale {
    static constexpr bool PERM = true, AFTER_DRAIN = false;
    bf16_t* O; int ldc; const float* ssq; float sc;
    __device__ __forceinline__ void operator()(const f32x4 (&acc)[2][2][4][2], const Unit& u, int wr, int wc, int fr, int fq) const {
        const int row0 = u.pm * BM + wr * 64 + fr, col0 = u.pn * BM + wc * 32 + 8 * fq;
        float sv[2][4];
#pragma unroll
        for (int ai = 0; ai < 2; ++ai)
#pragma unroll
            for (int m = 0; m < 4; ++m) sv[ai][m] = ssq ? ssq[row0 + ai * HALF + m * 16] : 0.f;
#pragma unroll
        for (int ai = 0; ai < 2; ++ai)
#pragma unroll
            for (int m = 0; m < 4; ++m) { const int row = row0 + ai * HALF + m * 16; bf16_t* rowp = O + (size_t)row * ldc + col0;
                const float f = ssq ? sc * __builtin_amdgcn_rsqf(sv[ai][m] * (1.0f / 2048.0f) + RMS_EPS) : sc;
#pragma unroll
                for (int bj = 0; bj < 2; ++bj) { const f32x4 v0 = acc[ai][bj][m][0] * f, v1 = acc[ai][bj][m][1] * f;
                    u32x4 w; w.x = cvt_pk_bf16(v0[0], v0[1]); w.y = cvt_pk_bf16(v0[2], v0[3]); w.z = cvt_pk_bf16(v1[0], v1[1]); w.w = cvt_pk_bf16(v1[2], v1[3]);
                    *(u32x4*)(rowp + bj * HALF) = w; } }
    }
};
struct EpiNull { static constexpr bool PERM = true, AFTER_DRAIN = false; float* sink;
    __device__ __forceinline__ void operator()(const f32x4 (&acc)[2][2][4][2], const Unit& u, int wr, int wc, int fr, int fq) const {
#pragma unroll
        for (int ai = 0; ai < 2; ++ai)
#pragma unroll
            for (int bj = 0; bj < 2; ++bj)
#pragma unroll
                for (int m = 0; m < 4; ++m)
#pragma unroll
                    for (int n = 0; n < 2; ++n) asm volatile("" :: "v"(acc[ai][bj][m][n])); } };
struct EpiSwiGLU {
    static constexpr bool PERM = true, AFTER_DRAIN = false;
    bf16_t* O; const float* ssq; unsigned char* O8; float ascale, oscale;
    __device__ __forceinline__ void operator()(const f32x4 (&acc)[2][2][4][2], const Unit& u, int wr, int wc, int fr, int fq) const {
        const int row0 = u.pm * BM + wr * 64 + fr, col0 = u.pn * HALF + wc * 32 + 8 * fq;
        float sv[2][4];
#pragma unroll
        for (int ai = 0; ai < 2; ++ai)
#pragma unroll
            for (int m = 0; m < 4; ++m) sv[ai][m] = ssq[row0 + ai * HALF + m * 16];
#pragma unroll
        for (int ai = 0; ai < 2; ++ai)
#pragma unroll
            for (int m = 0; m < 4; ++m) { const int row = row0 + ai * HALF + m * 16; bf16_t* rowp = O + (size_t)row * 5632 + col0;
                const float f = ascale * __builtin_amdgcn_rsqf(sv[ai][m] * (1.0f / 2048.0f) + RMS_EPS);
                const float fneg = -1.4426950408889634f * f, f2o = f * f * (O8 ? oscale : 1.0f);
                float r[8];
#pragma unroll
                for (int n = 0; n < 2; ++n)
#pragma unroll
                    for (int j = 0; j < 4; ++j) { const float ag = acc[ai][0][m][n][j], au = acc[ai][1][m][n][j];
                        r[n * 4 + j] = (ag * au) * (f2o * __builtin_amdgcn_rcpf(1.0f + __builtin_amdgcn_exp2f(fneg * ag))); }
                if (O8) { u32x2 w8; w8.x = pk4_fp8(r[0], r[1], r[2], r[3]); w8.y = pk4_fp8(r[4], r[5], r[6], r[7]);
                    *(u32x2*)(O8 + (size_t)row * 5632 + col0) = w8; }
                else { u32x4 w; w.x = cvt_pk_bf16(r[0], r[1]); w.y = cvt_pk_bf16(r[2], r[3]); w.z = cvt_pk_bf16(r[4], r[5]); w.w = cvt_pk_bf16(r[6], r[7]);
                *(u32x4*)rowp = w; } }
    }
};
}
namespace att {
using bf16x8 = __attribute__((ext_vector_type(8))) short;
using s16x4  = __attribute__((ext_vector_type(4))) short;
using f32x16 = __attribute__((ext_vector_type(16))) float;
using f32x4  = __attribute__((ext_vector_type(4))) float;
using u32x4  = __attribute__((ext_vector_type(4))) unsigned;
typedef unsigned short bf16;
constexpr int D = 128, KVBLK = 64;
constexpr int SHM_V = KVBLK * D * 2, SHM_K = KVBLK * D * 2;
constexpr int OFF_Q = 2 * SHM_V + 2 * SHM_K, OFF_WS = 131072 + 1024, OFF_KM = OFF_WS + 2048, ATT_LDS = OFF_KM + 4096;
constexpr float THR = 8.f;
constexpr float SB_DONE = 7.8886e-31f;
#ifndef QREG_SOFTMAX
#define QREG_SOFTMAX 1
#endif
#ifndef PIPE_SOFTMAX
#define PIPE_SOFTMAX 0
#endif
#define KSWZ(row, colB) ((row) * 256 + ((colB) ^ (((row) & 7) << 4)))
#define SBAR() __builtin_amdgcn_sched_barrier(0)
__device__ __forceinline__ int crow(int r, int hi) { return (r & 3) + 8 * (r >> 2) + 4 * hi; }
__device__ __forceinline__ unsigned cvtpk(float lo, float hi) { unsigned r; asm volatile("v_cvt_pk_bf16_f32 %0, %1, %2" : "=v"(r) : "v"(lo), "v"(hi)); return r; }
__device__ __forceinline__ float xchg32(float x, int hi) { auto rr = __builtin_amdgcn_permlane32_swap(__float_as_uint(x), __float_as_uint(x), false, false); return __uint_as_float(hi ? rr[0] : rr[1]); }
typedef __attribute__((address_space(3))) const char* lds_cp;
template <int D0> __device__ __forceinline__ void qkt_part(f32x16& p0, f32x16& p1, const lds_cp (&ka)[2][4], int boff, const lds_cp (&qa)[2][4]) {
  const bf16x8 qf = *reinterpret_cast<const __attribute__((address_space(3))) bf16x8*>(qa[D0 >> 2][D0 & 3]);
  const bf16x8 b0 = *reinterpret_cast<const __attribute__((address_space(3))) bf16x8*>(ka[D0 >> 2][D0 & 3] + boff);
  const bf16x8 b1 = *reinterpret_cast<const __attribute__((address_space(3))) bf16x8*>(ka[D0 >> 2][D0 & 3] + boff + 8192);
  p0 = __builtin_amdgcn_mfma_f32_32x32x16_bf16(b0, qf, p0, 0, 0, 0);
  p1 = __builtin_amdgcn_mfma_f32_32x32x16_bf16(b1, qf, p1, 0, 0, 0);
}
template <int D0> __device__ __forceinline__ void qkt_part(f32x16& p0, f32x16& p1, const lds_cp (&ka)[2][4], int boff, const bf16x8 (&qg)[8]) {
  const bf16x8 b0 = *reinterpret_cast<const __attribute__((address_space(3))) bf16x8*>(ka[D0 >> 2][D0 & 3] + boff);
  const bf16x8 b1 = *reinterpret_cast<const __attribute__((address_space(3))) bf16x8*>(ka[D0 >> 2][D0 & 3] + boff + 8192);
  p0 = __builtin_amdgcn_mfma_f32_32x32x16_bf16(b0, qg[D0], p0, 0, 0, 0);
  p1 = __builtin_amdgcn_mfma_f32_32x32x16_bf16(b1, qg[D0], p1, 0, 0, 0);
}
#define KLD(G, A0, A1) do { A0 = *reinterpret_cast<const __attribute__((address_space(3))) bf16x8*>(ka[(G) >> 2][(G) & 3] + boff); A1 = *reinterpret_cast<const __attribute__((address_space(3))) bf16x8*>(ka[(G) >> 2][(G) & 3] + boff + 8192); } while (0)
#define KMM(G, A0, A1) do { p0 = __builtin_amdgcn_mfma_f32_32x32x16_bf16(A0, qg[G], p0, 0, 0, 0); p1 = __builtin_amdgcn_mfma_f32_32x32x16_bf16(A1, qg[G], p1, 0, 0, 0); } while (0)
__device__ __forceinline__ void qkt(f32x16& p0, f32x16& p1, const lds_cp (&ka)[2][4], int boff, const bf16x8 (&qg)[8], float bias = 0.f) {
#pragma unroll
  for (int r = 0; r < 16; ++r) { p0[r] = bias; p1[r] = bias; }
  bf16x8 a0, a1, b0, b1, c0, c1, d0, d1;
  KLD(0, a0, a1); KLD(1, b0, b1); KLD(2, c0, c1); KLD(3, d0, d1); SBAR();
  KMM(0, a0, a1); SBAR(); KLD(4, a0, a1); SBAR();
  KMM(1, b0, b1); SBAR(); KLD(5, b0, b1); SBAR();
  KMM(2, c0, c1); SBAR(); KLD(6, c0, c1); SBAR();
  KMM(3, d0, d1); SBAR(); KLD(7, d0, d1); SBAR();
  KMM(4, a0, a1); KMM(5, b0, b1); KMM(6, c0, c1); KMM(7, d0, d1);
}
#undef KLD
#undef KMM
__device__ __forceinline__ void qkt(f32x16& p0, f32x16& p1, const lds_cp (&ka)[2][4], int boff, const lds_cp (&qr)[2][4], float bias = 0.f) {
#pragma unroll
  for (int r = 0; r < 16; ++r) { p0[r] = bias; p1[r] = bias; }
  qkt_part<0>(p0, p1, ka, boff, qr); qkt_part<1>(p0, p1, ka, boff, qr); qkt_part<2>(p0, p1, ka, boff, qr); qkt_part<3>(p0, p1, ka, boff, qr);
  qkt_part<4>(p0, p1, ka, boff, qr); qkt_part<5>(p0, p1, ka, boff, qr); qkt_part<6>(p0, p1, ka, boff, qr); qkt_part<7>(p0, p1, ka, boff, qr);
}
__device__ __forceinline__ int v_st(int k, int c) { const int kk = (k & ~0xC) | ((k & 4) << 1) | ((k & 8) >> 1); return ((kk >> 3) * 4 + (c >> 5)) * 512 + ((kk & 7) * 32 + (c & 31)) * 2; }
__device__ __forceinline__ int v_rd_base(int lane) { return ((lane & 3) << 3) | (((lane >> 2) & 3) << 6) | (((lane >> 4) & 1) << 5) | (((lane >> 5) & 1) << 8); }
constexpr int v_rd_off(int d0, int ks, int half) { return d0 * 512 + ks * 4096 + half * 2048; }
template <int OFF> __device__ __forceinline__ s16x4 tr_read(int vb) { s16x4 r; asm volatile("ds_read_b64_tr_b16 %0, %1 offset:%2" : "=&v"(r) : "v"(vb), "i"(OFF) : "memory"); return r; }
struct VFrag { s16x4 l0, h0, l1, h1, l2, h2, l3, h3; };
template <int D0> __device__ __forceinline__ void v_read(VFrag& f, int vb) {
  f.l0 = tr_read<v_rd_off(D0, 0, 0)>(vb); f.h0 = tr_read<v_rd_off(D0, 0, 1)>(vb); f.l1 = tr_read<v_rd_off(D0, 1, 0)>(vb); f.h1 = tr_read<v_rd_off(D0, 1, 1)>(vb);
  f.l2 = tr_read<v_rd_off(D0, 2, 0)>(vb); f.h2 = tr_read<v_rd_off(D0, 2, 1)>(vb); f.l3 = tr_read<v_rd_off(D0, 3, 0)>(vb); f.h3 = tr_read<v_rd_off(D0, 3, 1)>(vb);
}
__device__ __forceinline__ void pv_mma(f32x16& od, const VFrag& f, bf16x8 pa0, bf16x8 pa1, bf16x8 pa2, bf16x8 pa3) {
#define PK(L, H) (bf16x8){L[0], L[1], L[2], L[3], H[0], H[1], H[2], H[3]}
  od = __builtin_amdgcn_mfma_f32_32x32x16_bf16(pa0, PK(f.l0, f.h0), od, 0, 0, 0);
  od = __builtin_amdgcn_mfma_f32_32x32x16_bf16(pa1, PK(f.l1, f.h1), od, 0, 0, 0);
  od = __builtin_amdgcn_mfma_f32_32x32x16_bf16(pa2, PK(f.l2, f.h2), od, 0, 0, 0);
  od = __builtin_amdgcn_mfma_f32_32x32x16_bf16(pa3, PK(f.l3, f.h3), od, 0, 0, 0);
#undef PK
}
__device__ __forceinline__ void pv_d0(f32x16* o, int vb, bf16x8 pa0, bf16x8 pa1, bf16x8 pa2, bf16x8 pa3) {
  VFrag fa, fb;
  v_read<0>(fa, vb);
  v_read<1>(fb, vb); asm volatile("s_waitcnt lgkmcnt(8)" ::: "memory"); SBAR(); pv_mma(o[0], fa, pa0, pa1, pa2, pa3); SBAR();
  v_read<2>(fa, vb); asm volatile("s_waitcnt lgkmcnt(8)" ::: "memory"); SBAR(); pv_mma(o[1], fb, pa0, pa1, pa2, pa3); SBAR();
  v_read<3>(fb, vb); asm volatile("s_waitcnt lgkmcnt(8)" ::: "memory"); SBAR(); pv_mma(o[2], fa, pa0, pa1, pa2, pa3); SBAR();
  asm volatile("s_waitcnt lgkmcnt(0)" ::: "memory"); SBAR(); pv_mma(o[3], fb, pa0, pa1, pa2, pa3);
}
__device__ __forceinline__ void pack_p(const f32x16& p0, const f32x16& p1, bf16x8& pa0, bf16x8& pa1, bf16x8& pa2, bf16x8& pa3) {
#define PK4(P, BASE, OUT) do { unsigned a0 = cvtpk(P[BASE + 0], P[BASE + 1]), a1 = cvtpk(P[BASE + 2], P[BASE + 3]);   \
    unsigned b0 = cvtpk(P[BASE + 4], P[BASE + 5]), b1 = cvtpk(P[BASE + 6], P[BASE + 7]);                              \
    auto r0 = __builtin_amdgcn_permlane32_swap(a0, b0, false, false); auto r1 = __builtin_amdgcn_permlane32_swap(a1, b1, false, false); \
    u32x4 w = {r0[0], r1[0], r0[1], r1[1]}; OUT = *reinterpret_cast<bf16x8*>(&w); } while (0)
  PK4(p0, 0, pa0); PK4(p0, 8, pa1); PK4(p1, 0, pa2); PK4(p1, 8, pa3);
#undef PK4
}
__device__ __forceinline__ void softmax_tile(f32x16& p0, f32x16& p1, float& m_reg, float& l_reg, float& alpha) {
  float pmax = p0[0];
#pragma unroll
  for (int r = 1; r < 16; ++r) pmax = fmaxf(pmax, p0[r]);
#pragma unroll
  for (int r = 0; r < 16; ++r) pmax = fmaxf(pmax, p1[r]);
  pmax = fmaxf(pmax, xchg32(pmax, (int)(threadIdx.x >> 5) & 1));
  if (__all(pmax - m_reg <= THR)) { alpha = 1.f; }
  else { const float mn = fmaxf(m_reg, pmax); alpha = __builtin_amdgcn_exp2f(m_reg - mn); m_reg = mn; }
  float ps = 0.f;
#pragma unroll
  for (int r = 0; r < 16; ++r) { p0[r] = __builtin_amdgcn_exp2f(p0[r] - m_reg); ps += p0[r]; }
#pragma unroll
  for (int r = 0; r < 16; ++r) { p1[r] = __builtin_amdgcn_exp2f(p1[r] - m_reg); ps += p1[r]; }
  ps += xchg32(ps, (int)(threadIdx.x >> 5) & 1);
  l_reg = l_reg * alpha + ps;
}
template <bool BAND, int I> __device__ __forceinline__ float sb_group(f32x16& P, int kb, int qrel, int hi) {
  float run = 1.f;
#pragma unroll
  for (int e = 3; e >= 0; --e) { const int r = 4 * I + e; float rr = __builtin_amdgcn_rcpf(1.0f + __builtin_amdgcn_exp2f(P[r]));
    if (BAND) rr = (kb + crow(r, hi) < qrel) ? rr : 1.f;
    P[r] = (1.0f - rr) * run; run *= rr; }
  return run;
}
__device__ __forceinline__ void sb_combine(f32x16& p0, f32x16& p1, float (&gs)[8], float& carry, int hi) {
  float acc = 1.f;
#pragma unroll
  for (int i = 7; i >= 0; --i) { const float so_i = acc; acc *= gs[i]; const float x = hi ? acc : so_i; gs[i] = carry * so_i * xchg32(x, hi); }
  carry *= acc * xchg32(acc, hi);
#pragma unroll
  for (int i = 0; i < 4; ++i)
#pragma unroll
    for (int e = 0; e < 4; ++e) { p0[4 * i + e] *= gs[i]; p1[4 * i + e] *= gs[4 + i]; }
}
template <bool BAND>
__device__ __forceinline__ void sb_tile(f32x16& p0, f32x16& p1, float& carry, int kb, int qrel, int hi) {
  float gs[8];
  gs[0] = sb_group<BAND, 0>(p0, kb, qrel, hi); SBAR(); gs[1] = sb_group<BAND, 1>(p0, kb, qrel, hi); SBAR(); gs[2] = sb_group<BAND, 2>(p0, kb, qrel, hi); SBAR(); gs[3] = sb_group<BAND, 3>(p0, kb, qrel, hi); SBAR();
  gs[4] = sb_group<BAND, 0>(p1, kb + 32, qrel, hi); SBAR(); gs[5] = sb_group<BAND, 1>(p1, kb + 32, qrel, hi); SBAR(); gs[6] = sb_group<BAND, 2>(p1, kb + 32, qrel, hi); SBAR(); gs[7] = sb_group<BAND, 3>(p1, kb + 32, qrel, hi); SBAR();
  sb_combine(p0, p1, gs, carry, hi);
}

template <int MODE, bool OUT8 = false>
__device__ __forceinline__ void attn_unit(const bf16* __restrict__ Qb_or_hb, const bf16* __restrict__ Kh_in, const bf16* __restrict__ Vh_in, bf16* __restrict__ Ob,
                                          const float* __restrict__ gain, const float* __restrict__ kmean, int qb, int nkeys, char* lds, float s8 = 1.f,
                                          bool preissued = false, const bf16* __restrict__ nhb = nullptr, int nqb = 0, int nt0 = 0, int nt1 = -1) {
  constexpr int ldq = (MODE == 0) ? 512 : 128, ldk = (MODE == 0) ? 1024 : 128, ldo = (MODE == 0) ? 512 : 2048;
  constexpr long HSZ_ = 2048L * 128L;
  const bf16* __restrict__ Qb = (MODE == 0) ? Qb_or_hb : Qb_or_hb + (long)qb * (256 * 128);
  const bf16* __restrict__ Kh = (MODE == 0) ? Kh_in : Qb_or_hb + 8 * HSZ_;
  const bf16* __restrict__ Vh = (MODE == 0) ? Vh_in : Qb_or_hb + 16 * HSZ_;
  int tid_ = threadIdx.x; asm volatile("" : "+v"(tid_));
  const int tid = tid_, wid = __builtin_amdgcn_readfirstlane(tid >> 6), lane = tid & 63, r32 = lane & 31, hi = lane >> 5;
  char* V_lds = lds; char* K_lds = lds + 2 * SHM_V;
  float* ws = (float*)(lds + OFF_WS) + wid * 64; float* li_l = ws; float* al_l = ws + 32;
  float* km_l = (float*)(lds + OFF_KM);
  int* flg = (int*)(lds + OFF_KM);
  const int NT = (MODE == 0) ? nkeys / KVBLK : 4 * (qb + 1);
  const int qrel = wid * 32 + r32;
  float m_reg = -1e30f, l_reg = 0.f, carry = 1.f; f32x16 o[4] = {};
  const int vb0 = (int)(uintptr_t)V_lds + v_rd_base(lane);
  lds_cp ka[2][4];
#pragma unroll
  for (int y = 0; y < 2; ++y)
#pragma unroll
    for (int x = 0; x < 4; ++x) ka[y][x] = (lds_cp)(__attribute__((address_space(3))) char*)K_lds + r32 * 256 + 128 * (y ^ ((r32 >> 3) & 1)) + 32 * (x ^ ((r32 >> 1) & 3)) + 16 * (hi ^ (r32 & 1));
  lds_cp qr[2][4];
#pragma unroll
  for (int y = 0; y < 2; ++y)
#pragma unroll
    for (int x = 0; x < 4; ++x) qr[y][x] = ka[y][x] + (OFF_Q - 2 * SHM_V) + wid * 8192;
  long ksrc[2], vsrc[2];
#pragma unroll
  for (int i = 0; i < 2; ++i) { const int piece = wid + 8 * i;
    { const int row = piece * 4 + (lane >> 4), c = (lane & 15) ^ (row & 15); ksrc[i] = (long)row * ldk + c * 8; }
    { const int sub = piece * 2 + (lane >> 5), kk = (sub >> 2) * 8 + ((lane & 31) >> 2), k = (kk & ~0xC) | ((kk & 4) << 1) | ((kk & 8) >> 1), c = (sub & 3) * 32 + (lane & 3) * 8; vsrc[i] = (long)k * ldk + c; } }
  typedef __attribute__((address_space(3))) unsigned lds_u32;
  lds_u32* kdst = (lds_u32*)(__attribute__((address_space(3))) char*)(K_lds) + wid * 256; lds_u32* vdst = (lds_u32*)(__attribute__((address_space(3))) char*)(V_lds) + wid * 256;
#define TILE(it) ((MODE == 2) ? (NT - 1 - (it)) : (it))
#define DMA_K(k0, b) do { _Pragma("unroll") for (int i_ = 0; i_ < 2; ++i_) __builtin_amdgcn_global_load_lds((const unsigned*)(Kh + (long)(k0) * ldk + ksrc[i_]), kdst + (b) * (SHM_K / 4) + i_ * 2048, 16, 0, 0); } while (0)
#define DMA_V(k0, b) do { _Pragma("unroll") for (int i_ = 0; i_ < 2; ++i_) __builtin_amdgcn_global_load_lds((const unsigned*)(Vh + (long)(k0) * ldk + vsrc[i_]), vdst + (b) * (SHM_V / 4) + i_ * 2048, 16, 0, 0); } while (0)
#define SDRAIN() asm volatile("s_waitcnt vmcnt(0)" ::: "memory")
#define KSLOT(i_) ((i_) == 2 ? (OFF_Q - 2 * SHM_V) : (i_) * SHM_K)
#define VSLOT(i_) ((i_) == 2 ? (OFF_Q + SHM_K) : (i_) * SHM_V)
#define DMA_K3(k0, so) do { _Pragma("unroll") for (int i_ = 0; i_ < 2; ++i_) __builtin_amdgcn_global_load_lds((const unsigned*)(Kh + (long)(k0) * ldk + ksrc[i_]), kdst + (so) / 4 + i_ * 2048, 16, 0, 0); } while (0)
#define DMA_V3(k0, so) do { _Pragma("unroll") for (int i_ = 0; i_ < 2; ++i_) __builtin_amdgcn_global_load_lds((const unsigned*)(Vh + (long)(k0) * ldk + vsrc[i_]), vdst + (so) / 4 + i_ * 2048, 16, 0, 0); } while (0)
  lds_u32* qdst = (lds_u32*)(__attribute__((address_space(3))) char*)(lds + OFF_Q) + wid * 2048;
#define ISSUE_UNIT(QB_, KH_, VH_, T0_, T1_) do { \
    _Pragma("unroll") for (int i = 0; i < 8; ++i) { const int row = 4 * i + (lane >> 4), c = (lane & 15) ^ (row & 15); \
      __builtin_amdgcn_global_load_lds((const unsigned*)((QB_) + (long)(wid * 32 + row) * ldq + c * 8), qdst + i * 256, 16, 0, 0); } \
    _Pragma("unroll") for (int i_ = 0; i_ < 2; ++i_) { \
      __builtin_amdgcn_global_load_lds((const unsigned*)((KH_) + (long)((T0_) * KVBLK) * ldk + ksrc[i_]), kdst + i_ * 2048, 16, 0, 0); \
      __builtin_amdgcn_global_load_lds((const unsigned*)((VH_) + (long)((T0_) * KVBLK) * ldk + vsrc[i_]), vdst + i_ * 2048, 16, 0, 0); } \
    if ((T1_) >= 0) { _Pragma("unroll") for (int i_ = 0; i_ < 2; ++i_) __builtin_amdgcn_global_load_lds((const unsigned*)((KH_) + (long)((T1_) * KVBLK) * ldk + ksrc[i_]), kdst + (SHM_K / 4) + i_ * 2048, 16, 0, 0); } } while (0)
  if (!preissued) ISSUE_UNIT(Qb, Kh, Vh, TILE(0), ((MODE == 2 || PIPE_SOFTMAX) ? TILE(1) : -1));
  constexpr bool RING3 = (MODE != 2) && QREG_SOFTMAX && !PIPE_SOFTMAX;
  unsigned selmask = 0u;
  float gv[4] = {1.f, 1.f, 1.f, 1.f};
  if (gain) {
#pragma unroll
    for (int d0 = 0; d0 < 4; ++d0) gv[d0] = gain[d0 * 32 + r32]; }
  if (MODE == 1) { if (tid < 256) *(f32x4*)(km_l + tid * 4) = *(const f32x4*)(kmean + tid * 4); }
  SDRAIN();
  __syncthreads();
  if (MODE == 1) {
    float g[8];
#pragma unroll
    for (int n = 0; n < 8; ++n) g[n] = 0.f;
    { const int rh = (r32 >> 1) & 3, r3 = (r32 >> 3) & 1;
      const lds_cp qbase = qr[0][0] - 32 * rh - 128 * r3;
#pragma unroll 1
      for (int d0 = 0; d0 < 8; ++d0) {
        const bf16x8 qf = *reinterpret_cast<const __attribute__((address_space(3))) bf16x8*>(qbase + 32 * ((d0 & 3) ^ rh) + 128 * ((d0 >> 2) ^ r3));
        float q[8];
#pragma unroll
        for (int j = 0; j < 8; ++j) q[j] = __uint_as_float(((unsigned)(unsigned short)qf[j]) << 16);
        const float* kmp = km_l + d0 * 16 + hi * 8;
#pragma unroll
        for (int n = 0; n < 7; ++n) { const f32x4 k0v = *(const f32x4*)(kmp + n * 128), k1v = *(const f32x4*)(kmp + n * 128 + 4);
          g[n] += (q[0] * k0v[0] + q[1] * k0v[1]) + (q[2] * k0v[2] + q[3] * k0v[3]) + (q[4] * k1v[0] + q[5] * k1v[1]) + (q[6] * k1v[2] + q[7] * k1v[3]); }
      } }
#pragma unroll
    for (int n = 0; n < 7; ++n) { g[n] += xchg32(g[n], hi); if (n >= qb) g[n] = -INFINITY; }
    g[7] = -INFINITY;
#pragma unroll
    for (int n = 0; n < 7; ++n) { int cnt = 0;
#pragma unroll
      for (int mI = 0; mI < 7; ++mI) { if (mI != n) cnt += (g[mI] > g[n] || (g[mI] == g[n] && mI < n)) ? 1 : 0; }
      if (n < qb && cnt < 3) selmask |= (1u << n); }
  }
  bf16x8 qg[8];
  if (QREG_SOFTMAX && MODE != 2) {
#pragma unroll
    for (int d0 = 0; d0 < 8; ++d0) qg[d0] = *reinterpret_cast<const __attribute__((address_space(3))) bf16x8*>(qr[d0 >> 2][d0 & 3]); }
  int kc = KSLOT(0), kn = KSLOT(1), kn2 = KSLOT(2), vc = VSLOT(0), vn = VSLOT(1), vn2 = VSLOT(2);
  if (RING3) { DMA_K3(TILE(1) * KVBLK, kn); DMA_V3(TILE(1) * KVBLK, vn);
    asm volatile("s_waitcnt lgkmcnt(0)" ::: "memory"); __syncthreads(); }
  f32x16 pA0, pA1, pB0, pB1; bf16x8 pa0, pa1, pa2, pa3;
  if (MODE == 2 || PIPE_SOFTMAX) { float bias0 = 0.f; if (MODE == 1) { if (NT > 4) bias0 = (selmask & 1u) ? 0.f : -INFINITY; }
    qkt(pA0, pA1, ka, 0, qr, bias0);
    __syncthreads(); }
  int it = 0;
#define JB(i_) ((MODE == 2) ? (3 - (i_)) : ((i_) - (NT - 4)))
#define STEP(A0, A1, B0, B1, BAND, HASNEXT) do { \
    if (it + 2 < NT) DMA_K(TILE(it + 2) * KVBLK, it & 1); \
    if (it + 1 < NT) DMA_V(TILE(it + 1) * KVBLK, (it + 1) & 1); \
    bool skip = false; const int jb = JB(it); \
    if (BAND) { if (MODE == 1) skip = (64 * jb > wid * 32 + 31); if (MODE == 2) skip = (64 * jb >= wid * 32 + 31); } \
    if (MODE == 2) skip = skip || __all(carry < SB_DONE);        \
    if (HASNEXT) { float bias_ = 0.f; if (MODE == 1) { if (it + 1 < NT - 4) bias_ = ((selmask >> ((it + 1) >> 2)) & 1u) ? 0.f : -INFINITY; } \
      qkt(B0, B1, ka, ((it + 1) & 1) * SHM_K, qr, bias_); } \
    if (!skip) { \
      if (MODE == 2) { sb_tile<(BAND) != 0>(A0, A1, carry, 64 * jb, qrel, hi); } \
      else { \
        if (MODE == 1 && (BAND)) { _Pragma("unroll") for (int r = 0; r < 16; ++r) { const int kr = 64 * jb + crow(r, hi); if (kr > qrel) A0[r] = -INFINITY; if (kr + 32 > qrel) A1[r] = -INFINITY; } } \
        float alpha; softmax_tile(A0, A1, m_reg, l_reg, alpha); \
        if (__any(alpha < 1.f)) { if (hi == 0) al_l[r32] = alpha; asm volatile("s_waitcnt lgkmcnt(0)" ::: "memory"); \
          _Pragma("unroll") for (int d = 0; d < 4; ++d) _Pragma("unroll") for (int r = 0; r < 16; ++r) o[d][r] *= al_l[crow(r, hi)]; } \
      } \
      pack_p(A0, A1, pa0, pa1, pa2, pa3); \
      pv_d0(o, vb0 + (it & 1) * SHM_V, pa0, pa1, pa2, pa3); \
    } \
    SDRAIN(); __syncthreads(); ++it; } while (0)
#define SB_LD(G, F) do { F##q = *reinterpret_cast<const __attribute__((address_space(3))) bf16x8*>(qr[(G) >> 2][(G) & 3]); \
      F##0 = *reinterpret_cast<const __attribute__((address_space(3))) bf16x8*>(ka[(G) >> 2][(G) & 3] + kb_); F##1 = *reinterpret_cast<const __attribute__((address_space(3))) bf16x8*>(ka[(G) >> 2][(G) & 3] + kb_ + 8192); } while (0)
#define SB_PART(G, P, I, B0, B1, FC, FN) do { if ((G) < 7) SB_LD(((G) + 1) & 7, FN);              \
      B0 = __builtin_amdgcn_mfma_f32_32x32x16_bf16(FC##0, FC##q, B0, 0, 0, 0); B1 = __builtin_amdgcn_mfma_f32_32x32x16_bf16(FC##1, FC##q, B1, 0, 0, 0); \
      gs_[G] = sb_group<false, I>(P, 0, 0, hi); SBAR(); } while (0)
#define STEP_SB(A0, A1, B0, B1) do { \
    if (it + 2 < NT) DMA_K(TILE(it + 2) * KVBLK, it & 1); \
    DMA_V(TILE(it + 1) * KVBLK, (it + 1) & 1); \
    float gs_[8]; \
    _Pragma("unroll") for (int r = 0; r < 16; ++r) { B0[r] = 0.f; B1[r] = 0.f; } \
    const int kb_ = ((it + 1) & 1) * SHM_K; bf16x8 fx0, fx1, fxq, fy0, fy1, fyq; SB_LD(0, fx); SBAR(); \
    SB_PART(0, A0, 0, B0, B1, fx, fy); SB_PART(1, A0, 1, B0, B1, fy, fx); SB_PART(2, A0, 2, B0, B1, fx, fy); SB_PART(3, A0, 3, B0, B1, fy, fx); \
    SB_PART(4, A1, 0, B0, B1, fx, fy); SB_PART(5, A1, 1, B0, B1, fy, fx); SB_PART(6, A1, 2, B0, B1, fx, fy); SB_PART(7, A1, 3, B0, B1, fy, fx); \
    sb_combine(A0, A1, gs_, carry, hi); \
    { const bool dn_ = __all(carry < SB_DONE); if (lane == 0) flg[(it & 1) * 8 + wid] = dn_ ? 1 : 0; } \
    pack_p(A0, A1, pa0, pa1, pa2, pa3); \
    pv_d0(o, vb0 + (it & 1) * SHM_V, pa0, pa1, pa2, pa3); \
    SDRAIN(); __syncthreads(); \
    { const int* f_ = flg + (it & 1) * 8; stop = (f_[0] + f_[1] + f_[2] + f_[3] + f_[4] + f_[5] + f_[6] + f_[7]) == 8; } \
    ++it; } while (0)
#define SSTEP(BAND) do { \
    if (RING3) { if (it + 2 < NT) { DMA_K3(TILE(it + 2) * KVBLK, kn2); DMA_V3(TILE(it + 2) * KVBLK, vn2); } } \
    else if (it + 1 < NT) { DMA_K(TILE(it + 1) * KVBLK, (it + 1) & 1); DMA_V(TILE(it + 1) * KVBLK, (it + 1) & 1); } \
    bool skip = false; const int jb = JB(it); \
    if (BAND) skip = (64 * jb > wid * 32 + 31); \
    if (!skip) { \
      float bias_ = 0.f; if (MODE == 1 && !(BAND)) bias_ = ((selmask >> (it >> 2)) & 1u) ? 0.f : -INFINITY; \
      const int kb_ = RING3 ? kc : (it & 1) * SHM_K; \
      if (QREG_SOFTMAX) qkt(pA0, pA1, ka, kb_, qg, bias_); else qkt(pA0, pA1, ka, kb_, qr, bias_); \
      if (MODE == 1 && (BAND)) { _Pragma("unroll") for (int r = 0; r < 16; ++r) { const int kr = 64 * jb + crow(r, hi); if (kr > qrel) pA0[r] = -INFINITY; if (kr + 32 > qrel) pA1[r] = -INFINITY; } } \
      float alpha; softmax_tile(pA0, pA1, m_reg, l_reg, alpha); \
      if (__any(alpha < 1.f)) { if (hi == 0) al_l[r32] = alpha; asm volatile("s_waitcnt lgkmcnt(0)" ::: "memory"); \
        _Pragma("unroll") for (int d = 0; d < 4; ++d) _Pragma("unroll") for (int r = 0; r < 16; ++r) o[d][r] *= al_l[crow(r, hi)]; } \
      pack_p(pA0, pA1, pa0, pa1, pa2, pa3); \
      pv_d0(o, vb0 + (RING3 ? vc : (it & 1) * SHM_V), pa0, pa1, pa2, pa3); \
    } \
    if (RING3) { if (it + 2 < NT) asm volatile("s_waitcnt vmcnt(4)" ::: "memory"); else SDRAIN();        \
      { const int t_ = kc; kc = kn; kn = kn2; kn2 = t_; } { const int t_ = vc; vc = vn; vn = vn2; vn2 = t_; } } \
    else SDRAIN(); \
    if (RING3) { asm volatile("s_waitcnt lgkmcnt(0)" ::: "memory"); __builtin_amdgcn_s_barrier(); asm volatile("" ::: "memory"); }     \
    else __syncthreads(); \
    ++it; } while (0)
#define RESTART(BIASEXPR) do { qkt(pA0, pA1, ka, (it & 1) * SHM_K, qr, (BIASEXPR)); __syncthreads(); } while (0)
  if (MODE == 0) {
    if (PIPE_SOFTMAX) { STEP(pA0, pA1, pB0, pB1, 0, true); STEP(pB0, pB1, pA0, pA1, 0, true); STEP(pA0, pA1, pB0, pB1, 0, true); STEP(pB0, pB1, pA0, pA1, 0, false); }
    else { SSTEP(0); SSTEP(0); SSTEP(0); SSTEP(0); }
  } else if (MODE == 1) {
    if (PIPE_SOFTMAX) {
      if (NT > 4) { while (it < NT - 4) { STEP(pA0, pA1, pB0, pB1, 0, true); STEP(pB0, pB1, pA0, pA1, 0, (it + 1 < NT - 4)); }
        RESTART(0.f); }
      STEP(pA0, pA1, pB0, pB1, 1, true); STEP(pB0, pB1, pA0, pA1, 1, true); STEP(pA0, pA1, pB0, pB1, 1, true); STEP(pB0, pB1, pA0, pA1, 1, false);
    } else {
      while (it < NT - 4) SSTEP(0);
      SSTEP(1); SSTEP(1); SSTEP(1); SSTEP(1);
    }
  } else {
    STEP(pA0, pA1, pB0, pB1, 1, true); STEP(pB0, pB1, pA0, pA1, 1, true); STEP(pA0, pA1, pB0, pB1, 1, true); STEP(pB0, pB1, pA0, pA1, 1, false);
    if (NT > 4) {
      RESTART(0.f);
      bool stop = false;
      while (it + 2 < NT && !stop) { STEP_SB(pA0, pA1, pB0, pB1); STEP_SB(pB0, pB1, pA0, pA1); }
      if (!stop) { STEP_SB(pA0, pA1, pB0, pB1); STEP(pB0, pB1, pA0, pA1, 0, false); }
    }
  }
#undef RESTART
#undef STEP
#undef SSTEP
#undef STEP_SB
#undef SB_LD
#undef SB_PART
#undef JB
  if (OUT8) { if (nhb) ISSUE_UNIT(nhb + (long)nqb * (256 * 128), nhb + 8 * HSZ_, nhb + 16 * HSZ_, nt0, nt1); }
  float rli[16];
  if (MODE != 2) { if (hi == 0) li_l[r32] = l_reg; asm volatile("s_waitcnt lgkmcnt(0)" ::: "memory");
#pragma unroll
    for (int r = 0; r < 16; ++r) rli[r] = __builtin_amdgcn_rcpf(li_l[crow(r, hi)]); }
  else {
#pragma unroll
    for (int r = 0; r < 16; ++r) rli[r] = 1.f; }
  if (gain) {
#pragma unroll
    for (int r = 0; r < 16; ++r) { float s = 0.f;
#pragma unroll
      for (int d0 = 0; d0 < 4; ++d0) { o[d0][r] *= rli[r]; s += o[d0][r] * o[d0][r]; }
      s += __shfl_xor(s, 1); s += __shfl_xor(s, 2); s += __shfl_xor(s, 4); s += __shfl_xor(s, 8); s += __shfl_xor(s, 16);
      rli[r] = __builtin_amdgcn_rsqf(s * (1.0f / 128.0f) + 1e-6f); }
#pragma unroll
    for (int r = 0; r < 16; ++r)
#pragma unroll
      for (int d0 = 0; d0 < 4; ++d0) o[d0][r] *= gv[d0];
  }
  if (OUT8) {
#pragma unroll
    for (int r = 0; r < 16; ++r) { const float f = rli[r] * s8;
      const float v0 = __builtin_amdgcn_fmed3f(o[0][r] * f, -448.f, 448.f), v1 = __builtin_amdgcn_fmed3f(o[1][r] * f, -448.f, 448.f), v2 = __builtin_amdgcn_fmed3f(o[2][r] * f, -448.f, 448.f), v3 = __builtin_amdgcn_fmed3f(o[3][r] * f, -448.f, 448.f);
      int p = __builtin_amdgcn_cvt_pk_fp8_f32(v0, v1, 0, false); p = __builtin_amdgcn_cvt_pk_fp8_f32(v2, v3, p, true);
      *(unsigned*)((unsigned char*)Ob + (long)(wid * 32 + crow(r, hi)) * ldo + 4 * r32) = (unsigned)p; } }
  else { bf16* stg = (bf16*)lds + wid * 4096;
#pragma unroll
    for (int r = 0; r < 16; ++r) { const int orow = crow(r, hi);
#pragma unroll
      for (int d0 = 0; d0 < 4; ++d0) { const float v = o[d0][r] * rli[r]; unsigned u = __float_as_uint(v); u = (u + 0x7fffu + ((u >> 16) & 1u)) >> 16; stg[orow * 128 + d0 * 32 + r32] = (bf16)u; } }
    asm volatile("s_waitcnt lgkmcnt(0)" ::: "memory");
#pragma unroll
    for (int i = 0; i < 8; ++i) { const int row = i * 4 + (lane >> 4), ch = lane & 15; const u32x4 v = *(const u32x4*)(stg + row * 128 + ch * 8); *(u32x4*)(Ob + (long)(wid * 32 + row) * ldo + ch * 8) = v; } }
  __syncthreads();
#undef TILE
#undef ISSUE_UNIT
#undef DMA_K
#undef DMA_V
#undef DMA_K3
#undef DMA_V3
#undef KSLOT
#undef VSLOT
#undef SDRAIN
}
#undef KSWZ
#undef SBAR
}
#define GAS __attribute__((address_space(1)))
#define LAS __attribute__((address_space(3)))
typedef unsigned short bf16;
typedef unsigned v4u __attribute__((ext_vector_type(4)));
typedef float f32x4 __attribute__((ext_vector_type(4)));
#define LDS_WAIT() asm volatile("s_waitcnt lgkmcnt(0)" ::: "memory")
constexpr int NWAVES = 8;
constexpr int BATCH = 8, SEQ = 2048, DM = 2048, M = BATCH * SEQ, HD = 128, NH = 8;
constexpr int NQKV = 6144, FF = 5632, WX = 512, NMEM = 256, MMEM = BATCH * NMEM;
constexpr int QSB = 0, KSB = 1024, VSB = 2048, QMB = 3072, KMB = 4096, VMB = 5120;
constexpr float EPS = 1e-6f;
constexpr float QSCALE = 0.12751743082459868f;
constexpr size_t MiB = 1u << 20;
constexpr size_t WS_CTL = 0, CTL_ZERO_BYTES = 512 * 1024;
constexpr size_t WS_SSQ1 = 64 * 1024, WS_SSQ2 = 128 * 1024;
constexpr size_t WS_KSUM = 256 * 1024;
constexpr size_t WS_WIN = 1 * MiB, WS_WOUT = 25 * MiB, WS_WXQ = 33 * MiB, WS_WXKV = 35 * MiB, WS_WXO = 39 * MiB, WS_WGU = 41 * MiB, WS_WDN = 85 * MiB;
constexpr size_t WS_RA = 107 * MiB;
constexpr size_t WS_RB = 171 * MiB;
constexpr size_t WS_RC = 235 * MiB;
constexpr size_t WS_QX = 427 * MiB, WS_OX = 443 * MiB, WS_KVX = 459 * MiB, WS_MN = 463 * MiB, WS_KMEAN = 471 * MiB, WS_RINV0 = 471 * MiB  , WS_CS = 472 * MiB, WS_END = 474 * MiB;
constexpr int RING_BYTES = 131072, LDS_BYTES = 147456;
#ifndef FFN_FP8
#define FFN_FP8 1
#endif
constexpr float S_X2 = 16.f, S_WGU = 32.f, S_ACT = 8.f, S_WDN = 64.f, S_XN = 16.f, S_WV = 32.f, S_O = 16.f, S_WO = 32.f;
constexpr float S_OX = 16.f, S_WXO = 16.f;
#ifndef WXO_FP8
#define WXO_FP8 1
#endif
#ifndef WOUT_FP8
#define WOUT_FP8 1
#endif
constexpr size_t WS_WV8 = WS_WIN + 16 * MiB;

__device__ __forceinline__ float bf2f(unsigned short b) { return __uint_as_float((unsigned)b << 16); }
__device__ __forceinline__ unsigned f2bf(float f) { unsigned u = __builtin_bit_cast(unsigned, f); return (u + 0x7fffu + ((u >> 16) & 1u)) >> 16; }
__device__ __forceinline__ unsigned pk2(float lo, float hi) { return f2bf(lo) | (f2bf(hi) << 16); }
__device__ __forceinline__ float wave_sum(float v) {
#pragma unroll
    for (int o = 1; o < 64; o <<= 1) v += __shfl_xor(v, o);
    return v;
}
__device__ __forceinline__ float wave_max(float v) {
#pragma unroll
    for (int o = 1; o < 64; o <<= 1) v = fmaxf(v, __shfl_xor(v, o));
    return v;
}

typedef GAS unsigned gu32;
#define RLX_AGENT __ATOMIC_RELAXED, __HIP_MEMORY_SCOPE_AGENT
constexpr int CW_BAR = 4096;
constexpr int LDSCTL_OFF = RING_BYTES, MISC_OFF = LDSCTL_OFF + 320;
#define XB_TMO      128
#define XB_XCNT(j)  (256  + 64 * (j))
#define XB_XSUB(j)  (1280 + 64 * (j))
#define XB_XGEN(j)  (2304 + 64 * (j))
#define XB_TOP      3328
#define XB_TOPGEN   3392
#define XCD_BAR_WORDS 3456
#define XB_SPIN_CAP (1u << 18)

__device__ __forceinline__ unsigned xb_ld(unsigned* p)              { return __hip_atomic_load(p, __ATOMIC_RELAXED, __HIP_MEMORY_SCOPE_AGENT); }
__device__ __forceinline__ unsigned xb_add(unsigned* p, unsigned v) { return __hip_atomic_fetch_add(p, v, __ATOMIC_RELAXED, __HIP_MEMORY_SCOPE_AGENT); }
__device__ __forceinline__ unsigned xb_xcc_id() { return (unsigned)__builtin_amdgcn_s_getreg((3 << 11) | 20) & 0xFu; }
#define XB_SPIN(cond, bar) do { unsigned _sp = 0; while (cond) { __builtin_amdgcn_s_sleep(1); \
    if ((++_sp & 255u) == 0u) { if (xb_ld(&(bar)[XB_TMO])) break; if (_sp > XB_SPIN_CAP) { atomicAdd(&(bar)[XB_TMO], 1u); break; } } } } while (0)

struct XcdBarrier {
    unsigned* bar; unsigned x;
    volatile LAS unsigned* st;
};

__device__ __forceinline__ XcdBarrier xcd_barrier_post(unsigned* bar, volatile LAS unsigned* st) {
    XcdBarrier b; b.bar = bar; b.x = xb_xcc_id(); b.st = st;
    if (threadIdx.x == 0) (void)xb_add(&bar[XB_XCNT(b.x)], 1u);
    return b;
}
__device__ __forceinline__ void xcd_barrier_complete(unsigned* bar, unsigned x, unsigned& nloc, unsigned& nx) {
    const unsigned G = gridDim.x * gridDim.y * gridDim.z;
    unsigned sum, cnt, mine, sp = 0u;
    for (;;) {
        sum = 0u; cnt = 0u; mine = 0u;
#pragma unroll
        for (unsigned j = 0; j < 16; ++j) { const unsigned c = xb_ld(&bar[XB_XCNT(j)]); sum += c; cnt += (c > 0u) ? 1u : 0u; mine = (j == x) ? c : mine; }
        if (sum == G) break;
        __builtin_amdgcn_s_sleep(1);
        if ((++sp & 255u) == 0u) { if (xb_ld(&bar[XB_TMO])) break; if (sp > XB_SPIN_CAP) { atomicAdd(&bar[XB_TMO], 1u); break; } }
    }
    nloc = mine > 0u ? mine : 1u; nx = cnt > 0u ? cnt : 1u;
}

__device__ __forceinline__ void xcd_barrier(const XcdBarrier& b) {
    asm volatile("s_waitcnt vmcnt(0)" ::: "memory");
    __syncthreads();
    if (threadIdx.x == 0) {
        unsigned* bar = b.bar;
        __builtin_amdgcn_s_waitcnt(0);
        unsigned nloc = b.st[0], nx = b.st[1];
        if (nloc == 0u) { xcd_barrier_complete(bar, b.x, nloc, nx); b.st[0] = nloc; b.st[1] = nx; }
        const unsigned old = xb_add(&bar[XB_XSUB(b.x)], 1u);
        const unsigned gen = old / nloc;
        if (old + 1u == (gen + 1u) * nloc) {
            __builtin_amdgcn_fence(__ATOMIC_RELEASE, "agent");
            asm volatile("s_waitcnt vmcnt(0)" ::: "memory");
            const unsigned og = xb_add(&bar[XB_TOP], 1u);
            const unsigned tg = og / nx;
            if (og + 1u == (tg + 1u) * nx) xb_add(&bar[XB_TOPGEN], 1u);
            else XB_SPIN(xb_ld(&bar[XB_TOPGEN]) == tg, bar);
            __builtin_amdgcn_fence(__ATOMIC_ACQUIRE, "agent");
            xb_add(&bar[XB_XGEN(b.x)], 1u);
            asm volatile("s_waitcnt vmcnt(0)" ::: "memory");
        } else {
            XB_SPIN(xb_ld(&bar[XB_XGEN(b.x)]) == gen, bar);
            __builtin_amdgcn_fence(__ATOMIC_ACQUIRE, "agent");
            asm volatile("s_waitcnt vmcnt(0)" ::: "memory");
        }
    }
    __syncthreads();
}

struct Frame {
    LAS unsigned char* lds;
    int tid, lane, wave, vcu, G;
    const float *x, *mem; const int* pos;
    const float *g_mix, *w_in, *g_out_sb, *g_out_mb, *w_out, *g_xattn, *g_mem, *w_xq, *w_xkv, *w_xo, *g_ffn, *w_gu, *w_dn, *g_final;
    float* out; unsigned char* ws;
};

__device__ __forceinline__ void transpose_item(const float* W, int K, int N, bf16* WT, const float* gain, int inter, LAS float* scr, int item, int lane) {
    const int nblk = N / 32, kb = item / nblk, nb = item % nblk, k0 = 64 * kb, n0 = 32 * nb;
    int orow0 = n0;
    if (inter == 1) orow0 = (n0 < FF) ? (n0 / 128) * 256 + (n0 % 128) : ((n0 - FF) / 128) * 256 + 128 + ((n0 - FF) % 128);
    if (inter == 2) { const int reg = n0 / 1024, c = n0 % 1024; orow0 = (reg == 2) ? c : (reg == 5) ? 1024 + c : (reg < 2 ? reg : reg - 1) * 1024 + c; }
    float v[32];
#pragma unroll
    for (int i = 0; i < 32; ++i) v[i] = W[(size_t)(k0 + 2 * i + (lane >> 5)) * N + n0 + (lane & 31)];
#pragma unroll
    for (int i = 0; i < 32; ++i) { const int kk = 2 * i + (lane >> 5); float t = v[i]; if (gain) t *= gain[k0 + kk]; scr[kk * 33 + (lane & 31)] = t; }
    LDS_WAIT(); asm volatile("" ::: "memory");
    const int c = lane & 7;
#pragma unroll
    for (int j = 0; j < 4; ++j) { const int n = (lane >> 3) + 8 * j; const LAS float* s = scr + (8 * c) * 33 + n;
        v4u o; o.x = pk2(s[0 * 33], s[1 * 33]); o.y = pk2(s[2 * 33], s[3 * 33]); o.z = pk2(s[4 * 33], s[5 * 33]); o.w = pk2(s[6 * 33], s[7 * 33]);
        *(GAS v4u*)(WT + (size_t)(orow0 + n) * K + k0 + 8 * c) = o; }
    LDS_WAIT(); asm volatile("" ::: "memory");
}
__device__ __forceinline__ void transpose_item_fp8(const float* W, int K, int N, unsigned char* WT, const float* gain, int inter, float scale, LAS float* scr, int item, int lane, int kperm = 0) {
    const int nblk = N / 32, kb = item / nblk, nb = item % nblk, k0 = 64 * kb, n0 = 32 * nb;
    int orow0 = n0;
    if (inter == 1) orow0 = (n0 < FF) ? (n0 / 128) * 256 + (n0 % 128) : ((n0 - FF) / 128) * 256 + 128 + ((n0 - FF) % 128);
    if (inter == 2) { const int reg = n0 / 1024, c = n0 % 1024; orow0 = (reg == 2) ? c : (reg == 5) ? 1024 + c : (reg < 2 ? reg : reg - 1) * 1024 + c; }
    float v[32];
#pragma unroll
    for (int i = 0; i < 32; ++i) { int ks = k0 + 2 * i + (lane >> 5); if (kperm) ks = (ks & ~127) + 32 * (ks & 3) + ((ks & 127) >> 2); v[i] = W[(size_t)ks * N + n0 + (lane & 31)]; }
#pragma unroll
    for (int i = 0; i < 32; ++i) { const int kk = 2 * i + (lane >> 5); float t = v[i] * scale; if (gain) t *= gain[k0 + kk]; scr[kk * 33 + (lane & 31)] = t; }
    LDS_WAIT(); asm volatile("" ::: "memory");
    const int c = lane & 7;
#pragma unroll
    for (int j = 0; j < 4; ++j) { const int n = (lane >> 3) + 8 * j; const LAS float* s = scr + (8 * c) * 33 + n;
        pg8::u32x2 o; o.x = pg8::pk4_fp8(s[0 * 33], s[1 * 33], s[2 * 33], s[3 * 33]); o.y = pg8::pk4_fp8(s[4 * 33], s[5 * 33], s[6 * 33], s[7 * 33]);
        *(GAS pg8::u32x2*)(WT + (size_t)(orow0 + n) * K + k0 + 8 * c) = o; }
    LDS_WAIT(); asm volatile("" ::: "memory");
}
__device__ __forceinline__ void rms_row_to_bf16(const float* xrow, const float* g, bf16* orow, int lane, unsigned char* o8 = nullptr, float s8 = 1.f) {
    const GAS f32x4* xr = (const GAS f32x4*)xrow + lane; const GAS f32x4* gr = (const GAS f32x4*)g + lane;
    f32x4 v[8]; float s = 0.f;
#pragma unroll
    for (int j = 0; j < 8; ++j) { v[j] = xr[64 * j]; s += (v[j].x * v[j].x + v[j].y * v[j].y) + (v[j].z * v[j].z + v[j].w * v[j].w); }
    const float rstd = 1.0f / sqrtf(wave_sum(s) * (1.f / DM) + EPS);
    GAS unsigned long long* ob8 = (GAS unsigned long long*)orow + lane;
#pragma unroll
    for (int j = 0; j < 8; ++j) { const f32x4 gg = gr[64 * j];
        const float a0 = v[j].x * rstd * gg.x, a1 = v[j].y * rstd * gg.y, a2 = v[j].z * rstd * gg.z, a3 = v[j].w * rstd * gg.w;
        ob8[64 * j] = (unsigned long long)pk2(a0, a1) | ((unsigned long long)pk2(a2, a3) << 32);
        if (o8) ((GAS unsigned*)o8)[64 * j + lane] = pg8::pk4_fp8(a0 * s8, a1 * s8, a2 * s8, a3 * s8); }
}
__device__ __forceinline__ void x_row_convert(const float* xrow, bf16* orow, unsigned char* o8, float s8, float* rinv, int lane) {
    const GAS f32x4* xr = (const GAS f32x4*)xrow + lane;
    f32x4 v[8]; float s = 0.f;
#pragma unroll
    for (int j = 0; j < 8; ++j) { v[j] = xr[64 * j]; s += (v[j].x * v[j].x + v[j].y * v[j].y) + (v[j].z * v[j].z + v[j].w * v[j].w); }
    const float rstd = 1.0f / sqrtf(wave_sum(s) * (1.f / DM) + EPS);
    if (lane == 0) *rinv = rstd;
    GAS unsigned long long* ob8 = (GAS unsigned long long*)orow + lane;
#pragma unroll
    for (int j = 0; j < 8; ++j) { ob8[64 * j] = (unsigned long long)pk2(v[j].x, v[j].y) | ((unsigned long long)pk2(v[j].z, v[j].w) << 32);
        ((GAS unsigned*)o8)[64 * j + lane] = pg8::pk4_fp8(v[j].x * s8, v[j].y * s8, v[j].z * s8, v[j].w * s8); }
}
__constant__ float INV_FREQ[16] = {1.000000000e+00f, 4.403665960e-01f, 1.939227432e-01f, 8.539710194e-02f, 3.760603070e-02f, 1.656043902e-02f, 7.292664610e-03f, 3.211445874e-03f,
                                   1.414213562e-03f, 6.227723788e-04f, 2.742481884e-04f, 1.207697351e-04f, 5.318296098e-05f, 2.341999971e-05f, 1.031338616e-05f, 4.541670478e-06f};

__device__ __forceinline__ void p0_prologue(Frame& F) {
    LAS float* scr = (LAS float*)(F.lds + F.wave * 16384);
    const int gw = F.vcu * NWAVES + F.wave, NGW = F.G * NWAVES;
    bf16* ws16 = (bf16*)F.ws;
    constexpr int I0 = (DM / 64) * (NQKV / 32), I1 = (DM / 64) * (DM / 32), I2 = (DM / 64) * (WX / 32), I3 = (DM / 64) * (2 * WX / 32), I4 = (WX / 64) * (DM / 32),
                  I5 = (DM / 64) * (2 * FF / 32), I6 = (FF / 64) * (DM / 32);
    constexpr int I5H = I5 / 2;
    constexpr int NITEMS = I0 + I1 + I2 + I3 + I4 + I5H;
    for (int it = gw; it < NITEMS; it += NGW) {
        int r = it;
        if (r < I0) { const int reg = ((r % (NQKV / 32)) * 32) / 1024;
            if (reg == 2 || reg == 5) transpose_item_fp8(F.w_in, DM, NQKV, F.ws + WS_WV8, F.g_mix, 2, S_WV, scr, r, F.lane);
            else transpose_item(F.w_in, DM, NQKV, (bf16*)(F.ws + WS_WIN), F.g_mix, 2, scr, r, F.lane);
            continue; } r -= I0;
        if (r < I1) { if (WOUT_FP8) transpose_item_fp8(F.w_out, DM, DM, F.ws + WS_WOUT, nullptr, 0, S_WO, scr, r, F.lane, 1); else transpose_item(F.w_out, DM, DM, (bf16*)(F.ws + WS_WOUT), nullptr, 0, scr, r, F.lane); continue; } r -= I1;
        if (r < I2) { transpose_item(F.w_xq, DM, WX, (bf16*)(F.ws + WS_WXQ), F.g_xattn, 0, scr, r, F.lane); continue; } r -= I2;
        if (r < I3) { transpose_item(F.w_xkv, DM, 2 * WX, (bf16*)(F.ws + WS_WXKV), nullptr, 0, scr, r, F.lane); continue; } r -= I3;
        if (r < I4) { if (WXO_FP8) transpose_item_fp8(F.w_xo, WX, DM, F.ws + WS_WXO, nullptr, 0, S_WXO, scr, r, F.lane, 1); else transpose_item(F.w_xo, WX, DM, (bf16*)(F.ws + WS_WXO), nullptr, 0, scr, r, F.lane); continue; } r -= I4;
        transpose_item_fp8(F.w_gu, DM, 2 * FF, F.ws + WS_WGU, F.g_ffn, 1, S_WGU, scr, r, F.lane);
    }
    (void)ws16;
    for (int m = gw; m < M; m += NGW) x_row_convert(F.x + (size_t)m * DM, (bf16*)(F.ws + WS_RA) + (size_t)m * DM, F.ws + WS_RB + (size_t)m * DM, S_XN, (float*)(F.ws + WS_RINV0) + m, F.lane);
    for (int m = gw; m < MMEM; m += NGW) rms_row_to_bf16(F.mem + (size_t)m * DM, F.g_mem, (bf16*)(F.ws + WS_MN) + (size_t)m * DM, F.lane);
    float* cs = (float*)(F.ws + WS_CS);
    for (int e = (F.vcu * NWAVES + F.wave) * 64 + F.lane; e < M * 16; e += NGW * 64) {
        const int m = e >> 4, i = e & 15; const float ang = (float)F.pos[m] * INV_FREQ[i];
        double rev = (double)ang * 0.15915494309189535; rev -= floor(rev);
        const float a = (float)(rev * 6.283185307179586);
        cs[(size_t)m * 32 + i] = cosf(a); cs[(size_t)m * 32 + 16 + i] = sinf(a);
    }
}

__device__ __forceinline__ void ffn_weight_items(Frame& F, int wi, int nw) {
    LAS float* scr = (LAS float*)(F.lds + F.wave * 16384);
    constexpr int I5 = (DM / 64) * (2 * FF / 32), I6 = (FF / 64) * (DM / 32);
    for (int it = wi + I5 / 2; it < I5 + I6; it += nw) {
        if (it < I5) transpose_item_fp8(F.w_gu, DM, 2 * FF, F.ws + WS_WGU, F.g_ffn, 1, S_WGU, scr, it, F.lane);
        else transpose_item_fp8(F.w_dn, FF, DM, F.ws + WS_WDN, nullptr, 0, S_WDN, scr, it - I5, F.lane);
    }
}

__device__ __forceinline__ void final_norm_phase(Frame& F, const bf16* src, float* dst) {
    const int gw = F.vcu * NWAVES + F.wave, NGW = F.G * NWAVES;
    for (int m = gw; m < M; m += NGW) {
        const GAS v4u* xr = (const GAS v4u*)(src + (size_t)m * DM) + F.lane; const GAS f32x4* gr = (const GAS f32x4*)F.g_final;
        v4u w[4]; float s = 0.f;
#pragma unroll
        for (int j = 0; j < 4; ++j) w[j] = xr[64 * j];
        f32x4 v[8];
#pragma unroll
        for (int j = 0; j < 4; ++j) { v[2 * j] = (f32x4){__uint_as_float(w[j].x << 16), __uint_as_float(w[j].x & 0xffff0000u), __uint_as_float(w[j].y << 16), __uint_as_float(w[j].y & 0xffff0000u)};
            v[2 * j + 1] = (f32x4){__uint_as_float(w[j].z << 16), __uint_as_float(w[j].z & 0xffff0000u), __uint_as_float(w[j].w << 16), __uint_as_float(w[j].w & 0xffff0000u)}; }
#pragma unroll
        for (int j = 0; j < 8; ++j) s += (v[j].x * v[j].x + v[j].y * v[j].y) + (v[j].z * v[j].z + v[j].w * v[j].w);
        const float rstd = 1.0f / sqrtf(wave_sum(s) * (1.f / DM) + EPS);
        GAS f32x4* dr = (GAS f32x4*)(dst + (size_t)m * DM);
#pragma unroll
        for (int j = 0; j < 4; ++j) { const int c4 = (64 * j + F.lane) * 2;
            dr[c4] = v[2 * j] * rstd * gr[c4]; dr[c4 + 1] = v[2 * j + 1] * rstd * gr[c4 + 1]; }
    }
}

struct RangeOrder : pg8::StaticOrder {
    int i0, n;
    __device__ __forceinline__ bool next(int i, pg8::Unit& u) const { return i < n && pg8::StaticOrder::next(i + i0, u); }
};
template <int K> __device__ __forceinline__ const void* late_arg() {
    const void* p; asm volatile("s_load_dwordx2 %0, %1, %2\n\ts_waitcnt lgkmcnt(0)" : "=s"(p) : "s"(__builtin_amdgcn_kernarg_segment_ptr()), "i"(K * 8));
    return p;
}
constexpr int NPH = 11;
#ifndef REPEAT_WHICH
#define REPEAT_WHICH 3
#endif
#ifndef NULL_EPI_PROBE
#define NULL_EPI_PROBE 0
#endif
#ifndef FOLD_KMEAN
#define FOLD_KMEAN 1
#endif
#ifndef REPEAT_PHASE
#define REPEAT_PHASE -1
#endif
#ifndef REPEAT_MASK
#define REPEAT_MASK 0
#endif
#define REPS(k) (((REPEAT_PHASE == (k)) || ((REPEAT_MASK >> (k)) & 1)) ? 2 : 1)
#ifndef USE_MFMA_SB
#define USE_MFMA_SB 1
#endif
#ifndef USE_MFMA_MOBA
#define USE_MFMA_MOBA 1
#endif
#ifndef USE_MFMA_X
#define USE_MFMA_X 1
#endif
#ifndef MK_ONE_LAUNCH
#define MK_ONE_LAUNCH 1
#endif
struct Args { const void* in[17]; float* out; unsigned char* ws; int ph_lo, ph_hi; };
__global__ void __launch_bounds__(NWAVES * 64, 2) mk_fwd(Args args) {
    extern __shared__ __attribute__((aligned(16))) unsigned char lds[];
    Frame F;
    F.lds = (LAS unsigned char*)lds;
    F.tid = threadIdx.x; F.lane = F.tid & 63; F.wave = __builtin_amdgcn_readfirstlane(F.tid >> 6);
    F.G = gridDim.x; { const int bx = blockIdx.x; F.vcu = (F.G % 8 == 0) ? (bx % 8) * (F.G / 8) + bx / 8 : bx; }
    F.x = (const float*)args.in[0]; F.mem = (const float*)args.in[1]; F.pos = (const int*)args.in[2];
    F.g_mix = (const float*)args.in[3]; F.w_in = (const float*)args.in[4]; F.g_out_sb = nullptr; F.g_out_mb = nullptr; F.w_out = (const float*)args.in[7];
    F.g_xattn = (const float*)args.in[8]; F.g_mem = (const float*)args.in[9]; F.w_xq = (const float*)args.in[10]; F.w_xkv = (const float*)args.in[11]; F.w_xo = (const float*)args.in[12];
    F.g_ffn = nullptr; F.w_gu = nullptr; F.w_dn = nullptr; F.g_final = nullptr;
    F.out = args.out; F.ws = args.ws;
    unsigned char* ws = args.ws;
    const int lo = args.ph_lo, hi = args.ph_hi;
    for (int u = F.tid; u < (LDS_BYTES - LDSCTL_OFF) / 4; u += NWAVES * 64) ((LAS unsigned*)(F.lds + LDSCTL_OFF))[u] = 0u;
    __syncthreads();
    if (hi - lo > 1) {
        { GAS v4u* z = (GAS v4u*)(ws + WS_CTL); const int n16 = (int)(CTL_ZERO_BYTES / 16);
          for (int i = (int)blockIdx.x * (NWAVES * 64) + F.tid; i < n16; i += F.G * NWAVES * 64) z[i] = (v4u){0u, 0u, 0u, 0u}; }
        cg::this_grid().sync();
    }
    XcdBarrier bar = xcd_barrier_post((unsigned*)(ws + WS_CTL) + CW_BAR, (volatile LAS unsigned*)(F.lds + MISC_OFF) + 8);
#ifndef ONLY_PHASE
#define ONLY_PHASE -1
#endif
#define IN(k) ((ONLY_PHASE < 0 || ONLY_PHASE == (k)) && lo <= (k) && (k) < hi)
#define BOTH(k) (IN(k) && IN((k) + 1))
#define GRID_BAR() xcd_barrier(bar)
    float* ssq1 = (float*)(ws + WS_SSQ1); float* ssq2 = (float*)(ws + WS_SSQ2);
    pg8::bf16_t* ACT = (pg8::bf16_t*)(ws + WS_RC + 64 * MiB);
    pg8::bf16_t* RA = (pg8::bf16_t*)(ws + WS_RA); pg8::bf16_t* RB = (pg8::bf16_t*)(ws + WS_RB); pg8::bf16_t* RC = (pg8::bf16_t*)(ws + WS_RC);

    if (IN(0)) { F.w_gu = (const float*)late_arg<14>(); F.g_ffn = (const float*)late_arg<13>(); for (int rep = 0; rep < REPS(0); ++rep) p0_prologue(F); F.w_gu = nullptr; F.g_ffn = nullptr; if (BOTH(0)) GRID_BAR(); }
    if (IN(1)) {
        pg8::Gemm gq{RA, (const pg8::bf16_t*)(ws + WS_WIN), M, 4096, DM}; RangeOrder Sq; Sq.init(M, 4096, F.G, (int)blockIdx.x);
        pg8::EpiQKV Eq{RC, (const float*)(ws + WS_CS), QSCALE, (float*)(ws + WS_KSUM), 0, 1.f, (const float*)(ws + WS_RINV0)};
        pg8::Gemm gv{RB, (const pg8::bf16_t*)(ws + WS_WV8), M, 2048, DM / 2}; RangeOrder Sv; Sv.init(M, 2048, F.G, (int)blockIdx.x);
        pg8::EpiQKV Ev{RC, (const float*)(ws + WS_CS), QSCALE, (float*)(ws + WS_KSUM), 1, 1.f / (S_XN * S_WV), (const float*)(ws + WS_RINV0)};
        for (int rep = 0; rep < REPS(1); ++rep) {
        const bool grp = ((blockIdx.x >> 3) & 1) != 0;
        Sq.i0 = 0; Sq.n = 1 << 20;
        if (grp) { Sv.i0 = 0; Sv.n = 1; pg8::gemm_phase<pg8::EpiQKV, RangeOrder, true, true, true>(F.lds, gv, Sv, Ev); }
        pg8::gemm_phase<pg8::EpiQKV, RangeOrder, true, true>(F.lds, gq, Sq, Eq);
        Sv.i0 = grp ? 1 : 0; Sv.n = 1 << 20;
        pg8::gemm_phase<pg8::EpiQKV, RangeOrder, true, true, true>(F.lds, gv, Sv, Ev);
        }
        if (BOTH(1)) GRID_BAR();
    }
    if (IN(3)) {
        const att::bf16* qkv = (const att::bf16*)RC; att::bf16* ob = (att::bf16*)RB; const float* kmean = (const float*)(ws + WS_KSUM);
        F.g_out_sb = (const float*)late_arg<5>(); F.g_out_mb = (const float*)late_arg<6>();
        constexpr size_t HSZ = (size_t)SEQ * HD;
        for (int rep = 0; rep < REPS(3); ++rep) {
        if (rep == 0 || (REPEAT_WHICH & 1))
        for (int vv = F.vcu; vv < 256; vv += F.G) { const int bh = vv >> 2, s = vv & 3, b = bh >> 3, h = bh & 7; const size_t rb = (size_t)b * SEQ;
            const att::bf16* hS = qkv + ((size_t)b * 48 + h) * HSZ; const att::bf16* hM = qkv + ((size_t)b * 48 + 24 + h) * HSZ;
            for (int i = 0; i < 2; ++i) { const int qb = i ? s : 7 - s; const size_t r0 = rb + (size_t)qb * 256;
                att::attn_unit<2, true>(hS, nullptr, nullptr, (att::bf16*)((unsigned char*)ob + r0 * DM + h * HD), F.g_out_sb + h * HD, nullptr, qb, 0, (char*)lds, S_O,
                                        i != 0, i ? hM : hS, i ? 7 - s : s, i ? 0 : 4 * (s + 1) - 1, i ? -1 : 4 * (s + 1) - 2); }
            for (int i = 0; i < 2; ++i) { const int qb = i ? s : 7 - s; const size_t r0 = rb + (size_t)qb * 256;
                att::attn_unit<1, true>(hM, nullptr, nullptr, (att::bf16*)((unsigned char*)ob + r0 * DM + NH * HD + h * HD), F.g_out_mb + h * HD, kmean + (size_t)bh * 1024, qb, 0, (char*)lds, S_O,
                                        true, i ? nullptr : hM, s, 0, -1); } }
        }
        if (BOTH(3)) GRID_BAR();
    }
    if (IN(4)) {
        pg8::Gemm g{RB, (const pg8::bf16_t*)(ws + WS_WOUT), M, DM, WOUT_FP8 ? DM / 2 : DM}; pg8::StaticOrder S; S.init(M, DM, F.G, (int)blockIdx.x);
        pg8::EpiResB<false> E{RA, RC, ssq1, nullptr, 1.f, WOUT_FP8 ? 1.f / (S_O * S_WO) : 1.f};
        pg8::gemm_phase<pg8::EpiResB<false>, pg8::StaticOrder, true, true, WOUT_FP8 != 0>(F.lds, g, S, E);
        if (BOTH(4)) GRID_BAR();
    }
    if (IN(5)) {
      F.w_gu = (const float*)late_arg<14>(); F.g_ffn = (const float*)late_arg<13>(); F.w_dn = (const float*)late_arg<15>();
      for (int rep = 0; rep < REPS(5); ++rep) {
        { pg8::Gemm g{RC, (const pg8::bf16_t*)(ws + WS_WXQ), M, WX, DM}; pg8::StaticOrder S; S.init(M, WX, F.G, (int)blockIdx.x);
          pg8::EpiScale E{(pg8::bf16_t*)(ws + WS_QX), WX, ssq1, QSCALE};
          pg8::gemm_phase<pg8::EpiScale, pg8::StaticOrder, true, true>(F.lds, g, S, E); }
        { pg8::Gemm g{(const pg8::bf16_t*)(ws + WS_MN), (const pg8::bf16_t*)(ws + WS_WXKV), MMEM, 2 * WX, DM}; pg8::StaticOrder S; S.init(MMEM, 2 * WX, F.G, (int)((blockIdx.x + F.G - 128) % F.G));
          pg8::EpiScale E{(pg8::bf16_t*)(ws + WS_KVX), 2 * WX, nullptr, 1.0f};
          pg8::gemm_phase<pg8::EpiScale, pg8::StaticOrder, true, true>(F.lds, g, S, E); }
        if (F.G > 160) { if ((int)blockIdx.x >= 160) ffn_weight_items(F, ((int)blockIdx.x - 160) * NWAVES + F.wave, (F.G - 160) * NWAVES); }
        else ffn_weight_items(F, (int)blockIdx.x * NWAVES + F.wave, F.G * NWAVES);
      }
        if (BOTH(5)) GRID_BAR();
    }
    if (IN(6)) {
        const att::bf16* qx = (const att::bf16*)(ws + WS_QX); const att::bf16* kvx = (const att::bf16*)(ws + WS_KVX); att::bf16* ox = (att::bf16*)(ws + WS_OX);
        for (int rep = 0; rep < REPS(6); ++rep) {
        for (int vv = F.vcu; vv < 256; vv += F.G) { const int b = vv >> 5, h = (vv >> 3) & 3, qb = vv & 7; const size_t r0 = (size_t)b * SEQ + (size_t)qb * 256;
            if (WXO_FP8) att::attn_unit<0, true>(qx + r0 * WX + h * HD, kvx + (size_t)b * NMEM * (2 * WX) + h * HD, kvx + (size_t)b * NMEM * (2 * WX) + WX + h * HD, (att::bf16*)((unsigned char*)ox + r0 * WX + h * HD), nullptr, nullptr, qb, NMEM, (char*)lds, S_OX);
            else att::attn_unit<0>(qx + r0 * WX + h * HD, kvx + (size_t)b * NMEM * (2 * WX) + h * HD, kvx + (size_t)b * NMEM * (2 * WX) + WX + h * HD, ox + r0 * WX + h * HD, nullptr, nullptr, qb, NMEM, (char*)lds); }
        }
        if (BOTH(6)) GRID_BAR();
    }
    if (IN(7)) {
        pg8::Gemm g{(const pg8::bf16_t*)(ws + WS_OX), (const pg8::bf16_t*)(ws + WS_WXO), M, DM, WXO_FP8 ? WX / 2 : WX}; pg8::StaticOrder S; S.init(M, DM, F.G, (int)blockIdx.x);
        pg8::EpiResB<false> E{RC, RC, ssq2, (unsigned char*)RA, S_X2, WXO_FP8 ? 1.f / (S_OX * S_WXO) : 1.f};
        pg8::gemm_phase<pg8::EpiResB<false>, pg8::StaticOrder, true, true, WXO_FP8 != 0>(F.lds, g, S, E);
        if (BOTH(7)) GRID_BAR();
    }
    if (IN(8)) {
        pg8::Gemm g{RA, (const pg8::bf16_t*)(ws + WS_WGU), M, 2 * FF, FFN_FP8 ? DM / 2 : DM}; pg8::StaticOrder S; S.init(M, 2 * FF, F.G, (int)blockIdx.x);
        pg8::EpiSwiGLU E{ACT, ssq2, FFN_FP8 ? (unsigned char*)ACT : nullptr, FFN_FP8 ? 1.f / (S_X2 * S_WGU) : 1.f, S_ACT};
#if NULL_EPI_PROBE
        if (REPS(8) == 2) { pg8::EpiNull EN{nullptr}; pg8::gemm_phase<pg8::EpiNull, pg8::StaticOrder, true, true, FFN_FP8 != 0>(F.lds, g, S, EN); }
        pg8::gemm_phase<pg8::EpiSwiGLU, pg8::StaticOrder, true, true, FFN_FP8 != 0>(F.lds, g, S, E);
#else
        for (int rep = 0; rep < REPS(8); ++rep) pg8::gemm_phase<pg8::EpiSwiGLU, pg8::StaticOrder, true, true, FFN_FP8 != 0>(F.lds, g, S, E);
#endif
        if (BOTH(8)) GRID_BAR();
    }
    if (IN(9)) {
        pg8::Gemm g{ACT, (const pg8::bf16_t*)(ws + WS_WDN), M, DM, FF / 2}; pg8::StaticOrder S; S.init(M, DM, F.G, (int)blockIdx.x);
        pg8::EpiResB<false> E{RC, RC, nullptr, nullptr, 1.f, 1.f / (S_ACT * S_WDN)};
        pg8::gemm_phase<pg8::EpiResB<false>, pg8::StaticOrder, true, true, true>(F.lds, g, S, E);
        if (BOTH(9)) GRID_BAR();
    }
    if (IN(10)) { F.g_final = (const float*)late_arg<16>(); final_norm_phase(F, RC, F.out); }
#undef IN
#undef BOTH
}

extern "C" void kernel_launch(void* const* d_in, const int* in_sizes, int n_in, void* d_out, int out_size, void* d_ws, size_t ws_size, hipStream_t stream) {
    static int grid = 0;
    if (grid == 0) {
        if (n_in != 17 || in_sizes[0] != M * DM || out_size != M * DM || ws_size < WS_END) { fprintf(stderr, "kernel_launch: unexpected shapes (n_in %d in0 %d out %d ws %zu)\n", n_in, n_in > 0 ? in_sizes[0] : -1, out_size, ws_size); grid = -1; return; }
        int dev = 0, cus = 0, per_cu = 0;
        if (hipGetDevice(&dev) != hipSuccess || hipDeviceGetAttribute(&cus, hipDeviceAttributeMultiprocessorCount, dev) != hipSuccess) { grid = -1; return; }
        if (hipFuncSetAttribute((const void*)mk_fwd, hipFuncAttributeMaxDynamicSharedMemorySize, LDS_BYTES) != hipSuccess) { fprintf(stderr, "kernel_launch: hipFuncSetAttribute failed\n"); grid = -1; return; }
        if (hipOccupancyMaxActiveBlocksPerMultiprocessor(&per_cu, (const void*)mk_fwd, NWAVES * 64, LDS_BYTES) != hipSuccess || per_cu < 1) { fprintf(stderr, "kernel_launch: occupancy query failed (%d)\n", per_cu); per_cu = 1; }
        (void)hipGetLastError();
        grid = cus * (per_cu < 1 ? 1 : 1);
    }
    if (grid < 0) return;
#if !MK_ONE_LAUNCH
    (void)hipMemsetAsync((char*)d_ws + WS_CTL, 0, CTL_ZERO_BYTES, stream);
#endif
    Args a{};
    for (int i = 0; i < 17; ++i) a.in[i] = d_in[i];
    a.out = (float*)d_out; a.ws = (unsigned char*)d_ws;
#if MK_ONE_LAUNCH
    a.ph_lo = 0; a.ph_hi = NPH;
    void* kargs[] = {&a};
    hipError_t e = hipLaunchCooperativeKernel((const void*)mk_fwd, dim3(grid), dim3(NWAVES * 64), kargs, LDS_BYTES, stream);
    if (e != hipSuccess) fprintf(stderr, "kernel_launch: cooperative launch failed: %s (grid %d)\n", hipGetErrorString(e), grid);
#else
    for (int p = 0; p < NPH; ++p) { a.ph_lo = p; a.ph_hi = p + 1; hipLaunchKernelGGL(mk_fwd, dim3(grid), dim3(NWAVES * 64), LDS_BYTES, stream, a); }
    const hipError_t le = hipPeekAtLastError();
    if (le != hipSuccess) fprintf(stderr, "kernel_launch: launch failed: %s\n", hipGetErrorName(le));
#endif
}
```

```cpp
#include <hip/hip_runtime.h>
#include <hip/hip_cooperative_groups.h>
#include <cstdio>
#include <cstdint>
namespace cg = cooperative_groups;
namespace pg8 {
#define PG8_LAS __attribute__((address_space(3)))
typedef unsigned short bf16_t;
typedef short bf16x8 __attribute__((ext_vector_type(8)));
typedef float f32x4 __attribute__((ext_vector_type(4)));
typedef unsigned u32x4 __attribute__((ext_vector_type(4)));
constexpr int BM = 256, BK = 64, HALF = 128, HTB = HALF * BK * 2  , STAGE_BYTES = 8 * HTB, NXCD = 8, WGM = 8;

__host__ __device__ __forceinline__ int lds_byte(int r, int c) { const int st = (r >> 4) * 2 + (c >> 5), rr = r & 15, cc = c & 31, ob = rr * 64 + cc * 2; return st * 1024 + (ob ^ (((ob >> 9) & 1) << 5)); }
__host__ __device__ __forceinline__ void stage_rc(int b, int& R, int& C) { const int st = b / 1024, sb = b % 1024, swz = sb ^ (((sb >> 9) & 1) << 5); R = (st >> 1) * 16 + swz / 64; C = (st & 1) * 32 + (swz % 64) / 2; }
__host__ __device__ __forceinline__ int perm32(int rho) { const int n = rho >> 4, i = rho & 15; return 8 * (i >> 2) + 4 * n + (i & 3); }

struct Unit { int pm, pn; };
struct Gemm { const bf16_t* A; const bf16_t* Bt; int M, N, K; };

struct StaticOrder {
    int nM, nN, nwg, G, c;
    __host__ __device__ void init(int M, int N, int G_, int c_) { nM = M / BM; nN = N / BM; nwg = nM * nN; G = G_; c = c_; }
    __host__ __device__ bool next(int i, Unit& u) const {
        const long L = (long)i * G + c; if (L >= nwg) return false;
        int wgid = (int)L; { const int q = nwg / NXCD, r = nwg % NXCD, xcd = wgid % NXCD, off = wgid / NXCD; wgid = (xcd < r ? xcd * (q + 1) : r * (q + 1) + (xcd - r) * q) + off; }
        const int nig = WGM * nN, gid = wgid / nig, fm = gid * WGM, gsz = (nM - fm) < WGM ? (nM - fm) : WGM;
        u.pm = fm + ((wgid % nig) % gsz); u.pn = (wgid % nig) / gsz; return true;
    }
    __device__ __forceinline__ void a_ready(const Unit&) const {}
    __device__ __forceinline__ void done(const Unit&) const {}
};

__device__ __forceinline__ unsigned cvt_pk_bf16(float lo, float hi) { unsigned r; asm volatile("v_cvt_pk_bf16_f32 %0, %1, %2" : "=v"(r) : "v"(lo), "v"(hi)); return r; }
typedef float f32x2 __attribute__((ext_vector_type(2)));
template <class Epi, class Sched, bool ALIGN_EPI = false, bool SP2 = false, bool FP8 = false>
__device__ __forceinline__ void gemm_phase(PG8_LAS unsigned char* lds, const Gemm g, const Sched& S, const Epi& E) {
    int tid_ = threadIdx.x; asm volatile("" : "+v"(tid_));
    const int tid = tid_, wid = __builtin_amdgcn_readfirstlane(tid >> 6), lane = tid & 63, wr = wid >> 2, wc = wid & 3, fr = lane & 15, fq = lane >> 4;
    const int K = g.K, nt = K / BK;
    unsigned voffA[2], voffB[2];
#pragma unroll
    for (int i = 0; i < 2; ++i) { int R, C; stage_rc(tid * 16 + i * 8192, R, C); const int Rb = Epi::PERM ? ((R & ~31) + perm32(R & 31)) : R;
        voffA[i] = (unsigned)(R * K + C) * 2u; voffB[i] = (unsigned)(Rb * K + C) * 2u; }
    const size_t kstep = (size_t)(BK * 2);
    const size_t hstep = (size_t)HALF * K * 2;
    const size_t tstep = 2 * hstep;
    const unsigned ldsw = (unsigned)wid * 1024u;
    const int aoff = lds_byte(wr * 64 + fr, fq * 8), boff = lds_byte(wc * 32 + fr, fq * 8);
#define PG8_SA(b, h) (((b) * 2 + (h)) * HTB)
#define PG8_SB(b, h) ((4 + (b) * 2 + (h)) * HTB)
#define PG8_STAGE(bufoff, gbase, voff) do { _Pragma("unroll") for (int _i = 0; _i < 2; ++_i) \
        __builtin_amdgcn_global_load_lds((const unsigned*)((const char*)(gbase) + (voff)[_i]), (PG8_LAS unsigned*)(lds + (bufoff) + ldsw + _i * 8192), 16, 0, 0); } while (0)
#define PG8_LD8(p) __builtin_shufflevector(*(const PG8_LAS i32x4_*)(p), *(const PG8_LAS i32x4_*)((p) + 1024), 0, 1, 2, 3, 4, 5, 6, 7)
#define PG8_LDA(dst, b, h) do { if constexpr (FP8) { _Pragma("unroll") for (int m = 0; m < 4; ++m) dst##8[m] = PG8_LD8(lds + PG8_SA(b, h) + aoff + m * 2048); } \
        else { _Pragma("unroll") for (int m = 0; m < 4; ++m) _Pragma("unroll") for (int k = 0; k < 2; ++k) dst[m][k] = *(const PG8_LAS bf16x8*)(lds + PG8_SA(b, h) + aoff + m * 2048 + k * 1024); } } while (0)
#define PG8_LDB(dst, b, h) do { if constexpr (FP8) { _Pragma("unroll") for (int n = 0; n < 2; ++n) dst##8[n] = PG8_LD8(lds + PG8_SB(b, h) + boff + n * 2048); } \
        else { _Pragma("unroll") for (int n = 0; n < 2; ++n) _Pragma("unroll") for (int k = 0; k < 2; ++k) dst[n][k] = *(const PG8_LAS bf16x8*)(lds + PG8_SB(b, h) + boff + n * 2048 + k * 1024); } } while (0)
#define PG8_MMA(ai, bj, At, Bt) do { __builtin_amdgcn_s_setprio(1); _Pragma("unroll") for (int m = 0; m < 4; ++m) _Pragma("unroll") for (int n = 0; n < 2; ++n) { \
        if constexpr (FP8) asm volatile("v_mfma_scale_f32_16x16x128_f8f6f4 %0, %1, %2, %0, %3, %3 op_sel_hi:[0,0,0]" : "+v"(acc[ai][bj][m][n]) : "v"(Bt##8[n]), "v"(At##8[m]), "v"(sc1_)); \
        else { _Pragma("unroll") for (int k = 0; k < 2; ++k) acc[ai][bj][m][n] = __builtin_amdgcn_mfma_f32_16x16x32_bf16(Bt[n][k], At[m][k], acc[ai][bj][m][n], 0, 0, 0); } } \
        __builtin_amdgcn_s_setprio(0); } while (0)
#define PG8_WAIT_V(n) asm volatile("s_waitcnt vmcnt(" #n ")" ::: "memory")
#define PG8_WAIT_L(n) asm volatile("s_waitcnt lgkmcnt(" #n ")" ::: "memory")
#define PG8_BAR __builtin_amdgcn_s_barrier()
#define PG8_SCHED __builtin_amdgcn_sched_barrier(0)
    Unit cur, nxt; int ui = 0;
    if (!S.next(0, cur)) return;
    f32x4 acc[2][2][4][2];
#pragma unroll
    for (int a = 0; a < 2; ++a)
#pragma unroll
        for (int b = 0; b < 2; ++b)
#pragma unroll
            for (int m = 0; m < 4; ++m)
#pragma unroll
                for (int n = 0; n < 2; ++n) acc[a][b][m][n] = (f32x4){0.f, 0.f, 0.f, 0.f};
    typedef int i32x4_ __attribute__((ext_vector_type(4))); typedef int i32x8_ __attribute__((ext_vector_type(8)));
    int sc1_ = 0x7F7F7F7F; asm volatile("" : "+v"(sc1_));
    bf16x8 At[4][2], B0[2][2], B1[2][2]; i32x8_ At8[4], B08[2], B18[2];
    const char* cA = (const char*)g.A + (size_t)cur.pm * tstep; const char* cB = (const char*)g.Bt + (size_t)cur.pn * tstep;
    S.a_ready(cur);
    if constexpr (SP2) {
        PG8_STAGE(PG8_SB(0, 0), cB, voffB); PG8_STAGE(PG8_SB(0, 1), cB + hstep, voffB); PG8_STAGE(PG8_SA(0, 0), cA, voffA); PG8_STAGE(PG8_SA(0, 1), cA + hstep, voffA);
        if (wr == 1) PG8_BAR;
        PG8_WAIT_V(2); PG8_BAR;
        PG8_STAGE(PG8_SB(1, 0), cB + kstep, voffB); PG8_STAGE(PG8_SA(1, 0), cA + kstep, voffA); PG8_STAGE(PG8_SB(1, 1), cB + hstep + kstep, voffB);
        PG8_WAIT_V(6); PG8_BAR;
    } else {
        PG8_STAGE(PG8_SB(0, 0), cB, voffB); PG8_STAGE(PG8_SA(0, 0), cA, voffA); PG8_STAGE(PG8_SB(0, 1), cB + hstep, voffB); PG8_STAGE(PG8_SA(0, 1), cA + hstep, voffA);
        if (wr == 1) PG8_BAR;
        PG8_WAIT_V(4); PG8_BAR;
        PG8_STAGE(PG8_SB(1, 0), cB + kstep, voffB); PG8_STAGE(PG8_SA(1, 0), cA + kstep, voffA); PG8_STAGE(PG8_SB(1, 1), cB + hstep + kstep, voffB);
        PG8_WAIT_V(6); PG8_BAR;
    }
    for (;;) {
        const bool has_next = S.next(ui + 1, nxt);
        const char* nA = has_next ? (const char*)g.A + (size_t)nxt.pm * tstep : cA; const char* nB = has_next ? (const char*)g.Bt + (size_t)nxt.pn * tstep : cB;
        for (int t = 0; t < nt; t += 2) {
            const bool last = (t == nt - 2);
            const char* a1 = cA + (size_t)(t + 1) * kstep;
            const char* a2 = last ? nA : cA + (size_t)(t + 2) * kstep; const char* b2 = last ? nB : cB + (size_t)(t + 2) * kstep;
            const char* a3 = a2 + kstep; const char* b3 = b2 + kstep;
            if (last && has_next) S.a_ready(nxt);
            if constexpr (SP2) {
            PG8_LDB(B0, 0, 0); PG8_LDB(B1, 0, 1); PG8_SCHED; PG8_LDA(At, 0, 0); PG8_STAGE(PG8_SA(1, 1), a1 + hstep, voffA);
            PG8_WAIT_V(8); PG8_WAIT_L(0); PG8_BAR; PG8_MMA(0, 0, At, B0); PG8_MMA(0, 1, At, B1); PG8_BAR; PG8_SCHED;
            PG8_LDA(At, 0, 1); PG8_STAGE(PG8_SB(0, 0), b2, voffB); PG8_STAGE(PG8_SB(0, 1), b2 + hstep, voffB); PG8_STAGE(PG8_SA(0, 0), a2, voffA);
            PG8_WAIT_V(8); PG8_WAIT_L(0); PG8_BAR; PG8_MMA(1, 0, At, B0); PG8_MMA(1, 1, At, B1); PG8_BAR; PG8_SCHED;
            PG8_LDB(B0, 1, 0); PG8_LDB(B1, 1, 1); PG8_SCHED; PG8_LDA(At, 1, 0); PG8_STAGE(PG8_SA(0, 1), a2 + hstep, voffA);
            PG8_WAIT_V(8); PG8_WAIT_L(0); PG8_BAR; PG8_MMA(0, 0, At, B0); PG8_MMA(0, 1, At, B1); PG8_BAR; PG8_SCHED;
            PG8_LDA(At, 1, 1); PG8_STAGE(PG8_SB(1, 0), b3, voffB); PG8_STAGE(PG8_SB(1, 1), b3 + hstep, voffB); PG8_STAGE(PG8_SA(1, 0), a3, voffA);
            PG8_WAIT_V(8); PG8_WAIT_L(0); PG8_BAR; PG8_MMA(1, 0, At, B0); PG8_MMA(1, 1, At, B1); PG8_BAR; PG8_SCHED;
            } else {
            PG8_LDB(B0, 0, 0); PG8_SCHED; PG8_LDA(At, 0, 0); PG8_STAGE(PG8_SA(1, 1), a1 + hstep, voffA);
            PG8_WAIT_L(8); PG8_BAR; PG8_WAIT_L(0); PG8_MMA(0, 0, At, B0); PG8_BAR; PG8_SCHED;
            PG8_LDB(B1, 0, 1); PG8_STAGE(PG8_SB(0, 0), b2, voffB);
            PG8_BAR; PG8_WAIT_L(0); PG8_MMA(0, 1, At, B1); PG8_BAR;
            PG8_LDA(At, 0, 1); PG8_STAGE(PG8_SA(0, 0), a2, voffA);
            PG8_BAR; PG8_WAIT_L(0); PG8_MMA(1, 0, At, B0); PG8_BAR; PG8_SCHED;
            PG8_STAGE(PG8_SB(0, 1), b2 + hstep, voffB);
            PG8_WAIT_V(6); PG8_BAR; PG8_MMA(1, 1, At, B1); PG8_BAR;
            PG8_LDB(B0, 1, 0); PG8_SCHED; PG8_LDA(At, 1, 0); PG8_STAGE(PG8_SA(0, 1), a2 + hstep, voffA);
            PG8_WAIT_L(8); PG8_BAR; PG8_WAIT_L(0); PG8_MMA(0, 0, At, B0); PG8_BAR; PG8_SCHED;
            PG8_LDB(B1, 1, 1); PG8_STAGE(PG8_SB(1, 0), b3, voffB);
            PG8_BAR; PG8_WAIT_L(0); PG8_MMA(0, 1, At, B1); PG8_BAR;
            PG8_LDA(At, 1, 1); PG8_STAGE(PG8_SA(1, 0), a3, voffA);
            PG8_BAR; PG8_WAIT_L(0); PG8_MMA(1, 0, At, B0); PG8_BAR; PG8_SCHED;
            PG8_STAGE(PG8_SB(1, 1), b3 + hstep, voffB);
            PG8_WAIT_V(6); PG8_BAR; PG8_MMA(1, 1, At, B1); PG8_BAR;
            }
        }
        if constexpr (ALIGN_EPI) { if (wr == 0) PG8_BAR; }
        if constexpr (FP8) asm volatile("s_nop 15\n\ts_nop 15" ::: "memory");
        if constexpr (!Epi::AFTER_DRAIN) { E(acc, cur, wr, wc, fr, fq); S.done(cur); }
        if (!has_next) break;
#pragma unroll
        for (int a = 0; a < 2; ++a)
#pragma unroll
            for (int b = 0; b < 2; ++b)
#pragma unroll
                for (int m = 0; m < 4; ++m)
#pragma unroll
                    for (int n = 0; n < 2; ++n) acc[a][b][m][n] = (f32x4){0.f, 0.f, 0.f, 0.f};
        cur = nxt; cA = nA; cB = nB; ++ui;
        if constexpr (ALIGN_EPI) { if (wr == 1) PG8_BAR; }
    }
    PG8_WAIT_V(0);
    if constexpr (!ALIGN_EPI) { if (wr == 0) PG8_BAR; }
    PG8_BAR;
    if constexpr (Epi::AFTER_DRAIN) { E.fused(acc, cur, wr, wc, fr, fq, lds, wid, lane); S.done(cur); }
#undef PG8_SA
#undef PG8_SB
#undef PG8_STAGE
#undef PG8_LDA
#undef PG8_LD8
#undef PG8_LDB
#undef PG8_MMA
#undef PG8_WAIT_V
#undef PG8_WAIT_L
#undef PG8_BAR
#undef PG8_SCHED
}
}
namespace pg8 {
typedef unsigned u32x2 __attribute__((ext_vector_type(2)));
constexpr int LDX = 2048;
constexpr float RMS_EPS = 1e-6f;
#ifndef EPI_SC1
#define EPI_SC1 1
#endif
__device__ __forceinline__ void store16(void* p, u32x4 w) {
#if EPI_SC1
    asm volatile("global_store_dwordx4 %0, %1, off sc1\n\ts_nop 1" :: "v"(p), "v"(w) : "memory");
#else
    *(u32x4*)p = w;
#endif
}
struct EpiQKV {
    static constexpr bool PERM = true, AFTER_DRAIN = false;
    bf16_t* O; const float* cs; float qscale; float* ksum; int vmode; float vscale; const float* rinv;
    __device__ __forceinline__ void operator()(const f32x4 (&acc)[2][2][4][2], const Unit& u, int wr, int wc, int fr, int fq) const {
        const int row0 = u.pm * BM + wr * 64 + fr, pn = vmode ? (u.pn < 4 ? u.pn + 8 : u.pn + 16) : (u.pn < 8 ? u.pn : u.pn + 4);
        const float sc = (pn < 4 || (pn >= 12 && pn < 16)) ? qscale : vscale;
        const bool rot = (pn >= 12 && pn < 20) && (wc == 0);
        bf16_t* Ot = O + ((size_t)((u.pm >> 3) * 6 + (pn >> 2)) * 8 + (pn & 3) * 2) * (2048 * 128) + wc * 32 + 8 * fq;
        const bool kacc = (pn >= 16 && pn < 20);
        float rf[2][4];
#pragma unroll
        for (int ai = 0; ai < 2; ++ai)
#pragma unroll
            for (int m = 0; m < 4; ++m) rf[ai][m] = rinv[row0 + ai * HALF + m * 16];
        f32x4 ks[2][2] = {{{0.f, 0.f, 0.f, 0.f}, {0.f, 0.f, 0.f, 0.f}}, {{0.f, 0.f, 0.f, 0.f}, {0.f, 0.f, 0.f, 0.f}}};
#pragma unroll
        for (int ai = 0; ai < 2; ++ai)
#pragma unroll
            for (int m = 0; m < 4; ++m) { const int row = row0 + ai * HALF + m * 16; bf16_t* rowp = Ot + (size_t)(row & 2047) * 128;
                f32x4 c0 = {1.f, 1.f, 1.f, 1.f}, c1 = c0, s0 = {0.f, 0.f, 0.f, 0.f}, s1 = s0;
                if (rot) { const float* cr = cs + (size_t)row * 32 + 8 * (fq & 1); c0 = *(const f32x4*)cr; c1 = *(const f32x4*)(cr + 4); s0 = *(const f32x4*)(cr + 16); s1 = *(const f32x4*)(cr + 20);
                    if (fq < 2) { s0 = -s0; s1 = -s1; } }
#pragma unroll
                for (int bj = 0; bj < 2; ++bj) { f32x4 v0 = acc[ai][bj][m][0] * rf[ai][m], v1 = acc[ai][bj][m][1] * rf[ai][m];
                    if (rot) { f32x4 p0, p1;
#pragma unroll
                        for (int j = 0; j < 4; ++j) { p0[j] = __shfl_xor(v0[j], 32); p1[j] = __shfl_xor(v1[j], 32); }
                        v0 = v0 * c0 + p0 * s0; v1 = v1 * c1 + p1 * s1; }
                    if (kacc) { ks[bj][0] += v0; ks[bj][1] += v1; }
                    v0 = v0 * sc; v1 = v1 * sc; u32x4 w; w.x = cvt_pk_bf16(v0[0], v0[1]); w.y = cvt_pk_bf16(v0[2], v0[3]); w.z = cvt_pk_bf16(v1[0], v1[1]); w.w = cvt_pk_bf16(v1[2], v1[3]);
                    store16(rowp + (size_t)bj * (2048 * 128), w); } }
        if (kacc) {
            float* kp = ksum + (size_t)(((u.pm >> 3) * 8 + (pn - 16) * 2) * 8 + (u.pm & 7)) * 128 + wc * 32 + 8 * fq;
#pragma unroll
            for (int bj = 0; bj < 2; ++bj)
#pragma unroll
                for (int n = 0; n < 2; ++n)
#pragma unroll
                    for (int j = 0; j < 4; ++j) { float s = ks[bj][n][j]; s += __shfl_xor(s, 1); s += __shfl_xor(s, 2); s += __shfl_xor(s, 4); s += __shfl_xor(s, 8);
                        if (fr == 0) atomicAdd(kp + bj * 1024 + n * 4 + j, s); }
        }
    }
};
__device__ __forceinline__ unsigned pk4_fp8(float a, float b, float c, float d) {
    a = __builtin_amdgcn_fmed3f(a, -448.f, 448.f); b = __builtin_amdgcn_fmed3f(b, -448.f, 448.f); c = __builtin_amdgcn_fmed3f(c, -448.f, 448.f); d = __builtin_amdgcn_fmed3f(d, -448.f, 448.f);
    int p = __builtin_amdgcn_cvt_pk_fp8_f32(a, b, 0, false); p = __builtin_amdgcn_cvt_pk_fp8_f32(c, d, p, true); return (unsigned)p; }
struct EpiRes {
    static constexpr bool PERM = false, AFTER_DRAIN = false;
    const float* base; float* out; bf16_t* xb; float* ssq; unsigned char* x8; float s8; float ascale;
    __device__ __forceinline__ void operator()(const f32x4 (&acc)[2][2][4][2], const Unit& u, int wr, int wc, int fr, int fq) const {
        const int row0 = u.pm * BM + wr * 64 + fr, col0 = u.pn * BM + wc * 32 + 4 * fq;
#pragma unroll
        for (int ai = 0; ai < 2; ++ai)
#pragma unroll
            for (int m = 0; m < 4; ++m) { const int row = row0 + ai * HALF + m * 16; const size_t off = (size_t)row * LDX + col0; float s = 0.f;
#pragma unroll
                for (int bj = 0; bj < 2; ++bj)
#pragma unroll
                    for (int n = 0; n < 2; ++n) { const f32x4 v = *(const f32x4*)(base + off + bj * HALF + n * 16) + acc[ai][bj][m][n] * ascale;
                        *(f32x4*)(out + off + bj * HALF + n * 16) = v; s += (v[0] * v[0] + v[1] * v[1]) + (v[2] * v[2] + v[3] * v[3]);
                        if (xb) { u32x2 w; w.x = cvt_pk_bf16(v[0], v[1]); w.y = cvt_pk_bf16(v[2], v[3]); *(u32x2*)(xb + off + bj * HALF + n * 16) = w; }
                        if (x8) { *(unsigned*)(x8 + off + bj * HALF + n * 16) = pk4_fp8(v[0] * s8, v[1] * s8, v[2] * s8, v[3] * s8); } }
                if (ssq) { s += __shfl_xor(s, 16); s += __shfl_xor(s, 32); if (fq == 0) atomicAdd(ssq + row, s); }
                asm volatile("" ::: "memory"); }
    }
};
template <bool BASE_F32> struct EpiResB {
    static constexpr bool PERM = true, AFTER_DRAIN = false;
    const void* base; bf16_t* xo; float* ssq; unsigned char* x8; float s8; float ascale;
    __device__ __forceinline__ void operator()(const f32x4 (&acc)[2][2][4][2], const Unit& u, int wr, int wc, int fr, int fq) const {
        const int row0 = u.pm * BM + wr * 64 + fr, col0 = u.pn * BM + wc * 32 + 8 * fq;
#pragma unroll
        for (int ai = 0; ai < 2; ++ai)
#pragma unroll
            for (int m = 0; m < 4; ++m) { const int row = row0 + ai * HALF + m * 16; const size_t off = (size_t)row * LDX + col0; float s = 0.f;
#pragma unroll
                for (int bj = 0; bj < 2; ++bj) { f32x4 b0, b1;
                    if (BASE_F32) { const float* bp = (const float*)base + off + bj * HALF; b0 = *(const f32x4*)bp; b1 = *(const f32x4*)(bp + 4); }
                    else { const u32x4 w = *(const u32x4*)((const bf16_t*)base + off + bj * HALF);
                        b0 = (f32x4){__uint_as_float(w.x << 16), __uint_as_float(w.x & 0xffff0000u), __uint_as_float(w.y << 16), __uint_as_float(w.y & 0xffff0000u)};
                        b1 = (f32x4){__uint_as_float(w.z << 16), __uint_as_float(w.z & 0xffff0000u), __uint_as_float(w.w << 16), __uint_as_float(w.w & 0xffff0000u)}; }
                    const f32x4 v0 = b0 + acc[ai][bj][m][0] * ascale, v1 = b1 + acc[ai][bj][m][1] * ascale;
                    s += ((v0[0] * v0[0] + v0[1] * v0[1]) + (v0[2] * v0[2] + v0[3] * v0[3])) + ((v1[0] * v1[0] + v1[1] * v1[1]) + (v1[2] * v1[2] + v1[3] * v1[3]));
                    if (xo) { u32x4 w; w.x = cvt_pk_bf16(v0[0], v0[1]); w.y = cvt_pk_bf16(v0[2], v0[3]); w.z = cvt_pk_bf16(v1[0], v1[1]); w.w = cvt_pk_bf16(v1[2], v1[3]); store16(xo + off + bj * HALF, w); }
                    if (x8) { u32x2 w8; w8.x = pk4_fp8(v0[0] * s8, v0[1] * s8, v0[2] * s8, v0[3] * s8); w8.y = pk4_fp8(v1[0] * s8, v1[1] * s8, v1[2] * s8, v1[3] * s8); *(u32x2*)(x8 + off + bj * HALF) = w8; } }
                if (ssq) { s += __shfl_xor(s, 16); s += __shfl_xor(s, 32); if (fq == 0) atomicAdd(ssq + row, s); }
                if (BASE_F32 ? (m & 1) : (m == 3)) asm volatile("" ::: "memory"); }
    }
};
struct EpiScale {
    static constexpr bool PERM = true, AFTER_DRAIN = false;
    bf16_t* O; int ldc; const float* ssq; float sc;
    __device__ __forceinline__ void operator()(const f32x4 (&acc)[2][2][4][2], const Unit& u, int wr, int wc, int fr, int fq) const {
        const int row0 = u.pm * BM + wr * 64 + fr, col0 = u.pn * BM + wc * 32 + 8 * fq;
        float sv[2][4];
#pragma unroll
        for (int ai = 0; ai < 2; ++ai)
#pragma unroll
            for (int m = 0; m < 4; ++m) sv[ai][m] = ssq ? ssq[row0 + ai * HALF + m * 16] : 0.f;
#pragma unroll
        for (int ai = 0; ai < 2; ++ai)
#pragma unroll
            for (int m = 0; m < 4; ++m) { const int row = row0 + ai * HALF + m * 16; bf16_t* rowp = O + (size_t)row * ldc + col0;
                const float f = ssq ? sc * __builtin_amdgcn_rsqf(sv[ai][m] * (1.0f / 2048.0f) + RMS_EPS) : sc;
#pragma unroll
                for (int bj = 0; bj < 2; ++bj) { const f32x4 v0 = acc[ai][bj][m][0] * f, v1 = acc[ai][bj][m][1] * f;
                    u32x4 w; w.x = cvt_pk_bf16(v0[0], v0[1]); w.y = cvt_pk_bf16(v0[2], v0[3]); w.z = cvt_pk_bf16(v1[0], v1[1]); w.w = cvt_pk_bf16(v1[2], v1[3]);
                    *(u32x4*)(rowp + bj * HALF) = w; } }
    }
};
struct EpiNull { static constexpr bool PERM = true, AFTER_DRAIN = false; float* sink;
    __device__ __forceinline__ void operator()(const f32x4 (&acc)[2][2][4][2], const Unit& u, int wr, int wc, int fr, int fq) const {
#pragma unroll
        for (int ai = 0; ai < 2; ++ai)
#pragma unroll
            for (int bj = 0; bj < 2; ++bj)
#pragma unroll
                for (int m = 0; m < 4; ++m)
#pragma unroll
                    for (int n = 0; n < 2; ++n) asm volatile("" :: "v"(acc[ai][bj][m][n])); } };
struct EpiSwiGLU {
    static constexpr bool PERM = true, AFTER_DRAIN = false;
    bf16_t* O; const float* ssq; unsigned char* O8; float ascale, oscale;
    __device__ __forceinline__ void operator()(const f32x4 (&acc)[2][2][4][2], const Unit& u, int wr, int wc, int fr, int fq) const {
        const int row0 = u.pm * BM + wr * 64 + fr, col0 = u.pn * HALF + wc * 32 + 8 * fq;
        float sv[2][4];
#pragma unroll
        for (int ai = 0; ai < 2; ++ai)
#pragma unroll
            for (int m = 0; m < 4; ++m) sv[ai][m] = ssq[row0 + ai * HALF + m * 16];
#pragma unroll
        for (int ai = 0; ai < 2; ++ai)
#pragma unroll
            for (int m = 0; m < 4; ++m) { const int row = row0 + ai * HALF + m * 16; bf16_t* rowp = O + (size_t)row * 5632 + col0;
                const float f = ascale * __builtin_amdgcn_rsqf(sv[ai][m] * (1.0f / 2048.0f) + RMS_EPS);
                const float fneg = -1.4426950408889634f * f, f2o = f * f * (O8 ? oscale : 1.0f);
                float r[8];
#pragma unroll
                for (int n = 0; n < 2; ++n)
#pragma unroll
                    for (int j = 0; j < 4; ++j) { const float ag = acc[ai][0][m][n][j], au = acc[ai][1][m][n][j];
                        r[n * 4 + j] = (ag * au) * (f2o * __builtin_amdgcn_rcpf(1.0f + __builtin_amdgcn_exp2f(fneg * ag))); }
                if (O8) { u32x2 w8; w8.x = pk4_fp8(r[0], r[1], r[2], r[3]); w8.y = pk4_fp8(r[4], r[5], r[6], r[7]);
                    *(u32x2*)(O8 + (size_t)row * 5632 + col0) = w8; }
                else { u32x4 w; w.x = cvt_pk_bf16(r[0], r[1]); w.y = cvt_pk_bf16(r[2], r[3]); w.z = cvt_pk_bf16(r[4], r[5]); w.w = cvt_pk_bf16(r[6], r[7]);
                *(u32x4*)rowp = w; } }
    }
};
}
namespace att {
using bf16x8 = __attribute__((ext_vector_type(8))) short;
using s16x4  = __attribute__((ext_vector_type(4))) short;
using f32x16 = __attribute__((ext_vector_type(16))) float;
using f32x4  = __attribute__((ext_vector_type(4))) float;
using u32x4  = __attribute__((ext_vector_type(4))) unsigned;
typedef unsigned short bf16;
constexpr int D = 128, KVBLK = 64;
constexpr int SHM_V = KVBLK * D * 2, SHM_K = KVBLK * D * 2;
constexpr int OFF_Q = 2 * SHM_V + 2 * SHM_K, OFF_WS = 131072 + 1024, OFF_KM = OFF_WS + 2048, ATT_LDS = OFF_KM + 4096;
constexpr float THR = 8.f;
constexpr float SB_DONE = 7.8886e-31f;
#ifndef QREG_SOFTMAX
#define QREG_SOFTMAX 1
#endif
#ifndef PIPE_SOFTMAX
#define PIPE_SOFTMAX 0
#endif
#define KSWZ(row, colB) ((row) * 256 + ((colB) ^ (((row) & 7) << 4)))
#define SBAR() __builtin_amdgcn_sched_barrier(0)
__device__ __forceinline__ int crow(int r, int hi) { return (r & 3) + 8 * (r >> 2) + 4 * hi; }
__device__ __forceinline__ unsigned cvtpk(float lo, float hi) { unsigned r; asm volatile("v_cvt_pk_bf16_f32 %0, %1, %2" : "=v"(r) : "v"(lo), "v"(hi)); return r; }
__device__ __forceinline__ float xchg32(float x, int hi) { auto rr = __builtin_amdgcn_permlane32_swap(__float_as_uint(x), __float_as_uint(x), false, false); return __uint_as_float(hi ? rr[0] : rr[1]); }
typedef __attribute__((address_space(3))) const char* lds_cp;
template <int D0> __device__ __forceinline__ void qkt_part(f32x16& p0, f32x16& p1, const lds_cp (&ka)[2][4], int boff, const lds_cp (&qa)[2][4]) {
  const bf16x8 qf = *reinterpret_cast<const __attribute__((address_space(3))) bf16x8*>(qa[D0 >> 2][D0 & 3]);
  const bf16x8 b0 = *reinterpret_cast<const __attribute__((address_space(3))) bf16x8*>(ka[D0 >> 2][D0 & 3] + boff);
  const bf16x8 b1 = *reinterpret_cast<const __attribute__((address_space(3))) bf16x8*>(ka[D0 >> 2][D0 & 3] + boff + 8192);
  p0 = __builtin_amdgcn_mfma_f32_32x32x16_bf16(b0, qf, p0, 0, 0, 0);
  p1 = __builtin_amdgcn_mfma_f32_32x32x16_bf16(b1, qf, p1, 0, 0, 0);
}
template <int D0> __device__ __forceinline__ void qkt_part(f32x16& p0, f32x16& p1, const lds_cp (&ka)[2][4], int boff, const bf16x8 (&qg)[8]) {
  const bf16x8 b0 = *reinterpret_cast<const __attribute__((address_space(3))) bf16x8*>(ka[D0 >> 2][D0 & 3] + boff);
  const bf16x8 b1 = *reinterpret_cast<const __attribute__((address_space(3))) bf16x8*>(ka[D0 >> 2][D0 & 3] + boff + 8192);
  p0 = __builtin_amdgcn_mfma_f32_32x32x16_bf16(b0, qg[D0], p0, 0, 0, 0);
  p1 = __builtin_amdgcn_mfma_f32_32x32x16_bf16(b1, qg[D0], p1, 0, 0, 0);
}
#define KLD(G, A0, A1) do { A0 = *reinterpret_cast<const __attribute__((address_space(3))) bf16x8*>(ka[(G) >> 2][(G) & 3] + boff); A1 = *reinterpret_cast<const __attribute__((address_space(3))) bf16x8*>(ka[(G) >> 2][(G) & 3] + boff + 8192); } while (0)
#define KMM(G, A0, A1) do { p0 = __builtin_amdgcn_mfma_f32_32x32x16_bf16(A0, qg[G], p0, 0, 0, 0); p1 = __builtin_amdgcn_mfma_f32_32x32x16_bf16(A1, qg[G], p1, 0, 0, 0); } while (0)
__device__ __forceinline__ void qkt(f32x16& p0, f32x16& p1, const lds_cp (&ka)[2][4], int boff, const bf16x8 (&qg)[8], float bias = 0.f) {
#pragma unroll
  for (int r = 0; r < 16; ++r) { p0[r] = bias; p1[r] = bias; }
  bf16x8 a0, a1, b0, b1, c0, c1, d0, d1;
  KLD(0, a0, a1); KLD(1, b0, b1); KLD(2, c0, c1); KLD(3, d0, d1); SBAR();
  KMM(0, a0, a1); SBAR(); KLD(4, a0, a1); SBAR();
  KMM(1, b0, b1); SBAR(); KLD(5, b0, b1); SBAR();
  KMM(2, c0, c1); SBAR(); KLD(6, c0, c1); SBAR();
  KMM(3, d0, d1); SBAR(); KLD(7, d0, d1); SBAR();
  KMM(4, a0, a1); KMM(5, b0, b1); KMM(6, c0, c1); KMM(7, d0, d1);
}
#undef KLD
#undef KMM
__device__ __forceinline__ void qkt(f32x16& p0, f32x16& p1, const lds_cp (&ka)[2][4], int boff, const lds_cp (&qr)[2][4], float bias = 0.f) {
#pragma unroll
  for (int r = 0; r < 16; ++r) { p0[r] = bias; p1[r] = bias; }
  qkt_part<0>(p0, p1, ka, boff, qr); qkt_part<1>(p0, p1, ka, boff, qr); qkt_part<2>(p0, p1, ka, boff, qr); qkt_part<3>(p0, p1, ka, boff, qr);
  qkt_part<4>(p0, p1, ka, boff, qr); qkt_part<5>(p0, p1, ka, boff, qr); qkt_part<6>(p0, p1, ka, boff, qr); qkt_part<7>(p0, p1, ka, boff, qr);
}
__device__ __forceinline__ int v_st(int k, int c) { const int kk = (k & ~0xC) | ((k & 4) << 1) | ((k & 8) >> 1); return ((kk >> 3) * 4 + (c >> 5)) * 512 + ((kk & 7) * 32 + (c & 31)) * 2; }
__device__ __forceinline__ int v_rd_base(int lane) { return ((lane & 3) << 3) | (((lane >> 2) & 3) << 6) | (((lane >> 4) & 1) << 5) | (((lane >> 5) & 1) << 8); }
constexpr int v_rd_off(int d0, int ks, int half) { return d0 * 512 + ks * 4096 + half * 2048; }
template <int OFF> __device__ __forceinline__ s16x4 tr_read(int vb) { s16x4 r; asm volatile("ds_read_b64_tr_b16 %0, %1 offset:%2" : "=&v"(r) : "v"(vb), "i"(OFF) : "memory"); return r; }
struct VFrag { s16x4 l0, h0, l1, h1, l2, h2, l3, h3; };
template <int D0> __device__ __forceinline__ void v_read(VFrag& f, int vb) {
  f.l0 = tr_read<v_rd_off(D0, 0, 0)>(vb); f.h0 = tr_read<v_rd_off(D0, 0, 1)>(vb); f.l1 = tr_read<v_rd_off(D0, 1, 0)>(vb); f.h1 = tr_read<v_rd_off(D0, 1, 1)>(vb);
  f.l2 = tr_read<v_rd_off(D0, 2, 0)>(vb); f.h2 = tr_read<v_rd_off(D0, 2, 1)>(vb); f.l3 = tr_read<v_rd_off(D0, 3, 0)>(vb); f.h3 = tr_read<v_rd_off(D0, 3, 1)>(vb);
}
__device__ __forceinline__ void pv_mma(f32x16& od, const VFrag& f, bf16x8 pa0, bf16x8 pa1, bf16x8 pa2, bf16x8 pa3) {
#define PK(L, H) (bf16x8){L[0], L[1], L[2], L[3], H[0], H[1], H[2], H[3]}
  od = __builtin_amdgcn_mfma_f32_32x32x16_bf16(pa0, PK(f.l0, f.h0), od, 0, 0, 0);
  od = __builtin_amdgcn_mfma_f32_32x32x16_bf16(pa1, PK(f.l1, f.h1), od, 0, 0, 0);
  od = __builtin_amdgcn_mfma_f32_32x32x16_bf16(pa2, PK(f.l2, f.h2), od, 0, 0, 0);
  od = __builtin_amdgcn_mfma_f32_32x32x16_bf16(pa3, PK(f.l3, f.h3), od, 0, 0, 0);
#undef PK
}
__device__ __forceinline__ void pv_d0(f32x16* o, int vb, bf16x8 pa0, bf16x8 pa1, bf16x8 pa2, bf16x8 pa3) {
  VFrag fa, fb;
  v_read<0>(fa, vb);
  v_read<1>(fb, vb); asm volatile("s_waitcnt lgkmcnt(8)" ::: "memory"); SBAR(); pv_mma(o[0], fa, pa0, pa1, pa2, pa3); SBAR();
  v_read<2>(fa, vb); asm volatile("s_waitcnt lgkmcnt(8)" ::: "memory"); SBAR(); pv_mma(o[1], fb, pa0, pa1, pa2, pa3); SBAR();
  v_read<3>(fb, vb); asm volatile("s_waitcnt lgkmcnt(8)" ::: "memory"); SBAR(); pv_mma(o[2], fa, pa0, pa1, pa2, pa3); SBAR();
  asm volatile("s_waitcnt lgkmcnt(0)" ::: "memory"); SBAR(); pv_mma(o[3], fb, pa0, pa1, pa2, pa3);
}
__device__ __forceinline__ void pack_p(const f32x16& p0, const f32x16& p1, bf16x8& pa0, bf16x8& pa1, bf16x8& pa2, bf16x8& pa3) {
#define PK4(P, BASE, OUT) do { unsigned a0 = cvtpk(P[BASE + 0], P[BASE + 1]), a1 = cvtpk(P[BASE + 2], P[BASE + 3]);   \
    unsigned b0 = cvtpk(P[BASE + 4], P[BASE + 5]), b1 = cvtpk(P[BASE + 6], P[BASE + 7]);                              \
    auto r0 = __builtin_amdgcn_permlane32_swap(a0, b0, false, false); auto r1 = __builtin_amdgcn_permlane32_swap(a1, b1, false, false); \
    u32x4 w = {r0[0], r1[0], r0[1], r1[1]}; OUT = *reinterpret_cast<bf16x8*>(&w); } while (0)
  PK4(p0, 0, pa0); PK4(p0, 8, pa1); PK4(p1, 0, pa2); PK4(p1, 8, pa3);
#undef PK4
}
__device__ __forceinline__ void softmax_tile(f32x16& p0, f32x16& p1, float& m_reg, float& l_reg, float& alpha) {
  float pmax = p0[0];
#pragma unroll
  for (int r = 1; r < 16; ++r) pmax = fmaxf(pmax, p0[r]);
#pragma unroll
  for (int r = 0; r < 16; ++r) pmax = fmaxf(pmax, p1[r]);
  pmax = fmaxf(pmax, xchg32(pmax, (int)(threadIdx.x >> 5) & 1));
  if (__all(pmax - m_reg <= THR)) { alpha = 1.f; }
  else { const float mn = fmaxf(m_reg, pmax); alpha = __builtin_amdgcn_exp2f(m_reg - mn); m_reg = mn; }
  float ps = 0.f;
#pragma unroll
  for (int r = 0; r < 16; ++r) { p0[r] = __builtin_amdgcn_exp2f(p0[r] - m_reg); ps += p0[r]; }
#pragma unroll
  for (int r = 0; r < 16; ++r) { p1[r] = __builtin_amdgcn_exp2f(p1[r] - m_reg); ps += p1[r]; }
  ps += xchg32(ps, (int)(threadIdx.x >> 5) & 1);
  l_reg = l_reg * alpha + ps;
}
template <bool BAND, int I> __device__ __forceinline__ float sb_group(f32x16& P, int kb, int qrel, int hi) {
  float run = 1.f;
#pragma unroll
  for (int e = 3; e >= 0; --e) { const int r = 4 * I + e; float rr = __builtin_amdgcn_rcpf(1.0f + __builtin_amdgcn_exp2f(P[r]));
    if (BAND) rr = (kb + crow(r, hi) < qrel) ? rr : 1.f;
    P[r] = (1.0f - rr) * run; run *= rr; }
  return run;
}
__device__ __forceinline__ void sb_combine(f32x16& p0, f32x16& p1, float (&gs)[8], float& carry, int hi) {
  float acc = 1.f;
#pragma unroll
  for (int i = 7; i >= 0; --i) { const float so_i = acc; acc *= gs[i]; const float x = hi ? acc : so_i; gs[i] = carry * so_i * xchg32(x, hi); }
  carry *= acc * xchg32(acc, hi);
#pragma unroll
  for (int i = 0; i < 4; ++i)
#pragma unroll
    for (int e = 0; e < 4; ++e) { p0[4 * i + e] *= gs[i]; p1[4 * i + e] *= gs[4 + i]; }
}
template <bool BAND>
__device__ __forceinline__ void sb_tile(f32x16& p0, f32x16& p1, float& carry, int kb, int qrel, int hi) {
  float gs[8];
  gs[0] = sb_group<BAND, 0>(p0, kb, qrel, hi); SBAR(); gs[1] = sb_group<BAND, 1>(p0, kb, qrel, hi); SBAR(); gs[2] = sb_group<BAND, 2>(p0, kb, qrel, hi); SBAR(); gs[3] = sb_group<BAND, 3>(p0, kb, qrel, hi); SBAR();
  gs[4] = sb_group<BAND, 0>(p1, kb + 32, qrel, hi); SBAR(); gs[5] = sb_group<BAND, 1>(p1, kb + 32, qrel, hi); SBAR(); gs[6] = sb_group<BAND, 2>(p1, kb + 32, qrel, hi); SBAR(); gs[7] = sb_group<BAND, 3>(p1, kb + 32, qrel, hi); SBAR();
  sb_combine(p0, p1, gs, carry, hi);
}

template <int MODE, bool OUT8 = false>
__device__ __forceinline__ void attn_unit(const bf16* __restrict__ Qb_or_hb, const bf16* __restrict__ Kh_in, const bf16* __restrict__ Vh_in, bf16* __restrict__ Ob,
                                          const float* __restrict__ gain, const float* __restrict__ kmean, int qb, int nkeys, char* lds, float s8 = 1.f,
                                          bool preissued = false, const bf16* __restrict__ nhb = nullptr, int nqb = 0, int nt0 = 0, int nt1 = -1) {
  constexpr int ldq = (MODE == 0) ? 512 : 128, ldk = (MODE == 0) ? 1024 : 128, ldo = (MODE == 0) ? 512 : 2048;
  constexpr long HSZ_ = 2048L * 128L;
  const bf16* __restrict__ Qb = (MODE == 0) ? Qb_or_hb : Qb_or_hb + (long)qb * (256 * 128);
  const bf16* __restrict__ Kh = (MODE == 0) ? Kh_in : Qb_or_hb + 8 * HSZ_;
  const bf16* __restrict__ Vh = (MODE == 0) ? Vh_in : Qb_or_hb + 16 * HSZ_;
  int tid_ = threadIdx.x; asm volatile("" : "+v"(tid_));
  const int tid = tid_, wid = __builtin_amdgcn_readfirstlane(tid >> 6), lane = tid & 63, r32 = lane & 31, hi = lane >> 5;
  char* V_lds = lds; char* K_lds = lds + 2 * SHM_V;
  float* ws = (float*)(lds + OFF_WS) + wid * 64; float* li_l = ws; float* al_l = ws + 32;
  float* km_l = (float*)(lds + OFF_KM);
  int* flg = (int*)(lds + OFF_KM);
  const int NT = (MODE == 0) ? nkeys / KVBLK : 4 * (qb + 1);
  const int qrel = wid * 32 + r32;
  float m_reg = -1e30f, l_reg = 0.f, carry = 1.f; f32x16 o[4] = {};
  const int vb0 = (int)(uintptr_t)V_lds + v_rd_base(lane);
  lds_cp ka[2][4];
#pragma unroll
  for (int y = 0; y < 2; ++y)
#pragma unroll
    for (int x = 0; x < 4; ++x) ka[y][x] = (lds_cp)(__attribute__((address_space(3))) char*)K_lds + r32 * 256 + 128 * (y ^ ((r32 >> 3) & 1)) + 32 * (x ^ ((r32 >> 1) & 3)) + 16 * (hi ^ (r32 & 1));
  lds_cp qr[2][4];
#pragma unroll
  for (int y = 0; y < 2; ++y)
#pragma unroll
    for (int x = 0; x < 4; ++x) qr[y][x] = ka[y][x] + (OFF_Q - 2 * SHM_V) + wid * 8192;
  long ksrc[2], vsrc[2];
#pragma unroll
  for (int i = 0; i < 2; ++i) { const int piece = wid + 8 * i;
    { const int row = piece * 4 + (lane >> 4), c = (lane & 15) ^ (row & 15); ksrc[i] = (long)row * ldk + c * 8; }
    { const int sub = piece * 2 + (lane >> 5), kk = (sub >> 2) * 8 + ((lane & 31) >> 2), k = (kk & ~0xC) | ((kk & 4) << 1) | ((kk & 8) >> 1), c = (sub & 3) * 32 + (lane & 3) * 8; vsrc[i] = (long)k * ldk + c; } }
  typedef __attribute__((address_space(3))) unsigned lds_u32;
  lds_u32* kdst = (lds_u32*)(__attribute__((address_space(3))) char*)(K_lds) + wid * 256; lds_u32* vdst = (lds_u32*)(__attribute__((address_space(3))) char*)(V_lds) + wid * 256;
#define TILE(it) ((MODE == 2) ? (NT - 1 - (it)) : (it))
#define DMA_K(k0, b) do { _Pragma("unroll") for (int i_ = 0; i_ < 2; ++i_) __builtin_amdgcn_global_load_lds((const unsigned*)(Kh + (long)(k0) * ldk + ksrc[i_]), kdst + (b) * (SHM_K / 4) + i_ * 2048, 16, 0, 0); } while (0)
#define DMA_V(k0, b) do { _Pragma("unroll") for (int i_ = 0; i_ < 2; ++i_) __builtin_amdgcn_global_load_lds((const unsigned*)(Vh + (long)(k0) * ldk + vsrc[i_]), vdst + (b) * (SHM_V / 4) + i_ * 2048, 16, 0, 0); } while (0)
#define SDRAIN() asm volatile("s_waitcnt vmcnt(0)" ::: "memory")
#define KSLOT(i_) ((i_) == 2 ? (OFF_Q - 2 * SHM_V) : (i_) * SHM_K)
#define VSLOT(i_) ((i_) == 2 ? (OFF_Q + SHM_K) : (i_) * SHM_V)
#define DMA_K3(k0, so) do { _Pragma("unroll") for (int i_ = 0; i_ < 2; ++i_) __builtin_amdgcn_global_load_lds((const unsigned*)(Kh + (long)(k0) * ldk + ksrc[i_]), kdst + (so) / 4 + i_ * 2048, 16, 0, 0); } while (0)
#define DMA_V3(k0, so) do { _Pragma("unroll") for (int i_ = 0; i_ < 2; ++i_) __builtin_amdgcn_global_load_lds((const unsigned*)(Vh + (long)(k0) * ldk + vsrc[i_]), vdst + (so) / 4 + i_ * 2048, 16, 0, 0); } while (0)
  lds_u32* qdst = (lds_u32*)(__attribute__((address_space(3))) char*)(lds + OFF_Q) + wid * 2048;
#define ISSUE_UNIT(QB_, KH_, VH_, T0_, T1_) do { \
    _Pragma("unroll") for (int i = 0; i < 8; ++i) { const int row = 4 * i + (lane >> 4), c = (lane & 15) ^ (row & 15); \
      __builtin_amdgcn_global_load_lds((const unsigned*)((QB_) + (long)(wid * 32 + row) * ldq + c * 8), qdst + i * 256, 16, 0, 0); } \
    _Pragma("unroll") for (int i_ = 0; i_ < 2; ++i_) { \
      __builtin_amdgcn_global_load_lds((const unsigned*)((KH_) + (long)((T0_) * KVBLK) * ldk + ksrc[i_]), kdst + i_ * 2048, 16, 0, 0); \
      __builtin_amdgcn_global_load_lds((const unsigned*)((VH_) + (long)((T0_) * KVBLK) * ldk + vsrc[i_]), vdst + i_ * 2048, 16, 0, 0); } \
    if ((T1_) >= 0) { _Pragma("unroll") for (int i_ = 0; i_ < 2; ++i_) __builtin_amdgcn_global_load_lds((const unsigned*)((KH_) + (long)((T1_) * KVBLK) * ldk + ksrc[i_]), kdst + (SHM_K / 4) + i_ * 2048, 16, 0, 0); } } while (0)
  if (!preissued) ISSUE_UNIT(Qb, Kh, Vh, TILE(0), ((MODE == 2 || PIPE_SOFTMAX) ? TILE(1) : -1));
  constexpr bool RING3 = (MODE != 2) && QREG_SOFTMAX && !PIPE_SOFTMAX;
  unsigned selmask = 0u;
  float gv[4] = {1.f, 1.f, 1.f, 1.f};
  if (gain) {
#pragma unroll
    for (int d0 = 0; d0 < 4; ++d0) gv[d0] = gain[d0 * 32 + r32]; }
  if (MODE == 1) { if (tid < 256) *(f32x4*)(km_l + tid * 4) = *(const f32x4*)(kmean + tid * 4); }
  SDRAIN();
  __syncthreads();
  if (MODE == 1) {
    float g[8];
#pragma unroll
    for (int n = 0; n < 8; ++n) g[n] = 0.f;
    { const int rh = (r32 >> 1) & 3, r3 = (r32 >> 3) & 1;
      const lds_cp qbase = qr[0][0] - 32 * rh - 128 * r3;
#pragma unroll 1
      for (int d0 = 0; d0 < 8; ++d0) {
        const bf16x8 qf = *reinterpret_cast<const __attribute__((address_space(3))) bf16x8*>(qbase + 32 * ((d0 & 3) ^ rh) + 128 * ((d0 >> 2) ^ r3));
        float q[8];
#pragma unroll
        for (int j = 0; j < 8; ++j) q[j] = __uint_as_float(((unsigned)(unsigned short)qf[j]) << 16);
        const float* kmp = km_l + d0 * 16 + hi * 8;
#pragma unroll
        for (int n = 0; n < 7; ++n) { const f32x4 k0v = *(const f32x4*)(kmp + n * 128), k1v = *(const f32x4*)(kmp + n * 128 + 4);
          g[n] += (q[0] * k0v[0] + q[1] * k0v[1]) + (q[2] * k0v[2] + q[3] * k0v[3]) + (q[4] * k1v[0] + q[5] * k1v[1]) + (q[6] * k1v[2] + q[7] * k1v[3]); }
      } }
#pragma unroll
    for (int n = 0; n < 7; ++n) { g[n] += xchg32(g[n], hi); if (n >= qb) g[n] = -INFINITY; }
    g[7] = -INFINITY;
#pragma unroll
    for (int n = 0; n < 7; ++n) { int cnt = 0;
#pragma unroll
      for (int mI = 0; mI < 7; ++mI) { if (mI != n) cnt += (g[mI] > g[n] || (g[mI] == g[n] && mI < n)) ? 1 : 0; }
      if (n < qb && cnt < 3) selmask |= (1u << n); }
  }
  bf16x8 qg[8];
  if (QREG_SOFTMAX && MODE != 2) {
#pragma unroll
    for (int d0 = 0; d0 < 8; ++d0) qg[d0] = *reinterpret_cast<const __attribute__((address_space(3))) bf16x8*>(qr[d0 >> 2][d0 & 3]); }
  int kc = KSLOT(0), kn = KSLOT(1), kn2 = KSLOT(2), vc = VSLOT(0), vn = VSLOT(1), vn2 = VSLOT(2);
  if (RING3) { DMA_K3(TILE(1) * KVBLK, kn); DMA_V3(TILE(1) * KVBLK, vn);
    asm volatile("s_waitcnt lgkmcnt(0)" ::: "memory"); __syncthreads(); }
  f32x16 pA0, pA1, pB0, pB1; bf16x8 pa0, pa1, pa2, pa3;
  if (MODE == 2 || PIPE_SOFTMAX) { float bias0 = 0.f; if (MODE == 1) { if (NT > 4) bias0 = (selmask & 1u) ? 0.f : -INFINITY; }
    qkt(pA0, pA1, ka, 0, qr, bias0);
    __syncthreads(); }
  int it = 0;
#define JB(i_) ((MODE == 2) ? (3 - (i_)) : ((i_) - (NT - 4)))
#define STEP(A0, A1, B0, B1, BAND, HASNEXT) do { \
    if (it + 2 < NT) DMA_K(TILE(it + 2) * KVBLK, it & 1); \
    if (it + 1 < NT) DMA_V(TILE(it + 1) * KVBLK, (it + 1) & 1); \
    bool skip = false; const int jb = JB(it); \
    if (BAND) { if (MODE == 1) skip = (64 * jb > wid * 32 + 31); if (MODE == 2) skip = (64 * jb >= wid * 32 + 31); } \
    if (MODE == 2) skip = skip || __all(carry < SB_DONE);        \
    if (HASNEXT) { float bias_ = 0.f; if (MODE == 1) { if (it + 1 < NT - 4) bias_ = ((selmask >> ((it + 1) >> 2)) & 1u) ? 0.f : -INFINITY; } \
      qkt(B0, B1, ka, ((it + 1) & 1) * SHM_K, qr, bias_); } \
    if (!skip) { \
      if (MODE == 2) { sb_tile<(BAND) != 0>(A0, A1, carry, 64 * jb, qrel, hi); } \
      else { \
        if (MODE == 1 && (BAND)) { _Pragma("unroll") for (int r = 0; r < 16; ++r) { const int kr = 64 * jb + crow(r, hi); if (kr > qrel) A0[r] = -INFINITY; if (kr + 32 > qrel) A1[r] = -INFINITY; } } \
        float alpha; softmax_tile(A0, A1, m_reg, l_reg, alpha); \
        if (__any(alpha < 1.f)) { if (hi == 0) al_l[r32] = alpha; asm volatile("s_waitcnt lgkmcnt(0)" ::: "memory"); \
          _Pragma("unroll") for (int d = 0; d < 4; ++d) _Pragma("unroll") for (int r = 0; r < 16; ++r) o[d][r] *= al_l[crow(r, hi)]; } \
      } \
      pack_p(A0, A1, pa0, pa1, pa2, pa3); \
      pv_d0(o, vb0 + (it & 1) * SHM_V, pa0, pa1, pa2, pa3); \
    } \
    SDRAIN(); __syncthreads(); ++it; } while (0)
#define SB_LD(G, F) do { F##q = *reinterpret_cast<const __attribute__((address_space(3))) bf16x8*>(qr[(G) >> 2][(G) & 3]); \
      F##0 = *reinterpret_cast<const __attribute__((address_space(3))) bf16x8*>(ka[(G) >> 2][(G) & 3] + kb_); F##1 = *reinterpret_cast<const __attribute__((address_space(3))) bf16x8*>(ka[(G) >> 2][(G) & 3] + kb_ + 8192); } while (0)
#define SB_PART(G, P, I, B0, B1, FC, FN) do { if ((G) < 7) SB_LD(((G) + 1) & 7, FN);              \
      B0 = __builtin_amdgcn_mfma_f32_32x32x16_bf16(FC##0, FC##q, B0, 0, 0, 0); B1 = __builtin_amdgcn_mfma_f32_32x32x16_bf16(FC##1, FC##q, B1, 0, 0, 0); \
      gs_[G] = sb_group<false, I>(P, 0, 0, hi); SBAR(); } while (0)
#define STEP_SB(A0, A1, B0, B1) do { \
    if (it + 2 < NT) DMA_K(TILE(it + 2) * KVBLK, it & 1); \
    DMA_V(TILE(it + 1) * KVBLK, (it + 1) & 1); \
    float gs_[8]; \
    _Pragma("unroll") for (int r = 0; r < 16; ++r) { B0[r] = 0.f; B1[r] = 0.f; } \
    const int kb_ = ((it + 1) & 1) * SHM_K; bf16x8 fx0, fx1, fxq, fy0, fy1, fyq; SB_LD(0, fx); SBAR(); \
    SB_PART(0, A0, 0, B0, B1, fx, fy); SB_PART(1, A0, 1, B0, B1, fy, fx); SB_PART(2, A0, 2, B0, B1, fx, fy); SB_PART(3, A0, 3, B0, B1, fy, fx); \
    SB_PART(4, A1, 0, B0, B1, fx, fy); SB_PART(5, A1, 1, B0, B1, fy, fx); SB_PART(6, A1, 2, B0, B1, fx, fy); SB_PART(7, A1, 3, B0, B1, fy, fx); \
    sb_combine(A0, A1, gs_, carry, hi); \
    { const bool dn_ = __all(carry < SB_DONE); if (lane == 0) flg[(it & 1) * 8 + wid] = dn_ ? 1 : 0; } \
    pack_p(A0, A1, pa0, pa1, pa2, pa3); \
    pv_d0(o, vb0 + (it & 1) * SHM_V, pa0, pa1, pa2, pa3); \
    SDRAIN(); __syncthreads(); \
    { const int* f_ = flg + (it & 1) * 8; stop = (f_[0] + f_[1] + f_[2] + f_[3] + f_[4] + f_[5] + f_[6] + f_[7]) == 8; } \
    ++it; } while (0)
#define SSTEP(BAND) do { \
    if (RING3) { if (it + 2 < NT) { DMA_K3(TILE(it + 2) * KVBLK, kn2); DMA_V3(TILE(it + 2) * KVBLK, vn2); } } \
    else if (it + 1 < NT) { DMA_K(TILE(it + 1) * KVBLK, (it + 1) & 1); DMA_V(TILE(it + 1) * KVBLK, (it + 1) & 1); } \
    bool skip = false; const int jb = JB(it); \
    if (BAND) skip = (64 * jb > wid * 32 + 31); \
    if (!skip) { \
      float bias_ = 0.f; if (MODE == 1 && !(BAND)) bias_ = ((selmask >> (it >> 2)) & 1u) ? 0.f : -INFINITY; \
      const int kb_ = RING3 ? kc : (it & 1) * SHM_K; \
      if (QREG_SOFTMAX) qkt(pA0, pA1, ka, kb_, qg, bias_); else qkt(pA0, pA1, ka, kb_, qr, bias_); \
      if (MODE == 1 && (BAND)) { _Pragma("unroll") for (int r = 0; r < 16; ++r) { const int kr = 64 * jb + crow(r, hi); if (kr > qrel) pA0[r] = -INFINITY; if (kr + 32 > qrel) pA1[r] = -INFINITY; } } \
      float alpha; softmax_tile(pA0, pA1, m_reg, l_reg, alpha); \
      if (__any(alpha < 1.f)) { if (hi == 0) al_l[r32] = alpha; asm volatile("s_waitcnt lgkmcnt(0)" ::: "memory"); \
        _Pragma("unroll") for (int d = 0; d < 4; ++d) _Pragma("unroll") for (int r = 0; r < 16; ++r) o[d][r] *= al_l[crow(r, hi)]; } \
      pack_p(pA0, pA1, pa0, pa1, pa2, pa3); \
      pv_d0(o, vb0 + (RING3 ? vc : (it & 1) * SHM_V), pa0, pa1, pa2, pa3); \
    } \
    if (RING3) { if (it + 2 < NT) asm volatile("s_waitcnt vmcnt(4)" ::: "memory"); else SDRAIN();        \
      { const int t_ = kc; kc = kn; kn = kn2; kn2 = t_; } { const int t_ = vc; vc = vn; vn = vn2; vn2 = t_; } } \
    else SDRAIN(); \
    if (RING3) { asm volatile("s_waitcnt lgkmcnt(0)" ::: "memory"); __builtin_amdgcn_s_barrier(); asm volatile("" ::: "memory"); }     \
    else __syncthreads(); \
    ++it; } while (0)
#define RESTART(BIASEXPR) do { qkt(pA0, pA1, ka, (it & 1) * SHM_K, qr, (BIASEXPR)); __syncthreads(); } while (0)
  if (MODE == 0) {
    if (PIPE_SOFTMAX) { STEP(pA0, pA1, pB0, pB1, 0, true); STEP(pB0, pB1, pA0, pA1, 0, true); STEP(pA0, pA1, pB0, pB1, 0, true); STEP(pB0, pB1, pA0, pA1, 0, false); }
    else { SSTEP(0); SSTEP(0); SSTEP(0); SSTEP(0); }
  } else if (MODE == 1) {
    if (PIPE_SOFTMAX) {
      if (NT > 4) { while (it < NT - 4) { STEP(pA0, pA1, pB0, pB1, 0, true); STEP(pB0, pB1, pA0, pA1, 0, (it + 1 < NT - 4)); }
        RESTART(0.f); }
      STEP(pA0, pA1, pB0, pB1, 1, true); STEP(pB0, pB1, pA0, pA1, 1, true); STEP(pA0, pA1, pB0, pB1, 1, true); STEP(pB0, pB1, pA0, pA1, 1, false);
    } else {
      while (it < NT - 4) SSTEP(0);
      SSTEP(1); SSTEP(1); SSTEP(1); SSTEP(1);
    }
  } else {
    STEP(pA0, pA1, pB0, pB1, 1, true); STEP(pB0, pB1, pA0, pA1, 1, true); STEP(pA0, pA1, pB0, pB1, 1, true); STEP(pB0, pB1, pA0, pA1, 1, false);
    if (NT > 4) {
      RESTART(0.f);
      bool stop = false;
      while (it + 2 < NT && !stop) { STEP_SB(pA0, pA1, pB0, pB1); STEP_SB(pB0, pB1, pA0, pA1); }
      if (!stop) { STEP_SB(pA0, pA1, pB0, pB1); STEP(pB0, pB1, pA0, pA1, 0, false); }
    }
  }
#undef RESTART
#undef STEP
#undef SSTEP
#undef STEP_SB
#undef SB_LD
#undef SB_PART
#undef JB
  if (OUT8) { if (nhb) ISSUE_UNIT(nhb + (long)nqb * (256 * 128), nhb + 8 * HSZ_, nhb + 16 * HSZ_, nt0, nt1); }
  float rli[16];
  if (MODE != 2) { if (hi == 0) li_l[r32] = l_reg; asm volatile("s_waitcnt lgkmcnt(0)" ::: "memory");
#pragma unroll
    for (int r = 0; r < 16; ++r) rli[r] = __builtin_amdgcn_rcpf(li_l[crow(r, hi)]); }
  else {
#pragma unroll
    for (int r = 0; r < 16; ++r) rli[r] = 1.f; }
  if (gain) {
#pragma unroll
    for (int r = 0; r < 16; ++r) { float s = 0.f;
#pragma unroll
      for (int d0 = 0; d0 < 4; ++d0) { o[d0][r] *= rli[r]; s += o[d0][r] * o[d0][r]; }
      s += __shfl_xor(s, 1); s += __shfl_xor(s, 2); s += __shfl_xor(s, 4); s += __shfl_xor(s, 8); s += __shfl_xor(s, 16);
      rli[r] = __builtin_amdgcn_rsqf(s * (1.0f / 128.0f) + 1e-6f); }
#pragma unroll
    for (int r = 0; r < 16; ++r)
#pragma unroll
      for (int d0 = 0; d0 < 4; ++d0) o[d0][r] *= gv[d0];
  }
  if (OUT8) {
#pragma unroll
    for (int r = 0; r < 16; ++r) { const float f = rli[r] * s8;
      const float v0 = __builtin_amdgcn_fmed3f(o[0][r] * f, -448.f, 448.f), v1 = __builtin_amdgcn_fmed3f(o[1][r] * f, -448.f, 448.f), v2 = __builtin_amdgcn_fmed3f(o[2][r] * f, -448.f, 448.f), v3 = __builtin_amdgcn_fmed3f(o[3][r] * f, -448.f, 448.f);
      int p = __builtin_amdgcn_cvt_pk_fp8_f32(v0, v1, 0, false); p = __builtin_amdgcn_cvt_pk_fp8_f32(v2, v3, p, true);
      *(unsigned*)((unsigned char*)Ob + (long)(wid * 32 + crow(r, hi)) * ldo + 4 * r32) = (unsigned)p; } }
  else { bf16* stg = (bf16*)lds + wid * 4096;
#pragma unroll
    for (int r = 0; r < 16; ++r) { const int orow = crow(r, hi);
#pragma unroll
      for (int d0 = 0; d0 < 4; ++d0) { const float v = o[d0][r] * rli[r]; unsigned u = __float_as_uint(v); u = (u + 0x7fffu + ((u >> 16) & 1u)) >> 16; stg[orow * 128 + d0 * 32 + r32] = (bf16)u; } }
    asm volatile("s_waitcnt lgkmcnt(0)" ::: "memory");
#pragma unroll
    for (int i = 0; i < 8; ++i) { const int row = i * 4 + (lane >> 4), ch = lane & 15; const u32x4 v = *(const u32x4*)(stg + row * 128 + ch * 8); *(u32x4*)(Ob + (long)(wid * 32 + row) * ldo + ch * 8) = v; } }
  __syncthreads();
#undef TILE
#undef ISSUE_UNIT
#undef DMA_K
#undef DMA_V
#undef DMA_K3
#undef DMA_V3
#undef KSLOT
#undef VSLOT
#undef SDRAIN
}
#undef KSWZ
#undef SBAR
}
#define GAS __attribute__((address_space(1)))
#define LAS __attribute__((address_space(3)))
typedef unsigned short bf16;
typedef unsigned v4u __attribute__((ext_vector_type(4)));
typedef float f32x4 __attribute__((ext_vector_type(4)));
#define LDS_WAIT() asm volatile("s_waitcnt lgkmcnt(0)" ::: "memory")
constexpr int NWAVES = 8;
constexpr int BATCH = 8, SEQ = 2048, DM = 2048, M = BATCH * SEQ, HD = 128, NH = 8;
constexpr int NQKV = 6144, FF = 5632, WX = 512, NMEM = 256, MMEM = BATCH * NMEM;
constexpr int QSB = 0, KSB = 1024, VSB = 2048, QMB = 3072, KMB = 4096, VMB = 5120;
constexpr float EPS = 1e-6f;
constexpr float QSCALE = 0.12751743082459868f;
constexpr size_t MiB = 1u << 20;
constexpr size_t WS_CTL = 0, CTL_ZERO_BYTES = 512 * 1024;
constexpr size_t WS_SSQ1 = 64 * 1024, WS_SSQ2 = 128 * 1024;
constexpr size_t WS_KSUM = 256 * 1024;
constexpr size_t WS_WIN = 1 * MiB, WS_WOUT = 25 * MiB, WS_WXQ = 33 * MiB, WS_WXKV = 35 * MiB, WS_WXO = 39 * MiB, WS_WGU = 41 * MiB, WS_WDN = 85 * MiB;
constexpr size_t WS_RA = 107 * MiB;
constexpr size_t WS_RB = 171 * MiB;
constexpr size_t WS_RC = 235 * MiB;
constexpr size_t WS_QX = 427 * MiB, WS_OX = 443 * MiB, WS_KVX = 459 * MiB, WS_MN = 463 * MiB, WS_KMEAN = 471 * MiB, WS_RINV0 = 471 * MiB  , WS_CS = 472 * MiB, WS_END = 474 * MiB;
constexpr int RING_BYTES = 131072, LDS_BYTES = 147456;
#ifndef FFN_FP8
#define FFN_FP8 1
#endif
constexpr float S_X2 = 16.f, S_WGU = 32.f, S_ACT = 8.f, S_WDN = 64.f, S_XN = 16.f, S_WV = 32.f, S_O = 16.f, S_WO = 32.f;
constexpr float S_OX = 16.f, S_WXO = 16.f;
#ifndef WXO_FP8
#define WXO_FP8 1
#endif
#ifndef WOUT_FP8
#define WOUT_FP8 1
#endif
constexpr size_t WS_WV8 = WS_WIN + 16 * MiB;

__device__ __forceinline__ float bf2f(unsigned short b) { return __uint_as_float((unsigned)b << 16); }
__device__ __forceinline__ unsigned f2bf(float f) { unsigned u = __builtin_bit_cast(unsigned, f); return (u + 0x7fffu + ((u >> 16) & 1u)) >> 16; }
__device__ __forceinline__ unsigned pk2(float lo, float hi) { return f2bf(lo) | (f2bf(hi) << 16); }
__device__ __forceinline__ float wave_sum(float v) {
#pragma unroll
    for (int o = 1; o < 64; o <<= 1) v += __shfl_xor(v, o);
    return v;
}
__device__ __forceinline__ float wave_max(float v) {
#pragma unroll
    for (int o = 1; o < 64; o <<= 1) v = fmaxf(v, __shfl_xor(v, o));
    return v;
}

typedef GAS unsigned gu32;
#define RLX_AGENT __ATOMIC_RELAXED, __HIP_MEMORY_SCOPE_AGENT
constexpr int CW_BAR = 4096;
constexpr int LDSCTL_OFF = RING_BYTES, MISC_OFF = LDSCTL_OFF + 320;
#define XB_TMO      128
#define XB_XCNT(j)  (256  + 64 * (j))
#define XB_XSUB(j)  (1280 + 64 * (j))
#define XB_XGEN(j)  (2304 + 64 * (j))
#define XB_TOP      3328
#define XB_TOPGEN   3392
#define XCD_BAR_WORDS 3456
#define XB_SPIN_CAP (1u << 18)

__device__ __forceinline__ unsigned xb_ld(unsigned* p)              { return __hip_atomic_load(p, __ATOMIC_RELAXED, __HIP_MEMORY_SCOPE_AGENT); }
__device__ __forceinline__ unsigned xb_add(unsigned* p, unsigned v) { return __hip_atomic_fetch_add(p, v, __ATOMIC_RELAXED, __HIP_MEMORY_SCOPE_AGENT); }
__device__ __forceinline__ unsigned xb_xcc_id() { return (unsigned)__builtin_amdgcn_s_getreg((3 << 11) | 20) & 0xFu; }
#define XB_SPIN(cond, bar) do { unsigned _sp = 0; while (cond) { __builtin_amdgcn_s_sleep(1); \
    if ((++_sp & 255u) == 0u) { if (xb_ld(&(bar)[XB_TMO])) break; if (_sp > XB_SPIN_CAP) { atomicAdd(&(bar)[XB_TMO], 1u); break; } } } } while (0)

struct XcdBarrier {
    unsigned* bar; unsigned x;
    volatile LAS unsigned* st;
};

__device__ __forceinline__ XcdBarrier xcd_barrier_post(unsigned* bar, volatile LAS unsigned* st) {
    XcdBarrier b; b.bar = bar; b.x = xb_xcc_id(); b.st = st;
    if (threadIdx.x == 0) (void)xb_add(&bar[XB_XCNT(b.x)], 1u);
    return b;
}
__device__ __forceinline__ void xcd_barrier_complete(unsigned* bar, unsigned x, unsigned& nloc, unsigned& nx) {
    const unsigned G = gridDim.x * gridDim.y * gridDim.z;
    unsigned sum, cnt, mine, sp = 0u;
    for (;;) {
        sum = 0u; cnt = 0u; mine = 0u;
#pragma unroll
        for (unsigned j = 0; j < 16; ++j) { const unsigned c = xb_ld(&bar[XB_XCNT(j)]); sum += c; cnt += (c > 0u) ? 1u : 0u; mine = (j == x) ? c : mine; }
        if (sum == G) break;
        __builtin_amdgcn_s_sleep(1);
        if ((++sp & 255u) == 0u) { if (xb_ld(&bar[XB_TMO])) break; if (sp > XB_SPIN_CAP) { atomicAdd(&bar[XB_TMO], 1u); break; } }
    }
    nloc = mine > 0u ? mine : 1u; nx = cnt > 0u ? cnt : 1u;
}

__device__ __forceinline__ void xcd_barrier(const XcdBarrier& b) {
    asm volatile("s_waitcnt vmcnt(0)" ::: "memory");
    __syncthreads();
    if (threadIdx.x == 0) {
        unsigned* bar = b.bar;
        __builtin_amdgcn_s_waitcnt(0);
        unsigned nloc = b.st[0], nx = b.st[1];
        if (nloc == 0u) { xcd_barrier_complete(bar, b.x, nloc, nx); b.st[0] = nloc; b.st[1] = nx; }
        const unsigned old = xb_add(&bar[XB_XSUB(b.x)], 1u);
        const unsigned gen = old / nloc;
        if (old + 1u == (gen + 1u) * nloc) {
            __builtin_amdgcn_fence(__ATOMIC_RELEASE, "agent");
            asm volatile("s_waitcnt vmcnt(0)" ::: "memory");
            const unsigned og = xb_add(&bar[XB_TOP], 1u);
            const unsigned tg = og / nx;
            if (og + 1u == (tg + 1u) * nx) xb_add(&bar[XB_TOPGEN], 1u);
            else XB_SPIN(xb_ld(&bar[XB_TOPGEN]) == tg, bar);
            __builtin_amdgcn_fence(__ATOMIC_ACQUIRE, "agent");
            xb_add(&bar[XB_XGEN(b.x)], 1u);
            asm volatile("s_waitcnt vmcnt(0)" ::: "memory");
        } else {
            XB_SPIN(xb_ld(&bar[XB_XGEN(b.x)]) == gen, bar);
            __builtin_amdgcn_fence(__ATOMIC_ACQUIRE, "agent");
            asm volatile("s_waitcnt vmcnt(0)" ::: "memory");
        }
    }
    __syncthreads();
}

struct Frame {
    LAS unsigned char* lds;
    int tid, lane, wave, vcu, G;
    const float *x, *mem; const int* pos;
    const float *g_mix, *w_in, *g_out_sb, *g_out_mb, *w_out, *g_xattn, *g_mem, *w_xq, *w_xkv, *w_xo, *g_ffn, *w_gu, *w_dn, *g_final;
    float* out; unsigned char* ws;
};

__device__ __forceinline__ void transpose_item(const float* W, int K, int N, bf16* WT, const float* gain, int inter, LAS float* scr, int item, int lane) {
    const int nblk = N / 32, kb = item / nblk, nb = item % nblk, k0 = 64 * kb, n0 = 32 * nb;
    int orow0 = n0;
    if (inter == 1) orow0 = (n0 < FF) ? (n0 / 128) * 256 + (n0 % 128) : ((n0 - FF) / 128) * 256 + 128 + ((n0 - FF) % 128);
    if (inter == 2) { const int reg = n0 / 1024, c = n0 % 1024; orow0 = (reg == 2) ? c : (reg == 5) ? 1024 + c : (reg < 2 ? reg : reg - 1) * 1024 + c; }
    float v[32];
#pragma unroll
    for (int i = 0; i < 32; ++i) v[i] = W[(size_t)(k0 + 2 * i + (lane >> 5)) * N + n0 + (lane & 31)];
#pragma unroll
    for (int i = 0; i < 32; ++i) { const int kk = 2 * i + (lane >> 5); float t = v[i]; if (gain) t *= gain[k0 + kk]; scr[kk * 33 + (lane & 31)] = t; }
    LDS_WAIT(); asm volatile("" ::: "memory");
    const int c = lane & 7;
#pragma unroll
    for (int j = 0; j < 4; ++j) { const int n = (lane >> 3) + 8 * j; const LAS float* s = scr + (8 * c) * 33 + n;
        v4u o; o.x = pk2(s[0 * 33], s[1 * 33]); o.y = pk2(s[2 * 33], s[3 * 33]); o.z = pk2(s[4 * 33], s[5 * 33]); o.w = pk2(s[6 * 33], s[7 * 33]);
        *(GAS v4u*)(WT + (size_t)(orow0 + n) * K + k0 + 8 * c) = o; }
    LDS_WAIT(); asm volatile("" ::: "memory");
}
__device__ __forceinline__ void transpose_item_fp8(const float* W, int K, int N, unsigned char* WT, const float* gain, int inter, float scale, LAS float* scr, int item, int lane, int kperm = 0) {
    const int nblk = N / 32, kb = item / nblk, nb = item % nblk, k0 = 64 * kb, n0 = 32 * nb;
    int orow0 = n0;
    if (inter == 1) orow0 = (n0 < FF) ? (n0 / 128) * 256 + (n0 % 128) : ((n0 - FF) / 128) * 256 + 128 + ((n0 - FF) % 128);
    if (inter == 2) { const int reg = n0 / 1024, c = n0 % 1024; orow0 = (reg == 2) ? c : (reg == 5) ? 1024 + c : (reg < 2 ? reg : reg - 1) * 1024 + c; }
    float v[32];
#pragma unroll
    for (int i = 0; i < 32; ++i) { int ks = k0 + 2 * i + (lane >> 5); if (kperm) ks = (ks & ~127) + 32 * (ks & 3) + ((ks & 127) >> 2); v[i] = W[(size_t)ks * N + n0 + (lane & 31)]; }
#pragma unroll
    for (int i = 0; i < 32; ++i) { const int kk = 2 * i + (lane >> 5); float t = v[i] * scale; if (gain) t *= gain[k0 + kk]; scr[kk * 33 + (lane & 31)] = t; }
    LDS_WAIT(); asm volatile("" ::: "memory");
    const int c = lane & 7;
#pragma unroll
    for (int j = 0; j < 4; ++j) { const int n = (lane >> 3) + 8 * j; const LAS float* s = scr + (8 * c) * 33 + n;
        pg8::u32x2 o; o.x = pg8::pk4_fp8(s[0 * 33], s[1 * 33], s[2 * 33], s[3 * 33]); o.y = pg8::pk4_fp8(s[4 * 33], s[5 * 33], s[6 * 33], s[7 * 33]);
        *(GAS pg8::u32x2*)(WT + (size_t)(orow0 + n) * K + k0 + 8 * c) = o; }
    LDS_WAIT(); asm volatile("" ::: "memory");
}
__device__ __forceinline__ void rms_row_to_bf16(const float* xrow, const float* g, bf16* orow, int lane, unsigned char* o8 = nullptr, float s8 = 1.f) {
    const GAS f32x4* xr = (const GAS f32x4*)xrow + lane; const GAS f32x4* gr = (const GAS f32x4*)g + lane;
    f32x4 v[8]; float s = 0.f;
#pragma unroll
    for (int j = 0; j < 8; ++j) { v[j] = xr[64 * j]; s += (v[j].x * v[j].x + v[j].y * v[j].y) + (v[j].z * v[j].z + v[j].w * v[j].w); }
    const float rstd = 1.0f / sqrtf(wave_sum(s) * (1.f / DM) + EPS);
    GAS unsigned long long* ob8 = (GAS unsigned long long*)orow + lane;
#pragma unroll
    for (int j = 0; j < 8; ++j) { const f32x4 gg = gr[64 * j];
        const float a0 = v[j].x * rstd * gg.x, a1 = v[j].y * rstd * gg.y, a2 = v[j].z * rstd * gg.z, a3 = v[j].w * rstd * gg.w;
        ob8[64 * j] = (unsigned long long)pk2(a0, a1) | ((unsigned long long)pk2(a2, a3) << 32);
        if (o8) ((GAS unsigned*)o8)[64 * j + lane] = pg8::pk4_fp8(a0 * s8, a1 * s8, a2 * s8, a3 * s8); }
}
__device__ __forceinline__ void x_row_convert(const float* xrow, bf16* orow, unsigned char* o8, float s8, float* rinv, int lane) {
    const GAS f32x4* xr = (const GAS f32x4*)xrow + lane;
    f32x4 v[8]; float s = 0.f;
#pragma unroll
    for (int j = 0; j < 8; ++j) { v[j] = xr[64 * j]; s += (v[j].x * v[j].x + v[j].y * v[j].y) + (v[j].z * v[j].z + v[j].w * v[j].w); }
    const float rstd = 1.0f / sqrtf(wave_sum(s) * (1.f / DM) + EPS);
    if (lane == 0) *rinv = rstd;
    GAS unsigned long long* ob8 = (GAS unsigned long long*)orow + lane;
#pragma unroll
    for (int j = 0; j < 8; ++j) { ob8[64 * j] = (unsigned long long)pk2(v[j].x, v[j].y) | ((unsigned long long)pk2(v[j].z, v[j].w) << 32);
        ((GAS unsigned*)o8)[64 * j + lane] = pg8::pk4_fp8(v[j].x * s8, v[j].y * s8, v[j].z * s8, v[j].w * s8); }
}
__constant__ float INV_FREQ[16] = {1.000000000e+00f, 4.403665960e-01f, 1.939227432e-01f, 8.539710194e-02f, 3.760603070e-02f, 1.656043902e-02f, 7.292664610e-03f, 3.211445874e-03f,
                                   1.414213562e-03f, 6.227723788e-04f, 2.742481884e-04f, 1.207697351e-04f, 5.318296098e-05f, 2.341999971e-05f, 1.031338616e-05f, 4.541670478e-06f};

struct TItem { const float* src; unsigned char* dst; const float* gain; float scale; int N, K, fp8, kperm; };
__device__ __forceinline__ void ti_decode(TItem& t, const float* W, int K, int N, unsigned char* WT, const float* gain, int inter, float scale, int fp8, int kperm, int item) {
    const int nblk = N / 32, kb = item / nblk, nb = item % nblk, k0 = 64 * kb, n0 = 32 * nb;
    int orow0 = n0;
    if (inter == 1) orow0 = (n0 < FF) ? (n0 / 128) * 256 + (n0 % 128) : ((n0 - FF) / 128) * 256 + 128 + ((n0 - FF) % 128);
    if (inter == 2) { const int reg = n0 / 1024, c = n0 % 1024; orow0 = (reg == 2) ? c : (reg == 5) ? 1024 + c : (reg < 2 ? reg : reg - 1) * 1024 + c; }
    const int ksrc0 = kperm ? (k0 & ~127) + ((k0 & 64) >> 2) : k0;
    t.src = W + (size_t)ksrc0 * N + n0; t.N = N; t.K = K; t.fp8 = fp8; t.kperm = kperm; t.scale = scale; t.gain = gain ? gain + k0 : nullptr;
    t.dst = WT + ((size_t)orow0 * K + k0) * (fp8 ? 1 : 2);
}
__device__ __forceinline__ void ti_load(const TItem& t, float (&v)[32], f32x4 (&g)[2], int lane) {
    const GAS float* s = (const GAS float*)t.src + (lane & 31);
#pragma unroll
    for (int i = 0; i < 32; ++i) { const int kk = 2 * i + (lane >> 5); const int ro = t.kperm ? 32 * (kk & 3) + (kk >> 2) : kk; v[i] = s[(size_t)ro * t.N]; }
    const GAS f32x4* gp = (const GAS f32x4*)((t.gain ? t.gain : t.src) + 8 * (lane & 7)); g[0] = gp[0]; g[1] = gp[1];
}
__device__ __forceinline__ void ti_finish(const TItem& t, const float (&v)[32], const f32x4 (&g)[2], LAS float* scr, int lane) {
#pragma unroll
    for (int i = 0; i < 32; ++i) scr[(2 * i + (lane >> 5)) * 33 + (lane & 31)] = v[i];
    LDS_WAIT(); asm volatile("" ::: "memory");
    const int c = lane & 7; const float sc = t.scale; const bool hg = t.gain != nullptr;
    const float g0 = hg ? g[0].x * sc : sc, g1 = hg ? g[0].y * sc : sc, g2 = hg ? g[0].z * sc : sc, g3 = hg ? g[0].w * sc : sc, g4 = hg ? g[1].x * sc : sc, g5 = hg ? g[1].y * sc : sc, g6 = hg ? g[1].z * sc : sc, g7 = hg ? g[1].w * sc : sc;
    if (t.fp8) {
#pragma unroll
        for (int j = 0; j < 4; ++j) { const int n = (lane >> 3) + 8 * j; const LAS float* s = scr + (8 * c) * 33 + n;
            pg8::u32x2 o; o.x = pg8::pk4_fp8(s[0 * 33] * g0, s[1 * 33] * g1, s[2 * 33] * g2, s[3 * 33] * g3); o.y = pg8::pk4_fp8(s[4 * 33] * g4, s[5 * 33] * g5, s[6 * 33] * g6, s[7 * 33] * g7);
            *(GAS pg8::u32x2*)(t.dst + (size_t)n * t.K + 8 * c) = o; }
    } else {
#pragma unroll
        for (int j = 0; j < 4; ++j) { const int n = (lane >> 3) + 8 * j; const LAS float* s = scr + (8 * c) * 33 + n;
            v4u o; o.x = pk2(s[0 * 33] * g0, s[1 * 33] * g1); o.y = pk2(s[2 * 33] * g2, s[3 * 33] * g3); o.z = pk2(s[4 * 33] * g4, s[5 * 33] * g5); o.w = pk2(s[6 * 33] * g6, s[7 * 33] * g7);
            *(GAS v4u*)(t.dst + ((size_t)n * t.K + 8 * c) * 2) = o; }
    }
    LDS_WAIT(); asm volatile("" ::: "memory");
}
__device__ __forceinline__ void xrow_load(const float* xrow, f32x4 (&v)[8], int lane) {
    const GAS f32x4* xr = (const GAS f32x4*)xrow + lane;
#pragma unroll
    for (int j = 0; j < 8; ++j) v[j] = xr[64 * j];
}
__device__ __forceinline__ void xrow_finish(const f32x4 (&v)[8], bf16* orow, unsigned char* o8, float s8, float* rinv, int lane) {
    float s = 0.f;
#pragma unroll
    for (int j = 0; j < 8; ++j) s += (v[j].x * v[j].x + v[j].y * v[j].y) + (v[j].z * v[j].z + v[j].w * v[j].w);
    const float rstd = 1.0f / sqrtf(wave_sum(s) * (1.f / DM) + EPS);
    if (lane == 0) *rinv = rstd;
    GAS unsigned long long* ob8 = (GAS unsigned long long*)orow + lane;
#pragma unroll
    for (int j = 0; j < 8; ++j) { ob8[64 * j] = (unsigned long long)pk2(v[j].x, v[j].y) | ((unsigned long long)pk2(v[j].z, v[j].w) << 32);
        ((GAS unsigned*)o8)[64 * j + lane] = pg8::pk4_fp8(v[j].x * s8, v[j].y * s8, v[j].z * s8, v[j].w * s8); }
}
__device__ __forceinline__ void p0_item(Frame& F, TItem& t, int it) {
    constexpr int I0 = (DM / 64) * (NQKV / 32), I1 = (DM / 64) * (DM / 32), I2 = (DM / 64) * (WX / 32), I3 = (DM / 64) * (2 * WX / 32), I4 = (WX / 64) * (DM / 32);
    int r = it;
    if (r < I0) { const int reg = ((r % (NQKV / 32)) * 32) / 1024;
        if (reg == 2 || reg == 5) ti_decode(t, F.w_in, DM, NQKV, F.ws + WS_WV8, F.g_mix, 2, S_WV, 1, 0, r);
        else ti_decode(t, F.w_in, DM, NQKV, F.ws + WS_WIN, F.g_mix, 2, 1.f, 0, 0, r);
        return; } r -= I0;
    if (r < I1) { ti_decode(t, F.w_out, DM, DM, F.ws + WS_WOUT, nullptr, 0, S_WO, 1, 1, r); return; } r -= I1;
    if (r < I2) { ti_decode(t, F.w_xq, DM, WX, F.ws + WS_WXQ, F.g_xattn, 0, 1.f, 0, 0, r); return; } r -= I2;
    if (r < I3) { ti_decode(t, F.w_xkv, DM, 2 * WX, F.ws + WS_WXKV, nullptr, 0, 1.f, 0, 0, r); return; } r -= I3;
    if (r < I4) { ti_decode(t, F.w_xo, WX, DM, F.ws + WS_WXO, nullptr, 0, S_WXO, 1, 1, r); return; } r -= I4;
    ti_decode(t, F.w_gu, DM, 2 * FF, F.ws + WS_WGU, F.g_ffn, 1, S_WGU, 1, 0, r);
}
__device__ __forceinline__ void p0_prologue(Frame& F) {
    LAS float* scr = (LAS float*)(F.lds + F.wave * 16384);
    const int gw = F.vcu * NWAVES + F.wave, NGW = F.G * NWAVES;
    constexpr int I0 = (DM / 64) * (NQKV / 32), I1 = (DM / 64) * (DM / 32), I2 = (DM / 64) * (WX / 32), I3 = (DM / 64) * (2 * WX / 32), I4 = (WX / 64) * (DM / 32),
                  I5 = (DM / 64) * (2 * FF / 32);
    constexpr int I5H = I5 / 2;
    constexpr int NITEMS = I0 + I1 + I2 + I3 + I4 + I5H;
    {   float va[32], vb[32]; f32x4 ga[2], gb[2]; TItem ta, tb;
        int it = gw;
        if (it < NITEMS) { p0_item(F, ta, it); ti_load(ta, va, ga, F.lane);
            for (;;) {
                int itn = it + NGW; p0_item(F, tb, itn < NITEMS ? itn : it); ti_load(tb, vb, gb, F.lane);
                ti_finish(ta, va, ga, scr, F.lane); it = itn; if (it >= NITEMS) break;
                itn = it + NGW; p0_item(F, ta, itn < NITEMS ? itn : it); ti_load(ta, va, ga, F.lane);
                ti_finish(tb, vb, gb, scr, F.lane); it = itn; if (it >= NITEMS) break;
            } }
    }
    {   f32x4 va[8], vb[8];
        bf16* xb = (bf16*)(F.ws + WS_RA); unsigned char* x8 = F.ws + WS_RB; float* ri = (float*)(F.ws + WS_RINV0);
        int m = gw;
        if (m < M) { xrow_load(F.x + (size_t)m * DM, va, F.lane);
            for (;;) {
                int mn = m + NGW; xrow_load(F.x + (size_t)(mn < M ? mn : m) * DM, vb, F.lane);
                xrow_finish(va, xb + (size_t)m * DM, x8 + (size_t)m * DM, S_XN, ri + m, F.lane); m = mn; if (m >= M) break;
                mn = m + NGW; xrow_load(F.x + (size_t)(mn < M ? mn : m) * DM, va, F.lane);
                xrow_finish(vb, xb + (size_t)m * DM, x8 + (size_t)m * DM, S_XN, ri + m, F.lane); m = mn; if (m >= M) break;
            } }
    }
    for (int m = gw; m < MMEM; m += NGW) rms_row_to_bf16(F.mem + (size_t)m * DM, F.g_mem, (bf16*)(F.ws + WS_MN) + (size_t)m * DM, F.lane);
    float* cs = (float*)(F.ws + WS_CS);
    for (int e = (F.vcu * NWAVES + F.wave) * 64 + F.lane; e < M * 16; e += NGW * 64) {
        const int m = e >> 4, i = e & 15; const float ang = (float)F.pos[m] * INV_FREQ[i];
        double rev = (double)ang * 0.15915494309189535; rev -= floor(rev);
        const float a = (float)(rev * 6.283185307179586);
        cs[(size_t)m * 32 + i] = cosf(a); cs[(size_t)m * 32 + 16 + i] = sinf(a);
    }
}

__device__ __forceinline__ void ffn_item(Frame& F, TItem& t, int it) {
    constexpr int I5 = (DM / 64) * (2 * FF / 32);
    if (it < I5) ti_decode(t, F.w_gu, DM, 2 * FF, F.ws + WS_WGU, F.g_ffn, 1, S_WGU, 1, 0, it);
    else ti_decode(t, F.w_dn, FF, DM, F.ws + WS_WDN, nullptr, 0, S_WDN, 1, 0, it - I5);
}
__device__ __forceinline__ void ffn_weight_items(Frame& F, int wi, int nw) {
    LAS float* scr = (LAS float*)(F.lds + F.wave * 16384);
    constexpr int I5 = (DM / 64) * (2 * FF / 32), I6 = (FF / 64) * (DM / 32), NI = I5 + I6;
    float va[32], vb[32]; f32x4 ga[2], gb[2]; TItem ta, tb;
    int it = wi + I5 / 2;
    if (it < NI) { ffn_item(F, ta, it); ti_load(ta, va, ga, F.lane);
        for (;;) {
            int itn = it + nw; ffn_item(F, tb, itn < NI ? itn : it); ti_load(tb, vb, gb, F.lane);
            ti_finish(ta, va, ga, scr, F.lane); it = itn; if (it >= NI) break;
            itn = it + nw; ffn_item(F, ta, itn < NI ? itn : it); ti_load(ta, va, ga, F.lane);
            ti_finish(tb, vb, gb, scr, F.lane); it = itn; if (it >= NI) break;
        } }
}

__device__ __forceinline__ void final_norm_phase(Frame& F, const bf16* src, float* dst) {
    const int gw = F.vcu * NWAVES + F.wave, NGW = F.G * NWAVES;
    for (int m = gw; m < M; m += NGW) {
        const GAS v4u* xr = (const GAS v4u*)(src + (size_t)m * DM) + F.lane; const GAS f32x4* gr = (const GAS f32x4*)F.g_final;
        v4u w[4]; float s = 0.f;
#pragma unroll
        for (int j = 0; j < 4; ++j) w[j] = xr[64 * j];
        f32x4 v[8];
#pragma unroll
        for (int j = 0; j < 4; ++j) { v[2 * j] = (f32x4){__uint_as_float(w[j].x << 16), __uint_as_float(w[j].x & 0xffff0000u), __uint_as_float(w[j].y << 16), __uint_as_float(w[j].y & 0xffff0000u)};
            v[2 * j + 1] = (f32x4){__uint_as_float(w[j].z << 16), __uint_as_float(w[j].z & 0xffff0000u), __uint_as_float(w[j].w << 16), __uint_as_float(w[j].w & 0xffff0000u)}; }
#pragma unroll
        for (int j = 0; j < 8; ++j) s += (v[j].x * v[j].x + v[j].y * v[j].y) + (v[j].z * v[j].z + v[j].w * v[j].w);
        const float rstd = 1.0f / sqrtf(wave_sum(s) * (1.f / DM) + EPS);
        GAS f32x4* dr = (GAS f32x4*)(dst + (size_t)m * DM);
#pragma unroll
        for (int j = 0; j < 4; ++j) { const int c4 = (64 * j + F.lane) * 2;
            dr[c4] = v[2 * j] * rstd * gr[c4]; dr[c4 + 1] = v[2 * j + 1] * rstd * gr[c4 + 1]; }
    }
}

struct RangeOrder : pg8::StaticOrder {
    int i0, n;
    __device__ __forceinline__ bool next(int i, pg8::Unit& u) const { return i < n && pg8::StaticOrder::next(i + i0, u); }
};
template <int K> __device__ __forceinline__ const void* late_arg() {
    const void* p; asm volatile("s_load_dwordx2 %0, %1, %2\n\ts_waitcnt lgkmcnt(0)" : "=s"(p) : "s"(__builtin_amdgcn_kernarg_segment_ptr()), "i"(K * 8));
    return p;
}
constexpr int NPH = 11;
#ifndef REPEAT_WHICH
#define REPEAT_WHICH 3
#endif
#ifndef NULL_EPI_PROBE
#define NULL_EPI_PROBE 0
#endif
#ifndef FOLD_KMEAN
#define FOLD_KMEAN 1
#endif
#ifndef REPEAT_PHASE
#define REPEAT_PHASE -1
#endif
#ifndef REPEAT_MASK
#define REPEAT_MASK 0
#endif
#define REPS(k) (((REPEAT_PHASE == (k)) || ((REPEAT_MASK >> (k)) & 1)) ? 2 : 1)
#ifndef USE_MFMA_SB
#define USE_MFMA_SB 1
#endif
#ifndef USE_MFMA_MOBA
#define USE_MFMA_MOBA 1
#endif
#ifndef USE_MFMA_X
#define USE_MFMA_X 1
#endif
#ifndef MK_ONE_LAUNCH
#define MK_ONE_LAUNCH 1
#endif
struct Args { const void* in[17]; float* out; unsigned char* ws; int ph_lo, ph_hi; };
__global__ void __launch_bounds__(NWAVES * 64, 2) mk_fwd(Args args) {
    extern __shared__ __attribute__((aligned(16))) unsigned char lds[];
    Frame F;
    F.lds = (LAS unsigned char*)lds;
    F.tid = threadIdx.x; F.lane = F.tid & 63; F.wave = __builtin_amdgcn_readfirstlane(F.tid >> 6);
    F.G = gridDim.x; { const int bx = blockIdx.x; F.vcu = (F.G % 8 == 0) ? (bx % 8) * (F.G / 8) + bx / 8 : bx; }
    F.x = (const float*)args.in[0]; F.mem = (const float*)args.in[1]; F.pos = (const int*)args.in[2];
    F.g_mix = (const float*)args.in[3]; F.w_in = (const float*)args.in[4]; F.g_out_sb = nullptr; F.g_out_mb = nullptr; F.w_out = (const float*)args.in[7];
    F.g_xattn = (const float*)args.in[8]; F.g_mem = (const float*)args.in[9]; F.w_xq = (const float*)args.in[10]; F.w_xkv = (const float*)args.in[11]; F.w_xo = (const float*)args.in[12];
    F.g_ffn = nullptr; F.w_gu = nullptr; F.w_dn = nullptr; F.g_final = nullptr;
    F.out = args.out; F.ws = args.ws;
    unsigned char* ws = args.ws;
    const int lo = args.ph_lo, hi = args.ph_hi;
    for (int u = F.tid; u < (LDS_BYTES - LDSCTL_OFF) / 4; u += NWAVES * 64) ((LAS unsigned*)(F.lds + LDSCTL_OFF))[u] = 0u;
    __syncthreads();
    if (hi - lo > 1) {
        { GAS v4u* z = (GAS v4u*)(ws + WS_CTL); const int n16 = (int)(CTL_ZERO_BYTES / 16);
          for (int i = (int)blockIdx.x * (NWAVES * 64) + F.tid; i < n16; i += F.G * NWAVES * 64) z[i] = (v4u){0u, 0u, 0u, 0u}; }
        cg::this_grid().sync();
    }
    XcdBarrier bar = xcd_barrier_post((unsigned*)(ws + WS_CTL) + CW_BAR, (volatile LAS unsigned*)(F.lds + MISC_OFF) + 8);
#ifndef ONLY_PHASE
#define ONLY_PHASE -1
#endif
#define IN(k) ((ONLY_PHASE < 0 || ONLY_PHASE == (k)) && lo <= (k) && (k) < hi)
#define BOTH(k) (IN(k) && IN((k) + 1))
#define GRID_BAR() xcd_barrier(bar)
    float* ssq1 = (float*)(ws + WS_SSQ1); float* ssq2 = (float*)(ws + WS_SSQ2);
    pg8::bf16_t* ACT = (pg8::bf16_t*)(ws + WS_RC + 64 * MiB);
    pg8::bf16_t* RA = (pg8::bf16_t*)(ws + WS_RA); pg8::bf16_t* RB = (pg8::bf16_t*)(ws + WS_RB); pg8::bf16_t* RC = (pg8::bf16_t*)(ws + WS_RC);

    if (IN(0)) { F.w_gu = (const float*)late_arg<14>(); F.g_ffn = (const float*)late_arg<13>(); for (int rep = 0; rep < REPS(0); ++rep) p0_prologue(F); F.w_gu = nullptr; F.g_ffn = nullptr; if (BOTH(0)) GRID_BAR(); }
    if (IN(1)) {
        pg8::Gemm gq{RA, (const pg8::bf16_t*)(ws + WS_WIN), M, 4096, DM}; RangeOrder Sq; Sq.init(M, 4096, F.G, (int)blockIdx.x);
        pg8::EpiQKV Eq{RC, (const float*)(ws + WS_CS), QSCALE, (float*)(ws + WS_KSUM), 0, 1.f, (const float*)(ws + WS_RINV0)};
        pg8::Gemm gv{RB, (const pg8::bf16_t*)(ws + WS_WV8), M, 2048, DM / 2}; RangeOrder Sv; Sv.init(M, 2048, F.G, (int)blockIdx.x);
        pg8::EpiQKV Ev{RC, (const float*)(ws + WS_CS), QSCALE, (float*)(ws + WS_KSUM), 1, 1.f / (S_XN * S_WV), (const float*)(ws + WS_RINV0)};
        for (int rep = 0; rep < REPS(1); ++rep) {
        const bool grp = ((blockIdx.x >> 3) & 1) != 0;
        Sq.i0 = 0; Sq.n = 1 << 20;
        if (grp) { Sv.i0 = 0; Sv.n = 1; pg8::gemm_phase<pg8::EpiQKV, RangeOrder, true, true, true>(F.lds, gv, Sv, Ev); }
        pg8::gemm_phase<pg8::EpiQKV, RangeOrder, true, true>(F.lds, gq, Sq, Eq);
        Sv.i0 = grp ? 1 : 0; Sv.n = 1 << 20;
        pg8::gemm_phase<pg8::EpiQKV, RangeOrder, true, true, true>(F.lds, gv, Sv, Ev);
        }
        if (BOTH(1)) GRID_BAR();
    }
    if (IN(3)) {
        const att::bf16* qkv = (const att::bf16*)RC; att::bf16* ob = (att::bf16*)RB; const float* kmean = (const float*)(ws + WS_KSUM);
        F.g_out_sb = (const float*)late_arg<5>(); F.g_out_mb = (const float*)late_arg<6>();
        constexpr size_t HSZ = (size_t)SEQ * HD;
        for (int rep = 0; rep < REPS(3); ++rep) {
        if (rep == 0 || (REPEAT_WHICH & 1))
        for (int vv = F.vcu; vv < 256; vv += F.G) { const int bh = vv >> 2, s = vv & 3, b = bh >> 3, h = bh & 7; const size_t rb = (size_t)b * SEQ;
            const att::bf16* hS = qkv + ((size_t)b * 48 + h) * HSZ; const att::bf16* hM = qkv + ((size_t)b * 48 + 24 + h) * HSZ;
            for (int i = 0; i < 2; ++i) { const int qb = i ? s : 7 - s; const size_t r0 = rb + (size_t)qb * 256;
                att::attn_unit<2, true>(hS, nullptr, nullptr, (att::bf16*)((unsigned char*)ob + r0 * DM + h * HD), F.g_out_sb + h * HD, nullptr, qb, 0, (char*)lds, S_O,
                                        i != 0, i ? hM : hS, i ? 7 - s : s, i ? 0 : 4 * (s + 1) - 1, i ? -1 : 4 * (s + 1) - 2); }
            for (int i = 0; i < 2; ++i) { const int qb = i ? s : 7 - s; const size_t r0 = rb + (size_t)qb * 256;
                att::attn_unit<1, true>(hM, nullptr, nullptr, (att::bf16*)((unsigned char*)ob + r0 * DM + NH * HD + h * HD), F.g_out_mb + h * HD, kmean + (size_t)bh * 1024, qb, 0, (char*)lds, S_O,
                                        true, i ? nullptr : hM, s, 0, -1); } }
        }
        if (BOTH(3)) GRID_BAR();
    }
    if (IN(4)) {
        pg8::Gemm g{RB, (const pg8::bf16_t*)(ws + WS_WOUT), M, DM, WOUT_FP8 ? DM / 2 : DM}; pg8::StaticOrder S; S.init(M, DM, F.G, (int)blockIdx.x);
        pg8::EpiResB<false> E{RA, RC, ssq1, nullptr, 1.f, WOUT_FP8 ? 1.f / (S_O * S_WO) : 1.f};
        pg8::gemm_phase<pg8::EpiResB<false>, pg8::StaticOrder, true, true, WOUT_FP8 != 0>(F.lds, g, S, E);
        if (BOTH(4)) GRID_BAR();
    }
    if (IN(5)) {
      F.w_gu = (const float*)late_arg<14>(); F.g_ffn = (const float*)late_arg<13>(); F.w_dn = (const float*)late_arg<15>();
      for (int rep = 0; rep < REPS(5); ++rep) {
        { pg8::Gemm g{RC, (const pg8::bf16_t*)(ws + WS_WXQ), M, WX, DM}; pg8::StaticOrder S; S.init(M, WX, F.G, (int)blockIdx.x);
          pg8::EpiScale E{(pg8::bf16_t*)(ws + WS_QX), WX, ssq1, QSCALE};
          pg8::gemm_phase<pg8::EpiScale, pg8::StaticOrder, true, true>(F.lds, g, S, E); }
        { pg8::Gemm g{(const pg8::bf16_t*)(ws + WS_MN), (const pg8::bf16_t*)(ws + WS_WXKV), MMEM, 2 * WX, DM}; pg8::StaticOrder S; S.init(MMEM, 2 * WX, F.G, (int)((blockIdx.x + F.G - 128) % F.G));
          pg8::EpiScale E{(pg8::bf16_t*)(ws + WS_KVX), 2 * WX, nullptr, 1.0f};
          pg8::gemm_phase<pg8::EpiScale, pg8::StaticOrder, true, true>(F.lds, g, S, E); }
        if (F.G > 160) { if ((int)blockIdx.x >= 160) ffn_weight_items(F, ((int)blockIdx.x - 160) * NWAVES + F.wave, (F.G - 160) * NWAVES); }
        else ffn_weight_items(F, (int)blockIdx.x * NWAVES + F.wave, F.G * NWAVES);
      }
        if (BOTH(5)) GRID_BAR();
    }
    if (IN(6)) {
        const att::bf16* qx = (const att::bf16*)(ws + WS_QX); const att::bf16* kvx = (const att::bf16*)(ws + WS_KVX); att::bf16* ox = (att::bf16*)(ws + WS_OX);
        for (int rep = 0; rep < REPS(6); ++rep) {
        for (int vv = F.vcu; vv < 256; vv += F.G) { const int b = vv >> 5, h = (vv >> 3) & 3, qb = vv & 7; const size_t r0 = (size_t)b * SEQ + (size_t)qb * 256;
            if (WXO_FP8) att::attn_unit<0, true>(qx + r0 * WX + h * HD, kvx + (size_t)b * NMEM * (2 * WX) + h * HD, kvx + (size_t)b * NMEM * (2 * WX) + WX + h * HD, (att::bf16*)((unsigned char*)ox + r0 * WX + h * HD), nullptr, nullptr, qb, NMEM, (char*)lds, S_OX);
            else att::attn_unit<0>(qx + r0 * WX + h * HD, kvx + (size_t)b * NMEM * (2 * WX) + h * HD, kvx + (size_t)b * NMEM * (2 * WX) + WX + h * HD, ox + r0 * WX + h * HD, nullptr, nullptr, qb, NMEM, (char*)lds); }
        }
        if (BOTH(6)) GRID_BAR();
    }
    if (IN(7)) {
        pg8::Gemm g{(const pg8::bf16_t*)(ws + WS_OX), (const pg8::bf16_t*)(ws + WS_WXO), M, DM, WXO_FP8 ? WX / 2 : WX}; pg8::StaticOrder S; S.init(M, DM, F.G, (int)blockIdx.x);
        pg8::EpiResB<false> E{RC, RC, ssq2, (unsigned char*)RA, S_X2, WXO_FP8 ? 1.f / (S_OX * S_WXO) : 1.f};
        pg8::gemm_phase<pg8::EpiResB<false>, pg8::StaticOrder, true, true, WXO_FP8 != 0>(F.lds, g, S, E);
        if (BOTH(7)) GRID_BAR();
    }
    if (IN(8)) {
        pg8::Gemm g{RA, (const pg8::bf16_t*)(ws + WS_WGU), M, 2 * FF, FFN_FP8 ? DM / 2 : DM}; pg8::StaticOrder S; S.init(M, 2 * FF, F.G, (int)blockIdx.x);
        pg8::EpiSwiGLU E{ACT, ssq2, FFN_FP8 ? (unsigned char*)ACT : nullptr, FFN_FP8 ? 1.f / (S_X2 * S_WGU) : 1.f, S_ACT};
#if NULL_EPI_PROBE
        if (REPS(8) == 2) { pg8::EpiNull EN{nullptr}; pg8::gemm_phase<pg8::EpiNull, pg8::StaticOrder, true, true, FFN_FP8 != 0>(F.lds, g, S, EN); }
        pg8::gemm_phase<pg8::EpiSwiGLU, pg8::StaticOrder, true, true, FFN_FP8 != 0>(F.lds, g, S, E);
#else
        for (int rep = 0; rep < REPS(8); ++rep) pg8::gemm_phase<pg8::EpiSwiGLU, pg8::StaticOrder, true, true, FFN_FP8 != 0>(F.lds, g, S, E);
#endif
        if (BOTH(8)) GRID_BAR();
    }
    if (IN(9)) {
        pg8::Gemm g{ACT, (const pg8::bf16_t*)(ws + WS_WDN), M, DM, FF / 2}; pg8::StaticOrder S; S.init(M, DM, F.G, (int)blockIdx.x);
        pg8::EpiResB<false> E{RC, RC, nullptr, nullptr, 1.f, 1.f / (S_ACT * S_WDN)};
        pg8::gemm_phase<pg8::EpiResB<false>, pg8::StaticOrder, true, true, true>(F.lds, g, S, E);
        if (BOTH(9)) GRID_BAR();
    }
    if (IN(10)) { F.g_final = (const float*)late_arg<16>(); final_norm_phase(F, RC, F.out); }
#undef IN
#undef BOTH
}

extern "C" void kernel_launch(void* const* d_in, const int* in_sizes, int n_in, void* d_out, int out_size, void* d_ws, size_t ws_size, hipStream_t stream) {
    static int grid = 0;
    if (grid == 0) {
        if (n_in != 17 || in_sizes[0] != M * DM || out_size != M * DM || ws_size < WS_END) { fprintf(stderr, "kernel_launch: unexpected shapes (n_in %d in0 %d out %d ws %zu)\n", n_in, n_in > 0 ? in_sizes[0] : -1, out_size, ws_size); grid = -1; return; }
        int dev = 0, cus = 0, per_cu = 0;
        if (hipGetDevice(&dev) != hipSuccess || hipDeviceGetAttribute(&cus, hipDeviceAttributeMultiprocessorCount, dev) != hipSuccess) { grid = -1; return; }
        if (hipFuncSetAttribute((const void*)mk_fwd, hipFuncAttributeMaxDynamicSharedMemorySize, LDS_BYTES) != hipSuccess) { fprintf(stderr, "kernel_launch: hipFuncSetAttribute failed\n"); grid = -1; return; }
        if (hipOccupancyMaxActiveBlocksPerMultiprocessor(&per_cu, (const void*)mk_fwd, NWAVES * 64, LDS_BYTES) != hipSuccess || per_cu < 1) { fprintf(stderr, "kernel_launch: occupancy query failed (%d)\n", per_cu); per_cu = 1; }
        (void)hipGetLastError();
        grid = cus * (per_cu < 1 ? 1 : 1);
    }
    if (grid < 0) return;
#if !MK_ONE_LAUNCH
    (void)hipMemsetAsync((char*)d_ws + WS_CTL, 0, CTL_ZERO_BYTES, stream);
#endif
    Args a{};
    for (int i = 0; i < 17; ++i) a.in[i] = d_in[i];
    a.out = (float*)d_out; a.ws = (unsigned char*)d_ws;
#if MK_ONE_LAUNCH
    a.ph_lo = 0; a.ph_hi = NPH;
    void* kargs[] = {&a};
    hipError_t e = hipLaunchCooperativeKernel((const void*)mk_fwd, dim3(grid), dim3(NWAVES * 64), kargs, LDS_BYTES, stream);
    if (e != hipSuccess) fprintf(stderr, "kernel_launch: cooperative launch failed: %s (grid %d)\n", hipGetErrorString(e), grid);
#else
    for (int p = 0; p < NPH; ++p) { a.ph_lo = p; a.ph_hi = p + 1; hipLaunchKernelGGL(mk_fwd, dim3(grid), dim3(NWAVES * 64), LDS_BYTES, stream, a); }
    const hipError_t le = hipPeekAtLastError();
    if (le != hipSuccess) fprintf(stderr, "kernel_launch: launch failed: %s\n", hipGetErrorName(le));
#endif
}
```

```cpp
#include <hip/hip_runtime.h>
#include <hip/hip_cooperative_groups.h>
#include <cstdio>
#include <cstdint>
namespace cg = cooperative_groups;
namespace pg8 {
#define PG8_LAS __attribute__((address_space(3)))
typedef unsigned short bf16_t;
typedef short bf16x8 __attribute__((ext_vector_type(8)));
typedef float f32x4 __attribute__((ext_vector_type(4)));
typedef unsigned u32x4 __attribute__((ext_vector_type(4)));
constexpr int BM = 256, BK = 64, HALF = 128, HTB = HALF * BK * 2  , STAGE_BYTES = 8 * HTB, NXCD = 8, WGM = 8;

__host__ __device__ __forceinline__ int lds_byte(int r, int c) { const int st = (r >> 4) * 2 + (c >> 5), rr = r & 15, cc = c & 31, ob = rr * 64 + cc * 2; return st * 1024 + (ob ^ (((ob >> 9) & 1) << 5)); }
__host__ __device__ __forceinline__ void stage_rc(int b, int& R, int& C) { const int st = b / 1024, sb = b % 1024, swz = sb ^ (((sb >> 9) & 1) << 5); R = (st >> 1) * 16 + swz / 64; C = (st & 1) * 32 + (swz % 64) / 2; }
__host__ __device__ __forceinline__ int perm32(int rho) { const int n = rho >> 4, i = rho & 15; return 8 * (i >> 2) + 4 * n + (i & 3); }

struct Unit { int pm, pn; };
struct Gemm { const bf16_t* A; const bf16_t* Bt; int M, N, K; };

struct StaticOrder {
    int nM, nN, nwg, G, c;
    __host__ __device__ void init(int M, int N, int G_, int c_) { nM = M / BM; nN = N / BM; nwg = nM * nN; G = G_; c = c_; }
    __host__ __device__ bool next(int i, Unit& u) const {
        const long L = (long)i * G + c; if (L >= nwg) return false;
        int wgid = (int)L; { const int q = nwg / NXCD, r = nwg % NXCD, xcd = wgid % NXCD, off = wgid / NXCD; wgid = (xcd < r ? xcd * (q + 1) : r * (q + 1) + (xcd - r) * q) + off; }
        const int nig = WGM * nN, gid = wgid / nig, fm = gid * WGM, gsz = (nM - fm) < WGM ? (nM - fm) : WGM;
        u.pm = fm + ((wgid % nig) % gsz); u.pn = (wgid % nig) / gsz; return true;
    }
    __device__ __forceinline__ void a_ready(const Unit&) const {}
    __device__ __forceinline__ void done(const Unit&) const {}
};

__device__ __forceinline__ unsigned cvt_pk_bf16(float lo, float hi) { unsigned r; asm volatile("v_cvt_pk_bf16_f32 %0, %1, %2" : "=v"(r) : "v"(lo), "v"(hi)); return r; }
typedef float f32x2 __attribute__((ext_vector_type(2)));
template <class Epi, class Sched, bool ALIGN_EPI = false, bool SP2 = false, bool FP8 = false>
__device__ __forceinline__ void gemm_phase(PG8_LAS unsigned char* lds, const Gemm g, const Sched& S, const Epi& E) {
    int tid_ = threadIdx.x; asm volatile("" : "+v"(tid_));
    const int tid = tid_, wid = __builtin_amdgcn_readfirstlane(tid >> 6), lane = tid & 63, wr = wid >> 2, wc = wid & 3, fr = lane & 15, fq = lane >> 4;
    const int K = g.K, nt = K / BK;
    unsigned voffA[2], voffB[2];
#pragma unroll
    for (int i = 0; i < 2; ++i) { int R, C; stage_rc(tid * 16 + i * 8192, R, C); const int Rb = Epi::PERM ? ((R & ~31) + perm32(R & 31)) : R;
        voffA[i] = (unsigned)(R * K + C) * 2u; voffB[i] = (unsigned)(Rb * K + C) * 2u; }
    const size_t kstep = (size_t)(BK * 2);
    const size_t hstep = (size_t)HALF * K * 2;
    const size_t tstep = 2 * hstep;
    const unsigned ldsw = (unsigned)wid * 1024u;
    const int aoff = lds_byte(wr * 64 + fr, fq * 8), boff = lds_byte(wc * 32 + fr, fq * 8);
#define PG8_SA(b, h) (((b) * 2 + (h)) * HTB)
#define PG8_SB(b, h) ((4 + (b) * 2 + (h)) * HTB)
#define PG8_STAGE(bufoff, gbase, voff) do { _Pragma("unroll") for (int _i = 0; _i < 2; ++_i) \
        __builtin_amdgcn_global_load_lds((const unsigned*)((const char*)(gbase) + (voff)[_i]), (PG8_LAS unsigned*)(lds + (bufoff) + ldsw + _i * 8192), 16, 0, 0); } while (0)
#define PG8_LD8(p) __builtin_shufflevector(*(const PG8_LAS i32x4_*)(p), *(const PG8_LAS i32x4_*)((p) + 1024), 0, 1, 2, 3, 4, 5, 6, 7)
#define PG8_LDA(dst, b, h) do { if constexpr (FP8) { _Pragma("unroll") for (int m = 0; m < 4; ++m) dst##8[m] = PG8_LD8(lds + PG8_SA(b, h) + aoff + m * 2048); } \
        else { _Pragma("unroll") for (int m = 0; m < 4; ++m) _Pragma("unroll") for (int k = 0; k < 2; ++k) dst[m][k] = *(const PG8_LAS bf16x8*)(lds + PG8_SA(b, h) + aoff + m * 2048 + k * 1024); } } while (0)
#define PG8_LDB(dst, b, h) do { if constexpr (FP8) { _Pragma("unroll") for (int n = 0; n < 2; ++n) dst##8[n] = PG8_LD8(lds + PG8_SB(b, h) + boff + n * 2048); } \
        else { _Pragma("unroll") for (int n = 0; n < 2; ++n) _Pragma("unroll") for (int k = 0; k < 2; ++k) dst[n][k] = *(const PG8_LAS bf16x8*)(lds + PG8_SB(b, h) + boff + n * 2048 + k * 1024); } } while (0)
#define PG8_MMA(ai, bj, At, Bt) do { __builtin_amdgcn_s_setprio(1); _Pragma("unroll") for (int m = 0; m < 4; ++m) _Pragma("unroll") for (int n = 0; n < 2; ++n) { \
        if constexpr (FP8) asm volatile("v_mfma_scale_f32_16x16x128_f8f6f4 %0, %1, %2, %0, %3, %3 op_sel_hi:[0,0,0]" : "+v"(acc[ai][bj][m][n]) : "v"(Bt##8[n]), "v"(At##8[m]), "v"(sc1_)); \
        else { _Pragma("unroll") for (int k = 0; k < 2; ++k) acc[ai][bj][m][n] = __builtin_amdgcn_mfma_f32_16x16x32_bf16(Bt[n][k], At[m][k], acc[ai][bj][m][n], 0, 0, 0); } } \
        __builtin_amdgcn_s_setprio(0); } while (0)
#define PG8_WAIT_V(n) asm volatile("s_waitcnt vmcnt(" #n ")" ::: "memory")
#define PG8_WAIT_L(n) asm volatile("s_waitcnt lgkmcnt(" #n ")" ::: "memory")
#define PG8_BAR __builtin_amdgcn_s_barrier()
#define PG8_SCHED __builtin_amdgcn_sched_barrier(0)
    Unit cur, nxt; int ui = 0;
    if (!S.next(0, cur)) return;
    f32x4 acc[2][2][4][2];
#pragma unroll
    for (int a = 0; a < 2; ++a)
#pragma unroll
        for (int b = 0; b < 2; ++b)
#pragma unroll
            for (int m = 0; m < 4; ++m)
#pragma unroll
                for (int n = 0; n < 2; ++n) acc[a][b][m][n] = (f32x4){0.f, 0.f, 0.f, 0.f};
    typedef int i32x4_ __attribute__((ext_vector_type(4))); typedef int i32x8_ __attribute__((ext_vector_type(8)));
    int sc1_ = 0x7F7F7F7F; asm volatile("" : "+v"(sc1_));
    bf16x8 At[4][2], B0[2][2], B1[2][2]; i32x8_ At8[4], B08[2], B18[2];
    const char* cA = (const char*)g.A + (size_t)cur.pm * tstep; const char* cB = (const char*)g.Bt + (size_t)cur.pn * tstep;
    S.a_ready(cur);
    if constexpr (SP2) {
        PG8_STAGE(PG8_SB(0, 0), cB, voffB); PG8_STAGE(PG8_SB(0, 1), cB + hstep, voffB); PG8_STAGE(PG8_SA(0, 0), cA, voffA); PG8_STAGE(PG8_SA(0, 1), cA + hstep, voffA);
        if (wr == 1) PG8_BAR;
        PG8_WAIT_V(2); PG8_BAR;
        PG8_STAGE(PG8_SB(1, 0), cB + kstep, voffB); PG8_STAGE(PG8_SA(1, 0), cA + kstep, voffA); PG8_STAGE(PG8_SB(1, 1), cB + hstep + kstep, voffB);
        PG8_WAIT_V(6); PG8_BAR;
    } else {
        PG8_STAGE(PG8_SB(0, 0), cB, voffB); PG8_STAGE(PG8_SA(0, 0), cA, voffA); PG8_STAGE(PG8_SB(0, 1), cB + hstep, voffB); PG8_STAGE(PG8_SA(0, 1), cA + hstep, voffA);
        if (wr == 1) PG8_BAR;
        PG8_WAIT_V(4); PG8_BAR;
        PG8_STAGE(PG8_SB(1, 0), cB + kstep, voffB); PG8_STAGE(PG8_SA(1, 0), cA + kstep, voffA); PG8_STAGE(PG8_SB(1, 1), cB + hstep + kstep, voffB);
        PG8_WAIT_V(6); PG8_BAR;
    }
    for (;;) {
        const bool has_next = S.next(ui + 1, nxt);
        const char* nA = has_next ? (const char*)g.A + (size_t)nxt.pm * tstep : cA; const char* nB = has_next ? (const char*)g.Bt + (size_t)nxt.pn * tstep : cB;
        for (int t = 0; t < nt; t += 2) {
            const bool last = (t == nt - 2);
            const char* a1 = cA + (size_t)(t + 1) * kstep;
            const char* a2 = last ? nA : cA + (size_t)(t + 2) * kstep; const char* b2 = last ? nB : cB + (size_t)(t + 2) * kstep;
            const char* a3 = a2 + kstep; const char* b3 = b2 + kstep;
            if (last && has_next) S.a_ready(nxt);
            if constexpr (SP2) {
            PG8_LDB(B0, 0, 0); PG8_LDB(B1, 0, 1); PG8_SCHED; PG8_LDA(At, 0, 0); PG8_STAGE(PG8_SA(1, 1), a1 + hstep, voffA);
            PG8_WAIT_V(8); PG8_WAIT_L(0); PG8_BAR; PG8_MMA(0, 0, At, B0); PG8_MMA(0, 1, At, B1); PG8_BAR; PG8_SCHED;
            PG8_LDA(At, 0, 1); PG8_STAGE(PG8_SB(0, 0), b2, voffB); PG8_STAGE(PG8_SB(0, 1), b2 + hstep, voffB); PG8_STAGE(PG8_SA(0, 0), a2, voffA);
            PG8_WAIT_V(8); PG8_WAIT_L(0); PG8_BAR; PG8_MMA(1, 0, At, B0); PG8_MMA(1, 1, At, B1); PG8_BAR; PG8_SCHED;
            PG8_LDB(B0, 1, 0); PG8_LDB(B1, 1, 1); PG8_SCHED; PG8_LDA(At, 1, 0); PG8_STAGE(PG8_SA(0, 1), a2 + hstep, voffA);
            PG8_WAIT_V(8); PG8_WAIT_L(0); PG8_BAR; PG8_MMA(0, 0, At, B0); PG8_MMA(0, 1, At, B1); PG8_BAR; PG8_SCHED;
            PG8_LDA(At, 1, 1); PG8_STAGE(PG8_SB(1, 0), b3, voffB); PG8_STAGE(PG8_SB(1, 1), b3 + hstep, voffB); PG8_STAGE(PG8_SA(1, 0), a3, voffA);
            PG8_WAIT_V(8); PG8_WAIT_L(0); PG8_BAR; PG8_MMA(1, 0, At, B0); PG8_MMA(1, 1, At, B1); PG8_BAR; PG8_SCHED;
            } else {
            PG8_LDB(B0, 0, 0); PG8_SCHED; PG8_LDA(At, 0, 0); PG8_STAGE(PG8_SA(1, 1), a1 + hstep, voffA);
            PG8_WAIT_L(8); PG8_BAR; PG8_WAIT_L(0); PG8_MMA(0, 0, At, B0); PG8_BAR; PG8_SCHED;
            PG8_LDB(B1, 0, 1); PG8_STAGE(PG8_SB(0, 0), b2, voffB);
            PG8_BAR; PG8_WAIT_L(0); PG8_MMA(0, 1, At, B1); PG8_BAR;
            PG8_LDA(At, 0, 1); PG8_STAGE(PG8_SA(0, 0), a2, voffA);
            PG8_BAR; PG8_WAIT_L(0); PG8_MMA(1, 0, At, B0); PG8_BAR; PG8_SCHED;
            PG8_STAGE(PG8_SB(0, 1), b2 + hstep, voffB);
            PG8_WAIT_V(6); PG8_BAR; PG8_MMA(1, 1, At, B1); PG8_BAR;
            PG8_LDB(B0, 1, 0); PG8_SCHED; PG8_LDA(At, 1, 0); PG8_STAGE(PG8_SA(0, 1), a2 + hstep, voffA);
            PG8_WAIT_L(8); PG8_BAR; PG8_WAIT_L(0); PG8_MMA(0, 0, At, B0); PG8_BAR; PG8_SCHED;
            PG8_LDB(B1, 1, 1); PG8_STAGE(PG8_SB(1, 0), b3, voffB);
            PG8_BAR; PG8_WAIT_L(0); PG8_MMA(0, 1, At, B1); PG8_BAR;
            PG8_LDA(At, 1, 1); PG8_STAGE(PG8_SA(1, 0), a3, voffA);
            PG8_BAR; PG8_WAIT_L(0); PG8_MMA(1, 0, At, B0); PG8_BAR; PG8_SCHED;
            PG8_STAGE(PG8_SB(1, 1), b3 + hstep, voffB);
            PG8_WAIT_V(6); PG8_BAR; PG8_MMA(1, 1, At, B1); PG8_BAR;
            }
        }
        if constexpr (ALIGN_EPI) { if (wr == 0) PG8_BAR; }
        if constexpr (FP8) asm volatile("s_nop 15\n\ts_nop 15" ::: "memory");
        if constexpr (!Epi::AFTER_DRAIN) { E(acc, cur, wr, wc, fr, fq); S.done(cur); }
        if (!has_next) break;
#pragma unroll
        for (int a = 0; a < 2; ++a)
#pragma unroll
            for (int b = 0; b < 2; ++b)
#pragma unroll
                for (int m = 0; m < 4; ++m)
#pragma unroll
                    for (int n = 0; n < 2; ++n) acc[a][b][m][n] = (f32x4){0.f, 0.f, 0.f, 0.f};
        cur = nxt; cA = nA; cB = nB; ++ui;
        if constexpr (ALIGN_EPI) { if (wr == 1) PG8_BAR; }
    }
    PG8_WAIT_V(0);
    if constexpr (!ALIGN_EPI) { if (wr == 0) PG8_BAR; }
    PG8_BAR;
    if constexpr (Epi::AFTER_DRAIN) { E.fused(acc, cur, wr, wc, fr, fq, lds, wid, lane); S.done(cur); }
#undef PG8_SA
#undef PG8_SB
#undef PG8_STAGE
#undef PG8_LDA
#undef PG8_LD8
#undef PG8_LDB
#undef PG8_MMA
#undef PG8_WAIT_V
#undef PG8_WAIT_L
#undef PG8_BAR
#undef PG8_SCHED
}
}
namespace pg8 {
typedef unsigned u32x2 __attribute__((ext_vector_type(2)));
constexpr int LDX = 2048;
constexpr float RMS_EPS = 1e-6f;
#ifndef EPI_SC1
#define EPI_SC1 1
#endif
__device__ __forceinline__ void store16(void* p, u32x4 w) {
#if EPI_SC1
    asm volatile("global_store_dwordx4 %0, %1, off sc1\n\ts_nop 1" :: "v"(p), "v"(w) : "memory");
#else
    *(u32x4*)p = w;
#endif
}
struct EpiQKV {
    static constexpr bool PERM = true, AFTER_DRAIN = false;
    bf16_t* O; const float* cs; float qscale; float* ksum; int vmode; float vscale; const float* rinv; float pre; int pnoff;
    __device__ __forceinline__ void operator()(const f32x4 (&acc)[2][2][4][2], const Unit& u, int wr, int wc, int fr, int fq) const {
        const int row0 = u.pm * BM + wr * 64 + fr, pn = vmode ? (u.pn < 4 ? u.pn + 8 : u.pn + 16) : (u.pn + pnoff < 8 ? u.pn + pnoff : u.pn + pnoff + 4);
        const float sc = (pn < 4 || (pn >= 12 && pn < 16)) ? qscale : vscale;
        const bool rot = (pn >= 12 && pn < 20) && (wc == 0);
        bf16_t* Ot = O + ((size_t)((u.pm >> 3) * 6 + (pn >> 2)) * 8 + (pn & 3) * 2) * (2048 * 128) + wc * 32 + 8 * fq;
        const bool kacc = (pn >= 16 && pn < 20);
        float rf[2][4];
#pragma unroll
        for (int ai = 0; ai < 2; ++ai)
#pragma unroll
            for (int m = 0; m < 4; ++m) rf[ai][m] = rinv[row0 + ai * HALF + m * 16] * pre;
        f32x4 ks[2][2] = {{{0.f, 0.f, 0.f, 0.f}, {0.f, 0.f, 0.f, 0.f}}, {{0.f, 0.f, 0.f, 0.f}, {0.f, 0.f, 0.f, 0.f}}};
#pragma unroll
        for (int ai = 0; ai < 2; ++ai)
#pragma unroll
            for (int m = 0; m < 4; ++m) { const int row = row0 + ai * HALF + m * 16; bf16_t* rowp = Ot + (size_t)(row & 2047) * 128;
                f32x4 c0 = {1.f, 1.f, 1.f, 1.f}, c1 = c0, s0 = {0.f, 0.f, 0.f, 0.f}, s1 = s0;
                if (rot) { const float* cr = cs + (size_t)row * 32 + 8 * (fq & 1); c0 = *(const f32x4*)cr; c1 = *(const f32x4*)(cr + 4); s0 = *(const f32x4*)(cr + 16); s1 = *(const f32x4*)(cr + 20);
                    if (fq < 2) { s0 = -s0; s1 = -s1; } }
#pragma unroll
                for (int bj = 0; bj < 2; ++bj) { f32x4 v0 = acc[ai][bj][m][0] * rf[ai][m], v1 = acc[ai][bj][m][1] * rf[ai][m];
                    if (rot) { f32x4 p0, p1;
#pragma unroll
                        for (int j = 0; j < 4; ++j) { p0[j] = __shfl_xor(v0[j], 32); p1[j] = __shfl_xor(v1[j], 32); }
                        v0 = v0 * c0 + p0 * s0; v1 = v1 * c1 + p1 * s1; }
                    if (kacc) { ks[bj][0] += v0; ks[bj][1] += v1; }
                    v0 = v0 * sc; v1 = v1 * sc; u32x4 w; w.x = cvt_pk_bf16(v0[0], v0[1]); w.y = cvt_pk_bf16(v0[2], v0[3]); w.z = cvt_pk_bf16(v1[0], v1[1]); w.w = cvt_pk_bf16(v1[2], v1[3]);
                    store16(rowp + (size_t)bj * (2048 * 128), w); } }
        if (kacc) {
            float* kp = ksum + (size_t)(((u.pm >> 3) * 8 + (pn - 16) * 2) * 8 + (u.pm & 7)) * 128 + wc * 32 + 8 * fq;
#pragma unroll
            for (int bj = 0; bj < 2; ++bj)
#pragma unroll
                for (int n = 0; n < 2; ++n)
#pragma unroll
                    for (int j = 0; j < 4; ++j) { float s = ks[bj][n][j]; s += __shfl_xor(s, 1); s += __shfl_xor(s, 2); s += __shfl_xor(s, 4); s += __shfl_xor(s, 8);
                        if (fr == 0) atomicAdd(kp + bj * 1024 + n * 4 + j, s); }
        }
    }
};
__device__ __forceinline__ unsigned pk4_fp8(float a, float b, float c, float d) {
    a = __builtin_amdgcn_fmed3f(a, -448.f, 448.f); b = __builtin_amdgcn_fmed3f(b, -448.f, 448.f); c = __builtin_amdgcn_fmed3f(c, -448.f, 448.f); d = __builtin_amdgcn_fmed3f(d, -448.f, 448.f);
    int p = __builtin_amdgcn_cvt_pk_fp8_f32(a, b, 0, false); p = __builtin_amdgcn_cvt_pk_fp8_f32(c, d, p, true); return (unsigned)p; }
struct EpiRes {
    static constexpr bool PERM = false, AFTER_DRAIN = false;
    const float* base; float* out; bf16_t* xb; float* ssq; unsigned char* x8; float s8; float ascale;
    __device__ __forceinline__ void operator()(const f32x4 (&acc)[2][2][4][2], const Unit& u, int wr, int wc, int fr, int fq) const {
        const int row0 = u.pm * BM + wr * 64 + fr, col0 = u.pn * BM + wc * 32 + 4 * fq;
#pragma unroll
        for (int ai = 0; ai < 2; ++ai)
#pragma unroll
            for (int m = 0; m < 4; ++m) { const int row = row0 + ai * HALF + m * 16; const size_t off = (size_t)row * LDX + col0; float s = 0.f;
#pragma unroll
                for (int bj = 0; bj < 2; ++bj)
#pragma unroll
                    for (int n = 0; n < 2; ++n) { const f32x4 v = *(const f32x4*)(base + off + bj * HALF + n * 16) + acc[ai][bj][m][n] * ascale;
                        *(f32x4*)(out + off + bj * HALF + n * 16) = v; s += (v[0] * v[0] + v[1] * v[1]) + (v[2] * v[2] + v[3] * v[3]);
                        if (xb) { u32x2 w; w.x = cvt_pk_bf16(v[0], v[1]); w.y = cvt_pk_bf16(v[2], v[3]); *(u32x2*)(xb + off + bj * HALF + n * 16) = w; }
                        if (x8) { *(unsigned*)(x8 + off + bj * HALF + n * 16) = pk4_fp8(v[0] * s8, v[1] * s8, v[2] * s8, v[3] * s8); } }
                if (ssq) { s += __shfl_xor(s, 16); s += __shfl_xor(s, 32); if (fq == 0) atomicAdd(ssq + row, s); }
                asm volatile("" ::: "memory"); }
    }
};
template <bool BASE_F32> struct EpiResB {
    static constexpr bool PERM = true, AFTER_DRAIN = false;
    const void* base; bf16_t* xo; float* ssq; unsigned char* x8; float s8; float ascale;
    __device__ __forceinline__ void operator()(const f32x4 (&acc)[2][2][4][2], const Unit& u, int wr, int wc, int fr, int fq) const {
        const int row0 = u.pm * BM + wr * 64 + fr, col0 = u.pn * BM + wc * 32 + 8 * fq;
#pragma unroll
        for (int ai = 0; ai < 2; ++ai)
#pragma unroll
            for (int m = 0; m < 4; ++m) { const int row = row0 + ai * HALF + m * 16; const size_t off = (size_t)row * LDX + col0; float s = 0.f;
#pragma unroll
                for (int bj = 0; bj < 2; ++bj) { f32x4 b0, b1;
                    if (BASE_F32) { const float* bp = (const float*)base + off + bj * HALF; b0 = *(const f32x4*)bp; b1 = *(const f32x4*)(bp + 4); }
                    else { const u32x4 w = *(const u32x4*)((const bf16_t*)base + off + bj * HALF);
                        b0 = (f32x4){__uint_as_float(w.x << 16), __uint_as_float(w.x & 0xffff0000u), __uint_as_float(w.y << 16), __uint_as_float(w.y & 0xffff0000u)};
                        b1 = (f32x4){__uint_as_float(w.z << 16), __uint_as_float(w.z & 0xffff0000u), __uint_as_float(w.w << 16), __uint_as_float(w.w & 0xffff0000u)}; }
                    const f32x4 v0 = b0 + acc[ai][bj][m][0] * ascale, v1 = b1 + acc[ai][bj][m][1] * ascale;
                    s += ((v0[0] * v0[0] + v0[1] * v0[1]) + (v0[2] * v0[2] + v0[3] * v0[3])) + ((v1[0] * v1[0] + v1[1] * v1[1]) + (v1[2] * v1[2] + v1[3] * v1[3]));
                    if (xo) { u32x4 w; w.x = cvt_pk_bf16(v0[0], v0[1]); w.y = cvt_pk_bf16(v0[2], v0[3]); w.z = cvt_pk_bf16(v1[0], v1[1]); w.w = cvt_pk_bf16(v1[2], v1[3]); store16(xo + off + bj * HALF, w); }
                    if (x8) { u32x2 w8; w8.x = pk4_fp8(v0[0] * s8, v0[1] * s8, v0[2] * s8, v0[3] * s8); w8.y = pk4_fp8(v1[0] * s8, v1[1] * s8, v1[2] * s8, v1[3] * s8); *(u32x2*)(x8 + off + bj * HALF) = w8; } }
                if (ssq) { s += __shfl_xor(s, 16); s += __shfl_xor(s, 32); if (fq == 0) atomicAdd(ssq + row, s); }
                if (BASE_F32 ? (m & 1) : (m == 3)) asm volatile("" ::: "memory"); }
    }
};
struct EpiScale {
    static constexpr bool PERM = true, AFTER_DRAIN = false;
    bf16_t* O; int ldc; const float* ssq; float sc;
    __device__ __forceinline__ void operator()(const f32x4 (&acc)[2][2][4][2], const Unit& u, int wr, int wc, int fr, int fq) const {
        const int row0 = u.pm * BM + wr * 64 + fr, col0 = u.pn * BM + wc * 32 + 8 * fq;
        float sv[2][4];
#pragma unroll
        for (int ai = 0; ai < 2; ++ai)
#pragma unroll
            for (int m = 0; m < 4; ++m) sv[ai][m] = ssq ? ssq[row0 + ai * HALF + m * 16] : 0.f;
#pragma unroll
        for (int ai = 0; ai < 2; ++ai)
#pragma unroll
            for (int m = 0; m < 4; ++m) { const int row = row0 + ai * HALF + m * 16; bf16_t* rowp = O + (size_t)row * ldc + col0;
                const float f = ssq ? sc * __builtin_amdgcn_rsqf(sv[ai][m] * (1.0f / 2048.0f) + RMS_EPS) : sc;
#pragma unroll
                for (int bj = 0; bj < 2; ++bj) { const f32x4 v0 = acc[ai][bj][m][0] * f, v1 = acc[ai][bj][m][1] * f;
                    u32x4 w; w.x = cvt_pk_bf16(v0[0], v0[1]); w.y = cvt_pk_bf16(v0[2], v0[3]); w.z = cvt_pk_bf16(v1[0], v1[1]); w.w = cvt_pk_bf16(v1[2], v1[3]);
                    *(u32x4*)(rowp + bj * HALF) = w; } }
    }
};
struct EpiNull { static constexpr bool PERM = true, AFTER_DRAIN = false; float* sink;
    __device__ __forceinline__ void operator()(const f32x4 (&acc)[2][2][4][2], const Unit& u, int wr, int wc, int fr, int fq) const {
#pragma unroll
        for (int ai = 0; ai < 2; ++ai)
#pragma unroll
            for (int bj = 0; bj < 2; ++bj)
#pragma unroll
                for (int m = 0; m < 4; ++m)
#pragma unroll
                    for (int n = 0; n < 2; ++n) asm volatile("" :: "v"(acc[ai][bj][m][n])); } };
struct EpiSwiGLU {
    static constexpr bool PERM = true, AFTER_DRAIN = false;
    bf16_t* O; const float* ssq; unsigned char* O8; float ascale, oscale;
    __device__ __forceinline__ void operator()(const f32x4 (&acc)[2][2][4][2], const Unit& u, int wr, int wc, int fr, int fq) const {
        const int row0 = u.pm * BM + wr * 64 + fr, col0 = u.pn * HALF + wc * 32 + 8 * fq;
        float sv[2][4];
#pragma unroll
        for (int ai = 0; ai < 2; ++ai)
#pragma unroll
            for (int m = 0; m < 4; ++m) sv[ai][m] = ssq[row0 + ai * HALF + m * 16];
#pragma unroll
        for (int ai = 0; ai < 2; ++ai)
#pragma unroll
            for (int m = 0; m < 4; ++m) { const int row = row0 + ai * HALF + m * 16; bf16_t* rowp = O + (size_t)row * 5632 + col0;
                const float f = ascale * __builtin_amdgcn_rsqf(sv[ai][m] * (1.0f / 2048.0f) + RMS_EPS);
                const float fneg = -1.4426950408889634f * f, f2o = f * f * (O8 ? oscale : 1.0f);
                float r[8];
#pragma unroll
                for (int n = 0; n < 2; ++n)
#pragma unroll
                    for (int j = 0; j < 4; ++j) { const float ag = acc[ai][0][m][n][j], au = acc[ai][1][m][n][j];
                        r[n * 4 + j] = (ag * au) * (f2o * __builtin_amdgcn_rcpf(1.0f + __builtin_amdgcn_exp2f(fneg * ag))); }
                if (O8) { u32x2 w8; w8.x = pk4_fp8(r[0], r[1], r[2], r[3]); w8.y = pk4_fp8(r[4], r[5], r[6], r[7]);
                    *(u32x2*)(O8 + (size_t)row * 5632 + col0) = w8; }
                else { u32x4 w; w.x = cvt_pk_bf16(r[0], r[1]); w.y = cvt_pk_bf16(r[2], r[3]); w.z = cvt_pk_bf16(r[4], r[5]); w.w = cvt_pk_bf16(r[6], r[7]);
                *(u32x4*)rowp = w; } }
    }
};
}
namespace att {
using bf16x8 = __attribute__((ext_vector_type(8))) short;
using s16x4  = __attribute__((ext_vector_type(4))) short;
using f32x16 = __attribute__((ext_vector_type(16))) float;
using f32x4  = __attribute__((ext_vector_type(4))) float;
using u32x4  = __attribute__((ext_vector_type(4))) unsigned;
typedef unsigned short bf16;
constexpr int D = 128, KVBLK = 64;
constexpr int SHM_V = KVBLK * D * 2, SHM_K = KVBLK * D * 2;
constexpr int OFF_Q = 2 * SHM_V + 2 * SHM_K, OFF_WS = 131072 + 1024, OFF_KM = OFF_WS + 2048, ATT_LDS = OFF_KM + 4096;
constexpr float THR = 8.f;
constexpr float SB_DONE = 7.8886e-31f;
#ifndef QREG_SOFTMAX
#define QREG_SOFTMAX 1
#endif
#ifndef PIPE_SOFTMAX
#define PIPE_SOFTMAX 0
#endif
#define KSWZ(row, colB) ((row) * 256 + ((colB) ^ (((row) & 7) << 4)))
#define SBAR() __builtin_amdgcn_sched_barrier(0)
__device__ __forceinline__ int crow(int r, int hi) { return (r & 3) + 8 * (r >> 2) + 4 * hi; }
__device__ __forceinline__ unsigned cvtpk(float lo, float hi) { unsigned r; asm volatile("v_cvt_pk_bf16_f32 %0, %1, %2" : "=v"(r) : "v"(lo), "v"(hi)); return r; }
__device__ __forceinline__ float xchg32(float x, int hi) { auto rr = __builtin_amdgcn_permlane32_swap(__float_as_uint(x), __float_as_uint(x), false, false); return __uint_as_float(hi ? rr[0] : rr[1]); }
typedef __attribute__((address_space(3))) const char* lds_cp;
template <int D0> __device__ __forceinline__ void qkt_part(f32x16& p0, f32x16& p1, const lds_cp (&ka)[2][4], int boff, const lds_cp (&qa)[2][4]) {
  const bf16x8 qf = *reinterpret_cast<const __attribute__((address_space(3))) bf16x8*>(qa[D0 >> 2][D0 & 3]);
  const bf16x8 b0 = *reinterpret_cast<const __attribute__((address_space(3))) bf16x8*>(ka[D0 >> 2][D0 & 3] + boff);
  const bf16x8 b1 = *reinterpret_cast<const __attribute__((address_space(3))) bf16x8*>(ka[D0 >> 2][D0 & 3] + boff + 8192);
  p0 = __builtin_amdgcn_mfma_f32_32x32x16_bf16(b0, qf, p0, 0, 0, 0);
  p1 = __builtin_amdgcn_mfma_f32_32x32x16_bf16(b1, qf, p1, 0, 0, 0);
}
template <int D0> __device__ __forceinline__ void qkt_part(f32x16& p0, f32x16& p1, const lds_cp (&ka)[2][4], int boff, const bf16x8 (&qg)[8]) {
  const bf16x8 b0 = *reinterpret_cast<const __attribute__((address_space(3))) bf16x8*>(ka[D0 >> 2][D0 & 3] + boff);
  const bf16x8 b1 = *reinterpret_cast<const __attribute__((address_space(3))) bf16x8*>(ka[D0 >> 2][D0 & 3] + boff + 8192);
  p0 = __builtin_amdgcn_mfma_f32_32x32x16_bf16(b0, qg[D0], p0, 0, 0, 0);
  p1 = __builtin_amdgcn_mfma_f32_32x32x16_bf16(b1, qg[D0], p1, 0, 0, 0);
}
#define KLD(G, A0, A1) do { A0 = *reinterpret_cast<const __attribute__((address_space(3))) bf16x8*>(ka[(G) >> 2][(G) & 3] + boff); A1 = *reinterpret_cast<const __attribute__((address_space(3))) bf16x8*>(ka[(G) >> 2][(G) & 3] + boff + 8192); } while (0)
#define KMM(G, A0, A1) do { p0 = __builtin_amdgcn_mfma_f32_32x32x16_bf16(A0, qg[G], p0, 0, 0, 0); p1 = __builtin_amdgcn_mfma_f32_32x32x16_bf16(A1, qg[G], p1, 0, 0, 0); } while (0)
__device__ __forceinline__ void qkt(f32x16& p0, f32x16& p1, const lds_cp (&ka)[2][4], int boff, const bf16x8 (&qg)[8], float bias = 0.f) {
#pragma unroll
  for (int r = 0; r < 16; ++r) { p0[r] = bias; p1[r] = bias; }
  bf16x8 a0, a1, b0, b1, c0, c1, d0, d1;
  KLD(0, a0, a1); KLD(1, b0, b1); KLD(2, c0, c1); KLD(3, d0, d1); SBAR();
  KMM(0, a0, a1); SBAR(); KLD(4, a0, a1); SBAR();
  KMM(1, b0, b1); SBAR(); KLD(5, b0, b1); SBAR();
  KMM(2, c0, c1); SBAR(); KLD(6, c0, c1); SBAR();
  KMM(3, d0, d1); SBAR(); KLD(7, d0, d1); SBAR();
  KMM(4, a0, a1); KMM(5, b0, b1); KMM(6, c0, c1); KMM(7, d0, d1);
}
#undef KLD
#undef KMM
__device__ __forceinline__ void qkt(f32x16& p0, f32x16& p1, const lds_cp (&ka)[2][4], int boff, const lds_cp (&qr)[2][4], float bias = 0.f) {
#pragma unroll
  for (int r = 0; r < 16; ++r) { p0[r] = bias; p1[r] = bias; }
  qkt_part<0>(p0, p1, ka, boff, qr); qkt_part<1>(p0, p1, ka, boff, qr); qkt_part<2>(p0, p1, ka, boff, qr); qkt_part<3>(p0, p1, ka, boff, qr);
  qkt_part<4>(p0, p1, ka, boff, qr); qkt_part<5>(p0, p1, ka, boff, qr); qkt_part<6>(p0, p1, ka, boff, qr); qkt_part<7>(p0, p1, ka, boff, qr);
}
__device__ __forceinline__ int v_st(int k, int c) { const int kk = (k & ~0xC) | ((k & 4) << 1) | ((k & 8) >> 1); return ((kk >> 3) * 4 + (c >> 5)) * 512 + ((kk & 7) * 32 + (c & 31)) * 2; }
__device__ __forceinline__ int v_rd_base(int lane) { return ((lane & 3) << 3) | (((lane >> 2) & 3) << 6) | (((lane >> 4) & 1) << 5) | (((lane >> 5) & 1) << 8); }
constexpr int v_rd_off(int d0, int ks, int half) { return d0 * 512 + ks * 4096 + half * 2048; }
template <int OFF> __device__ __forceinline__ s16x4 tr_read(int vb) { s16x4 r; asm volatile("ds_read_b64_tr_b16 %0, %1 offset:%2" : "=&v"(r) : "v"(vb), "i"(OFF) : "memory"); return r; }
struct VFrag { s16x4 l0, h0, l1, h1, l2, h2, l3, h3; };
template <int D0> __device__ __forceinline__ void v_read(VFrag& f, int vb) {
  f.l0 = tr_read<v_rd_off(D0, 0, 0)>(vb); f.h0 = tr_read<v_rd_off(D0, 0, 1)>(vb); f.l1 = tr_read<v_rd_off(D0, 1, 0)>(vb); f.h1 = tr_read<v_rd_off(D0, 1, 1)>(vb);
  f.l2 = tr_read<v_rd_off(D0, 2, 0)>(vb); f.h2 = tr_read<v_rd_off(D0, 2, 1)>(vb); f.l3 = tr_read<v_rd_off(D0, 3, 0)>(vb); f.h3 = tr_read<v_rd_off(D0, 3, 1)>(vb);
}
__device__ __forceinline__ void pv_mma(f32x16& od, const VFrag& f, bf16x8 pa0, bf16x8 pa1, bf16x8 pa2, bf16x8 pa3) {
#define PK(L, H) (bf16x8){L[0], L[1], L[2], L[3], H[0], H[1], H[2], H[3]}
  od = __builtin_amdgcn_mfma_f32_32x32x16_bf16(pa0, PK(f.l0, f.h0), od, 0, 0, 0);
  od = __builtin_amdgcn_mfma_f32_32x32x16_bf16(pa1, PK(f.l1, f.h1), od, 0, 0, 0);
  od = __builtin_amdgcn_mfma_f32_32x32x16_bf16(pa2, PK(f.l2, f.h2), od, 0, 0, 0);
  od = __builtin_amdgcn_mfma_f32_32x32x16_bf16(pa3, PK(f.l3, f.h3), od, 0, 0, 0);
#undef PK
}
__device__ __forceinline__ void pv_d0(f32x16* o, int vb, bf16x8 pa0, bf16x8 pa1, bf16x8 pa2, bf16x8 pa3) {
  VFrag fa, fb;
  v_read<0>(fa, vb);
  v_read<1>(fb, vb); asm volatile("s_waitcnt lgkmcnt(8)" ::: "memory"); SBAR(); pv_mma(o[0], fa, pa0, pa1, pa2, pa3); SBAR();
  v_read<2>(fa, vb); asm volatile("s_waitcnt lgkmcnt(8)" ::: "memory"); SBAR(); pv_mma(o[1], fb, pa0, pa1, pa2, pa3); SBAR();
  v_read<3>(fb, vb); asm volatile("s_waitcnt lgkmcnt(8)" ::: "memory"); SBAR(); pv_mma(o[2], fa, pa0, pa1, pa2, pa3); SBAR();
  asm volatile("s_waitcnt lgkmcnt(0)" ::: "memory"); SBAR(); pv_mma(o[3], fb, pa0, pa1, pa2, pa3);
}
__device__ __forceinline__ void pack_p(const f32x16& p0, const f32x16& p1, bf16x8& pa0, bf16x8& pa1, bf16x8& pa2, bf16x8& pa3) {
#define PK4(P, BASE, OUT) do { unsigned a0 = cvtpk(P[BASE + 0], P[BASE + 1]), a1 = cvtpk(P[BASE + 2], P[BASE + 3]);   \
    unsigned b0 = cvtpk(P[BASE + 4], P[BASE + 5]), b1 = cvtpk(P[BASE + 6], P[BASE + 7]);                              \
    auto r0 = __builtin_amdgcn_permlane32_swap(a0, b0, false, false); auto r1 = __builtin_amdgcn_permlane32_swap(a1, b1, false, false); \
    u32x4 w = {r0[0], r1[0], r0[1], r1[1]}; OUT = *reinterpret_cast<bf16x8*>(&w); } while (0)
  PK4(p0, 0, pa0); PK4(p0, 8, pa1); PK4(p1, 0, pa2); PK4(p1, 8, pa3);
#undef PK4
}
__device__ __forceinline__ void softmax_tile(f32x16& p0, f32x16& p1, float& m_reg, float& l_reg, float& alpha) {
  float pmax = p0[0];
#pragma unroll
  for (int r = 1; r < 16; ++r) pmax = fmaxf(pmax, p0[r]);
#pragma unroll
  for (int r = 0; r < 16; ++r) pmax = fmaxf(pmax, p1[r]);
  pmax = fmaxf(pmax, xchg32(pmax, (int)(threadIdx.x >> 5) & 1));
  if (__all(pmax - m_reg <= THR)) { alpha = 1.f; }
  else { const float mn = fmaxf(m_reg, pmax); alpha = __builtin_amdgcn_exp2f(m_reg - mn); m_reg = mn; }
  float ps = 0.f;
#pragma unroll
  for (int r = 0; r < 16; ++r) { p0[r] = __builtin_amdgcn_exp2f(p0[r] - m_reg); ps += p0[r]; }
#pragma unroll
  for (int r = 0; r < 16; ++r) { p1[r] = __builtin_amdgcn_exp2f(p1[r] - m_reg); ps += p1[r]; }
  ps += xchg32(ps, (int)(threadIdx.x >> 5) & 1);
  l_reg = l_reg * alpha + ps;
}
template <bool BAND, int I> __device__ __forceinline__ float sb_group(f32x16& P, int kb, int qrel, int hi) {
  float run = 1.f;
#pragma unroll
  for (int e = 3; e >= 0; --e) { const int r = 4 * I + e; float rr = __builtin_amdgcn_rcpf(1.0f + __builtin_amdgcn_exp2f(P[r]));
    if (BAND) rr = (kb + crow(r, hi) < qrel) ? rr : 1.f;
    P[r] = (1.0f - rr) * run; run *= rr; }
  return run;
}
__device__ __forceinline__ void sb_combine(f32x16& p0, f32x16& p1, float (&gs)[8], float& carry, int hi) {
  float acc = 1.f;
#pragma unroll
  for (int i = 7; i >= 0; --i) { const float so_i = acc; acc *= gs[i]; const float x = hi ? acc : so_i; gs[i] = carry * so_i * xchg32(x, hi); }
  carry *= acc * xchg32(acc, hi);
#pragma unroll
  for (int i = 0; i < 4; ++i)
#pragma unroll
    for (int e = 0; e < 4; ++e) { p0[4 * i + e] *= gs[i]; p1[4 * i + e] *= gs[4 + i]; }
}
template <bool BAND>
__device__ __forceinline__ void sb_tile(f32x16& p0, f32x16& p1, float& carry, int kb, int qrel, int hi) {
  float gs[8];
  gs[0] = sb_group<BAND, 0>(p0, kb, qrel, hi); SBAR(); gs[1] = sb_group<BAND, 1>(p0, kb, qrel, hi); SBAR(); gs[2] = sb_group<BAND, 2>(p0, kb, qrel, hi); SBAR(); gs[3] = sb_group<BAND, 3>(p0, kb, qrel, hi); SBAR();
  gs[4] = sb_group<BAND, 0>(p1, kb + 32, qrel, hi); SBAR(); gs[5] = sb_group<BAND, 1>(p1, kb + 32, qrel, hi); SBAR(); gs[6] = sb_group<BAND, 2>(p1, kb + 32, qrel, hi); SBAR(); gs[7] = sb_group<BAND, 3>(p1, kb + 32, qrel, hi); SBAR();
  sb_combine(p0, p1, gs, carry, hi);
}

template <int MODE, bool OUT8 = false>
__device__ __forceinline__ void attn_unit(const bf16* __restrict__ Qb_or_hb, const bf16* __restrict__ Kh_in, const bf16* __restrict__ Vh_in, bf16* __restrict__ Ob,
                                          const float* __restrict__ gain, const float* __restrict__ kmean, int qb, int nkeys, char* lds, float s8 = 1.f,
                                          bool preissued = false, const bf16* __restrict__ nhb = nullptr, int nqb = 0, int nt0 = 0, int nt1 = -1) {
  constexpr int ldq = (MODE == 0) ? 512 : 128, ldk = (MODE == 0) ? 1024 : 128, ldo = (MODE == 0) ? 512 : 2048;
  constexpr long HSZ_ = 2048L * 128L;
  const bf16* __restrict__ Qb = (MODE == 0) ? Qb_or_hb : Qb_or_hb + (long)qb * (256 * 128);
  const bf16* __restrict__ Kh = (MODE == 0) ? Kh_in : Qb_or_hb + 8 * HSZ_;
  const bf16* __restrict__ Vh = (MODE == 0) ? Vh_in : Qb_or_hb + 16 * HSZ_;
  int tid_ = threadIdx.x; asm volatile("" : "+v"(tid_));
  const int tid = tid_, wid = __builtin_amdgcn_readfirstlane(tid >> 6), lane = tid & 63, r32 = lane & 31, hi = lane >> 5;
  char* V_lds = lds; char* K_lds = lds + 2 * SHM_V;
  float* ws = (float*)(lds + OFF_WS) + wid * 64; float* li_l = ws; float* al_l = ws + 32;
  float* km_l = (float*)(lds + OFF_KM);
  int* flg = (int*)(lds + OFF_KM);
  const int NT = (MODE == 0) ? nkeys / KVBLK : 4 * (qb + 1);
  const int qrel = wid * 32 + r32;
  float m_reg = -1e30f, l_reg = 0.f, carry = 1.f; f32x16 o[4] = {};
  const int vb0 = (int)(uintptr_t)V_lds + v_rd_base(lane);
  lds_cp ka[2][4];
#pragma unroll
  for (int y = 0; y < 2; ++y)
#pragma unroll
    for (int x = 0; x < 4; ++x) ka[y][x] = (lds_cp)(__attribute__((address_space(3))) char*)K_lds + r32 * 256 + 128 * (y ^ ((r32 >> 3) & 1)) + 32 * (x ^ ((r32 >> 1) & 3)) + 16 * (hi ^ (r32 & 1));
  lds_cp qr[2][4];
#pragma unroll
  for (int y = 0; y < 2; ++y)
#pragma unroll
    for (int x = 0; x < 4; ++x) qr[y][x] = ka[y][x] + (OFF_Q - 2 * SHM_V) + wid * 8192;
  long ksrc[2], vsrc[2];
#pragma unroll
  for (int i = 0; i < 2; ++i) { const int piece = wid + 8 * i;
    { const int row = piece * 4 + (lane >> 4), c = (lane & 15) ^ (row & 15); ksrc[i] = (long)row * ldk + c * 8; }
    { const int sub = piece * 2 + (lane >> 5), kk = (sub >> 2) * 8 + ((lane & 31) >> 2), k = (kk & ~0xC) | ((kk & 4) << 1) | ((kk & 8) >> 1), c = (sub & 3) * 32 + (lane & 3) * 8; vsrc[i] = (long)k * ldk + c; } }
  typedef __attribute__((address_space(3))) unsigned lds_u32;
  lds_u32* kdst = (lds_u32*)(__attribute__((address_space(3))) char*)(K_lds) + wid * 256; lds_u32* vdst = (lds_u32*)(__attribute__((address_space(3))) char*)(V_lds) + wid * 256;
#define TILE(it) ((MODE == 2) ? (NT - 1 - (it)) : (it))
#define DMA_K(k0, b) do { _Pragma("unroll") for (int i_ = 0; i_ < 2; ++i_) __builtin_amdgcn_global_load_lds((const unsigned*)(Kh + (long)(k0) * ldk + ksrc[i_]), kdst + (b) * (SHM_K / 4) + i_ * 2048, 16, 0, 0); } while (0)
#define DMA_V(k0, b) do { _Pragma("unroll") for (int i_ = 0; i_ < 2; ++i_) __builtin_amdgcn_global_load_lds((const unsigned*)(Vh + (long)(k0) * ldk + vsrc[i_]), vdst + (b) * (SHM_V / 4) + i_ * 2048, 16, 0, 0); } while (0)
#define SDRAIN() asm volatile("s_waitcnt vmcnt(0)" ::: "memory")
#define KSLOT(i_) ((i_) == 2 ? (OFF_Q - 2 * SHM_V) : (i_) * SHM_K)
#define VSLOT(i_) ((i_) == 2 ? (OFF_Q + SHM_K) : (i_) * SHM_V)
#define DMA_K3(k0, so) do { _Pragma("unroll") for (int i_ = 0; i_ < 2; ++i_) __builtin_amdgcn_global_load_lds((const unsigned*)(Kh + (long)(k0) * ldk + ksrc[i_]), kdst + (so) / 4 + i_ * 2048, 16, 0, 0); } while (0)
#define DMA_V3(k0, so) do { _Pragma("unroll") for (int i_ = 0; i_ < 2; ++i_) __builtin_amdgcn_global_load_lds((const unsigned*)(Vh + (long)(k0) * ldk + vsrc[i_]), vdst + (so) / 4 + i_ * 2048, 16, 0, 0); } while (0)
  lds_u32* qdst = (lds_u32*)(__attribute__((address_space(3))) char*)(lds + OFF_Q) + wid * 2048;
#define ISSUE_UNIT(QB_, KH_, VH_, T0_, T1_) do { \
    _Pragma("unroll") for (int i = 0; i < 8; ++i) { const int row = 4 * i + (lane >> 4), c = (lane & 15) ^ (row & 15); \
      __builtin_amdgcn_global_load_lds((const unsigned*)((QB_) + (long)(wid * 32 + row) * ldq + c * 8), qdst + i * 256, 16, 0, 0); } \
    _Pragma("unroll") for (int i_ = 0; i_ < 2; ++i_) { \
      __builtin_amdgcn_global_load_lds((const unsigned*)((KH_) + (long)((T0_) * KVBLK) * ldk + ksrc[i_]), kdst + i_ * 2048, 16, 0, 0); \
      __builtin_amdgcn_global_load_lds((const unsigned*)((VH_) + (long)((T0_) * KVBLK) * ldk + vsrc[i_]), vdst + i_ * 2048, 16, 0, 0); } \
    if ((T1_) >= 0) { _Pragma("unroll") for (int i_ = 0; i_ < 2; ++i_) __builtin_amdgcn_global_load_lds((const unsigned*)((KH_) + (long)((T1_) * KVBLK) * ldk + ksrc[i_]), kdst + (SHM_K / 4) + i_ * 2048, 16, 0, 0); } } while (0)
  if (!preissued) ISSUE_UNIT(Qb, Kh, Vh, TILE(0), ((MODE == 2 || PIPE_SOFTMAX) ? TILE(1) : -1));
  constexpr bool RING3 = (MODE != 2) && QREG_SOFTMAX && !PIPE_SOFTMAX;
  unsigned selmask = 0u;
  float gv[4] = {1.f, 1.f, 1.f, 1.f};
  if (gain) {
#pragma unroll
    for (int d0 = 0; d0 < 4; ++d0) gv[d0] = gain[d0 * 32 + r32]; }
  if (MODE == 1) { if (tid < 256) *(f32x4*)(km_l + tid * 4) = *(const f32x4*)(kmean + tid * 4); }
  SDRAIN();
  __syncthreads();
  if (MODE == 1) {
    float g[8];
#pragma unroll
    for (int n = 0; n < 8; ++n) g[n] = 0.f;
    { const int rh = (r32 >> 1) & 3, r3 = (r32 >> 3) & 1;
      const lds_cp qbase = qr[0][0] - 32 * rh - 128 * r3;
#pragma unroll 1
      for (int d0 = 0; d0 < 8; ++d0) {
        const bf16x8 qf = *reinterpret_cast<const __attribute__((address_space(3))) bf16x8*>(qbase + 32 * ((d0 & 3) ^ rh) + 128 * ((d0 >> 2) ^ r3));
        float q[8];
#pragma unroll
        for (int j = 0; j < 8; ++j) q[j] = __uint_as_float(((unsigned)(unsigned short)qf[j]) << 16);
        const float* kmp = km_l + d0 * 16 + hi * 8;
#pragma unroll
        for (int n = 0; n < 7; ++n) { const f32x4 k0v = *(const f32x4*)(kmp + n * 128), k1v = *(const f32x4*)(kmp + n * 128 + 4);
          g[n] += (q[0] * k0v[0] + q[1] * k0v[1]) + (q[2] * k0v[2] + q[3] * k0v[3]) + (q[4] * k1v[0] + q[5] * k1v[1]) + (q[6] * k1v[2] + q[7] * k1v[3]); }
      } }
#pragma unroll
    for (int n = 0; n < 7; ++n) { g[n] += xchg32(g[n], hi); if (n >= qb) g[n] = -INFINITY; }
    g[7] = -INFINITY;
#pragma unroll
    for (int n = 0; n < 7; ++n) { int cnt = 0;
#pragma unroll
      for (int mI = 0; mI < 7; ++mI) { if (mI != n) cnt += (g[mI] > g[n] || (g[mI] == g[n] && mI < n)) ? 1 : 0; }
      if (n < qb && cnt < 3) selmask |= (1u << n); }
  }
  bf16x8 qg[8];
  if (QREG_SOFTMAX && MODE != 2) {
#pragma unroll
    for (int d0 = 0; d0 < 8; ++d0) qg[d0] = *reinterpret_cast<const __attribute__((address_space(3))) bf16x8*>(qr[d0 >> 2][d0 & 3]); }
  int kc = KSLOT(0), kn = KSLOT(1), kn2 = KSLOT(2), vc = VSLOT(0), vn = VSLOT(1), vn2 = VSLOT(2);
  if (RING3) { DMA_K3(TILE(1) * KVBLK, kn); DMA_V3(TILE(1) * KVBLK, vn);
    asm volatile("s_waitcnt lgkmcnt(0)" ::: "memory"); __syncthreads(); }
  f32x16 pA0, pA1, pB0, pB1; bf16x8 pa0, pa1, pa2, pa3;
  if (MODE == 2 || PIPE_SOFTMAX) { float bias0 = 0.f; if (MODE == 1) { if (NT > 4) bias0 = (selmask & 1u) ? 0.f : -INFINITY; }
    qkt(pA0, pA1, ka, 0, qr, bias0);
    __syncthreads(); }
  int it = 0;
#define JB(i_) ((MODE == 2) ? (3 - (i_)) : ((i_) - (NT - 4)))
#define STEP(A0, A1, B0, B1, BAND, HASNEXT) do { \
    if (it + 2 < NT) DMA_K(TILE(it + 2) * KVBLK, it & 1); \
    if (it + 1 < NT) DMA_V(TILE(it + 1) * KVBLK, (it + 1) & 1); \
    bool skip = false; const int jb = JB(it); \
    if (BAND) { if (MODE == 1) skip = (64 * jb > wid * 32 + 31); if (MODE == 2) skip = (64 * jb >= wid * 32 + 31); } \
    if (MODE == 2) skip = skip || __all(carry < SB_DONE);        \
    if (HASNEXT) { float bias_ = 0.f; if (MODE == 1) { if (it + 1 < NT - 4) bias_ = ((selmask >> ((it + 1) >> 2)) & 1u) ? 0.f : -INFINITY; } \
      qkt(B0, B1, ka, ((it + 1) & 1) * SHM_K, qr, bias_); } \
    if (!skip) { \
      if (MODE == 2) { sb_tile<(BAND) != 0>(A0, A1, carry, 64 * jb, qrel, hi); } \
      else { \
        if (MODE == 1 && (BAND)) { _Pragma("unroll") for (int r = 0; r < 16; ++r) { const int kr = 64 * jb + crow(r, hi); if (kr > qrel) A0[r] = -INFINITY; if (kr + 32 > qrel) A1[r] = -INFINITY; } } \
        float alpha; softmax_tile(A0, A1, m_reg, l_reg, alpha); \
        if (__any(alpha < 1.f)) { if (hi == 0) al_l[r32] = alpha; asm volatile("s_waitcnt lgkmcnt(0)" ::: "memory"); \
          _Pragma("unroll") for (int d = 0; d < 4; ++d) _Pragma("unroll") for (int r = 0; r < 16; ++r) o[d][r] *= al_l[crow(r, hi)]; } \
      } \
      pack_p(A0, A1, pa0, pa1, pa2, pa3); \
      pv_d0(o, vb0 + (it & 1) * SHM_V, pa0, pa1, pa2, pa3); \
    } \
    SDRAIN(); __syncthreads(); ++it; } while (0)
#define SB_LD(G, F) do { F##q = *reinterpret_cast<const __attribute__((address_space(3))) bf16x8*>(qr[(G) >> 2][(G) & 3]); \
      F##0 = *reinterpret_cast<const __attribute__((address_space(3))) bf16x8*>(ka[(G) >> 2][(G) & 3] + kb_); F##1 = *reinterpret_cast<const __attribute__((address_space(3))) bf16x8*>(ka[(G) >> 2][(G) & 3] + kb_ + 8192); } while (0)
#define SB_PART(G, P, I, B0, B1, FC, FN) do { if ((G) < 7) SB_LD(((G) + 1) & 7, FN);              \
      B0 = __builtin_amdgcn_mfma_f32_32x32x16_bf16(FC##0, FC##q, B0, 0, 0, 0); B1 = __builtin_amdgcn_mfma_f32_32x32x16_bf16(FC##1, FC##q, B1, 0, 0, 0); \
      gs_[G] = sb_group<false, I>(P, 0, 0, hi); SBAR(); } while (0)
#define STEP_SB(A0, A1, B0, B1) do { \
    if (it + 2 < NT) DMA_K(TILE(it + 2) * KVBLK, it & 1); \
    DMA_V(TILE(it + 1) * KVBLK, (it + 1) & 1); \
    float gs_[8]; \
    _Pragma("unroll") for (int r = 0; r < 16; ++r) { B0[r] = 0.f; B1[r] = 0.f; } \
    const int kb_ = ((it + 1) & 1) * SHM_K; bf16x8 fx0, fx1, fxq, fy0, fy1, fyq; SB_LD(0, fx); SBAR(); \
    SB_PART(0, A0, 0, B0, B1, fx, fy); SB_PART(1, A0, 1, B0, B1, fy, fx); SB_PART(2, A0, 2, B0, B1, fx, fy); SB_PART(3, A0, 3, B0, B1, fy, fx); \
    SB_PART(4, A1, 0, B0, B1, fx, fy); SB_PART(5, A1, 1, B0, B1, fy, fx); SB_PART(6, A1, 2, B0, B1, fx, fy); SB_PART(7, A1, 3, B0, B1, fy, fx); \
    sb_combine(A0, A1, gs_, carry, hi); \
    { const bool dn_ = __all(carry < SB_DONE); if (lane == 0) flg[(it & 1) * 8 + wid] = dn_ ? 1 : 0; } \
    pack_p(A0, A1, pa0, pa1, pa2, pa3); \
    pv_d0(o, vb0 + (it & 1) * SHM_V, pa0, pa1, pa2, pa3); \
    SDRAIN(); __syncthreads(); \
    { const int* f_ = flg + (it & 1) * 8; stop = (f_[0] + f_[1] + f_[2] + f_[3] + f_[4] + f_[5] + f_[6] + f_[7]) == 8; } \
    ++it; } while (0)
#define SSTEP(BAND) do { \
    if (RING3) { if (it + 2 < NT) { DMA_K3(TILE(it + 2) * KVBLK, kn2); DMA_V3(TILE(it + 2) * KVBLK, vn2); } } \
    else if (it + 1 < NT) { DMA_K(TILE(it + 1) * KVBLK, (it + 1) & 1); DMA_V(TILE(it + 1) * KVBLK, (it + 1) & 1); } \
    bool skip = false; const int jb = JB(it); \
    if (BAND) skip = (64 * jb > wid * 32 + 31); \
    if (!skip) { \
      float bias_ = 0.f; if (MODE == 1 && !(BAND)) bias_ = ((selmask >> (it >> 2)) & 1u) ? 0.f : -INFINITY; \
      const int kb_ = RING3 ? kc : (it & 1) * SHM_K; \
      if (QREG_SOFTMAX) qkt(pA0, pA1, ka, kb_, qg, bias_); else qkt(pA0, pA1, ka, kb_, qr, bias_); \
      if (MODE == 1 && (BAND)) { _Pragma("unroll") for (int r = 0; r < 16; ++r) { const int kr = 64 * jb + crow(r, hi); if (kr > qrel) pA0[r] = -INFINITY; if (kr + 32 > qrel) pA1[r] = -INFINITY; } } \
      float alpha; softmax_tile(pA0, pA1, m_reg, l_reg, alpha); \
      if (__any(alpha < 1.f)) { if (hi == 0) al_l[r32] = alpha; asm volatile("s_waitcnt lgkmcnt(0)" ::: "memory"); \
        _Pragma("unroll") for (int d = 0; d < 4; ++d) _Pragma("unroll") for (int r = 0; r < 16; ++r) o[d][r] *= al_l[crow(r, hi)]; } \
      pack_p(pA0, pA1, pa0, pa1, pa2, pa3); \
      pv_d0(o, vb0 + (RING3 ? vc : (it & 1) * SHM_V), pa0, pa1, pa2, pa3); \
    } \
    if (RING3) { if (it + 2 < NT) asm volatile("s_waitcnt vmcnt(4)" ::: "memory"); else SDRAIN();        \
      { const int t_ = kc; kc = kn; kn = kn2; kn2 = t_; } { const int t_ = vc; vc = vn; vn = vn2; vn2 = t_; } } \
    else SDRAIN(); \
    if (RING3) { asm volatile("s_waitcnt lgkmcnt(0)" ::: "memory"); __builtin_amdgcn_s_barrier(); asm volatile("" ::: "memory"); }     \
    else __syncthreads(); \
    ++it; } while (0)
#define RESTART(BIASEXPR) do { qkt(pA0, pA1, ka, (it & 1) * SHM_K, qr, (BIASEXPR)); __syncthreads(); } while (0)
  if (MODE == 0) {
    if (PIPE_SOFTMAX) { STEP(pA0, pA1, pB0, pB1, 0, true); STEP(pB0, pB1, pA0, pA1, 0, true); STEP(pA0, pA1, pB0, pB1, 0, true); STEP(pB0, pB1, pA0, pA1, 0, false); }
    else { SSTEP(0); SSTEP(0); SSTEP(0); SSTEP(0); }
  } else if (MODE == 1) {
    if (PIPE_SOFTMAX) {
      if (NT > 4) { while (it < NT - 4) { STEP(pA0, pA1, pB0, pB1, 0, true); STEP(pB0, pB1, pA0, pA1, 0, (it + 1 < NT - 4)); }
        RESTART(0.f); }
      STEP(pA0, pA1, pB0, pB1, 1, true); STEP(pB0, pB1, pA0, pA1, 1, true); STEP(pA0, pA1, pB0, pB1, 1, true); STEP(pB0, pB1, pA0, pA1, 1, false);
    } else {
      while (it < NT - 4) SSTEP(0);
      SSTEP(1); SSTEP(1); SSTEP(1); SSTEP(1);
    }
  } else {
    STEP(pA0, pA1, pB0, pB1, 1, true); STEP(pB0, pB1, pA0, pA1, 1, true); STEP(pA0, pA1, pB0, pB1, 1, true); STEP(pB0, pB1, pA0, pA1, 1, false);
    if (NT > 4) {
      RESTART(0.f);
      bool stop = false;
      while (it + 2 < NT && !stop) { STEP_SB(pA0, pA1, pB0, pB1); STEP_SB(pB0, pB1, pA0, pA1); }
      if (!stop) { STEP_SB(pA0, pA1, pB0, pB1); STEP(pB0, pB1, pA0, pA1, 0, false); }
    }
  }
#undef RESTART
#undef STEP
#undef SSTEP
#undef STEP_SB
#undef SB_LD
#undef SB_PART
#undef JB
  if (OUT8) { if (nhb) ISSUE_UNIT(nhb + (long)nqb * (256 * 128), nhb + 8 * HSZ_, nhb + 16 * HSZ_, nt0, nt1); }
  float rli[16];
  if (MODE != 2) { if (hi == 0) li_l[r32] = l_reg; asm volatile("s_waitcnt lgkmcnt(0)" ::: "memory");
#pragma unroll
    for (int r = 0; r < 16; ++r) rli[r] = __builtin_amdgcn_rcpf(li_l[crow(r, hi)]); }
  else {
#pragma unroll
    for (int r = 0; r < 16; ++r) rli[r] = 1.f; }
  if (gain) {
#pragma unroll
    for (int r = 0; r < 16; ++r) { float s = 0.f;
#pragma unroll
      for (int d0 = 0; d0 < 4; ++d0) { o[d0][r] *= rli[r]; s += o[d0][r] * o[d0][r]; }
      s += __shfl_xor(s, 1); s += __shfl_xor(s, 2); s += __shfl_xor(s, 4); s += __shfl_xor(s, 8); s += __shfl_xor(s, 16);
      rli[r] = __builtin_amdgcn_rsqf(s * (1.0f / 128.0f) + 1e-6f); }
#pragma unroll
    for (int r = 0; r < 16; ++r)
#pragma unroll
      for (int d0 = 0; d0 < 4; ++d0) o[d0][r] *= gv[d0];
  }
  if (OUT8) {
#pragma unroll
    for (int r = 0; r < 16; ++r) { const float f = rli[r] * s8;
      const float v0 = __builtin_amdgcn_fmed3f(o[0][r] * f, -448.f, 448.f), v1 = __builtin_amdgcn_fmed3f(o[1][r] * f, -448.f, 448.f), v2 = __builtin_amdgcn_fmed3f(o[2][r] * f, -448.f, 448.f), v3 = __builtin_amdgcn_fmed3f(o[3][r] * f, -448.f, 448.f);
      int p = __builtin_amdgcn_cvt_pk_fp8_f32(v0, v1, 0, false); p = __builtin_amdgcn_cvt_pk_fp8_f32(v2, v3, p, true);
      *(unsigned*)((unsigned char*)Ob + (long)(wid * 32 + crow(r, hi)) * ldo + 4 * r32) = (unsigned)p; } }
  else { bf16* stg = (bf16*)lds + wid * 4096;
#pragma unroll
    for (int r = 0; r < 16; ++r) { const int orow = crow(r, hi);
#pragma unroll
      for (int d0 = 0; d0 < 4; ++d0) { const float v = o[d0][r] * rli[r]; unsigned u = __float_as_uint(v); u = (u + 0x7fffu + ((u >> 16) & 1u)) >> 16; stg[orow * 128 + d0 * 32 + r32] = (bf16)u; } }
    asm volatile("s_waitcnt lgkmcnt(0)" ::: "memory");
#pragma unroll
    for (int i = 0; i < 8; ++i) { const int row = i * 4 + (lane >> 4), ch = lane & 15; const u32x4 v = *(const u32x4*)(stg + row * 128 + ch * 8); *(u32x4*)(Ob + (long)(wid * 32 + row) * ldo + ch * 8) = v; } }
  __syncthreads();
#undef TILE
#undef ISSUE_UNIT
#undef DMA_K
#undef DMA_V
#undef DMA_K3
#undef DMA_V3
#undef KSLOT
#undef VSLOT
#undef SDRAIN
}
#undef KSWZ
#undef SBAR
}
#define GAS __attribute__((address_space(1)))
#define LAS __attribute__((address_space(3)))
typedef unsigned short bf16;
typedef unsigned v4u __attribute__((ext_vector_type(4)));
typedef float f32x4 __attribute__((ext_vector_type(4)));
#define LDS_WAIT() asm volatile("s_waitcnt lgkmcnt(0)" ::: "memory")
constexpr int NWAVES = 8;
constexpr int BATCH = 8, SEQ = 2048, DM = 2048, M = BATCH * SEQ, HD = 128, NH = 8;
constexpr int NQKV = 6144, FF = 5632, WX = 512, NMEM = 256, MMEM = BATCH * NMEM;
constexpr int QSB = 0, KSB = 1024, VSB = 2048, QMB = 3072, KMB = 4096, VMB = 5120;
constexpr float EPS = 1e-6f;
constexpr float QSCALE = 0.12751743082459868f;
constexpr size_t MiB = 1u << 20;
constexpr size_t WS_CTL = 0, CTL_ZERO_BYTES = 512 * 1024;
constexpr size_t WS_SSQ1 = 64 * 1024, WS_SSQ2 = 128 * 1024;
constexpr size_t WS_KSUM = 256 * 1024;
constexpr size_t WS_WIN = 1 * MiB, WS_WOUT = 25 * MiB, WS_WXQ = 33 * MiB, WS_WXKV = 35 * MiB, WS_WXO = 39 * MiB, WS_WGU = 41 * MiB, WS_WDN = 85 * MiB;
constexpr size_t WS_RA = 107 * MiB;
constexpr size_t WS_RB = 171 * MiB;
constexpr size_t WS_RC = 235 * MiB;
constexpr size_t WS_QX = 427 * MiB, WS_OX = 443 * MiB, WS_KVX = 459 * MiB, WS_MN = 463 * MiB, WS_KMEAN = 471 * MiB, WS_RINV0 = 471 * MiB  , WS_CS = 472 * MiB, WS_END = 474 * MiB;
constexpr int RING_BYTES = 131072, LDS_BYTES = 147456;
#ifndef FFN_FP8
#define FFN_FP8 1
#endif
#ifndef QK_FP8
#define QK_FP8 1
#endif
constexpr float S_X2 = 16.f, S_WGU = 32.f, S_ACT = 8.f, S_WDN = 64.f, S_XN = 16.f, S_WV = 32.f, S_WQK = 32.f, S_O = 16.f, S_WO = 32.f;
constexpr float S_OX = 16.f, S_WXO = 16.f;
#ifndef WXO_FP8
#define WXO_FP8 1
#endif
#ifndef WOUT_FP8
#define WOUT_FP8 1
#endif
constexpr size_t WS_WV8 = WS_WIN + 16 * MiB;

__device__ __forceinline__ float bf2f(unsigned short b) { return __uint_as_float((unsigned)b << 16); }
__device__ __forceinline__ unsigned f2bf(float f) { unsigned u = __builtin_bit_cast(unsigned, f); return (u + 0x7fffu + ((u >> 16) & 1u)) >> 16; }
__device__ __forceinline__ unsigned pk2(float lo, float hi) { return f2bf(lo) | (f2bf(hi) << 16); }
__device__ __forceinline__ float wave_sum(float v) {
#pragma unroll
    for (int o = 1; o < 64; o <<= 1) v += __shfl_xor(v, o);
    return v;
}
__device__ __forceinline__ float wave_max(float v) {
#pragma unroll
    for (int o = 1; o < 64; o <<= 1) v = fmaxf(v, __shfl_xor(v, o));
    return v;
}

typedef GAS unsigned gu32;
#define RLX_AGENT __ATOMIC_RELAXED, __HIP_MEMORY_SCOPE_AGENT
constexpr int CW_BAR = 4096;
constexpr int LDSCTL_OFF = RING_BYTES, MISC_OFF = LDSCTL_OFF + 320;
#define XB_TMO      128
#define XB_XCNT(j)  (256  + 64 * (j))
#define XB_XSUB(j)  (1280 + 64 * (j))
#define XB_XGEN(j)  (2304 + 64 * (j))
#define XB_TOP      3328
#define XB_TOPGEN   3392
#define XCD_BAR_WORDS 3456
#define XB_SPIN_CAP (1u << 18)

__device__ __forceinline__ unsigned xb_ld(unsigned* p)              { return __hip_atomic_load(p, __ATOMIC_RELAXED, __HIP_MEMORY_SCOPE_AGENT); }
__device__ __forceinline__ unsigned xb_add(unsigned* p, unsigned v) { return __hip_atomic_fetch_add(p, v, __ATOMIC_RELAXED, __HIP_MEMORY_SCOPE_AGENT); }
__device__ __forceinline__ unsigned xb_xcc_id() { return (unsigned)__builtin_amdgcn_s_getreg((3 << 11) | 20) & 0xFu; }
#define XB_SPIN(cond, bar) do { unsigned _sp = 0; while (cond) { __builtin_amdgcn_s_sleep(1); \
    if ((++_sp & 255u) == 0u) { if (xb_ld(&(bar)[XB_TMO])) break; if (_sp > XB_SPIN_CAP) { atomicAdd(&(bar)[XB_TMO], 1u); break; } } } } while (0)

struct XcdBarrier {
    unsigned* bar; unsigned x;
    volatile LAS unsigned* st;
};

__device__ __forceinline__ XcdBarrier xcd_barrier_post(unsigned* bar, volatile LAS unsigned* st) {
    XcdBarrier b; b.bar = bar; b.x = xb_xcc_id(); b.st = st;
    if (threadIdx.x == 0) (void)xb_add(&bar[XB_XCNT(b.x)], 1u);
    return b;
}
__device__ __forceinline__ void xcd_barrier_complete(unsigned* bar, unsigned x, unsigned& nloc, unsigned& nx) {
    const unsigned G = gridDim.x * gridDim.y * gridDim.z;
    unsigned sum, cnt, mine, sp = 0u;
    for (;;) {
        sum = 0u; cnt = 0u; mine = 0u;
#pragma unroll
        for (unsigned j = 0; j < 16; ++j) { const unsigned c = xb_ld(&bar[XB_XCNT(j)]); sum += c; cnt += (c > 0u) ? 1u : 0u; mine = (j == x) ? c : mine; }
        if (sum == G) break;
        __builtin_amdgcn_s_sleep(1);
        if ((++sp & 255u) == 0u) { if (xb_ld(&bar[XB_TMO])) break; if (sp > XB_SPIN_CAP) { atomicAdd(&bar[XB_TMO], 1u); break; } }
    }
    nloc = mine > 0u ? mine : 1u; nx = cnt > 0u ? cnt : 1u;
}

__device__ __forceinline__ void xcd_barrier(const XcdBarrier& b) {
    asm volatile("s_waitcnt vmcnt(0)" ::: "memory");
    __syncthreads();
    if (threadIdx.x == 0) {
        unsigned* bar = b.bar;
        __builtin_amdgcn_s_waitcnt(0);
        unsigned nloc = b.st[0], nx = b.st[1];
        if (nloc == 0u) { xcd_barrier_complete(bar, b.x, nloc, nx); b.st[0] = nloc; b.st[1] = nx; }
        const unsigned old = xb_add(&bar[XB_XSUB(b.x)], 1u);
        const unsigned gen = old / nloc;
        if (old + 1u == (gen + 1u) * nloc) {
            __builtin_amdgcn_fence(__ATOMIC_RELEASE, "agent");
            asm volatile("s_waitcnt vmcnt(0)" ::: "memory");
            const unsigned og = xb_add(&bar[XB_TOP], 1u);
            const unsigned tg = og / nx;
            if (og + 1u == (tg + 1u) * nx) xb_add(&bar[XB_TOPGEN], 1u);
            else XB_SPIN(xb_ld(&bar[XB_TOPGEN]) == tg, bar);
            __builtin_amdgcn_fence(__ATOMIC_ACQUIRE, "agent");
            xb_add(&bar[XB_XGEN(b.x)], 1u);
            asm volatile("s_waitcnt vmcnt(0)" ::: "memory");
        } else {
            XB_SPIN(xb_ld(&bar[XB_XGEN(b.x)]) == gen, bar);
            __builtin_amdgcn_fence(__ATOMIC_ACQUIRE, "agent");
            asm volatile("s_waitcnt vmcnt(0)" ::: "memory");
        }
    }
    __syncthreads();
}

struct Frame {
    LAS unsigned char* lds;
    int tid, lane, wave, vcu, G;
    const float *x, *mem; const int* pos;
    const float *g_mix, *w_in, *g_out_sb, *g_out_mb, *w_out, *g_xattn, *g_mem, *w_xq, *w_xkv, *w_xo, *g_ffn, *w_gu, *w_dn, *g_final;
    float* out; unsigned char* ws;
};

__device__ __forceinline__ void transpose_item(const float* W, int K, int N, bf16* WT, const float* gain, int inter, LAS float* scr, int item, int lane) {
    const int nblk = N / 32, kb = item / nblk, nb = item % nblk, k0 = 64 * kb, n0 = 32 * nb;
    int orow0 = n0;
    if (inter == 1) orow0 = (n0 < FF) ? (n0 / 128) * 256 + (n0 % 128) : ((n0 - FF) / 128) * 256 + 128 + ((n0 - FF) % 128);
    if (inter == 2) { const int reg = n0 / 1024, c = n0 % 1024; orow0 = (reg == 2) ? c : (reg == 5) ? 1024 + c : (reg < 2 ? reg : reg - 1) * 1024 + c; }
    float v[32];
#pragma unroll
    for (int i = 0; i < 32; ++i) v[i] = W[(size_t)(k0 + 2 * i + (lane >> 5)) * N + n0 + (lane & 31)];
#pragma unroll
    for (int i = 0; i < 32; ++i) { const int kk = 2 * i + (lane >> 5); float t = v[i]; if (gain) t *= gain[k0 + kk]; scr[kk * 33 + (lane & 31)] = t; }
    LDS_WAIT(); asm volatile("" ::: "memory");
    const int c = lane & 7;
#pragma unroll
    for (int j = 0; j < 4; ++j) { const int n = (lane >> 3) + 8 * j; const LAS float* s = scr + (8 * c) * 33 + n;
        v4u o; o.x = pk2(s[0 * 33], s[1 * 33]); o.y = pk2(s[2 * 33], s[3 * 33]); o.z = pk2(s[4 * 33], s[5 * 33]); o.w = pk2(s[6 * 33], s[7 * 33]);
        *(GAS v4u*)(WT + (size_t)(orow0 + n) * K + k0 + 8 * c) = o; }
    LDS_WAIT(); asm volatile("" ::: "memory");
}
__device__ __forceinline__ void transpose_item_fp8(const float* W, int K, int N, unsigned char* WT, const float* gain, int inter, float scale, LAS float* scr, int item, int lane, int kperm = 0) {
    const int nblk = N / 32, kb = item / nblk, nb = item % nblk, k0 = 64 * kb, n0 = 32 * nb;
    int orow0 = n0;
    if (inter == 1) orow0 = (n0 < FF) ? (n0 / 128) * 256 + (n0 % 128) : ((n0 - FF) / 128) * 256 + 128 + ((n0 - FF) % 128);
    if (inter == 2) { const int reg = n0 / 1024, c = n0 % 1024; orow0 = (reg == 2) ? c : (reg == 5) ? 1024 + c : (reg < 2 ? reg : reg - 1) * 1024 + c; }
    float v[32];
#pragma unroll
    for (int i = 0; i < 32; ++i) { int ks = k0 + 2 * i + (lane >> 5); if (kperm) ks = (ks & ~127) + 32 * (ks & 3) + ((ks & 127) >> 2); v[i] = W[(size_t)ks * N + n0 + (lane & 31)]; }
#pragma unroll
    for (int i = 0; i < 32; ++i) { const int kk = 2 * i + (lane >> 5); float t = v[i] * scale; if (gain) t *= gain[k0 + kk]; scr[kk * 33 + (lane & 31)] = t; }
    LDS_WAIT(); asm volatile("" ::: "memory");
    const int c = lane & 7;
#pragma unroll
    for (int j = 0; j < 4; ++j) { const int n = (lane >> 3) + 8 * j; const LAS float* s = scr + (8 * c) * 33 + n;
        pg8::u32x2 o; o.x = pg8::pk4_fp8(s[0 * 33], s[1 * 33], s[2 * 33], s[3 * 33]); o.y = pg8::pk4_fp8(s[4 * 33], s[5 * 33], s[6 * 33], s[7 * 33]);
        *(GAS pg8::u32x2*)(WT + (size_t)(orow0 + n) * K + k0 + 8 * c) = o; }
    LDS_WAIT(); asm volatile("" ::: "memory");
}
__device__ __forceinline__ void rms_row_to_bf16(const float* xrow, const float* g, bf16* orow, int lane, unsigned char* o8 = nullptr, float s8 = 1.f) {
    const GAS f32x4* xr = (const GAS f32x4*)xrow + lane; const GAS f32x4* gr = (const GAS f32x4*)g + lane;
    f32x4 v[8]; float s = 0.f;
#pragma unroll
    for (int j = 0; j < 8; ++j) { v[j] = xr[64 * j]; s += (v[j].x * v[j].x + v[j].y * v[j].y) + (v[j].z * v[j].z + v[j].w * v[j].w); }
    const float rstd = 1.0f / sqrtf(wave_sum(s) * (1.f / DM) + EPS);
    GAS unsigned long long* ob8 = (GAS unsigned long long*)orow + lane;
#pragma unroll
    for (int j = 0; j < 8; ++j) { const f32x4 gg = gr[64 * j];
        const float a0 = v[j].x * rstd * gg.x, a1 = v[j].y * rstd * gg.y, a2 = v[j].z * rstd * gg.z, a3 = v[j].w * rstd * gg.w;
        ob8[64 * j] = (unsigned long long)pk2(a0, a1) | ((unsigned long long)pk2(a2, a3) << 32);
        if (o8) ((GAS unsigned*)o8)[64 * j + lane] = pg8::pk4_fp8(a0 * s8, a1 * s8, a2 * s8, a3 * s8); }
}
__device__ __forceinline__ void x_row_convert(const float* xrow, bf16* orow, unsigned char* o8, float s8, float* rinv, int lane) {
    const GAS f32x4* xr = (const GAS f32x4*)xrow + lane;
    f32x4 v[8]; float s = 0.f;
#pragma unroll
    for (int j = 0; j < 8; ++j) { v[j] = xr[64 * j]; s += (v[j].x * v[j].x + v[j].y * v[j].y) + (v[j].z * v[j].z + v[j].w * v[j].w); }
    const float rstd = 1.0f / sqrtf(wave_sum(s) * (1.f / DM) + EPS);
    if (lane == 0) *rinv = rstd;
    GAS unsigned long long* ob8 = (GAS unsigned long long*)orow + lane;
#pragma unroll
    for (int j = 0; j < 8; ++j) { ob8[64 * j] = (unsigned long long)pk2(v[j].x, v[j].y) | ((unsigned long long)pk2(v[j].z, v[j].w) << 32);
        ((GAS unsigned*)o8)[64 * j + lane] = pg8::pk4_fp8(v[j].x * s8, v[j].y * s8, v[j].z * s8, v[j].w * s8); }
}
__constant__ float INV_FREQ[16] = {1.000000000e+00f, 4.403665960e-01f, 1.939227432e-01f, 8.539710194e-02f, 3.760603070e-02f, 1.656043902e-02f, 7.292664610e-03f, 3.211445874e-03f,
                                   1.414213562e-03f, 6.227723788e-04f, 2.742481884e-04f, 1.207697351e-04f, 5.318296098e-05f, 2.341999971e-05f, 1.031338616e-05f, 4.541670478e-06f};

struct TItem { const float* src; unsigned char* dst; const float* gain; float scale; int N, K, fp8, kperm; };
__device__ __forceinline__ void ti_decode(TItem& t, const float* W, int K, int N, unsigned char* WT, const float* gain, int inter, float scale, int fp8, int kperm, int item) {
    const int nblk = N / 32, kb = item / nblk, nb = item % nblk, k0 = 64 * kb, n0 = 32 * nb;
    int orow0 = n0;
    if (inter == 1) orow0 = (n0 < FF) ? (n0 / 128) * 256 + (n0 % 128) : ((n0 - FF) / 128) * 256 + 128 + ((n0 - FF) % 128);
    if (inter == 2) { const int reg = n0 / 1024, c = n0 % 1024; orow0 = (reg == 2) ? c : (reg == 5) ? 1024 + c : (reg < 2 ? reg : reg - 1) * 1024 + c; }
    const int ksrc0 = kperm ? (k0 & ~127) + ((k0 & 64) >> 2) : k0;
    t.src = W + (size_t)ksrc0 * N + n0; t.N = N; t.K = K; t.fp8 = fp8; t.kperm = kperm; t.scale = scale; t.gain = gain ? gain + k0 : nullptr;
    t.dst = WT + ((size_t)orow0 * K + k0) * (fp8 ? 1 : 2);
}
__device__ __forceinline__ void ti_load(const TItem& t, float (&v)[32], f32x4 (&g)[2], int lane) {
    const GAS float* s = (const GAS float*)t.src + (lane & 31);
#pragma unroll
    for (int i = 0; i < 32; ++i) { const int kk = 2 * i + (lane >> 5); const int ro = t.kperm ? 32 * (kk & 3) + (kk >> 2) : kk; v[i] = s[(size_t)ro * t.N]; }
    const GAS f32x4* gp = (const GAS f32x4*)((t.gain ? t.gain : t.src) + 8 * (lane & 7)); g[0] = gp[0]; g[1] = gp[1];
}
__device__ __forceinline__ void ti_finish(const TItem& t, const float (&v)[32], const f32x4 (&g)[2], LAS float* scr, int lane) {
#pragma unroll
    for (int i = 0; i < 32; ++i) scr[(2 * i + (lane >> 5)) * 33 + (lane & 31)] = v[i];
    LDS_WAIT(); asm volatile("" ::: "memory");
    const int c = lane & 7; const float sc = t.scale; const bool hg = t.gain != nullptr;
    const float g0 = hg ? g[0].x * sc : sc, g1 = hg ? g[0].y * sc : sc, g2 = hg ? g[0].z * sc : sc, g3 = hg ? g[0].w * sc : sc, g4 = hg ? g[1].x * sc : sc, g5 = hg ? g[1].y * sc : sc, g6 = hg ? g[1].z * sc : sc, g7 = hg ? g[1].w * sc : sc;
    if (t.fp8) {
#pragma unroll
        for (int j = 0; j < 4; ++j) { const int n = (lane >> 3) + 8 * j; const LAS float* s = scr + (8 * c) * 33 + n;
            pg8::u32x2 o; o.x = pg8::pk4_fp8(s[0 * 33] * g0, s[1 * 33] * g1, s[2 * 33] * g2, s[3 * 33] * g3); o.y = pg8::pk4_fp8(s[4 * 33] * g4, s[5 * 33] * g5, s[6 * 33] * g6, s[7 * 33] * g7);
            *(GAS pg8::u32x2*)(t.dst + (size_t)n * t.K + 8 * c) = o; }
    } else {
#pragma unroll
        for (int j = 0; j < 4; ++j) { const int n = (lane >> 3) + 8 * j; const LAS float* s = scr + (8 * c) * 33 + n;
            v4u o; o.x = pk2(s[0 * 33] * g0, s[1 * 33] * g1); o.y = pk2(s[2 * 33] * g2, s[3 * 33] * g3); o.z = pk2(s[4 * 33] * g4, s[5 * 33] * g5); o.w = pk2(s[6 * 33] * g6, s[7 * 33] * g7);
            *(GAS v4u*)(t.dst + ((size_t)n * t.K + 8 * c) * 2) = o; }
    }
    LDS_WAIT(); asm volatile("" ::: "memory");
}
__device__ __forceinline__ void xrow_load(const float* xrow, f32x4 (&v)[8], int lane) {
    const GAS f32x4* xr = (const GAS f32x4*)xrow + lane;
#pragma unroll
    for (int j = 0; j < 8; ++j) v[j] = xr[64 * j];
}
__device__ __forceinline__ void xrow_finish(const f32x4 (&v)[8], bf16* orow, unsigned char* o8, float s8, float* rinv, int lane) {
    float s = 0.f;
#pragma unroll
    for (int j = 0; j < 8; ++j) s += (v[j].x * v[j].x + v[j].y * v[j].y) + (v[j].z * v[j].z + v[j].w * v[j].w);
    const float rstd = 1.0f / sqrtf(wave_sum(s) * (1.f / DM) + EPS);
    if (lane == 0) *rinv = rstd;
    GAS unsigned long long* ob8 = (GAS unsigned long long*)orow + lane;
#pragma unroll
    for (int j = 0; j < 8; ++j) { ob8[64 * j] = (unsigned long long)pk2(v[j].x, v[j].y) | ((unsigned long long)pk2(v[j].z, v[j].w) << 32);
        ((GAS unsigned*)o8)[64 * j + lane] = pg8::pk4_fp8(v[j].x * s8, v[j].y * s8, v[j].z * s8, v[j].w * s8); }
}
__device__ __forceinline__ void p0_item(Frame& F, TItem& t, int it) {
    constexpr int I0 = (DM / 64) * (NQKV / 32), I1 = (DM / 64) * (DM / 32), I2 = (DM / 64) * (WX / 32), I3 = (DM / 64) * (2 * WX / 32), I4 = (WX / 64) * (DM / 32);
    int r = it;
    if (r < I0) { const int reg = ((r % (NQKV / 32)) * 32) / 1024;
        if (reg == 2 || reg == 5) ti_decode(t, F.w_in, DM, NQKV, F.ws + WS_WV8, F.g_mix, 2, S_WV, 1, 0, r);
        else if (QK_FP8 && reg < 2) ti_decode(t, F.w_in, DM, NQKV, F.ws + WS_WIN, F.g_mix, 2, S_WQK, 1, 0, r);
        else ti_decode(t, F.w_in, DM, NQKV, F.ws + WS_WIN, F.g_mix, 2, 1.f, 0, 0, r);
        return; } r -= I0;
    if (r < I1) { ti_decode(t, F.w_out, DM, DM, F.ws + WS_WOUT, nullptr, 0, S_WO, 1, 1, r); return; } r -= I1;
    if (r < I2) { ti_decode(t, F.w_xq, DM, WX, F.ws + WS_WXQ, F.g_xattn, 0, 1.f, 0, 0, r); return; } r -= I2;
    if (r < I3) { ti_decode(t, F.w_xkv, DM, 2 * WX, F.ws + WS_WXKV, nullptr, 0, 1.f, 0, 0, r); return; } r -= I3;
    if (r < I4) { ti_decode(t, F.w_xo, WX, DM, F.ws + WS_WXO, nullptr, 0, S_WXO, 1, 1, r); return; } r -= I4;
    ti_decode(t, F.w_gu, DM, 2 * FF, F.ws + WS_WGU, F.g_ffn, 1, S_WGU, 1, 0, r);
}
__device__ __forceinline__ void p0_prologue(Frame& F) {
    LAS float* scr = (LAS float*)(F.lds + F.wave * 16384);
    const int gw = F.vcu * NWAVES + F.wave, NGW = F.G * NWAVES;
    constexpr int I0 = (DM / 64) * (NQKV / 32), I1 = (DM / 64) * (DM / 32), I2 = (DM / 64) * (WX / 32), I3 = (DM / 64) * (2 * WX / 32), I4 = (WX / 64) * (DM / 32),
                  I5 = (DM / 64) * (2 * FF / 32);
    constexpr int I5H = I5 / 2;
    constexpr int NITEMS = I0 + I1 + I2 + I3 + I4 + I5H;
    {   float va[32], vb[32]; f32x4 ga[2], gb[2]; TItem ta, tb;
        int it = gw;
        if (it < NITEMS) { p0_item(F, ta, it); ti_load(ta, va, ga, F.lane);
            for (;;) {
                int itn = it + NGW; p0_item(F, tb, itn < NITEMS ? itn : it); ti_load(tb, vb, gb, F.lane);
                ti_finish(ta, va, ga, scr, F.lane); it = itn; if (it >= NITEMS) break;
                itn = it + NGW; p0_item(F, ta, itn < NITEMS ? itn : it); ti_load(ta, va, ga, F.lane);
                ti_finish(tb, vb, gb, scr, F.lane); it = itn; if (it >= NITEMS) break;
            } }
    }
    {   f32x4 va[8], vb[8];
        bf16* xb = (bf16*)(F.ws + WS_RA); unsigned char* x8 = F.ws + WS_RB; float* ri = (float*)(F.ws + WS_RINV0);
        int m = gw;
        if (m < M) { xrow_load(F.x + (size_t)m * DM, va, F.lane);
            for (;;) {
                int mn = m + NGW; xrow_load(F.x + (size_t)(mn < M ? mn : m) * DM, vb, F.lane);
                xrow_finish(va, xb + (size_t)m * DM, x8 + (size_t)m * DM, S_XN, ri + m, F.lane); m = mn; if (m >= M) break;
                mn = m + NGW; xrow_load(F.x + (size_t)(mn < M ? mn : m) * DM, va, F.lane);
                xrow_finish(vb, xb + (size_t)m * DM, x8 + (size_t)m * DM, S_XN, ri + m, F.lane); m = mn; if (m >= M) break;
            } }
    }
    for (int m = gw; m < MMEM; m += NGW) rms_row_to_bf16(F.mem + (size_t)m * DM, F.g_mem, (bf16*)(F.ws + WS_MN) + (size_t)m * DM, F.lane);
    float* cs = (float*)(F.ws + WS_CS);
    for (int e = (F.vcu * NWAVES + F.wave) * 64 + F.lane; e < M * 16; e += NGW * 64) {
        const int m = e >> 4, i = e & 15; const float ang = (float)F.pos[m] * INV_FREQ[i];
        double rev = (double)ang * 0.15915494309189535; rev -= floor(rev);
        const float a = (float)(rev * 6.283185307179586);
        cs[(size_t)m * 32 + i] = cosf(a); cs[(size_t)m * 32 + 16 + i] = sinf(a);
    }
}

__device__ __forceinline__ void ffn_item(Frame& F, TItem& t, int it) {
    constexpr int I5 = (DM / 64) * (2 * FF / 32);
    if (it < I5) ti_decode(t, F.w_gu, DM, 2 * FF, F.ws + WS_WGU, F.g_ffn, 1, S_WGU, 1, 0, it);
    else ti_decode(t, F.w_dn, FF, DM, F.ws + WS_WDN, nullptr, 0, S_WDN, 1, 0, it - I5);
}
__device__ __forceinline__ void ffn_weight_items(Frame& F, int wi, int nw) {
    LAS float* scr = (LAS float*)(F.lds + F.wave * 16384);
    constexpr int I5 = (DM / 64) * (2 * FF / 32), I6 = (FF / 64) * (DM / 32), NI = I5 + I6;
    float va[32], vb[32]; f32x4 ga[2], gb[2]; TItem ta, tb;
    int it = wi + I5 / 2;
    if (it < NI) { ffn_item(F, ta, it); ti_load(ta, va, ga, F.lane);
        for (;;) {
            int itn = it + nw; ffn_item(F, tb, itn < NI ? itn : it); ti_load(tb, vb, gb, F.lane);
            ti_finish(ta, va, ga, scr, F.lane); it = itn; if (it >= NI) break;
            itn = it + nw; ffn_item(F, ta, itn < NI ? itn : it); ti_load(ta, va, ga, F.lane);
            ti_finish(tb, vb, gb, scr, F.lane); it = itn; if (it >= NI) break;
        } }
}

__device__ __forceinline__ void final_norm_phase(Frame& F, const bf16* src, float* dst) {
    const int gw = F.vcu * NWAVES + F.wave, NGW = F.G * NWAVES;
    for (int m = gw; m < M; m += NGW) {
        const GAS v4u* xr = (const GAS v4u*)(src + (size_t)m * DM) + F.lane; const GAS f32x4* gr = (const GAS f32x4*)F.g_final;
        v4u w[4]; float s = 0.f;
#pragma unroll
        for (int j = 0; j < 4; ++j) w[j] = xr[64 * j];
        f32x4 v[8];
#pragma unroll
        for (int j = 0; j < 4; ++j) { v[2 * j] = (f32x4){__uint_as_float(w[j].x << 16), __uint_as_float(w[j].x & 0xffff0000u), __uint_as_float(w[j].y << 16), __uint_as_float(w[j].y & 0xffff0000u)};
            v[2 * j + 1] = (f32x4){__uint_as_float(w[j].z << 16), __uint_as_float(w[j].z & 0xffff0000u), __uint_as_float(w[j].w << 16), __uint_as_float(w[j].w & 0xffff0000u)}; }
#pragma unroll
        for (int j = 0; j < 8; ++j) s += (v[j].x * v[j].x + v[j].y * v[j].y) + (v[j].z * v[j].z + v[j].w * v[j].w);
        const float rstd = 1.0f / sqrtf(wave_sum(s) * (1.f / DM) + EPS);
        GAS f32x4* dr = (GAS f32x4*)(dst + (size_t)m * DM);
#pragma unroll
        for (int j = 0; j < 4; ++j) { const int c4 = (64 * j + F.lane) * 2;
            dr[c4] = v[2 * j] * rstd * gr[c4]; dr[c4 + 1] = v[2 * j + 1] * rstd * gr[c4 + 1]; }
    }
}

struct RangeOrder : pg8::StaticOrder {
    int i0, n;
    __device__ __forceinline__ bool next(int i, pg8::Unit& u) const { return i < n && pg8::StaticOrder::next(i + i0, u); }
};
template <int K> __device__ __forceinline__ const void* late_arg() {
    const void* p; asm volatile("s_load_dwordx2 %0, %1, %2\n\ts_waitcnt lgkmcnt(0)" : "=s"(p) : "s"(__builtin_amdgcn_kernarg_segment_ptr()), "i"(K * 8));
    return p;
}
constexpr int NPH = 11;
#ifndef REPEAT_WHICH
#define REPEAT_WHICH 3
#endif
#ifndef NULL_EPI_PROBE
#define NULL_EPI_PROBE 0
#endif
#ifndef FOLD_KMEAN
#define FOLD_KMEAN 1
#endif
#ifndef REPEAT_PHASE
#define REPEAT_PHASE -1
#endif
#ifndef REPEAT_MASK
#define REPEAT_MASK 0
#endif
#define REPS(k) (((REPEAT_PHASE == (k)) || ((REPEAT_MASK >> (k)) & 1)) ? 2 : 1)
#ifndef USE_MFMA_SB
#define USE_MFMA_SB 1
#endif
#ifndef USE_MFMA_MOBA
#define USE_MFMA_MOBA 1
#endif
#ifndef USE_MFMA_X
#define USE_MFMA_X 1
#endif
#ifndef MK_ONE_LAUNCH
#define MK_ONE_LAUNCH 1
#endif
struct Args { const void* in[17]; float* out; unsigned char* ws; int ph_lo, ph_hi; };
__global__ void __launch_bounds__(NWAVES * 64, 2) mk_fwd(Args args) {
    extern __shared__ __attribute__((aligned(16))) unsigned char lds[];
    Frame F;
    F.lds = (LAS unsigned char*)lds;
    F.tid = threadIdx.x; F.lane = F.tid & 63; F.wave = __builtin_amdgcn_readfirstlane(F.tid >> 6);
    F.G = gridDim.x; { const int bx = blockIdx.x; F.vcu = (F.G % 8 == 0) ? (bx % 8) * (F.G / 8) + bx / 8 : bx; }
    F.x = (const float*)args.in[0]; F.mem = (const float*)args.in[1]; F.pos = (const int*)args.in[2];
    F.g_mix = (const float*)args.in[3]; F.w_in = (const float*)args.in[4]; F.g_out_sb = nullptr; F.g_out_mb = nullptr; F.w_out = (const float*)args.in[7];
    F.g_xattn = (const float*)args.in[8]; F.g_mem = (const float*)args.in[9]; F.w_xq = (const float*)args.in[10]; F.w_xkv = (const float*)args.in[11]; F.w_xo = (const float*)args.in[12];
    F.g_ffn = nullptr; F.w_gu = nullptr; F.w_dn = nullptr; F.g_final = nullptr;
    F.out = args.out; F.ws = args.ws;
    unsigned char* ws = args.ws;
    const int lo = args.ph_lo, hi = args.ph_hi;
    for (int u = F.tid; u < (LDS_BYTES - LDSCTL_OFF) / 4; u += NWAVES * 64) ((LAS unsigned*)(F.lds + LDSCTL_OFF))[u] = 0u;
    __syncthreads();
    if (hi - lo > 1) {
        { GAS v4u* z = (GAS v4u*)(ws + WS_CTL); const int n16 = (int)(CTL_ZERO_BYTES / 16);
          for (int i = (int)blockIdx.x * (NWAVES * 64) + F.tid; i < n16; i += F.G * NWAVES * 64) z[i] = (v4u){0u, 0u, 0u, 0u}; }
        cg::this_grid().sync();
    }
    XcdBarrier bar = xcd_barrier_post((unsigned*)(ws + WS_CTL) + CW_BAR, (volatile LAS unsigned*)(F.lds + MISC_OFF) + 8);
#ifndef ONLY_PHASE
#define ONLY_PHASE -1
#endif
#define IN(k) ((ONLY_PHASE < 0 || ONLY_PHASE == (k)) && lo <= (k) && (k) < hi)
#define BOTH(k) (IN(k) && IN((k) + 1))
#define GRID_BAR() xcd_barrier(bar)
    float* ssq1 = (float*)(ws + WS_SSQ1); float* ssq2 = (float*)(ws + WS_SSQ2);
    pg8::bf16_t* ACT = (pg8::bf16_t*)(ws + WS_RC + 64 * MiB);
    pg8::bf16_t* RA = (pg8::bf16_t*)(ws + WS_RA); pg8::bf16_t* RB = (pg8::bf16_t*)(ws + WS_RB); pg8::bf16_t* RC = (pg8::bf16_t*)(ws + WS_RC);

    if (IN(0)) { F.w_gu = (const float*)late_arg<14>(); F.g_ffn = (const float*)late_arg<13>(); for (int rep = 0; rep < REPS(0); ++rep) p0_prologue(F); F.w_gu = nullptr; F.g_ffn = nullptr; if (BOTH(0)) GRID_BAR(); }
    if (IN(1)) {
        pg8::Gemm gs{RB, (const pg8::bf16_t*)(ws + WS_WIN), M, 2048, DM / 2}; RangeOrder Ss; Ss.init(M, 2048, F.G, (int)blockIdx.x);
        pg8::EpiQKV Es{RC, (const float*)(ws + WS_CS), QSCALE, (float*)(ws + WS_KSUM), 0, 1.f, (const float*)(ws + WS_RINV0), 1.f / (S_XN * S_WQK), 0};
        pg8::Gemm gm{RA, (const pg8::bf16_t*)(ws + WS_WIN) + (size_t)2048 * DM, M, 2048, DM}; RangeOrder Sm; Sm.init(M, 2048, F.G, (int)blockIdx.x);
        pg8::EpiQKV Em{RC, (const float*)(ws + WS_CS), QSCALE, (float*)(ws + WS_KSUM), 0, 1.f, (const float*)(ws + WS_RINV0), 1.f, 8};
        pg8::Gemm gv{RB, (const pg8::bf16_t*)(ws + WS_WV8), M, 2048, DM / 2}; RangeOrder Sv; Sv.init(M, 2048, F.G, (int)blockIdx.x);
        pg8::EpiQKV Ev{RC, (const float*)(ws + WS_CS), QSCALE, (float*)(ws + WS_KSUM), 1, 1.f / (S_XN * S_WV), (const float*)(ws + WS_RINV0), 1.f, 0};
        for (int rep = 0; rep < REPS(1); ++rep) {
        const bool grp = ((blockIdx.x >> 3) & 1) != 0;
        Ss.i0 = 0; Ss.n = 1 << 20; Sm.i0 = 0; Sm.n = 1 << 20;
        if (grp) { Sv.i0 = 0; Sv.n = 1; pg8::gemm_phase<pg8::EpiQKV, RangeOrder, true, true, true>(F.lds, gv, Sv, Ev); }
        pg8::gemm_phase<pg8::EpiQKV, RangeOrder, true, true, true>(F.lds, gs, Ss, Es);
        pg8::gemm_phase<pg8::EpiQKV, RangeOrder, true, true>(F.lds, gm, Sm, Em);
        Sv.i0 = grp ? 1 : 0; Sv.n = 1 << 20;
        pg8::gemm_phase<pg8::EpiQKV, RangeOrder, true, true, true>(F.lds, gv, Sv, Ev);
        }
        if (BOTH(1)) GRID_BAR();
    }
    if (IN(3)) {
        const att::bf16* qkv = (const att::bf16*)RC; att::bf16* ob = (att::bf16*)RB; const float* kmean = (const float*)(ws + WS_KSUM);
        F.g_out_sb = (const float*)late_arg<5>(); F.g_out_mb = (const float*)late_arg<6>();
        constexpr size_t HSZ = (size_t)SEQ * HD;
        for (int rep = 0; rep < REPS(3); ++rep) {
        if (rep == 0 || (REPEAT_WHICH & 1))
        for (int vv = F.vcu; vv < 256; vv += F.G) { const int bh = vv >> 2, s = vv & 3, b = bh >> 3, h = bh & 7; const size_t rb = (size_t)b * SEQ;
            const att::bf16* hS = qkv + ((size_t)b * 48 + h) * HSZ; const att::bf16* hM = qkv + ((size_t)b * 48 + 24 + h) * HSZ;
            for (int i = 0; i < 2; ++i) { const int qb = i ? s : 7 - s; const size_t r0 = rb + (size_t)qb * 256;
                att::attn_unit<2, true>(hS, nullptr, nullptr, (att::bf16*)((unsigned char*)ob + r0 * DM + h * HD), F.g_out_sb + h * HD, nullptr, qb, 0, (char*)lds, S_O,
                                        i != 0, i ? hM : hS, i ? 7 - s : s, i ? 0 : 4 * (s + 1) - 1, i ? -1 : 4 * (s + 1) - 2); }
            for (int i = 0; i < 2; ++i) { const int qb = i ? s : 7 - s; const size_t r0 = rb + (size_t)qb * 256;
                att::attn_unit<1, true>(hM, nullptr, nullptr, (att::bf16*)((unsigned char*)ob + r0 * DM + NH * HD + h * HD), F.g_out_mb + h * HD, kmean + (size_t)bh * 1024, qb, 0, (char*)lds, S_O,
                                        true, i ? nullptr : hM, s, 0, -1); } }
        }
        if (BOTH(3)) GRID_BAR();
    }
    if (IN(4)) {
        pg8::Gemm g{RB, (const pg8::bf16_t*)(ws + WS_WOUT), M, DM, WOUT_FP8 ? DM / 2 : DM}; pg8::StaticOrder S; S.init(M, DM, F.G, (int)blockIdx.x);
        pg8::EpiResB<false> E{RA, RC, ssq1, nullptr, 1.f, WOUT_FP8 ? 1.f / (S_O * S_WO) : 1.f};
        pg8::gemm_phase<pg8::EpiResB<false>, pg8::StaticOrder, true, true, WOUT_FP8 != 0>(F.lds, g, S, E);
        if (BOTH(4)) GRID_BAR();
    }
    if (IN(5)) {
      F.w_gu = (const float*)late_arg<14>(); F.g_ffn = (const float*)late_arg<13>(); F.w_dn = (const float*)late_arg<15>();
      for (int rep = 0; rep < REPS(5); ++rep) {
        { pg8::Gemm g{RC, (const pg8::bf16_t*)(ws + WS_WXQ), M, WX, DM}; pg8::StaticOrder S; S.init(M, WX, F.G, (int)blockIdx.x);
          pg8::EpiScale E{(pg8::bf16_t*)(ws + WS_QX), WX, ssq1, QSCALE};
          pg8::gemm_phase<pg8::EpiScale, pg8::StaticOrder, true, true>(F.lds, g, S, E); }
        { pg8::Gemm g{(const pg8::bf16_t*)(ws + WS_MN), (const pg8::bf16_t*)(ws + WS_WXKV), MMEM, 2 * WX, DM}; pg8::StaticOrder S; S.init(MMEM, 2 * WX, F.G, (int)((blockIdx.x + F.G - 128) % F.G));
          pg8::EpiScale E{(pg8::bf16_t*)(ws + WS_KVX), 2 * WX, nullptr, 1.0f};
          pg8::gemm_phase<pg8::EpiScale, pg8::StaticOrder, true, true>(F.lds, g, S, E); }
        if (F.G > 160) { if ((int)blockIdx.x >= 160) ffn_weight_items(F, ((int)blockIdx.x - 160) * NWAVES + F.wave, (F.G - 160) * NWAVES); }
        else ffn_weight_items(F, (int)blockIdx.x * NWAVES + F.wave, F.G * NWAVES);
      }
        if (BOTH(5)) GRID_BAR();
    }
    if (IN(6)) {
        const att::bf16* qx = (const att::bf16*)(ws + WS_QX); const att::bf16* kvx = (const att::bf16*)(ws + WS_KVX); att::bf16* ox = (att::bf16*)(ws + WS_OX);
        for (int rep = 0; rep < REPS(6); ++rep) {
        for (int vv = F.vcu; vv < 256; vv += F.G) { const int b = vv >> 5, h = (vv >> 3) & 3, qb = vv & 7; const size_t r0 = (size_t)b * SEQ + (size_t)qb * 256;
            if (WXO_FP8) att::attn_unit<0, true>(qx + r0 * WX + h * HD, kvx + (size_t)b * NMEM * (2 * WX) + h * HD, kvx + (size_t)b * NMEM * (2 * WX) + WX + h * HD, (att::bf16*)((unsigned char*)ox + r0 * WX + h * HD), nullptr, nullptr, qb, NMEM, (char*)lds, S_OX);
            else att::attn_unit<0>(qx + r0 * WX + h * HD, kvx + (size_t)b * NMEM * (2 * WX) + h * HD, kvx + (size_t)b * NMEM * (2 * WX) + WX + h * HD, ox + r0 * WX + h * HD, nullptr, nullptr, qb, NMEM, (char*)lds); }
        }
        if (BOTH(6)) GRID_BAR();
    }
    if (IN(7)) {
        pg8::Gemm g{(const pg8::bf16_t*)(ws + WS_OX), (const pg8::bf16_t*)(ws + WS_WXO), M, DM, WXO_FP8 ? WX / 2 : WX}; pg8::StaticOrder S; S.init(M, DM, F.G, (int)blockIdx.x);
        pg8::EpiResB<false> E{RC, RC, ssq2, (unsigned char*)RA, S_X2, WXO_FP8 ? 1.f / (S_OX * S_WXO) : 1.f};
        pg8::gemm_phase<pg8::EpiResB<false>, pg8::StaticOrder, true, true, WXO_FP8 != 0>(F.lds, g, S, E);
        if (BOTH(7)) GRID_BAR();
    }
    if (IN(8)) {
        pg8::Gemm g{RA, (const pg8::bf16_t*)(ws + WS_WGU), M, 2 * FF, FFN_FP8 ? DM / 2 : DM}; pg8::StaticOrder S; S.init(M, 2 * FF, F.G, (int)blockIdx.x);
        pg8::EpiSwiGLU E{ACT, ssq2, FFN_FP8 ? (unsigned char*)ACT : nullptr, FFN_FP8 ? 1.f / (S_X2 * S_WGU) : 1.f, S_ACT};
#if NULL_EPI_PROBE
        if (REPS(8) == 2) { pg8::EpiNull EN{nullptr}; pg8::gemm_phase<pg8::EpiNull, pg8::StaticOrder, true, true, FFN_FP8 != 0>(F.lds, g, S, EN); }
        pg8::gemm_phase<pg8::EpiSwiGLU, pg8::StaticOrder, true, true, FFN_FP8 != 0>(F.lds, g, S, E);
#else
        for (int rep = 0; rep < REPS(8); ++rep) pg8::gemm_phase<pg8::EpiSwiGLU, pg8::StaticOrder, true, true, FFN_FP8 != 0>(F.lds, g, S, E);
#endif
        if (BOTH(8)) GRID_BAR();
    }
    if (IN(9)) {
        pg8::Gemm g{ACT, (const pg8::bf16_t*)(ws + WS_WDN), M, DM, FF / 2}; pg8::StaticOrder S; S.init(M, DM, F.G, (int)blockIdx.x);
        pg8::EpiResB<false> E{RC, RC, nullptr, nullptr, 1.f, 1.f / (S_ACT * S_WDN)};
        pg8::gemm_phase<pg8::EpiResB<false>, pg8::StaticOrder, true, true, true>(F.lds, g, S, E);
        if (BOTH(9)) GRID_BAR();
    }
    if (IN(10)) { F.g_final = (const float*)late_arg<16>(); final_norm_phase(F, RC, F.out); }
#undef IN
#undef BOTH
}

extern "C" void kernel_launch(void* const* d_in, const int* in_sizes, int n_in, void* d_out, int out_size, void* d_ws, size_t ws_size, hipStream_t stream) {
    static int grid = 0;
    if (grid == 0) {
        if (n_in != 17 || in_sizes[0] != M * DM || out_size != M * DM || ws_size < WS_END) { fprintf(stderr, "kernel_launch: unexpected shapes (n_in %d in0 %d out %d ws %zu)\n", n_in, n_in > 0 ? in_sizes[0] : -1, out_size, ws_size); grid = -1; return; }
        int dev = 0, cus = 0, per_cu = 0;
        if (hipGetDevice(&dev) != hipSuccess || hipDeviceGetAttribute(&cus, hipDeviceAttributeMultiprocessorCount, dev) != hipSuccess) { grid = -1; return; }
        if (hipFuncSetAttribute((const void*)mk_fwd, hipFuncAttributeMaxDynamicSharedMemorySize, LDS_BYTES) != hipSuccess) { fprintf(stderr, "kernel_launch: hipFuncSetAttribute failed\n"); grid = -1; return; }
        if (hipOccupancyMaxActiveBlocksPerMultiprocessor(&per_cu, (const void*)mk_fwd, NWAVES * 64, LDS_BYTES) != hipSuccess || per_cu < 1) { fprintf(stderr, "kernel_launch: occupancy query failed (%d)\n", per_cu); per_cu = 1; }
        (void)hipGetLastError();
        grid = cus * (per_cu < 1 ? 1 : 1);
    }
    if (grid < 0) return;
#if !MK_ONE_LAUNCH
    (void)hipMemsetAsync((char*)d_ws + WS_CTL, 0, CTL_ZERO_BYTES, stream);
#endif
    Args a{};
    for (int i = 0; i < 17; ++i) a.in[i] = d_in[i];
    a.out = (float*)d_out; a.ws = (unsigned char*)d_ws;
#if MK_ONE_LAUNCH
    a.ph_lo = 0; a.ph_hi = NPH;
    void* kargs[] = {&a};
    hipError_t e = hipLaunchCooperativeKernel((const void*)mk_fwd, dim3(grid), dim3(NWAVES * 64), kargs, LDS_BYTES, stream);
    if (e != hipSuccess) fprintf(stderr, "kernel_launch: cooperative launch failed: %s (grid %d)\n", hipGetErrorString(e), grid);
#else
    for (int p = 0; p < NPH; ++p) { a.ph_lo = p; a.ph_hi = p + 1; hipLaunchKernelGGL(mk_fwd, dim3(grid), dim3(NWAVES * 64), LDS_BYTES, stream, a); }
    const hipError_t le = hipPeekAtLastError();
    if (le != hipSuccess) fprintf(stderr, "kernel_launch: launch failed: %s\n", hipGetErrorName(le));
#endif
}
```

```cpp
#include <hip/hip_runtime.h>
#include <hip/hip_cooperative_groups.h>
#include <cstdio>
#include <cstdint>
namespace cg = cooperative_groups;
namespace pg8 {
#define PG8_LAS __attribute__((address_space(3)))
typedef unsigned short bf16_t;
typedef short bf16x8 __attribute__((ext_vector_type(8)));
typedef float f32x4 __attribute__((ext_vector_type(4)));
typedef unsigned u32x4 __attribute__((ext_vector_type(4)));
constexpr int BM = 256, BK = 64, HALF = 128, HTB = HALF * BK * 2  , STAGE_BYTES = 8 * HTB, NXCD = 8, WGM = 8;

__host__ __device__ __forceinline__ int lds_byte(int r, int c) { const int st = (r >> 4) * 2 + (c >> 5), rr = r & 15, cc = c & 31, ob = rr * 64 + cc * 2; return st * 1024 + (ob ^ (((ob >> 9) & 1) << 5)); }
__host__ __device__ __forceinline__ void stage_rc(int b, int& R, int& C) { const int st = b / 1024, sb = b % 1024, swz = sb ^ (((sb >> 9) & 1) << 5); R = (st >> 1) * 16 + swz / 64; C = (st & 1) * 32 + (swz % 64) / 2; }
__host__ __device__ __forceinline__ int perm32(int rho) { const int n = rho >> 4, i = rho & 15; return 8 * (i >> 2) + 4 * n + (i & 3); }

struct Unit { int pm, pn; };
struct Gemm { const bf16_t* A; const bf16_t* Bt; int M, N, K; };

struct StaticOrder {
    int nM, nN, nwg, G, c;
    __host__ __device__ void init(int M, int N, int G_, int c_) { nM = M / BM; nN = N / BM; nwg = nM * nN; G = G_; c = c_; }
    __host__ __device__ bool next(int i, Unit& u) const {
        const long L = (long)i * G + c; if (L >= nwg) return false;
        int wgid = (int)L; { const int q = nwg / NXCD, r = nwg % NXCD, xcd = wgid % NXCD, off = wgid / NXCD; wgid = (xcd < r ? xcd * (q + 1) : r * (q + 1) + (xcd - r) * q) + off; }
        const int nig = WGM * nN, gid = wgid / nig, fm = gid * WGM, gsz = (nM - fm) < WGM ? (nM - fm) : WGM;
        u.pm = fm + ((wgid % nig) % gsz); u.pn = (wgid % nig) / gsz; return true;
    }
    __device__ __forceinline__ void a_ready(const Unit&) const {}
    __device__ __forceinline__ void done(const Unit&) const {}
};

__device__ __forceinline__ unsigned cvt_pk_bf16(float lo, float hi) { unsigned r; asm volatile("v_cvt_pk_bf16_f32 %0, %1, %2" : "=v"(r) : "v"(lo), "v"(hi)); return r; }
typedef float f32x2 __attribute__((ext_vector_type(2)));
template <class Epi, class Sched, bool ALIGN_EPI = false, bool SP2 = false, bool FP8 = false>
__device__ __forceinline__ void gemm_phase(PG8_LAS unsigned char* lds, const Gemm g, const Sched& S, const Epi& E) {
    int tid_ = threadIdx.x; asm volatile("" : "+v"(tid_));
    const int tid = tid_, wid = __builtin_amdgcn_readfirstlane(tid >> 6), lane = tid & 63, wr = wid >> 2, wc = wid & 3, fr = lane & 15, fq = lane >> 4;
    const int K = g.K, nt = K / BK;
    unsigned voffA[2], voffB[2];
#pragma unroll
    for (int i = 0; i < 2; ++i) { int R, C; stage_rc(tid * 16 + i * 8192, R, C); const int Rb = Epi::PERM ? ((R & ~31) + perm32(R & 31)) : R;
        voffA[i] = (unsigned)(R * K + C) * 2u; voffB[i] = (unsigned)(Rb * K + C) * 2u; }
    const size_t kstep = (size_t)(BK * 2);
    const size_t hstep = (size_t)HALF * K * 2;
    const size_t tstep = 2 * hstep;
    const unsigned ldsw = (unsigned)wid * 1024u;
    const int aoff = lds_byte(wr * 64 + fr, fq * 8), boff = lds_byte(wc * 32 + fr, fq * 8);
#define PG8_SA(b, h) (((b) * 2 + (h)) * HTB)
#define PG8_SB(b, h) ((4 + (b) * 2 + (h)) * HTB)
#define PG8_STAGE(bufoff, gbase, voff) do { _Pragma("unroll") for (int _i = 0; _i < 2; ++_i) \
        __builtin_amdgcn_global_load_lds((const unsigned*)((const char*)(gbase) + (voff)[_i]), (PG8_LAS unsigned*)(lds + (bufoff) + ldsw + _i * 8192), 16, 0, 0); } while (0)
#define PG8_LD8(p) __builtin_shufflevector(*(const PG8_LAS i32x4_*)(p), *(const PG8_LAS i32x4_*)((p) + 1024), 0, 1, 2, 3, 4, 5, 6, 7)
#define PG8_LDA(dst, b, h) do { if constexpr (FP8) { _Pragma("unroll") for (int m = 0; m < 4; ++m) dst##8[m] = PG8_LD8(lds + PG8_SA(b, h) + aoff + m * 2048); } \
        else { _Pragma("unroll") for (int m = 0; m < 4; ++m) _Pragma("unroll") for (int k = 0; k < 2; ++k) dst[m][k] = *(const PG8_LAS bf16x8*)(lds + PG8_SA(b, h) + aoff + m * 2048 + k * 1024); } } while (0)
#define PG8_LDB(dst, b, h) do { if constexpr (FP8) { _Pragma("unroll") for (int n = 0; n < 2; ++n) dst##8[n] = PG8_LD8(lds + PG8_SB(b, h) + boff + n * 2048); } \
        else { _Pragma("unroll") for (int n = 0; n < 2; ++n) _Pragma("unroll") for (int k = 0; k < 2; ++k) dst[n][k] = *(const PG8_LAS bf16x8*)(lds + PG8_SB(b, h) + boff + n * 2048 + k * 1024); } } while (0)
#define PG8_MMA(ai, bj, At, Bt) do { __builtin_amdgcn_s_setprio(1); _Pragma("unroll") for (int m = 0; m < 4; ++m) _Pragma("unroll") for (int n = 0; n < 2; ++n) { \
        if constexpr (FP8) asm volatile("v_mfma_scale_f32_16x16x128_f8f6f4 %0, %1, %2, %0, %3, %3 op_sel_hi:[0,0,0]" : "+v"(acc[ai][bj][m][n]) : "v"(Bt##8[n]), "v"(At##8[m]), "v"(sc1_)); \
        else { _Pragma("unroll") for (int k = 0; k < 2; ++k) acc[ai][bj][m][n] = __builtin_amdgcn_mfma_f32_16x16x32_bf16(Bt[n][k], At[m][k], acc[ai][bj][m][n], 0, 0, 0); } } \
        __builtin_amdgcn_s_setprio(0); } while (0)
#define PG8_WAIT_V(n) asm volatile("s_waitcnt vmcnt(" #n ")" ::: "memory")
#define PG8_WAIT_L(n) asm volatile("s_waitcnt lgkmcnt(" #n ")" ::: "memory")
#define PG8_BAR __builtin_amdgcn_s_barrier()
#define PG8_SCHED __builtin_amdgcn_sched_barrier(0)
    Unit cur, nxt; int ui = 0;
    if (!S.next(0, cur)) return;
    f32x4 acc[2][2][4][2];
#pragma unroll
    for (int a = 0; a < 2; ++a)
#pragma unroll
        for (int b = 0; b < 2; ++b)
#pragma unroll
            for (int m = 0; m < 4; ++m)
#pragma unroll
                for (int n = 0; n < 2; ++n) acc[a][b][m][n] = (f32x4){0.f, 0.f, 0.f, 0.f};
    typedef int i32x4_ __attribute__((ext_vector_type(4))); typedef int i32x8_ __attribute__((ext_vector_type(8)));
    int sc1_ = 0x7F7F7F7F; asm volatile("" : "+v"(sc1_));
    bf16x8 At[4][2], B0[2][2], B1[2][2]; i32x8_ At8[4], B08[2], B18[2];
    const char* cA = (const char*)g.A + (size_t)cur.pm * tstep; const char* cB = (const char*)g.Bt + (size_t)cur.pn * tstep;
    S.a_ready(cur);
    if constexpr (SP2) {
        PG8_STAGE(PG8_SB(0, 0), cB, voffB); PG8_STAGE(PG8_SB(0, 1), cB + hstep, voffB); PG8_STAGE(PG8_SA(0, 0), cA, voffA); PG8_STAGE(PG8_SA(0, 1), cA + hstep, voffA);
        if (wr == 1) PG8_BAR;
        PG8_WAIT_V(2); PG8_BAR;
        PG8_STAGE(PG8_SB(1, 0), cB + kstep, voffB); PG8_STAGE(PG8_SA(1, 0), cA + kstep, voffA); PG8_STAGE(PG8_SB(1, 1), cB + hstep + kstep, voffB);
        PG8_WAIT_V(6); PG8_BAR;
    } else {
        PG8_STAGE(PG8_SB(0, 0), cB, voffB); PG8_STAGE(PG8_SA(0, 0), cA, voffA); PG8_STAGE(PG8_SB(0, 1), cB + hstep, voffB); PG8_STAGE(PG8_SA(0, 1), cA + hstep, voffA);
        if (wr == 1) PG8_BAR;
        PG8_WAIT_V(4); PG8_BAR;
        PG8_STAGE(PG8_SB(1, 0), cB + kstep, voffB); PG8_STAGE(PG8_SA(1, 0), cA + kstep, voffA); PG8_STAGE(PG8_SB(1, 1), cB + hstep + kstep, voffB);
        PG8_WAIT_V(6); PG8_BAR;
    }
    for (;;) {
        const bool has_next = S.next(ui + 1, nxt);
        const char* nA = has_next ? (const char*)g.A + (size_t)nxt.pm * tstep : cA; const char* nB = has_next ? (const char*)g.Bt + (size_t)nxt.pn * tstep : cB;
        for (int t = 0; t < nt; t += 2) {
            const bool last = (t == nt - 2);
            const char* a1 = cA + (size_t)(t + 1) * kstep;
            const char* a2 = last ? nA : cA + (size_t)(t + 2) * kstep; const char* b2 = last ? nB : cB + (size_t)(t + 2) * kstep;
            const char* a3 = a2 + kstep; const char* b3 = b2 + kstep;
            if (last && has_next) S.a_ready(nxt);
            if constexpr (SP2) {
            PG8_LDB(B0, 0, 0); PG8_LDB(B1, 0, 1); PG8_SCHED; PG8_LDA(At, 0, 0); PG8_STAGE(PG8_SA(1, 1), a1 + hstep, voffA);
            PG8_WAIT_V(8); PG8_WAIT_L(0); PG8_BAR; PG8_MMA(0, 0, At, B0); PG8_MMA(0, 1, At, B1); PG8_BAR; PG8_SCHED;
            PG8_LDA(At, 0, 1); PG8_STAGE(PG8_SB(0, 0), b2, voffB); PG8_STAGE(PG8_SB(0, 1), b2 + hstep, voffB); PG8_STAGE(PG8_SA(0, 0), a2, voffA);
            PG8_WAIT_V(8); PG8_WAIT_L(0); PG8_BAR; PG8_MMA(1, 0, At, B0); PG8_MMA(1, 1, At, B1); PG8_BAR; PG8_SCHED;
            PG8_LDB(B0, 1, 0); PG8_LDB(B1, 1, 1); PG8_SCHED; PG8_LDA(At, 1, 0); PG8_STAGE(PG8_SA(0, 1), a2 + hstep, voffA);
            PG8_WAIT_V(8); PG8_WAIT_L(0); PG8_BAR; PG8_MMA(0, 0, At, B0); PG8_MMA(0, 1, At, B1); PG8_BAR; PG8_SCHED;
            PG8_LDA(At, 1, 1); PG8_STAGE(PG8_SB(1, 0), b3, voffB); PG8_STAGE(PG8_SB(1, 1), b3 + hstep, voffB); PG8_STAGE(PG8_SA(1, 0), a3, voffA);
            PG8_WAIT_V(8); PG8_WAIT_L(0); PG8_BAR; PG8_MMA(1, 0, At, B0); PG8_MMA(1, 1, At, B1); PG8_BAR; PG8_SCHED;
            } else {
            PG8_LDB(B0, 0, 0); PG8_SCHED; PG8_LDA(At, 0, 0); PG8_STAGE(PG8_SA(1, 1), a1 + hstep, voffA);
            PG8_WAIT_L(8); PG8_BAR; PG8_WAIT_L(0); PG8_MMA(0, 0, At, B0); PG8_BAR; PG8_SCHED;
            PG8_LDB(B1, 0, 1); PG8_STAGE(PG8_SB(0, 0), b2, voffB);
            PG8_BAR; PG8_WAIT_L(0); PG8_MMA(0, 1, At, B1); PG8_BAR;
            PG8_LDA(At, 0, 1); PG8_STAGE(PG8_SA(0, 0), a2, voffA);
            PG8_BAR; PG8_WAIT_L(0); PG8_MMA(1, 0, At, B0); PG8_BAR; PG8_SCHED;
            PG8_STAGE(PG8_SB(0, 1), b2 + hstep, voffB);
            PG8_WAIT_V(6); PG8_BAR; PG8_MMA(1, 1, At, B1); PG8_BAR;
            PG8_LDB(B0, 1, 0); PG8_SCHED; PG8_LDA(At, 1, 0); PG8_STAGE(PG8_SA(0, 1), a2 + hstep, voffA);
            PG8_WAIT_L(8); PG8_BAR; PG8_WAIT_L(0); PG8_MMA(0, 0, At, B0); PG8_BAR; PG8_SCHED;
            PG8_LDB(B1, 1, 1); PG8_STAGE(PG8_SB(1, 0), b3, voffB);
            PG8_BAR; PG8_WAIT_L(0); PG8_MMA(0, 1, At, B1); PG8_BAR;
            PG8_LDA(At, 1, 1); PG8_STAGE(PG8_SA(1, 0), a3, voffA);
            PG8_BAR; PG8_WAIT_L(0); PG8_MMA(1, 0, At, B0); PG8_BAR; PG8_SCHED;
            PG8_STAGE(PG8_SB(1, 1), b3 + hstep, voffB);
            PG8_WAIT_V(6); PG8_BAR; PG8_MMA(1, 1, At, B1); PG8_BAR;
            }
        }
        if constexpr (ALIGN_EPI) { if (wr == 0) PG8_BAR; }
        if constexpr (FP8) asm volatile("s_nop 15\n\ts_nop 15" ::: "memory");
        if constexpr (!Epi::AFTER_DRAIN) { E(acc, cur, wr, wc, fr, fq); S.done(cur); }
        if (!has_next) break;
#pragma unroll
        for (int a = 0; a < 2; ++a)
#pragma unroll
            for (int b = 0; b < 2; ++b)
#pragma unroll
                for (int m = 0; m < 4; ++m)
#pragma unroll
                    for (int n = 0; n < 2; ++n) acc[a][b][m][n] = (f32x4){0.f, 0.f, 0.f, 0.f};
        cur = nxt; cA = nA; cB = nB; ++ui;
        if constexpr (ALIGN_EPI) { if (wr == 1) PG8_BAR; }
    }
    PG8_WAIT_V(0);
    if constexpr (!ALIGN_EPI) { if (wr == 0) PG8_BAR; }
    PG8_BAR;
    if constexpr (Epi::AFTER_DRAIN) { E.fused(acc, cur, wr, wc, fr, fq, lds, wid, lane); S.done(cur); }
#undef PG8_SA
#undef PG8_SB
#undef PG8_STAGE
#undef PG8_LDA
#undef PG8_LD8
#undef PG8_LDB
#undef PG8_MMA
#undef PG8_WAIT_V
#undef PG8_WAIT_L
#undef PG8_BAR
#undef PG8_SCHED
}
}
namespace pg8 {
typedef unsigned u32x2 __attribute__((ext_vector_type(2)));
constexpr int LDX = 2048;
constexpr float RMS_EPS = 1e-6f;
#ifndef EPI_SC1
#define EPI_SC1 1
#endif
__device__ __forceinline__ void store16(void* p, u32x4 w) {
#if EPI_SC1
    asm volatile("global_store_dwordx4 %0, %1, off sc1\n\ts_nop 1" :: "v"(p), "v"(w) : "memory");
#else
    *(u32x4*)p = w;
#endif
}
struct EpiQKV {
    static constexpr bool PERM = true, AFTER_DRAIN = false;
    bf16_t* O; const float* cs; float qscale; float* ksum; int vmode; float vscale; const float* rinv; float pre; int pnoff;
    __device__ __forceinline__ void operator()(const f32x4 (&acc)[2][2][4][2], const Unit& u, int wr, int wc, int fr, int fq) const {
        const int row0 = u.pm * BM + wr * 64 + fr, pn = vmode ? (u.pn < 4 ? u.pn + 8 : u.pn + 16) : (u.pn + pnoff < 8 ? u.pn + pnoff : u.pn + pnoff + 4);
        const float sc = (pn < 4 || (pn >= 12 && pn < 16)) ? qscale : vscale;
        const bool rot = (pn >= 12 && pn < 20) && (wc == 0);
        bf16_t* Ot = O + ((size_t)((u.pm >> 3) * 6 + (pn >> 2)) * 8 + (pn & 3) * 2) * (2048 * 128) + wc * 32 + 8 * fq;
        const bool kacc = (pn >= 16 && pn < 20);
        float rf[2][4];
#pragma unroll
        for (int ai = 0; ai < 2; ++ai)
#pragma unroll
            for (int m = 0; m < 4; ++m) rf[ai][m] = rinv[row0 + ai * HALF + m * 16] * pre;
        f32x4 ks[2][2] = {{{0.f, 0.f, 0.f, 0.f}, {0.f, 0.f, 0.f, 0.f}}, {{0.f, 0.f, 0.f, 0.f}, {0.f, 0.f, 0.f, 0.f}}};
#pragma unroll
        for (int ai = 0; ai < 2; ++ai)
#pragma unroll
            for (int m = 0; m < 4; ++m) { const int row = row0 + ai * HALF + m * 16; bf16_t* rowp = Ot + (size_t)(row & 2047) * 128;
                f32x4 c0 = {1.f, 1.f, 1.f, 1.f}, c1 = c0, s0 = {0.f, 0.f, 0.f, 0.f}, s1 = s0;
                if (rot) { const float* cr = cs + (size_t)row * 32 + 8 * (fq & 1); c0 = *(const f32x4*)cr; c1 = *(const f32x4*)(cr + 4); s0 = *(const f32x4*)(cr + 16); s1 = *(const f32x4*)(cr + 20);
                    if (fq < 2) { s0 = -s0; s1 = -s1; } }
#pragma unroll
                for (int bj = 0; bj < 2; ++bj) { f32x4 v0 = acc[ai][bj][m][0] * rf[ai][m], v1 = acc[ai][bj][m][1] * rf[ai][m];
                    if (rot) { f32x4 p0, p1;
#pragma unroll
                        for (int j = 0; j < 4; ++j) { p0[j] = __shfl_xor(v0[j], 32); p1[j] = __shfl_xor(v1[j], 32); }
                        v0 = v0 * c0 + p0 * s0; v1 = v1 * c1 + p1 * s1; }
                    if (kacc) { ks[bj][0] += v0; ks[bj][1] += v1; }
                    v0 = v0 * sc; v1 = v1 * sc; u32x4 w; w.x = cvt_pk_bf16(v0[0], v0[1]); w.y = cvt_pk_bf16(v0[2], v0[3]); w.z = cvt_pk_bf16(v1[0], v1[1]); w.w = cvt_pk_bf16(v1[2], v1[3]);
                    store16(rowp + (size_t)bj * (2048 * 128), w); } }
        if (kacc) {
            float* kp = ksum + (size_t)(((u.pm >> 3) * 8 + (pn - 16) * 2) * 8 + (u.pm & 7)) * 128 + wc * 32 + 8 * fq;
#pragma unroll
            for (int bj = 0; bj < 2; ++bj)
#pragma unroll
                for (int n = 0; n < 2; ++n)
#pragma unroll
                    for (int j = 0; j < 4; ++j) { float s = ks[bj][n][j]; s += __shfl_xor(s, 1); s += __shfl_xor(s, 2); s += __shfl_xor(s, 4); s += __shfl_xor(s, 8);
                        if (fr == 0) atomicAdd(kp + bj * 1024 + n * 4 + j, s); }
        }
    }
};
__device__ __forceinline__ unsigned pk4_fp8(float a, float b, float c, float d) {
    a = __builtin_amdgcn_fmed3f(a, -448.f, 448.f); b = __builtin_amdgcn_fmed3f(b, -448.f, 448.f); c = __builtin_amdgcn_fmed3f(c, -448.f, 448.f); d = __builtin_amdgcn_fmed3f(d, -448.f, 448.f);
    int p = __builtin_amdgcn_cvt_pk_fp8_f32(a, b, 0, false); p = __builtin_amdgcn_cvt_pk_fp8_f32(c, d, p, true); return (unsigned)p; }
struct EpiRes {
    static constexpr bool PERM = false, AFTER_DRAIN = false;
    const float* base; float* out; bf16_t* xb; float* ssq; unsigned char* x8; float s8; float ascale;
    __device__ __forceinline__ void operator()(const f32x4 (&acc)[2][2][4][2], const Unit& u, int wr, int wc, int fr, int fq) const {
        const int row0 = u.pm * BM + wr * 64 + fr, col0 = u.pn * BM + wc * 32 + 4 * fq;
#pragma unroll
        for (int ai = 0; ai < 2; ++ai)
#pragma unroll
            for (int m = 0; m < 4; ++m) { const int row = row0 + ai * HALF + m * 16; const size_t off = (size_t)row * LDX + col0; float s = 0.f;
#pragma unroll
                for (int bj = 0; bj < 2; ++bj)
#pragma unroll
                    for (int n = 0; n < 2; ++n) { const f32x4 v = *(const f32x4*)(base + off + bj * HALF + n * 16) + acc[ai][bj][m][n] * ascale;
                        *(f32x4*)(out + off + bj * HALF + n * 16) = v; s += (v[0] * v[0] + v[1] * v[1]) + (v[2] * v[2] + v[3] * v[3]);
                        if (xb) { u32x2 w; w.x = cvt_pk_bf16(v[0], v[1]); w.y = cvt_pk_bf16(v[2], v[3]); *(u32x2*)(xb + off + bj * HALF + n * 16) = w; }
                        if (x8) { *(unsigned*)(x8 + off + bj * HALF + n * 16) = pk4_fp8(v[0] * s8, v[1] * s8, v[2] * s8, v[3] * s8); } }
                if (ssq) { s += __shfl_xor(s, 16); s += __shfl_xor(s, 32); if (fq == 0) atomicAdd(ssq + row, s); }
                asm volatile("" ::: "memory"); }
    }
};
template <bool BASE_F32> struct EpiResB {
    static constexpr bool PERM = true, AFTER_DRAIN = false;
    const void* base; bf16_t* xo; float* ssq; unsigned char* x8; float s8; float ascale;
    __device__ __forceinline__ void operator()(const f32x4 (&acc)[2][2][4][2], const Unit& u, int wr, int wc, int fr, int fq) const {
        const int row0 = u.pm * BM + wr * 64 + fr, col0 = u.pn * BM + wc * 32 + 8 * fq;
#pragma unroll
        for (int ai = 0; ai < 2; ++ai)
#pragma unroll
            for (int m = 0; m < 4; ++m) { const int row = row0 + ai * HALF + m * 16; const size_t off = (size_t)row * LDX + col0; float s = 0.f;
#pragma unroll
                for (int bj = 0; bj < 2; ++bj) { f32x4 b0, b1;
                    if (BASE_F32) { const float* bp = (const float*)base + off + bj * HALF; b0 = *(const f32x4*)bp; b1 = *(const f32x4*)(bp + 4); }
                    else { const u32x4 w = *(const u32x4*)((const bf16_t*)base + off + bj * HALF);
                        b0 = (f32x4){__uint_as_float(w.x << 16), __uint_as_float(w.x & 0xffff0000u), __uint_as_float(w.y << 16), __uint_as_float(w.y & 0xffff0000u)};
                        b1 = (f32x4){__uint_as_float(w.z << 16), __uint_as_float(w.z & 0xffff0000u), __uint_as_float(w.w << 16), __uint_as_float(w.w & 0xffff0000u)}; }
                    const f32x4 v0 = b0 + acc[ai][bj][m][0] * ascale, v1 = b1 + acc[ai][bj][m][1] * ascale;
                    s += ((v0[0] * v0[0] + v0[1] * v0[1]) + (v0[2] * v0[2] + v0[3] * v0[3])) + ((v1[0] * v1[0] + v1[1] * v1[1]) + (v1[2] * v1[2] + v1[3] * v1[3]));
                    if (xo) { u32x4 w; w.x = cvt_pk_bf16(v0[0], v0[1]); w.y = cvt_pk_bf16(v0[2], v0[3]); w.z = cvt_pk_bf16(v1[0], v1[1]); w.w = cvt_pk_bf16(v1[2], v1[3]); store16(xo + off + bj * HALF, w); }
                    if (x8) { u32x2 w8; w8.x = pk4_fp8(v0[0] * s8, v0[1] * s8, v0[2] * s8, v0[3] * s8); w8.y = pk4_fp8(v1[0] * s8, v1[1] * s8, v1[2] * s8, v1[3] * s8); *(u32x2*)(x8 + off + bj * HALF) = w8; } }
                if (ssq) { s += __shfl_xor(s, 16); s += __shfl_xor(s, 32); if (fq == 0) atomicAdd(ssq + row, s); }
                if (BASE_F32 ? (m & 1) : (m == 3)) asm volatile("" ::: "memory"); }
    }
};
struct EpiScale {
    static constexpr bool PERM = true, AFTER_DRAIN = false;
    bf16_t* O; int ldc; const float* ssq; float sc;
    __device__ __forceinline__ void operator()(const f32x4 (&acc)[2][2][4][2], const Unit& u, int wr, int wc, int fr, int fq) const {
        const int row0 = u.pm * BM + wr * 64 + fr, col0 = u.pn * BM + wc * 32 + 8 * fq;
        float sv[2][4];
#pragma unroll
        for (int ai = 0; ai < 2; ++ai)
#pragma unroll
            for (int m = 0; m < 4; ++m) sv[ai][m] = ssq ? ssq[row0 + ai * HALF + m * 16] : 0.f;
#pragma unroll
        for (int ai = 0; ai < 2; ++ai)
#pragma unroll
            for (int m = 0; m < 4; ++m) { const int row = row0 + ai * HALF + m * 16; bf16_t* rowp = O + (size_t)row * ldc + col0;
                const float f = ssq ? sc * __builtin_amdgcn_rsqf(sv[ai][m] * (1.0f / 2048.0f) + RMS_EPS) : sc;
#pragma unroll
                for (int bj = 0; bj < 2; ++bj) { const f32x4 v0 = acc[ai][bj][m][0] * f, v1 = acc[ai][bj][m][1] * f;
                    u32x4 w; w.x = cvt_pk_bf16(v0[0], v0[1]); w.y = cvt_pk_bf16(v0[2], v0[3]); w.z = cvt_pk_bf16(v1[0], v1[1]); w.w = cvt_pk_bf16(v1[2], v1[3]);
                    *(u32x4*)(rowp + bj * HALF) = w; } }
    }
};
struct EpiNull { static constexpr bool PERM = true, AFTER_DRAIN = false; float* sink;
    __device__ __forceinline__ void operator()(const f32x4 (&acc)[2][2][4][2], const Unit& u, int wr, int wc, int fr, int fq) const {
#pragma unroll
        for (int ai = 0; ai < 2; ++ai)
#pragma unroll
            for (int bj = 0; bj < 2; ++bj)
#pragma unroll
                for (int m = 0; m < 4; ++m)
#pragma unroll
                    for (int n = 0; n < 2; ++n) asm volatile("" :: "v"(acc[ai][bj][m][n])); } };
struct EpiSwiGLU {
    static constexpr bool PERM = true, AFTER_DRAIN = false;
    bf16_t* O; const float* ssq; unsigned char* O8; float ascale, oscale;
    __device__ __forceinline__ void operator()(const f32x4 (&acc)[2][2][4][2], const Unit& u, int wr, int wc, int fr, int fq) const {
        const int row0 = u.pm * BM + wr * 64 + fr, col0 = u.pn * HALF + wc * 32 + 8 * fq;
        float sv[2][4];
#pragma unroll
        for (int ai = 0; ai < 2; ++ai)
#pragma unroll
            for (int m = 0; m < 4; ++m) sv[ai][m] = ssq[row0 + ai * HALF + m * 16];
#pragma unroll
        for (int ai = 0; ai < 2; ++ai)
#pragma unroll
            for (int m = 0; m < 4; ++m) { const int row = row0 + ai * HALF + m * 16; bf16_t* rowp = O + (size_t)row * 5632 + col0;
                const float f = ascale * __builtin_amdgcn_rsqf(sv[ai][m] * (1.0f / 2048.0f) + RMS_EPS);
                const float fneg = -1.4426950408889634f * f, f2o = f * f * (O8 ? oscale : 1.0f);
                float r[8];
#pragma unroll
                for (int n = 0; n < 2; ++n)
#pragma unroll
                    for (int j = 0; j < 4; ++j) { const float ag = acc[ai][0][m][n][j], au = acc[ai][1][m][n][j];
                        r[n * 4 + j] = (ag * au) * (f2o * __builtin_amdgcn_rcpf(1.0f + __builtin_amdgcn_exp2f(fneg * ag))); }
                if (O8) { u32x2 w8; w8.x = pk4_fp8(r[0], r[1], r[2], r[3]); w8.y = pk4_fp8(r[4], r[5], r[6], r[7]);
                    *(u32x2*)(O8 + (size_t)row * 5632 + col0) = w8; }
                else { u32x4 w; w.x = cvt_pk_bf16(r[0], r[1]); w.y = cvt_pk_bf16(r[2], r[3]); w.z = cvt_pk_bf16(r[4], r[5]); w.w = cvt_pk_bf16(r[6], r[7]);
                *(u32x4*)rowp = w; } }
    }
};
}
namespace att {
using bf16x8 = __attribute__((ext_vector_type(8))) short;
using s16x4  = __attribute__((ext_vector_type(4))) short;
using f32x16 = __attribute__((ext_vector_type(16))) float;
using f32x4  = __attribute__((ext_vector_type(4))) float;
using u32x4  = __attribute__((ext_vector_type(4))) unsigned;
typedef unsigned short bf16;
constexpr int D = 128, KVBLK = 64;
constexpr int SHM_V = KVBLK * D * 2, SHM_K = KVBLK * D * 2;
constexpr int OFF_Q = 2 * SHM_V + 2 * SHM_K, OFF_WS = 131072 + 1024, OFF_KM = OFF_WS + 2048, ATT_LDS = OFF_KM + 4096;
constexpr float THR = 8.f;
constexpr float SB_DONE = 7.8886e-31f;
#ifndef QREG_SOFTMAX
#define QREG_SOFTMAX 1
#endif
#ifndef PIPE_SOFTMAX
#define PIPE_SOFTMAX 0
#endif
#define KSWZ(row, colB) ((row) * 256 + ((colB) ^ (((row) & 7) << 4)))
#define SBAR() __builtin_amdgcn_sched_barrier(0)
__device__ __forceinline__ int crow(int r, int hi) { return (r & 3) + 8 * (r >> 2) + 4 * hi; }
__device__ __forceinline__ unsigned cvtpk(float lo, float hi) { unsigned r; asm volatile("v_cvt_pk_bf16_f32 %0, %1, %2" : "=v"(r) : "v"(lo), "v"(hi)); return r; }
__device__ __forceinline__ float xchg32(float x, int hi) { auto rr = __builtin_amdgcn_permlane32_swap(__float_as_uint(x), __float_as_uint(x), false, false); return __uint_as_float(hi ? rr[0] : rr[1]); }
typedef __attribute__((address_space(3))) const char* lds_cp;
template <int D0> __device__ __forceinline__ void qkt_part(f32x16& p0, f32x16& p1, const lds_cp (&ka)[2][4], int boff, const lds_cp (&qa)[2][4]) {
  const bf16x8 qf = *reinterpret_cast<const __attribute__((address_space(3))) bf16x8*>(qa[D0 >> 2][D0 & 3]);
  const bf16x8 b0 = *reinterpret_cast<const __attribute__((address_space(3))) bf16x8*>(ka[D0 >> 2][D0 & 3] + boff);
  const bf16x8 b1 = *reinterpret_cast<const __attribute__((address_space(3))) bf16x8*>(ka[D0 >> 2][D0 & 3] + boff + 8192);
  p0 = __builtin_amdgcn_mfma_f32_32x32x16_bf16(b0, qf, p0, 0, 0, 0);
  p1 = __builtin_amdgcn_mfma_f32_32x32x16_bf16(b1, qf, p1, 0, 0, 0);
}
template <int D0> __device__ __forceinline__ void qkt_part(f32x16& p0, f32x16& p1, const lds_cp (&ka)[2][4], int boff, const bf16x8 (&qg)[8]) {
  const bf16x8 b0 = *reinterpret_cast<const __attribute__((address_space(3))) bf16x8*>(ka[D0 >> 2][D0 & 3] + boff);
  const bf16x8 b1 = *reinterpret_cast<const __attribute__((address_space(3))) bf16x8*>(ka[D0 >> 2][D0 & 3] + boff + 8192);
  p0 = __builtin_amdgcn_mfma_f32_32x32x16_bf16(b0, qg[D0], p0, 0, 0, 0);
  p1 = __builtin_amdgcn_mfma_f32_32x32x16_bf16(b1, qg[D0], p1, 0, 0, 0);
}
#define KLD(G, A0, A1) do { A0 = *reinterpret_cast<const __attribute__((address_space(3))) bf16x8*>(ka[(G) >> 2][(G) & 3] + boff); A1 = *reinterpret_cast<const __attribute__((address_space(3))) bf16x8*>(ka[(G) >> 2][(G) & 3] + boff + 8192); } while (0)
#define KMM(G, A0, A1) do { p0 = __builtin_amdgcn_mfma_f32_32x32x16_bf16(A0, qg[G], p0, 0, 0, 0); p1 = __builtin_amdgcn_mfma_f32_32x32x16_bf16(A1, qg[G], p1, 0, 0, 0); } while (0)
__device__ __forceinline__ void qkt(f32x16& p0, f32x16& p1, const lds_cp (&ka)[2][4], int boff, const bf16x8 (&qg)[8], float bias = 0.f) {
#pragma unroll
  for (int r = 0; r < 16; ++r) { p0[r] = bias; p1[r] = bias; }
  bf16x8 a0, a1, b0, b1, c0, c1, d0, d1;
  KLD(0, a0, a1); KLD(1, b0, b1); KLD(2, c0, c1); KLD(3, d0, d1); SBAR();
  KMM(0, a0, a1); SBAR(); KLD(4, a0, a1); SBAR();
  KMM(1, b0, b1); SBAR(); KLD(5, b0, b1); SBAR();
  KMM(2, c0, c1); SBAR(); KLD(6, c0, c1); SBAR();
  KMM(3, d0, d1); SBAR(); KLD(7, d0, d1); SBAR();
  KMM(4, a0, a1); KMM(5, b0, b1); KMM(6, c0, c1); KMM(7, d0, d1);
}
#undef KLD
#undef KMM
__device__ __forceinline__ void qkt(f32x16& p0, f32x16& p1, const lds_cp (&ka)[2][4], int boff, const lds_cp (&qr)[2][4], float bias = 0.f) {
#pragma unroll
  for (int r = 0; r < 16; ++r) { p0[r] = bias; p1[r] = bias; }
  qkt_part<0>(p0, p1, ka, boff, qr); qkt_part<1>(p0, p1, ka, boff, qr); qkt_part<2>(p0, p1, ka, boff, qr); qkt_part<3>(p0, p1, ka, boff, qr);
  qkt_part<4>(p0, p1, ka, boff, qr); qkt_part<5>(p0, p1, ka, boff, qr); qkt_part<6>(p0, p1, ka, boff, qr); qkt_part<7>(p0, p1, ka, boff, qr);
}
__device__ __forceinline__ int v_st(int k, int c) { const int kk = (k & ~0xC) | ((k & 4) << 1) | ((k & 8) >> 1); return ((kk >> 3) * 4 + (c >> 5)) * 512 + ((kk & 7) * 32 + (c & 31)) * 2; }
__device__ __forceinline__ int v_rd_base(int lane) { return ((lane & 3) << 3) | (((lane >> 2) & 3) << 6) | (((lane >> 4) & 1) << 5) | (((lane >> 5) & 1) << 8); }
constexpr int v_rd_off(int d0, int ks, int half) { return d0 * 512 + ks * 4096 + half * 2048; }
template <int OFF> __device__ __forceinline__ s16x4 tr_read(int vb) { s16x4 r; asm volatile("ds_read_b64_tr_b16 %0, %1 offset:%2" : "=&v"(r) : "v"(vb), "i"(OFF) : "memory"); return r; }
struct VFrag { s16x4 l0, h0, l1, h1, l2, h2, l3, h3; };
template <int D0> __device__ __forceinline__ void v_read(VFrag& f, int vb) {
  f.l0 = tr_read<v_rd_off(D0, 0, 0)>(vb); f.h0 = tr_read<v_rd_off(D0, 0, 1)>(vb); f.l1 = tr_read<v_rd_off(D0, 1, 0)>(vb); f.h1 = tr_read<v_rd_off(D0, 1, 1)>(vb);
  f.l2 = tr_read<v_rd_off(D0, 2, 0)>(vb); f.h2 = tr_read<v_rd_off(D0, 2, 1)>(vb); f.l3 = tr_read<v_rd_off(D0, 3, 0)>(vb); f.h3 = tr_read<v_rd_off(D0, 3, 1)>(vb);
}
__device__ __forceinline__ void pv_mma(f32x16& od, const VFrag& f, bf16x8 pa0, bf16x8 pa1, bf16x8 pa2, bf16x8 pa3) {
#define PK(L, H) (bf16x8){L[0], L[1], L[2], L[3], H[0], H[1], H[2], H[3]}
  od = __builtin_amdgcn_mfma_f32_32x32x16_bf16(pa0, PK(f.l0, f.h0), od, 0, 0, 0);
  od = __builtin_amdgcn_mfma_f32_32x32x16_bf16(pa1, PK(f.l1, f.h1), od, 0, 0, 0);
  od = __builtin_amdgcn_mfma_f32_32x32x16_bf16(pa2, PK(f.l2, f.h2), od, 0, 0, 0);
  od = __builtin_amdgcn_mfma_f32_32x32x16_bf16(pa3, PK(f.l3, f.h3), od, 0, 0, 0);
#undef PK
}
__device__ __forceinline__ void pv_d0(f32x16* o, int vb, bf16x8 pa0, bf16x8 pa1, bf16x8 pa2, bf16x8 pa3) {
  VFrag fa, fb;
  v_read<0>(fa, vb);
  v_read<1>(fb, vb); asm volatile("s_waitcnt lgkmcnt(8)" ::: "memory"); SBAR(); pv_mma(o[0], fa, pa0, pa1, pa2, pa3); SBAR();
  v_read<2>(fa, vb); asm volatile("s_waitcnt lgkmcnt(8)" ::: "memory"); SBAR(); pv_mma(o[1], fb, pa0, pa1, pa2, pa3); SBAR();
  v_read<3>(fb, vb); asm volatile("s_waitcnt lgkmcnt(8)" ::: "memory"); SBAR(); pv_mma(o[2], fa, pa0, pa1, pa2, pa3); SBAR();
  asm volatile("s_waitcnt lgkmcnt(0)" ::: "memory"); SBAR(); pv_mma(o[3], fb, pa0, pa1, pa2, pa3);
}
__device__ __forceinline__ void pack_p(const f32x16& p0, const f32x16& p1, bf16x8& pa0, bf16x8& pa1, bf16x8& pa2, bf16x8& pa3) {
#define PK4(P, BASE, OUT) do { unsigned a0 = cvtpk(P[BASE + 0], P[BASE + 1]), a1 = cvtpk(P[BASE + 2], P[BASE + 3]);   \
    unsigned b0 = cvtpk(P[BASE + 4], P[BASE + 5]), b1 = cvtpk(P[BASE + 6], P[BASE + 7]);                              \
    auto r0 = __builtin_amdgcn_permlane32_swap(a0, b0, false, false); auto r1 = __builtin_amdgcn_permlane32_swap(a1, b1, false, false); \
    u32x4 w = {r0[0], r1[0], r0[1], r1[1]}; OUT = *reinterpret_cast<bf16x8*>(&w); } while (0)
  PK4(p0, 0, pa0); PK4(p0, 8, pa1); PK4(p1, 0, pa2); PK4(p1, 8, pa3);
#undef PK4
}
__device__ __forceinline__ void softmax_tile(f32x16& p0, f32x16& p1, float& m_reg, float& l_reg, float& alpha) {
  float pmax = p0[0];
#pragma unroll
  for (int r = 1; r < 16; ++r) pmax = fmaxf(pmax, p0[r]);
#pragma unroll
  for (int r = 0; r < 16; ++r) pmax = fmaxf(pmax, p1[r]);
  pmax = fmaxf(pmax, xchg32(pmax, (int)(threadIdx.x >> 5) & 1));
  if (__all(pmax - m_reg <= THR)) { alpha = 1.f; }
  else { const float mn = fmaxf(m_reg, pmax); alpha = __builtin_amdgcn_exp2f(m_reg - mn); m_reg = mn; }
  float ps = 0.f;
#pragma unroll
  for (int r = 0; r < 16; ++r) { p0[r] = __builtin_amdgcn_exp2f(p0[r] - m_reg); ps += p0[r]; }
#pragma unroll
  for (int r = 0; r < 16; ++r) { p1[r] = __builtin_amdgcn_exp2f(p1[r] - m_reg); ps += p1[r]; }
  ps += xchg32(ps, (int)(threadIdx.x >> 5) & 1);
  l_reg = l_reg * alpha + ps;
}
template <bool BAND, int I> __device__ __forceinline__ float sb_group(f32x16& P, int kb, int qrel, int hi) {
  float run = 1.f;
#pragma unroll
  for (int e = 3; e >= 0; --e) { const int r = 4 * I + e; float rr = __builtin_amdgcn_rcpf(1.0f + __builtin_amdgcn_exp2f(P[r]));
    if (BAND) rr = (kb + crow(r, hi) < qrel) ? rr : 1.f;
    P[r] = (1.0f - rr) * run; run *= rr; }
  return run;
}
__device__ __forceinline__ void sb_combine(f32x16& p0, f32x16& p1, float (&gs)[8], float& carry, int hi) {
  float acc = 1.f;
#pragma unroll
  for (int i = 7; i >= 0; --i) { const float so_i = acc; acc *= gs[i]; const float x = hi ? acc : so_i; gs[i] = carry * so_i * xchg32(x, hi); }
  carry *= acc * xchg32(acc, hi);
#pragma unroll
  for (int i = 0; i < 4; ++i)
#pragma unroll
    for (int e = 0; e < 4; ++e) { p0[4 * i + e] *= gs[i]; p1[4 * i + e] *= gs[4 + i]; }
}
template <bool BAND>
__device__ __forceinline__ void sb_tile(f32x16& p0, f32x16& p1, float& carry, int kb, int qrel, int hi) {
  float gs[8];
  gs[0] = sb_group<BAND, 0>(p0, kb, qrel, hi); SBAR(); gs[1] = sb_group<BAND, 1>(p0, kb, qrel, hi); SBAR(); gs[2] = sb_group<BAND, 2>(p0, kb, qrel, hi); SBAR(); gs[3] = sb_group<BAND, 3>(p0, kb, qrel, hi); SBAR();
  gs[4] = sb_group<BAND, 0>(p1, kb + 32, qrel, hi); SBAR(); gs[5] = sb_group<BAND, 1>(p1, kb + 32, qrel, hi); SBAR(); gs[6] = sb_group<BAND, 2>(p1, kb + 32, qrel, hi); SBAR(); gs[7] = sb_group<BAND, 3>(p1, kb + 32, qrel, hi); SBAR();
  sb_combine(p0, p1, gs, carry, hi);
}

template <int MODE, bool OUT8 = false>
__device__ __forceinline__ void attn_unit(const bf16* __restrict__ Qb_or_hb, const bf16* __restrict__ Kh_in, const bf16* __restrict__ Vh_in, bf16* __restrict__ Ob,
                                          const float* __restrict__ gain, const float* __restrict__ kmean, int qb, int nkeys, char* lds, float s8 = 1.f,
                                          bool preissued = false, const bf16* __restrict__ nhb = nullptr, int nqb = 0, int nt0 = 0, int nt1 = -1) {
  constexpr int ldq = (MODE == 0) ? 512 : 128, ldk = (MODE == 0) ? 1024 : 128, ldo = (MODE == 0) ? 512 : 2048;
  constexpr long HSZ_ = 2048L * 128L;
  const bf16* __restrict__ Qb = (MODE == 0) ? Qb_or_hb : Qb_or_hb + (long)qb * (256 * 128);
  const bf16* __restrict__ Kh = (MODE == 0) ? Kh_in : Qb_or_hb + 8 * HSZ_;
  const bf16* __restrict__ Vh = (MODE == 0) ? Vh_in : Qb_or_hb + 16 * HSZ_;
  int tid_ = threadIdx.x; asm volatile("" : "+v"(tid_));
  const int tid = tid_, wid = __builtin_amdgcn_readfirstlane(tid >> 6), lane = tid & 63, r32 = lane & 31, hi = lane >> 5;
  char* V_lds = lds; char* K_lds = lds + 2 * SHM_V;
  float* ws = (float*)(lds + OFF_WS) + wid * 64; float* li_l = ws; float* al_l = ws + 32;
  float* km_l = (float*)(lds + OFF_KM);
  int* flg = (int*)(lds + OFF_KM);
  const int NT = (MODE == 0) ? nkeys / KVBLK : 4 * (qb + 1);
  const int qrel = wid * 32 + r32;
  float m_reg = -1e30f, l_reg = 0.f, carry = 1.f; f32x16 o[4] = {};
  const int vb0 = (int)(uintptr_t)V_lds + v_rd_base(lane);
  lds_cp ka[2][4];
#pragma unroll
  for (int y = 0; y < 2; ++y)
#pragma unroll
    for (int x = 0; x < 4; ++x) ka[y][x] = (lds_cp)(__attribute__((address_space(3))) char*)K_lds + r32 * 256 + 128 * (y ^ ((r32 >> 3) & 1)) + 32 * (x ^ ((r32 >> 1) & 3)) + 16 * (hi ^ (r32 & 1));
  lds_cp qr[2][4];
#pragma unroll
  for (int y = 0; y < 2; ++y)
#pragma unroll
    for (int x = 0; x < 4; ++x) qr[y][x] = ka[y][x] + (OFF_Q - 2 * SHM_V) + wid * 8192;
  long ksrc[2], vsrc[2];
#pragma unroll
  for (int i = 0; i < 2; ++i) { const int piece = wid + 8 * i;
    { const int row = piece * 4 + (lane >> 4), c = (lane & 15) ^ (row & 15); ksrc[i] = (long)row * ldk + c * 8; }
    { const int sub = piece * 2 + (lane >> 5), kk = (sub >> 2) * 8 + ((lane & 31) >> 2), k = (kk & ~0xC) | ((kk & 4) << 1) | ((kk & 8) >> 1), c = (sub & 3) * 32 + (lane & 3) * 8; vsrc[i] = (long)k * ldk + c; } }
  typedef __attribute__((address_space(3))) unsigned lds_u32;
  lds_u32* kdst = (lds_u32*)(__attribute__((address_space(3))) char*)(K_lds) + wid * 256; lds_u32* vdst = (lds_u32*)(__attribute__((address_space(3))) char*)(V_lds) + wid * 256;
#define TILE(it) ((MODE == 2) ? (NT - 1 - (it)) : (it))
#define DMA_K(k0, b) do { _Pragma("unroll") for (int i_ = 0; i_ < 2; ++i_) __builtin_amdgcn_global_load_lds((const unsigned*)(Kh + (long)(k0) * ldk + ksrc[i_]), kdst + (b) * (SHM_K / 4) + i_ * 2048, 16, 0, 0); } while (0)
#define DMA_V(k0, b) do { _Pragma("unroll") for (int i_ = 0; i_ < 2; ++i_) __builtin_amdgcn_global_load_lds((const unsigned*)(Vh + (long)(k0) * ldk + vsrc[i_]), vdst + (b) * (SHM_V / 4) + i_ * 2048, 16, 0, 0); } while (0)
#define SDRAIN() asm volatile("s_waitcnt vmcnt(0)" ::: "memory")
#define KSLOT(i_) ((i_) == 2 ? (OFF_Q - 2 * SHM_V) : (i_) * SHM_K)
#define VSLOT(i_) ((i_) == 2 ? (OFF_Q + SHM_K) : (i_) * SHM_V)
#define DMA_K3(k0, so) do { _Pragma("unroll") for (int i_ = 0; i_ < 2; ++i_) __builtin_amdgcn_global_load_lds((const unsigned*)(Kh + (long)(k0) * ldk + ksrc[i_]), kdst + (so) / 4 + i_ * 2048, 16, 0, 0); } while (0)
#define DMA_V3(k0, so) do { _Pragma("unroll") for (int i_ = 0; i_ < 2; ++i_) __builtin_amdgcn_global_load_lds((const unsigned*)(Vh + (long)(k0) * ldk + vsrc[i_]), vdst + (so) / 4 + i_ * 2048, 16, 0, 0); } while (0)
  lds_u32* qdst = (lds_u32*)(__attribute__((address_space(3))) char*)(lds + OFF_Q) + wid * 2048;
#define ISSUE_UNIT(QB_, KH_, VH_, T0_, T1_) do { \
    _Pragma("unroll") for (int i = 0; i < 8; ++i) { const int row = 4 * i + (lane >> 4), c = (lane & 15) ^ (row & 15); \
      __builtin_amdgcn_global_load_lds((const unsigned*)((QB_) + (long)(wid * 32 + row) * ldq + c * 8), qdst + i * 256, 16, 0, 0); } \
    _Pragma("unroll") for (int i_ = 0; i_ < 2; ++i_) { \
      __builtin_amdgcn_global_load_lds((const unsigned*)((KH_) + (long)((T0_) * KVBLK) * ldk + ksrc[i_]), kdst + i_ * 2048, 16, 0, 0); \
      __builtin_amdgcn_global_load_lds((const unsigned*)((VH_) + (long)((T0_) * KVBLK) * ldk + vsrc[i_]), vdst + i_ * 2048, 16, 0, 0); } \
    if ((T1_) >= 0) { _Pragma("unroll") for (int i_ = 0; i_ < 2; ++i_) __builtin_amdgcn_global_load_lds((const unsigned*)((KH_) + (long)((T1_) * KVBLK) * ldk + ksrc[i_]), kdst + (SHM_K / 4) + i_ * 2048, 16, 0, 0); } } while (0)
  if (!preissued) ISSUE_UNIT(Qb, Kh, Vh, TILE(0), ((MODE == 2 || PIPE_SOFTMAX) ? TILE(1) : -1));
  constexpr bool RING3 = (MODE != 2) && QREG_SOFTMAX && !PIPE_SOFTMAX;
  unsigned selmask = 0u;
  float gv[4] = {1.f, 1.f, 1.f, 1.f};
  if (gain) {
#pragma unroll
    for (int d0 = 0; d0 < 4; ++d0) gv[d0] = gain[d0 * 32 + r32]; }
  if (MODE == 1) { if (tid < 256) *(f32x4*)(km_l + tid * 4) = *(const f32x4*)(kmean + tid * 4); }
  SDRAIN();
  __syncthreads();
  if (MODE == 1) {
    float g[8];
#pragma unroll
    for (int n = 0; n < 8; ++n) g[n] = 0.f;
    { const int rh = (r32 >> 1) & 3, r3 = (r32 >> 3) & 1;
      const lds_cp qbase = qr[0][0] - 32 * rh - 128 * r3;
#pragma unroll 1
      for (int d0 = 0; d0 < 8; ++d0) {
        const bf16x8 qf = *reinterpret_cast<const __attribute__((address_space(3))) bf16x8*>(qbase + 32 * ((d0 & 3) ^ rh) + 128 * ((d0 >> 2) ^ r3));
        float q[8];
#pragma unroll
        for (int j = 0; j < 8; ++j) q[j] = __uint_as_float(((unsigned)(unsigned short)qf[j]) << 16);
        const float* kmp = km_l + d0 * 16 + hi * 8;
#pragma unroll
        for (int n = 0; n < 7; ++n) { const f32x4 k0v = *(const f32x4*)(kmp + n * 128), k1v = *(const f32x4*)(kmp + n * 128 + 4);
          g[n] += (q[0] * k0v[0] + q[1] * k0v[1]) + (q[2] * k0v[2] + q[3] * k0v[3]) + (q[4] * k1v[0] + q[5] * k1v[1]) + (q[6] * k1v[2] + q[7] * k1v[3]); }
      } }
#pragma unroll
    for (int n = 0; n < 7; ++n) { g[n] += xchg32(g[n], hi); if (n >= qb) g[n] = -INFINITY; }
    g[7] = -INFINITY;
#pragma unroll
    for (int n = 0; n < 7; ++n) { int cnt = 0;
#pragma unroll
      for (int mI = 0; mI < 7; ++mI) { if (mI != n) cnt += (g[mI] > g[n] || (g[mI] == g[n] && mI < n)) ? 1 : 0; }
      if (n < qb && cnt < 3) selmask |= (1u << n); }
  }
  bf16x8 qg[8];
  if (QREG_SOFTMAX && MODE != 2) {
#pragma unroll
    for (int d0 = 0; d0 < 8; ++d0) qg[d0] = *reinterpret_cast<const __attribute__((address_space(3))) bf16x8*>(qr[d0 >> 2][d0 & 3]); }
  int kc = KSLOT(0), kn = KSLOT(1), kn2 = KSLOT(2), vc = VSLOT(0), vn = VSLOT(1), vn2 = VSLOT(2);
  if (RING3) { DMA_K3(TILE(1) * KVBLK, kn); DMA_V3(TILE(1) * KVBLK, vn);
    asm volatile("s_waitcnt lgkmcnt(0)" ::: "memory"); __syncthreads(); }
  f32x16 pA0, pA1, pB0, pB1; bf16x8 pa0, pa1, pa2, pa3;
  if (MODE == 2 || PIPE_SOFTMAX) { float bias0 = 0.f; if (MODE == 1) { if (NT > 4) bias0 = (selmask & 1u) ? 0.f : -INFINITY; }
    qkt(pA0, pA1, ka, 0, qr, bias0);
    __syncthreads(); }
  int it = 0;
#define JB(i_) ((MODE == 2) ? (3 - (i_)) : ((i_) - (NT - 4)))
#define STEP(A0, A1, B0, B1, BAND, HASNEXT) do { \
    if (it + 2 < NT) DMA_K(TILE(it + 2) * KVBLK, it & 1); \
    if (it + 1 < NT) DMA_V(TILE(it + 1) * KVBLK, (it + 1) & 1); \
    bool skip = false; const int jb = JB(it); \
    if (BAND) { if (MODE == 1) skip = (64 * jb > wid * 32 + 31); if (MODE == 2) skip = (64 * jb >= wid * 32 + 31); } \
    if (MODE == 2) skip = skip || __all(carry < SB_DONE);        \
    if (HASNEXT) { float bias_ = 0.f; if (MODE == 1) { if (it + 1 < NT - 4) bias_ = ((selmask >> ((it + 1) >> 2)) & 1u) ? 0.f : -INFINITY; } \
      qkt(B0, B1, ka, ((it + 1) & 1) * SHM_K, qr, bias_); } \
    if (!skip) { \
      if (MODE == 2) { sb_tile<(BAND) != 0>(A0, A1, carry, 64 * jb, qrel, hi); } \
      else { \
        if (MODE == 1 && (BAND)) { _Pragma("unroll") for (int r = 0; r < 16; ++r) { const int kr = 64 * jb + crow(r, hi); if (kr > qrel) A0[r] = -INFINITY; if (kr + 32 > qrel) A1[r] = -INFINITY; } } \
        float alpha; softmax_tile(A0, A1, m_reg, l_reg, alpha); \
        if (__any(alpha < 1.f)) { if (hi == 0) al_l[r32] = alpha; asm volatile("s_waitcnt lgkmcnt(0)" ::: "memory"); \
          _Pragma("unroll") for (int d = 0; d < 4; ++d) _Pragma("unroll") for (int r = 0; r < 16; ++r) o[d][r] *= al_l[crow(r, hi)]; } \
      } \
      pack_p(A0, A1, pa0, pa1, pa2, pa3); \
      pv_d0(o, vb0 + (it & 1) * SHM_V, pa0, pa1, pa2, pa3); \
    } \
    SDRAIN(); __syncthreads(); ++it; } while (0)
#define SB_LD(G, F) do { F##q = *reinterpret_cast<const __attribute__((address_space(3))) bf16x8*>(qr[(G) >> 2][(G) & 3]); \
      F##0 = *reinterpret_cast<const __attribute__((address_space(3))) bf16x8*>(ka[(G) >> 2][(G) & 3] + kb_); F##1 = *reinterpret_cast<const __attribute__((address_space(3))) bf16x8*>(ka[(G) >> 2][(G) & 3] + kb_ + 8192); } while (0)
#define SB_PART(G, P, I, B0, B1, FC, FN) do { if ((G) < 7) SB_LD(((G) + 1) & 7, FN);              \
      B0 = __builtin_amdgcn_mfma_f32_32x32x16_bf16(FC##0, FC##q, B0, 0, 0, 0); B1 = __builtin_amdgcn_mfma_f32_32x32x16_bf16(FC##1, FC##q, B1, 0, 0, 0); \
      gs_[G] = sb_group<false, I>(P, 0, 0, hi); SBAR(); } while (0)
#define STEP_SB(A0, A1, B0, B1) do { \
    if (it + 2 < NT) DMA_K(TILE(it + 2) * KVBLK, it & 1); \
    DMA_V(TILE(it + 1) * KVBLK, (it + 1) & 1); \
    float gs_[8]; \
    _Pragma("unroll") for (int r = 0; r < 16; ++r) { B0[r] = 0.f; B1[r] = 0.f; } \
    const int kb_ = ((it + 1) & 1) * SHM_K; bf16x8 fx0, fx1, fxq, fy0, fy1, fyq; SB_LD(0, fx); SBAR(); \
    SB_PART(0, A0, 0, B0, B1, fx, fy); SB_PART(1, A0, 1, B0, B1, fy, fx); SB_PART(2, A0, 2, B0, B1, fx, fy); SB_PART(3, A0, 3, B0, B1, fy, fx); \
    SB_PART(4, A1, 0, B0, B1, fx, fy); SB_PART(5, A1, 1, B0, B1, fy, fx); SB_PART(6, A1, 2, B0, B1, fx, fy); SB_PART(7, A1, 3, B0, B1, fy, fx); \
    sb_combine(A0, A1, gs_, carry, hi); \
    { const bool dn_ = __all(carry < SB_DONE); if (lane == 0) flg[(it & 1) * 8 + wid] = dn_ ? 1 : 0; } \
    pack_p(A0, A1, pa0, pa1, pa2, pa3); \
    pv_d0(o, vb0 + (it & 1) * SHM_V, pa0, pa1, pa2, pa3); \
    SDRAIN(); __syncthreads(); \
    { const int* f_ = flg + (it & 1) * 8; stop = (f_[0] + f_[1] + f_[2] + f_[3] + f_[4] + f_[5] + f_[6] + f_[7]) == 8; } \
    ++it; } while (0)
#define SSTEP(BAND) do { \
    if (RING3) { if (it + 2 < NT) { DMA_K3(TILE(it + 2) * KVBLK, kn2); DMA_V3(TILE(it + 2) * KVBLK, vn2); } } \
    else if (it + 1 < NT) { DMA_K(TILE(it + 1) * KVBLK, (it + 1) & 1); DMA_V(TILE(it + 1) * KVBLK, (it + 1) & 1); } \
    bool skip = false; const int jb = JB(it); \
    if (BAND) skip = (64 * jb > wid * 32 + 31); \
    if (!skip) { \
      float bias_ = 0.f; if (MODE == 1 && !(BAND)) bias_ = ((selmask >> (it >> 2)) & 1u) ? 0.f : -INFINITY; \
      const int kb_ = RING3 ? kc : (it & 1) * SHM_K; \
      if (QREG_SOFTMAX) qkt(pA0, pA1, ka, kb_, qg, bias_); else qkt(pA0, pA1, ka, kb_, qr, bias_); \
      if (MODE == 1 && (BAND)) { _Pragma("unroll") for (int r = 0; r < 16; ++r) { const int kr = 64 * jb + crow(r, hi); if (kr > qrel) pA0[r] = -INFINITY; if (kr + 32 > qrel) pA1[r] = -INFINITY; } } \
      float alpha; softmax_tile(pA0, pA1, m_reg, l_reg, alpha); \
      if (__any(alpha < 1.f)) { if (hi == 0) al_l[r32] = alpha; asm volatile("s_waitcnt lgkmcnt(0)" ::: "memory"); \
        _Pragma("unroll") for (int d = 0; d < 4; ++d) _Pragma("unroll") for (int r = 0; r < 16; ++r) o[d][r] *= al_l[crow(r, hi)]; } \
      pack_p(pA0, pA1, pa0, pa1, pa2, pa3); \
      pv_d0(o, vb0 + (RING3 ? vc : (it & 1) * SHM_V), pa0, pa1, pa2, pa3); \
    } \
    if (RING3) { if (it + 2 < NT) asm volatile("s_waitcnt vmcnt(4)" ::: "memory"); else SDRAIN();        \
      { const int t_ = kc; kc = kn; kn = kn2; kn2 = t_; } { const int t_ = vc; vc = vn; vn = vn2; vn2 = t_; } } \
    else SDRAIN(); \
    if (RING3) { asm volatile("s_waitcnt lgkmcnt(0)" ::: "memory"); __builtin_amdgcn_s_barrier(); asm volatile("" ::: "memory"); }     \
    else __syncthreads(); \
    ++it; } while (0)
#define RESTART(BIASEXPR) do { qkt(pA0, pA1, ka, (it & 1) * SHM_K, qr, (BIASEXPR)); __syncthreads(); } while (0)
  if (MODE == 0) {
    if (PIPE_SOFTMAX) { STEP(pA0, pA1, pB0, pB1, 0, true); STEP(pB0, pB1, pA0, pA1, 0, true); STEP(pA0, pA1, pB0, pB1, 0, true); STEP(pB0, pB1, pA0, pA1, 0, false); }
    else { SSTEP(0); SSTEP(0); SSTEP(0); SSTEP(0); }
  } else if (MODE == 1) {
    if (PIPE_SOFTMAX) {
      if (NT > 4) { while (it < NT - 4) { STEP(pA0, pA1, pB0, pB1, 0, true); STEP(pB0, pB1, pA0, pA1, 0, (it + 1 < NT - 4)); }
        RESTART(0.f); }
      STEP(pA0, pA1, pB0, pB1, 1, true); STEP(pB0, pB1, pA0, pA1, 1, true); STEP(pA0, pA1, pB0, pB1, 1, true); STEP(pB0, pB1, pA0, pA1, 1, false);
    } else {
      while (it < NT - 4) SSTEP(0);
      SSTEP(1); SSTEP(1); SSTEP(1); SSTEP(1);
    }
  } else {
    STEP(pA0, pA1, pB0, pB1, 1, true); STEP(pB0, pB1, pA0, pA1, 1, true); STEP(pA0, pA1, pB0, pB1, 1, true); STEP(pB0, pB1, pA0, pA1, 1, false);
    if (NT > 4) {
      RESTART(0.f);
      bool stop = false;
      while (it + 2 < NT && !stop) { STEP_SB(pA0, pA1, pB0, pB1); STEP_SB(pB0, pB1, pA0, pA1); }
      if (!stop) { STEP_SB(pA0, pA1, pB0, pB1); STEP(pB0, pB1, pA0, pA1, 0, false); }
    }
  }
#undef RESTART
#undef STEP
#undef SSTEP
#undef STEP_SB
#undef SB_LD
#undef SB_PART
#undef JB
  if (OUT8) { if (nhb) ISSUE_UNIT(nhb + (long)nqb * (256 * 128), nhb + 8 * HSZ_, nhb + 16 * HSZ_, nt0, nt1); }
  float rli[16];
  if (MODE != 2) { if (hi == 0) li_l[r32] = l_reg; asm volatile("s_waitcnt lgkmcnt(0)" ::: "memory");
#pragma unroll
    for (int r = 0; r < 16; ++r) rli[r] = __builtin_amdgcn_rcpf(li_l[crow(r, hi)]); }
  else {
#pragma unroll
    for (int r = 0; r < 16; ++r) rli[r] = 1.f; }
  if (gain) {
#pragma unroll
    for (int r = 0; r < 16; ++r) { float s = 0.f;
#pragma unroll
      for (int d0 = 0; d0 < 4; ++d0) { o[d0][r] *= rli[r]; s += o[d0][r] * o[d0][r]; }
      s += __shfl_xor(s, 1); s += __shfl_xor(s, 2); s += __shfl_xor(s, 4); s += __shfl_xor(s, 8); s += __shfl_xor(s, 16);
      rli[r] = __builtin_amdgcn_rsqf(s * (1.0f / 128.0f) + 1e-6f); }
#pragma unroll
    for (int r = 0; r < 16; ++r)
#pragma unroll
      for (int d0 = 0; d0 < 4; ++d0) o[d0][r] *= gv[d0];
  }
  if (OUT8) {
#pragma unroll
    for (int r = 0; r < 16; ++r) { const float f = rli[r] * s8;
      const float v0 = __builtin_amdgcn_fmed3f(o[0][r] * f, -448.f, 448.f), v1 = __builtin_amdgcn_fmed3f(o[1][r] * f, -448.f, 448.f), v2 = __builtin_amdgcn_fmed3f(o[2][r] * f, -448.f, 448.f), v3 = __builtin_amdgcn_fmed3f(o[3][r] * f, -448.f, 448.f);
      int p = __builtin_amdgcn_cvt_pk_fp8_f32(v0, v1, 0, false); p = __builtin_amdgcn_cvt_pk_fp8_f32(v2, v3, p, true);
      *(unsigned*)((unsigned char*)Ob + (long)(wid * 32 + crow(r, hi)) * ldo + 4 * r32) = (unsigned)p; } }
  else { bf16* stg = (bf16*)lds + wid * 4096;
#pragma unroll
    for (int r = 0; r < 16; ++r) { const int orow = crow(r, hi);
#pragma unroll
      for (int d0 = 0; d0 < 4; ++d0) { const float v = o[d0][r] * rli[r]; unsigned u = __float_as_uint(v); u = (u + 0x7fffu + ((u >> 16) & 1u)) >> 16; stg[orow * 128 + d0 * 32 + r32] = (bf16)u; } }
    asm volatile("s_waitcnt lgkmcnt(0)" ::: "memory");
#pragma unroll
    for (int i = 0; i < 8; ++i) { const int row = i * 4 + (lane >> 4), ch = lane & 15; const u32x4 v = *(const u32x4*)(stg + row * 128 + ch * 8); *(u32x4*)(Ob + (long)(wid * 32 + row) * ldo + ch * 8) = v; } }
  __syncthreads();
#undef TILE
#undef ISSUE_UNIT
#undef DMA_K
#undef DMA_V
#undef DMA_K3
#undef DMA_V3
#undef KSLOT
#undef VSLOT
#undef SDRAIN
}
#undef KSWZ
#undef SBAR
}
#define GAS __attribute__((address_space(1)))
#define LAS __attribute__((address_space(3)))
typedef unsigned short bf16;
typedef unsigned v4u __attribute__((ext_vector_type(4)));
typedef float f32x4 __attribute__((ext_vector_type(4)));
#define LDS_WAIT() asm volatile("s_waitcnt lgkmcnt(0)" ::: "memory")
constexpr int NWAVES = 8;
constexpr int BATCH = 8, SEQ = 2048, DM = 2048, M = BATCH * SEQ, HD = 128, NH = 8;
constexpr int NQKV = 6144, FF = 5632, WX = 512, NMEM = 256, MMEM = BATCH * NMEM;
constexpr int QSB = 0, KSB = 1024, VSB = 2048, QMB = 3072, KMB = 4096, VMB = 5120;
constexpr float EPS = 1e-6f;
constexpr float QSCALE = 0.12751743082459868f;
constexpr size_t MiB = 1u << 20;
constexpr size_t WS_CTL = 0, CTL_ZERO_BYTES = 512 * 1024;
constexpr size_t WS_SSQ1 = 64 * 1024, WS_SSQ2 = 128 * 1024;
constexpr size_t WS_KSUM = 256 * 1024;
constexpr size_t WS_WIN = 1 * MiB, WS_WOUT = 25 * MiB, WS_WXQ = 33 * MiB, WS_WXKV = 35 * MiB, WS_WXO = 39 * MiB, WS_WGU = 41 * MiB, WS_WDN = 85 * MiB;
constexpr size_t WS_RA = 107 * MiB;
constexpr size_t WS_RB = 171 * MiB;
constexpr size_t WS_RC = 235 * MiB;
constexpr size_t WS_QX = 427 * MiB, WS_OX = 443 * MiB, WS_KVX = 459 * MiB, WS_MN = 463 * MiB, WS_KMEAN = 471 * MiB, WS_RINV0 = 471 * MiB  , WS_CS = 472 * MiB, WS_END = 474 * MiB;
constexpr int RING_BYTES = 131072, LDS_BYTES = 147456;
#ifndef FFN_FP8
#define FFN_FP8 1
#endif
#ifndef QK_FP8
#define QK_FP8 1
#endif
constexpr float S_X2 = 16.f, S_WGU = 32.f, S_ACT = 8.f, S_WDN = 64.f, S_XN = 16.f, S_WV = 32.f, S_WQK = 32.f, S_O = 16.f, S_WO = 32.f;
constexpr float S_OX = 16.f, S_WXO = 16.f;
#ifndef WXO_FP8
#define WXO_FP8 1
#endif
#ifndef WOUT_FP8
#define WOUT_FP8 1
#endif
constexpr size_t WS_WV8 = WS_WIN + 16 * MiB;

__device__ __forceinline__ float bf2f(unsigned short b) { return __uint_as_float((unsigned)b << 16); }
__device__ __forceinline__ unsigned f2bf(float f) { unsigned u = __builtin_bit_cast(unsigned, f); return (u + 0x7fffu + ((u >> 16) & 1u)) >> 16; }
__device__ __forceinline__ unsigned pk2(float lo, float hi) { return f2bf(lo) | (f2bf(hi) << 16); }
__device__ __forceinline__ float wave_sum(float v) {
#pragma unroll
    for (int o = 1; o < 64; o <<= 1) v += __shfl_xor(v, o);
    return v;
}
__device__ __forceinline__ float wave_max(float v) {
#pragma unroll
    for (int o = 1; o < 64; o <<= 1) v = fmaxf(v, __shfl_xor(v, o));
    return v;
}

typedef GAS unsigned gu32;
#define RLX_AGENT __ATOMIC_RELAXED, __HIP_MEMORY_SCOPE_AGENT
constexpr int CW_BAR = 4096;
constexpr int LDSCTL_OFF = RING_BYTES, MISC_OFF = LDSCTL_OFF + 320;
#define XB_TMO      128
#define XB_XCNT(j)  (256  + 64 * (j))
#define XB_XSUB(j)  (1280 + 64 * (j))
#define XB_XGEN(j)  (2304 + 64 * (j))
#define XB_TOP      3328
#define XB_TOPGEN   3392
#define XCD_BAR_WORDS 3456
#define XB_SPIN_CAP (1u << 18)

__device__ __forceinline__ unsigned xb_ld(unsigned* p)              { return __hip_atomic_load(p, __ATOMIC_RELAXED, __HIP_MEMORY_SCOPE_AGENT); }
__device__ __forceinline__ unsigned xb_add(unsigned* p, unsigned v) { return __hip_atomic_fetch_add(p, v, __ATOMIC_RELAXED, __HIP_MEMORY_SCOPE_AGENT); }
__device__ __forceinline__ unsigned xb_xcc_id() { return (unsigned)__builtin_amdgcn_s_getreg((3 << 11) | 20) & 0xFu; }
#define XB_SPIN(cond, bar) do { unsigned _sp = 0; while (cond) { __builtin_amdgcn_s_sleep(1); \
    if ((++_sp & 255u) == 0u) { if (xb_ld(&(bar)[XB_TMO])) break; if (_sp > XB_SPIN_CAP) { atomicAdd(&(bar)[XB_TMO], 1u); break; } } } } while (0)

struct XcdBarrier {
    unsigned* bar; unsigned x;
    volatile LAS unsigned* st;
};

__device__ __forceinline__ XcdBarrier xcd_barrier_post(unsigned* bar, volatile LAS unsigned* st) {
    XcdBarrier b; b.bar = bar; b.x = xb_xcc_id(); b.st = st;
    if (threadIdx.x == 0) (void)xb_add(&bar[XB_XCNT(b.x)], 1u);
    return b;
}
__device__ __forceinline__ void xcd_barrier_complete(unsigned* bar, unsigned x, unsigned& nloc, unsigned& nx) {
    const unsigned G = gridDim.x * gridDim.y * gridDim.z;
    unsigned sum, cnt, mine, sp = 0u;
    for (;;) {
        sum = 0u; cnt = 0u; mine = 0u;
#pragma unroll
        for (unsigned j = 0; j < 16; ++j) { const unsigned c = xb_ld(&bar[XB_XCNT(j)]); sum += c; cnt += (c > 0u) ? 1u : 0u; mine = (j == x) ? c : mine; }
        if (sum == G) break;
        __builtin_amdgcn_s_sleep(1);
        if ((++sp & 255u) == 0u) { if (xb_ld(&bar[XB_TMO])) break; if (sp > XB_SPIN_CAP) { atomicAdd(&bar[XB_TMO], 1u); break; } }
    }
    nloc = mine > 0u ? mine : 1u; nx = cnt > 0u ? cnt : 1u;
}

__device__ __forceinline__ void xcd_barrier(const XcdBarrier& b) {
    asm volatile("s_waitcnt vmcnt(0)" ::: "memory");
    __syncthreads();
    if (threadIdx.x == 0) {
        unsigned* bar = b.bar;
        __builtin_amdgcn_s_waitcnt(0);
        unsigned nloc = b.st[0], nx = b.st[1];
        if (nloc == 0u) { xcd_barrier_complete(bar, b.x, nloc, nx); b.st[0] = nloc; b.st[1] = nx; }
        const unsigned old = xb_add(&bar[XB_XSUB(b.x)], 1u);
        const unsigned gen = old / nloc;
        if (old + 1u == (gen + 1u) * nloc) {
            __builtin_amdgcn_fence(__ATOMIC_RELEASE, "agent");
            asm volatile("s_waitcnt vmcnt(0)" ::: "memory");
            const unsigned og = xb_add(&bar[XB_TOP], 1u);
            const unsigned tg = og / nx;
            if (og + 1u == (tg + 1u) * nx) xb_add(&bar[XB_TOPGEN], 1u);
            else XB_SPIN(xb_ld(&bar[XB_TOPGEN]) == tg, bar);
            __builtin_amdgcn_fence(__ATOMIC_ACQUIRE, "agent");
            xb_add(&bar[XB_XGEN(b.x)], 1u);
            asm volatile("s_waitcnt vmcnt(0)" ::: "memory");
        } else {
            XB_SPIN(xb_ld(&bar[XB_XGEN(b.x)]) == gen, bar);
            __builtin_amdgcn_fence(__ATOMIC_ACQUIRE, "agent");
            asm volatile("s_waitcnt vmcnt(0)" ::: "memory");
        }
    }
    __syncthreads();
}

struct Frame {
    LAS unsigned char* lds;
    int tid, lane, wave, vcu, G;
    const float *x, *mem; const int* pos;
    const float *g_mix, *w_in, *g_out_sb, *g_out_mb, *w_out, *g_xattn, *g_mem, *w_xq, *w_xkv, *w_xo, *g_ffn, *w_gu, *w_dn, *g_final;
    float* out; unsigned char* ws;
};

__device__ __forceinline__ void transpose_item(const float* W, int K, int N, bf16* WT, const float* gain, int inter, LAS float* scr, int item, int lane) {
    const int nblk = N / 32, kb = item / nblk, nb = item % nblk, k0 = 64 * kb, n0 = 32 * nb;
    int orow0 = n0;
    if (inter == 1) orow0 = (n0 < FF) ? (n0 / 128) * 256 + (n0 % 128) : ((n0 - FF) / 128) * 256 + 128 + ((n0 - FF) % 128);
    if (inter == 2) { const int reg = n0 / 1024, c = n0 % 1024; orow0 = (reg == 2) ? c : (reg == 5) ? 1024 + c : (reg < 2 ? reg : reg - 1) * 1024 + c; }
    float v[32];
#pragma unroll
    for (int i = 0; i < 32; ++i) v[i] = W[(size_t)(k0 + 2 * i + (lane >> 5)) * N + n0 + (lane & 31)];
#pragma unroll
    for (int i = 0; i < 32; ++i) { const int kk = 2 * i + (lane >> 5); float t = v[i]; if (gain) t *= gain[k0 + kk]; scr[kk * 33 + (lane & 31)] = t; }
    LDS_WAIT(); asm volatile("" ::: "memory");
    const int c = lane & 7;
#pragma unroll
    for (int j = 0; j < 4; ++j) { const int n = (lane >> 3) + 8 * j; const LAS float* s = scr + (8 * c) * 33 + n;
        v4u o; o.x = pk2(s[0 * 33], s[1 * 33]); o.y = pk2(s[2 * 33], s[3 * 33]); o.z = pk2(s[4 * 33], s[5 * 33]); o.w = pk2(s[6 * 33], s[7 * 33]);
        *(GAS v4u*)(WT + (size_t)(orow0 + n) * K + k0 + 8 * c) = o; }
    LDS_WAIT(); asm volatile("" ::: "memory");
}
__device__ __forceinline__ void transpose_item_fp8(const float* W, int K, int N, unsigned char* WT, const float* gain, int inter, float scale, LAS float* scr, int item, int lane, int kperm = 0) {
    const int nblk = N / 32, kb = item / nblk, nb = item % nblk, k0 = 64 * kb, n0 = 32 * nb;
    int orow0 = n0;
    if (inter == 1) orow0 = (n0 < FF) ? (n0 / 128) * 256 + (n0 % 128) : ((n0 - FF) / 128) * 256 + 128 + ((n0 - FF) % 128);
    if (inter == 2) { const int reg = n0 / 1024, c = n0 % 1024; orow0 = (reg == 2) ? c : (reg == 5) ? 1024 + c : (reg < 2 ? reg : reg - 1) * 1024 + c; }
    float v[32];
#pragma unroll
    for (int i = 0; i < 32; ++i) { int ks = k0 + 2 * i + (lane >> 5); if (kperm) ks = (ks & ~127) + 32 * (ks & 3) + ((ks & 127) >> 2); v[i] = W[(size_t)ks * N + n0 + (lane & 31)]; }
#pragma unroll
    for (int i = 0; i < 32; ++i) { const int kk = 2 * i + (lane >> 5); float t = v[i] * scale; if (gain) t *= gain[k0 + kk]; scr[kk * 33 + (lane & 31)] = t; }
    LDS_WAIT(); asm volatile("" ::: "memory");
    const int c = lane & 7;
#pragma unroll
    for (int j = 0; j < 4; ++j) { const int n = (lane >> 3) + 8 * j; const LAS float* s = scr + (8 * c) * 33 + n;
        pg8::u32x2 o; o.x = pg8::pk4_fp8(s[0 * 33], s[1 * 33], s[2 * 33], s[3 * 33]); o.y = pg8::pk4_fp8(s[4 * 33], s[5 * 33], s[6 * 33], s[7 * 33]);
        *(GAS pg8::u32x2*)(WT + (size_t)(orow0 + n) * K + k0 + 8 * c) = o; }
    LDS_WAIT(); asm volatile("" ::: "memory");
}
__device__ __forceinline__ void rms_row_to_bf16(const float* xrow, const float* g, bf16* orow, int lane, unsigned char* o8 = nullptr, float s8 = 1.f) {
    const GAS f32x4* xr = (const GAS f32x4*)xrow + lane; const GAS f32x4* gr = (const GAS f32x4*)g + lane;
    f32x4 v[8]; float s = 0.f;
#pragma unroll
    for (int j = 0; j < 8; ++j) { v[j] = xr[64 * j]; s += (v[j].x * v[j].x + v[j].y * v[j].y) + (v[j].z * v[j].z + v[j].w * v[j].w); }
    const float rstd = 1.0f / sqrtf(wave_sum(s) * (1.f / DM) + EPS);
    GAS unsigned long long* ob8 = (GAS unsigned long long*)orow + lane;
#pragma unroll
    for (int j = 0; j < 8; ++j) { const f32x4 gg = gr[64 * j];
        const float a0 = v[j].x * rstd * gg.x, a1 = v[j].y * rstd * gg.y, a2 = v[j].z * rstd * gg.z, a3 = v[j].w * rstd * gg.w;
        ob8[64 * j] = (unsigned long long)pk2(a0, a1) | ((unsigned long long)pk2(a2, a3) << 32);
        if (o8) ((GAS unsigned*)o8)[64 * j + lane] = pg8::pk4_fp8(a0 * s8, a1 * s8, a2 * s8, a3 * s8); }
}
__device__ __forceinline__ void x_row_convert(const float* xrow, bf16* orow, unsigned char* o8, float s8, float* rinv, int lane) {
    const GAS f32x4* xr = (const GAS f32x4*)xrow + lane;
    f32x4 v[8]; float s = 0.f;
#pragma unroll
    for (int j = 0; j < 8; ++j) { v[j] = xr[64 * j]; s += (v[j].x * v[j].x + v[j].y * v[j].y) + (v[j].z * v[j].z + v[j].w * v[j].w); }
    const float rstd = 1.0f / sqrtf(wave_sum(s) * (1.f / DM) + EPS);
    if (lane == 0) *rinv = rstd;
    GAS unsigned long long* ob8 = (GAS unsigned long long*)orow + lane;
#pragma unroll
    for (int j = 0; j < 8; ++j) { ob8[64 * j] = (unsigned long long)pk2(v[j].x, v[j].y) | ((unsigned long long)pk2(v[j].z, v[j].w) << 32);
        ((GAS unsigned*)o8)[64 * j + lane] = pg8::pk4_fp8(v[j].x * s8, v[j].y * s8, v[j].z * s8, v[j].w * s8); }
}
__constant__ float INV_FREQ[16] = {1.000000000e+00f, 4.403665960e-01f, 1.939227432e-01f, 8.539710194e-02f, 3.760603070e-02f, 1.656043902e-02f, 7.292664610e-03f, 3.211445874e-03f,
                                   1.414213562e-03f, 6.227723788e-04f, 2.742481884e-04f, 1.207697351e-04f, 5.318296098e-05f, 2.341999971e-05f, 1.031338616e-05f, 4.541670478e-06f};

struct TItem { const float* src; unsigned char* dst; const float* gain; float scale; int N, K, fp8, kperm; };
__device__ __forceinline__ void ti_decode(TItem& t, const float* W, int K, int N, unsigned char* WT, const float* gain, int inter, float scale, int fp8, int kperm, int item) {
    const int nblk = N / 32, kb = item / nblk, nb = item % nblk, k0 = 64 * kb, n0 = 32 * nb;
    int orow0 = n0;
    if (inter == 1) orow0 = (n0 < FF) ? (n0 / 128) * 256 + (n0 % 128) : ((n0 - FF) / 128) * 256 + 128 + ((n0 - FF) % 128);
    if (inter == 2) { const int reg = n0 / 1024, c = n0 % 1024; orow0 = (reg == 2) ? c : (reg == 5) ? 1024 + c : (reg < 2 ? reg : reg - 1) * 1024 + c; }
    const int ksrc0 = kperm ? (k0 & ~127) + ((k0 & 64) >> 2) : k0;
    t.src = W + (size_t)ksrc0 * N + n0; t.N = N; t.K = K; t.fp8 = fp8; t.kperm = kperm; t.scale = scale; t.gain = gain ? gain + k0 : nullptr;
    t.dst = WT + ((size_t)orow0 * K + k0) * (fp8 ? 1 : 2);
}
__device__ __forceinline__ void ti_load(const TItem& t, float (&v)[32], f32x4 (&g)[2], int lane) {
    const GAS float* s = (const GAS float*)t.src + (lane & 31);
#pragma unroll
    for (int i = 0; i < 32; ++i) { const int kk = 2 * i + (lane >> 5); const int ro = t.kperm ? 32 * (kk & 3) + (kk >> 2) : kk; v[i] = __builtin_nontemporal_load(s + (size_t)ro * t.N); }
    const GAS f32x4* gp = (const GAS f32x4*)((t.gain ? t.gain : t.src) + 8 * (lane & 7)); g[0] = gp[0]; g[1] = gp[1];
}
__device__ __forceinline__ void ti_finish(const TItem& t, const float (&v)[32], const f32x4 (&g)[2], LAS float* scr, int lane) {
#pragma unroll
    for (int i = 0; i < 32; ++i) scr[(2 * i + (lane >> 5)) * 33 + (lane & 31)] = v[i];
    LDS_WAIT(); asm volatile("" ::: "memory");
    const int c = lane & 7; const float sc = t.scale; const bool hg = t.gain != nullptr;
    const float g0 = hg ? g[0].x * sc : sc, g1 = hg ? g[0].y * sc : sc, g2 = hg ? g[0].z * sc : sc, g3 = hg ? g[0].w * sc : sc, g4 = hg ? g[1].x * sc : sc, g5 = hg ? g[1].y * sc : sc, g6 = hg ? g[1].z * sc : sc, g7 = hg ? g[1].w * sc : sc;
    if (t.fp8) {
#pragma unroll
        for (int j = 0; j < 4; ++j) { const int n = (lane >> 3) + 8 * j; const LAS float* s = scr + (8 * c) * 33 + n;
            pg8::u32x2 o; o.x = pg8::pk4_fp8(s[0 * 33] * g0, s[1 * 33] * g1, s[2 * 33] * g2, s[3 * 33] * g3); o.y = pg8::pk4_fp8(s[4 * 33] * g4, s[5 * 33] * g5, s[6 * 33] * g6, s[7 * 33] * g7);
            *(GAS pg8::u32x2*)(t.dst + (size_t)n * t.K + 8 * c) = o; }
    } else {
#pragma unroll
        for (int j = 0; j < 4; ++j) { const int n = (lane >> 3) + 8 * j; const LAS float* s = scr + (8 * c) * 33 + n;
            v4u o; o.x = pk2(s[0 * 33] * g0, s[1 * 33] * g1); o.y = pk2(s[2 * 33] * g2, s[3 * 33] * g3); o.z = pk2(s[4 * 33] * g4, s[5 * 33] * g5); o.w = pk2(s[6 * 33] * g6, s[7 * 33] * g7);
            *(GAS v4u*)(t.dst + ((size_t)n * t.K + 8 * c) * 2) = o; }
    }
    LDS_WAIT(); asm volatile("" ::: "memory");
}
__device__ __forceinline__ void xrow_load(const float* xrow, f32x4 (&v)[8], int lane) {
    const GAS f32x4* xr = (const GAS f32x4*)xrow + lane;
#pragma unroll
    for (int j = 0; j < 8; ++j) v[j] = __builtin_nontemporal_load(xr + 64 * j);
}
__device__ __forceinline__ void xrow_finish(const f32x4 (&v)[8], bf16* orow, unsigned char* o8, float s8, float* rinv, int lane) {
    float s = 0.f;
#pragma unroll
    for (int j = 0; j < 8; ++j) s += (v[j].x * v[j].x + v[j].y * v[j].y) + (v[j].z * v[j].z + v[j].w * v[j].w);
    const float rstd = 1.0f / sqrtf(wave_sum(s) * (1.f / DM) + EPS);
    if (lane == 0) *rinv = rstd;
    GAS unsigned long long* ob8 = (GAS unsigned long long*)orow + lane;
#pragma unroll
    for (int j = 0; j < 8; ++j) { ob8[64 * j] = (unsigned long long)pk2(v[j].x, v[j].y) | ((unsigned long long)pk2(v[j].z, v[j].w) << 32);
        ((GAS unsigned*)o8)[64 * j + lane] = pg8::pk4_fp8(v[j].x * s8, v[j].y * s8, v[j].z * s8, v[j].w * s8); }
}
__device__ __forceinline__ void p0_item(Frame& F, TItem& t, int it) {
    constexpr int I0 = (DM / 64) * (NQKV / 32), I1 = (DM / 64) * (DM / 32), I2 = (DM / 64) * (WX / 32), I3 = (DM / 64) * (2 * WX / 32), I4 = (WX / 64) * (DM / 32);
    int r = it;
    if (r < I0) { const int reg = ((r % (NQKV / 32)) * 32) / 1024;
        if (reg == 2 || reg == 5) ti_decode(t, F.w_in, DM, NQKV, F.ws + WS_WV8, F.g_mix, 2, S_WV, 1, 0, r);
        else if (QK_FP8 && reg < 2) ti_decode(t, F.w_in, DM, NQKV, F.ws + WS_WIN, F.g_mix, 2, S_WQK, 1, 0, r);
        else ti_decode(t, F.w_in, DM, NQKV, F.ws + WS_WIN, F.g_mix, 2, 1.f, 0, 0, r);
        return; } r -= I0;
    if (r < I1) { ti_decode(t, F.w_out, DM, DM, F.ws + WS_WOUT, nullptr, 0, S_WO, 1, 1, r); return; } r -= I1;
    if (r < I2) { ti_decode(t, F.w_xq, DM, WX, F.ws + WS_WXQ, F.g_xattn, 0, 1.f, 0, 0, r); return; } r -= I2;
    if (r < I3) { ti_decode(t, F.w_xkv, DM, 2 * WX, F.ws + WS_WXKV, nullptr, 0, 1.f, 0, 0, r); return; } r -= I3;
    if (r < I4) { ti_decode(t, F.w_xo, WX, DM, F.ws + WS_WXO, nullptr, 0, S_WXO, 1, 1, r); return; } r -= I4;
    ti_decode(t, F.w_gu, DM, 2 * FF, F.ws + WS_WGU, F.g_ffn, 1, S_WGU, 1, 0, r);
}
__device__ __forceinline__ void p0_prologue(Frame& F) {
    LAS float* scr = (LAS float*)(F.lds + F.wave * 16384);
    const int gw = F.vcu * NWAVES + F.wave, NGW = F.G * NWAVES;
    constexpr int I0 = (DM / 64) * (NQKV / 32), I1 = (DM / 64) * (DM / 32), I2 = (DM / 64) * (WX / 32), I3 = (DM / 64) * (2 * WX / 32), I4 = (WX / 64) * (DM / 32),
                  I5 = (DM / 64) * (2 * FF / 32);
    constexpr int I5H = I5 / 2;
    constexpr int NITEMS = I0 + I1 + I2 + I3 + I4 + I5H;
    {   float va[32], vb[32]; f32x4 ga[2], gb[2]; TItem ta, tb;
        int it = gw;
        if (it < NITEMS) { p0_item(F, ta, it); ti_load(ta, va, ga, F.lane);
            for (;;) {
                int itn = it + NGW; p0_item(F, tb, itn < NITEMS ? itn : it); ti_load(tb, vb, gb, F.lane);
                ti_finish(ta, va, ga, scr, F.lane); it = itn; if (it >= NITEMS) break;
                itn = it + NGW; p0_item(F, ta, itn < NITEMS ? itn : it); ti_load(ta, va, ga, F.lane);
                ti_finish(tb, vb, gb, scr, F.lane); it = itn; if (it >= NITEMS) break;
            } }
    }
    {   f32x4 va[8], vb[8];
        bf16* xb = (bf16*)(F.ws + WS_RA); unsigned char* x8 = F.ws + WS_RB; float* ri = (float*)(F.ws + WS_RINV0);
        int m = gw;
        if (m < M) { xrow_load(F.x + (size_t)m * DM, va, F.lane);
            for (;;) {
                int mn = m + NGW; xrow_load(F.x + (size_t)(mn < M ? mn : m) * DM, vb, F.lane);
                xrow_finish(va, xb + (size_t)m * DM, x8 + (size_t)m * DM, S_XN, ri + m, F.lane); m = mn; if (m >= M) break;
                mn = m + NGW; xrow_load(F.x + (size_t)(mn < M ? mn : m) * DM, va, F.lane);
                xrow_finish(vb, xb + (size_t)m * DM, x8 + (size_t)m * DM, S_XN, ri + m, F.lane); m = mn; if (m >= M) break;
            } }
    }
    for (int m = gw; m < MMEM; m += NGW) rms_row_to_bf16(F.mem + (size_t)m * DM, F.g_mem, (bf16*)(F.ws + WS_MN) + (size_t)m * DM, F.lane);
    float* cs = (float*)(F.ws + WS_CS);
    for (int e = (F.vcu * NWAVES + F.wave) * 64 + F.lane; e < M * 16; e += NGW * 64) {
        const int m = e >> 4, i = e & 15; const float ang = (float)F.pos[m] * INV_FREQ[i];
        double rev = (double)ang * 0.15915494309189535; rev -= floor(rev);
        const float a = (float)(rev * 6.283185307179586);
        cs[(size_t)m * 32 + i] = cosf(a); cs[(size_t)m * 32 + 16 + i] = sinf(a);
    }
}

__device__ __forceinline__ void ffn_item(Frame& F, TItem& t, int it) {
    constexpr int I5 = (DM / 64) * (2 * FF / 32);
    if (it < I5) ti_decode(t, F.w_gu, DM, 2 * FF, F.ws + WS_WGU, F.g_ffn, 1, S_WGU, 1, 0, it);
    else ti_decode(t, F.w_dn, FF, DM, F.ws + WS_WDN, nullptr, 0, S_WDN, 1, 0, it - I5);
}
__device__ __forceinline__ void ffn_weight_items(Frame& F, int wi, int nw) {
    LAS float* scr = (LAS float*)(F.lds + F.wave * 16384);
    constexpr int I5 = (DM / 64) * (2 * FF / 32), I6 = (FF / 64) * (DM / 32), NI = I5 + I6;
    float va[32], vb[32]; f32x4 ga[2], gb[2]; TItem ta, tb;
    int it = wi + I5 / 2;
    if (it < NI) { ffn_item(F, ta, it); ti_load(ta, va, ga, F.lane);
        for (;;) {
            int itn = it + nw; ffn_item(F, tb, itn < NI ? itn : it); ti_load(tb, vb, gb, F.lane);
            ti_finish(ta, va, ga, scr, F.lane); it = itn; if (it >= NI) break;
            itn = it + nw; ffn_item(F, ta, itn < NI ? itn : it); ti_load(ta, va, ga, F.lane);
            ti_finish(tb, vb, gb, scr, F.lane); it = itn; if (it >= NI) break;
        } }
}

__device__ __forceinline__ void final_norm_phase(Frame& F, const bf16* src, float* dst) {
    const int gw = F.vcu * NWAVES + F.wave, NGW = F.G * NWAVES;
    for (int m = gw; m < M; m += NGW) {
        const GAS v4u* xr = (const GAS v4u*)(src + (size_t)m * DM) + F.lane; const GAS f32x4* gr = (const GAS f32x4*)F.g_final;
        v4u w[4]; float s = 0.f;
#pragma unroll
        for (int j = 0; j < 4; ++j) w[j] = xr[64 * j];
        f32x4 v[8];
#pragma unroll
        for (int j = 0; j < 4; ++j) { v[2 * j] = (f32x4){__uint_as_float(w[j].x << 16), __uint_as_float(w[j].x & 0xffff0000u), __uint_as_float(w[j].y << 16), __uint_as_float(w[j].y & 0xffff0000u)};
            v[2 * j + 1] = (f32x4){__uint_as_float(w[j].z << 16), __uint_as_float(w[j].z & 0xffff0000u), __uint_as_float(w[j].w << 16), __uint_as_float(w[j].w & 0xffff0000u)}; }
#pragma unroll
        for (int j = 0; j < 8; ++j) s += (v[j].x * v[j].x + v[j].y * v[j].y) + (v[j].z * v[j].z + v[j].w * v[j].w);
        const float rstd = 1.0f / sqrtf(wave_sum(s) * (1.f / DM) + EPS);
        GAS f32x4* dr = (GAS f32x4*)(dst + (size_t)m * DM);
#pragma unroll
        for (int j = 0; j < 4; ++j) { const int c4 = (64 * j + F.lane) * 2;
            dr[c4] = v[2 * j] * rstd * gr[c4]; dr[c4 + 1] = v[2 * j + 1] * rstd * gr[c4 + 1]; }
    }
}

struct RangeOrder : pg8::StaticOrder {
    int i0, n;
    __device__ __forceinline__ bool next(int i, pg8::Unit& u) const { return i < n && pg8::StaticOrder::next(i + i0, u); }
};
template <int K> __device__ __forceinline__ const void* late_arg() {
    const void* p; asm volatile("s_load_dwordx2 %0, %1, %2\n\ts_waitcnt lgkmcnt(0)" : "=s"(p) : "s"(__builtin_amdgcn_kernarg_segment_ptr()), "i"(K * 8));
    return p;
}
constexpr int NPH = 11;
#ifndef REPEAT_WHICH
#define REPEAT_WHICH 3
#endif
#ifndef NULL_EPI_PROBE
#define NULL_EPI_PROBE 0
#endif
#ifndef FOLD_KMEAN
#define FOLD_KMEAN 1
#endif
#ifndef REPEAT_PHASE
#define REPEAT_PHASE -1
#endif
#ifndef REPEAT_MASK
#define REPEAT_MASK 0
#endif
#define REPS(k) (((REPEAT_PHASE == (k)) || ((REPEAT_MASK >> (k)) & 1)) ? 2 : 1)
#ifndef USE_MFMA_SB
#define USE_MFMA_SB 1
#endif
#ifndef USE_MFMA_MOBA
#define USE_MFMA_MOBA 1
#endif
#ifndef USE_MFMA_X
#define USE_MFMA_X 1
#endif
#ifndef MK_ONE_LAUNCH
#define MK_ONE_LAUNCH 1
#endif
struct Args { const void* in[17]; float* out; unsigned char* ws; int ph_lo, ph_hi; };
__global__ void __launch_bounds__(NWAVES * 64, 2) mk_fwd(Args args) {
    extern __shared__ __attribute__((aligned(16))) unsigned char lds[];
    Frame F;
    F.lds = (LAS unsigned char*)lds;
    F.tid = threadIdx.x; F.lane = F.tid & 63; F.wave = __builtin_amdgcn_readfirstlane(F.tid >> 6);
    F.G = gridDim.x; { const int bx = blockIdx.x; F.vcu = (F.G % 8 == 0) ? (bx % 8) * (F.G / 8) + bx / 8 : bx; }
    F.x = (const float*)args.in[0]; F.mem = (const float*)args.in[1]; F.pos = (const int*)args.in[2];
    F.g_mix = (const float*)args.in[3]; F.w_in = (const float*)args.in[4]; F.g_out_sb = nullptr; F.g_out_mb = nullptr; F.w_out = (const float*)args.in[7];
    F.g_xattn = (const float*)args.in[8]; F.g_mem = (const float*)args.in[9]; F.w_xq = (const float*)args.in[10]; F.w_xkv = (const float*)args.in[11]; F.w_xo = (const float*)args.in[12];
    F.g_ffn = nullptr; F.w_gu = nullptr; F.w_dn = nullptr; F.g_final = nullptr;
    F.out = args.out; F.ws = args.ws;
    unsigned char* ws = args.ws;
    const int lo = args.ph_lo, hi = args.ph_hi;
    for (int u = F.tid; u < (LDS_BYTES - LDSCTL_OFF) / 4; u += NWAVES * 64) ((LAS unsigned*)(F.lds + LDSCTL_OFF))[u] = 0u;
    __syncthreads();
    if (hi - lo > 1) {
        { GAS v4u* z = (GAS v4u*)(ws + WS_CTL); const int n16 = (int)(CTL_ZERO_BYTES / 16);
          for (int i = (int)blockIdx.x * (NWAVES * 64) + F.tid; i < n16; i += F.G * NWAVES * 64) z[i] = (v4u){0u, 0u, 0u, 0u}; }
        cg::this_grid().sync();
    }
    XcdBarrier bar = xcd_barrier_post((unsigned*)(ws + WS_CTL) + CW_BAR, (volatile LAS unsigned*)(F.lds + MISC_OFF) + 8);
#ifndef ONLY_PHASE
#define ONLY_PHASE -1
#endif
#define IN(k) ((ONLY_PHASE < 0 || ONLY_PHASE == (k)) && lo <= (k) && (k) < hi)
#define BOTH(k) (IN(k) && IN((k) + 1))
#define GRID_BAR() xcd_barrier(bar)
    float* ssq1 = (float*)(ws + WS_SSQ1); float* ssq2 = (float*)(ws + WS_SSQ2);
    pg8::bf16_t* ACT = (pg8::bf16_t*)(ws + WS_RC + 64 * MiB);
    pg8::bf16_t* RA = (pg8::bf16_t*)(ws + WS_RA); pg8::bf16_t* RB = (pg8::bf16_t*)(ws + WS_RB); pg8::bf16_t* RC = (pg8::bf16_t*)(ws + WS_RC);

    if (IN(0)) { F.w_gu = (const float*)late_arg<14>(); F.g_ffn = (const float*)late_arg<13>(); for (int rep = 0; rep < REPS(0); ++rep) p0_prologue(F); F.w_gu = nullptr; F.g_ffn = nullptr; if (BOTH(0)) GRID_BAR(); }
    if (IN(1)) {
        pg8::Gemm gs{RB, (const pg8::bf16_t*)(ws + WS_WIN), M, 2048, DM / 2}; RangeOrder Ss; Ss.init(M, 2048, F.G, (int)blockIdx.x);
        pg8::EpiQKV Es{RC, (const float*)(ws + WS_CS), QSCALE, (float*)(ws + WS_KSUM), 0, 1.f, (const float*)(ws + WS_RINV0), 1.f / (S_XN * S_WQK), 0};
        pg8::Gemm gm{RA, (const pg8::bf16_t*)(ws + WS_WIN) + (size_t)2048 * DM, M, 2048, DM}; RangeOrder Sm; Sm.init(M, 2048, F.G, (int)blockIdx.x);
        pg8::EpiQKV Em{RC, (const float*)(ws + WS_CS), QSCALE, (float*)(ws + WS_KSUM), 0, 1.f, (const float*)(ws + WS_RINV0), 1.f, 8};
        pg8::Gemm gv{RB, (const pg8::bf16_t*)(ws + WS_WV8), M, 2048, DM / 2}; RangeOrder Sv; Sv.init(M, 2048, F.G, (int)blockIdx.x);
        pg8::EpiQKV Ev{RC, (const float*)(ws + WS_CS), QSCALE, (float*)(ws + WS_KSUM), 1, 1.f / (S_XN * S_WV), (const float*)(ws + WS_RINV0), 1.f, 0};
        for (int rep = 0; rep < REPS(1); ++rep) {
        const bool grp = ((blockIdx.x >> 3) & 1) != 0;
        Ss.i0 = 0; Ss.n = 1 << 20; Sm.i0 = 0; Sm.n = 1 << 20;
        if (grp) { Sv.i0 = 0; Sv.n = 1; pg8::gemm_phase<pg8::EpiQKV, RangeOrder, true, true, true>(F.lds, gv, Sv, Ev); }
        pg8::gemm_phase<pg8::EpiQKV, RangeOrder, true, true, true>(F.lds, gs, Ss, Es);
        pg8::gemm_phase<pg8::EpiQKV, RangeOrder, true, true>(F.lds, gm, Sm, Em);
        Sv.i0 = grp ? 1 : 0; Sv.n = 1 << 20;
        pg8::gemm_phase<pg8::EpiQKV, RangeOrder, true, true, true>(F.lds, gv, Sv, Ev);
        }
        if (BOTH(1)) GRID_BAR();
    }
    if (IN(3)) {
        const att::bf16* qkv = (const att::bf16*)RC; att::bf16* ob = (att::bf16*)RB; const float* kmean = (const float*)(ws + WS_KSUM);
        F.g_out_sb = (const float*)late_arg<5>(); F.g_out_mb = (const float*)late_arg<6>();
        constexpr size_t HSZ = (size_t)SEQ * HD;
        for (int rep = 0; rep < REPS(3); ++rep) {
        if (rep == 0 || (REPEAT_WHICH & 1))
        for (int vv = F.vcu; vv < 256; vv += F.G) { const int bh = vv >> 2, s = vv & 3, b = bh >> 3, h = bh & 7; const size_t rb = (size_t)b * SEQ;
            const att::bf16* hS = qkv + ((size_t)b * 48 + h) * HSZ; const att::bf16* hM = qkv + ((size_t)b * 48 + 24 + h) * HSZ;
            for (int i = 0; i < 2; ++i) { const int qb = i ? s : 7 - s; const size_t r0 = rb + (size_t)qb * 256;
                att::attn_unit<2, true>(hS, nullptr, nullptr, (att::bf16*)((unsigned char*)ob + r0 * DM + h * HD), F.g_out_sb + h * HD, nullptr, qb, 0, (char*)lds, S_O,
                                        i != 0, i ? hM : hS, i ? 7 - s : s, i ? 0 : 4 * (s + 1) - 1, i ? -1 : 4 * (s + 1) - 2); }
            for (int i = 0; i < 2; ++i) { const int qb = i ? s : 7 - s; const size_t r0 = rb + (size_t)qb * 256;
                att::attn_unit<1, true>(hM, nullptr, nullptr, (att::bf16*)((unsigned char*)ob + r0 * DM + NH * HD + h * HD), F.g_out_mb + h * HD, kmean + (size_t)bh * 1024, qb, 0, (char*)lds, S_O,
                                        true, i ? nullptr : hM, s, 0, -1); } }
        }
        if (BOTH(3)) GRID_BAR();
    }
    if (IN(4)) {
        pg8::Gemm g{RB, (const pg8::bf16_t*)(ws + WS_WOUT), M, DM, WOUT_FP8 ? DM / 2 : DM}; pg8::StaticOrder S; S.init(M, DM, F.G, (int)blockIdx.x);
        pg8::EpiResB<false> E{RA, RC, ssq1, nullptr, 1.f, WOUT_FP8 ? 1.f / (S_O * S_WO) : 1.f};
        pg8::gemm_phase<pg8::EpiResB<false>, pg8::StaticOrder, true, true, WOUT_FP8 != 0>(F.lds, g, S, E);
        if (BOTH(4)) GRID_BAR();
    }
    if (IN(5)) {
      F.w_gu = (const float*)late_arg<14>(); F.g_ffn = (const float*)late_arg<13>(); F.w_dn = (const float*)late_arg<15>();
      for (int rep = 0; rep < REPS(5); ++rep) {
        { pg8::Gemm g{RC, (const pg8::bf16_t*)(ws + WS_WXQ), M, WX, DM}; pg8::StaticOrder S; S.init(M, WX, F.G, (int)blockIdx.x);
          pg8::EpiScale E{(pg8::bf16_t*)(ws + WS_QX), WX, ssq1, QSCALE};
          pg8::gemm_phase<pg8::EpiScale, pg8::StaticOrder, true, true>(F.lds, g, S, E); }
        { pg8::Gemm g{(const pg8::bf16_t*)(ws + WS_MN), (const pg8::bf16_t*)(ws + WS_WXKV), MMEM, 2 * WX, DM}; pg8::StaticOrder S; S.init(MMEM, 2 * WX, F.G, (int)((blockIdx.x + F.G - 128) % F.G));
          pg8::EpiScale E{(pg8::bf16_t*)(ws + WS_KVX), 2 * WX, nullptr, 1.0f};
          pg8::gemm_phase<pg8::EpiScale, pg8::StaticOrder, true, true>(F.lds, g, S, E); }
        if (F.G > 160) { if ((int)blockIdx.x >= 160) ffn_weight_items(F, ((int)blockIdx.x - 160) * NWAVES + F.wave, (F.G - 160) * NWAVES); }
        else ffn_weight_items(F, (int)blockIdx.x * NWAVES + F.wave, F.G * NWAVES);
      }
        if (BOTH(5)) GRID_BAR();
    }
    if (IN(6)) {
        const att::bf16* qx = (const att::bf16*)(ws + WS_QX); const att::bf16* kvx = (const att::bf16*)(ws + WS_KVX); att::bf16* ox = (att::bf16*)(ws + WS_OX);
        for (int rep = 0; rep < REPS(6); ++rep) {
        for (int vv = F.vcu; vv < 256; vv += F.G) { const int b = vv >> 5, h = (vv >> 3) & 3, qb = vv & 7; const size_t r0 = (size_t)b * SEQ + (size_t)qb * 256;
            if (WXO_FP8) att::attn_unit<0, true>(qx + r0 * WX + h * HD, kvx + (size_t)b * NMEM * (2 * WX) + h * HD, kvx + (size_t)b * NMEM * (2 * WX) + WX + h * HD, (att::bf16*)((unsigned char*)ox + r0 * WX + h * HD), nullptr, nullptr, qb, NMEM, (char*)lds, S_OX);
            else att::attn_unit<0>(qx + r0 * WX + h * HD, kvx + (size_t)b * NMEM * (2 * WX) + h * HD, kvx + (size_t)b * NMEM * (2 * WX) + WX + h * HD, ox + r0 * WX + h * HD, nullptr, nullptr, qb, NMEM, (char*)lds); }
        }
        if (BOTH(6)) GRID_BAR();
    }
    if (IN(7)) {
        pg8::Gemm g{(const pg8::bf16_t*)(ws + WS_OX), (const pg8::bf16_t*)(ws + WS_WXO), M, DM, WXO_FP8 ? WX / 2 : WX}; pg8::StaticOrder S; S.init(M, DM, F.G, (int)blockIdx.x);
        pg8::EpiResB<false> E{RC, RC, ssq2, (unsigned char*)RA, S_X2, WXO_FP8 ? 1.f / (S_OX * S_WXO) : 1.f};
        pg8::gemm_phase<pg8::EpiResB<false>, pg8::StaticOrder, true, true, WXO_FP8 != 0>(F.lds, g, S, E);
        if (BOTH(7)) GRID_BAR();
    }
    if (IN(8)) {
        pg8::Gemm g{RA, (const pg8::bf16_t*)(ws + WS_WGU), M, 2 * FF, FFN_FP8 ? DM / 2 : DM}; pg8::StaticOrder S; S.init(M, 2 * FF, F.G, (int)blockIdx.x);
        pg8::EpiSwiGLU E{ACT, ssq2, FFN_FP8 ? (unsigned char*)ACT : nullptr, FFN_FP8 ? 1.f / (S_X2 * S_WGU) : 1.f, S_ACT};
#if NULL_EPI_PROBE
        if (REPS(8) == 2) { pg8::EpiNull EN{nullptr}; pg8::gemm_phase<pg8::EpiNull, pg8::StaticOrder, true, true, FFN_FP8 != 0>(F.lds, g, S, EN); }
        pg8::gemm_phase<pg8::EpiSwiGLU, pg8::StaticOrder, true, true, FFN_FP8 != 0>(F.lds, g, S, E);
#else
        for (int rep = 0; rep < REPS(8); ++rep) pg8::gemm_phase<pg8::EpiSwiGLU, pg8::StaticOrder, true, true, FFN_FP8 != 0>(F.lds, g, S, E);
#endif
        if (BOTH(8)) GRID_BAR();
    }
    if (IN(9)) {
        pg8::Gemm g{ACT, (const pg8::bf16_t*)(ws + WS_WDN), M, DM, FF / 2}; pg8::StaticOrder S; S.init(M, DM, F.G, (int)blockIdx.x);
        pg8::EpiResB<false> E{RC, RC, nullptr, nullptr, 1.f, 1.f / (S_ACT * S_WDN)};
        pg8::gemm_phase<pg8::EpiResB<false>, pg8::StaticOrder, true, true, true>(F.lds, g, S, E);
        if (BOTH(9)) GRID_BAR();
    }
    if (IN(10)) { F.g_final = (const float*)late_arg<16>(); final_norm_phase(F, RC, F.out); }
#undef IN
#undef BOTH
}

extern "C" void kernel_launch(void* const* d_in, const int* in_sizes, int n_in, void* d_out, int out_size, void* d_ws, size_t ws_size, hipStream_t stream) {
    static int grid = 0;
    if (grid == 0) {
        if (n_in != 17 || in_sizes[0] != M * DM || out_size != M * DM || ws_size < WS_END) { fprintf(stderr, "kernel_launch: unexpected shapes (n_in %d in0 %d out %d ws %zu)\n", n_in, n_in > 0 ? in_sizes[0] : -1, out_size, ws_size); grid = -1; return; }
        int dev = 0, cus = 0, per_cu = 0;
        if (hipGetDevice(&dev) != hipSuccess || hipDeviceGetAttribute(&cus, hipDeviceAttributeMultiprocessorCount, dev) != hipSuccess) { grid = -1; return; }
        if (hipFuncSetAttribute((const void*)mk_fwd, hipFuncAttributeMaxDynamicSharedMemorySize, LDS_BYTES) != hipSuccess) { fprintf(stderr, "kernel_launch: hipFuncSetAttribute failed\n"); grid = -1; return; }
        if (hipOccupancyMaxActiveBlocksPerMultiprocessor(&per_cu, (const void*)mk_fwd, NWAVES * 64, LDS_BYTES) != hipSuccess || per_cu < 1) { fprintf(stderr, "kernel_launch: occupancy query failed (%d)\n", per_cu); per_cu = 1; }
        (void)hipGetLastError();
        grid = cus * (per_cu < 1 ? 1 : 1);
    }
    if (grid < 0) return;
#if !MK_ONE_LAUNCH
    (void)hipMemsetAsync((char*)d_ws + WS_CTL, 0, CTL_ZERO_BYTES, stream);
#endif
    Args a{};
    for (int i = 0; i < 17; ++i) a.in[i] = d_in[i];
    a.out = (float*)d_out; a.ws = (unsigned char*)d_ws;
#if MK_ONE_LAUNCH
    a.ph_lo = 0; a.ph_hi = NPH;
    void* kargs[] = {&a};
    hipError_t e = hipLaunchCooperativeKernel((const void*)mk_fwd, dim3(grid), dim3(NWAVES * 64), kargs, LDS_BYTES, stream);
    if (e != hipSuccess) fprintf(stderr, "kernel_launch: cooperative launch failed: %s (grid %d)\n", hipGetErrorString(e), grid);
#else
    for (int p = 0; p < NPH; ++p) { a.ph_lo = p; a.ph_hi = p + 1; hipLaunchKernelGGL(mk_fwd, dim3(grid), dim3(NWAVES * 64), LDS_BYTES, stream, a); }
    const hipError_t le = hipPeekAtLastError();
    if (le != hipSuccess) fprintf(stderr, "kernel_launch: launch failed: %s\n", hipGetErrorName(le));
#endif
}
```

```cpp
#include <hip/hip_runtime.h>
#include <hip/hip_cooperative_groups.h>
#include <cstdio>
#include <cstdint>
namespace cg = cooperative_groups;
namespace pg8 {
#define PG8_LAS __attribute__((address_space(3)))
typedef unsigned short bf16_t;
typedef short bf16x8 __attribute__((ext_vector_type(8)));
typedef float f32x4 __attribute__((ext_vector_type(4)));
typedef unsigned u32x4 __attribute__((ext_vector_type(4)));
constexpr int BM = 256, BK = 64, HALF = 128, HTB = HALF * BK * 2  , STAGE_BYTES = 8 * HTB, NXCD = 8, WGM = 8;

__host__ __device__ __forceinline__ int lds_byte(int r, int c) { const int st = (r >> 4) * 2 + (c >> 5), rr = r & 15, cc = c & 31, ob = rr * 64 + cc * 2; return st * 1024 + (ob ^ (((ob >> 9) & 1) << 5)); }
__host__ __device__ __forceinline__ void stage_rc(int b, int& R, int& C) { const int st = b / 1024, sb = b % 1024, swz = sb ^ (((sb >> 9) & 1) << 5); R = (st >> 1) * 16 + swz / 64; C = (st & 1) * 32 + (swz % 64) / 2; }
__host__ __device__ __forceinline__ int perm32(int rho) { const int n = rho >> 4, i = rho & 15; return 8 * (i >> 2) + 4 * n + (i & 3); }

struct Unit { int pm, pn; };
struct Gemm { const bf16_t* A; const bf16_t* Bt; int M, N, K; };

struct StaticOrder {
    int nM, nN, nwg, G, c;
    __host__ __device__ void init(int M, int N, int G_, int c_) { nM = M / BM; nN = N / BM; nwg = nM * nN; G = G_; c = c_; }
    __host__ __device__ bool next(int i, Unit& u) const {
        const long L = (long)i * G + c; if (L >= nwg) return false;
        int wgid = (int)L; { const int q = nwg / NXCD, r = nwg % NXCD, xcd = wgid % NXCD, off = wgid / NXCD; wgid = (xcd < r ? xcd * (q + 1) : r * (q + 1) + (xcd - r) * q) + off; }
        const int nig = WGM * nN, gid = wgid / nig, fm = gid * WGM, gsz = (nM - fm) < WGM ? (nM - fm) : WGM;
        u.pm = fm + ((wgid % nig) % gsz); u.pn = (wgid % nig) / gsz; return true;
    }
    __device__ __forceinline__ void a_ready(const Unit&) const {}
    __device__ __forceinline__ void done(const Unit&) const {}
};

__device__ __forceinline__ unsigned cvt_pk_bf16(float lo, float hi) { unsigned r; asm volatile("v_cvt_pk_bf16_f32 %0, %1, %2" : "=v"(r) : "v"(lo), "v"(hi)); return r; }
typedef float f32x2 __attribute__((ext_vector_type(2)));
template <class Epi, class Sched, bool ALIGN_EPI = false, bool SP2 = false, bool FP8 = false>
__device__ __forceinline__ void gemm_phase(PG8_LAS unsigned char* lds, const Gemm g, const Sched& S, const Epi& E) {
    int tid_ = threadIdx.x; asm volatile("" : "+v"(tid_));
    const int tid = tid_, wid = __builtin_amdgcn_readfirstlane(tid >> 6), lane = tid & 63, wr = wid >> 2, wc = wid & 3, fr = lane & 15, fq = lane >> 4;
    const int K = g.K, nt = K / BK;
    unsigned voffA[2], voffB[2];
#pragma unroll
    for (int i = 0; i < 2; ++i) { int R, C; stage_rc(tid * 16 + i * 8192, R, C); const int Rb = Epi::PERM ? ((R & ~31) + perm32(R & 31)) : R;
        voffA[i] = (unsigned)(R * K + C) * 2u; voffB[i] = (unsigned)(Rb * K + C) * 2u; }
    const size_t kstep = (size_t)(BK * 2);
    const size_t hstep = (size_t)HALF * K * 2;
    const size_t tstep = 2 * hstep;
    const unsigned ldsw = (unsigned)wid * 1024u;
    const int aoff = lds_byte(wr * 64 + fr, fq * 8), boff = lds_byte(wc * 32 + fr, fq * 8);
#define PG8_SA(b, h) (((b) * 2 + (h)) * HTB)
#define PG8_SB(b, h) ((4 + (b) * 2 + (h)) * HTB)
#define PG8_STAGE(bufoff, gbase, voff) do { _Pragma("unroll") for (int _i = 0; _i < 2; ++_i) \
        __builtin_amdgcn_global_load_lds((const unsigned*)((const char*)(gbase) + (voff)[_i]), (PG8_LAS unsigned*)(lds + (bufoff) + ldsw + _i * 8192), 16, 0, 0); } while (0)
#define PG8_LD8(p) __builtin_shufflevector(*(const PG8_LAS i32x4_*)(p), *(const PG8_LAS i32x4_*)((p) + 1024), 0, 1, 2, 3, 4, 5, 6, 7)
#define PG8_LDA(dst, b, h) do { if constexpr (FP8) { _Pragma("unroll") for (int m = 0; m < 4; ++m) dst##8[m] = PG8_LD8(lds + PG8_SA(b, h) + aoff + m * 2048); } \
        else { _Pragma("unroll") for (int m = 0; m < 4; ++m) _Pragma("unroll") for (int k = 0; k < 2; ++k) dst[m][k] = *(const PG8_LAS bf16x8*)(lds + PG8_SA(b, h) + aoff + m * 2048 + k * 1024); } } while (0)
#define PG8_LDB(dst, b, h) do { if constexpr (FP8) { _Pragma("unroll") for (int n = 0; n < 2; ++n) dst##8[n] = PG8_LD8(lds + PG8_SB(b, h) + boff + n * 2048); } \
        else { _Pragma("unroll") for (int n = 0; n < 2; ++n) _Pragma("unroll") for (int k = 0; k < 2; ++k) dst[n][k] = *(const PG8_LAS bf16x8*)(lds + PG8_SB(b, h) + boff + n * 2048 + k * 1024); } } while (0)
#define PG8_MMA(ai, bj, At, Bt) do { __builtin_amdgcn_s_setprio(1); _Pragma("unroll") for (int m = 0; m < 4; ++m) _Pragma("unroll") for (int n = 0; n < 2; ++n) { \
        if constexpr (FP8) asm volatile("v_mfma_scale_f32_16x16x128_f8f6f4 %0, %1, %2, %0, %3, %3 op_sel_hi:[0,0,0]" : "+v"(acc[ai][bj][m][n]) : "v"(Bt##8[n]), "v"(At##8[m]), "v"(sc1_)); \
        else { _Pragma("unroll") for (int k = 0; k < 2; ++k) acc[ai][bj][m][n] = __builtin_amdgcn_mfma_f32_16x16x32_bf16(Bt[n][k], At[m][k], acc[ai][bj][m][n], 0, 0, 0); } } \
        __builtin_amdgcn_s_setprio(0); } while (0)
#define PG8_WAIT_V(n) asm volatile("s_waitcnt vmcnt(" #n ")" ::: "memory")
#define PG8_WAIT_L(n) asm volatile("s_waitcnt lgkmcnt(" #n ")" ::: "memory")
#define PG8_BAR __builtin_amdgcn_s_barrier()
#define PG8_SCHED __builtin_amdgcn_sched_barrier(0)
    Unit cur, nxt; int ui = 0;
    if (!S.next(0, cur)) return;
    f32x4 acc[2][2][4][2];
#pragma unroll
    for (int a = 0; a < 2; ++a)
#pragma unroll
        for (int b = 0; b < 2; ++b)
#pragma unroll
            for (int m = 0; m < 4; ++m)
#pragma unroll
                for (int n = 0; n < 2; ++n) acc[a][b][m][n] = (f32x4){0.f, 0.f, 0.f, 0.f};
    typedef int i32x4_ __attribute__((ext_vector_type(4))); typedef int i32x8_ __attribute__((ext_vector_type(8)));
    int sc1_ = 0x7F7F7F7F; asm volatile("" : "+v"(sc1_));
    bf16x8 At[4][2], B0[2][2], B1[2][2]; i32x8_ At8[4], B08[2], B18[2];
    const char* cA = (const char*)g.A + (size_t)cur.pm * tstep; const char* cB = (const char*)g.Bt + (size_t)cur.pn * tstep;
    S.a_ready(cur);
    if constexpr (SP2) {
        PG8_STAGE(PG8_SB(0, 0), cB, voffB); PG8_STAGE(PG8_SB(0, 1), cB + hstep, voffB); PG8_STAGE(PG8_SA(0, 0), cA, voffA); PG8_STAGE(PG8_SA(0, 1), cA + hstep, voffA);
        if (wr == 1) PG8_BAR;
        PG8_WAIT_V(2); PG8_BAR;
        PG8_STAGE(PG8_SB(1, 0), cB + kstep, voffB); PG8_STAGE(PG8_SA(1, 0), cA + kstep, voffA); PG8_STAGE(PG8_SB(1, 1), cB + hstep + kstep, voffB);
        PG8_WAIT_V(6); PG8_BAR;
    } else {
        PG8_STAGE(PG8_SB(0, 0), cB, voffB); PG8_STAGE(PG8_SA(0, 0), cA, voffA); PG8_STAGE(PG8_SB(0, 1), cB + hstep, voffB); PG8_STAGE(PG8_SA(0, 1), cA + hstep, voffA);
        if (wr == 1) PG8_BAR;
        PG8_WAIT_V(4); PG8_BAR;
        PG8_STAGE(PG8_SB(1, 0), cB + kstep, voffB); PG8_STAGE(PG8_SA(1, 0), cA + kstep, voffA); PG8_STAGE(PG8_SB(1, 1), cB + hstep + kstep, voffB);
        PG8_WAIT_V(6); PG8_BAR;
    }
    for (;;) {
        const bool has_next = S.next(ui + 1, nxt);
        const char* nA = has_next ? (const char*)g.A + (size_t)nxt.pm * tstep : cA; const char* nB = has_next ? (const char*)g.Bt + (size_t)nxt.pn * tstep : cB;
        for (int t = 0; t < nt; t += 2) {
            const bool last = (t == nt - 2);
            const char* a1 = cA + (size_t)(t + 1) * kstep;
            const char* a2 = last ? nA : cA + (size_t)(t + 2) * kstep; const char* b2 = last ? nB : cB + (size_t)(t + 2) * kstep;
            const char* a3 = a2 + kstep; const char* b3 = b2 + kstep;
            if (last && has_next) S.a_ready(nxt);
            if constexpr (SP2) {
            PG8_LDB(B0, 0, 0); PG8_LDB(B1, 0, 1); PG8_SCHED; PG8_LDA(At, 0, 0); PG8_STAGE(PG8_SA(1, 1), a1 + hstep, voffA);
            PG8_WAIT_V(8); PG8_WAIT_L(0); PG8_BAR; PG8_MMA(0, 0, At, B0); PG8_MMA(0, 1, At, B1); PG8_BAR; PG8_SCHED;
            PG8_LDA(At, 0, 1); PG8_STAGE(PG8_SB(0, 0), b2, voffB); PG8_STAGE(PG8_SB(0, 1), b2 + hstep, voffB); PG8_STAGE(PG8_SA(0, 0), a2, voffA);
            PG8_WAIT_V(8); PG8_WAIT_L(0); PG8_BAR; PG8_MMA(1, 0, At, B0); PG8_MMA(1, 1, At, B1); PG8_BAR; PG8_SCHED;
            PG8_LDB(B0, 1, 0); PG8_LDB(B1, 1, 1); PG8_SCHED; PG8_LDA(At, 1, 0); PG8_STAGE(PG8_SA(0, 1), a2 + hstep, voffA);
            PG8_WAIT_V(8); PG8_WAIT_L(0); PG8_BAR; PG8_MMA(0, 0, At, B0); PG8_MMA(0, 1, At, B1); PG8_BAR; PG8_SCHED;
            PG8_LDA(At, 1, 1); PG8_STAGE(PG8_SB(1, 0), b3, voffB); PG8_STAGE(PG8_SB(1, 1), b3 + hstep, voffB); PG8_STAGE(PG8_SA(1, 0), a3, voffA);
            PG8_WAIT_V(8); PG8_WAIT_L(0); PG8_BAR; PG8_MMA(1, 0, At, B0); PG8_MMA(1, 1, At, B1); PG8_BAR; PG8_SCHED;
            } else {
            PG8_LDB(B0, 0, 0); PG8_SCHED; PG8_LDA(At, 0, 0); PG8_STAGE(PG8_SA(1, 1), a1 + hstep, voffA);
            PG8_WAIT_L(8); PG8_BAR; PG8_WAIT_L(0); PG8_MMA(0, 0, At, B0); PG8_BAR; PG8_SCHED;
            PG8_LDB(B1, 0, 1); PG8_STAGE(PG8_SB(0, 0), b2, voffB);
            PG8_BAR; PG8_WAIT_L(0); PG8_MMA(0, 1, At, B1); PG8_BAR;
            PG8_LDA(At, 0, 1); PG8_STAGE(PG8_SA(0, 0), a2, voffA);
            PG8_BAR; PG8_WAIT_L(0); PG8_MMA(1, 0, At, B0); PG8_BAR; PG8_SCHED;
            PG8_STAGE(PG8_SB(0, 1), b2 + hstep, voffB);
            PG8_WAIT_V(6); PG8_BAR; PG8_MMA(1, 1, At, B1); PG8_BAR;
            PG8_LDB(B0, 1, 0); PG8_SCHED; PG8_LDA(At, 1, 0); PG8_STAGE(PG8_SA(0, 1), a2 + hstep, voffA);
            PG8_WAIT_L(8); PG8_BAR; PG8_WAIT_L(0); PG8_MMA(0, 0, At, B0); PG8_BAR; PG8_SCHED;
            PG8_LDB(B1, 1, 1); PG8_STAGE(PG8_SB(1, 0), b3, voffB);
            PG8_BAR; PG8_WAIT_L(0); PG8_MMA(0, 1, At, B1); PG8_BAR;
            PG8_LDA(At, 1, 1); PG8_STAGE(PG8_SA(1, 0), a3, voffA);
            PG8_BAR; PG8_WAIT_L(0); PG8_MMA(1, 0, At, B0); PG8_BAR; PG8_SCHED;
            PG8_STAGE(PG8_SB(1, 1), b3 + hstep, voffB);
            PG8_WAIT_V(6); PG8_BAR; PG8_MMA(1, 1, At, B1); PG8_BAR;
            }
        }
        if constexpr (ALIGN_EPI) { if (wr == 0) PG8_BAR; }
        if constexpr (FP8) asm volatile("s_nop 15\n\ts_nop 15" ::: "memory");
        if constexpr (!Epi::AFTER_DRAIN) { E(acc, cur, wr, wc, fr, fq); S.done(cur); }
        if (!has_next) break;
#pragma unroll
        for (int a = 0; a < 2; ++a)
#pragma unroll
            for (int b = 0; b < 2; ++b)
#pragma unroll
                for (int m = 0; m < 4; ++m)
#pragma unroll
                    for (int n = 0; n < 2; ++n) acc[a][b][m][n] = (f32x4){0.f, 0.f, 0.f, 0.f};
        cur = nxt; cA = nA; cB = nB; ++ui;
        if constexpr (ALIGN_EPI) { if (wr == 1) PG8_BAR; }
    }
    PG8_WAIT_V(0);
    if constexpr (!ALIGN_EPI) { if (wr == 0) PG8_BAR; }
    PG8_BAR;
    if constexpr (Epi::AFTER_DRAIN) { E.fused(acc, cur, wr, wc, fr, fq, lds, wid, lane); S.done(cur); }
#undef PG8_SA
#undef PG8_SB
#undef PG8_STAGE
#undef PG8_LDA
#undef PG8_LD8
#undef PG8_LDB
#undef PG8_MMA
#undef PG8_WAIT_V
#undef PG8_WAIT_L
#undef PG8_BAR
#undef PG8_SCHED
}
}
namespace pg8 {
typedef unsigned u32x2 __attribute__((ext_vector_type(2)));
constexpr int LDX = 2048;
constexpr float RMS_EPS = 1e-6f;
#ifndef EPI_SC1
#define EPI_SC1 1
#endif
__device__ __forceinline__ void store16(void* p, u32x4 w) {
#if EPI_SC1
    asm volatile("global_store_dwordx4 %0, %1, off sc1\n\ts_nop 1" :: "v"(p), "v"(w) : "memory");
#else
    *(u32x4*)p = w;
#endif
}
struct EpiQKV {
    static constexpr bool PERM = true, AFTER_DRAIN = false;
    bf16_t* O; const float* cs; float qscale; float* ksum; int vmode; float vscale; const float* rinv; float pre; int pnoff;
    __device__ __forceinline__ void operator()(const f32x4 (&acc)[2][2][4][2], const Unit& u, int wr, int wc, int fr, int fq) const {
        const int row0 = u.pm * BM + wr * 64 + fr, pn = vmode ? (u.pn < 4 ? u.pn + 8 : u.pn + 16) : (u.pn + pnoff < 8 ? u.pn + pnoff : u.pn + pnoff + 4);
        const float sc = (pn < 4 || (pn >= 12 && pn < 16)) ? qscale : vscale;
        const bool rot = (pn >= 12 && pn < 20) && (wc == 0);
        bf16_t* Ot = O + ((size_t)((u.pm >> 3) * 6 + (pn >> 2)) * 8 + (pn & 3) * 2) * (2048 * 128) + wc * 32 + 8 * fq;
        const bool kacc = (pn >= 16 && pn < 20);
        float rf[2][4];
#pragma unroll
        for (int ai = 0; ai < 2; ++ai)
#pragma unroll
            for (int m = 0; m < 4; ++m) rf[ai][m] = rinv[row0 + ai * HALF + m * 16] * pre;
        f32x4 ks[2][2] = {{{0.f, 0.f, 0.f, 0.f}, {0.f, 0.f, 0.f, 0.f}}, {{0.f, 0.f, 0.f, 0.f}, {0.f, 0.f, 0.f, 0.f}}};
#pragma unroll
        for (int ai = 0; ai < 2; ++ai)
#pragma unroll
            for (int m = 0; m < 4; ++m) { const int row = row0 + ai * HALF + m * 16; bf16_t* rowp = Ot + (size_t)(row & 2047) * 128;
                f32x4 c0 = {1.f, 1.f, 1.f, 1.f}, c1 = c0, s0 = {0.f, 0.f, 0.f, 0.f}, s1 = s0;
                if (rot) { const float* cr = cs + (size_t)row * 32 + 8 * (fq & 1); c0 = *(const f32x4*)cr; c1 = *(const f32x4*)(cr + 4); s0 = *(const f32x4*)(cr + 16); s1 = *(const f32x4*)(cr + 20);
                    if (fq < 2) { s0 = -s0; s1 = -s1; } }
#pragma unroll
                for (int bj = 0; bj < 2; ++bj) { f32x4 v0 = acc[ai][bj][m][0] * rf[ai][m], v1 = acc[ai][bj][m][1] * rf[ai][m];
                    if (rot) { f32x4 p0, p1;
#pragma unroll
                        for (int j = 0; j < 4; ++j) { p0[j] = __shfl_xor(v0[j], 32); p1[j] = __shfl_xor(v1[j], 32); }
                        v0 = v0 * c0 + p0 * s0; v1 = v1 * c1 + p1 * s1; }
                    if (kacc) { ks[bj][0] += v0; ks[bj][1] += v1; }
                    v0 = v0 * sc; v1 = v1 * sc; u32x4 w; w.x = cvt_pk_bf16(v0[0], v0[1]); w.y = cvt_pk_bf16(v0[2], v0[3]); w.z = cvt_pk_bf16(v1[0], v1[1]); w.w = cvt_pk_bf16(v1[2], v1[3]);
                    store16(rowp + (size_t)bj * (2048 * 128), w); } }
        if (kacc) {
            float* kp = ksum + (size_t)(((u.pm >> 3) * 8 + (pn - 16) * 2) * 8 + (u.pm & 7)) * 128 + wc * 32 + 8 * fq;
#pragma unroll
            for (int bj = 0; bj < 2; ++bj)
#pragma unroll
                for (int n = 0; n < 2; ++n)
#pragma unroll
                    for (int j = 0; j < 4; ++j) { float s = ks[bj][n][j]; s += __shfl_xor(s, 1); s += __shfl_xor(s, 2); s += __shfl_xor(s, 4); s += __shfl_xor(s, 8);
                        if (fr == 0) atomicAdd(kp + bj * 1024 + n * 4 + j, s); }
        }
    }
};
__device__ __forceinline__ unsigned pk4_fp8(float a, float b, float c, float d) {
    a = __builtin_amdgcn_fmed3f(a, -448.f, 448.f); b = __builtin_amdgcn_fmed3f(b, -448.f, 448.f); c = __builtin_amdgcn_fmed3f(c, -448.f, 448.f); d = __builtin_amdgcn_fmed3f(d, -448.f, 448.f);
    int p = __builtin_amdgcn_cvt_pk_fp8_f32(a, b, 0, false); p = __builtin_amdgcn_cvt_pk_fp8_f32(c, d, p, true); return (unsigned)p; }
struct EpiRes {
    static constexpr bool PERM = false, AFTER_DRAIN = false;
    const float* base; float* out; bf16_t* xb; float* ssq; unsigned char* x8; float s8; float ascale;
    __device__ __forceinline__ void operator()(const f32x4 (&acc)[2][2][4][2], const Unit& u, int wr, int wc, int fr, int fq) const {
        const int row0 = u.pm * BM + wr * 64 + fr, col0 = u.pn * BM + wc * 32 + 4 * fq;
#pragma unroll
        for (int ai = 0; ai < 2; ++ai)
#pragma unroll
            for (int m = 0; m < 4; ++m) { const int row = row0 + ai * HALF + m * 16; const size_t off = (size_t)row * LDX + col0; float s = 0.f;
#pragma unroll
                for (int bj = 0; bj < 2; ++bj)
#pragma unroll
                    for (int n = 0; n < 2; ++n) { const f32x4 v = *(const f32x4*)(base + off + bj * HALF + n * 16) + acc[ai][bj][m][n] * ascale;
                        *(f32x4*)(out + off + bj * HALF + n * 16) = v; s += (v[0] * v[0] + v[1] * v[1]) + (v[2] * v[2] + v[3] * v[3]);
                        if (xb) { u32x2 w; w.x = cvt_pk_bf16(v[0], v[1]); w.y = cvt_pk_bf16(v[2], v[3]); *(u32x2*)(xb + off + bj * HALF + n * 16) = w; }
                        if (x8) { *(unsigned*)(x8 + off + bj * HALF + n * 16) = pk4_fp8(v[0] * s8, v[1] * s8, v[2] * s8, v[3] * s8); } }
                if (ssq) { s += __shfl_xor(s, 16); s += __shfl_xor(s, 32); if (fq == 0) atomicAdd(ssq + row, s); }
                asm volatile("" ::: "memory"); }
    }
};
template <bool BASE_F32> struct EpiResB {
    static constexpr bool PERM = true, AFTER_DRAIN = false;
    const void* base; bf16_t* xo; float* ssq; unsigned char* x8; float s8; float ascale;
    __device__ __forceinline__ void operator()(const f32x4 (&acc)[2][2][4][2], const Unit& u, int wr, int wc, int fr, int fq) const {
        const int row0 = u.pm * BM + wr * 64 + fr, col0 = u.pn * BM + wc * 32 + 8 * fq;
#pragma unroll
        for (int ai = 0; ai < 2; ++ai)
#pragma unroll
            for (int m = 0; m < 4; ++m) { const int row = row0 + ai * HALF + m * 16; const size_t off = (size_t)row * LDX + col0; float s = 0.f;
#pragma unroll
                for (int bj = 0; bj < 2; ++bj) { f32x4 b0, b1;
                    if (BASE_F32) { const float* bp = (const float*)base + off + bj * HALF; b0 = *(const f32x4*)bp; b1 = *(const f32x4*)(bp + 4); }
                    else { const u32x4 w = *(const u32x4*)((const bf16_t*)base + off + bj * HALF);
                        b0 = (f32x4){__uint_as_float(w.x << 16), __uint_as_float(w.x & 0xffff0000u), __uint_as_float(w.y << 16), __uint_as_float(w.y & 0xffff0000u)};
                        b1 = (f32x4){__uint_as_float(w.z << 16), __uint_as_float(w.z & 0xffff0000u), __uint_as_float(w.w << 16), __uint_as_float(w.w & 0xffff0000u)}; }
                    const f32x4 v0 = b0 + acc[ai][bj][m][0] * ascale, v1 = b1 + acc[ai][bj][m][1] * ascale;
                    s += ((v0[0] * v0[0] + v0[1] * v0[1]) + (v0[2] * v0[2] + v0[3] * v0[3])) + ((v1[0] * v1[0] + v1[1] * v1[1]) + (v1[2] * v1[2] + v1[3] * v1[3]));
                    if (xo) { u32x4 w; w.x = cvt_pk_bf16(v0[0], v0[1]); w.y = cvt_pk_bf16(v0[2], v0[3]); w.z = cvt_pk_bf16(v1[0], v1[1]); w.w = cvt_pk_bf16(v1[2], v1[3]); store16(xo + off + bj * HALF, w); }
                    if (x8) { u32x2 w8; w8.x = pk4_fp8(v0[0] * s8, v0[1] * s8, v0[2] * s8, v0[3] * s8); w8.y = pk4_fp8(v1[0] * s8, v1[1] * s8, v1[2] * s8, v1[3] * s8); *(u32x2*)(x8 + off + bj * HALF) = w8; } }
                if (ssq) { s += __shfl_xor(s, 16); s += __shfl_xor(s, 32); if (fq == 0) atomicAdd(ssq + row, s); }
                if (BASE_F32 ? (m & 1) : (m == 3)) asm volatile("" ::: "memory"); }
    }
};
struct EpiScale {
    static constexpr bool PERM = true, AFTER_DRAIN = false;
    bf16_t* O; int ldc; const float* ssq; float sc;
    __device__ __forceinline__ void operator()(const f32x4 (&acc)[2][2][4][2], const Unit& u, int wr, int wc, int fr, int fq) const {
        const int row0 = u.pm * BM + wr * 64 + fr, col0 = u.pn * BM + wc * 32 + 8 * fq;
        float sv[2][4];
#pragma unroll
        for (int ai = 0; ai < 2; ++ai)
#pragma unroll
            for (int m = 0; m < 4; ++m) sv[ai][m] = ssq ? ssq[row0 + ai * HALF + m * 16] : 0.f;
#pragma unroll
        for (int ai = 0; ai < 2; ++ai)
#pragma unroll
            for (int m = 0; m < 4; ++m) { const int row = row0 + ai * HALF + m * 16; bf16_t* rowp = O + (size_t)row * ldc + col0;
                const float f = ssq ? sc * __builtin_amdgcn_rsqf(sv[ai][m] * (1.0f / 2048.0f) + RMS_EPS) : sc;
#pragma unroll
                for (int bj = 0; bj < 2; ++bj) { const f32x4 v0 = acc[ai][bj][m][0] * f, v1 = acc[ai][bj][m][1] * f;
                    u32x4 w; w.x = cvt_pk_bf16(v0[0], v0[1]); w.y = cvt_pk_bf16(v0[2], v0[3]); w.z = cvt_pk_bf16(v1[0], v1[1]); w.w = cvt_pk_bf16(v1[2], v1[3]);
                    *(u32x4*)(rowp + bj * HALF) = w; } }
    }
};
struct EpiNull { static constexpr bool PERM = true, AFTER_DRAIN = false; float* sink;
    __device__ __forceinline__ void operator()(const f32x4 (&acc)[2][2][4][2], const Unit& u, int wr, int wc, int fr, int fq) const {
#pragma unroll
        for (int ai = 0; ai < 2; ++ai)
#pragma unroll
            for (int bj = 0; bj < 2; ++bj)
#pragma unroll
                for (int m = 0; m < 4; ++m)
#pragma unroll
                    for (int n = 0; n < 2; ++n) asm volatile("" :: "v"(acc[ai][bj][m][n])); } };
struct EpiSwiGLU {
    static constexpr bool PERM = true, AFTER_DRAIN = false;
    bf16_t* O; const float* ssq; unsigned char* O8; float ascale, oscale;
    __device__ __forceinline__ void operator()(const f32x4 (&acc)[2][2][4][2], const Unit& u, int wr, int wc, int fr, int fq) const {
        const int row0 = u.pm * BM + wr * 64 + fr, col0 = u.pn * HALF + wc * 32 + 8 * fq;
        float sv[2][4];
#pragma unroll
        for (int ai = 0; ai < 2; ++ai)
#pragma unroll
            for (int m = 0; m < 4; ++m) sv[ai][m] = ssq[row0 + ai * HALF + m * 16];
#pragma unroll
        for (int ai = 0; ai < 2; ++ai)
#pragma unroll
            for (int m = 0; m < 4; ++m) { const int row = row0 + ai * HALF + m * 16; bf16_t* rowp = O + (size_t)row * 5632 + col0;
                const float f = ascale * __builtin_amdgcn_rsqf(sv[ai][m] * (1.0f / 2048.0f) + RMS_EPS);
                const float fneg = -1.4426950408889634f * f, f2o = f * f * (O8 ? oscale : 1.0f);
                float r[8];
#pragma unroll
                for (int n = 0; n < 2; ++n)
#pragma unroll
                    for (int j = 0; j < 4; ++j) { const float ag = acc[ai][0][m][n][j], au = acc[ai][1][m][n][j];
                        r[n * 4 + j] = (ag * au) * (f2o * __builtin_amdgcn_rcpf(1.0f + __builtin_amdgcn_exp2f(fneg * ag))); }
                if (O8) { u32x2 w8; w8.x = pk4_fp8(r[0], r[1], r[2], r[3]); w8.y = pk4_fp8(r[4], r[5], r[6], r[7]);
                    *(u32x2*)(O8 + (size_t)row * 5632 + col0) = w8; }
                else { u32x4 w; w.x = cvt_pk_bf16(r[0], r[1]); w.y = cvt_pk_bf16(r[2], r[3]); w.z = cvt_pk_bf16(r[4], r[5]); w.w = cvt_pk_bf16(r[6], r[7]);
                *(u32x4*)rowp = w; } }
    }
};
}
namespace att {
using bf16x8 = __attribute__((ext_vector_type(8))) short;
using s16x4  = __attribute__((ext_vector_type(4))) short;
using f32x16 = __attribute__((ext_vector_type(16))) float;
using f32x4  = __attribute__((ext_vector_type(4))) float;
using u32x4  = __attribute__((ext_vector_type(4))) unsigned;
typedef unsigned short bf16;
constexpr int D = 128, KVBLK = 64;
constexpr int SHM_V = KVBLK * D * 2, SHM_K = KVBLK * D * 2;
constexpr int OFF_Q = 2 * SHM_V + 2 * SHM_K, OFF_WS = 131072 + 1024, OFF_KM = OFF_WS + 2048, ATT_LDS = OFF_KM + 4096;
constexpr float THR = 8.f;
constexpr float SB_DONE = 7.8886e-31f;
#ifndef QREG_SOFTMAX
#define QREG_SOFTMAX 1
#endif
#ifndef PIPE_SOFTMAX
#define PIPE_SOFTMAX 0
#endif
#define KSWZ(row, colB) ((row) * 256 + ((colB) ^ (((row) & 7) << 4)))
#define SBAR() __builtin_amdgcn_sched_barrier(0)
__device__ __forceinline__ int crow(int r, int hi) { return (r & 3) + 8 * (r >> 2) + 4 * hi; }
__device__ __forceinline__ unsigned cvtpk(float lo, float hi) { unsigned r; asm volatile("v_cvt_pk_bf16_f32 %0, %1, %2" : "=v"(r) : "v"(lo), "v"(hi)); return r; }
__device__ __forceinline__ float xchg32(float x, int hi) { auto rr = __builtin_amdgcn_permlane32_swap(__float_as_uint(x), __float_as_uint(x), false, false); return __uint_as_float(hi ? rr[0] : rr[1]); }
typedef __attribute__((address_space(3))) const char* lds_cp;
template <int D0> __device__ __forceinline__ void qkt_part(f32x16& p0, f32x16& p1, const lds_cp (&ka)[2][4], int boff, const lds_cp (&qa)[2][4]) {
  const bf16x8 qf = *reinterpret_cast<const __attribute__((address_space(3))) bf16x8*>(qa[D0 >> 2][D0 & 3]);
  const bf16x8 b0 = *reinterpret_cast<const __attribute__((address_space(3))) bf16x8*>(ka[D0 >> 2][D0 & 3] + boff);
  const bf16x8 b1 = *reinterpret_cast<const __attribute__((address_space(3))) bf16x8*>(ka[D0 >> 2][D0 & 3] + boff + 8192);
  p0 = __builtin_amdgcn_mfma_f32_32x32x16_bf16(b0, qf, p0, 0, 0, 0);
  p1 = __builtin_amdgcn_mfma_f32_32x32x16_bf16(b1, qf, p1, 0, 0, 0);
}
template <int D0> __device__ __forceinline__ void qkt_part(f32x16& p0, f32x16& p1, const lds_cp (&ka)[2][4], int boff, const bf16x8 (&qg)[8]) {
  const bf16x8 b0 = *reinterpret_cast<const __attribute__((address_space(3))) bf16x8*>(ka[D0 >> 2][D0 & 3] + boff);
  const bf16x8 b1 = *reinterpret_cast<const __attribute__((address_space(3))) bf16x8*>(ka[D0 >> 2][D0 & 3] + boff + 8192);
  p0 = __builtin_amdgcn_mfma_f32_32x32x16_bf16(b0, qg[D0], p0, 0, 0, 0);
  p1 = __builtin_amdgcn_mfma_f32_32x32x16_bf16(b1, qg[D0], p1, 0, 0, 0);
}
#define KLD(G, A0, A1) do { A0 = *reinterpret_cast<const __attribute__((address_space(3))) bf16x8*>(ka[(G) >> 2][(G) & 3] + boff); A1 = *reinterpret_cast<const __attribute__((address_space(3))) bf16x8*>(ka[(G) >> 2][(G) & 3] + boff + 8192); } while (0)
#define KMM(G, A0, A1) do { p0 = __builtin_amdgcn_mfma_f32_32x32x16_bf16(A0, qg[G], p0, 0, 0, 0); p1 = __builtin_amdgcn_mfma_f32_32x32x16_bf16(A1, qg[G], p1, 0, 0, 0); } while (0)
__device__ __forceinline__ void qkt(f32x16& p0, f32x16& p1, const lds_cp (&ka)[2][4], int boff, const bf16x8 (&qg)[8], float bias = 0.f) {
#pragma unroll
  for (int r = 0; r < 16; ++r) { p0[r] = bias; p1[r] = bias; }
  bf16x8 a0, a1, b0, b1, c0, c1, d0, d1;
  KLD(0, a0, a1); KLD(1, b0, b1); KLD(2, c0, c1); KLD(3, d0, d1); SBAR();
  KMM(0, a0, a1); SBAR(); KLD(4, a0, a1); SBAR();
  KMM(1, b0, b1); SBAR(); KLD(5, b0, b1); SBAR();
  KMM(2, c0, c1); SBAR(); KLD(6, c0, c1); SBAR();
  KMM(3, d0, d1); SBAR(); KLD(7, d0, d1); SBAR();
  KMM(4, a0, a1); KMM(5, b0, b1); KMM(6, c0, c1); KMM(7, d0, d1);
}
#undef KLD
#undef KMM
__device__ __forceinline__ void qkt(f32x16& p0, f32x16& p1, const lds_cp (&ka)[2][4], int boff, const lds_cp (&qr)[2][4], float bias = 0.f) {
#pragma unroll
  for (int r = 0; r < 16; ++r) { p0[r] = bias; p1[r] = bias; }
  qkt_part<0>(p0, p1, ka, boff, qr); qkt_part<1>(p0, p1, ka, boff, qr); qkt_part<2>(p0, p1, ka, boff, qr); qkt_part<3>(p0, p1, ka, boff, qr);
  qkt_part<4>(p0, p1, ka, boff, qr); qkt_part<5>(p0, p1, ka, boff, qr); qkt_part<6>(p0, p1, ka, boff, qr); qkt_part<7>(p0, p1, ka, boff, qr);
}
__device__ __forceinline__ int v_st(int k, int c) { const int kk = (k & ~0xC) | ((k & 4) << 1) | ((k & 8) >> 1); return ((kk >> 3) * 4 + (c >> 5)) * 512 + ((kk & 7) * 32 + (c & 31)) * 2; }
__device__ __forceinline__ int v_rd_base(int lane) { return ((lane & 3) << 3) | (((lane >> 2) & 3) << 6) | (((lane >> 4) & 1) << 5) | (((lane >> 5) & 1) << 8); }
constexpr int v_rd_off(int d0, int ks, int half) { return d0 * 512 + ks * 4096 + half * 2048; }
template <int OFF> __device__ __forceinline__ s16x4 tr_read(int vb) { s16x4 r; asm volatile("ds_read_b64_tr_b16 %0, %1 offset:%2" : "=&v"(r) : "v"(vb), "i"(OFF) : "memory"); return r; }
struct VFrag { s16x4 l0, h0, l1, h1, l2, h2, l3, h3; };
template <int D0> __device__ __forceinline__ void v_read(VFrag& f, int vb) {
  f.l0 = tr_read<v_rd_off(D0, 0, 0)>(vb); f.h0 = tr_read<v_rd_off(D0, 0, 1)>(vb); f.l1 = tr_read<v_rd_off(D0, 1, 0)>(vb); f.h1 = tr_read<v_rd_off(D0, 1, 1)>(vb);
  f.l2 = tr_read<v_rd_off(D0, 2, 0)>(vb); f.h2 = tr_read<v_rd_off(D0, 2, 1)>(vb); f.l3 = tr_read<v_rd_off(D0, 3, 0)>(vb); f.h3 = tr_read<v_rd_off(D0, 3, 1)>(vb);
}
__device__ __forceinline__ void pv_mma(f32x16& od, const VFrag& f, bf16x8 pa0, bf16x8 pa1, bf16x8 pa2, bf16x8 pa3) {
#define PK(L, H) (bf16x8){L[0], L[1], L[2], L[3], H[0], H[1], H[2], H[3]}
  od = __builtin_amdgcn_mfma_f32_32x32x16_bf16(pa0, PK(f.l0, f.h0), od, 0, 0, 0);
  od = __builtin_amdgcn_mfma_f32_32x32x16_bf16(pa1, PK(f.l1, f.h1), od, 0, 0, 0);
  od = __builtin_amdgcn_mfma_f32_32x32x16_bf16(pa2, PK(f.l2, f.h2), od, 0, 0, 0);
  od = __builtin_amdgcn_mfma_f32_32x32x16_bf16(pa3, PK(f.l3, f.h3), od, 0, 0, 0);
#undef PK
}
__device__ __forceinline__ void pv_d0(f32x16* o, int vb, bf16x8 pa0, bf16x8 pa1, bf16x8 pa2, bf16x8 pa3) {
  VFrag fa, fb;
  v_read<0>(fa, vb);
  v_read<1>(fb, vb); asm volatile("s_waitcnt lgkmcnt(8)" ::: "memory"); SBAR(); pv_mma(o[0], fa, pa0, pa1, pa2, pa3); SBAR();
  v_read<2>(fa, vb); asm volatile("s_waitcnt lgkmcnt(8)" ::: "memory"); SBAR(); pv_mma(o[1], fb, pa0, pa1, pa2, pa3); SBAR();
  v_read<3>(fb, vb); asm volatile("s_waitcnt lgkmcnt(8)" ::: "memory"); SBAR(); pv_mma(o[2], fa, pa0, pa1, pa2, pa3); SBAR();
  asm volatile("s_waitcnt lgkmcnt(0)" ::: "memory"); SBAR(); pv_mma(o[3], fb, pa0, pa1, pa2, pa3);
}
__device__ __forceinline__ void pack_p(const f32x16& p0, const f32x16& p1, bf16x8& pa0, bf16x8& pa1, bf16x8& pa2, bf16x8& pa3) {
#define PK4(P, BASE, OUT) do { unsigned a0 = cvtpk(P[BASE + 0], P[BASE + 1]), a1 = cvtpk(P[BASE + 2], P[BASE + 3]);   \
    unsigned b0 = cvtpk(P[BASE + 4], P[BASE + 5]), b1 = cvtpk(P[BASE + 6], P[BASE + 7]);                              \
    auto r0 = __builtin_amdgcn_permlane32_swap(a0, b0, false, false); auto r1 = __builtin_amdgcn_permlane32_swap(a1, b1, false, false); \
    u32x4 w = {r0[0], r1[0], r0[1], r1[1]}; OUT = *reinterpret_cast<bf16x8*>(&w); } while (0)
  PK4(p0, 0, pa0); PK4(p0, 8, pa1); PK4(p1, 0, pa2); PK4(p1, 8, pa3);
#undef PK4
}
__device__ __forceinline__ void softmax_tile(f32x16& p0, f32x16& p1, float& m_reg, float& l_reg, float& alpha) {
  float pmax = p0[0];
#pragma unroll
  for (int r = 1; r < 16; ++r) pmax = fmaxf(pmax, p0[r]);
#pragma unroll
  for (int r = 0; r < 16; ++r) pmax = fmaxf(pmax, p1[r]);
  pmax = fmaxf(pmax, xchg32(pmax, (int)(threadIdx.x >> 5) & 1));
  if (__all(pmax - m_reg <= THR)) { alpha = 1.f; }
  else { const float mn = fmaxf(m_reg, pmax); alpha = __builtin_amdgcn_exp2f(m_reg - mn); m_reg = mn; }
  float ps = 0.f;
#pragma unroll
  for (int r = 0; r < 16; ++r) { p0[r] = __builtin_amdgcn_exp2f(p0[r] - m_reg); ps += p0[r]; }
#pragma unroll
  for (int r = 0; r < 16; ++r) { p1[r] = __builtin_amdgcn_exp2f(p1[r] - m_reg); ps += p1[r]; }
  ps += xchg32(ps, (int)(threadIdx.x >> 5) & 1);
  l_reg = l_reg * alpha + ps;
}
template <bool BAND, int I> __device__ __forceinline__ float sb_group(f32x16& P, int kb, int qrel, int hi) {
  float run = 1.f;
#pragma unroll
  for (int e = 3; e >= 0; --e) { const int r = 4 * I + e; float rr = __builtin_amdgcn_rcpf(1.0f + __builtin_amdgcn_exp2f(P[r]));
    if (BAND) rr = (kb + crow(r, hi) < qrel) ? rr : 1.f;
    P[r] = (1.0f - rr) * run; run *= rr; }
  return run;
}
__device__ __forceinline__ void sb_combine(f32x16& p0, f32x16& p1, float (&gs)[8], float& carry, int hi) {
  float acc = 1.f;
#pragma unroll
  for (int i = 7; i >= 0; --i) { const float so_i = acc; acc *= gs[i]; const float x = hi ? acc : so_i; gs[i] = carry * so_i * xchg32(x, hi); }
  carry *= acc * xchg32(acc, hi);
#pragma unroll
  for (int i = 0; i < 4; ++i)
#pragma unroll
    for (int e = 0; e < 4; ++e) { p0[4 * i + e] *= gs[i]; p1[4 * i + e] *= gs[4 + i]; }
}
template <bool BAND>
__device__ __forceinline__ void sb_tile(f32x16& p0, f32x16& p1, float& carry, int kb, int qrel, int hi) {
  float gs[8];
  gs[0] = sb_group<BAND, 0>(p0, kb, qrel, hi); SBAR(); gs[1] = sb_group<BAND, 1>(p0, kb, qrel, hi); SBAR(); gs[2] = sb_group<BAND, 2>(p0, kb, qrel, hi); SBAR(); gs[3] = sb_group<BAND, 3>(p0, kb, qrel, hi); SBAR();
  gs[4] = sb_group<BAND, 0>(p1, kb + 32, qrel, hi); SBAR(); gs[5] = sb_group<BAND, 1>(p1, kb + 32, qrel, hi); SBAR(); gs[6] = sb_group<BAND, 2>(p1, kb + 32, qrel, hi); SBAR(); gs[7] = sb_group<BAND, 3>(p1, kb + 32, qrel, hi); SBAR();
  sb_combine(p0, p1, gs, carry, hi);
}

template <int MODE, bool OUT8 = false>
__device__ __forceinline__ void attn_unit(const bf16* __restrict__ Qb_or_hb, const bf16* __restrict__ Kh_in, const bf16* __restrict__ Vh_in, bf16* __restrict__ Ob,
                                          const float* __restrict__ gain, const float* __restrict__ kmean, int qb, int nkeys, char* lds, float s8 = 1.f,
                                          bool preissued = false, const bf16* __restrict__ nhb = nullptr, int nqb = 0, int nt0 = 0, int nt1 = -1) {
  constexpr int ldq = (MODE == 0) ? 512 : 128, ldk = (MODE == 0) ? 1024 : 128, ldo = (MODE == 0) ? 512 : 2048;
  constexpr long HSZ_ = 2048L * 128L;
  const bf16* __restrict__ Qb = (MODE == 0) ? Qb_or_hb : Qb_or_hb + (long)qb * (256 * 128);
  const bf16* __restrict__ Kh = (MODE == 0) ? Kh_in : Qb_or_hb + 8 * HSZ_;
  const bf16* __restrict__ Vh = (MODE == 0) ? Vh_in : Qb_or_hb + 16 * HSZ_;
  int tid_ = threadIdx.x; asm volatile("" : "+v"(tid_));
  const int tid = tid_, wid = __builtin_amdgcn_readfirstlane(tid >> 6), lane = tid & 63, r32 = lane & 31, hi = lane >> 5;
  char* V_lds = lds; char* K_lds = lds + 2 * SHM_V;
  float* ws = (float*)(lds + OFF_WS) + wid * 64; float* li_l = ws; float* al_l = ws + 32;
  float* km_l = (float*)(lds + OFF_KM);
  int* flg = (int*)(lds + OFF_KM);
  const int NT = (MODE == 0) ? nkeys / KVBLK : 4 * (qb + 1);
  const int qrel = wid * 32 + r32;
  float m_reg = -1e30f, l_reg = 0.f, carry = 1.f; f32x16 o[4] = {};
  const int vb0 = (int)(uintptr_t)V_lds + v_rd_base(lane);
  lds_cp ka[2][4];
#pragma unroll
  for (int y = 0; y < 2; ++y)
#pragma unroll
    for (int x = 0; x < 4; ++x) ka[y][x] = (lds_cp)(__attribute__((address_space(3))) char*)K_lds + r32 * 256 + 128 * (y ^ ((r32 >> 3) & 1)) + 32 * (x ^ ((r32 >> 1) & 3)) + 16 * (hi ^ (r32 & 1));
  lds_cp qr[2][4];
#pragma unroll
  for (int y = 0; y < 2; ++y)
#pragma unroll
    for (int x = 0; x < 4; ++x) qr[y][x] = ka[y][x] + (OFF_Q - 2 * SHM_V) + wid * 8192;
  long ksrc[2], vsrc[2];
#pragma unroll
  for (int i = 0; i < 2; ++i) { const int piece = wid + 8 * i;
    { const int row = piece * 4 + (lane >> 4), c = (lane & 15) ^ (row & 15); ksrc[i] = (long)row * ldk + c * 8; }
    { const int sub = piece * 2 + (lane >> 5), kk = (sub >> 2) * 8 + ((lane & 31) >> 2), k = (kk & ~0xC) | ((kk & 4) << 1) | ((kk & 8) >> 1), c = (sub & 3) * 32 + (lane & 3) * 8; vsrc[i] = (long)k * ldk + c; } }
  typedef __attribute__((address_space(3))) unsigned lds_u32;
  lds_u32* kdst = (lds_u32*)(__attribute__((address_space(3))) char*)(K_lds) + wid * 256; lds_u32* vdst = (lds_u32*)(__attribute__((address_space(3))) char*)(V_lds) + wid * 256;
#define TILE(it) ((MODE == 2) ? (NT - 1 - (it)) : (it))
#define DMA_K(k0, b) do { _Pragma("unroll") for (int i_ = 0; i_ < 2; ++i_) __builtin_amdgcn_global_load_lds((const unsigned*)(Kh + (long)(k0) * ldk + ksrc[i_]), kdst + (b) * (SHM_K / 4) + i_ * 2048, 16, 0, 0); } while (0)
#define DMA_V(k0, b) do { _Pragma("unroll") for (int i_ = 0; i_ < 2; ++i_) __builtin_amdgcn_global_load_lds((const unsigned*)(Vh + (long)(k0) * ldk + vsrc[i_]), vdst + (b) * (SHM_V / 4) + i_ * 2048, 16, 0, 0); } while (0)
#define SDRAIN() asm volatile("s_waitcnt vmcnt(0)" ::: "memory")
#define KSLOT(i_) ((i_) == 2 ? (OFF_Q - 2 * SHM_V) : (i_) * SHM_K)
#define VSLOT(i_) ((i_) == 2 ? (OFF_Q + SHM_K) : (i_) * SHM_V)
#define DMA_K3(k0, so) do { _Pragma("unroll") for (int i_ = 0; i_ < 2; ++i_) __builtin_amdgcn_global_load_lds((const unsigned*)(Kh + (long)(k0) * ldk + ksrc[i_]), kdst + (so) / 4 + i_ * 2048, 16, 0, 0); } while (0)
#define DMA_V3(k0, so) do { _Pragma("unroll") for (int i_ = 0; i_ < 2; ++i_) __builtin_amdgcn_global_load_lds((const unsigned*)(Vh + (long)(k0) * ldk + vsrc[i_]), vdst + (so) / 4 + i_ * 2048, 16, 0, 0); } while (0)
  lds_u32* qdst = (lds_u32*)(__attribute__((address_space(3))) char*)(lds + OFF_Q) + wid * 2048;
#define ISSUE_UNIT(QB_, KH_, VH_, T0_, T1_) do { \
    _Pragma("unroll") for (int i = 0; i < 8; ++i) { const int row = 4 * i + (lane >> 4), c = (lane & 15) ^ (row & 15); \
      __builtin_amdgcn_global_load_lds((const unsigned*)((QB_) + (long)(wid * 32 + row) * ldq + c * 8), qdst + i * 256, 16, 0, 0); } \
    _Pragma("unroll") for (int i_ = 0; i_ < 2; ++i_) { \
      __builtin_amdgcn_global_load_lds((const unsigned*)((KH_) + (long)((T0_) * KVBLK) * ldk + ksrc[i_]), kdst + i_ * 2048, 16, 0, 0); \
      __builtin_amdgcn_global_load_lds((const unsigned*)((VH_) + (long)((T0_) * KVBLK) * ldk + vsrc[i_]), vdst + i_ * 2048, 16, 0, 0); } \
    if ((T1_) >= 0) { _Pragma("unroll") for (int i_ = 0; i_ < 2; ++i_) __builtin_amdgcn_global_load_lds((const unsigned*)((KH_) + (long)((T1_) * KVBLK) * ldk + ksrc[i_]), kdst + (SHM_K / 4) + i_ * 2048, 16, 0, 0); } } while (0)
  if (!preissued) ISSUE_UNIT(Qb, Kh, Vh, TILE(0), ((MODE == 2 || PIPE_SOFTMAX) ? TILE(1) : -1));
  constexpr bool RING3 = (MODE != 2) && QREG_SOFTMAX && !PIPE_SOFTMAX;
  unsigned selmask = 0u;
  float gv[4] = {1.f, 1.f, 1.f, 1.f};
  if (gain) {
#pragma unroll
    for (int d0 = 0; d0 < 4; ++d0) gv[d0] = gain[d0 * 32 + r32]; }
  if (MODE == 1) { if (tid < 256) *(f32x4*)(km_l + tid * 4) = *(const f32x4*)(kmean + tid * 4); }
  SDRAIN();
  __syncthreads();
  if (MODE == 1) {
    float g[8];
#pragma unroll
    for (int n = 0; n < 8; ++n) g[n] = 0.f;
    { const int rh = (r32 >> 1) & 3, r3 = (r32 >> 3) & 1;
      const lds_cp qbase = qr[0][0] - 32 * rh - 128 * r3;
#pragma unroll 1
      for (int d0 = 0; d0 < 8; ++d0) {
        const bf16x8 qf = *reinterpret_cast<const __attribute__((address_space(3))) bf16x8*>(qbase + 32 * ((d0 & 3) ^ rh) + 128 * ((d0 >> 2) ^ r3));
        float q[8];
#pragma unroll
        for (int j = 0; j < 8; ++j) q[j] = __uint_as_float(((unsigned)(unsigned short)qf[j]) << 16);
        const float* kmp = km_l + d0 * 16 + hi * 8;
#pragma unroll
        for (int n = 0; n < 7; ++n) { const f32x4 k0v = *(const f32x4*)(kmp + n * 128), k1v = *(const f32x4*)(kmp + n * 128 + 4);
          g[n] += (q[0] * k0v[0] + q[1] * k0v[1]) + (q[2] * k0v[2] + q[3] * k0v[3]) + (q[4] * k1v[0] + q[5] * k1v[1]) + (q[6] * k1v[2] + q[7] * k1v[3]); }
      } }
#pragma unroll
    for (int n = 0; n < 7; ++n) { g[n] += xchg32(g[n], hi); if (n >= qb) g[n] = -INFINITY; }
    g[7] = -INFINITY;
#pragma unroll
    for (int n = 0; n < 7; ++n) { int cnt = 0;
#pragma unroll
      for (int mI = 0; mI < 7; ++mI) { if (mI != n) cnt += (g[mI] > g[n] || (g[mI] == g[n] && mI < n)) ? 1 : 0; }
      if (n < qb && cnt < 3) selmask |= (1u << n); }
  }
  bf16x8 qg[8];
  if (QREG_SOFTMAX && MODE != 2) {
#pragma unroll
    for (int d0 = 0; d0 < 8; ++d0) qg[d0] = *reinterpret_cast<const __attribute__((address_space(3))) bf16x8*>(qr[d0 >> 2][d0 & 3]); }
  int kc = KSLOT(0), kn = KSLOT(1), kn2 = KSLOT(2), vc = VSLOT(0), vn = VSLOT(1), vn2 = VSLOT(2);
  if (RING3) { DMA_K3(TILE(1) * KVBLK, kn); DMA_V3(TILE(1) * KVBLK, vn);
    asm volatile("s_waitcnt lgkmcnt(0)" ::: "memory"); __syncthreads(); }
  f32x16 pA0, pA1, pB0, pB1; bf16x8 pa0, pa1, pa2, pa3;
  if (MODE == 2 || PIPE_SOFTMAX) { float bias0 = 0.f; if (MODE == 1) { if (NT > 4) bias0 = (selmask & 1u) ? 0.f : -INFINITY; }
    qkt(pA0, pA1, ka, 0, qr, bias0);
    __syncthreads(); }
  int it = 0;
#define JB(i_) ((MODE == 2) ? (3 - (i_)) : ((i_) - (NT - 4)))
#define STEP(A0, A1, B0, B1, BAND, HASNEXT) do { \
    if (it + 2 < NT) DMA_K(TILE(it + 2) * KVBLK, it & 1); \
    if (it + 1 < NT) DMA_V(TILE(it + 1) * KVBLK, (it + 1) & 1); \
    bool skip = false; const int jb = JB(it); \
    if (BAND) { if (MODE == 1) skip = (64 * jb > wid * 32 + 31); if (MODE == 2) skip = (64 * jb >= wid * 32 + 31); } \
    if (MODE == 2) skip = skip || __all(carry < SB_DONE);        \
    if (HASNEXT) { float bias_ = 0.f; if (MODE == 1) { if (it + 1 < NT - 4) bias_ = ((selmask >> ((it + 1) >> 2)) & 1u) ? 0.f : -INFINITY; } \
      qkt(B0, B1, ka, ((it + 1) & 1) * SHM_K, qr, bias_); } \
    if (!skip) { \
      if (MODE == 2) { sb_tile<(BAND) != 0>(A0, A1, carry, 64 * jb, qrel, hi); } \
      else { \
        if (MODE == 1 && (BAND)) { _Pragma("unroll") for (int r = 0; r < 16; ++r) { const int kr = 64 * jb + crow(r, hi); if (kr > qrel) A0[r] = -INFINITY; if (kr + 32 > qrel) A1[r] = -INFINITY; } } \
        float alpha; softmax_tile(A0, A1, m_reg, l_reg, alpha); \
        if (__any(alpha < 1.f)) { if (hi == 0) al_l[r32] = alpha; asm volatile("s_waitcnt lgkmcnt(0)" ::: "memory"); \
          _Pragma("unroll") for (int d = 0; d < 4; ++d) _Pragma("unroll") for (int r = 0; r < 16; ++r) o[d][r] *= al_l[crow(r, hi)]; } \
      } \
      pack_p(A0, A1, pa0, pa1, pa2, pa3); \
      pv_d0(o, vb0 + (it & 1) * SHM_V, pa0, pa1, pa2, pa3); \
    } \
    SDRAIN(); __syncthreads(); ++it; } while (0)
#define SB_LD(G, F) do { F##q = *reinterpret_cast<const __attribute__((address_space(3))) bf16x8*>(qr[(G) >> 2][(G) & 3]); \
      F##0 = *reinterpret_cast<const __attribute__((address_space(3))) bf16x8*>(ka[(G) >> 2][(G) & 3] + kb_); F##1 = *reinterpret_cast<const __attribute__((address_space(3))) bf16x8*>(ka[(G) >> 2][(G) & 3] + kb_ + 8192); } while (0)
#define SB_PART(G, P, I, B0, B1, FC, FN) do { if ((G) < 7) SB_LD(((G) + 1) & 7, FN);              \
      B0 = __builtin_amdgcn_mfma_f32_32x32x16_bf16(FC##0, FC##q, B0, 0, 0, 0); B1 = __builtin_amdgcn_mfma_f32_32x32x16_bf16(FC##1, FC##q, B1, 0, 0, 0); \
      gs_[G] = sb_group<false, I>(P, 0, 0, hi); SBAR(); } while (0)
#define STEP_SB(A0, A1, B0, B1) do { \
    if (it + 2 < NT) DMA_K(TILE(it + 2) * KVBLK, it & 1); \
    DMA_V(TILE(it + 1) * KVBLK, (it + 1) & 1); \
    float gs_[8]; \
    _Pragma("unroll") for (int r = 0; r < 16; ++r) { B0[r] = 0.f; B1[r] = 0.f; } \
    const int kb_ = ((it + 1) & 1) * SHM_K; bf16x8 fx0, fx1, fxq, fy0, fy1, fyq; SB_LD(0, fx); SBAR(); \
    SB_PART(0, A0, 0, B0, B1, fx, fy); SB_PART(1, A0, 1, B0, B1, fy, fx); SB_PART(2, A0, 2, B0, B1, fx, fy); SB_PART(3, A0, 3, B0, B1, fy, fx); \
    SB_PART(4, A1, 0, B0, B1, fx, fy); SB_PART(5, A1, 1, B0, B1, fy, fx); SB_PART(6, A1, 2, B0, B1, fx, fy); SB_PART(7, A1, 3, B0, B1, fy, fx); \
    sb_combine(A0, A1, gs_, carry, hi); \
    { const bool dn_ = __all(carry < SB_DONE); if (lane == 0) flg[(it & 1) * 8 + wid] = dn_ ? 1 : 0; } \
    pack_p(A0, A1, pa0, pa1, pa2, pa3); \
    pv_d0(o, vb0 + (it & 1) * SHM_V, pa0, pa1, pa2, pa3); \
    SDRAIN(); __syncthreads(); \
    { const int* f_ = flg + (it & 1) * 8; stop = (f_[0] + f_[1] + f_[2] + f_[3] + f_[4] + f_[5] + f_[6] + f_[7]) == 8; } \
    ++it; } while (0)
#define SSTEP(BAND) do { \
    if (RING3) { if (it + 2 < NT) { DMA_K3(TILE(it + 2) * KVBLK, kn2); DMA_V3(TILE(it + 2) * KVBLK, vn2); } } \
    else if (it + 1 < NT) { DMA_K(TILE(it + 1) * KVBLK, (it + 1) & 1); DMA_V(TILE(it + 1) * KVBLK, (it + 1) & 1); } \
    bool skip = false; const int jb = JB(it); \
    if (BAND) skip = (64 * jb > wid * 32 + 31); \
    if (!skip) { \
      float bias_ = 0.f; if (MODE == 1 && !(BAND)) bias_ = ((selmask >> (it >> 2)) & 1u) ? 0.f : -INFINITY; \
      const int kb_ = RING3 ? kc : (it & 1) * SHM_K; \
      if (QREG_SOFTMAX) qkt(pA0, pA1, ka, kb_, qg, bias_); else qkt(pA0, pA1, ka, kb_, qr, bias_); \
      if (MODE == 1 && (BAND)) { _Pragma("unroll") for (int r = 0; r < 16; ++r) { const int kr = 64 * jb + crow(r, hi); if (kr > qrel) pA0[r] = -INFINITY; if (kr + 32 > qrel) pA1[r] = -INFINITY; } } \
      float alpha; softmax_tile(pA0, pA1, m_reg, l_reg, alpha); \
      if (__any(alpha < 1.f)) { if (hi == 0) al_l[r32] = alpha; asm volatile("s_waitcnt lgkmcnt(0)" ::: "memory"); \
        _Pragma("unroll") for (int d = 0; d < 4; ++d) _Pragma("unroll") for (int r = 0; r < 16; ++r) o[d][r] *= al_l[crow(r, hi)]; } \
      pack_p(pA0, pA1, pa0, pa1, pa2, pa3); \
      pv_d0(o, vb0 + (RING3 ? vc : (it & 1) * SHM_V), pa0, pa1, pa2, pa3); \
    } \
    if (RING3) { if (it + 2 < NT) asm volatile("s_waitcnt vmcnt(4)" ::: "memory"); else SDRAIN();        \
      { const int t_ = kc; kc = kn; kn = kn2; kn2 = t_; } { const int t_ = vc; vc = vn; vn = vn2; vn2 = t_; } } \
    else SDRAIN(); \
    if (RING3) { asm volatile("s_waitcnt lgkmcnt(0)" ::: "memory"); __builtin_amdgcn_s_barrier(); asm volatile("" ::: "memory"); }     \
    else __syncthreads(); \
    ++it; } while (0)
#define RESTART(BIASEXPR) do { qkt(pA0, pA1, ka, (it & 1) * SHM_K, qr, (BIASEXPR)); __syncthreads(); } while (0)
  if (MODE == 0) {
    if (PIPE_SOFTMAX) { STEP(pA0, pA1, pB0, pB1, 0, true); STEP(pB0, pB1, pA0, pA1, 0, true); STEP(pA0, pA1, pB0, pB1, 0, true); STEP(pB0, pB1, pA0, pA1, 0, false); }
    else { SSTEP(0); SSTEP(0); SSTEP(0); SSTEP(0); }
  } else if (MODE == 1) {
    if (PIPE_SOFTMAX) {
      if (NT > 4) { while (it < NT - 4) { STEP(pA0, pA1, pB0, pB1, 0, true); STEP(pB0, pB1, pA0, pA1, 0, (it + 1 < NT - 4)); }
        RESTART(0.f); }
      STEP(pA0, pA1, pB0, pB1, 1, true); STEP(pB0, pB1, pA0, pA1, 1, true); STEP(pA0, pA1, pB0, pB1, 1, true); STEP(pB0, pB1, pA0, pA1, 1, false);
    } else {
      while (it < NT - 4) SSTEP(0);
      SSTEP(1); SSTEP(1); SSTEP(1); SSTEP(1);
    }
  } else {
    STEP(pA0, pA1, pB0, pB1, 1, true); STEP(pB0, pB1, pA0, pA1, 1, true); STEP(pA0, pA1, pB0, pB1, 1, true); STEP(pB0, pB1, pA0, pA1, 1, false);
    if (NT > 4) {
      RESTART(0.f);
      bool stop = false;
      while (it + 2 < NT && !stop) { STEP_SB(pA0, pA1, pB0, pB1); STEP_SB(pB0, pB1, pA0, pA1); }
      if (!stop) { STEP_SB(pA0, pA1, pB0, pB1); STEP(pB0, pB1, pA0, pA1, 0, false); }
    }
  }
#undef RESTART
#undef STEP
#undef SSTEP
#undef STEP_SB
#undef SB_LD
#undef SB_PART
#undef JB
  if (OUT8) { if (nhb) ISSUE_UNIT(nhb + (long)nqb * (256 * 128), nhb + 8 * HSZ_, nhb + 16 * HSZ_, nt0, nt1); }
  float rli[16];
  if (MODE != 2) { if (hi == 0) li_l[r32] = l_reg; asm volatile("s_waitcnt lgkmcnt(0)" ::: "memory");
#pragma unroll
    for (int r = 0; r < 16; ++r) rli[r] = __builtin_amdgcn_rcpf(li_l[crow(r, hi)]); }
  else {
#pragma unroll
    for (int r = 0; r < 16; ++r) rli[r] = 1.f; }
  if (gain) {
#pragma unroll
    for (int r = 0; r < 16; ++r) { float s = 0.f;
#pragma unroll
      for (int d0 = 0; d0 < 4; ++d0) { o[d0][r] *= rli[r]; s += o[d0][r] * o[d0][r]; }
      s += __shfl_xor(s, 1); s += __shfl_xor(s, 2); s += __shfl_xor(s, 4); s += __shfl_xor(s, 8); s += __shfl_xor(s, 16);
      rli[r] = __builtin_amdgcn_rsqf(s * (1.0f / 128.0f) + 1e-6f); }
#pragma unroll
    for (int r = 0; r < 16; ++r)
#pragma unroll
      for (int d0 = 0; d0 < 4; ++d0) o[d0][r] *= gv[d0];
  }
  if (OUT8) {
#pragma unroll
    for (int r = 0; r < 16; ++r) { const float f = rli[r] * s8;
      const float v0 = __builtin_amdgcn_fmed3f(o[0][r] * f, -448.f, 448.f), v1 = __builtin_amdgcn_fmed3f(o[1][r] * f, -448.f, 448.f), v2 = __builtin_amdgcn_fmed3f(o[2][r] * f, -448.f, 448.f), v3 = __builtin_amdgcn_fmed3f(o[3][r] * f, -448.f, 448.f);
      int p = __builtin_amdgcn_cvt_pk_fp8_f32(v0, v1, 0, false); p = __builtin_amdgcn_cvt_pk_fp8_f32(v2, v3, p, true);
      *(unsigned*)((unsigned char*)Ob + (long)(wid * 32 + crow(r, hi)) * ldo + 4 * r32) = (unsigned)p; } }
  else { bf16* stg = (bf16*)lds + wid * 4096;
#pragma unroll
    for (int r = 0; r < 16; ++r) { const int orow = crow(r, hi);
#pragma unroll
      for (int d0 = 0; d0 < 4; ++d0) { const float v = o[d0][r] * rli[r]; unsigned u = __float_as_uint(v); u = (u + 0x7fffu + ((u >> 16) & 1u)) >> 16; stg[orow * 128 + d0 * 32 + r32] = (bf16)u; } }
    asm volatile("s_waitcnt lgkmcnt(0)" ::: "memory");
#pragma unroll
    for (int i = 0; i < 8; ++i) { const int row = i * 4 + (lane >> 4), ch = lane & 15; const u32x4 v = *(const u32x4*)(stg + row * 128 + ch * 8); *(u32x4*)(Ob + (long)(wid * 32 + row) * ldo + ch * 8) = v; } }
  __syncthreads();
#undef TILE
#undef ISSUE_UNIT
#undef DMA_K
#undef DMA_V
#undef DMA_K3
#undef DMA_V3
#undef KSLOT
#undef VSLOT
#undef SDRAIN
}
#undef KSWZ
#undef SBAR
}
#define GAS __attribute__((address_space(1)))
#define LAS __attribute__((address_space(3)))
typedef unsigned short bf16;
typedef unsigned v4u __attribute__((ext_vector_type(4)));
typedef float f32x4 __attribute__((ext_vector_type(4)));
#define LDS_WAIT() asm volatile("s_waitcnt lgkmcnt(0)" ::: "memory")
constexpr int NWAVES = 8;
constexpr int BATCH = 8, SEQ = 2048, DM = 2048, M = BATCH * SEQ, HD = 128, NH = 8;
constexpr int NQKV = 6144, FF = 5632, WX = 512, NMEM = 256, MMEM = BATCH * NMEM;
constexpr int QSB = 0, KSB = 1024, VSB = 2048, QMB = 3072, KMB = 4096, VMB = 5120;
constexpr float EPS = 1e-6f;
constexpr float QSCALE = 0.12751743082459868f;
constexpr size_t MiB = 1u << 20;
constexpr size_t WS_CTL = 0, CTL_ZERO_BYTES = 512 * 1024;
constexpr size_t WS_SSQ1 = 64 * 1024, WS_SSQ2 = 128 * 1024;
constexpr size_t WS_KSUM = 256 * 1024;
constexpr size_t WS_WIN = 1 * MiB, WS_WOUT = 25 * MiB, WS_WXQ = 33 * MiB, WS_WXKV = 35 * MiB, WS_WXO = 39 * MiB, WS_WGU = 41 * MiB, WS_WDN = 85 * MiB;
constexpr size_t WS_RA = 107 * MiB;
constexpr size_t WS_RB = 171 * MiB;
constexpr size_t WS_RC = 235 * MiB;
constexpr size_t WS_QX = 427 * MiB, WS_OX = 443 * MiB, WS_KVX = 459 * MiB, WS_MN = 463 * MiB, WS_KMEAN = 471 * MiB, WS_RINV0 = 471 * MiB  , WS_CS = 472 * MiB, WS_END = 474 * MiB;
constexpr int RING_BYTES = 131072, LDS_BYTES = 147456;
#ifndef FFN_FP8
#define FFN_FP8 1
#endif
#ifndef QK_FP8
#define QK_FP8 1
#endif
constexpr float S_X2 = 16.f, S_WGU = 32.f, S_ACT = 8.f, S_WDN = 64.f, S_XN = 16.f, S_WV = 32.f, S_WQK = 32.f, S_O = 16.f, S_WO = 32.f;
constexpr float S_OX = 16.f, S_WXO = 16.f;
#ifndef WXO_FP8
#define WXO_FP8 1
#endif
#ifndef WOUT_FP8
#define WOUT_FP8 1
#endif
constexpr size_t WS_WV8 = WS_WIN + 16 * MiB;

__device__ __forceinline__ float bf2f(unsigned short b) { return __uint_as_float((unsigned)b << 16); }
__device__ __forceinline__ unsigned f2bf(float f) { unsigned u = __builtin_bit_cast(unsigned, f); return (u + 0x7fffu + ((u >> 16) & 1u)) >> 16; }
__device__ __forceinline__ unsigned pk2(float lo, float hi) { return f2bf(lo) | (f2bf(hi) << 16); }
__device__ __forceinline__ float wave_sum(float v) {
#pragma unroll
    for (int o = 1; o < 64; o <<= 1) v += __shfl_xor(v, o);
    return v;
}
__device__ __forceinline__ float wave_max(float v) {
#pragma unroll
    for (int o = 1; o < 64; o <<= 1) v = fmaxf(v, __shfl_xor(v, o));
    return v;
}

typedef GAS unsigned gu32;
#define RLX_AGENT __ATOMIC_RELAXED, __HIP_MEMORY_SCOPE_AGENT
constexpr int CW_BAR = 4096;
constexpr int LDSCTL_OFF = RING_BYTES, MISC_OFF = LDSCTL_OFF + 320;
#define XB_TMO      128
#define XB_XCNT(j)  (256  + 64 * (j))
#define XB_XSUB(j)  (1280 + 64 * (j))
#define XB_XGEN(j)  (2304 + 64 * (j))
#define XB_TOP      3328
#define XB_TOPGEN   3392
#define XCD_BAR_WORDS 3456
#define XB_SPIN_CAP (1u << 18)

__device__ __forceinline__ unsigned xb_ld(unsigned* p)              { return __hip_atomic_load(p, __ATOMIC_RELAXED, __HIP_MEMORY_SCOPE_AGENT); }
__device__ __forceinline__ unsigned xb_add(unsigned* p, unsigned v) { return __hip_atomic_fetch_add(p, v, __ATOMIC_RELAXED, __HIP_MEMORY_SCOPE_AGENT); }
__device__ __forceinline__ unsigned xb_xcc_id() { return (unsigned)__builtin_amdgcn_s_getreg((3 << 11) | 20) & 0xFu; }
#define XB_SPIN(cond, bar) do { unsigned _sp = 0; while (cond) { __builtin_amdgcn_s_sleep(1); \
    if ((++_sp & 255u) == 0u) { if (xb_ld(&(bar)[XB_TMO])) break; if (_sp > XB_SPIN_CAP) { atomicAdd(&(bar)[XB_TMO], 1u); break; } } } } while (0)

struct XcdBarrier {
    unsigned* bar; unsigned x;
    volatile LAS unsigned* st;
};

__device__ __forceinline__ XcdBarrier xcd_barrier_post(unsigned* bar, volatile LAS unsigned* st) {
    XcdBarrier b; b.bar = bar; b.x = xb_xcc_id(); b.st = st;
    if (threadIdx.x == 0) (void)xb_add(&bar[XB_XCNT(b.x)], 1u);
    return b;
}
__device__ __forceinline__ void xcd_barrier_complete(unsigned* bar, unsigned x, unsigned& nloc, unsigned& nx) {
    const unsigned G = gridDim.x * gridDim.y * gridDim.z;
    unsigned sum, cnt, mine, sp = 0u;
    for (;;) {
        sum = 0u; cnt = 0u; mine = 0u;
#pragma unroll
        for (unsigned j = 0; j < 16; ++j) { const unsigned c = xb_ld(&bar[XB_XCNT(j)]); sum += c; cnt += (c > 0u) ? 1u : 0u; mine = (j == x) ? c : mine; }
        if (sum == G) break;
        __builtin_amdgcn_s_sleep(1);
        if ((++sp & 255u) == 0u) { if (xb_ld(&bar[XB_TMO])) break; if (sp > XB_SPIN_CAP) { atomicAdd(&bar[XB_TMO], 1u); break; } }
    }
    nloc = mine > 0u ? mine : 1u; nx = cnt > 0u ? cnt : 1u;
}

__device__ __forceinline__ void xcd_barrier(const XcdBarrier& b) {
    asm volatile("s_waitcnt vmcnt(0)" ::: "memory");
    __syncthreads();
    if (threadIdx.x == 0) {
        unsigned* bar = b.bar;
        __builtin_amdgcn_s_waitcnt(0);
        unsigned nloc = b.st[0], nx = b.st[1];
        if (nloc == 0u) { xcd_barrier_complete(bar, b.x, nloc, nx); b.st[0] = nloc; b.st[1] = nx; }
        const unsigned old = xb_add(&bar[XB_XSUB(b.x)], 1u);
        const unsigned gen = old / nloc;
        if (old + 1u == (gen + 1u) * nloc) {
            __builtin_amdgcn_fence(__ATOMIC_RELEASE, "agent");
            asm volatile("s_waitcnt vmcnt(0)" ::: "memory");
            const unsigned og = xb_add(&bar[XB_TOP], 1u);
            const unsigned tg = og / nx;
            if (og + 1u == (tg + 1u) * nx) xb_add(&bar[XB_TOPGEN], 1u);
            else XB_SPIN(xb_ld(&bar[XB_TOPGEN]) == tg, bar);
            __builtin_amdgcn_fence(__ATOMIC_ACQUIRE, "agent");
            xb_add(&bar[XB_XGEN(b.x)], 1u);
            asm volatile("s_waitcnt vmcnt(0)" ::: "memory");
        } else {
            XB_SPIN(xb_ld(&bar[XB_XGEN(b.x)]) == gen, bar);
            __builtin_amdgcn_fence(__ATOMIC_ACQUIRE, "agent");
            asm volatile("s_waitcnt vmcnt(0)" ::: "memory");
        }
    }
    __syncthreads();
}

struct Frame {
    LAS unsigned char* lds;
    int tid, lane, wave, vcu, G;
    const float *x, *mem; const int* pos;
    const float *g_mix, *w_in, *g_out_sb, *g_out_mb, *w_out, *g_xattn, *g_mem, *w_xq, *w_xkv, *w_xo, *g_ffn, *w_gu, *w_dn, *g_final;
    float* out; unsigned char* ws;
};

__device__ __forceinline__ void transpose_item(const float* W, int K, int N, bf16* WT, const float* gain, int inter, LAS float* scr, int item, int lane) {
    const int nblk = N / 32, kb = item / nblk, nb = item % nblk, k0 = 64 * kb, n0 = 32 * nb;
    int orow0 = n0;
    if (inter == 1) orow0 = (n0 < FF) ? (n0 / 128) * 256 + (n0 % 128) : ((n0 - FF) / 128) * 256 + 128 + ((n0 - FF) % 128);
    if (inter == 2) { const int reg = n0 / 1024, c = n0 % 1024; orow0 = (reg == 2) ? c : (reg == 5) ? 1024 + c : (reg < 2 ? reg : reg - 1) * 1024 + c; }
    float v[32];
#pragma unroll
    for (int i = 0; i < 32; ++i) v[i] = W[(size_t)(k0 + 2 * i + (lane >> 5)) * N + n0 + (lane & 31)];
#pragma unroll
    for (int i = 0; i < 32; ++i) { const int kk = 2 * i + (lane >> 5); float t = v[i]; if (gain) t *= gain[k0 + kk]; scr[kk * 33 + (lane & 31)] = t; }
    LDS_WAIT(); asm volatile("" ::: "memory");
    const int c = lane & 7;
#pragma unroll
    for (int j = 0; j < 4; ++j) { const int n = (lane >> 3) + 8 * j; const LAS float* s = scr + (8 * c) * 33 + n;
        v4u o; o.x = pk2(s[0 * 33], s[1 * 33]); o.y = pk2(s[2 * 33], s[3 * 33]); o.z = pk2(s[4 * 33], s[5 * 33]); o.w = pk2(s[6 * 33], s[7 * 33]);
        *(GAS v4u*)(WT + (size_t)(orow0 + n) * K + k0 + 8 * c) = o; }
    LDS_WAIT(); asm volatile("" ::: "memory");
}
__device__ __forceinline__ void transpose_item_fp8(const float* W, int K, int N, unsigned char* WT, const float* gain, int inter, float scale, LAS float* scr, int item, int lane, int kperm = 0) {
    const int nblk = N / 32, kb = item / nblk, nb = item % nblk, k0 = 64 * kb, n0 = 32 * nb;
    int orow0 = n0;
    if (inter == 1) orow0 = (n0 < FF) ? (n0 / 128) * 256 + (n0 % 128) : ((n0 - FF) / 128) * 256 + 128 + ((n0 - FF) % 128);
    if (inter == 2) { const int reg = n0 / 1024, c = n0 % 1024; orow0 = (reg == 2) ? c : (reg == 5) ? 1024 + c : (reg < 2 ? reg : reg - 1) * 1024 + c; }
    float v[32];
#pragma unroll
    for (int i = 0; i < 32; ++i) { int ks = k0 + 2 * i + (lane >> 5); if (kperm) ks = (ks & ~127) + 32 * (ks & 3) + ((ks & 127) >> 2); v[i] = W[(size_t)ks * N + n0 + (lane & 31)]; }
#pragma unroll
    for (int i = 0; i < 32; ++i) { const int kk = 2 * i + (lane >> 5); float t = v[i] * scale; if (gain) t *= gain[k0 + kk]; scr[kk * 33 + (lane & 31)] = t; }
    LDS_WAIT(); asm volatile("" ::: "memory");
    const int c = lane & 7;
#pragma unroll
    for (int j = 0; j < 4; ++j) { const int n = (lane >> 3) + 8 * j; const LAS float* s = scr + (8 * c) * 33 + n;
        pg8::u32x2 o; o.x = pg8::pk4_fp8(s[0 * 33], s[1 * 33], s[2 * 33], s[3 * 33]); o.y = pg8::pk4_fp8(s[4 * 33], s[5 * 33], s[6 * 33], s[7 * 33]);
        *(GAS pg8::u32x2*)(WT + (size_t)(orow0 + n) * K + k0 + 8 * c) = o; }
    LDS_WAIT(); asm volatile("" ::: "memory");
}
__device__ __forceinline__ void rms_row_to_bf16(const float* xrow, const float* g, bf16* orow, int lane, unsigned char* o8 = nullptr, float s8 = 1.f) {
    const GAS f32x4* xr = (const GAS f32x4*)xrow + lane; const GAS f32x4* gr = (const GAS f32x4*)g + lane;
    f32x4 v[8]; float s = 0.f;
#pragma unroll
    for (int j = 0; j < 8; ++j) { v[j] = __builtin_nontemporal_load(xr + 64 * j); s += (v[j].x * v[j].x + v[j].y * v[j].y) + (v[j].z * v[j].z + v[j].w * v[j].w); }
    const float rstd = 1.0f / sqrtf(wave_sum(s) * (1.f / DM) + EPS);
    GAS unsigned long long* ob8 = (GAS unsigned long long*)orow + lane;
#pragma unroll
    for (int j = 0; j < 8; ++j) { const f32x4 gg = gr[64 * j];
        const float a0 = v[j].x * rstd * gg.x, a1 = v[j].y * rstd * gg.y, a2 = v[j].z * rstd * gg.z, a3 = v[j].w * rstd * gg.w;
        ob8[64 * j] = (unsigned long long)pk2(a0, a1) | ((unsigned long long)pk2(a2, a3) << 32);
        if (o8) ((GAS unsigned*)o8)[64 * j + lane] = pg8::pk4_fp8(a0 * s8, a1 * s8, a2 * s8, a3 * s8); }
}
__device__ __forceinline__ void x_row_convert(const float* xrow, bf16* orow, unsigned char* o8, float s8, float* rinv, int lane) {
    const GAS f32x4* xr = (const GAS f32x4*)xrow + lane;
    f32x4 v[8]; float s = 0.f;
#pragma unroll
    for (int j = 0; j < 8; ++j) { v[j] = xr[64 * j]; s += (v[j].x * v[j].x + v[j].y * v[j].y) + (v[j].z * v[j].z + v[j].w * v[j].w); }
    const float rstd = 1.0f / sqrtf(wave_sum(s) * (1.f / DM) + EPS);
    if (lane == 0) *rinv = rstd;
    GAS unsigned long long* ob8 = (GAS unsigned long long*)orow + lane;
#pragma unroll
    for (int j = 0; j < 8; ++j) { ob8[64 * j] = (unsigned long long)pk2(v[j].x, v[j].y) | ((unsigned long long)pk2(v[j].z, v[j].w) << 32);
        ((GAS unsigned*)o8)[64 * j + lane] = pg8::pk4_fp8(v[j].x * s8, v[j].y * s8, v[j].z * s8, v[j].w * s8); }
}
__constant__ float INV_FREQ[16] = {1.000000000e+00f, 4.403665960e-01f, 1.939227432e-01f, 8.539710194e-02f, 3.760603070e-02f, 1.656043902e-02f, 7.292664610e-03f, 3.211445874e-03f,
                                   1.414213562e-03f, 6.227723788e-04f, 2.742481884e-04f, 1.207697351e-04f, 5.318296098e-05f, 2.341999971e-05f, 1.031338616e-05f, 4.541670478e-06f};

struct TItem { const float* src; unsigned char* dst; const float* gain; float scale; int N, K, fp8, kperm; };
__device__ __forceinline__ void ti_decode(TItem& t, const float* W, int K, int N, unsigned char* WT, const float* gain, int inter, float scale, int fp8, int kperm, int item) {
    const int nblk = N / 32, kb = item / nblk, nb = item % nblk, k0 = 64 * kb, n0 = 32 * nb;
    int orow0 = n0;
    if (inter == 1) orow0 = (n0 < FF) ? (n0 / 128) * 256 + (n0 % 128) : ((n0 - FF) / 128) * 256 + 128 + ((n0 - FF) % 128);
    if (inter == 2) { const int reg = n0 / 1024, c = n0 % 1024; orow0 = (reg == 2) ? c : (reg == 5) ? 1024 + c : (reg < 2 ? reg : reg - 1) * 1024 + c; }
    const int ksrc0 = kperm ? (k0 & ~127) + ((k0 & 64) >> 2) : k0;
    t.src = W + (size_t)ksrc0 * N + n0; t.N = N; t.K = K; t.fp8 = fp8; t.kperm = kperm; t.scale = scale; t.gain = gain ? gain + k0 : nullptr;
    t.dst = WT + ((size_t)orow0 * K + k0) * (fp8 ? 1 : 2);
}
__device__ __forceinline__ void ti_load(const TItem& t, float (&v)[32], f32x4 (&g)[2], int lane) {
    const GAS float* s = (const GAS float*)t.src + (lane & 31);
#pragma unroll
    for (int i = 0; i < 32; ++i) { const int kk = 2 * i + (lane >> 5); const int ro = t.kperm ? 32 * (kk & 3) + (kk >> 2) : kk; v[i] = __builtin_nontemporal_load(s + (size_t)ro * t.N); }
    const GAS f32x4* gp = (const GAS f32x4*)((t.gain ? t.gain : t.src) + 8 * (lane & 7)); g[0] = gp[0]; g[1] = gp[1];
}
__device__ __forceinline__ void ti_finish(const TItem& t, const float (&v)[32], const f32x4 (&g)[2], LAS float* scr, int lane) {
#pragma unroll
    for (int i = 0; i < 32; ++i) scr[(2 * i + (lane >> 5)) * 33 + (lane & 31)] = v[i];
    LDS_WAIT(); asm volatile("" ::: "memory");
    const int c = lane & 7; const float sc = t.scale; const bool hg = t.gain != nullptr;
    const float g0 = hg ? g[0].x * sc : sc, g1 = hg ? g[0].y * sc : sc, g2 = hg ? g[0].z * sc : sc, g3 = hg ? g[0].w * sc : sc, g4 = hg ? g[1].x * sc : sc, g5 = hg ? g[1].y * sc : sc, g6 = hg ? g[1].z * sc : sc, g7 = hg ? g[1].w * sc : sc;
    if (t.fp8) {
#pragma unroll
        for (int j = 0; j < 4; ++j) { const int n = (lane >> 3) + 8 * j; const LAS float* s = scr + (8 * c) * 33 + n;
            pg8::u32x2 o; o.x = pg8::pk4_fp8(s[0 * 33] * g0, s[1 * 33] * g1, s[2 * 33] * g2, s[3 * 33] * g3); o.y = pg8::pk4_fp8(s[4 * 33] * g4, s[5 * 33] * g5, s[6 * 33] * g6, s[7 * 33] * g7);
            *(GAS pg8::u32x2*)(t.dst + (size_t)n * t.K + 8 * c) = o; }
    } else {
#pragma unroll
        for (int j = 0; j < 4; ++j) { const int n = (lane >> 3) + 8 * j; const LAS float* s = scr + (8 * c) * 33 + n;
            v4u o; o.x = pk2(s[0 * 33] * g0, s[1 * 33] * g1); o.y = pk2(s[2 * 33] * g2, s[3 * 33] * g3); o.z = pk2(s[4 * 33] * g4, s[5 * 33] * g5); o.w = pk2(s[6 * 33] * g6, s[7 * 33] * g7);
            *(GAS v4u*)(t.dst + ((size_t)n * t.K + 8 * c) * 2) = o; }
    }
    LDS_WAIT(); asm volatile("" ::: "memory");
}
__device__ __forceinline__ void xrow_load(const float* xrow, f32x4 (&v)[8], int lane) {
    const GAS f32x4* xr = (const GAS f32x4*)xrow + lane;
#pragma unroll
    for (int j = 0; j < 8; ++j) v[j] = __builtin_nontemporal_load(xr + 64 * j);
}
__device__ __forceinline__ void xrow_finish(const f32x4 (&v)[8], bf16* orow, unsigned char* o8, float s8, float* rinv, int lane) {
    float s = 0.f;
#pragma unroll
    for (int j = 0; j < 8; ++j) s += (v[j].x * v[j].x + v[j].y * v[j].y) + (v[j].z * v[j].z + v[j].w * v[j].w);
    const float rstd = 1.0f / sqrtf(wave_sum(s) * (1.f / DM) + EPS);
    if (lane == 0) *rinv = rstd;
    GAS unsigned long long* ob8 = (GAS unsigned long long*)orow + lane;
#pragma unroll
    for (int j = 0; j < 8; ++j) { ob8[64 * j] = (unsigned long long)pk2(v[j].x, v[j].y) | ((unsigned long long)pk2(v[j].z, v[j].w) << 32);
        ((GAS unsigned*)o8)[64 * j + lane] = pg8::pk4_fp8(v[j].x * s8, v[j].y * s8, v[j].z * s8, v[j].w * s8); }
}
__device__ __forceinline__ void p0_item(Frame& F, TItem& t, int it) {
    constexpr int I0 = (DM / 64) * (NQKV / 32), I1 = (DM / 64) * (DM / 32), I2 = (DM / 64) * (WX / 32), I3 = (DM / 64) * (2 * WX / 32), I4 = (WX / 64) * (DM / 32);
    int r = it;
    if (r < I0) { const int reg = ((r % (NQKV / 32)) * 32) / 1024;
        if (reg == 2 || reg == 5) ti_decode(t, F.w_in, DM, NQKV, F.ws + WS_WV8, F.g_mix, 2, S_WV, 1, 0, r);
        else if (QK_FP8 && reg < 2) ti_decode(t, F.w_in, DM, NQKV, F.ws + WS_WIN, F.g_mix, 2, S_WQK, 1, 0, r);
        else ti_decode(t, F.w_in, DM, NQKV, F.ws + WS_WIN, F.g_mix, 2, 1.f, 0, 0, r);
        return; } r -= I0;
    if (r < I1) { ti_decode(t, F.w_out, DM, DM, F.ws + WS_WOUT, nullptr, 0, S_WO, 1, 1, r); return; } r -= I1;
    if (r < I2) { ti_decode(t, F.w_xq, DM, WX, F.ws + WS_WXQ, F.g_xattn, 0, 1.f, 0, 0, r); return; } r -= I2;
    if (r < I3) { ti_decode(t, F.w_xkv, DM, 2 * WX, F.ws + WS_WXKV, nullptr, 0, 1.f, 0, 0, r); return; } r -= I3;
    if (r < I4) { ti_decode(t, F.w_xo, WX, DM, F.ws + WS_WXO, nullptr, 0, S_WXO, 1, 1, r); return; } r -= I4;
    ti_decode(t, F.w_gu, DM, 2 * FF, F.ws + WS_WGU, F.g_ffn, 1, S_WGU, 1, 0, r);
}
__device__ __forceinline__ void p0_prologue(Frame& F) {
    LAS float* scr = (LAS float*)(F.lds + F.wave * 16384);
    const int gw = F.vcu * NWAVES + F.wave, NGW = F.G * NWAVES;
    constexpr int I0 = (DM / 64) * (NQKV / 32), I1 = (DM / 64) * (DM / 32), I2 = (DM / 64) * (WX / 32), I3 = (DM / 64) * (2 * WX / 32), I4 = (WX / 64) * (DM / 32),
                  I5 = (DM / 64) * (2 * FF / 32);
    constexpr int I5H = I5 / 2;
    constexpr int NITEMS = I0 + I1 + I2 + I3 + I4 + I5H;
    {   float va[32], vb[32]; f32x4 ga[2], gb[2]; TItem ta, tb;
        int it = gw;
        if (it < NITEMS) { p0_item(F, ta, it); ti_load(ta, va, ga, F.lane);
            for (;;) {
                int itn = it + NGW; p0_item(F, tb, itn < NITEMS ? itn : it); ti_load(tb, vb, gb, F.lane);
                ti_finish(ta, va, ga, scr, F.lane); it = itn; if (it >= NITEMS) break;
                itn = it + NGW; p0_item(F, ta, itn < NITEMS ? itn : it); ti_load(ta, va, ga, F.lane);
                ti_finish(tb, vb, gb, scr, F.lane); it = itn; if (it >= NITEMS) break;
            } }
    }
    {   f32x4 va[8], vb[8];
        bf16* xb = (bf16*)(F.ws + WS_RA); unsigned char* x8 = F.ws + WS_RB; float* ri = (float*)(F.ws + WS_RINV0);
        int m = gw;
        if (m < M) { xrow_load(F.x + (size_t)m * DM, va, F.lane);
            for (;;) {
                int mn = m + NGW; xrow_load(F.x + (size_t)(mn < M ? mn : m) * DM, vb, F.lane);
                xrow_finish(va, xb + (size_t)m * DM, x8 + (size_t)m * DM, S_XN, ri + m, F.lane); m = mn; if (m >= M) break;
                mn = m + NGW; xrow_load(F.x + (size_t)(mn < M ? mn : m) * DM, va, F.lane);
                xrow_finish(vb, xb + (size_t)m * DM, x8 + (size_t)m * DM, S_XN, ri + m, F.lane); m = mn; if (m >= M) break;
            } }
    }
    for (int m = gw; m < MMEM; m += NGW) rms_row_to_bf16(F.mem + (size_t)m * DM, F.g_mem, (bf16*)(F.ws + WS_MN) + (size_t)m * DM, F.lane);
    float* cs = (float*)(F.ws + WS_CS);
    for (int e = (F.vcu * NWAVES + F.wave) * 64 + F.lane; e < M * 16; e += NGW * 64) {
        const int m = e >> 4, i = e & 15; const float ang = (float)F.pos[m] * INV_FREQ[i];
        double rev = (double)ang * 0.15915494309189535; rev -= floor(rev);
        const float a = (float)(rev * 6.283185307179586);
        cs[(size_t)m * 32 + i] = cosf(a); cs[(size_t)m * 32 + 16 + i] = sinf(a);
    }
}

__device__ __forceinline__ void ffn_item(Frame& F, TItem& t, int it) {
    constexpr int I5 = (DM / 64) * (2 * FF / 32);
    if (it < I5) ti_decode(t, F.w_gu, DM, 2 * FF, F.ws + WS_WGU, F.g_ffn, 1, S_WGU, 1, 0, it);
    else ti_decode(t, F.w_dn, FF, DM, F.ws + WS_WDN, nullptr, 0, S_WDN, 1, 0, it - I5);
}
__device__ __forceinline__ void ffn_weight_items(Frame& F, int wi, int nw) {
    LAS float* scr = (LAS float*)(F.lds + F.wave * 16384);
    constexpr int I5 = (DM / 64) * (2 * FF / 32), I6 = (FF / 64) * (DM / 32), NI = I5 + I6;
    float va[32], vb[32]; f32x4 ga[2], gb[2]; TItem ta, tb;
    int it = wi + I5 / 2;
    if (it < NI) { ffn_item(F, ta, it); ti_load(ta, va, ga, F.lane);
        for (;;) {
            int itn = it + nw; ffn_item(F, tb, itn < NI ? itn : it); ti_load(tb, vb, gb, F.lane);
            ti_finish(ta, va, ga, scr, F.lane); it = itn; if (it >= NI) break;
            itn = it + nw; ffn_item(F, ta, itn < NI ? itn : it); ti_load(ta, va, ga, F.lane);
            ti_finish(tb, vb, gb, scr, F.lane); it = itn; if (it >= NI) break;
        } }
}

__device__ __forceinline__ void final_norm_phase(Frame& F, const bf16* src, float* dst) {
    const int gw = F.vcu * NWAVES + F.wave, NGW = F.G * NWAVES;
    for (int m = gw; m < M; m += NGW) {
        const GAS v4u* xr = (const GAS v4u*)(src + (size_t)m * DM) + F.lane; const GAS f32x4* gr = (const GAS f32x4*)F.g_final;
        v4u w[4]; float s = 0.f;
#pragma unroll
        for (int j = 0; j < 4; ++j) w[j] = xr[64 * j];
        f32x4 v[8];
#pragma unroll
        for (int j = 0; j < 4; ++j) { v[2 * j] = (f32x4){__uint_as_float(w[j].x << 16), __uint_as_float(w[j].x & 0xffff0000u), __uint_as_float(w[j].y << 16), __uint_as_float(w[j].y & 0xffff0000u)};
            v[2 * j + 1] = (f32x4){__uint_as_float(w[j].z << 16), __uint_as_float(w[j].z & 0xffff0000u), __uint_as_float(w[j].w << 16), __uint_as_float(w[j].w & 0xffff0000u)}; }
#pragma unroll
        for (int j = 0; j < 8; ++j) s += (v[j].x * v[j].x + v[j].y * v[j].y) + (v[j].z * v[j].z + v[j].w * v[j].w);
        const float rstd = 1.0f / sqrtf(wave_sum(s) * (1.f / DM) + EPS);
        GAS f32x4* dr = (GAS f32x4*)(dst + (size_t)m * DM);
#pragma unroll
        for (int j = 0; j < 4; ++j) { const int c4 = (64 * j + F.lane) * 2;
            dr[c4] = v[2 * j] * rstd * gr[c4]; dr[c4 + 1] = v[2 * j + 1] * rstd * gr[c4 + 1]; }
    }
}

struct RangeOrder : pg8::StaticOrder {
    int i0, n;
    __device__ __forceinline__ bool next(int i, pg8::Unit& u) const { return i < n && pg8::StaticOrder::next(i + i0, u); }
};
template <int K> __device__ __forceinline__ const void* late_arg() {
    const void* p; asm volatile("s_load_dwordx2 %0, %1, %2\n\ts_waitcnt lgkmcnt(0)" : "=s"(p) : "s"(__builtin_amdgcn_kernarg_segment_ptr()), "i"(K * 8));
    return p;
}
constexpr int NPH = 11;
#ifndef REPEAT_WHICH
#define REPEAT_WHICH 3
#endif
#ifndef NULL_EPI_PROBE
#define NULL_EPI_PROBE 0
#endif
#ifndef FOLD_KMEAN
#define FOLD_KMEAN 1
#endif
#ifndef REPEAT_PHASE
#define REPEAT_PHASE -1
#endif
#ifndef REPEAT_MASK
#define REPEAT_MASK 0
#endif
#define REPS(k) (((REPEAT_PHASE == (k)) || ((REPEAT_MASK >> (k)) & 1)) ? 2 : 1)
#ifndef USE_MFMA_SB
#define USE_MFMA_SB 1
#endif
#ifndef USE_MFMA_MOBA
#define USE_MFMA_MOBA 1
#endif
#ifndef USE_MFMA_X
#define USE_MFMA_X 1
#endif
#ifndef MK_ONE_LAUNCH
#define MK_ONE_LAUNCH 1
#endif
struct Args { const void* in[17]; float* out; unsigned char* ws; int ph_lo, ph_hi; };
__global__ void __launch_bounds__(NWAVES * 64, 2) mk_fwd(Args args) {
    extern __shared__ __attribute__((aligned(16))) unsigned char lds[];
    Frame F;
    F.lds = (LAS unsigned char*)lds;
    F.tid = threadIdx.x; F.lane = F.tid & 63; F.wave = __builtin_amdgcn_readfirstlane(F.tid >> 6);
    F.G = gridDim.x; { const int bx = blockIdx.x; F.vcu = (F.G % 8 == 0) ? (bx % 8) * (F.G / 8) + bx / 8 : bx; }
    F.x = (const float*)args.in[0]; F.mem = (const float*)args.in[1]; F.pos = (const int*)args.in[2];
    F.g_mix = (const float*)args.in[3]; F.w_in = (const float*)args.in[4]; F.g_out_sb = nullptr; F.g_out_mb = nullptr; F.w_out = (const float*)args.in[7];
    F.g_xattn = (const float*)args.in[8]; F.g_mem = (const float*)args.in[9]; F.w_xq = (const float*)args.in[10]; F.w_xkv = (const float*)args.in[11]; F.w_xo = (const float*)args.in[12];
    F.g_ffn = nullptr; F.w_gu = nullptr; F.w_dn = nullptr; F.g_final = nullptr;
    F.out = args.out; F.ws = args.ws;
    unsigned char* ws = args.ws;
    const int lo = args.ph_lo, hi = args.ph_hi;
    for (int u = F.tid; u < (LDS_BYTES - LDSCTL_OFF) / 4; u += NWAVES * 64) ((LAS unsigned*)(F.lds + LDSCTL_OFF))[u] = 0u;
    __syncthreads();
    if (hi - lo > 1) {
        { GAS v4u* z = (GAS v4u*)(ws + WS_CTL); const int n16 = (int)(CTL_ZERO_BYTES / 16);
          for (int i = (int)blockIdx.x * (NWAVES * 64) + F.tid; i < n16; i += F.G * NWAVES * 64) z[i] = (v4u){0u, 0u, 0u, 0u}; }
        cg::this_grid().sync();
    }
    XcdBarrier bar = xcd_barrier_post((unsigned*)(ws + WS_CTL) + CW_BAR, (volatile LAS unsigned*)(F.lds + MISC_OFF) + 8);
#ifndef ONLY_PHASE
#define ONLY_PHASE -1
#endif
#define IN(k) ((ONLY_PHASE < 0 || ONLY_PHASE == (k)) && lo <= (k) && (k) < hi)
#define BOTH(k) (IN(k) && IN((k) + 1))
#define GRID_BAR() xcd_barrier(bar)
    float* ssq1 = (float*)(ws + WS_SSQ1); float* ssq2 = (float*)(ws + WS_SSQ2);
    pg8::bf16_t* ACT = (pg8::bf16_t*)(ws + WS_RC + 64 * MiB);
    pg8::bf16_t* RA = (pg8::bf16_t*)(ws + WS_RA); pg8::bf16_t* RB = (pg8::bf16_t*)(ws + WS_RB); pg8::bf16_t* RC = (pg8::bf16_t*)(ws + WS_RC);

    if (IN(0)) { F.w_gu = (const float*)late_arg<14>(); F.g_ffn = (const float*)late_arg<13>(); for (int rep = 0; rep < REPS(0); ++rep) p0_prologue(F); F.w_gu = nullptr; F.g_ffn = nullptr; if (BOTH(0)) GRID_BAR(); }
    if (IN(1)) {
        pg8::Gemm gs{RB, (const pg8::bf16_t*)(ws + WS_WIN), M, 2048, DM / 2}; RangeOrder Ss; Ss.init(M, 2048, F.G, (int)blockIdx.x);
        pg8::EpiQKV Es{RC, (const float*)(ws + WS_CS), QSCALE, (float*)(ws + WS_KSUM), 0, 1.f, (const float*)(ws + WS_RINV0), 1.f / (S_XN * S_WQK), 0};
        pg8::Gemm gm{RA, (const pg8::bf16_t*)(ws + WS_WIN) + (size_t)2048 * DM, M, 2048, DM}; RangeOrder Sm; Sm.init(M, 2048, F.G, (int)blockIdx.x);
        pg8::EpiQKV Em{RC, (const float*)(ws + WS_CS), QSCALE, (float*)(ws + WS_KSUM), 0, 1.f, (const float*)(ws + WS_RINV0), 1.f, 8};
        pg8::Gemm gv{RB, (const pg8::bf16_t*)(ws + WS_WV8), M, 2048, DM / 2}; RangeOrder Sv; Sv.init(M, 2048, F.G, (int)blockIdx.x);
        pg8::EpiQKV Ev{RC, (const float*)(ws + WS_CS), QSCALE, (float*)(ws + WS_KSUM), 1, 1.f / (S_XN * S_WV), (const float*)(ws + WS_RINV0), 1.f, 0};
        for (int rep = 0; rep < REPS(1); ++rep) {
        const bool grp = ((blockIdx.x >> 3) & 1) != 0;
        Ss.i0 = 0; Ss.n = 1 << 20; Sm.i0 = 0; Sm.n = 1 << 20;
        if (grp) { Sv.i0 = 0; Sv.n = 1; pg8::gemm_phase<pg8::EpiQKV, RangeOrder, true, true, true>(F.lds, gv, Sv, Ev); }
        pg8::gemm_phase<pg8::EpiQKV, RangeOrder, true, true, true>(F.lds, gs, Ss, Es);
        pg8::gemm_phase<pg8::EpiQKV, RangeOrder, true, true>(F.lds, gm, Sm, Em);
        Sv.i0 = grp ? 1 : 0; Sv.n = 1 << 20;
        pg8::gemm_phase<pg8::EpiQKV, RangeOrder, true, true, true>(F.lds, gv, Sv, Ev);
        }
        if (BOTH(1)) GRID_BAR();
    }
    if (IN(3)) {
        const att::bf16* qkv = (const att::bf16*)RC; att::bf16* ob = (att::bf16*)RB; const float* kmean = (const float*)(ws + WS_KSUM);
        F.g_out_sb = (const float*)late_arg<5>(); F.g_out_mb = (const float*)late_arg<6>();
        constexpr size_t HSZ = (size_t)SEQ * HD;
        for (int rep = 0; rep < REPS(3); ++rep) {
        if (rep == 0 || (REPEAT_WHICH & 1))
        for (int vv = F.vcu; vv < 256; vv += F.G) { const int bh = vv >> 2, s = vv & 3, b = bh >> 3, h = bh & 7; const size_t rb = (size_t)b * SEQ;
            const att::bf16* hS = qkv + ((size_t)b * 48 + h) * HSZ; const att::bf16* hM = qkv + ((size_t)b * 48 + 24 + h) * HSZ;
            for (int i = 0; i < 2; ++i) { const int qb = i ? s : 7 - s; const size_t r0 = rb + (size_t)qb * 256;
                att::attn_unit<2, true>(hS, nullptr, nullptr, (att::bf16*)((unsigned char*)ob + r0 * DM + h * HD), F.g_out_sb + h * HD, nullptr, qb, 0, (char*)lds, S_O,
                                        i != 0, i ? hM : hS, i ? 7 - s : s, i ? 0 : 4 * (s + 1) - 1, i ? -1 : 4 * (s + 1) - 2); }
            for (int i = 0; i < 2; ++i) { const int qb = i ? s : 7 - s; const size_t r0 = rb + (size_t)qb * 256;
                att::attn_unit<1, true>(hM, nullptr, nullptr, (att::bf16*)((unsigned char*)ob + r0 * DM + NH * HD + h * HD), F.g_out_mb + h * HD, kmean + (size_t)bh * 1024, qb, 0, (char*)lds, S_O,
                                        true, i ? nullptr : hM, s, 0, -1); } }
        }
        if (BOTH(3)) GRID_BAR();
    }
    if (IN(4)) {
        pg8::Gemm g{RB, (const pg8::bf16_t*)(ws + WS_WOUT), M, DM, WOUT_FP8 ? DM / 2 : DM}; pg8::StaticOrder S; S.init(M, DM, F.G, (int)blockIdx.x);
        pg8::EpiResB<false> E{RA, RC, ssq1, nullptr, 1.f, WOUT_FP8 ? 1.f / (S_O * S_WO) : 1.f};
        pg8::gemm_phase<pg8::EpiResB<false>, pg8::StaticOrder, true, true, WOUT_FP8 != 0>(F.lds, g, S, E);
        if (BOTH(4)) GRID_BAR();
    }
    if (IN(5)) {
      F.w_gu = (const float*)late_arg<14>(); F.g_ffn = (const float*)late_arg<13>(); F.w_dn = (const float*)late_arg<15>();
      for (int rep = 0; rep < REPS(5); ++rep) {
        { pg8::Gemm g{RC, (const pg8::bf16_t*)(ws + WS_WXQ), M, WX, DM}; pg8::StaticOrder S; S.init(M, WX, F.G, (int)blockIdx.x);
          pg8::EpiScale E{(pg8::bf16_t*)(ws + WS_QX), WX, ssq1, QSCALE};
          pg8::gemm_phase<pg8::EpiScale, pg8::StaticOrder, true, true>(F.lds, g, S, E); }
        { pg8::Gemm g{(const pg8::bf16_t*)(ws + WS_MN), (const pg8::bf16_t*)(ws + WS_WXKV), MMEM, 2 * WX, DM}; pg8::StaticOrder S; S.init(MMEM, 2 * WX, F.G, (int)((blockIdx.x + F.G - 128) % F.G));
          pg8::EpiScale E{(pg8::bf16_t*)(ws + WS_KVX), 2 * WX, nullptr, 1.0f};
          pg8::gemm_phase<pg8::EpiScale, pg8::StaticOrder, true, true>(F.lds, g, S, E); }
        if (F.G > 160) { if ((int)blockIdx.x >= 160) ffn_weight_items(F, ((int)blockIdx.x - 160) * NWAVES + F.wave, (F.G - 160) * NWAVES); }
        else ffn_weight_items(F, (int)blockIdx.x * NWAVES + F.wave, F.G * NWAVES);
      }
        if (BOTH(5)) GRID_BAR();
    }
    if (IN(6)) {
        const att::bf16* qx = (const att::bf16*)(ws + WS_QX); const att::bf16* kvx = (const att::bf16*)(ws + WS_KVX); att::bf16* ox = (att::bf16*)(ws + WS_OX);
        for (int rep = 0; rep < REPS(6); ++rep) {
        for (int vv = F.vcu; vv < 256; vv += F.G) { const int b = vv >> 5, h = (vv >> 3) & 3, qb = vv & 7; const size_t r0 = (size_t)b * SEQ + (size_t)qb * 256;
            if (WXO_FP8) att::attn_unit<0, true>(qx + r0 * WX + h * HD, kvx + (size_t)b * NMEM * (2 * WX) + h * HD, kvx + (size_t)b * NMEM * (2 * WX) + WX + h * HD, (att::bf16*)((unsigned char*)ox + r0 * WX + h * HD), nullptr, nullptr, qb, NMEM, (char*)lds, S_OX);
            else att::attn_unit<0>(qx + r0 * WX + h * HD, kvx + (size_t)b * NMEM * (2 * WX) + h * HD, kvx + (size_t)b * NMEM * (2 * WX) + WX + h * HD, ox + r0 * WX + h * HD, nullptr, nullptr, qb, NMEM, (char*)lds); }
        }
        if (BOTH(6)) GRID_BAR();
    }
    if (IN(7)) {
        pg8::Gemm g{(const pg8::bf16_t*)(ws + WS_OX), (const pg8::bf16_t*)(ws + WS_WXO), M, DM, WXO_FP8 ? WX / 2 : WX}; pg8::StaticOrder S; S.init(M, DM, F.G, (int)blockIdx.x);
        pg8::EpiResB<false> E{RC, RC, ssq2, (unsigned char*)RA, S_X2, WXO_FP8 ? 1.f / (S_OX * S_WXO) : 1.f};
        pg8::gemm_phase<pg8::EpiResB<false>, pg8::StaticOrder, true, true, WXO_FP8 != 0>(F.lds, g, S, E);
        if (BOTH(7)) GRID_BAR();
    }
    if (IN(8)) {
        pg8::Gemm g{RA, (const pg8::bf16_t*)(ws + WS_WGU), M, 2 * FF, FFN_FP8 ? DM / 2 : DM}; pg8::StaticOrder S; S.init(M, 2 * FF, F.G, (int)blockIdx.x);
        pg8::EpiSwiGLU E{ACT, ssq2, FFN_FP8 ? (unsigned char*)ACT : nullptr, FFN_FP8 ? 1.f / (S_X2 * S_WGU) : 1.f, S_ACT};
#if NULL_EPI_PROBE
        if (REPS(8) == 2) { pg8::EpiNull EN{nullptr}; pg8::gemm_phase<pg8::EpiNull, pg8::StaticOrder, true, true, FFN_FP8 != 0>(F.lds, g, S, EN); }
        pg8::gemm_phase<pg8::EpiSwiGLU, pg8::StaticOrder, true, true, FFN_FP8 != 0>(F.lds, g, S, E);
#else
        for (int rep = 0; rep < REPS(8); ++rep) pg8::gemm_phase<pg8::EpiSwiGLU, pg8::StaticOrder, true, true, FFN_FP8 != 0>(F.lds, g, S, E);
#endif
        if (BOTH(8)) GRID_BAR();
    }
    if (IN(9)) {
        pg8::Gemm g{ACT, (const pg8::bf16_t*)(ws + WS_WDN), M, DM, FF / 2}; pg8::StaticOrder S; S.init(M, DM, F.G, (int)blockIdx.x);
        pg8::EpiResB<false> E{RC, RC, nullptr, nullptr, 1.f, 1.f / (S_ACT * S_WDN)};
        pg8::gemm_phase<pg8::EpiResB<false>, pg8::StaticOrder, true, true, true>(F.lds, g, S, E);
        if (BOTH(9)) GRID_BAR();
    }
    if (IN(10)) { F.g_final = (const float*)late_arg<16>(); final_norm_phase(F, RC, F.out); }
#undef IN
#undef BOTH
}

extern "C" void kernel_launch(void* const* d_in, const int* in_sizes, int n_in, void* d_out, int out_size, void* d_ws, size_t ws_size, hipStream_t stream) {
    static int grid = 0;
    if (grid == 0) {
        if (n_in != 17 || in_sizes[0] != M * DM || out_size != M * DM || ws_size < WS_END) { fprintf(stderr, "kernel_launch: unexpected shapes (n_in %d in0 %d out %d ws %zu)\n", n_in, n_in > 0 ? in_sizes[0] : -1, out_size, ws_size); grid = -1; return; }
        int dev = 0, cus = 0, per_cu = 0;
        if (hipGetDevice(&dev) != hipSuccess || hipDeviceGetAttribute(&cus, hipDeviceAttributeMultiprocessorCount, dev) != hipSuccess) { grid = -1; return; }
        if (hipFuncSetAttribute((const void*)mk_fwd, hipFuncAttributeMaxDynamicSharedMemorySize, LDS_BYTES) != hipSuccess) { fprintf(stderr, "kernel_launch: hipFuncSetAttribute failed\n"); grid = -1; return; }
        if (hipOccupancyMaxActiveBlocksPerMultiprocessor(&per_cu, (const void*)mk_fwd, NWAVES * 64, LDS_BYTES) != hipSuccess || per_cu < 1) { fprintf(stderr, "kernel_launch: occupancy query failed (%d)\n", per_cu); per_cu = 1; }
        (void)hipGetLastError();
        grid = cus * (per_cu < 1 ? 1 : 1);
    }
    if (grid < 0) return;
#if !MK_ONE_LAUNCH
    (void)hipMemsetAsync((char*)d_ws + WS_CTL, 0, CTL_ZERO_BYTES, stream);
#endif
    Args a{};
    for (int i = 0; i < 17; ++i) a.in[i] = d_in[i];
    a.out = (float*)d_out; a.ws = (unsigned char*)d_ws;
#if MK_ONE_LAUNCH
    a.ph_lo = 0; a.ph_hi = NPH;
    void* kargs[] = {&a};
    hipError_t e = hipLaunchCooperativeKernel((const void*)mk_fwd, dim3(grid), dim3(NWAVES * 64), kargs, LDS_BYTES, stream);
    if (e != hipSuccess) fprintf(stderr, "kernel_launch: cooperative launch failed: %s (grid %d)\n", hipGetErrorString(e), grid);
#else
    for (int p = 0; p < NPH; ++p) { a.ph_lo = p; a.ph_hi = p + 1; hipLaunchKernelGGL(mk_fwd, dim3(grid), dim3(NWAVES * 64), LDS_BYTES, stream, a); }
    const hipError_t le = hipPeekAtLastError();
    if (le != hipSuccess) fprintf(stderr, "kernel_launch: launch failed: %s\n", hipGetErrorName(le));
#endif
}
```

```cpp
#include <hip/hip_runtime.h>
#include <hip/hip_cooperative_groups.h>
#include <cstdio>
#include <cstdint>
namespace cg = cooperative_groups;
namespace pg8 {
#define PG8_LAS __attribute__((address_space(3)))
typedef unsigned short bf16_t;
typedef short bf16x8 __attribute__((ext_vector_type(8)));
typedef float f32x4 __attribute__((ext_vector_type(4)));
typedef unsigned u32x4 __attribute__((ext_vector_type(4)));
constexpr int BM = 256, BK = 64, HALF = 128, HTB = HALF * BK * 2  , STAGE_BYTES = 8 * HTB, NXCD = 8, WGM = 8;

__host__ __device__ __forceinline__ int lds_byte(int r, int c) { const int st = (r >> 4) * 2 + (c >> 5), rr = r & 15, cc = c & 31, ob = rr * 64 + cc * 2; return st * 1024 + (ob ^ (((ob >> 9) & 1) << 5)); }
__host__ __device__ __forceinline__ void stage_rc(int b, int& R, int& C) { const int st = b / 1024, sb = b % 1024, swz = sb ^ (((sb >> 9) & 1) << 5); R = (st >> 1) * 16 + swz / 64; C = (st & 1) * 32 + (swz % 64) / 2; }
__host__ __device__ __forceinline__ int perm32(int rho) { const int n = rho >> 4, i = rho & 15; return 8 * (i >> 2) + 4 * n + (i & 3); }

struct Unit { int pm, pn; };
struct Gemm { const bf16_t* A; const bf16_t* Bt; int M, N, K; };

struct StaticOrder {
    int nM, nN, nwg, G, c;
    __host__ __device__ void init(int M, int N, int G_, int c_) { nM = M / BM; nN = N / BM; nwg = nM * nN; G = G_; c = c_; }
    __host__ __device__ bool next(int i, Unit& u) const {
        const long L = (long)i * G + c; if (L >= nwg) return false;
        int wgid = (int)L; { const int q = nwg / NXCD, r = nwg % NXCD, xcd = wgid % NXCD, off = wgid / NXCD; wgid = (xcd < r ? xcd * (q + 1) : r * (q + 1) + (xcd - r) * q) + off; }
        const int nig = WGM * nN, gid = wgid / nig, fm = gid * WGM, gsz = (nM - fm) < WGM ? (nM - fm) : WGM;
        u.pm = fm + ((wgid % nig) % gsz); u.pn = (wgid % nig) / gsz; return true;
    }
    __device__ __forceinline__ void a_ready(const Unit&) const {}
    __device__ __forceinline__ void done(const Unit&) const {}
};

__device__ __forceinline__ unsigned cvt_pk_bf16(float lo, float hi) { unsigned r; asm volatile("v_cvt_pk_bf16_f32 %0, %1, %2" : "=v"(r) : "v"(lo), "v"(hi)); return r; }
typedef float f32x2 __attribute__((ext_vector_type(2)));
template <class Epi, class Sched, bool ALIGN_EPI = false, bool SP2 = false, bool FP8 = false>
__device__ __forceinline__ void gemm_phase(PG8_LAS unsigned char* lds, const Gemm g, const Sched& S, const Epi& E) {
    int tid_ = threadIdx.x; asm volatile("" : "+v"(tid_));
    const int tid = tid_, wid = __builtin_amdgcn_readfirstlane(tid >> 6), lane = tid & 63, wr = wid >> 2, wc = wid & 3, fr = lane & 15, fq = lane >> 4;
    const int K = g.K, nt = K / BK;
    unsigned voffA[2], voffB[2];
#pragma unroll
    for (int i = 0; i < 2; ++i) { int R, C; stage_rc(tid * 16 + i * 8192, R, C); const int Rb = Epi::PERM ? ((R & ~31) + perm32(R & 31)) : R;
        voffA[i] = (unsigned)(R * K + C) * 2u; voffB[i] = (unsigned)(Rb * K + C) * 2u; }
    const size_t kstep = (size_t)(BK * 2);
    const size_t hstep = (size_t)HALF * K * 2;
    const size_t tstep = 2 * hstep;
    const unsigned ldsw = (unsigned)wid * 1024u;
    const int aoff = lds_byte(wr * 64 + fr, fq * 8), boff = lds_byte(wc * 32 + fr, fq * 8);
#define PG8_SA(b, h) (((b) * 2 + (h)) * HTB)
#define PG8_SB(b, h) ((4 + (b) * 2 + (h)) * HTB)
#define PG8_STAGE(bufoff, gbase, voff) do { _Pragma("unroll") for (int _i = 0; _i < 2; ++_i) \
        __builtin_amdgcn_global_load_lds((const unsigned*)((const char*)(gbase) + (voff)[_i]), (PG8_LAS unsigned*)(lds + (bufoff) + ldsw + _i * 8192), 16, 0, 0); } while (0)
#define PG8_LD8(p) __builtin_shufflevector(*(const PG8_LAS i32x4_*)(p), *(const PG8_LAS i32x4_*)((p) + 1024), 0, 1, 2, 3, 4, 5, 6, 7)
#define PG8_LDA(dst, b, h) do { if constexpr (FP8) { _Pragma("unroll") for (int m = 0; m < 4; ++m) dst##8[m] = PG8_LD8(lds + PG8_SA(b, h) + aoff + m * 2048); } \
        else { _Pragma("unroll") for (int m = 0; m < 4; ++m) _Pragma("unroll") for (int k = 0; k < 2; ++k) dst[m][k] = *(const PG8_LAS bf16x8*)(lds + PG8_SA(b, h) + aoff + m * 2048 + k * 1024); } } while (0)
#define PG8_LDB(dst, b, h) do { if constexpr (FP8) { _Pragma("unroll") for (int n = 0; n < 2; ++n) dst##8[n] = PG8_LD8(lds + PG8_SB(b, h) + boff + n * 2048); } \
        else { _Pragma("unroll") for (int n = 0; n < 2; ++n) _Pragma("unroll") for (int k = 0; k < 2; ++k) dst[n][k] = *(const PG8_LAS bf16x8*)(lds + PG8_SB(b, h) + boff + n * 2048 + k * 1024); } } while (0)
#define PG8_MMA(ai, bj, At, Bt) do { __builtin_amdgcn_s_setprio(1); _Pragma("unroll") for (int m = 0; m < 4; ++m) _Pragma("unroll") for (int n = 0; n < 2; ++n) { \
        if constexpr (FP8) asm volatile("v_mfma_scale_f32_16x16x128_f8f6f4 %0, %1, %2, %0, %3, %3 op_sel_hi:[0,0,0]" : "+v"(acc[ai][bj][m][n]) : "v"(Bt##8[n]), "v"(At##8[m]), "v"(sc1_)); \
        else { _Pragma("unroll") for (int k = 0; k < 2; ++k) acc[ai][bj][m][n] = __builtin_amdgcn_mfma_f32_16x16x32_bf16(Bt[n][k], At[m][k], acc[ai][bj][m][n], 0, 0, 0); } } \
        __builtin_amdgcn_s_setprio(0); } while (0)
#define PG8_WAIT_V(n) asm volatile("s_waitcnt vmcnt(" #n ")" ::: "memory")
#define PG8_WAIT_L(n) asm volatile("s_waitcnt lgkmcnt(" #n ")" ::: "memory")
#define PG8_BAR __builtin_amdgcn_s_barrier()
#define PG8_SCHED __builtin_amdgcn_sched_barrier(0)
    Unit cur, nxt; int ui = 0;
    if (!S.next(0, cur)) return;
    f32x4 acc[2][2][4][2];
#pragma unroll
    for (int a = 0; a < 2; ++a)
#pragma unroll
        for (int b = 0; b < 2; ++b)
#pragma unroll
            for (int m = 0; m < 4; ++m)
#pragma unroll
                for (int n = 0; n < 2; ++n) acc[a][b][m][n] = (f32x4){0.f, 0.f, 0.f, 0.f};
    typedef int i32x4_ __attribute__((ext_vector_type(4))); typedef int i32x8_ __attribute__((ext_vector_type(8)));
    int sc1_ = 0x7F7F7F7F; asm volatile("" : "+v"(sc1_));
    bf16x8 At[4][2], B0[2][2], B1[2][2]; i32x8_ At8[4], B08[2], B18[2];
    const char* cA = (const char*)g.A + (size_t)cur.pm * tstep; const char* cB = (const char*)g.Bt + (size_t)cur.pn * tstep;
    S.a_ready(cur);
    if constexpr (SP2) {
        PG8_STAGE(PG8_SB(0, 0), cB, voffB); PG8_STAGE(PG8_SB(0, 1), cB + hstep, voffB); PG8_STAGE(PG8_SA(0, 0), cA, voffA); PG8_STAGE(PG8_SA(0, 1), cA + hstep, voffA);
        if (wr == 1) PG8_BAR;
        PG8_WAIT_V(2); PG8_BAR;
        PG8_STAGE(PG8_SB(1, 0), cB + kstep, voffB); PG8_STAGE(PG8_SA(1, 0), cA + kstep, voffA); PG8_STAGE(PG8_SB(1, 1), cB + hstep + kstep, voffB);
        PG8_WAIT_V(6); PG8_BAR;
    } else {
        PG8_STAGE(PG8_SB(0, 0), cB, voffB); PG8_STAGE(PG8_SA(0, 0), cA, voffA); PG8_STAGE(PG8_SB(0, 1), cB + hstep, voffB); PG8_STAGE(PG8_SA(0, 1), cA + hstep, voffA);
        if (wr == 1) PG8_BAR;
        PG8_WAIT_V(4); PG8_BAR;
        PG8_STAGE(PG8_SB(1, 0), cB + kstep, voffB); PG8_STAGE(PG8_SA(1, 0), cA + kstep, voffA); PG8_STAGE(PG8_SB(1, 1), cB + hstep + kstep, voffB);
        PG8_WAIT_V(6); PG8_BAR;
    }
    for (;;) {
        const bool has_next = S.next(ui + 1, nxt);
        const char* nA = has_next ? (const char*)g.A + (size_t)nxt.pm * tstep : cA; const char* nB = has_next ? (const char*)g.Bt + (size_t)nxt.pn * tstep : cB;
        for (int t = 0; t < nt; t += 2) {
            const bool last = (t == nt - 2);
            const char* a1 = cA + (size_t)(t + 1) * kstep;
            const char* a2 = last ? nA : cA + (size_t)(t + 2) * kstep; const char* b2 = last ? nB : cB + (size_t)(t + 2) * kstep;
            const char* a3 = a2 + kstep; const char* b3 = b2 + kstep;
            if (last && has_next) S.a_ready(nxt);
            if constexpr (SP2) {
            PG8_LDB(B0, 0, 0); PG8_LDB(B1, 0, 1); PG8_SCHED; PG8_LDA(At, 0, 0); PG8_STAGE(PG8_SA(1, 1), a1 + hstep, voffA);
            PG8_WAIT_V(8); PG8_WAIT_L(0); PG8_BAR; PG8_MMA(0, 0, At, B0); PG8_MMA(0, 1, At, B1); PG8_BAR; PG8_SCHED;
            PG8_LDA(At, 0, 1); PG8_STAGE(PG8_SB(0, 0), b2, voffB); PG8_STAGE(PG8_SB(0, 1), b2 + hstep, voffB); PG8_STAGE(PG8_SA(0, 0), a2, voffA);
            PG8_WAIT_V(8); PG8_WAIT_L(0); PG8_BAR; PG8_MMA(1, 0, At, B0); PG8_MMA(1, 1, At, B1); PG8_BAR; PG8_SCHED;
            PG8_LDB(B0, 1, 0); PG8_LDB(B1, 1, 1); PG8_SCHED; PG8_LDA(At, 1, 0); PG8_STAGE(PG8_SA(0, 1), a2 + hstep, voffA);
            PG8_WAIT_V(8); PG8_WAIT_L(0); PG8_BAR; PG8_MMA(0, 0, At, B0); PG8_MMA(0, 1, At, B1); PG8_BAR; PG8_SCHED;
            PG8_LDA(At, 1, 1); PG8_STAGE(PG8_SB(1, 0), b3, voffB); PG8_STAGE(PG8_SB(1, 1), b3 + hstep, voffB); PG8_STAGE(PG8_SA(1, 0), a3, voffA);
            PG8_WAIT_V(8); PG8_WAIT_L(0); PG8_BAR; PG8_MMA(1, 0, At, B0); PG8_MMA(1, 1, At, B1); PG8_BAR; PG8_SCHED;
            } else {
            PG8_LDB(B0, 0, 0); PG8_SCHED; PG8_LDA(At, 0, 0); PG8_STAGE(PG8_SA(1, 1), a1 + hstep, voffA);
            PG8_WAIT_L(8); PG8_BAR; PG8_WAIT_L(0); PG8_MMA(0, 0, At, B0); PG8_BAR; PG8_SCHED;
            PG8_LDB(B1, 0, 1); PG8_STAGE(PG8_SB(0, 0), b2, voffB);
            PG8_BAR; PG8_WAIT_L(0); PG8_MMA(0, 1, At, B1); PG8_BAR;
            PG8_LDA(At, 0, 1); PG8_STAGE(PG8_SA(0, 0), a2, voffA);
            PG8_BAR; PG8_WAIT_L(0); PG8_MMA(1, 0, At, B0); PG8_BAR; PG8_SCHED;
            PG8_STAGE(PG8_SB(0, 1), b2 + hstep, voffB);
            PG8_WAIT_V(6); PG8_BAR; PG8_MMA(1, 1, At, B1); PG8_BAR;
            PG8_LDB(B0, 1, 0); PG8_SCHED; PG8_LDA(At, 1, 0); PG8_STAGE(PG8_SA(0, 1), a2 + hstep, voffA);
            PG8_WAIT_L(8); PG8_BAR; PG8_WAIT_L(0); PG8_MMA(0, 0, At, B0); PG8_BAR; PG8_SCHED;
            PG8_LDB(B1, 1, 1); PG8_STAGE(PG8_SB(1, 0), b3, voffB);
            PG8_BAR; PG8_WAIT_L(0); PG8_MMA(0, 1, At, B1); PG8_BAR;
            PG8_LDA(At, 1, 1); PG8_STAGE(PG8_SA(1, 0), a3, voffA);
            PG8_BAR; PG8_WAIT_L(0); PG8_MMA(1, 0, At, B0); PG8_BAR; PG8_SCHED;
            PG8_STAGE(PG8_SB(1, 1), b3 + hstep, voffB);
            PG8_WAIT_V(6); PG8_BAR; PG8_MMA(1, 1, At, B1); PG8_BAR;
            }
        }
        if constexpr (ALIGN_EPI) { if (wr == 0) PG8_BAR; }
        if constexpr (FP8) asm volatile("s_nop 15\n\ts_nop 15" ::: "memory");
        if constexpr (!Epi::AFTER_DRAIN) { E(acc, cur, wr, wc, fr, fq); S.done(cur); }
        if (!has_next) break;
#pragma unroll
        for (int a = 0; a < 2; ++a)
#pragma unroll
            for (int b = 0; b < 2; ++b)
#pragma unroll
                for (int m = 0; m < 4; ++m)
#pragma unroll
                    for (int n = 0; n < 2; ++n) acc[a][b][m][n] = (f32x4){0.f, 0.f, 0.f, 0.f};
        cur = nxt; cA = nA; cB = nB; ++ui;
        if constexpr (ALIGN_EPI) { if (wr == 1) PG8_BAR; }
    }
    PG8_WAIT_V(0);
    if constexpr (!ALIGN_EPI) { if (wr == 0) PG8_BAR; }
    PG8_BAR;
    if constexpr (Epi::AFTER_DRAIN) { E.fused(acc, cur, wr, wc, fr, fq, lds, wid, lane); S.done(cur); }
#undef PG8_SA
#undef PG8_SB
#undef PG8_STAGE
#undef PG8_LDA
#undef PG8_LD8
#undef PG8_LDB
#undef PG8_MMA
#undef PG8_WAIT_V
#undef PG8_WAIT_L
#undef PG8_BAR
#undef PG8_SCHED
}
}
namespace pg8 {
typedef unsigned u32x2 __attribute__((ext_vector_type(2)));
constexpr int LDX = 2048;
constexpr float RMS_EPS = 1e-6f;
#ifndef EPI_SC1
#define EPI_SC1 1
#endif
__device__ __forceinline__ void store16(void* p, u32x4 w) {
#if EPI_SC1
    asm volatile("global_store_dwordx4 %0, %1, off sc1\n\ts_nop 1" :: "v"(p), "v"(w) : "memory");
#else
    *(u32x4*)p = w;
#endif
}
struct EpiQKV {
    static constexpr bool PERM = true, AFTER_DRAIN = false;
    bf16_t* O; const float* cs; float qscale; float* ksum; int vmode; float vscale; const float* rinv; float pre; int pnoff;
    __device__ __forceinline__ void operator()(const f32x4 (&acc)[2][2][4][2], const Unit& u, int wr, int wc, int fr, int fq) const {
        const int row0 = u.pm * BM + wr * 64 + fr, pn = vmode ? (u.pn < 4 ? u.pn + 8 : u.pn + 16) : (u.pn + pnoff < 8 ? u.pn + pnoff : u.pn + pnoff + 4);
        const float sc = (pn < 4 || (pn >= 12 && pn < 16)) ? qscale : vscale;
        const bool rot = (pn >= 12 && pn < 20) && (wc == 0);
        bf16_t* Ot = O + ((size_t)((u.pm >> 3) * 6 + (pn >> 2)) * 8 + (pn & 3) * 2) * (2048 * 128) + wc * 32 + 8 * fq;
        const bool kacc = (pn >= 16 && pn < 20);
        float rf[2][4];
#pragma unroll
        for (int ai = 0; ai < 2; ++ai)
#pragma unroll
            for (int m = 0; m < 4; ++m) rf[ai][m] = rinv[row0 + ai * HALF + m * 16] * pre;
        f32x4 ks[2][2] = {{{0.f, 0.f, 0.f, 0.f}, {0.f, 0.f, 0.f, 0.f}}, {{0.f, 0.f, 0.f, 0.f}, {0.f, 0.f, 0.f, 0.f}}};
#pragma unroll
        for (int ai = 0; ai < 2; ++ai)
#pragma unroll
            for (int m = 0; m < 4; ++m) { const int row = row0 + ai * HALF + m * 16; bf16_t* rowp = Ot + (size_t)(row & 2047) * 128;
                f32x4 c0 = {1.f, 1.f, 1.f, 1.f}, c1 = c0, s0 = {0.f, 0.f, 0.f, 0.f}, s1 = s0;
                if (rot) { const float* cr = cs + (size_t)row * 32 + 8 * (fq & 1); c0 = *(const f32x4*)cr; c1 = *(const f32x4*)(cr + 4); s0 = *(const f32x4*)(cr + 16); s1 = *(const f32x4*)(cr + 20);
                    if (fq < 2) { s0 = -s0; s1 = -s1; } }
#pragma unroll
                for (int bj = 0; bj < 2; ++bj) { f32x4 v0 = acc[ai][bj][m][0] * rf[ai][m], v1 = acc[ai][bj][m][1] * rf[ai][m];
                    if (rot) { f32x4 p0, p1;
#pragma unroll
                        for (int j = 0; j < 4; ++j) { p0[j] = __shfl_xor(v0[j], 32); p1[j] = __shfl_xor(v1[j], 32); }
                        v0 = v0 * c0 + p0 * s0; v1 = v1 * c1 + p1 * s1; }
                    if (kacc) { ks[bj][0] += v0; ks[bj][1] += v1; }
                    v0 = v0 * sc; v1 = v1 * sc; u32x4 w; w.x = cvt_pk_bf16(v0[0], v0[1]); w.y = cvt_pk_bf16(v0[2], v0[3]); w.z = cvt_pk_bf16(v1[0], v1[1]); w.w = cvt_pk_bf16(v1[2], v1[3]);
                    store16(rowp + (size_t)bj * (2048 * 128), w); } }
        if (kacc) {
            float* kp = ksum + (size_t)(((u.pm >> 3) * 8 + (pn - 16) * 2) * 8 + (u.pm & 7)) * 128 + wc * 32 + 8 * fq;
#pragma unroll
            for (int bj = 0; bj < 2; ++bj)
#pragma unroll
                for (int n = 0; n < 2; ++n)
#pragma unroll
                    for (int j = 0; j < 4; ++j) { float s = ks[bj][n][j]; s += __shfl_xor(s, 1); s += __shfl_xor(s, 2); s += __shfl_xor(s, 4); s += __shfl_xor(s, 8);
                        if (fr == 0) atomicAdd(kp + bj * 1024 + n * 4 + j, s); }
        }
    }
};
__device__ __forceinline__ unsigned pk4_fp8(float a, float b, float c, float d) {
    a = __builtin_amdgcn_fmed3f(a, -448.f, 448.f); b = __builtin_amdgcn_fmed3f(b, -448.f, 448.f); c = __builtin_amdgcn_fmed3f(c, -448.f, 448.f); d = __builtin_amdgcn_fmed3f(d, -448.f, 448.f);
    int p = __builtin_amdgcn_cvt_pk_fp8_f32(a, b, 0, false); p = __builtin_amdgcn_cvt_pk_fp8_f32(c, d, p, true); return (unsigned)p; }
struct EpiRes {
    static constexpr bool PERM = false, AFTER_DRAIN = false;
    const float* base; float* out; bf16_t* xb; float* ssq; unsigned char* x8; float s8; float ascale;
    __device__ __forceinline__ void operator()(const f32x4 (&acc)[2][2][4][2], const Unit& u, int wr, int wc, int fr, int fq) const {
        const int row0 = u.pm * BM + wr * 64 + fr, col0 = u.pn * BM + wc * 32 + 4 * fq;
#pragma unroll
        for (int ai = 0; ai < 2; ++ai)
#pragma unroll
            for (int m = 0; m < 4; ++m) { const int row = row0 + ai * HALF + m * 16; const size_t off = (size_t)row * LDX + col0; float s = 0.f;
#pragma unroll
                for (int bj = 0; bj < 2; ++bj)
#pragma unroll
                    for (int n = 0; n < 2; ++n) { const f32x4 v = *(const f32x4*)(base + off + bj * HALF + n * 16) + acc[ai][bj][m][n] * ascale;
                        *(f32x4*)(out + off + bj * HALF + n * 16) = v; s += (v[0] * v[0] + v[1] * v[1]) + (v[2] * v[2] + v[3] * v[3]);
                        if (xb) { u32x2 w; w.x = cvt_pk_bf16(v[0], v[1]); w.y = cvt_pk_bf16(v[2], v[3]); *(u32x2*)(xb + off + bj * HALF + n * 16) = w; }
                        if (x8) { *(unsigned*)(x8 + off + bj * HALF + n * 16) = pk4_fp8(v[0] * s8, v[1] * s8, v[2] * s8, v[3] * s8); } }
                if (ssq) { s += __shfl_xor(s, 16); s += __shfl_xor(s, 32); if (fq == 0) atomicAdd(ssq + row, s); }
                asm volatile("" ::: "memory"); }
    }
};
template <bool BASE_F32> struct EpiResB {
    static constexpr bool PERM = true, AFTER_DRAIN = false;
    const void* base; bf16_t* xo; float* ssq; unsigned char* x8; float s8; float ascale;
    __device__ __forceinline__ void operator()(const f32x4 (&acc)[2][2][4][2], const Unit& u, int wr, int wc, int fr, int fq) const {
        const int row0 = u.pm * BM + wr * 64 + fr, col0 = u.pn * BM + wc * 32 + 8 * fq;
#pragma unroll
        for (int ai = 0; ai < 2; ++ai)
#pragma unroll
            for (int m = 0; m < 4; ++m) { const int row = row0 + ai * HALF + m * 16; const size_t off = (size_t)row * LDX + col0; float s = 0.f;
#pragma unroll
                for (int bj = 0; bj < 2; ++bj) { f32x4 b0, b1;
                    if (BASE_F32) { const float* bp = (const float*)base + off + bj * HALF; b0 = *(const f32x4*)bp; b1 = *(const f32x4*)(bp + 4); }
                    else { const u32x4 w = *(const u32x4*)((const bf16_t*)base + off + bj * HALF);
                        b0 = (f32x4){__uint_as_float(w.x << 16), __uint_as_float(w.x & 0xffff0000u), __uint_as_float(w.y << 16), __uint_as_float(w.y & 0xffff0000u)};
                        b1 = (f32x4){__uint_as_float(w.z << 16), __uint_as_float(w.z & 0xffff0000u), __uint_as_float(w.w << 16), __uint_as_float(w.w & 0xffff0000u)}; }
                    const f32x4 v0 = b0 + acc[ai][bj][m][0] * ascale, v1 = b1 + acc[ai][bj][m][1] * ascale;
                    s += ((v0[0] * v0[0] + v0[1] * v0[1]) + (v0[2] * v0[2] + v0[3] * v0[3])) + ((v1[0] * v1[0] + v1[1] * v1[1]) + (v1[2] * v1[2] + v1[3] * v1[3]));
                    if (xo) { u32x4 w; w.x = cvt_pk_bf16(v0[0], v0[1]); w.y = cvt_pk_bf16(v0[2], v0[3]); w.z = cvt_pk_bf16(v1[0], v1[1]); w.w = cvt_pk_bf16(v1[2], v1[3]); store16(xo + off + bj * HALF, w); }
                    if (x8) { u32x2 w8; w8.x = pk4_fp8(v0[0] * s8, v0[1] * s8, v0[2] * s8, v0[3] * s8); w8.y = pk4_fp8(v1[0] * s8, v1[1] * s8, v1[2] * s8, v1[3] * s8); *(u32x2*)(x8 + off + bj * HALF) = w8; } }
                if (ssq) { s += __shfl_xor(s, 16); s += __shfl_xor(s, 32); if (fq == 0) atomicAdd(ssq + row, s); }
                if (BASE_F32 ? (m & 1) : (m == 3)) asm volatile("" ::: "memory"); }
    }
};
struct EpiScale {
    static constexpr bool PERM = true, AFTER_DRAIN = false;
    bf16_t* O; int ldc; const float* ssq; float sc;
    __device__ __forceinline__ void operator()(const f32x4 (&acc)[2][2][4][2], const Unit& u, int wr, int wc, int fr, int fq) const {
        const int row0 = u.pm * BM + wr * 64 + fr, col0 = u.pn * BM + wc * 32 + 8 * fq;
        float sv[2][4];
#pragma unroll
        for (int ai = 0; ai < 2; ++ai)
#pragma unroll
            for (int m = 0; m < 4; ++m) sv[ai][m] = ssq ? ssq[row0 + ai * HALF + m * 16] : 0.f;
#pragma unroll
        for (int ai = 0; ai < 2; ++ai)
#pragma unroll
            for (int m = 0; m < 4; ++m) { const int row = row0 + ai * HALF + m * 16; bf16_t* rowp = O + (size_t)row * ldc + col0;
                const float f = ssq ? sc * __builtin_amdgcn_rsqf(sv[ai][m] * (1.0f / 2048.0f) + RMS_EPS) : sc;
#pragma unroll
                for (int bj = 0; bj < 2; ++bj) { const f32x4 v0 = acc[ai][bj][m][0] * f, v1 = acc[ai][bj][m][1] * f;
                    u32x4 w; w.x = cvt_pk_bf16(v0[0], v0[1]); w.y = cvt_pk_bf16(v0[2], v0[3]); w.z = cvt_pk_bf16(v1[0], v1[1]); w.w = cvt_pk_bf16(v1[2], v1[3]);
                    *(u32x4*)(rowp + bj * HALF) = w; } }
    }
};
struct EpiNull { static constexpr bool PERM = true, AFTER_DRAIN = false; float* sink;
    __device__ __forceinline__ void operator()(const f32x4 (&acc)[2][2][4][2], const Unit& u, int wr, int wc, int fr, int fq) const {
#pragma unroll
        for (int ai = 0; ai < 2; ++ai)
#pragma unroll
            for (int bj = 0; bj < 2; ++bj)
#pragma unroll
                for (int m = 0; m < 4; ++m)
#pragma unroll
                    for (int n = 0; n < 2; ++n) asm volatile("" :: "v"(acc[ai][bj][m][n])); } };
struct EpiSwiGLU {
    static constexpr bool PERM = true, AFTER_DRAIN = false;
    bf16_t* O; const float* ssq; unsigned char* O8; float ascale, oscale;
    __device__ __forceinline__ void operator()(const f32x4 (&acc)[2][2][4][2], const Unit& u, int wr, int wc, int fr, int fq) const {
        const int row0 = u.pm * BM + wr * 64 + fr, col0 = u.pn * HALF + wc * 32 + 8 * fq;
        float sv[2][4];
#pragma unroll
        for (int ai = 0; ai < 2; ++ai)
#pragma unroll
            for (int m = 0; m < 4; ++m) sv[ai][m] = ssq[row0 + ai * HALF + m * 16];
#pragma unroll
        for (int ai = 0; ai < 2; ++ai)
#pragma unroll
            for (int m = 0; m < 4; ++m) { const int row = row0 + ai * HALF + m * 16; bf16_t* rowp = O + (size_t)row * 5632 + col0;
                const float f = ascale * __builtin_amdgcn_rsqf(sv[ai][m] * (1.0f / 2048.0f) + RMS_EPS);
                const float fneg = -1.4426950408889634f * f, f2o = f * f * (O8 ? oscale : 1.0f);
                float r[8];
#pragma unroll
                for (int n = 0; n < 2; ++n)
#pragma unroll
                    for (int j = 0; j < 4; ++j) { const float ag = acc[ai][0][m][n][j], au = acc[ai][1][m][n][j];
                        r[n * 4 + j] = (ag * au) * (f2o * __builtin_amdgcn_rcpf(1.0f + __builtin_amdgcn_exp2f(fneg * ag))); }
                if (O8) { u32x2 w8; w8.x = pk4_fp8(r[0], r[1], r[2], r[3]); w8.y = pk4_fp8(r[4], r[5], r[6], r[7]);
                    *(u32x2*)(O8 + (size_t)row * 5632 + col0) = w8; }
                else { u32x4 w; w.x = cvt_pk_bf16(r[0], r[1]); w.y = cvt_pk_bf16(r[2], r[3]); w.z = cvt_pk_bf16(r[4], r[5]); w.w = cvt_pk_bf16(r[6], r[7]);
                *(u32x4*)rowp = w; } }
    }
};
}
namespace att {
using bf16x8 = __attribute__((ext_vector_type(8))) short;
using s16x4  = __attribute__((ext_vector_type(4))) short;
using f32x16 = __attribute__((ext_vector_type(16))) float;
using f32x4  = __attribute__((ext_vector_type(4))) float;
using u32x4  = __attribute__((ext_vector_type(4))) unsigned;
typedef unsigned short bf16;
constexpr int D = 128, KVBLK = 64;
constexpr int SHM_V = KVBLK * D * 2, SHM_K = KVBLK * D * 2;
constexpr int OFF_Q = 2 * SHM_V + 2 * SHM_K, OFF_WS = 131072 + 1024, OFF_KM = OFF_WS + 2048, ATT_LDS = OFF_KM + 4096;
constexpr float THR = 8.f;
constexpr float SB_DONE = 7.8886e-31f;
#ifndef QREG_SOFTMAX
#define QREG_SOFTMAX 1
#endif
#ifndef PIPE_SOFTMAX
#define PIPE_SOFTMAX 0
#endif
#define KSWZ(row, colB) ((row) * 256 + ((colB) ^ (((row) & 7) << 4)))
#define SBAR() __builtin_amdgcn_sched_barrier(0)
__device__ __forceinline__ int crow(int r, int hi) { return (r & 3) + 8 * (r >> 2) + 4 * hi; }
__device__ __forceinline__ unsigned cvtpk(float lo, float hi) { unsigned r; asm volatile("v_cvt_pk_bf16_f32 %0, %1, %2" : "=v"(r) : "v"(lo), "v"(hi)); return r; }
__device__ __forceinline__ float xchg32(float x, int hi) { auto rr = __builtin_amdgcn_permlane32_swap(__float_as_uint(x), __float_as_uint(x), false, false); return __uint_as_float(hi ? rr[0] : rr[1]); }
typedef __attribute__((address_space(3))) const char* lds_cp;
template <int D0> __device__ __forceinline__ void qkt_part(f32x16& p0, f32x16& p1, const lds_cp (&ka)[2][4], int boff, const lds_cp (&qa)[2][4]) {
  const bf16x8 qf = *reinterpret_cast<const __attribute__((address_space(3))) bf16x8*>(qa[D0 >> 2][D0 & 3]);
  const bf16x8 b0 = *reinterpret_cast<const __attribute__((address_space(3))) bf16x8*>(ka[D0 >> 2][D0 & 3] + boff);
  const bf16x8 b1 = *reinterpret_cast<const __attribute__((address_space(3))) bf16x8*>(ka[D0 >> 2][D0 & 3] + boff + 8192);
  p0 = __builtin_amdgcn_mfma_f32_32x32x16_bf16(b0, qf, p0, 0, 0, 0);
  p1 = __builtin_amdgcn_mfma_f32_32x32x16_bf16(b1, qf, p1, 0, 0, 0);
}
template <int D0> __device__ __forceinline__ void qkt_part(f32x16& p0, f32x16& p1, const lds_cp (&ka)[2][4], int boff, const bf16x8 (&qg)[8]) {
  const bf16x8 b0 = *reinterpret_cast<const __attribute__((address_space(3))) bf16x8*>(ka[D0 >> 2][D0 & 3] + boff);
  const bf16x8 b1 = *reinterpret_cast<const __attribute__((address_space(3))) bf16x8*>(ka[D0 >> 2][D0 & 3] + boff + 8192);
  p0 = __builtin_amdgcn_mfma_f32_32x32x16_bf16(b0, qg[D0], p0, 0, 0, 0);
  p1 = __builtin_amdgcn_mfma_f32_32x32x16_bf16(b1, qg[D0], p1, 0, 0, 0);
}
#define KLD(G, A0, A1) do { A0 = *reinterpret_cast<const __attribute__((address_space(3))) bf16x8*>(ka[(G) >> 2][(G) & 3] + boff); A1 = *reinterpret_cast<const __attribute__((address_space(3))) bf16x8*>(ka[(G) >> 2][(G) & 3] + boff + 8192); } while (0)
#define KMM(G, A0, A1) do { p0 = __builtin_amdgcn_mfma_f32_32x32x16_bf16(A0, qg[G], p0, 0, 0, 0); p1 = __builtin_amdgcn_mfma_f32_32x32x16_bf16(A1, qg[G], p1, 0, 0, 0); } while (0)
__device__ __forceinline__ void qkt(f32x16& p0, f32x16& p1, const lds_cp (&ka)[2][4], int boff, const bf16x8 (&qg)[8], float bias = 0.f) {
#pragma unroll
  for (int r = 0; r < 16; ++r) { p0[r] = bias; p1[r] = bias; }
  bf16x8 a0, a1, b0, b1, c0, c1, d0, d1;
  KLD(0, a0, a1); KLD(1, b0, b1); KLD(2, c0, c1); KLD(3, d0, d1); SBAR();
  KMM(0, a0, a1); SBAR(); KLD(4, a0, a1); SBAR();
  KMM(1, b0, b1); SBAR(); KLD(5, b0, b1); SBAR();
  KMM(2, c0, c1); SBAR(); KLD(6, c0, c1); SBAR();
  KMM(3, d0, d1); SBAR(); KLD(7, d0, d1); SBAR();
  KMM(4, a0, a1); KMM(5, b0, b1); KMM(6, c0, c1); KMM(7, d0, d1);
}
#undef KLD
#undef KMM
__device__ __forceinline__ void qkt(f32x16& p0, f32x16& p1, const lds_cp (&ka)[2][4], int boff, const lds_cp (&qr)[2][4], float bias = 0.f) {
#pragma unroll
  for (int r = 0; r < 16; ++r) { p0[r] = bias; p1[r] = bias; }
  qkt_part<0>(p0, p1, ka, boff, qr); qkt_part<1>(p0, p1, ka, boff, qr); qkt_part<2>(p0, p1, ka, boff, qr); qkt_part<3>(p0, p1, ka, boff, qr);
  qkt_part<4>(p0, p1, ka, boff, qr); qkt_part<5>(p0, p1, ka, boff, qr); qkt_part<6>(p0, p1, ka, boff, qr); qkt_part<7>(p0, p1, ka, boff, qr);
}
__device__ __forceinline__ int v_st(int k, int c) { const int kk = (k & ~0xC) | ((k & 4) << 1) | ((k & 8) >> 1); return ((kk >> 3) * 4 + (c >> 5)) * 512 + ((kk & 7) * 32 + (c & 31)) * 2; }
__device__ __forceinline__ int v_rd_base(int lane) { return ((lane & 3) << 3) | (((lane >> 2) & 3) << 6) | (((lane >> 4) & 1) << 5) | (((lane >> 5) & 1) << 8); }
constexpr int v_rd_off(int d0, int ks, int half) { return d0 * 512 + ks * 4096 + half * 2048; }
template <int OFF> __device__ __forceinline__ s16x4 tr_read(int vb) { s16x4 r; asm volatile("ds_read_b64_tr_b16 %0, %1 offset:%2" : "=&v"(r) : "v"(vb), "i"(OFF) : "memory"); return r; }
struct VFrag { s16x4 l0, h0, l1, h1, l2, h2, l3, h3; };
template <int D0> __device__ __forceinline__ void v_read(VFrag& f, int vb) {
  f.l0 = tr_read<v_rd_off(D0, 0, 0)>(vb); f.h0 = tr_read<v_rd_off(D0, 0, 1)>(vb); f.l1 = tr_read<v_rd_off(D0, 1, 0)>(vb); f.h1 = tr_read<v_rd_off(D0, 1, 1)>(vb);
  f.l2 = tr_read<v_rd_off(D0, 2, 0)>(vb); f.h2 = tr_read<v_rd_off(D0, 2, 1)>(vb); f.l3 = tr_read<v_rd_off(D0, 3, 0)>(vb); f.h3 = tr_read<v_rd_off(D0, 3, 1)>(vb);
}
__device__ __forceinline__ void pv_mma(f32x16& od, const VFrag& f, bf16x8 pa0, bf16x8 pa1, bf16x8 pa2, bf16x8 pa3) {
#define PK(L, H) (bf16x8){L[0], L[1], L[2], L[3], H[0], H[1], H[2], H[3]}
  od = __builtin_amdgcn_mfma_f32_32x32x16_bf16(pa0, PK(f.l0, f.h0), od, 0, 0, 0);
  od = __builtin_amdgcn_mfma_f32_32x32x16_bf16(pa1, PK(f.l1, f.h1), od, 0, 0, 0);
  od = __builtin_amdgcn_mfma_f32_32x32x16_bf16(pa2, PK(f.l2, f.h2), od, 0, 0, 0);
  od = __builtin_amdgcn_mfma_f32_32x32x16_bf16(pa3, PK(f.l3, f.h3), od, 0, 0, 0);
#undef PK
}
__device__ __forceinline__ void pv_d0(f32x16* o, int vb, bf16x8 pa0, bf16x8 pa1, bf16x8 pa2, bf16x8 pa3) {
  VFrag fa, fb;
  v_read<0>(fa, vb);
  v_read<1>(fb, vb); asm volatile("s_waitcnt lgkmcnt(8)" ::: "memory"); SBAR(); pv_mma(o[0], fa, pa0, pa1, pa2, pa3); SBAR();
  v_read<2>(fa, vb); asm volatile("s_waitcnt lgkmcnt(8)" ::: "memory"); SBAR(); pv_mma(o[1], fb, pa0, pa1, pa2, pa3); SBAR();
  v_read<3>(fb, vb); asm volatile("s_waitcnt lgkmcnt(8)" ::: "memory"); SBAR(); pv_mma(o[2], fa, pa0, pa1, pa2, pa3); SBAR();
  asm volatile("s_waitcnt lgkmcnt(0)" ::: "memory"); SBAR(); pv_mma(o[3], fb, pa0, pa1, pa2, pa3);
}
__device__ __forceinline__ void pack_p(const f32x16& p0, const f32x16& p1, bf16x8& pa0, bf16x8& pa1, bf16x8& pa2, bf16x8& pa3) {
#define PK4(P, BASE, OUT) do { unsigned a0 = cvtpk(P[BASE + 0], P[BASE + 1]), a1 = cvtpk(P[BASE + 2], P[BASE + 3]);   \
    unsigned b0 = cvtpk(P[BASE + 4], P[BASE + 5]), b1 = cvtpk(P[BASE + 6], P[BASE + 7]);                              \
    auto r0 = __builtin_amdgcn_permlane32_swap(a0, b0, false, false); auto r1 = __builtin_amdgcn_permlane32_swap(a1, b1, false, false); \
    u32x4 w = {r0[0], r1[0], r0[1], r1[1]}; OUT = *reinterpret_cast<bf16x8*>(&w); } while (0)
  PK4(p0, 0, pa0); PK4(p0, 8, pa1); PK4(p1, 0, pa2); PK4(p1, 8, pa3);
#undef PK4
}
__device__ __forceinline__ void softmax_tile(f32x16& p0, f32x16& p1, float& m_reg, float& l_reg, float& alpha) {
  float pmax = p0[0];
#pragma unroll
  for (int r = 1; r < 16; ++r) pmax = fmaxf(pmax, p0[r]);
#pragma unroll
  for (int r = 0; r < 16; ++r) pmax = fmaxf(pmax, p1[r]);
  pmax = fmaxf(pmax, xchg32(pmax, (int)(threadIdx.x >> 5) & 1));
  if (__all(pmax - m_reg <= THR)) { alpha = 1.f; }
  else { const float mn = fmaxf(m_reg, pmax); alpha = __builtin_amdgcn_exp2f(m_reg - mn); m_reg = mn; }
  float ps = 0.f;
#pragma unroll
  for (int r = 0; r < 16; ++r) { p0[r] = __builtin_amdgcn_exp2f(p0[r] - m_reg); ps += p0[r]; }
#pragma unroll
  for (int r = 0; r < 16; ++r) { p1[r] = __builtin_amdgcn_exp2f(p1[r] - m_reg); ps += p1[r]; }
  ps += xchg32(ps, (int)(threadIdx.x >> 5) & 1);
  l_reg = l_reg * alpha + ps;
}
template <bool BAND, int I> __device__ __forceinline__ float sb_group(f32x16& P, int kb, int qrel, int hi) {
  float run = 1.f;
#pragma unroll
  for (int e = 3; e >= 0; --e) { const int r = 4 * I + e; float rr = __builtin_amdgcn_rcpf(1.0f + __builtin_amdgcn_exp2f(P[r]));
    if (BAND) rr = (kb + crow(r, hi) < qrel) ? rr : 1.f;
    P[r] = (1.0f - rr) * run; run *= rr; }
  return run;
}
__device__ __forceinline__ void sb_combine(f32x16& p0, f32x16& p1, float (&gs)[8], float& carry, int hi) {
  float acc = 1.f;
#pragma unroll
  for (int i = 7; i >= 0; --i) { const float so_i = acc; acc *= gs[i]; const float x = hi ? acc : so_i; gs[i] = carry * so_i * xchg32(x, hi); }
  carry *= acc * xchg32(acc, hi);
#pragma unroll
  for (int i = 0; i < 4; ++i)
#pragma unroll
    for (int e = 0; e < 4; ++e) { p0[4 * i + e] *= gs[i]; p1[4 * i + e] *= gs[4 + i]; }
}
template <bool BAND>
__device__ __forceinline__ void sb_tile(f32x16& p0, f32x16& p1, float& carry, int kb, int qrel, int hi) {
  float gs[8];
  gs[0] = sb_group<BAND, 0>(p0, kb, qrel, hi); SBAR(); gs[1] = sb_group<BAND, 1>(p0, kb, qrel, hi); SBAR(); gs[2] = sb_group<BAND, 2>(p0, kb, qrel, hi); SBAR(); gs[3] = sb_group<BAND, 3>(p0, kb, qrel, hi); SBAR();
  gs[4] = sb_group<BAND, 0>(p1, kb + 32, qrel, hi); SBAR(); gs[5] = sb_group<BAND, 1>(p1, kb + 32, qrel, hi); SBAR(); gs[6] = sb_group<BAND, 2>(p1, kb + 32, qrel, hi); SBAR(); gs[7] = sb_group<BAND, 3>(p1, kb + 32, qrel, hi); SBAR();
  sb_combine(p0, p1, gs, carry, hi);
}

template <int MODE, bool OUT8 = false>
__device__ __forceinline__ void attn_unit(const bf16* __restrict__ Qb_or_hb, const bf16* __restrict__ Kh_in, const bf16* __restrict__ Vh_in, bf16* __restrict__ Ob,
                                          const float* __restrict__ gain, const float* __restrict__ kmean, int qb, int nkeys, char* lds, float s8 = 1.f,
                                          bool preissued = false, const bf16* __restrict__ nhb = nullptr, int nqb = 0, int nt0 = 0, int nt1 = -1) {
  constexpr int ldq = (MODE == 0) ? 512 : 128, ldk = (MODE == 0) ? 1024 : 128, ldo = (MODE == 0) ? 512 : 2048;
  constexpr long HSZ_ = 2048L * 128L;
  const bf16* __restrict__ Qb = (MODE == 0) ? Qb_or_hb : Qb_or_hb + (long)qb * (256 * 128);
  const bf16* __restrict__ Kh = (MODE == 0) ? Kh_in : Qb_or_hb + 8 * HSZ_;
  const bf16* __restrict__ Vh = (MODE == 0) ? Vh_in : Qb_or_hb + 16 * HSZ_;
  int tid_ = threadIdx.x; asm volatile("" : "+v"(tid_));
  const int tid = tid_, wid = __builtin_amdgcn_readfirstlane(tid >> 6), lane = tid & 63, r32 = lane & 31, hi = lane >> 5;
  char* V_lds = lds; char* K_lds = lds + 2 * SHM_V;
  float* ws = (float*)(lds + OFF_WS) + wid * 64; float* li_l = ws; float* al_l = ws + 32;
  float* km_l = (float*)(lds + OFF_KM);
  int* flg = (int*)(lds + OFF_KM);
  const int NT = (MODE == 0) ? nkeys / KVBLK : 4 * (qb + 1);
  const int qrel = wid * 32 + r32;
  float m_reg = -1e30f, l_reg = 0.f, carry = 1.f; f32x16 o[4] = {};
  const int vb0 = (int)(uintptr_t)V_lds + v_rd_base(lane);
  lds_cp ka[2][4];
#pragma unroll
  for (int y = 0; y < 2; ++y)
#pragma unroll
    for (int x = 0; x < 4; ++x) ka[y][x] = (lds_cp)(__attribute__((address_space(3))) char*)K_lds + r32 * 256 + 128 * (y ^ ((r32 >> 3) & 1)) + 32 * (x ^ ((r32 >> 1) & 3)) + 16 * (hi ^ (r32 & 1));
  lds_cp qr[2][4];
#pragma unroll
  for (int y = 0; y < 2; ++y)
#pragma unroll
    for (int x = 0; x < 4; ++x) qr[y][x] = ka[y][x] + (OFF_Q - 2 * SHM_V) + wid * 8192;
  long ksrc[2], vsrc[2];
#pragma unroll
  for (int i = 0; i < 2; ++i) { const int piece = wid + 8 * i;
    { const int row = piece * 4 + (lane >> 4), c = (lane & 15) ^ (row & 15); ksrc[i] = (long)row * ldk + c * 8; }
    { const int sub = piece * 2 + (lane >> 5), kk = (sub >> 2) * 8 + ((lane & 31) >> 2), k = (kk & ~0xC) | ((kk & 4) << 1) | ((kk & 8) >> 1), c = (sub & 3) * 32 + (lane & 3) * 8; vsrc[i] = (long)k * ldk + c; } }
  typedef __attribute__((address_space(3))) unsigned lds_u32;
  lds_u32* kdst = (lds_u32*)(__attribute__((address_space(3))) char*)(K_lds) + wid * 256; lds_u32* vdst = (lds_u32*)(__attribute__((address_space(3))) char*)(V_lds) + wid * 256;
#define TILE(it) ((MODE == 2) ? (NT - 1 - (it)) : (it))
#define DMA_K(k0, b) do { _Pragma("unroll") for (int i_ = 0; i_ < 2; ++i_) __builtin_amdgcn_global_load_lds((const unsigned*)(Kh + (long)(k0) * ldk + ksrc[i_]), kdst + (b) * (SHM_K / 4) + i_ * 2048, 16, 0, 0); } while (0)
#define DMA_V(k0, b) do { _Pragma("unroll") for (int i_ = 0; i_ < 2; ++i_) __builtin_amdgcn_global_load_lds((const unsigned*)(Vh + (long)(k0) * ldk + vsrc[i_]), vdst + (b) * (SHM_V / 4) + i_ * 2048, 16, 0, 0); } while (0)
#define SDRAIN() asm volatile("s_waitcnt vmcnt(0)" ::: "memory")
#define KSLOT(i_) ((i_) == 2 ? (OFF_Q - 2 * SHM_V) : (i_) * SHM_K)
#define VSLOT(i_) ((i_) == 2 ? (OFF_Q + SHM_K) : (i_) * SHM_V)
#define DMA_K3(k0, so) do { _Pragma("unroll") for (int i_ = 0; i_ < 2; ++i_) __builtin_amdgcn_global_load_lds((const unsigned*)(Kh + (long)(k0) * ldk + ksrc[i_]), kdst + (so) / 4 + i_ * 2048, 16, 0, 0); } while (0)
#define DMA_V3(k0, so) do { _Pragma("unroll") for (int i_ = 0; i_ < 2; ++i_) __builtin_amdgcn_global_load_lds((const unsigned*)(Vh + (long)(k0) * ldk + vsrc[i_]), vdst + (so) / 4 + i_ * 2048, 16, 0, 0); } while (0)
  lds_u32* qdst = (lds_u32*)(__attribute__((address_space(3))) char*)(lds + OFF_Q) + wid * 2048;
#define ISSUE_UNIT(QB_, KH_, VH_, T0_, T1_) do { \
    _Pragma("unroll") for (int i = 0; i < 8; ++i) { const int row = 4 * i + (lane >> 4), c = (lane & 15) ^ (row & 15); \
      __builtin_amdgcn_global_load_lds((const unsigned*)((QB_) + (long)(wid * 32 + row) * ldq + c * 8), qdst + i * 256, 16, 0, 0); } \
    _Pragma("unroll") for (int i_ = 0; i_ < 2; ++i_) { \
      __builtin_amdgcn_global_load_lds((const unsigned*)((KH_) + (long)((T0_) * KVBLK) * ldk + ksrc[i_]), kdst + i_ * 2048, 16, 0, 0); \
      __builtin_amdgcn_global_load_lds((const unsigned*)((VH_) + (long)((T0_) * KVBLK) * ldk + vsrc[i_]), vdst + i_ * 2048, 16, 0, 0); } \
    if ((T1_) >= 0) { _Pragma("unroll") for (int i_ = 0; i_ < 2; ++i_) __builtin_amdgcn_global_load_lds((const unsigned*)((KH_) + (long)((T1_) * KVBLK) * ldk + ksrc[i_]), kdst + (SHM_K / 4) + i_ * 2048, 16, 0, 0); } } while (0)
  if (!preissued) ISSUE_UNIT(Qb, Kh, Vh, TILE(0), ((MODE == 2 || PIPE_SOFTMAX) ? TILE(1) : -1));
  constexpr bool RING3 = (MODE != 2) && QREG_SOFTMAX && !PIPE_SOFTMAX;
  unsigned selmask = 0u;
  float gv[4] = {1.f, 1.f, 1.f, 1.f};
  if (gain) {
#pragma unroll
    for (int d0 = 0; d0 < 4; ++d0) gv[d0] = gain[d0 * 32 + r32]; }
  if (MODE == 1) { if (tid < 256) *(f32x4*)(km_l + tid * 4) = *(const f32x4*)(kmean + tid * 4); }
  SDRAIN();
  __syncthreads();
  if (MODE == 1) {
    float g[8];
#pragma unroll
    for (int n = 0; n < 8; ++n) g[n] = 0.f;
    { const int rh = (r32 >> 1) & 3, r3 = (r32 >> 3) & 1;
      const lds_cp qbase = qr[0][0] - 32 * rh - 128 * r3;
#pragma unroll 1
      for (int d0 = 0; d0 < 8; ++d0) {
        const bf16x8 qf = *reinterpret_cast<const __attribute__((address_space(3))) bf16x8*>(qbase + 32 * ((d0 & 3) ^ rh) + 128 * ((d0 >> 2) ^ r3));
        float q[8];
#pragma unroll
        for (int j = 0; j < 8; ++j) q[j] = __uint_as_float(((unsigned)(unsigned short)qf[j]) << 16);
        const float* kmp = km_l + d0 * 16 + hi * 8;
#pragma unroll
        for (int n = 0; n < 7; ++n) { const f32x4 k0v = *(const f32x4*)(kmp + n * 128), k1v = *(const f32x4*)(kmp + n * 128 + 4);
          g[n] += (q[0] * k0v[0] + q[1] * k0v[1]) + (q[2] * k0v[2] + q[3] * k0v[3]) + (q[4] * k1v[0] + q[5] * k1v[1]) + (q[6] * k1v[2] + q[7] * k1v[3]); }
      } }
#pragma unroll
    for (int n = 0; n < 7; ++n) { g[n] += xchg32(g[n], hi); if (n >= qb) g[n] = -INFINITY; }
    g[7] = -INFINITY;
#pragma unroll
    for (int n = 0; n < 7; ++n) { int cnt = 0;
#pragma unroll
      for (int mI = 0; mI < 7; ++mI) { if (mI != n) cnt += (g[mI] > g[n] || (g[mI] == g[n] && mI < n)) ? 1 : 0; }
      if (n < qb && cnt < 3) selmask |= (1u << n); }
  }
  bf16x8 qg[8];
  if (QREG_SOFTMAX && MODE != 2) {
#pragma unroll
    for (int d0 = 0; d0 < 8; ++d0) qg[d0] = *reinterpret_cast<const __attribute__((address_space(3))) bf16x8*>(qr[d0 >> 2][d0 & 3]); }
  int kc = KSLOT(0), kn = KSLOT(1), kn2 = KSLOT(2), vc = VSLOT(0), vn = VSLOT(1), vn2 = VSLOT(2);
  if (RING3) { DMA_K3(TILE(1) * KVBLK, kn); DMA_V3(TILE(1) * KVBLK, vn);
    asm volatile("s_waitcnt lgkmcnt(0)" ::: "memory"); __syncthreads(); }
  f32x16 pA0, pA1, pB0, pB1; bf16x8 pa0, pa1, pa2, pa3;
  if (MODE == 2 || PIPE_SOFTMAX) { float bias0 = 0.f; if (MODE == 1) { if (NT > 4) bias0 = (selmask & 1u) ? 0.f : -INFINITY; }
    qkt(pA0, pA1, ka, 0, qr, bias0);
    __syncthreads(); }
  int it = 0;
#define JB(i_) ((MODE == 2) ? (3 - (i_)) : ((i_) - (NT - 4)))
#define STEP(A0, A1, B0, B1, BAND, HASNEXT) do { \
    if (it + 2 < NT) DMA_K(TILE(it + 2) * KVBLK, it & 1); \
    if (it + 1 < NT) DMA_V(TILE(it + 1) * KVBLK, (it + 1) & 1); \
    bool skip = false; const int jb = JB(it); \
    if (BAND) { if (MODE == 1) skip = (64 * jb > wid * 32 + 31); if (MODE == 2) skip = (64 * jb >= wid * 32 + 31); } \
    if (MODE == 2) skip = skip || __all(carry < SB_DONE);        \
    if (HASNEXT) { float bias_ = 0.f; if (MODE == 1) { if (it + 1 < NT - 4) bias_ = ((selmask >> ((it + 1) >> 2)) & 1u) ? 0.f : -INFINITY; } \
      qkt(B0, B1, ka, ((it + 1) & 1) * SHM_K, qr, bias_); } \
    if (!skip) { \
      if (MODE == 2) { sb_tile<(BAND) != 0>(A0, A1, carry, 64 * jb, qrel, hi); } \
      else { \
        if (MODE == 1 && (BAND)) { _Pragma("unroll") for (int r = 0; r < 16; ++r) { const int kr = 64 * jb + crow(r, hi); if (kr > qrel) A0[r] = -INFINITY; if (kr + 32 > qrel) A1[r] = -INFINITY; } } \
        float alpha; softmax_tile(A0, A1, m_reg, l_reg, alpha); \
        if (__any(alpha < 1.f)) { if (hi == 0) al_l[r32] = alpha; asm volatile("s_waitcnt lgkmcnt(0)" ::: "memory"); \
          _Pragma("unroll") for (int d = 0; d < 4; ++d) _Pragma("unroll") for (int r = 0; r < 16; ++r) o[d][r] *= al_l[crow(r, hi)]; } \
      } \
      pack_p(A0, A1, pa0, pa1, pa2, pa3); \
      pv_d0(o, vb0 + (it & 1) * SHM_V, pa0, pa1, pa2, pa3); \
    } \
    SDRAIN(); __syncthreads(); ++it; } while (0)
#define SB_LD(G, F) do { F##q = *reinterpret_cast<const __attribute__((address_space(3))) bf16x8*>(qr[(G) >> 2][(G) & 3]); \
      F##0 = *reinterpret_cast<const __attribute__((address_space(3))) bf16x8*>(ka[(G) >> 2][(G) & 3] + kb_); F##1 = *reinterpret_cast<const __attribute__((address_space(3))) bf16x8*>(ka[(G) >> 2][(G) & 3] + kb_ + 8192); } while (0)
#define SB_PART(G, P, I, B0, B1, FC, FN) do { if ((G) < 7) SB_LD(((G) + 1) & 7, FN);              \
      B0 = __builtin_amdgcn_mfma_f32_32x32x16_bf16(FC##0, FC##q, B0, 0, 0, 0); B1 = __builtin_amdgcn_mfma_f32_32x32x16_bf16(FC##1, FC##q, B1, 0, 0, 0); \
      gs_[G] = sb_group<false, I>(P, 0, 0, hi); SBAR(); } while (0)
#define STEP_SB(A0, A1, B0, B1) do { \
    if (it + 2 < NT) DMA_K(TILE(it + 2) * KVBLK, it & 1); \
    DMA_V(TILE(it + 1) * KVBLK, (it + 1) & 1); \
    float gs_[8]; \
    _Pragma("unroll") for (int r = 0; r < 16; ++r) { B0[r] = 0.f; B1[r] = 0.f; } \
    const int kb_ = ((it + 1) & 1) * SHM_K; bf16x8 fx0, fx1, fxq, fy0, fy1, fyq; SB_LD(0, fx); SBAR(); \
    SB_PART(0, A0, 0, B0, B1, fx, fy); SB_PART(1, A0, 1, B0, B1, fy, fx); SB_PART(2, A0, 2, B0, B1, fx, fy); SB_PART(3, A0, 3, B0, B1, fy, fx); \
    SB_PART(4, A1, 0, B0, B1, fx, fy); SB_PART(5, A1, 1, B0, B1, fy, fx); SB_PART(6, A1, 2, B0, B1, fx, fy); SB_PART(7, A1, 3, B0, B1, fy, fx); \
    sb_combine(A0, A1, gs_, carry, hi); \
    { const bool dn_ = __all(carry < SB_DONE); if (lane == 0) flg[(it & 1) * 8 + wid] = dn_ ? 1 : 0; } \
    pack_p(A0, A1, pa0, pa1, pa2, pa3); \
    pv_d0(o, vb0 + (it & 1) * SHM_V, pa0, pa1, pa2, pa3); \
    SDRAIN(); __syncthreads(); \
    { const int* f_ = flg + (it & 1) * 8; stop = (f_[0] + f_[1] + f_[2] + f_[3] + f_[4] + f_[5] + f_[6] + f_[7]) == 8; } \
    ++it; } while (0)
#define SSTEP(BAND) do { \
    if (RING3) { if (it + 2 < NT) { DMA_K3(TILE(it + 2) * KVBLK, kn2); DMA_V3(TILE(it + 2) * KVBLK, vn2); } } \
    else if (it + 1 < NT) { DMA_K(TILE(it + 1) * KVBLK, (it + 1) & 1); DMA_V(TILE(it + 1) * KVBLK, (it + 1) & 1); } \
    bool skip = false; const int jb = JB(it); \
    if (BAND) skip = (64 * jb > wid * 32 + 31); \
    if (!skip) { \
      float bias_ = 0.f; if (MODE == 1 && !(BAND)) bias_ = ((selmask >> (it >> 2)) & 1u) ? 0.f : -INFINITY; \
      const int kb_ = RING3 ? kc : (it & 1) * SHM_K; \
      if (QREG_SOFTMAX) qkt(pA0, pA1, ka, kb_, qg, bias_); else qkt(pA0, pA1, ka, kb_, qr, bias_); \
      if (MODE == 1 && (BAND)) { _Pragma("unroll") for (int r = 0; r < 16; ++r) { const int kr = 64 * jb + crow(r, hi); if (kr > qrel) pA0[r] = -INFINITY; if (kr + 32 > qrel) pA1[r] = -INFINITY; } } \
      float alpha; softmax_tile(pA0, pA1, m_reg, l_reg, alpha); \
      if (__any(alpha < 1.f)) { if (hi == 0) al_l[r32] = alpha; asm volatile("s_waitcnt lgkmcnt(0)" ::: "memory"); \
        _Pragma("unroll") for (int d = 0; d < 4; ++d) _Pragma("unroll") for (int r = 0; r < 16; ++r) o[d][r] *= al_l[crow(r, hi)]; } \
      pack_p(pA0, pA1, pa0, pa1, pa2, pa3); \
      pv_d0(o, vb0 + (RING3 ? vc : (it & 1) * SHM_V), pa0, pa1, pa2, pa3); \
    } \
    if (RING3) { if (it + 2 < NT) asm volatile("s_waitcnt vmcnt(4)" ::: "memory"); else SDRAIN();        \
      { const int t_ = kc; kc = kn; kn = kn2; kn2 = t_; } { const int t_ = vc; vc = vn; vn = vn2; vn2 = t_; } } \
    else SDRAIN(); \
    if (RING3) { asm volatile("s_waitcnt lgkmcnt(0)" ::: "memory"); __builtin_amdgcn_s_barrier(); asm volatile("" ::: "memory"); }     \
    else __syncthreads(); \
    ++it; } while (0)
#define RESTART(BIASEXPR) do { qkt(pA0, pA1, ka, (it & 1) * SHM_K, qr, (BIASEXPR)); __syncthreads(); } while (0)
  if (MODE == 0) {
    if (PIPE_SOFTMAX) { STEP(pA0, pA1, pB0, pB1, 0, true); STEP(pB0, pB1, pA0, pA1, 0, true); STEP(pA0, pA1, pB0, pB1, 0, true); STEP(pB0, pB1, pA0, pA1, 0, false); }
    else { SSTEP(0); SSTEP(0); SSTEP(0); SSTEP(0); }
  } else if (MODE == 1) {
    if (PIPE_SOFTMAX) {
      if (NT > 4) { while (it < NT - 4) { STEP(pA0, pA1, pB0, pB1, 0, true); STEP(pB0, pB1, pA0, pA1, 0, (it + 1 < NT - 4)); }
        RESTART(0.f); }
      STEP(pA0, pA1, pB0, pB1, 1, true); STEP(pB0, pB1, pA0, pA1, 1, true); STEP(pA0, pA1, pB0, pB1, 1, true); STEP(pB0, pB1, pA0, pA1, 1, false);
    } else {
      while (it < NT - 4) SSTEP(0);
      SSTEP(1); SSTEP(1); SSTEP(1); SSTEP(1);
    }
  } else {
    STEP(pA0, pA1, pB0, pB1, 1, true); STEP(pB0, pB1, pA0, pA1, 1, true); STEP(pA0, pA1, pB0, pB1, 1, true); STEP(pB0, pB1, pA0, pA1, 1, false);
    if (NT > 4) {
      RESTART(0.f);
      bool stop = false;
      while (it + 2 < NT && !stop) { STEP_SB(pA0, pA1, pB0, pB1); STEP_SB(pB0, pB1, pA0, pA1); }
      if (!stop) { STEP_SB(pA0, pA1, pB0, pB1); STEP(pB0, pB1, pA0, pA1, 0, false); }
    }
  }
#undef RESTART
#undef STEP
#undef SSTEP
#undef STEP_SB
#undef SB_LD
#undef SB_PART
#undef JB
  if (OUT8) { if (nhb) ISSUE_UNIT(nhb + (long)nqb * (256 * 128), nhb + 8 * HSZ_, nhb + 16 * HSZ_, nt0, nt1); }
  float rli[16];
  if (MODE != 2) { if (hi == 0) li_l[r32] = l_reg; asm volatile("s_waitcnt lgkmcnt(0)" ::: "memory");
#pragma unroll
    for (int r = 0; r < 16; ++r) rli[r] = __builtin_amdgcn_rcpf(li_l[crow(r, hi)]); }
  else {
#pragma unroll
    for (int r = 0; r < 16; ++r) rli[r] = 1.f; }
  if (gain) {
#pragma unroll
    for (int r = 0; r < 16; ++r) { float s = 0.f;
#pragma unroll
      for (int d0 = 0; d0 < 4; ++d0) { o[d0][r] *= rli[r]; s += o[d0][r] * o[d0][r]; }
      s += __shfl_xor(s, 1); s += __shfl_xor(s, 2); s += __shfl_xor(s, 4); s += __shfl_xor(s, 8); s += __shfl_xor(s, 16);
      rli[r] = __builtin_amdgcn_rsqf(s * (1.0f / 128.0f) + 1e-6f); }
#pragma unroll
    for (int r = 0; r < 16; ++r)
#pragma unroll
      for (int d0 = 0; d0 < 4; ++d0) o[d0][r] *= gv[d0];
  }
  if (OUT8) {
#pragma unroll
    for (int r = 0; r < 16; ++r) { const float f = rli[r] * s8;
      const float v0 = __builtin_amdgcn_fmed3f(o[0][r] * f, -448.f, 448.f), v1 = __builtin_amdgcn_fmed3f(o[1][r] * f, -448.f, 448.f), v2 = __builtin_amdgcn_fmed3f(o[2][r] * f, -448.f, 448.f), v3 = __builtin_amdgcn_fmed3f(o[3][r] * f, -448.f, 448.f);
      int p = __builtin_amdgcn_cvt_pk_fp8_f32(v0, v1, 0, false); p = __builtin_amdgcn_cvt_pk_fp8_f32(v2, v3, p, true);
      *(unsigned*)((unsigned char*)Ob + (long)(wid * 32 + crow(r, hi)) * ldo + 4 * r32) = (unsigned)p; } }
  else { bf16* stg = (bf16*)lds + wid * 4096;
#pragma unroll
    for (int r = 0; r < 16; ++r) { const int orow = crow(r, hi);
#pragma unroll
      for (int d0 = 0; d0 < 4; ++d0) { const float v = o[d0][r] * rli[r]; unsigned u = __float_as_uint(v); u = (u + 0x7fffu + ((u >> 16) & 1u)) >> 16; stg[orow * 128 + d0 * 32 + r32] = (bf16)u; } }
    asm volatile("s_waitcnt lgkmcnt(0)" ::: "memory");
#pragma unroll
    for (int i = 0; i < 8; ++i) { const int row = i * 4 + (lane >> 4), ch = lane & 15; const u32x4 v = *(const u32x4*)(stg + row * 128 + ch * 8); *(u32x4*)(Ob + (long)(wid * 32 + row) * ldo + ch * 8) = v; } }
  __syncthreads();
#undef TILE
#undef ISSUE_UNIT
#undef DMA_K
#undef DMA_V
#undef DMA_K3
#undef DMA_V3
#undef KSLOT
#undef VSLOT
#undef SDRAIN
}
#undef KSWZ
#undef SBAR
}
#define GAS __attribute__((address_space(1)))
#define LAS __attribute__((address_space(3)))
typedef unsigned short bf16;
typedef unsigned v4u __attribute__((ext_vector_type(4)));
typedef float f32x4 __attribute__((ext_vector_type(4)));
#define LDS_WAIT() asm volatile("s_waitcnt lgkmcnt(0)" ::: "memory")
constexpr int NWAVES = 8;
constexpr int BATCH = 8, SEQ = 2048, DM = 2048, M = BATCH * SEQ, HD = 128, NH = 8;
constexpr int NQKV = 6144, FF = 5632, WX = 512, NMEM = 256, MMEM = BATCH * NMEM;
constexpr int QSB = 0, KSB = 1024, VSB = 2048, QMB = 3072, KMB = 4096, VMB = 5120;
constexpr float EPS = 1e-6f;
constexpr float QSCALE = 0.12751743082459868f;
constexpr size_t MiB = 1u << 20;
constexpr size_t WS_CTL = 0, CTL_ZERO_BYTES = 512 * 1024;
constexpr size_t WS_SSQ1 = 64 * 1024, WS_SSQ2 = 128 * 1024;
constexpr size_t WS_KSUM = 256 * 1024;
constexpr size_t WS_WIN = 1 * MiB, WS_WOUT = 25 * MiB, WS_WXQ = 33 * MiB, WS_WXKV = 35 * MiB, WS_WXO = 39 * MiB, WS_WGU = 41 * MiB, WS_WDN = 85 * MiB;
constexpr size_t WS_RA = 107 * MiB;
constexpr size_t WS_RB = 171 * MiB;
constexpr size_t WS_RC = 235 * MiB;
constexpr size_t WS_QX = 427 * MiB, WS_OX = 443 * MiB, WS_KVX = 459 * MiB, WS_MN = 463 * MiB, WS_KMEAN = 471 * MiB, WS_RINV0 = 471 * MiB  , WS_CS = 472 * MiB, WS_END = 474 * MiB;
constexpr int RING_BYTES = 131072, LDS_BYTES = 147456;
#ifndef FFN_FP8
#define FFN_FP8 1
#endif
#ifndef QK_FP8
#define QK_FP8 1
#endif
constexpr float S_X2 = 16.f, S_WGU = 32.f, S_ACT = 8.f, S_WDN = 64.f, S_XN = 16.f, S_WV = 32.f, S_WQK = 32.f, S_O = 16.f, S_WO = 32.f;
constexpr float S_OX = 16.f, S_WXO = 16.f;
#ifndef WXO_FP8
#define WXO_FP8 1
#endif
#ifndef WOUT_FP8
#define WOUT_FP8 1
#endif
constexpr size_t WS_WV8 = WS_WIN + 16 * MiB;

__device__ __forceinline__ float bf2f(unsigned short b) { return __uint_as_float((unsigned)b << 16); }
__device__ __forceinline__ unsigned f2bf(float f) { unsigned u = __builtin_bit_cast(unsigned, f); return (u + 0x7fffu + ((u >> 16) & 1u)) >> 16; }
__device__ __forceinline__ unsigned pk2(float lo, float hi) { return f2bf(lo) | (f2bf(hi) << 16); }
__device__ __forceinline__ float wave_sum(float v) {
#pragma unroll
    for (int o = 1; o < 64; o <<= 1) v += __shfl_xor(v, o);
    return v;
}
__device__ __forceinline__ float wave_max(float v) {
#pragma unroll
    for (int o = 1; o < 64; o <<= 1) v = fmaxf(v, __shfl_xor(v, o));
    return v;
}

typedef GAS unsigned gu32;
#define RLX_AGENT __ATOMIC_RELAXED, __HIP_MEMORY_SCOPE_AGENT
constexpr int CW_BAR = 4096;
constexpr int LDSCTL_OFF = RING_BYTES, MISC_OFF = LDSCTL_OFF + 320;
#define XB_TMO      128
#define XB_XCNT(j)  (256  + 64 * (j))
#define XB_XSUB(j)  (1280 + 64 * (j))
#define XB_XGEN(j)  (2304 + 64 * (j))
#define XB_TOP      3328
#define XB_TOPGEN   3392
#define XCD_BAR_WORDS 3456
#define XB_SPIN_CAP (1u << 18)

__device__ __forceinline__ unsigned xb_ld(unsigned* p)              { return __hip_atomic_load(p, __ATOMIC_RELAXED, __HIP_MEMORY_SCOPE_AGENT); }
__device__ __forceinline__ unsigned xb_add(unsigned* p, unsigned v) { return __hip_atomic_fetch_add(p, v, __ATOMIC_RELAXED, __HIP_MEMORY_SCOPE_AGENT); }
__device__ __forceinline__ unsigned xb_xcc_id() { return (unsigned)__builtin_amdgcn_s_getreg((3 << 11) | 20) & 0xFu; }
#define XB_SPIN(cond, bar) do { unsigned _sp = 0; while (cond) { __builtin_amdgcn_s_sleep(1); \
    if ((++_sp & 255u) == 0u) { if (xb_ld(&(bar)[XB_TMO])) break; if (_sp > XB_SPIN_CAP) { atomicAdd(&(bar)[XB_TMO], 1u); break; } } } } while (0)

struct XcdBarrier {
    unsigned* bar; unsigned x;
    volatile LAS unsigned* st;
};

__device__ __forceinline__ XcdBarrier xcd_barrier_post(unsigned* bar, volatile LAS unsigned* st) {
    XcdBarrier b; b.bar = bar; b.x = xb_xcc_id(); b.st = st;
    if (threadIdx.x == 0) (void)xb_add(&bar[XB_XCNT(b.x)], 1u);
    return b;
}
__device__ __forceinline__ void xcd_barrier_complete(unsigned* bar, unsigned x, unsigned& nloc, unsigned& nx) {
    const unsigned G = gridDim.x * gridDim.y * gridDim.z;
    unsigned sum, cnt, mine, sp = 0u;
    for (;;) {
        sum = 0u; cnt = 0u; mine = 0u;
#pragma unroll
        for (unsigned j = 0; j < 16; ++j) { const unsigned c = xb_ld(&bar[XB_XCNT(j)]); sum += c; cnt += (c > 0u) ? 1u : 0u; mine = (j == x) ? c : mine; }
        if (sum == G) break;
        __builtin_amdgcn_s_sleep(1);
        if ((++sp & 255u) == 0u) { if (xb_ld(&bar[XB_TMO])) break; if (sp > XB_SPIN_CAP) { atomicAdd(&bar[XB_TMO], 1u); break; } }
    }
    nloc = mine > 0u ? mine : 1u; nx = cnt > 0u ? cnt : 1u;
}

__device__ __forceinline__ void xcd_barrier(const XcdBarrier& b) {
    asm volatile("s_waitcnt vmcnt(0)" ::: "memory");
    __syncthreads();
    if (threadIdx.x == 0) {
        unsigned* bar = b.bar;
        __builtin_amdgcn_s_waitcnt(0);
        unsigned nloc = b.st[0], nx = b.st[1];
        if (nloc == 0u) { xcd_barrier_complete(bar, b.x, nloc, nx); b.st[0] = nloc; b.st[1] = nx; }
        const unsigned old = xb_add(&bar[XB_XSUB(b.x)], 1u);
        const unsigned gen = old / nloc;
        if (old + 1u == (gen + 1u) * nloc) {
            __builtin_amdgcn_fence(__ATOMIC_RELEASE, "agent");
            asm volatile("s_waitcnt vmcnt(0)" ::: "memory");
            const unsigned og = xb_add(&bar[XB_TOP], 1u);
            const unsigned tg = og / nx;
            if (og + 1u == (tg + 1u) * nx) xb_add(&bar[XB_TOPGEN], 1u);
            else XB_SPIN(xb_ld(&bar[XB_TOPGEN]) == tg, bar);
            __builtin_amdgcn_fence(__ATOMIC_ACQUIRE, "agent");
            xb_add(&bar[XB_XGEN(b.x)], 1u);
            asm volatile("s_waitcnt vmcnt(0)" ::: "memory");
        } else {
            XB_SPIN(xb_ld(&bar[XB_XGEN(b.x)]) == gen, bar);
            __builtin_amdgcn_fence(__ATOMIC_ACQUIRE, "agent");
            asm volatile("s_waitcnt vmcnt(0)" ::: "memory");
        }
    }
    __syncthreads();
}

struct Frame {
    LAS unsigned char* lds;
    int tid, lane, wave, vcu, G;
    const float *x, *mem; const int* pos;
    const float *g_mix, *w_in, *g_out_sb, *g_out_mb, *w_out, *g_xattn, *g_mem, *w_xq, *w_xkv, *w_xo, *g_ffn, *w_gu, *w_dn, *g_final;
    float* out; unsigned char* ws;
};

__device__ __forceinline__ void transpose_item(const float* W, int K, int N, bf16* WT, const float* gain, int inter, LAS float* scr, int item, int lane) {
    const int nblk = N / 32, kb = item / nblk, nb = item % nblk, k0 = 64 * kb, n0 = 32 * nb;
    int orow0 = n0;
    if (inter == 1) orow0 = (n0 < FF) ? (n0 / 128) * 256 + (n0 % 128) : ((n0 - FF) / 128) * 256 + 128 + ((n0 - FF) % 128);
    if (inter == 2) { const int reg = n0 / 1024, c = n0 % 1024; orow0 = (reg == 2) ? c : (reg == 5) ? 1024 + c : (reg < 2 ? reg : reg - 1) * 1024 + c; }
    float v[32];
#pragma unroll
    for (int i = 0; i < 32; ++i) v[i] = W[(size_t)(k0 + 2 * i + (lane >> 5)) * N + n0 + (lane & 31)];
#pragma unroll
    for (int i = 0; i < 32; ++i) { const int kk = 2 * i + (lane >> 5); float t = v[i]; if (gain) t *= gain[k0 + kk]; scr[kk * 33 + (lane & 31)] = t; }
    LDS_WAIT(); asm volatile("" ::: "memory");
    const int c = lane & 7;
#pragma unroll
    for (int j = 0; j < 4; ++j) { const int n = (lane >> 3) + 8 * j; const LAS float* s = scr + (8 * c) * 33 + n;
        v4u o; o.x = pk2(s[0 * 33], s[1 * 33]); o.y = pk2(s[2 * 33], s[3 * 33]); o.z = pk2(s[4 * 33], s[5 * 33]); o.w = pk2(s[6 * 33], s[7 * 33]);
        *(GAS v4u*)(WT + (size_t)(orow0 + n) * K + k0 + 8 * c) = o; }
    LDS_WAIT(); asm volatile("" ::: "memory");
}
__device__ __forceinline__ void transpose_item_fp8(const float* W, int K, int N, unsigned char* WT, const float* gain, int inter, float scale, LAS float* scr, int item, int lane, int kperm = 0) {
    const int nblk = N / 32, kb = item / nblk, nb = item % nblk, k0 = 64 * kb, n0 = 32 * nb;
    int orow0 = n0;
    if (inter == 1) orow0 = (n0 < FF) ? (n0 / 128) * 256 + (n0 % 128) : ((n0 - FF) / 128) * 256 + 128 + ((n0 - FF) % 128);
    if (inter == 2) { const int reg = n0 / 1024, c = n0 % 1024; orow0 = (reg == 2) ? c : (reg == 5) ? 1024 + c : (reg < 2 ? reg : reg - 1) * 1024 + c; }
    float v[32];
#pragma unroll
    for (int i = 0; i < 32; ++i) { int ks = k0 + 2 * i + (lane >> 5); if (kperm) ks = (ks & ~127) + 32 * (ks & 3) + ((ks & 127) >> 2); v[i] = W[(size_t)ks * N + n0 + (lane & 31)]; }
#pragma unroll
    for (int i = 0; i < 32; ++i) { const int kk = 2 * i + (lane >> 5); float t = v[i] * scale; if (gain) t *= gain[k0 + kk]; scr[kk * 33 + (lane & 31)] = t; }
    LDS_WAIT(); asm volatile("" ::: "memory");
    const int c = lane & 7;
#pragma unroll
    for (int j = 0; j < 4; ++j) { const int n = (lane >> 3) + 8 * j; const LAS float* s = scr + (8 * c) * 33 + n;
        pg8::u32x2 o; o.x = pg8::pk4_fp8(s[0 * 33], s[1 * 33], s[2 * 33], s[3 * 33]); o.y = pg8::pk4_fp8(s[4 * 33], s[5 * 33], s[6 * 33], s[7 * 33]);
        *(GAS pg8::u32x2*)(WT + (size_t)(orow0 + n) * K + k0 + 8 * c) = o; }
    LDS_WAIT(); asm volatile("" ::: "memory");
}
__device__ __forceinline__ void rms_row_to_bf16(const float* xrow, const float* g, bf16* orow, int lane, unsigned char* o8 = nullptr, float s8 = 1.f) {
    const GAS f32x4* xr = (const GAS f32x4*)xrow + lane; const GAS f32x4* gr = (const GAS f32x4*)g + lane;
    f32x4 v[8]; float s = 0.f;
#pragma unroll
    for (int j = 0; j < 8; ++j) { v[j] = __builtin_nontemporal_load(xr + 64 * j); s += (v[j].x * v[j].x + v[j].y * v[j].y) + (v[j].z * v[j].z + v[j].w * v[j].w); }
    const float rstd = 1.0f / sqrtf(wave_sum(s) * (1.f / DM) + EPS);
    GAS unsigned long long* ob8 = (GAS unsigned long long*)orow + lane;
#pragma unroll
    for (int j = 0; j < 8; ++j) { const f32x4 gg = gr[64 * j];
        const float a0 = v[j].x * rstd * gg.x, a1 = v[j].y * rstd * gg.y, a2 = v[j].z * rstd * gg.z, a3 = v[j].w * rstd * gg.w;
        ob8[64 * j] = (unsigned long long)pk2(a0, a1) | ((unsigned long long)pk2(a2, a3) << 32);
        if (o8) ((GAS unsigned*)o8)[64 * j + lane] = pg8::pk4_fp8(a0 * s8, a1 * s8, a2 * s8, a3 * s8); }
}
__device__ __forceinline__ void x_row_convert(const float* xrow, bf16* orow, unsigned char* o8, float s8, float* rinv, int lane) {
    const GAS f32x4* xr = (const GAS f32x4*)xrow + lane;
    f32x4 v[8]; float s = 0.f;
#pragma unroll
    for (int j = 0; j < 8; ++j) { v[j] = xr[64 * j]; s += (v[j].x * v[j].x + v[j].y * v[j].y) + (v[j].z * v[j].z + v[j].w * v[j].w); }
    const float rstd = 1.0f / sqrtf(wave_sum(s) * (1.f / DM) + EPS);
    if (lane == 0) *rinv = rstd;
    GAS unsigned long long* ob8 = (GAS unsigned long long*)orow + lane;
#pragma unroll
    for (int j = 0; j < 8; ++j) { ob8[64 * j] = (unsigned long long)pk2(v[j].x, v[j].y) | ((unsigned long long)pk2(v[j].z, v[j].w) << 32);
        ((GAS unsigned*)o8)[64 * j + lane] = pg8::pk4_fp8(v[j].x * s8, v[j].y * s8, v[j].z * s8, v[j].w * s8); }
}
__constant__ float INV_FREQ[16] = {1.000000000e+00f, 4.403665960e-01f, 1.939227432e-01f, 8.539710194e-02f, 3.760603070e-02f, 1.656043902e-02f, 7.292664610e-03f, 3.211445874e-03f,
                                   1.414213562e-03f, 6.227723788e-04f, 2.742481884e-04f, 1.207697351e-04f, 5.318296098e-05f, 2.341999971e-05f, 1.031338616e-05f, 4.541670478e-06f};

struct TItem { const float* src; unsigned char* dst; const float* gain; float scale; int N, K, fp8, kperm; };
__device__ __forceinline__ void ti_decode(TItem& t, const float* W, int K, int N, unsigned char* WT, const float* gain, int inter, float scale, int fp8, int kperm, int item) {
    const int nblk = N / 32, kb = item / nblk, nb = item % nblk, k0 = 64 * kb, n0 = 32 * nb;
    int orow0 = n0;
    if (inter == 1) orow0 = (n0 < FF) ? (n0 / 128) * 256 + (n0 % 128) : ((n0 - FF) / 128) * 256 + 128 + ((n0 - FF) % 128);
    if (inter == 2) { const int reg = n0 / 1024, c = n0 % 1024; orow0 = (reg == 2) ? c : (reg == 5) ? 1024 + c : (reg < 2 ? reg : reg - 1) * 1024 + c; }
    const int ksrc0 = kperm ? (k0 & ~127) + ((k0 & 64) >> 2) : k0;
    t.src = W + (size_t)ksrc0 * N + n0; t.N = N; t.K = K; t.fp8 = fp8; t.kperm = kperm; t.scale = scale; t.gain = gain ? gain + k0 : nullptr;
    t.dst = WT + ((size_t)orow0 * K + k0) * (fp8 ? 1 : 2);
}
__device__ __forceinline__ void ti_load(const TItem& t, float (&v)[32], f32x4 (&g)[2], int lane) {
    const GAS float* s = (const GAS float*)t.src + (lane & 31);
#pragma unroll
    for (int i = 0; i < 32; ++i) { const int kk = 2 * i + (lane >> 5); const int ro = t.kperm ? 32 * (kk & 3) + (kk >> 2) : kk; v[i] = __builtin_nontemporal_load(s + (size_t)ro * t.N); }
    const GAS f32x4* gp = (const GAS f32x4*)((t.gain ? t.gain : t.src) + 8 * (lane & 7)); g[0] = gp[0]; g[1] = gp[1];
}
__device__ __forceinline__ void ti_finish(const TItem& t, const float (&v)[32], const f32x4 (&g)[2], LAS float* scr, int lane) {
#pragma unroll
    for (int i = 0; i < 32; ++i) scr[(2 * i + (lane >> 5)) * 33 + (lane & 31)] = v[i];
    LDS_WAIT(); asm volatile("" ::: "memory");
    const int c = lane & 7; const float sc = t.scale; const bool hg = t.gain != nullptr;
    const float g0 = hg ? g[0].x * sc : sc, g1 = hg ? g[0].y * sc : sc, g2 = hg ? g[0].z * sc : sc, g3 = hg ? g[0].w * sc : sc, g4 = hg ? g[1].x * sc : sc, g5 = hg ? g[1].y * sc : sc, g6 = hg ? g[1].z * sc : sc, g7 = hg ? g[1].w * sc : sc;
    if (t.fp8) {
#pragma unroll
        for (int j = 0; j < 4; ++j) { const int n = (lane >> 3) + 8 * j; const LAS float* s = scr + (8 * c) * 33 + n;
            pg8::u32x2 o; o.x = pg8::pk4_fp8(s[0 * 33] * g0, s[1 * 33] * g1, s[2 * 33] * g2, s[3 * 33] * g3); o.y = pg8::pk4_fp8(s[4 * 33] * g4, s[5 * 33] * g5, s[6 * 33] * g6, s[7 * 33] * g7);
            *(GAS pg8::u32x2*)(t.dst + (size_t)n * t.K + 8 * c) = o; }
    } else {
#pragma unroll
        for (int j = 0; j < 4; ++j) { const int n = (lane >> 3) + 8 * j; const LAS float* s = scr + (8 * c) * 33 + n;
            v4u o; o.x = pk2(s[0 * 33] * g0, s[1 * 33] * g1); o.y = pk2(s[2 * 33] * g2, s[3 * 33] * g3); o.z = pk2(s[4 * 33] * g4, s[5 * 33] * g5); o.w = pk2(s[6 * 33] * g6, s[7 * 33] * g7);
            *(GAS v4u*)(t.dst + ((size_t)n * t.K + 8 * c) * 2) = o; }
    }
    LDS_WAIT(); asm volatile("" ::: "memory");
}
__device__ __forceinline__ void xrow_load(const float* xrow, f32x4 (&v)[8], int lane) {
    const GAS f32x4* xr = (const GAS f32x4*)xrow + lane;
#pragma unroll
    for (int j = 0; j < 8; ++j) v[j] = __builtin_nontemporal_load(xr + 64 * j);
}
__device__ __forceinline__ void xrow_finish(const f32x4 (&v)[8], bf16* orow, unsigned char* o8, float s8, float* rinv, int lane) {
    float s = 0.f;
#pragma unroll
    for (int j = 0; j < 8; ++j) s += (v[j].x * v[j].x + v[j].y * v[j].y) + (v[j].z * v[j].z + v[j].w * v[j].w);
    const float rstd = 1.0f / sqrtf(wave_sum(s) * (1.f / DM) + EPS);
    if (lane == 0) *rinv = rstd;
    GAS unsigned long long* ob8 = (GAS unsigned long long*)orow + lane;
#pragma unroll
    for (int j = 0; j < 8; ++j) { ob8[64 * j] = (unsigned long long)pk2(v[j].x, v[j].y) | ((unsigned long long)pk2(v[j].z, v[j].w) << 32);
        ((GAS unsigned*)o8)[64 * j + lane] = pg8::pk4_fp8(v[j].x * s8, v[j].y * s8, v[j].z * s8, v[j].w * s8); }
}
__device__ __forceinline__ void p0_item(Frame& F, TItem& t, int it) {
    constexpr int I0 = (DM / 64) * (NQKV / 32), I1 = (DM / 64) * (DM / 32), I2 = (DM / 64) * (WX / 32), I3 = (DM / 64) * (2 * WX / 32), I4 = (WX / 64) * (DM / 32);
    int r = it;
    if (r < I0) { const int reg = ((r % (NQKV / 32)) * 32) / 1024;
        if (reg == 2 || reg == 5) ti_decode(t, F.w_in, DM, NQKV, F.ws + WS_WV8, F.g_mix, 2, S_WV, 1, 0, r);
        else if (QK_FP8 && reg < 2) ti_decode(t, F.w_in, DM, NQKV, F.ws + WS_WIN, F.g_mix, 2, S_WQK, 1, 0, r);
        else ti_decode(t, F.w_in, DM, NQKV, F.ws + WS_WIN, F.g_mix, 2, 1.f, 0, 0, r);
        return; } r -= I0;
    if (r < I1) { ti_decode(t, F.w_out, DM, DM, F.ws + WS_WOUT, nullptr, 0, S_WO, 1, 1, r); return; } r -= I1;
    if (r < I2) { ti_decode(t, F.w_xq, DM, WX, F.ws + WS_WXQ, F.g_xattn, 0, 1.f, 0, 0, r); return; } r -= I2;
    if (r < I3) { ti_decode(t, F.w_xkv, DM, 2 * WX, F.ws + WS_WXKV, nullptr, 0, 1.f, 0, 0, r); return; } r -= I3;
    ti_decode(t, F.w_xo, WX, DM, F.ws + WS_WXO, nullptr, 0, S_WXO, 1, 1, r);
}
__device__ __forceinline__ void p0_prologue(Frame& F) {
    LAS float* scr = (LAS float*)(F.lds + F.wave * 16384);
    const int gw = F.vcu * NWAVES + F.wave, NGW = F.G * NWAVES;
    constexpr int I0 = (DM / 64) * (NQKV / 32), I1 = (DM / 64) * (DM / 32), I2 = (DM / 64) * (WX / 32), I3 = (DM / 64) * (2 * WX / 32), I4 = (WX / 64) * (DM / 32),
                  I5 = (DM / 64) * (2 * FF / 32);
    constexpr int NITEMS = I0 + I1 + I2 + I3 + I4; (void)I5;
    {   float va[32], vb[32]; f32x4 ga[2], gb[2]; TItem ta, tb;
        int it = gw;
        if (it < NITEMS) { p0_item(F, ta, it); ti_load(ta, va, ga, F.lane);
            for (;;) {
                int itn = it + NGW; p0_item(F, tb, itn < NITEMS ? itn : it); ti_load(tb, vb, gb, F.lane);
                ti_finish(ta, va, ga, scr, F.lane); it = itn; if (it >= NITEMS) break;
                itn = it + NGW; p0_item(F, ta, itn < NITEMS ? itn : it); ti_load(ta, va, ga, F.lane);
                ti_finish(tb, vb, gb, scr, F.lane); it = itn; if (it >= NITEMS) break;
            } }
    }
    {   f32x4 va[8], vb[8];
        bf16* xb = (bf16*)(F.ws + WS_RA); unsigned char* x8 = F.ws + WS_RB; float* ri = (float*)(F.ws + WS_RINV0);
        int m = gw;
        if (m < M) { xrow_load(F.x + (size_t)m * DM, va, F.lane);
            for (;;) {
                int mn = m + NGW; xrow_load(F.x + (size_t)(mn < M ? mn : m) * DM, vb, F.lane);
                xrow_finish(va, xb + (size_t)m * DM, x8 + (size_t)m * DM, S_XN, ri + m, F.lane); m = mn; if (m >= M) break;
                mn = m + NGW; xrow_load(F.x + (size_t)(mn < M ? mn : m) * DM, va, F.lane);
                xrow_finish(vb, xb + (size_t)m * DM, x8 + (size_t)m * DM, S_XN, ri + m, F.lane); m = mn; if (m >= M) break;
            } }
    }
    for (int m = gw; m < MMEM; m += NGW) rms_row_to_bf16(F.mem + (size_t)m * DM, F.g_mem, (bf16*)(F.ws + WS_MN) + (size_t)m * DM, F.lane);
    float* cs = (float*)(F.ws + WS_CS);
    for (int e = (F.vcu * NWAVES + F.wave) * 64 + F.lane; e < M * 16; e += NGW * 64) {
        const int m = e >> 4, i = e & 15; const float ang = (float)F.pos[m] * INV_FREQ[i];
        double rev = (double)ang * 0.15915494309189535; rev -= floor(rev);
        const float a = (float)(rev * 6.283185307179586);
        cs[(size_t)m * 32 + i] = cosf(a); cs[(size_t)m * 32 + 16 + i] = sinf(a);
    }
}

__device__ __forceinline__ void ffn_item(Frame& F, TItem& t, int it) {
    constexpr int I5 = (DM / 64) * (2 * FF / 32);
    if (it < I5) ti_decode(t, F.w_gu, DM, 2 * FF, F.ws + WS_WGU, F.g_ffn, 1, S_WGU, 1, 0, it);
    else ti_decode(t, F.w_dn, FF, DM, F.ws + WS_WDN, nullptr, 0, S_WDN, 1, 0, it - I5);
}
__device__ __forceinline__ void ffn_weight_items(Frame& F, int wi, int nw) {
    LAS float* scr = (LAS float*)(F.lds + F.wave * 16384);
    constexpr int I5 = (DM / 64) * (2 * FF / 32), I6 = (FF / 64) * (DM / 32), NI = I5 + I6;
    float va[32], vb[32]; f32x4 ga[2], gb[2]; TItem ta, tb;
    int it = wi;
    if (it < NI) { ffn_item(F, ta, it); ti_load(ta, va, ga, F.lane);
        for (;;) {
            int itn = it + nw; ffn_item(F, tb, itn < NI ? itn : it); ti_load(tb, vb, gb, F.lane);
            ti_finish(ta, va, ga, scr, F.lane); it = itn; if (it >= NI) break;
            itn = it + nw; ffn_item(F, ta, itn < NI ? itn : it); ti_load(ta, va, ga, F.lane);
            ti_finish(tb, vb, gb, scr, F.lane); it = itn; if (it >= NI) break;
        } }
}

__device__ __forceinline__ void final_norm_phase(Frame& F, const bf16* src, float* dst) {
    const int gw = F.vcu * NWAVES + F.wave, NGW = F.G * NWAVES;
    for (int m = gw; m < M; m += NGW) {
        const GAS v4u* xr = (const GAS v4u*)(src + (size_t)m * DM) + F.lane; const GAS f32x4* gr = (const GAS f32x4*)F.g_final;
        v4u w[4]; float s = 0.f;
#pragma unroll
        for (int j = 0; j < 4; ++j) w[j] = xr[64 * j];
        f32x4 v[8];
#pragma unroll
        for (int j = 0; j < 4; ++j) { v[2 * j] = (f32x4){__uint_as_float(w[j].x << 16), __uint_as_float(w[j].x & 0xffff0000u), __uint_as_float(w[j].y << 16), __uint_as_float(w[j].y & 0xffff0000u)};
            v[2 * j + 1] = (f32x4){__uint_as_float(w[j].z << 16), __uint_as_float(w[j].z & 0xffff0000u), __uint_as_float(w[j].w << 16), __uint_as_float(w[j].w & 0xffff0000u)}; }
#pragma unroll
        for (int j = 0; j < 8; ++j) s += (v[j].x * v[j].x + v[j].y * v[j].y) + (v[j].z * v[j].z + v[j].w * v[j].w);
        const float rstd = 1.0f / sqrtf(wave_sum(s) * (1.f / DM) + EPS);
        GAS f32x4* dr = (GAS f32x4*)(dst + (size_t)m * DM);
#pragma unroll
        for (int j = 0; j < 4; ++j) { const int c4 = (64 * j + F.lane) * 2;
            dr[c4] = v[2 * j] * rstd * gr[c4]; dr[c4 + 1] = v[2 * j + 1] * rstd * gr[c4 + 1]; }
    }
}

struct RangeOrder : pg8::StaticOrder {
    int i0, n;
    __device__ __forceinline__ bool next(int i, pg8::Unit& u) const { return i < n && pg8::StaticOrder::next(i + i0, u); }
};
template <int K> __device__ __forceinline__ const void* late_arg() {
    const void* p; asm volatile("s_load_dwordx2 %0, %1, %2\n\ts_waitcnt lgkmcnt(0)" : "=s"(p) : "s"(__builtin_amdgcn_kernarg_segment_ptr()), "i"(K * 8));
    return p;
}
constexpr int NPH = 11;
#ifndef REPEAT_WHICH
#define REPEAT_WHICH 3
#endif
#ifndef NULL_EPI_PROBE
#define NULL_EPI_PROBE 0
#endif
#ifndef FOLD_KMEAN
#define FOLD_KMEAN 1
#endif
#ifndef REPEAT_PHASE
#define REPEAT_PHASE -1
#endif
#ifndef REPEAT_MASK
#define REPEAT_MASK 0
#endif
#define REPS(k) (((REPEAT_PHASE == (k)) || ((REPEAT_MASK >> (k)) & 1)) ? 2 : 1)
#ifndef USE_MFMA_SB
#define USE_MFMA_SB 1
#endif
#ifndef USE_MFMA_MOBA
#define USE_MFMA_MOBA 1
#endif
#ifndef USE_MFMA_X
#define USE_MFMA_X 1
#endif
#ifndef MK_ONE_LAUNCH
#define MK_ONE_LAUNCH 1
#endif
struct Args { const void* in[17]; float* out; unsigned char* ws; int ph_lo, ph_hi; };
__global__ void __launch_bounds__(NWAVES * 64, 2) mk_fwd(Args args) {
    extern __shared__ __attribute__((aligned(16))) unsigned char lds[];
    Frame F;
    F.lds = (LAS unsigned char*)lds;
    F.tid = threadIdx.x; F.lane = F.tid & 63; F.wave = __builtin_amdgcn_readfirstlane(F.tid >> 6);
    F.G = gridDim.x; { const int bx = blockIdx.x; F.vcu = (F.G % 8 == 0) ? (bx % 8) * (F.G / 8) + bx / 8 : bx; }
    F.x = (const float*)args.in[0]; F.mem = (const float*)args.in[1]; F.pos = (const int*)args.in[2];
    F.g_mix = (const float*)args.in[3]; F.w_in = (const float*)args.in[4]; F.g_out_sb = nullptr; F.g_out_mb = nullptr; F.w_out = (const float*)args.in[7];
    F.g_xattn = (const float*)args.in[8]; F.g_mem = (const float*)args.in[9]; F.w_xq = (const float*)args.in[10]; F.w_xkv = (const float*)args.in[11]; F.w_xo = (const float*)args.in[12];
    F.g_ffn = nullptr; F.w_gu = nullptr; F.w_dn = nullptr; F.g_final = nullptr;
    F.out = args.out; F.ws = args.ws;
    unsigned char* ws = args.ws;
    const int lo = args.ph_lo, hi = args.ph_hi;
    for (int u = F.tid; u < (LDS_BYTES - LDSCTL_OFF) / 4; u += NWAVES * 64) ((LAS unsigned*)(F.lds + LDSCTL_OFF))[u] = 0u;
    __syncthreads();
    if (hi - lo > 1) {
        { GAS v4u* z = (GAS v4u*)(ws + WS_CTL); const int n16 = (int)(CTL_ZERO_BYTES / 16);
          for (int i = (int)blockIdx.x * (NWAVES * 64) + F.tid; i < n16; i += F.G * NWAVES * 64) z[i] = (v4u){0u, 0u, 0u, 0u}; }
        cg::this_grid().sync();
    }
    XcdBarrier bar = xcd_barrier_post((unsigned*)(ws + WS_CTL) + CW_BAR, (volatile LAS unsigned*)(F.lds + MISC_OFF) + 8);
#ifndef ONLY_PHASE
#define ONLY_PHASE -1
#endif
#define IN(k) ((ONLY_PHASE < 0 || ONLY_PHASE == (k)) && lo <= (k) && (k) < hi)
#define BOTH(k) (IN(k) && IN((k) + 1))
#define GRID_BAR() xcd_barrier(bar)
    float* ssq1 = (float*)(ws + WS_SSQ1); float* ssq2 = (float*)(ws + WS_SSQ2);
    pg8::bf16_t* ACT = (pg8::bf16_t*)(ws + WS_RC + 64 * MiB);
    pg8::bf16_t* RA = (pg8::bf16_t*)(ws + WS_RA); pg8::bf16_t* RB = (pg8::bf16_t*)(ws + WS_RB); pg8::bf16_t* RC = (pg8::bf16_t*)(ws + WS_RC);

    if (IN(0)) { for (int rep = 0; rep < REPS(0); ++rep) p0_prologue(F); if (BOTH(0)) GRID_BAR(); }
    if (IN(1)) {
        pg8::Gemm gs{RB, (const pg8::bf16_t*)(ws + WS_WIN), M, 2048, DM / 2}; RangeOrder Ss; Ss.init(M, 2048, F.G, (int)blockIdx.x);
        pg8::EpiQKV Es{RC, (const float*)(ws + WS_CS), QSCALE, (float*)(ws + WS_KSUM), 0, 1.f, (const float*)(ws + WS_RINV0), 1.f / (S_XN * S_WQK), 0};
        pg8::Gemm gm{RA, (const pg8::bf16_t*)(ws + WS_WIN) + (size_t)2048 * DM, M, 2048, DM}; RangeOrder Sm; Sm.init(M, 2048, F.G, (int)blockIdx.x);
        pg8::EpiQKV Em{RC, (const float*)(ws + WS_CS), QSCALE, (float*)(ws + WS_KSUM), 0, 1.f, (const float*)(ws + WS_RINV0), 1.f, 8};
        pg8::Gemm gv{RB, (const pg8::bf16_t*)(ws + WS_WV8), M, 2048, DM / 2}; RangeOrder Sv; Sv.init(M, 2048, F.G, (int)blockIdx.x);
        pg8::EpiQKV Ev{RC, (const float*)(ws + WS_CS), QSCALE, (float*)(ws + WS_KSUM), 1, 1.f / (S_XN * S_WV), (const float*)(ws + WS_RINV0), 1.f, 0};
        for (int rep = 0; rep < REPS(1); ++rep) {
        const bool grp = ((blockIdx.x >> 3) & 1) != 0;
        Ss.i0 = 0; Ss.n = 1 << 20; Sm.i0 = 0; Sm.n = 1 << 20;
        if (grp) { Sv.i0 = 0; Sv.n = 1; pg8::gemm_phase<pg8::EpiQKV, RangeOrder, true, true, true>(F.lds, gv, Sv, Ev); }
        pg8::gemm_phase<pg8::EpiQKV, RangeOrder, true, true, true>(F.lds, gs, Ss, Es);
        pg8::gemm_phase<pg8::EpiQKV, RangeOrder, true, true>(F.lds, gm, Sm, Em);
        Sv.i0 = grp ? 1 : 0; Sv.n = 1 << 20;
        pg8::gemm_phase<pg8::EpiQKV, RangeOrder, true, true, true>(F.lds, gv, Sv, Ev);
        }
        if (BOTH(1)) GRID_BAR();
    }
    if (IN(3)) {
        const att::bf16* qkv = (const att::bf16*)RC; att::bf16* ob = (att::bf16*)RB; const float* kmean = (const float*)(ws + WS_KSUM);
        F.g_out_sb = (const float*)late_arg<5>(); F.g_out_mb = (const float*)late_arg<6>();
        constexpr size_t HSZ = (size_t)SEQ * HD;
        for (int rep = 0; rep < REPS(3); ++rep) {
        if (rep == 0 || (REPEAT_WHICH & 1))
        for (int vv = F.vcu; vv < 256; vv += F.G) { const int bh = vv >> 2, s = vv & 3, b = bh >> 3, h = bh & 7; const size_t rb = (size_t)b * SEQ;
            const att::bf16* hS = qkv + ((size_t)b * 48 + h) * HSZ; const att::bf16* hM = qkv + ((size_t)b * 48 + 24 + h) * HSZ;
            for (int i = 0; i < 2; ++i) { const int qb = i ? s : 7 - s; const size_t r0 = rb + (size_t)qb * 256;
                att::attn_unit<2, true>(hS, nullptr, nullptr, (att::bf16*)((unsigned char*)ob + r0 * DM + h * HD), F.g_out_sb + h * HD, nullptr, qb, 0, (char*)lds, S_O,
                                        i != 0, i ? hM : hS, i ? 7 - s : s, i ? 0 : 4 * (s + 1) - 1, i ? -1 : 4 * (s + 1) - 2); }
            for (int i = 0; i < 2; ++i) { const int qb = i ? s : 7 - s; const size_t r0 = rb + (size_t)qb * 256;
                att::attn_unit<1, true>(hM, nullptr, nullptr, (att::bf16*)((unsigned char*)ob + r0 * DM + NH * HD + h * HD), F.g_out_mb + h * HD, kmean + (size_t)bh * 1024, qb, 0, (char*)lds, S_O,
                                        true, i ? nullptr : hM, s, 0, -1); } }
        }
        if (BOTH(3)) GRID_BAR();
    }
    if (IN(4)) {
        pg8::Gemm g{RB, (const pg8::bf16_t*)(ws + WS_WOUT), M, DM, WOUT_FP8 ? DM / 2 : DM}; pg8::StaticOrder S; S.init(M, DM, F.G, (int)blockIdx.x);
        pg8::EpiResB<false> E{RA, RC, ssq1, nullptr, 1.f, WOUT_FP8 ? 1.f / (S_O * S_WO) : 1.f};
        pg8::gemm_phase<pg8::EpiResB<false>, pg8::StaticOrder, true, true, WOUT_FP8 != 0>(F.lds, g, S, E);
        if (BOTH(4)) GRID_BAR();
    }
    if (IN(5)) {
      F.w_gu = (const float*)late_arg<14>(); F.g_ffn = (const float*)late_arg<13>(); F.w_dn = (const float*)late_arg<15>();
      for (int rep = 0; rep < REPS(5); ++rep) {
        { pg8::Gemm g{RC, (const pg8::bf16_t*)(ws + WS_WXQ), M, WX, DM}; pg8::StaticOrder S; S.init(M, WX, F.G, (int)blockIdx.x);
          pg8::EpiScale E{(pg8::bf16_t*)(ws + WS_QX), WX, ssq1, QSCALE};
          pg8::gemm_phase<pg8::EpiScale, pg8::StaticOrder, true, true>(F.lds, g, S, E); }
        { pg8::Gemm g{(const pg8::bf16_t*)(ws + WS_MN), (const pg8::bf16_t*)(ws + WS_WXKV), MMEM, 2 * WX, DM}; pg8::StaticOrder S; S.init(MMEM, 2 * WX, F.G, (int)((blockIdx.x + F.G - 128) % F.G));
          pg8::EpiScale E{(pg8::bf16_t*)(ws + WS_KVX), 2 * WX, nullptr, 1.0f};
          pg8::gemm_phase<pg8::EpiScale, pg8::StaticOrder, true, true>(F.lds, g, S, E); }
        if (F.G > 160) { if ((int)blockIdx.x >= 160) ffn_weight_items(F, ((int)blockIdx.x - 160) * NWAVES + F.wave, (F.G - 160) * NWAVES); }
        else ffn_weight_items(F, (int)blockIdx.x * NWAVES + F.wave, F.G * NWAVES);
      }
        if (BOTH(5)) GRID_BAR();
    }
    if (IN(6)) {
        const att::bf16* qx = (const att::bf16*)(ws + WS_QX); const att::bf16* kvx = (const att::bf16*)(ws + WS_KVX); att::bf16* ox = (att::bf16*)(ws + WS_OX);
        for (int rep = 0; rep < REPS(6); ++rep) {
        for (int vv = F.vcu; vv < 256; vv += F.G) { const int b = vv >> 5, h = (vv >> 3) & 3, qb = vv & 7; const size_t r0 = (size_t)b * SEQ + (size_t)qb * 256;
            if (WXO_FP8) att::attn_unit<0, true>(qx + r0 * WX + h * HD, kvx + (size_t)b * NMEM * (2 * WX) + h * HD, kvx + (size_t)b * NMEM * (2 * WX) + WX + h * HD, (att::bf16*)((unsigned char*)ox + r0 * WX + h * HD), nullptr, nullptr, qb, NMEM, (char*)lds, S_OX);
            else att::attn_unit<0>(qx + r0 * WX + h * HD, kvx + (size_t)b * NMEM * (2 * WX) + h * HD, kvx + (size_t)b * NMEM * (2 * WX) + WX + h * HD, ox + r0 * WX + h * HD, nullptr, nullptr, qb, NMEM, (char*)lds); }
        }
        if (BOTH(6)) GRID_BAR();
    }
    if (IN(7)) {
        pg8::Gemm g{(const pg8::bf16_t*)(ws + WS_OX), (const pg8::bf16_t*)(ws + WS_WXO), M, DM, WXO_FP8 ? WX / 2 : WX}; pg8::StaticOrder S; S.init(M, DM, F.G, (int)blockIdx.x);
        pg8::EpiResB<false> E{RC, RC, ssq2, (unsigned char*)RA, S_X2, WXO_FP8 ? 1.f / (S_OX * S_WXO) : 1.f};
        pg8::gemm_phase<pg8::EpiResB<false>, pg8::StaticOrder, true, true, WXO_FP8 != 0>(F.lds, g, S, E);
        if (BOTH(7)) GRID_BAR();
    }
    if (IN(8)) {
        pg8::Gemm g{RA, (const pg8::bf16_t*)(ws + WS_WGU), M, 2 * FF, FFN_FP8 ? DM / 2 : DM}; pg8::StaticOrder S; S.init(M, 2 * FF, F.G, (int)blockIdx.x);
        pg8::EpiSwiGLU E{ACT, ssq2, FFN_FP8 ? (unsigned char*)ACT : nullptr, FFN_FP8 ? 1.f / (S_X2 * S_WGU) : 1.f, S_ACT};
#if NULL_EPI_PROBE
        if (REPS(8) == 2) { pg8::EpiNull EN{nullptr}; pg8::gemm_phase<pg8::EpiNull, pg8::StaticOrder, true, true, FFN_FP8 != 0>(F.lds, g, S, EN); }
        pg8::gemm_phase<pg8::EpiSwiGLU, pg8::StaticOrder, true, true, FFN_FP8 != 0>(F.lds, g, S, E);
#else
        for (int rep = 0; rep < REPS(8); ++rep) pg8::gemm_phase<pg8::EpiSwiGLU, pg8::StaticOrder, true, true, FFN_FP8 != 0>(F.lds, g, S, E);
#endif
        if (BOTH(8)) GRID_BAR();
    }
    if (IN(9)) {
        pg8::Gemm g{ACT, (const pg8::bf16_t*)(ws + WS_WDN), M, DM, FF / 2}; pg8::StaticOrder S; S.init(M, DM, F.G, (int)blockIdx.x);
        pg8::EpiResB<false> E{RC, RC, nullptr, nullptr, 1.f, 1.f / (S_ACT * S_WDN)};
        pg8::gemm_phase<pg8::EpiResB<false>, pg8::StaticOrder, true, true, true>(F.lds, g, S, E);
        if (BOTH(9)) GRID_BAR();
    }
    if (IN(10)) { F.g_final = (const float*)late_arg<16>(); final_norm_phase(F, RC, F.out); }
#undef IN
#undef BOTH
}

extern "C" void kernel_launch(void* const* d_in, const int* in_sizes, int n_in, void* d_out, int out_size, void* d_ws, size_t ws_size, hipStream_t stream) {
    static int grid = 0;
    if (grid == 0) {
        if (n_in != 17 || in_sizes[0] != M * DM || out_size != M * DM || ws_size < WS_END) { fprintf(stderr, "kernel_launch: unexpected shapes (n_in %d in0 %d out %d ws %zu)\n", n_in, n_in > 0 ? in_sizes[0] : -1, out_size, ws_size); grid = -1; return; }
        int dev = 0, cus = 0, per_cu = 0;
        if (hipGetDevice(&dev) != hipSuccess || hipDeviceGetAttribute(&cus, hipDeviceAttributeMultiprocessorCount, dev) != hipSuccess) { grid = -1; return; }
        if (hipFuncSetAttribute((const void*)mk_fwd, hipFuncAttributeMaxDynamicSharedMemorySize, LDS_BYTES) != hipSuccess) { fprintf(stderr, "kernel_launch: hipFuncSetAttribute failed\n"); grid = -1; return; }
        if (hipOccupancyMaxActiveBlocksPerMultiprocessor(&per_cu, (const void*)mk_fwd, NWAVES * 64, LDS_BYTES) != hipSuccess || per_cu < 1) { fprintf(stderr, "kernel_launch: occupancy query failed (%d)\n", per_cu); per_cu = 1; }
        (void)hipGetLastError();
        grid = cus * (per_cu < 1 ? 1 : 1);
    }
    if (grid < 0) return;
#if !MK_ONE_LAUNCH
    (void)hipMemsetAsync((char*)d_ws + WS_CTL, 0, CTL_ZERO_BYTES, stream);
#endif
    Args a{};
    for (int i = 0; i < 17; ++i) a.in[i] = d_in[i];
    a.out = (float*)d_out; a.ws = (unsigned char*)d_ws;
#if MK_ONE_LAUNCH
    a.ph_lo = 0; a.ph_hi = NPH;
    void* kargs[] = {&a};
    hipError_t e = hipLaunchCooperativeKernel((const void*)mk_fwd, dim3(grid), dim3(NWAVES * 64), kargs, LDS_BYTES, stream);
    if (e != hipSuccess) fprintf(stderr, "kernel_launch: cooperative launch failed: %s (grid %d)\n", hipGetErrorString(e), grid);
#else
    for (int p = 0; p < NPH; ++p) { a.ph_lo = p; a.ph_hi = p + 1; hipLaunchKernelGGL(mk_fwd, dim3(grid), dim3(NWAVES * 64), LDS_BYTES, stream, a); }
    const hipError_t le = hipPeekAtLastError();
    if (le != hipSuccess) fprintf(stderr, "kernel_launch: launch failed: %s\n", hipGetErrorName(le));
#endif
}
```

```cpp
#include <hip/hip_runtime.h>
#include <hip/hip_cooperative_groups.h>
#include <cstdio>
#include <cstdint>
namespace cg = cooperative_groups;
namespace pg8 {
#define PG8_LAS __attribute__((address_space(3)))
typedef unsigned short bf16_t;
typedef short bf16x8 __attribute__((ext_vector_type(8)));
typedef float f32x4 __attribute__((ext_vector_type(4)));
typedef unsigned u32x4 __attribute__((ext_vector_type(4)));
constexpr int BM = 256, BK = 64, HALF = 128, HTB = HALF * BK * 2  , STAGE_BYTES = 8 * HTB, NXCD = 8, WGM = 8;

__host__ __device__ __forceinline__ int lds_byte(int r, int c) { const int st = (r >> 4) * 2 + (c >> 5), rr = r & 15, cc = c & 31, ob = rr * 64 + cc * 2; return st * 1024 + (ob ^ (((ob >> 9) & 1) << 5)); }
__host__ __device__ __forceinline__ void stage_rc(int b, int& R, int& C) { const int st = b / 1024, sb = b % 1024, swz = sb ^ (((sb >> 9) & 1) << 5); R = (st >> 1) * 16 + swz / 64; C = (st & 1) * 32 + (swz % 64) / 2; }
__host__ __device__ __forceinline__ int perm32(int rho) { const int n = rho >> 4, i = rho & 15; return 8 * (i >> 2) + 4 * n + (i & 3); }

struct Unit { int pm, pn; };
struct Gemm { const bf16_t* A; const bf16_t* Bt; int M, N, K; };

struct StaticOrder {
    int nM, nN, nwg, G, c;
    __host__ __device__ void init(int M, int N, int G_, int c_) { nM = M / BM; nN = N / BM; nwg = nM * nN; G = G_; c = c_; }
    __host__ __device__ bool next(int i, Unit& u) const {
        const long L = (long)i * G + c; if (L >= nwg) return false;
        int wgid = (int)L; { const int q = nwg / NXCD, r = nwg % NXCD, xcd = wgid % NXCD, off = wgid / NXCD; wgid = (xcd < r ? xcd * (q + 1) : r * (q + 1) + (xcd - r) * q) + off; }
        const int nig = WGM * nN, gid = wgid / nig, fm = gid * WGM, gsz = (nM - fm) < WGM ? (nM - fm) : WGM;
        u.pm = fm + ((wgid % nig) % gsz); u.pn = (wgid % nig) / gsz; return true;
    }
    __device__ __forceinline__ void a_ready(const Unit&) const {}
    __device__ __forceinline__ void done(const Unit&) const {}
};

__device__ __forceinline__ unsigned cvt_pk_bf16(float lo, float hi) { unsigned r; asm volatile("v_cvt_pk_bf16_f32 %0, %1, %2" : "=v"(r) : "v"(lo), "v"(hi)); return r; }
typedef float f32x2 __attribute__((ext_vector_type(2)));
template <class Epi, class Sched, bool ALIGN_EPI = false, bool SP2 = false, bool FP8 = false>
__device__ __forceinline__ void gemm_phase(PG8_LAS unsigned char* lds, const Gemm g, const Sched& S, const Epi& E) {
    int tid_ = threadIdx.x; asm volatile("" : "+v"(tid_));
    const int tid = tid_, wid = __builtin_amdgcn_readfirstlane(tid >> 6), lane = tid & 63, wr = wid >> 2, wc = wid & 3, fr = lane & 15, fq = lane >> 4;
    const int K = g.K, nt = K / BK;
    unsigned voffA[2], voffB[2];
#pragma unroll
    for (int i = 0; i < 2; ++i) { int R, C; stage_rc(tid * 16 + i * 8192, R, C); const int Rb = Epi::PERM ? ((R & ~31) + perm32(R & 31)) : R;
        voffA[i] = (unsigned)(R * K + C) * 2u; voffB[i] = (unsigned)(Rb * K + C) * 2u; }
    const size_t kstep = (size_t)(BK * 2);
    const size_t hstep = (size_t)HALF * K * 2;
    const size_t tstep = 2 * hstep;
    const unsigned ldsw = (unsigned)wid * 1024u;
    const int aoff = lds_byte(wr * 64 + fr, fq * 8), boff = lds_byte(wc * 32 + fr, fq * 8);
#define PG8_SA(b, h) (((b) * 2 + (h)) * HTB)
#define PG8_SB(b, h) ((4 + (b) * 2 + (h)) * HTB)
#define PG8_STAGE(bufoff, gbase, voff) do { _Pragma("unroll") for (int _i = 0; _i < 2; ++_i) \
        __builtin_amdgcn_global_load_lds((const unsigned*)((const char*)(gbase) + (voff)[_i]), (PG8_LAS unsigned*)(lds + (bufoff) + ldsw + _i * 8192), 16, 0, 0); } while (0)
#define PG8_LD8(p) __builtin_shufflevector(*(const PG8_LAS i32x4_*)(p), *(const PG8_LAS i32x4_*)((p) + 1024), 0, 1, 2, 3, 4, 5, 6, 7)
#define PG8_LDA(dst, b, h) do { if constexpr (FP8) { _Pragma("unroll") for (int m = 0; m < 4; ++m) dst##8[m] = PG8_LD8(lds + PG8_SA(b, h) + aoff + m * 2048); } \
        else { _Pragma("unroll") for (int m = 0; m < 4; ++m) _Pragma("unroll") for (int k = 0; k < 2; ++k) dst[m][k] = *(const PG8_LAS bf16x8*)(lds + PG8_SA(b, h) + aoff + m * 2048 + k * 1024); } } while (0)
#define PG8_LDB(dst, b, h) do { if constexpr (FP8) { _Pragma("unroll") for (int n = 0; n < 2; ++n) dst##8[n] = PG8_LD8(lds + PG8_SB(b, h) + boff + n * 2048); } \
        else { _Pragma("unroll") for (int n = 0; n < 2; ++n) _Pragma("unroll") for (int k = 0; k < 2; ++k) dst[n][k] = *(const PG8_LAS bf16x8*)(lds + PG8_SB(b, h) + boff + n * 2048 + k * 1024); } } while (0)
#define PG8_MMA(ai, bj, At, Bt) do { __builtin_amdgcn_s_setprio(1); _Pragma("unroll") for (int m = 0; m < 4; ++m) _Pragma("unroll") for (int n = 0; n < 2; ++n) { \
        if constexpr (FP8) asm volatile("v_mfma_scale_f32_16x16x128_f8f6f4 %0, %1, %2, %0, %3, %3 op_sel_hi:[0,0,0]" : "+v"(acc[ai][bj][m][n]) : "v"(Bt##8[n]), "v"(At##8[m]), "v"(sc1_)); \
        else { _Pragma("unroll") for (int k = 0; k < 2; ++k) acc[ai][bj][m][n] = __builtin_amdgcn_mfma_f32_16x16x32_bf16(Bt[n][k], At[m][k], acc[ai][bj][m][n], 0, 0, 0); } } \
        __builtin_amdgcn_s_setprio(0); } while (0)
#define PG8_WAIT_V(n) asm volatile("s_waitcnt vmcnt(" #n ")" ::: "memory")
#define PG8_WAIT_L(n) asm volatile("s_waitcnt lgkmcnt(" #n ")" ::: "memory")
#define PG8_BAR __builtin_amdgcn_s_barrier()
#define PG8_SCHED __builtin_amdgcn_sched_barrier(0)
    Unit cur, nxt; int ui = 0;
    if (!S.next(0, cur)) return;
    f32x4 acc[2][2][4][2];
#pragma unroll
    for (int a = 0; a < 2; ++a)
#pragma unroll
        for (int b = 0; b < 2; ++b)
#pragma unroll
            for (int m = 0; m < 4; ++m)
#pragma unroll
                for (int n = 0; n < 2; ++n) acc[a][b][m][n] = (f32x4){0.f, 0.f, 0.f, 0.f};
    typedef int i32x4_ __attribute__((ext_vector_type(4))); typedef int i32x8_ __attribute__((ext_vector_type(8)));
    int sc1_ = 0x7F7F7F7F; asm volatile("" : "+v"(sc1_));
    bf16x8 At[4][2], B0[2][2], B1[2][2]; i32x8_ At8[4], B08[2], B18[2];
    const char* cA = (const char*)g.A + (size_t)cur.pm * tstep; const char* cB = (const char*)g.Bt + (size_t)cur.pn * tstep;
    S.a_ready(cur);
    if constexpr (SP2) {
        PG8_STAGE(PG8_SB(0, 0), cB, voffB); PG8_STAGE(PG8_SB(0, 1), cB + hstep, voffB); PG8_STAGE(PG8_SA(0, 0), cA, voffA); PG8_STAGE(PG8_SA(0, 1), cA + hstep, voffA);
        if (wr == 1) PG8_BAR;
        PG8_WAIT_V(2); PG8_BAR;
        PG8_STAGE(PG8_SB(1, 0), cB + kstep, voffB); PG8_STAGE(PG8_SA(1, 0), cA + kstep, voffA); PG8_STAGE(PG8_SB(1, 1), cB + hstep + kstep, voffB);
        PG8_WAIT_V(6); PG8_BAR;
    } else {
        PG8_STAGE(PG8_SB(0, 0), cB, voffB); PG8_STAGE(PG8_SA(0, 0), cA, voffA); PG8_STAGE(PG8_SB(0, 1), cB + hstep, voffB); PG8_STAGE(PG8_SA(0, 1), cA + hstep, voffA);
        if (wr == 1) PG8_BAR;
        PG8_WAIT_V(4); PG8_BAR;
        PG8_STAGE(PG8_SB(1, 0), cB + kstep, voffB); PG8_STAGE(PG8_SA(1, 0), cA + kstep, voffA); PG8_STAGE(PG8_SB(1, 1), cB + hstep + kstep, voffB);
        PG8_WAIT_V(6); PG8_BAR;
    }
    for (;;) {
        const bool has_next = S.next(ui + 1, nxt);
        const char* nA = has_next ? (const char*)g.A + (size_t)nxt.pm * tstep : cA; const char* nB = has_next ? (const char*)g.Bt + (size_t)nxt.pn * tstep : cB;
        for (int t = 0; t < nt; t += 2) {
            const bool last = (t == nt - 2);
            const char* a1 = cA + (size_t)(t + 1) * kstep;
            const char* a2 = last ? nA : cA + (size_t)(t + 2) * kstep; const char* b2 = last ? nB : cB + (size_t)(t + 2) * kstep;
            const char* a3 = a2 + kstep; const char* b3 = b2 + kstep;
            if (last && has_next) S.a_ready(nxt);
            if constexpr (SP2) {
            PG8_LDB(B0, 0, 0); PG8_LDB(B1, 0, 1); PG8_SCHED; PG8_LDA(At, 0, 0); PG8_STAGE(PG8_SA(1, 1), a1 + hstep, voffA);
            PG8_WAIT_V(8); PG8_WAIT_L(0); PG8_BAR; PG8_MMA(0, 0, At, B0); PG8_MMA(0, 1, At, B1); PG8_BAR; PG8_SCHED;
            PG8_LDA(At, 0, 1); PG8_STAGE(PG8_SB(0, 0), b2, voffB); PG8_STAGE(PG8_SB(0, 1), b2 + hstep, voffB); PG8_STAGE(PG8_SA(0, 0), a2, voffA);
            PG8_WAIT_V(8); PG8_WAIT_L(0); PG8_BAR; PG8_MMA(1, 0, At, B0); PG8_MMA(1, 1, At, B1); PG8_BAR; PG8_SCHED;
            PG8_LDB(B0, 1, 0); PG8_LDB(B1, 1, 1); PG8_SCHED; PG8_LDA(At, 1, 0); PG8_STAGE(PG8_SA(0, 1), a2 + hstep, voffA);
            PG8_WAIT_V(8); PG8_WAIT_L(0); PG8_BAR; PG8_MMA(0, 0, At, B0); PG8_MMA(0, 1, At, B1); PG8_BAR; PG8_SCHED;
            PG8_LDA(At, 1, 1); PG8_STAGE(PG8_SB(1, 0), b3, voffB); PG8_STAGE(PG8_SB(1, 1), b3 + hstep, voffB); PG8_STAGE(PG8_SA(1, 0), a3, voffA);
            PG8_WAIT_V(8); PG8_WAIT_L(0); PG8_BAR; PG8_MMA(1, 0, At, B0); PG8_MMA(1, 1, At, B1); PG8_BAR; PG8_SCHED;
            } else {
            PG8_LDB(B0, 0, 0); PG8_SCHED; PG8_LDA(At, 0, 0); PG8_STAGE(PG8_SA(1, 1), a1 + hstep, voffA);
            PG8_WAIT_L(8); PG8_BAR; PG8_WAIT_L(0); PG8_MMA(0, 0, At, B0); PG8_BAR; PG8_SCHED;
            PG8_LDB(B1, 0, 1); PG8_STAGE(PG8_SB(0, 0), b2, voffB);
            PG8_BAR; PG8_WAIT_L(0); PG8_MMA(0, 1, At, B1); PG8_BAR;
            PG8_LDA(At, 0, 1); PG8_STAGE(PG8_SA(0, 0), a2, voffA);
            PG8_BAR; PG8_WAIT_L(0); PG8_MMA(1, 0, At, B0); PG8_BAR; PG8_SCHED;
            PG8_STAGE(PG8_SB(0, 1), b2 + hstep, voffB);
            PG8_WAIT_V(6); PG8_BAR; PG8_MMA(1, 1, At, B1); PG8_BAR;
            PG8_LDB(B0, 1, 0); PG8_SCHED; PG8_LDA(At, 1, 0); PG8_STAGE(PG8_SA(0, 1), a2 + hstep, voffA);
            PG8_WAIT_L(8); PG8_BAR; PG8_WAIT_L(0); PG8_MMA(0, 0, At, B0); PG8_BAR; PG8_SCHED;
            PG8_LDB(B1, 1, 1); PG8_STAGE(PG8_SB(1, 0), b3, voffB);
            PG8_BAR; PG8_WAIT_L(0); PG8_MMA(0, 1, At, B1); PG8_BAR;
            PG8_LDA(At, 1, 1); PG8_STAGE(PG8_SA(1, 0), a3, voffA);
            PG8_BAR; PG8_WAIT_L(0); PG8_MMA(1, 0, At, B0); PG8_BAR; PG8_SCHED;
            PG8_STAGE(PG8_SB(1, 1), b3 + hstep, voffB);
            PG8_WAIT_V(6); PG8_BAR; PG8_MMA(1, 1, At, B1); PG8_BAR;
            }
        }
        if constexpr (ALIGN_EPI) { if (wr == 0) PG8_BAR; }
        if constexpr (FP8) asm volatile("s_nop 15\n\ts_nop 15" ::: "memory");
        if constexpr (!Epi::AFTER_DRAIN) { E(acc, cur, wr, wc, fr, fq); S.done(cur); }
        if (!has_next) break;
#pragma unroll
        for (int a = 0; a < 2; ++a)
#pragma unroll
            for (int b = 0; b < 2; ++b)
#pragma unroll
                for (int m = 0; m < 4; ++m)
#pragma unroll
                    for (int n = 0; n < 2; ++n) acc[a][b][m][n] = (f32x4){0.f, 0.f, 0.f, 0.f};
        cur = nxt; cA = nA; cB = nB; ++ui;
        if constexpr (ALIGN_EPI) { if (wr == 1) PG8_BAR; }
    }
    PG8_WAIT_V(0);
    if constexpr (!ALIGN_EPI) { if (wr == 0) PG8_BAR; }
    PG8_BAR;
    if constexpr (Epi::AFTER_DRAIN) { E.fused(acc, cur, wr, wc, fr, fq, lds, wid, lane); S.done(cur); }
#undef PG8_SA
#undef PG8_SB
#undef PG8_STAGE
#undef PG8_LDA
#undef PG8_LD8
#undef PG8_LDB
#undef PG8_MMA
#undef PG8_WAIT_V
#undef PG8_WAIT_L
#undef PG8_BAR
#undef PG8_SCHED
}
}
namespace pg8 {
typedef unsigned u32x2 __attribute__((ext_vector_type(2)));
constexpr int LDX = 2048;
constexpr float RMS_EPS = 1e-6f;
#ifndef EPI_SC1
#define EPI_SC1 1
#endif
__device__ __forceinline__ void store16(void* p, u32x4 w) {
#if EPI_SC1
    asm volatile("global_store_dwordx4 %0, %1, off sc1\n\ts_nop 1" :: "v"(p), "v"(w) : "memory");
#else
    *(u32x4*)p = w;
#endif
}
struct EpiQKV {
    static constexpr bool PERM = true, AFTER_DRAIN = false;
    bf16_t* O; const float* cs; float qscale; float* ksum; int vmode; float vscale; const float* rinv; float pre; int pnoff;
    __device__ __forceinline__ void operator()(const f32x4 (&acc)[2][2][4][2], const Unit& u, int wr, int wc, int fr, int fq) const {
        const int row0 = u.pm * BM + wr * 64 + fr, pn = vmode == 2 ? (u.pn < 12 ? u.pn : u.pn + 8) : vmode ? (u.pn < 4 ? u.pn + 8 : u.pn + 16) : (u.pn + pnoff < 8 ? u.pn + pnoff : u.pn + pnoff + 4);
        const float sc = (pn < 4 || (pn >= 12 && pn < 16)) ? qscale : vscale;
        const bool rot = (pn >= 12 && pn < 20) && (wc == 0);
        bf16_t* Ot = O + ((size_t)((u.pm >> 3) * 6 + (pn >> 2)) * 8 + (pn & 3) * 2) * (2048 * 128) + wc * 32 + 8 * fq;
        const bool kacc = (pn >= 16 && pn < 20);
        float rf[2][4];
#pragma unroll
        for (int ai = 0; ai < 2; ++ai)
#pragma unroll
            for (int m = 0; m < 4; ++m) rf[ai][m] = rinv[row0 + ai * HALF + m * 16] * pre;
        f32x4 ks[2][2] = {{{0.f, 0.f, 0.f, 0.f}, {0.f, 0.f, 0.f, 0.f}}, {{0.f, 0.f, 0.f, 0.f}, {0.f, 0.f, 0.f, 0.f}}};
#pragma unroll
        for (int ai = 0; ai < 2; ++ai)
#pragma unroll
            for (int m = 0; m < 4; ++m) { const int row = row0 + ai * HALF + m * 16; bf16_t* rowp = Ot + (size_t)(row & 2047) * 128;
                f32x4 c0 = {1.f, 1.f, 1.f, 1.f}, c1 = c0, s0 = {0.f, 0.f, 0.f, 0.f}, s1 = s0;
                if (rot) { const float* cr = cs + (size_t)row * 32 + 8 * (fq & 1); c0 = *(const f32x4*)cr; c1 = *(const f32x4*)(cr + 4); s0 = *(const f32x4*)(cr + 16); s1 = *(const f32x4*)(cr + 20);
                    if (fq < 2) { s0 = -s0; s1 = -s1; } }
#pragma unroll
                for (int bj = 0; bj < 2; ++bj) { f32x4 v0 = acc[ai][bj][m][0] * rf[ai][m], v1 = acc[ai][bj][m][1] * rf[ai][m];
                    if (rot) { f32x4 p0, p1;
#pragma unroll
                        for (int j = 0; j < 4; ++j) { p0[j] = __shfl_xor(v0[j], 32); p1[j] = __shfl_xor(v1[j], 32); }
                        v0 = v0 * c0 + p0 * s0; v1 = v1 * c1 + p1 * s1; }
                    if (kacc) { ks[bj][0] += v0; ks[bj][1] += v1; }
                    v0 = v0 * sc; v1 = v1 * sc; u32x4 w; w.x = cvt_pk_bf16(v0[0], v0[1]); w.y = cvt_pk_bf16(v0[2], v0[3]); w.z = cvt_pk_bf16(v1[0], v1[1]); w.w = cvt_pk_bf16(v1[2], v1[3]);
                    store16(rowp + (size_t)bj * (2048 * 128), w); } }
        if (kacc) {
            float* kp = ksum + (size_t)(((u.pm >> 3) * 8 + (pn - 16) * 2) * 8 + (u.pm & 7)) * 128 + wc * 32 + 8 * fq;
#pragma unroll
            for (int bj = 0; bj < 2; ++bj)
#pragma unroll
                for (int n = 0; n < 2; ++n)
#pragma unroll
                    for (int j = 0; j < 4; ++j) { float s = ks[bj][n][j]; s += __shfl_xor(s, 1); s += __shfl_xor(s, 2); s += __shfl_xor(s, 4); s += __shfl_xor(s, 8);
                        if (fr == 0) atomicAdd(kp + bj * 1024 + n * 4 + j, s); }
        }
    }
};
__device__ __forceinline__ unsigned pk4_fp8(float a, float b, float c, float d) {
    a = __builtin_amdgcn_fmed3f(a, -448.f, 448.f); b = __builtin_amdgcn_fmed3f(b, -448.f, 448.f); c = __builtin_amdgcn_fmed3f(c, -448.f, 448.f); d = __builtin_amdgcn_fmed3f(d, -448.f, 448.f);
    int p = __builtin_amdgcn_cvt_pk_fp8_f32(a, b, 0, false); p = __builtin_amdgcn_cvt_pk_fp8_f32(c, d, p, true); return (unsigned)p; }
struct EpiRes {
    static constexpr bool PERM = false, AFTER_DRAIN = false;
    const float* base; float* out; bf16_t* xb; float* ssq; unsigned char* x8; float s8; float ascale;
    __device__ __forceinline__ void operator()(const f32x4 (&acc)[2][2][4][2], const Unit& u, int wr, int wc, int fr, int fq) const {
        const int row0 = u.pm * BM + wr * 64 + fr, col0 = u.pn * BM + wc * 32 + 4 * fq;
#pragma unroll
        for (int ai = 0; ai < 2; ++ai)
#pragma unroll
            for (int m = 0; m < 4; ++m) { const int row = row0 + ai * HALF + m * 16; const size_t off = (size_t)row * LDX + col0; float s = 0.f;
#pragma unroll
                for (int bj = 0; bj < 2; ++bj)
#pragma unroll
                    for (int n = 0; n < 2; ++n) { const f32x4 v = *(const f32x4*)(base + off + bj * HALF + n * 16) + acc[ai][bj][m][n] * ascale;
                        *(f32x4*)(out + off + bj * HALF + n * 16) = v; s += (v[0] * v[0] + v[1] * v[1]) + (v[2] * v[2] + v[3] * v[3]);
                        if (xb) { u32x2 w; w.x = cvt_pk_bf16(v[0], v[1]); w.y = cvt_pk_bf16(v[2], v[3]); *(u32x2*)(xb + off + bj * HALF + n * 16) = w; }
                        if (x8) { *(unsigned*)(x8 + off + bj * HALF + n * 16) = pk4_fp8(v[0] * s8, v[1] * s8, v[2] * s8, v[3] * s8); } }
                if (ssq) { s += __shfl_xor(s, 16); s += __shfl_xor(s, 32); if (fq == 0) atomicAdd(ssq + row, s); }
                asm volatile("" ::: "memory"); }
    }
};
template <bool BASE_F32> struct EpiResB {
    static constexpr bool PERM = true, AFTER_DRAIN = false;
    const void* base; bf16_t* xo; float* ssq; unsigned char* x8; float s8; float ascale;
    __device__ __forceinline__ void operator()(const f32x4 (&acc)[2][2][4][2], const Unit& u, int wr, int wc, int fr, int fq) const {
        const int row0 = u.pm * BM + wr * 64 + fr, col0 = u.pn * BM + wc * 32 + 8 * fq;
#pragma unroll
        for (int ai = 0; ai < 2; ++ai)
#pragma unroll
            for (int m = 0; m < 4; ++m) { const int row = row0 + ai * HALF + m * 16; const size_t off = (size_t)row * LDX + col0; float s = 0.f;
#pragma unroll
                for (int bj = 0; bj < 2; ++bj) { f32x4 b0, b1;
                    if (BASE_F32) { const float* bp = (const float*)base + off + bj * HALF; b0 = *(const f32x4*)bp; b1 = *(const f32x4*)(bp + 4); }
                    else { const u32x4 w = *(const u32x4*)((const bf16_t*)base + off + bj * HALF);
                        b0 = (f32x4){__uint_as_float(w.x << 16), __uint_as_float(w.x & 0xffff0000u), __uint_as_float(w.y << 16), __uint_as_float(w.y & 0xffff0000u)};
                        b1 = (f32x4){__uint_as_float(w.z << 16), __uint_as_float(w.z & 0xffff0000u), __uint_as_float(w.w << 16), __uint_as_float(w.w & 0xffff0000u)}; }
                    const f32x4 v0 = b0 + acc[ai][bj][m][0] * ascale, v1 = b1 + acc[ai][bj][m][1] * ascale;
                    s += ((v0[0] * v0[0] + v0[1] * v0[1]) + (v0[2] * v0[2] + v0[3] * v0[3])) + ((v1[0] * v1[0] + v1[1] * v1[1]) + (v1[2] * v1[2] + v1[3] * v1[3]));
                    if (xo) { u32x4 w; w.x = cvt_pk_bf16(v0[0], v0[1]); w.y = cvt_pk_bf16(v0[2], v0[3]); w.z = cvt_pk_bf16(v1[0], v1[1]); w.w = cvt_pk_bf16(v1[2], v1[3]); store16(xo + off + bj * HALF, w); }
                    if (x8) { u32x2 w8; w8.x = pk4_fp8(v0[0] * s8, v0[1] * s8, v0[2] * s8, v0[3] * s8); w8.y = pk4_fp8(v1[0] * s8, v1[1] * s8, v1[2] * s8, v1[3] * s8); *(u32x2*)(x8 + off + bj * HALF) = w8; } }
                if (ssq) { s += __shfl_xor(s, 16); s += __shfl_xor(s, 32); if (fq == 0) atomicAdd(ssq + row, s); }
                if (BASE_F32 ? (m & 1) : (m == 3)) asm volatile("" ::: "memory"); }
    }
};
struct EpiScale {
    static constexpr bool PERM = true, AFTER_DRAIN = false;
    bf16_t* O; int ldc; const float* ssq; float sc;
    __device__ __forceinline__ void operator()(const f32x4 (&acc)[2][2][4][2], const Unit& u, int wr, int wc, int fr, int fq) const {
        const int row0 = u.pm * BM + wr * 64 + fr, col0 = u.pn * BM + wc * 32 + 8 * fq;
        float sv[2][4];
#pragma unroll
        for (int ai = 0; ai < 2; ++ai)
#pragma unroll
            for (int m = 0; m < 4; ++m) sv[ai][m] = ssq ? ssq[row0 + ai * HALF + m * 16] : 0.f;
#pragma unroll
        for (int ai = 0; ai < 2; ++ai)
#pragma unroll
            for (int m = 0; m < 4; ++m) { const int row = row0 + ai * HALF + m * 16; bf16_t* rowp = O + (size_t)row * ldc + col0;
                const float f = ssq ? sc * __builtin_amdgcn_rsqf(sv[ai][m] * (1.0f / 2048.0f) + RMS_EPS) : sc;
#pragma unroll
                for (int bj = 0; bj < 2; ++bj) { const f32x4 v0 = acc[ai][bj][m][0] * f, v1 = acc[ai][bj][m][1] * f;
                    u32x4 w; w.x = cvt_pk_bf16(v0[0], v0[1]); w.y = cvt_pk_bf16(v0[2], v0[3]); w.z = cvt_pk_bf16(v1[0], v1[1]); w.w = cvt_pk_bf16(v1[2], v1[3]);
                    *(u32x4*)(rowp + bj * HALF) = w; } }
    }
};
struct EpiNull { static constexpr bool PERM = true, AFTER_DRAIN = false; float* sink;
    __device__ __forceinline__ void operator()(const f32x4 (&acc)[2][2][4][2], const Unit& u, int wr, int wc, int fr, int fq) const {
#pragma unroll
        for (int ai = 0; ai < 2; ++ai)
#pragma unroll
            for (int bj = 0; bj < 2; ++bj)
#pragma unroll
                for (int m = 0; m < 4; ++m)
#pragma unroll
                    for (int n = 0; n < 2; ++n) asm volatile("" :: "v"(acc[ai][bj][m][n])); } };
struct EpiSwiGLU {
    static constexpr bool PERM = true, AFTER_DRAIN = false;
    bf16_t* O; const float* ssq; unsigned char* O8; float ascale, oscale;
    __device__ __forceinline__ void operator()(const f32x4 (&acc)[2][2][4][2], const Unit& u, int wr, int wc, int fr, int fq) const {
        const int row0 = u.pm * BM + wr * 64 + fr, col0 = u.pn * HALF + wc * 32 + 8 * fq;
        float sv[2][4];
#pragma unroll
        for (int ai = 0; ai < 2; ++ai)
#pragma unroll
            for (int m = 0; m < 4; ++m) sv[ai][m] = ssq[row0 + ai * HALF + m * 16];
#pragma unroll
        for (int ai = 0; ai < 2; ++ai)
#pragma unroll
            for (int m = 0; m < 4; ++m) { const int row = row0 + ai * HALF + m * 16; bf16_t* rowp = O + (size_t)row * 5632 + col0;
                const float f = ascale * __builtin_amdgcn_rsqf(sv[ai][m] * (1.0f / 2048.0f) + RMS_EPS);
                const float fneg = -1.4426950408889634f * f, f2o = f * f * (O8 ? oscale : 1.0f);
                float r[8];
#pragma unroll
                for (int n = 0; n < 2; ++n)
#pragma unroll
                    for (int j = 0; j < 4; ++j) { const float ag = acc[ai][0][m][n][j], au = acc[ai][1][m][n][j];
                        r[n * 4 + j] = (ag * au) * (f2o * __builtin_amdgcn_rcpf(1.0f + __builtin_amdgcn_exp2f(fneg * ag))); }
                if (O8) { u32x2 w8; w8.x = pk4_fp8(r[0], r[1], r[2], r[3]); w8.y = pk4_fp8(r[4], r[5], r[6], r[7]);
                    *(u32x2*)(O8 + (size_t)row * 5632 + col0) = w8; }
                else { u32x4 w; w.x = cvt_pk_bf16(r[0], r[1]); w.y = cvt_pk_bf16(r[2], r[3]); w.z = cvt_pk_bf16(r[4], r[5]); w.w = cvt_pk_bf16(r[6], r[7]);
                *(u32x4*)rowp = w; } }
    }
};
}
namespace att {
using bf16x8 = __attribute__((ext_vector_type(8))) short;
using s16x4  = __attribute__((ext_vector_type(4))) short;
using f32x16 = __attribute__((ext_vector_type(16))) float;
using f32x4  = __attribute__((ext_vector_type(4))) float;
using u32x4  = __attribute__((ext_vector_type(4))) unsigned;
typedef unsigned short bf16;
constexpr int D = 128, KVBLK = 64;
constexpr int SHM_V = KVBLK * D * 2, SHM_K = KVBLK * D * 2;
constexpr int OFF_Q = 2 * SHM_V + 2 * SHM_K, OFF_WS = 131072 + 1024, OFF_KM = OFF_WS + 2048, ATT_LDS = OFF_KM + 4096;
constexpr float THR = 8.f;
constexpr float SB_DONE = 7.8886e-31f;
#ifndef QREG_SOFTMAX
#define QREG_SOFTMAX 1
#endif
#ifndef PIPE_SOFTMAX
#define PIPE_SOFTMAX 0
#endif
#define KSWZ(row, colB) ((row) * 256 + ((colB) ^ (((row) & 7) << 4)))
#define SBAR() __builtin_amdgcn_sched_barrier(0)
__device__ __forceinline__ int crow(int r, int hi) { return (r & 3) + 8 * (r >> 2) + 4 * hi; }
__device__ __forceinline__ unsigned cvtpk(float lo, float hi) { unsigned r; asm volatile("v_cvt_pk_bf16_f32 %0, %1, %2" : "=v"(r) : "v"(lo), "v"(hi)); return r; }
__device__ __forceinline__ float xchg32(float x, int hi) { auto rr = __builtin_amdgcn_permlane32_swap(__float_as_uint(x), __float_as_uint(x), false, false); return __uint_as_float(hi ? rr[0] : rr[1]); }
typedef __attribute__((address_space(3))) const char* lds_cp;
template <int D0> __device__ __forceinline__ void qkt_part(f32x16& p0, f32x16& p1, const lds_cp (&ka)[2][4], int boff, const lds_cp (&qa)[2][4]) {
  const bf16x8 qf = *reinterpret_cast<const __attribute__((address_space(3))) bf16x8*>(qa[D0 >> 2][D0 & 3]);
  const bf16x8 b0 = *reinterpret_cast<const __attribute__((address_space(3))) bf16x8*>(ka[D0 >> 2][D0 & 3] + boff);
  const bf16x8 b1 = *reinterpret_cast<const __attribute__((address_space(3))) bf16x8*>(ka[D0 >> 2][D0 & 3] + boff + 8192);
  p0 = __builtin_amdgcn_mfma_f32_32x32x16_bf16(b0, qf, p0, 0, 0, 0);
  p1 = __builtin_amdgcn_mfma_f32_32x32x16_bf16(b1, qf, p1, 0, 0, 0);
}
template <int D0> __device__ __forceinline__ void qkt_part(f32x16& p0, f32x16& p1, const lds_cp (&ka)[2][4], int boff, const bf16x8 (&qg)[8]) {
  const bf16x8 b0 = *reinterpret_cast<const __attribute__((address_space(3))) bf16x8*>(ka[D0 >> 2][D0 & 3] + boff);
  const bf16x8 b1 = *reinterpret_cast<const __attribute__((address_space(3))) bf16x8*>(ka[D0 >> 2][D0 & 3] + boff + 8192);
  p0 = __builtin_amdgcn_mfma_f32_32x32x16_bf16(b0, qg[D0], p0, 0, 0, 0);
  p1 = __builtin_amdgcn_mfma_f32_32x32x16_bf16(b1, qg[D0], p1, 0, 0, 0);
}
#define KLD(G, A0, A1) do { A0 = *reinterpret_cast<const __attribute__((address_space(3))) bf16x8*>(ka[(G) >> 2][(G) & 3] + boff); A1 = *reinterpret_cast<const __attribute__((address_space(3))) bf16x8*>(ka[(G) >> 2][(G) & 3] + boff + 8192); } while (0)
#define KMM(G, A0, A1) do { p0 = __builtin_amdgcn_mfma_f32_32x32x16_bf16(A0, qg[G], p0, 0, 0, 0); p1 = __builtin_amdgcn_mfma_f32_32x32x16_bf16(A1, qg[G], p1, 0, 0, 0); } while (0)
__device__ __forceinline__ void qkt(f32x16& p0, f32x16& p1, const lds_cp (&ka)[2][4], int boff, const bf16x8 (&qg)[8], float bias = 0.f) {
#pragma unroll
  for (int r = 0; r < 16; ++r) { p0[r] = bias; p1[r] = bias; }
  bf16x8 a0, a1, b0, b1, c0, c1, d0, d1;
  KLD(0, a0, a1); KLD(1, b0, b1); KLD(2, c0, c1); KLD(3, d0, d1); SBAR();
  KMM(0, a0, a1); SBAR(); KLD(4, a0, a1); SBAR();
  KMM(1, b0, b1); SBAR(); KLD(5, b0, b1); SBAR();
  KMM(2, c0, c1); SBAR(); KLD(6, c0, c1); SBAR();
  KMM(3, d0, d1); SBAR(); KLD(7, d0, d1); SBAR();
  KMM(4, a0, a1); KMM(5, b0, b1); KMM(6, c0, c1); KMM(7, d0, d1);
}
#undef KLD
#undef KMM
__device__ __forceinline__ void qkt(f32x16& p0, f32x16& p1, const lds_cp (&ka)[2][4], int boff, const lds_cp (&qr)[2][4], float bias = 0.f) {
#pragma unroll
  for (int r = 0; r < 16; ++r) { p0[r] = bias; p1[r] = bias; }
  qkt_part<0>(p0, p1, ka, boff, qr); qkt_part<1>(p0, p1, ka, boff, qr); qkt_part<2>(p0, p1, ka, boff, qr); qkt_part<3>(p0, p1, ka, boff, qr);
  qkt_part<4>(p0, p1, ka, boff, qr); qkt_part<5>(p0, p1, ka, boff, qr); qkt_part<6>(p0, p1, ka, boff, qr); qkt_part<7>(p0, p1, ka, boff, qr);
}
__device__ __forceinline__ int v_st(int k, int c) { const int kk = (k & ~0xC) | ((k & 4) << 1) | ((k & 8) >> 1); return ((kk >> 3) * 4 + (c >> 5)) * 512 + ((kk & 7) * 32 + (c & 31)) * 2; }
__device__ __forceinline__ int v_rd_base(int lane) { return ((lane & 3) << 3) | (((lane >> 2) & 3) << 6) | (((lane >> 4) & 1) << 5) | (((lane >> 5) & 1) << 8); }
constexpr int v_rd_off(int d0, int ks, int half) { return d0 * 512 + ks * 4096 + half * 2048; }
template <int OFF> __device__ __forceinline__ s16x4 tr_read(int vb) { s16x4 r; asm volatile("ds_read_b64_tr_b16 %0, %1 offset:%2" : "=&v"(r) : "v"(vb), "i"(OFF) : "memory"); return r; }
struct VFrag { s16x4 l0, h0, l1, h1, l2, h2, l3, h3; };
template <int D0> __device__ __forceinline__ void v_read(VFrag& f, int vb) {
  f.l0 = tr_read<v_rd_off(D0, 0, 0)>(vb); f.h0 = tr_read<v_rd_off(D0, 0, 1)>(vb); f.l1 = tr_read<v_rd_off(D0, 1, 0)>(vb); f.h1 = tr_read<v_rd_off(D0, 1, 1)>(vb);
  f.l2 = tr_read<v_rd_off(D0, 2, 0)>(vb); f.h2 = tr_read<v_rd_off(D0, 2, 1)>(vb); f.l3 = tr_read<v_rd_off(D0, 3, 0)>(vb); f.h3 = tr_read<v_rd_off(D0, 3, 1)>(vb);
}
__device__ __forceinline__ void pv_mma(f32x16& od, const VFrag& f, bf16x8 pa0, bf16x8 pa1, bf16x8 pa2, bf16x8 pa3) {
#define PK(L, H) (bf16x8){L[0], L[1], L[2], L[3], H[0], H[1], H[2], H[3]}
  od = __builtin_amdgcn_mfma_f32_32x32x16_bf16(pa0, PK(f.l0, f.h0), od, 0, 0, 0);
  od = __builtin_amdgcn_mfma_f32_32x32x16_bf16(pa1, PK(f.l1, f.h1), od, 0, 0, 0);
  od = __builtin_amdgcn_mfma_f32_32x32x16_bf16(pa2, PK(f.l2, f.h2), od, 0, 0, 0);
  od = __builtin_amdgcn_mfma_f32_32x32x16_bf16(pa3, PK(f.l3, f.h3), od, 0, 0, 0);
#undef PK
}
__device__ __forceinline__ void pv_d0(f32x16* o, int vb, bf16x8 pa0, bf16x8 pa1, bf16x8 pa2, bf16x8 pa3) {
  VFrag fa, fb;
  v_read<0>(fa, vb);
  v_read<1>(fb, vb); asm volatile("s_waitcnt lgkmcnt(8)" ::: "memory"); SBAR(); pv_mma(o[0], fa, pa0, pa1, pa2, pa3); SBAR();
  v_read<2>(fa, vb); asm volatile("s_waitcnt lgkmcnt(8)" ::: "memory"); SBAR(); pv_mma(o[1], fb, pa0, pa1, pa2, pa3); SBAR();
  v_read<3>(fb, vb); asm volatile("s_waitcnt lgkmcnt(8)" ::: "memory"); SBAR(); pv_mma(o[2], fa, pa0, pa1, pa2, pa3); SBAR();
  asm volatile("s_waitcnt lgkmcnt(0)" ::: "memory"); SBAR(); pv_mma(o[3], fb, pa0, pa1, pa2, pa3);
}
__device__ __forceinline__ void pack_p(const f32x16& p0, const f32x16& p1, bf16x8& pa0, bf16x8& pa1, bf16x8& pa2, bf16x8& pa3) {
#define PK4(P, BASE, OUT) do { unsigned a0 = cvtpk(P[BASE + 0], P[BASE + 1]), a1 = cvtpk(P[BASE + 2], P[BASE + 3]);   \
    unsigned b0 = cvtpk(P[BASE + 4], P[BASE + 5]), b1 = cvtpk(P[BASE + 6], P[BASE + 7]);                              \
    auto r0 = __builtin_amdgcn_permlane32_swap(a0, b0, false, false); auto r1 = __builtin_amdgcn_permlane32_swap(a1, b1, false, false); \
    u32x4 w = {r0[0], r1[0], r0[1], r1[1]}; OUT = *reinterpret_cast<bf16x8*>(&w); } while (0)
  PK4(p0, 0, pa0); PK4(p0, 8, pa1); PK4(p1, 0, pa2); PK4(p1, 8, pa3);
#undef PK4
}
__device__ __forceinline__ void softmax_tile(f32x16& p0, f32x16& p1, float& m_reg, float& l_reg, float& alpha) {
  float pmax = p0[0];
#pragma unroll
  for (int r = 1; r < 16; ++r) pmax = fmaxf(pmax, p0[r]);
#pragma unroll
  for (int r = 0; r < 16; ++r) pmax = fmaxf(pmax, p1[r]);
  pmax = fmaxf(pmax, xchg32(pmax, (int)(threadIdx.x >> 5) & 1));
  if (__all(pmax - m_reg <= THR)) { alpha = 1.f; }
  else { const float mn = fmaxf(m_reg, pmax); alpha = __builtin_amdgcn_exp2f(m_reg - mn); m_reg = mn; }
  float ps = 0.f;
#pragma unroll
  for (int r = 0; r < 16; ++r) { p0[r] = __builtin_amdgcn_exp2f(p0[r] - m_reg); ps += p0[r]; }
#pragma unroll
  for (int r = 0; r < 16; ++r) { p1[r] = __builtin_amdgcn_exp2f(p1[r] - m_reg); ps += p1[r]; }
  ps += xchg32(ps, (int)(threadIdx.x >> 5) & 1);
  l_reg = l_reg * alpha + ps;
}
template <bool BAND, int I> __device__ __forceinline__ float sb_group(f32x16& P, int kb, int qrel, int hi) {
  float run = 1.f;
#pragma unroll
  for (int e = 3; e >= 0; --e) { const int r = 4 * I + e; float rr = __builtin_amdgcn_rcpf(1.0f + __builtin_amdgcn_exp2f(P[r]));
    if (BAND) rr = (kb + crow(r, hi) < qrel) ? rr : 1.f;
    P[r] = (1.0f - rr) * run; run *= rr; }
  return run;
}
__device__ __forceinline__ void sb_combine(f32x16& p0, f32x16& p1, float (&gs)[8], float& carry, int hi) {
  float acc = 1.f;
#pragma unroll
  for (int i = 7; i >= 0; --i) { const float so_i = acc; acc *= gs[i]; const float x = hi ? acc : so_i; gs[i] = carry * so_i * xchg32(x, hi); }
  carry *= acc * xchg32(acc, hi);
#pragma unroll
  for (int i = 0; i < 4; ++i)
#pragma unroll
    for (int e = 0; e < 4; ++e) { p0[4 * i + e] *= gs[i]; p1[4 * i + e] *= gs[4 + i]; }
}
template <bool BAND>
__device__ __forceinline__ void sb_tile(f32x16& p0, f32x16& p1, float& carry, int kb, int qrel, int hi) {
  float gs[8];
  gs[0] = sb_group<BAND, 0>(p0, kb, qrel, hi); SBAR(); gs[1] = sb_group<BAND, 1>(p0, kb, qrel, hi); SBAR(); gs[2] = sb_group<BAND, 2>(p0, kb, qrel, hi); SBAR(); gs[3] = sb_group<BAND, 3>(p0, kb, qrel, hi); SBAR();
  gs[4] = sb_group<BAND, 0>(p1, kb + 32, qrel, hi); SBAR(); gs[5] = sb_group<BAND, 1>(p1, kb + 32, qrel, hi); SBAR(); gs[6] = sb_group<BAND, 2>(p1, kb + 32, qrel, hi); SBAR(); gs[7] = sb_group<BAND, 3>(p1, kb + 32, qrel, hi); SBAR();
  sb_combine(p0, p1, gs, carry, hi);
}

template <int MODE, bool OUT8 = false>
__device__ __forceinline__ void attn_unit(const bf16* __restrict__ Qb_or_hb, const bf16* __restrict__ Kh_in, const bf16* __restrict__ Vh_in, bf16* __restrict__ Ob,
                                          const float* __restrict__ gain, const float* __restrict__ kmean, int qb, int nkeys, char* lds, float s8 = 1.f,
                                          bool preissued = false, const bf16* __restrict__ nhb = nullptr, int nqb = 0, int nt0 = 0, int nt1 = -1) {
  constexpr int ldq = (MODE == 0) ? 512 : 128, ldk = (MODE == 0) ? 1024 : 128, ldo = (MODE == 0) ? 512 : 2048;
  constexpr long HSZ_ = 2048L * 128L;
  const bf16* __restrict__ Qb = (MODE == 0) ? Qb_or_hb : Qb_or_hb + (long)qb * (256 * 128);
  const bf16* __restrict__ Kh = (MODE == 0) ? Kh_in : Qb_or_hb + 8 * HSZ_;
  const bf16* __restrict__ Vh = (MODE == 0) ? Vh_in : Qb_or_hb + 16 * HSZ_;
  int tid_ = threadIdx.x; asm volatile("" : "+v"(tid_));
  const int tid = tid_, wid = __builtin_amdgcn_readfirstlane(tid >> 6), lane = tid & 63, r32 = lane & 31, hi = lane >> 5;
  char* V_lds = lds; char* K_lds = lds + 2 * SHM_V;
  float* ws = (float*)(lds + OFF_WS) + wid * 64; float* li_l = ws; float* al_l = ws + 32;
  float* km_l = (float*)(lds + OFF_KM);
  int* flg = (int*)(lds + OFF_KM);
  const int NT = (MODE == 0) ? nkeys / KVBLK : 4 * (qb + 1);
  const int qrel = wid * 32 + r32;
  float m_reg = -1e30f, l_reg = 0.f, carry = 1.f; f32x16 o[4] = {};
  const int vb0 = (int)(uintptr_t)V_lds + v_rd_base(lane);
  lds_cp ka[2][4];
#pragma unroll
  for (int y = 0; y < 2; ++y)
#pragma unroll
    for (int x = 0; x < 4; ++x) ka[y][x] = (lds_cp)(__attribute__((address_space(3))) char*)K_lds + r32 * 256 + 128 * (y ^ ((r32 >> 3) & 1)) + 32 * (x ^ ((r32 >> 1) & 3)) + 16 * (hi ^ (r32 & 1));
  lds_cp qr[2][4];
#pragma unroll
  for (int y = 0; y < 2; ++y)
#pragma unroll
    for (int x = 0; x < 4; ++x) qr[y][x] = ka[y][x] + (OFF_Q - 2 * SHM_V) + wid * 8192;
  long ksrc[2], vsrc[2];
#pragma unroll
  for (int i = 0; i < 2; ++i) { const int piece = wid + 8 * i;
    { const int row = piece * 4 + (lane >> 4), c = (lane & 15) ^ (row & 15); ksrc[i] = (long)row * ldk + c * 8; }
    { const int sub = piece * 2 + (lane >> 5), kk = (sub >> 2) * 8 + ((lane & 31) >> 2), k = (kk & ~0xC) | ((kk & 4) << 1) | ((kk & 8) >> 1), c = (sub & 3) * 32 + (lane & 3) * 8; vsrc[i] = (long)k * ldk + c; } }
  typedef __attribute__((address_space(3))) unsigned lds_u32;
  lds_u32* kdst = (lds_u32*)(__attribute__((address_space(3))) char*)(K_lds) + wid * 256; lds_u32* vdst = (lds_u32*)(__attribute__((address_space(3))) char*)(V_lds) + wid * 256;
#define TILE(it) ((MODE == 2) ? (NT - 1 - (it)) : (it))
#define DMA_K(k0, b) do { _Pragma("unroll") for (int i_ = 0; i_ < 2; ++i_) __builtin_amdgcn_global_load_lds((const unsigned*)(Kh + (long)(k0) * ldk + ksrc[i_]), kdst + (b) * (SHM_K / 4) + i_ * 2048, 16, 0, 0); } while (0)
#define DMA_V(k0, b) do { _Pragma("unroll") for (int i_ = 0; i_ < 2; ++i_) __builtin_amdgcn_global_load_lds((const unsigned*)(Vh + (long)(k0) * ldk + vsrc[i_]), vdst + (b) * (SHM_V / 4) + i_ * 2048, 16, 0, 0); } while (0)
#define SDRAIN() asm volatile("s_waitcnt vmcnt(0)" ::: "memory")
#define KSLOT(i_) ((i_) == 2 ? (OFF_Q - 2 * SHM_V) : (i_) * SHM_K)
#define VSLOT(i_) ((i_) == 2 ? (OFF_Q + SHM_K) : (i_) * SHM_V)
#define DMA_K3(k0, so) do { _Pragma("unroll") for (int i_ = 0; i_ < 2; ++i_) __builtin_amdgcn_global_load_lds((const unsigned*)(Kh + (long)(k0) * ldk + ksrc[i_]), kdst + (so) / 4 + i_ * 2048, 16, 0, 0); } while (0)
#define DMA_V3(k0, so) do { _Pragma("unroll") for (int i_ = 0; i_ < 2; ++i_) __builtin_amdgcn_global_load_lds((const unsigned*)(Vh + (long)(k0) * ldk + vsrc[i_]), vdst + (so) / 4 + i_ * 2048, 16, 0, 0); } while (0)
  lds_u32* qdst = (lds_u32*)(__attribute__((address_space(3))) char*)(lds + OFF_Q) + wid * 2048;
#define ISSUE_UNIT(QB_, KH_, VH_, T0_, T1_) do { \
    _Pragma("unroll") for (int i = 0; i < 8; ++i) { const int row = 4 * i + (lane >> 4), c = (lane & 15) ^ (row & 15); \
      __builtin_amdgcn_global_load_lds((const unsigned*)((QB_) + (long)(wid * 32 + row) * ldq + c * 8), qdst + i * 256, 16, 0, 0); } \
    _Pragma("unroll") for (int i_ = 0; i_ < 2; ++i_) { \
      __builtin_amdgcn_global_load_lds((const unsigned*)((KH_) + (long)((T0_) * KVBLK) * ldk + ksrc[i_]), kdst + i_ * 2048, 16, 0, 0); \
      __builtin_amdgcn_global_load_lds((const unsigned*)((VH_) + (long)((T0_) * KVBLK) * ldk + vsrc[i_]), vdst + i_ * 2048, 16, 0, 0); } \
    if ((T1_) >= 0) { _Pragma("unroll") for (int i_ = 0; i_ < 2; ++i_) __builtin_amdgcn_global_load_lds((const unsigned*)((KH_) + (long)((T1_) * KVBLK) * ldk + ksrc[i_]), kdst + (SHM_K / 4) + i_ * 2048, 16, 0, 0); } } while (0)
  if (!preissued) ISSUE_UNIT(Qb, Kh, Vh, TILE(0), ((MODE == 2 || PIPE_SOFTMAX) ? TILE(1) : -1));
  constexpr bool RING3 = (MODE != 2) && QREG_SOFTMAX && !PIPE_SOFTMAX;
  unsigned selmask = 0u;
  float gv[4] = {1.f, 1.f, 1.f, 1.f};
  if (gain) {
#pragma unroll
    for (int d0 = 0; d0 < 4; ++d0) gv[d0] = gain[d0 * 32 + r32]; }
  if (MODE == 1) { if (tid < 256) *(f32x4*)(km_l + tid * 4) = *(const f32x4*)(kmean + tid * 4); }
  SDRAIN();
  __syncthreads();
  if (MODE == 1) {
    float g[8];
#pragma unroll
    for (int n = 0; n < 8; ++n) g[n] = 0.f;
    { const int rh = (r32 >> 1) & 3, r3 = (r32 >> 3) & 1;
      const lds_cp qbase = qr[0][0] - 32 * rh - 128 * r3;
#pragma unroll 1
      for (int d0 = 0; d0 < 8; ++d0) {
        const bf16x8 qf = *reinterpret_cast<const __attribute__((address_space(3))) bf16x8*>(qbase + 32 * ((d0 & 3) ^ rh) + 128 * ((d0 >> 2) ^ r3));
        float q[8];
#pragma unroll
        for (int j = 0; j < 8; ++j) q[j] = __uint_as_float(((unsigned)(unsigned short)qf[j]) << 16);
        const float* kmp = km_l + d0 * 16 + hi * 8;
#pragma unroll
        for (int n = 0; n < 7; ++n) { const f32x4 k0v = *(const f32x4*)(kmp + n * 128), k1v = *(const f32x4*)(kmp + n * 128 + 4);
          g[n] += (q[0] * k0v[0] + q[1] * k0v[1]) + (q[2] * k0v[2] + q[3] * k0v[3]) + (q[4] * k1v[0] + q[5] * k1v[1]) + (q[6] * k1v[2] + q[7] * k1v[3]); }
      } }
#pragma unroll
    for (int n = 0; n < 7; ++n) { g[n] += xchg32(g[n], hi); if (n >= qb) g[n] = -INFINITY; }
    g[7] = -INFINITY;
#pragma unroll
    for (int n = 0; n < 7; ++n) { int cnt = 0;
#pragma unroll
      for (int mI = 0; mI < 7; ++mI) { if (mI != n) cnt += (g[mI] > g[n] || (g[mI] == g[n] && mI < n)) ? 1 : 0; }
      if (n < qb && cnt < 3) selmask |= (1u << n); }
  }
  bf16x8 qg[8];
  if (QREG_SOFTMAX && MODE != 2) {
#pragma unroll
    for (int d0 = 0; d0 < 8; ++d0) qg[d0] = *reinterpret_cast<const __attribute__((address_space(3))) bf16x8*>(qr[d0 >> 2][d0 & 3]); }
  int kc = KSLOT(0), kn = KSLOT(1), kn2 = KSLOT(2), vc = VSLOT(0), vn = VSLOT(1), vn2 = VSLOT(2);
  if (RING3) { DMA_K3(TILE(1) * KVBLK, kn); DMA_V3(TILE(1) * KVBLK, vn);
    asm volatile("s_waitcnt lgkmcnt(0)" ::: "memory"); __syncthreads(); }
  f32x16 pA0, pA1, pB0, pB1; bf16x8 pa0, pa1, pa2, pa3;
  if (MODE == 2 || PIPE_SOFTMAX) { float bias0 = 0.f; if (MODE == 1) { if (NT > 4) bias0 = (selmask & 1u) ? 0.f : -INFINITY; }
    qkt(pA0, pA1, ka, 0, qr, bias0);
    __syncthreads(); }
  int it = 0;
#define JB(i_) ((MODE == 2) ? (3 - (i_)) : ((i_) - (NT - 4)))
#define STEP(A0, A1, B0, B1, BAND, HASNEXT) do { \
    if (it + 2 < NT) DMA_K(TILE(it + 2) * KVBLK, it & 1); \
    if (it + 1 < NT) DMA_V(TILE(it + 1) * KVBLK, (it + 1) & 1); \
    bool skip = false; const int jb = JB(it); \
    if (BAND) { if (MODE == 1) skip = (64 * jb > wid * 32 + 31); if (MODE == 2) skip = (64 * jb >= wid * 32 + 31); } \
    if (MODE == 2) skip = skip || __all(carry < SB_DONE);        \
    if (HASNEXT) { float bias_ = 0.f; if (MODE == 1) { if (it + 1 < NT - 4) bias_ = ((selmask >> ((it + 1) >> 2)) & 1u) ? 0.f : -INFINITY; } \
      qkt(B0, B1, ka, ((it + 1) & 1) * SHM_K, qr, bias_); } \
    if (!skip) { \
      if (MODE == 2) { sb_tile<(BAND) != 0>(A0, A1, carry, 64 * jb, qrel, hi); } \
      else { \
        if (MODE == 1 && (BAND)) { _Pragma("unroll") for (int r = 0; r < 16; ++r) { const int kr = 64 * jb + crow(r, hi); if (kr > qrel) A0[r] = -INFINITY; if (kr + 32 > qrel) A1[r] = -INFINITY; } } \
        float alpha; softmax_tile(A0, A1, m_reg, l_reg, alpha); \
        if (__any(alpha < 1.f)) { if (hi == 0) al_l[r32] = alpha; asm volatile("s_waitcnt lgkmcnt(0)" ::: "memory"); \
          _Pragma("unroll") for (int d = 0; d < 4; ++d) _Pragma("unroll") for (int r = 0; r < 16; ++r) o[d][r] *= al_l[crow(r, hi)]; } \
      } \
      pack_p(A0, A1, pa0, pa1, pa2, pa3); \
      pv_d0(o, vb0 + (it & 1) * SHM_V, pa0, pa1, pa2, pa3); \
    } \
    SDRAIN(); __syncthreads(); ++it; } while (0)
#define SB_LD(G, F) do { F##q = *reinterpret_cast<const __attribute__((address_space(3))) bf16x8*>(qr[(G) >> 2][(G) & 3]); \
      F##0 = *reinterpret_cast<const __attribute__((address_space(3))) bf16x8*>(ka[(G) >> 2][(G) & 3] + kb_); F##1 = *reinterpret_cast<const __attribute__((address_space(3))) bf16x8*>(ka[(G) >> 2][(G) & 3] + kb_ + 8192); } while (0)
#define SB_PART(G, P, I, B0, B1, FC, FN) do { if ((G) < 7) SB_LD(((G) + 1) & 7, FN);              \
      B0 = __builtin_amdgcn_mfma_f32_32x32x16_bf16(FC##0, FC##q, B0, 0, 0, 0); B1 = __builtin_amdgcn_mfma_f32_32x32x16_bf16(FC##1, FC##q, B1, 0, 0, 0); \
      gs_[G] = sb_group<false, I>(P, 0, 0, hi); SBAR(); } while (0)
#define STEP_SB(A0, A1, B0, B1) do { \
    if (it + 2 < NT) DMA_K(TILE(it + 2) * KVBLK, it & 1); \
    DMA_V(TILE(it + 1) * KVBLK, (it + 1) & 1); \
    float gs_[8]; \
    _Pragma("unroll") for (int r = 0; r < 16; ++r) { B0[r] = 0.f; B1[r] = 0.f; } \
    const int kb_ = ((it + 1) & 1) * SHM_K; bf16x8 fx0, fx1, fxq, fy0, fy1, fyq; SB_LD(0, fx); SBAR(); \
    SB_PART(0, A0, 0, B0, B1, fx, fy); SB_PART(1, A0, 1, B0, B1, fy, fx); SB_PART(2, A0, 2, B0, B1, fx, fy); SB_PART(3, A0, 3, B0, B1, fy, fx); \
    SB_PART(4, A1, 0, B0, B1, fx, fy); SB_PART(5, A1, 1, B0, B1, fy, fx); SB_PART(6, A1, 2, B0, B1, fx, fy); SB_PART(7, A1, 3, B0, B1, fy, fx); \
    sb_combine(A0, A1, gs_, carry, hi); \
    { const bool dn_ = __all(carry < SB_DONE); if (lane == 0) flg[(it & 1) * 8 + wid] = dn_ ? 1 : 0; } \
    pack_p(A0, A1, pa0, pa1, pa2, pa3); \
    pv_d0(o, vb0 + (it & 1) * SHM_V, pa0, pa1, pa2, pa3); \
    SDRAIN(); __syncthreads(); \
    { const int* f_ = flg + (it & 1) * 8; stop = (f_[0] + f_[1] + f_[2] + f_[3] + f_[4] + f_[5] + f_[6] + f_[7]) == 8; } \
    ++it; } while (0)
#define SSTEP(BAND) do { \
    if (RING3) { if (it + 2 < NT) { DMA_K3(TILE(it + 2) * KVBLK, kn2); DMA_V3(TILE(it + 2) * KVBLK, vn2); } } \
    else if (it + 1 < NT) { DMA_K(TILE(it + 1) * KVBLK, (it + 1) & 1); DMA_V(TILE(it + 1) * KVBLK, (it + 1) & 1); } \
    bool skip = false; const int jb = JB(it); \
    if (BAND) skip = (64 * jb > wid * 32 + 31); \
    if (!skip) { \
      float bias_ = 0.f; if (MODE == 1 && !(BAND)) bias_ = ((selmask >> (it >> 2)) & 1u) ? 0.f : -INFINITY; \
      const int kb_ = RING3 ? kc : (it & 1) * SHM_K; \
      if (QREG_SOFTMAX) qkt(pA0, pA1, ka, kb_, qg, bias_); else qkt(pA0, pA1, ka, kb_, qr, bias_); \
      if (MODE == 1 && (BAND)) { _Pragma("unroll") for (int r = 0; r < 16; ++r) { const int kr = 64 * jb + crow(r, hi); if (kr > qrel) pA0[r] = -INFINITY; if (kr + 32 > qrel) pA1[r] = -INFINITY; } } \
      float alpha; softmax_tile(pA0, pA1, m_reg, l_reg, alpha); \
      if (__any(alpha < 1.f)) { if (hi == 0) al_l[r32] = alpha; asm volatile("s_waitcnt lgkmcnt(0)" ::: "memory"); \
        _Pragma("unroll") for (int d = 0; d < 4; ++d) _Pragma("unroll") for (int r = 0; r < 16; ++r) o[d][r] *= al_l[crow(r, hi)]; } \
      pack_p(pA0, pA1, pa0, pa1, pa2, pa3); \
      pv_d0(o, vb0 + (RING3 ? vc : (it & 1) * SHM_V), pa0, pa1, pa2, pa3); \
    } \
    if (RING3) { if (it + 2 < NT) asm volatile("s_waitcnt vmcnt(4)" ::: "memory"); else SDRAIN();        \
      { const int t_ = kc; kc = kn; kn = kn2; kn2 = t_; } { const int t_ = vc; vc = vn; vn = vn2; vn2 = t_; } } \
    else SDRAIN(); \
    if (RING3) { asm volatile("s_waitcnt lgkmcnt(0)" ::: "memory"); __builtin_amdgcn_s_barrier(); asm volatile("" ::: "memory"); }     \
    else __syncthreads(); \
    ++it; } while (0)
#define RESTART(BIASEXPR) do { qkt(pA0, pA1, ka, (it & 1) * SHM_K, qr, (BIASEXPR)); __syncthreads(); } while (0)
  if (MODE == 0) {
    if (PIPE_SOFTMAX) { STEP(pA0, pA1, pB0, pB1, 0, true); STEP(pB0, pB1, pA0, pA1, 0, true); STEP(pA0, pA1, pB0, pB1, 0, true); STEP(pB0, pB1, pA0, pA1, 0, false); }
    else { SSTEP(0); SSTEP(0); SSTEP(0); SSTEP(0); }
  } else if (MODE == 1) {
    if (PIPE_SOFTMAX) {
      if (NT > 4) { while (it < NT - 4) { STEP(pA0, pA1, pB0, pB1, 0, true); STEP(pB0, pB1, pA0, pA1, 0, (it + 1 < NT - 4)); }
        RESTART(0.f); }
      STEP(pA0, pA1, pB0, pB1, 1, true); STEP(pB0, pB1, pA0, pA1, 1, true); STEP(pA0, pA1, pB0, pB1, 1, true); STEP(pB0, pB1, pA0, pA1, 1, false);
    } else {
      while (it < NT - 4) SSTEP(0);
      SSTEP(1); SSTEP(1); SSTEP(1); SSTEP(1);
    }
  } else {
    STEP(pA0, pA1, pB0, pB1, 1, true); STEP(pB0, pB1, pA0, pA1, 1, true); STEP(pA0, pA1, pB0, pB1, 1, true); STEP(pB0, pB1, pA0, pA1, 1, false);
    if (NT > 4) {
      RESTART(0.f);
      bool stop = false;
      while (it + 2 < NT && !stop) { STEP_SB(pA0, pA1, pB0, pB1); STEP_SB(pB0, pB1, pA0, pA1); }
      if (!stop) { STEP_SB(pA0, pA1, pB0, pB1); STEP(pB0, pB1, pA0, pA1, 0, false); }
    }
  }
#undef RESTART
#undef STEP
#undef SSTEP
#undef STEP_SB
#undef SB_LD
#undef SB_PART
#undef JB
  if (OUT8) { if (nhb) ISSUE_UNIT(nhb + (long)nqb * (256 * 128), nhb + 8 * HSZ_, nhb + 16 * HSZ_, nt0, nt1); }
  float rli[16];
  if (MODE != 2) { if (hi == 0) li_l[r32] = l_reg; asm volatile("s_waitcnt lgkmcnt(0)" ::: "memory");
#pragma unroll
    for (int r = 0; r < 16; ++r) rli[r] = __builtin_amdgcn_rcpf(li_l[crow(r, hi)]); }
  else {
#pragma unroll
    for (int r = 0; r < 16; ++r) rli[r] = 1.f; }
  if (gain) {
#pragma unroll
    for (int r = 0; r < 16; ++r) { float s = 0.f;
#pragma unroll
      for (int d0 = 0; d0 < 4; ++d0) { o[d0][r] *= rli[r]; s += o[d0][r] * o[d0][r]; }
      s += __shfl_xor(s, 1); s += __shfl_xor(s, 2); s += __shfl_xor(s, 4); s += __shfl_xor(s, 8); s += __shfl_xor(s, 16);
      rli[r] = __builtin_amdgcn_rsqf(s * (1.0f / 128.0f) + 1e-6f); }
#pragma unroll
    for (int r = 0; r < 16; ++r)
#pragma unroll
      for (int d0 = 0; d0 < 4; ++d0) o[d0][r] *= gv[d0];
  }
  if (OUT8) {
#pragma unroll
    for (int r = 0; r < 16; ++r) { const float f = rli[r] * s8;
      const float v0 = __builtin_amdgcn_fmed3f(o[0][r] * f, -448.f, 448.f), v1 = __builtin_amdgcn_fmed3f(o[1][r] * f, -448.f, 448.f), v2 = __builtin_amdgcn_fmed3f(o[2][r] * f, -448.f, 448.f), v3 = __builtin_amdgcn_fmed3f(o[3][r] * f, -448.f, 448.f);
      int p = __builtin_amdgcn_cvt_pk_fp8_f32(v0, v1, 0, false); p = __builtin_amdgcn_cvt_pk_fp8_f32(v2, v3, p, true);
      *(unsigned*)((unsigned char*)Ob + (long)(wid * 32 + crow(r, hi)) * ldo + 4 * r32) = (unsigned)p; } }
  else { bf16* stg = (bf16*)lds + wid * 4096;
#pragma unroll
    for (int r = 0; r < 16; ++r) { const int orow = crow(r, hi);
#pragma unroll
      for (int d0 = 0; d0 < 4; ++d0) { const float v = o[d0][r] * rli[r]; unsigned u = __float_as_uint(v); u = (u + 0x7fffu + ((u >> 16) & 1u)) >> 16; stg[orow * 128 + d0 * 32 + r32] = (bf16)u; } }
    asm volatile("s_waitcnt lgkmcnt(0)" ::: "memory");
#pragma unroll
    for (int i = 0; i < 8; ++i) { const int row = i * 4 + (lane >> 4), ch = lane & 15; const u32x4 v = *(const u32x4*)(stg + row * 128 + ch * 8); *(u32x4*)(Ob + (long)(wid * 32 + row) * ldo + ch * 8) = v; } }
  __syncthreads();
#undef TILE
#undef ISSUE_UNIT
#undef DMA_K
#undef DMA_V
#undef DMA_K3
#undef DMA_V3
#undef KSLOT
#undef VSLOT
#undef SDRAIN
}
#undef KSWZ
#undef SBAR
}
#define GAS __attribute__((address_space(1)))
#define LAS __attribute__((address_space(3)))
typedef unsigned short bf16;
typedef unsigned v4u __attribute__((ext_vector_type(4)));
typedef float f32x4 __attribute__((ext_vector_type(4)));
#define LDS_WAIT() asm volatile("s_waitcnt lgkmcnt(0)" ::: "memory")
constexpr int NWAVES = 8;
constexpr int BATCH = 8, SEQ = 2048, DM = 2048, M = BATCH * SEQ, HD = 128, NH = 8;
constexpr int NQKV = 6144, FF = 5632, WX = 512, NMEM = 256, MMEM = BATCH * NMEM;
constexpr int QSB = 0, KSB = 1024, VSB = 2048, QMB = 3072, KMB = 4096, VMB = 5120;
constexpr float EPS = 1e-6f;
constexpr float QSCALE = 0.12751743082459868f;
constexpr size_t MiB = 1u << 20;
constexpr size_t WS_CTL = 0, CTL_ZERO_BYTES = 512 * 1024;
constexpr size_t WS_SSQ1 = 64 * 1024, WS_SSQ2 = 128 * 1024;
constexpr size_t WS_KSUM = 256 * 1024;
constexpr size_t WS_WIN = 1 * MiB, WS_WOUT = 25 * MiB, WS_WXQ = 33 * MiB, WS_WXKV = 35 * MiB, WS_WXO = 39 * MiB, WS_WGU = 41 * MiB, WS_WDN = 85 * MiB;
constexpr size_t WS_RA = 107 * MiB;
constexpr size_t WS_RB = 171 * MiB;
constexpr size_t WS_RC = 235 * MiB;
constexpr size_t WS_QX = 427 * MiB, WS_OX = 443 * MiB, WS_KVX = 459 * MiB, WS_MN = 463 * MiB, WS_KMEAN = 471 * MiB, WS_RINV0 = 471 * MiB  , WS_CS = 472 * MiB, WS_END = 474 * MiB;
constexpr int RING_BYTES = 131072, LDS_BYTES = 147456;
#ifndef FFN_FP8
#define FFN_FP8 1
#endif
#ifndef QK_FP8
#define QK_FP8 1
#endif
constexpr float S_X2 = 16.f, S_WGU = 32.f, S_ACT = 8.f, S_WDN = 64.f, S_XN = 16.f, S_WV = 32.f, S_WQK = 32.f, S_O = 16.f, S_WO = 32.f;
constexpr float S_OX = 16.f, S_WXO = 16.f;
#ifndef WXO_FP8
#define WXO_FP8 1
#endif
#ifndef WOUT_FP8
#define WOUT_FP8 1
#endif
constexpr size_t WS_WV8 = WS_WIN + 16 * MiB;

__device__ __forceinline__ float bf2f(unsigned short b) { return __uint_as_float((unsigned)b << 16); }
__device__ __forceinline__ unsigned f2bf(float f) { unsigned u = __builtin_bit_cast(unsigned, f); return (u + 0x7fffu + ((u >> 16) & 1u)) >> 16; }
__device__ __forceinline__ unsigned pk2(float lo, float hi) { return f2bf(lo) | (f2bf(hi) << 16); }
__device__ __forceinline__ float wave_sum(float v) {
#pragma unroll
    for (int o = 1; o < 64; o <<= 1) v += __shfl_xor(v, o);
    return v;
}
__device__ __forceinline__ float wave_max(float v) {
#pragma unroll
    for (int o = 1; o < 64; o <<= 1) v = fmaxf(v, __shfl_xor(v, o));
    return v;
}

typedef GAS unsigned gu32;
#define RLX_AGENT __ATOMIC_RELAXED, __HIP_MEMORY_SCOPE_AGENT
constexpr int CW_BAR = 4096;
constexpr int LDSCTL_OFF = RING_BYTES, MISC_OFF = LDSCTL_OFF + 320;
#define XB_TMO      128
#define XB_XCNT(j)  (256  + 64 * (j))
#define XB_XSUB(j)  (1280 + 64 * (j))
#define XB_XGEN(j)  (2304 + 64 * (j))
#define XB_TOP      3328
#define XB_TOPGEN   3392
#define XCD_BAR_WORDS 3456
#define XB_SPIN_CAP (1u << 18)

__device__ __forceinline__ unsigned xb_ld(unsigned* p)              { return __hip_atomic_load(p, __ATOMIC_RELAXED, __HIP_MEMORY_SCOPE_AGENT); }
__device__ __forceinline__ unsigned xb_add(unsigned* p, unsigned v) { return __hip_atomic_fetch_add(p, v, __ATOMIC_RELAXED, __HIP_MEMORY_SCOPE_AGENT); }
__device__ __forceinline__ unsigned xb_xcc_id() { return (unsigned)__builtin_amdgcn_s_getreg((3 << 11) | 20) & 0xFu; }
#define XB_SPIN(cond, bar) do { unsigned _sp = 0; while (cond) { __builtin_amdgcn_s_sleep(1); \
    if ((++_sp & 255u) == 0u) { if (xb_ld(&(bar)[XB_TMO])) break; if (_sp > XB_SPIN_CAP) { atomicAdd(&(bar)[XB_TMO], 1u); break; } } } } while (0)

struct XcdBarrier {
    unsigned* bar; unsigned x;
    volatile LAS unsigned* st;
};

__device__ __forceinline__ XcdBarrier xcd_barrier_post(unsigned* bar, volatile LAS unsigned* st) {
    XcdBarrier b; b.bar = bar; b.x = xb_xcc_id(); b.st = st;
    if (threadIdx.x == 0) (void)xb_add(&bar[XB_XCNT(b.x)], 1u);
    return b;
}
__device__ __forceinline__ void xcd_barrier_complete(unsigned* bar, unsigned x, unsigned& nloc, unsigned& nx) {
    const unsigned G = gridDim.x * gridDim.y * gridDim.z;
    unsigned sum, cnt, mine, sp = 0u;
    for (;;) {
        sum = 0u; cnt = 0u; mine = 0u;
#pragma unroll
        for (unsigned j = 0; j < 16; ++j) { const unsigned c = xb_ld(&bar[XB_XCNT(j)]); sum += c; cnt += (c > 0u) ? 1u : 0u; mine = (j == x) ? c : mine; }
        if (sum == G) break;
        __builtin_amdgcn_s_sleep(1);
        if ((++sp & 255u) == 0u) { if (xb_ld(&bar[XB_TMO])) break; if (sp > XB_SPIN_CAP) { atomicAdd(&bar[XB_TMO], 1u); break; } }
    }
    nloc = mine > 0u ? mine : 1u; nx = cnt > 0u ? cnt : 1u;
}

__device__ __forceinline__ void xcd_barrier(const XcdBarrier& b) {
    asm volatile("s_waitcnt vmcnt(0)" ::: "memory");
    __syncthreads();
    if (threadIdx.x == 0) {
        unsigned* bar = b.bar;
        __builtin_amdgcn_s_waitcnt(0);
        unsigned nloc = b.st[0], nx = b.st[1];
        if (nloc == 0u) { xcd_barrier_complete(bar, b.x, nloc, nx); b.st[0] = nloc; b.st[1] = nx; }
        const unsigned old = xb_add(&bar[XB_XSUB(b.x)], 1u);
        const unsigned gen = old / nloc;
        if (old + 1u == (gen + 1u) * nloc) {
            __builtin_amdgcn_fence(__ATOMIC_RELEASE, "agent");
            asm volatile("s_waitcnt vmcnt(0)" ::: "memory");
            const unsigned og = xb_add(&bar[XB_TOP], 1u);
            const unsigned tg = og / nx;
            if (og + 1u == (tg + 1u) * nx) xb_add(&bar[XB_TOPGEN], 1u);
            else XB_SPIN(xb_ld(&bar[XB_TOPGEN]) == tg, bar);
            __builtin_amdgcn_fence(__ATOMIC_ACQUIRE, "agent");
            xb_add(&bar[XB_XGEN(b.x)], 1u);
            asm volatile("s_waitcnt vmcnt(0)" ::: "memory");
        } else {
            XB_SPIN(xb_ld(&bar[XB_XGEN(b.x)]) == gen, bar);
            __builtin_amdgcn_fence(__ATOMIC_ACQUIRE, "agent");
            asm volatile("s_waitcnt vmcnt(0)" ::: "memory");
        }
    }
    __syncthreads();
}

struct Frame {
    LAS unsigned char* lds;
    int tid, lane, wave, vcu, G;
    const float *x, *mem; const int* pos;
    const float *g_mix, *w_in, *g_out_sb, *g_out_mb, *w_out, *g_xattn, *g_mem, *w_xq, *w_xkv, *w_xo, *g_ffn, *w_gu, *w_dn, *g_final;
    float* out; unsigned char* ws;
};

__device__ __forceinline__ void transpose_item(const float* W, int K, int N, bf16* WT, const float* gain, int inter, LAS float* scr, int item, int lane) {
    const int nblk = N / 32, kb = item / nblk, nb = item % nblk, k0 = 64 * kb, n0 = 32 * nb;
    int orow0 = n0;
    if (inter == 1) orow0 = (n0 < FF) ? (n0 / 128) * 256 + (n0 % 128) : ((n0 - FF) / 128) * 256 + 128 + ((n0 - FF) % 128);
    if (inter == 2) { const int reg = n0 / 1024, c = n0 % 1024; orow0 = (reg == 2) ? c : (reg == 5) ? 1024 + c : (reg < 2 ? reg : reg - 1) * 1024 + c; }
    float v[32];
#pragma unroll
    for (int i = 0; i < 32; ++i) v[i] = W[(size_t)(k0 + 2 * i + (lane >> 5)) * N + n0 + (lane & 31)];
#pragma unroll
    for (int i = 0; i < 32; ++i) { const int kk = 2 * i + (lane >> 5); float t = v[i]; if (gain) t *= gain[k0 + kk]; scr[kk * 33 + (lane & 31)] = t; }
    LDS_WAIT(); asm volatile("" ::: "memory");
    const int c = lane & 7;
#pragma unroll
    for (int j = 0; j < 4; ++j) { const int n = (lane >> 3) + 8 * j; const LAS float* s = scr + (8 * c) * 33 + n;
        v4u o; o.x = pk2(s[0 * 33], s[1 * 33]); o.y = pk2(s[2 * 33], s[3 * 33]); o.z = pk2(s[4 * 33], s[5 * 33]); o.w = pk2(s[6 * 33], s[7 * 33]);
        *(GAS v4u*)(WT + (size_t)(orow0 + n) * K + k0 + 8 * c) = o; }
    LDS_WAIT(); asm volatile("" ::: "memory");
}
__device__ __forceinline__ void transpose_item_fp8(const float* W, int K, int N, unsigned char* WT, const float* gain, int inter, float scale, LAS float* scr, int item, int lane, int kperm = 0) {
    const int nblk = N / 32, kb = item / nblk, nb = item % nblk, k0 = 64 * kb, n0 = 32 * nb;
    int orow0 = n0;
    if (inter == 1) orow0 = (n0 < FF) ? (n0 / 128) * 256 + (n0 % 128) : ((n0 - FF) / 128) * 256 + 128 + ((n0 - FF) % 128);
    if (inter == 2) { const int reg = n0 / 1024, c = n0 % 1024; orow0 = (reg == 2) ? c : (reg == 5) ? 1024 + c : (reg < 2 ? reg : reg - 1) * 1024 + c; }
    float v[32];
#pragma unroll
    for (int i = 0; i < 32; ++i) { int ks = k0 + 2 * i + (lane >> 5); if (kperm) ks = (ks & ~127) + 32 * (ks & 3) + ((ks & 127) >> 2); v[i] = W[(size_t)ks * N + n0 + (lane & 31)]; }
#pragma unroll
    for (int i = 0; i < 32; ++i) { const int kk = 2 * i + (lane >> 5); float t = v[i] * scale; if (gain) t *= gain[k0 + kk]; scr[kk * 33 + (lane & 31)] = t; }
    LDS_WAIT(); asm volatile("" ::: "memory");
    const int c = lane & 7;
#pragma unroll
    for (int j = 0; j < 4; ++j) { const int n = (lane >> 3) + 8 * j; const LAS float* s = scr + (8 * c) * 33 + n;
        pg8::u32x2 o; o.x = pg8::pk4_fp8(s[0 * 33], s[1 * 33], s[2 * 33], s[3 * 33]); o.y = pg8::pk4_fp8(s[4 * 33], s[5 * 33], s[6 * 33], s[7 * 33]);
        *(GAS pg8::u32x2*)(WT + (size_t)(orow0 + n) * K + k0 + 8 * c) = o; }
    LDS_WAIT(); asm volatile("" ::: "memory");
}
__device__ __forceinline__ void rms_row_to_bf16(const float* xrow, const float* g, bf16* orow, int lane, unsigned char* o8 = nullptr, float s8 = 1.f) {
    const GAS f32x4* xr = (const GAS f32x4*)xrow + lane; const GAS f32x4* gr = (const GAS f32x4*)g + lane;
    f32x4 v[8]; float s = 0.f;
#pragma unroll
    for (int j = 0; j < 8; ++j) { v[j] = __builtin_nontemporal_load(xr + 64 * j); s += (v[j].x * v[j].x + v[j].y * v[j].y) + (v[j].z * v[j].z + v[j].w * v[j].w); }
    const float rstd = 1.0f / sqrtf(wave_sum(s) * (1.f / DM) + EPS);
    GAS unsigned long long* ob8 = (GAS unsigned long long*)orow + lane;
#pragma unroll
    for (int j = 0; j < 8; ++j) { const f32x4 gg = gr[64 * j];
        const float a0 = v[j].x * rstd * gg.x, a1 = v[j].y * rstd * gg.y, a2 = v[j].z * rstd * gg.z, a3 = v[j].w * rstd * gg.w;
        ob8[64 * j] = (unsigned long long)pk2(a0, a1) | ((unsigned long long)pk2(a2, a3) << 32);
        if (o8) ((GAS unsigned*)o8)[64 * j + lane] = pg8::pk4_fp8(a0 * s8, a1 * s8, a2 * s8, a3 * s8); }
}
__device__ __forceinline__ void x_row_convert(const float* xrow, bf16* orow, unsigned char* o8, float s8, float* rinv, int lane) {
    const GAS f32x4* xr = (const GAS f32x4*)xrow + lane;
    f32x4 v[8]; float s = 0.f;
#pragma unroll
    for (int j = 0; j < 8; ++j) { v[j] = xr[64 * j]; s += (v[j].x * v[j].x + v[j].y * v[j].y) + (v[j].z * v[j].z + v[j].w * v[j].w); }
    const float rstd = 1.0f / sqrtf(wave_sum(s) * (1.f / DM) + EPS);
    if (lane == 0) *rinv = rstd;
    GAS unsigned long long* ob8 = (GAS unsigned long long*)orow + lane;
#pragma unroll
    for (int j = 0; j < 8; ++j) { ob8[64 * j] = (unsigned long long)pk2(v[j].x, v[j].y) | ((unsigned long long)pk2(v[j].z, v[j].w) << 32);
        ((GAS unsigned*)o8)[64 * j + lane] = pg8::pk4_fp8(v[j].x * s8, v[j].y * s8, v[j].z * s8, v[j].w * s8); }
}
__constant__ float INV_FREQ[16] = {1.000000000e+00f, 4.403665960e-01f, 1.939227432e-01f, 8.539710194e-02f, 3.760603070e-02f, 1.656043902e-02f, 7.292664610e-03f, 3.211445874e-03f,
                                   1.414213562e-03f, 6.227723788e-04f, 2.742481884e-04f, 1.207697351e-04f, 5.318296098e-05f, 2.341999971e-05f, 1.031338616e-05f, 4.541670478e-06f};

struct TItem { const float* src; unsigned char* dst; const float* gain; float scale; int N, K, fp8, kperm; };
__device__ __forceinline__ void ti_decode(TItem& t, const float* W, int K, int N, unsigned char* WT, const float* gain, int inter, float scale, int fp8, int kperm, int item) {
    const int nblk = N / 32, kb = item / nblk, nb = item % nblk, k0 = 64 * kb, n0 = 32 * nb;
    int orow0 = n0;
    if (inter == 1) orow0 = (n0 < FF) ? (n0 / 128) * 256 + (n0 % 128) : ((n0 - FF) / 128) * 256 + 128 + ((n0 - FF) % 128);
    if (inter == 2) { const int reg = n0 / 1024, c = n0 % 1024; orow0 = (reg < 2 ? reg : reg == 2 ? 2 : reg == 5 ? 3 : reg - 1) * 1024 + c; }
    const int ksrc0 = kperm ? (k0 & ~127) + ((k0 & 64) >> 2) : k0;
    t.src = W + (size_t)ksrc0 * N + n0; t.N = N; t.K = K; t.fp8 = fp8; t.kperm = kperm; t.scale = scale; t.gain = gain ? gain + k0 : nullptr;
    t.dst = WT + ((size_t)orow0 * K + k0) * (fp8 ? 1 : 2);
}
__device__ __forceinline__ void ti_load(const TItem& t, float (&v)[32], f32x4 (&g)[2], int lane) {
    const GAS float* s = (const GAS float*)t.src + (lane & 31);
#pragma unroll
    for (int i = 0; i < 32; ++i) { const int kk = 2 * i + (lane >> 5); const int ro = t.kperm ? 32 * (kk & 3) + (kk >> 2) : kk; v[i] = __builtin_nontemporal_load(s + (size_t)ro * t.N); }
    const GAS f32x4* gp = (const GAS f32x4*)((t.gain ? t.gain : t.src) + 8 * (lane & 7)); g[0] = gp[0]; g[1] = gp[1];
}
__device__ __forceinline__ void ti_finish(const TItem& t, const float (&v)[32], const f32x4 (&g)[2], LAS float* scr, int lane) {
#pragma unroll
    for (int i = 0; i < 32; ++i) scr[(2 * i + (lane >> 5)) * 33 + (lane & 31)] = v[i];
    LDS_WAIT(); asm volatile("" ::: "memory");
    const int c = lane & 7; const float sc = t.scale; const bool hg = t.gain != nullptr;
    const float g0 = hg ? g[0].x * sc : sc, g1 = hg ? g[0].y * sc : sc, g2 = hg ? g[0].z * sc : sc, g3 = hg ? g[0].w * sc : sc, g4 = hg ? g[1].x * sc : sc, g5 = hg ? g[1].y * sc : sc, g6 = hg ? g[1].z * sc : sc, g7 = hg ? g[1].w * sc : sc;
    if (t.fp8) {
#pragma unroll
        for (int j = 0; j < 4; ++j) { const int n = (lane >> 3) + 8 * j; const LAS float* s = scr + (8 * c) * 33 + n;
            pg8::u32x2 o; o.x = pg8::pk4_fp8(s[0 * 33] * g0, s[1 * 33] * g1, s[2 * 33] * g2, s[3 * 33] * g3); o.y = pg8::pk4_fp8(s[4 * 33] * g4, s[5 * 33] * g5, s[6 * 33] * g6, s[7 * 33] * g7);
            *(GAS pg8::u32x2*)(t.dst + (size_t)n * t.K + 8 * c) = o; }
    } else {
#pragma unroll
        for (int j = 0; j < 4; ++j) { const int n = (lane >> 3) + 8 * j; const LAS float* s = scr + (8 * c) * 33 + n;
            v4u o; o.x = pk2(s[0 * 33] * g0, s[1 * 33] * g1); o.y = pk2(s[2 * 33] * g2, s[3 * 33] * g3); o.z = pk2(s[4 * 33] * g4, s[5 * 33] * g5); o.w = pk2(s[6 * 33] * g6, s[7 * 33] * g7);
            *(GAS v4u*)(t.dst + ((size_t)n * t.K + 8 * c) * 2) = o; }
    }
    LDS_WAIT(); asm volatile("" ::: "memory");
}
__device__ __forceinline__ void xrow_load(const float* xrow, f32x4 (&v)[8], int lane) {
    const GAS f32x4* xr = (const GAS f32x4*)xrow + lane;
#pragma unroll
    for (int j = 0; j < 8; ++j) v[j] = __builtin_nontemporal_load(xr + 64 * j);
}
__device__ __forceinline__ void xrow_finish(const f32x4 (&v)[8], bf16* orow, unsigned char* o8, float s8, float* rinv, int lane) {
    float s = 0.f;
#pragma unroll
    for (int j = 0; j < 8; ++j) s += (v[j].x * v[j].x + v[j].y * v[j].y) + (v[j].z * v[j].z + v[j].w * v[j].w);
    const float rstd = 1.0f / sqrtf(wave_sum(s) * (1.f / DM) + EPS);
    if (lane == 0) *rinv = rstd;
    GAS unsigned long long* ob8 = (GAS unsigned long long*)orow + lane;
#pragma unroll
    for (int j = 0; j < 8; ++j) { ob8[64 * j] = (unsigned long long)pk2(v[j].x, v[j].y) | ((unsigned long long)pk2(v[j].z, v[j].w) << 32);
        ((GAS unsigned*)o8)[64 * j + lane] = pg8::pk4_fp8(v[j].x * s8, v[j].y * s8, v[j].z * s8, v[j].w * s8); }
}
__device__ __forceinline__ void p0_item(Frame& F, TItem& t, int it) {
    constexpr int I0 = (DM / 64) * (NQKV / 32), I1 = (DM / 64) * (DM / 32), I2 = (DM / 64) * (WX / 32), I3 = (DM / 64) * (2 * WX / 32), I4 = (WX / 64) * (DM / 32);
    int r = it;
    if (r < I0) { const int reg = ((r % (NQKV / 32)) * 32) / 1024;
        if (reg == 2 || reg == 5) ti_decode(t, F.w_in, DM, NQKV, F.ws + WS_WIN, F.g_mix, 2, S_WV, 1, 0, r);
        else if (QK_FP8 && reg < 2) ti_decode(t, F.w_in, DM, NQKV, F.ws + WS_WIN, F.g_mix, 2, S_WQK, 1, 0, r);
        else ti_decode(t, F.w_in, DM, NQKV, F.ws + WS_WIN, F.g_mix, 2, 1.f, 0, 0, r);
        return; } r -= I0;
    if (r < I1) { ti_decode(t, F.w_out, DM, DM, F.ws + WS_WOUT, nullptr, 0, S_WO, 1, 1, r); return; } r -= I1;
    if (r < I2) { ti_decode(t, F.w_xq, DM, WX, F.ws + WS_WXQ, F.g_xattn, 0, 1.f, 0, 0, r); return; } r -= I2;
    if (r < I3) { ti_decode(t, F.w_xkv, DM, 2 * WX, F.ws + WS_WXKV, nullptr, 0, 1.f, 0, 0, r); return; } r -= I3;
    ti_decode(t, F.w_xo, WX, DM, F.ws + WS_WXO, nullptr, 0, S_WXO, 1, 1, r);
}
__device__ __forceinline__ void p0_prologue(Frame& F) {
    LAS float* scr = (LAS float*)(F.lds + F.wave * 16384);
    const int gw = F.vcu * NWAVES + F.wave, NGW = F.G * NWAVES;
    constexpr int I0 = (DM / 64) * (NQKV / 32), I1 = (DM / 64) * (DM / 32), I2 = (DM / 64) * (WX / 32), I3 = (DM / 64) * (2 * WX / 32), I4 = (WX / 64) * (DM / 32),
                  I5 = (DM / 64) * (2 * FF / 32);
    constexpr int NITEMS = I0 + I1 + I2 + I3 + I4; (void)I5;
    {   float va[32], vb[32]; f32x4 ga[2], gb[2]; TItem ta, tb;
        int it = gw;
        if (it < NITEMS) { p0_item(F, ta, it); ti_load(ta, va, ga, F.lane);
            for (;;) {
                int itn = it + NGW; p0_item(F, tb, itn < NITEMS ? itn : it); ti_load(tb, vb, gb, F.lane);
                ti_finish(ta, va, ga, scr, F.lane); it = itn; if (it >= NITEMS) break;
                itn = it + NGW; p0_item(F, ta, itn < NITEMS ? itn : it); ti_load(ta, va, ga, F.lane);
                ti_finish(tb, vb, gb, scr, F.lane); it = itn; if (it >= NITEMS) break;
            } }
    }
    {   f32x4 va[8], vb[8];
        bf16* xb = (bf16*)(F.ws + WS_RA); unsigned char* x8 = F.ws + WS_RB; float* ri = (float*)(F.ws + WS_RINV0);
        int m = gw;
        if (m < M) { xrow_load(F.x + (size_t)m * DM, va, F.lane);
            for (;;) {
                int mn = m + NGW; xrow_load(F.x + (size_t)(mn < M ? mn : m) * DM, vb, F.lane);
                xrow_finish(va, xb + (size_t)m * DM, x8 + (size_t)m * DM, S_XN, ri + m, F.lane); m = mn; if (m >= M) break;
                mn = m + NGW; xrow_load(F.x + (size_t)(mn < M ? mn : m) * DM, va, F.lane);
                xrow_finish(vb, xb + (size_t)m * DM, x8 + (size_t)m * DM, S_XN, ri + m, F.lane); m = mn; if (m >= M) break;
            } }
    }
    for (int m = gw; m < MMEM; m += NGW) rms_row_to_bf16(F.mem + (size_t)m * DM, F.g_mem, (bf16*)(F.ws + WS_MN) + (size_t)m * DM, F.lane);
    float* cs = (float*)(F.ws + WS_CS);
    for (int e = (F.vcu * NWAVES + F.wave) * 64 + F.lane; e < M * 16; e += NGW * 64) {
        const int m = e >> 4, i = e & 15; const float ang = (float)F.pos[m] * INV_FREQ[i];
        double rev = (double)ang * 0.15915494309189535; rev -= floor(rev);
        const float a = (float)(rev * 6.283185307179586);
        cs[(size_t)m * 32 + i] = cosf(a); cs[(size_t)m * 32 + 16 + i] = sinf(a);
    }
}

__device__ __forceinline__ void ffn_item(Frame& F, TItem& t, int it) {
    constexpr int I5 = (DM / 64) * (2 * FF / 32);
    if (it < I5) ti_decode(t, F.w_gu, DM, 2 * FF, F.ws + WS_WGU, F.g_ffn, 1, S_WGU, 1, 0, it);
    else ti_decode(t, F.w_dn, FF, DM, F.ws + WS_WDN, nullptr, 0, S_WDN, 1, 0, it - I5);
}
__device__ __forceinline__ void ffn_weight_items(Frame& F, int wi, int nw) {
    LAS float* scr = (LAS float*)(F.lds + F.wave * 16384);
    constexpr int I5 = (DM / 64) * (2 * FF / 32), I6 = (FF / 64) * (DM / 32), NI = I5 + I6;
    float va[32], vb[32]; f32x4 ga[2], gb[2]; TItem ta, tb;
    int it = wi;
    if (it < NI) { ffn_item(F, ta, it); ti_load(ta, va, ga, F.lane);
        for (;;) {
            int itn = it + nw; ffn_item(F, tb, itn < NI ? itn : it); ti_load(tb, vb, gb, F.lane);
            ti_finish(ta, va, ga, scr, F.lane); it = itn; if (it >= NI) break;
            itn = it + nw; ffn_item(F, ta, itn < NI ? itn : it); ti_load(ta, va, ga, F.lane);
            ti_finish(tb, vb, gb, scr, F.lane); it = itn; if (it >= NI) break;
        } }
}

__device__ __forceinline__ void final_norm_phase(Frame& F, const bf16* src, float* dst) {
    const int gw = F.vcu * NWAVES + F.wave, NGW = F.G * NWAVES;
    for (int m = gw; m < M; m += NGW) {
        const GAS v4u* xr = (const GAS v4u*)(src + (size_t)m * DM) + F.lane; const GAS f32x4* gr = (const GAS f32x4*)F.g_final;
        v4u w[4]; float s = 0.f;
#pragma unroll
        for (int j = 0; j < 4; ++j) w[j] = xr[64 * j];
        f32x4 v[8];
#pragma unroll
        for (int j = 0; j < 4; ++j) { v[2 * j] = (f32x4){__uint_as_float(w[j].x << 16), __uint_as_float(w[j].x & 0xffff0000u), __uint_as_float(w[j].y << 16), __uint_as_float(w[j].y & 0xffff0000u)};
            v[2 * j + 1] = (f32x4){__uint_as_float(w[j].z << 16), __uint_as_float(w[j].z & 0xffff0000u), __uint_as_float(w[j].w << 16), __uint_as_float(w[j].w & 0xffff0000u)}; }
#pragma unroll
        for (int j = 0; j < 8; ++j) s += (v[j].x * v[j].x + v[j].y * v[j].y) + (v[j].z * v[j].z + v[j].w * v[j].w);
        const float rstd = 1.0f / sqrtf(wave_sum(s) * (1.f / DM) + EPS);
        GAS f32x4* dr = (GAS f32x4*)(dst + (size_t)m * DM);
#pragma unroll
        for (int j = 0; j < 4; ++j) { const int c4 = (64 * j + F.lane) * 2;
            dr[c4] = v[2 * j] * rstd * gr[c4]; dr[c4 + 1] = v[2 * j + 1] * rstd * gr[c4 + 1]; }
    }
}

struct RangeOrder : pg8::StaticOrder {
    int i0, n;
    __device__ __forceinline__ bool next(int i, pg8::Unit& u) const { return i < n && pg8::StaticOrder::next(i + i0, u); }
};
template <int K> __device__ __forceinline__ const void* late_arg() {
    const void* p; asm volatile("s_load_dwordx2 %0, %1, %2\n\ts_waitcnt lgkmcnt(0)" : "=s"(p) : "s"(__builtin_amdgcn_kernarg_segment_ptr()), "i"(K * 8));
    return p;
}
constexpr int NPH = 11;
#ifndef REPEAT_WHICH
#define REPEAT_WHICH 3
#endif
#ifndef NULL_EPI_PROBE
#define NULL_EPI_PROBE 0
#endif
#ifndef FOLD_KMEAN
#define FOLD_KMEAN 1
#endif
#ifndef REPEAT_PHASE
#define REPEAT_PHASE -1
#endif
#ifndef REPEAT_MASK
#define REPEAT_MASK 0
#endif
#define REPS(k) (((REPEAT_PHASE == (k)) || ((REPEAT_MASK >> (k)) & 1)) ? 2 : 1)
#ifndef USE_MFMA_SB
#define USE_MFMA_SB 1
#endif
#ifndef USE_MFMA_MOBA
#define USE_MFMA_MOBA 1
#endif
#ifndef USE_MFMA_X
#define USE_MFMA_X 1
#endif
#ifndef MK_ONE_LAUNCH
#define MK_ONE_LAUNCH 1
#endif
struct Args { const void* in[17]; float* out; unsigned char* ws; int ph_lo, ph_hi; };
__global__ void __launch_bounds__(NWAVES * 64, 2) mk_fwd(Args args) {
    extern __shared__ __attribute__((aligned(16))) unsigned char lds[];
    Frame F;
    F.lds = (LAS unsigned char*)lds;
    F.tid = threadIdx.x; F.lane = F.tid & 63; F.wave = __builtin_amdgcn_readfirstlane(F.tid >> 6);
    F.G = gridDim.x; { const int bx = blockIdx.x; F.vcu = (F.G % 8 == 0) ? (bx % 8) * (F.G / 8) + bx / 8 : bx; }
    F.x = (const float*)args.in[0]; F.mem = (const float*)args.in[1]; F.pos = (const int*)args.in[2];
    F.g_mix = (const float*)args.in[3]; F.w_in = (const float*)args.in[4]; F.g_out_sb = nullptr; F.g_out_mb = nullptr; F.w_out = (const float*)args.in[7];
    F.g_xattn = (const float*)args.in[8]; F.g_mem = (const float*)args.in[9]; F.w_xq = (const float*)args.in[10]; F.w_xkv = (const float*)args.in[11]; F.w_xo = (const float*)args.in[12];
    F.g_ffn = nullptr; F.w_gu = nullptr; F.w_dn = nullptr; F.g_final = nullptr;
    F.out = args.out; F.ws = args.ws;
    unsigned char* ws = args.ws;
    const int lo = args.ph_lo, hi = args.ph_hi;
    for (int u = F.tid; u < (LDS_BYTES - LDSCTL_OFF) / 4; u += NWAVES * 64) ((LAS unsigned*)(F.lds + LDSCTL_OFF))[u] = 0u;
    __syncthreads();
    if (hi - lo > 1) {
        { GAS v4u* z = (GAS v4u*)(ws + WS_CTL); const int n16 = (int)(CTL_ZERO_BYTES / 16);
          for (int i = (int)blockIdx.x * (NWAVES * 64) + F.tid; i < n16; i += F.G * NWAVES * 64) z[i] = (v4u){0u, 0u, 0u, 0u}; }
        cg::this_grid().sync();
    }
    XcdBarrier bar = xcd_barrier_post((unsigned*)(ws + WS_CTL) + CW_BAR, (volatile LAS unsigned*)(F.lds + MISC_OFF) + 8);
#ifndef ONLY_PHASE
#define ONLY_PHASE -1
#endif
#define IN(k) ((ONLY_PHASE < 0 || ONLY_PHASE == (k)) && lo <= (k) && (k) < hi)
#define BOTH(k) (IN(k) && IN((k) + 1))
#define GRID_BAR() xcd_barrier(bar)
    float* ssq1 = (float*)(ws + WS_SSQ1); float* ssq2 = (float*)(ws + WS_SSQ2);
    pg8::bf16_t* ACT = (pg8::bf16_t*)(ws + WS_RC + 64 * MiB);
    pg8::bf16_t* RA = (pg8::bf16_t*)(ws + WS_RA); pg8::bf16_t* RB = (pg8::bf16_t*)(ws + WS_RB); pg8::bf16_t* RC = (pg8::bf16_t*)(ws + WS_RC);

    if (IN(0)) { for (int rep = 0; rep < REPS(0); ++rep) p0_prologue(F); if (BOTH(0)) GRID_BAR(); }
    if (IN(1)) {
        static_assert(S_WQK == S_WV, "one scale for the e4m3 rows of w_in");
        pg8::Gemm g8{RB, (const pg8::bf16_t*)(ws + WS_WIN), M, 4096, DM / 2}; RangeOrder S8; S8.init(M, 4096, F.G, (int)blockIdx.x);
        pg8::EpiQKV E8{RC, (const float*)(ws + WS_CS), QSCALE, (float*)(ws + WS_KSUM), 2, 1.f, (const float*)(ws + WS_RINV0), 1.f / (S_XN * S_WQK), 0};
        pg8::Gemm gm{RA, (const pg8::bf16_t*)(ws + WS_WIN) + (size_t)2048 * DM, M, 2048, DM}; RangeOrder Sm; Sm.init(M, 2048, F.G, (int)blockIdx.x);
        pg8::EpiQKV Em{RC, (const float*)(ws + WS_CS), QSCALE, (float*)(ws + WS_KSUM), 0, 1.f, (const float*)(ws + WS_RINV0), 1.f, 8};
        for (int rep = 0; rep < REPS(1); ++rep) {
        const bool grp = ((blockIdx.x >> 3) & 1) != 0;
        S8.i0 = 0; S8.n = 1 << 20; Sm.i0 = 0; Sm.n = 1 << 20;
        if (grp) pg8::gemm_phase<pg8::EpiQKV, RangeOrder, true, true, true>(F.lds, g8, S8, E8);
        pg8::gemm_phase<pg8::EpiQKV, RangeOrder, true, true>(F.lds, gm, Sm, Em);
        if (!grp) pg8::gemm_phase<pg8::EpiQKV, RangeOrder, true, true, true>(F.lds, g8, S8, E8);
        }
        if (BOTH(1)) GRID_BAR();
    }
    if (IN(3)) {
        const att::bf16* qkv = (const att::bf16*)RC; att::bf16* ob = (att::bf16*)RB; const float* kmean = (const float*)(ws + WS_KSUM);
        F.g_out_sb = (const float*)late_arg<5>(); F.g_out_mb = (const float*)late_arg<6>();
        constexpr size_t HSZ = (size_t)SEQ * HD;
        for (int rep = 0; rep < REPS(3); ++rep) {
        if (rep == 0 || (REPEAT_WHICH & 1))
        for (int vv = F.vcu; vv < 256; vv += F.G) { const int bh = vv >> 2, s = vv & 3, b = bh >> 3, h = bh & 7; const size_t rb = (size_t)b * SEQ;
            const att::bf16* hS = qkv + ((size_t)b * 48 + h) * HSZ; const att::bf16* hM = qkv + ((size_t)b * 48 + 24 + h) * HSZ;
            for (int i = 0; i < 2; ++i) { const int qb = i ? s : 7 - s; const size_t r0 = rb + (size_t)qb * 256;
                att::attn_unit<2, true>(hS, nullptr, nullptr, (att::bf16*)((unsigned char*)ob + r0 * DM + h * HD), F.g_out_sb + h * HD, nullptr, qb, 0, (char*)lds, S_O,
                                        i != 0, i ? hM : hS, i ? 7 - s : s, i ? 0 : 4 * (s + 1) - 1, i ? -1 : 4 * (s + 1) - 2); }
            for (int i = 0; i < 2; ++i) { const int qb = i ? s : 7 - s; const size_t r0 = rb + (size_t)qb * 256;
                att::attn_unit<1, true>(hM, nullptr, nullptr, (att::bf16*)((unsigned char*)ob + r0 * DM + NH * HD + h * HD), F.g_out_mb + h * HD, kmean + (size_t)bh * 1024, qb, 0, (char*)lds, S_O,
                                        true, i ? nullptr : hM, s, 0, -1); } }
        }
        if (BOTH(3)) GRID_BAR();
    }
    if (IN(4)) {
        pg8::Gemm g{RB, (const pg8::bf16_t*)(ws + WS_WOUT), M, DM, WOUT_FP8 ? DM / 2 : DM}; pg8::StaticOrder S; S.init(M, DM, F.G, (int)blockIdx.x);
        pg8::EpiResB<false> E{RA, RC, ssq1, nullptr, 1.f, WOUT_FP8 ? 1.f / (S_O * S_WO) : 1.f};
        pg8::gemm_phase<pg8::EpiResB<false>, pg8::StaticOrder, true, true, WOUT_FP8 != 0>(F.lds, g, S, E);
        if (BOTH(4)) GRID_BAR();
    }
    if (IN(5)) {
      F.w_gu = (const float*)late_arg<14>(); F.g_ffn = (const float*)late_arg<13>(); F.w_dn = (const float*)late_arg<15>();
      for (int rep = 0; rep < REPS(5); ++rep) {
        { pg8::Gemm g{RC, (const pg8::bf16_t*)(ws + WS_WXQ), M, WX, DM}; pg8::StaticOrder S; S.init(M, WX, F.G, (int)blockIdx.x);
          pg8::EpiScale E{(pg8::bf16_t*)(ws + WS_QX), WX, ssq1, QSCALE};
          pg8::gemm_phase<pg8::EpiScale, pg8::StaticOrder, true, true>(F.lds, g, S, E); }
        { pg8::Gemm g{(const pg8::bf16_t*)(ws + WS_MN), (const pg8::bf16_t*)(ws + WS_WXKV), MMEM, 2 * WX, DM}; pg8::StaticOrder S; S.init(MMEM, 2 * WX, F.G, (int)((blockIdx.x + F.G - 128) % F.G));
          pg8::EpiScale E{(pg8::bf16_t*)(ws + WS_KVX), 2 * WX, nullptr, 1.0f};
          pg8::gemm_phase<pg8::EpiScale, pg8::StaticOrder, true, true>(F.lds, g, S, E); }
        if (F.G > 160) { if ((int)blockIdx.x >= 160) ffn_weight_items(F, ((int)blockIdx.x - 160) * NWAVES + F.wave, (F.G - 160) * NWAVES); }
        else ffn_weight_items(F, (int)blockIdx.x * NWAVES + F.wave, F.G * NWAVES);
      }
        if (BOTH(5)) GRID_BAR();
    }
    if (IN(6)) {
        const att::bf16* qx = (const att::bf16*)(ws + WS_QX); const att::bf16* kvx = (const att::bf16*)(ws + WS_KVX); att::bf16* ox = (att::bf16*)(ws + WS_OX);
        for (int rep = 0; rep < REPS(6); ++rep) {
        for (int vv = F.vcu; vv < 256; vv += F.G) { const int b = vv >> 5, h = (vv >> 3) & 3, qb = vv & 7; const size_t r0 = (size_t)b * SEQ + (size_t)qb * 256;
            if (WXO_FP8) att::attn_unit<0, true>(qx + r0 * WX + h * HD, kvx + (size_t)b * NMEM * (2 * WX) + h * HD, kvx + (size_t)b * NMEM * (2 * WX) + WX + h * HD, (att::bf16*)((unsigned char*)ox + r0 * WX + h * HD), nullptr, nullptr, qb, NMEM, (char*)lds, S_OX);
            else att::attn_unit<0>(qx + r0 * WX + h * HD, kvx + (size_t)b * NMEM * (2 * WX) + h * HD, kvx + (size_t)b * NMEM * (2 * WX) + WX + h * HD, ox + r0 * WX + h * HD, nullptr, nullptr, qb, NMEM, (char*)lds); }
        }
        if (BOTH(6)) GRID_BAR();
    }
    if (IN(7)) {
        pg8::Gemm g{(const pg8::bf16_t*)(ws + WS_OX), (const pg8::bf16_t*)(ws + WS_WXO), M, DM, WXO_FP8 ? WX / 2 : WX}; pg8::StaticOrder S; S.init(M, DM, F.G, (int)blockIdx.x);
        pg8::EpiResB<false> E{RC, RC, ssq2, (unsigned char*)RA, S_X2, WXO_FP8 ? 1.f / (S_OX * S_WXO) : 1.f};
        pg8::gemm_phase<pg8::EpiResB<false>, pg8::StaticOrder, true, true, WXO_FP8 != 0>(F.lds, g, S, E);
        if (BOTH(7)) GRID_BAR();
    }
    if (IN(8)) {
        pg8::Gemm g{RA, (const pg8::bf16_t*)(ws + WS_WGU), M, 2 * FF, FFN_FP8 ? DM / 2 : DM}; pg8::StaticOrder S; S.init(M, 2 * FF, F.G, (int)blockIdx.x);
        pg8::EpiSwiGLU E{ACT, ssq2, FFN_FP8 ? (unsigned char*)ACT : nullptr, FFN_FP8 ? 1.f / (S_X2 * S_WGU) : 1.f, S_ACT};
#if NULL_EPI_PROBE
        if (REPS(8) == 2) { pg8::EpiNull EN{nullptr}; pg8::gemm_phase<pg8::EpiNull, pg8::StaticOrder, true, true, FFN_FP8 != 0>(F.lds, g, S, EN); }
        pg8::gemm_phase<pg8::EpiSwiGLU, pg8::StaticOrder, true, true, FFN_FP8 != 0>(F.lds, g, S, E);
#else
        for (int rep = 0; rep < REPS(8); ++rep) pg8::gemm_phase<pg8::EpiSwiGLU, pg8::StaticOrder, true, true, FFN_FP8 != 0>(F.lds, g, S, E);
#endif
        if (BOTH(8)) GRID_BAR();
    }
    if (IN(9)) {
        pg8::Gemm g{ACT, (const pg8::bf16_t*)(ws + WS_WDN), M, DM, FF / 2}; pg8::StaticOrder S; S.init(M, DM, F.G, (int)blockIdx.x);
        pg8::EpiResB<false> E{RC, RC, nullptr, nullptr, 1.f, 1.f / (S_ACT * S_WDN)};
        pg8::gemm_phase<pg8::EpiResB<false>, pg8::StaticOrder, true, true, true>(F.lds, g, S, E);
        if (BOTH(9)) GRID_BAR();
    }
    if (IN(10)) { F.g_final = (const float*)late_arg<16>(); final_norm_phase(F, RC, F.out); }
#undef IN
#undef BOTH
}

extern "C" void kernel_launch(void* const* d_in, const int* in_sizes, int n_in, void* d_out, int out_size, void* d_ws, size_t ws_size, hipStream_t stream) {
    static int grid = 0;
    if (grid == 0) {
        if (n_in != 17 || in_sizes[0] != M * DM || out_size != M * DM || ws_size < WS_END) { fprintf(stderr, "kernel_launch: unexpected shapes (n_in %d in0 %d out %d ws %zu)\n", n_in, n_in > 0 ? in_sizes[0] : -1, out_size, ws_size); grid = -1; return; }
        int dev = 0, cus = 0, per_cu = 0;
        if (hipGetDevice(&dev) != hipSuccess || hipDeviceGetAttribute(&cus, hipDeviceAttributeMultiprocessorCount, dev) != hipSuccess) { grid = -1; return; }
        if (hipFuncSetAttribute((const void*)mk_fwd, hipFuncAttributeMaxDynamicSharedMemorySize, LDS_BYTES) != hipSuccess) { fprintf(stderr, "kernel_launch: hipFuncSetAttribute failed\n"); grid = -1; return; }
        if (hipOccupancyMaxActiveBlocksPerMultiprocessor(&per_cu, (const void*)mk_fwd, NWAVES * 64, LDS_BYTES) != hipSuccess || per_cu < 1) { fprintf(stderr, "kernel_launch: occupancy query failed (%d)\n", per_cu); per_cu = 1; }
        (void)hipGetLastError();
        grid = cus * (per_cu < 1 ? 1 : 1);
    }
    if (grid < 0) return;
#if !MK_ONE_LAUNCH
    (void)hipMemsetAsync((char*)d_ws + WS_CTL, 0, CTL_ZERO_BYTES, stream);
#endif
    Args a{};
    for (int i = 0; i < 17; ++i) a.in[i] = d_in[i];
    a.out = (float*)d_out; a.ws = (unsigned char*)d_ws;
#if MK_ONE_LAUNCH
    a.ph_lo = 0; a.ph_hi = NPH;
    void* kargs[] = {&a};
    hipError_t e = hipLaunchCooperativeKernel((const void*)mk_fwd, dim3(grid), dim3(NWAVES * 64), kargs, LDS_BYTES, stream);
    if (e != hipSuccess) fprintf(stderr, "kernel_launch: cooperative launch failed: %s (grid %d)\n", hipGetErrorString(e), grid);
#else
    for (int p = 0; p < NPH; ++p) { a.ph_lo = p; a.ph_hi = p + 1; hipLaunchKernelGGL(mk_fwd, dim3(grid), dim3(NWAVES * 64), LDS_BYTES, stream, a); }
    const hipError_t le = hipPeekAtLastError();
    if (le != hipSuccess) fprintf(stderr, "kernel_launch: launch failed: %s\n", hipGetErrorName(le));
#endif
}
```

```cpp
#include <hip/hip_runtime.h>
#include <hip/hip_cooperative_groups.h>
#include <cstdio>
#include <cstdint>
namespace cg = cooperative_groups;
namespace pg8 {
#define PG8_LAS __attribute__((address_space(3)))
typedef unsigned short bf16_t;
typedef short bf16x8 __attribute__((ext_vector_type(8)));
typedef float f32x4 __attribute__((ext_vector_type(4)));
typedef unsigned u32x4 __attribute__((ext_vector_type(4)));
constexpr int BM = 256, BK = 64, HALF = 128, HTB = HALF * BK * 2  , STAGE_BYTES = 8 * HTB, NXCD = 8, WGM = 8;

__host__ __device__ __forceinline__ int lds_byte(int r, int c) { const int st = (r >> 4) * 2 + (c >> 5), rr = r & 15, cc = c & 31, ob = rr * 64 + cc * 2; return st * 1024 + (ob ^ (((ob >> 9) & 1) << 5)); }
__host__ __device__ __forceinline__ void stage_rc(int b, int& R, int& C) { const int st = b / 1024, sb = b % 1024, swz = sb ^ (((sb >> 9) & 1) << 5); R = (st >> 1) * 16 + swz / 64; C = (st & 1) * 32 + (swz % 64) / 2; }
__host__ __device__ __forceinline__ int perm32(int rho) { const int n = rho >> 4, i = rho & 15; return 8 * (i >> 2) + 4 * n + (i & 3); }

struct Unit { int pm, pn; };
struct Gemm { const bf16_t* A; const bf16_t* Bt; int M, N, K; size_t bgap = 0; };

struct StaticOrder {
    int nM, nN, nwg, G, c;
    __host__ __device__ void init(int M, int N, int G_, int c_) { nM = M / BM; nN = N / BM; nwg = nM * nN; G = G_; c = c_; }
    __host__ __device__ bool next(int i, Unit& u) const {
        const long L = (long)i * G + c; if (L >= nwg) return false;
        int wgid = (int)L; { const int q = nwg / NXCD, r = nwg % NXCD, xcd = wgid % NXCD, off = wgid / NXCD; wgid = (xcd < r ? xcd * (q + 1) : r * (q + 1) + (xcd - r) * q) + off; }
        const int nig = WGM * nN, gid = wgid / nig, fm = gid * WGM, gsz = (nM - fm) < WGM ? (nM - fm) : WGM;
        u.pm = fm + ((wgid % nig) % gsz); u.pn = (wgid % nig) / gsz; return true;
    }
    __device__ __forceinline__ void a_ready(const Unit&) const {}
    __device__ __forceinline__ void done(const Unit&) const {}
};

__device__ __forceinline__ unsigned cvt_pk_bf16(float lo, float hi) { unsigned r; asm volatile("v_cvt_pk_bf16_f32 %0, %1, %2" : "=v"(r) : "v"(lo), "v"(hi)); return r; }
typedef float f32x2 __attribute__((ext_vector_type(2)));
template <class Epi, class Sched, bool ALIGN_EPI = false, bool SP2 = false, bool FP8 = false>
__device__ __forceinline__ void gemm_phase(PG8_LAS unsigned char* lds, const Gemm g, const Sched& S, const Epi& E) {
    int tid_ = threadIdx.x; asm volatile("" : "+v"(tid_));
    const int tid = tid_, wid = __builtin_amdgcn_readfirstlane(tid >> 6), lane = tid & 63, wr = wid >> 2, wc = wid & 3, fr = lane & 15, fq = lane >> 4;
    const int K = g.K, nt = K / BK;
    unsigned voffA[2], voffB[2];
#pragma unroll
    for (int i = 0; i < 2; ++i) { int R, C; stage_rc(tid * 16 + i * 8192, R, C); const int Rb = Epi::PERM ? ((R & ~31) + perm32(R & 31)) : R;
        voffA[i] = (unsigned)(R * K + C) * 2u; voffB[i] = (unsigned)(Rb * K + C) * 2u; }
    const size_t kstep = (size_t)(BK * 2);
    const size_t hstep = (size_t)HALF * K * 2;
    const size_t tstep = 2 * hstep;
    const unsigned ldsw = (unsigned)wid * 1024u;
    const int aoff = lds_byte(wr * 64 + fr, fq * 8), boff = lds_byte(wc * 32 + fr, fq * 8);
#define PG8_SA(b, h) (((b) * 2 + (h)) * HTB)
#define PG8_SB(b, h) ((4 + (b) * 2 + (h)) * HTB)
#define PG8_STAGE(bufoff, gbase, voff) do { _Pragma("unroll") for (int _i = 0; _i < 2; ++_i) \
        __builtin_amdgcn_global_load_lds((const unsigned*)((const char*)(gbase) + (voff)[_i]), (PG8_LAS unsigned*)(lds + (bufoff) + ldsw + _i * 8192), 16, 0, 0); } while (0)
#define PG8_LD8(p) __builtin_shufflevector(*(const PG8_LAS i32x4_*)(p), *(const PG8_LAS i32x4_*)((p) + 1024), 0, 1, 2, 3, 4, 5, 6, 7)
#define PG8_LDA(dst, b, h) do { if constexpr (FP8) { _Pragma("unroll") for (int m = 0; m < 4; ++m) dst##8[m] = PG8_LD8(lds + PG8_SA(b, h) + aoff + m * 2048); } \
        else { _Pragma("unroll") for (int m = 0; m < 4; ++m) _Pragma("unroll") for (int k = 0; k < 2; ++k) dst[m][k] = *(const PG8_LAS bf16x8*)(lds + PG8_SA(b, h) + aoff + m * 2048 + k * 1024); } } while (0)
#define PG8_LDB(dst, b, h) do { if constexpr (FP8) { _Pragma("unroll") for (int n = 0; n < 2; ++n) dst##8[n] = PG8_LD8(lds + PG8_SB(b, h) + boff + n * 2048); } \
        else { _Pragma("unroll") for (int n = 0; n < 2; ++n) _Pragma("unroll") for (int k = 0; k < 2; ++k) dst[n][k] = *(const PG8_LAS bf16x8*)(lds + PG8_SB(b, h) + boff + n * 2048 + k * 1024); } } while (0)
#define PG8_MMA(ai, bj, At, Bt) do { __builtin_amdgcn_s_setprio(1); _Pragma("unroll") for (int m = 0; m < 4; ++m) _Pragma("unroll") for (int n = 0; n < 2; ++n) { \
        if constexpr (FP8) asm volatile("v_mfma_f32_16x16x128_f8f6f4 %0, %1, %2, %0" : "+v"(acc[ai][bj][m][n]) : "v"(Bt##8[n]), "v"(At##8[m])); \
        else { _Pragma("unroll") for (int k = 0; k < 2; ++k) acc[ai][bj][m][n] = __builtin_amdgcn_mfma_f32_16x16x32_bf16(Bt[n][k], At[m][k], acc[ai][bj][m][n], 0, 0, 0); } } \
        __builtin_amdgcn_s_setprio(0); } while (0)
#define PG8_WAIT_V(n) asm volatile("s_waitcnt vmcnt(" #n ")" ::: "memory")
#define PG8_WAIT_L(n) asm volatile("s_waitcnt lgkmcnt(" #n ")" ::: "memory")
#define PG8_BAR __builtin_amdgcn_s_barrier()
#define PG8_SCHED __builtin_amdgcn_sched_barrier(0)
    Unit cur, nxt; int ui = 0;
    if (!S.next(0, cur)) return;
    f32x4 acc[2][2][4][2];
#pragma unroll
    for (int a = 0; a < 2; ++a)
#pragma unroll
        for (int b = 0; b < 2; ++b)
#pragma unroll
            for (int m = 0; m < 4; ++m)
#pragma unroll
                for (int n = 0; n < 2; ++n) acc[a][b][m][n] = (f32x4){0.f, 0.f, 0.f, 0.f};
    typedef int i32x4_ __attribute__((ext_vector_type(4))); typedef int i32x8_ __attribute__((ext_vector_type(8)));
    bf16x8 At[4][2], B0[2][2], B1[2][2]; i32x8_ At8[4], B08[2], B18[2];
    const char* cA = (const char*)g.A + (size_t)cur.pm * tstep + (size_t)(cur.pm >> 3) * g.bgap; const char* cB = (const char*)g.Bt + (size_t)cur.pn * tstep;
    S.a_ready(cur);
    if constexpr (SP2) {
        PG8_STAGE(PG8_SB(0, 0), cB, voffB); PG8_STAGE(PG8_SB(0, 1), cB + hstep, voffB); PG8_STAGE(PG8_SA(0, 0), cA, voffA); PG8_STAGE(PG8_SA(0, 1), cA + hstep, voffA);
        if (wr == 1) PG8_BAR;
        PG8_WAIT_V(2); PG8_BAR;
        PG8_STAGE(PG8_SB(1, 0), cB + kstep, voffB); PG8_STAGE(PG8_SA(1, 0), cA + kstep, voffA); PG8_STAGE(PG8_SB(1, 1), cB + hstep + kstep, voffB);
        PG8_WAIT_V(6); PG8_BAR;
    } else {
        PG8_STAGE(PG8_SB(0, 0), cB, voffB); PG8_STAGE(PG8_SA(0, 0), cA, voffA); PG8_STAGE(PG8_SB(0, 1), cB + hstep, voffB); PG8_STAGE(PG8_SA(0, 1), cA + hstep, voffA);
        if (wr == 1) PG8_BAR;
        PG8_WAIT_V(4); PG8_BAR;
        PG8_STAGE(PG8_SB(1, 0), cB + kstep, voffB); PG8_STAGE(PG8_SA(1, 0), cA + kstep, voffA); PG8_STAGE(PG8_SB(1, 1), cB + hstep + kstep, voffB);
        PG8_WAIT_V(6); PG8_BAR;
    }
    for (;;) {
        const bool has_next = S.next(ui + 1, nxt);
        const char* nA = has_next ? (const char*)g.A + (size_t)nxt.pm * tstep + (size_t)(nxt.pm >> 3) * g.bgap : cA; const char* nB = has_next ? (const char*)g.Bt + (size_t)nxt.pn * tstep : cB;
        for (int t = 0; t < nt; t += 2) {
            const bool last = (t == nt - 2);
            const char* a1 = cA + (size_t)(t + 1) * kstep;
            const char* a2 = last ? nA : cA + (size_t)(t + 2) * kstep; const char* b2 = last ? nB : cB + (size_t)(t + 2) * kstep;
            const char* a3 = a2 + kstep; const char* b3 = b2 + kstep;
            if (last && has_next) S.a_ready(nxt);
            if constexpr (SP2) {
            PG8_LDB(B0, 0, 0); PG8_LDB(B1, 0, 1); PG8_SCHED; PG8_LDA(At, 0, 0); PG8_STAGE(PG8_SA(1, 1), a1 + hstep, voffA);
            PG8_WAIT_V(8); PG8_WAIT_L(0); PG8_BAR; PG8_MMA(0, 0, At, B0); PG8_MMA(0, 1, At, B1); PG8_BAR; PG8_SCHED;
            PG8_LDA(At, 0, 1); PG8_STAGE(PG8_SB(0, 0), b2, voffB); PG8_STAGE(PG8_SB(0, 1), b2 + hstep, voffB); PG8_STAGE(PG8_SA(0, 0), a2, voffA);
            PG8_WAIT_V(8); PG8_WAIT_L(0); PG8_BAR; PG8_MMA(1, 0, At, B0); PG8_MMA(1, 1, At, B1); PG8_BAR; PG8_SCHED;
            PG8_LDB(B0, 1, 0); PG8_LDB(B1, 1, 1); PG8_SCHED; PG8_LDA(At, 1, 0); PG8_STAGE(PG8_SA(0, 1), a2 + hstep, voffA);
            PG8_WAIT_V(8); PG8_WAIT_L(0); PG8_BAR; PG8_MMA(0, 0, At, B0); PG8_MMA(0, 1, At, B1); PG8_BAR; PG8_SCHED;
            PG8_LDA(At, 1, 1); PG8_STAGE(PG8_SB(1, 0), b3, voffB); PG8_STAGE(PG8_SB(1, 1), b3 + hstep, voffB); PG8_STAGE(PG8_SA(1, 0), a3, voffA);
            PG8_WAIT_V(8); PG8_WAIT_L(0); PG8_BAR; PG8_MMA(1, 0, At, B0); PG8_MMA(1, 1, At, B1); PG8_BAR; PG8_SCHED;
            } else {
            PG8_LDB(B0, 0, 0); PG8_SCHED; PG8_LDA(At, 0, 0); PG8_STAGE(PG8_SA(1, 1), a1 + hstep, voffA);
            PG8_WAIT_L(8); PG8_BAR; PG8_WAIT_L(0); PG8_MMA(0, 0, At, B0); PG8_BAR; PG8_SCHED;
            PG8_LDB(B1, 0, 1); PG8_STAGE(PG8_SB(0, 0), b2, voffB);
            PG8_BAR; PG8_WAIT_L(0); PG8_MMA(0, 1, At, B1); PG8_BAR;
            PG8_LDA(At, 0, 1); PG8_STAGE(PG8_SA(0, 0), a2, voffA);
            PG8_BAR; PG8_WAIT_L(0); PG8_MMA(1, 0, At, B0); PG8_BAR; PG8_SCHED;
            PG8_STAGE(PG8_SB(0, 1), b2 + hstep, voffB);
            PG8_WAIT_V(6); PG8_BAR; PG8_MMA(1, 1, At, B1); PG8_BAR;
            PG8_LDB(B0, 1, 0); PG8_SCHED; PG8_LDA(At, 1, 0); PG8_STAGE(PG8_SA(0, 1), a2 + hstep, voffA);
            PG8_WAIT_L(8); PG8_BAR; PG8_WAIT_L(0); PG8_MMA(0, 0, At, B0); PG8_BAR; PG8_SCHED;
            PG8_LDB(B1, 1, 1); PG8_STAGE(PG8_SB(1, 0), b3, voffB);
            PG8_BAR; PG8_WAIT_L(0); PG8_MMA(0, 1, At, B1); PG8_BAR;
            PG8_LDA(At, 1, 1); PG8_STAGE(PG8_SA(1, 0), a3, voffA);
            PG8_BAR; PG8_WAIT_L(0); PG8_MMA(1, 0, At, B0); PG8_BAR; PG8_SCHED;
            PG8_STAGE(PG8_SB(1, 1), b3 + hstep, voffB);
            PG8_WAIT_V(6); PG8_BAR; PG8_MMA(1, 1, At, B1); PG8_BAR;
            }
        }
        if constexpr (ALIGN_EPI) { if (wr == 0) PG8_BAR; }
        if constexpr (FP8) asm volatile("s_nop 15\n\ts_nop 15" ::: "memory");
        if constexpr (!Epi::AFTER_DRAIN) { E(acc, cur, wr, wc, fr, fq); S.done(cur); }
        if (!has_next) break;
#pragma unroll
        for (int a = 0; a < 2; ++a)
#pragma unroll
            for (int b = 0; b < 2; ++b)
#pragma unroll
                for (int m = 0; m < 4; ++m)
#pragma unroll
                    for (int n = 0; n < 2; ++n) acc[a][b][m][n] = (f32x4){0.f, 0.f, 0.f, 0.f};
        cur = nxt; cA = nA; cB = nB; ++ui;
        if constexpr (ALIGN_EPI) { if (wr == 1) PG8_BAR; }
    }
    PG8_WAIT_V(0);
    if constexpr (!ALIGN_EPI) { if (wr == 0) PG8_BAR; }
    PG8_BAR;
    if constexpr (Epi::AFTER_DRAIN) { E.fused(acc, cur, wr, wc, fr, fq, lds, wid, lane); S.done(cur); }
#undef PG8_SA
#undef PG8_SB
#undef PG8_STAGE
#undef PG8_LDA
#undef PG8_LD8
#undef PG8_LDB
#undef PG8_MMA
#undef PG8_WAIT_V
#undef PG8_WAIT_L
#undef PG8_BAR
#undef PG8_SCHED
}
}
namespace pg8 {
typedef unsigned u32x2 __attribute__((ext_vector_type(2)));
constexpr int LDX = 2048;
constexpr float RMS_EPS = 1e-6f;
#ifndef EPI_SC1
#define EPI_SC1 1
#endif
__device__ __forceinline__ void store16(void* p, u32x4 w) {
#if EPI_SC1
    asm volatile("global_store_dwordx4 %0, %1, off sc1\n\ts_nop 1" :: "v"(p), "v"(w) : "memory");
#else
    *(u32x4*)p = w;
#endif
}
struct EpiQKV {
    static constexpr bool PERM = true, AFTER_DRAIN = false;
    bf16_t* O; const float* cs; float qscale; float* ksum; int vmode; float vscale; const float* rinv; float pre; int pnoff;
    __device__ __forceinline__ void operator()(const f32x4 (&acc)[2][2][4][2], const Unit& u, int wr, int wc, int fr, int fq) const {
        const int row0 = u.pm * BM + wr * 64 + fr, pn = vmode == 2 ? (u.pn < 12 ? u.pn : u.pn + 8) : vmode ? (u.pn < 4 ? u.pn + 8 : u.pn + 16) : (u.pn + pnoff < 8 ? u.pn + pnoff : u.pn + pnoff + 4);
        const float sc = (pn < 4 || (pn >= 12 && pn < 16)) ? qscale : vscale;
        const bool rot = (pn >= 12 && pn < 20) && (wc == 0);
        bf16_t* Ot = O + ((size_t)((u.pm >> 3) * 6 + (pn >> 2)) * 8 + (pn & 3) * 2) * (2048 * 128) + wc * 32 + 8 * fq;
        const bool kacc = (pn >= 16 && pn < 20);
        float rf[2][4];
#pragma unroll
        for (int ai = 0; ai < 2; ++ai)
#pragma unroll
            for (int m = 0; m < 4; ++m) rf[ai][m] = rinv[row0 + ai * HALF + m * 16] * pre;
        f32x4 ks[2][2] = {{{0.f, 0.f, 0.f, 0.f}, {0.f, 0.f, 0.f, 0.f}}, {{0.f, 0.f, 0.f, 0.f}, {0.f, 0.f, 0.f, 0.f}}};
#pragma unroll
        for (int ai = 0; ai < 2; ++ai)
#pragma unroll
            for (int m = 0; m < 4; ++m) { const int row = row0 + ai * HALF + m * 16; bf16_t* rowp = Ot + (size_t)(row & 2047) * 128;
                f32x4 c0 = {1.f, 1.f, 1.f, 1.f}, c1 = c0, s0 = {0.f, 0.f, 0.f, 0.f}, s1 = s0;
                if (rot) { const float* cr = cs + (size_t)row * 32 + 8 * (fq & 1); c0 = *(const f32x4*)cr; c1 = *(const f32x4*)(cr + 4); s0 = *(const f32x4*)(cr + 16); s1 = *(const f32x4*)(cr + 20);
                    if (fq < 2) { s0 = -s0; s1 = -s1; } }
#pragma unroll
                for (int bj = 0; bj < 2; ++bj) { f32x4 v0 = acc[ai][bj][m][0] * rf[ai][m], v1 = acc[ai][bj][m][1] * rf[ai][m];
                    if (rot) { f32x4 p0, p1;
#pragma unroll
                        for (int j = 0; j < 4; ++j) { p0[j] = __shfl_xor(v0[j], 32); p1[j] = __shfl_xor(v1[j], 32); }
                        v0 = v0 * c0 + p0 * s0; v1 = v1 * c1 + p1 * s1; }
                    if (kacc) { ks[bj][0] += v0; ks[bj][1] += v1; }
                    v0 = v0 * sc; v1 = v1 * sc; u32x4 w; w.x = cvt_pk_bf16(v0[0], v0[1]); w.y = cvt_pk_bf16(v0[2], v0[3]); w.z = cvt_pk_bf16(v1[0], v1[1]); w.w = cvt_pk_bf16(v1[2], v1[3]);
                    store16(rowp + (size_t)bj * (2048 * 128), w); } }
        if (kacc) {
            float* kp = ksum + (size_t)(((u.pm >> 3) * 8 + (pn - 16) * 2) * 8 + (u.pm & 7)) * 128 + wc * 32 + 8 * fq;
#pragma unroll
            for (int bj = 0; bj < 2; ++bj)
#pragma unroll
                for (int n = 0; n < 2; ++n)
#pragma unroll
                    for (int j = 0; j < 4; ++j) { float s = ks[bj][n][j]; s += __shfl_xor(s, 1); s += __shfl_xor(s, 2); s += __shfl_xor(s, 4); s += __shfl_xor(s, 8);
                        if (fr == 0) atomicAdd(kp + bj * 1024 + n * 4 + j, s); }
        }
    }
};
__device__ __forceinline__ unsigned pk4_fp8(float a, float b, float c, float d) {
    a = __builtin_amdgcn_fmed3f(a, -448.f, 448.f); b = __builtin_amdgcn_fmed3f(b, -448.f, 448.f); c = __builtin_amdgcn_fmed3f(c, -448.f, 448.f); d = __builtin_amdgcn_fmed3f(d, -448.f, 448.f);
    int p = __builtin_amdgcn_cvt_pk_fp8_f32(a, b, 0, false); p = __builtin_amdgcn_cvt_pk_fp8_f32(c, d, p, true); return (unsigned)p; }
struct EpiRes {
    static constexpr bool PERM = false, AFTER_DRAIN = false;
    const float* base; float* out; bf16_t* xb; float* ssq; unsigned char* x8; float s8; float ascale;
    __device__ __forceinline__ void operator()(const f32x4 (&acc)[2][2][4][2], const Unit& u, int wr, int wc, int fr, int fq) const {
        const int row0 = u.pm * BM + wr * 64 + fr, col0 = u.pn * BM + wc * 32 + 4 * fq;
#pragma unroll
        for (int ai = 0; ai < 2; ++ai)
#pragma unroll
            for (int m = 0; m < 4; ++m) { const int row = row0 + ai * HALF + m * 16; const size_t off = (size_t)row * LDX + col0; float s = 0.f;
#pragma unroll
                for (int bj = 0; bj < 2; ++bj)
#pragma unroll
                    for (int n = 0; n < 2; ++n) { const f32x4 v = *(const f32x4*)(base + off + bj * HALF + n * 16) + acc[ai][bj][m][n] * ascale;
                        *(f32x4*)(out + off + bj * HALF + n * 16) = v; s += (v[0] * v[0] + v[1] * v[1]) + (v[2] * v[2] + v[3] * v[3]);
                        if (xb) { u32x2 w; w.x = cvt_pk_bf16(v[0], v[1]); w.y = cvt_pk_bf16(v[2], v[3]); *(u32x2*)(xb + off + bj * HALF + n * 16) = w; }
                        if (x8) { *(unsigned*)(x8 + off + bj * HALF + n * 16) = pk4_fp8(v[0] * s8, v[1] * s8, v[2] * s8, v[3] * s8); } }
                if (ssq) { s += __shfl_xor(s, 16); s += __shfl_xor(s, 32); if (fq == 0) atomicAdd(ssq + row, s); }
                asm volatile("" ::: "memory"); }
    }
};
template <bool BASE_F32> struct EpiResB {
    static constexpr bool PERM = true, AFTER_DRAIN = false;
    const void* base; bf16_t* xo; float* ssq; unsigned char* x8; float s8; float ascale; PG8_LAS float* red;
    __device__ __forceinline__ void operator()(const f32x4 (&acc)[2][2][4][2], const Unit& u, int wr, int wc, int fr, int fq) const {
        const int row0 = u.pm * BM + wr * 64 + fr, col0 = u.pn * BM + wc * 32 + 8 * fq;
        float sred[2][4];
#pragma unroll
        for (int ai = 0; ai < 2; ++ai)
#pragma unroll
            for (int m = 0; m < 4; ++m) { const int row = row0 + ai * HALF + m * 16; const size_t off = (size_t)row * LDX + col0; float s = 0.f;
#pragma unroll
                for (int bj = 0; bj < 2; ++bj) { f32x4 b0, b1;
                    if (BASE_F32) { const float* bp = (const float*)base + off + bj * HALF; b0 = *(const f32x4*)bp; b1 = *(const f32x4*)(bp + 4); }
                    else { const u32x4 w = *(const u32x4*)((const bf16_t*)base + off + bj * HALF);
                        b0 = (f32x4){__uint_as_float(w.x << 16), __uint_as_float(w.x & 0xffff0000u), __uint_as_float(w.y << 16), __uint_as_float(w.y & 0xffff0000u)};
                        b1 = (f32x4){__uint_as_float(w.z << 16), __uint_as_float(w.z & 0xffff0000u), __uint_as_float(w.w << 16), __uint_as_float(w.w & 0xffff0000u)}; }
                    const f32x4 v0 = b0 + acc[ai][bj][m][0] * ascale, v1 = b1 + acc[ai][bj][m][1] * ascale;
                    s += ((v0[0] * v0[0] + v0[1] * v0[1]) + (v0[2] * v0[2] + v0[3] * v0[3])) + ((v1[0] * v1[0] + v1[1] * v1[1]) + (v1[2] * v1[2] + v1[3] * v1[3]));
                    if (xo) { u32x4 w; w.x = cvt_pk_bf16(v0[0], v0[1]); w.y = cvt_pk_bf16(v0[2], v0[3]); w.z = cvt_pk_bf16(v1[0], v1[1]); w.w = cvt_pk_bf16(v1[2], v1[3]); store16(xo + off + bj * HALF, w); }
                    if (x8) { u32x2 w8; w8.x = pk4_fp8(v0[0] * s8, v0[1] * s8, v0[2] * s8, v0[3] * s8); w8.y = pk4_fp8(v1[0] * s8, v1[1] * s8, v1[2] * s8, v1[3] * s8); *(u32x2*)(x8 + off + bj * HALF) = w8; } }
                if (ssq) { s += __shfl_xor(s, 16); s += __shfl_xor(s, 32); sred[ai][m] = s; }
                if (BASE_F32 ? (m & 1) : (m == 3)) asm volatile("" ::: "memory"); }
        if (ssq) {
            PG8_LAS float* r = red + (wr * 4 + wc) * 128;
            if (fq == 0) {
#pragma unroll
                for (int g = 0; g < 8; ++g) r[g * 16 + fr] = sred[g >> 2][g & 3]; }
            asm volatile("s_waitcnt lgkmcnt(0)" ::: "memory"); __builtin_amdgcn_s_barrier(); asm volatile("" ::: "memory");
            if (fq < 2) { const int g = 2 * wc + fq; const PG8_LAS float* q = red + wr * 512 + g * 16 + fr; const float t = (q[0] + q[128]) + (q[256] + q[384]);
                atomicAdd(ssq + u.pm * BM + wr * 64 + fr + (g >> 2) * HALF + (g & 3) * 16, t); }
        }
    }
};
__device__ __forceinline__ void chunk_rotate(f32x4& a0, f32x4& a1) {
#pragma unroll
    for (int j = 0; j < 4; ++j) { auto r = __builtin_amdgcn_permlane16_swap(__float_as_uint(a0[j]), __float_as_uint(a1[j]), false, false); a0[j] = __uint_as_float(r[0]); a1[j] = __uint_as_float(r[1]); }
#pragma unroll
    for (int j = 0; j < 4; ++j) { auto r = __builtin_amdgcn_permlane32_swap(__float_as_uint(a0[j]), __float_as_uint(a1[j]), false, false); a0[j] = __uint_as_float(r[0]); a1[j] = __uint_as_float(r[1]); }
}
#ifndef FINAL_SC1
#define FINAL_SC1 0
#endif
#if FINAL_SC1
#define FINAL_STORE(p_, v_) asm volatile("global_store_dwordx4 %0, %1, off sc1\n\ts_nop 1" :: "v"(p_), "v"(v_) : "memory")
#else
#define FINAL_STORE(p_, v_) (*(f32x4*)(p_) = (v_))
#endif
struct EpiResFinal {
    static constexpr bool PERM = true, AFTER_DRAIN = false;
    const bf16_t* base; float* out; float* ssq; unsigned* cnt; const float* g; float ascale; PG8_LAS float* red;
    __device__ __forceinline__ void operator()(const f32x4 (&acc)[2][2][4][2], const Unit& u, int wr, int wc, int fr, int fq) const {
        const int row0 = u.pm * BM + wr * 64 + fr, col0 = u.pn * BM + wc * 32 + 8 * fq;
        f32x4 v[2][2][4][2]; float sred[2][4];
#pragma unroll
        for (int ai = 0; ai < 2; ++ai)
#pragma unroll
            for (int m = 0; m < 4; ++m) { const size_t off = (size_t)(row0 + ai * HALF + m * 16) * LDX + col0; float s = 0.f;
#pragma unroll
                for (int bj = 0; bj < 2; ++bj) { const u32x4 w = *(const u32x4*)(base + off + bj * HALF);
                    const f32x4 b0 = (f32x4){__uint_as_float(w.x << 16), __uint_as_float(w.x & 0xffff0000u), __uint_as_float(w.y << 16), __uint_as_float(w.y & 0xffff0000u)};
                    const f32x4 b1 = (f32x4){__uint_as_float(w.z << 16), __uint_as_float(w.z & 0xffff0000u), __uint_as_float(w.w << 16), __uint_as_float(w.w & 0xffff0000u)};
                    const f32x4 v0 = b0 + acc[ai][bj][m][0] * ascale, v1 = b1 + acc[ai][bj][m][1] * ascale; v[ai][bj][m][0] = v0; v[ai][bj][m][1] = v1;
                    s += ((v0[0] * v0[0] + v0[1] * v0[1]) + (v0[2] * v0[2] + v0[3] * v0[3])) + ((v1[0] * v1[0] + v1[1] * v1[1]) + (v1[2] * v1[2] + v1[3] * v1[3])); }
                s += __shfl_xor(s, 16); s += __shfl_xor(s, 32); sred[ai][m] = s; }
        {   PG8_LAS float* r = red + (wr * 4 + wc) * 128;
            if (fq == 0) {
#pragma unroll
                for (int gi = 0; gi < 8; ++gi) r[gi * 16 + fr] = sred[gi >> 2][gi & 3]; }
            asm volatile("s_waitcnt lgkmcnt(0)" ::: "memory"); __builtin_amdgcn_s_barrier(); asm volatile("" ::: "memory");
            if (fq < 2) { const int gi = 2 * wc + fq; const PG8_LAS float* q = red + wr * 512 + gi * 16 + fr; const float t = (q[0] + q[128]) + (q[256] + q[384]);
                atomicAdd(ssq + u.pm * BM + wr * 64 + fr + (gi >> 2) * HALF + (gi & 3) * 16, t); }
        }
        asm volatile("s_waitcnt vmcnt(0)" ::: "memory"); __builtin_amdgcn_s_barrier(); asm volatile("" ::: "memory");
        if (wr == 0 && wc == 0 && fr == 0 && fq == 0) {
            __hip_atomic_fetch_add(cnt + u.pm, 1u, __ATOMIC_RELEASE, __HIP_MEMORY_SCOPE_AGENT);
            unsigned sp = 0u;
            while (__hip_atomic_load(cnt + u.pm, __ATOMIC_ACQUIRE, __HIP_MEMORY_SCOPE_AGENT) < 8u) { __builtin_amdgcn_s_sleep(1); if (++sp > (1u << 22)) break; }
        }
        __builtin_amdgcn_s_barrier(); asm volatile("" ::: "memory");
        const f32x4* gp = (const f32x4*)(g + col0);
        const f32x4 g00 = gp[0], g01 = gp[1], g10 = gp[HALF / 4], g11 = gp[HALF / 4 + 1];
#pragma unroll
        for (int ai = 0; ai < 2; ++ai)
#pragma unroll
            for (int m = 0; m < 4; ++m) { const int row = row0 + ai * HALF + m * 16;
                const float ss = __hip_atomic_load(ssq + row, __ATOMIC_RELAXED, __HIP_MEMORY_SCOPE_AGENT);
                const float rs = 1.0f / sqrtf(ss * (1.0f / 2048.0f) + RMS_EPS);
                f32x4 a0 = v[ai][0][m][0] * rs * g00, a1 = v[ai][0][m][1] * rs * g01, b0 = v[ai][1][m][0] * rs * g10, b1 = v[ai][1][m][1] * rs * g11;
                chunk_rotate(a0, a1); chunk_rotate(b0, b1);
                float* ob = out + (size_t)row * LDX + u.pn * BM + wc * 32 + 4 * fq;
                FINAL_STORE(ob, a0); FINAL_STORE(ob + 16, a1); FINAL_STORE(ob + HALF, b0); FINAL_STORE(ob + HALF + 16, b1); }
    }
};
struct EpiScale {
    static constexpr bool PERM = true, AFTER_DRAIN = false;
    bf16_t* O; int ldc; const float* ssq; float sc;
    __device__ __forceinline__ void operator()(const f32x4 (&acc)[2][2][4][2], const Unit& u, int wr, int wc, int fr, int fq) const {
        const int row0 = u.pm * BM + wr * 64 + fr, col0 = u.pn * BM + wc * 32 + 8 * fq;
        float sv[2][4];
#pragma unroll
        for (int ai = 0; ai < 2; ++ai)
#pragma unroll
            for (int m = 0; m < 4; ++m) sv[ai][m] = ssq ? ssq[row0 + ai * HALF + m * 16] : 0.f;
#pragma unroll
        for (int ai = 0; ai < 2; ++ai)
#pragma unroll
            for (int m = 0; m < 4; ++m) { const int row = row0 + ai * HALF + m * 16; bf16_t* rowp = O + (size_t)row * ldc + col0;
                const float f = ssq ? sc * __builtin_amdgcn_rsqf(sv[ai][m] * (1.0f / 2048.0f) + RMS_EPS) : sc;
#pragma unroll
                for (int bj = 0; bj < 2; ++bj) { const f32x4 v0 = acc[ai][bj][m][0] * f, v1 = acc[ai][bj][m][1] * f;
                    u32x4 w; w.x = cvt_pk_bf16(v0[0], v0[1]); w.y = cvt_pk_bf16(v0[2], v0[3]); w.z = cvt_pk_bf16(v1[0], v1[1]); w.w = cvt_pk_bf16(v1[2], v1[3]);
                    store16(rowp + bj * HALF, w); } }
    }
};
struct EpiNull { static constexpr bool PERM = true, AFTER_DRAIN = false; float* sink;
    __device__ __forceinline__ void operator()(const f32x4 (&acc)[2][2][4][2], const Unit& u, int wr, int wc, int fr, int fq) const {
#pragma unroll
        for (int ai = 0; ai < 2; ++ai)
#pragma unroll
            for (int bj = 0; bj < 2; ++bj)
#pragma unroll
                for (int m = 0; m < 4; ++m)
#pragma unroll
                    for (int n = 0; n < 2; ++n) asm volatile("" :: "v"(acc[ai][bj][m][n])); } };
struct EpiSwiGLU {
    static constexpr bool PERM = true, AFTER_DRAIN = false;
    bf16_t* O; const float* ssq; unsigned char* O8; float ascale, oscale; size_t bgap;
    __device__ __forceinline__ void operator()(const f32x4 (&acc)[2][2][4][2], const Unit& u, int wr, int wc, int fr, int fq) const {
        const int row0 = u.pm * BM + wr * 64 + fr, col0 = u.pn * HALF + wc * 32 + 8 * fq;
        float sv[2][4];
#pragma unroll
        for (int ai = 0; ai < 2; ++ai)
#pragma unroll
            for (int m = 0; m < 4; ++m) sv[ai][m] = ssq[row0 + ai * HALF + m * 16];
#pragma unroll
        for (int ai = 0; ai < 2; ++ai)
#pragma unroll
            for (int m = 0; m < 4; ++m) { const int row = row0 + ai * HALF + m * 16; bf16_t* rowp = O + (size_t)row * 5632 + col0;
                const float f = ascale * __builtin_amdgcn_rsqf(sv[ai][m] * (1.0f / 2048.0f) + RMS_EPS);
                const float fneg = -1.4426950408889634f * f, f2o = f * f * (O8 ? oscale : 1.0f);
                float r[8];
#pragma unroll
                for (int n = 0; n < 2; ++n)
#pragma unroll
                    for (int j = 0; j < 4; ++j) { const float ag = acc[ai][0][m][n][j], au = acc[ai][1][m][n][j];
                        r[n * 4 + j] = (ag * au) * (f2o * __builtin_amdgcn_rcpf(1.0f + __builtin_amdgcn_exp2f(fneg * ag))); }
                if (O8) { u32x2 w8; w8.x = pk4_fp8(r[0], r[1], r[2], r[3]); w8.y = pk4_fp8(r[4], r[5], r[6], r[7]);
                    *(u32x2*)(O8 + (size_t)(row >> 11) * bgap + (size_t)row * 5632 + col0) = w8; }
                else { u32x4 w; w.x = cvt_pk_bf16(r[0], r[1]); w.y = cvt_pk_bf16(r[2], r[3]); w.z = cvt_pk_bf16(r[4], r[5]); w.w = cvt_pk_bf16(r[6], r[7]);
                *(u32x4*)rowp = w; } }
    }
};
}
namespace att {
using bf16x8 = __attribute__((ext_vector_type(8))) short;
using s16x4  = __attribute__((ext_vector_type(4))) short;
using f32x16 = __attribute__((ext_vector_type(16))) float;
using f32x4  = __attribute__((ext_vector_type(4))) float;
using u32x4  = __attribute__((ext_vector_type(4))) unsigned;
typedef unsigned short bf16;
constexpr int D = 128, KVBLK = 64;
constexpr int SHM_V = KVBLK * D * 2, SHM_K = KVBLK * D * 2;
constexpr int OFF_Q = 2 * SHM_V + 2 * SHM_K, OFF_WS = 131072 + 1024, OFF_KM = OFF_WS + 2048, ATT_LDS = OFF_KM + 4096;
constexpr float THR = 8.f;
constexpr float SB_DONE = 7.8886e-31f;
#ifndef QREG_SOFTMAX
#define QREG_SOFTMAX 1
#endif
#ifndef PIPE_SOFTMAX
#define PIPE_SOFTMAX 0
#endif
#define KSWZ(row, colB) ((row) * 256 + ((colB) ^ (((row) & 7) << 4)))
#define SBAR() __builtin_amdgcn_sched_barrier(0)
__device__ __forceinline__ int crow(int r, int hi) { return (r & 3) + 8 * (r >> 2) + 4 * hi; }
__device__ __forceinline__ unsigned cvtpk(float lo, float hi) { unsigned r; asm volatile("v_cvt_pk_bf16_f32 %0, %1, %2" : "=v"(r) : "v"(lo), "v"(hi)); return r; }
__device__ __forceinline__ float xchg32(float x, int hi) { auto rr = __builtin_amdgcn_permlane32_swap(__float_as_uint(x), __float_as_uint(x), false, false); return __uint_as_float(hi ? rr[0] : rr[1]); }
typedef __attribute__((address_space(3))) const char* lds_cp;
template <int D0> __device__ __forceinline__ void qkt_part(f32x16& p0, f32x16& p1, const lds_cp (&ka)[2][4], int boff, const lds_cp (&qa)[2][4]) {
  const bf16x8 qf = *reinterpret_cast<const __attribute__((address_space(3))) bf16x8*>(qa[D0 >> 2][D0 & 3]);
  const bf16x8 b0 = *reinterpret_cast<const __attribute__((address_space(3))) bf16x8*>(ka[D0 >> 2][D0 & 3] + boff);
  const bf16x8 b1 = *reinterpret_cast<const __attribute__((address_space(3))) bf16x8*>(ka[D0 >> 2][D0 & 3] + boff + 8192);
  p0 = __builtin_amdgcn_mfma_f32_32x32x16_bf16(b0, qf, p0, 0, 0, 0);
  p1 = __builtin_amdgcn_mfma_f32_32x32x16_bf16(b1, qf, p1, 0, 0, 0);
}
template <int D0> __device__ __forceinline__ void qkt_part(f32x16& p0, f32x16& p1, const lds_cp (&ka)[2][4], int boff, const bf16x8 (&qg)[8]) {
  const bf16x8 b0 = *reinterpret_cast<const __attribute__((address_space(3))) bf16x8*>(ka[D0 >> 2][D0 & 3] + boff);
  const bf16x8 b1 = *reinterpret_cast<const __attribute__((address_space(3))) bf16x8*>(ka[D0 >> 2][D0 & 3] + boff + 8192);
  p0 = __builtin_amdgcn_mfma_f32_32x32x16_bf16(b0, qg[D0], p0, 0, 0, 0);
  p1 = __builtin_amdgcn_mfma_f32_32x32x16_bf16(b1, qg[D0], p1, 0, 0, 0);
}
#define KLD(G, A0, A1) do { A0 = *reinterpret_cast<const __attribute__((address_space(3))) bf16x8*>(ka[(G) >> 2][(G) & 3] + boff); A1 = *reinterpret_cast<const __attribute__((address_space(3))) bf16x8*>(ka[(G) >> 2][(G) & 3] + boff + 8192); } while (0)
#define KMM(G, A0, A1) do { p0 = __builtin_amdgcn_mfma_f32_32x32x16_bf16(A0, qg[G], p0, 0, 0, 0); p1 = __builtin_amdgcn_mfma_f32_32x32x16_bf16(A1, qg[G], p1, 0, 0, 0); } while (0)
__device__ __forceinline__ void qkt(f32x16& p0, f32x16& p1, const lds_cp (&ka)[2][4], int boff, const bf16x8 (&qg)[8], float bias = 0.f) {
#pragma unroll
  for (int r = 0; r < 16; ++r) { p0[r] = bias; p1[r] = bias; }
  bf16x8 a0, a1, b0, b1, c0, c1, d0, d1;
  KLD(0, a0, a1); KLD(1, b0, b1); KLD(2, c0, c1); KLD(3, d0, d1); SBAR();
  KMM(0, a0, a1); SBAR(); KLD(4, a0, a1); SBAR();
  KMM(1, b0, b1); SBAR(); KLD(5, b0, b1); SBAR();
  KMM(2, c0, c1); SBAR(); KLD(6, c0, c1); SBAR();
  KMM(3, d0, d1); SBAR(); KLD(7, d0, d1); SBAR();
  KMM(4, a0, a1); KMM(5, b0, b1); KMM(6, c0, c1); KMM(7, d0, d1);
}
#undef KLD
#undef KMM
__device__ __forceinline__ void qkt(f32x16& p0, f32x16& p1, const lds_cp (&ka)[2][4], int boff, const lds_cp (&qr)[2][4], float bias = 0.f) {
#pragma unroll
  for (int r = 0; r < 16; ++r) { p0[r] = bias; p1[r] = bias; }
  qkt_part<0>(p0, p1, ka, boff, qr); qkt_part<1>(p0, p1, ka, boff, qr); qkt_part<2>(p0, p1, ka, boff, qr); qkt_part<3>(p0, p1, ka, boff, qr);
  qkt_part<4>(p0, p1, ka, boff, qr); qkt_part<5>(p0, p1, ka, boff, qr); qkt_part<6>(p0, p1, ka, boff, qr); qkt_part<7>(p0, p1, ka, boff, qr);
}
__device__ __forceinline__ int v_st(int k, int c) { const int kk = (k & ~0xC) | ((k & 4) << 1) | ((k & 8) >> 1); return ((kk >> 3) * 4 + (c >> 5)) * 512 + ((kk & 7) * 32 + (c & 31)) * 2; }
__device__ __forceinline__ int v_rd_base(int lane) { return ((lane & 3) << 3) | (((lane >> 2) & 3) << 6) | (((lane >> 4) & 1) << 5) | (((lane >> 5) & 1) << 8); }
constexpr int v_rd_off(int d0, int ks, int half) { return d0 * 512 + ks * 4096 + half * 2048; }
template <int OFF> __device__ __forceinline__ s16x4 tr_read(int vb) { s16x4 r; asm volatile("ds_read_b64_tr_b16 %0, %1 offset:%2" : "=&v"(r) : "v"(vb), "i"(OFF) : "memory"); return r; }
struct VFrag { s16x4 l0, h0, l1, h1, l2, h2, l3, h3; };
template <int D0> __device__ __forceinline__ void v_read(VFrag& f, int vb) {
  f.l0 = tr_read<v_rd_off(D0, 0, 0)>(vb); f.h0 = tr_read<v_rd_off(D0, 0, 1)>(vb); f.l1 = tr_read<v_rd_off(D0, 1, 0)>(vb); f.h1 = tr_read<v_rd_off(D0, 1, 1)>(vb);
  f.l2 = tr_read<v_rd_off(D0, 2, 0)>(vb); f.h2 = tr_read<v_rd_off(D0, 2, 1)>(vb); f.l3 = tr_read<v_rd_off(D0, 3, 0)>(vb); f.h3 = tr_read<v_rd_off(D0, 3, 1)>(vb);
}
__device__ __forceinline__ void pv_mma(f32x16& od, const VFrag& f, bf16x8 pa0, bf16x8 pa1, bf16x8 pa2, bf16x8 pa3) {
#define PK(L, H) (bf16x8){L[0], L[1], L[2], L[3], H[0], H[1], H[2], H[3]}
  od = __builtin_amdgcn_mfma_f32_32x32x16_bf16(pa0, PK(f.l0, f.h0), od, 0, 0, 0);
  od = __builtin_amdgcn_mfma_f32_32x32x16_bf16(pa1, PK(f.l1, f.h1), od, 0, 0, 0);
  od = __builtin_amdgcn_mfma_f32_32x32x16_bf16(pa2, PK(f.l2, f.h2), od, 0, 0, 0);
  od = __builtin_amdgcn_mfma_f32_32x32x16_bf16(pa3, PK(f.l3, f.h3), od, 0, 0, 0);
#undef PK
}
__device__ __forceinline__ void pv_d0(f32x16* o, int vb, bf16x8 pa0, bf16x8 pa1, bf16x8 pa2, bf16x8 pa3) {
  VFrag fa, fb;
  v_read<0>(fa, vb);
  v_read<1>(fb, vb); asm volatile("s_waitcnt lgkmcnt(8)" ::: "memory"); SBAR(); pv_mma(o[0], fa, pa0, pa1, pa2, pa3); SBAR();
  v_read<2>(fa, vb); asm volatile("s_waitcnt lgkmcnt(8)" ::: "memory"); SBAR(); pv_mma(o[1], fb, pa0, pa1, pa2, pa3); SBAR();
  v_read<3>(fb, vb); asm volatile("s_waitcnt lgkmcnt(8)" ::: "memory"); SBAR(); pv_mma(o[2], fa, pa0, pa1, pa2, pa3); SBAR();
  asm volatile("s_waitcnt lgkmcnt(0)" ::: "memory"); SBAR(); pv_mma(o[3], fb, pa0, pa1, pa2, pa3);
}
__device__ __forceinline__ void pack_p(const f32x16& p0, const f32x16& p1, bf16x8& pa0, bf16x8& pa1, bf16x8& pa2, bf16x8& pa3) {
#define PK4(P, BASE, OUT) do { unsigned a0 = cvtpk(P[BASE + 0], P[BASE + 1]), a1 = cvtpk(P[BASE + 2], P[BASE + 3]);   \
    unsigned b0 = cvtpk(P[BASE + 4], P[BASE + 5]), b1 = cvtpk(P[BASE + 6], P[BASE + 7]);                              \
    auto r0 = __builtin_amdgcn_permlane32_swap(a0, b0, false, false); auto r1 = __builtin_amdgcn_permlane32_swap(a1, b1, false, false); \
    u32x4 w = {r0[0], r1[0], r0[1], r1[1]}; OUT = *reinterpret_cast<bf16x8*>(&w); } while (0)
  PK4(p0, 0, pa0); PK4(p0, 8, pa1); PK4(p1, 0, pa2); PK4(p1, 8, pa3);
#undef PK4
}
__device__ __forceinline__ void softmax_tile(f32x16& p0, f32x16& p1, float& m_reg, float& l_reg, float& alpha) {
  float pmax = p0[0];
#pragma unroll
  for (int r = 1; r < 16; ++r) pmax = fmaxf(pmax, p0[r]);
#pragma unroll
  for (int r = 0; r < 16; ++r) pmax = fmaxf(pmax, p1[r]);
  pmax = fmaxf(pmax, xchg32(pmax, (int)(threadIdx.x >> 5) & 1));
  if (__all(pmax - m_reg <= THR)) { alpha = 1.f; }
  else { const float mn = fmaxf(m_reg, pmax); alpha = __builtin_amdgcn_exp2f(m_reg - mn); m_reg = mn; }
  float ps = 0.f;
#pragma unroll
  for (int r = 0; r < 16; ++r) { p0[r] = __builtin_amdgcn_exp2f(p0[r] - m_reg); ps += p0[r]; }
#pragma unroll
  for (int r = 0; r < 16; ++r) { p1[r] = __builtin_amdgcn_exp2f(p1[r] - m_reg); ps += p1[r]; }
  ps += xchg32(ps, (int)(threadIdx.x >> 5) & 1);
  l_reg = l_reg * alpha + ps;
}
template <bool BAND, int I> __device__ __forceinline__ float sb_group(f32x16& P, int kb, int qrel, int hi) {
  float run = 1.f;
#pragma unroll
  for (int e = 3; e >= 0; --e) { const int r = 4 * I + e; float rr = __builtin_amdgcn_rcpf(1.0f + __builtin_amdgcn_exp2f(P[r]));
    if (BAND) rr = (kb + crow(r, hi) < qrel) ? rr : 1.f;
    P[r] = (1.0f - rr) * run; run *= rr; }
  return run;
}
__device__ __forceinline__ void sb_combine(f32x16& p0, f32x16& p1, float (&gs)[8], float& carry, int hi) {
  float acc = 1.f;
#pragma unroll
  for (int i = 7; i >= 0; --i) { const float so_i = acc; acc *= gs[i]; const float x = hi ? acc : so_i; gs[i] = carry * so_i * xchg32(x, hi); }
  carry *= acc * xchg32(acc, hi);
#pragma unroll
  for (int i = 0; i < 4; ++i)
#pragma unroll
    for (int e = 0; e < 4; ++e) { p0[4 * i + e] *= gs[i]; p1[4 * i + e] *= gs[4 + i]; }
}
template <bool BAND>
__device__ __forceinline__ void sb_tile(f32x16& p0, f32x16& p1, float& carry, int kb, int qrel, int hi) {
  float gs[8];
  gs[0] = sb_group<BAND, 0>(p0, kb, qrel, hi); SBAR(); gs[1] = sb_group<BAND, 1>(p0, kb, qrel, hi); SBAR(); gs[2] = sb_group<BAND, 2>(p0, kb, qrel, hi); SBAR(); gs[3] = sb_group<BAND, 3>(p0, kb, qrel, hi); SBAR();
  gs[4] = sb_group<BAND, 0>(p1, kb + 32, qrel, hi); SBAR(); gs[5] = sb_group<BAND, 1>(p1, kb + 32, qrel, hi); SBAR(); gs[6] = sb_group<BAND, 2>(p1, kb + 32, qrel, hi); SBAR(); gs[7] = sb_group<BAND, 3>(p1, kb + 32, qrel, hi); SBAR();
  sb_combine(p0, p1, gs, carry, hi);
}

template <int MODE, bool OUT8 = false>
__device__ __forceinline__ void attn_unit(const bf16* __restrict__ Qb_or_hb, const bf16* __restrict__ Kh_in, const bf16* __restrict__ Vh_in, bf16* __restrict__ Ob,
                                          const float* __restrict__ gain, const float* __restrict__ kmean, int qb, int nkeys, char* lds, float s8 = 1.f,
                                          bool preissued = false, const bf16* __restrict__ nhb = nullptr, int nqb = 0, int nt0 = 0, int nt1 = -1) {
  constexpr int ldq = (MODE == 0) ? 512 : 128, ldk = (MODE == 0) ? 1024 : 128, ldo = (MODE == 0) ? 512 : 2048;
  constexpr long HSZ_ = 2048L * 128L;
  const bf16* __restrict__ Qb = (MODE == 0) ? Qb_or_hb : Qb_or_hb + (long)qb * (256 * 128);
  const bf16* __restrict__ Kh = (MODE == 0) ? Kh_in : Qb_or_hb + 8 * HSZ_;
  const bf16* __restrict__ Vh = (MODE == 0) ? Vh_in : Qb_or_hb + 16 * HSZ_;
  int tid_ = threadIdx.x; asm volatile("" : "+v"(tid_));
  const int tid = tid_, wid = __builtin_amdgcn_readfirstlane(tid >> 6), lane = tid & 63, r32 = lane & 31, hi = lane >> 5;
  char* V_lds = lds; char* K_lds = lds + 2 * SHM_V;
  float* ws = (float*)(lds + OFF_WS) + wid * 64; float* li_l = ws; float* al_l = ws + 32;
  float* km_l = (float*)(lds + OFF_KM);
  int* flg = (int*)(lds + OFF_KM);
  const int NT = (MODE == 0) ? nkeys / KVBLK : 4 * (qb + 1);
  const int qrel = wid * 32 + r32;
  float m_reg = -1e30f, l_reg = 0.f, carry = 1.f; f32x16 o[4] = {};
  const int vb0 = (int)(uintptr_t)V_lds + v_rd_base(lane);
  lds_cp ka[2][4];
#pragma unroll
  for (int y = 0; y < 2; ++y)
#pragma unroll
    for (int x = 0; x < 4; ++x) ka[y][x] = (lds_cp)(__attribute__((address_space(3))) char*)K_lds + r32 * 256 + 128 * (y ^ ((r32 >> 3) & 1)) + 32 * (x ^ ((r32 >> 1) & 3)) + 16 * (hi ^ (r32 & 1));
  lds_cp qr[2][4];
#pragma unroll
  for (int y = 0; y < 2; ++y)
#pragma unroll
    for (int x = 0; x < 4; ++x) qr[y][x] = ka[y][x] + (OFF_Q - 2 * SHM_V) + wid * 8192;
  long ksrc[2], vsrc[2];
#pragma unroll
  for (int i = 0; i < 2; ++i) { const int piece = wid + 8 * i;
    { const int row = piece * 4 + (lane >> 4), c = (lane & 15) ^ (row & 15); ksrc[i] = (long)row * ldk + c * 8; }
    { const int sub = piece * 2 + (lane >> 5), kk = (sub >> 2) * 8 + ((lane & 31) >> 2), k = (kk & ~0xC) | ((kk & 4) << 1) | ((kk & 8) >> 1), c = (sub & 3) * 32 + (lane & 3) * 8; vsrc[i] = (long)k * ldk + c; } }
  typedef __attribute__((address_space(3))) unsigned lds_u32;
  lds_u32* kdst = (lds_u32*)(__attribute__((address_space(3))) char*)(K_lds) + wid * 256; lds_u32* vdst = (lds_u32*)(__attribute__((address_space(3))) char*)(V_lds) + wid * 256;
#define TILE(it) ((MODE == 2) ? (NT - 1 - (it)) : (it))
#define DMA_K(k0, b) do { _Pragma("unroll") for (int i_ = 0; i_ < 2; ++i_) __builtin_amdgcn_global_load_lds((const unsigned*)(Kh + (long)(k0) * ldk + ksrc[i_]), kdst + (b) * (SHM_K / 4) + i_ * 2048, 16, 0, 0); } while (0)
#define DMA_V(k0, b) do { _Pragma("unroll") for (int i_ = 0; i_ < 2; ++i_) __builtin_amdgcn_global_load_lds((const unsigned*)(Vh + (long)(k0) * ldk + vsrc[i_]), vdst + (b) * (SHM_V / 4) + i_ * 2048, 16, 0, 0); } while (0)
#define SDRAIN() asm volatile("s_waitcnt vmcnt(0)" ::: "memory")
#define KSLOT(i_) ((i_) == 2 ? (OFF_Q - 2 * SHM_V) : (i_) * SHM_K)
#define VSLOT(i_) ((i_) == 2 ? (OFF_Q + SHM_K) : (i_) * SHM_V)
#define DMA_K3(k0, so) do { _Pragma("unroll") for (int i_ = 0; i_ < 2; ++i_) __builtin_amdgcn_global_load_lds((const unsigned*)(Kh + (long)(k0) * ldk + ksrc[i_]), kdst + (so) / 4 + i_ * 2048, 16, 0, 0); } while (0)
#define DMA_V3(k0, so) do { _Pragma("unroll") for (int i_ = 0; i_ < 2; ++i_) __builtin_amdgcn_global_load_lds((const unsigned*)(Vh + (long)(k0) * ldk + vsrc[i_]), vdst + (so) / 4 + i_ * 2048, 16, 0, 0); } while (0)
  lds_u32* qdst = (lds_u32*)(__attribute__((address_space(3))) char*)(lds + OFF_Q) + wid * 2048;
#define ISSUE_UNIT(QB_, KH_, VH_, T0_, T1_) do { \
    _Pragma("unroll") for (int i = 0; i < 8; ++i) { const int row = 4 * i + (lane >> 4), c = (lane & 15) ^ (row & 15); \
      __builtin_amdgcn_global_load_lds((const unsigned*)((QB_) + (long)(wid * 32 + row) * ldq + c * 8), qdst + i * 256, 16, 0, 0); } \
    _Pragma("unroll") for (int i_ = 0; i_ < 2; ++i_) { \
      __builtin_amdgcn_global_load_lds((const unsigned*)((KH_) + (long)((T0_) * KVBLK) * ldk + ksrc[i_]), kdst + i_ * 2048, 16, 0, 0); \
      __builtin_amdgcn_global_load_lds((const unsigned*)((VH_) + (long)((T0_) * KVBLK) * ldk + vsrc[i_]), vdst + i_ * 2048, 16, 0, 0); } \
    if ((T1_) >= 0) { _Pragma("unroll") for (int i_ = 0; i_ < 2; ++i_) __builtin_amdgcn_global_load_lds((const unsigned*)((KH_) + (long)((T1_) * KVBLK) * ldk + ksrc[i_]), kdst + (SHM_K / 4) + i_ * 2048, 16, 0, 0); } } while (0)
  if (!preissued) ISSUE_UNIT(Qb, Kh, Vh, TILE(0), ((MODE == 2 || PIPE_SOFTMAX) ? TILE(1) : -1));
  constexpr bool RING3 = (MODE != 2) && QREG_SOFTMAX && !PIPE_SOFTMAX;
  unsigned selmask = 0u;
  float gv[4] = {1.f, 1.f, 1.f, 1.f};
  if (gain) {
#pragma unroll
    for (int d0 = 0; d0 < 4; ++d0) gv[d0] = gain[d0 * 32 + r32]; }
  if (MODE == 1) { if (tid < 256) *(f32x4*)(km_l + tid * 4) = *(const f32x4*)(kmean + tid * 4); }
  SDRAIN();
  __syncthreads();
  if (MODE == 1) {
    float g[8];
#pragma unroll
    for (int n = 0; n < 8; ++n) g[n] = 0.f;
    { const int rh = (r32 >> 1) & 3, r3 = (r32 >> 3) & 1;
      const lds_cp qbase = qr[0][0] - 32 * rh - 128 * r3;
#pragma unroll 1
      for (int d0 = 0; d0 < 8; ++d0) {
        const bf16x8 qf = *reinterpret_cast<const __attribute__((address_space(3))) bf16x8*>(qbase + 32 * ((d0 & 3) ^ rh) + 128 * ((d0 >> 2) ^ r3));
        float q[8];
#pragma unroll
        for (int j = 0; j < 8; ++j) q[j] = __uint_as_float(((unsigned)(unsigned short)qf[j]) << 16);
        const float* kmp = km_l + d0 * 16 + hi * 8;
#pragma unroll
        for (int n = 0; n < 7; ++n) { const f32x4 k0v = *(const f32x4*)(kmp + n * 128), k1v = *(const f32x4*)(kmp + n * 128 + 4);
          g[n] += (q[0] * k0v[0] + q[1] * k0v[1]) + (q[2] * k0v[2] + q[3] * k0v[3]) + (q[4] * k1v[0] + q[5] * k1v[1]) + (q[6] * k1v[2] + q[7] * k1v[3]); }
      } }
#pragma unroll
    for (int n = 0; n < 7; ++n) { g[n] += xchg32(g[n], hi); if (n >= qb) g[n] = -INFINITY; }
    g[7] = -INFINITY;
#pragma unroll
    for (int n = 0; n < 7; ++n) { int cnt = 0;
#pragma unroll
      for (int mI = 0; mI < 7; ++mI) { if (mI != n) cnt += (g[mI] > g[n] || (g[mI] == g[n] && mI < n)) ? 1 : 0; }
      if (n < qb && cnt < 3) selmask |= (1u << n); }
  }
  bf16x8 qg[8];
  if (QREG_SOFTMAX && MODE != 2) {
#pragma unroll
    for (int d0 = 0; d0 < 8; ++d0) qg[d0] = *reinterpret_cast<const __attribute__((address_space(3))) bf16x8*>(qr[d0 >> 2][d0 & 3]); }
  int kc = KSLOT(0), kn = KSLOT(1), kn2 = KSLOT(2), vc = VSLOT(0), vn = VSLOT(1), vn2 = VSLOT(2);
  if (RING3) { DMA_K3(TILE(1) * KVBLK, kn); DMA_V3(TILE(1) * KVBLK, vn);
    asm volatile("s_waitcnt lgkmcnt(0)" ::: "memory"); __syncthreads(); }
  f32x16 pA0, pA1, pB0, pB1; bf16x8 pa0, pa1, pa2, pa3;
  if (MODE == 2 || PIPE_SOFTMAX) { float bias0 = 0.f; if (MODE == 1) { if (NT > 4) bias0 = (selmask & 1u) ? 0.f : -INFINITY; }
    qkt(pA0, pA1, ka, 0, qr, bias0);
    __syncthreads(); }
  int it = 0;
#define JB(i_) ((MODE == 2) ? (3 - (i_)) : ((i_) - (NT - 4)))
#define STEP(A0, A1, B0, B1, BAND, HASNEXT) do { \
    if (it + 2 < NT) DMA_K(TILE(it + 2) * KVBLK, it & 1); \
    if (it + 1 < NT) DMA_V(TILE(it + 1) * KVBLK, (it + 1) & 1); \
    bool skip = false; const int jb = JB(it); \
    if (BAND) { if (MODE == 1) skip = (64 * jb > wid * 32 + 31); if (MODE == 2) skip = (64 * jb >= wid * 32 + 31); } \
    if (MODE == 2) skip = skip || __all(carry < SB_DONE);        \
    if (HASNEXT) { float bias_ = 0.f; if (MODE == 1) { if (it + 1 < NT - 4) bias_ = ((selmask >> ((it + 1) >> 2)) & 1u) ? 0.f : -INFINITY; } \
      qkt(B0, B1, ka, ((it + 1) & 1) * SHM_K, qr, bias_); } \
    if (!skip) { \
      if (MODE == 2) { sb_tile<(BAND) != 0>(A0, A1, carry, 64 * jb, qrel, hi); } \
      else { \
        if (MODE == 1 && (BAND)) { _Pragma("unroll") for (int r = 0; r < 16; ++r) { const int kr = 64 * jb + crow(r, hi); if (kr > qrel) A0[r] = -INFINITY; if (kr + 32 > qrel) A1[r] = -INFINITY; } } \
        float alpha; softmax_tile(A0, A1, m_reg, l_reg, alpha); \
        if (__any(alpha < 1.f)) { if (hi == 0) al_l[r32] = alpha; asm volatile("s_waitcnt lgkmcnt(0)" ::: "memory"); \
          _Pragma("unroll") for (int d = 0; d < 4; ++d) _Pragma("unroll") for (int r = 0; r < 16; ++r) o[d][r] *= al_l[crow(r, hi)]; } \
      } \
      pack_p(A0, A1, pa0, pa1, pa2, pa3); \
      pv_d0(o, vb0 + (it & 1) * SHM_V, pa0, pa1, pa2, pa3); \
    } \
    SDRAIN(); __syncthreads(); ++it; } while (0)
#define SB_LD(G, F) do { F##q = *reinterpret_cast<const __attribute__((address_space(3))) bf16x8*>(qr[(G) >> 2][(G) & 3]); \
      F##0 = *reinterpret_cast<const __attribute__((address_space(3))) bf16x8*>(ka[(G) >> 2][(G) & 3] + kb_); F##1 = *reinterpret_cast<const __attribute__((address_space(3))) bf16x8*>(ka[(G) >> 2][(G) & 3] + kb_ + 8192); } while (0)
#define SB_PART(G, P, I, B0, B1, FC, FN) do { if ((G) < 7) SB_LD(((G) + 1) & 7, FN);              \
      B0 = __builtin_amdgcn_mfma_f32_32x32x16_bf16(FC##0, FC##q, B0, 0, 0, 0); B1 = __builtin_amdgcn_mfma_f32_32x32x16_bf16(FC##1, FC##q, B1, 0, 0, 0); \
      gs_[G] = sb_group<false, I>(P, 0, 0, hi); SBAR(); } while (0)
#define STEP_SB(A0, A1, B0, B1) do { \
    if (it + 2 < NT) DMA_K(TILE(it + 2) * KVBLK, it & 1); \
    DMA_V(TILE(it + 1) * KVBLK, (it + 1) & 1); \
    float gs_[8]; \
    _Pragma("unroll") for (int r = 0; r < 16; ++r) { B0[r] = 0.f; B1[r] = 0.f; } \
    const int kb_ = ((it + 1) & 1) * SHM_K; bf16x8 fx0, fx1, fxq, fy0, fy1, fyq; SB_LD(0, fx); SBAR(); \
    SB_PART(0, A0, 0, B0, B1, fx, fy); SB_PART(1, A0, 1, B0, B1, fy, fx); SB_PART(2, A0, 2, B0, B1, fx, fy); SB_PART(3, A0, 3, B0, B1, fy, fx); \
    SB_PART(4, A1, 0, B0, B1, fx, fy); SB_PART(5, A1, 1, B0, B1, fy, fx); SB_PART(6, A1, 2, B0, B1, fx, fy); SB_PART(7, A1, 3, B0, B1, fy, fx); \
    sb_combine(A0, A1, gs_, carry, hi); \
    { const bool dn_ = __all(carry < SB_DONE); if (lane == 0) flg[(it & 1) * 8 + wid] = dn_ ? 1 : 0; } \
    pack_p(A0, A1, pa0, pa1, pa2, pa3); \
    pv_d0(o, vb0 + (it & 1) * SHM_V, pa0, pa1, pa2, pa3); \
    SDRAIN(); __syncthreads(); \
    { const int* f_ = flg + (it & 1) * 8; stop = (f_[0] + f_[1] + f_[2] + f_[3] + f_[4] + f_[5] + f_[6] + f_[7]) == 8; } \
    ++it; } while (0)
#define SSTEP(BAND) do { \
    if (RING3) { if (it + 2 < NT) { DMA_K3(TILE(it + 2) * KVBLK, kn2); DMA_V3(TILE(it + 2) * KVBLK, vn2); } } \
    else if (it + 1 < NT) { DMA_K(TILE(it + 1) * KVBLK, (it + 1) & 1); DMA_V(TILE(it + 1) * KVBLK, (it + 1) & 1); } \
    bool skip = false; const int jb = JB(it); \
    if (BAND) skip = (64 * jb > wid * 32 + 31); \
    if (!skip) { \
      float bias_ = 0.f; if (MODE == 1 && !(BAND)) bias_ = ((selmask >> (it >> 2)) & 1u) ? 0.f : -INFINITY; \
      const int kb_ = RING3 ? kc : (it & 1) * SHM_K; \
      if (QREG_SOFTMAX) qkt(pA0, pA1, ka, kb_, qg, bias_); else qkt(pA0, pA1, ka, kb_, qr, bias_); \
      if (MODE == 1 && (BAND)) { _Pragma("unroll") for (int r = 0; r < 16; ++r) { const int kr = 64 * jb + crow(r, hi); if (kr > qrel) pA0[r] = -INFINITY; if (kr + 32 > qrel) pA1[r] = -INFINITY; } } \
      float alpha; softmax_tile(pA0, pA1, m_reg, l_reg, alpha); \
      if (__any(alpha < 1.f)) { if (hi == 0) al_l[r32] = alpha; asm volatile("s_waitcnt lgkmcnt(0)" ::: "memory"); \
        _Pragma("unroll") for (int d = 0; d < 4; ++d) _Pragma("unroll") for (int r = 0; r < 16; ++r) o[d][r] *= al_l[crow(r, hi)]; } \
      pack_p(pA0, pA1, pa0, pa1, pa2, pa3); \
      pv_d0(o, vb0 + (RING3 ? vc : (it & 1) * SHM_V), pa0, pa1, pa2, pa3); \
    } \
    if (RING3) { if (it + 2 < NT) asm volatile("s_waitcnt vmcnt(4)" ::: "memory"); else SDRAIN();        \
      { const int t_ = kc; kc = kn; kn = kn2; kn2 = t_; } { const int t_ = vc; vc = vn; vn = vn2; vn2 = t_; } } \
    else SDRAIN(); \
    if (RING3) { asm volatile("s_waitcnt lgkmcnt(0)" ::: "memory"); __builtin_amdgcn_s_barrier(); asm volatile("" ::: "memory"); }     \
    else __syncthreads(); \
    ++it; } while (0)
#define RESTART(BIASEXPR) do { qkt(pA0, pA1, ka, (it & 1) * SHM_K, qr, (BIASEXPR)); __syncthreads(); } while (0)
  if (MODE == 0) {
    if (PIPE_SOFTMAX) { STEP(pA0, pA1, pB0, pB1, 0, true); STEP(pB0, pB1, pA0, pA1, 0, true); STEP(pA0, pA1, pB0, pB1, 0, true); STEP(pB0, pB1, pA0, pA1, 0, false); }
    else { SSTEP(0); SSTEP(0); SSTEP(0); SSTEP(0); }
  } else if (MODE == 1) {
    if (PIPE_SOFTMAX) {
      if (NT > 4) { while (it < NT - 4) { STEP(pA0, pA1, pB0, pB1, 0, true); STEP(pB0, pB1, pA0, pA1, 0, (it + 1 < NT - 4)); }
        RESTART(0.f); }
      STEP(pA0, pA1, pB0, pB1, 1, true); STEP(pB0, pB1, pA0, pA1, 1, true); STEP(pA0, pA1, pB0, pB1, 1, true); STEP(pB0, pB1, pA0, pA1, 1, false);
    } else {
      while (it < NT - 4) SSTEP(0);
      SSTEP(1); SSTEP(1); SSTEP(1); SSTEP(1);
    }
  } else {
    STEP(pA0, pA1, pB0, pB1, 1, true); STEP(pB0, pB1, pA0, pA1, 1, true); STEP(pA0, pA1, pB0, pB1, 1, true); STEP(pB0, pB1, pA0, pA1, 1, false);
    if (NT > 4) {
      RESTART(0.f);
      bool stop = false;
      while (it + 2 < NT && !stop) { STEP_SB(pA0, pA1, pB0, pB1); STEP_SB(pB0, pB1, pA0, pA1); }
      if (!stop) { STEP_SB(pA0, pA1, pB0, pB1); STEP(pB0, pB1, pA0, pA1, 0, false); }
    }
  }
#undef RESTART
#undef STEP
#undef SSTEP
#undef STEP_SB
#undef SB_LD
#undef SB_PART
#undef JB
  if (OUT8) { if (nhb) ISSUE_UNIT(nhb + (long)nqb * (256 * 128), nhb + 8 * HSZ_, nhb + 16 * HSZ_, nt0, nt1); }
  float rli[16];
  if (MODE != 2) { if (hi == 0) li_l[r32] = l_reg; asm volatile("s_waitcnt lgkmcnt(0)" ::: "memory");
#pragma unroll
    for (int r = 0; r < 16; ++r) rli[r] = __builtin_amdgcn_rcpf(li_l[crow(r, hi)]); }
  else {
#pragma unroll
    for (int r = 0; r < 16; ++r) rli[r] = 1.f; }
  if (gain) {
#pragma unroll
    for (int r = 0; r < 16; ++r) { float s = 0.f;
#pragma unroll
      for (int d0 = 0; d0 < 4; ++d0) { o[d0][r] *= rli[r]; s += o[d0][r] * o[d0][r]; }
      s += __shfl_xor(s, 1); s += __shfl_xor(s, 2); s += __shfl_xor(s, 4); s += __shfl_xor(s, 8); s += __shfl_xor(s, 16);
      rli[r] = __builtin_amdgcn_rsqf(s * (1.0f / 128.0f) + 1e-6f); }
#pragma unroll
    for (int r = 0; r < 16; ++r)
#pragma unroll
      for (int d0 = 0; d0 < 4; ++d0) o[d0][r] *= gv[d0];
  }
  if (OUT8) {
#pragma unroll
    for (int r = 0; r < 16; ++r) { const float f = rli[r] * s8;
      const float v0 = __builtin_amdgcn_fmed3f(o[0][r] * f, -448.f, 448.f), v1 = __builtin_amdgcn_fmed3f(o[1][r] * f, -448.f, 448.f), v2 = __builtin_amdgcn_fmed3f(o[2][r] * f, -448.f, 448.f), v3 = __builtin_amdgcn_fmed3f(o[3][r] * f, -448.f, 448.f);
      int p = __builtin_amdgcn_cvt_pk_fp8_f32(v0, v1, 0, false); p = __builtin_amdgcn_cvt_pk_fp8_f32(v2, v3, p, true);
      asm volatile("global_store_dword %0, %1, off sc1" :: "v"((unsigned char*)Ob + (long)(wid * 32 + crow(r, hi)) * ldo + 4 * r32), "v"(p) : "memory"); } }
  else { bf16* stg = (bf16*)lds + wid * 4096;
#pragma unroll
    for (int r = 0; r < 16; ++r) { const int orow = crow(r, hi);
#pragma unroll
      for (int d0 = 0; d0 < 4; ++d0) { const float v = o[d0][r] * rli[r]; unsigned u = __float_as_uint(v); u = (u + 0x7fffu + ((u >> 16) & 1u)) >> 16; stg[orow * 128 + d0 * 32 + r32] = (bf16)u; } }
    asm volatile("s_waitcnt lgkmcnt(0)" ::: "memory");
#pragma unroll
    for (int i = 0; i < 8; ++i) { const int row = i * 4 + (lane >> 4), ch = lane & 15; const u32x4 v = *(const u32x4*)(stg + row * 128 + ch * 8); *(u32x4*)(Ob + (long)(wid * 32 + row) * ldo + ch * 8) = v; } }
  __syncthreads();
#undef TILE
#undef ISSUE_UNIT
#undef DMA_K
#undef DMA_V
#undef DMA_K3
#undef DMA_V3
#undef KSLOT
#undef VSLOT
#undef SDRAIN
}
#undef KSWZ
#undef SBAR
}
#define GAS __attribute__((address_space(1)))
#define LAS __attribute__((address_space(3)))
typedef unsigned short bf16;
typedef unsigned v4u __attribute__((ext_vector_type(4)));
typedef float f32x4 __attribute__((ext_vector_type(4)));
#define LDS_WAIT() asm volatile("s_waitcnt lgkmcnt(0)" ::: "memory")
constexpr int NWAVES = 8;
constexpr int BATCH = 8, SEQ = 2048, DM = 2048, M = BATCH * SEQ, HD = 128, NH = 8;
constexpr int NQKV = 6144, FF = 5632, WX = 512, NMEM = 256, MMEM = BATCH * NMEM;
constexpr int QSB = 0, KSB = 1024, VSB = 2048, QMB = 3072, KMB = 4096, VMB = 5120;
constexpr float EPS = 1e-6f;
constexpr float QSCALE = 0.12751743082459868f;
constexpr size_t MiB = 1u << 20;
constexpr size_t WS_CTL = 0, CTL_ZERO_BYTES = 512 * 1024;
constexpr size_t WS_SSQ1 = 64 * 1024, WS_SSQ2 = 128 * 1024;
constexpr size_t WS_KSUM = 256 * 1024;
constexpr size_t WS_WIN = 1 * MiB, WS_WOUT = 25 * MiB, WS_WXQ = 33 * MiB, WS_WXKV = 35 * MiB, WS_WXO = 39 * MiB, WS_WGU = 41 * MiB, WS_WDN = 85 * MiB;
constexpr size_t WS_RA = 107 * MiB;
constexpr size_t WS_RB = 171 * MiB;
constexpr size_t WS_RC = 235 * MiB;
constexpr size_t WS_QX = 427 * MiB, WS_OX = 443 * MiB, WS_KVX = 459 * MiB, WS_MN = 463 * MiB, WS_KMEAN = 471 * MiB, WS_RINV0 = 471 * MiB  , WS_CS = 472 * MiB, WS_END = 474 * MiB;
constexpr int RING_BYTES = 131072, LDS_BYTES = 147456;
#ifndef FFN_FP8
#define FFN_FP8 1
#endif
#ifndef QK_FP8
#define QK_FP8 1
#endif
constexpr float S_X2 = 16.f, S_WGU = 32.f, S_ACT = 8.f, S_WDN = 64.f, S_XN = 16.f, S_WV = 32.f, S_WQK = 32.f, S_O = 16.f, S_WO = 32.f;
constexpr float S_OX = 16.f, S_WXO = 16.f;
#ifndef WXO_FP8
#define WXO_FP8 1
#endif
#ifndef WOUT_FP8
#define WOUT_FP8 1
#endif
constexpr size_t WS_WV8 = WS_WIN + 16 * MiB;

__device__ __forceinline__ float bf2f(unsigned short b) { return __uint_as_float((unsigned)b << 16); }
__device__ __forceinline__ unsigned f2bf(float f) { unsigned u = __builtin_bit_cast(unsigned, f); return (u + 0x7fffu + ((u >> 16) & 1u)) >> 16; }
__device__ __forceinline__ unsigned pk2(float lo, float hi) { return f2bf(lo) | (f2bf(hi) << 16); }
__device__ __forceinline__ float wave_sum(float v) {
#pragma unroll
    for (int o = 1; o < 64; o <<= 1) v += __shfl_xor(v, o);
    return v;
}
__device__ __forceinline__ float wave_max(float v) {
#pragma unroll
    for (int o = 1; o < 64; o <<= 1) v = fmaxf(v, __shfl_xor(v, o));
    return v;
}

typedef GAS unsigned gu32;
#define RLX_AGENT __ATOMIC_RELAXED, __HIP_MEMORY_SCOPE_AGENT
constexpr int CW_BAR = 4096;
constexpr int LDSCTL_OFF = RING_BYTES, MISC_OFF = LDSCTL_OFF + 320;
#define XB_TMO      128
#define XB_XCNT(j)  (256  + 64 * (j))
#define XB_XSUB(j)  (1280 + 64 * (j))
#define XB_XGEN(j)  (2304 + 64 * (j))
#define XB_TOP      3328
#define XB_TOPGEN   3392
#define XCD_BAR_WORDS 3456
#define XB_SPIN_CAP (1u << 18)

__device__ __forceinline__ unsigned xb_ld(unsigned* p)              { return __hip_atomic_load(p, __ATOMIC_RELAXED, __HIP_MEMORY_SCOPE_AGENT); }
__device__ __forceinline__ unsigned xb_add(unsigned* p, unsigned v) { return __hip_atomic_fetch_add(p, v, __ATOMIC_RELAXED, __HIP_MEMORY_SCOPE_AGENT); }
__device__ __forceinline__ unsigned xb_xcc_id() { return (unsigned)__builtin_amdgcn_s_getreg((3 << 11) | 20) & 0xFu; }
#define XB_SPIN(cond, bar) do { unsigned _sp = 0; while (cond) { __builtin_amdgcn_s_sleep(1); \
    if ((++_sp & 255u) == 0u) { if (xb_ld(&(bar)[XB_TMO])) break; if (_sp > XB_SPIN_CAP) { atomicAdd(&(bar)[XB_TMO], 1u); break; } } } } while (0)

struct XcdBarrier {
    unsigned* bar; unsigned x;
    volatile LAS unsigned* st;
};

__device__ __forceinline__ XcdBarrier xcd_barrier_post(unsigned* bar, volatile LAS unsigned* st) {
    XcdBarrier b; b.bar = bar; b.x = xb_xcc_id(); b.st = st;
    if (threadIdx.x == 0) (void)xb_add(&bar[XB_XCNT(b.x)], 1u);
    return b;
}
__device__ __forceinline__ void xcd_barrier_complete(unsigned* bar, unsigned x, unsigned& nloc, unsigned& nx) {
    const unsigned G = gridDim.x * gridDim.y * gridDim.z;
    unsigned sum, cnt, mine, sp = 0u;
    for (;;) {
        sum = 0u; cnt = 0u; mine = 0u;
#pragma unroll
        for (unsigned j = 0; j < 16; ++j) { const unsigned c = xb_ld(&bar[XB_XCNT(j)]); sum += c; cnt += (c > 0u) ? 1u : 0u; mine = (j == x) ? c : mine; }
        if (sum == G) break;
        __builtin_amdgcn_s_sleep(1);
        if ((++sp & 255u) == 0u) { if (xb_ld(&bar[XB_TMO])) break; if (sp > XB_SPIN_CAP) { atomicAdd(&bar[XB_TMO], 1u); break; } }
    }
    nloc = mine > 0u ? mine : 1u; nx = cnt > 0u ? cnt : 1u;
}

__device__ __forceinline__ void xcd_barrier(const XcdBarrier& b) {
    asm volatile("s_waitcnt vmcnt(0)" ::: "memory");
    __syncthreads();
    if (threadIdx.x == 0) {
        unsigned* bar = b.bar;
        __builtin_amdgcn_s_waitcnt(0);
        unsigned nloc = b.st[0], nx = b.st[1];
        if (nloc == 0u) { xcd_barrier_complete(bar, b.x, nloc, nx); b.st[0] = nloc; b.st[1] = nx; }
        const unsigned old = xb_add(&bar[XB_XSUB(b.x)], 1u);
        const unsigned gen = old / nloc;
        if (old + 1u == (gen + 1u) * nloc) {
            __builtin_amdgcn_fence(__ATOMIC_RELEASE, "agent");
            asm volatile("s_waitcnt vmcnt(0)" ::: "memory");
            const unsigned og = xb_add(&bar[XB_TOP], 1u);
            const unsigned tg = og / nx;
            if (og + 1u == (tg + 1u) * nx) xb_add(&bar[XB_TOPGEN], 1u);
            else XB_SPIN(xb_ld(&bar[XB_TOPGEN]) == tg, bar);
            __builtin_amdgcn_fence(__ATOMIC_ACQUIRE, "agent");
            xb_add(&bar[XB_XGEN(b.x)], 1u);
            asm volatile("s_waitcnt vmcnt(0)" ::: "memory");
        } else {
            XB_SPIN(xb_ld(&bar[XB_XGEN(b.x)]) == gen, bar);
            __builtin_amdgcn_fence(__ATOMIC_ACQUIRE, "agent");
            asm volatile("s_waitcnt vmcnt(0)" ::: "memory");
        }
    }
    __syncthreads();
}

struct Frame {
    LAS unsigned char* lds;
    int tid, lane, wave, vcu, G;
    const float *x, *mem; const int* pos;
    const float *g_mix, *w_in, *g_out_sb, *g_out_mb, *w_out, *g_xattn, *g_mem, *w_xq, *w_xkv, *w_xo, *g_ffn, *w_gu, *w_dn, *g_final;
    float* out; unsigned char* ws;
};

__device__ __forceinline__ void transpose_item(const float* W, int K, int N, bf16* WT, const float* gain, int inter, LAS float* scr, int item, int lane) {
    const int nblk = N / 32, kb = item / nblk, nb = item % nblk, k0 = 64 * kb, n0 = 32 * nb;
    int orow0 = n0;
    if (inter == 1) orow0 = (n0 < FF) ? (n0 / 128) * 256 + (n0 % 128) : ((n0 - FF) / 128) * 256 + 128 + ((n0 - FF) % 128);
    if (inter == 2) { const int reg = n0 / 1024, c = n0 % 1024; orow0 = (reg == 2) ? c : (reg == 5) ? 1024 + c : (reg < 2 ? reg : reg - 1) * 1024 + c; }
    float v[32];
#pragma unroll
    for (int i = 0; i < 32; ++i) v[i] = W[(size_t)(k0 + 2 * i + (lane >> 5)) * N + n0 + (lane & 31)];
#pragma unroll
    for (int i = 0; i < 32; ++i) { const int kk = 2 * i + (lane >> 5); float t = v[i]; if (gain) t *= gain[k0 + kk]; scr[kk * 33 + (lane & 31)] = t; }
    LDS_WAIT(); asm volatile("" ::: "memory");
    const int c = lane & 7;
#pragma unroll
    for (int j = 0; j < 4; ++j) { const int n = (lane >> 3) + 8 * j; const LAS float* s = scr + (8 * c) * 33 + n;
        v4u o; o.x = pk2(s[0 * 33], s[1 * 33]); o.y = pk2(s[2 * 33], s[3 * 33]); o.z = pk2(s[4 * 33], s[5 * 33]); o.w = pk2(s[6 * 33], s[7 * 33]);
        *(GAS v4u*)(WT + (size_t)(orow0 + n) * K + k0 + 8 * c) = o; }
    LDS_WAIT(); asm volatile("" ::: "memory");
}
__device__ __forceinline__ void transpose_item_fp8(const float* W, int K, int N, unsigned char* WT, const float* gain, int inter, float scale, LAS float* scr, int item, int lane, int kperm = 0) {
    const int nblk = N / 32, kb = item / nblk, nb = item % nblk, k0 = 64 * kb, n0 = 32 * nb;
    int orow0 = n0;
    if (inter == 1) orow0 = (n0 < FF) ? (n0 / 128) * 256 + (n0 % 128) : ((n0 - FF) / 128) * 256 + 128 + ((n0 - FF) % 128);
    if (inter == 2) { const int reg = n0 / 1024, c = n0 % 1024; orow0 = (reg == 2) ? c : (reg == 5) ? 1024 + c : (reg < 2 ? reg : reg - 1) * 1024 + c; }
    float v[32];
#pragma unroll
    for (int i = 0; i < 32; ++i) { int ks = k0 + 2 * i + (lane >> 5); if (kperm) ks = (ks & ~127) + 32 * (ks & 3) + ((ks & 127) >> 2); v[i] = W[(size_t)ks * N + n0 + (lane & 31)]; }
#pragma unroll
    for (int i = 0; i < 32; ++i) { const int kk = 2 * i + (lane >> 5); float t = v[i] * scale; if (gain) t *= gain[k0 + kk]; scr[kk * 33 + (lane & 31)] = t; }
    LDS_WAIT(); asm volatile("" ::: "memory");
    const int c = lane & 7;
#pragma unroll
    for (int j = 0; j < 4; ++j) { const int n = (lane >> 3) + 8 * j; const LAS float* s = scr + (8 * c) * 33 + n;
        pg8::u32x2 o; o.x = pg8::pk4_fp8(s[0 * 33], s[1 * 33], s[2 * 33], s[3 * 33]); o.y = pg8::pk4_fp8(s[4 * 33], s[5 * 33], s[6 * 33], s[7 * 33]);
        *(GAS pg8::u32x2*)(WT + (size_t)(orow0 + n) * K + k0 + 8 * c) = o; }
    LDS_WAIT(); asm volatile("" ::: "memory");
}
__device__ __forceinline__ void rms_row_to_bf16(const float* xrow, const float* g, bf16* orow, int lane, unsigned char* o8 = nullptr, float s8 = 1.f) {
    const GAS f32x4* xr = (const GAS f32x4*)xrow + lane; const GAS f32x4* gr = (const GAS f32x4*)g + lane;
    f32x4 v[8]; float s = 0.f;
#pragma unroll
    for (int j = 0; j < 8; ++j) { v[j] = __builtin_nontemporal_load(xr + 64 * j); s += (v[j].x * v[j].x + v[j].y * v[j].y) + (v[j].z * v[j].z + v[j].w * v[j].w); }
    const float rstd = 1.0f / sqrtf(wave_sum(s) * (1.f / DM) + EPS);
    GAS unsigned long long* ob8 = (GAS unsigned long long*)orow + lane;
#pragma unroll
    for (int j = 0; j < 8; ++j) { const f32x4 gg = gr[64 * j];
        const float a0 = v[j].x * rstd * gg.x, a1 = v[j].y * rstd * gg.y, a2 = v[j].z * rstd * gg.z, a3 = v[j].w * rstd * gg.w;
        ob8[64 * j] = (unsigned long long)pk2(a0, a1) | ((unsigned long long)pk2(a2, a3) << 32);
        if (o8) ((GAS unsigned*)o8)[64 * j + lane] = pg8::pk4_fp8(a0 * s8, a1 * s8, a2 * s8, a3 * s8); }
}
__device__ __forceinline__ void x_row_convert(const float* xrow, bf16* orow, unsigned char* o8, float s8, float* rinv, int lane) {
    const GAS f32x4* xr = (const GAS f32x4*)xrow + lane;
    f32x4 v[8]; float s = 0.f;
#pragma unroll
    for (int j = 0; j < 8; ++j) { v[j] = xr[64 * j]; s += (v[j].x * v[j].x + v[j].y * v[j].y) + (v[j].z * v[j].z + v[j].w * v[j].w); }
    const float rstd = 1.0f / sqrtf(wave_sum(s) * (1.f / DM) + EPS);
    if (lane == 0) *rinv = rstd;
    GAS unsigned long long* ob8 = (GAS unsigned long long*)orow + lane;
#pragma unroll
    for (int j = 0; j < 8; ++j) { ob8[64 * j] = (unsigned long long)pk2(v[j].x, v[j].y) | ((unsigned long long)pk2(v[j].z, v[j].w) << 32);
        ((GAS unsigned*)o8)[64 * j + lane] = pg8::pk4_fp8(v[j].x * s8, v[j].y * s8, v[j].z * s8, v[j].w * s8); }
}
__constant__ float INV_FREQ[16] = {1.000000000e+00f, 4.403665960e-01f, 1.939227432e-01f, 8.539710194e-02f, 3.760603070e-02f, 1.656043902e-02f, 7.292664610e-03f, 3.211445874e-03f,
                                   1.414213562e-03f, 6.227723788e-04f, 2.742481884e-04f, 1.207697351e-04f, 5.318296098e-05f, 2.341999971e-05f, 1.031338616e-05f, 4.541670478e-06f};

struct TItem { const float* src; unsigned char* dst; const float* gain; float scale; int N, K, fp8, kperm; };
__device__ __forceinline__ void ti_decode(TItem& t, const float* W, int K, int N, unsigned char* WT, const float* gain, int inter, float scale, int fp8, int kperm, int item) {
    const int nblk = N / 32, kb = item / nblk, nb = item % nblk, k0 = 64 * kb, n0 = 32 * nb;
    int orow0 = n0;
    if (inter == 1) orow0 = (n0 < FF) ? (n0 / 128) * 256 + (n0 % 128) : ((n0 - FF) / 128) * 256 + 128 + ((n0 - FF) % 128);
    if (inter == 2) { const int reg = n0 / 1024, c = n0 % 1024; orow0 = (reg < 2 ? reg : reg == 2 ? 2 : reg == 5 ? 3 : reg - 1) * 1024 + c; }
    const int ksrc0 = kperm ? (k0 & ~127) + ((k0 & 64) >> 2) : k0;
    t.src = W + (size_t)ksrc0 * N + n0; t.N = N; t.K = K; t.fp8 = fp8; t.kperm = kperm; t.scale = scale; t.gain = gain ? gain + k0 : nullptr;
    t.dst = WT + ((size_t)orow0 * K + k0) * (fp8 ? 1 : 2);
}
__device__ __forceinline__ void ti_load(const TItem& t, float (&v)[32], f32x4 (&g)[2], int lane) {
    const GAS float* s = (const GAS float*)t.src + (lane & 31);
#pragma unroll
    for (int i = 0; i < 32; ++i) { const int kk = 2 * i + (lane >> 5); const int ro = t.kperm ? 32 * (kk & 3) + (kk >> 2) : kk; v[i] = __builtin_nontemporal_load(s + (size_t)ro * t.N); }
    const GAS f32x4* gp = (const GAS f32x4*)((t.gain ? t.gain : t.src) + 8 * (lane & 7)); g[0] = gp[0]; g[1] = gp[1];
}
__device__ __forceinline__ void ti_finish(const TItem& t, const float (&v)[32], const f32x4 (&g)[2], LAS float* scr, int lane) {
#pragma unroll
    for (int i = 0; i < 32; ++i) scr[(2 * i + (lane >> 5)) * 33 + (lane & 31)] = v[i];
    LDS_WAIT(); asm volatile("" ::: "memory");
    const int c = lane & 7; const float sc = t.scale; const bool hg = t.gain != nullptr;
    const float g0 = hg ? g[0].x * sc : sc, g1 = hg ? g[0].y * sc : sc, g2 = hg ? g[0].z * sc : sc, g3 = hg ? g[0].w * sc : sc, g4 = hg ? g[1].x * sc : sc, g5 = hg ? g[1].y * sc : sc, g6 = hg ? g[1].z * sc : sc, g7 = hg ? g[1].w * sc : sc;
    if (t.fp8) {
#pragma unroll
        for (int j = 0; j < 4; ++j) { const int n = (lane >> 3) + 8 * j; const LAS float* s = scr + (8 * c) * 33 + n;
            pg8::u32x2 o; o.x = pg8::pk4_fp8(s[0 * 33] * g0, s[1 * 33] * g1, s[2 * 33] * g2, s[3 * 33] * g3); o.y = pg8::pk4_fp8(s[4 * 33] * g4, s[5 * 33] * g5, s[6 * 33] * g6, s[7 * 33] * g7);
            *(GAS pg8::u32x2*)(t.dst + (size_t)n * t.K + 8 * c) = o; }
    } else {
#pragma unroll
        for (int j = 0; j < 4; ++j) { const int n = (lane >> 3) + 8 * j; const LAS float* s = scr + (8 * c) * 33 + n;
            v4u o; o.x = pk2(s[0 * 33] * g0, s[1 * 33] * g1); o.y = pk2(s[2 * 33] * g2, s[3 * 33] * g3); o.z = pk2(s[4 * 33] * g4, s[5 * 33] * g5); o.w = pk2(s[6 * 33] * g6, s[7 * 33] * g7);
            *(GAS v4u*)(t.dst + ((size_t)n * t.K + 8 * c) * 2) = o; }
    }
    LDS_WAIT(); asm volatile("" ::: "memory");
}
__device__ __forceinline__ void xrow_load(const float* xrow, f32x4 (&v)[8], int lane) {
    const GAS f32x4* xr = (const GAS f32x4*)xrow + lane;
#pragma unroll
    for (int j = 0; j < 8; ++j) v[j] = __builtin_nontemporal_load(xr + 64 * j);
}
__device__ __forceinline__ void xrow_finish(const f32x4 (&v)[8], bf16* orow, unsigned char* o8, float s8, float* rinv, int lane) {
    float s = 0.f;
#pragma unroll
    for (int j = 0; j < 8; ++j) s += (v[j].x * v[j].x + v[j].y * v[j].y) + (v[j].z * v[j].z + v[j].w * v[j].w);
    const float rstd = 1.0f / sqrtf(wave_sum(s) * (1.f / DM) + EPS);
    if (lane == 0) *rinv = rstd;
    GAS unsigned long long* ob8 = (GAS unsigned long long*)orow + lane;
#pragma unroll
    for (int j = 0; j < 8; ++j) { ob8[64 * j] = (unsigned long long)pk2(v[j].x, v[j].y) | ((unsigned long long)pk2(v[j].z, v[j].w) << 32);
        ((GAS unsigned*)o8)[64 * j + lane] = pg8::pk4_fp8(v[j].x * s8, v[j].y * s8, v[j].z * s8, v[j].w * s8); }
}
__device__ __forceinline__ void p0_item(Frame& F, TItem& t, int it) {
    constexpr int I0 = (DM / 64) * (NQKV / 32), I1 = (DM / 64) * (DM / 32), I2 = (DM / 64) * (WX / 32), I3 = (DM / 64) * (2 * WX / 32), I4 = (WX / 64) * (DM / 32);
    int r = it;
    if (r < I0) { const int reg = ((r % (NQKV / 32)) * 32) / 1024;
        if (reg == 2 || reg == 5) ti_decode(t, F.w_in, DM, NQKV, F.ws + WS_WIN, F.g_mix, 2, S_WV, 1, 0, r);
        else if (QK_FP8 && reg < 2) ti_decode(t, F.w_in, DM, NQKV, F.ws + WS_WIN, F.g_mix, 2, S_WQK, 1, 0, r);
        else ti_decode(t, F.w_in, DM, NQKV, F.ws + WS_WIN, F.g_mix, 2, 1.f, 0, 0, r);
        return; } r -= I0;
    if (r < I1) { ti_decode(t, F.w_out, DM, DM, F.ws + WS_WOUT, nullptr, 0, S_WO, 1, 1, r); return; } r -= I1;
    if (r < I2) { ti_decode(t, F.w_xq, DM, WX, F.ws + WS_WXQ, F.g_xattn, 0, 1.f, 0, 0, r); return; } r -= I2;
    if (r < I3) { ti_decode(t, F.w_xkv, DM, 2 * WX, F.ws + WS_WXKV, nullptr, 0, 1.f, 0, 0, r); return; } r -= I3;
    ti_decode(t, F.w_xo, WX, DM, F.ws + WS_WXO, nullptr, 0, S_WXO, 1, 1, r);
}
__device__ __forceinline__ void p0_prologue(Frame& F) {
    LAS float* scr = (LAS float*)(F.lds + F.wave * 16384);
    const int gw = F.vcu * NWAVES + F.wave, NGW = F.G * NWAVES;
    constexpr int I0 = (DM / 64) * (NQKV / 32), I1 = (DM / 64) * (DM / 32), I2 = (DM / 64) * (WX / 32), I3 = (DM / 64) * (2 * WX / 32), I4 = (WX / 64) * (DM / 32),
                  I5 = (DM / 64) * (2 * FF / 32);
    constexpr int NITEMS = I0 + I1 + I2 + I3 + I4; (void)I5;
    {   float va[32], vb[32]; f32x4 ga[2], gb[2]; TItem ta, tb;
        int it = gw;
        if (it < NITEMS) { p0_item(F, ta, it); ti_load(ta, va, ga, F.lane);
            for (;;) {
                int itn = it + NGW; p0_item(F, tb, itn < NITEMS ? itn : it); ti_load(tb, vb, gb, F.lane);
                ti_finish(ta, va, ga, scr, F.lane); it = itn; if (it >= NITEMS) break;
                itn = it + NGW; p0_item(F, ta, itn < NITEMS ? itn : it); ti_load(ta, va, ga, F.lane);
                ti_finish(tb, vb, gb, scr, F.lane); it = itn; if (it >= NITEMS) break;
            } }
    }
    {   f32x4 va[8], vb[8];
        bf16* xb = (bf16*)(F.ws + WS_RA); unsigned char* x8 = F.ws + WS_RB; float* ri = (float*)(F.ws + WS_RINV0);
        int m = gw;
        if (m < M) { xrow_load(F.x + (size_t)m * DM, va, F.lane);
            for (;;) {
                int mn = m + NGW; xrow_load(F.x + (size_t)(mn < M ? mn : m) * DM, vb, F.lane);
                xrow_finish(va, xb + (size_t)m * DM, x8 + (size_t)m * DM, S_XN, ri + m, F.lane); m = mn; if (m >= M) break;
                mn = m + NGW; xrow_load(F.x + (size_t)(mn < M ? mn : m) * DM, va, F.lane);
                xrow_finish(vb, xb + (size_t)m * DM, x8 + (size_t)m * DM, S_XN, ri + m, F.lane); m = mn; if (m >= M) break;
            } }
    }
    for (int m = gw; m < MMEM; m += NGW) rms_row_to_bf16(F.mem + (size_t)m * DM, F.g_mem, (bf16*)(F.ws + WS_MN) + (size_t)m * DM, F.lane);
    float* cs = (float*)(F.ws + WS_CS);
    for (int e = (F.vcu * NWAVES + F.wave) * 64 + F.lane; e < M * 16; e += NGW * 64) {
        const int m = e >> 4, i = e & 15; const float ang = (float)F.pos[m] * INV_FREQ[i];
        double rev = (double)ang * 0.15915494309189535; rev -= floor(rev);
        const float a = (float)(rev * 6.283185307179586);
        cs[(size_t)m * 32 + i] = cosf(a); cs[(size_t)m * 32 + 16 + i] = sinf(a);
    }
}

__device__ __forceinline__ void ffn_item(Frame& F, TItem& t, int it) {
    constexpr int I5 = (DM / 64) * (2 * FF / 32);
    if (it < I5) ti_decode(t, F.w_gu, DM, 2 * FF, F.ws + WS_WGU, F.g_ffn, 1, S_WGU, 1, 0, it);
    else ti_decode(t, F.w_dn, FF, DM, F.ws + WS_WDN, nullptr, 0, S_WDN, 1, 0, it - I5);
}
__device__ __forceinline__ void ffn_weight_items(Frame& F, int wi, int nw) {
    LAS float* scr = (LAS float*)(F.lds + F.wave * 16384);
    constexpr int I5 = (DM / 64) * (2 * FF / 32), I6 = (FF / 64) * (DM / 32), NI = I5 + I6;
    float va[32], vb[32]; f32x4 ga[2], gb[2]; TItem ta, tb;
    int it = wi;
    if (it < NI) { ffn_item(F, ta, it); ti_load(ta, va, ga, F.lane);
        for (;;) {
            int itn = it + nw; ffn_item(F, tb, itn < NI ? itn : it); ti_load(tb, vb, gb, F.lane);
            ti_finish(ta, va, ga, scr, F.lane); it = itn; if (it >= NI) break;
            itn = it + nw; ffn_item(F, ta, itn < NI ? itn : it); ti_load(ta, va, ga, F.lane);
            ti_finish(tb, vb, gb, scr, F.lane); it = itn; if (it >= NI) break;
        } }
}

__device__ __forceinline__ void final_norm_phase(Frame& F, const bf16* src, float* dst) {
    const int gw = F.vcu * NWAVES + F.wave, NGW = F.G * NWAVES;
    for (int m = gw; m < M; m += NGW) {
        const GAS v4u* xr = (const GAS v4u*)(src + (size_t)m * DM) + F.lane; const GAS f32x4* gr = (const GAS f32x4*)F.g_final;
        v4u w[4]; float s = 0.f;
#pragma unroll
        for (int j = 0; j < 4; ++j) w[j] = xr[64 * j];
        f32x4 v[8];
#pragma unroll
        for (int j = 0; j < 4; ++j) { v[2 * j] = (f32x4){__uint_as_float(w[j].x << 16), __uint_as_float(w[j].x & 0xffff0000u), __uint_as_float(w[j].y << 16), __uint_as_float(w[j].y & 0xffff0000u)};
            v[2 * j + 1] = (f32x4){__uint_as_float(w[j].z << 16), __uint_as_float(w[j].z & 0xffff0000u), __uint_as_float(w[j].w << 16), __uint_as_float(w[j].w & 0xffff0000u)}; }
#pragma unroll
        for (int j = 0; j < 8; ++j) s += (v[j].x * v[j].x + v[j].y * v[j].y) + (v[j].z * v[j].z + v[j].w * v[j].w);
        const float rstd = 1.0f / sqrtf(wave_sum(s) * (1.f / DM) + EPS);
        GAS f32x4* dr = (GAS f32x4*)(dst + (size_t)m * DM);
#pragma unroll
        for (int j = 0; j < 4; ++j) { const int c4 = (64 * j + F.lane) * 2;
            dr[c4] = v[2 * j] * rstd * gr[c4]; dr[c4 + 1] = v[2 * j + 1] * rstd * gr[c4 + 1]; }
    }
}

struct RowOrder : pg8::StaticOrder {
    __device__ __forceinline__ bool next(int i, pg8::Unit& u) const {
        const long L = (long)i * G + c; if (L >= nwg) return false;
        int wgid = (int)L; { const int q = nwg / pg8::NXCD, xcd = wgid % pg8::NXCD, off = wgid / pg8::NXCD; wgid = xcd * q + off; }
        u.pm = wgid / nN; u.pn = wgid % nN; return true;
    }
};
struct DepOrder {
    int b, h, s; unsigned* cnt; int tid; mutable bool ok;
    __device__ __forceinline__ bool next(int i, pg8::Unit& u) const { if (i >= 2) return false; u.pm = b * 8 + (i ? s : 7 - s); u.pn = h; return true; }
    __device__ __forceinline__ void a_ready(const pg8::Unit& u) const {
        if (ok) return; ok = true;
        if (tid == 0) { unsigned sp = 0u;
            while (__hip_atomic_load(cnt + u.pm, __ATOMIC_RELAXED, __HIP_MEMORY_SCOPE_AGENT) < 8u) { __builtin_amdgcn_s_sleep(2); if (++sp > (1u << 22)) break; }
            __builtin_amdgcn_fence(__ATOMIC_ACQUIRE, "agent"); }
        __syncthreads();
    }
    __device__ __forceinline__ void done(const pg8::Unit&) const {}
};
struct OneUnit {
    int pm, pn; bool has;
    __device__ __forceinline__ bool next(int i, pg8::Unit& u) const { if (i != 0 || !has) return false; u.pm = pm; u.pn = pn; return true; }
    __device__ __forceinline__ void a_ready(const pg8::Unit&) const {}
    __device__ __forceinline__ void done(const pg8::Unit&) const {}
};
struct RangeOrder : pg8::StaticOrder {
    int i0, n;
    __device__ __forceinline__ bool next(int i, pg8::Unit& u) const { return i < n && pg8::StaticOrder::next(i + i0, u); }
};
template <int K> __device__ __forceinline__ const void* late_arg() {
    const void* p; asm volatile("s_load_dwordx2 %0, %1, %2\n\ts_waitcnt lgkmcnt(0)" : "=s"(p) : "s"(__builtin_amdgcn_kernarg_segment_ptr()), "i"(K * 8));
    return p;
}
#define XB_LSUB(j)  (3456 + 64 * (j))
#define XB_LGEN(j)  (4480 + 64 * (j))
__device__ __forceinline__ void xcd_local_barrier(const XcdBarrier& b) {
    asm volatile("s_waitcnt vmcnt(0)" ::: "memory");
    __syncthreads();
    if (threadIdx.x == 0) {
        unsigned* bar = b.bar;
        __builtin_amdgcn_s_waitcnt(0);
        const unsigned nloc = b.st[0];
        const unsigned old = xb_add(&bar[XB_LSUB(b.x)], 1u);
        const unsigned gen = old / nloc;
        if (old + 1u == (gen + 1u) * nloc) xb_add(&bar[XB_LGEN(b.x)], 1u);
        else XB_SPIN(xb_ld(&bar[XB_LGEN(b.x)]) == gen, bar);
        __builtin_amdgcn_fence(__ATOMIC_ACQUIRE, "agent");
        asm volatile("s_waitcnt vmcnt(0)" ::: "memory");
    }
    __syncthreads();
}
#ifndef BATCHBAR
#define BATCHBAR 1
#endif
#ifndef XCDLOCAL
#define XCDLOCAL 1
#endif
__device__ __forceinline__ void batch_bar(unsigned* cnt, int tid) {
    asm volatile("s_waitcnt vmcnt(0)" ::: "memory"); __syncthreads();
    if (tid == 0) { __hip_atomic_fetch_add(cnt, 1u, __ATOMIC_RELAXED, __HIP_MEMORY_SCOPE_AGENT);
        unsigned sp = 0u;
        while (__hip_atomic_load(cnt, __ATOMIC_RELAXED, __HIP_MEMORY_SCOPE_AGENT) < 32u) { __builtin_amdgcn_s_sleep(1); if (++sp > (1u << 22)) break; }
        __builtin_amdgcn_fence(__ATOMIC_ACQUIRE, "agent"); }
    __syncthreads();
}
constexpr int NPH = 11;
#ifndef DEP34
#define DEP34 1
#endif
#ifndef FUSE_FINAL
#define FUSE_FINAL 1
#endif
#ifndef REPEAT_WHICH
#define REPEAT_WHICH 3
#endif
#ifndef NULL_EPI_PROBE
#define NULL_EPI_PROBE 0
#endif
#ifndef FOLD_KMEAN
#define FOLD_KMEAN 1
#endif
#ifndef REPEAT_PHASE
#define REPEAT_PHASE -1
#endif
#ifndef REPEAT_MASK
#define REPEAT_MASK 0
#endif
#define REPS(k) (((REPEAT_PHASE == (k)) || ((REPEAT_MASK >> (k)) & 1)) ? 2 : 1)
#ifndef USE_MFMA_SB
#define USE_MFMA_SB 1
#endif
#ifndef USE_MFMA_MOBA
#define USE_MFMA_MOBA 1
#endif
#ifndef USE_MFMA_X
#define USE_MFMA_X 1
#endif
#ifndef MK_ONE_LAUNCH
#define MK_ONE_LAUNCH 1
#endif
struct Args { const void* in[17]; float* out; unsigned char* ws; int ph_lo, ph_hi; };
__global__ void __launch_bounds__(NWAVES * 64, 2) mk_fwd(Args args) {
    extern __shared__ __attribute__((aligned(16))) unsigned char lds[];
    Frame F;
    F.lds = (LAS unsigned char*)lds;
    F.tid = threadIdx.x; F.lane = F.tid & 63; F.wave = __builtin_amdgcn_readfirstlane(F.tid >> 6);
    F.G = gridDim.x; { const int bx = blockIdx.x; F.vcu = (F.G % 8 == 0) ? (bx % 8) * (F.G / 8) + bx / 8 : bx; }
    F.x = (const float*)args.in[0]; F.mem = (const float*)args.in[1]; F.pos = (const int*)args.in[2];
    F.g_mix = (const float*)args.in[3]; F.w_in = (const float*)args.in[4]; F.g_out_sb = nullptr; F.g_out_mb = nullptr; F.w_out = (const float*)args.in[7];
    F.g_xattn = (const float*)args.in[8]; F.g_mem = (const float*)args.in[9]; F.w_xq = (const float*)args.in[10]; F.w_xkv = (const float*)args.in[11]; F.w_xo = (const float*)args.in[12];
    F.g_ffn = nullptr; F.w_gu = nullptr; F.w_dn = nullptr; F.g_final = nullptr;
    F.out = args.out; F.ws = args.ws;
    unsigned char* ws = args.ws;
    const int lo = args.ph_lo, hi = args.ph_hi;
    for (int u = F.tid; u < (LDS_BYTES - LDSCTL_OFF) / 4; u += NWAVES * 64) ((LAS unsigned*)(F.lds + LDSCTL_OFF))[u] = 0u;
    __syncthreads();
    if (hi - lo > 1) {
        { GAS v4u* z = (GAS v4u*)(ws + WS_CTL); const int n16 = (int)(CTL_ZERO_BYTES / 16);
          for (int i = (int)blockIdx.x * (NWAVES * 64) + F.tid; i < n16; i += F.G * NWAVES * 64) z[i] = (v4u){0u, 0u, 0u, 0u}; }
        cg::this_grid().sync();
    }
    unsigned* xmask = (unsigned*)(ws + WS_CTL + 52 * 1024);
    if (F.tid == 0 && F.G == 256) __hip_atomic_fetch_or(xmask + (F.vcu >> 5), 1u << (xb_xcc_id() & 15u), __ATOMIC_RELAXED, __HIP_MEMORY_SCOPE_AGENT);
    XcdBarrier bar = xcd_barrier_post((unsigned*)(ws + WS_CTL) + CW_BAR, (volatile LAS unsigned*)(F.lds + MISC_OFF) + 8);
#ifndef ONLY_PHASE
#define ONLY_PHASE -1
#endif
#define IN(k) ((ONLY_PHASE < 0 || ONLY_PHASE == (k)) && lo <= (k) && (k) < hi)
#define BOTH(k) (IN(k) && IN((k) + 1))
#define GRID_BAR() xcd_barrier(bar)
    float* ssq1 = (float*)(ws + WS_SSQ1); float* ssq2 = (float*)(ws + WS_SSQ2);
    constexpr size_t ACT_BGAP = 24 * MiB - (size_t)SEQ * FF;
    pg8::bf16_t* ACT = (pg8::bf16_t*)(ws + WS_RC);
    pg8::bf16_t* RA = (pg8::bf16_t*)(ws + WS_RA); pg8::bf16_t* RB = (pg8::bf16_t*)(ws + WS_RB); pg8::bf16_t* RC = (pg8::bf16_t*)(ws + WS_RC);

    if (IN(0)) { for (int rep = 0; rep < REPS(0); ++rep) p0_prologue(F); if (BOTH(0)) GRID_BAR(); }
    bool xcd_affine = false;
    if (XCDLOCAL && F.G == 256 && BOTH(0)) { unsigned okb = 1u;
#pragma unroll
        for (int j = 0; j < 8; ++j) { const unsigned mk = __hip_atomic_load(xmask + j, __ATOMIC_RELAXED, __HIP_MEMORY_SCOPE_AGENT); okb &= (unsigned)(mk != 0u && (mk & (mk - 1u)) == 0u); }
        xcd_affine = __builtin_amdgcn_readfirstlane((int)okb) != 0; }
    if (IN(1)) {
        static_assert(S_WQK == S_WV, "one scale for the e4m3 rows of w_in");
        pg8::Gemm g8{RB, (const pg8::bf16_t*)(ws + WS_WIN), M, 4096, DM / 2}; RangeOrder S8; S8.init(M, 4096, F.G, (int)blockIdx.x);
        pg8::EpiQKV E8{RC, (const float*)(ws + WS_CS), QSCALE, (float*)(ws + WS_KSUM), 2, 1.f, (const float*)(ws + WS_RINV0), 1.f / (S_XN * S_WQK), 0};
        pg8::Gemm gm{RA, (const pg8::bf16_t*)(ws + WS_WIN) + (size_t)2048 * DM, M, 2048, DM}; RangeOrder Sm; Sm.init(M, 2048, F.G, (int)blockIdx.x);
        pg8::EpiQKV Em{RC, (const float*)(ws + WS_CS), QSCALE, (float*)(ws + WS_KSUM), 0, 1.f, (const float*)(ws + WS_RINV0), 1.f, 8};
        for (int rep = 0; rep < REPS(1); ++rep) {
        const bool grp = ((blockIdx.x >> 3) & 1) != 0;
        S8.i0 = 0; S8.n = 1 << 20; Sm.i0 = 0; Sm.n = 1 << 20;
        if (grp) pg8::gemm_phase<pg8::EpiQKV, RangeOrder, true, true, true>(F.lds, g8, S8, E8);
        pg8::gemm_phase<pg8::EpiQKV, RangeOrder, true, true>(F.lds, gm, Sm, Em);
        if (!grp) pg8::gemm_phase<pg8::EpiQKV, RangeOrder, true, true, true>(F.lds, g8, S8, E8);
        }
        if (BOTH(1)) { if (BATCHBAR && F.G == 256) batch_bar((unsigned*)(ws + WS_CTL + 51 * 1024) + (F.vcu >> 5), F.tid); else GRID_BAR(); }
    }
    const bool dep34 = (DEP34 != 0) & (WOUT_FP8 != 0) & (int)BOTH(3) & (int)(F.G == 256); unsigned* cnt34 = (unsigned*)(ws + WS_CTL + 49 * 1024);
    if (IN(3)) {
        const att::bf16* qkv = (const att::bf16*)RC; att::bf16* ob = (att::bf16*)RB; const float* kmean = (const float*)(ws + WS_KSUM);
        F.g_out_sb = (const float*)late_arg<5>(); F.g_out_mb = (const float*)late_arg<6>();
        constexpr size_t HSZ = (size_t)SEQ * HD;
        for (int rep = 0; rep < REPS(3); ++rep) {
        if (rep == 0 || (REPEAT_WHICH & 1))
        for (int vv = F.vcu; vv < 256; vv += F.G) { const int bh = vv >> 2, s = vv & 3, b = bh >> 3, h = bh & 7; const size_t rb = (size_t)b * SEQ;
            const att::bf16* hS = qkv + ((size_t)b * 48 + h) * HSZ; const att::bf16* hM = qkv + ((size_t)b * 48 + 24 + h) * HSZ;
            for (int i = 0; i < 2; ++i) { const int qb = i ? s : 7 - s; const size_t r0 = rb + (size_t)qb * 256;
                att::attn_unit<2, true>(hS, nullptr, nullptr, (att::bf16*)((unsigned char*)ob + r0 * DM + h * HD), F.g_out_sb + h * HD, nullptr, qb, 0, (char*)lds, S_O,
                                        i != 0, i ? hM : hS, i ? 7 - s : s, i ? 0 : 4 * (s + 1) - 1, i ? -1 : 4 * (s + 1) - 2); }
            for (int i = 0; i < 2; ++i) { const int qb = i ? s : 7 - s; const size_t r0 = rb + (size_t)qb * 256;
                att::attn_unit<1, true>(hM, nullptr, nullptr, (att::bf16*)((unsigned char*)ob + r0 * DM + NH * HD + h * HD), F.g_out_mb + h * HD, kmean + (size_t)bh * 1024, qb, 0, (char*)lds, S_O,
                                        true, i ? nullptr : hM, s, 0, -1); } }
        }
        if (dep34) {
            asm volatile("s_waitcnt vmcnt(0)" ::: "memory"); __syncthreads();
            if (F.tid == 0) {
                const int bh = F.vcu >> 2, s = F.vcu & 3, b = bh >> 3;
                __hip_atomic_fetch_add(cnt34 + b * 8 + 7 - s, 1u, __ATOMIC_RELAXED, __HIP_MEMORY_SCOPE_AGENT); __hip_atomic_fetch_add(cnt34 + b * 8 + s, 1u, __ATOMIC_RELAXED, __HIP_MEMORY_SCOPE_AGENT); }
        } else if (BOTH(3)) GRID_BAR();
    }
    if (IN(4) && dep34) {
        pg8::Gemm g{RB, (const pg8::bf16_t*)(ws + WS_WOUT), M, DM, DM / 2};
        const int bh = F.vcu >> 2; DepOrder S{bh >> 3, bh & 7, F.vcu & 3, cnt34, F.tid, false};
        pg8::EpiResB<false> E{RA, RA, ssq1, nullptr, 1.f, 1.f / (S_O * S_WO), (LAS float*)(F.lds + 135168)};
        pg8::gemm_phase<pg8::EpiResB<false>, DepOrder, true, true, true>(F.lds, g, S, E);
        if (BOTH(4)) { if (xcd_affine) xcd_local_barrier(bar); else GRID_BAR(); }
    } else
    if (IN(4)) {
        pg8::Gemm g{RB, (const pg8::bf16_t*)(ws + WS_WOUT), M, DM, WOUT_FP8 ? DM / 2 : DM}; pg8::StaticOrder S; S.init(M, DM, F.G, (int)blockIdx.x);
        pg8::EpiResB<false> E{RA, RA, ssq1, nullptr, 1.f, WOUT_FP8 ? 1.f / (S_O * S_WO) : 1.f, (LAS float*)(F.lds + 135168)};
        pg8::gemm_phase<pg8::EpiResB<false>, pg8::StaticOrder, true, true, WOUT_FP8 != 0>(F.lds, g, S, E);
        if (BOTH(4)) { if (xcd_affine) xcd_local_barrier(bar); else GRID_BAR(); }
    }
    if (IN(5)) {
      F.w_gu = (const float*)late_arg<14>(); F.g_ffn = (const float*)late_arg<13>(); F.w_dn = (const float*)late_arg<15>();
      for (int rep = 0; rep < REPS(5); ++rep) {
        { pg8::Gemm g{RA, (const pg8::bf16_t*)(ws + WS_WXQ), M, WX, DM}; pg8::StaticOrder S; S.init(M, WX, F.G, (int)blockIdx.x);
          pg8::EpiScale E{(pg8::bf16_t*)(ws + WS_QX), WX, ssq1, QSCALE};
          pg8::gemm_phase<pg8::EpiScale, pg8::StaticOrder, true, true>(F.lds, g, S, E); }
        if (F.G == 256) {
          pg8::Gemm g{(const pg8::bf16_t*)(ws + WS_MN), (const pg8::bf16_t*)(ws + WS_WXKV), MMEM, 2 * WX, DM}; const int bx = (int)blockIdx.x; OneUnit S{bx & 7, (bx >> 3) - 16, bx >= 128 && bx < 160};
          pg8::EpiScale E{(pg8::bf16_t*)(ws + WS_KVX), 2 * WX, nullptr, 1.0f};
          pg8::gemm_phase<pg8::EpiScale, OneUnit, true, true>(F.lds, g, S, E);
        } else
        { pg8::Gemm g{(const pg8::bf16_t*)(ws + WS_MN), (const pg8::bf16_t*)(ws + WS_WXKV), MMEM, 2 * WX, DM}; pg8::StaticOrder S; S.init(MMEM, 2 * WX, F.G, (int)((blockIdx.x + F.G - 128) % F.G));
          pg8::EpiScale E{(pg8::bf16_t*)(ws + WS_KVX), 2 * WX, nullptr, 1.0f};
          pg8::gemm_phase<pg8::EpiScale, pg8::StaticOrder, true, true>(F.lds, g, S, E); }
        if (F.G > 160) { if ((int)blockIdx.x >= 160) ffn_weight_items(F, ((int)blockIdx.x - 160) * NWAVES + F.wave, (F.G - 160) * NWAVES); }
        else ffn_weight_items(F, (int)blockIdx.x * NWAVES + F.wave, F.G * NWAVES);
      }
        if (xcd_affine && (int)blockIdx.x >= 160) {
            asm volatile("s_waitcnt vmcnt(0)" ::: "memory"); __syncthreads();
            if (F.tid == 0) { __builtin_amdgcn_fence(__ATOMIC_RELEASE, "agent"); asm volatile("s_waitcnt vmcnt(0)" ::: "memory");
                __hip_atomic_fetch_add((unsigned*)(ws + WS_CTL + 53 * 1024), 1u, __ATOMIC_RELAXED, __HIP_MEMORY_SCOPE_AGENT); } }
        if (BOTH(5)) { if (xcd_affine) xcd_local_barrier(bar); else GRID_BAR(); }
    }
    if (IN(6)) {
        const att::bf16* qx = (const att::bf16*)(ws + WS_QX); const att::bf16* kvx = (const att::bf16*)(ws + WS_KVX); att::bf16* ox = (att::bf16*)(ws + WS_OX);
        for (int rep = 0; rep < REPS(6); ++rep) {
        for (int vv = F.vcu; vv < 256; vv += F.G) { const int b = vv >> 5, h = (vv >> 3) & 3, qb = vv & 7; const size_t r0 = (size_t)b * SEQ + (size_t)qb * 256;
            if (WXO_FP8) att::attn_unit<0, true>(qx + r0 * WX + h * HD, kvx + (size_t)b * NMEM * (2 * WX) + h * HD, kvx + (size_t)b * NMEM * (2 * WX) + WX + h * HD, (att::bf16*)((unsigned char*)ox + r0 * WX + h * HD), nullptr, nullptr, qb, NMEM, (char*)lds, S_OX);
            else att::attn_unit<0>(qx + r0 * WX + h * HD, kvx + (size_t)b * NMEM * (2 * WX) + h * HD, kvx + (size_t)b * NMEM * (2 * WX) + WX + h * HD, ox + r0 * WX + h * HD, nullptr, nullptr, qb, NMEM, (char*)lds); }
        }
        if (BOTH(6)) { if (xcd_affine) xcd_local_barrier(bar); else GRID_BAR(); }
    }
    if (IN(7)) {
        pg8::Gemm g{(const pg8::bf16_t*)(ws + WS_OX), (const pg8::bf16_t*)(ws + WS_WXO), M, DM, WXO_FP8 ? WX / 2 : WX}; pg8::StaticOrder S; S.init(M, DM, F.G, (int)blockIdx.x);
        pg8::EpiResB<false> E{RA, RA, ssq2, (unsigned char*)RB, S_X2, WXO_FP8 ? 1.f / (S_OX * S_WXO) : 1.f, (LAS float*)(F.lds + 135168)};
        pg8::gemm_phase<pg8::EpiResB<false>, pg8::StaticOrder, true, true, WXO_FP8 != 0>(F.lds, g, S, E);
        if (BOTH(7)) { if (xcd_affine) xcd_local_barrier(bar); else GRID_BAR(); }
    }
    if (IN(8) && xcd_affine) {
        if (F.tid == 0) { unsigned sp = 0u;
            while (__hip_atomic_load((unsigned*)(ws + WS_CTL + 53 * 1024), __ATOMIC_RELAXED, __HIP_MEMORY_SCOPE_AGENT) < (unsigned)(F.G - 160)) { __builtin_amdgcn_s_sleep(2); if (++sp > (1u << 22)) break; }
            __builtin_amdgcn_fence(__ATOMIC_ACQUIRE, "agent"); asm volatile("s_waitcnt vmcnt(0)" ::: "memory"); }
        __syncthreads(); }
    if (IN(8)) {
        pg8::Gemm g{RB, (const pg8::bf16_t*)(ws + WS_WGU), M, 2 * FF, FFN_FP8 ? DM / 2 : DM}; pg8::StaticOrder S; S.init(M, 2 * FF, F.G, (int)blockIdx.x);
        pg8::EpiSwiGLU E{ACT, ssq2, FFN_FP8 ? (unsigned char*)ACT : nullptr, FFN_FP8 ? 1.f / (S_X2 * S_WGU) : 1.f, S_ACT, ACT_BGAP};
#if NULL_EPI_PROBE
        if (REPS(8) == 2) { pg8::EpiNull EN{nullptr}; pg8::gemm_phase<pg8::EpiNull, pg8::StaticOrder, true, true, FFN_FP8 != 0>(F.lds, g, S, EN); }
        pg8::gemm_phase<pg8::EpiSwiGLU, pg8::StaticOrder, true, true, FFN_FP8 != 0>(F.lds, g, S, E);
#else
        for (int rep = 0; rep < REPS(8); ++rep) pg8::gemm_phase<pg8::EpiSwiGLU, pg8::StaticOrder, true, true, FFN_FP8 != 0>(F.lds, g, S, E);
#endif
        if (BOTH(8)) { if (xcd_affine) xcd_local_barrier(bar); else GRID_BAR(); }
    }
    if (IN(9)) {
        pg8::Gemm g{ACT, (const pg8::bf16_t*)(ws + WS_WDN), M, DM, FF / 2, ACT_BGAP};
        const bool fuse = FUSE_FINAL && BOTH(9) && F.G * 2 == (M / 256) * (DM / 256) && (F.G % 8) == 0;
        if (fuse) {
            F.g_final = (const float*)late_arg<16>();
            RowOrder S; S.init(M, DM, F.G, (int)blockIdx.x);
            pg8::EpiResFinal E{RA, F.out, (float*)(ws + WS_CTL + 192 * 1024), (unsigned*)(ws + WS_CTL + 48 * 1024), F.g_final, 1.f / (S_ACT * S_WDN), (LAS float*)(F.lds + 135168)};
            pg8::gemm_phase<pg8::EpiResFinal, RowOrder, true, true, true>(F.lds, g, S, E);
            return;
        }
        pg8::StaticOrder S; S.init(M, DM, F.G, (int)blockIdx.x);
        pg8::EpiResB<false> E{RA, RA, nullptr, nullptr, 1.f, 1.f / (S_ACT * S_WDN), (LAS float*)(F.lds + 135168)};
        pg8::gemm_phase<pg8::EpiResB<false>, pg8::StaticOrder, true, true, true>(F.lds, g, S, E);
        if (BOTH(9)) GRID_BAR();
    }
    if (IN(10)) { F.g_final = (const float*)late_arg<16>(); final_norm_phase(F, RA, F.out); }
#undef IN
#undef BOTH
}

extern "C" void kernel_launch(void* const* d_in, const int* in_sizes, int n_in, void* d_out, int out_size, void* d_ws, size_t ws_size, hipStream_t stream) {
    static int grid = 0;
    if (grid == 0) {
        if (n_in != 17 || in_sizes[0] != M * DM || out_size != M * DM || ws_size < WS_END) { fprintf(stderr, "kernel_launch: unexpected shapes (n_in %d in0 %d out %d ws %zu)\n", n_in, n_in > 0 ? in_sizes[0] : -1, out_size, ws_size); grid = -1; return; }
        int dev = 0, cus = 0, per_cu = 0;
        if (hipGetDevice(&dev) != hipSuccess || hipDeviceGetAttribute(&cus, hipDeviceAttributeMultiprocessorCount, dev) != hipSuccess) { grid = -1; return; }
        if (hipFuncSetAttribute((const void*)mk_fwd, hipFuncAttributeMaxDynamicSharedMemorySize, LDS_BYTES) != hipSuccess) { fprintf(stderr, "kernel_launch: hipFuncSetAttribute failed\n"); grid = -1; return; }
        if (hipOccupancyMaxActiveBlocksPerMultiprocessor(&per_cu, (const void*)mk_fwd, NWAVES * 64, LDS_BYTES) != hipSuccess || per_cu < 1) { fprintf(stderr, "kernel_launch: occupancy query failed (%d)\n", per_cu); per_cu = 1; }
        (void)hipGetLastError();
        grid = cus * (per_cu < 1 ? 1 : 1);
    }
    if (grid < 0) return;
#if !MK_ONE_LAUNCH
    (void)hipMemsetAsync((char*)d_ws + WS_CTL, 0, CTL_ZERO_BYTES, stream);
#endif
    Args a{};
    for (int i = 0; i < 17; ++i) a.in[i] = d_in[i];
    a.out = (float*)d_out; a.ws = (unsigned char*)d_ws;
#if MK_ONE_LAUNCH
    a.ph_lo = 0; a.ph_hi = NPH;
    void* kargs[] = {&a};
    hipError_t e = hipLaunchCooperativeKernel((const void*)mk_fwd, dim3(grid), dim3(NWAVES * 64), kargs, LDS_BYTES, stream);
    if (e != hipSuccess) fprintf(stderr, "kernel_launch: cooperative launch failed: %s (grid %d)\n", hipGetErrorString(e), grid);
#else
    for (int p = 0; p < NPH; ++p) { a.ph_lo = p; a.ph_hi = p + 1; hipLaunchKernelGGL(mk_fwd, dim3(grid), dim3(NWAVES * 64), LDS_BYTES, stream, a); }
    const hipError_t le = hipPeekAtLastError();
    if (le != hipSuccess) fprintf(stderr, "kernel_launch: launch failed: %s\n", hipGetErrorName(le));
#endif
}
```
